# Optimizing an MI355X kernel written in HIP

```python
import jax, jax.numpy as jnp
from jax import lax
import numpy as np

D_MODEL = 1024
BATCH = 4
SEQ = 8192
DEPTH = 2

F32 = jnp.float32
CHUNK = 64
MIX_HALF = D_MODEL // 2
A_HEADS = 4
A_DK = MIX_HALF // A_HEADS
A_DV = MIX_HALF // A_HEADS
B_HEADS = 4
B_DK = MIX_HALF // (2 * B_HEADS)
B_DV = MIX_HALF // B_HEADS
GLA_LOWRANK = 16
GLA_GATE_NORMALIZER = 16.0
C_HEADS = 4
C_DK = MIX_HALF // (2 * C_HEADS)
C_DV = MIX_HALF // C_HEADS
ROPE_THETA = 10000.0
D_HEADS = 4
D_DK = MIX_HALF // D_HEADS
D_DV = MIX_HALF // D_HEADS
CONV_WIDTH = 3
N_EXPERTS = 16
N_GROUPS = 4
EXPERTS_PER_GROUP = N_EXPERTS // N_GROUPS
TOP_K = 2
D_EXPERT = D_MODEL
DISPATCH_BLOCK = 128
ALPHA = (2.0 * DEPTH) ** 0.25
BETA = (8.0 * DEPTH) ** -0.25
N_AB = (DEPTH + 1) // 2
N_CD = DEPTH // 2
LN_EPS = 1e-5
NORM_EPS = 1e-6

AB_SPLITS = (A_HEADS * A_DK, A_HEADS * A_DK, A_HEADS * A_DK, A_HEADS * A_DV, A_HEADS * A_DV,
             B_HEADS * B_DK, B_HEADS * B_DK, B_HEADS * B_DV, B_HEADS * B_DV, GLA_LOWRANK, GLA_LOWRANK)
AB_VALUE_COLS = (3, 7)
CD_SPLITS = (C_HEADS * C_DK, C_HEADS * C_DK, C_HEADS * C_DV, C_HEADS * C_DV,
             2 * D_HEADS * D_DK, D_HEADS * D_DV, D_HEADS * D_DV, 4 * D_HEADS)
CD_VALUE_COLS = (2, 5)
P_AB = sum(AB_SPLITS)
P_CD = sum(CD_SPLITS)
MIX_AB = A_HEADS * A_DV + B_HEADS * B_DV
MIX_CD = C_HEADS * C_DV + D_HEADS * D_DV

kernel_name = 'bidir_hybrid_hgrn2_gla_retnet_mlstm_moe'


def _split(p, sizes):
    return jnp.split(p, [int(c) for c in np.cumsum(sizes)[:-1]], axis=-1)


def _heads(a, n_heads):
    b, t, w = a.shape
    return a.reshape(b, t, n_heads, w // n_heads).transpose(0, 2, 1, 3)


def _merge_heads(a):
    b, h, t, d = a.shape
    return a.transpose(0, 2, 1, 3).reshape(b, t, h * d)


def _flip(a):
    return jnp.flip(a, axis=2)


def _chunk(a):
    b, h, t = a.shape[:3]
    return jnp.moveaxis(a.reshape(b, h, t // CHUNK, CHUNK, *a.shape[3:]), 2, 0)


def _unchunk(a):
    n, b, h, l = a.shape[:4]
    return jnp.moveaxis(a, 0, 2).reshape(b, h, n * l, *a.shape[4:])


def _lower_mask():
    return jnp.tril(jnp.ones((CHUNK, CHUNK), dtype=bool))


def _head_norm(o, gain):
    o = o * lax.rsqrt(jnp.mean(o * o, axis=-1, keepdims=True) + NORM_EPS)
    return _merge_heads(o) * gain.astype(F32)


def _layer_norm(x, gain, bias):
    xf = x.astype(F32)
    xc = xf - jnp.mean(xf, axis=-1, keepdims=True)
    var = jnp.mean(xc * xc, axis=-1, keepdims=True)
    return (xc * lax.rsqrt(var + LN_EPS) * gain.astype(F32) + bias.astype(F32)).astype(x.dtype)


def _rotary(a):
    t, d = a.shape[2], a.shape[3]
    half = d // 2
    freqs = ROPE_THETA ** (-jnp.arange(half, dtype=F32) / half)
    ang = jnp.arange(t, dtype=F32)[:, None] * freqs[None, :]
    cos, sin = jnp.cos(ang), jnp.sin(ang)
    a1, a2 = a[..., :half], a[..., half:]
    return jnp.concatenate([a1 * cos - a2 * sin, a1 * sin + a2 * cos], axis=-1)


def _conv_centred(a, w, b):
    c = a.shape[-1]
    out = lax.conv_general_dilated(a, w.astype(a.dtype)[:, None, :], window_strides=(1,), padding='SAME',
                                   dimension_numbers=('NWC', 'WIO', 'NWC'), feature_group_count=c)
    return out + b.astype(a.dtype)


def _gated_chunk_scan(q, k, v, log_f):
    b, h, _, dk = q.shape
    dv = v.shape[-1]
    qc, kc, vc, gc = _chunk(q), _chunk(k), _chunk(v), _chunk(log_f)
    g_cum = jnp.cumsum(gc, axis=-2)
    g_ref = g_cum[..., CHUNK // 2 - 1:CHUNK // 2, :]
    scores = jnp.einsum('nbhid,nbhjd->nbhij', qc * jnp.exp(g_cum - g_ref), kc * jnp.exp(g_ref - g_cum))
    scores = jnp.where(_lower_mask(), scores, 0.0)
    o_intra = jnp.einsum('nbhij,nbhjv->nbhiv', scores, vc)
    q_inter = qc * jnp.exp(g_cum)
    k_state = kc * jnp.exp(g_cum[..., -1:, :] - g_cum)
    chunk_decay = jnp.exp(g_cum[..., -1, :])

    def step(state, xs):
        qn, kn, vn, dn = xs
        out = jnp.einsum('bhid,bhdv->bhiv', qn, state)
        state = dn[..., None] * state + jnp.einsum('bhjd,bhjv->bhdv', kn, vn)
        return state, out

    state0 = jnp.zeros((b, h, dk, dv), F32)
    _, o_inter = lax.scan(step, state0, (q_inter, k_state, vc, chunk_decay))
    return _unchunk(o_intra + o_inter)


def _retention_log_decay(direction):
    exps = 5.0 + 2.0 * jnp.arange(C_HEADS, dtype=F32) + direction
    return jnp.log1p(-jnp.exp2(-exps))


def _retention_chunk_scan(q, k, v, log_gamma):
    b, h, _, dk = q.shape
    dv = v.shape[-1]
    qc, kc, vc = _chunk(q), _chunk(k), _chunk(v)
    pos = jnp.arange(CHUNK, dtype=F32)
    lg = log_gamma[:, None, None]
    dist = pos[:, None] - pos[None, :]
    decay_intra = jnp.where(_lower_mask(), jnp.exp(jnp.maximum(dist, 0.0)[None] * lg), 0.0)
    scores = jnp.einsum('nbhid,nbhjd->nbhij', qc, kc) * decay_intra
    o_intra = jnp.einsum('nbhij,nbhjv->nbhiv', scores, vc)
    q_inter = qc * jnp.exp((pos + 1.0)[None, :, None] * lg)
    k_state = kc * jnp.exp((CHUNK - 1.0 - pos)[None, :, None] * lg)
    chunk_decay = jnp.exp(CHUNK * log_gamma)[:, None, None]

    def step(state, xs):
        qn, kn, vn = xs
        out = jnp.einsum('bhid,bhdv->bhiv', qn, state)
        state = chunk_decay * state + jnp.einsum('bhjd,bhjv->bhdv', kn, vn)
        return state, out

    state0 = jnp.zeros((b, h, dk, dv), F32)
    _, o_inter = lax.scan(step, state0, (q_inter, k_state, vc))
    return _unchunk(o_intra + o_inter)


def _mlstm_chunk_scan(q, k, v, log_i, log_f):
    b, h, _, dk = q.shape
    dv = v.shape[-1]
    qc, kc, vc = _chunk(q), _chunk(k), _chunk(v)
    ic, fc = _chunk(log_i), _chunk(log_f)
    b_cum = jnp.cumsum(fc, axis=-1)
    log_d = jnp.where(_lower_mask(), b_cum[..., :, None] - b_cum[..., None, :] + ic[..., None, :], -jnp.inf)
    m_intra = jnp.max(log_d, axis=-1)
    qk = jnp.einsum('nbhid,nbhjd->nbhij', qc, kc)
    log_w = b_cum[..., -1:] - b_cum + ic

    def step(carry, xs):
        c_st, n_st, m_st = carry
        qn, kn, vn, bn, ldn, min_, qkn, lwn = xs
        a = bn + m_st[..., None]
        m_i = jnp.maximum(a, min_)
        w = qkn * jnp.exp(ldn - m_i[..., None])
        s_inter = jnp.exp(a - m_i)
        num = s_inter[..., None] * jnp.einsum('bhid,bhdv->bhiv', qn, c_st) + jnp.einsum('bhij,bhjv->bhiv', w, vn)
        den = s_inter * jnp.einsum('bhid,bhd->bhi', qn, n_st) + jnp.sum(w, axis=-1)
        h_out = num / jnp.maximum(jnp.abs(den), jnp.exp(-m_i))[..., None]
        m_new = jnp.maximum(bn[..., -1] + m_st, jnp.max(lwn, axis=-1))
        s_old = jnp.exp(bn[..., -1] + m_st - m_new)
        wk = kn * jnp.exp(lwn - m_new[..., None])[..., None]
        c_st = s_old[..., None, None] * c_st + jnp.einsum('bhjd,bhjv->bhdv', wk, vn)
        n_st = s_old[..., None] * n_st + jnp.sum(wk, axis=-2)
        return (c_st, n_st, m_new), h_out

    carry0 = (jnp.zeros((b, h, dk, dv), F32), jnp.zeros((b, h, dk), F32), jnp.zeros((b, h), F32))
    _, h_all = lax.scan(step, carry0, (qc, kc, vc, b_cum, log_d, m_intra, qk, log_w))
    return _unchunk(h_all)


def _mixer_ab(x, w_in, b_in, lb, gk_up, gk_b, norm_a, norm_b, w_out):
    p = (x @ w_in + b_in).astype(F32)
    qa_r, fa_fwd, fa_bwd, ia_r, ga_r, qb_r, kb_r, vb_r, gb_r, rb_fwd, rb_bwd = _split(p, AB_SPLITS)
    q_a = _heads(jax.nn.silu(qa_r), A_HEADS)
    v_a = _heads(ia_r, A_HEADS)

    def hgrn_gates(f_logit):
        f = lb + (1.0 - lb) * jax.nn.sigmoid(f_logit)
        return _heads(1.0 - f, A_HEADS), _heads(jnp.log(f), A_HEADS)

    k_af, lf_af = hgrn_gates(fa_fwd)
    k_ab, lf_ab = hgrn_gates(fa_bwd)
    o_a = (_gated_chunk_scan(q_a, k_af, v_a, lf_af)
           + _flip(_gated_chunk_scan(_flip(q_a), _flip(k_ab), _flip(v_a), _flip(lf_ab))))
    o_a = _head_norm(o_a, norm_a) * jax.nn.silu(ga_r)
    q_b = _heads(qb_r, B_HEADS) * (B_DK ** -0.5)
    k_b = _heads(kb_r, B_HEADS)
    v_b = _heads(vb_r, B_HEADS)
    lf_bf = _heads(jax.nn.log_sigmoid(rb_fwd @ gk_up[0] + gk_b[0]) / GLA_GATE_NORMALIZER, B_HEADS)
    lf_bb = _heads(jax.nn.log_sigmoid(rb_bwd @ gk_up[1] + gk_b[1]) / GLA_GATE_NORMALIZER, B_HEADS)
    o_b = (_gated_chunk_scan(q_b, k_b, v_b, lf_bf)
           + _flip(_gated_chunk_scan(_flip(q_b), _flip(k_b), _flip(v_b), _flip(lf_bb))))
    o_b = _head_norm(o_b, norm_b) * jax.nn.silu(gb_r)
    mixed = jnp.concatenate([o_a, o_b], axis=-1).astype(x.dtype)
    return mixed @ w_out


def _mixer_cd(x, w_in, b_in, conv_w, conv_b, fgate_b, norm_c, norm_d, w_out):
    p = (x @ w_in + b_in).astype(F32)
    qc_r, kc_r, vc_r, gc_r, qkd_r, vd_r, od_r, gates = _split(p, CD_SPLITS)
    q_c = _rotary(_heads(qc_r, C_HEADS)) * (C_DK ** -0.5)
    k_c = _rotary(_heads(kc_r, C_HEADS))
    v_c = _heads(vc_r, C_HEADS)
    o_c = (_retention_chunk_scan(q_c, k_c, v_c, _retention_log_decay(0.0))
           + _flip(_retention_chunk_scan(_flip(q_c), _flip(k_c), _flip(v_c), _retention_log_decay(1.0))))
    o_c = _head_norm(o_c, norm_c) * jax.nn.silu(gc_r)
    qk_d = jax.nn.silu(_conv_centred(qkd_r, conv_w, conv_b))
    qd_r, kd_r = jnp.split(qk_d, 2, axis=-1)
    q_d = _heads(qd_r, D_HEADS) * (D_DK ** -0.5)
    k_d = _heads(kd_r, D_HEADS)
    v_d = _heads(vd_r, D_HEADS)
    gates = gates.transpose(0, 2, 1)
    li_f, lf_f_raw, li_b, lf_b_raw = jnp.split(gates, 4, axis=1)
    lf_f = jax.nn.log_sigmoid(lf_f_raw + fgate_b[0][:, None])
    lf_b = jax.nn.log_sigmoid(lf_b_raw + fgate_b[1][:, None])
    h_d = (_mlstm_chunk_scan(q_d, k_d, v_d, li_f, lf_f)
           + _flip(_mlstm_chunk_scan(_flip(q_d), _flip(k_d), _flip(v_d), _flip(li_b), _flip(lf_b))))
    o_d = _head_norm(h_d, norm_d) * jax.nn.sigmoid(od_r)
    mixed = jnp.concatenate([o_c, o_d], axis=-1).astype(x.dtype)
    return mixed @ w_out


def _route(xt, router_w, router_b):
    scores = jax.nn.softmax((xt @ router_w).astype(F32), axis=-1)
    biased = scores + router_b.astype(F32)
    per_group = biased.reshape(-1, N_GROUPS, EXPERTS_PER_GROUP)
    group_score = jnp.sum(lax.top_k(per_group, TOP_K)[0], axis=-1)
    g_sel = jnp.argmax(group_score, axis=-1)
    in_group = jnp.take_along_axis(per_group, g_sel[:, None, None], axis=1)[:, 0]
    _, local = lax.top_k(in_group, TOP_K)
    expert_idx = g_sel[:, None] * EXPERTS_PER_GROUP + local
    sel = jnp.take_along_axis(scores, expert_idx, axis=1)
    return expert_idx, sel / jnp.sum(sel, axis=-1, keepdims=True)


def _moe(x, router_w, router_b, w1, w3, w2):
    bsz, t, d = x.shape
    xt = x.reshape(-1, d)
    n_tok = xt.shape[0]
    expert_idx, gates = _route(xt, router_w, router_b)
    n_assign = n_tok * TOP_K
    flat_e = expert_idx.reshape(-1)
    flat_tok = jnp.repeat(jnp.arange(n_tok, dtype=jnp.int32), TOP_K)
    flat_g = gates.reshape(-1)
    order = jnp.argsort(flat_e)
    e_sorted = flat_e[order]
    counts = jnp.bincount(flat_e, length=N_EXPERTS)
    padded = (counts + DISPATCH_BLOCK - 1) // DISPATCH_BLOCK * DISPATCH_BLOCK
    start_sorted = jnp.cumsum(counts) - counts
    pad_end = jnp.cumsum(padded)
    start_padded = pad_end - padded
    dest = start_padded[e_sorted] + (jnp.arange(n_assign) - start_sorted[e_sorted])
    n_rows = -(-n_assign // DISPATCH_BLOCK) * DISPATCH_BLOCK + N_EXPERTS * DISPATCH_BLOCK
    n_blocks = n_rows // DISPATCH_BLOCK
    buf_tok = jnp.full((n_rows,), n_tok, jnp.int32).at[dest].set(flat_tok[order])
    buf_gate = jnp.zeros((n_rows,), F32).at[dest].set(flat_g[order])
    block_expert = jnp.minimum(jnp.searchsorted(pad_end, jnp.arange(n_blocks) * DISPATCH_BLOCK, side='right'),
                               N_EXPERTS - 1)
    x_pad = jnp.concatenate([xt, jnp.zeros((1, d), xt.dtype)], axis=0)

    def expert_block(args):
        e, tok = args
        xb = x_pad[tok]
        hid = jax.nn.silu(xb @ w1[e]) * (xb @ w3[e])
        return hid @ w2[e]

    y_blocks = lax.map(expert_block, (block_expert, buf_tok.reshape(n_blocks, DISPATCH_BLOCK)))
    y = y_blocks.reshape(n_rows, d).astype(F32) * buf_gate[:, None]
    out = jax.ops.segment_sum(y, buf_tok, num_segments=n_tok + 1)[:n_tok]
    return out.reshape(bsz, t, d).astype(x.dtype)


def setup_inputs(seed: int = 0) -> dict:
    key = jax.random.key(seed)
    ks = jax.random.split(key, 32)

    def nrm(k, shape, scale):
        return jax.random.normal(k, shape, F32) * scale

    ab_scale = np.concatenate([np.full((s,), BETA if i in AB_VALUE_COLS else 1.0, np.float32)
                               for i, s in enumerate(AB_SPLITS)])
    cd_scale = np.concatenate([np.full((s,), BETA if i in CD_VALUE_COLS else 1.0, np.float32)
                               for i, s in enumerate(CD_SPLITS)])
    return {
        'x': nrm(ks[0], (BATCH, SEQ, D_MODEL), 1.0),
        'ab_w_in': nrm(ks[1], (N_AB, D_MODEL, P_AB), D_MODEL ** -0.5) * jnp.asarray(ab_scale),
        'ab_b_in': nrm(ks[2], (N_AB, P_AB), 0.02),
        'hgrn_lb': nrm(ks[3], (DEPTH + 1, A_HEADS * A_DK), 0.1),
        'gla_gk_up': nrm(ks[4], (N_AB, 2, GLA_LOWRANK, B_HEADS * B_DK), GLA_LOWRANK ** -0.5),
        'gla_gk_b': nrm(ks[5], (N_AB, 2, B_HEADS * B_DK), 0.1),
        'hgrn_norm': 1.0 + nrm(ks[6], (N_AB, A_HEADS * A_DV), 0.02),
        'gla_norm': 1.0 + nrm(ks[7], (N_AB, B_HEADS * B_DV), 0.02),
        'ab_w_out': nrm(ks[8], (N_AB, MIX_AB, D_MODEL), MIX_AB ** -0.5 * BETA),
        'cd_w_in': nrm(ks[9], (N_CD, D_MODEL, P_CD), D_MODEL ** -0.5) * jnp.asarray(cd_scale),
        'cd_b_in': nrm(ks[10], (N_CD, P_CD), 0.02),
        'mlstm_conv_w': nrm(ks[11], (N_CD, CONV_WIDTH, 2 * D_HEADS * D_DK), CONV_WIDTH ** -0.5),
        'mlstm_conv_b': nrm(ks[12], (N_CD, 2 * D_HEADS * D_DK), 0.02),
        'mlstm_fgate_b': jnp.linspace(3.0, 6.0, D_HEADS, dtype=F32)[None, None, :] + nrm(ks[13], (N_CD, 2, D_HEADS), 0.1),
        'ret_norm': 1.0 + nrm(ks[14], (N_CD, C_HEADS * C_DV), 0.02),
        'mlstm_norm': 1.0 + nrm(ks[15], (N_CD, D_HEADS * D_DV), 0.02),
        'cd_w_out': nrm(ks[16], (N_CD, MIX_CD, D_MODEL), MIX_CD ** -0.5 * BETA),
        'ln_mix_g': 1.0 + nrm(ks[17], (DEPTH, D_MODEL), 0.02),
        'ln_mix_b': nrm(ks[18], (DEPTH, D_MODEL), 0.02),
        'ln_ffn_g': 1.0 + nrm(ks[19], (DEPTH, D_MODEL), 0.02),
        'ln_ffn_b': nrm(ks[20], (DEPTH, D_MODEL), 0.02),
        'router_w': nrm(ks[21], (D_MODEL, N_EXPERTS), D_MODEL ** -0.5),
        'router_b': nrm(ks[22], (N_EXPERTS,), 0.01),
        'moe_w1': nrm(ks[23], (DEPTH, N_EXPERTS, D_MODEL, D_EXPERT), D_MODEL ** -0.5 * BETA),
        'moe_w3': nrm(ks[24], (DEPTH, N_EXPERTS, D_MODEL, D_EXPERT), D_MODEL ** -0.5 * BETA),
        'moe_w2': nrm(ks[25], (DEPTH, N_EXPERTS, D_EXPERT, D_MODEL), D_EXPERT ** -0.5 * BETA),
    }


def reference(x, ab_w_in, ab_b_in, hgrn_lb, gla_gk_up, gla_gk_b, hgrn_norm, gla_norm, ab_w_out,
              cd_w_in, cd_b_in, mlstm_conv_w, mlstm_conv_b, mlstm_fgate_b, ret_norm, mlstm_norm, cd_w_out,
              ln_mix_g, ln_mix_b, ln_ffn_g, ln_ffn_b, router_w, router_b, moe_w1, moe_w3, moe_w2):
    lower_bounds = jnp.cumsum(jax.nn.softmax(hgrn_lb.astype(F32), axis=0), axis=0)
    h = x
    for layer in range(DEPTH):
        j = layer // 2
        if layer % 2 == 0:
            y = _mixer_ab(h, ab_w_in[j], ab_b_in[j], lower_bounds[layer], gla_gk_up[j], gla_gk_b[j],
                          hgrn_norm[j], gla_norm[j], ab_w_out[j])
        else:
            y = _mixer_cd(h, cd_w_in[j], cd_b_in[j], mlstm_conv_w[j], mlstm_conv_b[j], mlstm_fgate_b[j],
                          ret_norm[j], mlstm_norm[j], cd_w_out[j])
        h = _layer_norm(ALPHA * h + y, ln_mix_g[layer], ln_mix_b[layer])
        y = _moe(h, router_w, router_b, moe_w1[layer], moe_w3[layer], moe_w2[layer])
        h = _layer_norm(ALPHA * h + y, ln_ffn_g[layer], ln_ffn_b[layer])
    return h
```

```cpp
#ifdef CPU_EMU
#include <cmath>
#include <cstdio>
#include <cstring>
#include <cstdlib>
#include <cstddef>
#define DEV
#define DEV_INLINE static inline
typedef void* hipStream_t;
#else
#include <hip/hip_runtime.h>
#include <hip/hip_bf16.h>
#include <cstdio>
#define DEV __device__ __forceinline__
#define DEV_INLINE __device__ __forceinline__
#endif

#ifndef BATCH
#define BATCH 4
#endif
#ifndef SEQ
#define SEQ 8192
#endif
#define DM 1024
#define NTOK (BATCH * SEQ)
#define P_AB 4128
#define P_CD 3600
#define NEXP 16
#define ALPHA_F 1.4142135623730951f
#define LN_EPS_F 1e-5f
#define NORM_EPS_F 1e-6f
#define OSTR 1040

DEV_INLINE float sigmoidf_(float x) { return 1.0f / (1.0f + expf(-x)); }
DEV_INLINE float siluf_(float x) { return x / (1.0f + expf(-x)); }
DEV_INLINE float logsigmoidf_(float x) { return fminf(x, 0.0f) - log1pf(expf(-fabsf(x))); }

struct GemmNaive {
  const float* A; const float* B; const float* bias; float* C; int M, N, K, lda, ldb, ldc;
  DEV void operator()(long gid) const {
    int nb = N / 4; int mb = (int)(gid / nb), nq = (int)(gid % nb); int m0 = mb * 4, n0 = nq * 4;
    float a00=0,a01=0,a02=0,a03=0,a10=0,a11=0,a12=0,a13=0,a20=0,a21=0,a22=0,a23=0,a30=0,a31=0,a32=0,a33=0;
    const float* A0 = A + (long)m0 * lda; const float* A1 = A0 + lda; const float* A2 = A1 + lda; const float* A3 = A2 + lda;
    const float* Bp = B + n0;
    for (int k = 0; k < K; ++k) {
      float b0 = Bp[(long)k * ldb], b1 = Bp[(long)k * ldb + 1], b2 = Bp[(long)k * ldb + 2], b3 = Bp[(long)k * ldb + 3];
      float x0 = A0[k], x1 = A1[k], x2 = A2[k], x3 = A3[k];
      a00 += x0*b0; a01 += x0*b1; a02 += x0*b2; a03 += x0*b3;
      a10 += x1*b0; a11 += x1*b1; a12 += x1*b2; a13 += x1*b3;
      a20 += x2*b0; a21 += x2*b1; a22 += x2*b2; a23 += x2*b3;
      a30 += x3*b0; a31 += x3*b1; a32 += x3*b2; a33 += x3*b3;
    }
    float c0=0,c1=0,c2=0,c3=0; if (bias) { c0=bias[n0]; c1=bias[n0+1]; c2=bias[n0+2]; c3=bias[n0+3]; }
    float* C0 = C + (long)m0 * ldc + n0;
    C0[0]=a00+c0; C0[1]=a01+c1; C0[2]=a02+c2; C0[3]=a03+c3; C0 += ldc;
    C0[0]=a10+c0; C0[1]=a11+c1; C0[2]=a12+c2; C0[3]=a13+c3; C0 += ldc;
    C0[0]=a20+c0; C0[1]=a21+c1; C0[2]=a22+c2; C0[3]=a23+c3; C0 += ldc;
    C0[0]=a30+c0; C0[1]=a31+c1; C0[2]=a32+c2; C0[3]=a33+c3;
  }
};

struct PrepAB {
  float* P; float* aux; const float* hgrn_lb; const float* gk_up; const float* gk_b;
  DEV void operator()(long gid) const {
    int t = (int)(gid / 2048), c = (int)(gid % 2048);
    float* row = P + (long)t * P_AB;
    if (c < 512) row[c] = siluf_(row[c]);
    else if (c < 1536) {
      int cc = (c - 512) & 511;
      float a0 = hgrn_lb[cc], a1 = hgrn_lb[512 + cc], a2 = hgrn_lb[1024 + cc];
      float mx = fmaxf(a0, fmaxf(a1, a2));
      float e0 = expf(a0 - mx), e1 = expf(a1 - mx), e2 = expf(a2 - mx);
      float lb = e0 / (e0 + e1 + e2);
      row[c] = lb + (1.0f - lb) * sigmoidf_(row[c]);
    } else if (c < 1792) { int cc = c - 1536; row[2560 + cc] *= 0.125f; }
    else {
      int cc = c - 1792;
      for (int dir = 0; dir < 2; ++dir) {
        float z = gk_b[dir * 256 + cc];
        for (int r = 0; r < 16; ++r) z += row[4096 + dir * 16 + r] * gk_up[(dir * 16 + r) * 256 + cc];
        aux[(long)t * 512 + dir * 256 + cc] = expf(logsigmoidf_(z) * (1.0f / 16.0f));
      }
    }
  }
};

struct ScanAB {
  const float* P; const float* aux; float* O;
  DEV void operator()(long gid) const {
    int j = (int)(gid & 127), h = (int)((gid >> 7) & 3), dir = (int)((gid >> 9) & 1), mixer = (int)(gid >> 10);
    float* Od = O + (long)dir * SEQ * OSTR;
    if (mixer == 0) {
      float S[128];
#pragma unroll
      for (int d = 0; d < 128; ++d) S[d] = 0.f;
      for (int s = 0; s < SEQ; ++s) {
        int t = dir ? (SEQ - 1 - s) : s;
        const float* row = P + (long)t * P_AB;
        const float* q = row + h * 128; const float* f = row + 512 + dir * 512 + h * 128;
        float v = row[1536 + h * 128 + j];
        float o = 0.f;
#pragma unroll
        for (int d = 0; d < 128; ++d) { float fd = f[d]; S[d] = fd * S[d] + (1.0f - fd) * v; o += q[d] * S[d]; }
        Od[(long)t * OSTR + h * 128 + j] = o;
      }
    } else {
      float S[64];
#pragma unroll
      for (int d = 0; d < 64; ++d) S[d] = 0.f;
      for (int s = 0; s < SEQ; ++s) {
        int t = dir ? (SEQ - 1 - s) : s;
        const float* row = P + (long)t * P_AB;
        const float* q = row + 2560 + h * 64; const float* k = row + 2816 + h * 64;
        const float* f = aux + (long)t * 512 + dir * 256 + h * 64;
        float v = row[3072 + h * 128 + j];
        float o = 0.f;
#pragma unroll
        for (int d = 0; d < 64; ++d) { S[d] = f[d] * S[d] + k[d] * v; o += q[d] * S[d]; }
        Od[(long)t * OSTR + 512 + h * 128 + j] = o;
      }
    }
  }
};

struct HeadNormAB {
  const float* P; const float* O; const float* norm_a; const float* norm_b; float* mixed;
  DEV void operator()(long gid) const {
    int t = (int)(gid >> 3), h8 = (int)(gid & 7);
    const float* of = O + (long)t * OSTR + h8 * 128; const float* ob = of + (long)SEQ * OSTR;
    const float* row = P + (long)t * P_AB;
    float ss = 0.f;
    for (int j = 0; j < 128; ++j) { float o = of[j] + ob[j]; ss += o * o; }
    float r = 1.0f / sqrtf(ss * (1.0f / 128.0f) + NORM_EPS_F);
    for (int j = 0; j < 128; ++j) {
      int c = h8 * 128 + j;
      float o = (of[j] + ob[j]) * r;
      float gain = (h8 < 4) ? norm_a[c] : norm_b[c - 512];
      float g = (h8 < 4) ? row[2048 + c] : row[3584 + (c - 512)];
      mixed[(long)t * 1024 + c] = o * gain * siluf_(g);
    }
  }
};

struct PrepCD {
  float* P; float* aux; const float* conv_w; const float* conv_b;
  DEV void operator()(long gid) const {
    int t = (int)(gid / 1280), c = (int)(gid % 1280);
    float* row = P + (long)t * P_CD;
    if (c < 256) {
      int isk = c >> 7, hh = (c >> 5) & 3, i = c & 31;
      float freq = powf(10000.0f, -(float)i / 32.0f);
      float ang = (float)t * freq;
      float cs = cosf(ang), sn = sinf(ang);
      float* base = row + isk * 256 + hh * 64;
      float a1 = base[i], a2 = base[i + 32];
      float sc = isk ? 1.0f : 0.125f;
      base[i] = (a1 * cs - a2 * sn) * sc; base[i + 32] = (a1 * sn + a2 * cs) * sc;
    } else {
      int cc = c - 256;
      float acc = conv_b[cc] + row[1536 + cc] * conv_w[1024 + cc];
      if (t > 0) acc += row[1536 + cc - P_CD] * conv_w[cc];
      if (t < SEQ - 1) acc += row[1536 + cc + P_CD] * conv_w[2048 + cc];
      float s = siluf_(acc);
      if (cc < 512) s *= 0.08838834764831845f;
      aux[(long)t * 1024 + cc] = s;
    }
  }
};

struct ScanCD {
  const float* P; const float* aux; const float* fgate_b; float* O;
  DEV void operator()(long gid) const {
    if (gid < 1024) {
      int j = (int)(gid & 127), h = (int)((gid >> 7) & 3), dir = (int)((gid >> 9) & 1);
      float* Od = O + (long)dir * SEQ * OSTR;
      float gamma = 1.0f - exp2f(-(5.0f + 2.0f * (float)h + (float)dir));
      float S[64];
#pragma unroll
      for (int d = 0; d < 64; ++d) S[d] = 0.f;
      for (int s = 0; s < SEQ; ++s) {
        int t = dir ? (SEQ - 1 - s) : s;
        const float* row = P + (long)t * P_CD;
        const float* q = row + h * 64; const float* k = row + 256 + h * 64;
        float v = row[512 + h * 128 + j];
        float o = 0.f;
#pragma unroll
        for (int d = 0; d < 64; ++d) { S[d] = gamma * S[d] + k[d] * v; o += q[d] * S[d]; }
        Od[(long)t * OSTR + h * 128 + j] = o;
      }
    } else {
      int g = (int)(gid - 1024);
      int j = g % 129, h = (g / 129) & 3, dir = g / (129 * 4);
      float* Od = O + (long)dir * SEQ * OSTR;
      float fb = fgate_b[dir * 4 + h];
      float S[128];
#pragma unroll
      for (int d = 0; d < 128; ++d) S[d] = 0.f;
      float m = 0.f;
      for (int s = 0; s < SEQ; ++s) {
        int t = dir ? (SEQ - 1 - s) : s;
        const float* row = P + (long)t * P_CD;
        const float* q = aux + (long)t * 1024 + h * 128; const float* k = q + 512;
        float v = (j < 128) ? row[2560 + h * 128 + j] : 1.0f;
        float li = row[3584 + dir * 8 + h];
        float lf = logsigmoidf_(row[3584 + dir * 8 + 4 + h] + fb);
        float mn = fmaxf(lf + m, li);
        float fs = expf(lf + m - mn), is = expf(li - mn) * v;
        m = mn;
        float o = 0.f;
#pragma unroll
        for (int d = 0; d < 128; ++d) { S[d] = fs * S[d] + is * k[d]; o += q[d] * S[d]; }
        if (j < 128) Od[(long)t * OSTR + 512 + h * 128 + j] = o;
        else { Od[(long)t * OSTR + 1024 + h * 2] = o; Od[(long)t * OSTR + 1024 + h * 2 + 1] = m; }
      }
    }
  }
};

struct HeadNormCD {
  const float* P; const float* O; const float* norm_c; const float* norm_d; float* mixed;
  DEV void operator()(long gid) const {
    int t = (int)(gid >> 3), h8 = (int)(gid & 7);
    const float* of = O + (long)t * OSTR; const float* ob = of + (long)SEQ * OSTR;
    const float* row = P + (long)t * P_CD;
    float sf = 1.f, sb = 1.f;
    if (h8 >= 4) {
      int h = h8 - 4;
      sf = 1.0f / fmaxf(fabsf(of[1024 + h * 2]), expf(-of[1024 + h * 2 + 1]));
      sb = 1.0f / fmaxf(fabsf(ob[1024 + h * 2]), expf(-ob[1024 + h * 2 + 1]));
    }
    of += h8 * 128; ob += h8 * 128;
    float ss = 0.f;
    for (int j = 0; j < 128; ++j) { float o = of[j] * sf + ob[j] * sb; ss += o * o; }
    float r = 1.0f / sqrtf(ss * (1.0f / 128.0f) + NORM_EPS_F);
    for (int j = 0; j < 128; ++j) {
      int c = h8 * 128 + j;
      float o = (of[j] * sf + ob[j] * sb) * r;
      float val;
      if (h8 < 4) val = o * norm_c[c] * siluf_(row[1024 + c]);
      else val = o * norm_d[c - 512] * sigmoidf_(row[3072 + (c - 512)]);
      mixed[(long)t * 1024 + c] = val;
    }
  }
};

struct ResLN {
  const float* hin; const float* y; const float* g; const float* b; float* out;
  DEV void operator()(long gid) const {
    const float* hr = hin + gid * DM; const float* yr = y + gid * DM; float* o = out + gid * DM;
    float s = 0.f;
    for (int c = 0; c < DM; ++c) s += ALPHA_F * hr[c] + yr[c];
    float mean = s * (1.0f / DM);
    float v = 0.f;
    for (int c = 0; c < DM; ++c) { float d = ALPHA_F * hr[c] + yr[c] - mean; v += d * d; }
    float r = 1.0f / sqrtf(v * (1.0f / DM) + LN_EPS_F);
    for (int c = 0; c < DM; ++c) { float d = ALPHA_F * hr[c] + yr[c] - mean; o[c] = d * r * g[c] + b[c]; }
  }
};

DEV_INLINE void route_from_logits(const float* lg, const float* rb, int* e_out, float* g_out) {
  float mx = lg[0];
#pragma unroll
  for (int e = 1; e < 16; ++e) mx = fmaxf(mx, lg[e]);
  float sc[16]; float sum = 0.f;
#pragma unroll
  for (int e = 0; e < 16; ++e) { sc[e] = expf(lg[e] - mx); sum += sc[e]; }
  float inv = 1.0f / sum;
  float best_gs = -1e30f; int be1 = 0, be2 = 1; float bs1 = 0.f, bs2 = 0.f;
#pragma unroll
  for (int gq = 0; gq < 4; ++gq) {
    float m1 = -1e30f, m2 = -1e30f, s1 = 0.f, s2 = 0.f; int i1 = 0, i2 = 0;
#pragma unroll
    for (int i = 0; i < 4; ++i) {
      float s = sc[gq * 4 + i] * inv; float v = s + rb[gq * 4 + i];
      if (v > m1) { m2 = m1; i2 = i1; s2 = s1; m1 = v; i1 = gq * 4 + i; s1 = s; }
      else if (v > m2) { m2 = v; i2 = gq * 4 + i; s2 = s; }
    }
    float gs = m1 + m2;
    if (gs > best_gs) { best_gs = gs; be1 = i1; be2 = i2; bs1 = s1; bs2 = s2; }
  }
  e_out[0] = be1; e_out[1] = be2; g_out[0] = bs1 / (bs1 + bs2); g_out[1] = bs2 / (bs1 + bs2);
}
struct RouterNaive {
  const float* h; const float* rw; const float* rb; int* eidx; float* gate;
  DEV void operator()(long gid) const {
    const float* hr = h + gid * DM;
    float lg[16];
    for (int e = 0; e < 16; ++e) lg[e] = 0.f;
    for (int k = 0; k < DM; ++k) { float x = hr[k]; for (int e = 0; e < 16; ++e) lg[e] += x * rw[k * 16 + e]; }
    route_from_logits(lg, rb, eidx + gid * 2, gate + gid * 2);
  }
};

struct MoeHidNaive {
  const float* h; const float* w1; const float* w3; const int* eidx; float* hid; int slot;
  DEV void operator()(long gid) const {
    long tok = gid >> 8; int c0 = (int)(gid & 255) * 4;
    int e = eidx[tok * 2 + slot];
    const float* x = h + tok * DM;
    const float* W1 = w1 + (long)e * DM * DM + c0; const float* W3 = w3 + (long)e * DM * DM + c0;
    float a0=0,a1=0,a2=0,a3=0,b0=0,b1=0,b2=0,b3=0;
    for (int k = 0; k < DM; ++k) {
      float xv = x[k]; const float* p1 = W1 + (long)k * DM; const float* p3 = W3 + (long)k * DM;
      a0 += xv*p1[0]; a1 += xv*p1[1]; a2 += xv*p1[2]; a3 += xv*p1[3];
      b0 += xv*p3[0]; b1 += xv*p3[1]; b2 += xv*p3[2]; b3 += xv*p3[3];
    }
    float* o = hid + tok * DM + c0;
    o[0] = siluf_(a0)*b0; o[1] = siluf_(a1)*b1; o[2] = siluf_(a2)*b2; o[3] = siluf_(a3)*b3;
  }
};
struct MoeOutNaive {
  const float* hid; const float* w2; const int* eidx; const float* gate; float* y; int slot;
  DEV void operator()(long gid) const {
    long tok = gid >> 8; int c0 = (int)(gid & 255) * 4;
    int e = eidx[tok * 2 + slot]; float g = gate[tok * 2 + slot];
    const float* x = hid + tok * DM; const float* W = w2 + (long)e * DM * DM + c0;
    float a0=0,a1=0,a2=0,a3=0;
    for (int k = 0; k < DM; ++k) { float xv = x[k]; const float* p = W + (long)k * DM; a0 += xv*p[0]; a1 += xv*p[1]; a2 += xv*p[2]; a3 += xv*p[3]; }
    float* o = y + tok * DM + c0;
    if (slot == 0) { o[0] = g*a0; o[1] = g*a1; o[2] = g*a2; o[3] = g*a3; }
    else { o[0] += g*a0; o[1] += g*a1; o[2] += g*a2; o[3] += g*a3; }
  }
};
#ifdef CPU_EMU
template <class F> static void launch(const F& f, long n, hipStream_t) {
#pragma omp parallel for schedule(dynamic, 64)
  for (long g = 0; g < n; ++g) f(g);
}
void dbg_cmp(const char* name, const float* p, long n);
#define DBG(name, p, n) dbg_cmp(name, p, n)
#else
template <class F> __global__ void __launch_bounds__(256) kern(F f, long n) {
  long g = (long)blockIdx.x * 256 + threadIdx.x;
  if (g < n) f(g);
}
template <class F> static void launch(const F& f, long n, hipStream_t s) {
  kern<F><<<dim3((unsigned)((n + 255) / 256)), dim3(256), 0, s>>>(f, n);
}
#define DBG(name, p, n)
#endif

enum { I_X, I_AB_W_IN, I_AB_B_IN, I_HGRN_LB, I_GK_UP, I_GK_B, I_HGRN_NORM, I_GLA_NORM, I_AB_W_OUT,
       I_CD_W_IN, I_CD_B_IN, I_CONV_W, I_CONV_B, I_FGATE_B, I_RET_NORM, I_MLSTM_NORM, I_CD_W_OUT,
       I_LN_MIX_G, I_LN_MIX_B, I_LN_FFN_G, I_LN_FFN_B, I_ROUTER_W, I_ROUTER_B, I_MOE_W1, I_MOE_W3, I_MOE_W2 };

extern "C" void kernel_launch(void* const* d_in, const int* in_sizes, int n_in,
                              void* d_out, int out_size, void* d_ws, size_t ws_size, hipStream_t stream) {
  (void)in_sizes; (void)n_in; (void)out_size; (void)ws_size;
  const float* in[26];
  for (int i = 0; i < 26; ++i) in[i] = (const float*)d_in[i];
  float* hbuf = (float*)d_out;
  float* ws = (float*)d_ws;
  float* bufP = ws;                        ws += (size_t)SEQ * P_AB;
  float* bufAux = ws;                      ws += (size_t)SEQ * 1024;
  float* bufO = ws;                        ws += (size_t)2 * SEQ * OSTR;
  float* bufMixed = ws;                    ws += (size_t)NTOK * 1024;
  float* bufY = ws;                        ws += (size_t)NTOK * 1024;
  int* eidx = (int*)ws;                    ws += (size_t)NTOK * 2;
  float* gate = ws;                        ws += (size_t)NTOK * 2;

  for (int layer = 0; layer < 2; ++layer) {
    const float* hin = layer == 0 ? in[I_X] : hbuf;
    for (int b = 0; b < BATCH; ++b) {
      const float* hb = hin + (size_t)b * SEQ * DM;
      float* mixed_b = bufMixed + (size_t)b * SEQ * 1024;
      if (layer == 0) {
        GemmNaive g{}; g.A = hb; g.B = in[I_AB_W_IN]; g.bias = in[I_AB_B_IN]; g.C = bufP; g.M = SEQ; g.N = P_AB; g.K = DM; g.lda = DM; g.ldb = P_AB; g.ldc = P_AB;
        launch(g, (long)(SEQ / 4) * (P_AB / 4), stream);
        PrepAB p{}; p.P = bufP; p.aux = bufAux; p.hgrn_lb = in[I_HGRN_LB]; p.gk_up = in[I_GK_UP]; p.gk_b = in[I_GK_B];
        launch(p, (long)SEQ * 2048, stream);
        ScanAB s{}; s.P = bufP; s.aux = bufAux; s.O = bufO;
        launch(s, 2048, stream);
        HeadNormAB hn{}; hn.P = bufP; hn.O = bufO; hn.norm_a = in[I_HGRN_NORM]; hn.norm_b = in[I_GLA_NORM]; hn.mixed = mixed_b;
        launch(hn, (long)SEQ * 8, stream);
      } else {
        GemmNaive g{}; g.A = hb; g.B = in[I_CD_W_IN]; g.bias = in[I_CD_B_IN]; g.C = bufP; g.M = SEQ; g.N = P_CD; g.K = DM; g.lda = DM; g.ldb = P_CD; g.ldc = P_CD;
        launch(g, (long)(SEQ / 4) * (P_CD / 4), stream);
        PrepCD p{}; p.P = bufP; p.aux = bufAux; p.conv_w = in[I_CONV_W]; p.conv_b = in[I_CONV_B];
        launch(p, (long)SEQ * 1280, stream);
        ScanCD s{}; s.P = bufP; s.aux = bufAux; s.fgate_b = in[I_FGATE_B]; s.O = bufO;
        launch(s, 1024 + 1032, stream);
        HeadNormCD hn{}; hn.P = bufP; hn.O = bufO; hn.norm_c = in[I_RET_NORM]; hn.norm_d = in[I_MLSTM_NORM]; hn.mixed = mixed_b;
        launch(hn, (long)SEQ * 8, stream);
      }
    }
    {
      GemmNaive g{}; g.A = bufMixed; g.B = layer == 0 ? in[I_AB_W_OUT] : in[I_CD_W_OUT]; g.bias = nullptr; g.C = bufY;
      g.M = NTOK; g.N = DM; g.K = 1024; g.lda = 1024; g.ldb = DM; g.ldc = DM;
      launch(g, (long)(NTOK / 4) * (DM / 4), stream);
      DBG(layer == 0 ? "y_mix0" : "y_mix1", bufY, (long)NTOK * DM);
      ResLN l{}; l.hin = hin; l.y = bufY; l.g = in[I_LN_MIX_G] + layer * DM; l.b = in[I_LN_MIX_B] + layer * DM; l.out = hbuf;
      launch(l, NTOK, stream);
      DBG(layer == 0 ? "h_mix0" : "h_mix1", hbuf, (long)NTOK * DM);
    }
    {
      RouterNaive r{}; r.h = hbuf; r.rw = in[I_ROUTER_W]; r.rb = in[I_ROUTER_B]; r.eidx = eidx; r.gate = gate;
      launch(r, NTOK, stream);
      for (int slot = 0; slot < 2; ++slot) {
        MoeHidNaive mh{}; mh.h = hbuf; mh.w1 = in[I_MOE_W1] + (size_t)layer * NEXP * DM * DM; mh.w3 = in[I_MOE_W3] + (size_t)layer * NEXP * DM * DM;
        mh.eidx = eidx; mh.hid = bufMixed; mh.slot = slot;
        launch(mh, (long)NTOK * 256, stream);
        MoeOutNaive mo{}; mo.hid = bufMixed; mo.w2 = in[I_MOE_W2] + (size_t)layer * NEXP * DM * DM; mo.eidx = eidx; mo.gate = gate; mo.y = bufY; mo.slot = slot;
        launch(mo, (long)NTOK * 256, stream);
      }
      DBG(layer == 0 ? "y_moe0" : "y_moe1", bufY, (long)NTOK * DM);
      ResLN l{}; l.hin = hbuf; l.y = bufY; l.g = in[I_LN_FFN_G] + layer * DM; l.b = in[I_LN_FFN_B] + layer * DM; l.out = hbuf;
      launch(l, NTOK, stream);
      DBG(layer == 0 ? "h_ffn0" : "h_ffn1", hbuf, (long)NTOK * DM);
    }
  }
}
```

```cpp
#ifdef CPU_EMU
#include <cmath>
#include <cstdio>
#include <cstring>
#include <cstdlib>
#include <cstddef>
#define DEV
#define DEV_INLINE static inline
typedef void* hipStream_t;
#else
#include <hip/hip_runtime.h>
#include <hip/hip_bf16.h>
#include <cstdio>
#define DEV __device__ __forceinline__
#define DEV_INLINE __device__ __forceinline__
#endif
#ifndef BATCH
#define BATCH 4
#endif
#ifndef SEQ
#define SEQ 8192
#endif
#define DM 1024
#define NTOK (BATCH * SEQ)
#define P_AB 4128
#define P_CD 3600
#define PM_AB 4096
#define PM_CD 3584
#define NEXP 16
#define ALPHA_F 1.4142135623730951f
#define LN_EPS_F 1e-5f
#define NORM_EPS_F 1e-6f
#define HROWS (2 * NTOK + NEXP * 256)

typedef unsigned short bf16_t;

DEV_INLINE float bf2f(bf16_t b) { unsigned u = ((unsigned)b) << 16; float f; memcpy(&f, &u, 4); return f; }
DEV_INLINE bf16_t f2bf(float f) { unsigned u; memcpy(&u, &f, 4); u += 0x7FFFu + ((u >> 16) & 1u); return (bf16_t)(u >> 16); }
DEV_INLINE float sigmoidf_(float x) { return 1.0f / (1.0f + expf(-x)); }
DEV_INLINE float siluf_(float x) { return x / (1.0f + expf(-x)); }
DEV_INLINE float logsigmoidf_(float x) { return fminf(x, 0.0f) - log1pf(expf(-fabsf(x))); }

#define AL256(x) (((size_t)(x) + 255) & ~(size_t)255)
#define WS_CTL    ((size_t)0)
#define WS_HB     ((size_t)65536)
#define WS_R1     (WS_HB + (size_t)NTOK * 1024 * 2)
#define R1_P_BYTES ((size_t)NTOK * 4096 * 2)
#define R1_MIN    (AL256((size_t)HROWS * 1024 * 2) + (size_t)NEXP * 3072 * 1024 * 2)
#define R1_PL     (R1_P_BYTES + (size_t)NTOK * 512 * 2)
#define R1_BYTES  (R1_PL > R1_MIN ? R1_PL : R1_MIN)
#define WS_LFB    (WS_R1 + R1_P_BYTES)
#define WS_H      (WS_R1)
#define WS_WMOE   (WS_R1 + AL256((size_t)HROWS * 1024 * 2))
#define WMOE_BYTES ((size_t)NEXP * 3072 * 1024 * 2)
#define WS_R2     (WS_R1 + R1_BYTES)
#define R2_BYTES  ((size_t)HROWS * 1024 * 2 > (size_t)NTOK * 1024 * 4 ? (size_t)HROWS * 1024 * 2 : (size_t)NTOK * 1024 * 4)
#define WS_SIDE   (WS_R2 + AL256(R2_BYTES))
#define WS_OSIDE  (WS_SIDE + (size_t)NTOK * 32 * 4)
#define WS_WIN_AB (WS_OSIDE + (size_t)2 * NTOK * 8 * 4)
#define WS_WIN_CD (WS_WIN_AB + (size_t)4128 * 1024 * 2)
#define WS_WOUT_AB (WS_WIN_CD + (size_t)3600 * 1024 * 2)
#define WS_WOUT_CD (WS_WOUT_AB + (size_t)1024 * 1024 * 2)
#define WS_ROPE   (WS_WOUT_CD + (size_t)1024 * 1024 * 2)
#define WS_LB     (WS_ROPE + (size_t)SEQ * 64 * 4)
#define WS_LIST   (WS_LB + 4096)
#define WS_ASSIGN (WS_LIST + (size_t)2 * NEXP * NTOK * 4)
#define WS_GATE   (WS_ASSIGN + (size_t)NTOK * 16)
#define WS_END    (WS_GATE + (size_t)NTOK * 8)
#define CW_CNT(layer) (64 + 64 * (layer))

#define PSTRIDE 4096

enum { I_X, I_AB_W_IN, I_AB_B_IN, I_HGRN_LB, I_GK_UP, I_GK_B, I_HGRN_NORM, I_GLA_NORM, I_AB_W_OUT,
       I_CD_W_IN, I_CD_B_IN, I_CONV_W, I_CONV_B, I_FGATE_B, I_RET_NORM, I_MLSTM_NORM, I_CD_W_OUT,
       I_LN_MIX_G, I_LN_MIX_B, I_LN_FFN_G, I_LN_FFN_B, I_ROUTER_W, I_ROUTER_B, I_MOE_W1, I_MOE_W3, I_MOE_W2, N_IN };

struct Params {
  const float* in[N_IN];
  float* out;
  unsigned char* ws;
};

DEV_INLINE float epi_ab(int col, float v, const float* lb) {
  if (col < 512) return siluf_(v);
  if (col < 1536) { float l = lb[(col - 512) & 511]; return logf(l + (1.0f - l) * sigmoidf_(v)); }
  if (col >= 2560 && col < 2816) return v * 0.125f;
  return v;
}

DEV_INLINE void route_from_logits(const float* lg, const float* rb, int* e_out, float* g_out) {
  float mx = lg[0];
#pragma unroll
  for (int e = 1; e < 16; ++e) mx = fmaxf(mx, lg[e]);
  float sc[16]; float sum = 0.f;
#pragma unroll
  for (int e = 0; e < 16; ++e) { sc[e] = expf(lg[e] - mx); sum += sc[e]; }
  float inv = 1.0f / sum;
  float best_gs = -1e30f; int be1 = 0, be2 = 1; float bs1 = 0.f, bs2 = 0.f;
#pragma unroll
  for (int gq = 0; gq < 4; ++gq) {
    float m1 = -1e30f, m2 = -1e30f, s1 = 0.f, s2 = 0.f; int i1 = 0, i2 = 0;
#pragma unroll
    for (int i = 0; i < 4; ++i) {
      float s = sc[gq * 4 + i] * inv; float v = s + rb[gq * 4 + i];
      if (v > m1) { m2 = m1; i2 = i1; s2 = s1; m1 = v; i1 = gq * 4 + i; s1 = s; }
      else if (v > m2) { m2 = v; i2 = gq * 4 + i; s2 = s; }
    }
    float gs = m1 + m2;
    if (gs > best_gs) { best_gs = gs; be1 = i1; be2 = i2; bs1 = s1; bs2 = s2; }
  }
  e_out[0] = be1; e_out[1] = be2; g_out[0] = bs1 / (bs1 + bs2); g_out[1] = bs2 / (bs1 + bs2);
}
struct ScanAB2 {
  const bf16_t* P; const bf16_t* LFB; bf16_t* O;
  DEV void operator()(long gid) const {
    int j = (int)(gid & 127), h = (int)((gid >> 7) & 3), dir = (int)((gid >> 9) & 1), mixer = (int)((gid >> 10) & 1), b = (int)(gid >> 11);
    bf16_t* Od = O + (size_t)dir * NTOK * 1024;
    if (mixer == 0) {
      float S[128];
#pragma unroll
      for (int d = 0; d < 128; ++d) S[d] = 0.f;
      for (int s = 0; s < SEQ; ++s) {
        size_t t = (size_t)b * SEQ + (dir ? (SEQ - 1 - s) : s);
        const bf16_t* row = P + t * PSTRIDE;
        const bf16_t* q = row + h * 128; const bf16_t* lf = row + 512 + dir * 512 + h * 128;
        float v = bf2f(row[1536 + h * 128 + j]);
        float o = 0.f;
#pragma unroll
        for (int d = 0; d < 128; ++d) { float fd = expf(bf2f(lf[d])); S[d] = fd * S[d] + (1.0f - fd) * v; o += bf2f(q[d]) * S[d]; }
        Od[t * 1024 + h * 128 + j] = f2bf(o);
      }
    } else {
      float S[64];
#pragma unroll
      for (int d = 0; d < 64; ++d) S[d] = 0.f;
      for (int s = 0; s < SEQ; ++s) {
        size_t t = (size_t)b * SEQ + (dir ? (SEQ - 1 - s) : s);
        const bf16_t* row = P + t * PSTRIDE;
        const bf16_t* q = row + 2560 + h * 64; const bf16_t* k = row + 2816 + h * 64;
        const bf16_t* lf = LFB + t * 512 + dir * 256 + h * 64;
        float v = bf2f(row[3072 + h * 128 + j]);
        float o = 0.f;
#pragma unroll
        for (int d = 0; d < 64; ++d) { S[d] = expf(bf2f(lf[d])) * S[d] + bf2f(k[d]) * v; o += bf2f(q[d]) * S[d]; }
        Od[t * 1024 + 512 + h * 128 + j] = f2bf(o);
      }
    }
  }
};

struct PrepCD2 {
  bf16_t* P; bf16_t* QD; const float* rope; const float* conv_w; const float* conv_b;
  DEV void operator()(long gid) const {
    size_t tok = (size_t)(gid / 1280); int c = (int)(gid % 1280); int t = (int)(tok % SEQ);
    bf16_t* row = P + tok * PSTRIDE;
    if (c < 256) {
      int isk = c >> 7, hh = (c >> 5) & 3, i = c & 31;
      float cs = rope[(t * 32 + i) * 2], sn = rope[(t * 32 + i) * 2 + 1];
      bf16_t* base = row + isk * 256 + hh * 64;
      float a1 = bf2f(base[i]), a2 = bf2f(base[i + 32]);
      float sc = isk ? 1.0f : 0.125f;
      base[i] = f2bf((a1 * cs - a2 * sn) * sc); base[i + 32] = f2bf((a1 * sn + a2 * cs) * sc);
    } else {
      int cc = c - 256;
      float acc = conv_b[cc] + bf2f(row[1536 + cc]) * conv_w[1024 + cc];
      if (t > 0) acc += bf2f(row[1536 + cc - PSTRIDE]) * conv_w[cc];
      if (t < SEQ - 1) acc += bf2f(row[1536 + cc + PSTRIDE]) * conv_w[2048 + cc];
      float s = siluf_(acc);
      if (cc < 512) QD[tok * 512 + cc] = f2bf(s * 0.08838834764831845f);
      else row[3584 + (cc - 512)] = f2bf(s);
    }
  }
};

struct ScanCD2 {
  const bf16_t* P; const bf16_t* QD; const float* side; const float* fgate_b; bf16_t* O; float* oside;
  DEV void operator()(long gid) const {
    int b = (int)(gid / 2056); int g = (int)(gid % 2056);
    if (g < 1024) {
      int j = g & 127, h = (g >> 7) & 3, dir = (g >> 9) & 1;
      bf16_t* Od = O + (size_t)dir * NTOK * 1024;
      float gamma = 1.0f - exp2f(-(5.0f + 2.0f * (float)h + (float)dir));
      float S[64];
#pragma unroll
      for (int d = 0; d < 64; ++d) S[d] = 0.f;
      for (int s = 0; s < SEQ; ++s) {
        size_t t = (size_t)b * SEQ + (dir ? (SEQ - 1 - s) : s);
        const bf16_t* row = P + t * PSTRIDE;
        const bf16_t* q = row + h * 64; const bf16_t* k = row + 256 + h * 64;
        float v = bf2f(row[512 + h * 128 + j]);
        float o = 0.f;
#pragma unroll
        for (int d = 0; d < 64; ++d) { S[d] = gamma * S[d] + bf2f(k[d]) * v; o += bf2f(q[d]) * S[d]; }
        Od[t * 1024 + h * 128 + j] = f2bf(o);
      }
    } else {
      g -= 1024;
      int j = g % 129, h = (g / 129) & 3, dir = g / (129 * 4);
      bf16_t* Od = O + (size_t)dir * NTOK * 1024; float* os = oside + (size_t)dir * NTOK * 8;
      float fb = fgate_b[dir * 4 + h];
      float S[128];
#pragma unroll
      for (int d = 0; d < 128; ++d) S[d] = 0.f;
      float m = 0.f;
      for (int s = 0; s < SEQ; ++s) {
        size_t t = (size_t)b * SEQ + (dir ? (SEQ - 1 - s) : s);
        const bf16_t* row = P + t * PSTRIDE;
        const bf16_t* q = QD + t * 512 + h * 128; const bf16_t* k = row + 3584 + h * 128;
        float v = (j < 128) ? bf2f(row[2560 + h * 128 + j]) : 1.0f;
        float li = side[t * 32 + dir * 8 + h];
        float lf = logsigmoidf_(side[t * 32 + dir * 8 + 4 + h] + fb);
        float mn = fmaxf(lf + m, li);
        float fs = expf(lf + m - mn), is = expf(li - mn) * v;
        m = mn;
        float o = 0.f;
#pragma unroll
        for (int d = 0; d < 128; ++d) { S[d] = fs * S[d] + is * bf2f(k[d]); o += bf2f(q[d]) * S[d]; }
        if (j < 128) Od[t * 1024 + 512 + h * 128 + j] = f2bf(o);
        else { os[t * 8 + h * 2] = o; os[t * 8 + h * 2 + 1] = m; }
      }
    }
  }
};
#ifndef CPU_EMU
namespace pg8 {
#define PG8_LAS __attribute__((address_space(3)))
typedef short bf16x8 __attribute__((ext_vector_type(8)));
typedef float f32x4 __attribute__((ext_vector_type(4)));
typedef unsigned u32x4 __attribute__((ext_vector_type(4)));
typedef unsigned u32x2 __attribute__((ext_vector_type(2)));
constexpr int BM = 256, BK = 64, HALF = 128, HTB = HALF * BK * 2, STAGE_BYTES = 8 * HTB, NXCD = 8, WGM = 8, GK = 1024;

__device__ __forceinline__ int lds_byte(int r, int c) { const int st = (r >> 4) * 2 + (c >> 5), rr = r & 15, cc = c & 31, ob = rr * 64 + cc * 2; return st * 1024 + (ob ^ (((ob >> 9) & 1) << 5)); }
__device__ __forceinline__ void stage_rc(int b, int& R, int& C) { const int st = b / 1024, sb = b % 1024, swz = sb ^ (((sb >> 9) & 1) << 5); R = (st >> 1) * 16 + swz / 64; C = (st & 1) * 32 + (swz % 64) / 2; }
__device__ __forceinline__ int perm32(int rho) { const int n = rho >> 4, i = rho & 15; return 8 * (i >> 2) + 4 * n + (i & 3); }
__device__ __forceinline__ unsigned cvt_pk_bf16(float lo, float hi) { unsigned r; asm volatile("v_cvt_pk_bf16_f32 %0, %1, %2" : "=v"(r) : "v"(lo), "v"(hi)); return r; }

struct Unit { int pm, pn, e, row0; };

struct StaticOrder {
  int nM, nN, nwg, G, c;
  __device__ void init(int M, int N, int G_, int c_) { nM = M / BM; nN = N / BM; nwg = nM * nN; G = G_; c = c_; }
  __device__ bool next(int i, Unit& u) const {
    const long L = (long)i * G + c; if (L >= nwg) return false;
    int wgid = (int)L; { const int q = nwg / NXCD, r = nwg % NXCD, xcd = wgid % NXCD, off = wgid / NXCD; wgid = (xcd < r ? xcd * (q + 1) : r * (q + 1) + (xcd - r) * q) + off; }
    const int nig = WGM * nN, gid = wgid / nig, fm = gid * WGM, gsz = (nM - fm) < WGM ? (nM - fm) : WGM;
    u.pm = fm + ((wgid % nig) % gsz); u.pn = (wgid % nig) / gsz; u.e = 0; u.row0 = u.pm * BM; return true;
  }
};

template <class Prob>
__device__ __forceinline__ void gemm_phase(PG8_LAS unsigned char* lds, const Prob& S) {
  int tid_ = threadIdx.x; asm volatile("" : "+v"(tid_));
  const int tid = tid_, wid = __builtin_amdgcn_readfirstlane(tid >> 6), lane = tid & 63, wr = wid >> 2, wc = wid & 3, fr = lane & 15, fq = lane >> 4;
  constexpr int K = GK, nt = K / BK;
  int sR[2], sC[2]; unsigned voffB[2];
#pragma unroll
  for (int i = 0; i < 2; ++i) { int R, C; stage_rc(tid * 16 + i * 8192, R, C); sR[i] = R; sC[i] = C; const int Rb = Prob::PERM ? ((R & ~31) + perm32(R & 31)) : R; voffB[i] = (unsigned)(Rb * K + C) * 2u; }
  const size_t kstep = (size_t)(BK * 2);
  const size_t hstep = (size_t)HALF * K * 2;
  const unsigned ldsw = (unsigned)wid * 1024u;
  const int aoff = lds_byte(wr * 64 + fr, fq * 8), boff = lds_byte(wc * 32 + fr, fq * 8);
#define PG8_SA(b, h) (((b) * 2 + (h)) * HTB)
#define PG8_SB(b, h) ((4 + (b) * 2 + (h)) * HTB)
#define PG8_STAGE(bufoff, gbase, voff) do { _Pragma("unroll") for (int _i = 0; _i < 2; ++_i) \
    __builtin_amdgcn_global_load_lds((const unsigned*)((const char*)(gbase) + (voff)[_i]), (PG8_LAS unsigned*)(lds + (bufoff) + ldsw + _i * 8192), 16, 0, 0); } while (0)
#define PG8_LDA(dst, b, h) do { _Pragma("unroll") for (int m = 0; m < 4; ++m) _Pragma("unroll") for (int k = 0; k < 2; ++k) dst[m][k] = *(const PG8_LAS bf16x8*)(lds + PG8_SA(b, h) + aoff + m * 2048 + k * 1024); } while (0)
#define PG8_LDB(dst, b, h) do { _Pragma("unroll") for (int n = 0; n < 2; ++n) _Pragma("unroll") for (int k = 0; k < 2; ++k) dst[n][k] = *(const PG8_LAS bf16x8*)(lds + PG8_SB(b, h) + boff + n * 2048 + k * 1024); } while (0)
#define PG8_MMA(ai, bj, At, Bt) do { __builtin_amdgcn_s_setprio(1); _Pragma("unroll") for (int m = 0; m < 4; ++m) _Pragma("unroll") for (int n = 0; n < 2; ++n) _Pragma("unroll") for (int k = 0; k < 2; ++k) \
    acc[ai][bj][m][n] = __builtin_amdgcn_mfma_f32_16x16x32_bf16(Bt[n][k], At[m][k], acc[ai][bj][m][n], 0, 0, 0); __builtin_amdgcn_s_setprio(0); } while (0)
#define PG8_WAIT_V(n) asm volatile("s_waitcnt vmcnt(" #n ")" ::: "memory")
#define PG8_WAIT_L(n) asm volatile("s_waitcnt lgkmcnt(" #n ")" ::: "memory")
#define PG8_BAR __builtin_amdgcn_s_barrier()
#define PG8_SCHED __builtin_amdgcn_sched_barrier(0)
  Unit cur, nxt; int ui = 0;
  if (!S.next(0, cur)) return;
  f32x4 acc[2][2][4][2];
#pragma unroll
  for (int a = 0; a < 2; ++a)
#pragma unroll
    for (int b = 0; b < 2; ++b)
#pragma unroll
      for (int m = 0; m < 4; ++m)
#pragma unroll
        for (int n = 0; n < 2; ++n) acc[a][b][m][n] = (f32x4){0.f, 0.f, 0.f, 0.f};
  bf16x8 At[4][2], B0[2][2], B1[2][2];
  unsigned oc0[2], oc1[2], on0[2], on1[2];
#pragma unroll
  for (int i = 0; i < 2; ++i) { oc0[i] = S.a_off(cur, sR[i]) + (unsigned)sC[i] * 2u; oc1[i] = S.a_off(cur, HALF + sR[i]) + (unsigned)sC[i] * 2u; }
  const char* const Ab = S.a_base();
  const char* cB = S.b_base(cur);
  PG8_STAGE(PG8_SB(0, 0), cB, voffB); PG8_STAGE(PG8_SA(0, 0), Ab, oc0); PG8_STAGE(PG8_SB(0, 1), cB + hstep, voffB); PG8_STAGE(PG8_SA(0, 1), Ab, oc1);
  if (wr == 1) PG8_BAR;
  PG8_WAIT_V(4); PG8_BAR;
  PG8_STAGE(PG8_SB(1, 0), cB + kstep, voffB); PG8_STAGE(PG8_SA(1, 0), Ab + kstep, oc0); PG8_STAGE(PG8_SB(1, 1), cB + hstep + kstep, voffB);
  PG8_WAIT_V(6); PG8_BAR;
  for (;;) {
    const bool has_next = S.next(ui + 1, nxt);
    const char* nB = cB;
    if (has_next) {
      nB = S.b_base(nxt);
#pragma unroll
      for (int i = 0; i < 2; ++i) { on0[i] = S.a_off(nxt, sR[i]) + (unsigned)sC[i] * 2u; on1[i] = S.a_off(nxt, HALF + sR[i]) + (unsigned)sC[i] * 2u; }
    } else {
#pragma unroll
      for (int i = 0; i < 2; ++i) { on0[i] = oc0[i]; on1[i] = oc1[i]; }
    }
    for (int t = 0; t < nt; t += 2) {
      const bool last = (t == nt - 2);
      const char* a1 = Ab + (size_t)(t + 1) * kstep;
      const char* a2 = last ? Ab : Ab + (size_t)(t + 2) * kstep; const char* b2 = last ? nB : cB + (size_t)(t + 2) * kstep;
      const char* a3 = a2 + kstep; const char* b3 = b2 + kstep;
      unsigned o20[2], o21[2];
#pragma unroll
      for (int i = 0; i < 2; ++i) { o20[i] = last ? on0[i] : oc0[i]; o21[i] = last ? on1[i] : oc1[i]; }
      PG8_LDB(B0, 0, 0); PG8_SCHED; PG8_LDA(At, 0, 0); PG8_STAGE(PG8_SA(1, 1), a1, oc1);
      PG8_WAIT_L(8); PG8_BAR; PG8_WAIT_L(0); PG8_MMA(0, 0, At, B0); PG8_BAR; PG8_SCHED;
      PG8_LDB(B1, 0, 1); PG8_STAGE(PG8_SB(0, 0), b2, voffB);
      PG8_BAR; PG8_WAIT_L(0); PG8_MMA(0, 1, At, B1); PG8_BAR;
      PG8_LDA(At, 0, 1); PG8_STAGE(PG8_SA(0, 0), a2, o20);
      PG8_BAR; PG8_WAIT_L(0); PG8_MMA(1, 0, At, B0); PG8_BAR; PG8_SCHED;
      PG8_STAGE(PG8_SB(0, 1), b2 + hstep, voffB);
      PG8_WAIT_V(6); PG8_BAR; PG8_MMA(1, 1, At, B1); PG8_BAR;
      PG8_LDB(B0, 1, 0); PG8_SCHED; PG8_LDA(At, 1, 0); PG8_STAGE(PG8_SA(0, 1), a2, o21);
      PG8_WAIT_L(8); PG8_BAR; PG8_WAIT_L(0); PG8_MMA(0, 0, At, B0); PG8_BAR; PG8_SCHED;
      PG8_LDB(B1, 1, 1); PG8_STAGE(PG8_SB(1, 0), b3, voffB);
      PG8_BAR; PG8_WAIT_L(0); PG8_MMA(0, 1, At, B1); PG8_BAR;
      PG8_LDA(At, 1, 1); PG8_STAGE(PG8_SA(1, 0), a3, o20);
      PG8_BAR; PG8_WAIT_L(0); PG8_MMA(1, 0, At, B0); PG8_BAR; PG8_SCHED;
      PG8_STAGE(PG8_SB(1, 1), b3 + hstep, voffB);
      PG8_WAIT_V(6); PG8_BAR; PG8_MMA(1, 1, At, B1); PG8_BAR;
    }
    S.epi(acc, cur, wr, wc, fr, fq);
    if (!has_next) break;
#pragma unroll
    for (int a = 0; a < 2; ++a)
#pragma unroll
      for (int b = 0; b < 2; ++b)
#pragma unroll
        for (int m = 0; m < 4; ++m)
#pragma unroll
          for (int n = 0; n < 2; ++n) acc[a][b][m][n] = (f32x4){0.f, 0.f, 0.f, 0.f};
    cur = nxt; cB = nB; ++ui;
#pragma unroll
    for (int i = 0; i < 2; ++i) { oc0[i] = on0[i]; oc1[i] = on1[i]; }
  }
  PG8_WAIT_V(0);
  if (wr == 0) PG8_BAR;
  PG8_BAR;
#undef PG8_SA
#undef PG8_SB
#undef PG8_STAGE
#undef PG8_LDA
#undef PG8_LDB
#undef PG8_MMA
#undef PG8_WAIT_V
#undef PG8_WAIT_L
#undef PG8_BAR
#undef PG8_SCHED
}
}
#endif
#ifndef CPU_EMU
#include <hip/hip_cooperative_groups.h>
namespace cg = cooperative_groups;
#define LAS __attribute__((address_space(3)))
#define NTHREADS 512
#define LDS_BYTES (128 * 1024 + 2048)
typedef float f32x4 __attribute__((ext_vector_type(4)));
typedef short bf16x8 __attribute__((ext_vector_type(8)));
typedef unsigned u32x4 __attribute__((ext_vector_type(4)));
typedef unsigned u32x2 __attribute__((ext_vector_type(2)));

struct Ctx { int tid, lane, wid, G, bid; unsigned char* lds; };
__device__ __forceinline__ int opaque_tid() { int t = threadIdx.x; asm volatile("" : "+v"(t)); return t; }
__device__ __forceinline__ Ctx make_ctx(unsigned char* lds) { Ctx c; c.tid = opaque_tid(); c.lane = c.tid & 63; c.wid = __builtin_amdgcn_readfirstlane(c.tid >> 6); c.G = gridDim.x; c.bid = blockIdx.x; c.lds = lds; return c; }

__device__ __forceinline__ float wave_sum(float v) {
#pragma unroll
  for (int o = 32; o > 0; o >>= 1) v += __shfl_xor(v, o);
  return v;
}
__device__ __forceinline__ unsigned pk2(float a, float b) { return (unsigned)f2bf(a) | ((unsigned)f2bf(b) << 16); }
__device__ __forceinline__ void unpack8(u32x4 w, float* f) {
  f[0] = __uint_as_float(w.x << 16); f[1] = __uint_as_float(w.x & 0xffff0000u); f[2] = __uint_as_float(w.y << 16); f[3] = __uint_as_float(w.y & 0xffff0000u);
  f[4] = __uint_as_float(w.z << 16); f[5] = __uint_as_float(w.z & 0xffff0000u); f[6] = __uint_as_float(w.w << 16); f[7] = __uint_as_float(w.w & 0xffff0000u);
}

__device__ __forceinline__ void transpose_job(const Ctx& c, const float* src, int N, bf16_t* dst, int rs, int ro, int tile0, int tile_stride) {
  float* t = (float*)c.lds;
  const int ntn = (N + 63) / 64, ntiles = ntn * 16;
  for (int tl = tile0; tl < ntiles; tl += tile_stride) {
    const int kt = tl / ntn, nt_ = tl % ntn, k0 = kt * 64, n0 = nt_ * 64;
    __syncthreads();
#pragma unroll
    for (int i = 0; i < 8; ++i) { const int idx = c.tid + i * 512, kk = idx >> 6, nn = idx & 63; t[kk * 65 + nn] = (n0 + nn < N) ? src[(size_t)(k0 + kk) * N + n0 + nn] : 0.f; }
    __syncthreads();
#pragma unroll
    for (int i = 0; i < 4; ++i) { const int idx = c.tid + i * 512, nn = idx >> 5, kp = (idx & 31) * 2;
      if (n0 + nn < N) *(unsigned*)(dst + (size_t)((n0 + nn) * rs + ro) * 1024 + k0 + kp) = pk2(t[kp * 65 + nn], t[(kp + 1) * 65 + nn]); }
  }
  __syncthreads();
}
__device__ __forceinline__ void p0_prologue(unsigned char* lds_, const Params& p) {
  const Ctx c = make_ctx(lds_);
  unsigned char* ws = p.ws;
  if (c.bid == 0 && c.tid < 128) ((unsigned*)(ws + WS_CTL))[64 + c.tid] = 0u;
  { const float* x = p.in[I_X]; bf16_t* hb = (bf16_t*)(ws + WS_HB);
    for (size_t i = (size_t)c.bid * NTHREADS + c.tid; i < (size_t)NTOK * 1024 / 8; i += (size_t)c.G * NTHREADS) {
      const f32x4 a = *(const f32x4*)(x + i * 8), b = *(const f32x4*)(x + i * 8 + 4);
      u32x4 w; w.x = pk2(a[0], a[1]); w.y = pk2(a[2], a[3]); w.z = pk2(b[0], b[1]); w.w = pk2(b[2], b[3]);
      *(u32x4*)(hb + i * 8) = w; } }
  transpose_job(c, p.in[I_AB_W_IN], P_AB, (bf16_t*)(ws + WS_WIN_AB), 1, 0, c.bid, c.G);
  transpose_job(c, p.in[I_CD_W_IN], P_CD, (bf16_t*)(ws + WS_WIN_CD), 1, 0, c.bid, c.G);
  transpose_job(c, p.in[I_AB_W_OUT], 1024, (bf16_t*)(ws + WS_WOUT_AB), 1, 0, c.bid, c.G);
  transpose_job(c, p.in[I_CD_W_OUT], 1024, (bf16_t*)(ws + WS_WOUT_CD), 1, 0, c.bid, c.G);
  { float* rope = (float*)(ws + WS_ROPE);
    for (int i = c.bid * NTHREADS + c.tid; i < SEQ * 32; i += c.G * NTHREADS) { const int t = i >> 5, f = i & 31;
      const float freq = powf(10000.0f, -(float)f / 32.0f); const float ang = (float)t * freq; rope[i * 2] = cosf(ang); rope[i * 2 + 1] = sinf(ang); }
    if (c.bid == 1) { const float* hl = p.in[I_HGRN_LB]; float* lb = (float*)(ws + WS_LB);
      const int cc = c.tid; const float a0 = hl[cc], a1 = hl[512 + cc], a2 = hl[1024 + cc]; const float mx = fmaxf(a0, fmaxf(a1, a2));
      const float e0 = expf(a0 - mx), e1 = expf(a1 - mx), e2 = expf(a2 - mx); lb[cc] = e0 / (e0 + e1 + e2); } }
}
__device__ __forceinline__ void moe_weight_convert(unsigned char* lds_, const Params& p, int layer) {
  const Ctx c = make_ctx(lds_);
  bf16_t* w13 = (bf16_t*)(p.ws + WS_WMOE); bf16_t* w2 = w13 + (size_t)NEXP * 2048 * 1024;
  const size_t lo = (size_t)layer * NEXP * 1024 * 1024;
  for (int e = 0; e < NEXP; ++e) {
    const size_t mo = lo + (size_t)e * 1024 * 1024;
    transpose_job(c, p.in[I_MOE_W1] + mo, 1024, w13 + (size_t)e * 2048 * 1024, 2, 0, c.bid, c.G);
    transpose_job(c, p.in[I_MOE_W3] + mo, 1024, w13 + (size_t)e * 2048 * 1024, 2, 1, c.bid, c.G);
    transpose_job(c, p.in[I_MOE_W2] + mo, 1024, w2 + (size_t)e * 1024 * 1024, 1, 0, c.bid, c.G);
  }
}

struct ProbInProj {
  static constexpr bool PERM = true;
  pg8::StaticOrder so; const char* A; const char* Bt; bf16_t* P; const float* bias; const float* lb; int layer;
  __device__ __forceinline__ bool next(int i, pg8::Unit& u) const { return so.next(i, u); }
  __device__ __forceinline__ const char* a_base() const { return A; }
  __device__ __forceinline__ unsigned a_off(const pg8::Unit& u, int r) const { return (unsigned)(u.pm * 256 + r) * 2048u; }
  __device__ __forceinline__ const char* b_base(const pg8::Unit& u) const { return Bt + (size_t)u.pn * 256 * 2048; }
  __device__ __forceinline__ void epi(const f32x4 (&acc)[2][2][4][2], const pg8::Unit& u, int wr, int wc, int fr, int fq) const {
    const int row0 = u.row0 + wr * 64 + fr, colb = u.pn * 256 + wc * 32 + 8 * fq;
    int mode = 0;
    if (layer == 0) { mode = u.pn < 2 ? 1 : (u.pn < 6 ? 2 : (u.pn == 10 ? 3 : 0)); }
#pragma unroll
    for (int bj = 0; bj < 2; ++bj) {
      const int col0 = colb + bj * 128;
      const f32x4 b0 = *(const f32x4*)(bias + col0), b1 = *(const f32x4*)(bias + col0 + 4);
      f32x4 l0 = (f32x4){0.f, 0.f, 0.f, 0.f}, l1 = l0;
      if (mode == 2) { l0 = *(const f32x4*)(lb + ((col0 - 512) & 511)); l1 = *(const f32x4*)(lb + ((col0 - 512) & 511) + 4); }
#pragma unroll
      for (int ai = 0; ai < 2; ++ai)
#pragma unroll
        for (int m = 0; m < 4; ++m) {
          f32x4 v0 = acc[ai][bj][m][0] + b0, v1 = acc[ai][bj][m][1] + b1;
          if (mode == 1) {
#pragma unroll
            for (int j = 0; j < 4; ++j) { v0[j] = siluf_(v0[j]); v1[j] = siluf_(v1[j]); }
          } else if (mode == 2) {
#pragma unroll
            for (int j = 0; j < 4; ++j) { v0[j] = logf(l0[j] + (1.0f - l0[j]) * sigmoidf_(v0[j])); v1[j] = logf(l1[j] + (1.0f - l1[j]) * sigmoidf_(v1[j])); }
          } else if (mode == 3) { v0 *= 0.125f; v1 *= 0.125f; }
          u32x4 w; w.x = pk2(v0[0], v0[1]); w.y = pk2(v0[2], v0[3]); w.z = pk2(v1[0], v1[1]); w.w = pk2(v1[2], v1[3]);
          *(u32x4*)(P + (size_t)(row0 + ai * 128 + m * 16) * PSTRIDE + col0) = w;
        }
    }
  }
};
struct ProbOutProj {
  static constexpr bool PERM = false;
  pg8::StaticOrder so; const char* A; const char* Bt; float* Y;
  __device__ __forceinline__ bool next(int i, pg8::Unit& u) const { return so.next(i, u); }
  __device__ __forceinline__ const char* a_base() const { return A; }
  __device__ __forceinline__ unsigned a_off(const pg8::Unit& u, int r) const { return (unsigned)(u.pm * 256 + r) * 2048u; }
  __device__ __forceinline__ const char* b_base(const pg8::Unit& u) const { return Bt + (size_t)u.pn * 256 * 2048; }
  __device__ __forceinline__ void epi(const f32x4 (&acc)[2][2][4][2], const pg8::Unit& u, int wr, int wc, int fr, int fq) const {
    const int row0 = u.row0 + wr * 64 + fr, col0 = u.pn * 256 + wc * 32 + 4 * fq;
#pragma unroll
    for (int ai = 0; ai < 2; ++ai)
#pragma unroll
      for (int m = 0; m < 4; ++m) { float* rowp = Y + (size_t)(row0 + ai * 128 + m * 16) * 1024 + col0;
#pragma unroll
        for (int bj = 0; bj < 2; ++bj)
#pragma unroll
          for (int n = 0; n < 2; ++n) *(f32x4*)(rowp + bj * 128 + n * 16) = acc[ai][bj][m][n]; }
  }
};
struct MoeOrder {
  const int* cnt; int ntn, G, c;
  __device__ __forceinline__ bool next(int i, pg8::Unit& u) const {
    int L = i * G + c; int pad = 0;
    for (int e = 0; e < NEXP; ++e) { const int n = cnt[e], mt = (n + 255) >> 8, tiles = mt * ntn;
      if (L < tiles) { u.e = e; u.pn = L / mt; u.pm = L % mt; u.row0 = pad + u.pm * 256; return true; }
      L -= tiles; pad += mt * 256; }
    return false;
  }
};
struct ProbMoe1 {
  static constexpr bool PERM = true;
  MoeOrder mo; const char* A; const char* W13; const int* list; bf16_t* H;
  __device__ __forceinline__ bool next(int i, pg8::Unit& u) const { return mo.next(i, u); }
  __device__ __forceinline__ const char* a_base() const { return A; }
  __device__ __forceinline__ unsigned a_off(const pg8::Unit& u, int r) const { const int rr = u.pm * 256 + r; const int tok = rr < mo.cnt[u.e] ? list[u.e * NTOK + rr] : 0; return (unsigned)tok * 2048u; }
  __device__ __forceinline__ const char* b_base(const pg8::Unit& u) const { return W13 + ((size_t)u.e * 2048 + (size_t)u.pn * 256) * 2048; }
  __device__ __forceinline__ void epi(const f32x4 (&acc)[2][2][4][2], const pg8::Unit& u, int wr, int wc, int fr, int fq) const {
    const int row0 = u.row0 + wr * 64 + fr, colb = u.pn * 128 + wc * 16 + 4 * fq;
#pragma unroll
    for (int ai = 0; ai < 2; ++ai)
#pragma unroll
      for (int m = 0; m < 4; ++m)
#pragma unroll
        for (int bj = 0; bj < 2; ++bj) {
          const f32x4 v0 = acc[ai][bj][m][0], v1 = acc[ai][bj][m][1];
          u32x2 w; w.x = pk2(siluf_(v0[0]) * v0[1], siluf_(v0[2]) * v0[3]); w.y = pk2(siluf_(v1[0]) * v1[1], siluf_(v1[2]) * v1[3]);
          *(u32x2*)(H + (size_t)(row0 + ai * 128 + m * 16) * 1024 + colb + bj * 64) = w;
        }
  }
};
struct ProbMoe2 {
  static constexpr bool PERM = true;
  MoeOrder mo; const char* A; const char* W2; bf16_t* Y;
  __device__ __forceinline__ bool next(int i, pg8::Unit& u) const { return mo.next(i, u); }
  __device__ __forceinline__ const char* a_base() const { return A; }
  __device__ __forceinline__ unsigned a_off(const pg8::Unit& u, int r) const { return (unsigned)(u.row0 + r) * 2048u; }
  __device__ __forceinline__ const char* b_base(const pg8::Unit& u) const { return W2 + ((size_t)u.e * 1024 + (size_t)u.pn * 256) * 2048; }
  __device__ __forceinline__ void epi(const f32x4 (&acc)[2][2][4][2], const pg8::Unit& u, int wr, int wc, int fr, int fq) const {
    const int row0 = u.row0 + wr * 64 + fr, colb = u.pn * 256 + wc * 32 + 8 * fq;
#pragma unroll
    for (int ai = 0; ai < 2; ++ai)
#pragma unroll
      for (int m = 0; m < 4; ++m)
#pragma unroll
        for (int bj = 0; bj < 2; ++bj) {
          const f32x4 v0 = acc[ai][bj][m][0], v1 = acc[ai][bj][m][1];
          u32x4 w; w.x = pk2(v0[0], v0[1]); w.y = pk2(v0[2], v0[3]); w.z = pk2(v1[0], v1[1]); w.w = pk2(v1[2], v1[3]);
          *(u32x4*)(Y + (size_t)(row0 + ai * 128 + m * 16) * 1024 + colb + bj * 128) = w;
        }
  }
};

template <int NS>
__device__ __forceinline__ void side_phase(unsigned char* lds_, const Params& p, int layer) {
  const Ctx c = make_ctx(lds_);
  const bf16_t* hb = (const bf16_t*)(p.ws + WS_HB);
  const bf16_t* wt = (const bf16_t*)(p.ws + (layer == 0 ? WS_WIN_AB : WS_WIN_CD)) + (size_t)(layer == 0 ? PM_AB : PM_CD) * 1024;
  const float* bias = p.in[layer == 0 ? I_AB_B_IN : I_CD_B_IN] + (layer == 0 ? PM_AB : PM_CD);
  float* side = (float*)(p.ws + WS_SIDE);
  float* tl = (float*)c.lds + c.wid * (16 * 33);
  const int fr = c.lane & 15, fq = c.lane >> 4;
  for (int g = c.bid * 8 + c.wid; g < NTOK / 16; g += c.G * 8) {
    const int r0 = g * 16;
    f32x4 acc0 = (f32x4){0.f, 0.f, 0.f, 0.f}, acc1 = acc0;
    const bf16_t* ap = hb + (size_t)(r0 + fr) * 1024 + fq * 8;
    const bf16_t* bp0 = wt + (size_t)fr * 1024 + fq * 8; const bf16_t* bp1 = bp0 + 16 * 1024;
#pragma unroll 4
    for (int k = 0; k < 1024; k += 32) {
      const bf16x8 a = *(const bf16x8*)(ap + k), b0 = *(const bf16x8*)(bp0 + k);
      acc0 = __builtin_amdgcn_mfma_f32_16x16x32_bf16(a, b0, acc0, 0, 0, 0);
      if (NS == 32) { const bf16x8 b1 = *(const bf16x8*)(bp1 + k); acc1 = __builtin_amdgcn_mfma_f32_16x16x32_bf16(a, b1, acc1, 0, 0, 0); }
    }
#pragma unroll
    for (int j = 0; j < 4; ++j) { const float v0 = acc0[j] + bias[fr]; side[(size_t)(r0 + fq * 4 + j) * 32 + fr] = v0; tl[(fq * 4 + j) * 33 + fr] = v0;
      if (NS == 32) { const float v1 = acc1[j] + bias[16 + fr]; side[(size_t)(r0 + fq * 4 + j) * 32 + 16 + fr] = v1; tl[(fq * 4 + j) * 33 + 16 + fr] = v1; } }
    if (NS == 32) {
      __builtin_amdgcn_s_waitcnt(0xC07F);
      const float* gu = p.in[I_GK_UP]; const float* gb = p.in[I_GK_B]; bf16_t* lfb = (bf16_t*)(p.ws + WS_LFB);
      const int cb = c.lane * 8, dir = cb >> 8, cc = cb & 255;
      float w[16][8];
#pragma unroll
      for (int r = 0; r < 16; ++r)
#pragma unroll
        for (int j = 0; j < 8; ++j) w[r][j] = gu[(dir * 16 + r) * 256 + cc + j];
      float bb[8];
#pragma unroll
      for (int j = 0; j < 8; ++j) bb[j] = gb[dir * 256 + cc + j];
      for (int row = 0; row < 16; ++row) {
        float z[8];
#pragma unroll
        for (int j = 0; j < 8; ++j) z[j] = bb[j];
#pragma unroll
        for (int r = 0; r < 16; ++r) { const float s = tl[row * 33 + dir * 16 + r];
#pragma unroll
          for (int j = 0; j < 8; ++j) z[j] += s * w[r][j]; }
        u32x4 o; o.x = pk2(logsigmoidf_(z[0]) * 0.0625f, logsigmoidf_(z[1]) * 0.0625f); o.y = pk2(logsigmoidf_(z[2]) * 0.0625f, logsigmoidf_(z[3]) * 0.0625f);
        o.z = pk2(logsigmoidf_(z[4]) * 0.0625f, logsigmoidf_(z[5]) * 0.0625f); o.w = pk2(logsigmoidf_(z[6]) * 0.0625f, logsigmoidf_(z[7]) * 0.0625f);
        *(u32x4*)(lfb + (size_t)(r0 + row) * 512 + cb) = o;
      }
    }
  }
}

__device__ __forceinline__ void headnorm_phase(unsigned char* lds_, const Params& p, int layer) {
  const Ctx c = make_ctx(lds_);
  const bf16_t* P = (const bf16_t*)(p.ws + WS_R1); const bf16_t* O = (const bf16_t*)(p.ws + WS_R2);
  const float* oside = (const float*)(p.ws + WS_OSIDE);
  bf16_t* mixed = (bf16_t*)(p.ws + WS_HB);
  const int c0 = c.lane * 16, h8 = c.lane >> 3;
  const float* gain = layer == 0 ? (h8 < 4 ? p.in[I_HGRN_NORM] + c0 : p.in[I_GLA_NORM] + c0 - 512) : (h8 < 4 ? p.in[I_RET_NORM] + c0 : p.in[I_MLSTM_NORM] + c0 - 512);
  const int gcol = layer == 0 ? (h8 < 4 ? 2048 + c0 : 3584 + c0 - 512) : (h8 < 4 ? 1024 + c0 : 3072 + c0 - 512);
  float gn[16];
#pragma unroll
  for (int j = 0; j < 16; ++j) gn[j] = gain[j];
  for (int tok = c.bid * 8 + c.wid; tok < NTOK; tok += c.G * 8) {
    float of[16], ob[16], gt[16];
    { const u32x4* a = (const u32x4*)(O + (size_t)tok * 1024 + c0); unpack8(a[0], of); unpack8(a[1], of + 8);
      const u32x4* b = (const u32x4*)(O + (size_t)(NTOK + tok) * 1024 + c0); unpack8(b[0], ob); unpack8(b[1], ob + 8);
      const u32x4* g = (const u32x4*)(P + (size_t)tok * PSTRIDE + gcol); unpack8(g[0], gt); unpack8(g[1], gt + 8); }
    float sf = 1.f, sb = 1.f;
    if (layer == 1 && h8 >= 4) { const int h = h8 - 4;
      const float* s0 = oside + (size_t)tok * 8 + h * 2; const float* s1 = oside + (size_t)(NTOK + tok) * 8 + h * 2;
      sf = 1.0f / fmaxf(fabsf(s0[0]), expf(-s0[1])); sb = 1.0f / fmaxf(fabsf(s1[0]), expf(-s1[1])); }
    float o[16]; float ss = 0.f;
#pragma unroll
    for (int j = 0; j < 16; ++j) { o[j] = of[j] * sf + ob[j] * sb; ss += o[j] * o[j]; }
    ss += __shfl_xor(ss, 1); ss += __shfl_xor(ss, 2); ss += __shfl_xor(ss, 4);
    const float r = 1.0f / sqrtf(ss * (1.0f / 128.0f) + NORM_EPS_F);
    unsigned w[8];
#pragma unroll
    for (int j = 0; j < 8; ++j) {
      float g0 = gt[2 * j], g1 = gt[2 * j + 1];
      if (layer == 1 && h8 >= 4) { g0 = sigmoidf_(g0); g1 = sigmoidf_(g1); } else { g0 = siluf_(g0); g1 = siluf_(g1); }
      w[j] = pk2(o[2 * j] * r * gn[2 * j] * g0, o[2 * j + 1] * r * gn[2 * j + 1] * g1);
    }
    u32x4* d = (u32x4*)(mixed + (size_t)tok * 1024 + c0);
    d[0] = (u32x4){w[0], w[1], w[2], w[3]}; d[1] = (u32x4){w[4], w[5], w[6], w[7]};
  }
}

__device__ __forceinline__ void ln_phase(unsigned char* lds_, const Params& p, int layer, int mode) {
  const Ctx c = make_ctx(lds_);
  unsigned char* ws = p.ws;
  const float* hin = (mode == 0 && layer == 0) ? p.in[I_X] : p.out;
  float* hout = p.out; bf16_t* hb = (bf16_t*)(ws + WS_HB);
  const float* g = p.in[mode == 0 ? I_LN_MIX_G : I_LN_FFN_G] + layer * 1024; const float* b = p.in[mode == 0 ? I_LN_MIX_B : I_LN_FFN_B] + layer * 1024;
  unsigned* cnt = (unsigned*)(ws + WS_CTL) + CW_CNT(layer);
  int* list = (int*)(ws + WS_LIST) + (size_t)layer * NEXP * NTOK;
  int* assign = (int*)(ws + WS_ASSIGN); float* gate = (float*)(ws + WS_GATE);
  float* rw = (float*)c.lds;
  int pad[NEXP];
  if (mode == 0) { const float* r = p.in[I_ROUTER_W]; for (int i = c.tid; i < 1024 * 16 / 4; i += NTHREADS) ((f32x4*)rw)[i] = ((const f32x4*)r)[i]; __syncthreads(); }
  else { int acc = 0;
#pragma unroll
    for (int e = 0; e < NEXP; ++e) { pad[e] = acc; acc += (((int)cnt[e] + 255) >> 8) << 8; } }
  const int c0 = c.lane * 16;
  float gv[16], bv[16];
#pragma unroll
  for (int j = 0; j < 16; ++j) { gv[j] = g[c0 + j]; bv[j] = b[c0 + j]; }
  for (int tok = c.bid * 8 + c.wid; tok < NTOK; tok += c.G * 8) {
    float v[16];
    { const f32x4* hp = (const f32x4*)(hin + (size_t)tok * 1024 + c0);
#pragma unroll
      for (int q = 0; q < 4; ++q) { const f32x4 t = hp[q]; v[4 * q] = ALPHA_F * t[0]; v[4 * q + 1] = ALPHA_F * t[1]; v[4 * q + 2] = ALPHA_F * t[2]; v[4 * q + 3] = ALPHA_F * t[3]; } }
    if (mode == 0) { const f32x4* yp = (const f32x4*)((const float*)(ws + WS_R2) + (size_t)tok * 1024 + c0);
#pragma unroll
      for (int q = 0; q < 4; ++q) { const f32x4 t = yp[q]; v[4 * q] += t[0]; v[4 * q + 1] += t[1]; v[4 * q + 2] += t[2]; v[4 * q + 3] += t[3]; }
    } else {
      const int a0 = assign[tok * 4], a1 = assign[tok * 4 + 1], a2 = assign[tok * 4 + 2], a3 = assign[tok * 4 + 3];
      const float g0 = gate[tok * 2], g1 = gate[tok * 2 + 1];
      int p0 = 0, p1 = 0;
#pragma unroll
      for (int e = 0; e < NEXP; ++e) { if (e == a0) p0 = pad[e]; if (e == a2) p1 = pad[e]; }
      p0 += a1; p1 += a3;
      const bf16_t* Y = (const bf16_t*)(ws + WS_R2);
      float y0[16], y1[16];
      { const u32x4* q0 = (const u32x4*)(Y + (size_t)p0 * 1024 + c0); unpack8(q0[0], y0); unpack8(q0[1], y0 + 8);
        const u32x4* q1 = (const u32x4*)(Y + (size_t)p1 * 1024 + c0); unpack8(q1[0], y1); unpack8(q1[1], y1 + 8); }
#pragma unroll
      for (int j = 0; j < 16; ++j) v[j] += g0 * y0[j] + g1 * y1[j];
    }
    float s = 0.f;
#pragma unroll
    for (int j = 0; j < 16; ++j) s += v[j];
    const float mean = wave_sum(s) * (1.0f / 1024.0f);
    float q = 0.f;
#pragma unroll
    for (int j = 0; j < 16; ++j) { v[j] -= mean; q += v[j] * v[j]; }
    const float r = 1.0f / sqrtf(wave_sum(q) * (1.0f / 1024.0f) + LN_EPS_F);
#pragma unroll
    for (int j = 0; j < 16; ++j) v[j] = v[j] * r * gv[j] + bv[j];
    { f32x4* op = (f32x4*)(hout + (size_t)tok * 1024 + c0);
#pragma unroll
      for (int q4 = 0; q4 < 4; ++q4) op[q4] = (f32x4){v[4 * q4], v[4 * q4 + 1], v[4 * q4 + 2], v[4 * q4 + 3]}; }
    if (!(mode == 1 && layer == 1)) { u32x4* d = (u32x4*)(hb + (size_t)tok * 1024 + c0);
      d[0] = (u32x4){pk2(v[0], v[1]), pk2(v[2], v[3]), pk2(v[4], v[5]), pk2(v[6], v[7])}; d[1] = (u32x4){pk2(v[8], v[9]), pk2(v[10], v[11]), pk2(v[12], v[13]), pk2(v[14], v[15])}; }
    if (mode == 0) {
      float lg[16];
#pragma unroll
      for (int e = 0; e < 16; ++e) lg[e] = 0.f;
#pragma unroll
      for (int j = 0; j < 16; ++j) { const f32x4* wp = (const f32x4*)(rw + (c0 + j) * 16);
#pragma unroll
        for (int q4 = 0; q4 < 4; ++q4) { const f32x4 w = wp[q4]; lg[4 * q4] += v[j] * w[0]; lg[4 * q4 + 1] += v[j] * w[1]; lg[4 * q4 + 2] += v[j] * w[2]; lg[4 * q4 + 3] += v[j] * w[3]; }
        if (j & 1) asm volatile("" ::: "memory"); }
#pragma unroll
      for (int e = 0; e < 16; ++e) lg[e] = wave_sum(lg[e]);
      int eo[2]; float go[2];
      route_from_logits(lg, p.in[I_ROUTER_B], eo, go);
      if (c.lane == 0) {
        const int r1 = (int)atomicAdd(cnt + eo[0], 1u), r2 = (int)atomicAdd(cnt + eo[1], 1u);
        list[eo[0] * NTOK + r1] = tok; list[eo[1] * NTOK + r2] = tok;
        assign[tok * 4] = eo[0]; assign[tok * 4 + 1] = r1; assign[tok * 4 + 2] = eo[1]; assign[tok * 4 + 3] = r2;
        gate[tok * 2] = go[0]; gate[tok * 2 + 1] = go[1];
      }
    }
  }
  __syncthreads();
}
#endif
#ifndef CPU_EMU
template <class F> __device__ __forceinline__ void run_functor(const F& f, long n) {
  const int tid = opaque_tid();
  for (long g = (long)blockIdx.x * NTHREADS + tid; g < n; g += (long)gridDim.x * NTHREADS) f(g);
}

__global__ void __launch_bounds__(NTHREADS) mk_fwd(Params p) {
  extern __shared__ __attribute__((aligned(16))) unsigned char lds_raw[];
  cg::grid_group grid = cg::this_grid();
  const int G = gridDim.x, bid = blockIdx.x;
  PG8_LAS unsigned char* lds = (PG8_LAS unsigned char*)lds_raw;
  unsigned char* ws = p.ws;

  p0_prologue(lds_raw, p);
  grid.sync();
  for (int layer = 0; layer < 2; ++layer) {
    { ProbInProj pr; pr.so.init(NTOK, layer == 0 ? PM_AB : PM_CD, G, bid); pr.A = (const char*)(ws + WS_HB); pr.Bt = (const char*)(ws + (layer == 0 ? WS_WIN_AB : WS_WIN_CD));
      pr.P = (bf16_t*)(ws + WS_R1); pr.bias = p.in[layer == 0 ? I_AB_B_IN : I_CD_B_IN]; pr.lb = (const float*)(ws + WS_LB); pr.layer = layer;
      pg8::gemm_phase(lds, pr);
      if (layer == 0) side_phase<32>(lds_raw, p, 0); else side_phase<16>(lds_raw, p, 1); }
    grid.sync();
    if (layer == 0) { ScanAB2 s{}; s.P = (const bf16_t*)(ws + WS_R1); s.LFB = (const bf16_t*)(ws + WS_LFB); s.O = (bf16_t*)(ws + WS_R2); run_functor(s, (long)BATCH * 2048); }
    else {
      PrepCD2 pc{}; pc.P = (bf16_t*)(ws + WS_R1); pc.QD = (bf16_t*)(ws + WS_LFB); pc.rope = (const float*)(ws + WS_ROPE); pc.conv_w = p.in[I_CONV_W]; pc.conv_b = p.in[I_CONV_B];
      run_functor(pc, (long)NTOK * 1280);
      grid.sync();
      ScanCD2 s{}; s.P = (const bf16_t*)(ws + WS_R1); s.QD = (const bf16_t*)(ws + WS_LFB); s.side = (const float*)(ws + WS_SIDE); s.fgate_b = p.in[I_FGATE_B]; s.O = (bf16_t*)(ws + WS_R2); s.oside = (float*)(ws + WS_OSIDE);
      run_functor(s, (long)BATCH * 2056);
    }
    grid.sync();
    headnorm_phase(lds_raw, p, layer);
    grid.sync();
    { ProbOutProj pr; pr.so.init(NTOK, 1024, G, bid); pr.A = (const char*)(ws + WS_HB); pr.Bt = (const char*)(ws + (layer == 0 ? WS_WOUT_AB : WS_WOUT_CD)); pr.Y = (float*)(ws + WS_R2);
      pg8::gemm_phase(lds, pr);
      moe_weight_convert(lds_raw, p, layer); }
    grid.sync();
    ln_phase(lds_raw, p, layer, 0);
    grid.sync();
    { ProbMoe1 pr; pr.mo.cnt = (const int*)((const unsigned*)(ws + WS_CTL) + CW_CNT(layer)); pr.mo.ntn = 8; pr.mo.G = G; pr.mo.c = bid;
      pr.A = (const char*)(ws + WS_HB); pr.W13 = (const char*)(ws + WS_WMOE); pr.list = (const int*)(ws + WS_LIST) + (size_t)layer * NEXP * NTOK; pr.H = (bf16_t*)(ws + WS_H);
      pg8::gemm_phase(lds, pr); }
    grid.sync();
    { ProbMoe2 pr; pr.mo.cnt = (const int*)((const unsigned*)(ws + WS_CTL) + CW_CNT(layer)); pr.mo.ntn = 4; pr.mo.G = G; pr.mo.c = bid;
      pr.A = (const char*)(ws + WS_H); pr.W2 = (const char*)(ws + WS_WMOE) + (size_t)NEXP * 2048 * 1024 * 2; pr.Y = (bf16_t*)(ws + WS_R2);
      pg8::gemm_phase(lds, pr); }
    grid.sync();
    ln_phase(lds_raw, p, layer, 1);
    if (layer == 0) grid.sync();
  }
}

extern "C" void kernel_launch(void* const* d_in, const int* in_sizes, int n_in, void* d_out, int out_size, void* d_ws, size_t ws_size, hipStream_t stream) {
  static int grid_blocks = 0;
  if (grid_blocks == 0) {
    if (n_in != N_IN || ws_size < WS_END || out_size != NTOK * 1024) { fprintf(stderr, "kernel_launch: bad shapes: n_in %d ws %zu (need %zu) out %d\n", n_in, ws_size, (size_t)WS_END, out_size); grid_blocks = -1; return; }
    int dev = 0, cus = 0, per_cu = 0;
    hipGetDevice(&dev); hipDeviceGetAttribute(&cus, hipDeviceAttributeMultiprocessorCount, dev);
    if (hipFuncSetAttribute((const void*)mk_fwd, hipFuncAttributeMaxDynamicSharedMemorySize, LDS_BYTES) != hipSuccess) { fprintf(stderr, "kernel_launch: hipFuncSetAttribute failed\n"); grid_blocks = -1; return; }
    if (hipOccupancyMaxActiveBlocksPerMultiprocessor(&per_cu, (const void*)mk_fwd, NTHREADS, LDS_BYTES) != hipSuccess || per_cu < 1) { fprintf(stderr, "kernel_launch: occupancy query failed (%d)\n", per_cu); grid_blocks = -1; return; }
    grid_blocks = cus;
    (void)in_sizes;
  }
  if (grid_blocks < 0) return;
  Params p{};
  for (int i = 0; i < N_IN; ++i) p.in[i] = (const float*)d_in[i];
  p.out = (float*)d_out; p.ws = (unsigned char*)d_ws;
  void* args[] = {&p};
  hipError_t e = hipLaunchCooperativeKernel((const void*)mk_fwd, dim3(grid_blocks), dim3(NTHREADS), args, LDS_BYTES, stream);
  if (e != hipSuccess) fprintf(stderr, "cooperative launch failed: %s (grid %d)\n", hipGetErrorString(e), grid_blocks);
}
#endif
#ifdef CPU_EMU
#include <vector>
void dbg_cmp(const char* name, const float* p, long n);
template <class F> static void run_functor(const F& f, long n) {
#pragma omp parallel for schedule(dynamic, 16)
  for (long g = 0; g < n; ++g) f(g);
}
static void cpu_round_w(const float* src, size_t n, std::vector<float>& dst) { dst.resize(n); for (size_t i = 0; i < n; ++i) dst[i] = bf2f(f2bf(src[i])); }

extern "C" void kernel_launch(void* const* d_in, const int* in_sizes, int n_in, void* d_out, int out_size, void* d_ws, size_t ws_size, hipStream_t) {
  (void)in_sizes; (void)n_in; (void)out_size;
  if (ws_size < WS_END) { printf("ws too small %zu < %zu\n", ws_size, (size_t)WS_END); return; }
  Params p{}; for (int i = 0; i < N_IN; ++i) p.in[i] = (const float*)d_in[i];
  p.out = (float*)d_out; p.ws = (unsigned char*)d_ws;
  unsigned char* ws = p.ws;
  bf16_t* HB = (bf16_t*)(ws + WS_HB); bf16_t* P = (bf16_t*)(ws + WS_R1); bf16_t* LFB = (bf16_t*)(ws + WS_LFB);
  bf16_t* O = (bf16_t*)(ws + WS_R2); float* yf = (float*)(ws + WS_R2); bf16_t* Y = (bf16_t*)(ws + WS_R2); bf16_t* H = (bf16_t*)(ws + WS_H);
  float* side = (float*)(ws + WS_SIDE); float* oside = (float*)(ws + WS_OSIDE); float* rope = (float*)(ws + WS_ROPE); float* lb = (float*)(ws + WS_LB);
  int* assign = (int*)(ws + WS_ASSIGN); float* gate = (float*)(ws + WS_GATE);
  for (size_t i = 0; i < (size_t)NTOK * 1024; ++i) HB[i] = f2bf(p.in[I_X][i]);
  for (int i = 0; i < SEQ * 32; ++i) { int t = i >> 5, f = i & 31; float freq = powf(10000.0f, -(float)f / 32.0f); float ang = (float)t * freq; rope[i * 2] = cosf(ang); rope[i * 2 + 1] = sinf(ang); }
  for (int cc = 0; cc < 512; ++cc) { const float* hl = p.in[I_HGRN_LB]; float a0 = hl[cc], a1 = hl[512 + cc], a2 = hl[1024 + cc]; float mx = fmaxf(a0, fmaxf(a1, a2));
    float e0 = expf(a0 - mx), e1 = expf(a1 - mx), e2 = expf(a2 - mx); lb[cc] = e0 / (e0 + e1 + e2); }
  std::vector<float> wr;
  for (int layer = 0; layer < 2; ++layer) {
    const int PW = layer == 0 ? P_AB : P_CD, PM = layer == 0 ? PM_AB : PM_CD;
    const float* bias = p.in[layer == 0 ? I_AB_B_IN : I_CD_B_IN];
    cpu_round_w(p.in[layer == 0 ? I_AB_W_IN : I_CD_W_IN], (size_t)1024 * PW, wr);
#pragma omp parallel for
    for (long tok = 0; tok < NTOK; ++tok) {
      std::vector<float> acc(PW, 0.f);
      for (int k = 0; k < 1024; ++k) { float a = bf2f(HB[tok * 1024 + k]); const float* w = &wr[(size_t)k * PW]; for (int n = 0; n < PW; ++n) acc[n] += a * w[n]; }
      for (int n = 0; n < PM; ++n) { float v = acc[n] + bias[n]; if (layer == 0) v = epi_ab(n, v, lb); P[tok * PSTRIDE + n] = f2bf(v); }
      for (int n = PM; n < PW; ++n) side[tok * 32 + (n - PM)] = acc[n] + bias[n];
      if (layer == 0) for (int dir = 0; dir < 2; ++dir) for (int cc = 0; cc < 256; ++cc) {
        float z = p.in[I_GK_B][dir * 256 + cc];
        for (int r = 0; r < 16; ++r) z += side[tok * 32 + dir * 16 + r] * p.in[I_GK_UP][(dir * 16 + r) * 256 + cc];
        LFB[tok * 512 + dir * 256 + cc] = f2bf(logsigmoidf_(z) * 0.0625f); }
    }
    if (layer == 0) { ScanAB2 s{}; s.P = P; s.LFB = LFB; s.O = O; run_functor(s, (long)BATCH * 2048); }
    else { PrepCD2 pc{}; pc.P = P; pc.QD = LFB; pc.rope = rope; pc.conv_w = p.in[I_CONV_W]; pc.conv_b = p.in[I_CONV_B]; run_functor(pc, (long)NTOK * 1280);
      ScanCD2 s{}; s.P = P; s.QD = LFB; s.side = side; s.fgate_b = p.in[I_FGATE_B]; s.O = O; s.oside = oside; run_functor(s, (long)BATCH * 2056); }
#pragma omp parallel for
    for (long tok = 0; tok < NTOK; ++tok) for (int h8 = 0; h8 < 8; ++h8) {
      float sf = 1.f, sb = 1.f;
      if (layer == 1 && h8 >= 4) { int h = h8 - 4; const float* s0 = oside + tok * 8 + h * 2; const float* s1 = oside + (size_t)(NTOK + tok) * 8 + h * 2;
        sf = 1.0f / fmaxf(fabsf(s0[0]), expf(-s0[1])); sb = 1.0f / fmaxf(fabsf(s1[0]), expf(-s1[1])); }
      float o[128]; float ss = 0.f;
      for (int j = 0; j < 128; ++j) { int c = h8 * 128 + j; o[j] = bf2f(O[tok * 1024 + c]) * sf + bf2f(O[(size_t)(NTOK + tok) * 1024 + c]) * sb; ss += o[j] * o[j]; }
      float r = 1.0f / sqrtf(ss * (1.0f / 128.0f) + NORM_EPS_F);
      for (int j = 0; j < 128; ++j) { int c = h8 * 128 + j; float gn, gt;
        if (layer == 0) { gn = h8 < 4 ? p.in[I_HGRN_NORM][c] : p.in[I_GLA_NORM][c - 512]; gt = siluf_(bf2f(P[tok * PSTRIDE + (h8 < 4 ? 2048 + c : 3584 + c - 512)])); }
        else { gn = h8 < 4 ? p.in[I_RET_NORM][c] : p.in[I_MLSTM_NORM][c - 512]; float gr = bf2f(P[tok * PSTRIDE + (h8 < 4 ? 1024 + c : 3072 + c - 512)]); gt = h8 < 4 ? siluf_(gr) : sigmoidf_(gr); }
        HB[tok * 1024 + c] = f2bf(o[j] * r * gn * gt); }
    }
    cpu_round_w(p.in[layer == 0 ? I_AB_W_OUT : I_CD_W_OUT], (size_t)1024 * 1024, wr);
#pragma omp parallel for
    for (long tok = 0; tok < NTOK; ++tok) { std::vector<float> acc(1024, 0.f);
      for (int k = 0; k < 1024; ++k) { float a = bf2f(HB[tok * 1024 + k]); const float* w = &wr[(size_t)k * 1024]; for (int n = 0; n < 1024; ++n) acc[n] += a * w[n]; }
      for (int n = 0; n < 1024; ++n) yf[tok * 1024 + n] = acc[n]; }
    dbg_cmp(layer == 0 ? "y_mix0" : "y_mix1", yf, (long)NTOK * 1024);
    int cnt[NEXP] = {0}; std::vector<int> list((size_t)NEXP * NTOK);
    const float* hin = layer == 0 ? p.in[I_X] : p.out;
    for (long tok = 0; tok < NTOK; ++tok) {
      float v[1024]; double s = 0; for (int c = 0; c < 1024; ++c) { v[c] = ALPHA_F * hin[tok * 1024 + c] + yf[tok * 1024 + c]; s += v[c]; }
      float mean = (float)(s / 1024); double q = 0; for (int c = 0; c < 1024; ++c) { v[c] -= mean; q += (double)v[c] * v[c]; }
      float r = 1.0f / sqrtf((float)(q / 1024) + LN_EPS_F);
      float lg[16] = {0};
      for (int c = 0; c < 1024; ++c) { v[c] = v[c] * r * p.in[I_LN_MIX_G][layer * 1024 + c] + p.in[I_LN_MIX_B][layer * 1024 + c]; p.out[tok * 1024 + c] = v[c]; HB[tok * 1024 + c] = f2bf(v[c]);
        for (int e = 0; e < 16; ++e) lg[e] += v[c] * p.in[I_ROUTER_W][c * 16 + e]; }
      int eo[2]; float go[2]; route_from_logits(lg, p.in[I_ROUTER_B], eo, go);
      int r1 = cnt[eo[0]]++, r2 = cnt[eo[1]]++;
      list[(size_t)eo[0] * NTOK + r1] = (int)tok; list[(size_t)eo[1] * NTOK + r2] = (int)tok;
      assign[tok * 4] = eo[0]; assign[tok * 4 + 1] = r1; assign[tok * 4 + 2] = eo[1]; assign[tok * 4 + 3] = r2; gate[tok * 2] = go[0]; gate[tok * 2 + 1] = go[1];
    }
    dbg_cmp(layer == 0 ? "h_mix0" : "h_mix1", p.out, (long)NTOK * 1024);
    int pad[NEXP]; { int a = 0; for (int e = 0; e < NEXP; ++e) { pad[e] = a; a += ((cnt[e] + 255) >> 8) << 8; } }
    const size_t lo = (size_t)layer * NEXP * 1024 * 1024;
    for (int e = 0; e < NEXP; ++e) {
      std::vector<float> w1, w3, w2; cpu_round_w(p.in[I_MOE_W1] + lo + (size_t)e * 1048576, 1048576, w1); cpu_round_w(p.in[I_MOE_W3] + lo + (size_t)e * 1048576, 1048576, w3); cpu_round_w(p.in[I_MOE_W2] + lo + (size_t)e * 1048576, 1048576, w2);
#pragma omp parallel for
      for (int rr = 0; rr < cnt[e]; ++rr) { int tok = list[(size_t)e * NTOK + rr]; size_t pos = pad[e] + rr;
        std::vector<float> a1(1024, 0.f), a3(1024, 0.f), a2(1024, 0.f);
        for (int k = 0; k < 1024; ++k) { float a = bf2f(HB[(size_t)tok * 1024 + k]); const float* p1 = &w1[(size_t)k * 1024]; const float* p3 = &w3[(size_t)k * 1024]; for (int n = 0; n < 1024; ++n) { a1[n] += a * p1[n]; a3[n] += a * p3[n]; } }
        for (int n = 0; n < 1024; ++n) H[pos * 1024 + n] = f2bf(siluf_(a1[n]) * a3[n]);
        for (int k = 0; k < 1024; ++k) { float a = bf2f(H[pos * 1024 + k]); const float* p2 = &w2[(size_t)k * 1024]; for (int n = 0; n < 1024; ++n) a2[n] += a * p2[n]; }
        for (int n = 0; n < 1024; ++n) Y[pos * 1024 + n] = f2bf(a2[n]); }
    }
    for (long tok = 0; tok < NTOK; ++tok) {
      size_t p0 = pad[assign[tok * 4]] + assign[tok * 4 + 1], p1 = pad[assign[tok * 4 + 2]] + assign[tok * 4 + 3];
      float v[1024]; double s = 0; for (int c = 0; c < 1024; ++c) { v[c] = ALPHA_F * p.out[tok * 1024 + c] + gate[tok * 2] * bf2f(Y[p0 * 1024 + c]) + gate[tok * 2 + 1] * bf2f(Y[p1 * 1024 + c]); s += v[c]; }
      float mean = (float)(s / 1024); double q = 0; for (int c = 0; c < 1024; ++c) { v[c] -= mean; q += (double)v[c] * v[c]; }
      float r = 1.0f / sqrtf((float)(q / 1024) + LN_EPS_F);
      for (int c = 0; c < 1024; ++c) { v[c] = v[c] * r * p.in[I_LN_FFN_G][layer * 1024 + c] + p.in[I_LN_FFN_B][layer * 1024 + c]; p.out[tok * 1024 + c] = v[c]; HB[tok * 1024 + c] = f2bf(v[c]); }
    }
    dbg_cmp(layer == 0 ? "h_ffn0" : "h_ffn1", p.out, (long)NTOK * 1024);
  }
}
#endif
```

```cpp
#ifdef CPU_EMU
#include <cmath>
#include <cstdio>
#include <cstring>
#include <cstdlib>
#include <cstddef>
#define DEV
#define DEV_INLINE static inline
typedef void* hipStream_t;
#else
#include <hip/hip_runtime.h>
#include <hip/hip_bf16.h>
#include <cstdio>
#define DEV __device__ __forceinline__
#define DEV_INLINE __device__ __forceinline__
#endif
#ifndef BATCH
#define BATCH 4
#endif
#ifndef SEQ
#define SEQ 8192
#endif
#define DM 1024
#define NTOK (BATCH * SEQ)
#define P_AB 4128
#define P_CD 3600
#define PM_AB 4096
#define PM_CD 3584
#define NEXP 16
#define ALPHA_F 1.4142135623730951f
#define LN_EPS_F 1e-5f
#define NORM_EPS_F 1e-6f
#define HROWS (2 * NTOK + NEXP * 256)

typedef unsigned short bf16_t;

DEV_INLINE float bf2f(bf16_t b) { unsigned u = ((unsigned)b) << 16; float f; memcpy(&f, &u, 4); return f; }
DEV_INLINE bf16_t f2bf(float f) { unsigned u; memcpy(&u, &f, 4); u += 0x7FFFu + ((u >> 16) & 1u); return (bf16_t)(u >> 16); }
DEV_INLINE float sigmoidf_(float x) { return 1.0f / (1.0f + expf(-x)); }
DEV_INLINE float siluf_(float x) { return x / (1.0f + expf(-x)); }
DEV_INLINE float logsigmoidf_(float x) { return fminf(x, 0.0f) - log1pf(expf(-fabsf(x))); }

#define AL256(x) (((size_t)(x) + 255) & ~(size_t)255)
#define WS_CTL    ((size_t)0)
#define WS_HB     ((size_t)65536)
#define WS_R1     (WS_HB + (size_t)NTOK * 1024 * 2)
#define R1_P_BYTES ((size_t)NTOK * 4096 * 2)
#define R1_MIN    (AL256((size_t)HROWS * 1024 * 2) + (size_t)NEXP * 3072 * 1024 * 2)
#define R1_PL     (R1_P_BYTES + (size_t)NTOK * 512 * 2)
#define R1_BYTES  (R1_PL > R1_MIN ? R1_PL : R1_MIN)
#define WS_LFB    (WS_R1 + R1_P_BYTES)
#define WS_H      (WS_R1)
#define WS_WMOE   (WS_R1 + AL256((size_t)HROWS * 1024 * 2))
#define WMOE_BYTES ((size_t)NEXP * 3072 * 1024 * 2)
#define WS_R2     (WS_R1 + R1_BYTES)
#define R2_BYTES  ((size_t)HROWS * 1024 * 2 > (size_t)NTOK * 1024 * 4 ? (size_t)HROWS * 1024 * 2 : (size_t)NTOK * 1024 * 4)
#define WS_SIDE   (WS_R2 + AL256(R2_BYTES))
#define WS_OSIDE  (WS_SIDE + (size_t)NTOK * 32 * 4)
#define WS_WIN_AB (WS_OSIDE + (size_t)2 * NTOK * 8 * 4)
#define WS_WIN_CD (WS_WIN_AB + (size_t)4128 * 1024 * 2)
#define WS_WOUT_AB (WS_WIN_CD + (size_t)3600 * 1024 * 2)
#define WS_WOUT_CD (WS_WOUT_AB + (size_t)1024 * 1024 * 2)
#define WS_ROPE   (WS_WOUT_CD + (size_t)1024 * 1024 * 2)
#define WS_LB     (WS_ROPE + (size_t)SEQ * 64 * 4)
#define WS_LIST   (WS_LB + 4096)
#define WS_ASSIGN (WS_LIST + (size_t)2 * NEXP * NTOK * 4)
#define WS_GATE   (WS_ASSIGN + (size_t)NTOK * 16)
#define WS_END    (WS_GATE + (size_t)NTOK * 8)
#define CW_CNT(layer) (64 + 64 * (layer))

#define PSTRIDE 4096

enum { I_X, I_AB_W_IN, I_AB_B_IN, I_HGRN_LB, I_GK_UP, I_GK_B, I_HGRN_NORM, I_GLA_NORM, I_AB_W_OUT,
       I_CD_W_IN, I_CD_B_IN, I_CONV_W, I_CONV_B, I_FGATE_B, I_RET_NORM, I_MLSTM_NORM, I_CD_W_OUT,
       I_LN_MIX_G, I_LN_MIX_B, I_LN_FFN_G, I_LN_FFN_B, I_ROUTER_W, I_ROUTER_B, I_MOE_W1, I_MOE_W3, I_MOE_W2, N_IN };

struct Params {
  const float* in[N_IN];
  float* out;
  unsigned char* ws;
};

DEV_INLINE float epi_ab(int col, float v, const float* lb) {
  if (col < 512) return siluf_(v);
  if (col < 1536) { float l = lb[(col - 512) & 511]; return logf(l + (1.0f - l) * sigmoidf_(v)); }
  if (col >= 2560 && col < 2816) return v * 0.125f;
  return v;
}

DEV_INLINE void route_from_logits(const float* lg, const float* rb, int* e_out, float* g_out) {
  float mx = lg[0];
#pragma unroll
  for (int e = 1; e < 16; ++e) mx = fmaxf(mx, lg[e]);
  float sc[16]; float sum = 0.f;
#pragma unroll
  for (int e = 0; e < 16; ++e) { sc[e] = expf(lg[e] - mx); sum += sc[e]; }
  float inv = 1.0f / sum;
  float best_gs = -1e30f; int be1 = 0, be2 = 1; float bs1 = 0.f, bs2 = 0.f;
#pragma unroll
  for (int gq = 0; gq < 4; ++gq) {
    float m1 = -1e30f, m2 = -1e30f, s1 = 0.f, s2 = 0.f; int i1 = 0, i2 = 0;
#pragma unroll
    for (int i = 0; i < 4; ++i) {
      float s = sc[gq * 4 + i] * inv; float v = s + rb[gq * 4 + i];
      if (v > m1) { m2 = m1; i2 = i1; s2 = s1; m1 = v; i1 = gq * 4 + i; s1 = s; }
      else if (v > m2) { m2 = v; i2 = gq * 4 + i; s2 = s; }
    }
    float gs = m1 + m2;
    if (gs > best_gs) { best_gs = gs; be1 = i1; be2 = i2; bs1 = s1; bs2 = s2; }
  }
  e_out[0] = be1; e_out[1] = be2; g_out[0] = bs1 / (bs1 + bs2); g_out[1] = bs2 / (bs1 + bs2);
}
struct ScanAB2 {
  const bf16_t* P; const bf16_t* LFB; bf16_t* O;
  DEV void operator()(long gid) const {
    int j = (int)(gid & 127), h = (int)((gid >> 7) & 3), dir = (int)((gid >> 9) & 1), mixer = (int)((gid >> 10) & 1), b = (int)(gid >> 11);
    bf16_t* Od = O + (size_t)dir * NTOK * 1024;
    if (mixer == 0) {
      float S[128];
#pragma unroll
      for (int d = 0; d < 128; ++d) S[d] = 0.f;
      for (int s = 0; s < SEQ; ++s) {
        size_t t = (size_t)b * SEQ + (dir ? (SEQ - 1 - s) : s);
        const bf16_t* row = P + t * PSTRIDE;
        const bf16_t* q = row + h * 128; const bf16_t* lf = row + 512 + dir * 512 + h * 128;
        float v = bf2f(row[1536 + h * 128 + j]);
        float o = 0.f;
#pragma unroll
        for (int d = 0; d < 128; ++d) { float fd = expf(bf2f(lf[d])); S[d] = fd * S[d] + (1.0f - fd) * v; o += bf2f(q[d]) * S[d]; }
        Od[t * 1024 + h * 128 + j] = f2bf(o);
      }
    } else {
      float S[64];
#pragma unroll
      for (int d = 0; d < 64; ++d) S[d] = 0.f;
      for (int s = 0; s < SEQ; ++s) {
        size_t t = (size_t)b * SEQ + (dir ? (SEQ - 1 - s) : s);
        const bf16_t* row = P + t * PSTRIDE;
        const bf16_t* q = row + 2560 + h * 64; const bf16_t* k = row + 2816 + h * 64;
        const bf16_t* lf = LFB + t * 512 + dir * 256 + h * 64;
        float v = bf2f(row[3072 + h * 128 + j]);
        float o = 0.f;
#pragma unroll
        for (int d = 0; d < 64; ++d) { S[d] = expf(bf2f(lf[d])) * S[d] + bf2f(k[d]) * v; o += bf2f(q[d]) * S[d]; }
        Od[t * 1024 + 512 + h * 128 + j] = f2bf(o);
      }
    }
  }
};

struct PrepCD2 {
  bf16_t* P; bf16_t* QD; const float* rope; const float* conv_w; const float* conv_b;
  DEV void operator()(long gid) const {
    size_t tok = (size_t)(gid / 1280); int c = (int)(gid % 1280); int t = (int)(tok % SEQ);
    bf16_t* row = P + tok * PSTRIDE;
    if (c < 256) {
      int isk = c >> 7, hh = (c >> 5) & 3, i = c & 31;
      float cs = rope[(t * 32 + i) * 2], sn = rope[(t * 32 + i) * 2 + 1];
      bf16_t* base = row + isk * 256 + hh * 64;
      float a1 = bf2f(base[i]), a2 = bf2f(base[i + 32]);
      float sc = isk ? 1.0f : 0.125f;
      base[i] = f2bf((a1 * cs - a2 * sn) * sc); base[i + 32] = f2bf((a1 * sn + a2 * cs) * sc);
    } else {
      int cc = c - 256;
      float acc = conv_b[cc] + bf2f(row[1536 + cc]) * conv_w[1024 + cc];
      if (t > 0) acc += bf2f(row[1536 + cc - PSTRIDE]) * conv_w[cc];
      if (t < SEQ - 1) acc += bf2f(row[1536 + cc + PSTRIDE]) * conv_w[2048 + cc];
      float s = siluf_(acc);
      if (cc < 512) QD[tok * 512 + cc] = f2bf(s * 0.08838834764831845f);
      else row[3584 + (cc - 512)] = f2bf(s);
    }
  }
};

struct ScanCD2 {
  const bf16_t* P; const bf16_t* QD; const float* side; const float* fgate_b; bf16_t* O; float* oside;
  DEV void operator()(long gid) const {
    int b = (int)(gid / 2056); int g = (int)(gid % 2056);
    if (g < 1024) {
      int j = g & 127, h = (g >> 7) & 3, dir = (g >> 9) & 1;
      bf16_t* Od = O + (size_t)dir * NTOK * 1024;
      float gamma = 1.0f - exp2f(-(5.0f + 2.0f * (float)h + (float)dir));
      float S[64];
#pragma unroll
      for (int d = 0; d < 64; ++d) S[d] = 0.f;
      for (int s = 0; s < SEQ; ++s) {
        size_t t = (size_t)b * SEQ + (dir ? (SEQ - 1 - s) : s);
        const bf16_t* row = P + t * PSTRIDE;
        const bf16_t* q = row + h * 64; const bf16_t* k = row + 256 + h * 64;
        float v = bf2f(row[512 + h * 128 + j]);
        float o = 0.f;
#pragma unroll
        for (int d = 0; d < 64; ++d) { S[d] = gamma * S[d] + bf2f(k[d]) * v; o += bf2f(q[d]) * S[d]; }
        Od[t * 1024 + h * 128 + j] = f2bf(o);
      }
    } else {
      g -= 1024;
      int j = g % 129, h = (g / 129) & 3, dir = g / (129 * 4);
      bf16_t* Od = O + (size_t)dir * NTOK * 1024; float* os = oside + (size_t)dir * NTOK * 8;
      float fb = fgate_b[dir * 4 + h];
      float S[128];
#pragma unroll
      for (int d = 0; d < 128; ++d) S[d] = 0.f;
      float m = 0.f;
      for (int s = 0; s < SEQ; ++s) {
        size_t t = (size_t)b * SEQ + (dir ? (SEQ - 1 - s) : s);
        const bf16_t* row = P + t * PSTRIDE;
        const bf16_t* q = QD + t * 512 + h * 128; const bf16_t* k = row + 3584 + h * 128;
        float v = (j < 128) ? bf2f(row[2560 + h * 128 + j]) : 1.0f;
        float li = side[t * 32 + dir * 8 + h];
        float lf = logsigmoidf_(side[t * 32 + dir * 8 + 4 + h] + fb);
        float mn = fmaxf(lf + m, li);
        float fs = expf(lf + m - mn), is = expf(li - mn) * v;
        m = mn;
        float o = 0.f;
#pragma unroll
        for (int d = 0; d < 128; ++d) { S[d] = fs * S[d] + is * bf2f(k[d]); o += bf2f(q[d]) * S[d]; }
        if (j < 128) Od[t * 1024 + 512 + h * 128 + j] = f2bf(o);
        else { os[t * 8 + h * 2] = o; os[t * 8 + h * 2 + 1] = m; }
      }
    }
  }
};
#ifndef CPU_EMU
namespace pg8 {
#define PG8_LAS __attribute__((address_space(3)))
typedef short bf16x8 __attribute__((ext_vector_type(8)));
typedef float f32x4 __attribute__((ext_vector_type(4)));
typedef unsigned u32x4 __attribute__((ext_vector_type(4)));
typedef unsigned u32x2 __attribute__((ext_vector_type(2)));
constexpr int BM = 256, BK = 64, HALF = 128, HTB = HALF * BK * 2, STAGE_BYTES = 8 * HTB, NXCD = 8, WGM = 8, GK = 1024;

__device__ __forceinline__ int lds_byte(int r, int c) { const int st = (r >> 4) * 2 + (c >> 5), rr = r & 15, cc = c & 31, ob = rr * 64 + cc * 2; return st * 1024 + (ob ^ (((ob >> 9) & 1) << 5)); }
__device__ __forceinline__ void stage_rc(int b, int& R, int& C) { const int st = b / 1024, sb = b % 1024, swz = sb ^ (((sb >> 9) & 1) << 5); R = (st >> 1) * 16 + swz / 64; C = (st & 1) * 32 + (swz % 64) / 2; }
__device__ __forceinline__ int perm32(int rho) { const int n = rho >> 4, i = rho & 15; return 8 * (i >> 2) + 4 * n + (i & 3); }
__device__ __forceinline__ unsigned cvt_pk_bf16(float lo, float hi) { unsigned r; asm volatile("v_cvt_pk_bf16_f32 %0, %1, %2" : "=v"(r) : "v"(lo), "v"(hi)); return r; }

struct Unit { int pm, pn, e, row0; };

struct StaticOrder {
  int nM, nN, nwg, G, c;
  __device__ void init(int M, int N, int G_, int c_) { nM = M / BM; nN = N / BM; nwg = nM * nN; G = G_; c = c_; }
  __device__ bool next(int i, Unit& u) const {
    const long L = (long)i * G + c; if (L >= nwg) return false;
    int wgid = (int)L; { const int q = nwg / NXCD, r = nwg % NXCD, xcd = wgid % NXCD, off = wgid / NXCD; wgid = (xcd < r ? xcd * (q + 1) : r * (q + 1) + (xcd - r) * q) + off; }
    const int nig = WGM * nN, gid = wgid / nig, fm = gid * WGM, gsz = (nM - fm) < WGM ? (nM - fm) : WGM;
    u.pm = fm + ((wgid % nig) % gsz); u.pn = (wgid % nig) / gsz; u.e = 0; u.row0 = u.pm * BM; return true;
  }
};

template <class Prob>
__device__ __forceinline__ void gemm_phase(PG8_LAS unsigned char* lds, const Prob& S, int wv) {
  int wv_ = wv; asm volatile("" : "+s"(wv_));
  int l_; asm volatile("v_mbcnt_lo_u32_b32 %0, -1, 0\n\tv_mbcnt_hi_u32_b32 %0, -1, %0" : "=v"(l_));
  int tid_ = wv_ * 64 + l_;
  const int tid = tid_, wid = __builtin_amdgcn_readfirstlane(tid >> 6), lane = tid & 63, wr = wid >> 2, wc = wid & 3, fr = lane & 15, fq = lane >> 4;
  constexpr int K = GK, nt = K / BK;
  int sR[2], sC[2]; unsigned voffB[2];
#pragma unroll
  for (int i = 0; i < 2; ++i) { int R, C; stage_rc(tid * 16 + i * 8192, R, C); sR[i] = R; sC[i] = C; const int Rb = Prob::PERM ? ((R & ~31) + perm32(R & 31)) : R; voffB[i] = (unsigned)(Rb * K + C) * 2u; }
  const size_t kstep = (size_t)(BK * 2);
  const size_t hstep = (size_t)HALF * K * 2;
  const unsigned ldsw = (unsigned)wid * 1024u;
  const int aoff = lds_byte(wr * 64 + fr, fq * 8), boff = lds_byte(wc * 32 + fr, fq * 8);
#define PG8_SA(b, h) (((b) * 2 + (h)) * HTB)
#define PG8_SB(b, h) ((4 + (b) * 2 + (h)) * HTB)
#define PG8_STAGE(bufoff, gbase, voff) do { _Pragma("unroll") for (int _i = 0; _i < 2; ++_i) \
    __builtin_amdgcn_global_load_lds((const unsigned*)((const char*)(gbase) + (voff)[_i]), (PG8_LAS unsigned*)(lds + (bufoff) + ldsw + _i * 8192), 16, 0, 0); } while (0)
#define PG8_LDA(dst, b, h) do { _Pragma("unroll") for (int m = 0; m < 4; ++m) _Pragma("unroll") for (int k = 0; k < 2; ++k) dst[m][k] = *(const PG8_LAS bf16x8*)(lds + PG8_SA(b, h) + aoff + m * 2048 + k * 1024); } while (0)
#define PG8_LDB(dst, b, h) do { _Pragma("unroll") for (int n = 0; n < 2; ++n) _Pragma("unroll") for (int k = 0; k < 2; ++k) dst[n][k] = *(const PG8_LAS bf16x8*)(lds + PG8_SB(b, h) + boff + n * 2048 + k * 1024); } while (0)
#define PG8_MMA(ai, bj, At, Bt) do { __builtin_amdgcn_s_setprio(1); _Pragma("unroll") for (int m = 0; m < 4; ++m) _Pragma("unroll") for (int n = 0; n < 2; ++n) _Pragma("unroll") for (int k = 0; k < 2; ++k) \
    acc[ai][bj][m][n] = __builtin_amdgcn_mfma_f32_16x16x32_bf16(Bt[n][k], At[m][k], acc[ai][bj][m][n], 0, 0, 0); __builtin_amdgcn_s_setprio(0); } while (0)
#define PG8_WAIT_V(n) asm volatile("s_waitcnt vmcnt(" #n ")" ::: "memory")
#define PG8_WAIT_L(n) asm volatile("s_waitcnt lgkmcnt(" #n ")" ::: "memory")
#define PG8_BAR __builtin_amdgcn_s_barrier()
#define PG8_SCHED __builtin_amdgcn_sched_barrier(0)
  Unit cur, nxt; int ui = 0;
  if (!S.next(0, cur)) return;
  f32x4 acc[2][2][4][2];
#pragma unroll
  for (int a = 0; a < 2; ++a)
#pragma unroll
    for (int b = 0; b < 2; ++b)
#pragma unroll
      for (int m = 0; m < 4; ++m)
#pragma unroll
        for (int n = 0; n < 2; ++n) acc[a][b][m][n] = (f32x4){0.f, 0.f, 0.f, 0.f};
  bf16x8 At[4][2], B0[2][2], B1[2][2];
  unsigned oc0[2], oc1[2], on0[2], on1[2];
#pragma unroll
  for (int i = 0; i < 2; ++i) { oc0[i] = S.a_off(cur, sR[i]) + (unsigned)sC[i] * 2u; oc1[i] = S.a_off(cur, HALF + sR[i]) + (unsigned)sC[i] * 2u; }
  const char* const Ab = S.a_base();
  const char* cB = S.b_base(cur);
  PG8_STAGE(PG8_SB(0, 0), cB, voffB); PG8_STAGE(PG8_SA(0, 0), Ab, oc0); PG8_STAGE(PG8_SB(0, 1), cB + hstep, voffB); PG8_STAGE(PG8_SA(0, 1), Ab, oc1);
  if (wr == 1) PG8_BAR;
  PG8_WAIT_V(4); PG8_BAR;
  PG8_STAGE(PG8_SB(1, 0), cB + kstep, voffB); PG8_STAGE(PG8_SA(1, 0), Ab + kstep, oc0); PG8_STAGE(PG8_SB(1, 1), cB + hstep + kstep, voffB);
  PG8_WAIT_V(6); PG8_BAR;
  for (;;) {
    const bool has_next = S.next(ui + 1, nxt);
    const char* nB = cB;
    if (has_next) {
      nB = S.b_base(nxt);
      int l2_; asm volatile("v_mbcnt_lo_u32_b32 %0, -1, 0\n\tv_mbcnt_hi_u32_b32 %0, -1, %0" : "=v"(l2_));
      const int tid2 = wid * 64 + l2_;
#pragma unroll
      for (int i = 0; i < 2; ++i) { int R, C; stage_rc(tid2 * 16 + i * 8192, R, C); on0[i] = S.a_off(nxt, R) + (unsigned)C * 2u; on1[i] = S.a_off(nxt, HALF + R) + (unsigned)C * 2u; }
    } else {
#pragma unroll
      for (int i = 0; i < 2; ++i) { on0[i] = oc0[i]; on1[i] = oc1[i]; }
    }
    for (int t = 0; t < nt; t += 2) {
      const bool last = (t == nt - 2);
      const char* a1 = Ab + (size_t)(t + 1) * kstep;
      const char* a2 = last ? Ab : Ab + (size_t)(t + 2) * kstep; const char* b2 = last ? nB : cB + (size_t)(t + 2) * kstep;
      const char* a3 = a2 + kstep; const char* b3 = b2 + kstep;
      unsigned o20[2], o21[2];
#pragma unroll
      for (int i = 0; i < 2; ++i) { o20[i] = last ? on0[i] : oc0[i]; o21[i] = last ? on1[i] : oc1[i]; }
      PG8_LDB(B0, 0, 0); PG8_SCHED; PG8_LDA(At, 0, 0); PG8_STAGE(PG8_SA(1, 1), a1, oc1);
      PG8_WAIT_L(8); PG8_BAR; PG8_WAIT_L(0); PG8_MMA(0, 0, At, B0); PG8_BAR; PG8_SCHED;
      PG8_LDB(B1, 0, 1); PG8_STAGE(PG8_SB(0, 0), b2, voffB);
      PG8_BAR; PG8_WAIT_L(0); PG8_MMA(0, 1, At, B1); PG8_BAR;
      PG8_LDA(At, 0, 1); PG8_STAGE(PG8_SA(0, 0), a2, o20);
      PG8_BAR; PG8_WAIT_L(0); PG8_MMA(1, 0, At, B0); PG8_BAR; PG8_SCHED;
      PG8_STAGE(PG8_SB(0, 1), b2 + hstep, voffB);
      PG8_WAIT_V(6); PG8_BAR; PG8_MMA(1, 1, At, B1); PG8_BAR;
      PG8_LDB(B0, 1, 0); PG8_SCHED; PG8_LDA(At, 1, 0); PG8_STAGE(PG8_SA(0, 1), a2, o21);
      PG8_WAIT_L(8); PG8_BAR; PG8_WAIT_L(0); PG8_MMA(0, 0, At, B0); PG8_BAR; PG8_SCHED;
      PG8_LDB(B1, 1, 1); PG8_STAGE(PG8_SB(1, 0), b3, voffB);
      PG8_BAR; PG8_WAIT_L(0); PG8_MMA(0, 1, At, B1); PG8_BAR;
      PG8_LDA(At, 1, 1); PG8_STAGE(PG8_SA(1, 0), a3, o20);
      PG8_BAR; PG8_WAIT_L(0); PG8_MMA(1, 0, At, B0); PG8_BAR; PG8_SCHED;
      PG8_STAGE(PG8_SB(1, 1), b3 + hstep, voffB);
      PG8_WAIT_V(6); PG8_BAR; PG8_MMA(1, 1, At, B1); PG8_BAR;
    }
    { int l3_; asm volatile("v_mbcnt_lo_u32_b32 %0, -1, 0\n\tv_mbcnt_hi_u32_b32 %0, -1, %0" : "=v"(l3_));
      S.epi(acc, cur, wr, wc, l3_ & 15, l3_ >> 4); }
    if (!has_next) break;
#pragma unroll
    for (int a = 0; a < 2; ++a)
#pragma unroll
      for (int b = 0; b < 2; ++b)
#pragma unroll
        for (int m = 0; m < 4; ++m)
#pragma unroll
          for (int n = 0; n < 2; ++n) acc[a][b][m][n] = (f32x4){0.f, 0.f, 0.f, 0.f};
    cur = nxt; cB = nB; ++ui;
#pragma unroll
    for (int i = 0; i < 2; ++i) { oc0[i] = on0[i]; oc1[i] = on1[i]; }
  }
  PG8_WAIT_V(0);
  if (wr == 0) PG8_BAR;
  PG8_BAR;
#undef PG8_SA
#undef PG8_SB
#undef PG8_STAGE
#undef PG8_LDA
#undef PG8_LDB
#undef PG8_MMA
#undef PG8_WAIT_V
#undef PG8_WAIT_L
#undef PG8_BAR
#undef PG8_SCHED
}
}
#endif
#ifndef CPU_EMU
#include <hip/hip_cooperative_groups.h>
namespace cg = cooperative_groups;
#define LAS __attribute__((address_space(3)))
#define NTHREADS 512
#define LDS_BYTES (128 * 1024 + 2048)
typedef float f32x4 __attribute__((ext_vector_type(4)));
typedef short bf16x8 __attribute__((ext_vector_type(8)));
typedef unsigned u32x4 __attribute__((ext_vector_type(4)));
typedef unsigned u32x2 __attribute__((ext_vector_type(2)));

struct Ctx { int tid, lane, wid, G, bid; unsigned char* lds; };
__device__ __forceinline__ int lane_id() { int l; asm volatile("v_mbcnt_lo_u32_b32 %0, -1, 0\n\tv_mbcnt_hi_u32_b32 %0, -1, %0" : "=v"(l)); return l; }
__device__ __forceinline__ int opaque_tid(int wv) { int w = wv; asm volatile("" : "+s"(w)); int t = w * 64 + lane_id(); asm volatile("" : "+v"(t)); return t; }
__device__ __forceinline__ Ctx make_ctx(unsigned char* lds, int wv) { Ctx c; c.tid = opaque_tid(wv); c.lane = c.tid & 63; c.wid = __builtin_amdgcn_readfirstlane(c.tid >> 6); c.G = gridDim.x; c.bid = blockIdx.x; c.lds = lds; return c; }

__device__ __forceinline__ float wave_sum(float v) {
#pragma unroll
  for (int o = 32; o > 0; o >>= 1) v += __shfl_xor(v, o);
  return v;
}
__device__ __forceinline__ unsigned pk2(float a, float b) { return (unsigned)f2bf(a) | ((unsigned)f2bf(b) << 16); }
__device__ __forceinline__ void unpack8(u32x4 w, float* f) {
  f[0] = __uint_as_float(w.x << 16); f[1] = __uint_as_float(w.x & 0xffff0000u); f[2] = __uint_as_float(w.y << 16); f[3] = __uint_as_float(w.y & 0xffff0000u);
  f[4] = __uint_as_float(w.z << 16); f[5] = __uint_as_float(w.z & 0xffff0000u); f[6] = __uint_as_float(w.w << 16); f[7] = __uint_as_float(w.w & 0xffff0000u);
}

__device__ __forceinline__ void transpose_job(const Ctx& c, const float* src, int N, bf16_t* dst, int rs, int ro, int tile0, int tile_stride) {
  float* t = (float*)c.lds;
  const int ntn = (N + 63) / 64, ntiles = ntn * 16;
  for (int tl = tile0; tl < ntiles; tl += tile_stride) {
    const int kt = tl / ntn, nt_ = tl % ntn, k0 = kt * 64, n0 = nt_ * 64;
    __syncthreads();
#pragma unroll
    for (int i = 0; i < 8; ++i) { const int idx = c.tid + i * 512, kk = idx >> 6, nn = idx & 63; t[kk * 65 + nn] = (n0 + nn < N) ? src[(size_t)(k0 + kk) * N + n0 + nn] : 0.f; }
    __syncthreads();
#pragma unroll
    for (int i = 0; i < 4; ++i) { const int idx = c.tid + i * 512, nn = idx >> 5, kp = (idx & 31) * 2;
      if (n0 + nn < N) *(unsigned*)(dst + (size_t)((n0 + nn) * rs + ro) * 1024 + k0 + kp) = pk2(t[kp * 65 + nn], t[(kp + 1) * 65 + nn]); }
  }
  __syncthreads();
}
__device__ __forceinline__ void p0_prologue(unsigned char* lds_, int wv, const Params& p) {
  const Ctx c = make_ctx(lds_, wv);
  unsigned char* ws = p.ws;
  if (c.bid == 0 && c.tid < 128) ((unsigned*)(ws + WS_CTL))[64 + c.tid] = 0u;
  if (c.bid == 0 && c.tid == 0) ((unsigned*)(ws + WS_CTL))[1024] = 0u;
  { const float* x = p.in[I_X]; bf16_t* hb = (bf16_t*)(ws + WS_HB);
    for (size_t i = (size_t)c.bid * NTHREADS + c.tid; i < (size_t)NTOK * 1024 / 8; i += (size_t)c.G * NTHREADS) {
      const f32x4 a = *(const f32x4*)(x + i * 8), b = *(const f32x4*)(x + i * 8 + 4);
      u32x4 w; w.x = pk2(a[0], a[1]); w.y = pk2(a[2], a[3]); w.z = pk2(b[0], b[1]); w.w = pk2(b[2], b[3]);
      *(u32x4*)(hb + i * 8) = w; } }
  transpose_job(c, p.in[I_AB_W_IN], P_AB, (bf16_t*)(ws + WS_WIN_AB), 1, 0, c.bid, c.G);
  transpose_job(c, p.in[I_CD_W_IN], P_CD, (bf16_t*)(ws + WS_WIN_CD), 1, 0, c.bid, c.G);
  transpose_job(c, p.in[I_AB_W_OUT], 1024, (bf16_t*)(ws + WS_WOUT_AB), 1, 0, c.bid, c.G);
  transpose_job(c, p.in[I_CD_W_OUT], 1024, (bf16_t*)(ws + WS_WOUT_CD), 1, 0, c.bid, c.G);
  { float* rope = (float*)(ws + WS_ROPE);
    for (int i = c.bid * NTHREADS + c.tid; i < SEQ * 32; i += c.G * NTHREADS) { const int t = i >> 5, f = i & 31;
      const float freq = powf(10000.0f, -(float)f / 32.0f); const float ang = (float)t * freq; rope[i * 2] = cosf(ang); rope[i * 2 + 1] = sinf(ang); }
    if (c.bid == 1) { const float* hl = p.in[I_HGRN_LB]; float* lb = (float*)(ws + WS_LB);
      const int cc = c.tid; const float a0 = hl[cc], a1 = hl[512 + cc], a2 = hl[1024 + cc]; const float mx = fmaxf(a0, fmaxf(a1, a2));
      const float e0 = expf(a0 - mx), e1 = expf(a1 - mx), e2 = expf(a2 - mx); lb[cc] = e0 / (e0 + e1 + e2); } }
}
__device__ __forceinline__ void moe_weight_convert(unsigned char* lds_, int wv, const Params& p, int layer) {
  const Ctx c = make_ctx(lds_, wv);
  bf16_t* w13 = (bf16_t*)(p.ws + WS_WMOE); bf16_t* w2 = w13 + (size_t)NEXP * 2048 * 1024;
  const size_t lo = (size_t)layer * NEXP * 1024 * 1024;
  for (int e = 0; e < NEXP; ++e) {
    const size_t mo = lo + (size_t)e * 1024 * 1024;
    transpose_job(c, p.in[I_MOE_W1] + mo, 1024, w13 + (size_t)e * 2048 * 1024, 2, 0, c.bid, c.G);
    transpose_job(c, p.in[I_MOE_W3] + mo, 1024, w13 + (size_t)e * 2048 * 1024, 2, 1, c.bid, c.G);
    transpose_job(c, p.in[I_MOE_W2] + mo, 1024, w2 + (size_t)e * 1024 * 1024, 1, 0, c.bid, c.G);
  }
}

struct ProbInProj {
  static constexpr bool PERM = true;
  pg8::StaticOrder so; const char* A; const char* Bt; bf16_t* P; const float* bias; const float* lb; int layer;
  __device__ __forceinline__ bool next(int i, pg8::Unit& u) const { return so.next(i, u); }
  __device__ __forceinline__ const char* a_base() const { return A; }
  __device__ __forceinline__ unsigned a_off(const pg8::Unit& u, int r) const { return (unsigned)(u.pm * 256 + r) * 2048u; }
  __device__ __forceinline__ const char* b_base(const pg8::Unit& u) const { return Bt + (size_t)u.pn * 256 * 2048; }
  __device__ __forceinline__ void epi(const f32x4 (&acc)[2][2][4][2], const pg8::Unit& u, int wr, int wc, int fr, int fq) const {
    const int row0 = u.row0 + wr * 64 + fr, colb = u.pn * 256 + wc * 32 + 8 * fq;
    int mode = 0;
    if (layer == 0) { mode = u.pn < 2 ? 1 : (u.pn < 6 ? 2 : (u.pn == 10 ? 3 : 0)); }
#pragma unroll
    for (int bj = 0; bj < 2; ++bj) {
      const int col0 = colb + bj * 128;
      const f32x4 b0 = *(const f32x4*)(bias + col0), b1 = *(const f32x4*)(bias + col0 + 4);
      f32x4 l0 = (f32x4){0.f, 0.f, 0.f, 0.f}, l1 = l0;
      if (mode == 2) { l0 = *(const f32x4*)(lb + ((col0 - 512) & 511)); l1 = *(const f32x4*)(lb + ((col0 - 512) & 511) + 4); }
#pragma unroll
      for (int ai = 0; ai < 2; ++ai)
#pragma unroll
        for (int m = 0; m < 4; ++m) {
          f32x4 v0 = acc[ai][bj][m][0] + b0, v1 = acc[ai][bj][m][1] + b1;
          if (mode == 1) {
#pragma unroll
            for (int j = 0; j < 4; ++j) { v0[j] = siluf_(v0[j]); v1[j] = siluf_(v1[j]); }
          } else if (mode == 2) {
#pragma unroll
            for (int j = 0; j < 4; ++j) { v0[j] = logf(l0[j] + (1.0f - l0[j]) * sigmoidf_(v0[j])); v1[j] = logf(l1[j] + (1.0f - l1[j]) * sigmoidf_(v1[j])); }
          } else if (mode == 3) { v0 *= 0.125f; v1 *= 0.125f; }
          u32x4 w; w.x = pk2(v0[0], v0[1]); w.y = pk2(v0[2], v0[3]); w.z = pk2(v1[0], v1[1]); w.w = pk2(v1[2], v1[3]);
          *(u32x4*)(P + (size_t)(row0 + ai * 128 + m * 16) * PSTRIDE + col0) = w;
        }
    }
  }
};
struct ProbOutProj {
  static constexpr bool PERM = false;
  pg8::StaticOrder so; const char* A; const char* Bt; float* Y;
  __device__ __forceinline__ bool next(int i, pg8::Unit& u) const { return so.next(i, u); }
  __device__ __forceinline__ const char* a_base() const { return A; }
  __device__ __forceinline__ unsigned a_off(const pg8::Unit& u, int r) const { return (unsigned)(u.pm * 256 + r) * 2048u; }
  __device__ __forceinline__ const char* b_base(const pg8::Unit& u) const { return Bt + (size_t)u.pn * 256 * 2048; }
  __device__ __forceinline__ void epi(const f32x4 (&acc)[2][2][4][2], const pg8::Unit& u, int wr, int wc, int fr, int fq) const {
    const int row0 = u.row0 + wr * 64 + fr, col0 = u.pn * 256 + wc * 32 + 4 * fq;
#pragma unroll
    for (int ai = 0; ai < 2; ++ai)
#pragma unroll
      for (int m = 0; m < 4; ++m) { float* rowp = Y + (size_t)(row0 + ai * 128 + m * 16) * 1024 + col0;
#pragma unroll
        for (int bj = 0; bj < 2; ++bj)
#pragma unroll
          for (int n = 0; n < 2; ++n) *(f32x4*)(rowp + bj * 128 + n * 16) = acc[ai][bj][m][n]; }
  }
};
struct MoeOrder {
  const int* cnt; int ntn, G, c;
  __device__ __forceinline__ bool next(int i, pg8::Unit& u) const {
    int L = i * G + c; int pad = 0;
    for (int e = 0; e < NEXP; ++e) { const int n = cnt[e], mt = (n + 255) >> 8, tiles = mt * ntn;
      if (L < tiles) { u.e = e; u.pn = L / mt; u.pm = L % mt; u.row0 = pad + u.pm * 256; return true; }
      L -= tiles; pad += mt * 256; }
    return false;
  }
};
struct ProbMoe1 {
  static constexpr bool PERM = true;
  MoeOrder mo; const char* A; const char* W13; const int* list; bf16_t* H;
  __device__ __forceinline__ bool next(int i, pg8::Unit& u) const { return mo.next(i, u); }
  __device__ __forceinline__ const char* a_base() const { return A; }
  __device__ __forceinline__ unsigned a_off(const pg8::Unit& u, int r) const { const int rr = u.pm * 256 + r; const int tok = rr < mo.cnt[u.e] ? list[u.e * NTOK + rr] : 0; return (unsigned)tok * 2048u; }
  __device__ __forceinline__ const char* b_base(const pg8::Unit& u) const { return W13 + ((size_t)u.e * 2048 + (size_t)u.pn * 256) * 2048; }
  __device__ __forceinline__ void epi(const f32x4 (&acc)[2][2][4][2], const pg8::Unit& u, int wr, int wc, int fr, int fq) const {
    const int row0 = u.row0 + wr * 64 + fr, colb = u.pn * 128 + wc * 16 + 4 * fq;
#pragma unroll
    for (int ai = 0; ai < 2; ++ai)
#pragma unroll
      for (int m = 0; m < 4; ++m)
#pragma unroll
        for (int bj = 0; bj < 2; ++bj) {
          const f32x4 v0 = acc[ai][bj][m][0], v1 = acc[ai][bj][m][1];
          u32x2 w; w.x = pk2(siluf_(v0[0]) * v0[1], siluf_(v0[2]) * v0[3]); w.y = pk2(siluf_(v1[0]) * v1[1], siluf_(v1[2]) * v1[3]);
          *(u32x2*)(H + (size_t)(row0 + ai * 128 + m * 16) * 1024 + colb + bj * 64) = w;
        }
  }
};
struct ProbMoe2 {
  static constexpr bool PERM = true;
  MoeOrder mo; const char* A; const char* W2; bf16_t* Y;
  __device__ __forceinline__ bool next(int i, pg8::Unit& u) const { return mo.next(i, u); }
  __device__ __forceinline__ const char* a_base() const { return A; }
  __device__ __forceinline__ unsigned a_off(const pg8::Unit& u, int r) const { return (unsigned)(u.row0 + r) * 2048u; }
  __device__ __forceinline__ const char* b_base(const pg8::Unit& u) const { return W2 + ((size_t)u.e * 1024 + (size_t)u.pn * 256) * 2048; }
  __device__ __forceinline__ void epi(const f32x4 (&acc)[2][2][4][2], const pg8::Unit& u, int wr, int wc, int fr, int fq) const {
    const int row0 = u.row0 + wr * 64 + fr, colb = u.pn * 256 + wc * 32 + 8 * fq;
#pragma unroll
    for (int ai = 0; ai < 2; ++ai)
#pragma unroll
      for (int m = 0; m < 4; ++m)
#pragma unroll
        for (int bj = 0; bj < 2; ++bj) {
          const f32x4 v0 = acc[ai][bj][m][0], v1 = acc[ai][bj][m][1];
          u32x4 w; w.x = pk2(v0[0], v0[1]); w.y = pk2(v0[2], v0[3]); w.z = pk2(v1[0], v1[1]); w.w = pk2(v1[2], v1[3]);
          *(u32x4*)(Y + (size_t)(row0 + ai * 128 + m * 16) * 1024 + colb + bj * 128) = w;
        }
  }
};

template <int NS>
__device__ __forceinline__ void side_phase(unsigned char* lds_, int wv, const Params& p, int layer) {
  const Ctx c = make_ctx(lds_, wv);
  const bf16_t* hb = (const bf16_t*)(p.ws + WS_HB);
  const bf16_t* wt = (const bf16_t*)(p.ws + (layer == 0 ? WS_WIN_AB : WS_WIN_CD)) + (size_t)(layer == 0 ? PM_AB : PM_CD) * 1024;
  const float* bias = p.in[layer == 0 ? I_AB_B_IN : I_CD_B_IN] + (layer == 0 ? PM_AB : PM_CD);
  float* side = (float*)(p.ws + WS_SIDE);
  float* tl = (float*)c.lds + c.wid * (16 * 33);
  const int fr = c.lane & 15, fq = c.lane >> 4;
  for (int g = c.bid * 8 + c.wid; g < NTOK / 16; g += c.G * 8) {
    const int r0 = g * 16;
    f32x4 acc0 = (f32x4){0.f, 0.f, 0.f, 0.f}, acc1 = acc0;
    const bf16_t* ap = hb + (size_t)(r0 + fr) * 1024 + fq * 8;
    const bf16_t* bp0 = wt + (size_t)fr * 1024 + fq * 8; const bf16_t* bp1 = bp0 + 16 * 1024;
#pragma unroll 4
    for (int k = 0; k < 1024; k += 32) {
      const bf16x8 a = *(const bf16x8*)(ap + k), b0 = *(const bf16x8*)(bp0 + k);
      acc0 = __builtin_amdgcn_mfma_f32_16x16x32_bf16(a, b0, acc0, 0, 0, 0);
      if (NS == 32) { const bf16x8 b1 = *(const bf16x8*)(bp1 + k); acc1 = __builtin_amdgcn_mfma_f32_16x16x32_bf16(a, b1, acc1, 0, 0, 0); }
    }
#pragma unroll
    for (int j = 0; j < 4; ++j) { const float v0 = acc0[j] + bias[fr]; side[(size_t)(r0 + fq * 4 + j) * 32 + fr] = v0; tl[(fq * 4 + j) * 33 + fr] = v0;
      if (NS == 32) { const float v1 = acc1[j] + bias[16 + fr]; side[(size_t)(r0 + fq * 4 + j) * 32 + 16 + fr] = v1; tl[(fq * 4 + j) * 33 + 16 + fr] = v1; } }
    if (NS == 32) {
      __builtin_amdgcn_s_waitcnt(0xC07F);
      const float* gu = p.in[I_GK_UP]; const float* gb = p.in[I_GK_B]; bf16_t* lfb = (bf16_t*)(p.ws + WS_LFB);
      const int cb = c.lane * 8, dir = cb >> 8, cc = cb & 255;
      float w[16][8];
#pragma unroll
      for (int r = 0; r < 16; ++r)
#pragma unroll
        for (int j = 0; j < 8; ++j) w[r][j] = gu[(dir * 16 + r) * 256 + cc + j];
      float bb[8];
#pragma unroll
      for (int j = 0; j < 8; ++j) bb[j] = gb[dir * 256 + cc + j];
      for (int row = 0; row < 16; ++row) {
        float z[8];
#pragma unroll
        for (int j = 0; j < 8; ++j) z[j] = bb[j];
#pragma unroll
        for (int r = 0; r < 16; ++r) { const float s = tl[row * 33 + dir * 16 + r];
#pragma unroll
          for (int j = 0; j < 8; ++j) z[j] += s * w[r][j]; }
        u32x4 o; o.x = pk2(logsigmoidf_(z[0]) * 0.0625f, logsigmoidf_(z[1]) * 0.0625f); o.y = pk2(logsigmoidf_(z[2]) * 0.0625f, logsigmoidf_(z[3]) * 0.0625f);
        o.z = pk2(logsigmoidf_(z[4]) * 0.0625f, logsigmoidf_(z[5]) * 0.0625f); o.w = pk2(logsigmoidf_(z[6]) * 0.0625f, logsigmoidf_(z[7]) * 0.0625f);
        *(u32x4*)(lfb + (size_t)(r0 + row) * 512 + cb) = o;
      }
    }
  }
}

__device__ __forceinline__ void headnorm_phase(unsigned char* lds_, int wv, const Params& p, int layer) {
  const Ctx c = make_ctx(lds_, wv);
  const bf16_t* P = (const bf16_t*)(p.ws + WS_R1); const bf16_t* O = (const bf16_t*)(p.ws + WS_R2);
  bf16_t* mixed = (bf16_t*)(p.ws + WS_HB);
  const int c0 = c.lane * 16, h8 = c.lane >> 3;
  const float* gain = layer == 0 ? (h8 < 4 ? p.in[I_HGRN_NORM] + c0 : p.in[I_GLA_NORM] + c0 - 512) : (h8 < 4 ? p.in[I_RET_NORM] + c0 : p.in[I_MLSTM_NORM] + c0 - 512);
  const int gcol = layer == 0 ? (h8 < 4 ? 2048 + c0 : 3584 + c0 - 512) : (h8 < 4 ? 1024 + c0 : 3072 + c0 - 512);
  float gn[16];
#pragma unroll
  for (int j = 0; j < 16; ++j) gn[j] = gain[j];
  for (int tok = c.bid * 8 + c.wid; tok < NTOK; tok += c.G * 8) {
    float of[16], ob[16], gt[16];
    { const u32x4* a = (const u32x4*)(O + (size_t)tok * 1024 + c0); unpack8(a[0], of); unpack8(a[1], of + 8);
      const u32x4* b = (const u32x4*)(O + (size_t)(NTOK + tok) * 1024 + c0); unpack8(b[0], ob); unpack8(b[1], ob + 8);
      const u32x4* g = (const u32x4*)(P + (size_t)tok * PSTRIDE + gcol); unpack8(g[0], gt); unpack8(g[1], gt + 8); }
    const float sf = 1.f, sb = 1.f;
    float o[16]; float ss = 0.f;
#pragma unroll
    for (int j = 0; j < 16; ++j) { o[j] = of[j] * sf + ob[j] * sb; ss += o[j] * o[j]; }
    ss += __shfl_xor(ss, 1); ss += __shfl_xor(ss, 2); ss += __shfl_xor(ss, 4);
    const float r = 1.0f / sqrtf(ss * (1.0f / 128.0f) + NORM_EPS_F);
    unsigned w[8];
#pragma unroll
    for (int j = 0; j < 8; ++j) {
      float g0 = gt[2 * j], g1 = gt[2 * j + 1];
      if (layer == 1 && h8 >= 4) { g0 = sigmoidf_(g0); g1 = sigmoidf_(g1); } else { g0 = siluf_(g0); g1 = siluf_(g1); }
      w[j] = pk2(o[2 * j] * r * gn[2 * j] * g0, o[2 * j + 1] * r * gn[2 * j + 1] * g1);
    }
    u32x4* d = (u32x4*)(mixed + (size_t)tok * 1024 + c0);
    d[0] = (u32x4){w[0], w[1], w[2], w[3]}; d[1] = (u32x4){w[4], w[5], w[6], w[7]};
  }
}

__device__ __forceinline__ void ln_phase(unsigned char* lds_, int wv, const Params& p, int layer, int mode) {
  const Ctx c = make_ctx(lds_, wv);
  unsigned char* ws = p.ws;
  const float* hin = (mode == 0 && layer == 0) ? p.in[I_X] : p.out;
  float* hout = p.out; bf16_t* hb = (bf16_t*)(ws + WS_HB);
  const float* g = p.in[mode == 0 ? I_LN_MIX_G : I_LN_FFN_G] + layer * 1024; const float* b = p.in[mode == 0 ? I_LN_MIX_B : I_LN_FFN_B] + layer * 1024;
  unsigned* cnt = (unsigned*)(ws + WS_CTL) + CW_CNT(layer);
  int* list = (int*)(ws + WS_LIST) + (size_t)layer * NEXP * NTOK;
  int* assign = (int*)(ws + WS_ASSIGN); float* gate = (float*)(ws + WS_GATE);
  float* rw = (float*)c.lds;
  int pad[NEXP];
  if (mode == 0) { const float* r = p.in[I_ROUTER_W]; for (int i = c.tid; i < 1024 * 16 / 4; i += NTHREADS) ((f32x4*)rw)[i] = ((const f32x4*)r)[i]; __syncthreads(); }
  else { int acc = 0;
#pragma unroll
    for (int e = 0; e < NEXP; ++e) { pad[e] = acc; acc += (((int)cnt[e] + 255) >> 8) << 8; } }
  const int c0 = c.lane * 16;
  float gv[16], bv[16];
#pragma unroll
  for (int j = 0; j < 16; ++j) { gv[j] = g[c0 + j]; bv[j] = b[c0 + j]; }
  for (int tok = c.bid * 8 + c.wid; tok < NTOK; tok += c.G * 8) {
    float v[16];
    { const f32x4* hp = (const f32x4*)(hin + (size_t)tok * 1024 + c0);
#pragma unroll
      for (int q = 0; q < 4; ++q) { const f32x4 t = hp[q]; v[4 * q] = ALPHA_F * t[0]; v[4 * q + 1] = ALPHA_F * t[1]; v[4 * q + 2] = ALPHA_F * t[2]; v[4 * q + 3] = ALPHA_F * t[3]; } }
    if (mode == 0) { const f32x4* yp = (const f32x4*)((const float*)(ws + WS_R2) + (size_t)tok * 1024 + c0);
#pragma unroll
      for (int q = 0; q < 4; ++q) { const f32x4 t = yp[q]; v[4 * q] += t[0]; v[4 * q + 1] += t[1]; v[4 * q + 2] += t[2]; v[4 * q + 3] += t[3]; }
    } else {
      const int a0 = assign[tok * 4], a1 = assign[tok * 4 + 1], a2 = assign[tok * 4 + 2], a3 = assign[tok * 4 + 3];
      const float g0 = gate[tok * 2], g1 = gate[tok * 2 + 1];
      int p0 = 0, p1 = 0;
#pragma unroll
      for (int e = 0; e < NEXP; ++e) { if (e == a0) p0 = pad[e]; if (e == a2) p1 = pad[e]; }
      p0 += a1; p1 += a3;
      const bf16_t* Y = (const bf16_t*)(ws + WS_R2);
      float y0[16], y1[16];
      { const u32x4* q0 = (const u32x4*)(Y + (size_t)p0 * 1024 + c0); unpack8(q0[0], y0); unpack8(q0[1], y0 + 8);
        const u32x4* q1 = (const u32x4*)(Y + (size_t)p1 * 1024 + c0); unpack8(q1[0], y1); unpack8(q1[1], y1 + 8); }
#pragma unroll
      for (int j = 0; j < 16; ++j) v[j] += g0 * y0[j] + g1 * y1[j];
    }
    float s = 0.f;
#pragma unroll
    for (int j = 0; j < 16; ++j) s += v[j];
    const float mean = wave_sum(s) * (1.0f / 1024.0f);
    float q = 0.f;
#pragma unroll
    for (int j = 0; j < 16; ++j) { v[j] -= mean; q += v[j] * v[j]; }
    const float r = 1.0f / sqrtf(wave_sum(q) * (1.0f / 1024.0f) + LN_EPS_F);
#pragma unroll
    for (int j = 0; j < 16; ++j) v[j] = v[j] * r * gv[j] + bv[j];
    { f32x4* op = (f32x4*)(hout + (size_t)tok * 1024 + c0);
#pragma unroll
      for (int q4 = 0; q4 < 4; ++q4) op[q4] = (f32x4){v[4 * q4], v[4 * q4 + 1], v[4 * q4 + 2], v[4 * q4 + 3]}; }
    if (!(mode == 1 && layer == 1)) { u32x4* d = (u32x4*)(hb + (size_t)tok * 1024 + c0);
      d[0] = (u32x4){pk2(v[0], v[1]), pk2(v[2], v[3]), pk2(v[4], v[5]), pk2(v[6], v[7])}; d[1] = (u32x4){pk2(v[8], v[9]), pk2(v[10], v[11]), pk2(v[12], v[13]), pk2(v[14], v[15])}; }
    if (mode == 0) {
      float lg[16];
#pragma unroll
      for (int e = 0; e < 16; ++e) lg[e] = 0.f;
#pragma unroll
      for (int j = 0; j < 16; ++j) { const f32x4* wp = (const f32x4*)(rw + (c0 + j) * 16);
#pragma unroll
        for (int q4 = 0; q4 < 4; ++q4) { const f32x4 w = wp[q4]; lg[4 * q4] += v[j] * w[0]; lg[4 * q4 + 1] += v[j] * w[1]; lg[4 * q4 + 2] += v[j] * w[2]; lg[4 * q4 + 3] += v[j] * w[3]; }
        if (j & 1) asm volatile("" ::: "memory"); }
#pragma unroll
      for (int e = 0; e < 16; ++e) lg[e] = wave_sum(lg[e]);
      int eo[2]; float go[2];
      route_from_logits(lg, p.in[I_ROUTER_B], eo, go);
      if (c.lane == 0) {
        const int r1 = (int)atomicAdd(cnt + eo[0], 1u), r2 = (int)atomicAdd(cnt + eo[1], 1u);
        list[eo[0] * NTOK + r1] = tok; list[eo[1] * NTOK + r2] = tok;
        assign[tok * 4] = eo[0]; assign[tok * 4 + 1] = r1; assign[tok * 4 + 2] = eo[1]; assign[tok * 4 + 3] = r2;
        gate[tok * 2] = go[0]; gate[tok * 2 + 1] = go[1];
      }
    }
  }
  __syncthreads();
}
#endif
#ifndef CPU_EMU
namespace scan {
typedef short bf16x8 __attribute__((ext_vector_type(8)));
typedef float f32x4 __attribute__((ext_vector_type(4)));
typedef unsigned u32x4 __attribute__((ext_vector_type(4)));
typedef unsigned u32x2 __attribute__((ext_vector_type(2)));
enum { MIX_A = 0, MIX_B = 1, MIX_C = 2, MIX_D = 3 };
constexpr int LD_T = 144;
constexpr int OFF_QS = 0, OFF_KS = 17408, OFF_QI = 34816, OFF_KT = 52224, OFF_VT = 70656, OFF_SC = 77568, OFF_ST = 86784, OFF_DEC = 99840, OFF_EM = 100352, OFF_DEN = 100608, SCAN_LDS = 100864;

__device__ __forceinline__ float incl_scan_add(float x, int lane) {
#pragma unroll
  for (int o = 1; o < 64; o <<= 1) { const float t = __shfl_up(x, o); if (lane >= o) x += t; }
  return x;
}
__device__ __forceinline__ float incl_scan_max(float x, int lane) {
#pragma unroll
  for (int o = 1; o < 64; o <<= 1) { const float t = __shfl_up(x, o); if (lane >= o) x = fmaxf(x, t); }
  return x;
}
__device__ __forceinline__ bf16x8 ldfrag(const unsigned char* base, int ld, int row, int kbyte) { return *(const bf16x8*)(base + row * ld + kbyte); }
__device__ __forceinline__ unsigned pk(float a, float b) { return (unsigned)f2bf(a) | ((unsigned)f2bf(b) << 16); }
__device__ __forceinline__ float lo16(unsigned w) { return __uint_as_float(w << 16); }
__device__ __forceinline__ float hi16(unsigned w) { return __uint_as_float(w & 0xffff0000u); }

template <int MIXER>
__device__ __forceinline__ void scan_item(unsigned char* lds, int wv, const Params& p, int b, int h, int dir, int vs) {
  constexpr int DK = (MIXER == MIX_A || MIXER == MIX_D) ? 128 : 64;
  constexpr int NC = DK / 8;
  constexpr int LD_D = DK * 2 + 16;
  constexpr int NVT = MIXER == MIX_D ? 3 : 2;
  constexpr int NKD = DK / 32;
  const int tid = opaque_tid(wv), lane0 = tid & 63, wid = __builtin_amdgcn_readfirstlane(tid >> 6);
  unsigned char* ws = p.ws;
  const bf16_t* P = (const bf16_t*)(ws + WS_R1);
  const bf16_t* LFBp = (const bf16_t*)(ws + WS_LFB);
  const float* side = (const float*)(ws + WS_SIDE);
  const float* rope = (const float*)(ws + WS_ROPE);
  bf16_t* O = (bf16_t*)(ws + WS_R2) + (size_t)dir * NTOK * 1024;
  unsigned char* QS = lds + OFF_QS; unsigned char* KS = lds + OFF_KS; unsigned char* QI = lds + OFF_QI; unsigned char* KT = lds + OFF_KT;
  unsigned char* VT = lds + OFF_VT; unsigned char* SC = lds + OFF_SC; unsigned char* ST = lds + OFF_ST;
  float* DEC = (float*)(lds + OFF_DEC); float* EM = (float*)(lds + OFF_EM); float* DEN = (float*)(lds + OFF_DEN);

  int qcol, kcol, lfcol, vcol, ocol;
  if (MIXER == MIX_A) { qcol = h * 128; kcol = 0; lfcol = 512 + dir * 512 + h * 128; vcol = 1536 + h * 128 + vs * 32; ocol = h * 128 + vs * 32; }
  else if (MIXER == MIX_B) { qcol = 2560 + h * 64; kcol = 2816 + h * 64; lfcol = dir * 256 + h * 64; vcol = 3072 + h * 128 + vs * 32; ocol = 512 + h * 128 + vs * 32; }
  else if (MIXER == MIX_C) { qcol = h * 64; kcol = 256 + h * 64; lfcol = 0; vcol = 512 + h * 128 + vs * 32; ocol = h * 128 + vs * 32; }
  else { qcol = 1536 + h * 128; kcol = 2048 + h * 128; lfcol = 0; vcol = 2560 + h * 128 + vs * 32; ocol = 512 + h * 128 + vs * 32; }
  const int c0 = (MIXER == MIX_C) ? wid * 4 : wid * NC;
  const float lgam = (MIXER == MIX_C) ? log1pf(-exp2f(-(5.0f + 2.0f * (float)h + (float)dir))) : 0.f;
  const float fgb = (MIXER == MIX_D) ? p.in[I_FGATE_B][dir * 4 + h] : 0.f;
  for (int i = tid; i < 48 * LD_D / 4; i += NTHREADS) ((unsigned*)ST)[i] = 0u;
  if (MIXER == MIX_D) { for (int i = tid; i < 16 * 64; i += NTHREADS) { const int r = 32 + (i >> 6), j = i & 63; *(bf16_t*)(VT + r * LD_T + j * 2) = (r == 32) ? (bf16_t)0x3F80 : (bf16_t)0; } }
  f32x4 sacc[NVT == 3 ? 3 : 2];
#pragma unroll
  for (int i = 0; i < (NVT == 3 ? 3 : 2); ++i) sacc[i] = (f32x4){0.f, 0.f, 0.f, 0.f};
  float m_st = 0.f;
  const size_t tokbase = (size_t)b * SEQ;
  const int sgn = dir ? -1 : 1;
  __syncthreads();

  for (int n = 0; n < SEQ / 64; ++n) {
    int lane = lane0; asm volatile("" : "+v"(lane));
    const int fr = lane & 15, fq = lane >> 4;
    const int t = dir ? (SEQ - 1 - (n * 64 + lane)) : (n * 64 + lane);
    const bf16_t* row = P + (tokbase + t) * PSTRIDE;
    float q[NC], k[NC], g[NC];
    if (MIXER == MIX_A) {
      const u32x4* qp = (const u32x4*)(row + qcol + c0); const u32x4* lp = (const u32x4*)(row + lfcol + c0);
      const u32x4 q0 = qp[0], q1 = qp[1], l0 = lp[0], l1 = lp[1];
      const unsigned qw[8] = {q0.x, q0.y, q0.z, q0.w, q1.x, q1.y, q1.z, q1.w}, lw[8] = {l0.x, l0.y, l0.z, l0.w, l1.x, l1.y, l1.z, l1.w};
#pragma unroll
      for (int c = 0; c < 8; ++c) { q[2 * c] = lo16(qw[c]); q[2 * c + 1] = hi16(qw[c]); g[2 * c] = lo16(lw[c]); g[2 * c + 1] = hi16(lw[c]); }
#pragma unroll
      for (int c = 0; c < NC; ++c) k[c] = -expm1f(g[c]);
    } else if (MIXER == MIX_B) {
      const u32x4 q0 = *(const u32x4*)(row + qcol + c0), k0 = *(const u32x4*)(row + kcol + c0), l0 = *(const u32x4*)(LFBp + (tokbase + t) * 512 + lfcol + c0);
      const unsigned qw[4] = {q0.x, q0.y, q0.z, q0.w}, kw[4] = {k0.x, k0.y, k0.z, k0.w}, lw[4] = {l0.x, l0.y, l0.z, l0.w};
#pragma unroll
      for (int c = 0; c < 4; ++c) { q[2 * c] = lo16(qw[c]); q[2 * c + 1] = hi16(qw[c]); k[2 * c] = lo16(kw[c]); k[2 * c + 1] = hi16(kw[c]); g[2 * c] = lo16(lw[c]); g[2 * c + 1] = hi16(lw[c]); }
    } else if (MIXER == MIX_C) {
      const u32x2 qa = *(const u32x2*)(row + qcol + c0), qb = *(const u32x2*)(row + qcol + 32 + c0), ka = *(const u32x2*)(row + kcol + c0), kb = *(const u32x2*)(row + kcol + 32 + c0);
      const f32x4 r0 = *(const f32x4*)(rope + ((size_t)t * 32 + c0) * 2), r1 = *(const f32x4*)(rope + ((size_t)t * 32 + c0) * 2 + 4);
      const float cs[4] = {r0[0], r0[2], r1[0], r1[2]}, sn[4] = {r0[1], r0[3], r1[1], r1[3]};
      const float q1[4] = {lo16(qa.x), hi16(qa.x), lo16(qa.y), hi16(qa.y)}, q2[4] = {lo16(qb.x), hi16(qb.x), lo16(qb.y), hi16(qb.y)};
      const float k1[4] = {lo16(ka.x), hi16(ka.x), lo16(ka.y), hi16(ka.y)}, k2[4] = {lo16(kb.x), hi16(kb.x), lo16(kb.y), hi16(kb.y)};
#pragma unroll
      for (int c = 0; c < 4; ++c) { q[c] = (q1[c] * cs[c] - q2[c] * sn[c]) * 0.125f; q[4 + c] = (q1[c] * sn[c] + q2[c] * cs[c]) * 0.125f; k[c] = k1[c] * cs[c] - k2[c] * sn[c]; k[4 + c] = k1[c] * sn[c] + k2[c] * cs[c]; }
#pragma unroll
      for (int c = 0; c < NC; ++c) g[c] = (float)(lane + 1) * lgam;
    } else {
      const u32x4* qp = (const u32x4*)(row + qcol + c0); const u32x4* kp = (const u32x4*)(row + kcol + c0);
      const u32x4 q0 = qp[0], q1 = qp[1], k0 = kp[0], k1 = kp[1];
      const unsigned qw[8] = {q0.x, q0.y, q0.z, q0.w, q1.x, q1.y, q1.z, q1.w}, kw[8] = {k0.x, k0.y, k0.z, k0.w, k1.x, k1.y, k1.z, k1.w};
      unsigned eq[8] = {0, 0, 0, 0, 0, 0, 0, 0}, ek[8] = {0, 0, 0, 0, 0, 0, 0, 0};
      const int te = (lane == 0) ? t - sgn : t + sgn;
      if ((lane == 0 || lane == 63) && te >= 0 && te < SEQ) {
        const bf16_t* er = P + (tokbase + te) * PSTRIDE;
        const u32x4 a0 = *(const u32x4*)(er + qcol + c0), a1 = *(const u32x4*)(er + qcol + c0 + 8), b0 = *(const u32x4*)(er + kcol + c0), b1 = *(const u32x4*)(er + kcol + c0 + 8);
        eq[0] = a0.x; eq[1] = a0.y; eq[2] = a0.z; eq[3] = a0.w; eq[4] = a1.x; eq[5] = a1.y; eq[6] = a1.z; eq[7] = a1.w;
        ek[0] = b0.x; ek[1] = b0.y; ek[2] = b0.z; ek[3] = b0.w; ek[4] = b1.x; ek[5] = b1.y; ek[6] = b1.z; ek[7] = b1.w;
      }
      const float* cw = p.in[I_CONV_W]; const float* cb = p.in[I_CONV_B];
      const int qch = h * 128 + c0, kch = 512 + h * 128 + c0;
#pragma unroll
      for (int c = 0; c < 8; ++c) {
        const float cw0a = cw[qch + 2 * c], cw0b = cw[qch + 2 * c + 1], cw1a = cw[1024 + qch + 2 * c], cw1b = cw[1024 + qch + 2 * c + 1], cw2a = cw[2048 + qch + 2 * c], cw2b = cw[2048 + qch + 2 * c + 1], cbqa = cb[qch + 2 * c], cbqb = cb[qch + 2 * c + 1];
        const float ck0a = cw[kch + 2 * c], ck0b = cw[kch + 2 * c + 1], ck1a = cw[1024 + kch + 2 * c], ck1b = cw[1024 + kch + 2 * c + 1], ck2a = cw[2048 + kch + 2 * c], ck2b = cw[2048 + kch + 2 * c + 1], cbka = cb[kch + 2 * c], cbkb = cb[kch + 2 * c + 1];
        const unsigned upq = __shfl_up(qw[c], 1), dnq = __shfl_down(qw[c], 1), upk = __shfl_up(kw[c], 1), dnk = __shfl_down(kw[c], 1);
        const unsigned loq = lane > 0 ? upq : eq[c], hiq = lane < 63 ? dnq : eq[c], lok = lane > 0 ? upk : ek[c], hik = lane < 63 ? dnk : ek[c];
        const unsigned m1q = dir ? hiq : loq, p1q = dir ? loq : hiq, m1k = dir ? hik : lok, p1k = dir ? lok : hik;
        const float a0 = cbqa + cw0a * lo16(m1q) + cw1a * lo16(qw[c]) + cw2a * lo16(p1q);
        const float a1 = cbqb + cw0b * hi16(m1q) + cw1b * hi16(qw[c]) + cw2b * hi16(p1q);
        const float b0 = cbka + ck0a * lo16(m1k) + ck1a * lo16(kw[c]) + ck2a * lo16(p1k);
        const float b1 = cbkb + ck0b * hi16(m1k) + ck1b * hi16(kw[c]) + ck2b * hi16(p1k);
        q[2 * c] = siluf_(a0) * 0.08838834764831845f; q[2 * c + 1] = siluf_(a1) * 0.08838834764831845f; k[2 * c] = siluf_(b0); k[2 * c + 1] = siluf_(b1);
        asm volatile("" ::: "memory");
      }
#pragma unroll
      for (int c = 0; c < NC; ++c) g[c] = 0.f;
    }
    const u32x2 vv = *(const u32x2*)(row + vcol + wid * 4);

    float s_qs[NC], s_ks[NC], s_qi[NC], s_kt[NC];
    if (MIXER != MIX_D) {
#pragma unroll
      for (int c = 0; c < NC; ++c) {
        float gc = (MIXER == MIX_C) ? g[c] : incl_scan_add(g[c], lane);
        const float gref = __shfl(gc, 31), glast = __shfl(gc, 63);
        const float a = __expf(gc - gref), ia = __expf(gref - gc);
        s_qs[c] = a; s_ks[c] = ia; s_qi[c] = __expf(gc); s_kt[c] = __expf(glast - gc);
        if (lane == 63) DEC[(MIXER == MIX_C) ? (c < 4 ? c0 + c : 32 + c0 + c - 4) : c0 + c] = __expf(glast);
      }
    } else {
      const float li = side[(tokbase + t) * 32 + dir * 8 + h];
      const float lf = logsigmoidf_(side[(tokbase + t) * 32 + dir * 8 + 4 + h] + fgb);
      const float bc = incl_scan_add(lf, lane);
      const float u = li - bc;
      const float pm = incl_scan_max(u, lane);
      const float cmax = __shfl(pm, 63), blast = __shfl(bc, 63);
      const float a_i = bc + m_st, m_i = fmaxf(a_i, bc + pm);
      const float alpha = __expf(bc - m_i + cmax), beta = __expf(u - cmax), sint = __expf(a_i - m_i);
      const float m_new = fmaxf(blast + m_st, blast + cmax);
      const float s_old = __expf(blast + m_st - m_new), wks = __expf(blast + u - m_new);
      m_st = m_new;
#pragma unroll
      for (int c = 0; c < NC; ++c) { s_qs[c] = alpha; s_ks[c] = beta; s_qi[c] = sint; s_kt[c] = wks; }
      if (wid == 0) EM[lane] = __expf(-m_i);
      if (lane == 63) {
#pragma unroll
        for (int c = 0; c < NC; ++c) DEC[c0 + c] = s_old;
      }
    }
    {
      unsigned wq[NC / 2], wk[NC / 2], wi[NC / 2];
#pragma unroll
      for (int c = 0; c < NC / 2; ++c) { wq[c] = pk(q[2 * c] * s_qs[2 * c], q[2 * c + 1] * s_qs[2 * c + 1]); wk[c] = pk(k[2 * c] * s_ks[2 * c], k[2 * c + 1] * s_ks[2 * c + 1]); wi[c] = pk(q[2 * c] * s_qi[2 * c], q[2 * c + 1] * s_qi[2 * c + 1]); }
      if (MIXER == MIX_C) {
        *(u32x2*)(QS + lane * LD_D + c0 * 2) = (u32x2){wq[0], wq[1]}; *(u32x2*)(QS + lane * LD_D + (32 + c0) * 2) = (u32x2){wq[2], wq[3]};
        *(u32x2*)(KS + lane * LD_D + c0 * 2) = (u32x2){wk[0], wk[1]}; *(u32x2*)(KS + lane * LD_D + (32 + c0) * 2) = (u32x2){wk[2], wk[3]};
        *(u32x2*)(QI + lane * LD_D + c0 * 2) = (u32x2){wi[0], wi[1]}; *(u32x2*)(QI + lane * LD_D + (32 + c0) * 2) = (u32x2){wi[2], wi[3]};
      } else {
#pragma unroll
        for (int c = 0; c < NC / 8; ++c) {
          *(u32x4*)(QS + lane * LD_D + (c0 + 8 * c) * 2) = (u32x4){wq[4 * c], wq[4 * c + 1], wq[4 * c + 2], wq[4 * c + 3]};
          *(u32x4*)(KS + lane * LD_D + (c0 + 8 * c) * 2) = (u32x4){wk[4 * c], wk[4 * c + 1], wk[4 * c + 2], wk[4 * c + 3]};
          *(u32x4*)(QI + lane * LD_D + (c0 + 8 * c) * 2) = (u32x4){wi[4 * c], wi[4 * c + 1], wi[4 * c + 2], wi[4 * c + 3]};
        }
      }
#pragma unroll
      for (int c = 0; c < NC; ++c) { const int d = (MIXER == MIX_C) ? (c < 4 ? c0 + c : 32 + c0 + c - 4) : c0 + c; *(bf16_t*)(KT + d * LD_T + lane * 2) = f2bf(k[c] * s_kt[c]); }
      *(bf16_t*)(VT + (wid * 4 + 0) * LD_T + lane * 2) = (bf16_t)(vv.x & 0xffff); *(bf16_t*)(VT + (wid * 4 + 1) * LD_T + lane * 2) = (bf16_t)(vv.x >> 16);
      *(bf16_t*)(VT + (wid * 4 + 2) * LD_T + lane * 2) = (bf16_t)(vv.y & 0xffff); *(bf16_t*)(VT + (wid * 4 + 3) * LD_T + lane * 2) = (bf16_t)(vv.y >> 16);
    }
    __syncthreads();
    {
      const int it = wid & 3;
#pragma unroll
      for (int jj = 0; jj < 2; ++jj) {
        const int jt = 2 * (wid >> 2) + jj;
        if (jt <= it) {
          f32x4 acc = (f32x4){0.f, 0.f, 0.f, 0.f};
#pragma unroll
          for (int ks = 0; ks < NKD; ++ks) acc = __builtin_amdgcn_mfma_f32_16x16x32_bf16(ldfrag(KS, LD_D, jt * 16 + fr, ks * 64 + fq * 16), ldfrag(QS, LD_D, it * 16 + fr, ks * 64 + fq * 16), acc, 0, 0, 0);
          const int i = it * 16 + fr, j0 = jt * 16 + fq * 4;
          const float v0 = (j0 + 0 <= i) ? acc[0] : 0.f, v1 = (j0 + 1 <= i) ? acc[1] : 0.f, v2 = (j0 + 2 <= i) ? acc[2] : 0.f, v3 = (j0 + 3 <= i) ? acc[3] : 0.f;
          *(u32x2*)(SC + i * LD_T + j0 * 2) = (u32x2){pk(v0, v1), pk(v2, v3)};
        } else {
          const int i = it * 16 + fr, j0 = jt * 16 + fq * 4;
          *(u32x2*)(SC + i * LD_T + j0 * 2) = (u32x2){0u, 0u};
        }
      }
    }
    f32x4 oacc = (f32x4){0.f, 0.f, 0.f, 0.f}, dacc = (f32x4){0.f, 0.f, 0.f, 0.f};
    {
      const int vt = wid >> 2, it = wid & 3;
#pragma unroll
      for (int ks = 0; ks < NKD; ++ks) oacc = __builtin_amdgcn_mfma_f32_16x16x32_bf16(ldfrag(ST, LD_D, vt * 16 + fr, ks * 64 + fq * 16), ldfrag(QI, LD_D, it * 16 + fr, ks * 64 + fq * 16), oacc, 0, 0, 0);
      if (NVT == 3 && wid < 4) {
#pragma unroll
        for (int ks = 0; ks < NKD; ++ks) dacc = __builtin_amdgcn_mfma_f32_16x16x32_bf16(ldfrag(ST, LD_D, 32 + fr, ks * 64 + fq * 16), ldfrag(QI, LD_D, wid * 16 + fr, ks * 64 + fq * 16), dacc, 0, 0, 0);
      }
    }
    __syncthreads();
    {
      const int vt = wid >> 2, it = wid & 3;
#pragma unroll
      for (int ks = 0; ks < 2; ++ks) oacc = __builtin_amdgcn_mfma_f32_16x16x32_bf16(ldfrag(VT, LD_T, vt * 16 + fr, ks * 64 + fq * 16), ldfrag(SC, LD_T, it * 16 + fr, ks * 64 + fq * 16), oacc, 0, 0, 0);
      if (NVT == 3) {
        if (wid < 4) {
#pragma unroll
          for (int ks = 0; ks < 2; ++ks) dacc = __builtin_amdgcn_mfma_f32_16x16x32_bf16(ldfrag(VT, LD_T, 32 + fr, ks * 64 + fq * 16), ldfrag(SC, LD_T, wid * 16 + fr, ks * 64 + fq * 16), dacc, 0, 0, 0);
          if (fq == 0) DEN[wid * 16 + fr] = dacc[0];
        }
        __syncthreads();
        const int i = it * 16 + fr;
        const float dn = 1.0f / fmaxf(fabsf(DEN[i]), EM[i]);
        oacc *= dn;
      }
      const int i = it * 16 + fr;
      const int ti = dir ? (SEQ - 1 - (n * 64 + i)) : (n * 64 + i);
      *(u32x2*)(O + (tokbase + ti) * 1024 + ocol + vt * 16 + fq * 4) = (u32x2){pk(oacc[0], oacc[1]), pk(oacc[2], oacc[3])};
    }
    {
      constexpr int NST = (DK == 128) ? NVT : 1;
#pragma unroll
      for (int s = 0; s < NST; ++s) {
        const int dt = (DK == 128) ? wid : (wid & 3), vt = (DK == 128) ? s : (wid >> 2);
        const f32x4 dc = *(const f32x4*)(DEC + dt * 16 + fq * 4);
        f32x4 acc = sacc[s] * dc;
#pragma unroll
        for (int ks = 0; ks < 2; ++ks) acc = __builtin_amdgcn_mfma_f32_16x16x32_bf16(ldfrag(KT, LD_T, dt * 16 + fr, ks * 64 + fq * 16), ldfrag(VT, LD_T, vt * 16 + fr, ks * 64 + fq * 16), acc, 0, 0, 0);
        sacc[s] = acc;
        *(u32x2*)(ST + (vt * 16 + fr) * LD_D + (dt * 16 + fq * 4) * 2) = (u32x2){pk(acc[0], acc[1]), pk(acc[2], acc[3])};
      }
    }
    __syncthreads();
  }
}

template <int MIXER>
__device__ __forceinline__ void scan_dispatch(unsigned char* lds, int wv, const Params& p, int id) {
  const int vs = id & 3, dir = (id >> 2) & 1, h = (id >> 3) & 3, b = id >> 5;
  scan_item<MIXER>(lds, wv, p, b, h, dir, vs);
}
}

__device__ __forceinline__ void scan_phase(unsigned char* lds, int wv, const Params& p, int layer) {
  for (int item = blockIdx.x; item < 256; item += gridDim.x) {
    if (layer == 0) { if (item < 128) scan::scan_dispatch<scan::MIX_A>(lds, wv, p, item); else scan::scan_dispatch<scan::MIX_B>(lds, wv, p, item - 128); }
    else { if (item < 128) scan::scan_dispatch<scan::MIX_D>(lds, wv, p, item); else scan::scan_dispatch<scan::MIX_C>(lds, wv, p, item - 128); }
    __syncthreads();
  }
}
#endif
#ifndef CPU_EMU
__device__ __forceinline__ void grid_bar(unsigned* ctr, unsigned& epoch, unsigned G, int wv) {
  asm volatile("s_waitcnt vmcnt(0)" ::: "memory");
  __syncthreads();
  epoch += G;
  if (wv == 0 && lane_id() == 0) {
    __builtin_amdgcn_fence(__ATOMIC_RELEASE, "agent");
    asm volatile("s_waitcnt vmcnt(0)" ::: "memory");
    __hip_atomic_fetch_add(ctr, 1u, __ATOMIC_RELAXED, __HIP_MEMORY_SCOPE_AGENT);
    unsigned spins = 0;
    while (__hip_atomic_load(ctr, __ATOMIC_RELAXED, __HIP_MEMORY_SCOPE_AGENT) < epoch) { __builtin_amdgcn_s_sleep(2); if (++spins > (1u << 26)) break; }
    __builtin_amdgcn_fence(__ATOMIC_ACQUIRE, "agent");
    asm volatile("s_waitcnt vmcnt(0)" ::: "memory");
  }
  __syncthreads();
}

__global__ void __launch_bounds__(NTHREADS) mk_fwd(Params p) {
  extern __shared__ __attribute__((aligned(16))) unsigned char lds_raw[];
  cg::grid_group grid = cg::this_grid();
  const int G = gridDim.x, bid = blockIdx.x;
  const int wv = __builtin_amdgcn_readfirstlane(threadIdx.x >> 6);
  PG8_LAS unsigned char* lds = (PG8_LAS unsigned char*)lds_raw;
  unsigned char* ws = p.ws;

  p0_prologue(lds_raw, wv, p);
  grid.sync();
  unsigned* bar = (unsigned*)(ws + WS_CTL) + 1024;
  unsigned epoch = 0;
  for (int layer = 0; layer < 2; ++layer) {
    { ProbInProj pr; pr.so.init(NTOK, layer == 0 ? PM_AB : PM_CD, G, bid); pr.A = (const char*)(ws + WS_HB); pr.Bt = (const char*)(ws + (layer == 0 ? WS_WIN_AB : WS_WIN_CD));
      pr.P = (bf16_t*)(ws + WS_R1); pr.bias = p.in[layer == 0 ? I_AB_B_IN : I_CD_B_IN]; pr.lb = (const float*)(ws + WS_LB); pr.layer = layer;
      pg8::gemm_phase(lds, pr, wv);
      if (layer == 0) side_phase<32>(lds_raw, wv, p, 0); else side_phase<16>(lds_raw, wv, p, 1); }
    grid_bar(bar, epoch, (unsigned)G, wv);
    scan_phase(lds_raw, wv, p, layer);
    grid_bar(bar, epoch, (unsigned)G, wv);
    headnorm_phase(lds_raw, wv, p, layer);
    grid_bar(bar, epoch, (unsigned)G, wv);
    { ProbOutProj pr; pr.so.init(NTOK, 1024, G, bid); pr.A = (const char*)(ws + WS_HB); pr.Bt = (const char*)(ws + (layer == 0 ? WS_WOUT_AB : WS_WOUT_CD)); pr.Y = (float*)(ws + WS_R2);
      pg8::gemm_phase(lds, pr, wv);
      moe_weight_convert(lds_raw, wv, p, layer); }
    grid_bar(bar, epoch, (unsigned)G, wv);
    ln_phase(lds_raw, wv, p, layer, 0);
    grid_bar(bar, epoch, (unsigned)G, wv);
    { ProbMoe1 pr; pr.mo.cnt = (const int*)((const unsigned*)(ws + WS_CTL) + CW_CNT(layer)); pr.mo.ntn = 8; pr.mo.G = G; pr.mo.c = bid;
      pr.A = (const char*)(ws + WS_HB); pr.W13 = (const char*)(ws + WS_WMOE); pr.list = (const int*)(ws + WS_LIST) + (size_t)layer * NEXP * NTOK; pr.H = (bf16_t*)(ws + WS_H);
      pg8::gemm_phase(lds, pr, wv); }
    grid_bar(bar, epoch, (unsigned)G, wv);
    { ProbMoe2 pr; pr.mo.cnt = (const int*)((const unsigned*)(ws + WS_CTL) + CW_CNT(layer)); pr.mo.ntn = 4; pr.mo.G = G; pr.mo.c = bid;
      pr.A = (const char*)(ws + WS_H); pr.W2 = (const char*)(ws + WS_WMOE) + (size_t)NEXP * 2048 * 1024 * 2; pr.Y = (bf16_t*)(ws + WS_R2);
      pg8::gemm_phase(lds, pr, wv); }
    grid_bar(bar, epoch, (unsigned)G, wv);
    ln_phase(lds_raw, wv, p, layer, 1);
    if (layer == 0) grid_bar(bar, epoch, (unsigned)G, wv);
  }
}

extern "C" void kernel_launch(void* const* d_in, const int* in_sizes, int n_in, void* d_out, int out_size, void* d_ws, size_t ws_size, hipStream_t stream) {
  static int grid_blocks = 0;
  if (grid_blocks == 0) {
    if (n_in != N_IN || ws_size < WS_END || out_size != NTOK * 1024) { fprintf(stderr, "kernel_launch: bad shapes: n_in %d ws %zu (need %zu) out %d\n", n_in, ws_size, (size_t)WS_END, out_size); grid_blocks = -1; return; }
    int dev = 0, cus = 0, per_cu = 0;
    hipGetDevice(&dev); hipDeviceGetAttribute(&cus, hipDeviceAttributeMultiprocessorCount, dev);
    if (hipFuncSetAttribute((const void*)mk_fwd, hipFuncAttributeMaxDynamicSharedMemorySize, LDS_BYTES) != hipSuccess) { fprintf(stderr, "kernel_launch: hipFuncSetAttribute failed\n"); grid_blocks = -1; return; }
    if (hipOccupancyMaxActiveBlocksPerMultiprocessor(&per_cu, (const void*)mk_fwd, NTHREADS, LDS_BYTES) != hipSuccess || per_cu < 1) { fprintf(stderr, "kernel_launch: occupancy query failed (%d)\n", per_cu); grid_blocks = -1; return; }
    grid_blocks = cus;
    (void)in_sizes;
  }
  if (grid_blocks < 0) return;
  Params p{};
  for (int i = 0; i < N_IN; ++i) p.in[i] = (const float*)d_in[i];
  p.out = (float*)d_out; p.ws = (unsigned char*)d_ws;
  void* args[] = {&p};
  hipError_t e = hipLaunchCooperativeKernel((const void*)mk_fwd, dim3(grid_blocks), dim3(NTHREADS), args, LDS_BYTES, stream);
  if (e != hipSuccess) fprintf(stderr, "cooperative launch failed: %s (grid %d)\n", hipGetErrorString(e), grid_blocks);
}
#endif
#ifdef CPU_EMU
#include <vector>
void dbg_cmp(const char* name, const float* p, long n);
template <class F> static void run_functor(const F& f, long n) {
#pragma omp parallel for schedule(dynamic, 16)
  for (long g = 0; g < n; ++g) f(g);
}
static void cpu_round_w(const float* src, size_t n, std::vector<float>& dst) { dst.resize(n); for (size_t i = 0; i < n; ++i) dst[i] = bf2f(f2bf(src[i])); }

extern "C" void kernel_launch(void* const* d_in, const int* in_sizes, int n_in, void* d_out, int out_size, void* d_ws, size_t ws_size, hipStream_t) {
  (void)in_sizes; (void)n_in; (void)out_size;
  if (ws_size < WS_END) { printf("ws too small %zu < %zu\n", ws_size, (size_t)WS_END); return; }
  Params p{}; for (int i = 0; i < N_IN; ++i) p.in[i] = (const float*)d_in[i];
  p.out = (float*)d_out; p.ws = (unsigned char*)d_ws;
  unsigned char* ws = p.ws;
  bf16_t* HB = (bf16_t*)(ws + WS_HB); bf16_t* P = (bf16_t*)(ws + WS_R1); bf16_t* LFB = (bf16_t*)(ws + WS_LFB);
  bf16_t* O = (bf16_t*)(ws + WS_R2); float* yf = (float*)(ws + WS_R2); bf16_t* Y = (bf16_t*)(ws + WS_R2); bf16_t* H = (bf16_t*)(ws + WS_H);
  float* side = (float*)(ws + WS_SIDE); float* oside = (float*)(ws + WS_OSIDE); float* rope = (float*)(ws + WS_ROPE); float* lb = (float*)(ws + WS_LB);
  int* assign = (int*)(ws + WS_ASSIGN); float* gate = (float*)(ws + WS_GATE);
  for (size_t i = 0; i < (size_t)NTOK * 1024; ++i) HB[i] = f2bf(p.in[I_X][i]);
  for (int i = 0; i < SEQ * 32; ++i) { int t = i >> 5, f = i & 31; float freq = powf(10000.0f, -(float)f / 32.0f); float ang = (float)t * freq; rope[i * 2] = cosf(ang); rope[i * 2 + 1] = sinf(ang); }
  for (int cc = 0; cc < 512; ++cc) { const float* hl = p.in[I_HGRN_LB]; float a0 = hl[cc], a1 = hl[512 + cc], a2 = hl[1024 + cc]; float mx = fmaxf(a0, fmaxf(a1, a2));
    float e0 = expf(a0 - mx), e1 = expf(a1 - mx), e2 = expf(a2 - mx); lb[cc] = e0 / (e0 + e1 + e2); }
  std::vector<float> wr;
  for (int layer = 0; layer < 2; ++layer) {
    const int PW = layer == 0 ? P_AB : P_CD, PM = layer == 0 ? PM_AB : PM_CD;
    const float* bias = p.in[layer == 0 ? I_AB_B_IN : I_CD_B_IN];
    cpu_round_w(p.in[layer == 0 ? I_AB_W_IN : I_CD_W_IN], (size_t)1024 * PW, wr);
#pragma omp parallel for
    for (long tok = 0; tok < NTOK; ++tok) {
      std::vector<float> acc(PW, 0.f);
      for (int k = 0; k < 1024; ++k) { float a = bf2f(HB[tok * 1024 + k]); const float* w = &wr[(size_t)k * PW]; for (int n = 0; n < PW; ++n) acc[n] += a * w[n]; }
      for (int n = 0; n < PM; ++n) { float v = acc[n] + bias[n]; if (layer == 0) v = epi_ab(n, v, lb); P[tok * PSTRIDE + n] = f2bf(v); }
      for (int n = PM; n < PW; ++n) side[tok * 32 + (n - PM)] = acc[n] + bias[n];
      if (layer == 0) for (int dir = 0; dir < 2; ++dir) for (int cc = 0; cc < 256; ++cc) {
        float z = p.in[I_GK_B][dir * 256 + cc];
        for (int r = 0; r < 16; ++r) z += side[tok * 32 + dir * 16 + r] * p.in[I_GK_UP][(dir * 16 + r) * 256 + cc];
        LFB[tok * 512 + dir * 256 + cc] = f2bf(logsigmoidf_(z) * 0.0625f); }
    }
    if (layer == 0) { ScanAB2 s{}; s.P = P; s.LFB = LFB; s.O = O; run_functor(s, (long)BATCH * 2048); }
    else { PrepCD2 pc{}; pc.P = P; pc.QD = LFB; pc.rope = rope; pc.conv_w = p.in[I_CONV_W]; pc.conv_b = p.in[I_CONV_B]; run_functor(pc, (long)NTOK * 1280);
      ScanCD2 s{}; s.P = P; s.QD = LFB; s.side = side; s.fgate_b = p.in[I_FGATE_B]; s.O = O; s.oside = oside; run_functor(s, (long)BATCH * 2056); }
#pragma omp parallel for
    for (long tok = 0; tok < NTOK; ++tok) for (int h8 = 0; h8 < 8; ++h8) {
      float sf = 1.f, sb = 1.f;
      if (layer == 1 && h8 >= 4) { int h = h8 - 4; const float* s0 = oside + tok * 8 + h * 2; const float* s1 = oside + (size_t)(NTOK + tok) * 8 + h * 2;
        sf = 1.0f / fmaxf(fabsf(s0[0]), expf(-s0[1])); sb = 1.0f / fmaxf(fabsf(s1[0]), expf(-s1[1])); }
      float o[128]; float ss = 0.f;
      for (int j = 0; j < 128; ++j) { int c = h8 * 128 + j; o[j] = bf2f(O[tok * 1024 + c]) * sf + bf2f(O[(size_t)(NTOK + tok) * 1024 + c]) * sb; ss += o[j] * o[j]; }
      float r = 1.0f / sqrtf(ss * (1.0f / 128.0f) + NORM_EPS_F);
      for (int j = 0; j < 128; ++j) { int c = h8 * 128 + j; float gn, gt;
        if (layer == 0) { gn = h8 < 4 ? p.in[I_HGRN_NORM][c] : p.in[I_GLA_NORM][c - 512]; gt = siluf_(bf2f(P[tok * PSTRIDE + (h8 < 4 ? 2048 + c : 3584 + c - 512)])); }
        else { gn = h8 < 4 ? p.in[I_RET_NORM][c] : p.in[I_MLSTM_NORM][c - 512]; float gr = bf2f(P[tok * PSTRIDE + (h8 < 4 ? 1024 + c : 3072 + c - 512)]); gt = h8 < 4 ? siluf_(gr) : sigmoidf_(gr); }
        HB[tok * 1024 + c] = f2bf(o[j] * r * gn * gt); }
    }
    cpu_round_w(p.in[layer == 0 ? I_AB_W_OUT : I_CD_W_OUT], (size_t)1024 * 1024, wr);
#pragma omp parallel for
    for (long tok = 0; tok < NTOK; ++tok) { std::vector<float> acc(1024, 0.f);
      for (int k = 0; k < 1024; ++k) { float a = bf2f(HB[tok * 1024 + k]); const float* w = &wr[(size_t)k * 1024]; for (int n = 0; n < 1024; ++n) acc[n] += a * w[n]; }
      for (int n = 0; n < 1024; ++n) yf[tok * 1024 + n] = acc[n]; }
    dbg_cmp(layer == 0 ? "y_mix0" : "y_mix1", yf, (long)NTOK * 1024);
    int cnt[NEXP] = {0}; std::vector<int> list((size_t)NEXP * NTOK);
    const float* hin = layer == 0 ? p.in[I_X] : p.out;
    for (long tok = 0; tok < NTOK; ++tok) {
      float v[1024]; double s = 0; for (int c = 0; c < 1024; ++c) { v[c] = ALPHA_F * hin[tok * 1024 + c] + yf[tok * 1024 + c]; s += v[c]; }
      float mean = (float)(s / 1024); double q = 0; for (int c = 0; c < 1024; ++c) { v[c] -= mean; q += (double)v[c] * v[c]; }
      float r = 1.0f / sqrtf((float)(q / 1024) + LN_EPS_F);
      float lg[16] = {0};
      for (int c = 0; c < 1024; ++c) { v[c] = v[c] * r * p.in[I_LN_MIX_G][layer * 1024 + c] + p.in[I_LN_MIX_B][layer * 1024 + c]; p.out[tok * 1024 + c] = v[c]; HB[tok * 1024 + c] = f2bf(v[c]);
        for (int e = 0; e < 16; ++e) lg[e] += v[c] * p.in[I_ROUTER_W][c * 16 + e]; }
      int eo[2]; float go[2]; route_from_logits(lg, p.in[I_ROUTER_B], eo, go);
      int r1 = cnt[eo[0]]++, r2 = cnt[eo[1]]++;
      list[(size_t)eo[0] * NTOK + r1] = (int)tok; list[(size_t)eo[1] * NTOK + r2] = (int)tok;
      assign[tok * 4] = eo[0]; assign[tok * 4 + 1] = r1; assign[tok * 4 + 2] = eo[1]; assign[tok * 4 + 3] = r2; gate[tok * 2] = go[0]; gate[tok * 2 + 1] = go[1];
    }
    dbg_cmp(layer == 0 ? "h_mix0" : "h_mix1", p.out, (long)NTOK * 1024);
    int pad[NEXP]; { int a = 0; for (int e = 0; e < NEXP; ++e) { pad[e] = a; a += ((cnt[e] + 255) >> 8) << 8; } }
    const size_t lo = (size_t)layer * NEXP * 1024 * 1024;
    for (int e = 0; e < NEXP; ++e) {
      std::vector<float> w1, w3, w2; cpu_round_w(p.in[I_MOE_W1] + lo + (size_t)e * 1048576, 1048576, w1); cpu_round_w(p.in[I_MOE_W3] + lo + (size_t)e * 1048576, 1048576, w3); cpu_round_w(p.in[I_MOE_W2] + lo + (size_t)e * 1048576, 1048576, w2);
#pragma omp parallel for
      for (int rr = 0; rr < cnt[e]; ++rr) { int tok = list[(size_t)e * NTOK + rr]; size_t pos = pad[e] + rr;
        std::vector<float> a1(1024, 0.f), a3(1024, 0.f), a2(1024, 0.f);
        for (int k = 0; k < 1024; ++k) { float a = bf2f(HB[(size_t)tok * 1024 + k]); const float* p1 = &w1[(size_t)k * 1024]; const float* p3 = &w3[(size_t)k * 1024]; for (int n = 0; n < 1024; ++n) { a1[n] += a * p1[n]; a3[n] += a * p3[n]; } }
        for (int n = 0; n < 1024; ++n) H[pos * 1024 + n] = f2bf(siluf_(a1[n]) * a3[n]);
        for (int k = 0; k < 1024; ++k) { float a = bf2f(H[pos * 1024 + k]); const float* p2 = &w2[(size_t)k * 1024]; for (int n = 0; n < 1024; ++n) a2[n] += a * p2[n]; }
        for (int n = 0; n < 1024; ++n) Y[pos * 1024 + n] = f2bf(a2[n]); }
    }
    for (long tok = 0; tok < NTOK; ++tok) {
      size_t p0 = pad[assign[tok * 4]] + assign[tok * 4 + 1], p1 = pad[assign[tok * 4 + 2]] + assign[tok * 4 + 3];
      float v[1024]; double s = 0; for (int c = 0; c < 1024; ++c) { v[c] = ALPHA_F * p.out[tok * 1024 + c] + gate[tok * 2] * bf2f(Y[p0 * 1024 + c]) + gate[tok * 2 + 1] * bf2f(Y[p1 * 1024 + c]); s += v[c]; }
      float mean = (float)(s / 1024); double q = 0; for (int c = 0; c < 1024; ++c) { v[c] -= mean; q += (double)v[c] * v[c]; }
      float r = 1.0f / sqrtf((float)(q / 1024) + LN_EPS_F);
      for (int c = 0; c < 1024; ++c) { v[c] = v[c] * r * p.in[I_LN_FFN_G][layer * 1024 + c] + p.in[I_LN_FFN_B][layer * 1024 + c]; p.out[tok * 1024 + c] = v[c]; HB[tok * 1024 + c] = f2bf(v[c]); }
    }
    dbg_cmp(layer == 0 ? "h_ffn0" : "h_ffn1", p.out, (long)NTOK * 1024);
  }
}
#endif
```

```cpp
#ifdef CPU_EMU
#include <cmath>
#include <cstdio>
#include <cstring>
#include <cstdlib>
#include <cstddef>
#define DEV
#define DEV_INLINE static inline
typedef void* hipStream_t;
#else
#include <hip/hip_runtime.h>
#include <hip/hip_bf16.h>
#include <cstdio>
#define DEV __device__ __forceinline__
#define DEV_INLINE __device__ __forceinline__
#endif
#ifndef PROBE_DUP
#define PROBE_DUP 0
#endif
#ifndef BATCH
#define BATCH 4
#endif
#ifndef SEQ
#define SEQ 8192
#endif
#define DM 1024
#define NTOK (BATCH * SEQ)
#define P_AB 4128
#define P_CD 3600
#define PM_AB 4096
#define PM_CD 3584
#define NEXP 16
#define ALPHA_F 1.4142135623730951f
#define LN_EPS_F 1e-5f
#define NORM_EPS_F 1e-6f
#define HROWS (2 * NTOK + NEXP * 256)

typedef unsigned short bf16_t;

DEV_INLINE float bf2f(bf16_t b) { unsigned u = ((unsigned)b) << 16; float f; memcpy(&f, &u, 4); return f; }
DEV_INLINE bf16_t f2bf(float f) { unsigned u; memcpy(&u, &f, 4); u += 0x7FFFu + ((u >> 16) & 1u); return (bf16_t)(u >> 16); }
DEV_INLINE float sigmoidf_(float x) { return 1.0f / (1.0f + expf(-x)); }
DEV_INLINE float siluf_(float x) { return x / (1.0f + expf(-x)); }
DEV_INLINE float logsigmoidf_(float x) { return fminf(x, 0.0f) - log1pf(expf(-fabsf(x))); }

#define AL256(x) (((size_t)(x) + 255) & ~(size_t)255)
#define WS_CTL    ((size_t)0)
#define WS_HB     ((size_t)65536)
#define WS_R1     (WS_HB + (size_t)NTOK * 1024 * 2)
#define R1_P_BYTES ((size_t)NTOK * 4096 * 2)
#define R1_MIN    (AL256((size_t)HROWS * 1024 * 2) + (size_t)NEXP * 3072 * 1024 * 2)
#define R1_PL     (R1_P_BYTES + (size_t)NTOK * 512 * 2)
#define R1_BYTES  (R1_PL > R1_MIN ? R1_PL : R1_MIN)
#define WS_LFB    (WS_R1 + R1_P_BYTES)
#define WS_H      (WS_R1)
#define WS_WMOE   (WS_R1 + AL256((size_t)HROWS * 1024 * 2))
#define WMOE_BYTES ((size_t)NEXP * 3072 * 1024 * 2)
#define WS_R2     (WS_R1 + R1_BYTES)
#define R2_BYTES  ((size_t)HROWS * 1024 * 2 > (size_t)NTOK * 1024 * 4 ? (size_t)HROWS * 1024 * 2 : (size_t)NTOK * 1024 * 4)
#define WS_SIDE   (WS_R2 + AL256(R2_BYTES))
#define WS_OSIDE  (WS_SIDE + (size_t)NTOK * 32 * 4)
#define WS_WIN_AB (WS_OSIDE + (size_t)2 * NTOK * 8 * 4)
#define WS_WIN_CD (WS_WIN_AB + (size_t)4128 * 1024 * 2)
#define WS_WOUT_AB (WS_WIN_CD + (size_t)3600 * 1024 * 2)
#define WS_WOUT_CD (WS_WOUT_AB + (size_t)1024 * 1024 * 2)
#define WS_ROPE   (WS_WOUT_CD + (size_t)1024 * 1024 * 2)
#define WS_LB     (WS_ROPE + (size_t)SEQ * 64 * 4)
#define WS_LIST   (WS_LB + 4096)
#define WS_ASSIGN (WS_LIST + (size_t)2 * NEXP * NTOK * 4)
#define WS_GATE   (WS_ASSIGN + (size_t)NTOK * 16)
#define WS_END    (WS_GATE + (size_t)NTOK * 8)
#define CW_CNT(layer) (64 + 256 * (layer))

#define PSTRIDE 4096

enum { I_X, I_AB_W_IN, I_AB_B_IN, I_HGRN_LB, I_GK_UP, I_GK_B, I_HGRN_NORM, I_GLA_NORM, I_AB_W_OUT,
       I_CD_W_IN, I_CD_B_IN, I_CONV_W, I_CONV_B, I_FGATE_B, I_RET_NORM, I_MLSTM_NORM, I_CD_W_OUT,
       I_LN_MIX_G, I_LN_MIX_B, I_LN_FFN_G, I_LN_FFN_B, I_ROUTER_W, I_ROUTER_B, I_MOE_W1, I_MOE_W3, I_MOE_W2, N_IN };

struct Params {
  const float* in[N_IN];
  float* out;
  unsigned char* ws;
};

DEV_INLINE float epi_ab(int col, float v, const float* lb) {
  if (col < 512) return siluf_(v);
  if (col < 1536) { float l = lb[(col - 512) & 511]; return logf(l + (1.0f - l) * sigmoidf_(v)); }
  if (col >= 2560 && col < 2816) return v * 0.125f;
  return v;
}

DEV_INLINE void route_from_logits(const float* lg, const float* rb, int* e_out, float* g_out) {
  float mx = lg[0];
#pragma unroll
  for (int e = 1; e < 16; ++e) mx = fmaxf(mx, lg[e]);
  float sc[16]; float sum = 0.f;
#pragma unroll
  for (int e = 0; e < 16; ++e) { sc[e] = expf(lg[e] - mx); sum += sc[e]; }
  float inv = 1.0f / sum;
  float best_gs = -1e30f; int be1 = 0, be2 = 1; float bs1 = 0.f, bs2 = 0.f;
#pragma unroll
  for (int gq = 0; gq < 4; ++gq) {
    float m1 = -1e30f, m2 = -1e30f, s1 = 0.f, s2 = 0.f; int i1 = 0, i2 = 0;
#pragma unroll
    for (int i = 0; i < 4; ++i) {
      float s = sc[gq * 4 + i] * inv; float v = s + rb[gq * 4 + i];
      if (v > m1) { m2 = m1; i2 = i1; s2 = s1; m1 = v; i1 = gq * 4 + i; s1 = s; }
      else if (v > m2) { m2 = v; i2 = gq * 4 + i; s2 = s; }
    }
    float gs = m1 + m2;
    if (gs > best_gs) { best_gs = gs; be1 = i1; be2 = i2; bs1 = s1; bs2 = s2; }
  }
  e_out[0] = be1; e_out[1] = be2; g_out[0] = bs1 / (bs1 + bs2); g_out[1] = bs2 / (bs1 + bs2);
}
struct ScanAB2 {
  const bf16_t* P; const bf16_t* LFB; bf16_t* O;
  DEV void operator()(long gid) const {
    int j = (int)(gid & 127), h = (int)((gid >> 7) & 3), dir = (int)((gid >> 9) & 1), mixer = (int)((gid >> 10) & 1), b = (int)(gid >> 11);
    bf16_t* Od = O + (size_t)dir * NTOK * 1024;
    if (mixer == 0) {
      float S[128];
#pragma unroll
      for (int d = 0; d < 128; ++d) S[d] = 0.f;
      for (int s = 0; s < SEQ; ++s) {
        size_t t = (size_t)b * SEQ + (dir ? (SEQ - 1 - s) : s);
        const bf16_t* row = P + t * PSTRIDE;
        const bf16_t* q = row + h * 128; const bf16_t* lf = row + 512 + dir * 512 + h * 128;
        float v = bf2f(row[1536 + h * 128 + j]);
        float o = 0.f;
#pragma unroll
        for (int d = 0; d < 128; ++d) { float fd = expf(bf2f(lf[d])); S[d] = fd * S[d] + (1.0f - fd) * v; o += bf2f(q[d]) * S[d]; }
        Od[t * 1024 + h * 128 + j] = f2bf(o);
      }
    } else {
      float S[64];
#pragma unroll
      for (int d = 0; d < 64; ++d) S[d] = 0.f;
      for (int s = 0; s < SEQ; ++s) {
        size_t t = (size_t)b * SEQ + (dir ? (SEQ - 1 - s) : s);
        const bf16_t* row = P + t * PSTRIDE;
        const bf16_t* q = row + 2560 + h * 64; const bf16_t* k = row + 2816 + h * 64;
        const bf16_t* lf = LFB + t * 512 + dir * 256 + h * 64;
        float v = bf2f(row[3072 + h * 128 + j]);
        float o = 0.f;
#pragma unroll
        for (int d = 0; d < 64; ++d) { S[d] = expf(bf2f(lf[d])) * S[d] + bf2f(k[d]) * v; o += bf2f(q[d]) * S[d]; }
        Od[t * 1024 + 512 + h * 128 + j] = f2bf(o);
      }
    }
  }
};

struct PrepCD2 {
  bf16_t* P; bf16_t* QD; const float* rope; const float* conv_w; const float* conv_b;
  DEV void operator()(long gid) const {
    size_t tok = (size_t)(gid / 1280); int c = (int)(gid % 1280); int t = (int)(tok % SEQ);
    bf16_t* row = P + tok * PSTRIDE;
    if (c < 256) {
      int isk = c >> 7, hh = (c >> 5) & 3, i = c & 31;
      float cs = rope[(t * 32 + i) * 2], sn = rope[(t * 32 + i) * 2 + 1];
      bf16_t* base = row + isk * 256 + hh * 64;
      float a1 = bf2f(base[i]), a2 = bf2f(base[i + 32]);
      float sc = isk ? 1.0f : 0.125f;
      base[i] = f2bf((a1 * cs - a2 * sn) * sc); base[i + 32] = f2bf((a1 * sn + a2 * cs) * sc);
    } else {
      int cc = c - 256;
      float acc = conv_b[cc] + bf2f(row[1536 + cc]) * conv_w[1024 + cc];
      if (t > 0) acc += bf2f(row[1536 + cc - PSTRIDE]) * conv_w[cc];
      if (t < SEQ - 1) acc += bf2f(row[1536 + cc + PSTRIDE]) * conv_w[2048 + cc];
      float s = siluf_(acc);
      if (cc < 512) QD[tok * 512 + cc] = f2bf(s * 0.08838834764831845f);
      else row[3584 + (cc - 512)] = f2bf(s);
    }
  }
};

struct ScanCD2 {
  const bf16_t* P; const bf16_t* QD; const float* side; const float* fgate_b; bf16_t* O; float* oside;
  DEV void operator()(long gid) const {
    int b = (int)(gid / 2056); int g = (int)(gid % 2056);
    if (g < 1024) {
      int j = g & 127, h = (g >> 7) & 3, dir = (g >> 9) & 1;
      bf16_t* Od = O + (size_t)dir * NTOK * 1024;
      float gamma = 1.0f - exp2f(-(5.0f + 2.0f * (float)h + (float)dir));
      float S[64];
#pragma unroll
      for (int d = 0; d < 64; ++d) S[d] = 0.f;
      for (int s = 0; s < SEQ; ++s) {
        size_t t = (size_t)b * SEQ + (dir ? (SEQ - 1 - s) : s);
        const bf16_t* row = P + t * PSTRIDE;
        const bf16_t* q = row + h * 64; const bf16_t* k = row + 256 + h * 64;
        float v = bf2f(row[512 + h * 128 + j]);
        float o = 0.f;
#pragma unroll
        for (int d = 0; d < 64; ++d) { S[d] = gamma * S[d] + bf2f(k[d]) * v; o += bf2f(q[d]) * S[d]; }
        Od[t * 1024 + h * 128 + j] = f2bf(o);
      }
    } else {
      g -= 1024;
      int j = g % 129, h = (g / 129) & 3, dir = g / (129 * 4);
      bf16_t* Od = O + (size_t)dir * NTOK * 1024; float* os = oside + (size_t)dir * NTOK * 8;
      float fb = fgate_b[dir * 4 + h];
      float S[128];
#pragma unroll
      for (int d = 0; d < 128; ++d) S[d] = 0.f;
      float m = 0.f;
      for (int s = 0; s < SEQ; ++s) {
        size_t t = (size_t)b * SEQ + (dir ? (SEQ - 1 - s) : s);
        const bf16_t* row = P + t * PSTRIDE;
        const bf16_t* q = QD + t * 512 + h * 128; const bf16_t* k = row + 3584 + h * 128;
        float v = (j < 128) ? bf2f(row[2560 + h * 128 + j]) : 1.0f;
        float li = side[t * 32 + dir * 8 + h];
        float lf = logsigmoidf_(side[t * 32 + dir * 8 + 4 + h] + fb);
        float mn = fmaxf(lf + m, li);
        float fs = expf(lf + m - mn), is = expf(li - mn) * v;
        m = mn;
        float o = 0.f;
#pragma unroll
        for (int d = 0; d < 128; ++d) { S[d] = fs * S[d] + is * bf2f(k[d]); o += bf2f(q[d]) * S[d]; }
        if (j < 128) Od[t * 1024 + 512 + h * 128 + j] = f2bf(o);
        else { os[t * 8 + h * 2] = o; os[t * 8 + h * 2 + 1] = m; }
      }
    }
  }
};
#ifndef CPU_EMU
namespace pg8 {
#define PG8_LAS __attribute__((address_space(3)))
typedef short bf16x8 __attribute__((ext_vector_type(8)));
typedef float f32x4 __attribute__((ext_vector_type(4)));
typedef unsigned u32x4 __attribute__((ext_vector_type(4)));
typedef unsigned u32x2 __attribute__((ext_vector_type(2)));
constexpr int BM = 256, BK = 64, HALF = 128, HTB = HALF * BK * 2, STAGE_BYTES = 8 * HTB, NXCD = 8, WGM = 8, GK = 1024;

__device__ __forceinline__ int lds_byte(int r, int c) { const int st = (r >> 4) * 2 + (c >> 5), rr = r & 15, cc = c & 31, ob = rr * 64 + cc * 2; return st * 1024 + (ob ^ (((ob >> 9) & 1) << 5)); }
__device__ __forceinline__ void stage_rc(int b, int& R, int& C) { const int st = b / 1024, sb = b % 1024, swz = sb ^ (((sb >> 9) & 1) << 5); R = (st >> 1) * 16 + swz / 64; C = (st & 1) * 32 + (swz % 64) / 2; }
__device__ __forceinline__ int perm32(int rho) { const int n = rho >> 4, i = rho & 15; return 8 * (i >> 2) + 4 * n + (i & 3); }
__device__ __forceinline__ unsigned cvt_pk_bf16(float lo, float hi) { unsigned r; asm volatile("v_cvt_pk_bf16_f32 %0, %1, %2" : "=v"(r) : "v"(lo), "v"(hi)); return r; }

struct Unit { int pm, pn, e, row0; };

struct StaticOrder {
  int nM, nN, nwg, G, c;
  __device__ void init(int M, int N, int G_, int c_) { nM = M / BM; nN = N / BM; nwg = nM * nN; G = G_; c = c_; }
  __device__ bool next(int i, Unit& u) const {
    const long L = (long)i * G + c; if (L >= nwg) return false;
    int wgid = (int)L; { const int q = nwg / NXCD, r = nwg % NXCD, xcd = wgid % NXCD, off = wgid / NXCD; wgid = (xcd < r ? xcd * (q + 1) : r * (q + 1) + (xcd - r) * q) + off; }
    const int nig = WGM * nN, gid = wgid / nig, fm = gid * WGM, gsz = (nM - fm) < WGM ? (nM - fm) : WGM;
    u.pm = fm + ((wgid % nig) % gsz); u.pn = (wgid % nig) / gsz; u.e = 0; u.row0 = u.pm * BM; return true;
  }
};

template <class Prob>
__device__ __forceinline__ void gemm_phase(PG8_LAS unsigned char* lds, const Prob& S, int wv) {
  int wv_ = wv; asm volatile("" : "+s"(wv_));
  int l_; asm volatile("v_mbcnt_lo_u32_b32 %0, -1, 0\n\tv_mbcnt_hi_u32_b32 %0, -1, %0" : "=v"(l_));
  int tid_ = wv_ * 64 + l_;
  const int tid = tid_, wid = __builtin_amdgcn_readfirstlane(tid >> 6), lane = tid & 63, wr = wid >> 2, wc = wid & 3, fr = lane & 15, fq = lane >> 4;
  constexpr int K = GK, nt = K / BK;
  int sR[2], sC[2]; unsigned voffB[2];
#pragma unroll
  for (int i = 0; i < 2; ++i) { int R, C; stage_rc(tid * 16 + i * 8192, R, C); sR[i] = R; sC[i] = C; const int Rb = Prob::PERM ? ((R & ~31) + perm32(R & 31)) : R; voffB[i] = (unsigned)(Rb * K + C) * 2u; }
  const size_t kstep = (size_t)(BK * 2);
  const size_t hstep = (size_t)HALF * K * 2;
  const unsigned ldsw = (unsigned)wid * 1024u;
  const int aoff = lds_byte(wr * 64 + fr, fq * 8), boff = lds_byte(wc * 32 + fr, fq * 8);
#define PG8_SA(b, h) (((b) * 2 + (h)) * HTB)
#define PG8_SB(b, h) ((4 + (b) * 2 + (h)) * HTB)
#define PG8_STAGE(bufoff, gbase, voff) do { _Pragma("unroll") for (int _i = 0; _i < 2; ++_i) \
    __builtin_amdgcn_global_load_lds((const unsigned*)((const char*)(gbase) + (voff)[_i]), (PG8_LAS unsigned*)(lds + (bufoff) + ldsw + _i * 8192), 16, 0, 0); } while (0)
#define PG8_LDA(dst, b, h) do { _Pragma("unroll") for (int m = 0; m < 4; ++m) _Pragma("unroll") for (int k = 0; k < 2; ++k) dst[m][k] = *(const PG8_LAS bf16x8*)(lds + PG8_SA(b, h) + aoff + m * 2048 + k * 1024); } while (0)
#define PG8_LDB(dst, b, h) do { _Pragma("unroll") for (int n = 0; n < 2; ++n) _Pragma("unroll") for (int k = 0; k < 2; ++k) dst[n][k] = *(const PG8_LAS bf16x8*)(lds + PG8_SB(b, h) + boff + n * 2048 + k * 1024); } while (0)
#define PG8_MMA(ai, bj, At, Bt) do { __builtin_amdgcn_s_setprio(1); _Pragma("unroll") for (int m = 0; m < 4; ++m) _Pragma("unroll") for (int n = 0; n < 2; ++n) _Pragma("unroll") for (int k = 0; k < 2; ++k) \
    acc[ai][bj][m][n] = __builtin_amdgcn_mfma_f32_16x16x32_bf16(Bt[n][k], At[m][k], acc[ai][bj][m][n], 0, 0, 0); __builtin_amdgcn_s_setprio(0); } while (0)
#define PG8_WAIT_V(n) asm volatile("s_waitcnt vmcnt(" #n ")" ::: "memory")
#define PG8_WAIT_L(n) asm volatile("s_waitcnt lgkmcnt(" #n ")" ::: "memory")
#define PG8_BAR __builtin_amdgcn_s_barrier()
#define PG8_SCHED __builtin_amdgcn_sched_barrier(0)
  Unit cur, nxt; int ui = 0;
  if (!S.next(0, cur)) return;
  f32x4 acc[2][2][4][2];
#pragma unroll
  for (int a = 0; a < 2; ++a)
#pragma unroll
    for (int b = 0; b < 2; ++b)
#pragma unroll
      for (int m = 0; m < 4; ++m)
#pragma unroll
        for (int n = 0; n < 2; ++n) acc[a][b][m][n] = (f32x4){0.f, 0.f, 0.f, 0.f};
  bf16x8 At[4][2], B0[2][2], B1[2][2];
  unsigned oc0[2], oc1[2], on0[2], on1[2];
#pragma unroll
  for (int i = 0; i < 2; ++i) { oc0[i] = S.a_off(cur, sR[i]) + (unsigned)sC[i] * 2u; oc1[i] = S.a_off(cur, HALF + sR[i]) + (unsigned)sC[i] * 2u; }
  const char* const Ab = S.a_base();
  const char* cB = S.b_base(cur);
  PG8_STAGE(PG8_SB(0, 0), cB, voffB); PG8_STAGE(PG8_SA(0, 0), Ab, oc0); PG8_STAGE(PG8_SB(0, 1), cB + hstep, voffB); PG8_STAGE(PG8_SA(0, 1), Ab, oc1);
  if (wr == 1) PG8_BAR;
  PG8_WAIT_V(4); PG8_BAR;
  PG8_STAGE(PG8_SB(1, 0), cB + kstep, voffB); PG8_STAGE(PG8_SA(1, 0), Ab + kstep, oc0); PG8_STAGE(PG8_SB(1, 1), cB + hstep + kstep, voffB);
  PG8_WAIT_V(6); PG8_BAR;
  for (;;) {
    const bool has_next = S.next(ui + 1, nxt);
    const char* nB = cB;
    if (has_next) {
      nB = S.b_base(nxt);
      int l2_; asm volatile("v_mbcnt_lo_u32_b32 %0, -1, 0\n\tv_mbcnt_hi_u32_b32 %0, -1, %0" : "=v"(l2_));
      const int tid2 = wid * 64 + l2_;
#pragma unroll
      for (int i = 0; i < 2; ++i) { int R, C; stage_rc(tid2 * 16 + i * 8192, R, C); on0[i] = S.a_off(nxt, R) + (unsigned)C * 2u; on1[i] = S.a_off(nxt, HALF + R) + (unsigned)C * 2u; }
    } else {
#pragma unroll
      for (int i = 0; i < 2; ++i) { on0[i] = oc0[i]; on1[i] = oc1[i]; }
    }
    for (int t = 0; t < nt; t += 2) {
      const bool last = (t == nt - 2);
      const char* a1 = Ab + (size_t)(t + 1) * kstep;
      const char* a2 = last ? Ab : Ab + (size_t)(t + 2) * kstep; const char* b2 = last ? nB : cB + (size_t)(t + 2) * kstep;
      const char* a3 = a2 + kstep; const char* b3 = b2 + kstep;
      unsigned o20[2], o21[2];
#pragma unroll
      for (int i = 0; i < 2; ++i) { o20[i] = last ? on0[i] : oc0[i]; o21[i] = last ? on1[i] : oc1[i]; }
      PG8_LDB(B0, 0, 0); PG8_SCHED; PG8_LDA(At, 0, 0); PG8_STAGE(PG8_SA(1, 1), a1, oc1);
      PG8_WAIT_L(8); PG8_BAR; PG8_WAIT_L(0); PG8_MMA(0, 0, At, B0); PG8_BAR; PG8_SCHED;
      PG8_LDB(B1, 0, 1); PG8_STAGE(PG8_SB(0, 0), b2, voffB);
      PG8_BAR; PG8_WAIT_L(0); PG8_MMA(0, 1, At, B1); PG8_BAR;
      PG8_LDA(At, 0, 1); PG8_STAGE(PG8_SA(0, 0), a2, o20);
      PG8_BAR; PG8_WAIT_L(0); PG8_MMA(1, 0, At, B0); PG8_BAR; PG8_SCHED;
      PG8_STAGE(PG8_SB(0, 1), b2 + hstep, voffB);
      PG8_WAIT_V(6); PG8_BAR; PG8_MMA(1, 1, At, B1); PG8_BAR;
      PG8_LDB(B0, 1, 0); PG8_SCHED; PG8_LDA(At, 1, 0); PG8_STAGE(PG8_SA(0, 1), a2, o21);
      PG8_WAIT_L(8); PG8_BAR; PG8_WAIT_L(0); PG8_MMA(0, 0, At, B0); PG8_BAR; PG8_SCHED;
      PG8_LDB(B1, 1, 1); PG8_STAGE(PG8_SB(1, 0), b3, voffB);
      PG8_BAR; PG8_WAIT_L(0); PG8_MMA(0, 1, At, B1); PG8_BAR;
      PG8_LDA(At, 1, 1); PG8_STAGE(PG8_SA(1, 0), a3, o20);
      PG8_BAR; PG8_WAIT_L(0); PG8_MMA(1, 0, At, B0); PG8_BAR; PG8_SCHED;
      PG8_STAGE(PG8_SB(1, 1), b3 + hstep, voffB);
      PG8_WAIT_V(6); PG8_BAR; PG8_MMA(1, 1, At, B1); PG8_BAR;
    }
    { int l3_; asm volatile("v_mbcnt_lo_u32_b32 %0, -1, 0\n\tv_mbcnt_hi_u32_b32 %0, -1, %0" : "=v"(l3_));
      S.epi(acc, cur, wr, wc, l3_ & 15, l3_ >> 4); }
    if (!has_next) break;
#pragma unroll
    for (int a = 0; a < 2; ++a)
#pragma unroll
      for (int b = 0; b < 2; ++b)
#pragma unroll
        for (int m = 0; m < 4; ++m)
#pragma unroll
          for (int n = 0; n < 2; ++n) acc[a][b][m][n] = (f32x4){0.f, 0.f, 0.f, 0.f};
    cur = nxt; cB = nB; ++ui;
#pragma unroll
    for (int i = 0; i < 2; ++i) { oc0[i] = on0[i]; oc1[i] = on1[i]; }
  }
  PG8_WAIT_V(0);
  if (wr == 0) PG8_BAR;
  PG8_BAR;
#undef PG8_SA
#undef PG8_SB
#undef PG8_STAGE
#undef PG8_LDA
#undef PG8_LDB
#undef PG8_MMA
#undef PG8_WAIT_V
#undef PG8_WAIT_L
#undef PG8_BAR
#undef PG8_SCHED
}
}
#endif
#ifndef CPU_EMU
#include <hip/hip_cooperative_groups.h>
namespace cg = cooperative_groups;
#define LAS __attribute__((address_space(3)))
#define NTHREADS 512
#define LDS_BYTES (128 * 1024 + 2048)
typedef float f32x4 __attribute__((ext_vector_type(4)));
typedef short bf16x8 __attribute__((ext_vector_type(8)));
typedef unsigned u32x4 __attribute__((ext_vector_type(4)));
typedef unsigned u32x2 __attribute__((ext_vector_type(2)));

struct Ctx { int tid, lane, wid, G, bid; unsigned char* lds; };
__device__ __forceinline__ int lane_id() { int l; asm volatile("v_mbcnt_lo_u32_b32 %0, -1, 0\n\tv_mbcnt_hi_u32_b32 %0, -1, %0" : "=v"(l)); return l; }
__device__ __forceinline__ int opaque_tid(int wv) { int w = wv; asm volatile("" : "+s"(w)); int t = w * 64 + lane_id(); asm volatile("" : "+v"(t)); return t; }
__device__ __forceinline__ Ctx make_ctx(unsigned char* lds, int wv) { Ctx c; c.tid = opaque_tid(wv); c.lane = c.tid & 63; c.wid = __builtin_amdgcn_readfirstlane(c.tid >> 6); c.G = gridDim.x; c.bid = blockIdx.x; c.lds = lds; return c; }

__device__ __forceinline__ float wave_sum(float v) {
#pragma unroll
  for (int o = 32; o > 0; o >>= 1) v += __shfl_xor(v, o);
  return v;
}
__device__ __forceinline__ unsigned pk2(float a, float b) { return (unsigned)f2bf(a) | ((unsigned)f2bf(b) << 16); }
__device__ __forceinline__ void unpack8(u32x4 w, float* f) {
  f[0] = __uint_as_float(w.x << 16); f[1] = __uint_as_float(w.x & 0xffff0000u); f[2] = __uint_as_float(w.y << 16); f[3] = __uint_as_float(w.y & 0xffff0000u);
  f[4] = __uint_as_float(w.z << 16); f[5] = __uint_as_float(w.z & 0xffff0000u); f[6] = __uint_as_float(w.w << 16); f[7] = __uint_as_float(w.w & 0xffff0000u);
}

__device__ __forceinline__ void transpose_job(const Ctx& c, const float* src, int N, bf16_t* dst, int rs, int ro, int tile0, int tile_stride) {
  float* t = (float*)c.lds;
  const int ntn = (N + 63) / 64, ntiles = ntn * 16;
  for (int tl = tile0; tl < ntiles; tl += tile_stride) {
    const int kt = tl / ntn, nt_ = tl % ntn, k0 = kt * 64, n0 = nt_ * 64;
    __syncthreads();
#pragma unroll
    for (int i = 0; i < 8; ++i) { const int idx = c.tid + i * 512, kk = idx >> 6, nn = idx & 63; t[kk * 65 + nn] = (n0 + nn < N) ? src[(size_t)(k0 + kk) * N + n0 + nn] : 0.f; }
    __syncthreads();
#pragma unroll
    for (int i = 0; i < 4; ++i) { const int idx = c.tid + i * 512, nn = idx >> 5, kp = (idx & 31) * 2;
      if (n0 + nn < N) *(unsigned*)(dst + (size_t)((n0 + nn) * rs + ro) * 1024 + k0 + kp) = pk2(t[kp * 65 + nn], t[(kp + 1) * 65 + nn]); }
  }
  __syncthreads();
}
__device__ __forceinline__ void p0_prologue(unsigned char* lds_, int wv, const Params& p) {
  const Ctx c = make_ctx(lds_, wv);
  unsigned char* ws = p.ws;
  if (c.bid == 0) { ((unsigned*)(ws + WS_CTL))[64 + c.tid] = 0u; }
  if (c.bid == 0 && c.tid == 0) ((unsigned*)(ws + WS_CTL))[1024] = 0u;
  { const float* x = p.in[I_X]; bf16_t* hb = (bf16_t*)(ws + WS_HB);
    for (size_t i = (size_t)c.bid * NTHREADS + c.tid; i < (size_t)NTOK * 1024 / 8; i += (size_t)c.G * NTHREADS) {
      const f32x4 a = *(const f32x4*)(x + i * 8), b = *(const f32x4*)(x + i * 8 + 4);
      u32x4 w; w.x = pk2(a[0], a[1]); w.y = pk2(a[2], a[3]); w.z = pk2(b[0], b[1]); w.w = pk2(b[2], b[3]);
      *(u32x4*)(hb + i * 8) = w; } }
  transpose_job(c, p.in[I_AB_W_IN], P_AB, (bf16_t*)(ws + WS_WIN_AB), 1, 0, c.bid, c.G);
  transpose_job(c, p.in[I_CD_W_IN], P_CD, (bf16_t*)(ws + WS_WIN_CD), 1, 0, c.bid, c.G);
  transpose_job(c, p.in[I_AB_W_OUT], 1024, (bf16_t*)(ws + WS_WOUT_AB), 1, 0, c.bid, c.G);
  transpose_job(c, p.in[I_CD_W_OUT], 1024, (bf16_t*)(ws + WS_WOUT_CD), 1, 0, c.bid, c.G);
  { float* rope = (float*)(ws + WS_ROPE);
    for (int i = c.bid * NTHREADS + c.tid; i < SEQ * 32; i += c.G * NTHREADS) { const int t = i >> 5, f = i & 31;
      const float freq = powf(10000.0f, -(float)f / 32.0f); const float ang = (float)t * freq; rope[i * 2] = cosf(ang); rope[i * 2 + 1] = sinf(ang); }
    if (c.bid == 1) { const float* hl = p.in[I_HGRN_LB]; float* lb = (float*)(ws + WS_LB);
      const int cc = c.tid; const float a0 = hl[cc], a1 = hl[512 + cc], a2 = hl[1024 + cc]; const float mx = fmaxf(a0, fmaxf(a1, a2));
      const float e0 = expf(a0 - mx), e1 = expf(a1 - mx), e2 = expf(a2 - mx); lb[cc] = e0 / (e0 + e1 + e2); } }
}
__device__ __forceinline__ void moe_weight_convert(unsigned char* lds_, int wv, const Params& p, int layer) {
  const Ctx c = make_ctx(lds_, wv);
  bf16_t* w13 = (bf16_t*)(p.ws + WS_WMOE); bf16_t* w2 = w13 + (size_t)NEXP * 2048 * 1024;
  const size_t lo = (size_t)layer * NEXP * 1024 * 1024;
  for (int e = 0; e < NEXP; ++e) {
    const size_t mo = lo + (size_t)e * 1024 * 1024;
    transpose_job(c, p.in[I_MOE_W1] + mo, 1024, w13 + (size_t)e * 2048 * 1024, 2, 0, c.bid, c.G);
    transpose_job(c, p.in[I_MOE_W3] + mo, 1024, w13 + (size_t)e * 2048 * 1024, 2, 1, c.bid, c.G);
    transpose_job(c, p.in[I_MOE_W2] + mo, 1024, w2 + (size_t)e * 1024 * 1024, 1, 0, c.bid, c.G);
  }
}

struct ProbInProj {
  static constexpr bool PERM = true;
  pg8::StaticOrder so; const char* A; const char* Bt; bf16_t* P; const float* bias; const float* lb; int layer;
  __device__ __forceinline__ bool next(int i, pg8::Unit& u) const { return so.next(i, u); }
  __device__ __forceinline__ const char* a_base() const { return A; }
  __device__ __forceinline__ unsigned a_off(const pg8::Unit& u, int r) const { return (unsigned)(u.pm * 256 + r) * 2048u; }
  __device__ __forceinline__ const char* b_base(const pg8::Unit& u) const { return Bt + (size_t)u.pn * 256 * 2048; }
  __device__ __forceinline__ void epi(const f32x4 (&acc)[2][2][4][2], const pg8::Unit& u, int wr, int wc, int fr, int fq) const {
    const int row0 = u.row0 + wr * 64 + fr, colb = u.pn * 256 + wc * 32 + 8 * fq;
    int mode = 0;
    if (layer == 0) { mode = u.pn < 2 ? 1 : (u.pn < 6 ? 2 : (u.pn == 10 ? 3 : 0)); }
#pragma unroll
    for (int bj = 0; bj < 2; ++bj) {
      const int col0 = colb + bj * 128;
      const f32x4 b0 = *(const f32x4*)(bias + col0), b1 = *(const f32x4*)(bias + col0 + 4);
      f32x4 l0 = (f32x4){0.f, 0.f, 0.f, 0.f}, l1 = l0;
      if (mode == 2) { l0 = *(const f32x4*)(lb + ((col0 - 512) & 511)); l1 = *(const f32x4*)(lb + ((col0 - 512) & 511) + 4); }
#pragma unroll
      for (int ai = 0; ai < 2; ++ai)
#pragma unroll
        for (int m = 0; m < 4; ++m) {
          f32x4 v0 = acc[ai][bj][m][0] + b0, v1 = acc[ai][bj][m][1] + b1;
          if (mode == 1) {
#pragma unroll
            for (int j = 0; j < 4; ++j) { v0[j] = siluf_(v0[j]); v1[j] = siluf_(v1[j]); }
          } else if (mode == 2) {
#pragma unroll
            for (int j = 0; j < 4; ++j) { v0[j] = logf(l0[j] + (1.0f - l0[j]) * sigmoidf_(v0[j])); v1[j] = logf(l1[j] + (1.0f - l1[j]) * sigmoidf_(v1[j])); }
          } else if (mode == 3) { v0 *= 0.125f; v1 *= 0.125f; }
          u32x4 w; w.x = pk2(v0[0], v0[1]); w.y = pk2(v0[2], v0[3]); w.z = pk2(v1[0], v1[1]); w.w = pk2(v1[2], v1[3]);
          *(u32x4*)(P + (size_t)(row0 + ai * 128 + m * 16) * PSTRIDE + col0) = w;
        }
    }
  }
};
struct ProbOutProj {
  static constexpr bool PERM = false;
  pg8::StaticOrder so; const char* A; const char* Bt; float* Y;
  __device__ __forceinline__ bool next(int i, pg8::Unit& u) const { return so.next(i, u); }
  __device__ __forceinline__ const char* a_base() const { return A; }
  __device__ __forceinline__ unsigned a_off(const pg8::Unit& u, int r) const { return (unsigned)(u.pm * 256 + r) * 2048u; }
  __device__ __forceinline__ const char* b_base(const pg8::Unit& u) const { return Bt + (size_t)u.pn * 256 * 2048; }
  __device__ __forceinline__ void epi(const f32x4 (&acc)[2][2][4][2], const pg8::Unit& u, int wr, int wc, int fr, int fq) const {
    const int row0 = u.row0 + wr * 64 + fr, col0 = u.pn * 256 + wc * 32 + 4 * fq;
#pragma unroll
    for (int ai = 0; ai < 2; ++ai)
#pragma unroll
      for (int m = 0; m < 4; ++m) { float* rowp = Y + (size_t)(row0 + ai * 128 + m * 16) * 1024 + col0;
#pragma unroll
        for (int bj = 0; bj < 2; ++bj)
#pragma unroll
          for (int n = 0; n < 2; ++n) *(f32x4*)(rowp + bj * 128 + n * 16) = acc[ai][bj][m][n]; }
  }
};
struct MoeOrder {
  const int* cnt; int ntn, G, c;
  __device__ __forceinline__ bool next(int i, pg8::Unit& u) const {
    int L = i * G + c; int pad = 0;
    for (int e = 0; e < NEXP; ++e) { const int n = cnt[e * 16], mt = (n + 255) >> 8, tiles = mt * ntn;
      if (L < tiles) { u.e = e; u.pn = L / mt; u.pm = L % mt; u.row0 = pad + u.pm * 256; return true; }
      L -= tiles; pad += mt * 256; }
    return false;
  }
};
struct ProbMoe1 {
  static constexpr bool PERM = true;
  MoeOrder mo; const char* A; const char* W13; const int* list; bf16_t* H;
  __device__ __forceinline__ bool next(int i, pg8::Unit& u) const { return mo.next(i, u); }
  __device__ __forceinline__ const char* a_base() const { return A; }
  __device__ __forceinline__ unsigned a_off(const pg8::Unit& u, int r) const { const int rr = u.pm * 256 + r; const int tok = rr < mo.cnt[u.e * 16] ? list[u.e * NTOK + rr] : 0; return (unsigned)tok * 2048u; }
  __device__ __forceinline__ const char* b_base(const pg8::Unit& u) const { return W13 + ((size_t)u.e * 2048 + (size_t)u.pn * 256) * 2048; }
  __device__ __forceinline__ void epi(const f32x4 (&acc)[2][2][4][2], const pg8::Unit& u, int wr, int wc, int fr, int fq) const {
    const int row0 = u.row0 + wr * 64 + fr, colb = u.pn * 128 + wc * 16 + 4 * fq;
#pragma unroll
    for (int ai = 0; ai < 2; ++ai)
#pragma unroll
      for (int m = 0; m < 4; ++m)
#pragma unroll
        for (int bj = 0; bj < 2; ++bj) {
          const f32x4 v0 = acc[ai][bj][m][0], v1 = acc[ai][bj][m][1];
          u32x2 w; w.x = pk2(siluf_(v0[0]) * v0[1], siluf_(v0[2]) * v0[3]); w.y = pk2(siluf_(v1[0]) * v1[1], siluf_(v1[2]) * v1[3]);
          *(u32x2*)(H + (size_t)(row0 + ai * 128 + m * 16) * 1024 + colb + bj * 64) = w;
        }
  }
};
struct ProbMoe2 {
  static constexpr bool PERM = true;
  MoeOrder mo; const char* A; const char* W2; bf16_t* Y;
  __device__ __forceinline__ bool next(int i, pg8::Unit& u) const { return mo.next(i, u); }
  __device__ __forceinline__ const char* a_base() const { return A; }
  __device__ __forceinline__ unsigned a_off(const pg8::Unit& u, int r) const { return (unsigned)(u.row0 + r) * 2048u; }
  __device__ __forceinline__ const char* b_base(const pg8::Unit& u) const { return W2 + ((size_t)u.e * 1024 + (size_t)u.pn * 256) * 2048; }
  __device__ __forceinline__ void epi(const f32x4 (&acc)[2][2][4][2], const pg8::Unit& u, int wr, int wc, int fr, int fq) const {
    const int row0 = u.row0 + wr * 64 + fr, colb = u.pn * 256 + wc * 32 + 8 * fq;
#pragma unroll
    for (int ai = 0; ai < 2; ++ai)
#pragma unroll
      for (int m = 0; m < 4; ++m)
#pragma unroll
        for (int bj = 0; bj < 2; ++bj) {
          const f32x4 v0 = acc[ai][bj][m][0], v1 = acc[ai][bj][m][1];
          u32x4 w; w.x = pk2(v0[0], v0[1]); w.y = pk2(v0[2], v0[3]); w.z = pk2(v1[0], v1[1]); w.w = pk2(v1[2], v1[3]);
          *(u32x4*)(Y + (size_t)(row0 + ai * 128 + m * 16) * 1024 + colb + bj * 128) = w;
        }
  }
};

template <int NS>
__device__ __forceinline__ void side_phase(unsigned char* lds_, int wv, const Params& p, int layer) {
  const Ctx c = make_ctx(lds_, wv);
  const bf16_t* hb = (const bf16_t*)(p.ws + WS_HB);
  const bf16_t* wt = (const bf16_t*)(p.ws + (layer == 0 ? WS_WIN_AB : WS_WIN_CD)) + (size_t)(layer == 0 ? PM_AB : PM_CD) * 1024;
  const float* bias = p.in[layer == 0 ? I_AB_B_IN : I_CD_B_IN] + (layer == 0 ? PM_AB : PM_CD);
  float* side = (float*)(p.ws + WS_SIDE);
  float* tl = (float*)c.lds + c.wid * (16 * 33);
  const int fr = c.lane & 15, fq = c.lane >> 4;
  for (int g = c.bid * 8 + c.wid; g < NTOK / 16; g += c.G * 8) {
    const int r0 = g * 16;
    f32x4 acc0 = (f32x4){0.f, 0.f, 0.f, 0.f}, acc1 = acc0;
    const bf16_t* ap = hb + (size_t)(r0 + fr) * 1024 + fq * 8;
    const bf16_t* bp0 = wt + (size_t)fr * 1024 + fq * 8; const bf16_t* bp1 = bp0 + 16 * 1024;
#pragma unroll 4
    for (int k = 0; k < 1024; k += 32) {
      const bf16x8 a = *(const bf16x8*)(ap + k), b0 = *(const bf16x8*)(bp0 + k);
      acc0 = __builtin_amdgcn_mfma_f32_16x16x32_bf16(a, b0, acc0, 0, 0, 0);
      if (NS == 32) { const bf16x8 b1 = *(const bf16x8*)(bp1 + k); acc1 = __builtin_amdgcn_mfma_f32_16x16x32_bf16(a, b1, acc1, 0, 0, 0); }
    }
#pragma unroll
    for (int j = 0; j < 4; ++j) { const float v0 = acc0[j] + bias[fr]; side[(size_t)(r0 + fq * 4 + j) * 32 + fr] = v0; tl[(fq * 4 + j) * 33 + fr] = v0;
      if (NS == 32) { const float v1 = acc1[j] + bias[16 + fr]; side[(size_t)(r0 + fq * 4 + j) * 32 + 16 + fr] = v1; tl[(fq * 4 + j) * 33 + 16 + fr] = v1; } }
    if (NS == 32) {
      __builtin_amdgcn_s_waitcnt(0xC07F);
      const float* gu = p.in[I_GK_UP]; const float* gb = p.in[I_GK_B]; bf16_t* lfb = (bf16_t*)(p.ws + WS_LFB);
      const int cb = c.lane * 8, dir = cb >> 8, cc = cb & 255;
      float w[16][8];
#pragma unroll
      for (int r = 0; r < 16; ++r)
#pragma unroll
        for (int j = 0; j < 8; ++j) w[r][j] = gu[(dir * 16 + r) * 256 + cc + j];
      float bb[8];
#pragma unroll
      for (int j = 0; j < 8; ++j) bb[j] = gb[dir * 256 + cc + j];
      for (int row = 0; row < 16; ++row) {
        float z[8];
#pragma unroll
        for (int j = 0; j < 8; ++j) z[j] = bb[j];
#pragma unroll
        for (int r = 0; r < 16; ++r) { const float s = tl[row * 33 + dir * 16 + r];
#pragma unroll
          for (int j = 0; j < 8; ++j) z[j] += s * w[r][j]; }
        u32x4 o; o.x = pk2(logsigmoidf_(z[0]) * 0.0625f, logsigmoidf_(z[1]) * 0.0625f); o.y = pk2(logsigmoidf_(z[2]) * 0.0625f, logsigmoidf_(z[3]) * 0.0625f);
        o.z = pk2(logsigmoidf_(z[4]) * 0.0625f, logsigmoidf_(z[5]) * 0.0625f); o.w = pk2(logsigmoidf_(z[6]) * 0.0625f, logsigmoidf_(z[7]) * 0.0625f);
        *(u32x4*)(lfb + (size_t)(r0 + row) * 512 + cb) = o;
      }
    }
  }
}

__device__ __forceinline__ void headnorm_phase(unsigned char* lds_, int wv, const Params& p, int layer) {
  const Ctx c = make_ctx(lds_, wv);
  const bf16_t* P = (const bf16_t*)(p.ws + WS_R1); const bf16_t* O = (const bf16_t*)(p.ws + WS_R2);
  bf16_t* mixed = (bf16_t*)(p.ws + WS_HB);
  const int c0 = c.lane * 16, h8 = c.lane >> 3;
  const float* gain = layer == 0 ? (h8 < 4 ? p.in[I_HGRN_NORM] + c0 : p.in[I_GLA_NORM] + c0 - 512) : (h8 < 4 ? p.in[I_RET_NORM] + c0 : p.in[I_MLSTM_NORM] + c0 - 512);
  const int gcol = layer == 0 ? (h8 < 4 ? 2048 + c0 : 3584 + c0 - 512) : (h8 < 4 ? 1024 + c0 : 3072 + c0 - 512);
  float gn[16];
#pragma unroll
  for (int j = 0; j < 16; ++j) gn[j] = gain[j];
  for (int tok = c.bid * 8 + c.wid; tok < NTOK; tok += c.G * 8) {
    float of[16], ob[16], gt[16];
    { const u32x4* a = (const u32x4*)(O + (size_t)tok * 1024 + c0); unpack8(a[0], of); unpack8(a[1], of + 8);
      const u32x4* b = (const u32x4*)(O + (size_t)(NTOK + tok) * 1024 + c0); unpack8(b[0], ob); unpack8(b[1], ob + 8);
      const u32x4* g = (const u32x4*)(P + (size_t)tok * PSTRIDE + gcol); unpack8(g[0], gt); unpack8(g[1], gt + 8); }
    const float sf = 1.f, sb = 1.f;
    float o[16]; float ss = 0.f;
#pragma unroll
    for (int j = 0; j < 16; ++j) { o[j] = of[j] * sf + ob[j] * sb; ss += o[j] * o[j]; }
    ss += __shfl_xor(ss, 1); ss += __shfl_xor(ss, 2); ss += __shfl_xor(ss, 4);
    const float r = 1.0f / sqrtf(ss * (1.0f / 128.0f) + NORM_EPS_F);
    unsigned w[8];
#pragma unroll
    for (int j = 0; j < 8; ++j) {
      float g0 = gt[2 * j], g1 = gt[2 * j + 1];
      if (layer == 1 && h8 >= 4) { g0 = sigmoidf_(g0); g1 = sigmoidf_(g1); } else { g0 = siluf_(g0); g1 = siluf_(g1); }
      w[j] = pk2(o[2 * j] * r * gn[2 * j] * g0, o[2 * j + 1] * r * gn[2 * j + 1] * g1);
    }
    u32x4* d = (u32x4*)(mixed + (size_t)tok * 1024 + c0);
    d[0] = (u32x4){w[0], w[1], w[2], w[3]}; d[1] = (u32x4){w[4], w[5], w[6], w[7]};
  }
}

__device__ __forceinline__ void ln_phase(unsigned char* lds_, int wv, const Params& p, int layer, int mode) {
  const Ctx c = make_ctx(lds_, wv);
  unsigned char* ws = p.ws;
  const float* hin = (mode == 0 && layer == 0) ? p.in[I_X] : p.out;
  float* hout = p.out; bf16_t* hb = (bf16_t*)(ws + WS_HB);
  const float* g = p.in[mode == 0 ? I_LN_MIX_G : I_LN_FFN_G] + layer * 1024; const float* b = p.in[mode == 0 ? I_LN_MIX_B : I_LN_FFN_B] + layer * 1024;
  unsigned* cnt = (unsigned*)(ws + WS_CTL) + CW_CNT(layer);
  int* list = (int*)(ws + WS_LIST) + (size_t)layer * NEXP * NTOK;
  int* assign = (int*)(ws + WS_ASSIGN); float* gate = (float*)(ws + WS_GATE);
  float* rwT = (float*)c.lds;
  int* lcnt = (int*)(c.lds + 65536); int* lbase = lcnt + 16; int* rec = lcnt + 32; float* recg = (float*)(rec + 4 * 2048);
  int pad[NEXP];
  if (mode == 0) { const float* r = p.in[I_ROUTER_W];
    for (int i = c.tid; i < 1024 * 16; i += NTHREADS) rwT[(i & 15) * 1024 + (i >> 4)] = r[i];
    if (c.tid < 16) lcnt[c.tid] = 0;
    __syncthreads(); }
  else { int acc = 0;
#pragma unroll
    for (int e = 0; e < NEXP; ++e) { pad[e] = acc; acc += (((int)cnt[e * 16] + 255) >> 8) << 8; } }
  const int c0 = c.lane * 4;
  float gv[16], bv[16];
#pragma unroll
  for (int q = 0; q < 4; ++q) { const f32x4 t0 = *(const f32x4*)(g + q * 256 + c0), t1 = *(const f32x4*)(b + q * 256 + c0);
#pragma unroll
    for (int j = 0; j < 4; ++j) { gv[4 * q + j] = t0[j]; bv[4 * q + j] = t1[j]; } }
  int it = 0;
  for (int tok = c.bid * 8 + c.wid; tok < NTOK; tok += c.G * 8, ++it) {
    float v[16];
#pragma unroll
    for (int q = 0; q < 4; ++q) { const f32x4 t = *(const f32x4*)(hin + (size_t)tok * 1024 + q * 256 + c0); v[4 * q] = ALPHA_F * t[0]; v[4 * q + 1] = ALPHA_F * t[1]; v[4 * q + 2] = ALPHA_F * t[2]; v[4 * q + 3] = ALPHA_F * t[3]; }
    if (mode == 0) {
#pragma unroll
      for (int q = 0; q < 4; ++q) { const f32x4 t = *(const f32x4*)((const float*)(ws + WS_R2) + (size_t)tok * 1024 + q * 256 + c0); v[4 * q] += t[0]; v[4 * q + 1] += t[1]; v[4 * q + 2] += t[2]; v[4 * q + 3] += t[3]; }
    } else {
      const int a0 = assign[tok * 4], a1 = assign[tok * 4 + 1], a2 = assign[tok * 4 + 2], a3 = assign[tok * 4 + 3];
      const float g0 = gate[tok * 2], g1 = gate[tok * 2 + 1];
      int p0 = 0, p1 = 0;
#pragma unroll
      for (int e = 0; e < NEXP; ++e) { if (e == a0) p0 = pad[e]; if (e == a2) p1 = pad[e]; }
      p0 += a1; p1 += a3;
      const bf16_t* Y = (const bf16_t*)(ws + WS_R2);
#pragma unroll
      for (int q = 0; q < 4; ++q) { const u32x2 y0 = *(const u32x2*)(Y + (size_t)p0 * 1024 + q * 256 + c0), y1 = *(const u32x2*)(Y + (size_t)p1 * 1024 + q * 256 + c0);
        v[4 * q] += g0 * __uint_as_float(y0.x << 16) + g1 * __uint_as_float(y1.x << 16); v[4 * q + 1] += g0 * __uint_as_float(y0.x & 0xffff0000u) + g1 * __uint_as_float(y1.x & 0xffff0000u);
        v[4 * q + 2] += g0 * __uint_as_float(y0.y << 16) + g1 * __uint_as_float(y1.y << 16); v[4 * q + 3] += g0 * __uint_as_float(y0.y & 0xffff0000u) + g1 * __uint_as_float(y1.y & 0xffff0000u); }
    }
    float s = 0.f;
#pragma unroll
    for (int j = 0; j < 16; ++j) s += v[j];
    const float mean = wave_sum(s) * (1.0f / 1024.0f);
    float qq = 0.f;
#pragma unroll
    for (int j = 0; j < 16; ++j) { v[j] -= mean; qq += v[j] * v[j]; }
    const float r = 1.0f / sqrtf(wave_sum(qq) * (1.0f / 1024.0f) + LN_EPS_F);
#pragma unroll
    for (int j = 0; j < 16; ++j) v[j] = v[j] * r * gv[j] + bv[j];
#pragma unroll
    for (int q = 0; q < 4; ++q) *(f32x4*)(hout + (size_t)tok * 1024 + q * 256 + c0) = (f32x4){v[4 * q], v[4 * q + 1], v[4 * q + 2], v[4 * q + 3]};
    if (!(mode == 1 && layer == 1)) {
#pragma unroll
      for (int q = 0; q < 4; ++q) *(u32x2*)(hb + (size_t)tok * 1024 + q * 256 + c0) = (u32x2){pk2(v[4 * q], v[4 * q + 1]), pk2(v[4 * q + 2], v[4 * q + 3])}; }
    if (mode == 0) {
      float lg[16];
#pragma unroll
      for (int e = 0; e < 16; ++e) { float a = 0.f;
#pragma unroll
        for (int q = 0; q < 4; ++q) { const f32x4 w = *(const f32x4*)(rwT + e * 1024 + q * 256 + c0); a += v[4 * q] * w[0] + v[4 * q + 1] * w[1] + v[4 * q + 2] * w[2] + v[4 * q + 3] * w[3]; }
        lg[e] = a; }
#pragma unroll
      for (int e = 0; e < 16; ++e) lg[e] = wave_sum(lg[e]);
      int eo[2]; float go[2];
      route_from_logits(lg, p.in[I_ROUTER_B], eo, go);
      if (c.lane == 0) {
        const int r1 = atomicAdd(lcnt + eo[0], 1), r2 = atomicAdd(lcnt + eo[1], 1);
        const int ri = it * 8 + c.wid;
        rec[ri * 4] = eo[0]; rec[ri * 4 + 1] = r1; rec[ri * 4 + 2] = eo[1]; rec[ri * 4 + 3] = r2; recg[ri * 2] = go[0]; recg[ri * 2 + 1] = go[1];
      }
    }
  }
  if (mode == 0) {
    __syncthreads();
    if (c.tid < 16) lbase[c.tid] = (int)atomicAdd(cnt + c.tid * 16, (unsigned)lcnt[c.tid]);
    __syncthreads();
    const int nrec = ((NTOK + c.G * 8 - 1) / (c.G * 8)) * 8;
    for (int ri = c.tid; ri < nrec; ri += NTHREADS) {
      const int tok = c.bid * 8 + (ri & 7) + (ri >> 3) * c.G * 8;
      if (tok < NTOK) {
        const int e1 = rec[ri * 4], e2 = rec[ri * 4 + 2]; const int r1 = rec[ri * 4 + 1] + lbase[e1], r2 = rec[ri * 4 + 3] + lbase[e2];
        list[e1 * NTOK + r1] = tok; list[e2 * NTOK + r2] = tok;
        assign[tok * 4] = e1; assign[tok * 4 + 1] = r1; assign[tok * 4 + 2] = e2; assign[tok * 4 + 3] = r2;
        gate[tok * 2] = recg[ri * 2]; gate[tok * 2 + 1] = recg[ri * 2 + 1];
      }
    }
  }
  __syncthreads();
}
#endif
#ifndef CPU_EMU
namespace scan {
typedef short bf16x8 __attribute__((ext_vector_type(8)));
typedef float f32x4 __attribute__((ext_vector_type(4)));
typedef unsigned u32x4 __attribute__((ext_vector_type(4)));
typedef unsigned u32x2 __attribute__((ext_vector_type(2)));
enum { MIX_A = 0, MIX_B = 1, MIX_C = 2, MIX_D = 3 };
constexpr int LD_T = 144;
constexpr int OFF_QS = 0, OFF_KS = 17408, OFF_QI = 34816, OFF_KT = 52224, OFF_VT = 70656, OFF_SC = 77568, OFF_ST = 86784, OFF_DEC = 99840, OFF_EM = 100352, OFF_DEN = 100608, OFF_CW = 100864, SCAN_LDS = 104960;

__device__ __forceinline__ float incl_scan_add(float x) {
  x += __builtin_bit_cast(float, __builtin_amdgcn_update_dpp(0, __builtin_bit_cast(int, x), 0x111, 0xf, 0xf, false));
  x += __builtin_bit_cast(float, __builtin_amdgcn_update_dpp(0, __builtin_bit_cast(int, x), 0x112, 0xf, 0xf, false));
  x += __builtin_bit_cast(float, __builtin_amdgcn_update_dpp(0, __builtin_bit_cast(int, x), 0x114, 0xf, 0xf, false));
  x += __builtin_bit_cast(float, __builtin_amdgcn_update_dpp(0, __builtin_bit_cast(int, x), 0x118, 0xf, 0xf, false));
  x += __builtin_bit_cast(float, __builtin_amdgcn_update_dpp(0, __builtin_bit_cast(int, x), 0x142, 0xa, 0xf, false));
  x += __builtin_bit_cast(float, __builtin_amdgcn_update_dpp(0, __builtin_bit_cast(int, x), 0x143, 0xc, 0xf, false));
  return x;
}
__device__ __forceinline__ float incl_scan_max(float x) {
  const int ninf = (int)0xff800000u;
  x = fmaxf(x, __builtin_bit_cast(float, __builtin_amdgcn_update_dpp(ninf, __builtin_bit_cast(int, x), 0x111, 0xf, 0xf, false)));
  x = fmaxf(x, __builtin_bit_cast(float, __builtin_amdgcn_update_dpp(ninf, __builtin_bit_cast(int, x), 0x112, 0xf, 0xf, false)));
  x = fmaxf(x, __builtin_bit_cast(float, __builtin_amdgcn_update_dpp(ninf, __builtin_bit_cast(int, x), 0x114, 0xf, 0xf, false)));
  x = fmaxf(x, __builtin_bit_cast(float, __builtin_amdgcn_update_dpp(ninf, __builtin_bit_cast(int, x), 0x118, 0xf, 0xf, false)));
  x = fmaxf(x, __builtin_bit_cast(float, __builtin_amdgcn_update_dpp(ninf, __builtin_bit_cast(int, x), 0x142, 0xa, 0xf, false)));
  x = fmaxf(x, __builtin_bit_cast(float, __builtin_amdgcn_update_dpp(ninf, __builtin_bit_cast(int, x), 0x143, 0xc, 0xf, false)));
  return x;
}
__device__ __forceinline__ float rdlane(float x, int l) { return __builtin_bit_cast(float, __builtin_amdgcn_readlane(__builtin_bit_cast(int, x), l)); }
__device__ __forceinline__ bf16x8 ldfrag(const unsigned char* base, int ld, int row, int kbyte) { return *(const bf16x8*)(base + row * ld + kbyte); }
__device__ __forceinline__ unsigned pk(float a, float b) { return (unsigned)f2bf(a) | ((unsigned)f2bf(b) << 16); }
__device__ __forceinline__ float lo16(unsigned w) { return __uint_as_float(w << 16); }
__device__ __forceinline__ float hi16(unsigned w) { return __uint_as_float(w & 0xffff0000u); }

struct Raw { u32x4 a0, a1, b0, b1; f32x4 r0, r1; u32x2 v; float s0, s1; };

template <int MIXER>
__device__ __forceinline__ void scan_item(unsigned char* lds, int wv, const Params& p, int b, int h, int dir, int vs) {
  constexpr int DK = (MIXER == MIX_A || MIXER == MIX_D) ? 128 : 64;
  constexpr int NC = DK / 8;
  constexpr int LD_D = DK * 2 + 16;
  constexpr int NVT = MIXER == MIX_D ? 3 : 2;
  constexpr int NKD = DK / 32;
  const int tid = opaque_tid(wv), lane0 = tid & 63, wid = __builtin_amdgcn_readfirstlane(tid >> 6);
  unsigned char* ws = p.ws;
  const bf16_t* P = (const bf16_t*)(ws + WS_R1);
  const bf16_t* LFBp = (const bf16_t*)(ws + WS_LFB);
  const float* side = (const float*)(ws + WS_SIDE);
  const float* rope = (const float*)(ws + WS_ROPE);
  bf16_t* O = (bf16_t*)(ws + WS_R2) + (size_t)dir * NTOK * 1024;
  unsigned char* QS = lds + OFF_QS; unsigned char* KS = lds + OFF_KS; unsigned char* QI = lds + OFF_QI; unsigned char* KT = lds + OFF_KT;
  unsigned char* VT = lds + OFF_VT; unsigned char* SC = lds + OFF_SC; unsigned char* ST = lds + OFF_ST;
  float* DEC = (float*)(lds + OFF_DEC); float* EM = (float*)(lds + OFF_EM); float* DEN = (float*)(lds + OFF_DEN);

  int qcol, kcol, lfcol, vcol, ocol;
  if (MIXER == MIX_A) { qcol = h * 128; kcol = 0; lfcol = 512 + dir * 512 + h * 128; vcol = 1536 + h * 128 + vs * 32; ocol = h * 128 + vs * 32; }
  else if (MIXER == MIX_B) { qcol = 2560 + h * 64; kcol = 2816 + h * 64; lfcol = dir * 256 + h * 64; vcol = 3072 + h * 128 + vs * 32; ocol = 512 + h * 128 + vs * 32; }
  else if (MIXER == MIX_C) { qcol = h * 64; kcol = 256 + h * 64; lfcol = 0; vcol = 512 + h * 128 + vs * 32; ocol = h * 128 + vs * 32; }
  else { qcol = h * 128  ; kcol = 3584 + h * 128  ; lfcol = 0; vcol = 2560 + h * 128 + vs * 32; ocol = 512 + h * 128 + vs * 32; }
  const int c0 = (MIXER == MIX_C) ? wid * 4 : wid * NC;
  const float lgam = (MIXER == MIX_C) ? log1pf(-exp2f(-(5.0f + 2.0f * (float)h + (float)dir))) : 0.f;
  const float fgb = (MIXER == MIX_D) ? p.in[I_FGATE_B][dir * 4 + h] : 0.f;
  for (int i = tid; i < 48 * LD_D / 4; i += NTHREADS) ((unsigned*)ST)[i] = 0u;
  if (MIXER == MIX_D) {
    for (int i = tid; i < 16 * 64; i += NTHREADS) { const int r = 32 + (i >> 6), j = i & 63; *(bf16_t*)(VT + r * LD_T + j * 2) = (r == 32) ? (bf16_t)0x3F80 : (bf16_t)0; }
  }
  f32x4 sacc[NVT == 3 ? 3 : 2];
#pragma unroll
  for (int i = 0; i < (NVT == 3 ? 3 : 2); ++i) sacc[i] = (f32x4){0.f, 0.f, 0.f, 0.f};
  float m_st = 0.f;
  const size_t tokbase = (size_t)b * SEQ;
  const int sgn = dir ? -1 : 1;
  __syncthreads();

  Raw R;
#define SCAN_LOAD(n_) do { \
    int ln_ = lane0; asm volatile("" : "+v"(ln_)); \
    const int t_ = dir ? (SEQ - 1 - ((n_) * 64 + ln_)) : ((n_) * 64 + ln_); \
    const bf16_t* row_ = P + (tokbase + t_) * PSTRIDE; \
    if (MIXER == MIX_A) { const u32x4* qp_ = (const u32x4*)(row_ + qcol + c0); const u32x4* lp_ = (const u32x4*)(row_ + lfcol + c0); R.a0 = qp_[0]; R.a1 = qp_[1]; R.b0 = lp_[0]; R.b1 = lp_[1]; } \
    else if (MIXER == MIX_B) { R.a0 = *(const u32x4*)(row_ + qcol + c0); R.a1 = *(const u32x4*)(row_ + kcol + c0); R.b0 = *(const u32x4*)(LFBp + (tokbase + t_) * 512 + lfcol + c0); } \
    else if (MIXER == MIX_C) { const u32x2 qa_ = *(const u32x2*)(row_ + qcol + c0), qb_ = *(const u32x2*)(row_ + qcol + 32 + c0), ka_ = *(const u32x2*)(row_ + kcol + c0), kb_ = *(const u32x2*)(row_ + kcol + 32 + c0); \
      R.a0 = (u32x4){qa_.x, qa_.y, qb_.x, qb_.y}; R.a1 = (u32x4){ka_.x, ka_.y, kb_.x, kb_.y}; \
      R.r0 = *(const f32x4*)(rope + ((size_t)t_ * 32 + c0) * 2); R.r1 = *(const f32x4*)(rope + ((size_t)t_ * 32 + c0) * 2 + 4); } \
    else { const u32x4* qp_ = (const u32x4*)(LFBp + (tokbase + t_) * 512 + qcol + c0); const u32x4* kp_ = (const u32x4*)(row_ + kcol + c0); R.a0 = qp_[0]; R.a1 = qp_[1]; R.b0 = kp_[0]; R.b1 = kp_[1]; \
      R.s0 = side[(tokbase + t_) * 32 + dir * 8 + h]; R.s1 = side[(tokbase + t_) * 32 + dir * 8 + 4 + h]; } \
    R.v = *(const u32x2*)(row_ + vcol + wid * 4); } while (0)

  SCAN_LOAD(0);
  for (int n = 0; n < SEQ / 64; ++n) {
    int lane = lane0; asm volatile("" : "+v"(lane));
    const int fr = lane & 15, fq = lane >> 4;
    float q[NC], k[NC], g[NC];
    const u32x2 vv = R.v;
    float g_li = 0.f, g_lf = 0.f;
    if (MIXER == MIX_A) {
      const unsigned qw[8] = {R.a0.x, R.a0.y, R.a0.z, R.a0.w, R.a1.x, R.a1.y, R.a1.z, R.a1.w}, lw[8] = {R.b0.x, R.b0.y, R.b0.z, R.b0.w, R.b1.x, R.b1.y, R.b1.z, R.b1.w};
#pragma unroll
      for (int c = 0; c < 8; ++c) { q[2 * c] = lo16(qw[c]); q[2 * c + 1] = hi16(qw[c]); g[2 * c] = lo16(lw[c]); g[2 * c + 1] = hi16(lw[c]); }
#pragma unroll
      for (int c = 0; c < NC; ++c) k[c] = 1.0f - __expf(g[c]);
    } else if (MIXER == MIX_B) {
      const unsigned qw[4] = {R.a0.x, R.a0.y, R.a0.z, R.a0.w}, kw[4] = {R.a1.x, R.a1.y, R.a1.z, R.a1.w}, lw[4] = {R.b0.x, R.b0.y, R.b0.z, R.b0.w};
#pragma unroll
      for (int c = 0; c < 4; ++c) { q[2 * c] = lo16(qw[c]); q[2 * c + 1] = hi16(qw[c]); k[2 * c] = lo16(kw[c]); k[2 * c + 1] = hi16(kw[c]); g[2 * c] = lo16(lw[c]); g[2 * c + 1] = hi16(lw[c]); }
    } else if (MIXER == MIX_C) {
      const float cs[4] = {R.r0[0], R.r0[2], R.r1[0], R.r1[2]}, sn[4] = {R.r0[1], R.r0[3], R.r1[1], R.r1[3]};
      const float q1[4] = {lo16(R.a0.x), hi16(R.a0.x), lo16(R.a0.y), hi16(R.a0.y)}, q2[4] = {lo16(R.a0.z), hi16(R.a0.z), lo16(R.a0.w), hi16(R.a0.w)};
      const float k1[4] = {lo16(R.a1.x), hi16(R.a1.x), lo16(R.a1.y), hi16(R.a1.y)}, k2[4] = {lo16(R.a1.z), hi16(R.a1.z), lo16(R.a1.w), hi16(R.a1.w)};
#pragma unroll
      for (int c = 0; c < 4; ++c) { q[c] = (q1[c] * cs[c] - q2[c] * sn[c]) * 0.125f; q[4 + c] = (q1[c] * sn[c] + q2[c] * cs[c]) * 0.125f; k[c] = k1[c] * cs[c] - k2[c] * sn[c]; k[4 + c] = k1[c] * sn[c] + k2[c] * cs[c]; }
#pragma unroll
      for (int c = 0; c < NC; ++c) g[c] = (float)(lane + 1) * lgam;
    } else {
      const unsigned qw[8] = {R.a0.x, R.a0.y, R.a0.z, R.a0.w, R.a1.x, R.a1.y, R.a1.z, R.a1.w}, kw[8] = {R.b0.x, R.b0.y, R.b0.z, R.b0.w, R.b1.x, R.b1.y, R.b1.z, R.b1.w};
      g_li = R.s0; g_lf = R.s1;
#pragma unroll
      for (int c = 0; c < 8; ++c) { q[2 * c] = lo16(qw[c]); q[2 * c + 1] = hi16(qw[c]); k[2 * c] = lo16(kw[c]); k[2 * c + 1] = hi16(kw[c]); }
#pragma unroll
      for (int c = 0; c < NC; ++c) g[c] = 0.f;
    }
    if (n + 1 < SEQ / 64) SCAN_LOAD(n + 1);

    float s_qs[NC], s_ks[NC], s_qi[NC], s_kt[NC];
    if (MIXER != MIX_D) {
#pragma unroll
      for (int c = 0; c < NC; ++c) {
        const float gc = (MIXER == MIX_C) ? g[c] : incl_scan_add(g[c]);
        const float gref = rdlane(gc, 31), glast = rdlane(gc, 63);
        const float a = __expf(gc - gref), ia = __builtin_amdgcn_rcpf(a);
        s_qs[c] = a; s_ks[c] = ia; s_qi[c] = a * __expf(gref); s_kt[c] = ia * __expf(glast - gref);
        if (lane == 63) DEC[(MIXER == MIX_C) ? (c < 4 ? c0 + c : 32 + c0 + c - 4) : c0 + c] = __expf(glast);
      }
    } else {
      const float li = g_li;
      const float lf = logsigmoidf_(g_lf + fgb);
      const float bc = incl_scan_add(lf);
      const float u = li - bc;
      const float pm = incl_scan_max(u);
      const float cmax = rdlane(pm, 63), blast = rdlane(bc, 63);
      const float a_i = bc + m_st, m_i = fmaxf(a_i, bc + pm);
      const float alpha = __expf(bc - m_i + cmax), beta = __expf(u - cmax), sint = __expf(a_i - m_i);
      const float m_new = fmaxf(blast + m_st, blast + cmax);
      const float s_old = __expf(blast + m_st - m_new), wks = __expf(blast + u - m_new);
      m_st = m_new;
#pragma unroll
      for (int c = 0; c < NC; ++c) { s_qs[c] = alpha; s_ks[c] = beta; s_qi[c] = sint; s_kt[c] = wks; }
      if (wid == 0) EM[lane] = __expf(-m_i);
      if (lane == 63) {
#pragma unroll
        for (int c = 0; c < NC; ++c) DEC[c0 + c] = s_old;
      }
    }
    {
      unsigned wq[NC / 2], wk[NC / 2], wi[NC / 2];
#pragma unroll
      for (int c = 0; c < NC / 2; ++c) { wq[c] = pk(q[2 * c] * s_qs[2 * c], q[2 * c + 1] * s_qs[2 * c + 1]); wk[c] = pk(k[2 * c] * s_ks[2 * c], k[2 * c + 1] * s_ks[2 * c + 1]); wi[c] = pk(q[2 * c] * s_qi[2 * c], q[2 * c + 1] * s_qi[2 * c + 1]); }
      if (MIXER == MIX_C) {
        *(u32x2*)(QS + lane * LD_D + c0 * 2) = (u32x2){wq[0], wq[1]}; *(u32x2*)(QS + lane * LD_D + (32 + c0) * 2) = (u32x2){wq[2], wq[3]};
        *(u32x2*)(KS + lane * LD_D + c0 * 2) = (u32x2){wk[0], wk[1]}; *(u32x2*)(KS + lane * LD_D + (32 + c0) * 2) = (u32x2){wk[2], wk[3]};
        *(u32x2*)(QI + lane * LD_D + c0 * 2) = (u32x2){wi[0], wi[1]}; *(u32x2*)(QI + lane * LD_D + (32 + c0) * 2) = (u32x2){wi[2], wi[3]};
      } else {
#pragma unroll
        for (int c = 0; c < NC / 8; ++c) {
          *(u32x4*)(QS + lane * LD_D + (c0 + 8 * c) * 2) = (u32x4){wq[4 * c], wq[4 * c + 1], wq[4 * c + 2], wq[4 * c + 3]};
          *(u32x4*)(KS + lane * LD_D + (c0 + 8 * c) * 2) = (u32x4){wk[4 * c], wk[4 * c + 1], wk[4 * c + 2], wk[4 * c + 3]};
          *(u32x4*)(QI + lane * LD_D + (c0 + 8 * c) * 2) = (u32x4){wi[4 * c], wi[4 * c + 1], wi[4 * c + 2], wi[4 * c + 3]};
        }
      }
#pragma unroll
      for (int c = 0; c < NC; ++c) { const int d = (MIXER == MIX_C) ? (c < 4 ? c0 + c : 32 + c0 + c - 4) : c0 + c; *(bf16_t*)(KT + d * LD_T + lane * 2) = f2bf(k[c] * s_kt[c]); }
      *(bf16_t*)(VT + (wid * 4 + 0) * LD_T + lane * 2) = (bf16_t)(vv.x & 0xffff); *(bf16_t*)(VT + (wid * 4 + 1) * LD_T + lane * 2) = (bf16_t)(vv.x >> 16);
      *(bf16_t*)(VT + (wid * 4 + 2) * LD_T + lane * 2) = (bf16_t)(vv.y & 0xffff); *(bf16_t*)(VT + (wid * 4 + 3) * LD_T + lane * 2) = (bf16_t)(vv.y >> 16);
    }
    __syncthreads();
    {
      const int it = wid & 3;
#pragma unroll
      for (int jj = 0; jj < 2; ++jj) {
        const int jt = 2 * (wid >> 2) + jj;
        if (jt <= it) {
          f32x4 acc = (f32x4){0.f, 0.f, 0.f, 0.f};
#pragma unroll
          for (int ks = 0; ks < NKD; ++ks) acc = __builtin_amdgcn_mfma_f32_16x16x32_bf16(ldfrag(KS, LD_D, jt * 16 + fr, ks * 64 + fq * 16), ldfrag(QS, LD_D, it * 16 + fr, ks * 64 + fq * 16), acc, 0, 0, 0);
          const int i = it * 16 + fr, j0 = jt * 16 + fq * 4;
          const float v0 = (j0 + 0 <= i) ? acc[0] : 0.f, v1 = (j0 + 1 <= i) ? acc[1] : 0.f, v2 = (j0 + 2 <= i) ? acc[2] : 0.f, v3 = (j0 + 3 <= i) ? acc[3] : 0.f;
          *(u32x2*)(SC + i * LD_T + j0 * 2) = (u32x2){pk(v0, v1), pk(v2, v3)};
        } else {
          const int i = it * 16 + fr, j0 = jt * 16 + fq * 4;
          *(u32x2*)(SC + i * LD_T + j0 * 2) = (u32x2){0u, 0u};
        }
      }
    }
    f32x4 oacc = (f32x4){0.f, 0.f, 0.f, 0.f}, dacc = (f32x4){0.f, 0.f, 0.f, 0.f};
    {
      const int vt = wid >> 2, it = wid & 3;
#pragma unroll
      for (int ks = 0; ks < NKD; ++ks) oacc = __builtin_amdgcn_mfma_f32_16x16x32_bf16(ldfrag(ST, LD_D, vt * 16 + fr, ks * 64 + fq * 16), ldfrag(QI, LD_D, it * 16 + fr, ks * 64 + fq * 16), oacc, 0, 0, 0);
      if (NVT == 3 && wid < 4) {
#pragma unroll
        for (int ks = 0; ks < NKD; ++ks) dacc = __builtin_amdgcn_mfma_f32_16x16x32_bf16(ldfrag(ST, LD_D, 32 + fr, ks * 64 + fq * 16), ldfrag(QI, LD_D, wid * 16 + fr, ks * 64 + fq * 16), dacc, 0, 0, 0);
      }
    }
    __syncthreads();
    {
      const int vt = wid >> 2, it = wid & 3;
#pragma unroll
      for (int ks = 0; ks < 2; ++ks) oacc = __builtin_amdgcn_mfma_f32_16x16x32_bf16(ldfrag(VT, LD_T, vt * 16 + fr, ks * 64 + fq * 16), ldfrag(SC, LD_T, it * 16 + fr, ks * 64 + fq * 16), oacc, 0, 0, 0);
      if (NVT == 3) {
        if (wid < 4) {
#pragma unroll
          for (int ks = 0; ks < 2; ++ks) dacc = __builtin_amdgcn_mfma_f32_16x16x32_bf16(ldfrag(VT, LD_T, 32 + fr, ks * 64 + fq * 16), ldfrag(SC, LD_T, wid * 16 + fr, ks * 64 + fq * 16), dacc, 0, 0, 0);
          if (fq == 0) DEN[wid * 16 + fr] = dacc[0];
        }
        __syncthreads();
        const int i = it * 16 + fr;
        const float dn = 1.0f / fmaxf(fabsf(DEN[i]), EM[i]);
        oacc *= dn;
      }
      const int i = it * 16 + fr;
      const int ti = dir ? (SEQ - 1 - (n * 64 + i)) : (n * 64 + i);
      *(u32x2*)(O + (tokbase + ti) * 1024 + ocol + vt * 16 + fq * 4) = (u32x2){pk(oacc[0], oacc[1]), pk(oacc[2], oacc[3])};
    }
    {
      constexpr int NST = (DK == 128) ? NVT : 1;
#pragma unroll
      for (int s = 0; s < NST; ++s) {
        const int dt = (DK == 128) ? wid : (wid & 3), vt = (DK == 128) ? s : (wid >> 2);
        const f32x4 dc = *(const f32x4*)(DEC + dt * 16 + fq * 4);
        f32x4 acc = sacc[s] * dc;
#pragma unroll
        for (int ks = 0; ks < 2; ++ks) acc = __builtin_amdgcn_mfma_f32_16x16x32_bf16(ldfrag(KT, LD_T, dt * 16 + fr, ks * 64 + fq * 16), ldfrag(VT, LD_T, vt * 16 + fr, ks * 64 + fq * 16), acc, 0, 0, 0);
        sacc[s] = acc;
        *(u32x2*)(ST + (vt * 16 + fr) * LD_D + (dt * 16 + fq * 4) * 2) = (u32x2){pk(acc[0], acc[1]), pk(acc[2], acc[3])};
      }
    }
    __syncthreads();
  }
}

template <int MIXER>
__device__ __forceinline__ void scan_dispatch(unsigned char* lds, int wv, const Params& p, int id) {
  const int vs = id & 3, dir = (id >> 2) & 1, h = (id >> 3) & 3, b = id >> 5;
  scan_item<MIXER>(lds, wv, p, b, h, dir, vs);
}
}

__device__ __forceinline__ void convd_phase(unsigned char* lds_, int wv, const Params& p) {
  const Ctx c = make_ctx(lds_, wv);
  bf16_t* P = (bf16_t*)(p.ws + WS_R1); bf16_t* QD = (bf16_t*)(p.ws + WS_LFB);
  const float* cw = p.in[I_CONV_W]; const float* cb = p.in[I_CONV_B];
  const int ch = c.lane * 16;
  float w0[16], w1[16], w2[16], bb[16];
#pragma unroll
  for (int j = 0; j < 16; ++j) { w0[j] = cw[ch + j]; w1[j] = cw[1024 + ch + j]; w2[j] = cw[2048 + ch + j]; bb[j] = cb[ch + j]; }
  for (int tok = c.bid * 8 + c.wid; tok < NTOK; tok += c.G * 8) {
    const int t = tok % SEQ;
    const bf16_t* row = P + (size_t)tok * PSTRIDE + 1536 + ch;
    float x0[16], x1[16], x2[16];
    { const u32x4* r1 = (const u32x4*)row; unpack8(r1[0], x1); unpack8(r1[1], x1 + 8); }
    if (t > 0) { const u32x4* r0 = (const u32x4*)(row - PSTRIDE); unpack8(r0[0], x0); unpack8(r0[1], x0 + 8); }
    else {
#pragma unroll
      for (int j = 0; j < 16; ++j) x0[j] = 0.f; }
    if (t < SEQ - 1) { const u32x4* r2 = (const u32x4*)(row + PSTRIDE); unpack8(r2[0], x2); unpack8(r2[1], x2 + 8); }
    else {
#pragma unroll
      for (int j = 0; j < 16; ++j) x2[j] = 0.f; }
    const float sc = ch < 512 ? 0.08838834764831845f : 1.0f;
    unsigned w[8];
#pragma unroll
    for (int j = 0; j < 8; ++j) {
      const float a0 = bb[2 * j] + w0[2 * j] * x0[2 * j] + w1[2 * j] * x1[2 * j] + w2[2 * j] * x2[2 * j];
      const float a1 = bb[2 * j + 1] + w0[2 * j + 1] * x0[2 * j + 1] + w1[2 * j + 1] * x1[2 * j + 1] + w2[2 * j + 1] * x2[2 * j + 1];
      w[j] = pk2(siluf_(a0) * sc, siluf_(a1) * sc);
    }
    u32x4* d = (ch < 512) ? (u32x4*)(QD + (size_t)tok * 512 + ch) : (u32x4*)(P + (size_t)tok * PSTRIDE + 3584 + (ch - 512));
    d[0] = (u32x4){w[0], w[1], w[2], w[3]}; d[1] = (u32x4){w[4], w[5], w[6], w[7]};
  }
}

__device__ __forceinline__ void scan_phase(unsigned char* lds, int wv, const Params& p, int layer) {
  for (int item = blockIdx.x; item < 256; item += gridDim.x) {
    if (layer == 0) { if (item < 128) scan::scan_dispatch<scan::MIX_A>(lds, wv, p, item); else scan::scan_dispatch<scan::MIX_B>(lds, wv, p, item - 128); }
    else { if (item < 128) scan::scan_dispatch<scan::MIX_D>(lds, wv, p, item); else scan::scan_dispatch<scan::MIX_C>(lds, wv, p, item - 128); }
    __syncthreads();
  }
}
#endif
#ifndef CPU_EMU
__device__ __forceinline__ void grid_bar(unsigned* ctr, unsigned& epoch, unsigned G, int wv) {
  asm volatile("s_waitcnt vmcnt(0)" ::: "memory");
  __syncthreads();
  epoch += G;
  if (wv == 0 && lane_id() == 0) {
    __builtin_amdgcn_fence(__ATOMIC_RELEASE, "agent");
    asm volatile("s_waitcnt vmcnt(0)" ::: "memory");
    __hip_atomic_fetch_add(ctr, 1u, __ATOMIC_RELAXED, __HIP_MEMORY_SCOPE_AGENT);
    unsigned spins = 0;
    while (__hip_atomic_load(ctr, __ATOMIC_RELAXED, __HIP_MEMORY_SCOPE_AGENT) < epoch) { __builtin_amdgcn_s_sleep(2); if (++spins > (1u << 26)) break; }
    __builtin_amdgcn_fence(__ATOMIC_ACQUIRE, "agent");
    asm volatile("s_waitcnt vmcnt(0)" ::: "memory");
  }
  __syncthreads();
}

__global__ void __launch_bounds__(NTHREADS) mk_fwd(Params p) {
  extern __shared__ __attribute__((aligned(16))) unsigned char lds_raw[];
  cg::grid_group grid = cg::this_grid();
  const int G = gridDim.x, bid = blockIdx.x;
  const int wv = __builtin_amdgcn_readfirstlane(threadIdx.x >> 6);
  PG8_LAS unsigned char* lds = (PG8_LAS unsigned char*)lds_raw;
  unsigned char* ws = p.ws;

  p0_prologue(lds_raw, wv, p);
  grid.sync();
  unsigned* bar = (unsigned*)(ws + WS_CTL) + 1024;
  unsigned epoch = 0;
  for (int layer = 0; layer < 2; ++layer) {
    { ProbInProj pr; pr.so.init(NTOK, layer == 0 ? PM_AB : PM_CD, G, bid); pr.A = (const char*)(ws + WS_HB); pr.Bt = (const char*)(ws + (layer == 0 ? WS_WIN_AB : WS_WIN_CD));
      pr.P = (bf16_t*)(ws + WS_R1); pr.bias = p.in[layer == 0 ? I_AB_B_IN : I_CD_B_IN]; pr.lb = (const float*)(ws + WS_LB); pr.layer = layer;
      pg8::gemm_phase(lds, pr, wv);
#if (PROBE_DUP & 1)
      pg8::gemm_phase(lds, pr, wv);
#endif
      if (layer == 0) side_phase<32>(lds_raw, wv, p, 0); else side_phase<16>(lds_raw, wv, p, 1); }
    grid_bar(bar, epoch, (unsigned)G, wv);
    if (layer == 1) { convd_phase(lds_raw, wv, p); grid_bar(bar, epoch, (unsigned)G, wv); }
    scan_phase(lds_raw, wv, p, layer);
#if (PROBE_DUP & 2)
    scan_phase(lds_raw, wv, p, layer);
#endif
    grid_bar(bar, epoch, (unsigned)G, wv);
    headnorm_phase(lds_raw, wv, p, layer);
#if (PROBE_DUP & 8)
    headnorm_phase(lds_raw, wv, p, layer);
#endif
    grid_bar(bar, epoch, (unsigned)G, wv);
    { ProbOutProj pr; pr.so.init(NTOK, 1024, G, bid); pr.A = (const char*)(ws + WS_HB); pr.Bt = (const char*)(ws + (layer == 0 ? WS_WOUT_AB : WS_WOUT_CD)); pr.Y = (float*)(ws + WS_R2);
      pg8::gemm_phase(lds, pr, wv);
#if (PROBE_DUP & 1)
      pg8::gemm_phase(lds, pr, wv);
#endif
      moe_weight_convert(lds_raw, wv, p, layer);
#if (PROBE_DUP & 4)
      moe_weight_convert(lds_raw, wv, p, layer);
#endif
 }
    grid_bar(bar, epoch, (unsigned)G, wv);
    ln_phase(lds_raw, wv, p, layer, 0);
    grid_bar(bar, epoch, (unsigned)G, wv);
    { ProbMoe1 pr; pr.mo.cnt = (const int*)((const unsigned*)(ws + WS_CTL) + CW_CNT(layer)); pr.mo.ntn = 8; pr.mo.G = G; pr.mo.c = bid;
      pr.A = (const char*)(ws + WS_HB); pr.W13 = (const char*)(ws + WS_WMOE); pr.list = (const int*)(ws + WS_LIST) + (size_t)layer * NEXP * NTOK; pr.H = (bf16_t*)(ws + WS_H);
      pg8::gemm_phase(lds, pr, wv);
#if (PROBE_DUP & 1)
      pg8::gemm_phase(lds, pr, wv);
#endif
 }
    grid_bar(bar, epoch, (unsigned)G, wv);
    { ProbMoe2 pr; pr.mo.cnt = (const int*)((const unsigned*)(ws + WS_CTL) + CW_CNT(layer)); pr.mo.ntn = 4; pr.mo.G = G; pr.mo.c = bid;
      pr.A = (const char*)(ws + WS_H); pr.W2 = (const char*)(ws + WS_WMOE) + (size_t)NEXP * 2048 * 1024 * 2; pr.Y = (bf16_t*)(ws + WS_R2);
      pg8::gemm_phase(lds, pr, wv);
#if (PROBE_DUP & 1)
      pg8::gemm_phase(lds, pr, wv);
#endif
 }
    grid_bar(bar, epoch, (unsigned)G, wv);
    ln_phase(lds_raw, wv, p, layer, 1);
    if (layer == 0) grid_bar(bar, epoch, (unsigned)G, wv);
  }
}

extern "C" void kernel_launch(void* const* d_in, const int* in_sizes, int n_in, void* d_out, int out_size, void* d_ws, size_t ws_size, hipStream_t stream) {
  static int grid_blocks = 0;
  if (grid_blocks == 0) {
    if (n_in != N_IN || ws_size < WS_END || out_size != NTOK * 1024) { fprintf(stderr, "kernel_launch: bad shapes: n_in %d ws %zu (need %zu) out %d\n", n_in, ws_size, (size_t)WS_END, out_size); grid_blocks = -1; return; }
    int dev = 0, cus = 0, per_cu = 0;
    hipGetDevice(&dev); hipDeviceGetAttribute(&cus, hipDeviceAttributeMultiprocessorCount, dev);
    if (hipFuncSetAttribute((const void*)mk_fwd, hipFuncAttributeMaxDynamicSharedMemorySize, LDS_BYTES) != hipSuccess) { fprintf(stderr, "kernel_launch: hipFuncSetAttribute failed\n"); grid_blocks = -1; return; }
    if (hipOccupancyMaxActiveBlocksPerMultiprocessor(&per_cu, (const void*)mk_fwd, NTHREADS, LDS_BYTES) != hipSuccess || per_cu < 1) { fprintf(stderr, "kernel_launch: occupancy query failed (%d)\n", per_cu); grid_blocks = -1; return; }
    grid_blocks = cus;
    (void)in_sizes;
  }
  if (grid_blocks < 0) return;
  Params p{};
  for (int i = 0; i < N_IN; ++i) p.in[i] = (const float*)d_in[i];
  p.out = (float*)d_out; p.ws = (unsigned char*)d_ws;
  void* args[] = {&p};
  hipError_t e = hipLaunchCooperativeKernel((const void*)mk_fwd, dim3(grid_blocks), dim3(NTHREADS), args, LDS_BYTES, stream);
  if (e != hipSuccess) fprintf(stderr, "cooperative launch failed: %s (grid %d)\n", hipGetErrorString(e), grid_blocks);
}
#endif
#ifdef CPU_EMU
#include <vector>
void dbg_cmp(const char* name, const float* p, long n);
template <class F> static void run_functor(const F& f, long n) {
#pragma omp parallel for schedule(dynamic, 16)
  for (long g = 0; g < n; ++g) f(g);
}
static void cpu_round_w(const float* src, size_t n, std::vector<float>& dst) { dst.resize(n); for (size_t i = 0; i < n; ++i) dst[i] = bf2f(f2bf(src[i])); }

extern "C" void kernel_launch(void* const* d_in, const int* in_sizes, int n_in, void* d_out, int out_size, void* d_ws, size_t ws_size, hipStream_t) {
  (void)in_sizes; (void)n_in; (void)out_size;
  if (ws_size < WS_END) { printf("ws too small %zu < %zu\n", ws_size, (size_t)WS_END); return; }
  Params p{}; for (int i = 0; i < N_IN; ++i) p.in[i] = (const float*)d_in[i];
  p.out = (float*)d_out; p.ws = (unsigned char*)d_ws;
  unsigned char* ws = p.ws;
  bf16_t* HB = (bf16_t*)(ws + WS_HB); bf16_t* P = (bf16_t*)(ws + WS_R1); bf16_t* LFB = (bf16_t*)(ws + WS_LFB);
  bf16_t* O = (bf16_t*)(ws + WS_R2); float* yf = (float*)(ws + WS_R2); bf16_t* Y = (bf16_t*)(ws + WS_R2); bf16_t* H = (bf16_t*)(ws + WS_H);
  float* side = (float*)(ws + WS_SIDE); float* oside = (float*)(ws + WS_OSIDE); float* rope = (float*)(ws + WS_ROPE); float* lb = (float*)(ws + WS_LB);
  int* assign = (int*)(ws + WS_ASSIGN); float* gate = (float*)(ws + WS_GATE);
  for (size_t i = 0; i < (size_t)NTOK * 1024; ++i) HB[i] = f2bf(p.in[I_X][i]);
  for (int i = 0; i < SEQ * 32; ++i) { int t = i >> 5, f = i & 31; float freq = powf(10000.0f, -(float)f / 32.0f); float ang = (float)t * freq; rope[i * 2] = cosf(ang); rope[i * 2 + 1] = sinf(ang); }
  for (int cc = 0; cc < 512; ++cc) { const float* hl = p.in[I_HGRN_LB]; float a0 = hl[cc], a1 = hl[512 + cc], a2 = hl[1024 + cc]; float mx = fmaxf(a0, fmaxf(a1, a2));
    float e0 = expf(a0 - mx), e1 = expf(a1 - mx), e2 = expf(a2 - mx); lb[cc] = e0 / (e0 + e1 + e2); }
  std::vector<float> wr;
  for (int layer = 0; layer < 2; ++layer) {
    const int PW = layer == 0 ? P_AB : P_CD, PM = layer == 0 ? PM_AB : PM_CD;
    const float* bias = p.in[layer == 0 ? I_AB_B_IN : I_CD_B_IN];
    cpu_round_w(p.in[layer == 0 ? I_AB_W_IN : I_CD_W_IN], (size_t)1024 * PW, wr);
#pragma omp parallel for
    for (long tok = 0; tok < NTOK; ++tok) {
      std::vector<float> acc(PW, 0.f);
      for (int k = 0; k < 1024; ++k) { float a = bf2f(HB[tok * 1024 + k]); const float* w = &wr[(size_t)k * PW]; for (int n = 0; n < PW; ++n) acc[n] += a * w[n]; }
      for (int n = 0; n < PM; ++n) { float v = acc[n] + bias[n]; if (layer == 0) v = epi_ab(n, v, lb); P[tok * PSTRIDE + n] = f2bf(v); }
      for (int n = PM; n < PW; ++n) side[tok * 32 + (n - PM)] = acc[n] + bias[n];
      if (layer == 0) for (int dir = 0; dir < 2; ++dir) for (int cc = 0; cc < 256; ++cc) {
        float z = p.in[I_GK_B][dir * 256 + cc];
        for (int r = 0; r < 16; ++r) z += side[tok * 32 + dir * 16 + r] * p.in[I_GK_UP][(dir * 16 + r) * 256 + cc];
        LFB[tok * 512 + dir * 256 + cc] = f2bf(logsigmoidf_(z) * 0.0625f); }
    }
    if (layer == 0) { ScanAB2 s{}; s.P = P; s.LFB = LFB; s.O = O; run_functor(s, (long)BATCH * 2048); }
    else { PrepCD2 pc{}; pc.P = P; pc.QD = LFB; pc.rope = rope; pc.conv_w = p.in[I_CONV_W]; pc.conv_b = p.in[I_CONV_B]; run_functor(pc, (long)NTOK * 1280);
      ScanCD2 s{}; s.P = P; s.QD = LFB; s.side = side; s.fgate_b = p.in[I_FGATE_B]; s.O = O; s.oside = oside; run_functor(s, (long)BATCH * 2056); }
#pragma omp parallel for
    for (long tok = 0; tok < NTOK; ++tok) for (int h8 = 0; h8 < 8; ++h8) {
      float sf = 1.f, sb = 1.f;
      if (layer == 1 && h8 >= 4) { int h = h8 - 4; const float* s0 = oside + tok * 8 + h * 2; const float* s1 = oside + (size_t)(NTOK + tok) * 8 + h * 2;
        sf = 1.0f / fmaxf(fabsf(s0[0]), expf(-s0[1])); sb = 1.0f / fmaxf(fabsf(s1[0]), expf(-s1[1])); }
      float o[128]; float ss = 0.f;
      for (int j = 0; j < 128; ++j) { int c = h8 * 128 + j; o[j] = bf2f(O[tok * 1024 + c]) * sf + bf2f(O[(size_t)(NTOK + tok) * 1024 + c]) * sb; ss += o[j] * o[j]; }
      float r = 1.0f / sqrtf(ss * (1.0f / 128.0f) + NORM_EPS_F);
      for (int j = 0; j < 128; ++j) { int c = h8 * 128 + j; float gn, gt;
        if (layer == 0) { gn = h8 < 4 ? p.in[I_HGRN_NORM][c] : p.in[I_GLA_NORM][c - 512]; gt = siluf_(bf2f(P[tok * PSTRIDE + (h8 < 4 ? 2048 + c : 3584 + c - 512)])); }
        else { gn = h8 < 4 ? p.in[I_RET_NORM][c] : p.in[I_MLSTM_NORM][c - 512]; float gr = bf2f(P[tok * PSTRIDE + (h8 < 4 ? 1024 + c : 3072 + c - 512)]); gt = h8 < 4 ? siluf_(gr) : sigmoidf_(gr); }
        HB[tok * 1024 + c] = f2bf(o[j] * r * gn * gt); }
    }
    cpu_round_w(p.in[layer == 0 ? I_AB_W_OUT : I_CD_W_OUT], (size_t)1024 * 1024, wr);
#pragma omp parallel for
    for (long tok = 0; tok < NTOK; ++tok) { std::vector<float> acc(1024, 0.f);
      for (int k = 0; k < 1024; ++k) { float a = bf2f(HB[tok * 1024 + k]); const float* w = &wr[(size_t)k * 1024]; for (int n = 0; n < 1024; ++n) acc[n] += a * w[n]; }
      for (int n = 0; n < 1024; ++n) yf[tok * 1024 + n] = acc[n]; }
    dbg_cmp(layer == 0 ? "y_mix0" : "y_mix1", yf, (long)NTOK * 1024);
    int cnt[NEXP] = {0}; std::vector<int> list((size_t)NEXP * NTOK);
    const float* hin = layer == 0 ? p.in[I_X] : p.out;
    for (long tok = 0; tok < NTOK; ++tok) {
      float v[1024]; double s = 0; for (int c = 0; c < 1024; ++c) { v[c] = ALPHA_F * hin[tok * 1024 + c] + yf[tok * 1024 + c]; s += v[c]; }
      float mean = (float)(s / 1024); double q = 0; for (int c = 0; c < 1024; ++c) { v[c] -= mean; q += (double)v[c] * v[c]; }
      float r = 1.0f / sqrtf((float)(q / 1024) + LN_EPS_F);
      float lg[16] = {0};
      for (int c = 0; c < 1024; ++c) { v[c] = v[c] * r * p.in[I_LN_MIX_G][layer * 1024 + c] + p.in[I_LN_MIX_B][layer * 1024 + c]; p.out[tok * 1024 + c] = v[c]; HB[tok * 1024 + c] = f2bf(v[c]);
        for (int e = 0; e < 16; ++e) lg[e] += v[c] * p.in[I_ROUTER_W][c * 16 + e]; }
      int eo[2]; float go[2]; route_from_logits(lg, p.in[I_ROUTER_B], eo, go);
      int r1 = cnt[eo[0]]++, r2 = cnt[eo[1]]++;
      list[(size_t)eo[0] * NTOK + r1] = (int)tok; list[(size_t)eo[1] * NTOK + r2] = (int)tok;
      assign[tok * 4] = eo[0]; assign[tok * 4 + 1] = r1; assign[tok * 4 + 2] = eo[1]; assign[tok * 4 + 3] = r2; gate[tok * 2] = go[0]; gate[tok * 2 + 1] = go[1];
    }
    dbg_cmp(layer == 0 ? "h_mix0" : "h_mix1", p.out, (long)NTOK * 1024);
    int pad[NEXP]; { int a = 0; for (int e = 0; e < NEXP; ++e) { pad[e] = a; a += ((cnt[e] + 255) >> 8) << 8; } }
    const size_t lo = (size_t)layer * NEXP * 1024 * 1024;
    for (int e = 0; e < NEXP; ++e) {
      std::vector<float> w1, w3, w2; cpu_round_w(p.in[I_MOE_W1] + lo + (size_t)e * 1048576, 1048576, w1); cpu_round_w(p.in[I_MOE_W3] + lo + (size_t)e * 1048576, 1048576, w3); cpu_round_w(p.in[I_MOE_W2] + lo + (size_t)e * 1048576, 1048576, w2);
#pragma omp parallel for
      for (int rr = 0; rr < cnt[e]; ++rr) { int tok = list[(size_t)e * NTOK + rr]; size_t pos = pad[e] + rr;
        std::vector<float> a1(1024, 0.f), a3(1024, 0.f), a2(1024, 0.f);
        for (int k = 0; k < 1024; ++k) { float a = bf2f(HB[(size_t)tok * 1024 + k]); const float* p1 = &w1[(size_t)k * 1024]; const float* p3 = &w3[(size_t)k * 1024]; for (int n = 0; n < 1024; ++n) { a1[n] += a * p1[n]; a3[n] += a * p3[n]; } }
        for (int n = 0; n < 1024; ++n) H[pos * 1024 + n] = f2bf(siluf_(a1[n]) * a3[n]);
        for (int k = 0; k < 1024; ++k) { float a = bf2f(H[pos * 1024 + k]); const float* p2 = &w2[(size_t)k * 1024]; for (int n = 0; n < 1024; ++n) a2[n] += a * p2[n]; }
        for (int n = 0; n < 1024; ++n) Y[pos * 1024 + n] = f2bf(a2[n]); }
    }
    for (long tok = 0; tok < NTOK; ++tok) {
      size_t p0 = pad[assign[tok * 4]] + assign[tok * 4 + 1], p1 = pad[assign[tok * 4 + 2]] + assign[tok * 4 + 3];
      float v[1024]; double s = 0; for (int c = 0; c < 1024; ++c) { v[c] = ALPHA_F * p.out[tok * 1024 + c] + gate[tok * 2] * bf2f(Y[p0 * 1024 + c]) + gate[tok * 2 + 1] * bf2f(Y[p1 * 1024 + c]); s += v[c]; }
      float mean = (float)(s / 1024); double q = 0; for (int c = 0; c < 1024; ++c) { v[c] -= mean; q += (double)v[c] * v[c]; }
      float r = 1.0f / sqrtf((float)(q / 1024) + LN_EPS_F);
      for (int c = 0; c < 1024; ++c) { v[c] = v[c] * r * p.in[I_LN_FFN_G][layer * 1024 + c] + p.in[I_LN_FFN_B][layer * 1024 + c]; p.out[tok * 1024 + c] = v[c]; HB[tok * 1024 + c] = f2bf(v[c]); }
    }
    dbg_cmp(layer == 0 ? "h_ffn0" : "h_ffn1", p.out, (long)NTOK * 1024);
  }
}
#endif
```

```cpp
#ifdef CPU_EMU
#include <cmath>
#include <cstdio>
#include <cstring>
#include <cstdlib>
#include <cstddef>
#define DEV
#define DEV_INLINE static inline
typedef void* hipStream_t;
#else
#include <hip/hip_runtime.h>
#include <hip/hip_bf16.h>
#include <cstdio>
#define DEV __device__ __forceinline__
#define DEV_INLINE __device__ __forceinline__
#endif
#ifndef PROBE_DUP
#define PROBE_DUP 0
#endif
#ifndef BATCH
#define BATCH 4
#endif
#ifndef SEQ
#define SEQ 8192
#endif
#define DM 1024
#define NTOK (BATCH * SEQ)
#define P_AB 4128
#define P_CD 3600
#define PM_AB 4096
#define PM_CD 3584
#define NEXP 16
#define ALPHA_F 1.4142135623730951f
#define LN_EPS_F 1e-5f
#define NORM_EPS_F 1e-6f
#define HROWS (2 * NTOK + NEXP * 256)

typedef unsigned short bf16_t;

DEV_INLINE float bf2f(bf16_t b) { unsigned u = ((unsigned)b) << 16; float f; memcpy(&f, &u, 4); return f; }
DEV_INLINE bf16_t f2bf(float f) { unsigned u; memcpy(&u, &f, 4); u += 0x7FFFu + ((u >> 16) & 1u); return (bf16_t)(u >> 16); }
DEV_INLINE float sigmoidf_(float x) { return 1.0f / (1.0f + expf(-x)); }
DEV_INLINE float siluf_(float x) { return x / (1.0f + expf(-x)); }
DEV_INLINE float logsigmoidf_(float x) { return fminf(x, 0.0f) - log1pf(expf(-fabsf(x))); }

#define AL256(x) (((size_t)(x) + 255) & ~(size_t)255)
#define WS_CTL    ((size_t)0)
#define WS_HB     ((size_t)65536)
#define WS_R1     (WS_HB + (size_t)NTOK * 1024 * 2)
#define R1_P_BYTES ((size_t)NTOK * 4096 * 2)
#define R1_MIN    (AL256((size_t)HROWS * 1024 * 2) + (size_t)NEXP * 3072 * 1024 * 2)
#define R1_PL     (R1_P_BYTES + (size_t)NTOK * 512 * 2)
#define R1_BYTES  (R1_PL > R1_MIN ? R1_PL : R1_MIN)
#define WS_LFB    (WS_R1 + R1_P_BYTES)
#define WS_H      (WS_R1)
#define WS_WMOE   (WS_R1 + AL256((size_t)HROWS * 1024 * 2))
#define WMOE_BYTES ((size_t)NEXP * 3072 * 1024 * 2)
#define WS_R2     (WS_R1 + R1_BYTES)
#define R2_BYTES  ((size_t)HROWS * 1024 * 2 > (size_t)NTOK * 1024 * 4 ? (size_t)HROWS * 1024 * 2 : (size_t)NTOK * 1024 * 4)
#define WS_SIDE   (WS_R2 + AL256(R2_BYTES))
#define WS_OSIDE  (WS_SIDE + (size_t)NTOK * 32 * 4)
#define WS_WIN_AB (WS_OSIDE + (size_t)2 * NTOK * 8 * 4)
#define WS_WIN_CD (WS_WIN_AB + (size_t)4128 * 1024 * 2)
#define WS_WOUT_AB (WS_WIN_CD + (size_t)3600 * 1024 * 2)
#define WS_WOUT_CD (WS_WOUT_AB + (size_t)1024 * 1024 * 2)
#define WS_ROPE   (WS_WOUT_CD + (size_t)1024 * 1024 * 2)
#define WS_LB     (WS_ROPE + (size_t)SEQ * 64 * 4)
#define WS_LIST   (WS_LB + 4096)
#define WS_ASSIGN (WS_LIST + (size_t)2 * NEXP * NTOK * 4)
#define WS_GATE   (WS_ASSIGN + (size_t)NTOK * 16)
#define WS_END    (WS_GATE + (size_t)NTOK * 8)
#define CW_CNT(layer) (64 + 256 * (layer))

#define PSTRIDE 4096

enum { I_X, I_AB_W_IN, I_AB_B_IN, I_HGRN_LB, I_GK_UP, I_GK_B, I_HGRN_NORM, I_GLA_NORM, I_AB_W_OUT,
       I_CD_W_IN, I_CD_B_IN, I_CONV_W, I_CONV_B, I_FGATE_B, I_RET_NORM, I_MLSTM_NORM, I_CD_W_OUT,
       I_LN_MIX_G, I_LN_MIX_B, I_LN_FFN_G, I_LN_FFN_B, I_ROUTER_W, I_ROUTER_B, I_MOE_W1, I_MOE_W3, I_MOE_W2, N_IN };

struct Params {
  const float* in[N_IN];
  float* out;
  unsigned char* ws;
};

DEV_INLINE float epi_ab(int col, float v, const float* lb) {
  if (col < 512) return siluf_(v);
  if (col < 1536) { float l = lb[(col - 512) & 511]; return logf(l + (1.0f - l) * sigmoidf_(v)); }
  if (col >= 2560 && col < 2816) return v * 0.125f;
  return v;
}

DEV_INLINE void route_from_logits(const float* lg, const float* rb, int* e_out, float* g_out) {
  float mx = lg[0];
#pragma unroll
  for (int e = 1; e < 16; ++e) mx = fmaxf(mx, lg[e]);
  float sc[16]; float sum = 0.f;
#pragma unroll
  for (int e = 0; e < 16; ++e) { sc[e] = expf(lg[e] - mx); sum += sc[e]; }
  float inv = 1.0f / sum;
  float best_gs = -1e30f; int be1 = 0, be2 = 1; float bs1 = 0.f, bs2 = 0.f;
#pragma unroll
  for (int gq = 0; gq < 4; ++gq) {
    float m1 = -1e30f, m2 = -1e30f, s1 = 0.f, s2 = 0.f; int i1 = 0, i2 = 0;
#pragma unroll
    for (int i = 0; i < 4; ++i) {
      float s = sc[gq * 4 + i] * inv; float v = s + rb[gq * 4 + i];
      if (v > m1) { m2 = m1; i2 = i1; s2 = s1; m1 = v; i1 = gq * 4 + i; s1 = s; }
      else if (v > m2) { m2 = v; i2 = gq * 4 + i; s2 = s; }
    }
    float gs = m1 + m2;
    if (gs > best_gs) { best_gs = gs; be1 = i1; be2 = i2; bs1 = s1; bs2 = s2; }
  }
  e_out[0] = be1; e_out[1] = be2; g_out[0] = bs1 / (bs1 + bs2); g_out[1] = bs2 / (bs1 + bs2);
}
struct ScanAB2 {
  const bf16_t* P; const bf16_t* LFB; bf16_t* O;
  DEV void operator()(long gid) const {
    int j = (int)(gid & 127), h = (int)((gid >> 7) & 3), dir = (int)((gid >> 9) & 1), mixer = (int)((gid >> 10) & 1), b = (int)(gid >> 11);
    bf16_t* Od = O + (size_t)dir * NTOK * 1024;
    if (mixer == 0) {
      float S[128];
#pragma unroll
      for (int d = 0; d < 128; ++d) S[d] = 0.f;
      for (int s = 0; s < SEQ; ++s) {
        size_t t = (size_t)b * SEQ + (dir ? (SEQ - 1 - s) : s);
        const bf16_t* row = P + t * PSTRIDE;
        const bf16_t* q = row + h * 128; const bf16_t* lf = row + 512 + dir * 512 + h * 128;
        float v = bf2f(row[1536 + h * 128 + j]);
        float o = 0.f;
#pragma unroll
        for (int d = 0; d < 128; ++d) { float fd = expf(bf2f(lf[d])); S[d] = fd * S[d] + (1.0f - fd) * v; o += bf2f(q[d]) * S[d]; }
        Od[t * 1024 + h * 128 + j] = f2bf(o);
      }
    } else {
      float S[64];
#pragma unroll
      for (int d = 0; d < 64; ++d) S[d] = 0.f;
      for (int s = 0; s < SEQ; ++s) {
        size_t t = (size_t)b * SEQ + (dir ? (SEQ - 1 - s) : s);
        const bf16_t* row = P + t * PSTRIDE;
        const bf16_t* q = row + 2560 + h * 64; const bf16_t* k = row + 2816 + h * 64;
        const bf16_t* lf = LFB + t * 512 + dir * 256 + h * 64;
        float v = bf2f(row[3072 + h * 128 + j]);
        float o = 0.f;
#pragma unroll
        for (int d = 0; d < 64; ++d) { S[d] = expf(bf2f(lf[d])) * S[d] + bf2f(k[d]) * v; o += bf2f(q[d]) * S[d]; }
        Od[t * 1024 + 512 + h * 128 + j] = f2bf(o);
      }
    }
  }
};

struct PrepCD2 {
  bf16_t* P; bf16_t* QD; const float* rope; const float* conv_w; const float* conv_b;
  DEV void operator()(long gid) const {
    size_t tok = (size_t)(gid / 1280); int c = (int)(gid % 1280); int t = (int)(tok % SEQ);
    bf16_t* row = P + tok * PSTRIDE;
    if (c < 256) {
      int isk = c >> 7, hh = (c >> 5) & 3, i = c & 31;
      float cs = rope[(t * 32 + i) * 2], sn = rope[(t * 32 + i) * 2 + 1];
      bf16_t* base = row + isk * 256 + hh * 64;
      float a1 = bf2f(base[i]), a2 = bf2f(base[i + 32]);
      float sc = isk ? 1.0f : 0.125f;
      base[i] = f2bf((a1 * cs - a2 * sn) * sc); base[i + 32] = f2bf((a1 * sn + a2 * cs) * sc);
    } else {
      int cc = c - 256;
      float acc = conv_b[cc] + bf2f(row[1536 + cc]) * conv_w[1024 + cc];
      if (t > 0) acc += bf2f(row[1536 + cc - PSTRIDE]) * conv_w[cc];
      if (t < SEQ - 1) acc += bf2f(row[1536 + cc + PSTRIDE]) * conv_w[2048 + cc];
      float s = siluf_(acc);
      if (cc < 512) QD[tok * 512 + cc] = f2bf(s * 0.08838834764831845f);
      else row[3584 + (cc - 512)] = f2bf(s);
    }
  }
};

struct ScanCD2 {
  const bf16_t* P; const bf16_t* QD; const float* side; const float* fgate_b; bf16_t* O; float* oside;
  DEV void operator()(long gid) const {
    int b = (int)(gid / 2056); int g = (int)(gid % 2056);
    if (g < 1024) {
      int j = g & 127, h = (g >> 7) & 3, dir = (g >> 9) & 1;
      bf16_t* Od = O + (size_t)dir * NTOK * 1024;
      float gamma = 1.0f - exp2f(-(5.0f + 2.0f * (float)h + (float)dir));
      float S[64];
#pragma unroll
      for (int d = 0; d < 64; ++d) S[d] = 0.f;
      for (int s = 0; s < SEQ; ++s) {
        size_t t = (size_t)b * SEQ + (dir ? (SEQ - 1 - s) : s);
        const bf16_t* row = P + t * PSTRIDE;
        const bf16_t* q = row + h * 64; const bf16_t* k = row + 256 + h * 64;
        float v = bf2f(row[512 + h * 128 + j]);
        float o = 0.f;
#pragma unroll
        for (int d = 0; d < 64; ++d) { S[d] = gamma * S[d] + bf2f(k[d]) * v; o += bf2f(q[d]) * S[d]; }
        Od[t * 1024 + h * 128 + j] = f2bf(o);
      }
    } else {
      g -= 1024;
      int j = g % 129, h = (g / 129) & 3, dir = g / (129 * 4);
      bf16_t* Od = O + (size_t)dir * NTOK * 1024; float* os = oside + (size_t)dir * NTOK * 8;
      float fb = fgate_b[dir * 4 + h];
      float S[128];
#pragma unroll
      for (int d = 0; d < 128; ++d) S[d] = 0.f;
      float m = 0.f;
      for (int s = 0; s < SEQ; ++s) {
        size_t t = (size_t)b * SEQ + (dir ? (SEQ - 1 - s) : s);
        const bf16_t* row = P + t * PSTRIDE;
        const bf16_t* q = QD + t * 512 + h * 128; const bf16_t* k = row + 3584 + h * 128;
        float v = (j < 128) ? bf2f(row[2560 + h * 128 + j]) : 1.0f;
        float li = side[t * 32 + dir * 8 + h];
        float lf = logsigmoidf_(side[t * 32 + dir * 8 + 4 + h] + fb);
        float mn = fmaxf(lf + m, li);
        float fs = expf(lf + m - mn), is = expf(li - mn) * v;
        m = mn;
        float o = 0.f;
#pragma unroll
        for (int d = 0; d < 128; ++d) { S[d] = fs * S[d] + is * bf2f(k[d]); o += bf2f(q[d]) * S[d]; }
        if (j < 128) Od[t * 1024 + 512 + h * 128 + j] = f2bf(o);
        else { os[t * 8 + h * 2] = o; os[t * 8 + h * 2 + 1] = m; }
      }
    }
  }
};
#ifndef CPU_EMU
namespace pg8 {
#define PG8_LAS __attribute__((address_space(3)))
typedef short bf16x8 __attribute__((ext_vector_type(8)));
typedef float f32x4 __attribute__((ext_vector_type(4)));
typedef unsigned u32x4 __attribute__((ext_vector_type(4)));
typedef unsigned u32x2 __attribute__((ext_vector_type(2)));
constexpr int BM = 256, BK = 64, HALF = 128, HTB = HALF * BK * 2, STAGE_BYTES = 8 * HTB, NXCD = 8, WGM = 8, GK = 1024;

__device__ __forceinline__ int lds_byte(int r, int c) { const int st = (r >> 4) * 2 + (c >> 5), rr = r & 15, cc = c & 31, ob = rr * 64 + cc * 2; return st * 1024 + (ob ^ (((ob >> 9) & 1) << 5)); }
__device__ __forceinline__ void stage_rc(int b, int& R, int& C) { const int st = b / 1024, sb = b % 1024, swz = sb ^ (((sb >> 9) & 1) << 5); R = (st >> 1) * 16 + swz / 64; C = (st & 1) * 32 + (swz % 64) / 2; }
__device__ __forceinline__ int perm32(int rho) { const int n = rho >> 4, i = rho & 15; return 8 * (i >> 2) + 4 * n + (i & 3); }
__device__ __forceinline__ unsigned cvt_pk_bf16(float lo, float hi) { unsigned r; asm volatile("v_cvt_pk_bf16_f32 %0, %1, %2" : "=v"(r) : "v"(lo), "v"(hi)); return r; }

struct Unit { int pm, pn, e, row0; };

struct StaticOrder {
  int nM, nN, nwg, G, c;
  __device__ void init(int M, int N, int G_, int c_) { nM = M / BM; nN = N / BM; nwg = nM * nN; G = G_; c = c_; }
  __device__ bool next(int i, Unit& u) const {
    const long L = (long)i * G + c; if (L >= nwg) return false;
    int wgid = (int)L; { const int q = nwg / NXCD, r = nwg % NXCD, xcd = wgid % NXCD, off = wgid / NXCD; wgid = (xcd < r ? xcd * (q + 1) : r * (q + 1) + (xcd - r) * q) + off; }
    const int nig = WGM * nN, gid = wgid / nig, fm = gid * WGM, gsz = (nM - fm) < WGM ? (nM - fm) : WGM;
    u.pm = fm + ((wgid % nig) % gsz); u.pn = (wgid % nig) / gsz; u.e = 0; u.row0 = u.pm * BM; return true;
  }
};

template <class Prob>
__device__ __forceinline__ void gemm_phase(PG8_LAS unsigned char* lds, const Prob& S, int wv) {
  int wv_ = wv; asm volatile("" : "+s"(wv_));
  int l_; asm volatile("v_mbcnt_lo_u32_b32 %0, -1, 0\n\tv_mbcnt_hi_u32_b32 %0, -1, %0" : "=v"(l_));
  int tid_ = wv_ * 64 + l_;
  const int tid = tid_, wid = __builtin_amdgcn_readfirstlane(tid >> 6), lane = tid & 63, wr = wid >> 2, wc = wid & 3, fr = lane & 15, fq = lane >> 4;
  constexpr int K = GK, nt = K / BK;
  int sR[2], sC[2]; unsigned voffB[2];
#pragma unroll
  for (int i = 0; i < 2; ++i) { int R, C; stage_rc(tid * 16 + i * 8192, R, C); sR[i] = R; sC[i] = C; const int Rb = Prob::PERM ? ((R & ~31) + perm32(R & 31)) : R; voffB[i] = (unsigned)(Rb * K + C) * 2u; }
  const size_t kstep = (size_t)(BK * 2);
  const size_t hstep = (size_t)HALF * K * 2;
  const unsigned ldsw = (unsigned)wid * 1024u;
  const int aoff = lds_byte(wr * 64 + fr, fq * 8), boff = lds_byte(wc * 32 + fr, fq * 8);
#define PG8_SA(b, h) (((b) * 2 + (h)) * HTB)
#define PG8_SB(b, h) ((4 + (b) * 2 + (h)) * HTB)
#define PG8_STAGE(bufoff, gbase, voff) do { _Pragma("unroll") for (int _i = 0; _i < 2; ++_i) \
    __builtin_amdgcn_global_load_lds((const unsigned*)((const char*)(gbase) + (voff)[_i]), (PG8_LAS unsigned*)(lds + (bufoff) + ldsw + _i * 8192), 16, 0, 0); } while (0)
#define PG8_LDA(dst, b, h) do { _Pragma("unroll") for (int m = 0; m < 4; ++m) _Pragma("unroll") for (int k = 0; k < 2; ++k) dst[m][k] = *(const PG8_LAS bf16x8*)(lds + PG8_SA(b, h) + aoff + m * 2048 + k * 1024); } while (0)
#define PG8_LDB(dst, b, h) do { _Pragma("unroll") for (int n = 0; n < 2; ++n) _Pragma("unroll") for (int k = 0; k < 2; ++k) dst[n][k] = *(const PG8_LAS bf16x8*)(lds + PG8_SB(b, h) + boff + n * 2048 + k * 1024); } while (0)
#define PG8_MMA(ai, bj, At, Bt) do { __builtin_amdgcn_s_setprio(1); _Pragma("unroll") for (int m = 0; m < 4; ++m) _Pragma("unroll") for (int n = 0; n < 2; ++n) _Pragma("unroll") for (int k = 0; k < 2; ++k) \
    acc[ai][bj][m][n] = __builtin_amdgcn_mfma_f32_16x16x32_bf16(Bt[n][k], At[m][k], acc[ai][bj][m][n], 0, 0, 0); __builtin_amdgcn_s_setprio(0); } while (0)
#define PG8_WAIT_V(n) asm volatile("s_waitcnt vmcnt(" #n ")" ::: "memory")
#define PG8_WAIT_L(n) asm volatile("s_waitcnt lgkmcnt(" #n ")" ::: "memory")
#define PG8_BAR __builtin_amdgcn_s_barrier()
#define PG8_SCHED __builtin_amdgcn_sched_barrier(0)
  Unit cur, nxt; int ui = 0;
  if (!S.next(0, cur)) return;
  f32x4 acc[2][2][4][2];
#pragma unroll
  for (int a = 0; a < 2; ++a)
#pragma unroll
    for (int b = 0; b < 2; ++b)
#pragma unroll
      for (int m = 0; m < 4; ++m)
#pragma unroll
        for (int n = 0; n < 2; ++n) acc[a][b][m][n] = (f32x4){0.f, 0.f, 0.f, 0.f};
  bf16x8 At[4][2], B0[2][2], B1[2][2];
  unsigned oc0[2], oc1[2], on0[2], on1[2];
#pragma unroll
  for (int i = 0; i < 2; ++i) { oc0[i] = S.a_off(cur, sR[i]) + (unsigned)sC[i] * 2u; oc1[i] = S.a_off(cur, HALF + sR[i]) + (unsigned)sC[i] * 2u; }
  const char* const Ab = S.a_base();
  const char* cB = S.b_base(cur);
  PG8_STAGE(PG8_SB(0, 0), cB, voffB); PG8_STAGE(PG8_SA(0, 0), Ab, oc0); PG8_STAGE(PG8_SB(0, 1), cB + hstep, voffB); PG8_STAGE(PG8_SA(0, 1), Ab, oc1);
  if (wr == 1) PG8_BAR;
  PG8_WAIT_V(4); PG8_BAR;
  PG8_STAGE(PG8_SB(1, 0), cB + kstep, voffB); PG8_STAGE(PG8_SA(1, 0), Ab + kstep, oc0); PG8_STAGE(PG8_SB(1, 1), cB + hstep + kstep, voffB);
  PG8_WAIT_V(6); PG8_BAR;
  for (;;) {
    const bool has_next = S.next(ui + 1, nxt);
    const char* nB = cB;
    if (has_next) {
      nB = S.b_base(nxt);
      int l2_; asm volatile("v_mbcnt_lo_u32_b32 %0, -1, 0\n\tv_mbcnt_hi_u32_b32 %0, -1, %0" : "=v"(l2_));
      const int tid2 = wid * 64 + l2_;
#pragma unroll
      for (int i = 0; i < 2; ++i) { int R, C; stage_rc(tid2 * 16 + i * 8192, R, C); on0[i] = S.a_off(nxt, R) + (unsigned)C * 2u; on1[i] = S.a_off(nxt, HALF + R) + (unsigned)C * 2u; }
    } else {
#pragma unroll
      for (int i = 0; i < 2; ++i) { on0[i] = oc0[i]; on1[i] = oc1[i]; }
    }
    for (int t = 0; t < nt; t += 2) {
      const bool last = (t == nt - 2);
      const char* a1 = Ab + (size_t)(t + 1) * kstep;
      const char* a2 = last ? Ab : Ab + (size_t)(t + 2) * kstep; const char* b2 = last ? nB : cB + (size_t)(t + 2) * kstep;
      const char* a3 = a2 + kstep; const char* b3 = b2 + kstep;
      unsigned o20[2], o21[2];
#pragma unroll
      for (int i = 0; i < 2; ++i) { o20[i] = last ? on0[i] : oc0[i]; o21[i] = last ? on1[i] : oc1[i]; }
      PG8_LDB(B0, 0, 0); PG8_SCHED; PG8_LDA(At, 0, 0); PG8_STAGE(PG8_SA(1, 1), a1, oc1);
      PG8_WAIT_L(8); PG8_BAR; PG8_WAIT_L(0); PG8_MMA(0, 0, At, B0); PG8_BAR; PG8_SCHED;
      PG8_LDB(B1, 0, 1); PG8_STAGE(PG8_SB(0, 0), b2, voffB);
      PG8_BAR; PG8_WAIT_L(0); PG8_MMA(0, 1, At, B1); PG8_BAR;
      PG8_LDA(At, 0, 1); PG8_STAGE(PG8_SA(0, 0), a2, o20);
      PG8_BAR; PG8_WAIT_L(0); PG8_MMA(1, 0, At, B0); PG8_BAR; PG8_SCHED;
      PG8_STAGE(PG8_SB(0, 1), b2 + hstep, voffB);
      PG8_WAIT_V(6); PG8_BAR; PG8_MMA(1, 1, At, B1); PG8_BAR;
      PG8_LDB(B0, 1, 0); PG8_SCHED; PG8_LDA(At, 1, 0); PG8_STAGE(PG8_SA(0, 1), a2, o21);
      PG8_WAIT_L(8); PG8_BAR; PG8_WAIT_L(0); PG8_MMA(0, 0, At, B0); PG8_BAR; PG8_SCHED;
      PG8_LDB(B1, 1, 1); PG8_STAGE(PG8_SB(1, 0), b3, voffB);
      PG8_BAR; PG8_WAIT_L(0); PG8_MMA(0, 1, At, B1); PG8_BAR;
      PG8_LDA(At, 1, 1); PG8_STAGE(PG8_SA(1, 0), a3, o20);
      PG8_BAR; PG8_WAIT_L(0); PG8_MMA(1, 0, At, B0); PG8_BAR; PG8_SCHED;
      PG8_STAGE(PG8_SB(1, 1), b3 + hstep, voffB);
      PG8_WAIT_V(6); PG8_BAR; PG8_MMA(1, 1, At, B1); PG8_BAR;
    }
    { int l3_; asm volatile("v_mbcnt_lo_u32_b32 %0, -1, 0\n\tv_mbcnt_hi_u32_b32 %0, -1, %0" : "=v"(l3_));
      S.epi(acc, cur, wr, wc, l3_ & 15, l3_ >> 4); }
    if (!has_next) break;
#pragma unroll
    for (int a = 0; a < 2; ++a)
#pragma unroll
      for (int b = 0; b < 2; ++b)
#pragma unroll
        for (int m = 0; m < 4; ++m)
#pragma unroll
          for (int n = 0; n < 2; ++n) acc[a][b][m][n] = (f32x4){0.f, 0.f, 0.f, 0.f};
    cur = nxt; cB = nB; ++ui;
#pragma unroll
    for (int i = 0; i < 2; ++i) { oc0[i] = on0[i]; oc1[i] = on1[i]; }
  }
  PG8_WAIT_V(0);
  if (wr == 0) PG8_BAR;
  PG8_BAR;
#undef PG8_SA
#undef PG8_SB
#undef PG8_STAGE
#undef PG8_LDA
#undef PG8_LDB
#undef PG8_MMA
#undef PG8_WAIT_V
#undef PG8_WAIT_L
#undef PG8_BAR
#undef PG8_SCHED
}
}
#endif
#ifndef CPU_EMU
#include <hip/hip_cooperative_groups.h>
namespace cg = cooperative_groups;
#define LAS __attribute__((address_space(3)))
#define NTHREADS 512
#define LDS_BYTES (146 * 1024)
typedef float f32x4 __attribute__((ext_vector_type(4)));
typedef short bf16x8 __attribute__((ext_vector_type(8)));
typedef unsigned u32x4 __attribute__((ext_vector_type(4)));
typedef unsigned u32x2 __attribute__((ext_vector_type(2)));

struct Ctx { int tid, lane, wid, G, bid; unsigned char* lds; };
__device__ __forceinline__ int lane_id() { int l; asm volatile("v_mbcnt_lo_u32_b32 %0, -1, 0\n\tv_mbcnt_hi_u32_b32 %0, -1, %0" : "=v"(l)); return l; }
__device__ __forceinline__ int opaque_tid(int wv) { int w = wv; asm volatile("" : "+s"(w)); int t = w * 64 + lane_id(); asm volatile("" : "+v"(t)); return t; }
__device__ __forceinline__ Ctx make_ctx(unsigned char* lds, int wv) { Ctx c; c.tid = opaque_tid(wv); c.lane = c.tid & 63; c.wid = __builtin_amdgcn_readfirstlane(c.tid >> 6); c.G = gridDim.x; c.bid = blockIdx.x; c.lds = lds; return c; }

__device__ __forceinline__ float wave_sum(float v) {
#pragma unroll
  for (int o = 32; o > 0; o >>= 1) v += __shfl_xor(v, o);
  return v;
}
typedef float f32x2_t __attribute__((ext_vector_type(2)));
typedef __bf16 bf16x2_t __attribute__((ext_vector_type(2)));
__device__ __forceinline__ unsigned pk_hw(float a, float b) { const f32x2_t v = {a, b}; return __builtin_bit_cast(unsigned, __builtin_convertvector(v, bf16x2_t)); }
__device__ __forceinline__ unsigned pk2(float a, float b) { return pk_hw(a, b); }
__device__ __forceinline__ void unpack8(u32x4 w, float* f) {
  f[0] = __uint_as_float(w.x << 16); f[1] = __uint_as_float(w.x & 0xffff0000u); f[2] = __uint_as_float(w.y << 16); f[3] = __uint_as_float(w.y & 0xffff0000u);
  f[4] = __uint_as_float(w.z << 16); f[5] = __uint_as_float(w.z & 0xffff0000u); f[6] = __uint_as_float(w.w << 16); f[7] = __uint_as_float(w.w & 0xffff0000u);
}

__device__ __forceinline__ void transpose_job(const Ctx& c, const float* src, int N, bf16_t* dst, int rs, int ro, int tile0, int tile_stride) {
  float* t = (float*)c.lds;
  const int ntn = (N + 63) / 64, ntiles = ntn * 16;
  for (int tl = tile0; tl < ntiles; tl += tile_stride) {
    const int kt = tl / ntn, nt_ = tl % ntn, k0 = kt * 64, n0 = nt_ * 64;
    __syncthreads();
#pragma unroll
    for (int i = 0; i < 8; ++i) { const int idx = c.tid + i * 512, kk = idx >> 6, nn = idx & 63; t[kk * 65 + nn] = (n0 + nn < N) ? src[(size_t)(k0 + kk) * N + n0 + nn] : 0.f; }
    __syncthreads();
#pragma unroll
    for (int i = 0; i < 4; ++i) { const int idx = c.tid + i * 512, nn = idx >> 5, kp = (idx & 31) * 2;
      if (n0 + nn < N) *(unsigned*)(dst + (size_t)((n0 + nn) * rs + ro) * 1024 + k0 + kp) = pk2(t[kp * 65 + nn], t[(kp + 1) * 65 + nn]); }
  }
  __syncthreads();
}
__device__ __forceinline__ void p0_prologue(unsigned char* lds_, int wv, const Params& p) {
  const Ctx c = make_ctx(lds_, wv);
  unsigned char* ws = p.ws;
  if (c.bid == 0) { ((unsigned*)(ws + WS_CTL))[64 + c.tid] = 0u; }
  if (c.bid == 0 && c.tid == 0) ((unsigned*)(ws + WS_CTL))[1024] = 0u;
  { const float* x = p.in[I_X]; bf16_t* hb = (bf16_t*)(ws + WS_HB);
    for (size_t i = (size_t)c.bid * NTHREADS + c.tid; i < (size_t)NTOK * 1024 / 8; i += (size_t)c.G * NTHREADS) {
      const f32x4 a = *(const f32x4*)(x + i * 8), b = *(const f32x4*)(x + i * 8 + 4);
      u32x4 w; w.x = pk2(a[0], a[1]); w.y = pk2(a[2], a[3]); w.z = pk2(b[0], b[1]); w.w = pk2(b[2], b[3]);
      *(u32x4*)(hb + i * 8) = w; } }
  transpose_job(c, p.in[I_AB_W_IN], P_AB, (bf16_t*)(ws + WS_WIN_AB), 1, 0, c.bid, c.G);
  transpose_job(c, p.in[I_CD_W_IN], P_CD, (bf16_t*)(ws + WS_WIN_CD), 1, 0, c.bid, c.G);
  transpose_job(c, p.in[I_AB_W_OUT], 1024, (bf16_t*)(ws + WS_WOUT_AB), 1, 0, c.bid, c.G);
  transpose_job(c, p.in[I_CD_W_OUT], 1024, (bf16_t*)(ws + WS_WOUT_CD), 1, 0, c.bid, c.G);
  { float* rope = (float*)(ws + WS_ROPE);
    for (int i = c.bid * NTHREADS + c.tid; i < SEQ * 32; i += c.G * NTHREADS) { const int t = i >> 5, f = i & 31;
      const float freq = powf(10000.0f, -(float)f / 32.0f); const float ang = (float)t * freq; rope[i * 2] = cosf(ang); rope[i * 2 + 1] = sinf(ang); }
    if (c.bid == 1) { const float* hl = p.in[I_HGRN_LB]; float* lb = (float*)(ws + WS_LB);
      const int cc = c.tid; const float a0 = hl[cc], a1 = hl[512 + cc], a2 = hl[1024 + cc]; const float mx = fmaxf(a0, fmaxf(a1, a2));
      const float e0 = expf(a0 - mx), e1 = expf(a1 - mx), e2 = expf(a2 - mx); lb[cc] = e0 / (e0 + e1 + e2); } }
}
__device__ __forceinline__ void moe_weight_convert(unsigned char* lds_, int wv, const Params& p, int layer) {
  const Ctx c = make_ctx(lds_, wv);
  bf16_t* w13 = (bf16_t*)(p.ws + WS_WMOE); bf16_t* w2 = w13 + (size_t)NEXP * 2048 * 1024;
  const size_t lo = (size_t)layer * NEXP * 1024 * 1024;
  for (int e = 0; e < NEXP; ++e) {
    const size_t mo = lo + (size_t)e * 1024 * 1024;
    transpose_job(c, p.in[I_MOE_W1] + mo, 1024, w13 + (size_t)e * 2048 * 1024, 2, 0, c.bid, c.G);
    transpose_job(c, p.in[I_MOE_W3] + mo, 1024, w13 + (size_t)e * 2048 * 1024, 2, 1, c.bid, c.G);
    transpose_job(c, p.in[I_MOE_W2] + mo, 1024, w2 + (size_t)e * 1024 * 1024, 1, 0, c.bid, c.G);
  }
}

struct ProbInProj {
  static constexpr bool PERM = true;
  pg8::StaticOrder so; const char* A; const char* Bt; bf16_t* P; const float* bias; const float* lb; int layer;
  __device__ __forceinline__ bool next(int i, pg8::Unit& u) const { return so.next(i, u); }
  __device__ __forceinline__ const char* a_base() const { return A; }
  __device__ __forceinline__ unsigned a_off(const pg8::Unit& u, int r) const { return (unsigned)(u.pm * 256 + r) * 2048u; }
  __device__ __forceinline__ const char* b_base(const pg8::Unit& u) const { return Bt + (size_t)u.pn * 256 * 2048; }
  __device__ __forceinline__ void epi(const f32x4 (&acc)[2][2][4][2], const pg8::Unit& u, int wr, int wc, int fr, int fq) const {
    const int row0 = u.row0 + wr * 64 + fr, colb = u.pn * 256 + wc * 32 + 8 * fq;
    int mode = 0;
    if (layer == 0) { mode = u.pn < 2 ? 1 : (u.pn < 6 ? 2 : (u.pn == 10 ? 3 : 0)); }
#pragma unroll
    for (int bj = 0; bj < 2; ++bj) {
      const int col0 = colb + bj * 128;
      const f32x4 b0 = *(const f32x4*)(bias + col0), b1 = *(const f32x4*)(bias + col0 + 4);
      f32x4 l0 = (f32x4){0.f, 0.f, 0.f, 0.f}, l1 = l0;
      if (mode == 2) { l0 = *(const f32x4*)(lb + ((col0 - 512) & 511)); l1 = *(const f32x4*)(lb + ((col0 - 512) & 511) + 4); }
#pragma unroll
      for (int ai = 0; ai < 2; ++ai)
#pragma unroll
        for (int m = 0; m < 4; ++m) {
          f32x4 v0 = acc[ai][bj][m][0] + b0, v1 = acc[ai][bj][m][1] + b1;
          if (mode == 1) {
#pragma unroll
            for (int j = 0; j < 4; ++j) { v0[j] = siluf_(v0[j]); v1[j] = siluf_(v1[j]); }
          } else if (mode == 2) {
#pragma unroll
            for (int j = 0; j < 4; ++j) { v0[j] = __log2f(l0[j] + (1.0f - l0[j]) * sigmoidf_(v0[j])); v1[j] = __log2f(l1[j] + (1.0f - l1[j]) * sigmoidf_(v1[j])); }
          } else if (mode == 3) { v0 *= 0.125f; v1 *= 0.125f; }
          u32x4 w; w.x = pk2(v0[0], v0[1]); w.y = pk2(v0[2], v0[3]); w.z = pk2(v1[0], v1[1]); w.w = pk2(v1[2], v1[3]);
          *(u32x4*)(P + (size_t)(row0 + ai * 128 + m * 16) * PSTRIDE + col0) = w;
        }
    }
  }
};
struct ProbOutProj {
  static constexpr bool PERM = false;
  pg8::StaticOrder so; const char* A; const char* Bt; float* Y;
  __device__ __forceinline__ bool next(int i, pg8::Unit& u) const { return so.next(i, u); }
  __device__ __forceinline__ const char* a_base() const { return A; }
  __device__ __forceinline__ unsigned a_off(const pg8::Unit& u, int r) const { return (unsigned)(u.pm * 256 + r) * 2048u; }
  __device__ __forceinline__ const char* b_base(const pg8::Unit& u) const { return Bt + (size_t)u.pn * 256 * 2048; }
  __device__ __forceinline__ void epi(const f32x4 (&acc)[2][2][4][2], const pg8::Unit& u, int wr, int wc, int fr, int fq) const {
    const int row0 = u.row0 + wr * 64 + fr, col0 = u.pn * 256 + wc * 32 + 4 * fq;
#pragma unroll
    for (int ai = 0; ai < 2; ++ai)
#pragma unroll
      for (int m = 0; m < 4; ++m) { float* rowp = Y + (size_t)(row0 + ai * 128 + m * 16) * 1024 + col0;
#pragma unroll
        for (int bj = 0; bj < 2; ++bj)
#pragma unroll
          for (int n = 0; n < 2; ++n) *(f32x4*)(rowp + bj * 128 + n * 16) = acc[ai][bj][m][n]; }
  }
};
struct MoeOrder {
  const int* cnt; int ntn, G, c;
  __device__ __forceinline__ bool next(int i, pg8::Unit& u) const {
    int L = i * G + c; int pad = 0;
    for (int e = 0; e < NEXP; ++e) { const int n = cnt[e * 16], mt = (n + 255) >> 8, tiles = mt * ntn;
      if (L < tiles) { u.e = e; u.pn = L / mt; u.pm = L % mt; u.row0 = pad + u.pm * 256; return true; }
      L -= tiles; pad += mt * 256; }
    return false;
  }
};
struct ProbMoe1 {
  static constexpr bool PERM = true;
  MoeOrder mo; const char* A; const char* W13; const int* list; bf16_t* H;
  __device__ __forceinline__ bool next(int i, pg8::Unit& u) const { return mo.next(i, u); }
  __device__ __forceinline__ const char* a_base() const { return A; }
  __device__ __forceinline__ unsigned a_off(const pg8::Unit& u, int r) const { const int rr = u.pm * 256 + r; const int tok = rr < mo.cnt[u.e * 16] ? list[u.e * NTOK + rr] : 0; return (unsigned)tok * 2048u; }
  __device__ __forceinline__ const char* b_base(const pg8::Unit& u) const { return W13 + ((size_t)u.e * 2048 + (size_t)u.pn * 256) * 2048; }
  __device__ __forceinline__ void epi(const f32x4 (&acc)[2][2][4][2], const pg8::Unit& u, int wr, int wc, int fr, int fq) const {
    const int row0 = u.row0 + wr * 64 + fr, colb = u.pn * 128 + wc * 16 + 4 * fq;
#pragma unroll
    for (int ai = 0; ai < 2; ++ai)
#pragma unroll
      for (int m = 0; m < 4; ++m)
#pragma unroll
        for (int bj = 0; bj < 2; ++bj) {
          const f32x4 v0 = acc[ai][bj][m][0], v1 = acc[ai][bj][m][1];
          u32x2 w; w.x = pk2(siluf_(v0[0]) * v0[1], siluf_(v0[2]) * v0[3]); w.y = pk2(siluf_(v1[0]) * v1[1], siluf_(v1[2]) * v1[3]);
          *(u32x2*)(H + (size_t)(row0 + ai * 128 + m * 16) * 1024 + colb + bj * 64) = w;
        }
  }
};
struct ProbMoe2 {
  static constexpr bool PERM = true;
  MoeOrder mo; const char* A; const char* W2; bf16_t* Y;
  __device__ __forceinline__ bool next(int i, pg8::Unit& u) const { return mo.next(i, u); }
  __device__ __forceinline__ const char* a_base() const { return A; }
  __device__ __forceinline__ unsigned a_off(const pg8::Unit& u, int r) const { return (unsigned)(u.row0 + r) * 2048u; }
  __device__ __forceinline__ const char* b_base(const pg8::Unit& u) const { return W2 + ((size_t)u.e * 1024 + (size_t)u.pn * 256) * 2048; }
  __device__ __forceinline__ void epi(const f32x4 (&acc)[2][2][4][2], const pg8::Unit& u, int wr, int wc, int fr, int fq) const {
    const int row0 = u.row0 + wr * 64 + fr, colb = u.pn * 256 + wc * 32 + 8 * fq;
#pragma unroll
    for (int ai = 0; ai < 2; ++ai)
#pragma unroll
      for (int m = 0; m < 4; ++m)
#pragma unroll
        for (int bj = 0; bj < 2; ++bj) {
          const f32x4 v0 = acc[ai][bj][m][0], v1 = acc[ai][bj][m][1];
          u32x4 w; w.x = pk2(v0[0], v0[1]); w.y = pk2(v0[2], v0[3]); w.z = pk2(v1[0], v1[1]); w.w = pk2(v1[2], v1[3]);
          *(u32x4*)(Y + (size_t)(row0 + ai * 128 + m * 16) * 1024 + colb + bj * 128) = w;
        }
  }
};

template <int NS>
__device__ __forceinline__ void side_phase(unsigned char* lds_, int wv, const Params& p, int layer) {
  const Ctx c = make_ctx(lds_, wv);
  const bf16_t* hb = (const bf16_t*)(p.ws + WS_HB);
  const bf16_t* wt = (const bf16_t*)(p.ws + (layer == 0 ? WS_WIN_AB : WS_WIN_CD)) + (size_t)(layer == 0 ? PM_AB : PM_CD) * 1024;
  const float* bias = p.in[layer == 0 ? I_AB_B_IN : I_CD_B_IN] + (layer == 0 ? PM_AB : PM_CD);
  float* side = (float*)(p.ws + WS_SIDE);
  float* tl = (float*)c.lds + c.wid * (16 * 33);
  const int fr = c.lane & 15, fq = c.lane >> 4;
  for (int g = c.bid * 8 + c.wid; g < NTOK / 16; g += c.G * 8) {
    const int r0 = g * 16;
    f32x4 acc0 = (f32x4){0.f, 0.f, 0.f, 0.f}, acc1 = acc0;
    const bf16_t* ap = hb + (size_t)(r0 + fr) * 1024 + fq * 8;
    const bf16_t* bp0 = wt + (size_t)fr * 1024 + fq * 8; const bf16_t* bp1 = bp0 + 16 * 1024;
#pragma unroll 4
    for (int k = 0; k < 1024; k += 32) {
      const bf16x8 a = *(const bf16x8*)(ap + k), b0 = *(const bf16x8*)(bp0 + k);
      acc0 = __builtin_amdgcn_mfma_f32_16x16x32_bf16(a, b0, acc0, 0, 0, 0);
      if (NS == 32) { const bf16x8 b1 = *(const bf16x8*)(bp1 + k); acc1 = __builtin_amdgcn_mfma_f32_16x16x32_bf16(a, b1, acc1, 0, 0, 0); }
    }
#pragma unroll
    for (int j = 0; j < 4; ++j) { const float v0 = acc0[j] + bias[fr]; side[(size_t)(r0 + fq * 4 + j) * 32 + fr] = v0; tl[(fq * 4 + j) * 33 + fr] = v0;
      if (NS == 32) { const float v1 = acc1[j] + bias[16 + fr]; side[(size_t)(r0 + fq * 4 + j) * 32 + 16 + fr] = v1; tl[(fq * 4 + j) * 33 + 16 + fr] = v1; } }
    if (NS == 32) {
      __builtin_amdgcn_s_waitcnt(0xC07F);
      const float* gu = p.in[I_GK_UP]; const float* gb = p.in[I_GK_B]; bf16_t* lfb = (bf16_t*)(p.ws + WS_LFB);
      const int cb = c.lane * 8, dir = cb >> 8, cc = cb & 255;
      float w[16][8];
#pragma unroll
      for (int r = 0; r < 16; ++r)
#pragma unroll
        for (int j = 0; j < 8; ++j) w[r][j] = gu[(dir * 16 + r) * 256 + cc + j];
      float bb[8];
#pragma unroll
      for (int j = 0; j < 8; ++j) bb[j] = gb[dir * 256 + cc + j];
      constexpr float LFS = 0.0625f * 1.4426950408889634f;
      for (int row = 0; row < 16; ++row) {
        float z[8];
#pragma unroll
        for (int j = 0; j < 8; ++j) z[j] = bb[j];
#pragma unroll
        for (int r = 0; r < 16; ++r) { const float s = tl[row * 33 + dir * 16 + r];
#pragma unroll
          for (int j = 0; j < 8; ++j) z[j] += s * w[r][j]; }
        u32x4 o; o.x = pk2(logsigmoidf_(z[0]) * LFS, logsigmoidf_(z[1]) * LFS); o.y = pk2(logsigmoidf_(z[2]) * LFS, logsigmoidf_(z[3]) * LFS);
        o.z = pk2(logsigmoidf_(z[4]) * LFS, logsigmoidf_(z[5]) * LFS); o.w = pk2(logsigmoidf_(z[6]) * LFS, logsigmoidf_(z[7]) * LFS);
        *(u32x4*)(lfb + (size_t)(r0 + row) * 512 + cb) = o;
      }
    }
  }
}

__device__ __forceinline__ void headnorm_phase(unsigned char* lds_, int wv, const Params& p, int layer) {
  const Ctx c = make_ctx(lds_, wv);
  const bf16_t* P = (const bf16_t*)(p.ws + WS_R1); const bf16_t* O = (const bf16_t*)(p.ws + WS_R2);
  bf16_t* mixed = (bf16_t*)(p.ws + WS_HB);
  const int c0 = c.lane * 16, h8 = c.lane >> 3;
  const float* gain = layer == 0 ? (h8 < 4 ? p.in[I_HGRN_NORM] + c0 : p.in[I_GLA_NORM] + c0 - 512) : (h8 < 4 ? p.in[I_RET_NORM] + c0 : p.in[I_MLSTM_NORM] + c0 - 512);
  const int gcol = layer == 0 ? (h8 < 4 ? 2048 + c0 : 3584 + c0 - 512) : (h8 < 4 ? 1024 + c0 : 3072 + c0 - 512);
  float gn[16];
#pragma unroll
  for (int j = 0; j < 16; ++j) gn[j] = gain[j];
  for (int tok = c.bid * 8 + c.wid; tok < NTOK; tok += c.G * 8) {
    float of[16], ob[16], gt[16];
    { const u32x4* a = (const u32x4*)(O + (size_t)tok * 1024 + c0); unpack8(a[0], of); unpack8(a[1], of + 8);
      const u32x4* b = (const u32x4*)(O + (size_t)(NTOK + tok) * 1024 + c0); unpack8(b[0], ob); unpack8(b[1], ob + 8);
      const u32x4* g = (const u32x4*)(P + (size_t)tok * PSTRIDE + gcol); unpack8(g[0], gt); unpack8(g[1], gt + 8); }
    const float sf = 1.f, sb = 1.f;
    float o[16]; float ss = 0.f;
#pragma unroll
    for (int j = 0; j < 16; ++j) { o[j] = of[j] * sf + ob[j] * sb; ss += o[j] * o[j]; }
    ss += __shfl_xor(ss, 1); ss += __shfl_xor(ss, 2); ss += __shfl_xor(ss, 4);
    const float r = 1.0f / sqrtf(ss * (1.0f / 128.0f) + NORM_EPS_F);
    unsigned w[8];
#pragma unroll
    for (int j = 0; j < 8; ++j) {
      float g0 = gt[2 * j], g1 = gt[2 * j + 1];
      if (layer == 1 && h8 >= 4) { g0 = sigmoidf_(g0); g1 = sigmoidf_(g1); } else { g0 = siluf_(g0); g1 = siluf_(g1); }
      w[j] = pk2(o[2 * j] * r * gn[2 * j] * g0, o[2 * j + 1] * r * gn[2 * j + 1] * g1);
    }
    u32x4* d = (u32x4*)(mixed + (size_t)tok * 1024 + c0);
    d[0] = (u32x4){w[0], w[1], w[2], w[3]}; d[1] = (u32x4){w[4], w[5], w[6], w[7]};
  }
}

__device__ __forceinline__ void ln_phase(unsigned char* lds_, int wv, const Params& p, int layer, int mode) {
  const Ctx c = make_ctx(lds_, wv);
  unsigned char* ws = p.ws;
  const float* hin = (mode == 0 && layer == 0) ? p.in[I_X] : p.out;
  float* hout = p.out; bf16_t* hb = (bf16_t*)(ws + WS_HB);
  const float* g = p.in[mode == 0 ? I_LN_MIX_G : I_LN_FFN_G] + layer * 1024; const float* b = p.in[mode == 0 ? I_LN_MIX_B : I_LN_FFN_B] + layer * 1024;
  unsigned* cnt = (unsigned*)(ws + WS_CTL) + CW_CNT(layer);
  int* list = (int*)(ws + WS_LIST) + (size_t)layer * NEXP * NTOK;
  int* assign = (int*)(ws + WS_ASSIGN); float* gate = (float*)(ws + WS_GATE);
  float* rwT = (float*)c.lds;
  int* lcnt = (int*)(c.lds + 65536); int* lbase = lcnt + 16; int* rec = lcnt + 32; float* recg = (float*)(rec + 4 * 2048);
  int pad[NEXP];
  if (mode == 0) { const float* r = p.in[I_ROUTER_W];
    for (int i = c.tid; i < 1024 * 16; i += NTHREADS) rwT[(i & 15) * 1024 + (i >> 4)] = r[i];
    if (c.tid < 16) lcnt[c.tid] = 0;
    __syncthreads(); }
  else { int acc = 0;
#pragma unroll
    for (int e = 0; e < NEXP; ++e) { pad[e] = acc; acc += (((int)cnt[e * 16] + 255) >> 8) << 8; } }
  const int c0 = c.lane * 4;
  float gv[16], bv[16];
#pragma unroll
  for (int q = 0; q < 4; ++q) { const f32x4 t0 = *(const f32x4*)(g + q * 256 + c0), t1 = *(const f32x4*)(b + q * 256 + c0);
#pragma unroll
    for (int j = 0; j < 4; ++j) { gv[4 * q + j] = t0[j]; bv[4 * q + j] = t1[j]; } }
  int it = 0;
  for (int tok = c.bid * 8 + c.wid; tok < NTOK; tok += c.G * 8, ++it) {
    float v[16];
#pragma unroll
    for (int q = 0; q < 4; ++q) { const f32x4 t = *(const f32x4*)(hin + (size_t)tok * 1024 + q * 256 + c0); v[4 * q] = ALPHA_F * t[0]; v[4 * q + 1] = ALPHA_F * t[1]; v[4 * q + 2] = ALPHA_F * t[2]; v[4 * q + 3] = ALPHA_F * t[3]; }
    if (mode == 0) {
#pragma unroll
      for (int q = 0; q < 4; ++q) { const f32x4 t = *(const f32x4*)((const float*)(ws + WS_R2) + (size_t)tok * 1024 + q * 256 + c0); v[4 * q] += t[0]; v[4 * q + 1] += t[1]; v[4 * q + 2] += t[2]; v[4 * q + 3] += t[3]; }
    } else {
      const int a0 = assign[tok * 4], a1 = assign[tok * 4 + 1], a2 = assign[tok * 4 + 2], a3 = assign[tok * 4 + 3];
      const float g0 = gate[tok * 2], g1 = gate[tok * 2 + 1];
      int p0 = 0, p1 = 0;
#pragma unroll
      for (int e = 0; e < NEXP; ++e) { if (e == a0) p0 = pad[e]; if (e == a2) p1 = pad[e]; }
      p0 += a1; p1 += a3;
      const bf16_t* Y = (const bf16_t*)(ws + WS_R2);
#pragma unroll
      for (int q = 0; q < 4; ++q) { const u32x2 y0 = *(const u32x2*)(Y + (size_t)p0 * 1024 + q * 256 + c0), y1 = *(const u32x2*)(Y + (size_t)p1 * 1024 + q * 256 + c0);
        v[4 * q] += g0 * __uint_as_float(y0.x << 16) + g1 * __uint_as_float(y1.x << 16); v[4 * q + 1] += g0 * __uint_as_float(y0.x & 0xffff0000u) + g1 * __uint_as_float(y1.x & 0xffff0000u);
        v[4 * q + 2] += g0 * __uint_as_float(y0.y << 16) + g1 * __uint_as_float(y1.y << 16); v[4 * q + 3] += g0 * __uint_as_float(y0.y & 0xffff0000u) + g1 * __uint_as_float(y1.y & 0xffff0000u); }
    }
    float s = 0.f;
#pragma unroll
    for (int j = 0; j < 16; ++j) s += v[j];
    const float mean = wave_sum(s) * (1.0f / 1024.0f);
    float qq = 0.f;
#pragma unroll
    for (int j = 0; j < 16; ++j) { v[j] -= mean; qq += v[j] * v[j]; }
    const float r = 1.0f / sqrtf(wave_sum(qq) * (1.0f / 1024.0f) + LN_EPS_F);
#pragma unroll
    for (int j = 0; j < 16; ++j) v[j] = v[j] * r * gv[j] + bv[j];
#pragma unroll
    for (int q = 0; q < 4; ++q) *(f32x4*)(hout + (size_t)tok * 1024 + q * 256 + c0) = (f32x4){v[4 * q], v[4 * q + 1], v[4 * q + 2], v[4 * q + 3]};
    if (!(mode == 1 && layer == 1)) {
#pragma unroll
      for (int q = 0; q < 4; ++q) *(u32x2*)(hb + (size_t)tok * 1024 + q * 256 + c0) = (u32x2){pk2(v[4 * q], v[4 * q + 1]), pk2(v[4 * q + 2], v[4 * q + 3])}; }
    if (mode == 0) {
      float lg[16];
#pragma unroll
      for (int e = 0; e < 16; ++e) { float a = 0.f;
#pragma unroll
        for (int q = 0; q < 4; ++q) { const f32x4 w = *(const f32x4*)(rwT + e * 1024 + q * 256 + c0); a += v[4 * q] * w[0] + v[4 * q + 1] * w[1] + v[4 * q + 2] * w[2] + v[4 * q + 3] * w[3]; }
        lg[e] = a; }
#pragma unroll
      for (int e = 0; e < 16; ++e) lg[e] = wave_sum(lg[e]);
      int eo[2]; float go[2];
      route_from_logits(lg, p.in[I_ROUTER_B], eo, go);
      if (c.lane == 0) {
        const int r1 = atomicAdd(lcnt + eo[0], 1), r2 = atomicAdd(lcnt + eo[1], 1);
        const int ri = it * 8 + c.wid;
        rec[ri * 4] = eo[0]; rec[ri * 4 + 1] = r1; rec[ri * 4 + 2] = eo[1]; rec[ri * 4 + 3] = r2; recg[ri * 2] = go[0]; recg[ri * 2 + 1] = go[1];
      }
    }
  }
  if (mode == 0) {
    __syncthreads();
    if (c.tid < 16) lbase[c.tid] = (int)atomicAdd(cnt + c.tid * 16, (unsigned)lcnt[c.tid]);
    __syncthreads();
    const int nrec = ((NTOK + c.G * 8 - 1) / (c.G * 8)) * 8;
    for (int ri = c.tid; ri < nrec; ri += NTHREADS) {
      const int tok = c.bid * 8 + (ri & 7) + (ri >> 3) * c.G * 8;
      if (tok < NTOK) {
        const int e1 = rec[ri * 4], e2 = rec[ri * 4 + 2]; const int r1 = rec[ri * 4 + 1] + lbase[e1], r2 = rec[ri * 4 + 3] + lbase[e2];
        list[e1 * NTOK + r1] = tok; list[e2 * NTOK + r2] = tok;
        assign[tok * 4] = e1; assign[tok * 4 + 1] = r1; assign[tok * 4 + 2] = e2; assign[tok * 4 + 3] = r2;
        gate[tok * 2] = recg[ri * 2]; gate[tok * 2 + 1] = recg[ri * 2 + 1];
      }
    }
  }
  __syncthreads();
}
#endif
#ifndef CPU_EMU
namespace scan {
typedef short bf16x8 __attribute__((ext_vector_type(8)));
typedef float f32x4 __attribute__((ext_vector_type(4)));
typedef unsigned u32x4 __attribute__((ext_vector_type(4)));
typedef unsigned u32x2 __attribute__((ext_vector_type(2)));
enum { MIX_A = 0, MIX_B = 1, MIX_C = 2, MIX_D = 3 };
constexpr int LD_T = 144;
constexpr int OFF_QS = 0, OFF_KS = 17408, OFF_QI = 34816, OFF_KT = 52224, OFF_VT = 70656, OFF_SC = 77568, OFF_ST = 86784, OFF_DEC = 99840, OFF_EM = 100352, OFF_DEN = 100608, OFF_CW = 100864, SCAN_LDS = 104960;

__device__ __forceinline__ float incl_scan_add(float x) {
  x += __builtin_bit_cast(float, __builtin_amdgcn_update_dpp(0, __builtin_bit_cast(int, x), 0x111, 0xf, 0xf, false));
  x += __builtin_bit_cast(float, __builtin_amdgcn_update_dpp(0, __builtin_bit_cast(int, x), 0x112, 0xf, 0xf, false));
  x += __builtin_bit_cast(float, __builtin_amdgcn_update_dpp(0, __builtin_bit_cast(int, x), 0x114, 0xf, 0xf, false));
  x += __builtin_bit_cast(float, __builtin_amdgcn_update_dpp(0, __builtin_bit_cast(int, x), 0x118, 0xf, 0xf, false));
  x += __builtin_bit_cast(float, __builtin_amdgcn_update_dpp(0, __builtin_bit_cast(int, x), 0x142, 0xa, 0xf, false));
  x += __builtin_bit_cast(float, __builtin_amdgcn_update_dpp(0, __builtin_bit_cast(int, x), 0x143, 0xc, 0xf, false));
  return x;
}
__device__ __forceinline__ float incl_scan_max(float x) {
  const int ninf = (int)0xff800000u;
  x = fmaxf(x, __builtin_bit_cast(float, __builtin_amdgcn_update_dpp(ninf, __builtin_bit_cast(int, x), 0x111, 0xf, 0xf, false)));
  x = fmaxf(x, __builtin_bit_cast(float, __builtin_amdgcn_update_dpp(ninf, __builtin_bit_cast(int, x), 0x112, 0xf, 0xf, false)));
  x = fmaxf(x, __builtin_bit_cast(float, __builtin_amdgcn_update_dpp(ninf, __builtin_bit_cast(int, x), 0x114, 0xf, 0xf, false)));
  x = fmaxf(x, __builtin_bit_cast(float, __builtin_amdgcn_update_dpp(ninf, __builtin_bit_cast(int, x), 0x118, 0xf, 0xf, false)));
  x = fmaxf(x, __builtin_bit_cast(float, __builtin_amdgcn_update_dpp(ninf, __builtin_bit_cast(int, x), 0x142, 0xa, 0xf, false)));
  x = fmaxf(x, __builtin_bit_cast(float, __builtin_amdgcn_update_dpp(ninf, __builtin_bit_cast(int, x), 0x143, 0xc, 0xf, false)));
  return x;
}
__device__ __forceinline__ float rdlane(float x, int l) { return __builtin_bit_cast(float, __builtin_amdgcn_readlane(__builtin_bit_cast(int, x), l)); }
__device__ __forceinline__ bf16x8 ldfrag(const unsigned char* base, int ld, int row, int kbyte) { return *(const bf16x8*)(base + row * ld + kbyte); }
__device__ __forceinline__ unsigned pk(float a, float b) { return pk_hw(a, b); }
__device__ __forceinline__ float lo16(unsigned w) { return __uint_as_float(w << 16); }
__device__ __forceinline__ float hi16(unsigned w) { return __uint_as_float(w & 0xffff0000u); }

__device__ __forceinline__ void lds_barrier() { asm volatile("s_waitcnt lgkmcnt(0)" ::: "memory"); __builtin_amdgcn_s_barrier(); asm volatile("" ::: "memory"); }
struct Raw { u32x4 a0, a1, b0, b1; f32x4 r0, r1; u32x2 v; float s0, s1; };

template <int MIXER>
__device__ __forceinline__ void scan_item(unsigned char* lds, int wv, const Params& p, int b, int h, int dir, int vs) {
  constexpr int DK = (MIXER == MIX_A || MIXER == MIX_D) ? 128 : 64;
  constexpr int NC = DK / 8;
  constexpr int LD_D = DK * 2 + 16;
  constexpr int NVT = MIXER == MIX_D ? 3 : 2;
  constexpr int NKD = DK / 32;
  const int tid = opaque_tid(wv), lane0 = tid & 63, wid = __builtin_amdgcn_readfirstlane(tid >> 6);
  unsigned char* ws = p.ws;
  const bf16_t* P = (const bf16_t*)(ws + WS_R1);
  const bf16_t* LFBp = (const bf16_t*)(ws + WS_LFB);
  const float* side = (const float*)(ws + WS_SIDE);
  const float* rope = (const float*)(ws + WS_ROPE);
  bf16_t* O = (bf16_t*)(ws + WS_R2) + (size_t)dir * NTOK * 1024;
  unsigned char* QS = lds + OFF_QS; unsigned char* KS = lds + OFF_KS; unsigned char* QI = lds + OFF_QI; unsigned char* KT = lds + OFF_KT;
  unsigned char* VT = lds + OFF_VT; unsigned char* SC = lds + OFF_SC; unsigned char* ST = lds + OFF_ST;
  float* DEC = (float*)(lds + OFF_DEC); float* EM = (float*)(lds + OFF_EM); float* DEN = (float*)(lds + OFF_DEN);

  int qcol, kcol, lfcol, vcol, ocol;
  if (MIXER == MIX_A) { qcol = h * 128; kcol = 0; lfcol = 512 + dir * 512 + h * 128; vcol = 1536 + h * 128 + vs * 32; ocol = h * 128 + vs * 32; }
  else if (MIXER == MIX_B) { qcol = 2560 + h * 64; kcol = 2816 + h * 64; lfcol = dir * 256 + h * 64; vcol = 3072 + h * 128 + vs * 32; ocol = 512 + h * 128 + vs * 32; }
  else if (MIXER == MIX_C) { qcol = h * 64; kcol = 256 + h * 64; lfcol = 0; vcol = 512 + h * 128 + vs * 32; ocol = h * 128 + vs * 32; }
  else { qcol = h * 128  ; kcol = 3584 + h * 128  ; lfcol = 0; vcol = 2560 + h * 128 + vs * 32; ocol = 512 + h * 128 + vs * 32; }
  const int c0 = (MIXER == MIX_C) ? wid * 4 : wid * NC;
  const float lgam = (MIXER == MIX_C) ? log1pf(-exp2f(-(5.0f + 2.0f * (float)h + (float)dir))) : 0.f;
  const float fgb = (MIXER == MIX_D) ? p.in[I_FGATE_B][dir * 4 + h] : 0.f;
  for (int i = tid; i < 48 * LD_D / 4; i += NTHREADS) ((unsigned*)ST)[i] = 0u;
  if (MIXER == MIX_D) {
    for (int i = tid; i < 16 * 64; i += NTHREADS) { const int r = 32 + (i >> 6), j = i & 63; *(bf16_t*)(VT + r * LD_T + j * 2) = (r == 32) ? (bf16_t)0x3F80 : (bf16_t)0; }
  }
  f32x4 sacc[NVT == 3 ? 3 : 2];
#pragma unroll
  for (int i = 0; i < (NVT == 3 ? 3 : 2); ++i) sacc[i] = (f32x4){0.f, 0.f, 0.f, 0.f};
  float m_st = 0.f;
  const size_t tokbase = (size_t)b * SEQ;
  const int sgn = dir ? -1 : 1;
  __syncthreads();

  Raw R;
#define SCAN_LOAD(n_) do { \
    int ln_ = lane0; asm volatile("" : "+v"(ln_)); \
    const int t_ = dir ? (SEQ - 1 - ((n_) * 64 + ln_)) : ((n_) * 64 + ln_); \
    const bf16_t* row_ = P + (tokbase + t_) * PSTRIDE; \
    if (MIXER == MIX_A) { const u32x4* qp_ = (const u32x4*)(row_ + qcol + c0); const u32x4* lp_ = (const u32x4*)(row_ + lfcol + c0); R.a0 = qp_[0]; R.a1 = qp_[1]; R.b0 = lp_[0]; R.b1 = lp_[1]; } \
    else if (MIXER == MIX_B) { R.a0 = *(const u32x4*)(row_ + qcol + c0); R.a1 = *(const u32x4*)(row_ + kcol + c0); R.b0 = *(const u32x4*)(LFBp + (tokbase + t_) * 512 + lfcol + c0); } \
    else if (MIXER == MIX_C) { const u32x2 qa_ = *(const u32x2*)(row_ + qcol + c0), qb_ = *(const u32x2*)(row_ + qcol + 32 + c0), ka_ = *(const u32x2*)(row_ + kcol + c0), kb_ = *(const u32x2*)(row_ + kcol + 32 + c0); \
      R.a0 = (u32x4){qa_.x, qa_.y, qb_.x, qb_.y}; R.a1 = (u32x4){ka_.x, ka_.y, kb_.x, kb_.y}; \
      R.r0 = *(const f32x4*)(rope + ((size_t)t_ * 32 + c0) * 2); R.r1 = *(const f32x4*)(rope + ((size_t)t_ * 32 + c0) * 2 + 4); } \
    else { const u32x4* qp_ = (const u32x4*)(LFBp + (tokbase + t_) * 512 + qcol + c0); const u32x4* kp_ = (const u32x4*)(row_ + kcol + c0); R.a0 = qp_[0]; R.a1 = qp_[1]; R.b0 = kp_[0]; R.b1 = kp_[1]; \
      R.s0 = side[(tokbase + t_) * 32 + dir * 8 + h]; R.s1 = side[(tokbase + t_) * 32 + dir * 8 + 4 + h]; } \
    R.v = *(const u32x2*)(row_ + vcol + wid * 4); } while (0)

  SCAN_LOAD(0);
  for (int n = 0; n < SEQ / 64; ++n) {
    int lane = lane0; asm volatile("" : "+v"(lane));
    const int fr = lane & 15, fq = lane >> 4;
    float q[NC], k[NC], g[NC];
    const u32x2 vv = R.v;
    float g_li = 0.f, g_lf = 0.f;
    if (MIXER == MIX_A) {
      const unsigned qw[8] = {R.a0.x, R.a0.y, R.a0.z, R.a0.w, R.a1.x, R.a1.y, R.a1.z, R.a1.w}, lw[8] = {R.b0.x, R.b0.y, R.b0.z, R.b0.w, R.b1.x, R.b1.y, R.b1.z, R.b1.w};
#pragma unroll
      for (int c = 0; c < 8; ++c) { q[2 * c] = lo16(qw[c]); q[2 * c + 1] = hi16(qw[c]); g[2 * c] = lo16(lw[c]); g[2 * c + 1] = hi16(lw[c]); }
#pragma unroll
      for (int c = 0; c < NC; ++c) k[c] = 1.0f - __expf(g[c]);
    } else if (MIXER == MIX_B) {
      const unsigned qw[4] = {R.a0.x, R.a0.y, R.a0.z, R.a0.w}, kw[4] = {R.a1.x, R.a1.y, R.a1.z, R.a1.w}, lw[4] = {R.b0.x, R.b0.y, R.b0.z, R.b0.w};
#pragma unroll
      for (int c = 0; c < 4; ++c) { q[2 * c] = lo16(qw[c]); q[2 * c + 1] = hi16(qw[c]); k[2 * c] = lo16(kw[c]); k[2 * c + 1] = hi16(kw[c]); g[2 * c] = lo16(lw[c]); g[2 * c + 1] = hi16(lw[c]); }
    } else if (MIXER == MIX_C) {
      const float cs[4] = {R.r0[0], R.r0[2], R.r1[0], R.r1[2]}, sn[4] = {R.r0[1], R.r0[3], R.r1[1], R.r1[3]};
      const float q1[4] = {lo16(R.a0.x), hi16(R.a0.x), lo16(R.a0.y), hi16(R.a0.y)}, q2[4] = {lo16(R.a0.z), hi16(R.a0.z), lo16(R.a0.w), hi16(R.a0.w)};
      const float k1[4] = {lo16(R.a1.x), hi16(R.a1.x), lo16(R.a1.y), hi16(R.a1.y)}, k2[4] = {lo16(R.a1.z), hi16(R.a1.z), lo16(R.a1.w), hi16(R.a1.w)};
#pragma unroll
      for (int c = 0; c < 4; ++c) { q[c] = (q1[c] * cs[c] - q2[c] * sn[c]) * 0.125f; q[4 + c] = (q1[c] * sn[c] + q2[c] * cs[c]) * 0.125f; k[c] = k1[c] * cs[c] - k2[c] * sn[c]; k[4 + c] = k1[c] * sn[c] + k2[c] * cs[c]; }
#pragma unroll
      for (int c = 0; c < NC; ++c) g[c] = (float)(lane + 1) * lgam;
    } else {
      const unsigned qw[8] = {R.a0.x, R.a0.y, R.a0.z, R.a0.w, R.a1.x, R.a1.y, R.a1.z, R.a1.w}, kw[8] = {R.b0.x, R.b0.y, R.b0.z, R.b0.w, R.b1.x, R.b1.y, R.b1.z, R.b1.w};
      g_li = R.s0; g_lf = R.s1;
#pragma unroll
      for (int c = 0; c < 8; ++c) { q[2 * c] = lo16(qw[c]); q[2 * c + 1] = hi16(qw[c]); k[2 * c] = lo16(kw[c]); k[2 * c + 1] = hi16(kw[c]); }
#pragma unroll
      for (int c = 0; c < NC; ++c) g[c] = 0.f;
    }
    if (n + 1 < SEQ / 64) SCAN_LOAD(n + 1);

#ifndef PROBE_REPA
#define PROBE_REPA 1
#endif
    const float m_save = m_st;
#pragma unroll 1
    for (int rep = 0; rep < PROBE_REPA; ++rep) {
    if (PROBE_REPA > 1) { m_st = m_save;
#pragma unroll
      for (int c = 0; c < NC; ++c) asm volatile("" : "+v"(g[c]), "+v"(q[c]), "+v"(k[c])); }
    float s_qs[NC], s_ks[NC], s_qi[NC], s_kt[NC];
    if (MIXER != MIX_D) {
#pragma unroll
      for (int c = 0; c < NC; ++c) {
        const float gc = (MIXER == MIX_C) ? g[c] : incl_scan_add(g[c]);
        const float gref = rdlane(gc, 31), glast = rdlane(gc, 63);
        const float a = __expf(gc - gref), ia = __builtin_amdgcn_rcpf(a);
        s_qs[c] = a; s_ks[c] = ia; s_qi[c] = a * __expf(gref); s_kt[c] = ia * __expf(glast - gref);
        if (lane == 63) DEC[(MIXER == MIX_C) ? (c < 4 ? c0 + c : 32 + c0 + c - 4) : c0 + c] = __expf(glast);
      }
    } else {
      const float li = g_li;
      const float lf = logsigmoidf_(g_lf + fgb);
      const float bc = incl_scan_add(lf);
      const float u = li - bc;
      const float pm = incl_scan_max(u);
      const float cmax = rdlane(pm, 63), blast = rdlane(bc, 63);
      const float a_i = bc + m_st, m_i = fmaxf(a_i, bc + pm);
      const float alpha = __expf(bc - m_i + cmax), beta = __expf(u - cmax), sint = __expf(a_i - m_i);
      const float m_new = fmaxf(blast + m_st, blast + cmax);
      const float s_old = __expf(blast + m_st - m_new), wks = __expf(blast + u - m_new);
      m_st = m_new;
#pragma unroll
      for (int c = 0; c < NC; ++c) { s_qs[c] = alpha; s_ks[c] = beta; s_qi[c] = sint; s_kt[c] = wks; }
      if (wid == 0) EM[lane] = __expf(-m_i);
      if (lane == 63) {
#pragma unroll
        for (int c = 0; c < NC; ++c) DEC[c0 + c] = s_old;
      }
    }
    {
      unsigned wq[NC / 2], wk[NC / 2], wi[NC / 2];
#pragma unroll
      for (int c = 0; c < NC / 2; ++c) { wq[c] = pk(q[2 * c] * s_qs[2 * c], q[2 * c + 1] * s_qs[2 * c + 1]); wk[c] = pk(k[2 * c] * s_ks[2 * c], k[2 * c + 1] * s_ks[2 * c + 1]); wi[c] = pk(q[2 * c] * s_qi[2 * c], q[2 * c + 1] * s_qi[2 * c + 1]); }
      if (MIXER == MIX_C) {
        *(u32x2*)(QS + lane * LD_D + c0 * 2) = (u32x2){wq[0], wq[1]}; *(u32x2*)(QS + lane * LD_D + (32 + c0) * 2) = (u32x2){wq[2], wq[3]};
        *(u32x2*)(KS + lane * LD_D + c0 * 2) = (u32x2){wk[0], wk[1]}; *(u32x2*)(KS + lane * LD_D + (32 + c0) * 2) = (u32x2){wk[2], wk[3]};
        *(u32x2*)(QI + lane * LD_D + c0 * 2) = (u32x2){wi[0], wi[1]}; *(u32x2*)(QI + lane * LD_D + (32 + c0) * 2) = (u32x2){wi[2], wi[3]};
      } else {
#pragma unroll
        for (int c = 0; c < NC / 8; ++c) {
          *(u32x4*)(QS + lane * LD_D + (c0 + 8 * c) * 2) = (u32x4){wq[4 * c], wq[4 * c + 1], wq[4 * c + 2], wq[4 * c + 3]};
          *(u32x4*)(KS + lane * LD_D + (c0 + 8 * c) * 2) = (u32x4){wk[4 * c], wk[4 * c + 1], wk[4 * c + 2], wk[4 * c + 3]};
          *(u32x4*)(QI + lane * LD_D + (c0 + 8 * c) * 2) = (u32x4){wi[4 * c], wi[4 * c + 1], wi[4 * c + 2], wi[4 * c + 3]};
        }
      }
#pragma unroll
      for (int c = 0; c < NC; ++c) { const int d = (MIXER == MIX_C) ? (c < 4 ? c0 + c : 32 + c0 + c - 4) : c0 + c; *(bf16_t*)(KT + d * LD_T + lane * 2) = f2bf(k[c] * s_kt[c]); }
      *(bf16_t*)(VT + (wid * 4 + 0) * LD_T + lane * 2) = (bf16_t)(vv.x & 0xffff); *(bf16_t*)(VT + (wid * 4 + 1) * LD_T + lane * 2) = (bf16_t)(vv.x >> 16);
      *(bf16_t*)(VT + (wid * 4 + 2) * LD_T + lane * 2) = (bf16_t)(vv.y & 0xffff); *(bf16_t*)(VT + (wid * 4 + 3) * LD_T + lane * 2) = (bf16_t)(vv.y >> 16);
    }
    }
    lds_barrier();
    {
      const int it = wid & 3;
#pragma unroll
      for (int jj = 0; jj < 2; ++jj) {
        const int jt = 2 * (wid >> 2) + jj;
        if (jt <= it) {
          f32x4 acc = (f32x4){0.f, 0.f, 0.f, 0.f};
#pragma unroll
          for (int ks = 0; ks < NKD; ++ks) acc = __builtin_amdgcn_mfma_f32_16x16x32_bf16(ldfrag(KS, LD_D, jt * 16 + fr, ks * 64 + fq * 16), ldfrag(QS, LD_D, it * 16 + fr, ks * 64 + fq * 16), acc, 0, 0, 0);
          const int i = it * 16 + fr, j0 = jt * 16 + fq * 4;
          const float v0 = (j0 + 0 <= i) ? acc[0] : 0.f, v1 = (j0 + 1 <= i) ? acc[1] : 0.f, v2 = (j0 + 2 <= i) ? acc[2] : 0.f, v3 = (j0 + 3 <= i) ? acc[3] : 0.f;
          *(u32x2*)(SC + i * LD_T + j0 * 2) = (u32x2){pk(v0, v1), pk(v2, v3)};
        } else {
          const int i = it * 16 + fr, j0 = jt * 16 + fq * 4;
          *(u32x2*)(SC + i * LD_T + j0 * 2) = (u32x2){0u, 0u};
        }
      }
    }
    f32x4 oacc = (f32x4){0.f, 0.f, 0.f, 0.f}, dacc = (f32x4){0.f, 0.f, 0.f, 0.f};
    {
      const int vt = wid >> 2, it = wid & 3;
#pragma unroll
      for (int ks = 0; ks < NKD; ++ks) oacc = __builtin_amdgcn_mfma_f32_16x16x32_bf16(ldfrag(ST, LD_D, vt * 16 + fr, ks * 64 + fq * 16), ldfrag(QI, LD_D, it * 16 + fr, ks * 64 + fq * 16), oacc, 0, 0, 0);
      if (NVT == 3 && wid < 4) {
#pragma unroll
        for (int ks = 0; ks < NKD; ++ks) dacc = __builtin_amdgcn_mfma_f32_16x16x32_bf16(ldfrag(ST, LD_D, 32 + fr, ks * 64 + fq * 16), ldfrag(QI, LD_D, wid * 16 + fr, ks * 64 + fq * 16), dacc, 0, 0, 0);
      }
    }
    lds_barrier();
    {
      const int vt = wid >> 2, it = wid & 3;
#pragma unroll
      for (int ks = 0; ks < 2; ++ks) oacc = __builtin_amdgcn_mfma_f32_16x16x32_bf16(ldfrag(VT, LD_T, vt * 16 + fr, ks * 64 + fq * 16), ldfrag(SC, LD_T, it * 16 + fr, ks * 64 + fq * 16), oacc, 0, 0, 0);
      if (NVT == 3) {
        if (wid < 4) {
#pragma unroll
          for (int ks = 0; ks < 2; ++ks) dacc = __builtin_amdgcn_mfma_f32_16x16x32_bf16(ldfrag(VT, LD_T, 32 + fr, ks * 64 + fq * 16), ldfrag(SC, LD_T, wid * 16 + fr, ks * 64 + fq * 16), dacc, 0, 0, 0);
          if (fq == 0) DEN[wid * 16 + fr] = dacc[0];
        }
        lds_barrier();
        const int i = it * 16 + fr;
        const float dn = 1.0f / fmaxf(fabsf(DEN[i]), EM[i]);
        oacc *= dn;
      }
      const int i = it * 16 + fr;
      const int ti = dir ? (SEQ - 1 - (n * 64 + i)) : (n * 64 + i);
      *(u32x2*)(O + (tokbase + ti) * 1024 + ocol + vt * 16 + fq * 4) = (u32x2){pk(oacc[0], oacc[1]), pk(oacc[2], oacc[3])};
    }
    {
      constexpr int NST = (DK == 128) ? NVT : 1;
#pragma unroll
      for (int s = 0; s < NST; ++s) {
        const int dt = (DK == 128) ? wid : (wid & 3), vt = (DK == 128) ? s : (wid >> 2);
        const f32x4 dc = *(const f32x4*)(DEC + dt * 16 + fq * 4);
        f32x4 acc = sacc[s] * dc;
#pragma unroll
        for (int ks = 0; ks < 2; ++ks) acc = __builtin_amdgcn_mfma_f32_16x16x32_bf16(ldfrag(KT, LD_T, dt * 16 + fr, ks * 64 + fq * 16), ldfrag(VT, LD_T, vt * 16 + fr, ks * 64 + fq * 16), acc, 0, 0, 0);
        sacc[s] = acc;
        *(u32x2*)(ST + (vt * 16 + fr) * LD_D + (dt * 16 + fq * 4) * 2) = (u32x2){pk(acc[0], acc[1]), pk(acc[2], acc[3])};
      }
    }
    lds_barrier();
  }
}

template <int MIXER>
__device__ __forceinline__ void scan_dispatch(unsigned char* lds, int wv, const Params& p, int id) {
  const int vs = id & 3, dir = (id >> 2) & 1, h = (id >> 3) & 3, b = id >> 5;
  scan_item<MIXER>(lds, wv, p, b, h, dir, vs);
}
}

__device__ __forceinline__ void convd_phase(unsigned char* lds_, int wv, const Params& p) {
  const Ctx c = make_ctx(lds_, wv);
  bf16_t* P = (bf16_t*)(p.ws + WS_R1); bf16_t* QD = (bf16_t*)(p.ws + WS_LFB);
  const float* cw = p.in[I_CONV_W]; const float* cb = p.in[I_CONV_B];
  const int ch = c.lane * 16;
  float w0[16], w1[16], w2[16], bb[16];
#pragma unroll
  for (int j = 0; j < 16; ++j) { w0[j] = cw[ch + j]; w1[j] = cw[1024 + ch + j]; w2[j] = cw[2048 + ch + j]; bb[j] = cb[ch + j]; }
  for (int tok = c.bid * 8 + c.wid; tok < NTOK; tok += c.G * 8) {
    const int t = tok % SEQ;
    const bf16_t* row = P + (size_t)tok * PSTRIDE + 1536 + ch;
    float x0[16], x1[16], x2[16];
    { const u32x4* r1 = (const u32x4*)row; unpack8(r1[0], x1); unpack8(r1[1], x1 + 8); }
    if (t > 0) { const u32x4* r0 = (const u32x4*)(row - PSTRIDE); unpack8(r0[0], x0); unpack8(r0[1], x0 + 8); }
    else {
#pragma unroll
      for (int j = 0; j < 16; ++j) x0[j] = 0.f; }
    if (t < SEQ - 1) { const u32x4* r2 = (const u32x4*)(row + PSTRIDE); unpack8(r2[0], x2); unpack8(r2[1], x2 + 8); }
    else {
#pragma unroll
      for (int j = 0; j < 16; ++j) x2[j] = 0.f; }
    const float sc = ch < 512 ? 0.08838834764831845f : 1.0f;
    unsigned w[8];
#pragma unroll
    for (int j = 0; j < 8; ++j) {
      const float a0 = bb[2 * j] + w0[2 * j] * x0[2 * j] + w1[2 * j] * x1[2 * j] + w2[2 * j] * x2[2 * j];
      const float a1 = bb[2 * j + 1] + w0[2 * j + 1] * x0[2 * j + 1] + w1[2 * j + 1] * x1[2 * j + 1] + w2[2 * j + 1] * x2[2 * j + 1];
      w[j] = pk2(siluf_(a0) * sc, siluf_(a1) * sc);
    }
    u32x4* d = (ch < 512) ? (u32x4*)(QD + (size_t)tok * 512 + ch) : (u32x4*)(P + (size_t)tok * PSTRIDE + 3584 + (ch - 512));
    d[0] = (u32x4){w[0], w[1], w[2], w[3]}; d[1] = (u32x4){w[4], w[5], w[6], w[7]};
  }
}

__device__ __forceinline__ void scan_phase(unsigned char* lds, int wv, const Params& p, int layer) {
  for (int item = blockIdx.x; item < 256; item += gridDim.x) {
    if (layer == 0) { if (item < 128) scan::scan_dispatch<scan::MIX_A>(lds, wv, p, item); else scan::scan_dispatch<scan::MIX_B>(lds, wv, p, item - 128); }
    else { if (item < 128) scan::scan_dispatch<scan::MIX_D>(lds, wv, p, item); else scan::scan_dispatch<scan::MIX_C>(lds, wv, p, item - 128); }
    __syncthreads();
  }
}
#endif
#ifndef CPU_EMU
namespace scan2 {
using namespace scan;
constexpr int S_QS = 0, S_KS = 17408, S_QI = 34816, S_KT = 52224  , S_VT = 89088  , S_SC = 102912, S_ST = 112128  , S_DEC = 138240  , S_EM = 139264  , S_END = 139776;

constexpr int T_SC = 102912  , T_ST = 121344  , T_DEC = 147456  , T_EM = 148480  , T_END = 148992;
template <int MIXER>
__device__ __forceinline__ void scan_item2(unsigned char* lds, int wv, const Params& p, int b, int h, int dir, int vs) {
  constexpr int DK = (MIXER == MIX_A || MIXER == MIX_D) ? 128 : 64;
  constexpr int NC = DK / 8;
  constexpr int LD_D = DK * 2 + 16;
  constexpr int NVT = MIXER == MIX_D ? 3 : 2;
  constexpr int NKD = DK / 32;
  constexpr int NST = (DK == 128) ? NVT : 1;
  constexpr int NCH = SEQ / 64;
  const int tid = opaque_tid(wv), lane0 = tid & 63, wid = __builtin_amdgcn_readfirstlane(tid >> 6);
  unsigned char* ws = p.ws;
  const bf16_t* P = (const bf16_t*)(ws + WS_R1);
  const bf16_t* LFBp = (const bf16_t*)(ws + WS_LFB);
  const float* side = (const float*)(ws + WS_SIDE);
  const float* rope = (const float*)(ws + WS_ROPE);
  bf16_t* O = (bf16_t*)(ws + WS_R2) + (size_t)dir * NTOK * 1024;
  unsigned char* QS = lds + S_QS; unsigned char* KS = lds + S_KS; unsigned char* QI = lds + S_QI;
  unsigned char* SC = lds + T_SC + (wid >> 2) * 9216;
  int qcol, kcol, lfcol, vcol, ocol;
  if (MIXER == MIX_A) { qcol = h * 128; kcol = 0; lfcol = 512 + dir * 512 + h * 128; vcol = 1536 + h * 128 + vs * 32; ocol = h * 128 + vs * 32; }
  else if (MIXER == MIX_B) { qcol = 2560 + h * 64; kcol = 2816 + h * 64; lfcol = dir * 256 + h * 64; vcol = 3072 + h * 128 + vs * 32; ocol = 512 + h * 128 + vs * 32; }
  else if (MIXER == MIX_C) { qcol = h * 64; kcol = 256 + h * 64; lfcol = 0; vcol = 512 + h * 128 + vs * 32; ocol = h * 128 + vs * 32; }
  else { qcol = h * 128; kcol = 3584 + h * 128; lfcol = 0; vcol = 2560 + h * 128 + vs * 32; ocol = 512 + h * 128 + vs * 32; }
  const size_t tokbase = (size_t)b * SEQ;
  const int c0 = (MIXER == MIX_C) ? wid * 4 : wid * NC;
  for (int i = tid; i < 2 * 13056 / 4; i += NTHREADS) ((unsigned*)(lds + T_ST))[i] = 0u;
  for (int i = tid; i < 2 * 9216 / 4; i += NTHREADS) ((unsigned*)(lds + T_SC))[i] = 0u;
  if (MIXER == MIX_D) { for (int i = tid; i < 2 * 16 * 64; i += NTHREADS) { const int bf = i >> 10, r = 32 + ((i >> 6) & 15), j = i & 63; *(bf16_t*)(lds + S_VT + bf * 6912 + r * LD_T + j * 2) = (r == 32) ? (bf16_t)0x3F80 : (bf16_t)0; } }
  const float lgam2 = (MIXER == MIX_C) ? log1pf(-exp2f(-(5.0f + 2.0f * (float)h + (float)dir))) * 1.4426950408889634f : 0.f;
  const float fgb = (MIXER == MIX_D) ? p.in[I_FGATE_B][dir * 4 + h] : 0.f;
  float m_st = 0.f;
  __syncthreads();

  Raw R, Rn; u32x2 Rv, Rvn;
#define A_LOAD(R, Rv, n_) do { \
    int ln_ = lane0; asm volatile("" : "+v"(ln_)); \
    const int t_ = dir ? (SEQ - 1 - ((n_) * 64 + ln_)) : ((n_) * 64 + ln_); \
    const bf16_t* row_ = P + (tokbase + t_) * PSTRIDE; \
    if (MIXER == MIX_A) { const u32x4* qp_ = (const u32x4*)(row_ + qcol + c0); const u32x4* lp_ = (const u32x4*)(row_ + lfcol + c0); R.a0 = qp_[0]; R.a1 = qp_[1]; R.b0 = lp_[0]; R.b1 = lp_[1]; } \
    else if (MIXER == MIX_B) { R.a0 = *(const u32x4*)(row_ + qcol + c0); R.a1 = *(const u32x4*)(row_ + kcol + c0); R.b0 = *(const u32x4*)(LFBp + (tokbase + t_) * 512 + lfcol + c0); } \
    else if (MIXER == MIX_C) { const u32x2 qa_ = *(const u32x2*)(row_ + qcol + c0), qb_ = *(const u32x2*)(row_ + qcol + 32 + c0), ka_ = *(const u32x2*)(row_ + kcol + c0), kb_ = *(const u32x2*)(row_ + kcol + 32 + c0); \
      R.a0 = (u32x4){qa_.x, qa_.y, qb_.x, qb_.y}; R.a1 = (u32x4){ka_.x, ka_.y, kb_.x, kb_.y}; \
      R.r0 = *(const f32x4*)(rope + ((size_t)t_ * 32 + c0) * 2); R.r1 = *(const f32x4*)(rope + ((size_t)t_ * 32 + c0) * 2 + 4); } \
    else { const u32x4* qp_ = (const u32x4*)(LFBp + (tokbase + t_) * 512 + qcol + c0); const u32x4* kp_ = (const u32x4*)(row_ + kcol + c0); R.a0 = qp_[0]; R.a1 = qp_[1]; R.b0 = kp_[0]; R.b1 = kp_[1]; \
      R.s0 = side[(tokbase + t_) * 32 + dir * 8 + h]; R.s1 = side[(tokbase + t_) * 32 + dir * 8 + 4 + h]; } \
    Rv = *(const u32x2*)(row_ + vcol + wid * 4); } while (0)

  unsigned pq[NC / 2], pks[NC / 2], pqi[NC / 2];
#define A_PREP(buf_) do { \
    int lane = lane0; asm volatile("" : "+v"(lane)); \
    unsigned char* KTb = lds + S_KT + (buf_) * 18432; float* DECb = (float*)(lds + T_DEC + (buf_) * 512); float* EMb = (float*)(lds + T_EM + (buf_) * 256); \
    float q[NC], k[NC], g[NC], ktv[NC]; \
    if (MIXER == MIX_A) { \
      const unsigned qw[8] = {R.a0.x, R.a0.y, R.a0.z, R.a0.w, R.a1.x, R.a1.y, R.a1.z, R.a1.w}, lw[8] = {R.b0.x, R.b0.y, R.b0.z, R.b0.w, R.b1.x, R.b1.y, R.b1.z, R.b1.w}; \
      _Pragma("unroll") for (int c = 0; c < 8; ++c) { q[2 * c] = lo16(qw[c]); q[2 * c + 1] = hi16(qw[c]); g[2 * c] = lo16(lw[c]); g[2 * c + 1] = hi16(lw[c]); } \
      _Pragma("unroll") for (int c = 0; c < NC; ++c) k[c] = 1.0f - __builtin_amdgcn_exp2f(g[c]); \
    } else if (MIXER == MIX_B) { \
      const unsigned qw[4] = {R.a0.x, R.a0.y, R.a0.z, R.a0.w}, kw[4] = {R.a1.x, R.a1.y, R.a1.z, R.a1.w}, lw[4] = {R.b0.x, R.b0.y, R.b0.z, R.b0.w}; \
      _Pragma("unroll") for (int c = 0; c < 4; ++c) { q[2 * c] = lo16(qw[c]); q[2 * c + 1] = hi16(qw[c]); k[2 * c] = lo16(kw[c]); k[2 * c + 1] = hi16(kw[c]); g[2 * c] = lo16(lw[c]); g[2 * c + 1] = hi16(lw[c]); } \
    } else if (MIXER == MIX_C) { \
      const float cs[4] = {R.r0[0], R.r0[2], R.r1[0], R.r1[2]}, sn[4] = {R.r0[1], R.r0[3], R.r1[1], R.r1[3]}; \
      const float q1[4] = {lo16(R.a0.x), hi16(R.a0.x), lo16(R.a0.y), hi16(R.a0.y)}, q2[4] = {lo16(R.a0.z), hi16(R.a0.z), lo16(R.a0.w), hi16(R.a0.w)}; \
      const float k1[4] = {lo16(R.a1.x), hi16(R.a1.x), lo16(R.a1.y), hi16(R.a1.y)}, k2[4] = {lo16(R.a1.z), hi16(R.a1.z), lo16(R.a1.w), hi16(R.a1.w)}; \
      _Pragma("unroll") for (int c = 0; c < 4; ++c) { q[c] = (q1[c] * cs[c] - q2[c] * sn[c]) * 0.125f; q[4 + c] = (q1[c] * sn[c] + q2[c] * cs[c]) * 0.125f; k[c] = k1[c] * cs[c] - k2[c] * sn[c]; k[4 + c] = k1[c] * sn[c] + k2[c] * cs[c]; } \
    } else { \
      const unsigned qw[8] = {R.a0.x, R.a0.y, R.a0.z, R.a0.w, R.a1.x, R.a1.y, R.a1.z, R.a1.w}, kw[8] = {R.b0.x, R.b0.y, R.b0.z, R.b0.w, R.b1.x, R.b1.y, R.b1.z, R.b1.w}; \
      _Pragma("unroll") for (int c = 0; c < 8; ++c) { q[2 * c] = lo16(qw[c]); q[2 * c + 1] = hi16(qw[c]); k[2 * c] = lo16(kw[c]); k[2 * c + 1] = hi16(kw[c]); } \
    } \
    if (MIXER == MIX_A || MIXER == MIX_B) { \
        \
      _Pragma("unroll") for (int c = 0; c < NC; ++c) g[c] += __builtin_bit_cast(float, __builtin_amdgcn_update_dpp(0, __builtin_bit_cast(int, g[c]), 0x111, 0xf, 0xf, false)); \
      _Pragma("unroll") for (int c = 0; c < NC; ++c) g[c] += __builtin_bit_cast(float, __builtin_amdgcn_update_dpp(0, __builtin_bit_cast(int, g[c]), 0x112, 0xf, 0xf, false)); \
      _Pragma("unroll") for (int c = 0; c < NC; ++c) g[c] += __builtin_bit_cast(float, __builtin_amdgcn_update_dpp(0, __builtin_bit_cast(int, g[c]), 0x114, 0xf, 0xf, false)); \
      _Pragma("unroll") for (int c = 0; c < NC; ++c) g[c] += __builtin_bit_cast(float, __builtin_amdgcn_update_dpp(0, __builtin_bit_cast(int, g[c]), 0x118, 0xf, 0xf, false)); \
      _Pragma("unroll") for (int c = 0; c < NC; ++c) g[c] += __builtin_bit_cast(float, __builtin_amdgcn_update_dpp(0, __builtin_bit_cast(int, g[c]), 0x142, 0xa, 0xf, false)); \
      _Pragma("unroll") for (int c = 0; c < NC; ++c) g[c] += __builtin_bit_cast(float, __builtin_amdgcn_update_dpp(0, __builtin_bit_cast(int, g[c]), 0x143, 0xc, 0xf, false)); \
      float ev[NC]; \
      _Pragma("unroll") for (int c = 0; c < NC; ++c) { \
          \
        const float e = __builtin_amdgcn_exp2f(g[c]), r = __builtin_amdgcn_rcpf(e); \
        const float e31 = rdlane(e, 31), r31 = rdlane(r, 31), e63 = rdlane(e, 63); \
        const float qi = q[c] * e, kr = k[c] * r; \
        g[c] = qi; q[c] = qi * r31; k[c] = kr * e31; ktv[c] = kr * e63; \
        ev[c] = e; } \
      if (lane == 63) { _Pragma("unroll") for (int c = 0; c < NC / 4; ++c) *(f32x4*)(DECb + c0 + 4 * c) = (f32x4){ev[4 * c], ev[4 * c + 1], ev[4 * c + 2], ev[4 * c + 3]}; } \
    } else if (MIXER == MIX_C) { \
        \
      const float gl = (float)(lane + 1) * lgam2; \
      const float e = __builtin_amdgcn_exp2f(gl), r = __builtin_amdgcn_rcpf(e); \
      const float e31 = rdlane(e, 31), r31 = rdlane(r, 31), e63 = rdlane(e, 63); \
      const float f_qs = e * r31, f_ks = r * e31, f_kt = r * e63; \
      _Pragma("unroll") for (int c = 0; c < NC; ++c) { g[c] = q[c] * e; q[c] *= f_qs; ktv[c] = k[c] * f_kt; k[c] *= f_ks; } \
      if (lane < 4) { DECb[c0 + lane] = e63; DECb[32 + c0 + lane] = e63; } \
    } else { \
      const float li = R.s0 * 1.4426950408889634f; const float lf = logsigmoidf_(R.s1 + fgb) * 1.4426950408889634f;     \
      const float bc = incl_scan_add(lf); const float u = li - bc; const float pm = incl_scan_max(u); \
      const float cmax = rdlane(pm, 63), blast = rdlane(bc, 63); \
      const float a_i = bc + m_st, m_i = fmaxf(a_i, bc + pm); \
      const float d_alpha = __builtin_amdgcn_exp2f(bc - m_i + cmax), d_beta = __builtin_amdgcn_exp2f(u - cmax), d_sint = __builtin_amdgcn_exp2f(a_i - m_i); \
      const float m_new = fmaxf(blast + m_st, blast + cmax); \
      const float d_sold = __builtin_amdgcn_exp2f(blast + m_st - m_new), d_wks = __builtin_amdgcn_exp2f(blast + u - m_new); m_st = m_new; \
      _Pragma("unroll") for (int c = 0; c < NC; ++c) { ktv[c] = k[c] * d_wks; g[c] = q[c] * d_sint; q[c] *= d_alpha; k[c] *= d_beta; if (lane == 63) DECb[c0 + c] = d_sold; } \
      if (wid == 0) EMb[lane] = __builtin_amdgcn_exp2f(-m_i); \
    } \
    _Pragma("unroll") for (int c = 0; c < NC / 2; ++c) { const unsigned w_ = pk_hw(ktv[2 * c], ktv[2 * c + 1]); \
      const int d0_ = (MIXER == MIX_C) ? (2 * c < 4 ? c0 + 2 * c : 32 + c0 + 2 * c - 4) : c0 + 2 * c; \
      *(bf16_t*)(KTb + d0_ * LD_T + lane * 2) = (bf16_t)(w_ & 0xffff); *(bf16_t*)(KTb + (d0_ + 1) * LD_T + lane * 2) = (bf16_t)(w_ >> 16); } \
    _Pragma("unroll") for (int c = 0; c < NC / 2; ++c) { pq[c] = pk_hw(q[2 * c], q[2 * c + 1]); pks[c] = pk_hw(k[2 * c], k[2 * c + 1]); pqi[c] = pk_hw(g[2 * c], g[2 * c + 1]); } \
    { unsigned char* VTb = lds + S_VT + (buf_) * 6912 + (wid * 4) * LD_T + lane * 2; \
      *(bf16_t*)(VTb + 0 * LD_T) = (bf16_t)(Rv.x & 0xffff); *(bf16_t*)(VTb + 1 * LD_T) = (bf16_t)(Rv.x >> 16); *(bf16_t*)(VTb + 2 * LD_T) = (bf16_t)(Rv.y & 0xffff); *(bf16_t*)(VTb + 3 * LD_T) = (bf16_t)(Rv.y >> 16); } \
  } while (0)
#define A_WRITE() do { int lane = lane0; asm volatile("" : "+v"(lane)); \
    if (MIXER == MIX_C) { \
      *(u32x2*)(QS + lane * LD_D + c0 * 2) = (u32x2){pq[0], pq[1]}; *(u32x2*)(QS + lane * LD_D + (32 + c0) * 2) = (u32x2){pq[2], pq[3]}; \
      *(u32x2*)(KS + lane * LD_D + c0 * 2) = (u32x2){pks[0], pks[1]}; *(u32x2*)(KS + lane * LD_D + (32 + c0) * 2) = (u32x2){pks[2], pks[3]}; \
      *(u32x2*)(QI + lane * LD_D + c0 * 2) = (u32x2){pqi[0], pqi[1]}; *(u32x2*)(QI + lane * LD_D + (32 + c0) * 2) = (u32x2){pqi[2], pqi[3]}; \
    } else { \
      _Pragma("unroll") for (int c = 0; c < NC / 8; ++c) { \
        *(u32x4*)(QS + lane * LD_D + (c0 + 8 * c) * 2) = (u32x4){pq[4 * c], pq[4 * c + 1], pq[4 * c + 2], pq[4 * c + 3]}; \
        *(u32x4*)(KS + lane * LD_D + (c0 + 8 * c) * 2) = (u32x4){pks[4 * c], pks[4 * c + 1], pks[4 * c + 2], pks[4 * c + 3]}; \
        *(u32x4*)(QI + lane * LD_D + (c0 + 8 * c) * 2) = (u32x4){pqi[4 * c], pqi[4 * c + 1], pqi[4 * c + 2], pqi[4 * c + 3]}; } } } while (0)

  f32x4 sacc[NST];
#pragma unroll
  for (int i = 0; i < NST; ++i) sacc[i] = (f32x4){0.f, 0.f, 0.f, 0.f};
  A_LOAD(R, Rv, 0);
  A_PREP(0);
  A_LOAD(R, Rv, 1);
  A_LOAD(Rn, Rvn, 2);
  A_WRITE();
  lds_barrier();
  for (int n = 0; n < NCH; ++n) {
    const int cb = n & 1, nb = (n + 1) & 1;
#pragma unroll 1
    for (int pass = 0; pass < 2; ++pass) {
    if ((pass == 0) == (wid < 4)) {
    if (n + 1 < NCH) { A_PREP(nb); R = Rn; Rv = Rvn; if (n + 3 < NCH) A_LOAD(Rn, Rvn, n + 3); }
    } else {
      int lane = lane0; asm volatile("" : "+v"(lane));
      const int fr = lane & 15, fq = lane >> 4;
      const int it = wid & 3, vt = wid >> 2;
      const unsigned char* STc = lds + T_ST + cb * 13056; unsigned char* STn = lds + T_ST + nb * 13056;
      const unsigned char* KTc = lds + S_KT + cb * 18432; const unsigned char* VTc = lds + S_VT + cb * 6912;
      const float* DECc = (const float*)(lds + T_DEC + cb * 512); const float* EMc = (const float*)(lds + T_EM + cb * 256);
#pragma unroll
      for (int jt = 0; jt < 4; ++jt) {
        if (jt <= it) {
          f32x4 acc = (f32x4){0.f, 0.f, 0.f, 0.f};
#pragma unroll
          for (int ks = 0; ks < NKD; ++ks) acc = __builtin_amdgcn_mfma_f32_16x16x32_bf16(ldfrag(KS, LD_D, jt * 16 + fr, ks * 64 + fq * 16), ldfrag(QS, LD_D, it * 16 + fr, ks * 64 + fq * 16), acc, 0, 0, 0);
          const int i = it * 16 + fr, j0 = jt * 16 + fq * 4;
          const float v0 = (j0 + 0 <= i) ? acc[0] : 0.f, v1 = (j0 + 1 <= i) ? acc[1] : 0.f, v2 = (j0 + 2 <= i) ? acc[2] : 0.f, v3 = (j0 + 3 <= i) ? acc[3] : 0.f;
          *(u32x2*)(SC + i * LD_T + j0 * 2) = (u32x2){pk_hw(v0, v1), pk_hw(v2, v3)};
        }
      }
      f32x4 oacc = (f32x4){0.f, 0.f, 0.f, 0.f}, dacc = (f32x4){0.f, 0.f, 0.f, 0.f};
#pragma unroll
      for (int ks = 0; ks < NKD; ++ks) oacc = __builtin_amdgcn_mfma_f32_16x16x32_bf16(ldfrag(STc, LD_D, vt * 16 + fr, ks * 64 + fq * 16), ldfrag(QI, LD_D, it * 16 + fr, ks * 64 + fq * 16), oacc, 0, 0, 0);
      if (NVT == 3) {
#pragma unroll
        for (int ks = 0; ks < NKD; ++ks) dacc = __builtin_amdgcn_mfma_f32_16x16x32_bf16(ldfrag(STc, LD_D, 32 + fr, ks * 64 + fq * 16), ldfrag(QI, LD_D, it * 16 + fr, ks * 64 + fq * 16), dacc, 0, 0, 0);
      }
      asm volatile("s_waitcnt lgkmcnt(0)" ::: "memory");
      oacc = __builtin_amdgcn_mfma_f32_16x16x32_bf16(ldfrag(VTc, LD_T, vt * 16 + fr, fq * 16), ldfrag(SC, LD_T, it * 16 + fr, fq * 16), oacc, 0, 0, 0);
      if (it >= 2) oacc = __builtin_amdgcn_mfma_f32_16x16x32_bf16(ldfrag(VTc, LD_T, vt * 16 + fr, 64 + fq * 16), ldfrag(SC, LD_T, it * 16 + fr, 64 + fq * 16), oacc, 0, 0, 0);
      float dn = 1.0f;
      if (NVT == 3) {
        dacc = __builtin_amdgcn_mfma_f32_16x16x32_bf16(ldfrag(VTc, LD_T, 32 + fr, fq * 16), ldfrag(SC, LD_T, it * 16 + fr, fq * 16), dacc, 0, 0, 0);
        if (it >= 2) dacc = __builtin_amdgcn_mfma_f32_16x16x32_bf16(ldfrag(VTc, LD_T, 32 + fr, 64 + fq * 16), ldfrag(SC, LD_T, it * 16 + fr, 64 + fq * 16), dacc, 0, 0, 0);
        const float den = __shfl(dacc[0], fr);
        dn = 1.0f / fmaxf(fabsf(den), EMc[it * 16 + fr]);
      }
      {
        const int i = it * 16 + fr;
        const int ti = dir ? (SEQ - 1 - (n * 64 + i)) : (n * 64 + i);
        const f32x4 o = oacc * dn;
        *(u32x2*)(O + (tokbase + ti) * 1024 + ocol + vt * 16 + fq * 4) = (u32x2){pk_hw(o[0], o[1]), pk_hw(o[2], o[3])};
      }
#pragma unroll
      for (int s = 0; s < NST; ++s) {
        const int dt = (DK == 128) ? wid : (wid & 3), vt2 = (DK == 128) ? s : (wid >> 2);
        const f32x4 dc = *(const f32x4*)(DECc + dt * 16 + fq * 4);
        f32x4 acc = sacc[s] * dc;
#pragma unroll
        for (int ks = 0; ks < 2; ++ks) acc = __builtin_amdgcn_mfma_f32_16x16x32_bf16(ldfrag(KTc, LD_T, dt * 16 + fr, ks * 64 + fq * 16), ldfrag(VTc, LD_T, vt2 * 16 + fr, ks * 64 + fq * 16), acc, 0, 0, 0);
        sacc[s] = acc;
        *(u32x2*)(STn + (vt2 * 16 + fr) * LD_D + (dt * 16 + fq * 4) * 2) = (u32x2){pk_hw(acc[0], acc[1]), pk_hw(acc[2], acc[3])};
      }
    }
    }
    lds_barrier();
    if (n + 1 < NCH) A_WRITE();
    lds_barrier();
  }
#undef A_LOAD
#undef A_PREP
#undef A_WRITE
}

template <int MIXER>
__device__ __forceinline__ void scan_dispatch2(unsigned char* lds, int wv, const Params& p, int id) {
  const int vs = id & 3, dir = (id >> 2) & 1, h = (id >> 3) & 3, b = id >> 5;
  scan_item2<MIXER>(lds, wv, p, b, h, dir, vs);
}
}

__device__ __forceinline__ void scan_phase2(unsigned char* lds, int wv, const Params& p, int layer) {
  for (int it0 = blockIdx.x; it0 < 256; it0 += gridDim.x) {
    const int xq = it0 & 7, yq = it0 >> 3, stream = (yq >> 2) * 8 + xq;
    const int item = (stream >> 5) * 128 + (stream & 31) * 4 + (yq & 3);
    if (layer == 0) { if (item < 128) scan2::scan_dispatch2<scan::MIX_A>(lds, wv, p, item); else scan2::scan_dispatch2<scan::MIX_B>(lds, wv, p, item - 128); }
    else { if (item < 128) scan2::scan_dispatch2<scan::MIX_D>(lds, wv, p, item); else scan2::scan_dispatch2<scan::MIX_C>(lds, wv, p, item - 128); }
    __syncthreads();
  }
}
#endif
#ifndef CPU_EMU
__device__ __forceinline__ void grid_bar(unsigned* ctr, unsigned& epoch, unsigned G, int wv) {
  asm volatile("s_waitcnt vmcnt(0)" ::: "memory");
  __syncthreads();
  epoch += G;
  if (wv == 0 && lane_id() == 0) {
    __builtin_amdgcn_fence(__ATOMIC_RELEASE, "agent");
    asm volatile("s_waitcnt vmcnt(0)" ::: "memory");
    __hip_atomic_fetch_add(ctr, 1u, __ATOMIC_RELAXED, __HIP_MEMORY_SCOPE_AGENT);
    unsigned spins = 0;
    while (__hip_atomic_load(ctr, __ATOMIC_RELAXED, __HIP_MEMORY_SCOPE_AGENT) < epoch) { __builtin_amdgcn_s_sleep(2); if (++spins > (1u << 26)) break; }
    __builtin_amdgcn_fence(__ATOMIC_ACQUIRE, "agent");
    asm volatile("s_waitcnt vmcnt(0)" ::: "memory");
  }
  __syncthreads();
}

__global__ void __launch_bounds__(NTHREADS) mk_fwd(Params p) {
  extern __shared__ __attribute__((aligned(16))) unsigned char lds_raw[];
  cg::grid_group grid = cg::this_grid();
  const int G = gridDim.x, bid = blockIdx.x;
  const int wv = __builtin_amdgcn_readfirstlane(threadIdx.x >> 6);
  PG8_LAS unsigned char* lds = (PG8_LAS unsigned char*)lds_raw;
  unsigned char* ws = p.ws;

  p0_prologue(lds_raw, wv, p);
  grid.sync();
  unsigned* bar = (unsigned*)(ws + WS_CTL) + 1024;
  unsigned epoch = 0;
  for (int layer = 0; layer < 2; ++layer) {
    { ProbInProj pr; pr.so.init(NTOK, layer == 0 ? PM_AB : PM_CD, G, bid); pr.A = (const char*)(ws + WS_HB); pr.Bt = (const char*)(ws + (layer == 0 ? WS_WIN_AB : WS_WIN_CD));
      pr.P = (bf16_t*)(ws + WS_R1); pr.bias = p.in[layer == 0 ? I_AB_B_IN : I_CD_B_IN]; pr.lb = (const float*)(ws + WS_LB); pr.layer = layer;
      pg8::gemm_phase(lds, pr, wv);
#if (PROBE_DUP & 1)
      pg8::gemm_phase(lds, pr, wv);
#endif
      if (layer == 0) side_phase<32>(lds_raw, wv, p, 0); else side_phase<16>(lds_raw, wv, p, 1); }
    grid_bar(bar, epoch, (unsigned)G, wv);
    if (layer == 1) { convd_phase(lds_raw, wv, p); grid_bar(bar, epoch, (unsigned)G, wv); }
    scan_phase2(lds_raw, wv, p, layer);
#if (PROBE_DUP & 2)
    scan_phase2(lds_raw, wv, p, layer);
#endif
    grid_bar(bar, epoch, (unsigned)G, wv);
    headnorm_phase(lds_raw, wv, p, layer);
#if (PROBE_DUP & 8)
    headnorm_phase(lds_raw, wv, p, layer);
#endif
    grid_bar(bar, epoch, (unsigned)G, wv);
    { ProbOutProj pr; pr.so.init(NTOK, 1024, G, bid); pr.A = (const char*)(ws + WS_HB); pr.Bt = (const char*)(ws + (layer == 0 ? WS_WOUT_AB : WS_WOUT_CD)); pr.Y = (float*)(ws + WS_R2);
      pg8::gemm_phase(lds, pr, wv);
#if (PROBE_DUP & 1)
      pg8::gemm_phase(lds, pr, wv);
#endif
      moe_weight_convert(lds_raw, wv, p, layer);
#if (PROBE_DUP & 4)
      moe_weight_convert(lds_raw, wv, p, layer);
#endif
 }
    grid_bar(bar, epoch, (unsigned)G, wv);
    ln_phase(lds_raw, wv, p, layer, 0);
    grid_bar(bar, epoch, (unsigned)G, wv);
    { ProbMoe1 pr; pr.mo.cnt = (const int*)((const unsigned*)(ws + WS_CTL) + CW_CNT(layer)); pr.mo.ntn = 8; pr.mo.G = G; pr.mo.c = bid;
      pr.A = (const char*)(ws + WS_HB); pr.W13 = (const char*)(ws + WS_WMOE); pr.list = (const int*)(ws + WS_LIST) + (size_t)layer * NEXP * NTOK; pr.H = (bf16_t*)(ws + WS_H);
      pg8::gemm_phase(lds, pr, wv);
#if (PROBE_DUP & 1)
      pg8::gemm_phase(lds, pr, wv);
#endif
 }
    grid_bar(bar, epoch, (unsigned)G, wv);
    { ProbMoe2 pr; pr.mo.cnt = (const int*)((const unsigned*)(ws + WS_CTL) + CW_CNT(layer)); pr.mo.ntn = 4; pr.mo.G = G; pr.mo.c = bid;
      pr.A = (const char*)(ws + WS_H); pr.W2 = (const char*)(ws + WS_WMOE) + (size_t)NEXP * 2048 * 1024 * 2; pr.Y = (bf16_t*)(ws + WS_R2);
      pg8::gemm_phase(lds, pr, wv);
#if (PROBE_DUP & 1)
      pg8::gemm_phase(lds, pr, wv);
#endif
 }
    grid_bar(bar, epoch, (unsigned)G, wv);
    ln_phase(lds_raw, wv, p, layer, 1);
    if (layer == 0) grid_bar(bar, epoch, (unsigned)G, wv);
  }
}

extern "C" void kernel_launch(void* const* d_in, const int* in_sizes, int n_in, void* d_out, int out_size, void* d_ws, size_t ws_size, hipStream_t stream) {
  static int grid_blocks = 0;
  if (grid_blocks == 0) {
    if (n_in != N_IN || ws_size < WS_END || out_size != NTOK * 1024) { fprintf(stderr, "kernel_launch: bad shapes: n_in %d ws %zu (need %zu) out %d\n", n_in, ws_size, (size_t)WS_END, out_size); grid_blocks = -1; return; }
    int dev = 0, cus = 0, per_cu = 0;
    hipGetDevice(&dev); hipDeviceGetAttribute(&cus, hipDeviceAttributeMultiprocessorCount, dev);
    if (hipFuncSetAttribute((const void*)mk_fwd, hipFuncAttributeMaxDynamicSharedMemorySize, LDS_BYTES) != hipSuccess) { fprintf(stderr, "kernel_launch: hipFuncSetAttribute failed\n"); grid_blocks = -1; return; }
    if (hipOccupancyMaxActiveBlocksPerMultiprocessor(&per_cu, (const void*)mk_fwd, NTHREADS, LDS_BYTES) != hipSuccess || per_cu < 1) { fprintf(stderr, "kernel_launch: occupancy query failed (%d)\n", per_cu); grid_blocks = -1; return; }
    grid_blocks = cus;
    (void)in_sizes;
  }
  if (grid_blocks < 0) return;
  Params p{};
  for (int i = 0; i < N_IN; ++i) p.in[i] = (const float*)d_in[i];
  p.out = (float*)d_out; p.ws = (unsigned char*)d_ws;
  void* args[] = {&p};
  hipError_t e = hipLaunchCooperativeKernel((const void*)mk_fwd, dim3(grid_blocks), dim3(NTHREADS), args, LDS_BYTES, stream);
  if (e != hipSuccess) fprintf(stderr, "cooperative launch failed: %s (grid %d)\n", hipGetErrorString(e), grid_blocks);
}
#endif
#ifdef CPU_EMU
#include <vector>
void dbg_cmp(const char* name, const float* p, long n);
template <class F> static void run_functor(const F& f, long n) {
#pragma omp parallel for schedule(dynamic, 16)
  for (long g = 0; g < n; ++g) f(g);
}
static void cpu_round_w(const float* src, size_t n, std::vector<float>& dst) { dst.resize(n); for (size_t i = 0; i < n; ++i) dst[i] = bf2f(f2bf(src[i])); }

extern "C" void kernel_launch(void* const* d_in, const int* in_sizes, int n_in, void* d_out, int out_size, void* d_ws, size_t ws_size, hipStream_t) {
  (void)in_sizes; (void)n_in; (void)out_size;
  if (ws_size < WS_END) { printf("ws too small %zu < %zu\n", ws_size, (size_t)WS_END); return; }
  Params p{}; for (int i = 0; i < N_IN; ++i) p.in[i] = (const float*)d_in[i];
  p.out = (float*)d_out; p.ws = (unsigned char*)d_ws;
  unsigned char* ws = p.ws;
  bf16_t* HB = (bf16_t*)(ws + WS_HB); bf16_t* P = (bf16_t*)(ws + WS_R1); bf16_t* LFB = (bf16_t*)(ws + WS_LFB);
  bf16_t* O = (bf16_t*)(ws + WS_R2); float* yf = (float*)(ws + WS_R2); bf16_t* Y = (bf16_t*)(ws + WS_R2); bf16_t* H = (bf16_t*)(ws + WS_H);
  float* side = (float*)(ws + WS_SIDE); float* oside = (float*)(ws + WS_OSIDE); float* rope = (float*)(ws + WS_ROPE); float* lb = (float*)(ws + WS_LB);
  int* assign = (int*)(ws + WS_ASSIGN); float* gate = (float*)(ws + WS_GATE);
  for (size_t i = 0; i < (size_t)NTOK * 1024; ++i) HB[i] = f2bf(p.in[I_X][i]);
  for (int i = 0; i < SEQ * 32; ++i) { int t = i >> 5, f = i & 31; float freq = powf(10000.0f, -(float)f / 32.0f); float ang = (float)t * freq; rope[i * 2] = cosf(ang); rope[i * 2 + 1] = sinf(ang); }
  for (int cc = 0; cc < 512; ++cc) { const float* hl = p.in[I_HGRN_LB]; float a0 = hl[cc], a1 = hl[512 + cc], a2 = hl[1024 + cc]; float mx = fmaxf(a0, fmaxf(a1, a2));
    float e0 = expf(a0 - mx), e1 = expf(a1 - mx), e2 = expf(a2 - mx); lb[cc] = e0 / (e0 + e1 + e2); }
  std::vector<float> wr;
  for (int layer = 0; layer < 2; ++layer) {
    const int PW = layer == 0 ? P_AB : P_CD, PM = layer == 0 ? PM_AB : PM_CD;
    const float* bias = p.in[layer == 0 ? I_AB_B_IN : I_CD_B_IN];
    cpu_round_w(p.in[layer == 0 ? I_AB_W_IN : I_CD_W_IN], (size_t)1024 * PW, wr);
#pragma omp parallel for
    for (long tok = 0; tok < NTOK; ++tok) {
      std::vector<float> acc(PW, 0.f);
      for (int k = 0; k < 1024; ++k) { float a = bf2f(HB[tok * 1024 + k]); const float* w = &wr[(size_t)k * PW]; for (int n = 0; n < PW; ++n) acc[n] += a * w[n]; }
      for (int n = 0; n < PM; ++n) { float v = acc[n] + bias[n]; if (layer == 0) v = epi_ab(n, v, lb); P[tok * PSTRIDE + n] = f2bf(v); }
      for (int n = PM; n < PW; ++n) side[tok * 32 + (n - PM)] = acc[n] + bias[n];
      if (layer == 0) for (int dir = 0; dir < 2; ++dir) for (int cc = 0; cc < 256; ++cc) {
        float z = p.in[I_GK_B][dir * 256 + cc];
        for (int r = 0; r < 16; ++r) z += side[tok * 32 + dir * 16 + r] * p.in[I_GK_UP][(dir * 16 + r) * 256 + cc];
        LFB[tok * 512 + dir * 256 + cc] = f2bf(logsigmoidf_(z) * 0.0625f); }
    }
    if (layer == 0) { ScanAB2 s{}; s.P = P; s.LFB = LFB; s.O = O; run_functor(s, (long)BATCH * 2048); }
    else { PrepCD2 pc{}; pc.P = P; pc.QD = LFB; pc.rope = rope; pc.conv_w = p.in[I_CONV_W]; pc.conv_b = p.in[I_CONV_B]; run_functor(pc, (long)NTOK * 1280);
      ScanCD2 s{}; s.P = P; s.QD = LFB; s.side = side; s.fgate_b = p.in[I_FGATE_B]; s.O = O; s.oside = oside; run_functor(s, (long)BATCH * 2056); }
#pragma omp parallel for
    for (long tok = 0; tok < NTOK; ++tok) for (int h8 = 0; h8 < 8; ++h8) {
      float sf = 1.f, sb = 1.f;
      if (layer == 1 && h8 >= 4) { int h = h8 - 4; const float* s0 = oside + tok * 8 + h * 2; const float* s1 = oside + (size_t)(NTOK + tok) * 8 + h * 2;
        sf = 1.0f / fmaxf(fabsf(s0[0]), expf(-s0[1])); sb = 1.0f / fmaxf(fabsf(s1[0]), expf(-s1[1])); }
      float o[128]; float ss = 0.f;
      for (int j = 0; j < 128; ++j) { int c = h8 * 128 + j; o[j] = bf2f(O[tok * 1024 + c]) * sf + bf2f(O[(size_t)(NTOK + tok) * 1024 + c]) * sb; ss += o[j] * o[j]; }
      float r = 1.0f / sqrtf(ss * (1.0f / 128.0f) + NORM_EPS_F);
      for (int j = 0; j < 128; ++j) { int c = h8 * 128 + j; float gn, gt;
        if (layer == 0) { gn = h8 < 4 ? p.in[I_HGRN_NORM][c] : p.in[I_GLA_NORM][c - 512]; gt = siluf_(bf2f(P[tok * PSTRIDE + (h8 < 4 ? 2048 + c : 3584 + c - 512)])); }
        else { gn = h8 < 4 ? p.in[I_RET_NORM][c] : p.in[I_MLSTM_NORM][c - 512]; float gr = bf2f(P[tok * PSTRIDE + (h8 < 4 ? 1024 + c : 3072 + c - 512)]); gt = h8 < 4 ? siluf_(gr) : sigmoidf_(gr); }
        HB[tok * 1024 + c] = f2bf(o[j] * r * gn * gt); }
    }
    cpu_round_w(p.in[layer == 0 ? I_AB_W_OUT : I_CD_W_OUT], (size_t)1024 * 1024, wr);
#pragma omp parallel for
    for (long tok = 0; tok < NTOK; ++tok) { std::vector<float> acc(1024, 0.f);
      for (int k = 0; k < 1024; ++k) { float a = bf2f(HB[tok * 1024 + k]); const float* w = &wr[(size_t)k * 1024]; for (int n = 0; n < 1024; ++n) acc[n] += a * w[n]; }
      for (int n = 0; n < 1024; ++n) yf[tok * 1024 + n] = acc[n]; }
    dbg_cmp(layer == 0 ? "y_mix0" : "y_mix1", yf, (long)NTOK * 1024);
    int cnt[NEXP] = {0}; std::vector<int> list((size_t)NEXP * NTOK);
    const float* hin = layer == 0 ? p.in[I_X] : p.out;
    for (long tok = 0; tok < NTOK; ++tok) {
      float v[1024]; double s = 0; for (int c = 0; c < 1024; ++c) { v[c] = ALPHA_F * hin[tok * 1024 + c] + yf[tok * 1024 + c]; s += v[c]; }
      float mean = (float)(s / 1024); double q = 0; for (int c = 0; c < 1024; ++c) { v[c] -= mean; q += (double)v[c] * v[c]; }
      float r = 1.0f / sqrtf((float)(q / 1024) + LN_EPS_F);
      float lg[16] = {0};
      for (int c = 0; c < 1024; ++c) { v[c] = v[c] * r * p.in[I_LN_MIX_G][layer * 1024 + c] + p.in[I_LN_MIX_B][layer * 1024 + c]; p.out[tok * 1024 + c] = v[c]; HB[tok * 1024 + c] = f2bf(v[c]);
        for (int e = 0; e < 16; ++e) lg[e] += v[c] * p.in[I_ROUTER_W][c * 16 + e]; }
      int eo[2]; float go[2]; route_from_logits(lg, p.in[I_ROUTER_B], eo, go);
      int r1 = cnt[eo[0]]++, r2 = cnt[eo[1]]++;
      list[(size_t)eo[0] * NTOK + r1] = (int)tok; list[(size_t)eo[1] * NTOK + r2] = (int)tok;
      assign[tok * 4] = eo[0]; assign[tok * 4 + 1] = r1; assign[tok * 4 + 2] = eo[1]; assign[tok * 4 + 3] = r2; gate[tok * 2] = go[0]; gate[tok * 2 + 1] = go[1];
    }
    dbg_cmp(layer == 0 ? "h_mix0" : "h_mix1", p.out, (long)NTOK * 1024);
    int pad[NEXP]; { int a = 0; for (int e = 0; e < NEXP; ++e) { pad[e] = a; a += ((cnt[e] + 255) >> 8) << 8; } }
    const size_t lo = (size_t)layer * NEXP * 1024 * 1024;
    for (int e = 0; e < NEXP; ++e) {
      std::vector<float> w1, w3, w2; cpu_round_w(p.in[I_MOE_W1] + lo + (size_t)e * 1048576, 1048576, w1); cpu_round_w(p.in[I_MOE_W3] + lo + (size_t)e * 1048576, 1048576, w3); cpu_round_w(p.in[I_MOE_W2] + lo + (size_t)e * 1048576, 1048576, w2);
#pragma omp parallel for
      for (int rr = 0; rr < cnt[e]; ++rr) { int tok = list[(size_t)e * NTOK + rr]; size_t pos = pad[e] + rr;
        std::vector<float> a1(1024, 0.f), a3(1024, 0.f), a2(1024, 0.f);
        for (int k = 0; k < 1024; ++k) { float a = bf2f(HB[(size_t)tok * 1024 + k]); const float* p1 = &w1[(size_t)k * 1024]; const float* p3 = &w3[(size_t)k * 1024]; for (int n = 0; n < 1024; ++n) { a1[n] += a * p1[n]; a3[n] += a * p3[n]; } }
        for (int n = 0; n < 1024; ++n) H[pos * 1024 + n] = f2bf(siluf_(a1[n]) * a3[n]);
        for (int k = 0; k < 1024; ++k) { float a = bf2f(H[pos * 1024 + k]); const float* p2 = &w2[(size_t)k * 1024]; for (int n = 0; n < 1024; ++n) a2[n] += a * p2[n]; }
        for (int n = 0; n < 1024; ++n) Y[pos * 1024 + n] = f2bf(a2[n]); }
    }
    for (long tok = 0; tok < NTOK; ++tok) {
      size_t p0 = pad[assign[tok * 4]] + assign[tok * 4 + 1], p1 = pad[assign[tok * 4 + 2]] + assign[tok * 4 + 3];
      float v[1024]; double s = 0; for (int c = 0; c < 1024; ++c) { v[c] = ALPHA_F * p.out[tok * 1024 + c] + gate[tok * 2] * bf2f(Y[p0 * 1024 + c]) + gate[tok * 2 + 1] * bf2f(Y[p1 * 1024 + c]); s += v[c]; }
      float mean = (float)(s / 1024); double q = 0; for (int c = 0; c < 1024; ++c) { v[c] -= mean; q += (double)v[c] * v[c]; }
      float r = 1.0f / sqrtf((float)(q / 1024) + LN_EPS_F);
      for (int c = 0; c < 1024; ++c) { v[c] = v[c] * r * p.in[I_LN_FFN_G][layer * 1024 + c] + p.in[I_LN_FFN_B][layer * 1024 + c]; p.out[tok * 1024 + c] = v[c]; HB[tok * 1024 + c] = f2bf(v[c]); }
    }
    dbg_cmp(layer == 0 ? "h_ffn0" : "h_ffn1", p.out, (long)NTOK * 1024);
  }
}
#endif
```

```cpp
#ifdef CPU_EMU
#include <cmath>
#include <cstdio>
#include <cstring>
#include <cstdlib>
#include <cstddef>
#define DEV
#define DEV_INLINE static inline
typedef void* hipStream_t;
#else
#include <hip/hip_runtime.h>
#include <hip/hip_bf16.h>
#include <cstdio>
#define DEV __device__ __forceinline__
#define DEV_INLINE __device__ __forceinline__
#endif
#ifndef PROBE_DUP
#define PROBE_DUP 0
#endif
#ifndef BATCH
#define BATCH 4
#endif
#ifndef SEQ
#define SEQ 8192
#endif
#define DM 1024
#define NTOK (BATCH * SEQ)
#define P_AB 4128
#define P_CD 3600
#define PM_AB 4096
#define PM_CD 3584
#define NEXP 16
#define ALPHA_F 1.4142135623730951f
#define LN_EPS_F 1e-5f
#define NORM_EPS_F 1e-6f
#define HROWS (2 * NTOK + NEXP * 256)

typedef unsigned short bf16_t;

DEV_INLINE float bf2f(bf16_t b) { unsigned u = ((unsigned)b) << 16; float f; memcpy(&f, &u, 4); return f; }
DEV_INLINE bf16_t f2bf(float f) { unsigned u; memcpy(&u, &f, 4); u += 0x7FFFu + ((u >> 16) & 1u); return (bf16_t)(u >> 16); }
DEV_INLINE float sigmoidf_(float x) { return 1.0f / (1.0f + expf(-x)); }
DEV_INLINE float siluf_(float x) { return x / (1.0f + expf(-x)); }
DEV_INLINE float logsigmoidf_(float x) { return fminf(x, 0.0f) - log1pf(expf(-fabsf(x))); }

#define AL256(x) (((size_t)(x) + 255) & ~(size_t)255)
#define WS_CTL    ((size_t)0)
#define WS_HB     ((size_t)65536)
#define WS_R1     (WS_HB + (size_t)NTOK * 1024 * 2)
#define R1_P_BYTES ((size_t)NTOK * 4096 * 2)
#define R1_MIN    (AL256((size_t)HROWS * 1024 * 2) + (size_t)NEXP * 3072 * 1024 * 2)
#define R1_PL     (R1_P_BYTES + (size_t)NTOK * 512 * 2)
#define R1_BYTES  (R1_PL > R1_MIN ? R1_PL : R1_MIN)
#define WS_LFB    (WS_R1 + R1_P_BYTES)
#define WS_H      (WS_R1)
#define WS_WMOE   (WS_R1 + AL256((size_t)HROWS * 1024 * 2))
#define WMOE_BYTES ((size_t)NEXP * 3072 * 1024 * 2)
#define WS_R2     (WS_R1 + R1_BYTES)
#define R2_BYTES  ((size_t)HROWS * 1024 * 2 > (size_t)NTOK * 1024 * 4 ? (size_t)HROWS * 1024 * 2 : (size_t)NTOK * 1024 * 4)
#define WS_SIDE   (WS_R2 + AL256(R2_BYTES))
#define WS_OSIDE  (WS_SIDE + (size_t)NTOK * 32 * 4)
#define WS_WIN_AB (WS_OSIDE + (size_t)2 * NTOK * 8 * 4)
#define WS_WIN_CD (WS_WIN_AB + (size_t)4128 * 1024 * 2)
#define WS_WOUT_AB (WS_WIN_CD + (size_t)3600 * 1024 * 2)
#define WS_WOUT_CD (WS_WOUT_AB + (size_t)1024 * 1024 * 2)
#define WS_ROPE   (WS_WOUT_CD + (size_t)1024 * 1024 * 2)
#define WS_LB     (WS_ROPE + (size_t)SEQ * 64 * 4)
#define WS_LIST   (WS_LB + 4096)
#define WS_ASSIGN (WS_LIST + (size_t)2 * NEXP * NTOK * 4)
#define WS_GATE   (WS_ASSIGN + (size_t)NTOK * 16)
#define WS_END    (WS_GATE + (size_t)NTOK * 8)
#define CW_CNT(layer) (64 + 256 * (layer))

#define PSTRIDE 4096

enum { I_X, I_AB_W_IN, I_AB_B_IN, I_HGRN_LB, I_GK_UP, I_GK_B, I_HGRN_NORM, I_GLA_NORM, I_AB_W_OUT,
       I_CD_W_IN, I_CD_B_IN, I_CONV_W, I_CONV_B, I_FGATE_B, I_RET_NORM, I_MLSTM_NORM, I_CD_W_OUT,
       I_LN_MIX_G, I_LN_MIX_B, I_LN_FFN_G, I_LN_FFN_B, I_ROUTER_W, I_ROUTER_B, I_MOE_W1, I_MOE_W3, I_MOE_W2, N_IN };

struct Params {
  const float* in[N_IN];
  float* out;
  unsigned char* ws;
};

DEV_INLINE float epi_ab(int col, float v, const float* lb) {
  if (col < 512) return siluf_(v);
  if (col < 1536) { float l = lb[(col - 512) & 511]; return logf(l + (1.0f - l) * sigmoidf_(v)); }
  if (col >= 2560 && col < 2816) return v * 0.125f;
  return v;
}

DEV_INLINE void route_from_logits(const float* lg, const float* rb, int* e_out, float* g_out) {
  float mx = lg[0];
#pragma unroll
  for (int e = 1; e < 16; ++e) mx = fmaxf(mx, lg[e]);
  float sc[16]; float sum = 0.f;
#pragma unroll
  for (int e = 0; e < 16; ++e) { sc[e] = expf(lg[e] - mx); sum += sc[e]; }
  float inv = 1.0f / sum;
  float best_gs = -1e30f; int be1 = 0, be2 = 1; float bs1 = 0.f, bs2 = 0.f;
#pragma unroll
  for (int gq = 0; gq < 4; ++gq) {
    float m1 = -1e30f, m2 = -1e30f, s1 = 0.f, s2 = 0.f; int i1 = 0, i2 = 0;
#pragma unroll
    for (int i = 0; i < 4; ++i) {
      float s = sc[gq * 4 + i] * inv; float v = s + rb[gq * 4 + i];
      if (v > m1) { m2 = m1; i2 = i1; s2 = s1; m1 = v; i1 = gq * 4 + i; s1 = s; }
      else if (v > m2) { m2 = v; i2 = gq * 4 + i; s2 = s; }
    }
    float gs = m1 + m2;
    if (gs > best_gs) { best_gs = gs; be1 = i1; be2 = i2; bs1 = s1; bs2 = s2; }
  }
  e_out[0] = be1; e_out[1] = be2; g_out[0] = bs1 / (bs1 + bs2); g_out[1] = bs2 / (bs1 + bs2);
}
struct ScanAB2 {
  const bf16_t* P; const bf16_t* LFB; bf16_t* O;
  DEV void operator()(long gid) const {
    int j = (int)(gid & 127), h = (int)((gid >> 7) & 3), dir = (int)((gid >> 9) & 1), mixer = (int)((gid >> 10) & 1), b = (int)(gid >> 11);
    bf16_t* Od = O + (size_t)dir * NTOK * 1024;
    if (mixer == 0) {
      float S[128];
#pragma unroll
      for (int d = 0; d < 128; ++d) S[d] = 0.f;
      for (int s = 0; s < SEQ; ++s) {
        size_t t = (size_t)b * SEQ + (dir ? (SEQ - 1 - s) : s);
        const bf16_t* row = P + t * PSTRIDE;
        const bf16_t* q = row + h * 128; const bf16_t* lf = row + 512 + dir * 512 + h * 128;
        float v = bf2f(row[1536 + h * 128 + j]);
        float o = 0.f;
#pragma unroll
        for (int d = 0; d < 128; ++d) { float fd = expf(bf2f(lf[d])); S[d] = fd * S[d] + (1.0f - fd) * v; o += bf2f(q[d]) * S[d]; }
        Od[t * 1024 + h * 128 + j] = f2bf(o);
      }
    } else {
      float S[64];
#pragma unroll
      for (int d = 0; d < 64; ++d) S[d] = 0.f;
      for (int s = 0; s < SEQ; ++s) {
        size_t t = (size_t)b * SEQ + (dir ? (SEQ - 1 - s) : s);
        const bf16_t* row = P + t * PSTRIDE;
        const bf16_t* q = row + 2560 + h * 64; const bf16_t* k = row + 2816 + h * 64;
        const bf16_t* lf = LFB + t * 512 + dir * 256 + h * 64;
        float v = bf2f(row[3072 + h * 128 + j]);
        float o = 0.f;
#pragma unroll
        for (int d = 0; d < 64; ++d) { S[d] = expf(bf2f(lf[d])) * S[d] + bf2f(k[d]) * v; o += bf2f(q[d]) * S[d]; }
        Od[t * 1024 + 512 + h * 128 + j] = f2bf(o);
      }
    }
  }
};

struct PrepCD2 {
  bf16_t* P; bf16_t* QD; const float* rope; const float* conv_w; const float* conv_b;
  DEV void operator()(long gid) const {
    size_t tok = (size_t)(gid / 1280); int c = (int)(gid % 1280); int t = (int)(tok % SEQ);
    bf16_t* row = P + tok * PSTRIDE;
    if (c < 256) {
      int isk = c >> 7, hh = (c >> 5) & 3, i = c & 31;
      float cs = rope[(t * 32 + i) * 2], sn = rope[(t * 32 + i) * 2 + 1];
      bf16_t* base = row + isk * 256 + hh * 64;
      float a1 = bf2f(base[i]), a2 = bf2f(base[i + 32]);
      float sc = isk ? 1.0f : 0.125f;
      base[i] = f2bf((a1 * cs - a2 * sn) * sc); base[i + 32] = f2bf((a1 * sn + a2 * cs) * sc);
    } else {
      int cc = c - 256;
      float acc = conv_b[cc] + bf2f(row[1536 + cc]) * conv_w[1024 + cc];
      if (t > 0) acc += bf2f(row[1536 + cc - PSTRIDE]) * conv_w[cc];
      if (t < SEQ - 1) acc += bf2f(row[1536 + cc + PSTRIDE]) * conv_w[2048 + cc];
      float s = siluf_(acc);
      if (cc < 512) QD[tok * 512 + cc] = f2bf(s * 0.08838834764831845f);
      else row[3584 + (cc - 512)] = f2bf(s);
    }
  }
};

struct ScanCD2 {
  const bf16_t* P; const bf16_t* QD; const float* side; const float* fgate_b; bf16_t* O; float* oside;
  DEV void operator()(long gid) const {
    int b = (int)(gid / 2056); int g = (int)(gid % 2056);
    if (g < 1024) {
      int j = g & 127, h = (g >> 7) & 3, dir = (g >> 9) & 1;
      bf16_t* Od = O + (size_t)dir * NTOK * 1024;
      float gamma = 1.0f - exp2f(-(5.0f + 2.0f * (float)h + (float)dir));
      float S[64];
#pragma unroll
      for (int d = 0; d < 64; ++d) S[d] = 0.f;
      for (int s = 0; s < SEQ; ++s) {
        size_t t = (size_t)b * SEQ + (dir ? (SEQ - 1 - s) : s);
        const bf16_t* row = P + t * PSTRIDE;
        const bf16_t* q = row + h * 64; const bf16_t* k = row + 256 + h * 64;
        float v = bf2f(row[512 + h * 128 + j]);
        float o = 0.f;
#pragma unroll
        for (int d = 0; d < 64; ++d) { S[d] = gamma * S[d] + bf2f(k[d]) * v; o += bf2f(q[d]) * S[d]; }
        Od[t * 1024 + h * 128 + j] = f2bf(o);
      }
    } else {
      g -= 1024;
      int j = g % 129, h = (g / 129) & 3, dir = g / (129 * 4);
      bf16_t* Od = O + (size_t)dir * NTOK * 1024; float* os = oside + (size_t)dir * NTOK * 8;
      float fb = fgate_b[dir * 4 + h];
      float S[128];
#pragma unroll
      for (int d = 0; d < 128; ++d) S[d] = 0.f;
      float m = 0.f;
      for (int s = 0; s < SEQ; ++s) {
        size_t t = (size_t)b * SEQ + (dir ? (SEQ - 1 - s) : s);
        const bf16_t* row = P + t * PSTRIDE;
        const bf16_t* q = QD + t * 512 + h * 128; const bf16_t* k = row + 3584 + h * 128;
        float v = (j < 128) ? bf2f(row[2560 + h * 128 + j]) : 1.0f;
        float li = side[t * 32 + dir * 8 + h];
        float lf = logsigmoidf_(side[t * 32 + dir * 8 + 4 + h] + fb);
        float mn = fmaxf(lf + m, li);
        float fs = expf(lf + m - mn), is = expf(li - mn) * v;
        m = mn;
        float o = 0.f;
#pragma unroll
        for (int d = 0; d < 128; ++d) { S[d] = fs * S[d] + is * bf2f(k[d]); o += bf2f(q[d]) * S[d]; }
        if (j < 128) Od[t * 1024 + 512 + h * 128 + j] = f2bf(o);
        else { os[t * 8 + h * 2] = o; os[t * 8 + h * 2 + 1] = m; }
      }
    }
  }
};
#ifndef CPU_EMU
namespace pg8 {
#define PG8_LAS __attribute__((address_space(3)))
typedef short bf16x8 __attribute__((ext_vector_type(8)));
typedef float f32x4 __attribute__((ext_vector_type(4)));
typedef unsigned u32x4 __attribute__((ext_vector_type(4)));
typedef unsigned u32x2 __attribute__((ext_vector_type(2)));
constexpr int BM = 256, BK = 64, HALF = 128, HTB = HALF * BK * 2, STAGE_BYTES = 8 * HTB, NXCD = 8, WGM = 8, GK = 1024;

__device__ __forceinline__ int lds_byte(int r, int c) { const int st = (r >> 4) * 2 + (c >> 5), rr = r & 15, cc = c & 31, ob = rr * 64 + cc * 2; return st * 1024 + (ob ^ (((ob >> 9) & 1) << 5)); }
__device__ __forceinline__ void stage_rc(int b, int& R, int& C) { const int st = b / 1024, sb = b % 1024, swz = sb ^ (((sb >> 9) & 1) << 5); R = (st >> 1) * 16 + swz / 64; C = (st & 1) * 32 + (swz % 64) / 2; }
__device__ __forceinline__ int perm32(int rho) { const int n = rho >> 4, i = rho & 15; return 8 * (i >> 2) + 4 * n + (i & 3); }
__device__ __forceinline__ unsigned cvt_pk_bf16(float lo, float hi) { unsigned r; asm volatile("v_cvt_pk_bf16_f32 %0, %1, %2" : "=v"(r) : "v"(lo), "v"(hi)); return r; }

struct Unit { int pm, pn, e, row0, ne; };

struct StaticOrder {
  int nM, nN, nwg, G, c;
  __device__ void init(int M, int N, int G_, int c_) { nM = M / BM; nN = N / BM; nwg = nM * nN; G = G_; c = c_; }
  __device__ bool next(int i, Unit& u) const {
    const long L = (long)i * G + c; if (L >= nwg) return false;
    int wgid = (int)L; { const int q = nwg / NXCD, r = nwg % NXCD, xcd = wgid % NXCD, off = wgid / NXCD; wgid = (xcd < r ? xcd * (q + 1) : r * (q + 1) + (xcd - r) * q) + off; }
    const int nig = WGM * nN, gid = wgid / nig, fm = gid * WGM, gsz = (nM - fm) < WGM ? (nM - fm) : WGM;
    u.pm = fm + ((wgid % nig) % gsz); u.pn = (wgid % nig) / gsz; u.e = 0; u.row0 = u.pm * BM; u.ne = 0; return true;
  }
};

template <class Prob>
__device__ __forceinline__ void gemm_phase(PG8_LAS unsigned char* lds, const Prob& S, int wv) {
  int wv_ = wv; asm volatile("" : "+s"(wv_));
  int l_; asm volatile("v_mbcnt_lo_u32_b32 %0, -1, 0\n\tv_mbcnt_hi_u32_b32 %0, -1, %0" : "=v"(l_));
  int tid_ = wv_ * 64 + l_;
  const int tid = tid_, wid = __builtin_amdgcn_readfirstlane(tid >> 6), lane = tid & 63, wr = wid >> 2, wc = wid & 3, fr = lane & 15, fq = lane >> 4;
  constexpr int K = GK, nt = K / BK;
  int sR[2], sC[2]; unsigned voffB[2];
#pragma unroll
  for (int i = 0; i < 2; ++i) { int R, C; stage_rc(tid * 16 + i * 8192, R, C); sR[i] = R; sC[i] = C; const int Rb = Prob::PERM ? ((R & ~31) + perm32(R & 31)) : R; voffB[i] = (unsigned)(Rb * K + C) * 2u; }
  const size_t kstep = (size_t)(BK * 2);
  const size_t hstep = (size_t)HALF * K * 2;
  const unsigned ldsw = (unsigned)wid * 1024u;
  const int aoff = lds_byte(wr * 64 + fr, fq * 8), boff = lds_byte(wc * 32 + fr, fq * 8);
#define PG8_SA(b, h) (((b) * 2 + (h)) * HTB)
#define PG8_SB(b, h) ((4 + (b) * 2 + (h)) * HTB)
#define PG8_STAGE(bufoff, gbase, voff) do { _Pragma("unroll") for (int _i = 0; _i < 2; ++_i) \
    __builtin_amdgcn_global_load_lds((const unsigned*)((const char*)(gbase) + (voff)[_i]), (PG8_LAS unsigned*)(lds + (bufoff) + ldsw + _i * 8192), 16, 0, 0); } while (0)
#define PG8_LDA(dst, b, h) do { _Pragma("unroll") for (int m = 0; m < 4; ++m) _Pragma("unroll") for (int k = 0; k < 2; ++k) dst[m][k] = *(const PG8_LAS bf16x8*)(lds + PG8_SA(b, h) + aoff + m * 2048 + k * 1024); } while (0)
#define PG8_LDB(dst, b, h) do { _Pragma("unroll") for (int n = 0; n < 2; ++n) _Pragma("unroll") for (int k = 0; k < 2; ++k) dst[n][k] = *(const PG8_LAS bf16x8*)(lds + PG8_SB(b, h) + boff + n * 2048 + k * 1024); } while (0)
#define PG8_MMA(ai, bj, At, Bt) do { __builtin_amdgcn_s_setprio(1); _Pragma("unroll") for (int m = 0; m < 4; ++m) _Pragma("unroll") for (int n = 0; n < 2; ++n) _Pragma("unroll") for (int k = 0; k < 2; ++k) \
    acc[ai][bj][m][n] = __builtin_amdgcn_mfma_f32_16x16x32_bf16(Bt[n][k], At[m][k], acc[ai][bj][m][n], 0, 0, 0); __builtin_amdgcn_s_setprio(0); } while (0)
#define PG8_WAIT_V(n) asm volatile("s_waitcnt vmcnt(" #n ")" ::: "memory")
#define PG8_WAIT_L(n) asm volatile("s_waitcnt lgkmcnt(" #n ")" ::: "memory")
#define PG8_BAR __builtin_amdgcn_s_barrier()
#define PG8_SCHED __builtin_amdgcn_sched_barrier(0)
  Unit cur, nxt; int ui = 0;
  if (!S.next(0, cur)) return;
  f32x4 acc[2][2][4][2];
#pragma unroll
  for (int a = 0; a < 2; ++a)
#pragma unroll
    for (int b = 0; b < 2; ++b)
#pragma unroll
      for (int m = 0; m < 4; ++m)
#pragma unroll
        for (int n = 0; n < 2; ++n) acc[a][b][m][n] = (f32x4){0.f, 0.f, 0.f, 0.f};
  bf16x8 At[4][2], B0[2][2], B1[2][2];
  unsigned oc0[2], oc1[2], on0[2], on1[2];
#pragma unroll
  for (int i = 0; i < 2; ++i) { oc0[i] = S.a_off(cur, sR[i]) + (unsigned)sC[i] * 2u; oc1[i] = S.a_off(cur, HALF + sR[i]) + (unsigned)sC[i] * 2u; }
  const char* const Ab = S.a_base();
  const char* cB = S.b_base(cur);
  PG8_STAGE(PG8_SB(0, 0), cB, voffB); PG8_STAGE(PG8_SA(0, 0), Ab, oc0); PG8_STAGE(PG8_SB(0, 1), cB + hstep, voffB); PG8_STAGE(PG8_SA(0, 1), Ab, oc1);
  if (wr == 1) PG8_BAR;
  PG8_WAIT_V(4); PG8_BAR;
  PG8_STAGE(PG8_SB(1, 0), cB + kstep, voffB); PG8_STAGE(PG8_SA(1, 0), Ab + kstep, oc0); PG8_STAGE(PG8_SB(1, 1), cB + hstep + kstep, voffB);
  PG8_WAIT_V(6); PG8_BAR;
  for (;;) {
    const bool has_next = S.next(ui + 1, nxt);
    const char* nB = cB;
    if (has_next) {
      nB = S.b_base(nxt);
      int l2_; asm volatile("v_mbcnt_lo_u32_b32 %0, -1, 0\n\tv_mbcnt_hi_u32_b32 %0, -1, %0" : "=v"(l2_));
      const int tid2 = wid * 64 + l2_;
#pragma unroll
      for (int i = 0; i < 2; ++i) { int R, C; stage_rc(tid2 * 16 + i * 8192, R, C); on0[i] = S.a_off(nxt, R) + (unsigned)C * 2u; on1[i] = S.a_off(nxt, HALF + R) + (unsigned)C * 2u; }
    } else {
#pragma unroll
      for (int i = 0; i < 2; ++i) { on0[i] = oc0[i]; on1[i] = oc1[i]; }
    }
    for (int t = 0; t < nt; t += 2) {
      const bool last = (t == nt - 2);
      const char* a1 = Ab + (size_t)(t + 1) * kstep;
      const char* a2 = last ? Ab : Ab + (size_t)(t + 2) * kstep; const char* b2 = last ? nB : cB + (size_t)(t + 2) * kstep;
      const char* a3 = a2 + kstep; const char* b3 = b2 + kstep;
      unsigned o20[2], o21[2];
#pragma unroll
      for (int i = 0; i < 2; ++i) { o20[i] = last ? on0[i] : oc0[i]; o21[i] = last ? on1[i] : oc1[i]; }
      PG8_LDB(B0, 0, 0); PG8_SCHED; PG8_LDA(At, 0, 0); PG8_STAGE(PG8_SA(1, 1), a1, oc1);
      PG8_WAIT_L(8); PG8_BAR; PG8_WAIT_L(0); PG8_MMA(0, 0, At, B0); PG8_BAR; PG8_SCHED;
      PG8_LDB(B1, 0, 1); PG8_STAGE(PG8_SB(0, 0), b2, voffB);
      PG8_BAR; PG8_WAIT_L(0); PG8_MMA(0, 1, At, B1); PG8_BAR;
      PG8_LDA(At, 0, 1); PG8_STAGE(PG8_SA(0, 0), a2, o20);
      PG8_BAR; PG8_WAIT_L(0); PG8_MMA(1, 0, At, B0); PG8_BAR; PG8_SCHED;
      PG8_STAGE(PG8_SB(0, 1), b2 + hstep, voffB);
      PG8_WAIT_V(6); PG8_BAR; PG8_MMA(1, 1, At, B1); PG8_BAR;
      PG8_LDB(B0, 1, 0); PG8_SCHED; PG8_LDA(At, 1, 0); PG8_STAGE(PG8_SA(0, 1), a2, o21);
      PG8_WAIT_L(8); PG8_BAR; PG8_WAIT_L(0); PG8_MMA(0, 0, At, B0); PG8_BAR; PG8_SCHED;
      PG8_LDB(B1, 1, 1); PG8_STAGE(PG8_SB(1, 0), b3, voffB);
      PG8_BAR; PG8_WAIT_L(0); PG8_MMA(0, 1, At, B1); PG8_BAR;
      PG8_LDA(At, 1, 1); PG8_STAGE(PG8_SA(1, 0), a3, o20);
      PG8_BAR; PG8_WAIT_L(0); PG8_MMA(1, 0, At, B0); PG8_BAR; PG8_SCHED;
      PG8_STAGE(PG8_SB(1, 1), b3 + hstep, voffB);
      PG8_WAIT_V(6); PG8_BAR; PG8_MMA(1, 1, At, B1); PG8_BAR;
    }
    { int l3_; asm volatile("v_mbcnt_lo_u32_b32 %0, -1, 0\n\tv_mbcnt_hi_u32_b32 %0, -1, %0" : "=v"(l3_));
      S.epi(acc, cur, wr, wc, l3_ & 15, l3_ >> 4); }
    if (!has_next) break;
#pragma unroll
    for (int a = 0; a < 2; ++a)
#pragma unroll
      for (int b = 0; b < 2; ++b)
#pragma unroll
        for (int m = 0; m < 4; ++m)
#pragma unroll
          for (int n = 0; n < 2; ++n) acc[a][b][m][n] = (f32x4){0.f, 0.f, 0.f, 0.f};
    cur = nxt; cB = nB; ++ui;
#pragma unroll
    for (int i = 0; i < 2; ++i) { oc0[i] = on0[i]; oc1[i] = on1[i]; }
  }
  PG8_WAIT_V(0);
  if (wr == 0) PG8_BAR;
  PG8_BAR;
#undef PG8_SA
#undef PG8_SB
#undef PG8_STAGE
#undef PG8_LDA
#undef PG8_LDB
#undef PG8_MMA
#undef PG8_WAIT_V
#undef PG8_WAIT_L
#undef PG8_BAR
#undef PG8_SCHED
}
}
#endif
#ifndef CPU_EMU
#include <hip/hip_cooperative_groups.h>
namespace cg = cooperative_groups;
#define LAS __attribute__((address_space(3)))
#define NTHREADS 512
#define LDS_BYTES (146 * 1024)
typedef float f32x4 __attribute__((ext_vector_type(4)));
typedef short bf16x8 __attribute__((ext_vector_type(8)));
typedef unsigned u32x4 __attribute__((ext_vector_type(4)));
typedef unsigned u32x2 __attribute__((ext_vector_type(2)));

struct Ctx { int tid, lane, wid, G, bid; unsigned char* lds; };
__device__ __forceinline__ int lane_id() { int l; asm volatile("v_mbcnt_lo_u32_b32 %0, -1, 0\n\tv_mbcnt_hi_u32_b32 %0, -1, %0" : "=v"(l)); return l; }
__device__ __forceinline__ int opaque_tid(int wv) { int w = wv; asm volatile("" : "+s"(w)); int t = w * 64 + lane_id(); asm volatile("" : "+v"(t)); return t; }
__device__ __forceinline__ Ctx make_ctx(unsigned char* lds, int wv) { Ctx c; c.tid = opaque_tid(wv); c.lane = c.tid & 63; c.wid = __builtin_amdgcn_readfirstlane(c.tid >> 6); c.G = gridDim.x; c.bid = blockIdx.x; c.lds = lds; return c; }

__device__ __forceinline__ float wave_sum(float x) {
  x += __builtin_bit_cast(float, __builtin_amdgcn_update_dpp(0, __builtin_bit_cast(int, x), 0x111, 0xf, 0xf, false));
  x += __builtin_bit_cast(float, __builtin_amdgcn_update_dpp(0, __builtin_bit_cast(int, x), 0x112, 0xf, 0xf, false));
  x += __builtin_bit_cast(float, __builtin_amdgcn_update_dpp(0, __builtin_bit_cast(int, x), 0x114, 0xf, 0xf, false));
  x += __builtin_bit_cast(float, __builtin_amdgcn_update_dpp(0, __builtin_bit_cast(int, x), 0x118, 0xf, 0xf, false));
  x += __builtin_bit_cast(float, __builtin_amdgcn_update_dpp(0, __builtin_bit_cast(int, x), 0x142, 0xa, 0xf, false));
  x += __builtin_bit_cast(float, __builtin_amdgcn_update_dpp(0, __builtin_bit_cast(int, x), 0x143, 0xc, 0xf, false));
  return __builtin_bit_cast(float, __builtin_amdgcn_readlane(__builtin_bit_cast(int, x), 63));
}
__device__ __forceinline__ float fsigmoid(float x) { return __builtin_amdgcn_rcpf(1.0f + __builtin_amdgcn_exp2f(-1.4426950408889634f * x)); }
__device__ __forceinline__ float fsilu(float x) { return x * fsigmoid(x); }
typedef float f32x2_t __attribute__((ext_vector_type(2)));
typedef __bf16 bf16x2_t __attribute__((ext_vector_type(2)));
__device__ __forceinline__ unsigned pk_hw(float a, float b) { const f32x2_t v = {a, b}; return __builtin_bit_cast(unsigned, __builtin_convertvector(v, bf16x2_t)); }
__device__ __forceinline__ unsigned pk2(float a, float b) { return pk_hw(a, b); }
__device__ __forceinline__ void unpack8(u32x4 w, float* f) {
  f[0] = __uint_as_float(w.x << 16); f[1] = __uint_as_float(w.x & 0xffff0000u); f[2] = __uint_as_float(w.y << 16); f[3] = __uint_as_float(w.y & 0xffff0000u);
  f[4] = __uint_as_float(w.z << 16); f[5] = __uint_as_float(w.z & 0xffff0000u); f[6] = __uint_as_float(w.w << 16); f[7] = __uint_as_float(w.w & 0xffff0000u);
}

__device__ __forceinline__ void transpose_job(const Ctx& c, const float* src, int N, bf16_t* dst, int rs, int ro, int tile0, int tile_stride) {
  float* t = (float*)c.lds;
  const int ntn = (N + 63) / 64, ntiles = ntn * 16;
  for (int tl = tile0; tl < ntiles; tl += tile_stride) {
    const int kt = tl / ntn, nt_ = tl % ntn, k0 = kt * 64, n0 = nt_ * 64;
    __syncthreads();
#pragma unroll
    for (int i = 0; i < 8; ++i) { const int idx = c.tid + i * 512, kk = idx >> 6, nn = idx & 63; t[kk * 65 + nn] = (n0 + nn < N) ? src[(size_t)(k0 + kk) * N + n0 + nn] : 0.f; }
    __syncthreads();
#pragma unroll
    for (int i = 0; i < 4; ++i) { const int idx = c.tid + i * 512, nn = idx >> 5, kp = (idx & 31) * 2;
      if (n0 + nn < N) *(unsigned*)(dst + (size_t)((n0 + nn) * rs + ro) * 1024 + k0 + kp) = pk2(t[kp * 65 + nn], t[(kp + 1) * 65 + nn]); }
  }
  __syncthreads();
}
__device__ __forceinline__ void p0_prologue(unsigned char* lds_, int wv, const Params& p) {
  const Ctx c = make_ctx(lds_, wv);
  unsigned char* ws = p.ws;
  if (c.bid == 0) { ((unsigned*)(ws + WS_CTL))[64 + c.tid] = 0u; }
  if (c.bid == 0 && c.tid == 0) ((unsigned*)(ws + WS_CTL))[1024] = 0u;
  { const float* x = p.in[I_X]; bf16_t* hb = (bf16_t*)(ws + WS_HB);
    for (size_t i = (size_t)c.bid * NTHREADS + c.tid; i < (size_t)NTOK * 1024 / 8; i += (size_t)c.G * NTHREADS) {
      const f32x4 a = *(const f32x4*)(x + i * 8), b = *(const f32x4*)(x + i * 8 + 4);
      u32x4 w; w.x = pk2(a[0], a[1]); w.y = pk2(a[2], a[3]); w.z = pk2(b[0], b[1]); w.w = pk2(b[2], b[3]);
      *(u32x4*)(hb + i * 8) = w; } }
  transpose_job(c, p.in[I_AB_W_IN], P_AB, (bf16_t*)(ws + WS_WIN_AB), 1, 0, c.bid, c.G);
  transpose_job(c, p.in[I_CD_W_IN], P_CD, (bf16_t*)(ws + WS_WIN_CD), 1, 0, c.bid, c.G);
  transpose_job(c, p.in[I_AB_W_OUT], 1024, (bf16_t*)(ws + WS_WOUT_AB), 1, 0, c.bid, c.G);
  transpose_job(c, p.in[I_CD_W_OUT], 1024, (bf16_t*)(ws + WS_WOUT_CD), 1, 0, c.bid, c.G);
  { float* rope = (float*)(ws + WS_ROPE);
    for (int i = c.bid * NTHREADS + c.tid; i < SEQ * 32; i += c.G * NTHREADS) { const int t = i >> 5, f = i & 31;
      const float freq = powf(10000.0f, -(float)f / 32.0f); const float ang = (float)t * freq; rope[i * 2] = cosf(ang); rope[i * 2 + 1] = sinf(ang); }
    if (c.bid == 1) { const float* hl = p.in[I_HGRN_LB]; float* lb = (float*)(ws + WS_LB);
      const int cc = c.tid; const float a0 = hl[cc], a1 = hl[512 + cc], a2 = hl[1024 + cc]; const float mx = fmaxf(a0, fmaxf(a1, a2));
      const float e0 = expf(a0 - mx), e1 = expf(a1 - mx), e2 = expf(a2 - mx); lb[cc] = e0 / (e0 + e1 + e2); } }
}
__device__ __forceinline__ void moe_weight_convert(unsigned char* lds_, int wv, const Params& p, int layer) {
  const Ctx c = make_ctx(lds_, wv);
  bf16_t* w13 = (bf16_t*)(p.ws + WS_WMOE); bf16_t* w2 = w13 + (size_t)NEXP * 2048 * 1024;
  const size_t lo = (size_t)layer * NEXP * 1024 * 1024;
  for (int e = 0; e < NEXP; ++e) {
    const size_t mo = lo + (size_t)e * 1024 * 1024;
    transpose_job(c, p.in[I_MOE_W1] + mo, 1024, w13 + (size_t)e * 2048 * 1024, 2, 0, c.bid, c.G);
    transpose_job(c, p.in[I_MOE_W3] + mo, 1024, w13 + (size_t)e * 2048 * 1024, 2, 1, c.bid, c.G);
    transpose_job(c, p.in[I_MOE_W2] + mo, 1024, w2 + (size_t)e * 1024 * 1024, 1, 0, c.bid, c.G);
  }
}

struct ProbInProj {
  static constexpr bool PERM = true;
  pg8::StaticOrder so; const char* A; const char* Bt; bf16_t* P; const float* bias; const float* lb; int layer;
  __device__ __forceinline__ bool next(int i, pg8::Unit& u) const { return so.next(i, u); }
  __device__ __forceinline__ const char* a_base() const { return A; }
  __device__ __forceinline__ unsigned a_off(const pg8::Unit& u, int r) const { return (unsigned)(u.pm * 256 + r) * 2048u; }
  __device__ __forceinline__ const char* b_base(const pg8::Unit& u) const { return Bt + (size_t)u.pn * 256 * 2048; }
  __device__ __forceinline__ void epi(const f32x4 (&acc)[2][2][4][2], const pg8::Unit& u, int wr, int wc, int fr, int fq) const {
    const int row0 = u.row0 + wr * 64 + fr, colb = u.pn * 256 + wc * 32 + 8 * fq;
    int mode = 0;
    if (layer == 0) { mode = u.pn < 2 ? 1 : (u.pn < 6 ? 2 : (u.pn == 10 ? 3 : 0)); }
#pragma unroll
    for (int bj = 0; bj < 2; ++bj) {
      const int col0 = colb + bj * 128;
      const f32x4 b0 = *(const f32x4*)(bias + col0), b1 = *(const f32x4*)(bias + col0 + 4);
      f32x4 l0 = (f32x4){0.f, 0.f, 0.f, 0.f}, l1 = l0;
      if (mode == 2) { l0 = *(const f32x4*)(lb + ((col0 - 512) & 511)); l1 = *(const f32x4*)(lb + ((col0 - 512) & 511) + 4); }
#pragma unroll
      for (int ai = 0; ai < 2; ++ai)
#pragma unroll
        for (int m = 0; m < 4; ++m) {
          f32x4 v0 = acc[ai][bj][m][0] + b0, v1 = acc[ai][bj][m][1] + b1;
          if (mode == 1) {
#pragma unroll
            for (int j = 0; j < 4; ++j) { v0[j] = fsilu(v0[j]); v1[j] = fsilu(v1[j]); }
          } else if (mode == 2) {
#pragma unroll
            for (int j = 0; j < 4; ++j) { v0[j] = __builtin_amdgcn_logf(l0[j] + (1.0f - l0[j]) * fsigmoid(v0[j])); v1[j] = __builtin_amdgcn_logf(l1[j] + (1.0f - l1[j]) * fsigmoid(v1[j])); }
          } else if (mode == 3) { v0 *= 0.125f; v1 *= 0.125f; }
          u32x4 w; w.x = pk2(v0[0], v0[1]); w.y = pk2(v0[2], v0[3]); w.z = pk2(v1[0], v1[1]); w.w = pk2(v1[2], v1[3]);
          *(u32x4*)(P + (size_t)(row0 + ai * 128 + m * 16) * PSTRIDE + col0) = w;
        }
    }
  }
};
struct ProbOutProj {
  static constexpr bool PERM = false;
  pg8::StaticOrder so; const char* A; const char* Bt; float* Y;
  __device__ __forceinline__ bool next(int i, pg8::Unit& u) const { return so.next(i, u); }
  __device__ __forceinline__ const char* a_base() const { return A; }
  __device__ __forceinline__ unsigned a_off(const pg8::Unit& u, int r) const { return (unsigned)(u.pm * 256 + r) * 2048u; }
  __device__ __forceinline__ const char* b_base(const pg8::Unit& u) const { return Bt + (size_t)u.pn * 256 * 2048; }
  __device__ __forceinline__ void epi(const f32x4 (&acc)[2][2][4][2], const pg8::Unit& u, int wr, int wc, int fr, int fq) const {
    const int row0 = u.row0 + wr * 64 + fr, col0 = u.pn * 256 + wc * 32 + 4 * fq;
#pragma unroll
    for (int ai = 0; ai < 2; ++ai)
#pragma unroll
      for (int m = 0; m < 4; ++m) { float* rowp = Y + (size_t)(row0 + ai * 128 + m * 16) * 1024 + col0;
#pragma unroll
        for (int bj = 0; bj < 2; ++bj)
#pragma unroll
          for (int n = 0; n < 2; ++n) *(f32x4*)(rowp + bj * 128 + n * 16) = acc[ai][bj][m][n]; }
  }
};
#define MOE_TAB_OFF (128 * 1024)
struct MoeOrder {
  const int* tab;
  __device__ __forceinline__ void init(const int* cnt, int ntn, int G, int c, unsigned char* lds, int wv) {
    int* t = (int*)(lds + MOE_TAB_OFF);
    const int tid = opaque_tid(wv);
    if (tid < 64) {
      int L = tid * G + c, pad = 0, found = 0, ue = 0, upn = 0, upm = 0, urow = 0, une = 0;
      for (int e = 0; e < NEXP; ++e) { const int n = cnt[e * 16], mt = (n + 255) >> 8, tiles = mt * ntn;
        if (!found && L < tiles) { ue = e; upn = L / mt; upm = L % mt; urow = pad + upm * 256; une = n; found = 1; }
        if (!found) { L -= tiles; pad += mt * 256; } }
      t[tid * 8 + 0] = found; t[tid * 8 + 1] = ue; t[tid * 8 + 2] = upn; t[tid * 8 + 3] = upm; t[tid * 8 + 4] = urow; t[tid * 8 + 5] = une;
    }
    __syncthreads();
    tab = t;
  }
  __device__ __forceinline__ bool next(int i, pg8::Unit& u) const {
    if (i >= 64) return false;
    const int* t = tab + i * 8;
    if (!__builtin_amdgcn_readfirstlane(t[0])) return false;
    u.e = __builtin_amdgcn_readfirstlane(t[1]); u.pn = __builtin_amdgcn_readfirstlane(t[2]); u.pm = __builtin_amdgcn_readfirstlane(t[3]);
    u.row0 = __builtin_amdgcn_readfirstlane(t[4]); u.ne = __builtin_amdgcn_readfirstlane(t[5]); return true;
  }
};
struct ProbMoe1 {
  static constexpr bool PERM = true;
  MoeOrder mo; const char* A; const char* W13; const int* list; bf16_t* H;
  __device__ __forceinline__ bool next(int i, pg8::Unit& u) const { return mo.next(i, u); }
  __device__ __forceinline__ const char* a_base() const { return A; }
  __device__ __forceinline__ unsigned a_off(const pg8::Unit& u, int r) const { const int rr = u.pm * 256 + r; const int tok = rr < u.ne ? list[u.e * NTOK + rr] : 0; return (unsigned)tok * 2048u; }
  __device__ __forceinline__ const char* b_base(const pg8::Unit& u) const { return W13 + ((size_t)u.e * 2048 + (size_t)u.pn * 256) * 2048; }
  __device__ __forceinline__ void epi(const f32x4 (&acc)[2][2][4][2], const pg8::Unit& u, int wr, int wc, int fr, int fq) const {
    const int row0 = u.row0 + wr * 64 + fr, colb = u.pn * 128 + wc * 16 + 4 * fq;
#pragma unroll
    for (int ai = 0; ai < 2; ++ai)
#pragma unroll
      for (int m = 0; m < 4; ++m)
#pragma unroll
        for (int bj = 0; bj < 2; ++bj) {
          const f32x4 v0 = acc[ai][bj][m][0], v1 = acc[ai][bj][m][1];
          u32x2 w; w.x = pk2(fsilu(v0[0]) * v0[1], fsilu(v0[2]) * v0[3]); w.y = pk2(fsilu(v1[0]) * v1[1], fsilu(v1[2]) * v1[3]);
          *(u32x2*)(H + (size_t)(row0 + ai * 128 + m * 16) * 1024 + colb + bj * 64) = w;
        }
  }
};
struct ProbMoe2 {
  static constexpr bool PERM = true;
  MoeOrder mo; const char* A; const char* W2; bf16_t* Y;
  __device__ __forceinline__ bool next(int i, pg8::Unit& u) const { return mo.next(i, u); }
  __device__ __forceinline__ const char* a_base() const { return A; }
  __device__ __forceinline__ unsigned a_off(const pg8::Unit& u, int r) const { return (unsigned)(u.row0 + r) * 2048u; }
  __device__ __forceinline__ const char* b_base(const pg8::Unit& u) const { return W2 + ((size_t)u.e * 1024 + (size_t)u.pn * 256) * 2048; }
  __device__ __forceinline__ void epi(const f32x4 (&acc)[2][2][4][2], const pg8::Unit& u, int wr, int wc, int fr, int fq) const {
    const int row0 = u.row0 + wr * 64 + fr, colb = u.pn * 256 + wc * 32 + 8 * fq;
#pragma unroll
    for (int ai = 0; ai < 2; ++ai)
#pragma unroll
      for (int m = 0; m < 4; ++m)
#pragma unroll
        for (int bj = 0; bj < 2; ++bj) {
          const f32x4 v0 = acc[ai][bj][m][0], v1 = acc[ai][bj][m][1];
          u32x4 w; w.x = pk2(v0[0], v0[1]); w.y = pk2(v0[2], v0[3]); w.z = pk2(v1[0], v1[1]); w.w = pk2(v1[2], v1[3]);
          *(u32x4*)(Y + (size_t)(row0 + ai * 128 + m * 16) * 1024 + colb + bj * 128) = w;
        }
  }
};

template <int NS>
__device__ __forceinline__ void side_phase(unsigned char* lds_, int wv, const Params& p, int layer) {
  const Ctx c = make_ctx(lds_, wv);
  const bf16_t* hb = (const bf16_t*)(p.ws + WS_HB);
  const bf16_t* wt = (const bf16_t*)(p.ws + (layer == 0 ? WS_WIN_AB : WS_WIN_CD)) + (size_t)(layer == 0 ? PM_AB : PM_CD) * 1024;
  const float* bias = p.in[layer == 0 ? I_AB_B_IN : I_CD_B_IN] + (layer == 0 ? PM_AB : PM_CD);
  float* side = (float*)(p.ws + WS_SIDE);
  float* tl = (float*)c.lds + c.wid * (16 * 33);
  const int fr = c.lane & 15, fq = c.lane >> 4;
  for (int g = c.bid * 8 + c.wid; g < NTOK / 16; g += c.G * 8) {
    const int r0 = g * 16;
    f32x4 acc0 = (f32x4){0.f, 0.f, 0.f, 0.f}, acc1 = acc0;
    const bf16_t* ap = hb + (size_t)(r0 + fr) * 1024 + fq * 8;
    const bf16_t* bp0 = wt + (size_t)fr * 1024 + fq * 8; const bf16_t* bp1 = bp0 + 16 * 1024;
#pragma unroll 4
    for (int k = 0; k < 1024; k += 32) {
      const bf16x8 a = *(const bf16x8*)(ap + k), b0 = *(const bf16x8*)(bp0 + k);
      acc0 = __builtin_amdgcn_mfma_f32_16x16x32_bf16(a, b0, acc0, 0, 0, 0);
      if (NS == 32) { const bf16x8 b1 = *(const bf16x8*)(bp1 + k); acc1 = __builtin_amdgcn_mfma_f32_16x16x32_bf16(a, b1, acc1, 0, 0, 0); }
    }
#pragma unroll
    for (int j = 0; j < 4; ++j) { const float v0 = acc0[j] + bias[fr]; side[(size_t)(r0 + fq * 4 + j) * 32 + fr] = v0; tl[(fq * 4 + j) * 33 + fr] = v0;
      if (NS == 32) { const float v1 = acc1[j] + bias[16 + fr]; side[(size_t)(r0 + fq * 4 + j) * 32 + 16 + fr] = v1; tl[(fq * 4 + j) * 33 + 16 + fr] = v1; } }
    if (NS == 32) {
      __builtin_amdgcn_s_waitcnt(0xC07F);
      const float* gu = p.in[I_GK_UP]; const float* gb = p.in[I_GK_B]; bf16_t* lfb = (bf16_t*)(p.ws + WS_LFB);
      const int cb = c.lane * 8, dir = cb >> 8, cc = cb & 255;
      float w[16][8];
#pragma unroll
      for (int r = 0; r < 16; ++r)
#pragma unroll
        for (int j = 0; j < 8; ++j) w[r][j] = gu[(dir * 16 + r) * 256 + cc + j];
      float bb[8];
#pragma unroll
      for (int j = 0; j < 8; ++j) bb[j] = gb[dir * 256 + cc + j];
      constexpr float LFS = 0.0625f * 1.4426950408889634f;
      for (int row = 0; row < 16; ++row) {
        float z[8];
#pragma unroll
        for (int j = 0; j < 8; ++j) z[j] = bb[j];
#pragma unroll
        for (int r = 0; r < 16; ++r) { const float s = tl[row * 33 + dir * 16 + r];
#pragma unroll
          for (int j = 0; j < 8; ++j) z[j] += s * w[r][j]; }
        u32x4 o; o.x = pk2(logsigmoidf_(z[0]) * LFS, logsigmoidf_(z[1]) * LFS); o.y = pk2(logsigmoidf_(z[2]) * LFS, logsigmoidf_(z[3]) * LFS);
        o.z = pk2(logsigmoidf_(z[4]) * LFS, logsigmoidf_(z[5]) * LFS); o.w = pk2(logsigmoidf_(z[6]) * LFS, logsigmoidf_(z[7]) * LFS);
        *(u32x4*)(lfb + (size_t)(r0 + row) * 512 + cb) = o;
      }
    }
  }
}

__device__ __forceinline__ void headnorm_phase(unsigned char* lds_, int wv, const Params& p, int layer) {
  const Ctx c = make_ctx(lds_, wv);
  const bf16_t* P = (const bf16_t*)(p.ws + WS_R1); const bf16_t* O = (const bf16_t*)(p.ws + WS_R2);
  bf16_t* mixed = (bf16_t*)(p.ws + WS_HB);
  const int c0 = c.lane * 16, h8 = c.lane >> 3;
  const float* gain = layer == 0 ? (h8 < 4 ? p.in[I_HGRN_NORM] + c0 : p.in[I_GLA_NORM] + c0 - 512) : (h8 < 4 ? p.in[I_RET_NORM] + c0 : p.in[I_MLSTM_NORM] + c0 - 512);
  const int gcol = layer == 0 ? (h8 < 4 ? 2048 + c0 : 3584 + c0 - 512) : (h8 < 4 ? 1024 + c0 : 3072 + c0 - 512);
  float gn[16];
#pragma unroll
  for (int j = 0; j < 16; ++j) gn[j] = gain[j];
  for (int tok = c.bid * 8 + c.wid; tok < NTOK; tok += c.G * 8) {
    float of[16], ob[16], gt[16];
    { const u32x4* a = (const u32x4*)(O + (size_t)tok * 1024 + c0); unpack8(a[0], of); unpack8(a[1], of + 8);
      const u32x4* b = (const u32x4*)(O + (size_t)(NTOK + tok) * 1024 + c0); unpack8(b[0], ob); unpack8(b[1], ob + 8);
      const u32x4* g = (const u32x4*)(P + (size_t)tok * PSTRIDE + gcol); unpack8(g[0], gt); unpack8(g[1], gt + 8); }
    const float sf = 1.f, sb = 1.f;
    float o[16]; float ss = 0.f;
#pragma unroll
    for (int j = 0; j < 16; ++j) { o[j] = of[j] * sf + ob[j] * sb; ss += o[j] * o[j]; }
    ss += __shfl_xor(ss, 1); ss += __shfl_xor(ss, 2); ss += __shfl_xor(ss, 4);
    const float r = 1.0f / sqrtf(ss * (1.0f / 128.0f) + NORM_EPS_F);
    unsigned w[8];
#pragma unroll
    for (int j = 0; j < 8; ++j) {
      float g0 = gt[2 * j], g1 = gt[2 * j + 1];
      if (layer == 1 && h8 >= 4) { g0 = fsigmoid(g0); g1 = fsigmoid(g1); } else { g0 = fsilu(g0); g1 = fsilu(g1); }
      w[j] = pk2(o[2 * j] * r * gn[2 * j] * g0, o[2 * j + 1] * r * gn[2 * j + 1] * g1);
    }
    u32x4* d = (u32x4*)(mixed + (size_t)tok * 1024 + c0);
    d[0] = (u32x4){w[0], w[1], w[2], w[3]}; d[1] = (u32x4){w[4], w[5], w[6], w[7]};
  }
}

__device__ __forceinline__ void ln_phase(unsigned char* lds_, int wv, const Params& p, int layer, int mode, int dry = 0) {
  const Ctx c = make_ctx(lds_, wv);
  unsigned char* ws = p.ws;
  const float* hin = (mode == 0 && layer == 0) ? p.in[I_X] : p.out;
  float* hout = dry ? (float*)(ws + WS_H) : p.out; bf16_t* hb = (bf16_t*)(ws + WS_HB);
  const float* g = p.in[mode == 0 ? I_LN_MIX_G : I_LN_FFN_G] + layer * 1024; const float* b = p.in[mode == 0 ? I_LN_MIX_B : I_LN_FFN_B] + layer * 1024;
  unsigned* cnt = (unsigned*)(ws + WS_CTL) + CW_CNT(layer);
  int* list = (int*)(ws + WS_LIST) + (size_t)layer * NEXP * NTOK;
  int* assign = (int*)(ws + WS_ASSIGN); float* gate = (float*)(ws + WS_GATE);
  float* rwT = (float*)c.lds;
  int* lcnt = (int*)(c.lds + 65536); int* lbase = lcnt + 16; int* rec = lcnt + 32; float* recg = (float*)(rec + 4 * 2048);
  int pad[NEXP];
  if (mode == 0) { const float* r = p.in[I_ROUTER_W];
    for (int i = c.tid; i < 1024 * 16; i += NTHREADS) rwT[(i & 15) * 1024 + (i >> 4)] = r[i];
    if (c.tid < 16) lcnt[c.tid] = 0;
    __syncthreads(); }
  else { int acc = 0;
#pragma unroll
    for (int e = 0; e < NEXP; ++e) { pad[e] = acc; acc += (((int)cnt[e * 16] + 255) >> 8) << 8; } }
  const int c0 = c.lane * 4;
  float gv[16], bv[16];
#pragma unroll
  for (int q = 0; q < 4; ++q) { const f32x4 t0 = *(const f32x4*)(g + q * 256 + c0), t1 = *(const f32x4*)(b + q * 256 + c0);
#pragma unroll
    for (int j = 0; j < 4; ++j) { gv[4 * q + j] = t0[j]; bv[4 * q + j] = t1[j]; } }
  const int tstride = c.G * 8;
  int it = 0;
  for (int tok0 = c.bid * 8 + c.wid; tok0 < NTOK; tok0 += 2 * tstride, it += 2) {
    float v[2][16];
    float gy0[2], gy1[2];
#pragma unroll
    for (int u = 0; u < 2; ++u) {
      const int tok = tok0 + u * tstride;
      if (tok < NTOK) {
#pragma unroll
        for (int q = 0; q < 4; ++q) { const f32x4 t = *(const f32x4*)(hin + (size_t)tok * 1024 + q * 256 + c0); v[u][4 * q] = ALPHA_F * t[0]; v[u][4 * q + 1] = ALPHA_F * t[1]; v[u][4 * q + 2] = ALPHA_F * t[2]; v[u][4 * q + 3] = ALPHA_F * t[3]; }
        if (mode == 0) {
#pragma unroll
          for (int q = 0; q < 4; ++q) { const f32x4 t = *(const f32x4*)((const float*)(ws + WS_R2) + (size_t)tok * 1024 + q * 256 + c0); v[u][4 * q] += t[0]; v[u][4 * q + 1] += t[1]; v[u][4 * q + 2] += t[2]; v[u][4 * q + 3] += t[3]; }
        } else {
          const int a0 = assign[tok * 4], a1 = assign[tok * 4 + 1], a2 = assign[tok * 4 + 2], a3 = assign[tok * 4 + 3];
          gy0[u] = gate[tok * 2]; gy1[u] = gate[tok * 2 + 1];
          int p0 = 0, p1 = 0;
#pragma unroll
          for (int e = 0; e < NEXP; ++e) { if (e == a0) p0 = pad[e]; if (e == a2) p1 = pad[e]; }
          p0 += a1; p1 += a3;
          const bf16_t* Y = (const bf16_t*)(ws + WS_R2);
#pragma unroll
          for (int q = 0; q < 4; ++q) { const u32x2 y0 = *(const u32x2*)(Y + (size_t)p0 * 1024 + q * 256 + c0), y1 = *(const u32x2*)(Y + (size_t)p1 * 1024 + q * 256 + c0);
            v[u][4 * q] += gy0[u] * __uint_as_float(y0.x << 16) + gy1[u] * __uint_as_float(y1.x << 16); v[u][4 * q + 1] += gy0[u] * __uint_as_float(y0.x & 0xffff0000u) + gy1[u] * __uint_as_float(y1.x & 0xffff0000u);
            v[u][4 * q + 2] += gy0[u] * __uint_as_float(y0.y << 16) + gy1[u] * __uint_as_float(y1.y << 16); v[u][4 * q + 3] += gy0[u] * __uint_as_float(y0.y & 0xffff0000u) + gy1[u] * __uint_as_float(y1.y & 0xffff0000u); }
        }
      } else {
#pragma unroll
        for (int j = 0; j < 16; ++j) v[u][j] = 0.f;
      }
    }
#pragma unroll
    for (int u = 0; u < 2; ++u) {
      const int tok = tok0 + u * tstride;
      float s = 0.f;
#pragma unroll
      for (int j = 0; j < 16; ++j) s += v[u][j];
      const float mean = wave_sum(s) * (1.0f / 1024.0f);
      float qq = 0.f;
#pragma unroll
      for (int j = 0; j < 16; ++j) { v[u][j] -= mean; qq += v[u][j] * v[u][j]; }
      const float r = 1.0f / sqrtf(wave_sum(qq) * (1.0f / 1024.0f) + LN_EPS_F);
#pragma unroll
      for (int j = 0; j < 16; ++j) v[u][j] = v[u][j] * r * gv[j] + bv[j];
      if (tok < NTOK) {
#pragma unroll
        for (int q = 0; q < 4; ++q) *(f32x4*)(hout + (size_t)tok * 1024 + q * 256 + c0) = (f32x4){v[u][4 * q], v[u][4 * q + 1], v[u][4 * q + 2], v[u][4 * q + 3]};
        if (!(mode == 1 && layer == 1) && !dry) {
#pragma unroll
          for (int q = 0; q < 4; ++q) *(u32x2*)(hb + (size_t)tok * 1024 + q * 256 + c0) = (u32x2){pk2(v[u][4 * q], v[u][4 * q + 1]), pk2(v[u][4 * q + 2], v[u][4 * q + 3])}; }
      }
      if (mode == 0) {
        float lg[16];
#pragma unroll
        for (int e = 0; e < 16; ++e) { float a = 0.f;
#pragma unroll
          for (int q = 0; q < 4; ++q) { const f32x4 w = *(const f32x4*)(rwT + e * 1024 + q * 256 + c0); a += v[u][4 * q] * w[0] + v[u][4 * q + 1] * w[1] + v[u][4 * q + 2] * w[2] + v[u][4 * q + 3] * w[3]; }
          lg[e] = a; }
#pragma unroll
        for (int e = 0; e < 16; ++e) lg[e] = wave_sum(lg[e]);
        int eo[2]; float go[2];
        route_from_logits(lg, p.in[I_ROUTER_B], eo, go);
        if (c.lane == 0 && tok < NTOK && !dry) {
          const int r1 = atomicAdd(lcnt + eo[0], 1), r2 = atomicAdd(lcnt + eo[1], 1);
          const int ri = (it + u) * 8 + c.wid;
          rec[ri * 4] = eo[0]; rec[ri * 4 + 1] = r1; rec[ri * 4 + 2] = eo[1]; rec[ri * 4 + 3] = r2; recg[ri * 2] = go[0]; recg[ri * 2 + 1] = go[1];
        }
      }
    }
  }
  if (mode == 0 && !dry) {
    __syncthreads();
    if (c.tid < 16) lbase[c.tid] = (int)atomicAdd(cnt + c.tid * 16, (unsigned)lcnt[c.tid]);
    __syncthreads();
    const int nrec = ((NTOK + c.G * 8 - 1) / (c.G * 8)) * 8;
    for (int ri = c.tid; ri < nrec; ri += NTHREADS) {
      const int tok = c.bid * 8 + (ri & 7) + (ri >> 3) * c.G * 8;
      if (tok < NTOK) {
        const int e1 = rec[ri * 4], e2 = rec[ri * 4 + 2]; const int r1 = rec[ri * 4 + 1] + lbase[e1], r2 = rec[ri * 4 + 3] + lbase[e2];
        list[e1 * NTOK + r1] = tok; list[e2 * NTOK + r2] = tok;
        assign[tok * 4] = e1; assign[tok * 4 + 1] = r1; assign[tok * 4 + 2] = e2; assign[tok * 4 + 3] = r2;
        gate[tok * 2] = recg[ri * 2]; gate[tok * 2 + 1] = recg[ri * 2 + 1];
      }
    }
  }
  __syncthreads();
}
#endif
#ifndef CPU_EMU
namespace scan {
typedef short bf16x8 __attribute__((ext_vector_type(8)));
typedef float f32x4 __attribute__((ext_vector_type(4)));
typedef unsigned u32x4 __attribute__((ext_vector_type(4)));
typedef unsigned u32x2 __attribute__((ext_vector_type(2)));
enum { MIX_A = 0, MIX_B = 1, MIX_C = 2, MIX_D = 3 };
constexpr int LD_T = 144;
constexpr int OFF_QS = 0, OFF_KS = 17408, OFF_QI = 34816, OFF_KT = 52224, OFF_VT = 70656, OFF_SC = 77568, OFF_ST = 86784, OFF_DEC = 99840, OFF_EM = 100352, OFF_DEN = 100608, OFF_CW = 100864, SCAN_LDS = 104960;

__device__ __forceinline__ float incl_scan_add(float x) {
  x += __builtin_bit_cast(float, __builtin_amdgcn_update_dpp(0, __builtin_bit_cast(int, x), 0x111, 0xf, 0xf, false));
  x += __builtin_bit_cast(float, __builtin_amdgcn_update_dpp(0, __builtin_bit_cast(int, x), 0x112, 0xf, 0xf, false));
  x += __builtin_bit_cast(float, __builtin_amdgcn_update_dpp(0, __builtin_bit_cast(int, x), 0x114, 0xf, 0xf, false));
  x += __builtin_bit_cast(float, __builtin_amdgcn_update_dpp(0, __builtin_bit_cast(int, x), 0x118, 0xf, 0xf, false));
  x += __builtin_bit_cast(float, __builtin_amdgcn_update_dpp(0, __builtin_bit_cast(int, x), 0x142, 0xa, 0xf, false));
  x += __builtin_bit_cast(float, __builtin_amdgcn_update_dpp(0, __builtin_bit_cast(int, x), 0x143, 0xc, 0xf, false));
  return x;
}
__device__ __forceinline__ float incl_scan_max(float x) {
  const int ninf = (int)0xff800000u;
  x = fmaxf(x, __builtin_bit_cast(float, __builtin_amdgcn_update_dpp(ninf, __builtin_bit_cast(int, x), 0x111, 0xf, 0xf, false)));
  x = fmaxf(x, __builtin_bit_cast(float, __builtin_amdgcn_update_dpp(ninf, __builtin_bit_cast(int, x), 0x112, 0xf, 0xf, false)));
  x = fmaxf(x, __builtin_bit_cast(float, __builtin_amdgcn_update_dpp(ninf, __builtin_bit_cast(int, x), 0x114, 0xf, 0xf, false)));
  x = fmaxf(x, __builtin_bit_cast(float, __builtin_amdgcn_update_dpp(ninf, __builtin_bit_cast(int, x), 0x118, 0xf, 0xf, false)));
  x = fmaxf(x, __builtin_bit_cast(float, __builtin_amdgcn_update_dpp(ninf, __builtin_bit_cast(int, x), 0x142, 0xa, 0xf, false)));
  x = fmaxf(x, __builtin_bit_cast(float, __builtin_amdgcn_update_dpp(ninf, __builtin_bit_cast(int, x), 0x143, 0xc, 0xf, false)));
  return x;
}
__device__ __forceinline__ float rdlane(float x, int l) { return __builtin_bit_cast(float, __builtin_amdgcn_readlane(__builtin_bit_cast(int, x), l)); }
__device__ __forceinline__ bf16x8 ldfrag(const unsigned char* base, int ld, int row, int kbyte) { return *(const bf16x8*)(base + row * ld + kbyte); }
__device__ __forceinline__ unsigned pk(float a, float b) { return pk_hw(a, b); }
__device__ __forceinline__ float lo16(unsigned w) { return __uint_as_float(w << 16); }
__device__ __forceinline__ float hi16(unsigned w) { return __uint_as_float(w & 0xffff0000u); }

__device__ __forceinline__ void lds_barrier() { asm volatile("s_waitcnt lgkmcnt(0)" ::: "memory"); __builtin_amdgcn_s_barrier(); asm volatile("" ::: "memory"); }
struct Raw { u32x4 a0, a1, b0, b1; f32x4 r0, r1; u32x2 v; float s0, s1; };

template <int MIXER>
__device__ __forceinline__ void scan_item(unsigned char* lds, int wv, const Params& p, int b, int h, int dir, int vs) {
  constexpr int DK = (MIXER == MIX_A || MIXER == MIX_D) ? 128 : 64;
  constexpr int NC = DK / 8;
  constexpr int LD_D = DK * 2 + 16;
  constexpr int NVT = MIXER == MIX_D ? 3 : 2;
  constexpr int NKD = DK / 32;
  const int tid = opaque_tid(wv), lane0 = tid & 63, wid = __builtin_amdgcn_readfirstlane(tid >> 6);
  unsigned char* ws = p.ws;
  const bf16_t* P = (const bf16_t*)(ws + WS_R1);
  const bf16_t* LFBp = (const bf16_t*)(ws + WS_LFB);
  const float* side = (const float*)(ws + WS_SIDE);
  const float* rope = (const float*)(ws + WS_ROPE);
  bf16_t* O = (bf16_t*)(ws + WS_R2) + (size_t)dir * NTOK * 1024;
  unsigned char* QS = lds + OFF_QS; unsigned char* KS = lds + OFF_KS; unsigned char* QI = lds + OFF_QI; unsigned char* KT = lds + OFF_KT;
  unsigned char* VT = lds + OFF_VT; unsigned char* SC = lds + OFF_SC; unsigned char* ST = lds + OFF_ST;
  float* DEC = (float*)(lds + OFF_DEC); float* EM = (float*)(lds + OFF_EM); float* DEN = (float*)(lds + OFF_DEN);

  int qcol, kcol, lfcol, vcol, ocol;
  if (MIXER == MIX_A) { qcol = h * 128; kcol = 0; lfcol = 512 + dir * 512 + h * 128; vcol = 1536 + h * 128 + vs * 32; ocol = h * 128 + vs * 32; }
  else if (MIXER == MIX_B) { qcol = 2560 + h * 64; kcol = 2816 + h * 64; lfcol = dir * 256 + h * 64; vcol = 3072 + h * 128 + vs * 32; ocol = 512 + h * 128 + vs * 32; }
  else if (MIXER == MIX_C) { qcol = h * 64; kcol = 256 + h * 64; lfcol = 0; vcol = 512 + h * 128 + vs * 32; ocol = h * 128 + vs * 32; }
  else { qcol = h * 128  ; kcol = 3584 + h * 128  ; lfcol = 0; vcol = 2560 + h * 128 + vs * 32; ocol = 512 + h * 128 + vs * 32; }
  const int c0 = (MIXER == MIX_C) ? wid * 4 : wid * NC;
  const float lgam = (MIXER == MIX_C) ? log1pf(-exp2f(-(5.0f + 2.0f * (float)h + (float)dir))) : 0.f;
  const float fgb = (MIXER == MIX_D) ? p.in[I_FGATE_B][dir * 4 + h] : 0.f;
  for (int i = tid; i < 48 * LD_D / 4; i += NTHREADS) ((unsigned*)ST)[i] = 0u;
  if (MIXER == MIX_D) {
    for (int i = tid; i < 16 * 64; i += NTHREADS) { const int r = 32 + (i >> 6), j = i & 63; *(bf16_t*)(VT + r * LD_T + j * 2) = (r == 32) ? (bf16_t)0x3F80 : (bf16_t)0; }
  }
  f32x4 sacc[NVT == 3 ? 3 : 2];
#pragma unroll
  for (int i = 0; i < (NVT == 3 ? 3 : 2); ++i) sacc[i] = (f32x4){0.f, 0.f, 0.f, 0.f};
  float m_st = 0.f;
  const size_t tokbase = (size_t)b * SEQ;
  const int sgn = dir ? -1 : 1;
  __syncthreads();

  Raw R;
#define SCAN_LOAD(n_) do { \
    int ln_ = lane0; asm volatile("" : "+v"(ln_)); \
    const int t_ = dir ? (SEQ - 1 - ((n_) * 64 + ln_)) : ((n_) * 64 + ln_); \
    const bf16_t* row_ = P + (tokbase + t_) * PSTRIDE; \
    if (MIXER == MIX_A) { const u32x4* qp_ = (const u32x4*)(row_ + qcol + c0); const u32x4* lp_ = (const u32x4*)(row_ + lfcol + c0); R.a0 = qp_[0]; R.a1 = qp_[1]; R.b0 = lp_[0]; R.b1 = lp_[1]; } \
    else if (MIXER == MIX_B) { R.a0 = *(const u32x4*)(row_ + qcol + c0); R.a1 = *(const u32x4*)(row_ + kcol + c0); R.b0 = *(const u32x4*)(LFBp + (tokbase + t_) * 512 + lfcol + c0); } \
    else if (MIXER == MIX_C) { const u32x2 qa_ = *(const u32x2*)(row_ + qcol + c0), qb_ = *(const u32x2*)(row_ + qcol + 32 + c0), ka_ = *(const u32x2*)(row_ + kcol + c0), kb_ = *(const u32x2*)(row_ + kcol + 32 + c0); \
      R.a0 = (u32x4){qa_.x, qa_.y, qb_.x, qb_.y}; R.a1 = (u32x4){ka_.x, ka_.y, kb_.x, kb_.y}; \
      R.r0 = *(const f32x4*)(rope + ((size_t)t_ * 32 + c0) * 2); R.r1 = *(const f32x4*)(rope + ((size_t)t_ * 32 + c0) * 2 + 4); } \
    else { const u32x4* qp_ = (const u32x4*)(LFBp + (tokbase + t_) * 512 + qcol + c0); const u32x4* kp_ = (const u32x4*)(row_ + kcol + c0); R.a0 = qp_[0]; R.a1 = qp_[1]; R.b0 = kp_[0]; R.b1 = kp_[1]; \
      R.s0 = side[(tokbase + t_) * 32 + dir * 8 + h]; R.s1 = side[(tokbase + t_) * 32 + dir * 8 + 4 + h]; } \
    R.v = *(const u32x2*)(row_ + vcol + wid * 4); } while (0)

  SCAN_LOAD(0);
  for (int n = 0; n < SEQ / 64; ++n) {
    int lane = lane0; asm volatile("" : "+v"(lane));
    const int fr = lane & 15, fq = lane >> 4;
    float q[NC], k[NC], g[NC];
    const u32x2 vv = R.v;
    float g_li = 0.f, g_lf = 0.f;
    if (MIXER == MIX_A) {
      const unsigned qw[8] = {R.a0.x, R.a0.y, R.a0.z, R.a0.w, R.a1.x, R.a1.y, R.a1.z, R.a1.w}, lw[8] = {R.b0.x, R.b0.y, R.b0.z, R.b0.w, R.b1.x, R.b1.y, R.b1.z, R.b1.w};
#pragma unroll
      for (int c = 0; c < 8; ++c) { q[2 * c] = lo16(qw[c]); q[2 * c + 1] = hi16(qw[c]); g[2 * c] = lo16(lw[c]); g[2 * c + 1] = hi16(lw[c]); }
#pragma unroll
      for (int c = 0; c < NC; ++c) k[c] = 1.0f - __expf(g[c]);
    } else if (MIXER == MIX_B) {
      const unsigned qw[4] = {R.a0.x, R.a0.y, R.a0.z, R.a0.w}, kw[4] = {R.a1.x, R.a1.y, R.a1.z, R.a1.w}, lw[4] = {R.b0.x, R.b0.y, R.b0.z, R.b0.w};
#pragma unroll
      for (int c = 0; c < 4; ++c) { q[2 * c] = lo16(qw[c]); q[2 * c + 1] = hi16(qw[c]); k[2 * c] = lo16(kw[c]); k[2 * c + 1] = hi16(kw[c]); g[2 * c] = lo16(lw[c]); g[2 * c + 1] = hi16(lw[c]); }
    } else if (MIXER == MIX_C) {
      const float cs[4] = {R.r0[0], R.r0[2], R.r1[0], R.r1[2]}, sn[4] = {R.r0[1], R.r0[3], R.r1[1], R.r1[3]};
      const float q1[4] = {lo16(R.a0.x), hi16(R.a0.x), lo16(R.a0.y), hi16(R.a0.y)}, q2[4] = {lo16(R.a0.z), hi16(R.a0.z), lo16(R.a0.w), hi16(R.a0.w)};
      const float k1[4] = {lo16(R.a1.x), hi16(R.a1.x), lo16(R.a1.y), hi16(R.a1.y)}, k2[4] = {lo16(R.a1.z), hi16(R.a1.z), lo16(R.a1.w), hi16(R.a1.w)};
#pragma unroll
      for (int c = 0; c < 4; ++c) { q[c] = (q1[c] * cs[c] - q2[c] * sn[c]) * 0.125f; q[4 + c] = (q1[c] * sn[c] + q2[c] * cs[c]) * 0.125f; k[c] = k1[c] * cs[c] - k2[c] * sn[c]; k[4 + c] = k1[c] * sn[c] + k2[c] * cs[c]; }
#pragma unroll
      for (int c = 0; c < NC; ++c) g[c] = (float)(lane + 1) * lgam;
    } else {
      const unsigned qw[8] = {R.a0.x, R.a0.y, R.a0.z, R.a0.w, R.a1.x, R.a1.y, R.a1.z, R.a1.w}, kw[8] = {R.b0.x, R.b0.y, R.b0.z, R.b0.w, R.b1.x, R.b1.y, R.b1.z, R.b1.w};
      g_li = R.s0; g_lf = R.s1;
#pragma unroll
      for (int c = 0; c < 8; ++c) { q[2 * c] = lo16(qw[c]); q[2 * c + 1] = hi16(qw[c]); k[2 * c] = lo16(kw[c]); k[2 * c + 1] = hi16(kw[c]); }
#pragma unroll
      for (int c = 0; c < NC; ++c) g[c] = 0.f;
    }
    if (n + 1 < SEQ / 64) SCAN_LOAD(n + 1);

#ifndef PROBE_REPA
#define PROBE_REPA 1
#endif
    const float m_save = m_st;
#pragma unroll 1
    for (int rep = 0; rep < PROBE_REPA; ++rep) {
    if (PROBE_REPA > 1) { m_st = m_save;
#pragma unroll
      for (int c = 0; c < NC; ++c) asm volatile("" : "+v"(g[c]), "+v"(q[c]), "+v"(k[c])); }
    float s_qs[NC], s_ks[NC], s_qi[NC], s_kt[NC];
    if (MIXER != MIX_D) {
#pragma unroll
      for (int c = 0; c < NC; ++c) {
        const float gc = (MIXER == MIX_C) ? g[c] : incl_scan_add(g[c]);
        const float gref = rdlane(gc, 31), glast = rdlane(gc, 63);
        const float a = __expf(gc - gref), ia = __builtin_amdgcn_rcpf(a);
        s_qs[c] = a; s_ks[c] = ia; s_qi[c] = a * __expf(gref); s_kt[c] = ia * __expf(glast - gref);
        if (lane == 63) DEC[(MIXER == MIX_C) ? (c < 4 ? c0 + c : 32 + c0 + c - 4) : c0 + c] = __expf(glast);
      }
    } else {
      const float li = g_li;
      const float lf = logsigmoidf_(g_lf + fgb);
      const float bc = incl_scan_add(lf);
      const float u = li - bc;
      const float pm = incl_scan_max(u);
      const float cmax = rdlane(pm, 63), blast = rdlane(bc, 63);
      const float a_i = bc + m_st, m_i = fmaxf(a_i, bc + pm);
      const float alpha = __expf(bc - m_i + cmax), beta = __expf(u - cmax), sint = __expf(a_i - m_i);
      const float m_new = fmaxf(blast + m_st, blast + cmax);
      const float s_old = __expf(blast + m_st - m_new), wks = __expf(blast + u - m_new);
      m_st = m_new;
#pragma unroll
      for (int c = 0; c < NC; ++c) { s_qs[c] = alpha; s_ks[c] = beta; s_qi[c] = sint; s_kt[c] = wks; }
      if (wid == 0) EM[lane] = __expf(-m_i);
      if (lane == 63) {
#pragma unroll
        for (int c = 0; c < NC; ++c) DEC[c0 + c] = s_old;
      }
    }
    {
      unsigned wq[NC / 2], wk[NC / 2], wi[NC / 2];
#pragma unroll
      for (int c = 0; c < NC / 2; ++c) { wq[c] = pk(q[2 * c] * s_qs[2 * c], q[2 * c + 1] * s_qs[2 * c + 1]); wk[c] = pk(k[2 * c] * s_ks[2 * c], k[2 * c + 1] * s_ks[2 * c + 1]); wi[c] = pk(q[2 * c] * s_qi[2 * c], q[2 * c + 1] * s_qi[2 * c + 1]); }
      if (MIXER == MIX_C) {
        *(u32x2*)(QS + lane * LD_D + c0 * 2) = (u32x2){wq[0], wq[1]}; *(u32x2*)(QS + lane * LD_D + (32 + c0) * 2) = (u32x2){wq[2], wq[3]};
        *(u32x2*)(KS + lane * LD_D + c0 * 2) = (u32x2){wk[0], wk[1]}; *(u32x2*)(KS + lane * LD_D + (32 + c0) * 2) = (u32x2){wk[2], wk[3]};
        *(u32x2*)(QI + lane * LD_D + c0 * 2) = (u32x2){wi[0], wi[1]}; *(u32x2*)(QI + lane * LD_D + (32 + c0) * 2) = (u32x2){wi[2], wi[3]};
      } else {
#pragma unroll
        for (int c = 0; c < NC / 8; ++c) {
          *(u32x4*)(QS + lane * LD_D + (c0 + 8 * c) * 2) = (u32x4){wq[4 * c], wq[4 * c + 1], wq[4 * c + 2], wq[4 * c + 3]};
          *(u32x4*)(KS + lane * LD_D + (c0 + 8 * c) * 2) = (u32x4){wk[4 * c], wk[4 * c + 1], wk[4 * c + 2], wk[4 * c + 3]};
          *(u32x4*)(QI + lane * LD_D + (c0 + 8 * c) * 2) = (u32x4){wi[4 * c], wi[4 * c + 1], wi[4 * c + 2], wi[4 * c + 3]};
        }
      }
#pragma unroll
      for (int c = 0; c < NC; ++c) { const int d = (MIXER == MIX_C) ? (c < 4 ? c0 + c : 32 + c0 + c - 4) : c0 + c; *(bf16_t*)(KT + d * LD_T + lane * 2) = f2bf(k[c] * s_kt[c]); }
      *(bf16_t*)(VT + (wid * 4 + 0) * LD_T + lane * 2) = (bf16_t)(vv.x & 0xffff); *(bf16_t*)(VT + (wid * 4 + 1) * LD_T + lane * 2) = (bf16_t)(vv.x >> 16);
      *(bf16_t*)(VT + (wid * 4 + 2) * LD_T + lane * 2) = (bf16_t)(vv.y & 0xffff); *(bf16_t*)(VT + (wid * 4 + 3) * LD_T + lane * 2) = (bf16_t)(vv.y >> 16);
    }
    }
    lds_barrier();
    {
      const int it = wid & 3;
#pragma unroll
      for (int jj = 0; jj < 2; ++jj) {
        const int jt = 2 * (wid >> 2) + jj;
        if (jt <= it) {
          f32x4 acc = (f32x4){0.f, 0.f, 0.f, 0.f};
#pragma unroll
          for (int ks = 0; ks < NKD; ++ks) acc = __builtin_amdgcn_mfma_f32_16x16x32_bf16(ldfrag(KS, LD_D, jt * 16 + fr, ks * 64 + fq * 16), ldfrag(QS, LD_D, it * 16 + fr, ks * 64 + fq * 16), acc, 0, 0, 0);
          const int i = it * 16 + fr, j0 = jt * 16 + fq * 4;
          const float v0 = (j0 + 0 <= i) ? acc[0] : 0.f, v1 = (j0 + 1 <= i) ? acc[1] : 0.f, v2 = (j0 + 2 <= i) ? acc[2] : 0.f, v3 = (j0 + 3 <= i) ? acc[3] : 0.f;
          *(u32x2*)(SC + i * LD_T + j0 * 2) = (u32x2){pk(v0, v1), pk(v2, v3)};
        } else {
          const int i = it * 16 + fr, j0 = jt * 16 + fq * 4;
          *(u32x2*)(SC + i * LD_T + j0 * 2) = (u32x2){0u, 0u};
        }
      }
    }
    f32x4 oacc = (f32x4){0.f, 0.f, 0.f, 0.f}, dacc = (f32x4){0.f, 0.f, 0.f, 0.f};
    {
      const int vt = wid >> 2, it = wid & 3;
#pragma unroll
      for (int ks = 0; ks < NKD; ++ks) oacc = __builtin_amdgcn_mfma_f32_16x16x32_bf16(ldfrag(ST, LD_D, vt * 16 + fr, ks * 64 + fq * 16), ldfrag(QI, LD_D, it * 16 + fr, ks * 64 + fq * 16), oacc, 0, 0, 0);
      if (NVT == 3 && wid < 4) {
#pragma unroll
        for (int ks = 0; ks < NKD; ++ks) dacc = __builtin_amdgcn_mfma_f32_16x16x32_bf16(ldfrag(ST, LD_D, 32 + fr, ks * 64 + fq * 16), ldfrag(QI, LD_D, wid * 16 + fr, ks * 64 + fq * 16), dacc, 0, 0, 0);
      }
    }
    lds_barrier();
    {
      const int vt = wid >> 2, it = wid & 3;
#pragma unroll
      for (int ks = 0; ks < 2; ++ks) oacc = __builtin_amdgcn_mfma_f32_16x16x32_bf16(ldfrag(VT, LD_T, vt * 16 + fr, ks * 64 + fq * 16), ldfrag(SC, LD_T, it * 16 + fr, ks * 64 + fq * 16), oacc, 0, 0, 0);
      if (NVT == 3) {
        if (wid < 4) {
#pragma unroll
          for (int ks = 0; ks < 2; ++ks) dacc = __builtin_amdgcn_mfma_f32_16x16x32_bf16(ldfrag(VT, LD_T, 32 + fr, ks * 64 + fq * 16), ldfrag(SC, LD_T, wid * 16 + fr, ks * 64 + fq * 16), dacc, 0, 0, 0);
          if (fq == 0) DEN[wid * 16 + fr] = dacc[0];
        }
        lds_barrier();
        const int i = it * 16 + fr;
        const float dn = 1.0f / fmaxf(fabsf(DEN[i]), EM[i]);
        oacc *= dn;
      }
      const int i = it * 16 + fr;
      const int ti = dir ? (SEQ - 1 - (n * 64 + i)) : (n * 64 + i);
      *(u32x2*)(O + (tokbase + ti) * 1024 + ocol + vt * 16 + fq * 4) = (u32x2){pk(oacc[0], oacc[1]), pk(oacc[2], oacc[3])};
    }
    {
      constexpr int NST = (DK == 128) ? NVT : 1;
#pragma unroll
      for (int s = 0; s < NST; ++s) {
        const int dt = (DK == 128) ? wid : (wid & 3), vt = (DK == 128) ? s : (wid >> 2);
        const f32x4 dc = *(const f32x4*)(DEC + dt * 16 + fq * 4);
        f32x4 acc = sacc[s] * dc;
#pragma unroll
        for (int ks = 0; ks < 2; ++ks) acc = __builtin_amdgcn_mfma_f32_16x16x32_bf16(ldfrag(KT, LD_T, dt * 16 + fr, ks * 64 + fq * 16), ldfrag(VT, LD_T, vt * 16 + fr, ks * 64 + fq * 16), acc, 0, 0, 0);
        sacc[s] = acc;
        *(u32x2*)(ST + (vt * 16 + fr) * LD_D + (dt * 16 + fq * 4) * 2) = (u32x2){pk(acc[0], acc[1]), pk(acc[2], acc[3])};
      }
    }
    lds_barrier();
  }
}

template <int MIXER>
__device__ __forceinline__ void scan_dispatch(unsigned char* lds, int wv, const Params& p, int id) {
  const int vs = id & 3, dir = (id >> 2) & 1, h = (id >> 3) & 3, b = id >> 5;
  scan_item<MIXER>(lds, wv, p, b, h, dir, vs);
}
}

__device__ __forceinline__ void convd_phase(unsigned char* lds_, int wv, const Params& p) {
  const Ctx c = make_ctx(lds_, wv);
  bf16_t* P = (bf16_t*)(p.ws + WS_R1); bf16_t* QD = (bf16_t*)(p.ws + WS_LFB);
  const float* cw = p.in[I_CONV_W]; const float* cb = p.in[I_CONV_B];
  const int ch = c.lane * 16;
  float w0[16], w1[16], w2[16], bb[16];
#pragma unroll
  for (int j = 0; j < 16; ++j) { w0[j] = cw[ch + j]; w1[j] = cw[1024 + ch + j]; w2[j] = cw[2048 + ch + j]; bb[j] = cb[ch + j]; }
  for (int tok = c.bid * 8 + c.wid; tok < NTOK; tok += c.G * 8) {
    const int t = tok % SEQ;
    const bf16_t* row = P + (size_t)tok * PSTRIDE + 1536 + ch;
    float x0[16], x1[16], x2[16];
    { const u32x4* r1 = (const u32x4*)row; unpack8(r1[0], x1); unpack8(r1[1], x1 + 8); }
    if (t > 0) { const u32x4* r0 = (const u32x4*)(row - PSTRIDE); unpack8(r0[0], x0); unpack8(r0[1], x0 + 8); }
    else {
#pragma unroll
      for (int j = 0; j < 16; ++j) x0[j] = 0.f; }
    if (t < SEQ - 1) { const u32x4* r2 = (const u32x4*)(row + PSTRIDE); unpack8(r2[0], x2); unpack8(r2[1], x2 + 8); }
    else {
#pragma unroll
      for (int j = 0; j < 16; ++j) x2[j] = 0.f; }
    const float sc = ch < 512 ? 0.08838834764831845f : 1.0f;
    unsigned w[8];
#pragma unroll
    for (int j = 0; j < 8; ++j) {
      const float a0 = bb[2 * j] + w0[2 * j] * x0[2 * j] + w1[2 * j] * x1[2 * j] + w2[2 * j] * x2[2 * j];
      const float a1 = bb[2 * j + 1] + w0[2 * j + 1] * x0[2 * j + 1] + w1[2 * j + 1] * x1[2 * j + 1] + w2[2 * j + 1] * x2[2 * j + 1];
      w[j] = pk2(fsilu(a0) * sc, fsilu(a1) * sc);
    }
    u32x4* d = (ch < 512) ? (u32x4*)(QD + (size_t)tok * 512 + ch) : (u32x4*)(P + (size_t)tok * PSTRIDE + 3584 + (ch - 512));
    d[0] = (u32x4){w[0], w[1], w[2], w[3]}; d[1] = (u32x4){w[4], w[5], w[6], w[7]};
  }
}

__device__ __forceinline__ void scan_phase(unsigned char* lds, int wv, const Params& p, int layer) {
  for (int item = blockIdx.x; item < 256; item += gridDim.x) {
    if (layer == 0) { if (item < 128) scan::scan_dispatch<scan::MIX_A>(lds, wv, p, item); else scan::scan_dispatch<scan::MIX_B>(lds, wv, p, item - 128); }
    else { if (item < 128) scan::scan_dispatch<scan::MIX_D>(lds, wv, p, item); else scan::scan_dispatch<scan::MIX_C>(lds, wv, p, item - 128); }
    __syncthreads();
  }
}
#endif
#ifndef CPU_EMU
namespace scan2 {
using namespace scan;
constexpr int S_QS = 0, S_KS = 17408, S_QI = 34816, S_KT = 52224  , S_VT = 89088  , S_SC = 102912, S_ST = 112128  , S_DEC = 138240  , S_EM = 139264  , S_END = 139776;

constexpr int T_SC = 102912  , T_ST = 121344  , T_DEC = 147456  , T_EM = 148480  , T_END = 148992;
template <int MIXER>
__device__ __forceinline__ void scan_item2(unsigned char* lds, int wv, const Params& p, int b, int h, int dir, int vs) {
  constexpr int DK = (MIXER == MIX_A || MIXER == MIX_D) ? 128 : 64;
  constexpr int NC = DK / 8;
  constexpr int LD_D = DK * 2 + 16;
  constexpr int NVT = MIXER == MIX_D ? 3 : 2;
  constexpr int NKD = DK / 32;
  constexpr int NST = (DK == 128) ? NVT : 1;
  constexpr int NCH = SEQ / 64;
  const int tid = opaque_tid(wv), lane0 = tid & 63, wid = __builtin_amdgcn_readfirstlane(tid >> 6);
  unsigned char* ws = p.ws;
  const bf16_t* P = (const bf16_t*)(ws + WS_R1);
  const bf16_t* LFBp = (const bf16_t*)(ws + WS_LFB);
  const float* side = (const float*)(ws + WS_SIDE);
  const float* rope = (const float*)(ws + WS_ROPE);
  bf16_t* O = (bf16_t*)(ws + WS_R2) + (size_t)dir * NTOK * 1024;
  unsigned char* QS = lds + S_QS; unsigned char* KS = lds + S_KS; unsigned char* QI = lds + S_QI;
  unsigned char* SC = lds + T_SC + (wid >> 2) * 9216;
  int qcol, kcol, lfcol, vcol, ocol;
  if (MIXER == MIX_A) { qcol = h * 128; kcol = 0; lfcol = 512 + dir * 512 + h * 128; vcol = 1536 + h * 128 + vs * 32; ocol = h * 128 + vs * 32; }
  else if (MIXER == MIX_B) { qcol = 2560 + h * 64; kcol = 2816 + h * 64; lfcol = dir * 256 + h * 64; vcol = 3072 + h * 128 + vs * 32; ocol = 512 + h * 128 + vs * 32; }
  else if (MIXER == MIX_C) { qcol = h * 64; kcol = 256 + h * 64; lfcol = 0; vcol = 512 + h * 128 + vs * 32; ocol = h * 128 + vs * 32; }
  else { qcol = h * 128; kcol = 3584 + h * 128; lfcol = 0; vcol = 2560 + h * 128 + vs * 32; ocol = 512 + h * 128 + vs * 32; }
  const size_t tokbase = (size_t)b * SEQ;
  const int c0 = (MIXER == MIX_C) ? wid * 4 : wid * NC;
  for (int i = tid; i < 2 * 13056 / 4; i += NTHREADS) ((unsigned*)(lds + T_ST))[i] = 0u;
  for (int i = tid; i < 2 * 9216 / 4; i += NTHREADS) ((unsigned*)(lds + T_SC))[i] = 0u;
  if (MIXER == MIX_D) { for (int i = tid; i < 2 * 16 * 64; i += NTHREADS) { const int bf = i >> 10, r = 32 + ((i >> 6) & 15), j = i & 63; *(bf16_t*)(lds + S_VT + bf * 6912 + r * LD_T + j * 2) = (r == 32) ? (bf16_t)0x3F80 : (bf16_t)0; } }
  const float lgam2 = (MIXER == MIX_C) ? log1pf(-exp2f(-(5.0f + 2.0f * (float)h + (float)dir))) * 1.4426950408889634f : 0.f;
  const float fgb = (MIXER == MIX_D) ? p.in[I_FGATE_B][dir * 4 + h] : 0.f;
  float m_st = 0.f;
  __syncthreads();

  Raw R, Rn; u32x2 Rv, Rvn;
#define A_LOAD(R, Rv, n_) do { \
    int ln_ = lane0; asm volatile("" : "+v"(ln_)); \
    const int t_ = dir ? (SEQ - 1 - ((n_) * 64 + ln_)) : ((n_) * 64 + ln_); \
    const bf16_t* row_ = P + (tokbase + t_) * PSTRIDE; \
    if (MIXER == MIX_A) { const u32x4* qp_ = (const u32x4*)(row_ + qcol + c0); const u32x4* lp_ = (const u32x4*)(row_ + lfcol + c0); R.a0 = qp_[0]; R.a1 = qp_[1]; R.b0 = lp_[0]; R.b1 = lp_[1]; } \
    else if (MIXER == MIX_B) { R.a0 = *(const u32x4*)(row_ + qcol + c0); R.a1 = *(const u32x4*)(row_ + kcol + c0); R.b0 = *(const u32x4*)(LFBp + (tokbase + t_) * 512 + lfcol + c0); } \
    else if (MIXER == MIX_C) { const u32x2 qa_ = *(const u32x2*)(row_ + qcol + c0), qb_ = *(const u32x2*)(row_ + qcol + 32 + c0), ka_ = *(const u32x2*)(row_ + kcol + c0), kb_ = *(const u32x2*)(row_ + kcol + 32 + c0); \
      R.a0 = (u32x4){qa_.x, qa_.y, qb_.x, qb_.y}; R.a1 = (u32x4){ka_.x, ka_.y, kb_.x, kb_.y}; \
      R.r0 = *(const f32x4*)(rope + ((size_t)t_ * 32 + c0) * 2); R.r1 = *(const f32x4*)(rope + ((size_t)t_ * 32 + c0) * 2 + 4); } \
    else { const u32x4* qp_ = (const u32x4*)(LFBp + (tokbase + t_) * 512 + qcol + c0); const u32x4* kp_ = (const u32x4*)(row_ + kcol + c0); R.a0 = qp_[0]; R.a1 = qp_[1]; R.b0 = kp_[0]; R.b1 = kp_[1]; \
      R.s0 = side[(tokbase + t_) * 32 + dir * 8 + h]; R.s1 = side[(tokbase + t_) * 32 + dir * 8 + 4 + h]; } \
    Rv = *(const u32x2*)(row_ + vcol + wid * 4); } while (0)

  unsigned pq[NC / 2], pks[NC / 2], pqi[NC / 2];
#define A_PREP(buf_) do { \
    int lane = lane0; asm volatile("" : "+v"(lane)); \
    unsigned char* KTb = lds + S_KT + (buf_) * 18432; float* DECb = (float*)(lds + T_DEC + (buf_) * 512); float* EMb = (float*)(lds + T_EM + (buf_) * 256); \
    float q[NC], k[NC], g[NC], ktv[NC]; \
    if (MIXER == MIX_A) { \
      const unsigned qw[8] = {R.a0.x, R.a0.y, R.a0.z, R.a0.w, R.a1.x, R.a1.y, R.a1.z, R.a1.w}, lw[8] = {R.b0.x, R.b0.y, R.b0.z, R.b0.w, R.b1.x, R.b1.y, R.b1.z, R.b1.w}; \
      _Pragma("unroll") for (int c = 0; c < 8; ++c) { q[2 * c] = lo16(qw[c]); q[2 * c + 1] = hi16(qw[c]); g[2 * c] = lo16(lw[c]); g[2 * c + 1] = hi16(lw[c]); } \
      _Pragma("unroll") for (int c = 0; c < NC; ++c) k[c] = 1.0f - __builtin_amdgcn_exp2f(g[c]); \
    } else if (MIXER == MIX_B) { \
      const unsigned qw[4] = {R.a0.x, R.a0.y, R.a0.z, R.a0.w}, kw[4] = {R.a1.x, R.a1.y, R.a1.z, R.a1.w}, lw[4] = {R.b0.x, R.b0.y, R.b0.z, R.b0.w}; \
      _Pragma("unroll") for (int c = 0; c < 4; ++c) { q[2 * c] = lo16(qw[c]); q[2 * c + 1] = hi16(qw[c]); k[2 * c] = lo16(kw[c]); k[2 * c + 1] = hi16(kw[c]); g[2 * c] = lo16(lw[c]); g[2 * c + 1] = hi16(lw[c]); } \
    } else if (MIXER == MIX_C) { \
      const float cs[4] = {R.r0[0], R.r0[2], R.r1[0], R.r1[2]}, sn[4] = {R.r0[1], R.r0[3], R.r1[1], R.r1[3]}; \
      const float q1[4] = {lo16(R.a0.x), hi16(R.a0.x), lo16(R.a0.y), hi16(R.a0.y)}, q2[4] = {lo16(R.a0.z), hi16(R.a0.z), lo16(R.a0.w), hi16(R.a0.w)}; \
      const float k1[4] = {lo16(R.a1.x), hi16(R.a1.x), lo16(R.a1.y), hi16(R.a1.y)}, k2[4] = {lo16(R.a1.z), hi16(R.a1.z), lo16(R.a1.w), hi16(R.a1.w)}; \
      _Pragma("unroll") for (int c = 0; c < 4; ++c) { q[c] = (q1[c] * cs[c] - q2[c] * sn[c]) * 0.125f; q[4 + c] = (q1[c] * sn[c] + q2[c] * cs[c]) * 0.125f; k[c] = k1[c] * cs[c] - k2[c] * sn[c]; k[4 + c] = k1[c] * sn[c] + k2[c] * cs[c]; } \
    } else { \
      const unsigned qw[8] = {R.a0.x, R.a0.y, R.a0.z, R.a0.w, R.a1.x, R.a1.y, R.a1.z, R.a1.w}, kw[8] = {R.b0.x, R.b0.y, R.b0.z, R.b0.w, R.b1.x, R.b1.y, R.b1.z, R.b1.w}; \
      _Pragma("unroll") for (int c = 0; c < 8; ++c) { q[2 * c] = lo16(qw[c]); q[2 * c + 1] = hi16(qw[c]); k[2 * c] = lo16(kw[c]); k[2 * c + 1] = hi16(kw[c]); } \
    } \
    if (MIXER == MIX_A || MIXER == MIX_B) { \
        \
      _Pragma("unroll") for (int c = 0; c < NC; ++c) g[c] += __builtin_bit_cast(float, __builtin_amdgcn_update_dpp(0, __builtin_bit_cast(int, g[c]), 0x111, 0xf, 0xf, false)); \
      _Pragma("unroll") for (int c = 0; c < NC; ++c) g[c] += __builtin_bit_cast(float, __builtin_amdgcn_update_dpp(0, __builtin_bit_cast(int, g[c]), 0x112, 0xf, 0xf, false)); \
      _Pragma("unroll") for (int c = 0; c < NC; ++c) g[c] += __builtin_bit_cast(float, __builtin_amdgcn_update_dpp(0, __builtin_bit_cast(int, g[c]), 0x114, 0xf, 0xf, false)); \
      _Pragma("unroll") for (int c = 0; c < NC; ++c) g[c] += __builtin_bit_cast(float, __builtin_amdgcn_update_dpp(0, __builtin_bit_cast(int, g[c]), 0x118, 0xf, 0xf, false)); \
      _Pragma("unroll") for (int c = 0; c < NC; ++c) g[c] += __builtin_bit_cast(float, __builtin_amdgcn_update_dpp(0, __builtin_bit_cast(int, g[c]), 0x142, 0xa, 0xf, false)); \
      _Pragma("unroll") for (int c = 0; c < NC; ++c) g[c] += __builtin_bit_cast(float, __builtin_amdgcn_update_dpp(0, __builtin_bit_cast(int, g[c]), 0x143, 0xc, 0xf, false)); \
      float ev[NC]; \
      _Pragma("unroll") for (int c = 0; c < NC; ++c) { \
          \
        const float e = __builtin_amdgcn_exp2f(g[c]), r = __builtin_amdgcn_rcpf(e); \
        const float e31 = rdlane(e, 31), r31 = rdlane(r, 31), e63 = rdlane(e, 63); \
        const float qi = q[c] * e, kr = k[c] * r; \
        g[c] = qi; q[c] = qi * r31; k[c] = kr * e31; ktv[c] = kr * e63; \
        ev[c] = e; } \
      if (lane == 63) { _Pragma("unroll") for (int c = 0; c < NC / 4; ++c) *(f32x4*)(DECb + c0 + 4 * c) = (f32x4){ev[4 * c], ev[4 * c + 1], ev[4 * c + 2], ev[4 * c + 3]}; } \
    } else if (MIXER == MIX_C) { \
        \
      const float gl = (float)(lane + 1) * lgam2; \
      const float e = __builtin_amdgcn_exp2f(gl), r = __builtin_amdgcn_rcpf(e); \
      const float e31 = rdlane(e, 31), r31 = rdlane(r, 31), e63 = rdlane(e, 63); \
      const float f_qs = e * r31, f_ks = r * e31, f_kt = r * e63; \
      _Pragma("unroll") for (int c = 0; c < NC; ++c) { g[c] = q[c] * e; q[c] *= f_qs; ktv[c] = k[c] * f_kt; k[c] *= f_ks; } \
      if (lane < 4) { DECb[c0 + lane] = e63; DECb[32 + c0 + lane] = e63; } \
    } else { \
      const float li = R.s0 * 1.4426950408889634f; const float lf = logsigmoidf_(R.s1 + fgb) * 1.4426950408889634f;     \
      const float bc = incl_scan_add(lf); const float u = li - bc; const float pm = incl_scan_max(u); \
      const float cmax = rdlane(pm, 63), blast = rdlane(bc, 63); \
      const float a_i = bc + m_st, m_i = fmaxf(a_i, bc + pm); \
      const float d_alpha = __builtin_amdgcn_exp2f(bc - m_i + cmax), d_beta = __builtin_amdgcn_exp2f(u - cmax), d_sint = __builtin_amdgcn_exp2f(a_i - m_i); \
      const float m_new = fmaxf(blast + m_st, blast + cmax); \
      const float d_sold = __builtin_amdgcn_exp2f(blast + m_st - m_new), d_wks = __builtin_amdgcn_exp2f(blast + u - m_new); m_st = m_new; \
      _Pragma("unroll") for (int c = 0; c < NC; ++c) { ktv[c] = k[c] * d_wks; g[c] = q[c] * d_sint; q[c] *= d_alpha; k[c] *= d_beta; if (lane == 63) DECb[c0 + c] = d_sold; } \
      if (wid == 0) EMb[lane] = __builtin_amdgcn_exp2f(-m_i); \
    } \
    _Pragma("unroll") for (int c = 0; c < NC / 2; ++c) { const unsigned w_ = pk_hw(ktv[2 * c], ktv[2 * c + 1]); \
      const int d0_ = (MIXER == MIX_C) ? (2 * c < 4 ? c0 + 2 * c : 32 + c0 + 2 * c - 4) : c0 + 2 * c; \
      *(bf16_t*)(KTb + d0_ * LD_T + lane * 2) = (bf16_t)(w_ & 0xffff); *(bf16_t*)(KTb + (d0_ + 1) * LD_T + lane * 2) = (bf16_t)(w_ >> 16); } \
    _Pragma("unroll") for (int c = 0; c < NC / 2; ++c) { pq[c] = pk_hw(q[2 * c], q[2 * c + 1]); pks[c] = pk_hw(k[2 * c], k[2 * c + 1]); pqi[c] = pk_hw(g[2 * c], g[2 * c + 1]); } \
    { unsigned char* VTb = lds + S_VT + (buf_) * 6912 + (wid * 4) * LD_T + lane * 2; \
      *(bf16_t*)(VTb + 0 * LD_T) = (bf16_t)(Rv.x & 0xffff); *(bf16_t*)(VTb + 1 * LD_T) = (bf16_t)(Rv.x >> 16); *(bf16_t*)(VTb + 2 * LD_T) = (bf16_t)(Rv.y & 0xffff); *(bf16_t*)(VTb + 3 * LD_T) = (bf16_t)(Rv.y >> 16); } \
  } while (0)
#define A_WRITE() do { int lane = lane0; asm volatile("" : "+v"(lane)); \
    if (MIXER == MIX_C) { \
      *(u32x2*)(QS + lane * LD_D + c0 * 2) = (u32x2){pq[0], pq[1]}; *(u32x2*)(QS + lane * LD_D + (32 + c0) * 2) = (u32x2){pq[2], pq[3]}; \
      *(u32x2*)(KS + lane * LD_D + c0 * 2) = (u32x2){pks[0], pks[1]}; *(u32x2*)(KS + lane * LD_D + (32 + c0) * 2) = (u32x2){pks[2], pks[3]}; \
      *(u32x2*)(QI + lane * LD_D + c0 * 2) = (u32x2){pqi[0], pqi[1]}; *(u32x2*)(QI + lane * LD_D + (32 + c0) * 2) = (u32x2){pqi[2], pqi[3]}; \
    } else { \
      _Pragma("unroll") for (int c = 0; c < NC / 8; ++c) { \
        *(u32x4*)(QS + lane * LD_D + (c0 + 8 * c) * 2) = (u32x4){pq[4 * c], pq[4 * c + 1], pq[4 * c + 2], pq[4 * c + 3]}; \
        *(u32x4*)(KS + lane * LD_D + (c0 + 8 * c) * 2) = (u32x4){pks[4 * c], pks[4 * c + 1], pks[4 * c + 2], pks[4 * c + 3]}; \
        *(u32x4*)(QI + lane * LD_D + (c0 + 8 * c) * 2) = (u32x4){pqi[4 * c], pqi[4 * c + 1], pqi[4 * c + 2], pqi[4 * c + 3]}; } } } while (0)

  f32x4 sacc[NST];
#pragma unroll
  for (int i = 0; i < NST; ++i) sacc[i] = (f32x4){0.f, 0.f, 0.f, 0.f};
  A_LOAD(R, Rv, 0);
  A_PREP(0);
  A_LOAD(R, Rv, 1);
  A_LOAD(Rn, Rvn, 2);
  A_WRITE();
  lds_barrier();
  for (int n = 0; n < NCH; ++n) {
    const int cb = n & 1, nb = (n + 1) & 1;
#pragma unroll 1
    for (int pass = 0; pass < 2; ++pass) {
    if ((pass == 0) == (wid < 4)) {
    if (n + 1 < NCH) { A_PREP(nb); R = Rn; Rv = Rvn; if (n + 3 < NCH) A_LOAD(Rn, Rvn, n + 3); }
    } else {
      int lane = lane0; asm volatile("" : "+v"(lane));
      const int fr = lane & 15, fq = lane >> 4;
      const int it = wid & 3, vt = wid >> 2;
      const unsigned char* STc = lds + T_ST + cb * 13056; unsigned char* STn = lds + T_ST + nb * 13056;
      const unsigned char* KTc = lds + S_KT + cb * 18432; const unsigned char* VTc = lds + S_VT + cb * 6912;
      const float* DECc = (const float*)(lds + T_DEC + cb * 512); const float* EMc = (const float*)(lds + T_EM + cb * 256);
#pragma unroll
      for (int jt = 0; jt < 4; ++jt) {
        if (jt <= it) {
          f32x4 acc = (f32x4){0.f, 0.f, 0.f, 0.f};
#pragma unroll
          for (int ks = 0; ks < NKD; ++ks) acc = __builtin_amdgcn_mfma_f32_16x16x32_bf16(ldfrag(KS, LD_D, jt * 16 + fr, ks * 64 + fq * 16), ldfrag(QS, LD_D, it * 16 + fr, ks * 64 + fq * 16), acc, 0, 0, 0);
          const int i = it * 16 + fr, j0 = jt * 16 + fq * 4;
          const float v0 = (j0 + 0 <= i) ? acc[0] : 0.f, v1 = (j0 + 1 <= i) ? acc[1] : 0.f, v2 = (j0 + 2 <= i) ? acc[2] : 0.f, v3 = (j0 + 3 <= i) ? acc[3] : 0.f;
          *(u32x2*)(SC + i * LD_T + j0 * 2) = (u32x2){pk_hw(v0, v1), pk_hw(v2, v3)};
        }
      }
      f32x4 oacc = (f32x4){0.f, 0.f, 0.f, 0.f}, dacc = (f32x4){0.f, 0.f, 0.f, 0.f};
#pragma unroll
      for (int ks = 0; ks < NKD; ++ks) oacc = __builtin_amdgcn_mfma_f32_16x16x32_bf16(ldfrag(STc, LD_D, vt * 16 + fr, ks * 64 + fq * 16), ldfrag(QI, LD_D, it * 16 + fr, ks * 64 + fq * 16), oacc, 0, 0, 0);
      if (NVT == 3) {
#pragma unroll
        for (int ks = 0; ks < NKD; ++ks) dacc = __builtin_amdgcn_mfma_f32_16x16x32_bf16(ldfrag(STc, LD_D, 32 + fr, ks * 64 + fq * 16), ldfrag(QI, LD_D, it * 16 + fr, ks * 64 + fq * 16), dacc, 0, 0, 0);
      }
      asm volatile("s_waitcnt lgkmcnt(0)" ::: "memory");
      oacc = __builtin_amdgcn_mfma_f32_16x16x32_bf16(ldfrag(VTc, LD_T, vt * 16 + fr, fq * 16), ldfrag(SC, LD_T, it * 16 + fr, fq * 16), oacc, 0, 0, 0);
      if (it >= 2) oacc = __builtin_amdgcn_mfma_f32_16x16x32_bf16(ldfrag(VTc, LD_T, vt * 16 + fr, 64 + fq * 16), ldfrag(SC, LD_T, it * 16 + fr, 64 + fq * 16), oacc, 0, 0, 0);
      float dn = 1.0f;
      if (NVT == 3) {
        dacc = __builtin_amdgcn_mfma_f32_16x16x32_bf16(ldfrag(VTc, LD_T, 32 + fr, fq * 16), ldfrag(SC, LD_T, it * 16 + fr, fq * 16), dacc, 0, 0, 0);
        if (it >= 2) dacc = __builtin_amdgcn_mfma_f32_16x16x32_bf16(ldfrag(VTc, LD_T, 32 + fr, 64 + fq * 16), ldfrag(SC, LD_T, it * 16 + fr, 64 + fq * 16), dacc, 0, 0, 0);
        const float den = __shfl(dacc[0], fr);
        dn = 1.0f / fmaxf(fabsf(den), EMc[it * 16 + fr]);
      }
      {
        const int i = it * 16 + fr;
        const int ti = dir ? (SEQ - 1 - (n * 64 + i)) : (n * 64 + i);
        const f32x4 o = oacc * dn;
        *(u32x2*)(O + (tokbase + ti) * 1024 + ocol + vt * 16 + fq * 4) = (u32x2){pk_hw(o[0], o[1]), pk_hw(o[2], o[3])};
      }
#pragma unroll
      for (int s = 0; s < NST; ++s) {
        const int dt = (DK == 128) ? wid : (wid & 3), vt2 = (DK == 128) ? s : (wid >> 2);
        const f32x4 dc = *(const f32x4*)(DECc + dt * 16 + fq * 4);
        f32x4 acc = sacc[s] * dc;
#pragma unroll
        for (int ks = 0; ks < 2; ++ks) acc = __builtin_amdgcn_mfma_f32_16x16x32_bf16(ldfrag(KTc, LD_T, dt * 16 + fr, ks * 64 + fq * 16), ldfrag(VTc, LD_T, vt2 * 16 + fr, ks * 64 + fq * 16), acc, 0, 0, 0);
        sacc[s] = acc;
        *(u32x2*)(STn + (vt2 * 16 + fr) * LD_D + (dt * 16 + fq * 4) * 2) = (u32x2){pk_hw(acc[0], acc[1]), pk_hw(acc[2], acc[3])};
      }
    }
    }
    lds_barrier();
    if (n + 1 < NCH) A_WRITE();
    lds_barrier();
  }
#undef A_LOAD
#undef A_PREP
#undef A_WRITE
}

template <int MIXER>
__device__ __forceinline__ void scan_dispatch2(unsigned char* lds, int wv, const Params& p, int id) {
  const int vs = id & 3, dir = (id >> 2) & 1, h = (id >> 3) & 3, b = id >> 5;
  scan_item2<MIXER>(lds, wv, p, b, h, dir, vs);
}
}

__device__ __forceinline__ void scan_phase2(unsigned char* lds, int wv, const Params& p, int layer) {
  for (int it0 = blockIdx.x; it0 < 256; it0 += gridDim.x) {
    const int xq = it0 & 7, yq = it0 >> 3, stream = (yq >> 2) * 8 + xq;
    const int item = (stream >> 5) * 128 + (stream & 31) * 4 + (yq & 3);
    if (layer == 0) { if (item < 128) scan2::scan_dispatch2<scan::MIX_A>(lds, wv, p, item); else scan2::scan_dispatch2<scan::MIX_B>(lds, wv, p, item - 128); }
    else { if (item < 128) scan2::scan_dispatch2<scan::MIX_D>(lds, wv, p, item); else scan2::scan_dispatch2<scan::MIX_C>(lds, wv, p, item - 128); }
    __syncthreads();
  }
}
#endif
#ifndef CPU_EMU
__device__ __forceinline__ void grid_bar(unsigned* ctr, unsigned& epoch, unsigned G, int wv) {
  asm volatile("s_waitcnt vmcnt(0)" ::: "memory");
  __syncthreads();
  epoch += G;
  if (wv == 0 && lane_id() == 0) {
    __builtin_amdgcn_fence(__ATOMIC_RELEASE, "agent");
    asm volatile("s_waitcnt vmcnt(0)" ::: "memory");
    __hip_atomic_fetch_add(ctr, 1u, __ATOMIC_RELAXED, __HIP_MEMORY_SCOPE_AGENT);
    unsigned spins = 0;
    while (__hip_atomic_load(ctr, __ATOMIC_RELAXED, __HIP_MEMORY_SCOPE_AGENT) < epoch) { __builtin_amdgcn_s_sleep(2); if (++spins > (1u << 26)) break; }
    __builtin_amdgcn_fence(__ATOMIC_ACQUIRE, "agent");
    asm volatile("s_waitcnt vmcnt(0)" ::: "memory");
  }
  __syncthreads();
}
#if (PROBE_DUP & 16)
#define grid_bar(a, b, c, d) do { grid_bar(a, b, c, d); grid_bar(a, b, c, d); } while (0)
#endif

__global__ void __launch_bounds__(NTHREADS) mk_fwd(Params p) {
  extern __shared__ __attribute__((aligned(16))) unsigned char lds_raw[];
  cg::grid_group grid = cg::this_grid();
  const int G = gridDim.x, bid = blockIdx.x;
  const int wv = __builtin_amdgcn_readfirstlane(threadIdx.x >> 6);
  PG8_LAS unsigned char* lds = (PG8_LAS unsigned char*)lds_raw;
  unsigned char* ws = p.ws;

  p0_prologue(lds_raw, wv, p);
#if (PROBE_DUP & 128)
  p0_prologue(lds_raw, wv, p);
#endif
  grid.sync();
  unsigned* bar = (unsigned*)(ws + WS_CTL) + 1024;
  unsigned epoch = 0;
  for (int layer = 0; layer < 2; ++layer) {
    { ProbInProj pr; pr.so.init(NTOK, layer == 0 ? PM_AB : PM_CD, G, bid); pr.A = (const char*)(ws + WS_HB); pr.Bt = (const char*)(ws + (layer == 0 ? WS_WIN_AB : WS_WIN_CD));
      pr.P = (bf16_t*)(ws + WS_R1); pr.bias = p.in[layer == 0 ? I_AB_B_IN : I_CD_B_IN]; pr.lb = (const float*)(ws + WS_LB); pr.layer = layer;
      pg8::gemm_phase(lds, pr, wv);
#if (PROBE_DUP & 1)
      pg8::gemm_phase(lds, pr, wv);
#endif
      if (layer == 0) side_phase<32>(lds_raw, wv, p, 0); else side_phase<16>(lds_raw, wv, p, 1);
#if (PROBE_DUP & 256)
      if (layer == 0) side_phase<32>(lds_raw, wv, p, 0); else side_phase<16>(lds_raw, wv, p, 1);
#endif
 }
    grid_bar(bar, epoch, (unsigned)G, wv);
    if (layer == 1) { convd_phase(lds_raw, wv, p); grid_bar(bar, epoch, (unsigned)G, wv); }
    scan_phase2(lds_raw, wv, p, layer);
#if (PROBE_DUP & 2)
    scan_phase2(lds_raw, wv, p, layer);
#endif
    grid_bar(bar, epoch, (unsigned)G, wv);
    headnorm_phase(lds_raw, wv, p, layer);
#if (PROBE_DUP & 8)
    headnorm_phase(lds_raw, wv, p, layer);
#endif
    grid_bar(bar, epoch, (unsigned)G, wv);
    { ProbOutProj pr; pr.so.init(NTOK, 1024, G, bid); pr.A = (const char*)(ws + WS_HB); pr.Bt = (const char*)(ws + (layer == 0 ? WS_WOUT_AB : WS_WOUT_CD)); pr.Y = (float*)(ws + WS_R2);
      pg8::gemm_phase(lds, pr, wv);
#if (PROBE_DUP & 1)
      pg8::gemm_phase(lds, pr, wv);
#endif
      moe_weight_convert(lds_raw, wv, p, layer);
#if (PROBE_DUP & 4)
      moe_weight_convert(lds_raw, wv, p, layer);
#endif
 }
    grid_bar(bar, epoch, (unsigned)G, wv);
#if (PROBE_DUP & 32)
    ln_phase(lds_raw, wv, p, layer, 0, 1);
#endif
    ln_phase(lds_raw, wv, p, layer, 0);
    grid_bar(bar, epoch, (unsigned)G, wv);
    { ProbMoe1 pr; pr.mo.init((const int*)((const unsigned*)(ws + WS_CTL) + CW_CNT(layer)), 8, G, bid, lds_raw, wv);
      pr.A = (const char*)(ws + WS_HB); pr.W13 = (const char*)(ws + WS_WMOE); pr.list = (const int*)(ws + WS_LIST) + (size_t)layer * NEXP * NTOK; pr.H = (bf16_t*)(ws + WS_H);
      pg8::gemm_phase(lds, pr, wv);
#if (PROBE_DUP & 1)
      pg8::gemm_phase(lds, pr, wv);
#endif
 }
    grid_bar(bar, epoch, (unsigned)G, wv);
    { ProbMoe2 pr; pr.mo.init((const int*)((const unsigned*)(ws + WS_CTL) + CW_CNT(layer)), 4, G, bid, lds_raw, wv);
      pr.A = (const char*)(ws + WS_H); pr.W2 = (const char*)(ws + WS_WMOE) + (size_t)NEXP * 2048 * 1024 * 2; pr.Y = (bf16_t*)(ws + WS_R2);
      pg8::gemm_phase(lds, pr, wv);
#if (PROBE_DUP & 1)
      pg8::gemm_phase(lds, pr, wv);
#endif
 }
    grid_bar(bar, epoch, (unsigned)G, wv);
#if (PROBE_DUP & 64)
    ln_phase(lds_raw, wv, p, layer, 1, 1);
#endif
    ln_phase(lds_raw, wv, p, layer, 1);
    if (layer == 0) grid_bar(bar, epoch, (unsigned)G, wv);
  }
}

extern "C" void kernel_launch(void* const* d_in, const int* in_sizes, int n_in, void* d_out, int out_size, void* d_ws, size_t ws_size, hipStream_t stream) {
  static int grid_blocks = 0;
  if (grid_blocks == 0) {
    if (n_in != N_IN || ws_size < WS_END || out_size != NTOK * 1024) { fprintf(stderr, "kernel_launch: bad shapes: n_in %d ws %zu (need %zu) out %d\n", n_in, ws_size, (size_t)WS_END, out_size); grid_blocks = -1; return; }
    int dev = 0, cus = 0, per_cu = 0;
    hipGetDevice(&dev); hipDeviceGetAttribute(&cus, hipDeviceAttributeMultiprocessorCount, dev);
    if (hipFuncSetAttribute((const void*)mk_fwd, hipFuncAttributeMaxDynamicSharedMemorySize, LDS_BYTES) != hipSuccess) { fprintf(stderr, "kernel_launch: hipFuncSetAttribute failed\n"); grid_blocks = -1; return; }
    if (hipOccupancyMaxActiveBlocksPerMultiprocessor(&per_cu, (const void*)mk_fwd, NTHREADS, LDS_BYTES) != hipSuccess || per_cu < 1) { fprintf(stderr, "kernel_launch: occupancy query failed (%d)\n", per_cu); grid_blocks = -1; return; }
    grid_blocks = cus;
    (void)in_sizes;
  }
  if (grid_blocks < 0) return;
  Params p{};
  for (int i = 0; i < N_IN; ++i) p.in[i] = (const float*)d_in[i];
  p.out = (float*)d_out; p.ws = (unsigned char*)d_ws;
  void* args[] = {&p};
  hipError_t e = hipLaunchCooperativeKernel((const void*)mk_fwd, dim3(grid_blocks), dim3(NTHREADS), args, LDS_BYTES, stream);
  if (e != hipSuccess) fprintf(stderr, "cooperative launch failed: %s (grid %d)\n", hipGetErrorString(e), grid_blocks);
}
#endif
#ifdef CPU_EMU
#include <vector>
void dbg_cmp(const char* name, const float* p, long n);
template <class F> static void run_functor(const F& f, long n) {
#pragma omp parallel for schedule(dynamic, 16)
  for (long g = 0; g < n; ++g) f(g);
}
static void cpu_round_w(const float* src, size_t n, std::vector<float>& dst) { dst.resize(n); for (size_t i = 0; i < n; ++i) dst[i] = bf2f(f2bf(src[i])); }

extern "C" void kernel_launch(void* const* d_in, const int* in_sizes, int n_in, void* d_out, int out_size, void* d_ws, size_t ws_size, hipStream_t) {
  (void)in_sizes; (void)n_in; (void)out_size;
  if (ws_size < WS_END) { printf("ws too small %zu < %zu\n", ws_size, (size_t)WS_END); return; }
  Params p{}; for (int i = 0; i < N_IN; ++i) p.in[i] = (const float*)d_in[i];
  p.out = (float*)d_out; p.ws = (unsigned char*)d_ws;
  unsigned char* ws = p.ws;
  bf16_t* HB = (bf16_t*)(ws + WS_HB); bf16_t* P = (bf16_t*)(ws + WS_R1); bf16_t* LFB = (bf16_t*)(ws + WS_LFB);
  bf16_t* O = (bf16_t*)(ws + WS_R2); float* yf = (float*)(ws + WS_R2); bf16_t* Y = (bf16_t*)(ws + WS_R2); bf16_t* H = (bf16_t*)(ws + WS_H);
  float* side = (float*)(ws + WS_SIDE); float* oside = (float*)(ws + WS_OSIDE); float* rope = (float*)(ws + WS_ROPE); float* lb = (float*)(ws + WS_LB);
  int* assign = (int*)(ws + WS_ASSIGN); float* gate = (float*)(ws + WS_GATE);
  for (size_t i = 0; i < (size_t)NTOK * 1024; ++i) HB[i] = f2bf(p.in[I_X][i]);
  for (int i = 0; i < SEQ * 32; ++i) { int t = i >> 5, f = i & 31; float freq = powf(10000.0f, -(float)f / 32.0f); float ang = (float)t * freq; rope[i * 2] = cosf(ang); rope[i * 2 + 1] = sinf(ang); }
  for (int cc = 0; cc < 512; ++cc) { const float* hl = p.in[I_HGRN_LB]; float a0 = hl[cc], a1 = hl[512 + cc], a2 = hl[1024 + cc]; float mx = fmaxf(a0, fmaxf(a1, a2));
    float e0 = expf(a0 - mx), e1 = expf(a1 - mx), e2 = expf(a2 - mx); lb[cc] = e0 / (e0 + e1 + e2); }
  std::vector<float> wr;
  for (int layer = 0; layer < 2; ++layer) {
    const int PW = layer == 0 ? P_AB : P_CD, PM = layer == 0 ? PM_AB : PM_CD;
    const float* bias = p.in[layer == 0 ? I_AB_B_IN : I_CD_B_IN];
    cpu_round_w(p.in[layer == 0 ? I_AB_W_IN : I_CD_W_IN], (size_t)1024 * PW, wr);
#pragma omp parallel for
    for (long tok = 0; tok < NTOK; ++tok) {
      std::vector<float> acc(PW, 0.f);
      for (int k = 0; k < 1024; ++k) { float a = bf2f(HB[tok * 1024 + k]); const float* w = &wr[(size_t)k * PW]; for (int n = 0; n < PW; ++n) acc[n] += a * w[n]; }
      for (int n = 0; n < PM; ++n) { float v = acc[n] + bias[n]; if (layer == 0) v = epi_ab(n, v, lb); P[tok * PSTRIDE + n] = f2bf(v); }
      for (int n = PM; n < PW; ++n) side[tok * 32 + (n - PM)] = acc[n] + bias[n];
      if (layer == 0) for (int dir = 0; dir < 2; ++dir) for (int cc = 0; cc < 256; ++cc) {
        float z = p.in[I_GK_B][dir * 256 + cc];
        for (int r = 0; r < 16; ++r) z += side[tok * 32 + dir * 16 + r] * p.in[I_GK_UP][(dir * 16 + r) * 256 + cc];
        LFB[tok * 512 + dir * 256 + cc] = f2bf(logsigmoidf_(z) * 0.0625f); }
    }
    if (layer == 0) { ScanAB2 s{}; s.P = P; s.LFB = LFB; s.O = O; run_functor(s, (long)BATCH * 2048); }
    else { PrepCD2 pc{}; pc.P = P; pc.QD = LFB; pc.rope = rope; pc.conv_w = p.in[I_CONV_W]; pc.conv_b = p.in[I_CONV_B]; run_functor(pc, (long)NTOK * 1280);
      ScanCD2 s{}; s.P = P; s.QD = LFB; s.side = side; s.fgate_b = p.in[I_FGATE_B]; s.O = O; s.oside = oside; run_functor(s, (long)BATCH * 2056); }
#pragma omp parallel for
    for (long tok = 0; tok < NTOK; ++tok) for (int h8 = 0; h8 < 8; ++h8) {
      float sf = 1.f, sb = 1.f;
      if (layer == 1 && h8 >= 4) { int h = h8 - 4; const float* s0 = oside + tok * 8 + h * 2; const float* s1 = oside + (size_t)(NTOK + tok) * 8 + h * 2;
        sf = 1.0f / fmaxf(fabsf(s0[0]), expf(-s0[1])); sb = 1.0f / fmaxf(fabsf(s1[0]), expf(-s1[1])); }
      float o[128]; float ss = 0.f;
      for (int j = 0; j < 128; ++j) { int c = h8 * 128 + j; o[j] = bf2f(O[tok * 1024 + c]) * sf + bf2f(O[(size_t)(NTOK + tok) * 1024 + c]) * sb; ss += o[j] * o[j]; }
      float r = 1.0f / sqrtf(ss * (1.0f / 128.0f) + NORM_EPS_F);
      for (int j = 0; j < 128; ++j) { int c = h8 * 128 + j; float gn, gt;
        if (layer == 0) { gn = h8 < 4 ? p.in[I_HGRN_NORM][c] : p.in[I_GLA_NORM][c - 512]; gt = siluf_(bf2f(P[tok * PSTRIDE + (h8 < 4 ? 2048 + c : 3584 + c - 512)])); }
        else { gn = h8 < 4 ? p.in[I_RET_NORM][c] : p.in[I_MLSTM_NORM][c - 512]; float gr = bf2f(P[tok * PSTRIDE + (h8 < 4 ? 1024 + c : 3072 + c - 512)]); gt = h8 < 4 ? siluf_(gr) : sigmoidf_(gr); }
        HB[tok * 1024 + c] = f2bf(o[j] * r * gn * gt); }
    }
    cpu_round_w(p.in[layer == 0 ? I_AB_W_OUT : I_CD_W_OUT], (size_t)1024 * 1024, wr);
#pragma omp parallel for
    for (long tok = 0; tok < NTOK; ++tok) { std::vector<float> acc(1024, 0.f);
      for (int k = 0; k < 1024; ++k) { float a = bf2f(HB[tok * 1024 + k]); const float* w = &wr[(size_t)k * 1024]; for (int n = 0; n < 1024; ++n) acc[n] += a * w[n]; }
      for (int n = 0; n < 1024; ++n) yf[tok * 1024 + n] = acc[n]; }
    dbg_cmp(layer == 0 ? "y_mix0" : "y_mix1", yf, (long)NTOK * 1024);
    int cnt[NEXP] = {0}; std::vector<int> list((size_t)NEXP * NTOK);
    const float* hin = layer == 0 ? p.in[I_X] : p.out;
    for (long tok = 0; tok < NTOK; ++tok) {
      float v[1024]; double s = 0; for (int c = 0; c < 1024; ++c) { v[c] = ALPHA_F * hin[tok * 1024 + c] + yf[tok * 1024 + c]; s += v[c]; }
      float mean = (float)(s / 1024); double q = 0; for (int c = 0; c < 1024; ++c) { v[c] -= mean; q += (double)v[c] * v[c]; }
      float r = 1.0f / sqrtf((float)(q / 1024) + LN_EPS_F);
      float lg[16] = {0};
      for (int c = 0; c < 1024; ++c) { v[c] = v[c] * r * p.in[I_LN_MIX_G][layer * 1024 + c] + p.in[I_LN_MIX_B][layer * 1024 + c]; p.out[tok * 1024 + c] = v[c]; HB[tok * 1024 + c] = f2bf(v[c]);
        for (int e = 0; e < 16; ++e) lg[e] += v[c] * p.in[I_ROUTER_W][c * 16 + e]; }
      int eo[2]; float go[2]; route_from_logits(lg, p.in[I_ROUTER_B], eo, go);
      int r1 = cnt[eo[0]]++, r2 = cnt[eo[1]]++;
      list[(size_t)eo[0] * NTOK + r1] = (int)tok; list[(size_t)eo[1] * NTOK + r2] = (int)tok;
      assign[tok * 4] = eo[0]; assign[tok * 4 + 1] = r1; assign[tok * 4 + 2] = eo[1]; assign[tok * 4 + 3] = r2; gate[tok * 2] = go[0]; gate[tok * 2 + 1] = go[1];
    }
    dbg_cmp(layer == 0 ? "h_mix0" : "h_mix1", p.out, (long)NTOK * 1024);
    int pad[NEXP]; { int a = 0; for (int e = 0; e < NEXP; ++e) { pad[e] = a; a += ((cnt[e] + 255) >> 8) << 8; } }
    const size_t lo = (size_t)layer * NEXP * 1024 * 1024;
    for (int e = 0; e < NEXP; ++e) {
      std::vector<float> w1, w3, w2; cpu_round_w(p.in[I_MOE_W1] + lo + (size_t)e * 1048576, 1048576, w1); cpu_round_w(p.in[I_MOE_W3] + lo + (size_t)e * 1048576, 1048576, w3); cpu_round_w(p.in[I_MOE_W2] + lo + (size_t)e * 1048576, 1048576, w2);
#pragma omp parallel for
      for (int rr = 0; rr < cnt[e]; ++rr) { int tok = list[(size_t)e * NTOK + rr]; size_t pos = pad[e] + rr;
        std::vector<float> a1(1024, 0.f), a3(1024, 0.f), a2(1024, 0.f);
        for (int k = 0; k < 1024; ++k) { float a = bf2f(HB[(size_t)tok * 1024 + k]); const float* p1 = &w1[(size_t)k * 1024]; const float* p3 = &w3[(size_t)k * 1024]; for (int n = 0; n < 1024; ++n) { a1[n] += a * p1[n]; a3[n] += a * p3[n]; } }
        for (int n = 0; n < 1024; ++n) H[pos * 1024 + n] = f2bf(siluf_(a1[n]) * a3[n]);
        for (int k = 0; k < 1024; ++k) { float a = bf2f(H[pos * 1024 + k]); const float* p2 = &w2[(size_t)k * 1024]; for (int n = 0; n < 1024; ++n) a2[n] += a * p2[n]; }
        for (int n = 0; n < 1024; ++n) Y[pos * 1024 + n] = f2bf(a2[n]); }
    }
    for (long tok = 0; tok < NTOK; ++tok) {
      size_t p0 = pad[assign[tok * 4]] + assign[tok * 4 + 1], p1 = pad[assign[tok * 4 + 2]] + assign[tok * 4 + 3];
      float v[1024]; double s = 0; for (int c = 0; c < 1024; ++c) { v[c] = ALPHA_F * p.out[tok * 1024 + c] + gate[tok * 2] * bf2f(Y[p0 * 1024 + c]) + gate[tok * 2 + 1] * bf2f(Y[p1 * 1024 + c]); s += v[c]; }
      float mean = (float)(s / 1024); double q = 0; for (int c = 0; c < 1024; ++c) { v[c] -= mean; q += (double)v[c] * v[c]; }
      float r = 1.0f / sqrtf((float)(q / 1024) + LN_EPS_F);
      for (int c = 0; c < 1024; ++c) { v[c] = v[c] * r * p.in[I_LN_FFN_G][layer * 1024 + c] + p.in[I_LN_FFN_B][layer * 1024 + c]; p.out[tok * 1024 + c] = v[c]; HB[tok * 1024 + c] = f2bf(v[c]); }
    }
    dbg_cmp(layer == 0 ? "h_ffn0" : "h_ffn1", p.out, (long)NTOK * 1024);
  }
}
#endif
```

```cpp
#ifdef CPU_EMU
#include <cmath>
#include <cstdio>
#include <cstring>
#include <cstdlib>
#include <cstddef>
#define DEV
#define DEV_INLINE static inline
typedef void* hipStream_t;
#else
#include <hip/hip_runtime.h>
#include <hip/hip_bf16.h>
#include <cstdio>
#define DEV __device__ __forceinline__
#define DEV_INLINE __device__ __forceinline__
#endif
#ifndef PROBE_DUP
#define PROBE_DUP 0
#endif
#ifndef BATCH
#define BATCH 4
#endif
#ifndef SEQ
#define SEQ 8192
#endif
#define DM 1024
#define NTOK (BATCH * SEQ)
#define P_AB 4128
#define P_CD 3600
#define PM_AB 4096
#define PM_CD 3584
#define NEXP 16
#define ALPHA_F 1.4142135623730951f
#define LN_EPS_F 1e-5f
#define NORM_EPS_F 1e-6f
#define HROWS (2 * NTOK + NEXP * 256)

typedef unsigned short bf16_t;

DEV_INLINE float bf2f(bf16_t b) { unsigned u = ((unsigned)b) << 16; float f; memcpy(&f, &u, 4); return f; }
DEV_INLINE bf16_t f2bf(float f) { unsigned u; memcpy(&u, &f, 4); u += 0x7FFFu + ((u >> 16) & 1u); return (bf16_t)(u >> 16); }
DEV_INLINE float sigmoidf_(float x) { return 1.0f / (1.0f + expf(-x)); }
DEV_INLINE float siluf_(float x) { return x / (1.0f + expf(-x)); }
DEV_INLINE float logsigmoidf_(float x) { return fminf(x, 0.0f) - log1pf(expf(-fabsf(x))); }

#define AL256(x) (((size_t)(x) + 255) & ~(size_t)255)
#define WS_CTL    ((size_t)0)
#define WS_HB     ((size_t)65536)
#define WS_R1     (WS_HB + (size_t)NTOK * 1024 * 2)
#define R1_P_BYTES ((size_t)NTOK * 4096 * 2)
#define R1_MIN    (AL256((size_t)HROWS * 1024 * 2) + (size_t)NEXP * 3072 * 1024 * 2)
#define R1_PL     (R1_P_BYTES + (size_t)NTOK * 512 * 2)
#define R1_BYTES  (R1_PL > R1_MIN ? R1_PL : R1_MIN)
#define WS_LFB    (WS_R1 + R1_P_BYTES)
#define WS_H      (WS_R1)
#define WS_WMOE   (WS_R1 + AL256((size_t)HROWS * 1024 * 2))
#define WMOE_BYTES ((size_t)NEXP * 3072 * 1024 * 2)
#define WS_R2     (WS_R1 + R1_BYTES)
#define R2_BYTES  ((size_t)HROWS * 1024 * 2 > (size_t)NTOK * 1024 * 4 ? (size_t)HROWS * 1024 * 2 : (size_t)NTOK * 1024 * 4)
#define WS_SIDE   (WS_R2 + AL256(R2_BYTES))
#define WS_OSIDE  (WS_SIDE + (size_t)NTOK * 32 * 4)
#define WS_WIN_AB (WS_OSIDE + (size_t)2 * NTOK * 8 * 4)
#define WS_WIN_CD (WS_WIN_AB + (size_t)4128 * 1024 * 2)
#define WS_WOUT_AB (WS_WIN_CD + (size_t)3600 * 1024 * 2)
#define WS_WOUT_CD (WS_WOUT_AB + (size_t)1024 * 1024 * 2)
#define WS_ROPE   (WS_WOUT_CD + (size_t)1024 * 1024 * 2)
#define WS_LB     (WS_ROPE + (size_t)SEQ * 64 * 4)
#define WS_LIST   (WS_LB + 4096)
#define WS_ASSIGN (WS_LIST + (size_t)2 * NEXP * NTOK * 4)
#define WS_GATE   (WS_ASSIGN + (size_t)NTOK * 16)
#define WS_END    (WS_GATE + (size_t)NTOK * 8)
#define CW_CNT(layer) (64 + 256 * (layer))

#define PSTRIDE 4096
#define PIDX(tok, col) ((((size_t)((col) >> 7)) * NTOK + (size_t)(tok)) * 128 + (size_t)((col) & 127))

enum { I_X, I_AB_W_IN, I_AB_B_IN, I_HGRN_LB, I_GK_UP, I_GK_B, I_HGRN_NORM, I_GLA_NORM, I_AB_W_OUT,
       I_CD_W_IN, I_CD_B_IN, I_CONV_W, I_CONV_B, I_FGATE_B, I_RET_NORM, I_MLSTM_NORM, I_CD_W_OUT,
       I_LN_MIX_G, I_LN_MIX_B, I_LN_FFN_G, I_LN_FFN_B, I_ROUTER_W, I_ROUTER_B, I_MOE_W1, I_MOE_W3, I_MOE_W2, N_IN };

struct Params {
  const float* in[N_IN];
  float* out;
  unsigned char* ws;
};

DEV_INLINE float epi_ab(int col, float v, const float* lb) {
  if (col < 512) return siluf_(v);
  if (col < 1536) { float l = lb[(col - 512) & 511]; return logf(l + (1.0f - l) * sigmoidf_(v)); }
  if (col >= 2560 && col < 2816) return v * 0.125f;
  return v;
}

DEV_INLINE void route_from_logits(const float* lg, const float* rb, int* e_out, float* g_out) {
  float mx = lg[0];
#pragma unroll
  for (int e = 1; e < 16; ++e) mx = fmaxf(mx, lg[e]);
  float sc[16]; float sum = 0.f;
#pragma unroll
  for (int e = 0; e < 16; ++e) { sc[e] = expf(lg[e] - mx); sum += sc[e]; }
  float inv = 1.0f / sum;
  float best_gs = -1e30f; int be1 = 0, be2 = 1; float bs1 = 0.f, bs2 = 0.f;
#pragma unroll
  for (int gq = 0; gq < 4; ++gq) {
    float m1 = -1e30f, m2 = -1e30f, s1 = 0.f, s2 = 0.f; int i1 = 0, i2 = 0;
#pragma unroll
    for (int i = 0; i < 4; ++i) {
      float s = sc[gq * 4 + i] * inv; float v = s + rb[gq * 4 + i];
      if (v > m1) { m2 = m1; i2 = i1; s2 = s1; m1 = v; i1 = gq * 4 + i; s1 = s; }
      else if (v > m2) { m2 = v; i2 = gq * 4 + i; s2 = s; }
    }
    float gs = m1 + m2;
    if (gs > best_gs) { best_gs = gs; be1 = i1; be2 = i2; bs1 = s1; bs2 = s2; }
  }
  e_out[0] = be1; e_out[1] = be2; g_out[0] = bs1 / (bs1 + bs2); g_out[1] = bs2 / (bs1 + bs2);
}
struct ScanAB2 {
  const bf16_t* P; const bf16_t* LFB; bf16_t* O;
  DEV void operator()(long gid) const {
    int j = (int)(gid & 127), h = (int)((gid >> 7) & 3), dir = (int)((gid >> 9) & 1), mixer = (int)((gid >> 10) & 1), b = (int)(gid >> 11);
    bf16_t* Od = O + (size_t)dir * NTOK * 1024;
    if (mixer == 0) {
      float S[128];
#pragma unroll
      for (int d = 0; d < 128; ++d) S[d] = 0.f;
      for (int s = 0; s < SEQ; ++s) {
        size_t t = (size_t)b * SEQ + (dir ? (SEQ - 1 - s) : s);
        const bf16_t* row = P + t * PSTRIDE;
        const bf16_t* q = row + h * 128; const bf16_t* lf = row + 512 + dir * 512 + h * 128;
        float v = bf2f(row[1536 + h * 128 + j]);
        float o = 0.f;
#pragma unroll
        for (int d = 0; d < 128; ++d) { float fd = expf(bf2f(lf[d])); S[d] = fd * S[d] + (1.0f - fd) * v; o += bf2f(q[d]) * S[d]; }
        Od[t * 1024 + h * 128 + j] = f2bf(o);
      }
    } else {
      float S[64];
#pragma unroll
      for (int d = 0; d < 64; ++d) S[d] = 0.f;
      for (int s = 0; s < SEQ; ++s) {
        size_t t = (size_t)b * SEQ + (dir ? (SEQ - 1 - s) : s);
        const bf16_t* row = P + t * PSTRIDE;
        const bf16_t* q = row + 2560 + h * 64; const bf16_t* k = row + 2816 + h * 64;
        const bf16_t* lf = LFB + t * 512 + dir * 256 + h * 64;
        float v = bf2f(row[3072 + h * 128 + j]);
        float o = 0.f;
#pragma unroll
        for (int d = 0; d < 64; ++d) { S[d] = expf(bf2f(lf[d])) * S[d] + bf2f(k[d]) * v; o += bf2f(q[d]) * S[d]; }
        Od[t * 1024 + 512 + h * 128 + j] = f2bf(o);
      }
    }
  }
};

struct PrepCD2 {
  bf16_t* P; bf16_t* QD; const float* rope; const float* conv_w; const float* conv_b;
  DEV void operator()(long gid) const {
    size_t tok = (size_t)(gid / 1280); int c = (int)(gid % 1280); int t = (int)(tok % SEQ);
    bf16_t* row = P + tok * PSTRIDE;
    if (c < 256) {
      int isk = c >> 7, hh = (c >> 5) & 3, i = c & 31;
      float cs = rope[(t * 32 + i) * 2], sn = rope[(t * 32 + i) * 2 + 1];
      bf16_t* base = row + isk * 256 + hh * 64;
      float a1 = bf2f(base[i]), a2 = bf2f(base[i + 32]);
      float sc = isk ? 1.0f : 0.125f;
      base[i] = f2bf((a1 * cs - a2 * sn) * sc); base[i + 32] = f2bf((a1 * sn + a2 * cs) * sc);
    } else {
      int cc = c - 256;
      float acc = conv_b[cc] + bf2f(row[1536 + cc]) * conv_w[1024 + cc];
      if (t > 0) acc += bf2f(row[1536 + cc - PSTRIDE]) * conv_w[cc];
      if (t < SEQ - 1) acc += bf2f(row[1536 + cc + PSTRIDE]) * conv_w[2048 + cc];
      float s = siluf_(acc);
      if (cc < 512) QD[tok * 512 + cc] = f2bf(s * 0.08838834764831845f);
      else row[3584 + (cc - 512)] = f2bf(s);
    }
  }
};

struct ScanCD2 {
  const bf16_t* P; const bf16_t* QD; const float* side; const float* fgate_b; bf16_t* O; float* oside;
  DEV void operator()(long gid) const {
    int b = (int)(gid / 2056); int g = (int)(gid % 2056);
    if (g < 1024) {
      int j = g & 127, h = (g >> 7) & 3, dir = (g >> 9) & 1;
      bf16_t* Od = O + (size_t)dir * NTOK * 1024;
      float gamma = 1.0f - exp2f(-(5.0f + 2.0f * (float)h + (float)dir));
      float S[64];
#pragma unroll
      for (int d = 0; d < 64; ++d) S[d] = 0.f;
      for (int s = 0; s < SEQ; ++s) {
        size_t t = (size_t)b * SEQ + (dir ? (SEQ - 1 - s) : s);
        const bf16_t* row = P + t * PSTRIDE;
        const bf16_t* q = row + h * 64; const bf16_t* k = row + 256 + h * 64;
        float v = bf2f(row[512 + h * 128 + j]);
        float o = 0.f;
#pragma unroll
        for (int d = 0; d < 64; ++d) { S[d] = gamma * S[d] + bf2f(k[d]) * v; o += bf2f(q[d]) * S[d]; }
        Od[t * 1024 + h * 128 + j] = f2bf(o);
      }
    } else {
      g -= 1024;
      int j = g % 129, h = (g / 129) & 3, dir = g / (129 * 4);
      bf16_t* Od = O + (size_t)dir * NTOK * 1024; float* os = oside + (size_t)dir * NTOK * 8;
      float fb = fgate_b[dir * 4 + h];
      float S[128];
#pragma unroll
      for (int d = 0; d < 128; ++d) S[d] = 0.f;
      float m = 0.f;
      for (int s = 0; s < SEQ; ++s) {
        size_t t = (size_t)b * SEQ + (dir ? (SEQ - 1 - s) : s);
        const bf16_t* row = P + t * PSTRIDE;
        const bf16_t* q = QD + t * 512 + h * 128; const bf16_t* k = row + 3584 + h * 128;
        float v = (j < 128) ? bf2f(row[2560 + h * 128 + j]) : 1.0f;
        float li = side[t * 32 + dir * 8 + h];
        float lf = logsigmoidf_(side[t * 32 + dir * 8 + 4 + h] + fb);
        float mn = fmaxf(lf + m, li);
        float fs = expf(lf + m - mn), is = expf(li - mn) * v;
        m = mn;
        float o = 0.f;
#pragma unroll
        for (int d = 0; d < 128; ++d) { S[d] = fs * S[d] + is * bf2f(k[d]); o += bf2f(q[d]) * S[d]; }
        if (j < 128) Od[t * 1024 + 512 + h * 128 + j] = f2bf(o);
        else { os[t * 8 + h * 2] = o; os[t * 8 + h * 2 + 1] = m; }
      }
    }
  }
};
#ifndef CPU_EMU
namespace pg8 {
#define PG8_LAS __attribute__((address_space(3)))
typedef short bf16x8 __attribute__((ext_vector_type(8)));
typedef float f32x4 __attribute__((ext_vector_type(4)));
typedef unsigned u32x4 __attribute__((ext_vector_type(4)));
typedef unsigned u32x2 __attribute__((ext_vector_type(2)));
constexpr int BM = 256, BK = 64, HALF = 128, HTB = HALF * BK * 2, STAGE_BYTES = 8 * HTB, NXCD = 8, WGM = 8, GK = 1024;

__device__ __forceinline__ int lds_byte(int r, int c) { const int st = (r >> 4) * 2 + (c >> 5), rr = r & 15, cc = c & 31, ob = rr * 64 + cc * 2; return st * 1024 + (ob ^ (((ob >> 9) & 1) << 5)); }
__device__ __forceinline__ void stage_rc(int b, int& R, int& C) { const int st = b / 1024, sb = b % 1024, swz = sb ^ (((sb >> 9) & 1) << 5); R = (st >> 1) * 16 + swz / 64; C = (st & 1) * 32 + (swz % 64) / 2; }
__device__ __forceinline__ int perm32(int rho) { const int n = rho >> 4, i = rho & 15; return 8 * (i >> 2) + 4 * n + (i & 3); }
__device__ __forceinline__ unsigned cvt_pk_bf16(float lo, float hi) { unsigned r; asm volatile("v_cvt_pk_bf16_f32 %0, %1, %2" : "=v"(r) : "v"(lo), "v"(hi)); return r; }

struct Unit { int pm, pn, e, row0, ne; };

struct StaticOrder {
  int nM, nN, nwg, G, c;
  __device__ void init(int M, int N, int G_, int c_) { nM = M / BM; nN = N / BM; nwg = nM * nN; G = G_; c = c_; }
  __device__ bool next(int i, Unit& u) const {
    const long L = (long)i * G + c; if (L >= nwg) return false;
    int wgid = (int)L; { const int q = nwg / NXCD, r = nwg % NXCD, xcd = wgid % NXCD, off = wgid / NXCD; wgid = (xcd < r ? xcd * (q + 1) : r * (q + 1) + (xcd - r) * q) + off; }
    const int nig = WGM * nN, gid = wgid / nig, fm = gid * WGM, gsz = (nM - fm) < WGM ? (nM - fm) : WGM;
    u.pm = fm + ((wgid % nig) % gsz); u.pn = (wgid % nig) / gsz; u.e = 0; u.row0 = u.pm * BM; u.ne = 0; return true;
  }
};

template <class Prob>
__device__ __forceinline__ void gemm_phase(PG8_LAS unsigned char* lds, const Prob& S, int wv) {
  int wv_ = wv; asm volatile("" : "+s"(wv_));
  int l_; asm volatile("v_mbcnt_lo_u32_b32 %0, -1, 0\n\tv_mbcnt_hi_u32_b32 %0, -1, %0" : "=v"(l_));
  int tid_ = wv_ * 64 + l_;
  const int tid = tid_, wid = __builtin_amdgcn_readfirstlane(tid >> 6), lane = tid & 63, wr = wid >> 2, wc = wid & 3, fr = lane & 15, fq = lane >> 4;
  constexpr int K = GK, nt = K / BK;
  int sR[2], sC[2]; unsigned voffB[2];
#pragma unroll
  for (int i = 0; i < 2; ++i) { int R, C; stage_rc(tid * 16 + i * 8192, R, C); sR[i] = R; sC[i] = C; const int Rb = Prob::PERM ? ((R & ~31) + perm32(R & 31)) : R; voffB[i] = (unsigned)(Rb * K + C) * 2u; }
  const size_t kstep = (size_t)(BK * 2);
  const size_t hstep = (size_t)HALF * K * 2;
  const unsigned ldsw = (unsigned)wid * 1024u;
  const int aoff = lds_byte(wr * 64 + fr, fq * 8), boff = lds_byte(wc * 32 + fr, fq * 8);
#define PG8_SA(b, h) (((b) * 2 + (h)) * HTB)
#define PG8_SB(b, h) ((4 + (b) * 2 + (h)) * HTB)
#define PG8_STAGE(bufoff, gbase, voff) do { _Pragma("unroll") for (int _i = 0; _i < 2; ++_i) \
    __builtin_amdgcn_global_load_lds((const unsigned*)((const char*)(gbase) + (voff)[_i]), (PG8_LAS unsigned*)(lds + (bufoff) + ldsw + _i * 8192), 16, 0, 0); } while (0)
#define PG8_LDA(dst, b, h) do { _Pragma("unroll") for (int m = 0; m < 4; ++m) _Pragma("unroll") for (int k = 0; k < 2; ++k) dst[m][k] = *(const PG8_LAS bf16x8*)(lds + PG8_SA(b, h) + aoff + m * 2048 + k * 1024); } while (0)
#define PG8_LDB(dst, b, h) do { _Pragma("unroll") for (int n = 0; n < 2; ++n) _Pragma("unroll") for (int k = 0; k < 2; ++k) dst[n][k] = *(const PG8_LAS bf16x8*)(lds + PG8_SB(b, h) + boff + n * 2048 + k * 1024); } while (0)
#define PG8_MMA(ai, bj, At, Bt) do { __builtin_amdgcn_s_setprio(1); _Pragma("unroll") for (int m = 0; m < 4; ++m) _Pragma("unroll") for (int n = 0; n < 2; ++n) _Pragma("unroll") for (int k = 0; k < 2; ++k) \
    acc[ai][bj][m][n] = __builtin_amdgcn_mfma_f32_16x16x32_bf16(Bt[n][k], At[m][k], acc[ai][bj][m][n], 0, 0, 0); __builtin_amdgcn_s_setprio(0); } while (0)
#define PG8_WAIT_V(n) asm volatile("s_waitcnt vmcnt(" #n ")" ::: "memory")
#define PG8_WAIT_L(n) asm volatile("s_waitcnt lgkmcnt(" #n ")" ::: "memory")
#define PG8_BAR __builtin_amdgcn_s_barrier()
#define PG8_SCHED __builtin_amdgcn_sched_barrier(0)
  Unit cur, nxt; int ui = 0;
  if (!S.next(0, cur)) return;
  f32x4 acc[2][2][4][2];
#pragma unroll
  for (int a = 0; a < 2; ++a)
#pragma unroll
    for (int b = 0; b < 2; ++b)
#pragma unroll
      for (int m = 0; m < 4; ++m)
#pragma unroll
        for (int n = 0; n < 2; ++n) acc[a][b][m][n] = (f32x4){0.f, 0.f, 0.f, 0.f};
  bf16x8 At[4][2], B0[2][2], B1[2][2];
  unsigned oc0[2], oc1[2], on0[2], on1[2];
#pragma unroll
  for (int i = 0; i < 2; ++i) { oc0[i] = S.a_off(cur, sR[i]) + (unsigned)sC[i] * 2u; oc1[i] = S.a_off(cur, HALF + sR[i]) + (unsigned)sC[i] * 2u; }
  const char* const Ab = S.a_base();
  const char* cB = S.b_base(cur);
  PG8_STAGE(PG8_SB(0, 0), cB, voffB); PG8_STAGE(PG8_SA(0, 0), Ab, oc0); PG8_STAGE(PG8_SB(0, 1), cB + hstep, voffB); PG8_STAGE(PG8_SA(0, 1), Ab, oc1);
  if (wr == 1) PG8_BAR;
  PG8_WAIT_V(4); PG8_BAR;
  PG8_STAGE(PG8_SB(1, 0), cB + kstep, voffB); PG8_STAGE(PG8_SA(1, 0), Ab + kstep, oc0); PG8_STAGE(PG8_SB(1, 1), cB + hstep + kstep, voffB);
  PG8_WAIT_V(6); PG8_BAR;
  for (;;) {
    const bool has_next = S.next(ui + 1, nxt);
    const char* nB = cB;
    if (has_next) {
      nB = S.b_base(nxt);
      int l2_; asm volatile("v_mbcnt_lo_u32_b32 %0, -1, 0\n\tv_mbcnt_hi_u32_b32 %0, -1, %0" : "=v"(l2_));
      const int tid2 = wid * 64 + l2_;
#pragma unroll
      for (int i = 0; i < 2; ++i) { int R, C; stage_rc(tid2 * 16 + i * 8192, R, C); on0[i] = S.a_off(nxt, R) + (unsigned)C * 2u; on1[i] = S.a_off(nxt, HALF + R) + (unsigned)C * 2u; }
    } else {
#pragma unroll
      for (int i = 0; i < 2; ++i) { on0[i] = oc0[i]; on1[i] = oc1[i]; }
    }
    for (int t = 0; t < nt; t += 2) {
      const bool last = (t == nt - 2);
      const char* a1 = Ab + (size_t)(t + 1) * kstep;
      const char* a2 = last ? Ab : Ab + (size_t)(t + 2) * kstep; const char* b2 = last ? nB : cB + (size_t)(t + 2) * kstep;
      const char* a3 = a2 + kstep; const char* b3 = b2 + kstep;
      unsigned o20[2], o21[2];
#pragma unroll
      for (int i = 0; i < 2; ++i) { o20[i] = last ? on0[i] : oc0[i]; o21[i] = last ? on1[i] : oc1[i]; }
      PG8_LDB(B0, 0, 0); PG8_SCHED; PG8_LDA(At, 0, 0); PG8_STAGE(PG8_SA(1, 1), a1, oc1);
      PG8_WAIT_L(8); PG8_BAR; PG8_WAIT_L(0); PG8_MMA(0, 0, At, B0); PG8_BAR; PG8_SCHED;
      PG8_LDB(B1, 0, 1); PG8_STAGE(PG8_SB(0, 0), b2, voffB);
      PG8_BAR; PG8_WAIT_L(0); PG8_MMA(0, 1, At, B1); PG8_BAR;
      PG8_LDA(At, 0, 1); PG8_STAGE(PG8_SA(0, 0), a2, o20);
      PG8_BAR; PG8_WAIT_L(0); PG8_MMA(1, 0, At, B0); PG8_BAR; PG8_SCHED;
      PG8_STAGE(PG8_SB(0, 1), b2 + hstep, voffB);
      PG8_WAIT_V(6); PG8_BAR; PG8_MMA(1, 1, At, B1); PG8_BAR;
      PG8_LDB(B0, 1, 0); PG8_SCHED; PG8_LDA(At, 1, 0); PG8_STAGE(PG8_SA(0, 1), a2, o21);
      PG8_WAIT_L(8); PG8_BAR; PG8_WAIT_L(0); PG8_MMA(0, 0, At, B0); PG8_BAR; PG8_SCHED;
      PG8_LDB(B1, 1, 1); PG8_STAGE(PG8_SB(1, 0), b3, voffB);
      PG8_BAR; PG8_WAIT_L(0); PG8_MMA(0, 1, At, B1); PG8_BAR;
      PG8_LDA(At, 1, 1); PG8_STAGE(PG8_SA(1, 0), a3, o20);
      PG8_BAR; PG8_WAIT_L(0); PG8_MMA(1, 0, At, B0); PG8_BAR; PG8_SCHED;
      PG8_STAGE(PG8_SB(1, 1), b3 + hstep, voffB);
      PG8_WAIT_V(6); PG8_BAR; PG8_MMA(1, 1, At, B1); PG8_BAR;
    }
    { int l3_; asm volatile("v_mbcnt_lo_u32_b32 %0, -1, 0\n\tv_mbcnt_hi_u32_b32 %0, -1, %0" : "=v"(l3_));
      S.epi(acc, cur, wr, wc, l3_ & 15, l3_ >> 4); }
    if (!has_next) break;
#pragma unroll
    for (int a = 0; a < 2; ++a)
#pragma unroll
      for (int b = 0; b < 2; ++b)
#pragma unroll
        for (int m = 0; m < 4; ++m)
#pragma unroll
          for (int n = 0; n < 2; ++n) acc[a][b][m][n] = (f32x4){0.f, 0.f, 0.f, 0.f};
    cur = nxt; cB = nB; ++ui;
#pragma unroll
    for (int i = 0; i < 2; ++i) { oc0[i] = on0[i]; oc1[i] = on1[i]; }
  }
  PG8_WAIT_V(0);
  if (wr == 0) PG8_BAR;
  PG8_BAR;
#undef PG8_SA
#undef PG8_SB
#undef PG8_STAGE
#undef PG8_LDA
#undef PG8_LDB
#undef PG8_MMA
#undef PG8_WAIT_V
#undef PG8_WAIT_L
#undef PG8_BAR
#undef PG8_SCHED
}
}
#endif
#ifndef CPU_EMU
#include <hip/hip_cooperative_groups.h>
namespace cg = cooperative_groups;
#define LAS __attribute__((address_space(3)))
#define NTHREADS 512
#define LDS_BYTES (146 * 1024)
typedef float f32x4 __attribute__((ext_vector_type(4)));
typedef short bf16x8 __attribute__((ext_vector_type(8)));
typedef unsigned u32x4 __attribute__((ext_vector_type(4)));
typedef unsigned u32x2 __attribute__((ext_vector_type(2)));

struct Ctx { int tid, lane, wid, G, bid; unsigned char* lds; };
__device__ __forceinline__ int lane_id() { int l; asm volatile("v_mbcnt_lo_u32_b32 %0, -1, 0\n\tv_mbcnt_hi_u32_b32 %0, -1, %0" : "=v"(l)); return l; }
__device__ __forceinline__ int opaque_tid(int wv) { int w = wv; asm volatile("" : "+s"(w)); int t = w * 64 + lane_id(); asm volatile("" : "+v"(t)); return t; }
__device__ __forceinline__ Ctx make_ctx(unsigned char* lds, int wv) { Ctx c; c.tid = opaque_tid(wv); c.lane = c.tid & 63; c.wid = __builtin_amdgcn_readfirstlane(c.tid >> 6); c.G = gridDim.x; c.bid = blockIdx.x; c.lds = lds; return c; }

__device__ __forceinline__ float wave_sum(float x) {
  x += __builtin_bit_cast(float, __builtin_amdgcn_update_dpp(0, __builtin_bit_cast(int, x), 0x111, 0xf, 0xf, false));
  x += __builtin_bit_cast(float, __builtin_amdgcn_update_dpp(0, __builtin_bit_cast(int, x), 0x112, 0xf, 0xf, false));
  x += __builtin_bit_cast(float, __builtin_amdgcn_update_dpp(0, __builtin_bit_cast(int, x), 0x114, 0xf, 0xf, false));
  x += __builtin_bit_cast(float, __builtin_amdgcn_update_dpp(0, __builtin_bit_cast(int, x), 0x118, 0xf, 0xf, false));
  x += __builtin_bit_cast(float, __builtin_amdgcn_update_dpp(0, __builtin_bit_cast(int, x), 0x142, 0xa, 0xf, false));
  x += __builtin_bit_cast(float, __builtin_amdgcn_update_dpp(0, __builtin_bit_cast(int, x), 0x143, 0xc, 0xf, false));
  return __builtin_bit_cast(float, __builtin_amdgcn_readlane(__builtin_bit_cast(int, x), 63));
}
__device__ __forceinline__ float fsigmoid(float x) { return __builtin_amdgcn_rcpf(1.0f + __builtin_amdgcn_exp2f(-1.4426950408889634f * x)); }
__device__ __forceinline__ float fsilu(float x) { return x * fsigmoid(x); }
typedef float f32x2_t __attribute__((ext_vector_type(2)));
typedef __bf16 bf16x2_t __attribute__((ext_vector_type(2)));
__device__ __forceinline__ unsigned pk_hw(float a, float b) { const f32x2_t v = {a, b}; return __builtin_bit_cast(unsigned, __builtin_convertvector(v, bf16x2_t)); }
__device__ __forceinline__ unsigned pk2(float a, float b) { return pk_hw(a, b); }
__device__ __forceinline__ void unpack8(u32x4 w, float* f) {
  f[0] = __uint_as_float(w.x << 16); f[1] = __uint_as_float(w.x & 0xffff0000u); f[2] = __uint_as_float(w.y << 16); f[3] = __uint_as_float(w.y & 0xffff0000u);
  f[4] = __uint_as_float(w.z << 16); f[5] = __uint_as_float(w.z & 0xffff0000u); f[6] = __uint_as_float(w.w << 16); f[7] = __uint_as_float(w.w & 0xffff0000u);
}

__device__ __forceinline__ void transpose_job(const Ctx& c, const float* src, int N, bf16_t* dst, int rs, int ro, int tile0, int tile_stride) {
  float* t = (float*)c.lds;
  const int ntn = (N + 63) / 64, ntiles = ntn * 16;
  for (int tl = tile0; tl < ntiles; tl += tile_stride) {
    const int kt = tl / ntn, nt_ = tl % ntn, k0 = kt * 64, n0 = nt_ * 64;
    __syncthreads();
#pragma unroll
    for (int i = 0; i < 8; ++i) { const int idx = c.tid + i * 512, kk = idx >> 6, nn = idx & 63; t[kk * 65 + nn] = (n0 + nn < N) ? src[(size_t)(k0 + kk) * N + n0 + nn] : 0.f; }
    __syncthreads();
#pragma unroll
    for (int i = 0; i < 4; ++i) { const int idx = c.tid + i * 512, nn = idx >> 5, kp = (idx & 31) * 2;
      if (n0 + nn < N) *(unsigned*)(dst + (size_t)((n0 + nn) * rs + ro) * 1024 + k0 + kp) = pk2(t[kp * 65 + nn], t[(kp + 1) * 65 + nn]); }
  }
  __syncthreads();
}
__device__ __forceinline__ void p0_prologue(unsigned char* lds_, int wv, const Params& p) {
  const Ctx c = make_ctx(lds_, wv);
  unsigned char* ws = p.ws;
  if (c.bid == 0) { ((unsigned*)(ws + WS_CTL))[64 + c.tid] = 0u; }
  if (c.bid == 0 && c.tid == 0) ((unsigned*)(ws + WS_CTL))[1024] = 0u;
  { const float* x = p.in[I_X]; bf16_t* hb = (bf16_t*)(ws + WS_HB);
    for (size_t i = (size_t)c.bid * NTHREADS + c.tid; i < (size_t)NTOK * 1024 / 8; i += (size_t)c.G * NTHREADS) {
      const f32x4 a = *(const f32x4*)(x + i * 8), b = *(const f32x4*)(x + i * 8 + 4);
      u32x4 w; w.x = pk2(a[0], a[1]); w.y = pk2(a[2], a[3]); w.z = pk2(b[0], b[1]); w.w = pk2(b[2], b[3]);
      *(u32x4*)(hb + i * 8) = w; } }
  transpose_job(c, p.in[I_AB_W_IN], P_AB, (bf16_t*)(ws + WS_WIN_AB), 1, 0, c.bid, c.G);
  transpose_job(c, p.in[I_CD_W_IN], P_CD, (bf16_t*)(ws + WS_WIN_CD), 1, 0, c.bid, c.G);
  transpose_job(c, p.in[I_AB_W_OUT], 1024, (bf16_t*)(ws + WS_WOUT_AB), 1, 0, c.bid, c.G);
  transpose_job(c, p.in[I_CD_W_OUT], 1024, (bf16_t*)(ws + WS_WOUT_CD), 1, 0, c.bid, c.G);
  { float* rope = (float*)(ws + WS_ROPE);
    for (int i = c.bid * NTHREADS + c.tid; i < SEQ * 32; i += c.G * NTHREADS) { const int t = i >> 5, f = i & 31;
      const float freq = powf(10000.0f, -(float)f / 32.0f); const float ang = (float)t * freq; rope[i * 2] = cosf(ang); rope[i * 2 + 1] = sinf(ang); }
    if (c.bid == 1) { const float* hl = p.in[I_HGRN_LB]; float* lb = (float*)(ws + WS_LB);
      const int cc = c.tid; const float a0 = hl[cc], a1 = hl[512 + cc], a2 = hl[1024 + cc]; const float mx = fmaxf(a0, fmaxf(a1, a2));
      const float e0 = expf(a0 - mx), e1 = expf(a1 - mx), e2 = expf(a2 - mx); lb[cc] = e0 / (e0 + e1 + e2); } }
}
__device__ __forceinline__ void moe_weight_convert(unsigned char* lds_, int wv, const Params& p, int layer) {
  const Ctx c = make_ctx(lds_, wv);
  bf16_t* w13 = (bf16_t*)(p.ws + WS_WMOE); bf16_t* w2 = w13 + (size_t)NEXP * 2048 * 1024;
  const size_t lo = (size_t)layer * NEXP * 1024 * 1024;
  for (int e = 0; e < NEXP; ++e) {
    const size_t mo = lo + (size_t)e * 1024 * 1024;
    transpose_job(c, p.in[I_MOE_W1] + mo, 1024, w13 + (size_t)e * 2048 * 1024, 2, 0, c.bid, c.G);
    transpose_job(c, p.in[I_MOE_W3] + mo, 1024, w13 + (size_t)e * 2048 * 1024, 2, 1, c.bid, c.G);
    transpose_job(c, p.in[I_MOE_W2] + mo, 1024, w2 + (size_t)e * 1024 * 1024, 1, 0, c.bid, c.G);
  }
}

struct ProbInProj {
  static constexpr bool PERM = true;
  pg8::StaticOrder so; const char* A; const char* Bt; bf16_t* P; const float* bias; const float* lb; int layer;
  __device__ __forceinline__ bool next(int i, pg8::Unit& u) const { return so.next(i, u); }
  __device__ __forceinline__ const char* a_base() const { return A; }
  __device__ __forceinline__ unsigned a_off(const pg8::Unit& u, int r) const { return (unsigned)(u.pm * 256 + r) * 2048u; }
  __device__ __forceinline__ const char* b_base(const pg8::Unit& u) const { return Bt + (size_t)u.pn * 256 * 2048; }
  __device__ __forceinline__ void epi(const f32x4 (&acc)[2][2][4][2], const pg8::Unit& u, int wr, int wc, int fr, int fq) const {
    const int row0 = u.row0 + wr * 64 + fr, colb = u.pn * 256 + wc * 32 + 8 * fq;
    int mode = 0;
    if (layer == 0) { mode = u.pn < 2 ? 1 : (u.pn < 6 ? 2 : (u.pn == 10 ? 3 : 0)); }
#pragma unroll
    for (int bj = 0; bj < 2; ++bj) {
      const int col0 = colb + bj * 128;
      const f32x4 b0 = *(const f32x4*)(bias + col0), b1 = *(const f32x4*)(bias + col0 + 4);
      f32x4 l0 = (f32x4){0.f, 0.f, 0.f, 0.f}, l1 = l0;
      if (mode == 2) { l0 = *(const f32x4*)(lb + ((col0 - 512) & 511)); l1 = *(const f32x4*)(lb + ((col0 - 512) & 511) + 4); }
#pragma unroll
      for (int ai = 0; ai < 2; ++ai)
#pragma unroll
        for (int m = 0; m < 4; ++m) {
          f32x4 v0 = acc[ai][bj][m][0] + b0, v1 = acc[ai][bj][m][1] + b1;
          if (mode == 1) {
#pragma unroll
            for (int j = 0; j < 4; ++j) { v0[j] = fsilu(v0[j]); v1[j] = fsilu(v1[j]); }
          } else if (mode == 2) {
#pragma unroll
            for (int j = 0; j < 4; ++j) { v0[j] = __builtin_amdgcn_logf(l0[j] + (1.0f - l0[j]) * fsigmoid(v0[j])); v1[j] = __builtin_amdgcn_logf(l1[j] + (1.0f - l1[j]) * fsigmoid(v1[j])); }
          } else if (mode == 3) { v0 *= 0.125f; v1 *= 0.125f; }
          u32x4 w; w.x = pk2(v0[0], v0[1]); w.y = pk2(v0[2], v0[3]); w.z = pk2(v1[0], v1[1]); w.w = pk2(v1[2], v1[3]);
          *(u32x4*)(P + PIDX(row0 + ai * 128 + m * 16, col0)) = w;
        }
    }
  }
};
struct ProbOutProj {
  static constexpr bool PERM = false;
  pg8::StaticOrder so; const char* A; const char* Bt; float* Y;
  __device__ __forceinline__ bool next(int i, pg8::Unit& u) const { return so.next(i, u); }
  __device__ __forceinline__ const char* a_base() const { return A; }
  __device__ __forceinline__ unsigned a_off(const pg8::Unit& u, int r) const { return (unsigned)(u.pm * 256 + r) * 2048u; }
  __device__ __forceinline__ const char* b_base(const pg8::Unit& u) const { return Bt + (size_t)u.pn * 256 * 2048; }
  __device__ __forceinline__ void epi(const f32x4 (&acc)[2][2][4][2], const pg8::Unit& u, int wr, int wc, int fr, int fq) const {
    const int row0 = u.row0 + wr * 64 + fr, col0 = u.pn * 256 + wc * 32 + 4 * fq;
#pragma unroll
    for (int ai = 0; ai < 2; ++ai)
#pragma unroll
      for (int m = 0; m < 4; ++m) { float* rowp = Y + (size_t)(row0 + ai * 128 + m * 16) * 1024 + col0;
#pragma unroll
        for (int bj = 0; bj < 2; ++bj)
#pragma unroll
          for (int n = 0; n < 2; ++n) *(f32x4*)(rowp + bj * 128 + n * 16) = acc[ai][bj][m][n]; }
  }
};
#define MOE_TAB_OFF (128 * 1024)
struct MoeOrder {
  const int* tab;
  __device__ __forceinline__ void init(const int* cnt, int ntn, int G, int c, unsigned char* lds, int wv) {
    int* t = (int*)(lds + MOE_TAB_OFF);
    const int tid = opaque_tid(wv);
    if (tid < 64) {
      int L = tid * G + c, pad = 0, found = 0, ue = 0, upn = 0, upm = 0, urow = 0, une = 0;
      for (int e = 0; e < NEXP; ++e) { const int n = cnt[e * 16], mt = (n + 255) >> 8, tiles = mt * ntn;
        if (!found && L < tiles) { ue = e; upn = L / mt; upm = L % mt; urow = pad + upm * 256; une = n; found = 1; }
        if (!found) { L -= tiles; pad += mt * 256; } }
      t[tid * 8 + 0] = found; t[tid * 8 + 1] = ue; t[tid * 8 + 2] = upn; t[tid * 8 + 3] = upm; t[tid * 8 + 4] = urow; t[tid * 8 + 5] = une;
    }
    __syncthreads();
    tab = t;
  }
  __device__ __forceinline__ bool next(int i, pg8::Unit& u) const {
    if (i >= 64) return false;
    const int* t = tab + i * 8;
    if (!__builtin_amdgcn_readfirstlane(t[0])) return false;
    u.e = __builtin_amdgcn_readfirstlane(t[1]); u.pn = __builtin_amdgcn_readfirstlane(t[2]); u.pm = __builtin_amdgcn_readfirstlane(t[3]);
    u.row0 = __builtin_amdgcn_readfirstlane(t[4]); u.ne = __builtin_amdgcn_readfirstlane(t[5]); return true;
  }
};
struct ProbMoe1 {
  static constexpr bool PERM = true;
  MoeOrder mo; const char* A; const char* W13; const int* list; bf16_t* H;
  __device__ __forceinline__ bool next(int i, pg8::Unit& u) const { return mo.next(i, u); }
  __device__ __forceinline__ const char* a_base() const { return A; }
  __device__ __forceinline__ unsigned a_off(const pg8::Unit& u, int r) const { const int rr = u.pm * 256 + r; const int tok = rr < u.ne ? list[u.e * NTOK + rr] : 0; return (unsigned)tok * 2048u; }
  __device__ __forceinline__ const char* b_base(const pg8::Unit& u) const { return W13 + ((size_t)u.e * 2048 + (size_t)u.pn * 256) * 2048; }
  __device__ __forceinline__ void epi(const f32x4 (&acc)[2][2][4][2], const pg8::Unit& u, int wr, int wc, int fr, int fq) const {
    const int row0 = u.row0 + wr * 64 + fr, colb = u.pn * 128 + wc * 16 + 4 * fq;
#pragma unroll
    for (int ai = 0; ai < 2; ++ai)
#pragma unroll
      for (int m = 0; m < 4; ++m)
#pragma unroll
        for (int bj = 0; bj < 2; ++bj) {
          const f32x4 v0 = acc[ai][bj][m][0], v1 = acc[ai][bj][m][1];
          u32x2 w; w.x = pk2(fsilu(v0[0]) * v0[1], fsilu(v0[2]) * v0[3]); w.y = pk2(fsilu(v1[0]) * v1[1], fsilu(v1[2]) * v1[3]);
          *(u32x2*)(H + (size_t)(row0 + ai * 128 + m * 16) * 1024 + colb + bj * 64) = w;
        }
  }
};
struct ProbMoe2 {
  static constexpr bool PERM = true;
  MoeOrder mo; const char* A; const char* W2; bf16_t* Y;
  __device__ __forceinline__ bool next(int i, pg8::Unit& u) const { return mo.next(i, u); }
  __device__ __forceinline__ const char* a_base() const { return A; }
  __device__ __forceinline__ unsigned a_off(const pg8::Unit& u, int r) const { return (unsigned)(u.row0 + r) * 2048u; }
  __device__ __forceinline__ const char* b_base(const pg8::Unit& u) const { return W2 + ((size_t)u.e * 1024 + (size_t)u.pn * 256) * 2048; }
  __device__ __forceinline__ void epi(const f32x4 (&acc)[2][2][4][2], const pg8::Unit& u, int wr, int wc, int fr, int fq) const {
    const int row0 = u.row0 + wr * 64 + fr, colb = u.pn * 256 + wc * 32 + 8 * fq;
#pragma unroll
    for (int ai = 0; ai < 2; ++ai)
#pragma unroll
      for (int m = 0; m < 4; ++m)
#pragma unroll
        for (int bj = 0; bj < 2; ++bj) {
          const f32x4 v0 = acc[ai][bj][m][0], v1 = acc[ai][bj][m][1];
          u32x4 w; w.x = pk2(v0[0], v0[1]); w.y = pk2(v0[2], v0[3]); w.z = pk2(v1[0], v1[1]); w.w = pk2(v1[2], v1[3]);
          *(u32x4*)(Y + (size_t)(row0 + ai * 128 + m * 16) * 1024 + colb + bj * 128) = w;
        }
  }
};

template <int NS>
__device__ __forceinline__ void side_phase(unsigned char* lds_, int wv, const Params& p, int layer) {
  const Ctx c = make_ctx(lds_, wv);
  const bf16_t* hb = (const bf16_t*)(p.ws + WS_HB);
  const bf16_t* wt = (const bf16_t*)(p.ws + (layer == 0 ? WS_WIN_AB : WS_WIN_CD)) + (size_t)(layer == 0 ? PM_AB : PM_CD) * 1024;
  const float* bias = p.in[layer == 0 ? I_AB_B_IN : I_CD_B_IN] + (layer == 0 ? PM_AB : PM_CD);
  float* side = (float*)(p.ws + WS_SIDE);
  float* tl = (float*)c.lds + c.wid * (16 * 33);
  const int fr = c.lane & 15, fq = c.lane >> 4;
  for (int g = c.bid * 8 + c.wid; g < NTOK / 16; g += c.G * 8) {
    const int r0 = g * 16;
    f32x4 acc0 = (f32x4){0.f, 0.f, 0.f, 0.f}, acc1 = acc0;
    const bf16_t* ap = hb + (size_t)(r0 + fr) * 1024 + fq * 8;
    const bf16_t* bp0 = wt + (size_t)fr * 1024 + fq * 8; const bf16_t* bp1 = bp0 + 16 * 1024;
#pragma unroll 4
    for (int k = 0; k < 1024; k += 32) {
      const bf16x8 a = *(const bf16x8*)(ap + k), b0 = *(const bf16x8*)(bp0 + k);
      acc0 = __builtin_amdgcn_mfma_f32_16x16x32_bf16(a, b0, acc0, 0, 0, 0);
      if (NS == 32) { const bf16x8 b1 = *(const bf16x8*)(bp1 + k); acc1 = __builtin_amdgcn_mfma_f32_16x16x32_bf16(a, b1, acc1, 0, 0, 0); }
    }
#pragma unroll
    for (int j = 0; j < 4; ++j) { const float v0 = acc0[j] + bias[fr]; side[(size_t)(r0 + fq * 4 + j) * 32 + fr] = v0; tl[(fq * 4 + j) * 33 + fr] = v0;
      if (NS == 32) { const float v1 = acc1[j] + bias[16 + fr]; side[(size_t)(r0 + fq * 4 + j) * 32 + 16 + fr] = v1; tl[(fq * 4 + j) * 33 + 16 + fr] = v1; } }
    if (NS == 32) {
      __builtin_amdgcn_s_waitcnt(0xC07F);
      const float* gu = p.in[I_GK_UP]; const float* gb = p.in[I_GK_B]; bf16_t* lfb = (bf16_t*)(p.ws + WS_LFB);
      const int cb = c.lane * 8, dir = cb >> 8, cc = cb & 255;
      float w[16][8];
#pragma unroll
      for (int r = 0; r < 16; ++r)
#pragma unroll
        for (int j = 0; j < 8; ++j) w[r][j] = gu[(dir * 16 + r) * 256 + cc + j];
      float bb[8];
#pragma unroll
      for (int j = 0; j < 8; ++j) bb[j] = gb[dir * 256 + cc + j];
      constexpr float LFS = 0.0625f * 1.4426950408889634f;
      for (int row = 0; row < 16; ++row) {
        float z[8];
#pragma unroll
        for (int j = 0; j < 8; ++j) z[j] = bb[j];
#pragma unroll
        for (int r = 0; r < 16; ++r) { const float s = tl[row * 33 + dir * 16 + r];
#pragma unroll
          for (int j = 0; j < 8; ++j) z[j] += s * w[r][j]; }
        u32x4 o; o.x = pk2(logsigmoidf_(z[0]) * LFS, logsigmoidf_(z[1]) * LFS); o.y = pk2(logsigmoidf_(z[2]) * LFS, logsigmoidf_(z[3]) * LFS);
        o.z = pk2(logsigmoidf_(z[4]) * LFS, logsigmoidf_(z[5]) * LFS); o.w = pk2(logsigmoidf_(z[6]) * LFS, logsigmoidf_(z[7]) * LFS);
        *(u32x4*)(lfb + PIDX(r0 + row, cb)) = o;
      }
    }
  }
}

__device__ __forceinline__ void headnorm_phase(unsigned char* lds_, int wv, const Params& p, int layer) {
  const Ctx c = make_ctx(lds_, wv);
  const bf16_t* P = (const bf16_t*)(p.ws + WS_R1); const bf16_t* O = (const bf16_t*)(p.ws + WS_R2);
  bf16_t* mixed = (bf16_t*)(p.ws + WS_HB);
  const int c0 = c.lane * 16, h8 = c.lane >> 3;
  const float* gain = layer == 0 ? (h8 < 4 ? p.in[I_HGRN_NORM] + c0 : p.in[I_GLA_NORM] + c0 - 512) : (h8 < 4 ? p.in[I_RET_NORM] + c0 : p.in[I_MLSTM_NORM] + c0 - 512);
  const int gcol = layer == 0 ? (h8 < 4 ? 2048 + c0 : 3584 + c0 - 512) : (h8 < 4 ? 1024 + c0 : 3072 + c0 - 512);
  float gn[16];
#pragma unroll
  for (int j = 0; j < 16; ++j) gn[j] = gain[j];
  for (int tok = c.bid * 8 + c.wid; tok < NTOK; tok += c.G * 8) {
    float of[16], ob[16], gt[16];
    { const u32x4* a = (const u32x4*)(O + PIDX(tok, c0)); unpack8(a[0], of); unpack8(a[1], of + 8);
      const u32x4* b = (const u32x4*)(O + (size_t)NTOK * 1024 + PIDX(tok, c0)); unpack8(b[0], ob); unpack8(b[1], ob + 8);
      const u32x4* g = (const u32x4*)(P + PIDX(tok, gcol)); unpack8(g[0], gt); unpack8(g[1], gt + 8); }
    const float sf = 1.f, sb = 1.f;
    float o[16]; float ss = 0.f;
#pragma unroll
    for (int j = 0; j < 16; ++j) { o[j] = of[j] * sf + ob[j] * sb; ss += o[j] * o[j]; }
    ss += __shfl_xor(ss, 1); ss += __shfl_xor(ss, 2); ss += __shfl_xor(ss, 4);
    const float r = 1.0f / sqrtf(ss * (1.0f / 128.0f) + NORM_EPS_F);
    unsigned w[8];
#pragma unroll
    for (int j = 0; j < 8; ++j) {
      float g0 = gt[2 * j], g1 = gt[2 * j + 1];
      if (layer == 1 && h8 >= 4) { g0 = fsigmoid(g0); g1 = fsigmoid(g1); } else { g0 = fsilu(g0); g1 = fsilu(g1); }
      w[j] = pk2(o[2 * j] * r * gn[2 * j] * g0, o[2 * j + 1] * r * gn[2 * j + 1] * g1);
    }
    u32x4* d = (u32x4*)(mixed + (size_t)tok * 1024 + c0);
    d[0] = (u32x4){w[0], w[1], w[2], w[3]}; d[1] = (u32x4){w[4], w[5], w[6], w[7]};
  }
}

__device__ __forceinline__ void ln_phase(unsigned char* lds_, int wv, const Params& p, int layer, int mode, int dry = 0) {
  const Ctx c = make_ctx(lds_, wv);
  unsigned char* ws = p.ws;
  const float* hin = (mode == 0 && layer == 0) ? p.in[I_X] : p.out;
  float* hout = dry ? (float*)(ws + WS_H) : p.out; bf16_t* hb = (bf16_t*)(ws + WS_HB);
  const float* g = p.in[mode == 0 ? I_LN_MIX_G : I_LN_FFN_G] + layer * 1024; const float* b = p.in[mode == 0 ? I_LN_MIX_B : I_LN_FFN_B] + layer * 1024;
  unsigned* cnt = (unsigned*)(ws + WS_CTL) + CW_CNT(layer);
  int* list = (int*)(ws + WS_LIST) + (size_t)layer * NEXP * NTOK;
  int* assign = (int*)(ws + WS_ASSIGN); float* gate = (float*)(ws + WS_GATE);
  float* rwT = (float*)c.lds;
  int* lcnt = (int*)(c.lds + 65536); int* lbase = lcnt + 16; int* rec = lcnt + 32; float* recg = (float*)(rec + 4 * 2048);
  int pad[NEXP];
  if (mode == 0) { const float* r = p.in[I_ROUTER_W];
    for (int i = c.tid; i < 1024 * 16; i += NTHREADS) rwT[(i & 15) * 1024 + (i >> 4)] = r[i];
    if (c.tid < 16) lcnt[c.tid] = 0;
    __syncthreads(); }
  else { int acc = 0;
#pragma unroll
    for (int e = 0; e < NEXP; ++e) { pad[e] = acc; acc += (((int)cnt[e * 16] + 255) >> 8) << 8; } }
  const int c0 = c.lane * 4;
  float gv[16], bv[16];
#pragma unroll
  for (int q = 0; q < 4; ++q) { const f32x4 t0 = *(const f32x4*)(g + q * 256 + c0), t1 = *(const f32x4*)(b + q * 256 + c0);
#pragma unroll
    for (int j = 0; j < 4; ++j) { gv[4 * q + j] = t0[j]; bv[4 * q + j] = t1[j]; } }
  const int tstride = c.G * 8;
  int it = 0;
  for (int tok0 = c.bid * 8 + c.wid; tok0 < NTOK; tok0 += 2 * tstride, it += 2) {
    float v[2][16];
    float gy0[2], gy1[2];
#pragma unroll
    for (int u = 0; u < 2; ++u) {
      const int tok = tok0 + u * tstride;
      if (tok < NTOK) {
#pragma unroll
        for (int q = 0; q < 4; ++q) { const f32x4 t = *(const f32x4*)(hin + (size_t)tok * 1024 + q * 256 + c0); v[u][4 * q] = ALPHA_F * t[0]; v[u][4 * q + 1] = ALPHA_F * t[1]; v[u][4 * q + 2] = ALPHA_F * t[2]; v[u][4 * q + 3] = ALPHA_F * t[3]; }
        if (mode == 0) {
#pragma unroll
          for (int q = 0; q < 4; ++q) { const f32x4 t = *(const f32x4*)((const float*)(ws + WS_R2) + (size_t)tok * 1024 + q * 256 + c0); v[u][4 * q] += t[0]; v[u][4 * q + 1] += t[1]; v[u][4 * q + 2] += t[2]; v[u][4 * q + 3] += t[3]; }
        } else {
          const int a0 = assign[tok * 4], a1 = assign[tok * 4 + 1], a2 = assign[tok * 4 + 2], a3 = assign[tok * 4 + 3];
          gy0[u] = gate[tok * 2]; gy1[u] = gate[tok * 2 + 1];
          int p0 = 0, p1 = 0;
#pragma unroll
          for (int e = 0; e < NEXP; ++e) { if (e == a0) p0 = pad[e]; if (e == a2) p1 = pad[e]; }
          p0 += a1; p1 += a3;
          const bf16_t* Y = (const bf16_t*)(ws + WS_R2);
#pragma unroll
          for (int q = 0; q < 4; ++q) { const u32x2 y0 = *(const u32x2*)(Y + (size_t)p0 * 1024 + q * 256 + c0), y1 = *(const u32x2*)(Y + (size_t)p1 * 1024 + q * 256 + c0);
            v[u][4 * q] += gy0[u] * __uint_as_float(y0.x << 16) + gy1[u] * __uint_as_float(y1.x << 16); v[u][4 * q + 1] += gy0[u] * __uint_as_float(y0.x & 0xffff0000u) + gy1[u] * __uint_as_float(y1.x & 0xffff0000u);
            v[u][4 * q + 2] += gy0[u] * __uint_as_float(y0.y << 16) + gy1[u] * __uint_as_float(y1.y << 16); v[u][4 * q + 3] += gy0[u] * __uint_as_float(y0.y & 0xffff0000u) + gy1[u] * __uint_as_float(y1.y & 0xffff0000u); }
        }
      } else {
#pragma unroll
        for (int j = 0; j < 16; ++j) v[u][j] = 0.f;
      }
    }
#pragma unroll
    for (int u = 0; u < 2; ++u) {
      const int tok = tok0 + u * tstride;
      float s = 0.f;
#pragma unroll
      for (int j = 0; j < 16; ++j) s += v[u][j];
      const float mean = wave_sum(s) * (1.0f / 1024.0f);
      float qq = 0.f;
#pragma unroll
      for (int j = 0; j < 16; ++j) { v[u][j] -= mean; qq += v[u][j] * v[u][j]; }
      const float r = 1.0f / sqrtf(wave_sum(qq) * (1.0f / 1024.0f) + LN_EPS_F);
#pragma unroll
      for (int j = 0; j < 16; ++j) v[u][j] = v[u][j] * r * gv[j] + bv[j];
      if (tok < NTOK) {
#pragma unroll
        for (int q = 0; q < 4; ++q) *(f32x4*)(hout + (size_t)tok * 1024 + q * 256 + c0) = (f32x4){v[u][4 * q], v[u][4 * q + 1], v[u][4 * q + 2], v[u][4 * q + 3]};
        if (!(mode == 1 && layer == 1) && !dry) {
#pragma unroll
          for (int q = 0; q < 4; ++q) *(u32x2*)(hb + (size_t)tok * 1024 + q * 256 + c0) = (u32x2){pk2(v[u][4 * q], v[u][4 * q + 1]), pk2(v[u][4 * q + 2], v[u][4 * q + 3])}; }
      }
      if (mode == 0) {
        float lg[16];
#pragma unroll
        for (int e = 0; e < 16; ++e) { float a = 0.f;
#pragma unroll
          for (int q = 0; q < 4; ++q) { const f32x4 w = *(const f32x4*)(rwT + e * 1024 + q * 256 + c0); a += v[u][4 * q] * w[0] + v[u][4 * q + 1] * w[1] + v[u][4 * q + 2] * w[2] + v[u][4 * q + 3] * w[3]; }
          lg[e] = a; }
#pragma unroll
        for (int e = 0; e < 16; ++e) lg[e] = wave_sum(lg[e]);
        int eo[2]; float go[2];
        route_from_logits(lg, p.in[I_ROUTER_B], eo, go);
        if (c.lane == 0 && tok < NTOK && !dry) {
          const int r1 = atomicAdd(lcnt + eo[0], 1), r2 = atomicAdd(lcnt + eo[1], 1);
          const int ri = (it + u) * 8 + c.wid;
          rec[ri * 4] = eo[0]; rec[ri * 4 + 1] = r1; rec[ri * 4 + 2] = eo[1]; rec[ri * 4 + 3] = r2; recg[ri * 2] = go[0]; recg[ri * 2 + 1] = go[1];
        }
      }
    }
  }
  if (mode == 0 && !dry) {
    __syncthreads();
    if (c.tid < 16) lbase[c.tid] = (int)atomicAdd(cnt + c.tid * 16, (unsigned)lcnt[c.tid]);
    __syncthreads();
    const int nrec = ((NTOK + c.G * 8 - 1) / (c.G * 8)) * 8;
    for (int ri = c.tid; ri < nrec; ri += NTHREADS) {
      const int tok = c.bid * 8 + (ri & 7) + (ri >> 3) * c.G * 8;
      if (tok < NTOK) {
        const int e1 = rec[ri * 4], e2 = rec[ri * 4 + 2]; const int r1 = rec[ri * 4 + 1] + lbase[e1], r2 = rec[ri * 4 + 3] + lbase[e2];
        list[e1 * NTOK + r1] = tok; list[e2 * NTOK + r2] = tok;
        assign[tok * 4] = e1; assign[tok * 4 + 1] = r1; assign[tok * 4 + 2] = e2; assign[tok * 4 + 3] = r2;
        gate[tok * 2] = recg[ri * 2]; gate[tok * 2 + 1] = recg[ri * 2 + 1];
      }
    }
  }
  __syncthreads();
}
#endif
#ifndef CPU_EMU
namespace scan {
typedef short bf16x8 __attribute__((ext_vector_type(8)));
typedef float f32x4 __attribute__((ext_vector_type(4)));
typedef unsigned u32x4 __attribute__((ext_vector_type(4)));
typedef unsigned u32x2 __attribute__((ext_vector_type(2)));
enum { MIX_A = 0, MIX_B = 1, MIX_C = 2, MIX_D = 3 };
constexpr int LD_T = 144;
constexpr int OFF_QS = 0, OFF_KS = 17408, OFF_QI = 34816, OFF_KT = 52224, OFF_VT = 70656, OFF_SC = 77568, OFF_ST = 86784, OFF_DEC = 99840, OFF_EM = 100352, OFF_DEN = 100608, OFF_CW = 100864, SCAN_LDS = 104960;

__device__ __forceinline__ float incl_scan_add(float x) {
  x += __builtin_bit_cast(float, __builtin_amdgcn_update_dpp(0, __builtin_bit_cast(int, x), 0x111, 0xf, 0xf, false));
  x += __builtin_bit_cast(float, __builtin_amdgcn_update_dpp(0, __builtin_bit_cast(int, x), 0x112, 0xf, 0xf, false));
  x += __builtin_bit_cast(float, __builtin_amdgcn_update_dpp(0, __builtin_bit_cast(int, x), 0x114, 0xf, 0xf, false));
  x += __builtin_bit_cast(float, __builtin_amdgcn_update_dpp(0, __builtin_bit_cast(int, x), 0x118, 0xf, 0xf, false));
  x += __builtin_bit_cast(float, __builtin_amdgcn_update_dpp(0, __builtin_bit_cast(int, x), 0x142, 0xa, 0xf, false));
  x += __builtin_bit_cast(float, __builtin_amdgcn_update_dpp(0, __builtin_bit_cast(int, x), 0x143, 0xc, 0xf, false));
  return x;
}
__device__ __forceinline__ float incl_scan_max(float x) {
  const int ninf = (int)0xff800000u;
  x = fmaxf(x, __builtin_bit_cast(float, __builtin_amdgcn_update_dpp(ninf, __builtin_bit_cast(int, x), 0x111, 0xf, 0xf, false)));
  x = fmaxf(x, __builtin_bit_cast(float, __builtin_amdgcn_update_dpp(ninf, __builtin_bit_cast(int, x), 0x112, 0xf, 0xf, false)));
  x = fmaxf(x, __builtin_bit_cast(float, __builtin_amdgcn_update_dpp(ninf, __builtin_bit_cast(int, x), 0x114, 0xf, 0xf, false)));
  x = fmaxf(x, __builtin_bit_cast(float, __builtin_amdgcn_update_dpp(ninf, __builtin_bit_cast(int, x), 0x118, 0xf, 0xf, false)));
  x = fmaxf(x, __builtin_bit_cast(float, __builtin_amdgcn_update_dpp(ninf, __builtin_bit_cast(int, x), 0x142, 0xa, 0xf, false)));
  x = fmaxf(x, __builtin_bit_cast(float, __builtin_amdgcn_update_dpp(ninf, __builtin_bit_cast(int, x), 0x143, 0xc, 0xf, false)));
  return x;
}
__device__ __forceinline__ float rdlane(float x, int l) { return __builtin_bit_cast(float, __builtin_amdgcn_readlane(__builtin_bit_cast(int, x), l)); }
__device__ __forceinline__ bf16x8 ldfrag(const unsigned char* base, int ld, int row, int kbyte) { return *(const bf16x8*)(base + row * ld + kbyte); }
__device__ __forceinline__ unsigned pk(float a, float b) { return pk_hw(a, b); }
__device__ __forceinline__ float lo16(unsigned w) { return __uint_as_float(w << 16); }
__device__ __forceinline__ float hi16(unsigned w) { return __uint_as_float(w & 0xffff0000u); }

__device__ __forceinline__ void lds_barrier() { asm volatile("s_waitcnt lgkmcnt(0)" ::: "memory"); __builtin_amdgcn_s_barrier(); asm volatile("" ::: "memory"); }
struct Raw { u32x4 a0, a1, b0, b1; f32x4 r0, r1; u32x2 v; float s0, s1; };

template <int MIXER>
__device__ __forceinline__ void scan_item(unsigned char* lds, int wv, const Params& p, int b, int h, int dir, int vs) {
  constexpr int DK = (MIXER == MIX_A || MIXER == MIX_D) ? 128 : 64;
  constexpr int NC = DK / 8;
  constexpr int LD_D = DK * 2 + 16;
  constexpr int NVT = MIXER == MIX_D ? 3 : 2;
  constexpr int NKD = DK / 32;
  const int tid = opaque_tid(wv), lane0 = tid & 63, wid = __builtin_amdgcn_readfirstlane(tid >> 6);
  unsigned char* ws = p.ws;
  const bf16_t* P = (const bf16_t*)(ws + WS_R1);
  const bf16_t* LFBp = (const bf16_t*)(ws + WS_LFB);
  const float* side = (const float*)(ws + WS_SIDE);
  const float* rope = (const float*)(ws + WS_ROPE);
  bf16_t* O = (bf16_t*)(ws + WS_R2) + (size_t)dir * NTOK * 1024;
  unsigned char* QS = lds + OFF_QS; unsigned char* KS = lds + OFF_KS; unsigned char* QI = lds + OFF_QI; unsigned char* KT = lds + OFF_KT;
  unsigned char* VT = lds + OFF_VT; unsigned char* SC = lds + OFF_SC; unsigned char* ST = lds + OFF_ST;
  float* DEC = (float*)(lds + OFF_DEC); float* EM = (float*)(lds + OFF_EM); float* DEN = (float*)(lds + OFF_DEN);

  int qcol, kcol, lfcol, vcol, ocol;
  if (MIXER == MIX_A) { qcol = h * 128; kcol = 0; lfcol = 512 + dir * 512 + h * 128; vcol = 1536 + h * 128 + vs * 32; ocol = h * 128 + vs * 32; }
  else if (MIXER == MIX_B) { qcol = 2560 + h * 64; kcol = 2816 + h * 64; lfcol = dir * 256 + h * 64; vcol = 3072 + h * 128 + vs * 32; ocol = 512 + h * 128 + vs * 32; }
  else if (MIXER == MIX_C) { qcol = h * 64; kcol = 256 + h * 64; lfcol = 0; vcol = 512 + h * 128 + vs * 32; ocol = h * 128 + vs * 32; }
  else { qcol = h * 128  ; kcol = 3584 + h * 128  ; lfcol = 0; vcol = 2560 + h * 128 + vs * 32; ocol = 512 + h * 128 + vs * 32; }
  const int c0 = (MIXER == MIX_C) ? wid * 4 : wid * NC;
  const float lgam = (MIXER == MIX_C) ? log1pf(-exp2f(-(5.0f + 2.0f * (float)h + (float)dir))) : 0.f;
  const float fgb = (MIXER == MIX_D) ? p.in[I_FGATE_B][dir * 4 + h] : 0.f;
  for (int i = tid; i < 48 * LD_D / 4; i += NTHREADS) ((unsigned*)ST)[i] = 0u;
  if (MIXER == MIX_D) {
    for (int i = tid; i < 16 * 64; i += NTHREADS) { const int r = 32 + (i >> 6), j = i & 63; *(bf16_t*)(VT + r * LD_T + j * 2) = (r == 32) ? (bf16_t)0x3F80 : (bf16_t)0; }
  }
  f32x4 sacc[NVT == 3 ? 3 : 2];
#pragma unroll
  for (int i = 0; i < (NVT == 3 ? 3 : 2); ++i) sacc[i] = (f32x4){0.f, 0.f, 0.f, 0.f};
  float m_st = 0.f;
  const size_t tokbase = (size_t)b * SEQ;
  const int sgn = dir ? -1 : 1;
  __syncthreads();

  Raw R;
#define SCAN_LOAD(n_) do { \
    int ln_ = lane0; asm volatile("" : "+v"(ln_)); \
    const int t_ = dir ? (SEQ - 1 - ((n_) * 64 + ln_)) : ((n_) * 64 + ln_); \
    const bf16_t* row_ = P + (tokbase + t_) * PSTRIDE; \
    if (MIXER == MIX_A) { const u32x4* qp_ = (const u32x4*)(row_ + qcol + c0); const u32x4* lp_ = (const u32x4*)(row_ + lfcol + c0); R.a0 = qp_[0]; R.a1 = qp_[1]; R.b0 = lp_[0]; R.b1 = lp_[1]; } \
    else if (MIXER == MIX_B) { R.a0 = *(const u32x4*)(row_ + qcol + c0); R.a1 = *(const u32x4*)(row_ + kcol + c0); R.b0 = *(const u32x4*)(LFBp + (tokbase + t_) * 512 + lfcol + c0); } \
    else if (MIXER == MIX_C) { const u32x2 qa_ = *(const u32x2*)(row_ + qcol + c0), qb_ = *(const u32x2*)(row_ + qcol + 32 + c0), ka_ = *(const u32x2*)(row_ + kcol + c0), kb_ = *(const u32x2*)(row_ + kcol + 32 + c0); \
      R.a0 = (u32x4){qa_.x, qa_.y, qb_.x, qb_.y}; R.a1 = (u32x4){ka_.x, ka_.y, kb_.x, kb_.y}; \
      R.r0 = *(const f32x4*)(rope + ((size_t)t_ * 32 + c0) * 2); R.r1 = *(const f32x4*)(rope + ((size_t)t_ * 32 + c0) * 2 + 4); } \
    else { const u32x4* qp_ = (const u32x4*)(LFBp + (tokbase + t_) * 512 + qcol + c0); const u32x4* kp_ = (const u32x4*)(row_ + kcol + c0); R.a0 = qp_[0]; R.a1 = qp_[1]; R.b0 = kp_[0]; R.b1 = kp_[1]; \
      R.s0 = side[(tokbase + t_) * 32 + dir * 8 + h]; R.s1 = side[(tokbase + t_) * 32 + dir * 8 + 4 + h]; } \
    R.v = *(const u32x2*)(row_ + vcol + wid * 4); } while (0)

  SCAN_LOAD(0);
  for (int n = 0; n < SEQ / 64; ++n) {
    int lane = lane0; asm volatile("" : "+v"(lane));
    const int fr = lane & 15, fq = lane >> 4;
    float q[NC], k[NC], g[NC];
    const u32x2 vv = R.v;
    float g_li = 0.f, g_lf = 0.f;
    if (MIXER == MIX_A) {
      const unsigned qw[8] = {R.a0.x, R.a0.y, R.a0.z, R.a0.w, R.a1.x, R.a1.y, R.a1.z, R.a1.w}, lw[8] = {R.b0.x, R.b0.y, R.b0.z, R.b0.w, R.b1.x, R.b1.y, R.b1.z, R.b1.w};
#pragma unroll
      for (int c = 0; c < 8; ++c) { q[2 * c] = lo16(qw[c]); q[2 * c + 1] = hi16(qw[c]); g[2 * c] = lo16(lw[c]); g[2 * c + 1] = hi16(lw[c]); }
#pragma unroll
      for (int c = 0; c < NC; ++c) k[c] = 1.0f - __expf(g[c]);
    } else if (MIXER == MIX_B) {
      const unsigned qw[4] = {R.a0.x, R.a0.y, R.a0.z, R.a0.w}, kw[4] = {R.a1.x, R.a1.y, R.a1.z, R.a1.w}, lw[4] = {R.b0.x, R.b0.y, R.b0.z, R.b0.w};
#pragma unroll
      for (int c = 0; c < 4; ++c) { q[2 * c] = lo16(qw[c]); q[2 * c + 1] = hi16(qw[c]); k[2 * c] = lo16(kw[c]); k[2 * c + 1] = hi16(kw[c]); g[2 * c] = lo16(lw[c]); g[2 * c + 1] = hi16(lw[c]); }
    } else if (MIXER == MIX_C) {
      const float cs[4] = {R.r0[0], R.r0[2], R.r1[0], R.r1[2]}, sn[4] = {R.r0[1], R.r0[3], R.r1[1], R.r1[3]};
      const float q1[4] = {lo16(R.a0.x), hi16(R.a0.x), lo16(R.a0.y), hi16(R.a0.y)}, q2[4] = {lo16(R.a0.z), hi16(R.a0.z), lo16(R.a0.w), hi16(R.a0.w)};
      const float k1[4] = {lo16(R.a1.x), hi16(R.a1.x), lo16(R.a1.y), hi16(R.a1.y)}, k2[4] = {lo16(R.a1.z), hi16(R.a1.z), lo16(R.a1.w), hi16(R.a1.w)};
#pragma unroll
      for (int c = 0; c < 4; ++c) { q[c] = (q1[c] * cs[c] - q2[c] * sn[c]) * 0.125f; q[4 + c] = (q1[c] * sn[c] + q2[c] * cs[c]) * 0.125f; k[c] = k1[c] * cs[c] - k2[c] * sn[c]; k[4 + c] = k1[c] * sn[c] + k2[c] * cs[c]; }
#pragma unroll
      for (int c = 0; c < NC; ++c) g[c] = (float)(lane + 1) * lgam;
    } else {
      const unsigned qw[8] = {R.a0.x, R.a0.y, R.a0.z, R.a0.w, R.a1.x, R.a1.y, R.a1.z, R.a1.w}, kw[8] = {R.b0.x, R.b0.y, R.b0.z, R.b0.w, R.b1.x, R.b1.y, R.b1.z, R.b1.w};
      g_li = R.s0; g_lf = R.s1;
#pragma unroll
      for (int c = 0; c < 8; ++c) { q[2 * c] = lo16(qw[c]); q[2 * c + 1] = hi16(qw[c]); k[2 * c] = lo16(kw[c]); k[2 * c + 1] = hi16(kw[c]); }
#pragma unroll
      for (int c = 0; c < NC; ++c) g[c] = 0.f;
    }
    if (n + 1 < SEQ / 64) SCAN_LOAD(n + 1);

#ifndef PROBE_REPA
#define PROBE_REPA 1
#endif
    const float m_save = m_st;
#pragma unroll 1
    for (int rep = 0; rep < PROBE_REPA; ++rep) {
    if (PROBE_REPA > 1) { m_st = m_save;
#pragma unroll
      for (int c = 0; c < NC; ++c) asm volatile("" : "+v"(g[c]), "+v"(q[c]), "+v"(k[c])); }
    float s_qs[NC], s_ks[NC], s_qi[NC], s_kt[NC];
    if (MIXER != MIX_D) {
#pragma unroll
      for (int c = 0; c < NC; ++c) {
        const float gc = (MIXER == MIX_C) ? g[c] : incl_scan_add(g[c]);
        const float gref = rdlane(gc, 31), glast = rdlane(gc, 63);
        const float a = __expf(gc - gref), ia = __builtin_amdgcn_rcpf(a);
        s_qs[c] = a; s_ks[c] = ia; s_qi[c] = a * __expf(gref); s_kt[c] = ia * __expf(glast - gref);
        if (lane == 63) DEC[(MIXER == MIX_C) ? (c < 4 ? c0 + c : 32 + c0 + c - 4) : c0 + c] = __expf(glast);
      }
    } else {
      const float li = g_li;
      const float lf = logsigmoidf_(g_lf + fgb);
      const float bc = incl_scan_add(lf);
      const float u = li - bc;
      const float pm = incl_scan_max(u);
      const float cmax = rdlane(pm, 63), blast = rdlane(bc, 63);
      const float a_i = bc + m_st, m_i = fmaxf(a_i, bc + pm);
      const float alpha = __expf(bc - m_i + cmax), beta = __expf(u - cmax), sint = __expf(a_i - m_i);
      const float m_new = fmaxf(blast + m_st, blast + cmax);
      const float s_old = __expf(blast + m_st - m_new), wks = __expf(blast + u - m_new);
      m_st = m_new;
#pragma unroll
      for (int c = 0; c < NC; ++c) { s_qs[c] = alpha; s_ks[c] = beta; s_qi[c] = sint; s_kt[c] = wks; }
      if (wid == 0) EM[lane] = __expf(-m_i);
      if (lane == 63) {
#pragma unroll
        for (int c = 0; c < NC; ++c) DEC[c0 + c] = s_old;
      }
    }
    {
      unsigned wq[NC / 2], wk[NC / 2], wi[NC / 2];
#pragma unroll
      for (int c = 0; c < NC / 2; ++c) { wq[c] = pk(q[2 * c] * s_qs[2 * c], q[2 * c + 1] * s_qs[2 * c + 1]); wk[c] = pk(k[2 * c] * s_ks[2 * c], k[2 * c + 1] * s_ks[2 * c + 1]); wi[c] = pk(q[2 * c] * s_qi[2 * c], q[2 * c + 1] * s_qi[2 * c + 1]); }
      if (MIXER == MIX_C) {
        *(u32x2*)(QS + lane * LD_D + c0 * 2) = (u32x2){wq[0], wq[1]}; *(u32x2*)(QS + lane * LD_D + (32 + c0) * 2) = (u32x2){wq[2], wq[3]};
        *(u32x2*)(KS + lane * LD_D + c0 * 2) = (u32x2){wk[0], wk[1]}; *(u32x2*)(KS + lane * LD_D + (32 + c0) * 2) = (u32x2){wk[2], wk[3]};
        *(u32x2*)(QI + lane * LD_D + c0 * 2) = (u32x2){wi[0], wi[1]}; *(u32x2*)(QI + lane * LD_D + (32 + c0) * 2) = (u32x2){wi[2], wi[3]};
      } else {
#pragma unroll
        for (int c = 0; c < NC / 8; ++c) {
          *(u32x4*)(QS + lane * LD_D + (c0 + 8 * c) * 2) = (u32x4){wq[4 * c], wq[4 * c + 1], wq[4 * c + 2], wq[4 * c + 3]};
          *(u32x4*)(KS + lane * LD_D + (c0 + 8 * c) * 2) = (u32x4){wk[4 * c], wk[4 * c + 1], wk[4 * c + 2], wk[4 * c + 3]};
          *(u32x4*)(QI + lane * LD_D + (c0 + 8 * c) * 2) = (u32x4){wi[4 * c], wi[4 * c + 1], wi[4 * c + 2], wi[4 * c + 3]};
        }
      }
#pragma unroll
      for (int c = 0; c < NC; ++c) { const int d = (MIXER == MIX_C) ? (c < 4 ? c0 + c : 32 + c0 + c - 4) : c0 + c; *(bf16_t*)(KT + d * LD_T + lane * 2) = f2bf(k[c] * s_kt[c]); }
      *(bf16_t*)(VT + (wid * 4 + 0) * LD_T + lane * 2) = (bf16_t)(vv.x & 0xffff); *(bf16_t*)(VT + (wid * 4 + 1) * LD_T + lane * 2) = (bf16_t)(vv.x >> 16);
      *(bf16_t*)(VT + (wid * 4 + 2) * LD_T + lane * 2) = (bf16_t)(vv.y & 0xffff); *(bf16_t*)(VT + (wid * 4 + 3) * LD_T + lane * 2) = (bf16_t)(vv.y >> 16);
    }
    }
    lds_barrier();
    {
      const int it = wid & 3;
#pragma unroll
      for (int jj = 0; jj < 2; ++jj) {
        const int jt = 2 * (wid >> 2) + jj;
        if (jt <= it) {
          f32x4 acc = (f32x4){0.f, 0.f, 0.f, 0.f};
#pragma unroll
          for (int ks = 0; ks < NKD; ++ks) acc = __builtin_amdgcn_mfma_f32_16x16x32_bf16(ldfrag(KS, LD_D, jt * 16 + fr, ks * 64 + fq * 16), ldfrag(QS, LD_D, it * 16 + fr, ks * 64 + fq * 16), acc, 0, 0, 0);
          const int i = it * 16 + fr, j0 = jt * 16 + fq * 4;
          const float v0 = (j0 + 0 <= i) ? acc[0] : 0.f, v1 = (j0 + 1 <= i) ? acc[1] : 0.f, v2 = (j0 + 2 <= i) ? acc[2] : 0.f, v3 = (j0 + 3 <= i) ? acc[3] : 0.f;
          *(u32x2*)(SC + i * LD_T + j0 * 2) = (u32x2){pk(v0, v1), pk(v2, v3)};
        } else {
          const int i = it * 16 + fr, j0 = jt * 16 + fq * 4;
          *(u32x2*)(SC + i * LD_T + j0 * 2) = (u32x2){0u, 0u};
        }
      }
    }
    f32x4 oacc = (f32x4){0.f, 0.f, 0.f, 0.f}, dacc = (f32x4){0.f, 0.f, 0.f, 0.f};
    {
      const int vt = wid >> 2, it = wid & 3;
#pragma unroll
      for (int ks = 0; ks < NKD; ++ks) oacc = __builtin_amdgcn_mfma_f32_16x16x32_bf16(ldfrag(ST, LD_D, vt * 16 + fr, ks * 64 + fq * 16), ldfrag(QI, LD_D, it * 16 + fr, ks * 64 + fq * 16), oacc, 0, 0, 0);
      if (NVT == 3 && wid < 4) {
#pragma unroll
        for (int ks = 0; ks < NKD; ++ks) dacc = __builtin_amdgcn_mfma_f32_16x16x32_bf16(ldfrag(ST, LD_D, 32 + fr, ks * 64 + fq * 16), ldfrag(QI, LD_D, wid * 16 + fr, ks * 64 + fq * 16), dacc, 0, 0, 0);
      }
    }
    lds_barrier();
    {
      const int vt = wid >> 2, it = wid & 3;
#pragma unroll
      for (int ks = 0; ks < 2; ++ks) oacc = __builtin_amdgcn_mfma_f32_16x16x32_bf16(ldfrag(VT, LD_T, vt * 16 + fr, ks * 64 + fq * 16), ldfrag(SC, LD_T, it * 16 + fr, ks * 64 + fq * 16), oacc, 0, 0, 0);
      if (NVT == 3) {
        if (wid < 4) {
#pragma unroll
          for (int ks = 0; ks < 2; ++ks) dacc = __builtin_amdgcn_mfma_f32_16x16x32_bf16(ldfrag(VT, LD_T, 32 + fr, ks * 64 + fq * 16), ldfrag(SC, LD_T, wid * 16 + fr, ks * 64 + fq * 16), dacc, 0, 0, 0);
          if (fq == 0) DEN[wid * 16 + fr] = dacc[0];
        }
        lds_barrier();
        const int i = it * 16 + fr;
        const float dn = 1.0f / fmaxf(fabsf(DEN[i]), EM[i]);
        oacc *= dn;
      }
      const int i = it * 16 + fr;
      const int ti = dir ? (SEQ - 1 - (n * 64 + i)) : (n * 64 + i);
      *(u32x2*)(O + (tokbase + ti) * 1024 + ocol + vt * 16 + fq * 4) = (u32x2){pk(oacc[0], oacc[1]), pk(oacc[2], oacc[3])};
    }
    {
      constexpr int NST = (DK == 128) ? NVT : 1;
#pragma unroll
      for (int s = 0; s < NST; ++s) {
        const int dt = (DK == 128) ? wid : (wid & 3), vt = (DK == 128) ? s : (wid >> 2);
        const f32x4 dc = *(const f32x4*)(DEC + dt * 16 + fq * 4);
        f32x4 acc = sacc[s] * dc;
#pragma unroll
        for (int ks = 0; ks < 2; ++ks) acc = __builtin_amdgcn_mfma_f32_16x16x32_bf16(ldfrag(KT, LD_T, dt * 16 + fr, ks * 64 + fq * 16), ldfrag(VT, LD_T, vt * 16 + fr, ks * 64 + fq * 16), acc, 0, 0, 0);
        sacc[s] = acc;
        *(u32x2*)(ST + (vt * 16 + fr) * LD_D + (dt * 16 + fq * 4) * 2) = (u32x2){pk(acc[0], acc[1]), pk(acc[2], acc[3])};
      }
    }
    lds_barrier();
  }
}

template <int MIXER>
__device__ __forceinline__ void scan_dispatch(unsigned char* lds, int wv, const Params& p, int id) {
  const int vs = id & 3, dir = (id >> 2) & 1, h = (id >> 3) & 3, b = id >> 5;
  scan_item<MIXER>(lds, wv, p, b, h, dir, vs);
}
}

__device__ __forceinline__ void convd_phase(unsigned char* lds_, int wv, const Params& p) {
  const Ctx c = make_ctx(lds_, wv);
  bf16_t* P = (bf16_t*)(p.ws + WS_R1); bf16_t* QD = (bf16_t*)(p.ws + WS_LFB);
  const float* cw = p.in[I_CONV_W]; const float* cb = p.in[I_CONV_B];
  const int ch = c.lane * 16;
  float w0[16], w1[16], w2[16], bb[16];
#pragma unroll
  for (int j = 0; j < 16; ++j) { w0[j] = cw[ch + j]; w1[j] = cw[1024 + ch + j]; w2[j] = cw[2048 + ch + j]; bb[j] = cb[ch + j]; }
  for (int tok = c.bid * 8 + c.wid; tok < NTOK; tok += c.G * 8) {
    const int t = tok % SEQ;
    const bf16_t* row = P + PIDX(tok, 1536 + ch);
    float x0[16], x1[16], x2[16];
    { const u32x4* r1 = (const u32x4*)row; unpack8(r1[0], x1); unpack8(r1[1], x1 + 8); }
    if (t > 0) { const u32x4* r0 = (const u32x4*)(row - 128); unpack8(r0[0], x0); unpack8(r0[1], x0 + 8); }
    else {
#pragma unroll
      for (int j = 0; j < 16; ++j) x0[j] = 0.f; }
    if (t < SEQ - 1) { const u32x4* r2 = (const u32x4*)(row + 128); unpack8(r2[0], x2); unpack8(r2[1], x2 + 8); }
    else {
#pragma unroll
      for (int j = 0; j < 16; ++j) x2[j] = 0.f; }
    const float sc = ch < 512 ? 0.08838834764831845f : 1.0f;
    unsigned w[8];
#pragma unroll
    for (int j = 0; j < 8; ++j) {
      const float a0 = bb[2 * j] + w0[2 * j] * x0[2 * j] + w1[2 * j] * x1[2 * j] + w2[2 * j] * x2[2 * j];
      const float a1 = bb[2 * j + 1] + w0[2 * j + 1] * x0[2 * j + 1] + w1[2 * j + 1] * x1[2 * j + 1] + w2[2 * j + 1] * x2[2 * j + 1];
      w[j] = pk2(fsilu(a0) * sc, fsilu(a1) * sc);
    }
    u32x4* d = (ch < 512) ? (u32x4*)(QD + PIDX(tok, ch)) : (u32x4*)(P + PIDX(tok, 3584 + (ch - 512)));
    d[0] = (u32x4){w[0], w[1], w[2], w[3]}; d[1] = (u32x4){w[4], w[5], w[6], w[7]};
  }
}

__device__ __forceinline__ void scan_phase(unsigned char* lds, int wv, const Params& p, int layer) {
  for (int item = blockIdx.x; item < 256; item += gridDim.x) {
    if (layer == 0) { if (item < 128) scan::scan_dispatch<scan::MIX_A>(lds, wv, p, item); else scan::scan_dispatch<scan::MIX_B>(lds, wv, p, item - 128); }
    else { if (item < 128) scan::scan_dispatch<scan::MIX_D>(lds, wv, p, item); else scan::scan_dispatch<scan::MIX_C>(lds, wv, p, item - 128); }
    __syncthreads();
  }
}
#endif
#ifndef CPU_EMU
namespace scan2 {
using namespace scan;
constexpr int S_QS = 0, S_KS = 17408, S_QI = 34816, S_KT = 52224  , S_VT = 89088  , S_SC = 102912, S_ST = 112128  , S_DEC = 138240  , S_EM = 139264  , S_END = 139776;

constexpr int T_SC = 102912  , T_ST = 121344  , T_DEC = 147456  , T_EM = 148480  , T_END = 148992;
template <int MIXER>
__device__ __forceinline__ void scan_item2(unsigned char* lds, int wv, const Params& p, int b, int h, int dir, int vs) {
  constexpr int DK = (MIXER == MIX_A || MIXER == MIX_D) ? 128 : 64;
  constexpr int NC = DK / 8;
  constexpr int LD_D = DK * 2 + 16;
  constexpr int NVT = MIXER == MIX_D ? 3 : 2;
  constexpr int NKD = DK / 32;
  constexpr int NST = (DK == 128) ? NVT : 1;
  constexpr int NCH = SEQ / 64;
  const int tid = opaque_tid(wv), lane0 = tid & 63, wid = __builtin_amdgcn_readfirstlane(tid >> 6);
  unsigned char* ws = p.ws;
  const bf16_t* P = (const bf16_t*)(ws + WS_R1);
  const bf16_t* LFBp = (const bf16_t*)(ws + WS_LFB);
  const float* side = (const float*)(ws + WS_SIDE);
  const float* rope = (const float*)(ws + WS_ROPE);
  bf16_t* O = (bf16_t*)(ws + WS_R2) + (size_t)dir * NTOK * 1024;
  unsigned char* QS = lds + S_QS; unsigned char* KS = lds + S_KS; unsigned char* QI = lds + S_QI;
  unsigned char* SC = lds + T_SC + (wid >> 2) * 9216;
  int qcol, kcol, lfcol, vcol, ocol;
  if (MIXER == MIX_A) { qcol = h * 128; kcol = 0; lfcol = 512 + dir * 512 + h * 128; vcol = 1536 + h * 128 + vs * 32; ocol = h * 128 + vs * 32; }
  else if (MIXER == MIX_B) { qcol = 2560 + h * 64; kcol = 2816 + h * 64; lfcol = dir * 256 + h * 64; vcol = 3072 + h * 128 + vs * 32; ocol = 512 + h * 128 + vs * 32; }
  else if (MIXER == MIX_C) { qcol = h * 64; kcol = 256 + h * 64; lfcol = 0; vcol = 512 + h * 128 + vs * 32; ocol = h * 128 + vs * 32; }
  else { qcol = h * 128; kcol = 3584 + h * 128; lfcol = 0; vcol = 2560 + h * 128 + vs * 32; ocol = 512 + h * 128 + vs * 32; }
  const size_t tokbase = (size_t)b * SEQ;
  const int c0 = (MIXER == MIX_C) ? wid * 4 : wid * NC;
  for (int i = tid; i < 2 * 13056 / 4; i += NTHREADS) ((unsigned*)(lds + T_ST))[i] = 0u;
  for (int i = tid; i < 2 * 9216 / 4; i += NTHREADS) ((unsigned*)(lds + T_SC))[i] = 0u;
  if (MIXER == MIX_D) { for (int i = tid; i < 2 * 16 * 64; i += NTHREADS) { const int bf = i >> 10, r = 32 + ((i >> 6) & 15), j = i & 63; *(bf16_t*)(lds + S_VT + bf * 6912 + r * LD_T + j * 2) = (r == 32) ? (bf16_t)0x3F80 : (bf16_t)0; } }
  const float lgam2 = (MIXER == MIX_C) ? log1pf(-exp2f(-(5.0f + 2.0f * (float)h + (float)dir))) * 1.4426950408889634f : 0.f;
  const float fgb = (MIXER == MIX_D) ? p.in[I_FGATE_B][dir * 4 + h] : 0.f;
  float m_st = 0.f;
  __syncthreads();

  Raw R, Rn; u32x2 Rv, Rvn;
#define A_LOAD(R, Rv, n_) do { \
    int ln_ = lane0; asm volatile("" : "+v"(ln_)); \
    const int t_ = dir ? (SEQ - 1 - ((n_) * 64 + ln_)) : ((n_) * 64 + ln_); \
    const size_t tk_ = tokbase + t_; \
    if (MIXER == MIX_A) { const u32x4* qp_ = (const u32x4*)(P + PIDX(tk_, qcol + c0)); const u32x4* lp_ = (const u32x4*)(P + PIDX(tk_, lfcol + c0)); R.a0 = qp_[0]; R.a1 = qp_[1]; R.b0 = lp_[0]; R.b1 = lp_[1]; } \
    else if (MIXER == MIX_B) { R.a0 = *(const u32x4*)(P + PIDX(tk_, qcol + c0)); R.a1 = *(const u32x4*)(P + PIDX(tk_, kcol + c0)); R.b0 = *(const u32x4*)(LFBp + PIDX(tk_, lfcol + c0)); } \
    else if (MIXER == MIX_C) { const u32x2 qa_ = *(const u32x2*)(P + PIDX(tk_, qcol + c0)), qb_ = *(const u32x2*)(P + PIDX(tk_, qcol + 32 + c0)), ka_ = *(const u32x2*)(P + PIDX(tk_, kcol + c0)), kb_ = *(const u32x2*)(P + PIDX(tk_, kcol + 32 + c0)); \
      R.a0 = (u32x4){qa_.x, qa_.y, qb_.x, qb_.y}; R.a1 = (u32x4){ka_.x, ka_.y, kb_.x, kb_.y}; \
      R.r0 = *(const f32x4*)(rope + ((size_t)t_ * 32 + c0) * 2); R.r1 = *(const f32x4*)(rope + ((size_t)t_ * 32 + c0) * 2 + 4); } \
    else { const u32x4* qp_ = (const u32x4*)(LFBp + PIDX(tk_, qcol + c0)); const u32x4* kp_ = (const u32x4*)(P + PIDX(tk_, kcol + c0)); R.a0 = qp_[0]; R.a1 = qp_[1]; R.b0 = kp_[0]; R.b1 = kp_[1]; \
      R.s0 = side[tk_ * 32 + dir * 8 + h]; R.s1 = side[tk_ * 32 + dir * 8 + 4 + h]; } \
    Rv = *(const u32x2*)(P + PIDX(tk_, vcol + wid * 4)); } while (0)

  unsigned pq[NC / 2], pks[NC / 2], pqi[NC / 2];
#define A_PREP(buf_, R, Rv) do { \
    int lane = lane0; asm volatile("" : "+v"(lane)); \
    unsigned char* KTb = lds + S_KT + (buf_) * 18432; float* DECb = (float*)(lds + T_DEC + (buf_) * 512); float* EMb = (float*)(lds + T_EM + (buf_) * 256); \
    float q[NC], k[NC], g[NC], ktv[NC]; \
    if (MIXER == MIX_A) { \
      const unsigned qw[8] = {R.a0.x, R.a0.y, R.a0.z, R.a0.w, R.a1.x, R.a1.y, R.a1.z, R.a1.w}, lw[8] = {R.b0.x, R.b0.y, R.b0.z, R.b0.w, R.b1.x, R.b1.y, R.b1.z, R.b1.w}; \
      _Pragma("unroll") for (int c = 0; c < 8; ++c) { q[2 * c] = lo16(qw[c]); q[2 * c + 1] = hi16(qw[c]); g[2 * c] = lo16(lw[c]); g[2 * c + 1] = hi16(lw[c]); } \
      _Pragma("unroll") for (int c = 0; c < NC; ++c) k[c] = 1.0f - __builtin_amdgcn_exp2f(g[c]); \
    } else if (MIXER == MIX_B) { \
      const unsigned qw[4] = {R.a0.x, R.a0.y, R.a0.z, R.a0.w}, kw[4] = {R.a1.x, R.a1.y, R.a1.z, R.a1.w}, lw[4] = {R.b0.x, R.b0.y, R.b0.z, R.b0.w}; \
      _Pragma("unroll") for (int c = 0; c < 4; ++c) { q[2 * c] = lo16(qw[c]); q[2 * c + 1] = hi16(qw[c]); k[2 * c] = lo16(kw[c]); k[2 * c + 1] = hi16(kw[c]); g[2 * c] = lo16(lw[c]); g[2 * c + 1] = hi16(lw[c]); } \
    } else if (MIXER == MIX_C) { \
      const float cs[4] = {R.r0[0], R.r0[2], R.r1[0], R.r1[2]}, sn[4] = {R.r0[1], R.r0[3], R.r1[1], R.r1[3]}; \
      const float q1[4] = {lo16(R.a0.x), hi16(R.a0.x), lo16(R.a0.y), hi16(R.a0.y)}, q2[4] = {lo16(R.a0.z), hi16(R.a0.z), lo16(R.a0.w), hi16(R.a0.w)}; \
      const float k1[4] = {lo16(R.a1.x), hi16(R.a1.x), lo16(R.a1.y), hi16(R.a1.y)}, k2[4] = {lo16(R.a1.z), hi16(R.a1.z), lo16(R.a1.w), hi16(R.a1.w)}; \
      _Pragma("unroll") for (int c = 0; c < 4; ++c) { q[c] = (q1[c] * cs[c] - q2[c] * sn[c]) * 0.125f; q[4 + c] = (q1[c] * sn[c] + q2[c] * cs[c]) * 0.125f; k[c] = k1[c] * cs[c] - k2[c] * sn[c]; k[4 + c] = k1[c] * sn[c] + k2[c] * cs[c]; } \
    } else { \
      const unsigned qw[8] = {R.a0.x, R.a0.y, R.a0.z, R.a0.w, R.a1.x, R.a1.y, R.a1.z, R.a1.w}, kw[8] = {R.b0.x, R.b0.y, R.b0.z, R.b0.w, R.b1.x, R.b1.y, R.b1.z, R.b1.w}; \
      _Pragma("unroll") for (int c = 0; c < 8; ++c) { q[2 * c] = lo16(qw[c]); q[2 * c + 1] = hi16(qw[c]); k[2 * c] = lo16(kw[c]); k[2 * c + 1] = hi16(kw[c]); } \
    } \
    if (MIXER == MIX_A || MIXER == MIX_B) { \
        \
      _Pragma("unroll") for (int c = 0; c < NC; ++c) g[c] += __builtin_bit_cast(float, __builtin_amdgcn_update_dpp(0, __builtin_bit_cast(int, g[c]), 0x111, 0xf, 0xf, false)); \
      _Pragma("unroll") for (int c = 0; c < NC; ++c) g[c] += __builtin_bit_cast(float, __builtin_amdgcn_update_dpp(0, __builtin_bit_cast(int, g[c]), 0x112, 0xf, 0xf, false)); \
      _Pragma("unroll") for (int c = 0; c < NC; ++c) g[c] += __builtin_bit_cast(float, __builtin_amdgcn_update_dpp(0, __builtin_bit_cast(int, g[c]), 0x114, 0xf, 0xf, false)); \
      _Pragma("unroll") for (int c = 0; c < NC; ++c) g[c] += __builtin_bit_cast(float, __builtin_amdgcn_update_dpp(0, __builtin_bit_cast(int, g[c]), 0x118, 0xf, 0xf, false)); \
      _Pragma("unroll") for (int c = 0; c < NC; ++c) g[c] += __builtin_bit_cast(float, __builtin_amdgcn_update_dpp(0, __builtin_bit_cast(int, g[c]), 0x142, 0xa, 0xf, false)); \
      _Pragma("unroll") for (int c = 0; c < NC; ++c) g[c] += __builtin_bit_cast(float, __builtin_amdgcn_update_dpp(0, __builtin_bit_cast(int, g[c]), 0x143, 0xc, 0xf, false)); \
      float ev[NC]; \
      _Pragma("unroll") for (int c = 0; c < NC; ++c) { \
          \
        const float e = __builtin_amdgcn_exp2f(g[c]), r = __builtin_amdgcn_rcpf(e); \
        const float e31 = rdlane(e, 31), r31 = rdlane(r, 31), e63 = rdlane(e, 63); \
        const float qi = q[c] * e, kr = k[c] * r; \
        g[c] = qi; q[c] = qi * r31; k[c] = kr * e31; ktv[c] = kr * e63; \
        ev[c] = e; } \
      if (lane == 63) { _Pragma("unroll") for (int c = 0; c < NC / 4; ++c) *(f32x4*)(DECb + c0 + 4 * c) = (f32x4){ev[4 * c], ev[4 * c + 1], ev[4 * c + 2], ev[4 * c + 3]}; } \
    } else if (MIXER == MIX_C) { \
        \
      const float gl = (float)(lane + 1) * lgam2; \
      const float e = __builtin_amdgcn_exp2f(gl), r = __builtin_amdgcn_rcpf(e); \
      const float e31 = rdlane(e, 31), r31 = rdlane(r, 31), e63 = rdlane(e, 63); \
      const float f_qs = e * r31, f_ks = r * e31, f_kt = r * e63; \
      _Pragma("unroll") for (int c = 0; c < NC; ++c) { g[c] = q[c] * e; q[c] *= f_qs; ktv[c] = k[c] * f_kt; k[c] *= f_ks; } \
      if (lane < 4) { DECb[c0 + lane] = e63; DECb[32 + c0 + lane] = e63; } \
    } else { \
      const float li = R.s0 * 1.4426950408889634f; const float lf = logsigmoidf_(R.s1 + fgb) * 1.4426950408889634f;     \
      const float bc = incl_scan_add(lf); const float u = li - bc; const float pm = incl_scan_max(u); \
      const float cmax = rdlane(pm, 63), blast = rdlane(bc, 63); \
      const float a_i = bc + m_st, m_i = fmaxf(a_i, bc + pm); \
      const float d_alpha = __builtin_amdgcn_exp2f(bc - m_i + cmax), d_beta = __builtin_amdgcn_exp2f(u - cmax), d_sint = __builtin_amdgcn_exp2f(a_i - m_i); \
      const float m_new = fmaxf(blast + m_st, blast + cmax); \
      const float d_sold = __builtin_amdgcn_exp2f(blast + m_st - m_new), d_wks = __builtin_amdgcn_exp2f(blast + u - m_new); m_st = m_new; \
      _Pragma("unroll") for (int c = 0; c < NC; ++c) { ktv[c] = k[c] * d_wks; g[c] = q[c] * d_sint; q[c] *= d_alpha; k[c] *= d_beta; if (lane == 63) DECb[c0 + c] = d_sold; } \
      if (wid == 0) EMb[lane] = __builtin_amdgcn_exp2f(-m_i); \
    } \
    _Pragma("unroll") for (int c = 0; c < NC / 2; ++c) { const unsigned w_ = pk_hw(ktv[2 * c], ktv[2 * c + 1]); \
      const int d0_ = (MIXER == MIX_C) ? (2 * c < 4 ? c0 + 2 * c : 32 + c0 + 2 * c - 4) : c0 + 2 * c; \
      *(bf16_t*)(KTb + d0_ * LD_T + lane * 2) = (bf16_t)(w_ & 0xffff); *(bf16_t*)(KTb + (d0_ + 1) * LD_T + lane * 2) = (bf16_t)(w_ >> 16); } \
    _Pragma("unroll") for (int c = 0; c < NC / 2; ++c) { pq[c] = pk_hw(q[2 * c], q[2 * c + 1]); pks[c] = pk_hw(k[2 * c], k[2 * c + 1]); pqi[c] = pk_hw(g[2 * c], g[2 * c + 1]); } \
    { unsigned char* VTb = lds + S_VT + (buf_) * 6912 + (wid * 4) * LD_T + lane * 2; \
      *(bf16_t*)(VTb + 0 * LD_T) = (bf16_t)(Rv.x & 0xffff); *(bf16_t*)(VTb + 1 * LD_T) = (bf16_t)(Rv.x >> 16); *(bf16_t*)(VTb + 2 * LD_T) = (bf16_t)(Rv.y & 0xffff); *(bf16_t*)(VTb + 3 * LD_T) = (bf16_t)(Rv.y >> 16); } \
  } while (0)
#define A_WRITE() do { int lane = lane0; asm volatile("" : "+v"(lane)); \
    if (MIXER == MIX_C) { \
      *(u32x2*)(QS + lane * LD_D + c0 * 2) = (u32x2){pq[0], pq[1]}; *(u32x2*)(QS + lane * LD_D + (32 + c0) * 2) = (u32x2){pq[2], pq[3]}; \
      *(u32x2*)(KS + lane * LD_D + c0 * 2) = (u32x2){pks[0], pks[1]}; *(u32x2*)(KS + lane * LD_D + (32 + c0) * 2) = (u32x2){pks[2], pks[3]}; \
      *(u32x2*)(QI + lane * LD_D + c0 * 2) = (u32x2){pqi[0], pqi[1]}; *(u32x2*)(QI + lane * LD_D + (32 + c0) * 2) = (u32x2){pqi[2], pqi[3]}; \
    } else { \
      _Pragma("unroll") for (int c = 0; c < NC / 8; ++c) { \
        *(u32x4*)(QS + lane * LD_D + (c0 + 8 * c) * 2) = (u32x4){pq[4 * c], pq[4 * c + 1], pq[4 * c + 2], pq[4 * c + 3]}; \
        *(u32x4*)(KS + lane * LD_D + (c0 + 8 * c) * 2) = (u32x4){pks[4 * c], pks[4 * c + 1], pks[4 * c + 2], pks[4 * c + 3]}; \
        *(u32x4*)(QI + lane * LD_D + (c0 + 8 * c) * 2) = (u32x4){pqi[4 * c], pqi[4 * c + 1], pqi[4 * c + 2], pqi[4 * c + 3]}; } } } while (0)

  f32x4 sacc[NST];
#pragma unroll
  for (int i = 0; i < NST; ++i) sacc[i] = (f32x4){0.f, 0.f, 0.f, 0.f};
  A_LOAD(R, Rv, 0);
  A_PREP(0, R, Rv);
  A_LOAD(R, Rv, 1);
  A_LOAD(Rn, Rvn, 2);
  A_WRITE();
  lds_barrier();
#define SCAN_ITER(n_, RX, RvX) do { const int n = (n_); \
    const int cb = n & 1, nb = (n + 1) & 1; \
    if (n + 1 < NCH) { A_PREP(nb, RX, RvX); if (n + 3 < NCH) A_LOAD(RX, RvX, n + 3); } \
    { { \
      int lane = lane0; asm volatile("" : "+v"(lane)); \
      const int fr = lane & 15, fq = lane >> 4; \
      const int it = wid & 3, vt = wid >> 2; \
      const unsigned char* STc = lds + T_ST + cb * 13056; unsigned char* STn = lds + T_ST + nb * 13056; \
      const unsigned char* KTc = lds + S_KT + cb * 18432; const unsigned char* VTc = lds + S_VT + cb * 6912; \
      const float* DECc = (const float*)(lds + T_DEC + cb * 512); const float* EMc = (const float*)(lds + T_EM + cb * 256); \
_Pragma("unroll") \
      for (int jt = 0; jt < 4; ++jt) { \
        if (jt <= it) { \
          f32x4 acc = (f32x4){0.f, 0.f, 0.f, 0.f}; \
_Pragma("unroll") \
          for (int ks = 0; ks < NKD; ++ks) acc = __builtin_amdgcn_mfma_f32_16x16x32_bf16(ldfrag(KS, LD_D, jt * 16 + fr, ks * 64 + fq * 16), ldfrag(QS, LD_D, it * 16 + fr, ks * 64 + fq * 16), acc, 0, 0, 0); \
          const int i = it * 16 + fr, j0 = jt * 16 + fq * 4; \
          const float v0 = (j0 + 0 <= i) ? acc[0] : 0.f, v1 = (j0 + 1 <= i) ? acc[1] : 0.f, v2 = (j0 + 2 <= i) ? acc[2] : 0.f, v3 = (j0 + 3 <= i) ? acc[3] : 0.f; \
          *(u32x2*)(SC + i * LD_T + j0 * 2) = (u32x2){pk_hw(v0, v1), pk_hw(v2, v3)}; \
        } \
      } \
      f32x4 oacc = (f32x4){0.f, 0.f, 0.f, 0.f}, dacc = (f32x4){0.f, 0.f, 0.f, 0.f}; \
_Pragma("unroll") \
      for (int ks = 0; ks < NKD; ++ks) oacc = __builtin_amdgcn_mfma_f32_16x16x32_bf16(ldfrag(STc, LD_D, vt * 16 + fr, ks * 64 + fq * 16), ldfrag(QI, LD_D, it * 16 + fr, ks * 64 + fq * 16), oacc, 0, 0, 0); \
      if (NVT == 3) { \
_Pragma("unroll") \
        for (int ks = 0; ks < NKD; ++ks) dacc = __builtin_amdgcn_mfma_f32_16x16x32_bf16(ldfrag(STc, LD_D, 32 + fr, ks * 64 + fq * 16), ldfrag(QI, LD_D, it * 16 + fr, ks * 64 + fq * 16), dacc, 0, 0, 0); \
      } \
      asm volatile("s_waitcnt lgkmcnt(0)" ::: "memory"); \
      oacc = __builtin_amdgcn_mfma_f32_16x16x32_bf16(ldfrag(VTc, LD_T, vt * 16 + fr, fq * 16), ldfrag(SC, LD_T, it * 16 + fr, fq * 16), oacc, 0, 0, 0); \
      if (it >= 2) oacc = __builtin_amdgcn_mfma_f32_16x16x32_bf16(ldfrag(VTc, LD_T, vt * 16 + fr, 64 + fq * 16), ldfrag(SC, LD_T, it * 16 + fr, 64 + fq * 16), oacc, 0, 0, 0); \
      float dn = 1.0f; \
      if (NVT == 3) { \
        dacc = __builtin_amdgcn_mfma_f32_16x16x32_bf16(ldfrag(VTc, LD_T, 32 + fr, fq * 16), ldfrag(SC, LD_T, it * 16 + fr, fq * 16), dacc, 0, 0, 0); \
        if (it >= 2) dacc = __builtin_amdgcn_mfma_f32_16x16x32_bf16(ldfrag(VTc, LD_T, 32 + fr, 64 + fq * 16), ldfrag(SC, LD_T, it * 16 + fr, 64 + fq * 16), dacc, 0, 0, 0); \
        const float den = __shfl(dacc[0], fr); \
        dn = 1.0f / fmaxf(fabsf(den), EMc[it * 16 + fr]); \
      } \
      { \
        const int i = it * 16 + fr; \
        const int ti = dir ? (SEQ - 1 - (n * 64 + i)) : (n * 64 + i); \
        const f32x4 o = oacc * dn; \
        *(u32x2*)(O + PIDX(tokbase + ti, ocol + vt * 16 + fq * 4)) = (u32x2){pk_hw(o[0], o[1]), pk_hw(o[2], o[3])}; \
      } \
_Pragma("unroll") \
      for (int s = 0; s < NST; ++s) { \
        const int dt = (DK == 128) ? wid : (wid & 3), vt2 = (DK == 128) ? s : (wid >> 2); \
        const f32x4 dc = *(const f32x4*)(DECc + dt * 16 + fq * 4); \
        f32x4 acc = sacc[s] * dc; \
_Pragma("unroll") \
        for (int ks = 0; ks < 2; ++ks) acc = __builtin_amdgcn_mfma_f32_16x16x32_bf16(ldfrag(KTc, LD_T, dt * 16 + fr, ks * 64 + fq * 16), ldfrag(VTc, LD_T, vt2 * 16 + fr, ks * 64 + fq * 16), acc, 0, 0, 0); \
        sacc[s] = acc; \
        *(u32x2*)(STn + (vt2 * 16 + fr) * LD_D + (dt * 16 + fq * 4) * 2) = (u32x2){pk_hw(acc[0], acc[1]), pk_hw(acc[2], acc[3])}; \
      } \
    } \
    } \
    lds_barrier(); \
    if (n + 1 < NCH) A_WRITE(); \
    lds_barrier(); \
  } while (0)
  static_assert(NCH % 2 == 0, "chunk count must be even");
#pragma unroll 1
  for (int n2 = 0; n2 < NCH; n2 += 2) { SCAN_ITER(n2, R, Rv); SCAN_ITER(n2 + 1, Rn, Rvn); }
#undef SCAN_ITER
#undef A_LOAD
#undef A_PREP
#undef A_WRITE
}

template <int MIXER>
__device__ __forceinline__ void scan_dispatch2(unsigned char* lds, int wv, const Params& p, int id) {
  const int vs = id & 3, dir = (id >> 2) & 1, h = (id >> 3) & 3, b = id >> 5;
  scan_item2<MIXER>(lds, wv, p, b, h, dir, vs);
}
}

__device__ __forceinline__ void scan_phase2(unsigned char* lds, int wv, const Params& p, int layer) {
  for (int it0 = blockIdx.x; it0 < 256; it0 += gridDim.x) {
    const int xq = it0 & 7, yq = it0 >> 3, stream = (yq >> 2) * 8 + xq;
    const int item = (stream >> 5) * 128 + (stream & 31) * 4 + (yq & 3);
    if (layer == 0) { if (item < 128) scan2::scan_dispatch2<scan::MIX_A>(lds, wv, p, item); else scan2::scan_dispatch2<scan::MIX_B>(lds, wv, p, item - 128); }
    else { if (item < 128) scan2::scan_dispatch2<scan::MIX_D>(lds, wv, p, item); else scan2::scan_dispatch2<scan::MIX_C>(lds, wv, p, item - 128); }
    __syncthreads();
  }
}
#endif
#ifndef CPU_EMU
__device__ __forceinline__ void grid_bar(unsigned* ctr, unsigned& epoch, unsigned G, int wv) {
  asm volatile("s_waitcnt vmcnt(0)" ::: "memory");
  __syncthreads();
  epoch += G;
  if (wv == 0 && lane_id() == 0) {
    __builtin_amdgcn_fence(__ATOMIC_RELEASE, "agent");
    asm volatile("s_waitcnt vmcnt(0)" ::: "memory");
    __hip_atomic_fetch_add(ctr, 1u, __ATOMIC_RELAXED, __HIP_MEMORY_SCOPE_AGENT);
    unsigned spins = 0;
    while (__hip_atomic_load(ctr, __ATOMIC_RELAXED, __HIP_MEMORY_SCOPE_AGENT) < epoch) { __builtin_amdgcn_s_sleep(2); if (++spins > (1u << 26)) break; }
    __builtin_amdgcn_fence(__ATOMIC_ACQUIRE, "agent");
    asm volatile("s_waitcnt vmcnt(0)" ::: "memory");
  }
  __syncthreads();
}
#if (PROBE_DUP & 16)
#define grid_bar(a, b, c, d) do { grid_bar(a, b, c, d); grid_bar(a, b, c, d); } while (0)
#endif

__global__ void __launch_bounds__(NTHREADS) mk_fwd(Params p) {
  extern __shared__ __attribute__((aligned(16))) unsigned char lds_raw[];
  cg::grid_group grid = cg::this_grid();
  const int G = gridDim.x, bid = blockIdx.x;
  const int wv = __builtin_amdgcn_readfirstlane(threadIdx.x >> 6);
  PG8_LAS unsigned char* lds = (PG8_LAS unsigned char*)lds_raw;
  unsigned char* ws = p.ws;

  p0_prologue(lds_raw, wv, p);
#if (PROBE_DUP & 128)
  p0_prologue(lds_raw, wv, p);
#endif
  grid.sync();
  unsigned* bar = (unsigned*)(ws + WS_CTL) + 1024;
  unsigned epoch = 0;
  for (int layer = 0; layer < 2; ++layer) {
    { ProbInProj pr; pr.so.init(NTOK, layer == 0 ? PM_AB : PM_CD, G, bid); pr.A = (const char*)(ws + WS_HB); pr.Bt = (const char*)(ws + (layer == 0 ? WS_WIN_AB : WS_WIN_CD));
      pr.P = (bf16_t*)(ws + WS_R1); pr.bias = p.in[layer == 0 ? I_AB_B_IN : I_CD_B_IN]; pr.lb = (const float*)(ws + WS_LB); pr.layer = layer;
      pg8::gemm_phase(lds, pr, wv);
#if (PROBE_DUP & 1)
      pg8::gemm_phase(lds, pr, wv);
#endif
      if (layer == 0) side_phase<32>(lds_raw, wv, p, 0); else side_phase<16>(lds_raw, wv, p, 1);
#if (PROBE_DUP & 256)
      if (layer == 0) side_phase<32>(lds_raw, wv, p, 0); else side_phase<16>(lds_raw, wv, p, 1);
#endif
 }
    grid_bar(bar, epoch, (unsigned)G, wv);
    if (layer == 1) { convd_phase(lds_raw, wv, p); grid_bar(bar, epoch, (unsigned)G, wv); }
    scan_phase2(lds_raw, wv, p, layer);
#if (PROBE_DUP & 2)
    scan_phase2(lds_raw, wv, p, layer);
#endif
#if (PROBE_DUP & 512)
    if (layer == 0) scan_phase2(lds_raw, wv, p, layer);
#endif
#if (PROBE_DUP & 1024)
    if (layer == 1) scan_phase2(lds_raw, wv, p, layer);
#endif
    grid_bar(bar, epoch, (unsigned)G, wv);
    headnorm_phase(lds_raw, wv, p, layer);
#if (PROBE_DUP & 8)
    headnorm_phase(lds_raw, wv, p, layer);
#endif
    grid_bar(bar, epoch, (unsigned)G, wv);
    { ProbOutProj pr; pr.so.init(NTOK, 1024, G, bid); pr.A = (const char*)(ws + WS_HB); pr.Bt = (const char*)(ws + (layer == 0 ? WS_WOUT_AB : WS_WOUT_CD)); pr.Y = (float*)(ws + WS_R2);
      pg8::gemm_phase(lds, pr, wv);
#if (PROBE_DUP & 1)
      pg8::gemm_phase(lds, pr, wv);
#endif
      moe_weight_convert(lds_raw, wv, p, layer);
#if (PROBE_DUP & 4)
      moe_weight_convert(lds_raw, wv, p, layer);
#endif
 }
    grid_bar(bar, epoch, (unsigned)G, wv);
#if (PROBE_DUP & 32)
    ln_phase(lds_raw, wv, p, layer, 0, 1);
#endif
    ln_phase(lds_raw, wv, p, layer, 0);
    grid_bar(bar, epoch, (unsigned)G, wv);
    { ProbMoe1 pr; pr.mo.init((const int*)((const unsigned*)(ws + WS_CTL) + CW_CNT(layer)), 8, G, bid, lds_raw, wv);
      pr.A = (const char*)(ws + WS_HB); pr.W13 = (const char*)(ws + WS_WMOE); pr.list = (const int*)(ws + WS_LIST) + (size_t)layer * NEXP * NTOK; pr.H = (bf16_t*)(ws + WS_H);
      pg8::gemm_phase(lds, pr, wv);
#if (PROBE_DUP & 1)
      pg8::gemm_phase(lds, pr, wv);
#endif
 }
    grid_bar(bar, epoch, (unsigned)G, wv);
    { ProbMoe2 pr; pr.mo.init((const int*)((const unsigned*)(ws + WS_CTL) + CW_CNT(layer)), 4, G, bid, lds_raw, wv);
      pr.A = (const char*)(ws + WS_H); pr.W2 = (const char*)(ws + WS_WMOE) + (size_t)NEXP * 2048 * 1024 * 2; pr.Y = (bf16_t*)(ws + WS_R2);
      pg8::gemm_phase(lds, pr, wv);
#if (PROBE_DUP & 1)
      pg8::gemm_phase(lds, pr, wv);
#endif
 }
    grid_bar(bar, epoch, (unsigned)G, wv);
#if (PROBE_DUP & 64)
    ln_phase(lds_raw, wv, p, layer, 1, 1);
#endif
    ln_phase(lds_raw, wv, p, layer, 1);
    if (layer == 0) grid_bar(bar, epoch, (unsigned)G, wv);
  }
}

extern "C" void kernel_launch(void* const* d_in, const int* in_sizes, int n_in, void* d_out, int out_size, void* d_ws, size_t ws_size, hipStream_t stream) {
  static int grid_blocks = 0;
  if (grid_blocks == 0) {
    if (n_in != N_IN || ws_size < WS_END || out_size != NTOK * 1024) { fprintf(stderr, "kernel_launch: bad shapes: n_in %d ws %zu (need %zu) out %d\n", n_in, ws_size, (size_t)WS_END, out_size); grid_blocks = -1; return; }
    int dev = 0, cus = 0, per_cu = 0;
    hipGetDevice(&dev); hipDeviceGetAttribute(&cus, hipDeviceAttributeMultiprocessorCount, dev);
    if (hipFuncSetAttribute((const void*)mk_fwd, hipFuncAttributeMaxDynamicSharedMemorySize, LDS_BYTES) != hipSuccess) { fprintf(stderr, "kernel_launch: hipFuncSetAttribute failed\n"); grid_blocks = -1; return; }
    if (hipOccupancyMaxActiveBlocksPerMultiprocessor(&per_cu, (const void*)mk_fwd, NTHREADS, LDS_BYTES) != hipSuccess || per_cu < 1) { fprintf(stderr, "kernel_launch: occupancy query failed (%d)\n", per_cu); grid_blocks = -1; return; }
    grid_blocks = cus;
    (void)in_sizes;
  }
  if (grid_blocks < 0) return;
  Params p{};
  for (int i = 0; i < N_IN; ++i) p.in[i] = (const float*)d_in[i];
  p.out = (float*)d_out; p.ws = (unsigned char*)d_ws;
  void* args[] = {&p};
  hipError_t e = hipLaunchCooperativeKernel((const void*)mk_fwd, dim3(grid_blocks), dim3(NTHREADS), args, LDS_BYTES, stream);
  if (e != hipSuccess) fprintf(stderr, "cooperative launch failed: %s (grid %d)\n", hipGetErrorString(e), grid_blocks);
}
#endif
#ifdef CPU_EMU
#include <vector>
void dbg_cmp(const char* name, const float* p, long n);
template <class F> static void run_functor(const F& f, long n) {
#pragma omp parallel for schedule(dynamic, 16)
  for (long g = 0; g < n; ++g) f(g);
}
static void cpu_round_w(const float* src, size_t n, std::vector<float>& dst) { dst.resize(n); for (size_t i = 0; i < n; ++i) dst[i] = bf2f(f2bf(src[i])); }

extern "C" void kernel_launch(void* const* d_in, const int* in_sizes, int n_in, void* d_out, int out_size, void* d_ws, size_t ws_size, hipStream_t) {
  (void)in_sizes; (void)n_in; (void)out_size;
  if (ws_size < WS_END) { printf("ws too small %zu < %zu\n", ws_size, (size_t)WS_END); return; }
  Params p{}; for (int i = 0; i < N_IN; ++i) p.in[i] = (const float*)d_in[i];
  p.out = (float*)d_out; p.ws = (unsigned char*)d_ws;
  unsigned char* ws = p.ws;
  bf16_t* HB = (bf16_t*)(ws + WS_HB); bf16_t* P = (bf16_t*)(ws + WS_R1); bf16_t* LFB = (bf16_t*)(ws + WS_LFB);
  bf16_t* O = (bf16_t*)(ws + WS_R2); float* yf = (float*)(ws + WS_R2); bf16_t* Y = (bf16_t*)(ws + WS_R2); bf16_t* H = (bf16_t*)(ws + WS_H);
  float* side = (float*)(ws + WS_SIDE); float* oside = (float*)(ws + WS_OSIDE); float* rope = (float*)(ws + WS_ROPE); float* lb = (float*)(ws + WS_LB);
  int* assign = (int*)(ws + WS_ASSIGN); float* gate = (float*)(ws + WS_GATE);
  for (size_t i = 0; i < (size_t)NTOK * 1024; ++i) HB[i] = f2bf(p.in[I_X][i]);
  for (int i = 0; i < SEQ * 32; ++i) { int t = i >> 5, f = i & 31; float freq = powf(10000.0f, -(float)f / 32.0f); float ang = (float)t * freq; rope[i * 2] = cosf(ang); rope[i * 2 + 1] = sinf(ang); }
  for (int cc = 0; cc < 512; ++cc) { const float* hl = p.in[I_HGRN_LB]; float a0 = hl[cc], a1 = hl[512 + cc], a2 = hl[1024 + cc]; float mx = fmaxf(a0, fmaxf(a1, a2));
    float e0 = expf(a0 - mx), e1 = expf(a1 - mx), e2 = expf(a2 - mx); lb[cc] = e0 / (e0 + e1 + e2); }
  std::vector<float> wr;
  for (int layer = 0; layer < 2; ++layer) {
    const int PW = layer == 0 ? P_AB : P_CD, PM = layer == 0 ? PM_AB : PM_CD;
    const float* bias = p.in[layer == 0 ? I_AB_B_IN : I_CD_B_IN];
    cpu_round_w(p.in[layer == 0 ? I_AB_W_IN : I_CD_W_IN], (size_t)1024 * PW, wr);
#pragma omp parallel for
    for (long tok = 0; tok < NTOK; ++tok) {
      std::vector<float> acc(PW, 0.f);
      for (int k = 0; k < 1024; ++k) { float a = bf2f(HB[tok * 1024 + k]); const float* w = &wr[(size_t)k * PW]; for (int n = 0; n < PW; ++n) acc[n] += a * w[n]; }
      for (int n = 0; n < PM; ++n) { float v = acc[n] + bias[n]; if (layer == 0) v = epi_ab(n, v, lb); P[tok * PSTRIDE + n] = f2bf(v); }
      for (int n = PM; n < PW; ++n) side[tok * 32 + (n - PM)] = acc[n] + bias[n];
      if (layer == 0) for (int dir = 0; dir < 2; ++dir) for (int cc = 0; cc < 256; ++cc) {
        float z = p.in[I_GK_B][dir * 256 + cc];
        for (int r = 0; r < 16; ++r) z += side[tok * 32 + dir * 16 + r] * p.in[I_GK_UP][(dir * 16 + r) * 256 + cc];
        LFB[tok * 512 + dir * 256 + cc] = f2bf(logsigmoidf_(z) * 0.0625f); }
    }
    if (layer == 0) { ScanAB2 s{}; s.P = P; s.LFB = LFB; s.O = O; run_functor(s, (long)BATCH * 2048); }
    else { PrepCD2 pc{}; pc.P = P; pc.QD = LFB; pc.rope = rope; pc.conv_w = p.in[I_CONV_W]; pc.conv_b = p.in[I_CONV_B]; run_functor(pc, (long)NTOK * 1280);
      ScanCD2 s{}; s.P = P; s.QD = LFB; s.side = side; s.fgate_b = p.in[I_FGATE_B]; s.O = O; s.oside = oside; run_functor(s, (long)BATCH * 2056); }
#pragma omp parallel for
    for (long tok = 0; tok < NTOK; ++tok) for (int h8 = 0; h8 < 8; ++h8) {
      float sf = 1.f, sb = 1.f;
      if (layer == 1 && h8 >= 4) { int h = h8 - 4; const float* s0 = oside + tok * 8 + h * 2; const float* s1 = oside + (size_t)(NTOK + tok) * 8 + h * 2;
        sf = 1.0f / fmaxf(fabsf(s0[0]), expf(-s0[1])); sb = 1.0f / fmaxf(fabsf(s1[0]), expf(-s1[1])); }
      float o[128]; float ss = 0.f;
      for (int j = 0; j < 128; ++j) { int c = h8 * 128 + j; o[j] = bf2f(O[tok * 1024 + c]) * sf + bf2f(O[(size_t)(NTOK + tok) * 1024 + c]) * sb; ss += o[j] * o[j]; }
      float r = 1.0f / sqrtf(ss * (1.0f / 128.0f) + NORM_EPS_F);
      for (int j = 0; j < 128; ++j) { int c = h8 * 128 + j; float gn, gt;
        if (layer == 0) { gn = h8 < 4 ? p.in[I_HGRN_NORM][c] : p.in[I_GLA_NORM][c - 512]; gt = siluf_(bf2f(P[tok * PSTRIDE + (h8 < 4 ? 2048 + c : 3584 + c - 512)])); }
        else { gn = h8 < 4 ? p.in[I_RET_NORM][c] : p.in[I_MLSTM_NORM][c - 512]; float gr = bf2f(P[tok * PSTRIDE + (h8 < 4 ? 1024 + c : 3072 + c - 512)]); gt = h8 < 4 ? siluf_(gr) : sigmoidf_(gr); }
        HB[tok * 1024 + c] = f2bf(o[j] * r * gn * gt); }
    }
    cpu_round_w(p.in[layer == 0 ? I_AB_W_OUT : I_CD_W_OUT], (size_t)1024 * 1024, wr);
#pragma omp parallel for
    for (long tok = 0; tok < NTOK; ++tok) { std::vector<float> acc(1024, 0.f);
      for (int k = 0; k < 1024; ++k) { float a = bf2f(HB[tok * 1024 + k]); const float* w = &wr[(size_t)k * 1024]; for (int n = 0; n < 1024; ++n) acc[n] += a * w[n]; }
      for (int n = 0; n < 1024; ++n) yf[tok * 1024 + n] = acc[n]; }
    dbg_cmp(layer == 0 ? "y_mix0" : "y_mix1", yf, (long)NTOK * 1024);
    int cnt[NEXP] = {0}; std::vector<int> list((size_t)NEXP * NTOK);
    const float* hin = layer == 0 ? p.in[I_X] : p.out;
    for (long tok = 0; tok < NTOK; ++tok) {
      float v[1024]; double s = 0; for (int c = 0; c < 1024; ++c) { v[c] = ALPHA_F * hin[tok * 1024 + c] + yf[tok * 1024 + c]; s += v[c]; }
      float mean = (float)(s / 1024); double q = 0; for (int c = 0; c < 1024; ++c) { v[c] -= mean; q += (double)v[c] * v[c]; }
      float r = 1.0f / sqrtf((float)(q / 1024) + LN_EPS_F);
      float lg[16] = {0};
      for (int c = 0; c < 1024; ++c) { v[c] = v[c] * r * p.in[I_LN_MIX_G][layer * 1024 + c] + p.in[I_LN_MIX_B][layer * 1024 + c]; p.out[tok * 1024 + c] = v[c]; HB[tok * 1024 + c] = f2bf(v[c]);
        for (int e = 0; e < 16; ++e) lg[e] += v[c] * p.in[I_ROUTER_W][c * 16 + e]; }
      int eo[2]; float go[2]; route_from_logits(lg, p.in[I_ROUTER_B], eo, go);
      int r1 = cnt[eo[0]]++, r2 = cnt[eo[1]]++;
      list[(size_t)eo[0] * NTOK + r1] = (int)tok; list[(size_t)eo[1] * NTOK + r2] = (int)tok;
      assign[tok * 4] = eo[0]; assign[tok * 4 + 1] = r1; assign[tok * 4 + 2] = eo[1]; assign[tok * 4 + 3] = r2; gate[tok * 2] = go[0]; gate[tok * 2 + 1] = go[1];
    }
    dbg_cmp(layer == 0 ? "h_mix0" : "h_mix1", p.out, (long)NTOK * 1024);
    int pad[NEXP]; { int a = 0; for (int e = 0; e < NEXP; ++e) { pad[e] = a; a += ((cnt[e] + 255) >> 8) << 8; } }
    const size_t lo = (size_t)layer * NEXP * 1024 * 1024;
    for (int e = 0; e < NEXP; ++e) {
      std::vector<float> w1, w3, w2; cpu_round_w(p.in[I_MOE_W1] + lo + (size_t)e * 1048576, 1048576, w1); cpu_round_w(p.in[I_MOE_W3] + lo + (size_t)e * 1048576, 1048576, w3); cpu_round_w(p.in[I_MOE_W2] + lo + (size_t)e * 1048576, 1048576, w2);
#pragma omp parallel for
      for (int rr = 0; rr < cnt[e]; ++rr) { int tok = list[(size_t)e * NTOK + rr]; size_t pos = pad[e] + rr;
        std::vector<float> a1(1024, 0.f), a3(1024, 0.f), a2(1024, 0.f);
        for (int k = 0; k < 1024; ++k) { float a = bf2f(HB[(size_t)tok * 1024 + k]); const float* p1 = &w1[(size_t)k * 1024]; const float* p3 = &w3[(size_t)k * 1024]; for (int n = 0; n < 1024; ++n) { a1[n] += a * p1[n]; a3[n] += a * p3[n]; } }
        for (int n = 0; n < 1024; ++n) H[pos * 1024 + n] = f2bf(siluf_(a1[n]) * a3[n]);
        for (int k = 0; k < 1024; ++k) { float a = bf2f(H[pos * 1024 + k]); const float* p2 = &w2[(size_t)k * 1024]; for (int n = 0; n < 1024; ++n) a2[n] += a * p2[n]; }
        for (int n = 0; n < 1024; ++n) Y[pos * 1024 + n] = f2bf(a2[n]); }
    }
    for (long tok = 0; tok < NTOK; ++tok) {
      size_t p0 = pad[assign[tok * 4]] + assign[tok * 4 + 1], p1 = pad[assign[tok * 4 + 2]] + assign[tok * 4 + 3];
      float v[1024]; double s = 0; for (int c = 0; c < 1024; ++c) { v[c] = ALPHA_F * p.out[tok * 1024 + c] + gate[tok * 2] * bf2f(Y[p0 * 1024 + c]) + gate[tok * 2 + 1] * bf2f(Y[p1 * 1024 + c]); s += v[c]; }
      float mean = (float)(s / 1024); double q = 0; for (int c = 0; c < 1024; ++c) { v[c] -= mean; q += (double)v[c] * v[c]; }
      float r = 1.0f / sqrtf((float)(q / 1024) + LN_EPS_F);
      for (int c = 0; c < 1024; ++c) { v[c] = v[c] * r * p.in[I_LN_FFN_G][layer * 1024 + c] + p.in[I_LN_FFN_B][layer * 1024 + c]; p.out[tok * 1024 + c] = v[c]; HB[tok * 1024 + c] = f2bf(v[c]); }
    }
    dbg_cmp(layer == 0 ? "h_ffn0" : "h_ffn1", p.out, (long)NTOK * 1024);
  }
}
#endif
```

```cpp
#ifdef CPU_EMU
#include <cmath>
#include <cstdio>
#include <cstring>
#include <cstdlib>
#include <cstddef>
#define DEV
#define DEV_INLINE static inline
typedef void* hipStream_t;
#else
#include <hip/hip_runtime.h>
#include <hip/hip_bf16.h>
#include <cstdio>
#define DEV __device__ __forceinline__
#define DEV_INLINE __device__ __forceinline__
#endif
#ifndef PROBE_DUP
#define PROBE_DUP 0
#endif
#ifndef BATCH
#define BATCH 4
#endif
#ifndef SEQ
#define SEQ 8192
#endif
#define DM 1024
#define NTOK (BATCH * SEQ)
#define P_AB 4128
#define P_CD 3600
#define PM_AB 4096
#define PM_CD 3584
#define NEXP 16
#define ALPHA_F 1.4142135623730951f
#define LN_EPS_F 1e-5f
#define NORM_EPS_F 1e-6f
#define HROWS (2 * NTOK + NEXP * 256)

typedef unsigned short bf16_t;

DEV_INLINE float bf2f(bf16_t b) { unsigned u = ((unsigned)b) << 16; float f; memcpy(&f, &u, 4); return f; }
DEV_INLINE bf16_t f2bf(float f) { unsigned u; memcpy(&u, &f, 4); u += 0x7FFFu + ((u >> 16) & 1u); return (bf16_t)(u >> 16); }
DEV_INLINE float sigmoidf_(float x) { return 1.0f / (1.0f + expf(-x)); }
DEV_INLINE float siluf_(float x) { return x / (1.0f + expf(-x)); }
DEV_INLINE float logsigmoidf_(float x) { return fminf(x, 0.0f) - log1pf(expf(-fabsf(x))); }

#define AL256(x) (((size_t)(x) + 255) & ~(size_t)255)
#define WS_CTL    ((size_t)0)
#define WS_HB     ((size_t)65536)
#define WS_R1     (WS_HB + (size_t)NTOK * 1024 * 2)
#define R1_P_BYTES ((size_t)NTOK * 4096 * 2)
#define R1_MIN    (AL256((size_t)HROWS * 1024 * 2) + (size_t)NEXP * 3072 * 1024 * 2)
#define R1_PL     (R1_P_BYTES + (size_t)NTOK * 512 * 2)
#define R1_BYTES  (R1_PL > R1_MIN ? R1_PL : R1_MIN)
#define WS_LFB    (WS_R1 + R1_P_BYTES)
#define WS_H      (WS_R1)
#define WS_WMOE   (WS_R1 + AL256((size_t)HROWS * 1024 * 2))
#define WMOE_BYTES ((size_t)NEXP * 3072 * 1024 * 2)
#define WS_R2     (WS_R1 + R1_BYTES)
#define R2_BYTES  ((size_t)HROWS * 1024 * 2 > (size_t)NTOK * 1024 * 4 ? (size_t)HROWS * 1024 * 2 : (size_t)NTOK * 1024 * 4)
#define WS_SIDE   (WS_R2 + AL256(R2_BYTES))
#define WS_OSIDE  (WS_SIDE + (size_t)NTOK * 32 * 4)
#define WS_WIN_AB (WS_OSIDE + (size_t)2 * NTOK * 8 * 4)
#define WS_WIN_CD (WS_WIN_AB + (size_t)4128 * 1024 * 2)
#define WS_WOUT_AB (WS_WIN_CD + (size_t)3600 * 1024 * 2)
#define WS_WOUT_CD (WS_WOUT_AB + (size_t)1024 * 1024 * 2)
#define WS_ROPE   (WS_WOUT_CD + (size_t)1024 * 1024 * 2)
#define WS_LB     (WS_ROPE + (size_t)SEQ * 64 * 4)
#define WS_LIST   (WS_LB + 4096)
#define WS_ASSIGN (WS_LIST + (size_t)2 * NEXP * NTOK * 4)
#define WS_GATE   (WS_ASSIGN + (size_t)NTOK * 16)
#define WS_END    (WS_GATE + (size_t)NTOK * 8)
#define CW_CNT(layer) (64 + 256 * (layer))

#define PSTRIDE 4096
#define PIDX(tok, col) ((((size_t)((col) >> 7)) * NTOK + (size_t)(tok)) * 128 + (size_t)((col) & 127))

enum { I_X, I_AB_W_IN, I_AB_B_IN, I_HGRN_LB, I_GK_UP, I_GK_B, I_HGRN_NORM, I_GLA_NORM, I_AB_W_OUT,
       I_CD_W_IN, I_CD_B_IN, I_CONV_W, I_CONV_B, I_FGATE_B, I_RET_NORM, I_MLSTM_NORM, I_CD_W_OUT,
       I_LN_MIX_G, I_LN_MIX_B, I_LN_FFN_G, I_LN_FFN_B, I_ROUTER_W, I_ROUTER_B, I_MOE_W1, I_MOE_W3, I_MOE_W2, N_IN };

struct Params {
  const float* in[N_IN];
  float* out;
  unsigned char* ws;
};

DEV_INLINE float epi_ab(int col, float v, const float* lb) {
  if (col < 512) return siluf_(v);
  if (col < 1536) { float l = lb[(col - 512) & 511]; return logf(l + (1.0f - l) * sigmoidf_(v)); }
  if (col >= 2560 && col < 2816) return v * 0.125f;
  return v;
}

DEV_INLINE void route_from_logits(const float* lg, const float* rb, int* e_out, float* g_out) {
  float mx = lg[0];
#pragma unroll
  for (int e = 1; e < 16; ++e) mx = fmaxf(mx, lg[e]);
  float sc[16]; float sum = 0.f;
#pragma unroll
  for (int e = 0; e < 16; ++e) { sc[e] = expf(lg[e] - mx); sum += sc[e]; }
  float inv = 1.0f / sum;
  float best_gs = -1e30f; int be1 = 0, be2 = 1; float bs1 = 0.f, bs2 = 0.f;
#pragma unroll
  for (int gq = 0; gq < 4; ++gq) {
    float m1 = -1e30f, m2 = -1e30f, s1 = 0.f, s2 = 0.f; int i1 = 0, i2 = 0;
#pragma unroll
    for (int i = 0; i < 4; ++i) {
      float s = sc[gq * 4 + i] * inv; float v = s + rb[gq * 4 + i];
      if (v > m1) { m2 = m1; i2 = i1; s2 = s1; m1 = v; i1 = gq * 4 + i; s1 = s; }
      else if (v > m2) { m2 = v; i2 = gq * 4 + i; s2 = s; }
    }
    float gs = m1 + m2;
    if (gs > best_gs) { best_gs = gs; be1 = i1; be2 = i2; bs1 = s1; bs2 = s2; }
  }
  e_out[0] = be1; e_out[1] = be2; g_out[0] = bs1 / (bs1 + bs2); g_out[1] = bs2 / (bs1 + bs2);
}
struct ScanAB2 {
  const bf16_t* P; const bf16_t* LFB; bf16_t* O;
  DEV void operator()(long gid) const {
    int j = (int)(gid & 127), h = (int)((gid >> 7) & 3), dir = (int)((gid >> 9) & 1), mixer = (int)((gid >> 10) & 1), b = (int)(gid >> 11);
    bf16_t* Od = O + (size_t)dir * NTOK * 1024;
    if (mixer == 0) {
      float S[128];
#pragma unroll
      for (int d = 0; d < 128; ++d) S[d] = 0.f;
      for (int s = 0; s < SEQ; ++s) {
        size_t t = (size_t)b * SEQ + (dir ? (SEQ - 1 - s) : s);
        const bf16_t* row = P + t * PSTRIDE;
        const bf16_t* q = row + h * 128; const bf16_t* lf = row + 512 + dir * 512 + h * 128;
        float v = bf2f(row[1536 + h * 128 + j]);
        float o = 0.f;
#pragma unroll
        for (int d = 0; d < 128; ++d) { float fd = expf(bf2f(lf[d])); S[d] = fd * S[d] + (1.0f - fd) * v; o += bf2f(q[d]) * S[d]; }
        Od[t * 1024 + h * 128 + j] = f2bf(o);
      }
    } else {
      float S[64];
#pragma unroll
      for (int d = 0; d < 64; ++d) S[d] = 0.f;
      for (int s = 0; s < SEQ; ++s) {
        size_t t = (size_t)b * SEQ + (dir ? (SEQ - 1 - s) : s);
        const bf16_t* row = P + t * PSTRIDE;
        const bf16_t* q = row + 2560 + h * 64; const bf16_t* k = row + 2816 + h * 64;
        const bf16_t* lf = LFB + t * 512 + dir * 256 + h * 64;
        float v = bf2f(row[3072 + h * 128 + j]);
        float o = 0.f;
#pragma unroll
        for (int d = 0; d < 64; ++d) { S[d] = expf(bf2f(lf[d])) * S[d] + bf2f(k[d]) * v; o += bf2f(q[d]) * S[d]; }
        Od[t * 1024 + 512 + h * 128 + j] = f2bf(o);
      }
    }
  }
};

struct PrepCD2 {
  bf16_t* P; bf16_t* QD; const float* rope; const float* conv_w; const float* conv_b;
  DEV void operator()(long gid) const {
    size_t tok = (size_t)(gid / 1280); int c = (int)(gid % 1280); int t = (int)(tok % SEQ);
    bf16_t* row = P + tok * PSTRIDE;
    if (c < 256) {
      int isk = c >> 7, hh = (c >> 5) & 3, i = c & 31;
      float cs = rope[(t * 32 + i) * 2], sn = rope[(t * 32 + i) * 2 + 1];
      bf16_t* base = row + isk * 256 + hh * 64;
      float a1 = bf2f(base[i]), a2 = bf2f(base[i + 32]);
      float sc = isk ? 1.0f : 0.125f;
      base[i] = f2bf((a1 * cs - a2 * sn) * sc); base[i + 32] = f2bf((a1 * sn + a2 * cs) * sc);
    } else {
      int cc = c - 256;
      float acc = conv_b[cc] + bf2f(row[1536 + cc]) * conv_w[1024 + cc];
      if (t > 0) acc += bf2f(row[1536 + cc - PSTRIDE]) * conv_w[cc];
      if (t < SEQ - 1) acc += bf2f(row[1536 + cc + PSTRIDE]) * conv_w[2048 + cc];
      float s = siluf_(acc);
      if (cc < 512) QD[tok * 512 + cc] = f2bf(s * 0.08838834764831845f);
      else row[3584 + (cc - 512)] = f2bf(s);
    }
  }
};

struct ScanCD2 {
  const bf16_t* P; const bf16_t* QD; const float* side; const float* fgate_b; bf16_t* O; float* oside;
  DEV void operator()(long gid) const {
    int b = (int)(gid / 2056); int g = (int)(gid % 2056);
    if (g < 1024) {
      int j = g & 127, h = (g >> 7) & 3, dir = (g >> 9) & 1;
      bf16_t* Od = O + (size_t)dir * NTOK * 1024;
      float gamma = 1.0f - exp2f(-(5.0f + 2.0f * (float)h + (float)dir));
      float S[64];
#pragma unroll
      for (int d = 0; d < 64; ++d) S[d] = 0.f;
      for (int s = 0; s < SEQ; ++s) {
        size_t t = (size_t)b * SEQ + (dir ? (SEQ - 1 - s) : s);
        const bf16_t* row = P + t * PSTRIDE;
        const bf16_t* q = row + h * 64; const bf16_t* k = row + 256 + h * 64;
        float v = bf2f(row[512 + h * 128 + j]);
        float o = 0.f;
#pragma unroll
        for (int d = 0; d < 64; ++d) { S[d] = gamma * S[d] + bf2f(k[d]) * v; o += bf2f(q[d]) * S[d]; }
        Od[t * 1024 + h * 128 + j] = f2bf(o);
      }
    } else {
      g -= 1024;
      int j = g % 129, h = (g / 129) & 3, dir = g / (129 * 4);
      bf16_t* Od = O + (size_t)dir * NTOK * 1024; float* os = oside + (size_t)dir * NTOK * 8;
      float fb = fgate_b[dir * 4 + h];
      float S[128];
#pragma unroll
      for (int d = 0; d < 128; ++d) S[d] = 0.f;
      float m = 0.f;
      for (int s = 0; s < SEQ; ++s) {
        size_t t = (size_t)b * SEQ + (dir ? (SEQ - 1 - s) : s);
        const bf16_t* row = P + t * PSTRIDE;
        const bf16_t* q = QD + t * 512 + h * 128; const bf16_t* k = row + 3584 + h * 128;
        float v = (j < 128) ? bf2f(row[2560 + h * 128 + j]) : 1.0f;
        float li = side[t * 32 + dir * 8 + h];
        float lf = logsigmoidf_(side[t * 32 + dir * 8 + 4 + h] + fb);
        float mn = fmaxf(lf + m, li);
        float fs = expf(lf + m - mn), is = expf(li - mn) * v;
        m = mn;
        float o = 0.f;
#pragma unroll
        for (int d = 0; d < 128; ++d) { S[d] = fs * S[d] + is * bf2f(k[d]); o += bf2f(q[d]) * S[d]; }
        if (j < 128) Od[t * 1024 + 512 + h * 128 + j] = f2bf(o);
        else { os[t * 8 + h * 2] = o; os[t * 8 + h * 2 + 1] = m; }
      }
    }
  }
};
#ifndef CPU_EMU
namespace pg8 {
#define PG8_LAS __attribute__((address_space(3)))
typedef short bf16x8 __attribute__((ext_vector_type(8)));
typedef float f32x4 __attribute__((ext_vector_type(4)));
typedef unsigned u32x4 __attribute__((ext_vector_type(4)));
typedef unsigned u32x2 __attribute__((ext_vector_type(2)));
constexpr int BM = 256, BK = 64, HALF = 128, HTB = HALF * BK * 2, STAGE_BYTES = 8 * HTB, NXCD = 8, WGM = 8, GK = 1024;

__device__ __forceinline__ int lds_byte(int r, int c) { const int st = (r >> 4) * 2 + (c >> 5), rr = r & 15, cc = c & 31, ob = rr * 64 + cc * 2; return st * 1024 + (ob ^ (((ob >> 9) & 1) << 5)); }
__device__ __forceinline__ void stage_rc(int b, int& R, int& C) { const int st = b / 1024, sb = b % 1024, swz = sb ^ (((sb >> 9) & 1) << 5); R = (st >> 1) * 16 + swz / 64; C = (st & 1) * 32 + (swz % 64) / 2; }
__device__ __forceinline__ int perm32(int rho) { const int n = rho >> 4, i = rho & 15; return 8 * (i >> 2) + 4 * n + (i & 3); }
__device__ __forceinline__ unsigned cvt_pk_bf16(float lo, float hi) { unsigned r; asm volatile("v_cvt_pk_bf16_f32 %0, %1, %2" : "=v"(r) : "v"(lo), "v"(hi)); return r; }

struct Unit { int pm, pn, e, row0, ne; };

struct StaticOrder {
  int nM, nN, nwg, G, c;
  __device__ void init(int M, int N, int G_, int c_) { nM = M / BM; nN = N / BM; nwg = nM * nN; G = G_; c = c_; }
  __device__ bool next(int i, Unit& u) const {
    const long L = (long)i * G + c; if (L >= nwg) return false;
    int wgid = (int)L; { const int q = nwg / NXCD, r = nwg % NXCD, xcd = wgid % NXCD, off = wgid / NXCD; wgid = (xcd < r ? xcd * (q + 1) : r * (q + 1) + (xcd - r) * q) + off; }
    const int nig = WGM * nN, gid = wgid / nig, fm = gid * WGM, gsz = (nM - fm) < WGM ? (nM - fm) : WGM;
    u.pm = fm + ((wgid % nig) % gsz); u.pn = (wgid % nig) / gsz; u.e = 0; u.row0 = u.pm * BM; u.ne = 0; return true;
  }
};

template <class Prob>
__device__ __forceinline__ void gemm_phase(PG8_LAS unsigned char* lds, const Prob& S, int wv) {
  int wv_ = wv; asm volatile("" : "+s"(wv_));
  int l_; asm volatile("v_mbcnt_lo_u32_b32 %0, -1, 0\n\tv_mbcnt_hi_u32_b32 %0, -1, %0" : "=v"(l_));
  int tid_ = wv_ * 64 + l_;
  const int tid = tid_, wid = __builtin_amdgcn_readfirstlane(tid >> 6), lane = tid & 63, wr = wid >> 2, wc = wid & 3, fr = lane & 15, fq = lane >> 4;
  constexpr int K = GK, nt = K / BK;
  int sR[2], sC[2]; unsigned voffB[2];
#pragma unroll
  for (int i = 0; i < 2; ++i) { int R, C; stage_rc(tid * 16 + i * 8192, R, C); sR[i] = R; sC[i] = C; const int Rb = Prob::PERM ? ((R & ~31) + perm32(R & 31)) : R; voffB[i] = (unsigned)(Rb * K + C) * 2u; }
  const size_t kstep = (size_t)(BK * 2);
  const size_t hstep = (size_t)HALF * K * 2;
  const unsigned ldsw = (unsigned)wid * 1024u;
  const int aoff = lds_byte(wr * 64 + fr, fq * 8), boff = lds_byte(wc * 32 + fr, fq * 8);
#define PG8_SA(b, h) (((b) * 2 + (h)) * HTB)
#define PG8_SB(b, h) ((4 + (b) * 2 + (h)) * HTB)
#define PG8_STAGE(bufoff, gbase, voff) do { _Pragma("unroll") for (int _i = 0; _i < 2; ++_i) \
    __builtin_amdgcn_global_load_lds((const unsigned*)((const char*)(gbase) + (voff)[_i]), (PG8_LAS unsigned*)(lds + (bufoff) + ldsw + _i * 8192), 16, 0, 0); } while (0)
#define PG8_LDA(dst, b, h) do { _Pragma("unroll") for (int m = 0; m < 4; ++m) _Pragma("unroll") for (int k = 0; k < 2; ++k) dst[m][k] = *(const PG8_LAS bf16x8*)(lds + PG8_SA(b, h) + aoff + m * 2048 + k * 1024); } while (0)
#define PG8_LDB(dst, b, h) do { _Pragma("unroll") for (int n = 0; n < 2; ++n) _Pragma("unroll") for (int k = 0; k < 2; ++k) dst[n][k] = *(const PG8_LAS bf16x8*)(lds + PG8_SB(b, h) + boff + n * 2048 + k * 1024); } while (0)
#define PG8_MMA(ai, bj, At, Bt) do { __builtin_amdgcn_s_setprio(1); _Pragma("unroll") for (int m = 0; m < 4; ++m) _Pragma("unroll") for (int n = 0; n < 2; ++n) _Pragma("unroll") for (int k = 0; k < 2; ++k) \
    acc[ai][bj][m][n] = __builtin_amdgcn_mfma_f32_16x16x32_bf16(Bt[n][k], At[m][k], acc[ai][bj][m][n], 0, 0, 0); __builtin_amdgcn_s_setprio(0); } while (0)
#define PG8_WAIT_V(n) asm volatile("s_waitcnt vmcnt(" #n ")" ::: "memory")
#define PG8_WAIT_L(n) asm volatile("s_waitcnt lgkmcnt(" #n ")" ::: "memory")
#define PG8_BAR __builtin_amdgcn_s_barrier()
#define PG8_SCHED __builtin_amdgcn_sched_barrier(0)
  Unit cur, nxt; int ui = 0;
  if (!S.next(0, cur)) return;
  f32x4 acc[2][2][4][2];
#pragma unroll
  for (int a = 0; a < 2; ++a)
#pragma unroll
    for (int b = 0; b < 2; ++b)
#pragma unroll
      for (int m = 0; m < 4; ++m)
#pragma unroll
        for (int n = 0; n < 2; ++n) acc[a][b][m][n] = (f32x4){0.f, 0.f, 0.f, 0.f};
  bf16x8 At[4][2], B0[2][2], B1[2][2];
  unsigned oc0[2], oc1[2], on0[2], on1[2];
#pragma unroll
  for (int i = 0; i < 2; ++i) { oc0[i] = S.a_off(cur, sR[i]) + (unsigned)sC[i] * 2u; oc1[i] = S.a_off(cur, HALF + sR[i]) + (unsigned)sC[i] * 2u; }
  const char* const Ab = S.a_base();
  const char* cB = S.b_base(cur);
  PG8_STAGE(PG8_SB(0, 0), cB, voffB); PG8_STAGE(PG8_SA(0, 0), Ab, oc0); PG8_STAGE(PG8_SB(0, 1), cB + hstep, voffB); PG8_STAGE(PG8_SA(0, 1), Ab, oc1);
  if (wr == 1) PG8_BAR;
  PG8_WAIT_V(4); PG8_BAR;
  PG8_STAGE(PG8_SB(1, 0), cB + kstep, voffB); PG8_STAGE(PG8_SA(1, 0), Ab + kstep, oc0); PG8_STAGE(PG8_SB(1, 1), cB + hstep + kstep, voffB);
  PG8_WAIT_V(6); PG8_BAR;
  for (;;) {
    const bool has_next = S.next(ui + 1, nxt);
    const char* nB = cB;
    if (has_next) {
      nB = S.b_base(nxt);
      int l2_; asm volatile("v_mbcnt_lo_u32_b32 %0, -1, 0\n\tv_mbcnt_hi_u32_b32 %0, -1, %0" : "=v"(l2_));
      const int tid2 = wid * 64 + l2_;
#pragma unroll
      for (int i = 0; i < 2; ++i) { int R, C; stage_rc(tid2 * 16 + i * 8192, R, C); on0[i] = S.a_off(nxt, R) + (unsigned)C * 2u; on1[i] = S.a_off(nxt, HALF + R) + (unsigned)C * 2u; }
    } else {
#pragma unroll
      for (int i = 0; i < 2; ++i) { on0[i] = oc0[i]; on1[i] = oc1[i]; }
    }
    for (int t = 0; t < nt; t += 2) {
      const bool last = (t == nt - 2);
      const char* a1 = Ab + (size_t)(t + 1) * kstep;
      const char* a2 = last ? Ab : Ab + (size_t)(t + 2) * kstep; const char* b2 = last ? nB : cB + (size_t)(t + 2) * kstep;
      const char* a3 = a2 + kstep; const char* b3 = b2 + kstep;
      unsigned o20[2], o21[2];
#pragma unroll
      for (int i = 0; i < 2; ++i) { o20[i] = last ? on0[i] : oc0[i]; o21[i] = last ? on1[i] : oc1[i]; }
      PG8_LDB(B0, 0, 0); PG8_SCHED; PG8_LDA(At, 0, 0); PG8_STAGE(PG8_SA(1, 1), a1, oc1);
      PG8_WAIT_L(8); PG8_BAR; PG8_WAIT_L(0); PG8_MMA(0, 0, At, B0); PG8_BAR; PG8_SCHED;
      PG8_LDB(B1, 0, 1); PG8_STAGE(PG8_SB(0, 0), b2, voffB);
      PG8_BAR; PG8_WAIT_L(0); PG8_MMA(0, 1, At, B1); PG8_BAR;
      PG8_LDA(At, 0, 1); PG8_STAGE(PG8_SA(0, 0), a2, o20);
      PG8_BAR; PG8_WAIT_L(0); PG8_MMA(1, 0, At, B0); PG8_BAR; PG8_SCHED;
      PG8_STAGE(PG8_SB(0, 1), b2 + hstep, voffB);
      PG8_WAIT_V(6); PG8_BAR; PG8_MMA(1, 1, At, B1); PG8_BAR;
      PG8_LDB(B0, 1, 0); PG8_SCHED; PG8_LDA(At, 1, 0); PG8_STAGE(PG8_SA(0, 1), a2, o21);
      PG8_WAIT_L(8); PG8_BAR; PG8_WAIT_L(0); PG8_MMA(0, 0, At, B0); PG8_BAR; PG8_SCHED;
      PG8_LDB(B1, 1, 1); PG8_STAGE(PG8_SB(1, 0), b3, voffB);
      PG8_BAR; PG8_WAIT_L(0); PG8_MMA(0, 1, At, B1); PG8_BAR;
      PG8_LDA(At, 1, 1); PG8_STAGE(PG8_SA(1, 0), a3, o20);
      PG8_BAR; PG8_WAIT_L(0); PG8_MMA(1, 0, At, B0); PG8_BAR; PG8_SCHED;
      PG8_STAGE(PG8_SB(1, 1), b3 + hstep, voffB);
      PG8_WAIT_V(6); PG8_BAR; PG8_MMA(1, 1, At, B1); PG8_BAR;
    }
    { int l3_; asm volatile("v_mbcnt_lo_u32_b32 %0, -1, 0\n\tv_mbcnt_hi_u32_b32 %0, -1, %0" : "=v"(l3_));
      S.epi(acc, cur, wr, wc, l3_ & 15, l3_ >> 4); }
    if (!has_next) break;
#pragma unroll
    for (int a = 0; a < 2; ++a)
#pragma unroll
      for (int b = 0; b < 2; ++b)
#pragma unroll
        for (int m = 0; m < 4; ++m)
#pragma unroll
          for (int n = 0; n < 2; ++n) acc[a][b][m][n] = (f32x4){0.f, 0.f, 0.f, 0.f};
    cur = nxt; cB = nB; ++ui;
#pragma unroll
    for (int i = 0; i < 2; ++i) { oc0[i] = on0[i]; oc1[i] = on1[i]; }
  }
  PG8_WAIT_V(0);
  if (wr == 0) PG8_BAR;
  PG8_BAR;
#undef PG8_SA
#undef PG8_SB
#undef PG8_STAGE
#undef PG8_LDA
#undef PG8_LDB
#undef PG8_MMA
#undef PG8_WAIT_V
#undef PG8_WAIT_L
#undef PG8_BAR
#undef PG8_SCHED
}
}
#endif
#ifndef CPU_EMU
#include <hip/hip_cooperative_groups.h>
namespace cg = cooperative_groups;
#define LAS __attribute__((address_space(3)))
#define NTHREADS 512
#define LDS_BYTES (154 * 1024)
typedef float f32x4 __attribute__((ext_vector_type(4)));
typedef short bf16x8 __attribute__((ext_vector_type(8)));
typedef unsigned u32x4 __attribute__((ext_vector_type(4)));
typedef unsigned u32x2 __attribute__((ext_vector_type(2)));

struct Ctx { int tid, lane, wid, G, bid; unsigned char* lds; };
__device__ __forceinline__ int lane_id() { int l; asm volatile("v_mbcnt_lo_u32_b32 %0, -1, 0\n\tv_mbcnt_hi_u32_b32 %0, -1, %0" : "=v"(l)); return l; }
__device__ __forceinline__ int opaque_tid(int wv) { int w = wv; asm volatile("" : "+s"(w)); int t = w * 64 + lane_id(); asm volatile("" : "+v"(t)); return t; }
__device__ __forceinline__ Ctx make_ctx(unsigned char* lds, int wv) { Ctx c; c.tid = opaque_tid(wv); c.lane = c.tid & 63; c.wid = __builtin_amdgcn_readfirstlane(c.tid >> 6); c.G = gridDim.x; c.bid = blockIdx.x; c.lds = lds; return c; }

__device__ __forceinline__ float wave_sum(float x) {
  x += __builtin_bit_cast(float, __builtin_amdgcn_update_dpp(0, __builtin_bit_cast(int, x), 0x111, 0xf, 0xf, false));
  x += __builtin_bit_cast(float, __builtin_amdgcn_update_dpp(0, __builtin_bit_cast(int, x), 0x112, 0xf, 0xf, false));
  x += __builtin_bit_cast(float, __builtin_amdgcn_update_dpp(0, __builtin_bit_cast(int, x), 0x114, 0xf, 0xf, false));
  x += __builtin_bit_cast(float, __builtin_amdgcn_update_dpp(0, __builtin_bit_cast(int, x), 0x118, 0xf, 0xf, false));
  x += __builtin_bit_cast(float, __builtin_amdgcn_update_dpp(0, __builtin_bit_cast(int, x), 0x142, 0xa, 0xf, false));
  x += __builtin_bit_cast(float, __builtin_amdgcn_update_dpp(0, __builtin_bit_cast(int, x), 0x143, 0xc, 0xf, false));
  return __builtin_bit_cast(float, __builtin_amdgcn_readlane(__builtin_bit_cast(int, x), 63));
}
__device__ __forceinline__ float fsigmoid(float x) { return __builtin_amdgcn_rcpf(1.0f + __builtin_amdgcn_exp2f(-1.4426950408889634f * x)); }
__device__ __forceinline__ float fsilu(float x) { return x * fsigmoid(x); }
typedef float f32x2_t __attribute__((ext_vector_type(2)));
typedef __bf16 bf16x2_t __attribute__((ext_vector_type(2)));
__device__ __forceinline__ unsigned pk_hw(float a, float b) { const f32x2_t v = {a, b}; return __builtin_bit_cast(unsigned, __builtin_convertvector(v, bf16x2_t)); }
__device__ __forceinline__ unsigned pk2(float a, float b) { return pk_hw(a, b); }
__device__ __forceinline__ void unpack8(u32x4 w, float* f) {
  f[0] = __uint_as_float(w.x << 16); f[1] = __uint_as_float(w.x & 0xffff0000u); f[2] = __uint_as_float(w.y << 16); f[3] = __uint_as_float(w.y & 0xffff0000u);
  f[4] = __uint_as_float(w.z << 16); f[5] = __uint_as_float(w.z & 0xffff0000u); f[6] = __uint_as_float(w.w << 16); f[7] = __uint_as_float(w.w & 0xffff0000u);
}

__device__ __forceinline__ void transpose_job(const Ctx& c, const float* src, int N, bf16_t* dst, int rs, int ro, int tile0, int tile_stride) {
  float* t = (float*)c.lds;
  const int ntn = (N + 63) / 64, ntiles = ntn * 16;
  for (int tl = tile0; tl < ntiles; tl += tile_stride) {
    const int kt = tl / ntn, nt_ = tl % ntn, k0 = kt * 64, n0 = nt_ * 64;
    __syncthreads();
#pragma unroll
    for (int i = 0; i < 8; ++i) { const int idx = c.tid + i * 512, kk = idx >> 6, nn = idx & 63; t[kk * 65 + nn] = (n0 + nn < N) ? src[(size_t)(k0 + kk) * N + n0 + nn] : 0.f; }
    __syncthreads();
#pragma unroll
    for (int i = 0; i < 4; ++i) { const int idx = c.tid + i * 512, nn = idx >> 5, kp = (idx & 31) * 2;
      if (n0 + nn < N) *(unsigned*)(dst + (size_t)((n0 + nn) * rs + ro) * 1024 + k0 + kp) = pk2(t[kp * 65 + nn], t[(kp + 1) * 65 + nn]); }
  }
  __syncthreads();
}
__device__ __forceinline__ void p0_prologue(unsigned char* lds_, int wv, const Params& p) {
  const Ctx c = make_ctx(lds_, wv);
  unsigned char* ws = p.ws;
  if (c.bid == 0) { ((unsigned*)(ws + WS_CTL))[64 + c.tid] = 0u; }
  if (c.bid == 0 && c.tid == 0) ((unsigned*)(ws + WS_CTL))[1024] = 0u;
  { const float* x = p.in[I_X]; bf16_t* hb = (bf16_t*)(ws + WS_HB);
    for (size_t i = (size_t)c.bid * NTHREADS + c.tid; i < (size_t)NTOK * 1024 / 8; i += (size_t)c.G * NTHREADS) {
      const f32x4 a = *(const f32x4*)(x + i * 8), b = *(const f32x4*)(x + i * 8 + 4);
      u32x4 w; w.x = pk2(a[0], a[1]); w.y = pk2(a[2], a[3]); w.z = pk2(b[0], b[1]); w.w = pk2(b[2], b[3]);
      *(u32x4*)(hb + i * 8) = w; } }
  transpose_job(c, p.in[I_AB_W_IN], P_AB, (bf16_t*)(ws + WS_WIN_AB), 1, 0, c.bid, c.G);
  transpose_job(c, p.in[I_CD_W_IN], P_CD, (bf16_t*)(ws + WS_WIN_CD), 1, 0, c.bid, c.G);
  transpose_job(c, p.in[I_AB_W_OUT], 1024, (bf16_t*)(ws + WS_WOUT_AB), 1, 0, c.bid, c.G);
  transpose_job(c, p.in[I_CD_W_OUT], 1024, (bf16_t*)(ws + WS_WOUT_CD), 1, 0, c.bid, c.G);
  { float* rope = (float*)(ws + WS_ROPE);
    for (int i = c.bid * NTHREADS + c.tid; i < SEQ * 32; i += c.G * NTHREADS) { const int t = i >> 5, f = i & 31;
      const float freq = powf(10000.0f, -(float)f / 32.0f); const float ang = (float)t * freq; rope[i * 2] = cosf(ang); rope[i * 2 + 1] = sinf(ang); }
    if (c.bid == 1) { const float* hl = p.in[I_HGRN_LB]; float* lb = (float*)(ws + WS_LB);
      const int cc = c.tid; const float a0 = hl[cc], a1 = hl[512 + cc], a2 = hl[1024 + cc]; const float mx = fmaxf(a0, fmaxf(a1, a2));
      const float e0 = expf(a0 - mx), e1 = expf(a1 - mx), e2 = expf(a2 - mx); lb[cc] = e0 / (e0 + e1 + e2); } }
}
__device__ __forceinline__ void moe_weight_convert(unsigned char* lds_, int wv, const Params& p, int layer) {
  const Ctx c = make_ctx(lds_, wv);
  bf16_t* w13 = (bf16_t*)(p.ws + WS_WMOE); bf16_t* w2 = w13 + (size_t)NEXP * 2048 * 1024;
  const size_t lo = (size_t)layer * NEXP * 1024 * 1024;
  for (int e = 0; e < NEXP; ++e) {
    const size_t mo = lo + (size_t)e * 1024 * 1024;
    transpose_job(c, p.in[I_MOE_W1] + mo, 1024, w13 + (size_t)e * 2048 * 1024, 2, 0, c.bid, c.G);
    transpose_job(c, p.in[I_MOE_W3] + mo, 1024, w13 + (size_t)e * 2048 * 1024, 2, 1, c.bid, c.G);
    transpose_job(c, p.in[I_MOE_W2] + mo, 1024, w2 + (size_t)e * 1024 * 1024, 1, 0, c.bid, c.G);
  }
}

struct ProbInProj {
  static constexpr bool PERM = true;
  pg8::StaticOrder so; const char* A; const char* Bt; bf16_t* P; const float* bias; const float* lb; int layer;
  __device__ __forceinline__ bool next(int i, pg8::Unit& u) const { return so.next(i, u); }
  __device__ __forceinline__ const char* a_base() const { return A; }
  __device__ __forceinline__ unsigned a_off(const pg8::Unit& u, int r) const { return (unsigned)(u.pm * 256 + r) * 2048u; }
  __device__ __forceinline__ const char* b_base(const pg8::Unit& u) const { return Bt + (size_t)u.pn * 256 * 2048; }
  __device__ __forceinline__ void epi(const f32x4 (&acc)[2][2][4][2], const pg8::Unit& u, int wr, int wc, int fr, int fq) const {
    const int row0 = u.row0 + wr * 64 + fr, colb = u.pn * 256 + wc * 32 + 8 * fq;
    int mode = 0;
    if (layer == 0) { mode = u.pn < 2 ? 1 : (u.pn < 6 ? 2 : (u.pn == 10 ? 3 : 0)); }
#pragma unroll
    for (int bj = 0; bj < 2; ++bj) {
      const int col0 = colb + bj * 128;
      const f32x4 b0 = *(const f32x4*)(bias + col0), b1 = *(const f32x4*)(bias + col0 + 4);
      f32x4 l0 = (f32x4){0.f, 0.f, 0.f, 0.f}, l1 = l0;
      if (mode == 2) { l0 = *(const f32x4*)(lb + ((col0 - 512) & 511)); l1 = *(const f32x4*)(lb + ((col0 - 512) & 511) + 4); }
#pragma unroll
      for (int ai = 0; ai < 2; ++ai)
#pragma unroll
        for (int m = 0; m < 4; ++m) {
          f32x4 v0 = acc[ai][bj][m][0] + b0, v1 = acc[ai][bj][m][1] + b1;
          if (mode == 1) {
#pragma unroll
            for (int j = 0; j < 4; ++j) { v0[j] = fsilu(v0[j]); v1[j] = fsilu(v1[j]); }
          } else if (mode == 2) {
#pragma unroll
            for (int j = 0; j < 4; ++j) { v0[j] = __builtin_amdgcn_logf(l0[j] + (1.0f - l0[j]) * fsigmoid(v0[j])); v1[j] = __builtin_amdgcn_logf(l1[j] + (1.0f - l1[j]) * fsigmoid(v1[j])); }
          } else if (mode == 3) { v0 *= 0.125f; v1 *= 0.125f; }
          u32x4 w; w.x = pk2(v0[0], v0[1]); w.y = pk2(v0[2], v0[3]); w.z = pk2(v1[0], v1[1]); w.w = pk2(v1[2], v1[3]);
          *(u32x4*)(P + PIDX(row0 + ai * 128 + m * 16, col0)) = w;
        }
    }
  }
};
struct ProbOutProj {
  static constexpr bool PERM = false;
  pg8::StaticOrder so; const char* A; const char* Bt; float* Y;
  __device__ __forceinline__ bool next(int i, pg8::Unit& u) const { return so.next(i, u); }
  __device__ __forceinline__ const char* a_base() const { return A; }
  __device__ __forceinline__ unsigned a_off(const pg8::Unit& u, int r) const { return (unsigned)(u.pm * 256 + r) * 2048u; }
  __device__ __forceinline__ const char* b_base(const pg8::Unit& u) const { return Bt + (size_t)u.pn * 256 * 2048; }
  __device__ __forceinline__ void epi(const f32x4 (&acc)[2][2][4][2], const pg8::Unit& u, int wr, int wc, int fr, int fq) const {
    const int row0 = u.row0 + wr * 64 + fr, col0 = u.pn * 256 + wc * 32 + 4 * fq;
#pragma unroll
    for (int ai = 0; ai < 2; ++ai)
#pragma unroll
      for (int m = 0; m < 4; ++m) { float* rowp = Y + (size_t)(row0 + ai * 128 + m * 16) * 1024 + col0;
#pragma unroll
        for (int bj = 0; bj < 2; ++bj)
#pragma unroll
          for (int n = 0; n < 2; ++n) *(f32x4*)(rowp + bj * 128 + n * 16) = acc[ai][bj][m][n]; }
  }
};
#define MOE_TAB_OFF (128 * 1024)
struct MoeOrder {
  const int* tab;
  __device__ __forceinline__ void init(const int* cnt, int ntn, int G, int c, unsigned char* lds, int wv) {
    int* t = (int*)(lds + MOE_TAB_OFF);
    const int tid = opaque_tid(wv);
    if (tid < 64) {
      int L = tid * G + c, pad = 0, found = 0, ue = 0, upn = 0, upm = 0, urow = 0, une = 0;
      for (int e = 0; e < NEXP; ++e) { const int n = cnt[e * 16], mt = (n + 255) >> 8, tiles = mt * ntn;
        if (!found && L < tiles) { ue = e; upn = L / mt; upm = L % mt; urow = pad + upm * 256; une = n; found = 1; }
        if (!found) { L -= tiles; pad += mt * 256; } }
      t[tid * 8 + 0] = found; t[tid * 8 + 1] = ue; t[tid * 8 + 2] = upn; t[tid * 8 + 3] = upm; t[tid * 8 + 4] = urow; t[tid * 8 + 5] = une;
    }
    __syncthreads();
    tab = t;
  }
  __device__ __forceinline__ bool next(int i, pg8::Unit& u) const {
    if (i >= 64) return false;
    const int* t = tab + i * 8;
    if (!__builtin_amdgcn_readfirstlane(t[0])) return false;
    u.e = __builtin_amdgcn_readfirstlane(t[1]); u.pn = __builtin_amdgcn_readfirstlane(t[2]); u.pm = __builtin_amdgcn_readfirstlane(t[3]);
    u.row0 = __builtin_amdgcn_readfirstlane(t[4]); u.ne = __builtin_amdgcn_readfirstlane(t[5]); return true;
  }
};
struct ProbMoe1 {
  static constexpr bool PERM = true;
  MoeOrder mo; const char* A; const char* W13; const int* list; bf16_t* H;
  __device__ __forceinline__ bool next(int i, pg8::Unit& u) const { return mo.next(i, u); }
  __device__ __forceinline__ const char* a_base() const { return A; }
  __device__ __forceinline__ unsigned a_off(const pg8::Unit& u, int r) const { const int rr = u.pm * 256 + r; const int tok = rr < u.ne ? list[u.e * NTOK + rr] : 0; return (unsigned)tok * 2048u; }
  __device__ __forceinline__ const char* b_base(const pg8::Unit& u) const { return W13 + ((size_t)u.e * 2048 + (size_t)u.pn * 256) * 2048; }
  __device__ __forceinline__ void epi(const f32x4 (&acc)[2][2][4][2], const pg8::Unit& u, int wr, int wc, int fr, int fq) const {
    const int row0 = u.row0 + wr * 64 + fr, colb = u.pn * 128 + wc * 16 + 4 * fq;
#pragma unroll
    for (int ai = 0; ai < 2; ++ai)
#pragma unroll
      for (int m = 0; m < 4; ++m)
#pragma unroll
        for (int bj = 0; bj < 2; ++bj) {
          const f32x4 v0 = acc[ai][bj][m][0], v1 = acc[ai][bj][m][1];
          u32x2 w; w.x = pk2(fsilu(v0[0]) * v0[1], fsilu(v0[2]) * v0[3]); w.y = pk2(fsilu(v1[0]) * v1[1], fsilu(v1[2]) * v1[3]);
          *(u32x2*)(H + (size_t)(row0 + ai * 128 + m * 16) * 1024 + colb + bj * 64) = w;
        }
  }
};
struct ProbMoe2 {
  static constexpr bool PERM = true;
  MoeOrder mo; const char* A; const char* W2; bf16_t* Y;
  __device__ __forceinline__ bool next(int i, pg8::Unit& u) const { return mo.next(i, u); }
  __device__ __forceinline__ const char* a_base() const { return A; }
  __device__ __forceinline__ unsigned a_off(const pg8::Unit& u, int r) const { return (unsigned)(u.row0 + r) * 2048u; }
  __device__ __forceinline__ const char* b_base(const pg8::Unit& u) const { return W2 + ((size_t)u.e * 1024 + (size_t)u.pn * 256) * 2048; }
  __device__ __forceinline__ void epi(const f32x4 (&acc)[2][2][4][2], const pg8::Unit& u, int wr, int wc, int fr, int fq) const {
    const int row0 = u.row0 + wr * 64 + fr, colb = u.pn * 256 + wc * 32 + 8 * fq;
#pragma unroll
    for (int ai = 0; ai < 2; ++ai)
#pragma unroll
      for (int m = 0; m < 4; ++m)
#pragma unroll
        for (int bj = 0; bj < 2; ++bj) {
          const f32x4 v0 = acc[ai][bj][m][0], v1 = acc[ai][bj][m][1];
          u32x4 w; w.x = pk2(v0[0], v0[1]); w.y = pk2(v0[2], v0[3]); w.z = pk2(v1[0], v1[1]); w.w = pk2(v1[2], v1[3]);
          *(u32x4*)(Y + (size_t)(row0 + ai * 128 + m * 16) * 1024 + colb + bj * 128) = w;
        }
  }
};

template <int NS>
__device__ __forceinline__ void side_phase(unsigned char* lds_, int wv, const Params& p, int layer) {
  const Ctx c = make_ctx(lds_, wv);
  const bf16_t* hb = (const bf16_t*)(p.ws + WS_HB);
  const bf16_t* wt = (const bf16_t*)(p.ws + (layer == 0 ? WS_WIN_AB : WS_WIN_CD)) + (size_t)(layer == 0 ? PM_AB : PM_CD) * 1024;
  const float* bias = p.in[layer == 0 ? I_AB_B_IN : I_CD_B_IN] + (layer == 0 ? PM_AB : PM_CD);
  float* side = (float*)(p.ws + WS_SIDE);
  float* tl = (float*)c.lds + c.wid * (16 * 33);
  const int fr = c.lane & 15, fq = c.lane >> 4;
  for (int g = c.bid * 8 + c.wid; g < NTOK / 16; g += c.G * 8) {
    const int r0 = g * 16;
    f32x4 acc0 = (f32x4){0.f, 0.f, 0.f, 0.f}, acc1 = acc0;
    const bf16_t* ap = hb + (size_t)(r0 + fr) * 1024 + fq * 8;
    const bf16_t* bp0 = wt + (size_t)fr * 1024 + fq * 8; const bf16_t* bp1 = bp0 + 16 * 1024;
#pragma unroll 4
    for (int k = 0; k < 1024; k += 32) {
      const bf16x8 a = *(const bf16x8*)(ap + k), b0 = *(const bf16x8*)(bp0 + k);
      acc0 = __builtin_amdgcn_mfma_f32_16x16x32_bf16(a, b0, acc0, 0, 0, 0);
      if (NS == 32) { const bf16x8 b1 = *(const bf16x8*)(bp1 + k); acc1 = __builtin_amdgcn_mfma_f32_16x16x32_bf16(a, b1, acc1, 0, 0, 0); }
    }
#pragma unroll
    for (int j = 0; j < 4; ++j) { const float v0 = acc0[j] + bias[fr]; side[(size_t)(r0 + fq * 4 + j) * 32 + fr] = v0; tl[(fq * 4 + j) * 33 + fr] = v0;
      if (NS == 32) { const float v1 = acc1[j] + bias[16 + fr]; side[(size_t)(r0 + fq * 4 + j) * 32 + 16 + fr] = v1; tl[(fq * 4 + j) * 33 + 16 + fr] = v1; } }
    if (NS == 32) {
      __builtin_amdgcn_s_waitcnt(0xC07F);
      const float* gu = p.in[I_GK_UP]; const float* gb = p.in[I_GK_B]; bf16_t* lfb = (bf16_t*)(p.ws + WS_LFB);
      const int cb = c.lane * 8, dir = cb >> 8, cc = cb & 255;
      float w[16][8];
#pragma unroll
      for (int r = 0; r < 16; ++r)
#pragma unroll
        for (int j = 0; j < 8; ++j) w[r][j] = gu[(dir * 16 + r) * 256 + cc + j];
      float bb[8];
#pragma unroll
      for (int j = 0; j < 8; ++j) bb[j] = gb[dir * 256 + cc + j];
      constexpr float LFS = 0.0625f * 1.4426950408889634f;
      for (int row = 0; row < 16; ++row) {
        float z[8];
#pragma unroll
        for (int j = 0; j < 8; ++j) z[j] = bb[j];
#pragma unroll
        for (int r = 0; r < 16; ++r) { const float s = tl[row * 33 + dir * 16 + r];
#pragma unroll
          for (int j = 0; j < 8; ++j) z[j] += s * w[r][j]; }
        u32x4 o; o.x = pk2(logsigmoidf_(z[0]) * LFS, logsigmoidf_(z[1]) * LFS); o.y = pk2(logsigmoidf_(z[2]) * LFS, logsigmoidf_(z[3]) * LFS);
        o.z = pk2(logsigmoidf_(z[4]) * LFS, logsigmoidf_(z[5]) * LFS); o.w = pk2(logsigmoidf_(z[6]) * LFS, logsigmoidf_(z[7]) * LFS);
        *(u32x4*)(lfb + PIDX(r0 + row, cb)) = o;
      }
    }
  }
}

__device__ __forceinline__ void headnorm_phase(unsigned char* lds_, int wv, const Params& p, int layer) {
  const Ctx c = make_ctx(lds_, wv);
  const bf16_t* P = (const bf16_t*)(p.ws + WS_R1); const bf16_t* O = (const bf16_t*)(p.ws + WS_R2);
  bf16_t* mixed = (bf16_t*)(p.ws + WS_HB);
  const int c0 = c.lane * 16, h8 = c.lane >> 3;
  const float* gain = layer == 0 ? (h8 < 4 ? p.in[I_HGRN_NORM] + c0 : p.in[I_GLA_NORM] + c0 - 512) : (h8 < 4 ? p.in[I_RET_NORM] + c0 : p.in[I_MLSTM_NORM] + c0 - 512);
  const int gcol = layer == 0 ? (h8 < 4 ? 2048 + c0 : 3584 + c0 - 512) : (h8 < 4 ? 1024 + c0 : 3072 + c0 - 512);
  float gn[16];
#pragma unroll
  for (int j = 0; j < 16; ++j) gn[j] = gain[j];
  for (int tok = c.bid * 8 + c.wid; tok < NTOK; tok += c.G * 8) {
    float of[16], ob[16], gt[16];
    { const u32x4* a = (const u32x4*)(O + PIDX(tok, c0)); unpack8(a[0], of); unpack8(a[1], of + 8);
      const u32x4* b = (const u32x4*)(O + (size_t)NTOK * 1024 + PIDX(tok, c0)); unpack8(b[0], ob); unpack8(b[1], ob + 8);
      const u32x4* g = (const u32x4*)(P + PIDX(tok, gcol)); unpack8(g[0], gt); unpack8(g[1], gt + 8); }
    const float sf = 1.f, sb = 1.f;
    float o[16]; float ss = 0.f;
#pragma unroll
    for (int j = 0; j < 16; ++j) { o[j] = of[j] * sf + ob[j] * sb; ss += o[j] * o[j]; }
    ss += __shfl_xor(ss, 1); ss += __shfl_xor(ss, 2); ss += __shfl_xor(ss, 4);
    const float r = 1.0f / sqrtf(ss * (1.0f / 128.0f) + NORM_EPS_F);
    unsigned w[8];
#pragma unroll
    for (int j = 0; j < 8; ++j) {
      float g0 = gt[2 * j], g1 = gt[2 * j + 1];
      if (layer == 1 && h8 >= 4) { g0 = fsigmoid(g0); g1 = fsigmoid(g1); } else { g0 = fsilu(g0); g1 = fsilu(g1); }
      w[j] = pk2(o[2 * j] * r * gn[2 * j] * g0, o[2 * j + 1] * r * gn[2 * j + 1] * g1);
    }
    u32x4* d = (u32x4*)(mixed + (size_t)tok * 1024 + c0);
    d[0] = (u32x4){w[0], w[1], w[2], w[3]}; d[1] = (u32x4){w[4], w[5], w[6], w[7]};
  }
}

__device__ __forceinline__ void ln_phase(unsigned char* lds_, int wv, const Params& p, int layer, int mode, int dry = 0) {
  const Ctx c = make_ctx(lds_, wv);
  unsigned char* ws = p.ws;
  const float* hin = (mode == 0 && layer == 0) ? p.in[I_X] : p.out;
  float* hout = dry ? (float*)(ws + WS_H) : p.out; bf16_t* hb = (bf16_t*)(ws + WS_HB);
  const float* g = p.in[mode == 0 ? I_LN_MIX_G : I_LN_FFN_G] + layer * 1024; const float* b = p.in[mode == 0 ? I_LN_MIX_B : I_LN_FFN_B] + layer * 1024;
  unsigned* cnt = (unsigned*)(ws + WS_CTL) + CW_CNT(layer);
  int* list = (int*)(ws + WS_LIST) + (size_t)layer * NEXP * NTOK;
  int* assign = (int*)(ws + WS_ASSIGN); float* gate = (float*)(ws + WS_GATE);
  float* rwT = (float*)c.lds;
  int* lcnt = (int*)(c.lds + 65536); int* lbase = lcnt + 16; int* rec = lcnt + 32; float* recg = (float*)(rec + 4 * 2048);
  int pad[NEXP];
  if (mode == 0) { const float* r = p.in[I_ROUTER_W];
    for (int i = c.tid; i < 1024 * 16; i += NTHREADS) rwT[(i & 15) * 1024 + (i >> 4)] = r[i];
    if (c.tid < 16) lcnt[c.tid] = 0;
    __syncthreads(); }
  else { int acc = 0;
#pragma unroll
    for (int e = 0; e < NEXP; ++e) { pad[e] = acc; acc += (((int)cnt[e * 16] + 255) >> 8) << 8; } }
  const int c0 = c.lane * 4;
  float gv[16], bv[16];
#pragma unroll
  for (int q = 0; q < 4; ++q) { const f32x4 t0 = *(const f32x4*)(g + q * 256 + c0), t1 = *(const f32x4*)(b + q * 256 + c0);
#pragma unroll
    for (int j = 0; j < 4; ++j) { gv[4 * q + j] = t0[j]; bv[4 * q + j] = t1[j]; } }
  const int tstride = c.G * 8;
  int it = 0;
  for (int tok0 = c.bid * 8 + c.wid; tok0 < NTOK; tok0 += 2 * tstride, it += 2) {
    float v[2][16];
    float gy0[2], gy1[2];
#pragma unroll
    for (int u = 0; u < 2; ++u) {
      const int tok = tok0 + u * tstride;
      if (tok < NTOK) {
#pragma unroll
        for (int q = 0; q < 4; ++q) { const f32x4 t = *(const f32x4*)(hin + (size_t)tok * 1024 + q * 256 + c0); v[u][4 * q] = ALPHA_F * t[0]; v[u][4 * q + 1] = ALPHA_F * t[1]; v[u][4 * q + 2] = ALPHA_F * t[2]; v[u][4 * q + 3] = ALPHA_F * t[3]; }
        if (mode == 0) {
#pragma unroll
          for (int q = 0; q < 4; ++q) { const f32x4 t = *(const f32x4*)((const float*)(ws + WS_R2) + (size_t)tok * 1024 + q * 256 + c0); v[u][4 * q] += t[0]; v[u][4 * q + 1] += t[1]; v[u][4 * q + 2] += t[2]; v[u][4 * q + 3] += t[3]; }
        } else {
          const int a0 = assign[tok * 4], a1 = assign[tok * 4 + 1], a2 = assign[tok * 4 + 2], a3 = assign[tok * 4 + 3];
          gy0[u] = gate[tok * 2]; gy1[u] = gate[tok * 2 + 1];
          int p0 = 0, p1 = 0;
#pragma unroll
          for (int e = 0; e < NEXP; ++e) { if (e == a0) p0 = pad[e]; if (e == a2) p1 = pad[e]; }
          p0 += a1; p1 += a3;
          const bf16_t* Y = (const bf16_t*)(ws + WS_R2);
#pragma unroll
          for (int q = 0; q < 4; ++q) { const u32x2 y0 = *(const u32x2*)(Y + (size_t)p0 * 1024 + q * 256 + c0), y1 = *(const u32x2*)(Y + (size_t)p1 * 1024 + q * 256 + c0);
            v[u][4 * q] += gy0[u] * __uint_as_float(y0.x << 16) + gy1[u] * __uint_as_float(y1.x << 16); v[u][4 * q + 1] += gy0[u] * __uint_as_float(y0.x & 0xffff0000u) + gy1[u] * __uint_as_float(y1.x & 0xffff0000u);
            v[u][4 * q + 2] += gy0[u] * __uint_as_float(y0.y << 16) + gy1[u] * __uint_as_float(y1.y << 16); v[u][4 * q + 3] += gy0[u] * __uint_as_float(y0.y & 0xffff0000u) + gy1[u] * __uint_as_float(y1.y & 0xffff0000u); }
        }
      } else {
#pragma unroll
        for (int j = 0; j < 16; ++j) v[u][j] = 0.f;
      }
    }
#pragma unroll
    for (int u = 0; u < 2; ++u) {
      const int tok = tok0 + u * tstride;
      float s = 0.f;
#pragma unroll
      for (int j = 0; j < 16; ++j) s += v[u][j];
      const float mean = wave_sum(s) * (1.0f / 1024.0f);
      float qq = 0.f;
#pragma unroll
      for (int j = 0; j < 16; ++j) { v[u][j] -= mean; qq += v[u][j] * v[u][j]; }
      const float r = 1.0f / sqrtf(wave_sum(qq) * (1.0f / 1024.0f) + LN_EPS_F);
#pragma unroll
      for (int j = 0; j < 16; ++j) v[u][j] = v[u][j] * r * gv[j] + bv[j];
      if (tok < NTOK) {
#pragma unroll
        for (int q = 0; q < 4; ++q) *(f32x4*)(hout + (size_t)tok * 1024 + q * 256 + c0) = (f32x4){v[u][4 * q], v[u][4 * q + 1], v[u][4 * q + 2], v[u][4 * q + 3]};
        if (!(mode == 1 && layer == 1) && !dry) {
#pragma unroll
          for (int q = 0; q < 4; ++q) *(u32x2*)(hb + (size_t)tok * 1024 + q * 256 + c0) = (u32x2){pk2(v[u][4 * q], v[u][4 * q + 1]), pk2(v[u][4 * q + 2], v[u][4 * q + 3])}; }
      }
      if (mode == 0) {
        float lg[16];
#pragma unroll
        for (int e = 0; e < 16; ++e) { float a = 0.f;
#pragma unroll
          for (int q = 0; q < 4; ++q) { const f32x4 w = *(const f32x4*)(rwT + e * 1024 + q * 256 + c0); a += v[u][4 * q] * w[0] + v[u][4 * q + 1] * w[1] + v[u][4 * q + 2] * w[2] + v[u][4 * q + 3] * w[3]; }
          lg[e] = a; }
#pragma unroll
        for (int e = 0; e < 16; ++e) lg[e] = wave_sum(lg[e]);
        int eo[2]; float go[2];
        route_from_logits(lg, p.in[I_ROUTER_B], eo, go);
        if (c.lane == 0 && tok < NTOK && !dry) {
          const int r1 = atomicAdd(lcnt + eo[0], 1), r2 = atomicAdd(lcnt + eo[1], 1);
          const int ri = (it + u) * 8 + c.wid;
          rec[ri * 4] = eo[0]; rec[ri * 4 + 1] = r1; rec[ri * 4 + 2] = eo[1]; rec[ri * 4 + 3] = r2; recg[ri * 2] = go[0]; recg[ri * 2 + 1] = go[1];
        }
      }
    }
  }
  if (mode == 0 && !dry) {
    __syncthreads();
    if (c.tid < 16) lbase[c.tid] = (int)atomicAdd(cnt + c.tid * 16, (unsigned)lcnt[c.tid]);
    __syncthreads();
    const int nrec = ((NTOK + c.G * 8 - 1) / (c.G * 8)) * 8;
    for (int ri = c.tid; ri < nrec; ri += NTHREADS) {
      const int tok = c.bid * 8 + (ri & 7) + (ri >> 3) * c.G * 8;
      if (tok < NTOK) {
        const int e1 = rec[ri * 4], e2 = rec[ri * 4 + 2]; const int r1 = rec[ri * 4 + 1] + lbase[e1], r2 = rec[ri * 4 + 3] + lbase[e2];
        list[e1 * NTOK + r1] = tok; list[e2 * NTOK + r2] = tok;
        assign[tok * 4] = e1; assign[tok * 4 + 1] = r1; assign[tok * 4 + 2] = e2; assign[tok * 4 + 3] = r2;
        gate[tok * 2] = recg[ri * 2]; gate[tok * 2 + 1] = recg[ri * 2 + 1];
      }
    }
  }
  __syncthreads();
}
#endif
#ifndef CPU_EMU
namespace scan {
typedef short bf16x8 __attribute__((ext_vector_type(8)));
typedef float f32x4 __attribute__((ext_vector_type(4)));
typedef unsigned u32x4 __attribute__((ext_vector_type(4)));
typedef unsigned u32x2 __attribute__((ext_vector_type(2)));
enum { MIX_A = 0, MIX_B = 1, MIX_C = 2, MIX_D = 3 };
constexpr int LD_T = 144;
constexpr int OFF_QS = 0, OFF_KS = 17408, OFF_QI = 34816, OFF_KT = 52224, OFF_VT = 70656, OFF_SC = 77568, OFF_ST = 86784, OFF_DEC = 99840, OFF_EM = 100352, OFF_DEN = 100608, OFF_CW = 100864, SCAN_LDS = 104960;

__device__ __forceinline__ float incl_scan_add(float x) {
  x += __builtin_bit_cast(float, __builtin_amdgcn_update_dpp(0, __builtin_bit_cast(int, x), 0x111, 0xf, 0xf, false));
  x += __builtin_bit_cast(float, __builtin_amdgcn_update_dpp(0, __builtin_bit_cast(int, x), 0x112, 0xf, 0xf, false));
  x += __builtin_bit_cast(float, __builtin_amdgcn_update_dpp(0, __builtin_bit_cast(int, x), 0x114, 0xf, 0xf, false));
  x += __builtin_bit_cast(float, __builtin_amdgcn_update_dpp(0, __builtin_bit_cast(int, x), 0x118, 0xf, 0xf, false));
  x += __builtin_bit_cast(float, __builtin_amdgcn_update_dpp(0, __builtin_bit_cast(int, x), 0x142, 0xa, 0xf, false));
  x += __builtin_bit_cast(float, __builtin_amdgcn_update_dpp(0, __builtin_bit_cast(int, x), 0x143, 0xc, 0xf, false));
  return x;
}
__device__ __forceinline__ float incl_scan_max(float x) {
  const int ninf = (int)0xff800000u;
  x = fmaxf(x, __builtin_bit_cast(float, __builtin_amdgcn_update_dpp(ninf, __builtin_bit_cast(int, x), 0x111, 0xf, 0xf, false)));
  x = fmaxf(x, __builtin_bit_cast(float, __builtin_amdgcn_update_dpp(ninf, __builtin_bit_cast(int, x), 0x112, 0xf, 0xf, false)));
  x = fmaxf(x, __builtin_bit_cast(float, __builtin_amdgcn_update_dpp(ninf, __builtin_bit_cast(int, x), 0x114, 0xf, 0xf, false)));
  x = fmaxf(x, __builtin_bit_cast(float, __builtin_amdgcn_update_dpp(ninf, __builtin_bit_cast(int, x), 0x118, 0xf, 0xf, false)));
  x = fmaxf(x, __builtin_bit_cast(float, __builtin_amdgcn_update_dpp(ninf, __builtin_bit_cast(int, x), 0x142, 0xa, 0xf, false)));
  x = fmaxf(x, __builtin_bit_cast(float, __builtin_amdgcn_update_dpp(ninf, __builtin_bit_cast(int, x), 0x143, 0xc, 0xf, false)));
  return x;
}
__device__ __forceinline__ float rdlane(float x, int l) { return __builtin_bit_cast(float, __builtin_amdgcn_readlane(__builtin_bit_cast(int, x), l)); }
__device__ __forceinline__ bf16x8 ldfrag(const unsigned char* base, int ld, int row, int kbyte) { return *(const bf16x8*)(base + row * ld + kbyte); }
__device__ __forceinline__ unsigned pk(float a, float b) { return pk_hw(a, b); }
__device__ __forceinline__ float lo16(unsigned w) { return __uint_as_float(w << 16); }
__device__ __forceinline__ float hi16(unsigned w) { return __uint_as_float(w & 0xffff0000u); }

__device__ __forceinline__ void lds_barrier() { asm volatile("s_waitcnt lgkmcnt(0)" ::: "memory"); __builtin_amdgcn_s_barrier(); asm volatile("" ::: "memory"); }
struct Raw { u32x4 a0, a1, b0, b1; f32x4 r0, r1; u32x2 v; float s0, s1; };

template <int MIXER>
__device__ __forceinline__ void scan_item(unsigned char* lds, int wv, const Params& p, int b, int h, int dir, int vs) {
  constexpr int DK = (MIXER == MIX_A || MIXER == MIX_D) ? 128 : 64;
  constexpr int NC = DK / 8;
  constexpr int LD_D = DK * 2 + 16;
  constexpr int NVT = MIXER == MIX_D ? 3 : 2;
  constexpr int NKD = DK / 32;
  const int tid = opaque_tid(wv), lane0 = tid & 63, wid = __builtin_amdgcn_readfirstlane(tid >> 6);
  unsigned char* ws = p.ws;
  const bf16_t* P = (const bf16_t*)(ws + WS_R1);
  const bf16_t* LFBp = (const bf16_t*)(ws + WS_LFB);
  const float* side = (const float*)(ws + WS_SIDE);
  const float* rope = (const float*)(ws + WS_ROPE);
  bf16_t* O = (bf16_t*)(ws + WS_R2) + (size_t)dir * NTOK * 1024;
  unsigned char* QS = lds + OFF_QS; unsigned char* KS = lds + OFF_KS; unsigned char* QI = lds + OFF_QI; unsigned char* KT = lds + OFF_KT;
  unsigned char* VT = lds + OFF_VT; unsigned char* SC = lds + OFF_SC; unsigned char* ST = lds + OFF_ST;
  float* DEC = (float*)(lds + OFF_DEC); float* EM = (float*)(lds + OFF_EM); float* DEN = (float*)(lds + OFF_DEN);

  int qcol, kcol, lfcol, vcol, ocol;
  if (MIXER == MIX_A) { qcol = h * 128; kcol = 0; lfcol = 512 + dir * 512 + h * 128; vcol = 1536 + h * 128 + vs * 32; ocol = h * 128 + vs * 32; }
  else if (MIXER == MIX_B) { qcol = 2560 + h * 64; kcol = 2816 + h * 64; lfcol = dir * 256 + h * 64; vcol = 3072 + h * 128 + vs * 32; ocol = 512 + h * 128 + vs * 32; }
  else if (MIXER == MIX_C) { qcol = h * 64; kcol = 256 + h * 64; lfcol = 0; vcol = 512 + h * 128 + vs * 32; ocol = h * 128 + vs * 32; }
  else { qcol = h * 128  ; kcol = 3584 + h * 128  ; lfcol = 0; vcol = 2560 + h * 128 + vs * 32; ocol = 512 + h * 128 + vs * 32; }
  const int c0 = (MIXER == MIX_C) ? wid * 4 : wid * NC;
  const float lgam = (MIXER == MIX_C) ? log1pf(-exp2f(-(5.0f + 2.0f * (float)h + (float)dir))) : 0.f;
  const float fgb = (MIXER == MIX_D) ? p.in[I_FGATE_B][dir * 4 + h] : 0.f;
  for (int i = tid; i < 48 * LD_D / 4; i += NTHREADS) ((unsigned*)ST)[i] = 0u;
  if (MIXER == MIX_D) {
    for (int i = tid; i < 16 * 64; i += NTHREADS) { const int r = 32 + (i >> 6), j = i & 63; *(bf16_t*)(VT + r * LD_T + j * 2) = (r == 32) ? (bf16_t)0x3F80 : (bf16_t)0; }
  }
  f32x4 sacc[NVT == 3 ? 3 : 2];
#pragma unroll
  for (int i = 0; i < (NVT == 3 ? 3 : 2); ++i) sacc[i] = (f32x4){0.f, 0.f, 0.f, 0.f};
  float m_st = 0.f;
  const size_t tokbase = (size_t)b * SEQ;
  const int sgn = dir ? -1 : 1;
  __syncthreads();

  Raw R;
#define SCAN_LOAD(n_) do { \
    int ln_ = lane0; asm volatile("" : "+v"(ln_)); \
    const int t_ = dir ? (SEQ - 1 - ((n_) * 64 + ln_)) : ((n_) * 64 + ln_); \
    const bf16_t* row_ = P + (tokbase + t_) * PSTRIDE; \
    if (MIXER == MIX_A) { const u32x4* qp_ = (const u32x4*)(row_ + qcol + c0); const u32x4* lp_ = (const u32x4*)(row_ + lfcol + c0); R.a0 = qp_[0]; R.a1 = qp_[1]; R.b0 = lp_[0]; R.b1 = lp_[1]; } \
    else if (MIXER == MIX_B) { R.a0 = *(const u32x4*)(row_ + qcol + c0); R.a1 = *(const u32x4*)(row_ + kcol + c0); R.b0 = *(const u32x4*)(LFBp + (tokbase + t_) * 512 + lfcol + c0); } \
    else if (MIXER == MIX_C) { const u32x2 qa_ = *(const u32x2*)(row_ + qcol + c0), qb_ = *(const u32x2*)(row_ + qcol + 32 + c0), ka_ = *(const u32x2*)(row_ + kcol + c0), kb_ = *(const u32x2*)(row_ + kcol + 32 + c0); \
      R.a0 = (u32x4){qa_.x, qa_.y, qb_.x, qb_.y}; R.a1 = (u32x4){ka_.x, ka_.y, kb_.x, kb_.y}; \
      R.r0 = *(const f32x4*)(rope + ((size_t)t_ * 32 + c0) * 2); R.r1 = *(const f32x4*)(rope + ((size_t)t_ * 32 + c0) * 2 + 4); } \
    else { const u32x4* qp_ = (const u32x4*)(LFBp + (tokbase + t_) * 512 + qcol + c0); const u32x4* kp_ = (const u32x4*)(row_ + kcol + c0); R.a0 = qp_[0]; R.a1 = qp_[1]; R.b0 = kp_[0]; R.b1 = kp_[1]; \
      R.s0 = side[(tokbase + t_) * 32 + dir * 8 + h]; R.s1 = side[(tokbase + t_) * 32 + dir * 8 + 4 + h]; } \
    R.v = *(const u32x2*)(row_ + vcol + wid * 4); } while (0)

  SCAN_LOAD(0);
  for (int n = 0; n < SEQ / 64; ++n) {
    int lane = lane0; asm volatile("" : "+v"(lane));
    const int fr = lane & 15, fq = lane >> 4;
    float q[NC], k[NC], g[NC];
    const u32x2 vv = R.v;
    float g_li = 0.f, g_lf = 0.f;
    if (MIXER == MIX_A) {
      const unsigned qw[8] = {R.a0.x, R.a0.y, R.a0.z, R.a0.w, R.a1.x, R.a1.y, R.a1.z, R.a1.w}, lw[8] = {R.b0.x, R.b0.y, R.b0.z, R.b0.w, R.b1.x, R.b1.y, R.b1.z, R.b1.w};
#pragma unroll
      for (int c = 0; c < 8; ++c) { q[2 * c] = lo16(qw[c]); q[2 * c + 1] = hi16(qw[c]); g[2 * c] = lo16(lw[c]); g[2 * c + 1] = hi16(lw[c]); }
#pragma unroll
      for (int c = 0; c < NC; ++c) k[c] = 1.0f - __expf(g[c]);
    } else if (MIXER == MIX_B) {
      const unsigned qw[4] = {R.a0.x, R.a0.y, R.a0.z, R.a0.w}, kw[4] = {R.a1.x, R.a1.y, R.a1.z, R.a1.w}, lw[4] = {R.b0.x, R.b0.y, R.b0.z, R.b0.w};
#pragma unroll
      for (int c = 0; c < 4; ++c) { q[2 * c] = lo16(qw[c]); q[2 * c + 1] = hi16(qw[c]); k[2 * c] = lo16(kw[c]); k[2 * c + 1] = hi16(kw[c]); g[2 * c] = lo16(lw[c]); g[2 * c + 1] = hi16(lw[c]); }
    } else if (MIXER == MIX_C) {
      const float cs[4] = {R.r0[0], R.r0[2], R.r1[0], R.r1[2]}, sn[4] = {R.r0[1], R.r0[3], R.r1[1], R.r1[3]};
      const float q1[4] = {lo16(R.a0.x), hi16(R.a0.x), lo16(R.a0.y), hi16(R.a0.y)}, q2[4] = {lo16(R.a0.z), hi16(R.a0.z), lo16(R.a0.w), hi16(R.a0.w)};
      const float k1[4] = {lo16(R.a1.x), hi16(R.a1.x), lo16(R.a1.y), hi16(R.a1.y)}, k2[4] = {lo16(R.a1.z), hi16(R.a1.z), lo16(R.a1.w), hi16(R.a1.w)};
#pragma unroll
      for (int c = 0; c < 4; ++c) { q[c] = (q1[c] * cs[c] - q2[c] * sn[c]) * 0.125f; q[4 + c] = (q1[c] * sn[c] + q2[c] * cs[c]) * 0.125f; k[c] = k1[c] * cs[c] - k2[c] * sn[c]; k[4 + c] = k1[c] * sn[c] + k2[c] * cs[c]; }
#pragma unroll
      for (int c = 0; c < NC; ++c) g[c] = (float)(lane + 1) * lgam;
    } else {
      const unsigned qw[8] = {R.a0.x, R.a0.y, R.a0.z, R.a0.w, R.a1.x, R.a1.y, R.a1.z, R.a1.w}, kw[8] = {R.b0.x, R.b0.y, R.b0.z, R.b0.w, R.b1.x, R.b1.y, R.b1.z, R.b1.w};
      g_li = R.s0; g_lf = R.s1;
#pragma unroll
      for (int c = 0; c < 8; ++c) { q[2 * c] = lo16(qw[c]); q[2 * c + 1] = hi16(qw[c]); k[2 * c] = lo16(kw[c]); k[2 * c + 1] = hi16(kw[c]); }
#pragma unroll
      for (int c = 0; c < NC; ++c) g[c] = 0.f;
    }
    if (n + 1 < SEQ / 64) SCAN_LOAD(n + 1);

#ifndef PROBE_REPA
#define PROBE_REPA 1
#endif
    const float m_save = m_st;
#pragma unroll 1
    for (int rep = 0; rep < PROBE_REPA; ++rep) {
    if (PROBE_REPA > 1) { m_st = m_save;
#pragma unroll
      for (int c = 0; c < NC; ++c) asm volatile("" : "+v"(g[c]), "+v"(q[c]), "+v"(k[c])); }
    float s_qs[NC], s_ks[NC], s_qi[NC], s_kt[NC];
    if (MIXER != MIX_D) {
#pragma unroll
      for (int c = 0; c < NC; ++c) {
        const float gc = (MIXER == MIX_C) ? g[c] : incl_scan_add(g[c]);
        const float gref = rdlane(gc, 31), glast = rdlane(gc, 63);
        const float a = __expf(gc - gref), ia = __builtin_amdgcn_rcpf(a);
        s_qs[c] = a; s_ks[c] = ia; s_qi[c] = a * __expf(gref); s_kt[c] = ia * __expf(glast - gref);
        if (lane == 63) DEC[(MIXER == MIX_C) ? (c < 4 ? c0 + c : 32 + c0 + c - 4) : c0 + c] = __expf(glast);
      }
    } else {
      const float li = g_li;
      const float lf = logsigmoidf_(g_lf + fgb);
      const float bc = incl_scan_add(lf);
      const float u = li - bc;
      const float pm = incl_scan_max(u);
      const float cmax = rdlane(pm, 63), blast = rdlane(bc, 63);
      const float a_i = bc + m_st, m_i = fmaxf(a_i, bc + pm);
      const float alpha = __expf(bc - m_i + cmax), beta = __expf(u - cmax), sint = __expf(a_i - m_i);
      const float m_new = fmaxf(blast + m_st, blast + cmax);
      const float s_old = __expf(blast + m_st - m_new), wks = __expf(blast + u - m_new);
      m_st = m_new;
#pragma unroll
      for (int c = 0; c < NC; ++c) { s_qs[c] = alpha; s_ks[c] = beta; s_qi[c] = sint; s_kt[c] = wks; }
      if (wid == 0) EM[lane] = __expf(-m_i);
      if (lane == 63) {
#pragma unroll
        for (int c = 0; c < NC; ++c) DEC[c0 + c] = s_old;
      }
    }
    {
      unsigned wq[NC / 2], wk[NC / 2], wi[NC / 2];
#pragma unroll
      for (int c = 0; c < NC / 2; ++c) { wq[c] = pk(q[2 * c] * s_qs[2 * c], q[2 * c + 1] * s_qs[2 * c + 1]); wk[c] = pk(k[2 * c] * s_ks[2 * c], k[2 * c + 1] * s_ks[2 * c + 1]); wi[c] = pk(q[2 * c] * s_qi[2 * c], q[2 * c + 1] * s_qi[2 * c + 1]); }
      if (MIXER == MIX_C) {
        *(u32x2*)(QS + lane * LD_D + c0 * 2) = (u32x2){wq[0], wq[1]}; *(u32x2*)(QS + lane * LD_D + (32 + c0) * 2) = (u32x2){wq[2], wq[3]};
        *(u32x2*)(KS + lane * LD_D + c0 * 2) = (u32x2){wk[0], wk[1]}; *(u32x2*)(KS + lane * LD_D + (32 + c0) * 2) = (u32x2){wk[2], wk[3]};
        *(u32x2*)(QI + lane * LD_D + c0 * 2) = (u32x2){wi[0], wi[1]}; *(u32x2*)(QI + lane * LD_D + (32 + c0) * 2) = (u32x2){wi[2], wi[3]};
      } else {
#pragma unroll
        for (int c = 0; c < NC / 8; ++c) {
          *(u32x4*)(QS + lane * LD_D + (c0 + 8 * c) * 2) = (u32x4){wq[4 * c], wq[4 * c + 1], wq[4 * c + 2], wq[4 * c + 3]};
          *(u32x4*)(KS + lane * LD_D + (c0 + 8 * c) * 2) = (u32x4){wk[4 * c], wk[4 * c + 1], wk[4 * c + 2], wk[4 * c + 3]};
          *(u32x4*)(QI + lane * LD_D + (c0 + 8 * c) * 2) = (u32x4){wi[4 * c], wi[4 * c + 1], wi[4 * c + 2], wi[4 * c + 3]};
        }
      }
#pragma unroll
      for (int c = 0; c < NC; ++c) { const int d = (MIXER == MIX_C) ? (c < 4 ? c0 + c : 32 + c0 + c - 4) : c0 + c; *(bf16_t*)(KT + d * LD_T + lane * 2) = f2bf(k[c] * s_kt[c]); }
      *(bf16_t*)(VT + (wid * 4 + 0) * LD_T + lane * 2) = (bf16_t)(vv.x & 0xffff); *(bf16_t*)(VT + (wid * 4 + 1) * LD_T + lane * 2) = (bf16_t)(vv.x >> 16);
      *(bf16_t*)(VT + (wid * 4 + 2) * LD_T + lane * 2) = (bf16_t)(vv.y & 0xffff); *(bf16_t*)(VT + (wid * 4 + 3) * LD_T + lane * 2) = (bf16_t)(vv.y >> 16);
    }
    }
    lds_barrier();
    {
      const int it = wid & 3;
#pragma unroll
      for (int jj = 0; jj < 2; ++jj) {
        const int jt = 2 * (wid >> 2) + jj;
        if (jt <= it) {
          f32x4 acc = (f32x4){0.f, 0.f, 0.f, 0.f};
#pragma unroll
          for (int ks = 0; ks < NKD; ++ks) acc = __builtin_amdgcn_mfma_f32_16x16x32_bf16(ldfrag(KS, LD_D, jt * 16 + fr, ks * 64 + fq * 16), ldfrag(QS, LD_D, it * 16 + fr, ks * 64 + fq * 16), acc, 0, 0, 0);
          const int i = it * 16 + fr, j0 = jt * 16 + fq * 4;
          const float v0 = (j0 + 0 <= i) ? acc[0] : 0.f, v1 = (j0 + 1 <= i) ? acc[1] : 0.f, v2 = (j0 + 2 <= i) ? acc[2] : 0.f, v3 = (j0 + 3 <= i) ? acc[3] : 0.f;
          *(u32x2*)(SC + i * LD_T + j0 * 2) = (u32x2){pk(v0, v1), pk(v2, v3)};
        } else {
          const int i = it * 16 + fr, j0 = jt * 16 + fq * 4;
          *(u32x2*)(SC + i * LD_T + j0 * 2) = (u32x2){0u, 0u};
        }
      }
    }
    f32x4 oacc = (f32x4){0.f, 0.f, 0.f, 0.f}, dacc = (f32x4){0.f, 0.f, 0.f, 0.f};
    {
      const int vt = wid >> 2, it = wid & 3;
#pragma unroll
      for (int ks = 0; ks < NKD; ++ks) oacc = __builtin_amdgcn_mfma_f32_16x16x32_bf16(ldfrag(ST, LD_D, vt * 16 + fr, ks * 64 + fq * 16), ldfrag(QI, LD_D, it * 16 + fr, ks * 64 + fq * 16), oacc, 0, 0, 0);
      if (NVT == 3 && wid < 4) {
#pragma unroll
        for (int ks = 0; ks < NKD; ++ks) dacc = __builtin_amdgcn_mfma_f32_16x16x32_bf16(ldfrag(ST, LD_D, 32 + fr, ks * 64 + fq * 16), ldfrag(QI, LD_D, wid * 16 + fr, ks * 64 + fq * 16), dacc, 0, 0, 0);
      }
    }
    lds_barrier();
    {
      const int vt = wid >> 2, it = wid & 3;
#pragma unroll
      for (int ks = 0; ks < 2; ++ks) oacc = __builtin_amdgcn_mfma_f32_16x16x32_bf16(ldfrag(VT, LD_T, vt * 16 + fr, ks * 64 + fq * 16), ldfrag(SC, LD_T, it * 16 + fr, ks * 64 + fq * 16), oacc, 0, 0, 0);
      if (NVT == 3) {
        if (wid < 4) {
#pragma unroll
          for (int ks = 0; ks < 2; ++ks) dacc = __builtin_amdgcn_mfma_f32_16x16x32_bf16(ldfrag(VT, LD_T, 32 + fr, ks * 64 + fq * 16), ldfrag(SC, LD_T, wid * 16 + fr, ks * 64 + fq * 16), dacc, 0, 0, 0);
          if (fq == 0) DEN[wid * 16 + fr] = dacc[0];
        }
        lds_barrier();
        const int i = it * 16 + fr;
        const float dn = 1.0f / fmaxf(fabsf(DEN[i]), EM[i]);
        oacc *= dn;
      }
      const int i = it * 16 + fr;
      const int ti = dir ? (SEQ - 1 - (n * 64 + i)) : (n * 64 + i);
      *(u32x2*)(O + (tokbase + ti) * 1024 + ocol + vt * 16 + fq * 4) = (u32x2){pk(oacc[0], oacc[1]), pk(oacc[2], oacc[3])};
    }
    {
      constexpr int NST = (DK == 128) ? NVT : 1;
#pragma unroll
      for (int s = 0; s < NST; ++s) {
        const int dt = (DK == 128) ? wid : (wid & 3), vt = (DK == 128) ? s : (wid >> 2);
        const f32x4 dc = *(const f32x4*)(DEC + dt * 16 + fq * 4);
        f32x4 acc = sacc[s] * dc;
#pragma unroll
        for (int ks = 0; ks < 2; ++ks) acc = __builtin_amdgcn_mfma_f32_16x16x32_bf16(ldfrag(KT, LD_T, dt * 16 + fr, ks * 64 + fq * 16), ldfrag(VT, LD_T, vt * 16 + fr, ks * 64 + fq * 16), acc, 0, 0, 0);
        sacc[s] = acc;
        *(u32x2*)(ST + (vt * 16 + fr) * LD_D + (dt * 16 + fq * 4) * 2) = (u32x2){pk(acc[0], acc[1]), pk(acc[2], acc[3])};
      }
    }
    lds_barrier();
  }
}

template <int MIXER>
__device__ __forceinline__ void scan_dispatch(unsigned char* lds, int wv, const Params& p, int id) {
  const int vs = id & 3, dir = (id >> 2) & 1, h = (id >> 3) & 3, b = id >> 5;
  scan_item<MIXER>(lds, wv, p, b, h, dir, vs);
}
}

__device__ __forceinline__ void convd_phase(unsigned char* lds_, int wv, const Params& p) {
  const Ctx c = make_ctx(lds_, wv);
  bf16_t* P = (bf16_t*)(p.ws + WS_R1); bf16_t* QD = (bf16_t*)(p.ws + WS_LFB);
  const float* cw = p.in[I_CONV_W]; const float* cb = p.in[I_CONV_B];
  const int ch = c.lane * 16;
  float w0[16], w1[16], w2[16], bb[16];
#pragma unroll
  for (int j = 0; j < 16; ++j) { w0[j] = cw[ch + j]; w1[j] = cw[1024 + ch + j]; w2[j] = cw[2048 + ch + j]; bb[j] = cb[ch + j]; }
  for (int tok = c.bid * 8 + c.wid; tok < NTOK; tok += c.G * 8) {
    const int t = tok % SEQ;
    const bf16_t* row = P + PIDX(tok, 1536 + ch);
    float x0[16], x1[16], x2[16];
    { const u32x4* r1 = (const u32x4*)row; unpack8(r1[0], x1); unpack8(r1[1], x1 + 8); }
    if (t > 0) { const u32x4* r0 = (const u32x4*)(row - 128); unpack8(r0[0], x0); unpack8(r0[1], x0 + 8); }
    else {
#pragma unroll
      for (int j = 0; j < 16; ++j) x0[j] = 0.f; }
    if (t < SEQ - 1) { const u32x4* r2 = (const u32x4*)(row + 128); unpack8(r2[0], x2); unpack8(r2[1], x2 + 8); }
    else {
#pragma unroll
      for (int j = 0; j < 16; ++j) x2[j] = 0.f; }
    const float sc = ch < 512 ? 0.08838834764831845f : 1.0f;
    unsigned w[8];
#pragma unroll
    for (int j = 0; j < 8; ++j) {
      const float a0 = bb[2 * j] + w0[2 * j] * x0[2 * j] + w1[2 * j] * x1[2 * j] + w2[2 * j] * x2[2 * j];
      const float a1 = bb[2 * j + 1] + w0[2 * j + 1] * x0[2 * j + 1] + w1[2 * j + 1] * x1[2 * j + 1] + w2[2 * j + 1] * x2[2 * j + 1];
      w[j] = pk2(fsilu(a0) * sc, fsilu(a1) * sc);
    }
    u32x4* d = (ch < 512) ? (u32x4*)(QD + PIDX(tok, ch)) : (u32x4*)(P + PIDX(tok, 3584 + (ch - 512)));
    d[0] = (u32x4){w[0], w[1], w[2], w[3]}; d[1] = (u32x4){w[4], w[5], w[6], w[7]};
  }
}

__device__ __forceinline__ void scan_phase(unsigned char* lds, int wv, const Params& p, int layer) {
  for (int item = blockIdx.x; item < 256; item += gridDim.x) {
    if (layer == 0) { if (item < 128) scan::scan_dispatch<scan::MIX_A>(lds, wv, p, item); else scan::scan_dispatch<scan::MIX_B>(lds, wv, p, item - 128); }
    else { if (item < 128) scan::scan_dispatch<scan::MIX_D>(lds, wv, p, item); else scan::scan_dispatch<scan::MIX_C>(lds, wv, p, item - 128); }
    __syncthreads();
  }
}
#endif
#ifndef CPU_EMU
namespace scan2 {
using namespace scan;
constexpr int S_QS = 0, S_KS = 17408, S_QI = 34816, S_KT = 52224  , S_VT = 89088  , S_SC = 102912, S_ST = 112128  , S_DEC = 138240  , S_EM = 139264  , S_END = 139776;

constexpr int U_QI = 0, U_KS = 34816, U_KT = 69632, U_VT = 106496, U_SC = 120320, U_ST = 129536, U_DEC = 155648, U_EM = 156672, U_END = 157184;
template <int MIXER>
__device__ __forceinline__ void scan_item2(unsigned char* lds, int wv, const Params& p, int b, int h, int dir, int vs) {
  constexpr int DK = (MIXER == MIX_A || MIXER == MIX_D) ? 128 : 64;
  constexpr int NC = DK / 8;
  constexpr int LD_D = DK * 2 + 16;
  constexpr int NVT = MIXER == MIX_D ? 3 : 2;
  constexpr int NKD = DK / 32;
  constexpr int NST = (DK == 128) ? NVT : 1;
  constexpr int NCH = SEQ / 64;
  const int tid = opaque_tid(wv), lane0 = tid & 63, wid = __builtin_amdgcn_readfirstlane(tid >> 6);
  unsigned char* ws = p.ws;
  const bf16_t* P = (const bf16_t*)(ws + WS_R1);
  const bf16_t* LFBp = (const bf16_t*)(ws + WS_LFB);
  const float* side = (const float*)(ws + WS_SIDE);
  const float* rope = (const float*)(ws + WS_ROPE);
  bf16_t* O = (bf16_t*)(ws + WS_R2) + (size_t)dir * NTOK * 1024;
  unsigned char* SC = lds + U_SC;
  int qcol, kcol, lfcol, vcol, ocol;
  if (MIXER == MIX_A) { qcol = h * 128; kcol = 0; lfcol = 512 + dir * 512 + h * 128; vcol = 1536 + h * 128 + vs * 32; ocol = h * 128 + vs * 32; }
  else if (MIXER == MIX_B) { qcol = 2560 + h * 64; kcol = 2816 + h * 64; lfcol = dir * 256 + h * 64; vcol = 3072 + h * 128 + vs * 32; ocol = 512 + h * 128 + vs * 32; }
  else if (MIXER == MIX_C) { qcol = h * 64; kcol = 256 + h * 64; lfcol = 0; vcol = 512 + h * 128 + vs * 32; ocol = h * 128 + vs * 32; }
  else { qcol = h * 128; kcol = 3584 + h * 128; lfcol = 0; vcol = 2560 + h * 128 + vs * 32; ocol = 512 + h * 128 + vs * 32; }
  const size_t tokbase = (size_t)b * SEQ;
  const int c0 = (MIXER == MIX_C) ? wid * 4 : wid * NC;
  for (int i = tid; i < 2 * 13056 / 4; i += NTHREADS) ((unsigned*)(lds + U_ST))[i] = 0u;
  for (int i = tid; i < 9216 / 4; i += NTHREADS) ((unsigned*)(lds + U_SC))[i] = 0u;
  if (MIXER == MIX_D) { for (int i = tid; i < 2 * 16 * 64; i += NTHREADS) { const int bf = i >> 10, r = 32 + ((i >> 6) & 15), j = i & 63; *(bf16_t*)(lds + U_VT + bf * 6912 + r * LD_T + j * 2) = (r == 32) ? (bf16_t)0x3F80 : (bf16_t)0; } }
  const float lgam2 = (MIXER == MIX_C) ? log1pf(-exp2f(-(5.0f + 2.0f * (float)h + (float)dir))) * 1.4426950408889634f : 0.f;
  const float fgb = (MIXER == MIX_D) ? p.in[I_FGATE_B][dir * 4 + h] : 0.f;
  float m_st = 0.f;
  __syncthreads();

  Raw R, Rn; u32x2 Rv, Rvn;
#define A_LOAD(R, Rv, n_) do { \
    int ln_ = lane0; asm volatile("" : "+v"(ln_)); \
    const int t_ = dir ? (SEQ - 1 - ((n_) * 64 + ln_)) : ((n_) * 64 + ln_); \
    const size_t tk_ = tokbase + t_; \
    if (MIXER == MIX_A) { const u32x4* qp_ = (const u32x4*)(P + PIDX(tk_, qcol + c0)); const u32x4* lp_ = (const u32x4*)(P + PIDX(tk_, lfcol + c0)); R.a0 = qp_[0]; R.a1 = qp_[1]; R.b0 = lp_[0]; R.b1 = lp_[1]; } \
    else if (MIXER == MIX_B) { R.a0 = *(const u32x4*)(P + PIDX(tk_, qcol + c0)); R.a1 = *(const u32x4*)(P + PIDX(tk_, kcol + c0)); R.b0 = *(const u32x4*)(LFBp + PIDX(tk_, lfcol + c0)); } \
    else if (MIXER == MIX_C) { const u32x2 qa_ = *(const u32x2*)(P + PIDX(tk_, qcol + c0)), qb_ = *(const u32x2*)(P + PIDX(tk_, qcol + 32 + c0)), ka_ = *(const u32x2*)(P + PIDX(tk_, kcol + c0)), kb_ = *(const u32x2*)(P + PIDX(tk_, kcol + 32 + c0)); \
      R.a0 = (u32x4){qa_.x, qa_.y, qb_.x, qb_.y}; R.a1 = (u32x4){ka_.x, ka_.y, kb_.x, kb_.y}; \
      R.r0 = *(const f32x4*)(rope + ((size_t)t_ * 32 + c0) * 2); R.r1 = *(const f32x4*)(rope + ((size_t)t_ * 32 + c0) * 2 + 4); } \
    else { const u32x4* qp_ = (const u32x4*)(LFBp + PIDX(tk_, qcol + c0)); const u32x4* kp_ = (const u32x4*)(P + PIDX(tk_, kcol + c0)); R.a0 = qp_[0]; R.a1 = qp_[1]; R.b0 = kp_[0]; R.b1 = kp_[1]; \
      R.s0 = side[tk_ * 32 + dir * 8 + h]; R.s1 = side[tk_ * 32 + dir * 8 + 4 + h]; } \
    Rv = *(const u32x2*)(P + PIDX(tk_, vcol + wid * 4)); } while (0)

  float rr_next = 1.f, rr_cur = 1.f;
#define A_PREP(buf_, R, Rv) do { \
    int lane = lane0; asm volatile("" : "+v"(lane)); \
    unsigned char* KTb = lds + U_KT + (buf_) * 18432; float* DECb = (float*)(lds + U_DEC + (buf_) * 512); float* EMb = (float*)(lds + U_EM + (buf_) * 256); \
    unsigned char* QIb = lds + U_QI + (buf_) * 17408; unsigned char* KSb = lds + U_KS + (buf_) * 17408; \
    float q[NC], k[NC], g[NC], ktv[NC]; \
    if (MIXER == MIX_A) { \
      const unsigned qw[8] = {R.a0.x, R.a0.y, R.a0.z, R.a0.w, R.a1.x, R.a1.y, R.a1.z, R.a1.w}, lw[8] = {R.b0.x, R.b0.y, R.b0.z, R.b0.w, R.b1.x, R.b1.y, R.b1.z, R.b1.w}; \
      _Pragma("unroll") for (int c = 0; c < 8; ++c) { q[2 * c] = lo16(qw[c]); q[2 * c + 1] = hi16(qw[c]); g[2 * c] = lo16(lw[c]); g[2 * c + 1] = hi16(lw[c]); } \
      _Pragma("unroll") for (int c = 0; c < NC; ++c) k[c] = 1.0f - __builtin_amdgcn_exp2f(g[c]); \
    } else if (MIXER == MIX_B) { \
      const unsigned qw[4] = {R.a0.x, R.a0.y, R.a0.z, R.a0.w}, kw[4] = {R.a1.x, R.a1.y, R.a1.z, R.a1.w}, lw[4] = {R.b0.x, R.b0.y, R.b0.z, R.b0.w}; \
      _Pragma("unroll") for (int c = 0; c < 4; ++c) { q[2 * c] = lo16(qw[c]); q[2 * c + 1] = hi16(qw[c]); k[2 * c] = lo16(kw[c]); k[2 * c + 1] = hi16(kw[c]); g[2 * c] = lo16(lw[c]); g[2 * c + 1] = hi16(lw[c]); } \
    } else if (MIXER == MIX_C) { \
      const float cs[4] = {R.r0[0], R.r0[2], R.r1[0], R.r1[2]}, sn[4] = {R.r0[1], R.r0[3], R.r1[1], R.r1[3]}; \
      const float q1[4] = {lo16(R.a0.x), hi16(R.a0.x), lo16(R.a0.y), hi16(R.a0.y)}, q2[4] = {lo16(R.a0.z), hi16(R.a0.z), lo16(R.a0.w), hi16(R.a0.w)}; \
      const float k1[4] = {lo16(R.a1.x), hi16(R.a1.x), lo16(R.a1.y), hi16(R.a1.y)}, k2[4] = {lo16(R.a1.z), hi16(R.a1.z), lo16(R.a1.w), hi16(R.a1.w)}; \
      _Pragma("unroll") for (int c = 0; c < 4; ++c) { q[c] = (q1[c] * cs[c] - q2[c] * sn[c]) * 0.125f; q[4 + c] = (q1[c] * sn[c] + q2[c] * cs[c]) * 0.125f; k[c] = k1[c] * cs[c] - k2[c] * sn[c]; k[4 + c] = k1[c] * sn[c] + k2[c] * cs[c]; } \
    } else { \
      const unsigned qw[8] = {R.a0.x, R.a0.y, R.a0.z, R.a0.w, R.a1.x, R.a1.y, R.a1.z, R.a1.w}, kw[8] = {R.b0.x, R.b0.y, R.b0.z, R.b0.w, R.b1.x, R.b1.y, R.b1.z, R.b1.w}; \
      _Pragma("unroll") for (int c = 0; c < 8; ++c) { q[2 * c] = lo16(qw[c]); q[2 * c + 1] = hi16(qw[c]); k[2 * c] = lo16(kw[c]); k[2 * c + 1] = hi16(kw[c]); } \
    } \
    if (MIXER == MIX_A || MIXER == MIX_B) { \
        \
      _Pragma("unroll") for (int c = 0; c < NC; ++c) g[c] += __builtin_bit_cast(float, __builtin_amdgcn_update_dpp(0, __builtin_bit_cast(int, g[c]), 0x111, 0xf, 0xf, false)); \
      _Pragma("unroll") for (int c = 0; c < NC; ++c) g[c] += __builtin_bit_cast(float, __builtin_amdgcn_update_dpp(0, __builtin_bit_cast(int, g[c]), 0x112, 0xf, 0xf, false)); \
      _Pragma("unroll") for (int c = 0; c < NC; ++c) g[c] += __builtin_bit_cast(float, __builtin_amdgcn_update_dpp(0, __builtin_bit_cast(int, g[c]), 0x114, 0xf, 0xf, false)); \
      _Pragma("unroll") for (int c = 0; c < NC; ++c) g[c] += __builtin_bit_cast(float, __builtin_amdgcn_update_dpp(0, __builtin_bit_cast(int, g[c]), 0x118, 0xf, 0xf, false)); \
      _Pragma("unroll") for (int c = 0; c < NC; ++c) g[c] += __builtin_bit_cast(float, __builtin_amdgcn_update_dpp(0, __builtin_bit_cast(int, g[c]), 0x142, 0xa, 0xf, false)); \
      _Pragma("unroll") for (int c = 0; c < NC; ++c) g[c] += __builtin_bit_cast(float, __builtin_amdgcn_update_dpp(0, __builtin_bit_cast(int, g[c]), 0x143, 0xc, 0xf, false)); \
      float ev[NC]; \
      _Pragma("unroll") for (int c = 0; c < NC; ++c) { \
          \
        const float e = __builtin_amdgcn_exp2f(g[c]), r = __builtin_amdgcn_rcpf(e); \
        const float e63 = rdlane(e, 63); \
        q[c] *= e; k[c] *= r; ktv[c] = k[c] * e63;     \
        ev[c] = e; } \
      if (lane == 63) { _Pragma("unroll") for (int c = 0; c < NC / 4; ++c) *(f32x4*)(DECb + c0 + 4 * c) = (f32x4){ev[4 * c], ev[4 * c + 1], ev[4 * c + 2], ev[4 * c + 3]}; } \
    } else if (MIXER == MIX_C) { \
        \
      const float gl = (float)(lane + 1) * lgam2; \
      const float e = __builtin_amdgcn_exp2f(gl), r = __builtin_amdgcn_rcpf(e); \
      const float e63 = rdlane(e, 63); const float f_kt = r * e63; \
      _Pragma("unroll") for (int c = 0; c < NC; ++c) { q[c] *= e; ktv[c] = k[c] * f_kt; k[c] *= r; } \
      if (lane < 4) { DECb[c0 + lane] = e63; DECb[32 + c0 + lane] = e63; } \
    } else { \
      const float li = R.s0 * 1.4426950408889634f; const float lf = logsigmoidf_(R.s1 + fgb) * 1.4426950408889634f;     \
      const float bc = incl_scan_add(lf); const float u = li - bc; const float pm = incl_scan_max(u); \
      const float cmax = rdlane(pm, 63), blast = rdlane(bc, 63); \
      const float a_i = bc + m_st, m_i = fmaxf(a_i, bc + pm); \
      const float d_alpha = __builtin_amdgcn_exp2f(bc - m_i + cmax), d_beta = __builtin_amdgcn_exp2f(u - cmax); \
      rr_next = __builtin_amdgcn_exp2f(m_st - cmax);     \
      const float m_new = fmaxf(blast + m_st, blast + cmax); \
      const float d_sold = __builtin_amdgcn_exp2f(blast + m_st - m_new), d_wks = __builtin_amdgcn_exp2f(blast + u - m_new); m_st = m_new; \
      _Pragma("unroll") for (int c = 0; c < NC; ++c) { ktv[c] = k[c] * d_wks; q[c] *= d_alpha; k[c] *= d_beta; if (lane == 63) DECb[c0 + c] = d_sold; } \
      if (wid == 0) EMb[lane] = __builtin_amdgcn_exp2f(-m_i); \
    } \
    _Pragma("unroll") for (int c = 0; c < NC / 2; ++c) { const unsigned w_ = pk_hw(ktv[2 * c], ktv[2 * c + 1]); \
      const int d0_ = (MIXER == MIX_C) ? (2 * c < 4 ? c0 + 2 * c : 32 + c0 + 2 * c - 4) : c0 + 2 * c; \
      *(bf16_t*)(KTb + d0_ * LD_T + lane * 2) = (bf16_t)(w_ & 0xffff); *(bf16_t*)(KTb + (d0_ + 1) * LD_T + lane * 2) = (bf16_t)(w_ >> 16); } \
    { unsigned pq[NC / 2], pks[NC / 2]; \
      _Pragma("unroll") for (int c = 0; c < NC / 2; ++c) { pq[c] = pk_hw(q[2 * c], q[2 * c + 1]); pks[c] = pk_hw(k[2 * c], k[2 * c + 1]); } \
      if (MIXER == MIX_C) { \
        *(u32x2*)(QIb + lane * LD_D + c0 * 2) = (u32x2){pq[0], pq[1]}; *(u32x2*)(QIb + lane * LD_D + (32 + c0) * 2) = (u32x2){pq[2], pq[3]}; \
        *(u32x2*)(KSb + lane * LD_D + c0 * 2) = (u32x2){pks[0], pks[1]}; *(u32x2*)(KSb + lane * LD_D + (32 + c0) * 2) = (u32x2){pks[2], pks[3]}; \
      } else { \
        _Pragma("unroll") for (int c = 0; c < NC / 8; ++c) { \
          *(u32x4*)(QIb + lane * LD_D + (c0 + 8 * c) * 2) = (u32x4){pq[4 * c], pq[4 * c + 1], pq[4 * c + 2], pq[4 * c + 3]}; \
          *(u32x4*)(KSb + lane * LD_D + (c0 + 8 * c) * 2) = (u32x4){pks[4 * c], pks[4 * c + 1], pks[4 * c + 2], pks[4 * c + 3]}; } } } \
    { unsigned char* VTb = lds + U_VT + (buf_) * 6912 + (wid * 4) * LD_T + lane * 2; \
      *(bf16_t*)(VTb + 0 * LD_T) = (bf16_t)(Rv.x & 0xffff); *(bf16_t*)(VTb + 1 * LD_T) = (bf16_t)(Rv.x >> 16); *(bf16_t*)(VTb + 2 * LD_T) = (bf16_t)(Rv.y & 0xffff); *(bf16_t*)(VTb + 3 * LD_T) = (bf16_t)(Rv.y >> 16); } \
  } while (0)
  f32x4 sacc[NST];
#pragma unroll
  for (int i = 0; i < NST; ++i) sacc[i] = (f32x4){0.f, 0.f, 0.f, 0.f};
  A_LOAD(R, Rv, 0);
  A_PREP(0, R, Rv);
  A_LOAD(R, Rv, 1);
  A_LOAD(Rn, Rvn, 2);
  rr_cur = rr_next;
  lds_barrier();
#define SCAN_ITER(n_, RX, RvX) do { const int n = (n_); \
    const int cb = n & 1, nb = (n + 1) & 1; \
    if (n + 1 < NCH) { A_PREP(nb, RX, RvX); if (n + 3 < NCH) A_LOAD(RX, RvX, n + 3); } \
    { { \
      int lane = lane0; asm volatile("" : "+v"(lane)); \
      const int fr = lane & 15, fq = lane >> 4; \
      const int it = wid & 3, vt = wid >> 2; \
      const unsigned char* STc = lds + U_ST + cb * 13056; unsigned char* STn = lds + U_ST + nb * 13056; \
      const unsigned char* KTc = lds + U_KT + cb * 18432; const unsigned char* VTc = lds + U_VT + cb * 6912; \
      const unsigned char* QI = lds + U_QI + cb * 17408; const unsigned char* KS = lds + U_KS + cb * 17408; \
      const float* DECc = (const float*)(lds + U_DEC + cb * 512); const float* EMc = (const float*)(lds + U_EM + cb * 256); \
_Pragma("unroll") \
      for (int jt = 0; jt < 4; ++jt) { \
        if (jt <= it) { \
          f32x4 acc = (f32x4){0.f, 0.f, 0.f, 0.f}; \
_Pragma("unroll") \
          for (int ks = 0; ks < NKD; ++ks) acc = __builtin_amdgcn_mfma_f32_16x16x32_bf16(ldfrag(KS, LD_D, jt * 16 + fr, ks * 64 + fq * 16), ldfrag(QI, LD_D, it * 16 + fr, ks * 64 + fq * 16), acc, 0, 0, 0); \
          const int i = it * 16 + fr, j0 = jt * 16 + fq * 4; \
          const float v0 = (j0 + 0 <= i) ? acc[0] : 0.f, v1 = (j0 + 1 <= i) ? acc[1] : 0.f, v2 = (j0 + 2 <= i) ? acc[2] : 0.f, v3 = (j0 + 3 <= i) ? acc[3] : 0.f; \
          *(u32x2*)(SC + i * LD_T + j0 * 2) = (u32x2){pk_hw(v0, v1), pk_hw(v2, v3)}; \
        } \
      } \
      f32x4 oacc = (f32x4){0.f, 0.f, 0.f, 0.f}, dacc = (f32x4){0.f, 0.f, 0.f, 0.f}; \
_Pragma("unroll") \
      for (int ks = 0; ks < NKD; ++ks) oacc = __builtin_amdgcn_mfma_f32_16x16x32_bf16(ldfrag(STc, LD_D, vt * 16 + fr, ks * 64 + fq * 16), ldfrag(QI, LD_D, it * 16 + fr, ks * 64 + fq * 16), oacc, 0, 0, 0); \
      if (NVT == 3) { \
_Pragma("unroll") \
        for (int ks = 0; ks < NKD; ++ks) dacc = __builtin_amdgcn_mfma_f32_16x16x32_bf16(ldfrag(STc, LD_D, 32 + fr, ks * 64 + fq * 16), ldfrag(QI, LD_D, it * 16 + fr, ks * 64 + fq * 16), dacc, 0, 0, 0); \
      } \
      if (MIXER == MIX_D) { oacc *= rr_cur; dacc *= rr_cur; } \
      asm volatile("s_waitcnt lgkmcnt(0)" ::: "memory"); \
      oacc = __builtin_amdgcn_mfma_f32_16x16x32_bf16(ldfrag(VTc, LD_T, vt * 16 + fr, fq * 16), ldfrag(SC, LD_T, it * 16 + fr, fq * 16), oacc, 0, 0, 0); \
      if (it >= 2) oacc = __builtin_amdgcn_mfma_f32_16x16x32_bf16(ldfrag(VTc, LD_T, vt * 16 + fr, 64 + fq * 16), ldfrag(SC, LD_T, it * 16 + fr, 64 + fq * 16), oacc, 0, 0, 0); \
      float dn = 1.0f; \
      if (NVT == 3) { \
        dacc = __builtin_amdgcn_mfma_f32_16x16x32_bf16(ldfrag(VTc, LD_T, 32 + fr, fq * 16), ldfrag(SC, LD_T, it * 16 + fr, fq * 16), dacc, 0, 0, 0); \
        if (it >= 2) dacc = __builtin_amdgcn_mfma_f32_16x16x32_bf16(ldfrag(VTc, LD_T, 32 + fr, 64 + fq * 16), ldfrag(SC, LD_T, it * 16 + fr, 64 + fq * 16), dacc, 0, 0, 0); \
        const float den = __shfl(dacc[0], fr); \
        dn = 1.0f / fmaxf(fabsf(den), EMc[it * 16 + fr]); \
      } \
      { \
        const int i = it * 16 + fr; \
        const int ti = dir ? (SEQ - 1 - (n * 64 + i)) : (n * 64 + i); \
        const f32x4 o = oacc * dn; \
        *(u32x2*)(O + PIDX(tokbase + ti, ocol + vt * 16 + fq * 4)) = (u32x2){pk_hw(o[0], o[1]), pk_hw(o[2], o[3])}; \
      } \
_Pragma("unroll") \
      for (int s = 0; s < NST; ++s) { \
        const int dt = (DK == 128) ? wid : (wid & 3), vt2 = (DK == 128) ? s : (wid >> 2); \
        const f32x4 dc = *(const f32x4*)(DECc + dt * 16 + fq * 4); \
        f32x4 acc = sacc[s] * dc; \
_Pragma("unroll") \
        for (int ks = 0; ks < 2; ++ks) acc = __builtin_amdgcn_mfma_f32_16x16x32_bf16(ldfrag(KTc, LD_T, dt * 16 + fr, ks * 64 + fq * 16), ldfrag(VTc, LD_T, vt2 * 16 + fr, ks * 64 + fq * 16), acc, 0, 0, 0); \
        sacc[s] = acc; \
        *(u32x2*)(STn + (vt2 * 16 + fr) * LD_D + (dt * 16 + fq * 4) * 2) = (u32x2){pk_hw(acc[0], acc[1]), pk_hw(acc[2], acc[3])}; \
      } \
    } \
    } \
    rr_cur = rr_next; \
    lds_barrier(); \
  } while (0)
  static_assert(NCH % 2 == 0, "chunk count must be even");
#pragma unroll 1
  for (int n2 = 0; n2 < NCH; n2 += 2) { SCAN_ITER(n2, R, Rv); SCAN_ITER(n2 + 1, Rn, Rvn); }
#undef SCAN_ITER
#undef A_LOAD
#undef A_PREP
}

template <int MIXER>
__device__ __forceinline__ void scan_dispatch2(unsigned char* lds, int wv, const Params& p, int id) {
  const int vs = id & 3, dir = (id >> 2) & 1, h = (id >> 3) & 3, b = id >> 5;
  scan_item2<MIXER>(lds, wv, p, b, h, dir, vs);
}
}

__device__ __forceinline__ void scan_phase2(unsigned char* lds, int wv, const Params& p, int layer) {
  for (int it0 = blockIdx.x; it0 < 256; it0 += gridDim.x) {
    const int xq = it0 & 7, yq = it0 >> 3, stream = (yq >> 2) * 8 + xq;
    const int item = (stream >> 5) * 128 + (stream & 31) * 4 + (yq & 3);
    if (layer == 0) { if (item < 128) scan2::scan_dispatch2<scan::MIX_A>(lds, wv, p, item); else scan2::scan_dispatch2<scan::MIX_B>(lds, wv, p, item - 128); }
    else { if (item < 128) scan2::scan_dispatch2<scan::MIX_D>(lds, wv, p, item); else scan2::scan_dispatch2<scan::MIX_C>(lds, wv, p, item - 128); }
    __syncthreads();
  }
}
#endif
#ifndef CPU_EMU
__device__ __forceinline__ void grid_bar(unsigned* ctr, unsigned& epoch, unsigned G, int wv) {
  asm volatile("s_waitcnt vmcnt(0)" ::: "memory");
  __syncthreads();
  epoch += G;
  if (wv == 0 && lane_id() == 0) {
    __builtin_amdgcn_fence(__ATOMIC_RELEASE, "agent");
    asm volatile("s_waitcnt vmcnt(0)" ::: "memory");
    __hip_atomic_fetch_add(ctr, 1u, __ATOMIC_RELAXED, __HIP_MEMORY_SCOPE_AGENT);
    unsigned spins = 0;
    while (__hip_atomic_load(ctr, __ATOMIC_RELAXED, __HIP_MEMORY_SCOPE_AGENT) < epoch) { __builtin_amdgcn_s_sleep(2); if (++spins > (1u << 26)) break; }
    __builtin_amdgcn_fence(__ATOMIC_ACQUIRE, "agent");
    asm volatile("s_waitcnt vmcnt(0)" ::: "memory");
  }
  __syncthreads();
}
#if (PROBE_DUP & 16)
#define grid_bar(a, b, c, d) do { grid_bar(a, b, c, d); grid_bar(a, b, c, d); } while (0)
#endif

__global__ void __launch_bounds__(NTHREADS) mk_fwd(Params p) {
  extern __shared__ __attribute__((aligned(16))) unsigned char lds_raw[];
  cg::grid_group grid = cg::this_grid();
  const int G = gridDim.x, bid = blockIdx.x;
  const int wv = __builtin_amdgcn_readfirstlane(threadIdx.x >> 6);
  PG8_LAS unsigned char* lds = (PG8_LAS unsigned char*)lds_raw;
  unsigned char* ws = p.ws;

  p0_prologue(lds_raw, wv, p);
#if (PROBE_DUP & 128)
  p0_prologue(lds_raw, wv, p);
#endif
  grid.sync();
  unsigned* bar = (unsigned*)(ws + WS_CTL) + 1024;
  unsigned epoch = 0;
  for (int layer = 0; layer < 2; ++layer) {
    { ProbInProj pr; pr.so.init(NTOK, layer == 0 ? PM_AB : PM_CD, G, bid); pr.A = (const char*)(ws + WS_HB); pr.Bt = (const char*)(ws + (layer == 0 ? WS_WIN_AB : WS_WIN_CD));
      pr.P = (bf16_t*)(ws + WS_R1); pr.bias = p.in[layer == 0 ? I_AB_B_IN : I_CD_B_IN]; pr.lb = (const float*)(ws + WS_LB); pr.layer = layer;
      pg8::gemm_phase(lds, pr, wv);
#if (PROBE_DUP & 1)
      pg8::gemm_phase(lds, pr, wv);
#endif
      if (layer == 0) side_phase<32>(lds_raw, wv, p, 0); else side_phase<16>(lds_raw, wv, p, 1);
#if (PROBE_DUP & 256)
      if (layer == 0) side_phase<32>(lds_raw, wv, p, 0); else side_phase<16>(lds_raw, wv, p, 1);
#endif
 }
    grid_bar(bar, epoch, (unsigned)G, wv);
    if (layer == 1) { convd_phase(lds_raw, wv, p); grid_bar(bar, epoch, (unsigned)G, wv); }
    scan_phase2(lds_raw, wv, p, layer);
#if (PROBE_DUP & 2)
    scan_phase2(lds_raw, wv, p, layer);
#endif
#if (PROBE_DUP & 512)
    if (layer == 0) scan_phase2(lds_raw, wv, p, layer);
#endif
#if (PROBE_DUP & 1024)
    if (layer == 1) scan_phase2(lds_raw, wv, p, layer);
#endif
    grid_bar(bar, epoch, (unsigned)G, wv);
    headnorm_phase(lds_raw, wv, p, layer);
#if (PROBE_DUP & 8)
    headnorm_phase(lds_raw, wv, p, layer);
#endif
    grid_bar(bar, epoch, (unsigned)G, wv);
    { ProbOutProj pr; pr.so.init(NTOK, 1024, G, bid); pr.A = (const char*)(ws + WS_HB); pr.Bt = (const char*)(ws + (layer == 0 ? WS_WOUT_AB : WS_WOUT_CD)); pr.Y = (float*)(ws + WS_R2);
      pg8::gemm_phase(lds, pr, wv);
#if (PROBE_DUP & 1)
      pg8::gemm_phase(lds, pr, wv);
#endif
      moe_weight_convert(lds_raw, wv, p, layer);
#if (PROBE_DUP & 4)
      moe_weight_convert(lds_raw, wv, p, layer);
#endif
 }
    grid_bar(bar, epoch, (unsigned)G, wv);
#if (PROBE_DUP & 32)
    ln_phase(lds_raw, wv, p, layer, 0, 1);
#endif
    ln_phase(lds_raw, wv, p, layer, 0);
    grid_bar(bar, epoch, (unsigned)G, wv);
    { ProbMoe1 pr; pr.mo.init((const int*)((const unsigned*)(ws + WS_CTL) + CW_CNT(layer)), 8, G, bid, lds_raw, wv);
      pr.A = (const char*)(ws + WS_HB); pr.W13 = (const char*)(ws + WS_WMOE); pr.list = (const int*)(ws + WS_LIST) + (size_t)layer * NEXP * NTOK; pr.H = (bf16_t*)(ws + WS_H);
      pg8::gemm_phase(lds, pr, wv);
#if (PROBE_DUP & 1)
      pg8::gemm_phase(lds, pr, wv);
#endif
 }
    grid_bar(bar, epoch, (unsigned)G, wv);
    { ProbMoe2 pr; pr.mo.init((const int*)((const unsigned*)(ws + WS_CTL) + CW_CNT(layer)), 4, G, bid, lds_raw, wv);
      pr.A = (const char*)(ws + WS_H); pr.W2 = (const char*)(ws + WS_WMOE) + (size_t)NEXP * 2048 * 1024 * 2; pr.Y = (bf16_t*)(ws + WS_R2);
      pg8::gemm_phase(lds, pr, wv);
#if (PROBE_DUP & 1)
      pg8::gemm_phase(lds, pr, wv);
#endif
 }
    grid_bar(bar, epoch, (unsigned)G, wv);
#if (PROBE_DUP & 64)
    ln_phase(lds_raw, wv, p, layer, 1, 1);
#endif
    ln_phase(lds_raw, wv, p, layer, 1);
    if (layer == 0) grid_bar(bar, epoch, (unsigned)G, wv);
  }
}

extern "C" void kernel_launch(void* const* d_in, const int* in_sizes, int n_in, void* d_out, int out_size, void* d_ws, size_t ws_size, hipStream_t stream) {
  static int grid_blocks = 0;
  if (grid_blocks == 0) {
    if (n_in != N_IN || ws_size < WS_END || out_size != NTOK * 1024) { fprintf(stderr, "kernel_launch: bad shapes: n_in %d ws %zu (need %zu) out %d\n", n_in, ws_size, (size_t)WS_END, out_size); grid_blocks = -1; return; }
    int dev = 0, cus = 0, per_cu = 0;
    hipGetDevice(&dev); hipDeviceGetAttribute(&cus, hipDeviceAttributeMultiprocessorCount, dev);
    if (hipFuncSetAttribute((const void*)mk_fwd, hipFuncAttributeMaxDynamicSharedMemorySize, LDS_BYTES) != hipSuccess) { fprintf(stderr, "kernel_launch: hipFuncSetAttribute failed\n"); grid_blocks = -1; return; }
    if (hipOccupancyMaxActiveBlocksPerMultiprocessor(&per_cu, (const void*)mk_fwd, NTHREADS, LDS_BYTES) != hipSuccess || per_cu < 1) { fprintf(stderr, "kernel_launch: occupancy query failed (%d)\n", per_cu); grid_blocks = -1; return; }
    grid_blocks = cus;
    (void)in_sizes;
  }
  if (grid_blocks < 0) return;
  Params p{};
  for (int i = 0; i < N_IN; ++i) p.in[i] = (const float*)d_in[i];
  p.out = (float*)d_out; p.ws = (unsigned char*)d_ws;
  void* args[] = {&p};
  hipError_t e = hipLaunchCooperativeKernel((const void*)mk_fwd, dim3(grid_blocks), dim3(NTHREADS), args, LDS_BYTES, stream);
  if (e != hipSuccess) fprintf(stderr, "cooperative launch failed: %s (grid %d)\n", hipGetErrorString(e), grid_blocks);
}
#endif
#ifdef CPU_EMU
#include <vector>
void dbg_cmp(const char* name, const float* p, long n);
template <class F> static void run_functor(const F& f, long n) {
#pragma omp parallel for schedule(dynamic, 16)
  for (long g = 0; g < n; ++g) f(g);
}
static void cpu_round_w(const float* src, size_t n, std::vector<float>& dst) { dst.resize(n); for (size_t i = 0; i < n; ++i) dst[i] = bf2f(f2bf(src[i])); }

extern "C" void kernel_launch(void* const* d_in, const int* in_sizes, int n_in, void* d_out, int out_size, void* d_ws, size_t ws_size, hipStream_t) {
  (void)in_sizes; (void)n_in; (void)out_size;
  if (ws_size < WS_END) { printf("ws too small %zu < %zu\n", ws_size, (size_t)WS_END); return; }
  Params p{}; for (int i = 0; i < N_IN; ++i) p.in[i] = (const float*)d_in[i];
  p.out = (float*)d_out; p.ws = (unsigned char*)d_ws;
  unsigned char* ws = p.ws;
  bf16_t* HB = (bf16_t*)(ws + WS_HB); bf16_t* P = (bf16_t*)(ws + WS_R1); bf16_t* LFB = (bf16_t*)(ws + WS_LFB);
  bf16_t* O = (bf16_t*)(ws + WS_R2); float* yf = (float*)(ws + WS_R2); bf16_t* Y = (bf16_t*)(ws + WS_R2); bf16_t* H = (bf16_t*)(ws + WS_H);
  float* side = (float*)(ws + WS_SIDE); float* oside = (float*)(ws + WS_OSIDE); float* rope = (float*)(ws + WS_ROPE); float* lb = (float*)(ws + WS_LB);
  int* assign = (int*)(ws + WS_ASSIGN); float* gate = (float*)(ws + WS_GATE);
  for (size_t i = 0; i < (size_t)NTOK * 1024; ++i) HB[i] = f2bf(p.in[I_X][i]);
  for (int i = 0; i < SEQ * 32; ++i) { int t = i >> 5, f = i & 31; float freq = powf(10000.0f, -(float)f / 32.0f); float ang = (float)t * freq; rope[i * 2] = cosf(ang); rope[i * 2 + 1] = sinf(ang); }
  for (int cc = 0; cc < 512; ++cc) { const float* hl = p.in[I_HGRN_LB]; float a0 = hl[cc], a1 = hl[512 + cc], a2 = hl[1024 + cc]; float mx = fmaxf(a0, fmaxf(a1, a2));
    float e0 = expf(a0 - mx), e1 = expf(a1 - mx), e2 = expf(a2 - mx); lb[cc] = e0 / (e0 + e1 + e2); }
  std::vector<float> wr;
  for (int layer = 0; layer < 2; ++layer) {
    const int PW = layer == 0 ? P_AB : P_CD, PM = layer == 0 ? PM_AB : PM_CD;
    const float* bias = p.in[layer == 0 ? I_AB_B_IN : I_CD_B_IN];
    cpu_round_w(p.in[layer == 0 ? I_AB_W_IN : I_CD_W_IN], (size_t)1024 * PW, wr);
#pragma omp parallel for
    for (long tok = 0; tok < NTOK; ++tok) {
      std::vector<float> acc(PW, 0.f);
      for (int k = 0; k < 1024; ++k) { float a = bf2f(HB[tok * 1024 + k]); const float* w = &wr[(size_t)k * PW]; for (int n = 0; n < PW; ++n) acc[n] += a * w[n]; }
      for (int n = 0; n < PM; ++n) { float v = acc[n] + bias[n]; if (layer == 0) v = epi_ab(n, v, lb); P[tok * PSTRIDE + n] = f2bf(v); }
      for (int n = PM; n < PW; ++n) side[tok * 32 + (n - PM)] = acc[n] + bias[n];
      if (layer == 0) for (int dir = 0; dir < 2; ++dir) for (int cc = 0; cc < 256; ++cc) {
        float z = p.in[I_GK_B][dir * 256 + cc];
        for (int r = 0; r < 16; ++r) z += side[tok * 32 + dir * 16 + r] * p.in[I_GK_UP][(dir * 16 + r) * 256 + cc];
        LFB[tok * 512 + dir * 256 + cc] = f2bf(logsigmoidf_(z) * 0.0625f); }
    }
    if (layer == 0) { ScanAB2 s{}; s.P = P; s.LFB = LFB; s.O = O; run_functor(s, (long)BATCH * 2048); }
    else { PrepCD2 pc{}; pc.P = P; pc.QD = LFB; pc.rope = rope; pc.conv_w = p.in[I_CONV_W]; pc.conv_b = p.in[I_CONV_B]; run_functor(pc, (long)NTOK * 1280);
      ScanCD2 s{}; s.P = P; s.QD = LFB; s.side = side; s.fgate_b = p.in[I_FGATE_B]; s.O = O; s.oside = oside; run_functor(s, (long)BATCH * 2056); }
#pragma omp parallel for
    for (long tok = 0; tok < NTOK; ++tok) for (int h8 = 0; h8 < 8; ++h8) {
      float sf = 1.f, sb = 1.f;
      if (layer == 1 && h8 >= 4) { int h = h8 - 4; const float* s0 = oside + tok * 8 + h * 2; const float* s1 = oside + (size_t)(NTOK + tok) * 8 + h * 2;
        sf = 1.0f / fmaxf(fabsf(s0[0]), expf(-s0[1])); sb = 1.0f / fmaxf(fabsf(s1[0]), expf(-s1[1])); }
      float o[128]; float ss = 0.f;
      for (int j = 0; j < 128; ++j) { int c = h8 * 128 + j; o[j] = bf2f(O[tok * 1024 + c]) * sf + bf2f(O[(size_t)(NTOK + tok) * 1024 + c]) * sb; ss += o[j] * o[j]; }
      float r = 1.0f / sqrtf(ss * (1.0f / 128.0f) + NORM_EPS_F);
      for (int j = 0; j < 128; ++j) { int c = h8 * 128 + j; float gn, gt;
        if (layer == 0) { gn = h8 < 4 ? p.in[I_HGRN_NORM][c] : p.in[I_GLA_NORM][c - 512]; gt = siluf_(bf2f(P[tok * PSTRIDE + (h8 < 4 ? 2048 + c : 3584 + c - 512)])); }
        else { gn = h8 < 4 ? p.in[I_RET_NORM][c] : p.in[I_MLSTM_NORM][c - 512]; float gr = bf2f(P[tok * PSTRIDE + (h8 < 4 ? 1024 + c : 3072 + c - 512)]); gt = h8 < 4 ? siluf_(gr) : sigmoidf_(gr); }
        HB[tok * 1024 + c] = f2bf(o[j] * r * gn * gt); }
    }
    cpu_round_w(p.in[layer == 0 ? I_AB_W_OUT : I_CD_W_OUT], (size_t)1024 * 1024, wr);
#pragma omp parallel for
    for (long tok = 0; tok < NTOK; ++tok) { std::vector<float> acc(1024, 0.f);
      for (int k = 0; k < 1024; ++k) { float a = bf2f(HB[tok * 1024 + k]); const float* w = &wr[(size_t)k * 1024]; for (int n = 0; n < 1024; ++n) acc[n] += a * w[n]; }
      for (int n = 0; n < 1024; ++n) yf[tok * 1024 + n] = acc[n]; }
    dbg_cmp(layer == 0 ? "y_mix0" : "y_mix1", yf, (long)NTOK * 1024);
    int cnt[NEXP] = {0}; std::vector<int> list((size_t)NEXP * NTOK);
    const float* hin = layer == 0 ? p.in[I_X] : p.out;
    for (long tok = 0; tok < NTOK; ++tok) {
      float v[1024]; double s = 0; for (int c = 0; c < 1024; ++c) { v[c] = ALPHA_F * hin[tok * 1024 + c] + yf[tok * 1024 + c]; s += v[c]; }
      float mean = (float)(s / 1024); double q = 0; for (int c = 0; c < 1024; ++c) { v[c] -= mean; q += (double)v[c] * v[c]; }
      float r = 1.0f / sqrtf((float)(q / 1024) + LN_EPS_F);
      float lg[16] = {0};
      for (int c = 0; c < 1024; ++c) { v[c] = v[c] * r * p.in[I_LN_MIX_G][layer * 1024 + c] + p.in[I_LN_MIX_B][layer * 1024 + c]; p.out[tok * 1024 + c] = v[c]; HB[tok * 1024 + c] = f2bf(v[c]);
        for (int e = 0; e < 16; ++e) lg[e] += v[c] * p.in[I_ROUTER_W][c * 16 + e]; }
      int eo[2]; float go[2]; route_from_logits(lg, p.in[I_ROUTER_B], eo, go);
      int r1 = cnt[eo[0]]++, r2 = cnt[eo[1]]++;
      list[(size_t)eo[0] * NTOK + r1] = (int)tok; list[(size_t)eo[1] * NTOK + r2] = (int)tok;
      assign[tok * 4] = eo[0]; assign[tok * 4 + 1] = r1; assign[tok * 4 + 2] = eo[1]; assign[tok * 4 + 3] = r2; gate[tok * 2] = go[0]; gate[tok * 2 + 1] = go[1];
    }
    dbg_cmp(layer == 0 ? "h_mix0" : "h_mix1", p.out, (long)NTOK * 1024);
    int pad[NEXP]; { int a = 0; for (int e = 0; e < NEXP; ++e) { pad[e] = a; a += ((cnt[e] + 255) >> 8) << 8; } }
    const size_t lo = (size_t)layer * NEXP * 1024 * 1024;
    for (int e = 0; e < NEXP; ++e) {
      std::vector<float> w1, w3, w2; cpu_round_w(p.in[I_MOE_W1] + lo + (size_t)e * 1048576, 1048576, w1); cpu_round_w(p.in[I_MOE_W3] + lo + (size_t)e * 1048576, 1048576, w3); cpu_round_w(p.in[I_MOE_W2] + lo + (size_t)e * 1048576, 1048576, w2);
#pragma omp parallel for
      for (int rr = 0; rr < cnt[e]; ++rr) { int tok = list[(size_t)e * NTOK + rr]; size_t pos = pad[e] + rr;
        std::vector<float> a1(1024, 0.f), a3(1024, 0.f), a2(1024, 0.f);
        for (int k = 0; k < 1024; ++k) { float a = bf2f(HB[(size_t)tok * 1024 + k]); const float* p1 = &w1[(size_t)k * 1024]; const float* p3 = &w3[(size_t)k * 1024]; for (int n = 0; n < 1024; ++n) { a1[n] += a * p1[n]; a3[n] += a * p3[n]; } }
        for (int n = 0; n < 1024; ++n) H[pos * 1024 + n] = f2bf(siluf_(a1[n]) * a3[n]);
        for (int k = 0; k < 1024; ++k) { float a = bf2f(H[pos * 1024 + k]); const float* p2 = &w2[(size_t)k * 1024]; for (int n = 0; n < 1024; ++n) a2[n] += a * p2[n]; }
        for (int n = 0; n < 1024; ++n) Y[pos * 1024 + n] = f2bf(a2[n]); }
    }
    for (long tok = 0; tok < NTOK; ++tok) {
      size_t p0 = pad[assign[tok * 4]] + assign[tok * 4 + 1], p1 = pad[assign[tok * 4 + 2]] + assign[tok * 4 + 3];
      float v[1024]; double s = 0; for (int c = 0; c < 1024; ++c) { v[c] = ALPHA_F * p.out[tok * 1024 + c] + gate[tok * 2] * bf2f(Y[p0 * 1024 + c]) + gate[tok * 2 + 1] * bf2f(Y[p1 * 1024 + c]); s += v[c]; }
      float mean = (float)(s / 1024); double q = 0; for (int c = 0; c < 1024; ++c) { v[c] -= mean; q += (double)v[c] * v[c]; }
      float r = 1.0f / sqrtf((float)(q / 1024) + LN_EPS_F);
      for (int c = 0; c < 1024; ++c) { v[c] = v[c] * r * p.in[I_LN_FFN_G][layer * 1024 + c] + p.in[I_LN_FFN_B][layer * 1024 + c]; p.out[tok * 1024 + c] = v[c]; HB[tok * 1024 + c] = f2bf(v[c]); }
    }
    dbg_cmp(layer == 0 ? "h_ffn0" : "h_ffn1", p.out, (long)NTOK * 1024);
  }
}
#endif
```

```cpp
#ifdef CPU_EMU
#include <cmath>
#include <cstdio>
#include <cstring>
#include <cstdlib>
#include <cstddef>
#define DEV
#define DEV_INLINE static inline
typedef void* hipStream_t;
#else
#include <hip/hip_runtime.h>
#include <hip/hip_bf16.h>
#include <cstdio>
#define DEV __device__ __forceinline__
#define DEV_INLINE __device__ __forceinline__
#endif
#ifndef PROBE_DUP
#define PROBE_DUP 0
#endif
#ifndef BATCH
#define BATCH 4
#endif
#ifndef SEQ
#define SEQ 8192
#endif
#define DM 1024
#define NTOK (BATCH * SEQ)
#define P_AB 4128
#define P_CD 3600
#define PM_AB 4096
#define PM_CD 3584
#define NEXP 16
#define ALPHA_F 1.4142135623730951f
#define LN_EPS_F 1e-5f
#define NORM_EPS_F 1e-6f
#define HROWS (2 * NTOK + NEXP * 256)

typedef unsigned short bf16_t;

DEV_INLINE float bf2f(bf16_t b) { unsigned u = ((unsigned)b) << 16; float f; memcpy(&f, &u, 4); return f; }
DEV_INLINE bf16_t f2bf(float f) { unsigned u; memcpy(&u, &f, 4); u += 0x7FFFu + ((u >> 16) & 1u); return (bf16_t)(u >> 16); }
DEV_INLINE float sigmoidf_(float x) { return 1.0f / (1.0f + expf(-x)); }
DEV_INLINE float siluf_(float x) { return x / (1.0f + expf(-x)); }
DEV_INLINE float logsigmoidf_(float x) { return fminf(x, 0.0f) - log1pf(expf(-fabsf(x))); }

#define AL256(x) (((size_t)(x) + 255) & ~(size_t)255)
#define WS_CTL    ((size_t)0)
#define WS_HB     ((size_t)65536)
#define WS_R1     (WS_HB + (size_t)NTOK * 1024 * 2)
#define R1_P_BYTES ((size_t)NTOK * 4096 * 2)
#define R1_MIN    (AL256((size_t)HROWS * 1024 * 2) + (size_t)NEXP * 3072 * 1024 * 2)
#define R1_PL     (R1_P_BYTES + (size_t)NTOK * 512 * 2)
#define R1_BYTES  (R1_PL > R1_MIN ? R1_PL : R1_MIN)
#define WS_LFB    (WS_R1 + R1_P_BYTES)
#define WS_H      (WS_R1)
#define WS_WMOE   (WS_R1 + AL256((size_t)HROWS * 1024 * 2))
#define WMOE_BYTES ((size_t)NEXP * 3072 * 1024 * 2)
#define WS_R2     (WS_R1 + R1_BYTES)
#define R2_BYTES  ((size_t)HROWS * 1024 * 2 > (size_t)NTOK * 1024 * 4 ? (size_t)HROWS * 1024 * 2 : (size_t)NTOK * 1024 * 4)
#define WS_SIDE   (WS_R2 + AL256(R2_BYTES))
#define WS_OSIDE  (WS_SIDE + (size_t)NTOK * 32 * 4)
#define WS_WIN_AB (WS_OSIDE + (size_t)2 * NTOK * 8 * 4)
#define WS_WIN_CD (WS_WIN_AB + (size_t)4128 * 1024 * 2)
#define WS_WOUT_AB (WS_WIN_CD + (size_t)3600 * 1024 * 2)
#define WS_WOUT_CD (WS_WOUT_AB + (size_t)1024 * 1024 * 2)
#define WS_ROPE   (WS_WOUT_CD + (size_t)1024 * 1024 * 2)
#define WS_LB     (WS_ROPE + (size_t)SEQ * 64 * 4)
#define WS_LIST   (WS_LB + 4096)
#define WS_ASSIGN (WS_LIST + (size_t)2 * NEXP * NTOK * 4)
#define WS_GATE   (WS_ASSIGN + (size_t)NTOK * 16)
#define WS_END    (WS_GATE + (size_t)NTOK * 8)
#define CW_CNT(layer) (64 + 256 * (layer))

#define PSTRIDE 4096
#define PIDX(tok, col) ((((size_t)((col) >> 7)) * NTOK + (size_t)(tok)) * 128 + (size_t)((col) & 127))

enum { I_X, I_AB_W_IN, I_AB_B_IN, I_HGRN_LB, I_GK_UP, I_GK_B, I_HGRN_NORM, I_GLA_NORM, I_AB_W_OUT,
       I_CD_W_IN, I_CD_B_IN, I_CONV_W, I_CONV_B, I_FGATE_B, I_RET_NORM, I_MLSTM_NORM, I_CD_W_OUT,
       I_LN_MIX_G, I_LN_MIX_B, I_LN_FFN_G, I_LN_FFN_B, I_ROUTER_W, I_ROUTER_B, I_MOE_W1, I_MOE_W3, I_MOE_W2, N_IN };

struct Params {
  const float* in[N_IN];
  float* out;
  unsigned char* ws;
};

DEV_INLINE float epi_ab(int col, float v, const float* lb) {
  if (col < 512) return siluf_(v);
  if (col < 1536) { float l = lb[(col - 512) & 511]; return logf(l + (1.0f - l) * sigmoidf_(v)); }
  if (col >= 2560 && col < 2816) return v * 0.125f;
  return v;
}

DEV_INLINE void route_from_logits(const float* lg, const float* rb, int* e_out, float* g_out) {
  float mx = lg[0];
#pragma unroll
  for (int e = 1; e < 16; ++e) mx = fmaxf(mx, lg[e]);
  float sc[16]; float sum = 0.f;
#pragma unroll
  for (int e = 0; e < 16; ++e) { sc[e] = expf(lg[e] - mx); sum += sc[e]; }
  float inv = 1.0f / sum;
  float best_gs = -1e30f; int be1 = 0, be2 = 1; float bs1 = 0.f, bs2 = 0.f;
#pragma unroll
  for (int gq = 0; gq < 4; ++gq) {
    float m1 = -1e30f, m2 = -1e30f, s1 = 0.f, s2 = 0.f; int i1 = 0, i2 = 0;
#pragma unroll
    for (int i = 0; i < 4; ++i) {
      float s = sc[gq * 4 + i] * inv; float v = s + rb[gq * 4 + i];
      if (v > m1) { m2 = m1; i2 = i1; s2 = s1; m1 = v; i1 = gq * 4 + i; s1 = s; }
      else if (v > m2) { m2 = v; i2 = gq * 4 + i; s2 = s; }
    }
    float gs = m1 + m2;
    if (gs > best_gs) { best_gs = gs; be1 = i1; be2 = i2; bs1 = s1; bs2 = s2; }
  }
  e_out[0] = be1; e_out[1] = be2; g_out[0] = bs1 / (bs1 + bs2); g_out[1] = bs2 / (bs1 + bs2);
}
struct ScanAB2 {
  const bf16_t* P; const bf16_t* LFB; bf16_t* O;
  DEV void operator()(long gid) const {
    int j = (int)(gid & 127), h = (int)((gid >> 7) & 3), dir = (int)((gid >> 9) & 1), mixer = (int)((gid >> 10) & 1), b = (int)(gid >> 11);
    bf16_t* Od = O + (size_t)dir * NTOK * 1024;
    if (mixer == 0) {
      float S[128];
#pragma unroll
      for (int d = 0; d < 128; ++d) S[d] = 0.f;
      for (int s = 0; s < SEQ; ++s) {
        size_t t = (size_t)b * SEQ + (dir ? (SEQ - 1 - s) : s);
        const bf16_t* row = P + t * PSTRIDE;
        const bf16_t* q = row + h * 128; const bf16_t* lf = row + 512 + dir * 512 + h * 128;
        float v = bf2f(row[1536 + h * 128 + j]);
        float o = 0.f;
#pragma unroll
        for (int d = 0; d < 128; ++d) { float fd = expf(bf2f(lf[d])); S[d] = fd * S[d] + (1.0f - fd) * v; o += bf2f(q[d]) * S[d]; }
        Od[t * 1024 + h * 128 + j] = f2bf(o);
      }
    } else {
      float S[64];
#pragma unroll
      for (int d = 0; d < 64; ++d) S[d] = 0.f;
      for (int s = 0; s < SEQ; ++s) {
        size_t t = (size_t)b * SEQ + (dir ? (SEQ - 1 - s) : s);
        const bf16_t* row = P + t * PSTRIDE;
        const bf16_t* q = row + 2560 + h * 64; const bf16_t* k = row + 2816 + h * 64;
        const bf16_t* lf = LFB + t * 512 + dir * 256 + h * 64;
        float v = bf2f(row[3072 + h * 128 + j]);
        float o = 0.f;
#pragma unroll
        for (int d = 0; d < 64; ++d) { S[d] = expf(bf2f(lf[d])) * S[d] + bf2f(k[d]) * v; o += bf2f(q[d]) * S[d]; }
        Od[t * 1024 + 512 + h * 128 + j] = f2bf(o);
      }
    }
  }
};

struct PrepCD2 {
  bf16_t* P; bf16_t* QD; const float* rope; const float* conv_w; const float* conv_b;
  DEV void operator()(long gid) const {
    size_t tok = (size_t)(gid / 1280); int c = (int)(gid % 1280); int t = (int)(tok % SEQ);
    bf16_t* row = P + tok * PSTRIDE;
    if (c < 256) {
      int isk = c >> 7, hh = (c >> 5) & 3, i = c & 31;
      float cs = rope[(t * 32 + i) * 2], sn = rope[(t * 32 + i) * 2 + 1];
      bf16_t* base = row + isk * 256 + hh * 64;
      float a1 = bf2f(base[i]), a2 = bf2f(base[i + 32]);
      float sc = isk ? 1.0f : 0.125f;
      base[i] = f2bf((a1 * cs - a2 * sn) * sc); base[i + 32] = f2bf((a1 * sn + a2 * cs) * sc);
    } else {
      int cc = c - 256;
      float acc = conv_b[cc] + bf2f(row[1536 + cc]) * conv_w[1024 + cc];
      if (t > 0) acc += bf2f(row[1536 + cc - PSTRIDE]) * conv_w[cc];
      if (t < SEQ - 1) acc += bf2f(row[1536 + cc + PSTRIDE]) * conv_w[2048 + cc];
      float s = siluf_(acc);
      if (cc < 512) QD[tok * 512 + cc] = f2bf(s * 0.08838834764831845f);
      else row[3584 + (cc - 512)] = f2bf(s);
    }
  }
};

struct ScanCD2 {
  const bf16_t* P; const bf16_t* QD; const float* side; const float* fgate_b; bf16_t* O; float* oside;
  DEV void operator()(long gid) const {
    int b = (int)(gid / 2056); int g = (int)(gid % 2056);
    if (g < 1024) {
      int j = g & 127, h = (g >> 7) & 3, dir = (g >> 9) & 1;
      bf16_t* Od = O + (size_t)dir * NTOK * 1024;
      float gamma = 1.0f - exp2f(-(5.0f + 2.0f * (float)h + (float)dir));
      float S[64];
#pragma unroll
      for (int d = 0; d < 64; ++d) S[d] = 0.f;
      for (int s = 0; s < SEQ; ++s) {
        size_t t = (size_t)b * SEQ + (dir ? (SEQ - 1 - s) : s);
        const bf16_t* row = P + t * PSTRIDE;
        const bf16_t* q = row + h * 64; const bf16_t* k = row + 256 + h * 64;
        float v = bf2f(row[512 + h * 128 + j]);
        float o = 0.f;
#pragma unroll
        for (int d = 0; d < 64; ++d) { S[d] = gamma * S[d] + bf2f(k[d]) * v; o += bf2f(q[d]) * S[d]; }
        Od[t * 1024 + h * 128 + j] = f2bf(o);
      }
    } else {
      g -= 1024;
      int j = g % 129, h = (g / 129) & 3, dir = g / (129 * 4);
      bf16_t* Od = O + (size_t)dir * NTOK * 1024; float* os = oside + (size_t)dir * NTOK * 8;
      float fb = fgate_b[dir * 4 + h];
      float S[128];
#pragma unroll
      for (int d = 0; d < 128; ++d) S[d] = 0.f;
      float m = 0.f;
      for (int s = 0; s < SEQ; ++s) {
        size_t t = (size_t)b * SEQ + (dir ? (SEQ - 1 - s) : s);
        const bf16_t* row = P + t * PSTRIDE;
        const bf16_t* q = QD + t * 512 + h * 128; const bf16_t* k = row + 3584 + h * 128;
        float v = (j < 128) ? bf2f(row[2560 + h * 128 + j]) : 1.0f;
        float li = side[t * 32 + dir * 8 + h];
        float lf = logsigmoidf_(side[t * 32 + dir * 8 + 4 + h] + fb);
        float mn = fmaxf(lf + m, li);
        float fs = expf(lf + m - mn), is = expf(li - mn) * v;
        m = mn;
        float o = 0.f;
#pragma unroll
        for (int d = 0; d < 128; ++d) { S[d] = fs * S[d] + is * bf2f(k[d]); o += bf2f(q[d]) * S[d]; }
        if (j < 128) Od[t * 1024 + 512 + h * 128 + j] = f2bf(o);
        else { os[t * 8 + h * 2] = o; os[t * 8 + h * 2 + 1] = m; }
      }
    }
  }
};
#ifndef CPU_EMU
namespace pg8 {
#define PG8_LAS __attribute__((address_space(3)))
typedef short bf16x8 __attribute__((ext_vector_type(8)));
typedef float f32x4 __attribute__((ext_vector_type(4)));
typedef unsigned u32x4 __attribute__((ext_vector_type(4)));
typedef unsigned u32x2 __attribute__((ext_vector_type(2)));
constexpr int BM = 256, BK = 64, HALF = 128, HTB = HALF * BK * 2, STAGE_BYTES = 8 * HTB, NXCD = 8, WGM = 8, GK = 1024;

__device__ __forceinline__ int lds_byte(int r, int c) { const int st = (r >> 4) * 2 + (c >> 5), rr = r & 15, cc = c & 31, ob = rr * 64 + cc * 2; return st * 1024 + (ob ^ (((ob >> 9) & 1) << 5)); }
__device__ __forceinline__ void stage_rc(int b, int& R, int& C) { const int st = b / 1024, sb = b % 1024, swz = sb ^ (((sb >> 9) & 1) << 5); R = (st >> 1) * 16 + swz / 64; C = (st & 1) * 32 + (swz % 64) / 2; }
__device__ __forceinline__ int perm32(int rho) { const int n = rho >> 4, i = rho & 15; return 8 * (i >> 2) + 4 * n + (i & 3); }
__device__ __forceinline__ unsigned cvt_pk_bf16(float lo, float hi) { unsigned r; asm volatile("v_cvt_pk_bf16_f32 %0, %1, %2" : "=v"(r) : "v"(lo), "v"(hi)); return r; }

struct Unit { int pm, pn, e, row0, ne; };

struct StaticOrder {
  int nM, nN, nwg, G, c;
  __device__ void init(int M, int N, int G_, int c_) { nM = M / BM; nN = N / BM; nwg = nM * nN; G = G_; c = c_; }
  __device__ bool next(int i, Unit& u) const {
    const long L = (long)i * G + c; if (L >= nwg) return false;
    int wgid = (int)L; { const int q = nwg / NXCD, r = nwg % NXCD, xcd = wgid % NXCD, off = wgid / NXCD; wgid = (xcd < r ? xcd * (q + 1) : r * (q + 1) + (xcd - r) * q) + off; }
    const int nig = WGM * nN, gid = wgid / nig, fm = gid * WGM, gsz = (nM - fm) < WGM ? (nM - fm) : WGM;
    u.pm = fm + ((wgid % nig) % gsz); u.pn = (wgid % nig) / gsz; u.e = 0; u.row0 = u.pm * BM; u.ne = 0; return true;
  }
};

template <class Prob>
__device__ __forceinline__ void gemm_phase(PG8_LAS unsigned char* lds, const Prob& S, int wv) {
  int wv_ = wv; asm volatile("" : "+s"(wv_));
  int l_; asm volatile("v_mbcnt_lo_u32_b32 %0, -1, 0\n\tv_mbcnt_hi_u32_b32 %0, -1, %0" : "=v"(l_));
  int tid_ = wv_ * 64 + l_;
  const int tid = tid_, wid = __builtin_amdgcn_readfirstlane(tid >> 6), lane = tid & 63, wr = wid >> 2, wc = wid & 3, fr = lane & 15, fq = lane >> 4;
  constexpr int K = GK, nt = K / BK;
  int sR[2], sC[2]; unsigned voffB[2];
#pragma unroll
  for (int i = 0; i < 2; ++i) { int R, C; stage_rc(tid * 16 + i * 8192, R, C); sR[i] = R; sC[i] = C; const int Rb = Prob::PERM ? ((R & ~31) + perm32(R & 31)) : R; voffB[i] = (unsigned)(Rb * K + C) * 2u; }
  const size_t kstep = (size_t)(BK * 2);
  const size_t hstep = (size_t)HALF * K * 2;
  const unsigned ldsw = (unsigned)wid * 1024u;
  const int aoff = lds_byte(wr * 64 + fr, fq * 8), boff = lds_byte(wc * 32 + fr, fq * 8);
#define PG8_SA(b, h) (((b) * 2 + (h)) * HTB)
#define PG8_SB(b, h) ((4 + (b) * 2 + (h)) * HTB)
#define PG8_STAGE(bufoff, gbase, voff) do { _Pragma("unroll") for (int _i = 0; _i < 2; ++_i) \
    __builtin_amdgcn_global_load_lds((const unsigned*)((const char*)(gbase) + (voff)[_i]), (PG8_LAS unsigned*)(lds + (bufoff) + ldsw + _i * 8192), 16, 0, 0); } while (0)
#define PG8_LDA(dst, b, h) do { _Pragma("unroll") for (int m = 0; m < 4; ++m) _Pragma("unroll") for (int k = 0; k < 2; ++k) dst[m][k] = *(const PG8_LAS bf16x8*)(lds + PG8_SA(b, h) + aoff + m * 2048 + k * 1024); } while (0)
#define PG8_LDB(dst, b, h) do { _Pragma("unroll") for (int n = 0; n < 2; ++n) _Pragma("unroll") for (int k = 0; k < 2; ++k) dst[n][k] = *(const PG8_LAS bf16x8*)(lds + PG8_SB(b, h) + boff + n * 2048 + k * 1024); } while (0)
#define PG8_MMA(ai, bj, At, Bt) do { __builtin_amdgcn_s_setprio(1); _Pragma("unroll") for (int m = 0; m < 4; ++m) _Pragma("unroll") for (int n = 0; n < 2; ++n) _Pragma("unroll") for (int k = 0; k < 2; ++k) \
    acc[ai][bj][m][n] = __builtin_amdgcn_mfma_f32_16x16x32_bf16(Bt[n][k], At[m][k], acc[ai][bj][m][n], 0, 0, 0); __builtin_amdgcn_s_setprio(0); } while (0)
#define PG8_WAIT_V(n) asm volatile("s_waitcnt vmcnt(" #n ")" ::: "memory")
#define PG8_WAIT_L(n) asm volatile("s_waitcnt lgkmcnt(" #n ")" ::: "memory")
#define PG8_BAR __builtin_amdgcn_s_barrier()
#define PG8_SCHED __builtin_amdgcn_sched_barrier(0)
  Unit cur, nxt; int ui = 0;
  if (!S.next(0, cur)) return;
  f32x4 acc[2][2][4][2];
#pragma unroll
  for (int a = 0; a < 2; ++a)
#pragma unroll
    for (int b = 0; b < 2; ++b)
#pragma unroll
      for (int m = 0; m < 4; ++m)
#pragma unroll
        for (int n = 0; n < 2; ++n) acc[a][b][m][n] = (f32x4){0.f, 0.f, 0.f, 0.f};
  bf16x8 At[4][2], B0[2][2], B1[2][2];
  unsigned oc0[2], oc1[2], on0[2], on1[2];
#pragma unroll
  for (int i = 0; i < 2; ++i) { oc0[i] = S.a_off(cur, sR[i]) + (unsigned)sC[i] * 2u; oc1[i] = S.a_off(cur, HALF + sR[i]) + (unsigned)sC[i] * 2u; }
  const char* const Ab = S.a_base();
  const char* cB = S.b_base(cur);
  PG8_STAGE(PG8_SB(0, 0), cB, voffB); PG8_STAGE(PG8_SA(0, 0), Ab, oc0); PG8_STAGE(PG8_SB(0, 1), cB + hstep, voffB); PG8_STAGE(PG8_SA(0, 1), Ab, oc1);
  if (wr == 1) PG8_BAR;
  PG8_WAIT_V(4); PG8_BAR;
  PG8_STAGE(PG8_SB(1, 0), cB + kstep, voffB); PG8_STAGE(PG8_SA(1, 0), Ab + kstep, oc0); PG8_STAGE(PG8_SB(1, 1), cB + hstep + kstep, voffB);
  PG8_WAIT_V(6); PG8_BAR;
  for (;;) {
    const bool has_next = S.next(ui + 1, nxt);
    const char* nB = cB;
    if (has_next) {
      nB = S.b_base(nxt);
      int l2_; asm volatile("v_mbcnt_lo_u32_b32 %0, -1, 0\n\tv_mbcnt_hi_u32_b32 %0, -1, %0" : "=v"(l2_));
      const int tid2 = wid * 64 + l2_;
#pragma unroll
      for (int i = 0; i < 2; ++i) { int R, C; stage_rc(tid2 * 16 + i * 8192, R, C); on0[i] = S.a_off(nxt, R) + (unsigned)C * 2u; on1[i] = S.a_off(nxt, HALF + R) + (unsigned)C * 2u; }
    } else {
#pragma unroll
      for (int i = 0; i < 2; ++i) { on0[i] = oc0[i]; on1[i] = oc1[i]; }
    }
    for (int t = 0; t < nt; t += 2) {
      const bool last = (t == nt - 2);
      const char* a1 = Ab + (size_t)(t + 1) * kstep;
      const char* a2 = last ? Ab : Ab + (size_t)(t + 2) * kstep; const char* b2 = last ? nB : cB + (size_t)(t + 2) * kstep;
      const char* a3 = a2 + kstep; const char* b3 = b2 + kstep;
      unsigned o20[2], o21[2];
#pragma unroll
      for (int i = 0; i < 2; ++i) { o20[i] = last ? on0[i] : oc0[i]; o21[i] = last ? on1[i] : oc1[i]; }
      PG8_LDB(B0, 0, 0); PG8_SCHED; PG8_LDA(At, 0, 0); PG8_STAGE(PG8_SA(1, 1), a1, oc1);
      PG8_WAIT_L(8); PG8_BAR; PG8_WAIT_L(0); PG8_MMA(0, 0, At, B0); PG8_BAR; PG8_SCHED;
      PG8_LDB(B1, 0, 1); PG8_STAGE(PG8_SB(0, 0), b2, voffB);
      PG8_BAR; PG8_WAIT_L(0); PG8_MMA(0, 1, At, B1); PG8_BAR;
      PG8_LDA(At, 0, 1); PG8_STAGE(PG8_SA(0, 0), a2, o20);
      PG8_BAR; PG8_WAIT_L(0); PG8_MMA(1, 0, At, B0); PG8_BAR; PG8_SCHED;
      PG8_STAGE(PG8_SB(0, 1), b2 + hstep, voffB);
      PG8_WAIT_V(6); PG8_BAR; PG8_MMA(1, 1, At, B1); PG8_BAR;
      PG8_LDB(B0, 1, 0); PG8_SCHED; PG8_LDA(At, 1, 0); PG8_STAGE(PG8_SA(0, 1), a2, o21);
      PG8_WAIT_L(8); PG8_BAR; PG8_WAIT_L(0); PG8_MMA(0, 0, At, B0); PG8_BAR; PG8_SCHED;
      PG8_LDB(B1, 1, 1); PG8_STAGE(PG8_SB(1, 0), b3, voffB);
      PG8_BAR; PG8_WAIT_L(0); PG8_MMA(0, 1, At, B1); PG8_BAR;
      PG8_LDA(At, 1, 1); PG8_STAGE(PG8_SA(1, 0), a3, o20);
      PG8_BAR; PG8_WAIT_L(0); PG8_MMA(1, 0, At, B0); PG8_BAR; PG8_SCHED;
      PG8_STAGE(PG8_SB(1, 1), b3 + hstep, voffB);
      PG8_WAIT_V(6); PG8_BAR; PG8_MMA(1, 1, At, B1); PG8_BAR;
    }
    { int l3_; asm volatile("v_mbcnt_lo_u32_b32 %0, -1, 0\n\tv_mbcnt_hi_u32_b32 %0, -1, %0" : "=v"(l3_));
      S.epi(acc, cur, wr, wc, l3_ & 15, l3_ >> 4); }
    if (!has_next) break;
#pragma unroll
    for (int a = 0; a < 2; ++a)
#pragma unroll
      for (int b = 0; b < 2; ++b)
#pragma unroll
        for (int m = 0; m < 4; ++m)
#pragma unroll
          for (int n = 0; n < 2; ++n) acc[a][b][m][n] = (f32x4){0.f, 0.f, 0.f, 0.f};
    cur = nxt; cB = nB; ++ui;
#pragma unroll
    for (int i = 0; i < 2; ++i) { oc0[i] = on0[i]; oc1[i] = on1[i]; }
  }
  PG8_WAIT_V(0);
  if (wr == 0) PG8_BAR;
  PG8_BAR;
#undef PG8_SA
#undef PG8_SB
#undef PG8_STAGE
#undef PG8_LDA
#undef PG8_LDB
#undef PG8_MMA
#undef PG8_WAIT_V
#undef PG8_WAIT_L
#undef PG8_BAR
#undef PG8_SCHED
}
}
#endif
#ifndef CPU_EMU
#include <hip/hip_cooperative_groups.h>
namespace cg = cooperative_groups;
#define LAS __attribute__((address_space(3)))
#define NTHREADS 512
#define LDS_BYTES (154 * 1024)
typedef float f32x4 __attribute__((ext_vector_type(4)));
typedef short bf16x8 __attribute__((ext_vector_type(8)));
typedef unsigned u32x4 __attribute__((ext_vector_type(4)));
typedef unsigned u32x2 __attribute__((ext_vector_type(2)));

struct Ctx { int tid, lane, wid, G, bid; unsigned char* lds; };
__device__ __forceinline__ int lane_id() { int l; asm volatile("v_mbcnt_lo_u32_b32 %0, -1, 0\n\tv_mbcnt_hi_u32_b32 %0, -1, %0" : "=v"(l)); return l; }
__device__ __forceinline__ int opaque_tid(int wv) { int w = wv; asm volatile("" : "+s"(w)); int t = w * 64 + lane_id(); asm volatile("" : "+v"(t)); return t; }
__device__ __forceinline__ Ctx make_ctx(unsigned char* lds, int wv) { Ctx c; c.tid = opaque_tid(wv); c.lane = c.tid & 63; c.wid = __builtin_amdgcn_readfirstlane(c.tid >> 6); c.G = gridDim.x; c.bid = blockIdx.x; c.lds = lds; return c; }

__device__ __forceinline__ float wave_sum(float x) {
  x += __builtin_bit_cast(float, __builtin_amdgcn_update_dpp(0, __builtin_bit_cast(int, x), 0x111, 0xf, 0xf, false));
  x += __builtin_bit_cast(float, __builtin_amdgcn_update_dpp(0, __builtin_bit_cast(int, x), 0x112, 0xf, 0xf, false));
  x += __builtin_bit_cast(float, __builtin_amdgcn_update_dpp(0, __builtin_bit_cast(int, x), 0x114, 0xf, 0xf, false));
  x += __builtin_bit_cast(float, __builtin_amdgcn_update_dpp(0, __builtin_bit_cast(int, x), 0x118, 0xf, 0xf, false));
  x += __builtin_bit_cast(float, __builtin_amdgcn_update_dpp(0, __builtin_bit_cast(int, x), 0x142, 0xa, 0xf, false));
  x += __builtin_bit_cast(float, __builtin_amdgcn_update_dpp(0, __builtin_bit_cast(int, x), 0x143, 0xc, 0xf, false));
  return __builtin_bit_cast(float, __builtin_amdgcn_readlane(__builtin_bit_cast(int, x), 63));
}
__device__ __forceinline__ float fsigmoid(float x) { return __builtin_amdgcn_rcpf(1.0f + __builtin_amdgcn_exp2f(-1.4426950408889634f * x)); }
__device__ __forceinline__ float fsilu(float x) { return x * fsigmoid(x); }
__device__ __forceinline__ float flog2sigmoid(float x) { const float y = x * 1.4426950408889634f; return fminf(y, 0.f) - __builtin_amdgcn_logf(1.0f + __builtin_amdgcn_exp2f(-fabsf(y))); }
typedef float f32x2_t __attribute__((ext_vector_type(2)));
typedef __bf16 bf16x2_t __attribute__((ext_vector_type(2)));
__device__ __forceinline__ unsigned pk_hw(float a, float b) { const f32x2_t v = {a, b}; return __builtin_bit_cast(unsigned, __builtin_convertvector(v, bf16x2_t)); }
__device__ __forceinline__ unsigned pk2(float a, float b) { return pk_hw(a, b); }
__device__ __forceinline__ void unpack8(u32x4 w, float* f) {
  f[0] = __uint_as_float(w.x << 16); f[1] = __uint_as_float(w.x & 0xffff0000u); f[2] = __uint_as_float(w.y << 16); f[3] = __uint_as_float(w.y & 0xffff0000u);
  f[4] = __uint_as_float(w.z << 16); f[5] = __uint_as_float(w.z & 0xffff0000u); f[6] = __uint_as_float(w.w << 16); f[7] = __uint_as_float(w.w & 0xffff0000u);
}

__device__ __forceinline__ void transpose_job(const Ctx& c, const float* src, int N, bf16_t* dst, int rs, int ro, int tile0, int tile_stride) {
  float* t = (float*)c.lds;
  const int ntn = (N + 63) / 64, ntiles = ntn * 16;
  for (int tl = tile0; tl < ntiles; tl += tile_stride) {
    const int kt = tl / ntn, nt_ = tl % ntn, k0 = kt * 64, n0 = nt_ * 64;
    __syncthreads();
#pragma unroll
    for (int i = 0; i < 8; ++i) { const int idx = c.tid + i * 512, kk = idx >> 6, nn = idx & 63; t[kk * 65 + nn] = (n0 + nn < N) ? src[(size_t)(k0 + kk) * N + n0 + nn] : 0.f; }
    __syncthreads();
#pragma unroll
    for (int i = 0; i < 4; ++i) { const int idx = c.tid + i * 512, nn = idx >> 5, kp = (idx & 31) * 2;
      if (n0 + nn < N) *(unsigned*)(dst + (size_t)((n0 + nn) * rs + ro) * 1024 + k0 + kp) = pk2(t[kp * 65 + nn], t[(kp + 1) * 65 + nn]); }
  }
  __syncthreads();
}
__device__ __forceinline__ void p0_prologue(unsigned char* lds_, int wv, const Params& p) {
  const Ctx c = make_ctx(lds_, wv);
  unsigned char* ws = p.ws;
  if (c.bid == 0) { ((unsigned*)(ws + WS_CTL))[64 + c.tid] = 0u; }
  if (c.bid == 0 && c.tid == 0) ((unsigned*)(ws + WS_CTL))[1024] = 0u;
  { const float* x = p.in[I_X]; bf16_t* hb = (bf16_t*)(ws + WS_HB);
    for (size_t i = (size_t)c.bid * NTHREADS + c.tid; i < (size_t)NTOK * 1024 / 8; i += (size_t)c.G * NTHREADS) {
      const f32x4 a = *(const f32x4*)(x + i * 8), b = *(const f32x4*)(x + i * 8 + 4);
      u32x4 w; w.x = pk2(a[0], a[1]); w.y = pk2(a[2], a[3]); w.z = pk2(b[0], b[1]); w.w = pk2(b[2], b[3]);
      *(u32x4*)(hb + i * 8) = w; } }
  transpose_job(c, p.in[I_AB_W_IN], P_AB, (bf16_t*)(ws + WS_WIN_AB), 1, 0, c.bid, c.G);
  transpose_job(c, p.in[I_CD_W_IN], P_CD, (bf16_t*)(ws + WS_WIN_CD), 1, 0, c.bid, c.G);
  transpose_job(c, p.in[I_AB_W_OUT], 1024, (bf16_t*)(ws + WS_WOUT_AB), 1, 0, c.bid, c.G);
  transpose_job(c, p.in[I_CD_W_OUT], 1024, (bf16_t*)(ws + WS_WOUT_CD), 1, 0, c.bid, c.G);
  { float* rope = (float*)(ws + WS_ROPE);
    for (int i = c.bid * NTHREADS + c.tid; i < SEQ * 32; i += c.G * NTHREADS) { const int t = i >> 5, f = i & 31;
      const float freq = powf(10000.0f, -(float)f / 32.0f); const float ang = (float)t * freq; rope[i * 2] = cosf(ang); rope[i * 2 + 1] = sinf(ang); }
    if (c.bid == 1) { const float* hl = p.in[I_HGRN_LB]; float* lb = (float*)(ws + WS_LB);
      const int cc = c.tid; const float a0 = hl[cc], a1 = hl[512 + cc], a2 = hl[1024 + cc]; const float mx = fmaxf(a0, fmaxf(a1, a2));
      const float e0 = expf(a0 - mx), e1 = expf(a1 - mx), e2 = expf(a2 - mx); lb[cc] = e0 / (e0 + e1 + e2); } }
}
__device__ __forceinline__ void moe_weight_convert(unsigned char* lds_, int wv, const Params& p, int layer) {
  const Ctx c = make_ctx(lds_, wv);
  bf16_t* w13 = (bf16_t*)(p.ws + WS_WMOE); bf16_t* w2 = w13 + (size_t)NEXP * 2048 * 1024;
  const size_t lo = (size_t)layer * NEXP * 1024 * 1024;
  const float* W1 = p.in[I_MOE_W1] + lo; const float* W3 = p.in[I_MOE_W3] + lo; const float* W2 = p.in[I_MOE_W2] + lo;
  float* t = (float*)c.lds;
  constexpr int NT = 48 * 128;
  const int lk = c.tid >> 5, ln4 = (c.tid & 31) * 4;
  const int sn = c.tid & 127, sk = (c.tid >> 7) * 8;
  f32x4 r[4];
#define MW_SRC(g_) ((((g_) >> 7) % 3 == 0 ? W1 : (((g_) >> 7) % 3 == 1 ? W3 : W2)) + (size_t)(((g_) >> 7) / 3) * 1048576 + (size_t)((((g_) & 127) >> 3) * 64) * 1024 + ((g_) & 7) * 128)
#define MW_LOAD(g_) do { const float* s_ = MW_SRC(g_); _Pragma("unroll") for (int i = 0; i < 4; ++i) r[i] = *(const f32x4*)(s_ + (size_t)(lk + 16 * i) * 1024 + ln4); } while (0)
  int g0 = c.bid;
  if (g0 < NT) MW_LOAD(g0);
  for (; g0 < NT; g0 += c.G) {
    __syncthreads();
#pragma unroll
    for (int i = 0; i < 4; ++i) { float* d = t + (lk + 16 * i) * 129 + ln4; d[0] = r[i][0]; d[1] = r[i][1]; d[2] = r[i][2]; d[3] = r[i][3]; }
    __syncthreads();
    const int gn = g0 + c.G;
    if (gn < NT) MW_LOAD(gn);
    const int m = g0 >> 7, e = m / 3, which = m % 3, k0 = ((g0 & 127) >> 3) * 64, n0 = (g0 & 7) * 128;
    bf16_t* drow = (which == 2) ? w2 + ((size_t)e * 1024 + n0 + sn) * 1024 : w13 + ((size_t)e * 2048 + 2 * (n0 + sn) + which) * 1024;
#pragma unroll
    for (int j = 0; j < 2; ++j) { const int kk = sk + 32 * j; const float* s = t + kk * 129 + sn;
      u32x4 w; w.x = pk2(s[0], s[129]); w.y = pk2(s[2 * 129], s[3 * 129]); w.z = pk2(s[4 * 129], s[5 * 129]); w.w = pk2(s[6 * 129], s[7 * 129]);
      *(u32x4*)(drow + k0 + kk) = w; }
  }
#undef MW_SRC
#undef MW_LOAD
  __syncthreads();
}

struct ProbInProj {
  static constexpr bool PERM = true;
  pg8::StaticOrder so; const char* A; const char* Bt; bf16_t* P; const float* bias; const float* lb; int layer;
  __device__ __forceinline__ bool next(int i, pg8::Unit& u) const { return so.next(i, u); }
  __device__ __forceinline__ const char* a_base() const { return A; }
  __device__ __forceinline__ unsigned a_off(const pg8::Unit& u, int r) const { return (unsigned)(u.pm * 256 + r) * 2048u; }
  __device__ __forceinline__ const char* b_base(const pg8::Unit& u) const { return Bt + (size_t)u.pn * 256 * 2048; }
  __device__ __forceinline__ void epi(const f32x4 (&acc)[2][2][4][2], const pg8::Unit& u, int wr, int wc, int fr, int fq) const {
    const int row0 = u.row0 + wr * 64 + fr, colb = u.pn * 256 + wc * 32 + 8 * fq;
    int mode = 0;
    if (layer == 0) { mode = u.pn < 2 ? 1 : (u.pn < 6 ? 2 : (u.pn == 10 ? 3 : 0)); }
#pragma unroll
    for (int bj = 0; bj < 2; ++bj) {
      const int col0 = colb + bj * 128;
      const f32x4 b0 = *(const f32x4*)(bias + col0), b1 = *(const f32x4*)(bias + col0 + 4);
      f32x4 l0 = (f32x4){0.f, 0.f, 0.f, 0.f}, l1 = l0;
      if (mode == 2) { l0 = *(const f32x4*)(lb + ((col0 - 512) & 511)); l1 = *(const f32x4*)(lb + ((col0 - 512) & 511) + 4); }
#pragma unroll
      for (int ai = 0; ai < 2; ++ai)
#pragma unroll
        for (int m = 0; m < 4; ++m) {
          f32x4 v0 = acc[ai][bj][m][0] + b0, v1 = acc[ai][bj][m][1] + b1;
          if (mode == 1) {
#pragma unroll
            for (int j = 0; j < 4; ++j) { v0[j] = fsilu(v0[j]); v1[j] = fsilu(v1[j]); }
          } else if (mode == 2) {
#pragma unroll
            for (int j = 0; j < 4; ++j) { v0[j] = __builtin_amdgcn_logf(l0[j] + (1.0f - l0[j]) * fsigmoid(v0[j])); v1[j] = __builtin_amdgcn_logf(l1[j] + (1.0f - l1[j]) * fsigmoid(v1[j])); }
          } else if (mode == 3) { v0 *= 0.125f; v1 *= 0.125f; }
          u32x4 w; w.x = pk2(v0[0], v0[1]); w.y = pk2(v0[2], v0[3]); w.z = pk2(v1[0], v1[1]); w.w = pk2(v1[2], v1[3]);
          *(u32x4*)(P + PIDX(row0 + ai * 128 + m * 16, col0)) = w;
        }
    }
  }
};
struct ProbOutProj {
  static constexpr bool PERM = false;
  pg8::StaticOrder so; const char* A; const char* Bt; float* Y; const float* Hres;
  __device__ __forceinline__ bool next(int i, pg8::Unit& u) const { return so.next(i, u); }
  __device__ __forceinline__ const char* a_base() const { return A; }
  __device__ __forceinline__ unsigned a_off(const pg8::Unit& u, int r) const { return (unsigned)(u.pm * 256 + r) * 2048u; }
  __device__ __forceinline__ const char* b_base(const pg8::Unit& u) const { return Bt + (size_t)u.pn * 256 * 2048; }
  __device__ __forceinline__ void epi(const f32x4 (&acc)[2][2][4][2], const pg8::Unit& u, int wr, int wc, int fr, int fq) const {
    const int row0 = u.row0 + wr * 64 + fr, col0 = u.pn * 256 + wc * 32 + 4 * fq;
#pragma unroll
    for (int ai = 0; ai < 2; ++ai)
#pragma unroll
      for (int m = 0; m < 4; ++m) { const size_t ro = (size_t)(row0 + ai * 128 + m * 16) * 1024 + col0; float* rowp = Y + ro; const float* hp = Hres + ro;
#pragma unroll
        for (int bj = 0; bj < 2; ++bj)
#pragma unroll
          for (int n = 0; n < 2; ++n) *(f32x4*)(rowp + bj * 128 + n * 16) = acc[ai][bj][m][n] + ALPHA_F * *(const f32x4*)(hp + bj * 128 + n * 16); }
  }
};
#define MOE_TAB_OFF (128 * 1024)
struct MoeOrder {
  const int* tab;
  __device__ __forceinline__ void init(const int* cnt, int ntn, int G, int c, unsigned char* lds, int wv) {
    int* t = (int*)(lds + MOE_TAB_OFF);
    const int tid = opaque_tid(wv);
    if (tid < 64) {
      int L = tid * G + c, pad = 0, found = 0, ue = 0, upn = 0, upm = 0, urow = 0, une = 0;
      for (int e = 0; e < NEXP; ++e) { const int n = cnt[e * 16], mt = (n + 255) >> 8, tiles = mt * ntn;
        if (!found && L < tiles) { ue = e; upn = L / mt; upm = L % mt; urow = pad + upm * 256; une = n; found = 1; }
        if (!found) { L -= tiles; pad += mt * 256; } }
      t[tid * 8 + 0] = found; t[tid * 8 + 1] = ue; t[tid * 8 + 2] = upn; t[tid * 8 + 3] = upm; t[tid * 8 + 4] = urow; t[tid * 8 + 5] = une;
    }
    __syncthreads();
    tab = t;
  }
  __device__ __forceinline__ bool next(int i, pg8::Unit& u) const {
    if (i >= 64) return false;
    const int* t = tab + i * 8;
    if (!__builtin_amdgcn_readfirstlane(t[0])) return false;
    u.e = __builtin_amdgcn_readfirstlane(t[1]); u.pn = __builtin_amdgcn_readfirstlane(t[2]); u.pm = __builtin_amdgcn_readfirstlane(t[3]);
    u.row0 = __builtin_amdgcn_readfirstlane(t[4]); u.ne = __builtin_amdgcn_readfirstlane(t[5]); return true;
  }
};
struct ProbMoe1 {
  static constexpr bool PERM = true;
  MoeOrder mo; const char* A; const char* W13; const int* list; bf16_t* H;
  __device__ __forceinline__ bool next(int i, pg8::Unit& u) const { return mo.next(i, u); }
  __device__ __forceinline__ const char* a_base() const { return A; }
  __device__ __forceinline__ unsigned a_off(const pg8::Unit& u, int r) const { const int rr = u.pm * 256 + r; const int tok = rr < u.ne ? list[u.e * NTOK + rr] : 0; return (unsigned)tok * 2048u; }
  __device__ __forceinline__ const char* b_base(const pg8::Unit& u) const { return W13 + ((size_t)u.e * 2048 + (size_t)u.pn * 256) * 2048; }
  __device__ __forceinline__ void epi(const f32x4 (&acc)[2][2][4][2], const pg8::Unit& u, int wr, int wc, int fr, int fq) const {
    const int row0 = u.row0 + wr * 64 + fr, colb = u.pn * 128 + wc * 16 + 4 * fq;
#pragma unroll
    for (int ai = 0; ai < 2; ++ai)
#pragma unroll
      for (int m = 0; m < 4; ++m)
#pragma unroll
        for (int bj = 0; bj < 2; ++bj) {
          const f32x4 v0 = acc[ai][bj][m][0], v1 = acc[ai][bj][m][1];
          u32x2 w; w.x = pk2(fsilu(v0[0]) * v0[1], fsilu(v0[2]) * v0[3]); w.y = pk2(fsilu(v1[0]) * v1[1], fsilu(v1[2]) * v1[3]);
          *(u32x2*)(H + (size_t)(row0 + ai * 128 + m * 16) * 1024 + colb + bj * 64) = w;
        }
  }
};
struct ProbMoe2 {
  static constexpr bool PERM = true;
  MoeOrder mo; const char* A; const char* W2; bf16_t* Y;
  __device__ __forceinline__ bool next(int i, pg8::Unit& u) const { return mo.next(i, u); }
  __device__ __forceinline__ const char* a_base() const { return A; }
  __device__ __forceinline__ unsigned a_off(const pg8::Unit& u, int r) const { return (unsigned)(u.row0 + r) * 2048u; }
  __device__ __forceinline__ const char* b_base(const pg8::Unit& u) const { return W2 + ((size_t)u.e * 1024 + (size_t)u.pn * 256) * 2048; }
  __device__ __forceinline__ void epi(const f32x4 (&acc)[2][2][4][2], const pg8::Unit& u, int wr, int wc, int fr, int fq) const {
    const int row0 = u.row0 + wr * 64 + fr, colb = u.pn * 256 + wc * 32 + 8 * fq;
#pragma unroll
    for (int ai = 0; ai < 2; ++ai)
#pragma unroll
      for (int m = 0; m < 4; ++m)
#pragma unroll
        for (int bj = 0; bj < 2; ++bj) {
          const f32x4 v0 = acc[ai][bj][m][0], v1 = acc[ai][bj][m][1];
          u32x4 w; w.x = pk2(v0[0], v0[1]); w.y = pk2(v0[2], v0[3]); w.z = pk2(v1[0], v1[1]); w.w = pk2(v1[2], v1[3]);
          *(u32x4*)(Y + (size_t)(row0 + ai * 128 + m * 16) * 1024 + colb + bj * 128) = w;
        }
  }
};

template <int NS>
__device__ __forceinline__ void side_phase(unsigned char* lds_, int wv, const Params& p, int layer) {
  const Ctx c = make_ctx(lds_, wv);
  const bf16_t* hb = (const bf16_t*)(p.ws + WS_HB);
  const bf16_t* wt = (const bf16_t*)(p.ws + (layer == 0 ? WS_WIN_AB : WS_WIN_CD)) + (size_t)(layer == 0 ? PM_AB : PM_CD) * 1024;
  const float* bias = p.in[layer == 0 ? I_AB_B_IN : I_CD_B_IN] + (layer == 0 ? PM_AB : PM_CD);
  float* side = (float*)(p.ws + WS_SIDE);
  float* tl = (float*)c.lds + c.wid * (16 * 33);
  const int fr = c.lane & 15, fq = c.lane >> 4;
  for (int g = c.bid * 8 + c.wid; g < NTOK / 16; g += c.G * 8) {
    const int r0 = g * 16;
    f32x4 acc0 = (f32x4){0.f, 0.f, 0.f, 0.f}, acc1 = acc0;
    const bf16_t* ap = hb + (size_t)(r0 + fr) * 1024 + fq * 8;
    const bf16_t* bp0 = wt + (size_t)fr * 1024 + fq * 8; const bf16_t* bp1 = bp0 + 16 * 1024;
#pragma unroll 4
    for (int k = 0; k < 1024; k += 32) {
      const bf16x8 a = *(const bf16x8*)(ap + k), b0 = *(const bf16x8*)(bp0 + k);
      acc0 = __builtin_amdgcn_mfma_f32_16x16x32_bf16(a, b0, acc0, 0, 0, 0);
      if (NS == 32) { const bf16x8 b1 = *(const bf16x8*)(bp1 + k); acc1 = __builtin_amdgcn_mfma_f32_16x16x32_bf16(a, b1, acc1, 0, 0, 0); }
    }
    float gsc = 1.f, gfb = 0.f; bool gls = false;
    if (NS == 16) { gsc = 1.4426950408889634f; gls = (fr & 4) != 0; gfb = gls ? p.in[I_FGATE_B][(fr >> 3) * 4 + (fr & 3)] : 0.f; }
#pragma unroll
    for (int j = 0; j < 4; ++j) { float v0 = acc0[j] + bias[fr]; if (NS == 16) v0 = gls ? flog2sigmoid(v0 + gfb) : v0 * gsc; side[(size_t)(r0 + fq * 4 + j) * 32 + fr] = v0; tl[(fq * 4 + j) * 33 + fr] = v0;
      if (NS == 32) { const float v1 = acc1[j] + bias[16 + fr]; side[(size_t)(r0 + fq * 4 + j) * 32 + 16 + fr] = v1; tl[(fq * 4 + j) * 33 + 16 + fr] = v1; } }
    if (NS == 32) {
      __builtin_amdgcn_s_waitcnt(0xC07F);
      const float* gu = p.in[I_GK_UP]; const float* gb = p.in[I_GK_B]; bf16_t* lfb = (bf16_t*)(p.ws + WS_LFB);
      const int cb = c.lane * 8, dir = cb >> 8, cc = cb & 255;
      float w[16][8];
#pragma unroll
      for (int r = 0; r < 16; ++r)
#pragma unroll
        for (int j = 0; j < 8; ++j) w[r][j] = gu[(dir * 16 + r) * 256 + cc + j];
      float bb[8];
#pragma unroll
      for (int j = 0; j < 8; ++j) bb[j] = gb[dir * 256 + cc + j];
      for (int row = 0; row < 16; ++row) {
        float z[8];
#pragma unroll
        for (int j = 0; j < 8; ++j) z[j] = bb[j];
#pragma unroll
        for (int r = 0; r < 16; ++r) { const float s = tl[row * 33 + dir * 16 + r];
#pragma unroll
          for (int j = 0; j < 8; ++j) z[j] += s * w[r][j]; }
        u32x4 o; o.x = pk2(flog2sigmoid(z[0]) * 0.0625f, flog2sigmoid(z[1]) * 0.0625f); o.y = pk2(flog2sigmoid(z[2]) * 0.0625f, flog2sigmoid(z[3]) * 0.0625f);
        o.z = pk2(flog2sigmoid(z[4]) * 0.0625f, flog2sigmoid(z[5]) * 0.0625f); o.w = pk2(flog2sigmoid(z[6]) * 0.0625f, flog2sigmoid(z[7]) * 0.0625f);
        *(u32x4*)(lfb + PIDX(r0 + row, cb)) = o;
      }
    }
  }
}

__device__ __forceinline__ void headnorm_phase(unsigned char* lds_, int wv, const Params& p, int layer) {
  const Ctx c = make_ctx(lds_, wv);
  const bf16_t* P = (const bf16_t*)(p.ws + WS_R1); const bf16_t* O = (const bf16_t*)(p.ws + WS_R2);
  bf16_t* mixed = (bf16_t*)(p.ws + WS_HB);
  const int c0 = c.lane * 16, h8 = c.lane >> 3;
  const float* gain = layer == 0 ? (h8 < 4 ? p.in[I_HGRN_NORM] + c0 : p.in[I_GLA_NORM] + c0 - 512) : (h8 < 4 ? p.in[I_RET_NORM] + c0 : p.in[I_MLSTM_NORM] + c0 - 512);
  const int gcol = layer == 0 ? (h8 < 4 ? 2048 + c0 : 3584 + c0 - 512) : (h8 < 4 ? 1024 + c0 : 3072 + c0 - 512);
  float gn[16];
#pragma unroll
  for (int j = 0; j < 16; ++j) gn[j] = gain[j];
  for (int tok = c.bid * 8 + c.wid; tok < NTOK; tok += c.G * 8) {
    float of[16], ob[16], gt[16];
    { const u32x4* a = (const u32x4*)(O + PIDX(tok, c0)); unpack8(a[0], of); unpack8(a[1], of + 8);
      const u32x4* b = (const u32x4*)(O + (size_t)NTOK * 1024 + PIDX(tok, c0)); unpack8(b[0], ob); unpack8(b[1], ob + 8);
      const u32x4* g = (const u32x4*)(P + PIDX(tok, gcol)); unpack8(g[0], gt); unpack8(g[1], gt + 8); }
    const float sf = 1.f, sb = 1.f;
    float o[16]; float ss = 0.f;
#pragma unroll
    for (int j = 0; j < 16; ++j) { o[j] = of[j] * sf + ob[j] * sb; ss += o[j] * o[j]; }
    ss += __shfl_xor(ss, 1); ss += __shfl_xor(ss, 2); ss += __shfl_xor(ss, 4);
    const float r = 1.0f / sqrtf(ss * (1.0f / 128.0f) + NORM_EPS_F);
    unsigned w[8];
#pragma unroll
    for (int j = 0; j < 8; ++j) {
      float g0 = gt[2 * j], g1 = gt[2 * j + 1];
      if (layer == 1 && h8 >= 4) { g0 = fsigmoid(g0); g1 = fsigmoid(g1); } else { g0 = fsilu(g0); g1 = fsilu(g1); }
      w[j] = pk2(o[2 * j] * r * gn[2 * j] * g0, o[2 * j + 1] * r * gn[2 * j + 1] * g1);
    }
    u32x4* d = (u32x4*)(mixed + (size_t)tok * 1024 + c0);
    d[0] = (u32x4){w[0], w[1], w[2], w[3]}; d[1] = (u32x4){w[4], w[5], w[6], w[7]};
  }
}

__device__ __forceinline__ void ln_phase(unsigned char* lds_, int wv, const Params& p, int layer, int mode, int dry = 0) {
  const Ctx c = make_ctx(lds_, wv);
  unsigned char* ws = p.ws;
  const float* hin = (mode == 0 && layer == 0) ? p.in[I_X] : p.out;
  float* hout = dry ? (float*)(ws + WS_H) : p.out; bf16_t* hb = (bf16_t*)(ws + WS_HB);
  const float* g = p.in[mode == 0 ? I_LN_MIX_G : I_LN_FFN_G] + layer * 1024; const float* b = p.in[mode == 0 ? I_LN_MIX_B : I_LN_FFN_B] + layer * 1024;
  unsigned* cnt = (unsigned*)(ws + WS_CTL) + CW_CNT(layer);
  int* list = (int*)(ws + WS_LIST) + (size_t)layer * NEXP * NTOK;
  int* assign = (int*)(ws + WS_ASSIGN); float* gate = (float*)(ws + WS_GATE);
  float* rwT = (float*)c.lds;
  int* lcnt = (int*)(c.lds + 65536); int* lbase = lcnt + 16; int* rec = lcnt + 32; float* recg = (float*)(rec + 4 * 2048);
  int pad[NEXP];
  if (mode == 0) { const float* r = p.in[I_ROUTER_W];
    for (int i = c.tid; i < 1024 * 16; i += NTHREADS) rwT[(i & 15) * 1024 + (i >> 4)] = r[i];
    if (c.tid < 16) lcnt[c.tid] = 0;
    __syncthreads(); }
  else { int acc = 0;
#pragma unroll
    for (int e = 0; e < NEXP; ++e) { pad[e] = acc; acc += (((int)cnt[e * 16] + 255) >> 8) << 8; } }
  const int c0 = c.lane * 4;
  float gv[16], bv[16];
#pragma unroll
  for (int q = 0; q < 4; ++q) { const f32x4 t0 = *(const f32x4*)(g + q * 256 + c0), t1 = *(const f32x4*)(b + q * 256 + c0);
#pragma unroll
    for (int j = 0; j < 4; ++j) { gv[4 * q + j] = t0[j]; bv[4 * q + j] = t1[j]; } }
  const int tstride = c.G * 8;
  int it = 0;
  for (int tok0 = c.bid * 8 + c.wid; tok0 < NTOK; tok0 += 2 * tstride, it += 2) {
    float v[2][16];
    float gy0[2], gy1[2];
#pragma unroll
    for (int u = 0; u < 2; ++u) {
      const int tok = tok0 + u * tstride;
      if (tok < NTOK) {
        if (mode == 0) {
#pragma unroll
          for (int q = 0; q < 4; ++q) { const f32x4 t = *(const f32x4*)((const float*)(ws + WS_R2) + (size_t)tok * 1024 + q * 256 + c0); v[u][4 * q] = t[0]; v[u][4 * q + 1] = t[1]; v[u][4 * q + 2] = t[2]; v[u][4 * q + 3] = t[3]; }
        } else {
#pragma unroll
          for (int q = 0; q < 4; ++q) { const f32x4 t = *(const f32x4*)(hin + (size_t)tok * 1024 + q * 256 + c0); v[u][4 * q] = ALPHA_F * t[0]; v[u][4 * q + 1] = ALPHA_F * t[1]; v[u][4 * q + 2] = ALPHA_F * t[2]; v[u][4 * q + 3] = ALPHA_F * t[3]; }
          const int a0 = assign[tok * 4], a1 = assign[tok * 4 + 1], a2 = assign[tok * 4 + 2], a3 = assign[tok * 4 + 3];
          gy0[u] = gate[tok * 2]; gy1[u] = gate[tok * 2 + 1];
          int p0 = 0, p1 = 0;
#pragma unroll
          for (int e = 0; e < NEXP; ++e) { if (e == a0) p0 = pad[e]; if (e == a2) p1 = pad[e]; }
          p0 += a1; p1 += a3;
          const bf16_t* Y = (const bf16_t*)(ws + WS_R2);
#pragma unroll
          for (int q = 0; q < 4; ++q) { const u32x2 y0 = *(const u32x2*)(Y + (size_t)p0 * 1024 + q * 256 + c0), y1 = *(const u32x2*)(Y + (size_t)p1 * 1024 + q * 256 + c0);
            v[u][4 * q] += gy0[u] * __uint_as_float(y0.x << 16) + gy1[u] * __uint_as_float(y1.x << 16); v[u][4 * q + 1] += gy0[u] * __uint_as_float(y0.x & 0xffff0000u) + gy1[u] * __uint_as_float(y1.x & 0xffff0000u);
            v[u][4 * q + 2] += gy0[u] * __uint_as_float(y0.y << 16) + gy1[u] * __uint_as_float(y1.y << 16); v[u][4 * q + 3] += gy0[u] * __uint_as_float(y0.y & 0xffff0000u) + gy1[u] * __uint_as_float(y1.y & 0xffff0000u); }
        }
      } else {
#pragma unroll
        for (int j = 0; j < 16; ++j) v[u][j] = 0.f;
      }
    }
#pragma unroll
    for (int u = 0; u < 2; ++u) {
      const int tok = tok0 + u * tstride;
      float s = 0.f;
#pragma unroll
      for (int j = 0; j < 16; ++j) s += v[u][j];
      const float mean = wave_sum(s) * (1.0f / 1024.0f);
      float qq = 0.f;
#pragma unroll
      for (int j = 0; j < 16; ++j) { v[u][j] -= mean; qq += v[u][j] * v[u][j]; }
      const float r = 1.0f / sqrtf(wave_sum(qq) * (1.0f / 1024.0f) + LN_EPS_F);
#pragma unroll
      for (int j = 0; j < 16; ++j) v[u][j] = v[u][j] * r * gv[j] + bv[j];
      if (tok < NTOK) {
#pragma unroll
        for (int q = 0; q < 4; ++q) *(f32x4*)(hout + (size_t)tok * 1024 + q * 256 + c0) = (f32x4){v[u][4 * q], v[u][4 * q + 1], v[u][4 * q + 2], v[u][4 * q + 3]};
        if (!(mode == 1 && layer == 1) && !dry) {
#pragma unroll
          for (int q = 0; q < 4; ++q) *(u32x2*)(hb + (size_t)tok * 1024 + q * 256 + c0) = (u32x2){pk2(v[u][4 * q], v[u][4 * q + 1]), pk2(v[u][4 * q + 2], v[u][4 * q + 3])}; }
      }
      if (mode == 0) {
        float lg[16];
#pragma unroll
        for (int e = 0; e < 16; ++e) { float a = 0.f;
#pragma unroll
          for (int q = 0; q < 4; ++q) { const f32x4 w = *(const f32x4*)(rwT + e * 1024 + q * 256 + c0); a += v[u][4 * q] * w[0] + v[u][4 * q + 1] * w[1] + v[u][4 * q + 2] * w[2] + v[u][4 * q + 3] * w[3]; }
          lg[e] = a; }
#pragma unroll
        for (int e = 0; e < 16; ++e) lg[e] = wave_sum(lg[e]);
        int eo[2]; float go[2];
        route_from_logits(lg, p.in[I_ROUTER_B], eo, go);
        if (c.lane == 0 && tok < NTOK && !dry) {
          const int r1 = atomicAdd(lcnt + eo[0], 1), r2 = atomicAdd(lcnt + eo[1], 1);
          const int ri = (it + u) * 8 + c.wid;
          rec[ri * 4] = eo[0]; rec[ri * 4 + 1] = r1; rec[ri * 4 + 2] = eo[1]; rec[ri * 4 + 3] = r2; recg[ri * 2] = go[0]; recg[ri * 2 + 1] = go[1];
        }
      }
    }
  }
  if (mode == 0 && !dry) {
    __syncthreads();
    if (c.tid < 16) lbase[c.tid] = (int)atomicAdd(cnt + c.tid * 16, (unsigned)lcnt[c.tid]);
    __syncthreads();
    const int nrec = ((NTOK + c.G * 8 - 1) / (c.G * 8)) * 8;
    for (int ri = c.tid; ri < nrec; ri += NTHREADS) {
      const int tok = c.bid * 8 + (ri & 7) + (ri >> 3) * c.G * 8;
      if (tok < NTOK) {
        const int e1 = rec[ri * 4], e2 = rec[ri * 4 + 2]; const int r1 = rec[ri * 4 + 1] + lbase[e1], r2 = rec[ri * 4 + 3] + lbase[e2];
        list[e1 * NTOK + r1] = tok; list[e2 * NTOK + r2] = tok;
        assign[tok * 4] = e1; assign[tok * 4 + 1] = r1; assign[tok * 4 + 2] = e2; assign[tok * 4 + 3] = r2;
        gate[tok * 2] = recg[ri * 2]; gate[tok * 2 + 1] = recg[ri * 2 + 1];
      }
    }
  }
  __syncthreads();
}
#endif
#ifndef CPU_EMU
namespace scan {
typedef short bf16x8 __attribute__((ext_vector_type(8)));
typedef float f32x4 __attribute__((ext_vector_type(4)));
typedef unsigned u32x4 __attribute__((ext_vector_type(4)));
typedef unsigned u32x2 __attribute__((ext_vector_type(2)));
enum { MIX_A = 0, MIX_B = 1, MIX_C = 2, MIX_D = 3 };
constexpr int LD_T = 144;
constexpr int OFF_QS = 0, OFF_KS = 17408, OFF_QI = 34816, OFF_KT = 52224, OFF_VT = 70656, OFF_SC = 77568, OFF_ST = 86784, OFF_DEC = 99840, OFF_EM = 100352, OFF_DEN = 100608, OFF_CW = 100864, SCAN_LDS = 104960;

__device__ __forceinline__ float incl_scan_add(float x) {
  x += __builtin_bit_cast(float, __builtin_amdgcn_update_dpp(0, __builtin_bit_cast(int, x), 0x111, 0xf, 0xf, false));
  x += __builtin_bit_cast(float, __builtin_amdgcn_update_dpp(0, __builtin_bit_cast(int, x), 0x112, 0xf, 0xf, false));
  x += __builtin_bit_cast(float, __builtin_amdgcn_update_dpp(0, __builtin_bit_cast(int, x), 0x114, 0xf, 0xf, false));
  x += __builtin_bit_cast(float, __builtin_amdgcn_update_dpp(0, __builtin_bit_cast(int, x), 0x118, 0xf, 0xf, false));
  x += __builtin_bit_cast(float, __builtin_amdgcn_update_dpp(0, __builtin_bit_cast(int, x), 0x142, 0xa, 0xf, false));
  x += __builtin_bit_cast(float, __builtin_amdgcn_update_dpp(0, __builtin_bit_cast(int, x), 0x143, 0xc, 0xf, false));
  return x;
}
__device__ __forceinline__ float incl_scan_max(float x) {
  const int ninf = (int)0xff800000u;
  x = fmaxf(x, __builtin_bit_cast(float, __builtin_amdgcn_update_dpp(ninf, __builtin_bit_cast(int, x), 0x111, 0xf, 0xf, false)));
  x = fmaxf(x, __builtin_bit_cast(float, __builtin_amdgcn_update_dpp(ninf, __builtin_bit_cast(int, x), 0x112, 0xf, 0xf, false)));
  x = fmaxf(x, __builtin_bit_cast(float, __builtin_amdgcn_update_dpp(ninf, __builtin_bit_cast(int, x), 0x114, 0xf, 0xf, false)));
  x = fmaxf(x, __builtin_bit_cast(float, __builtin_amdgcn_update_dpp(ninf, __builtin_bit_cast(int, x), 0x118, 0xf, 0xf, false)));
  x = fmaxf(x, __builtin_bit_cast(float, __builtin_amdgcn_update_dpp(ninf, __builtin_bit_cast(int, x), 0x142, 0xa, 0xf, false)));
  x = fmaxf(x, __builtin_bit_cast(float, __builtin_amdgcn_update_dpp(ninf, __builtin_bit_cast(int, x), 0x143, 0xc, 0xf, false)));
  return x;
}
__device__ __forceinline__ float rdlane(float x, int l) { return __builtin_bit_cast(float, __builtin_amdgcn_readlane(__builtin_bit_cast(int, x), l)); }
__device__ __forceinline__ bf16x8 ldfrag(const unsigned char* base, int ld, int row, int kbyte) { return *(const bf16x8*)(base + row * ld + kbyte); }
__device__ __forceinline__ unsigned pk(float a, float b) { return pk_hw(a, b); }
__device__ __forceinline__ float lo16(unsigned w) { return __uint_as_float(w << 16); }
__device__ __forceinline__ float hi16(unsigned w) { return __uint_as_float(w & 0xffff0000u); }

__device__ __forceinline__ void lds_barrier() { asm volatile("s_waitcnt lgkmcnt(0)" ::: "memory"); __builtin_amdgcn_s_barrier(); asm volatile("" ::: "memory"); }
struct Raw { u32x4 a0, a1, b0, b1; f32x4 r0, r1; u32x2 v; float s0, s1; };

template <int MIXER>
__device__ __forceinline__ void scan_item(unsigned char* lds, int wv, const Params& p, int b, int h, int dir, int vs) {
  constexpr int DK = (MIXER == MIX_A || MIXER == MIX_D) ? 128 : 64;
  constexpr int NC = DK / 8;
  constexpr int LD_D = DK * 2 + 16;
  constexpr int NVT = MIXER == MIX_D ? 3 : 2;
  constexpr int NKD = DK / 32;
  const int tid = opaque_tid(wv), lane0 = tid & 63, wid = __builtin_amdgcn_readfirstlane(tid >> 6);
  unsigned char* ws = p.ws;
  const bf16_t* P = (const bf16_t*)(ws + WS_R1);
  const bf16_t* LFBp = (const bf16_t*)(ws + WS_LFB);
  const float* side = (const float*)(ws + WS_SIDE);
  const float* rope = (const float*)(ws + WS_ROPE);
  bf16_t* O = (bf16_t*)(ws + WS_R2) + (size_t)dir * NTOK * 1024;
  unsigned char* QS = lds + OFF_QS; unsigned char* KS = lds + OFF_KS; unsigned char* QI = lds + OFF_QI; unsigned char* KT = lds + OFF_KT;
  unsigned char* VT = lds + OFF_VT; unsigned char* SC = lds + OFF_SC; unsigned char* ST = lds + OFF_ST;
  float* DEC = (float*)(lds + OFF_DEC); float* EM = (float*)(lds + OFF_EM); float* DEN = (float*)(lds + OFF_DEN);

  int qcol, kcol, lfcol, vcol, ocol;
  if (MIXER == MIX_A) { qcol = h * 128; kcol = 0; lfcol = 512 + dir * 512 + h * 128; vcol = 1536 + h * 128 + vs * 32; ocol = h * 128 + vs * 32; }
  else if (MIXER == MIX_B) { qcol = 2560 + h * 64; kcol = 2816 + h * 64; lfcol = dir * 256 + h * 64; vcol = 3072 + h * 128 + vs * 32; ocol = 512 + h * 128 + vs * 32; }
  else if (MIXER == MIX_C) { qcol = h * 64; kcol = 256 + h * 64; lfcol = 0; vcol = 512 + h * 128 + vs * 32; ocol = h * 128 + vs * 32; }
  else { qcol = h * 128  ; kcol = 3584 + h * 128  ; lfcol = 0; vcol = 2560 + h * 128 + vs * 32; ocol = 512 + h * 128 + vs * 32; }
  const int c0 = (MIXER == MIX_C) ? wid * 4 : wid * NC;
  const float lgam = (MIXER == MIX_C) ? log1pf(-exp2f(-(5.0f + 2.0f * (float)h + (float)dir))) : 0.f;
  const float fgb = (MIXER == MIX_D) ? p.in[I_FGATE_B][dir * 4 + h] : 0.f;
  for (int i = tid; i < 48 * LD_D / 4; i += NTHREADS) ((unsigned*)ST)[i] = 0u;
  if (MIXER == MIX_D) {
    for (int i = tid; i < 16 * 64; i += NTHREADS) { const int r = 32 + (i >> 6), j = i & 63; *(bf16_t*)(VT + r * LD_T + j * 2) = (r == 32) ? (bf16_t)0x3F80 : (bf16_t)0; }
  }
  f32x4 sacc[NVT == 3 ? 3 : 2];
#pragma unroll
  for (int i = 0; i < (NVT == 3 ? 3 : 2); ++i) sacc[i] = (f32x4){0.f, 0.f, 0.f, 0.f};
  float m_st = 0.f;
  const size_t tokbase = (size_t)b * SEQ;
  const int sgn = dir ? -1 : 1;
  __syncthreads();

  Raw R;
#define SCAN_LOAD(n_) do { \
    int ln_ = lane0; asm volatile("" : "+v"(ln_)); \
    const int t_ = dir ? (SEQ - 1 - ((n_) * 64 + ln_)) : ((n_) * 64 + ln_); \
    const bf16_t* row_ = P + (tokbase + t_) * PSTRIDE; \
    if (MIXER == MIX_A) { const u32x4* qp_ = (const u32x4*)(row_ + qcol + c0); const u32x4* lp_ = (const u32x4*)(row_ + lfcol + c0); R.a0 = qp_[0]; R.a1 = qp_[1]; R.b0 = lp_[0]; R.b1 = lp_[1]; } \
    else if (MIXER == MIX_B) { R.a0 = *(const u32x4*)(row_ + qcol + c0); R.a1 = *(const u32x4*)(row_ + kcol + c0); R.b0 = *(const u32x4*)(LFBp + (tokbase + t_) * 512 + lfcol + c0); } \
    else if (MIXER == MIX_C) { const u32x2 qa_ = *(const u32x2*)(row_ + qcol + c0), qb_ = *(const u32x2*)(row_ + qcol + 32 + c0), ka_ = *(const u32x2*)(row_ + kcol + c0), kb_ = *(const u32x2*)(row_ + kcol + 32 + c0); \
      R.a0 = (u32x4){qa_.x, qa_.y, qb_.x, qb_.y}; R.a1 = (u32x4){ka_.x, ka_.y, kb_.x, kb_.y}; \
      R.r0 = *(const f32x4*)(rope + ((size_t)t_ * 32 + c0) * 2); R.r1 = *(const f32x4*)(rope + ((size_t)t_ * 32 + c0) * 2 + 4); } \
    else { const u32x4* qp_ = (const u32x4*)(LFBp + (tokbase + t_) * 512 + qcol + c0); const u32x4* kp_ = (const u32x4*)(row_ + kcol + c0); R.a0 = qp_[0]; R.a1 = qp_[1]; R.b0 = kp_[0]; R.b1 = kp_[1]; \
      R.s0 = side[(tokbase + t_) * 32 + dir * 8 + h]; R.s1 = side[(tokbase + t_) * 32 + dir * 8 + 4 + h]; } \
    R.v = *(const u32x2*)(row_ + vcol + wid * 4); } while (0)

  SCAN_LOAD(0);
  for (int n = 0; n < SEQ / 64; ++n) {
    int lane = lane0; asm volatile("" : "+v"(lane));
    const int fr = lane & 15, fq = lane >> 4;
    float q[NC], k[NC], g[NC];
    const u32x2 vv = R.v;
    float g_li = 0.f, g_lf = 0.f;
    if (MIXER == MIX_A) {
      const unsigned qw[8] = {R.a0.x, R.a0.y, R.a0.z, R.a0.w, R.a1.x, R.a1.y, R.a1.z, R.a1.w}, lw[8] = {R.b0.x, R.b0.y, R.b0.z, R.b0.w, R.b1.x, R.b1.y, R.b1.z, R.b1.w};
#pragma unroll
      for (int c = 0; c < 8; ++c) { q[2 * c] = lo16(qw[c]); q[2 * c + 1] = hi16(qw[c]); g[2 * c] = lo16(lw[c]); g[2 * c + 1] = hi16(lw[c]); }
#pragma unroll
      for (int c = 0; c < NC; ++c) k[c] = 1.0f - __expf(g[c]);
    } else if (MIXER == MIX_B) {
      const unsigned qw[4] = {R.a0.x, R.a0.y, R.a0.z, R.a0.w}, kw[4] = {R.a1.x, R.a1.y, R.a1.z, R.a1.w}, lw[4] = {R.b0.x, R.b0.y, R.b0.z, R.b0.w};
#pragma unroll
      for (int c = 0; c < 4; ++c) { q[2 * c] = lo16(qw[c]); q[2 * c + 1] = hi16(qw[c]); k[2 * c] = lo16(kw[c]); k[2 * c + 1] = hi16(kw[c]); g[2 * c] = lo16(lw[c]); g[2 * c + 1] = hi16(lw[c]); }
    } else if (MIXER == MIX_C) {
      const float cs[4] = {R.r0[0], R.r0[2], R.r1[0], R.r1[2]}, sn[4] = {R.r0[1], R.r0[3], R.r1[1], R.r1[3]};
      const float q1[4] = {lo16(R.a0.x), hi16(R.a0.x), lo16(R.a0.y), hi16(R.a0.y)}, q2[4] = {lo16(R.a0.z), hi16(R.a0.z), lo16(R.a0.w), hi16(R.a0.w)};
      const float k1[4] = {lo16(R.a1.x), hi16(R.a1.x), lo16(R.a1.y), hi16(R.a1.y)}, k2[4] = {lo16(R.a1.z), hi16(R.a1.z), lo16(R.a1.w), hi16(R.a1.w)};
#pragma unroll
      for (int c = 0; c < 4; ++c) { q[c] = (q1[c] * cs[c] - q2[c] * sn[c]) * 0.125f; q[4 + c] = (q1[c] * sn[c] + q2[c] * cs[c]) * 0.125f; k[c] = k1[c] * cs[c] - k2[c] * sn[c]; k[4 + c] = k1[c] * sn[c] + k2[c] * cs[c]; }
#pragma unroll
      for (int c = 0; c < NC; ++c) g[c] = (float)(lane + 1) * lgam;
    } else {
      const unsigned qw[8] = {R.a0.x, R.a0.y, R.a0.z, R.a0.w, R.a1.x, R.a1.y, R.a1.z, R.a1.w}, kw[8] = {R.b0.x, R.b0.y, R.b0.z, R.b0.w, R.b1.x, R.b1.y, R.b1.z, R.b1.w};
      g_li = R.s0; g_lf = R.s1;
#pragma unroll
      for (int c = 0; c < 8; ++c) { q[2 * c] = lo16(qw[c]); q[2 * c + 1] = hi16(qw[c]); k[2 * c] = lo16(kw[c]); k[2 * c + 1] = hi16(kw[c]); }
#pragma unroll
      for (int c = 0; c < NC; ++c) g[c] = 0.f;
    }
    if (n + 1 < SEQ / 64) SCAN_LOAD(n + 1);

#ifndef PROBE_REPA
#define PROBE_REPA 1
#endif
    const float m_save = m_st;
#pragma unroll 1
    for (int rep = 0; rep < PROBE_REPA; ++rep) {
    if (PROBE_REPA > 1) { m_st = m_save;
#pragma unroll
      for (int c = 0; c < NC; ++c) asm volatile("" : "+v"(g[c]), "+v"(q[c]), "+v"(k[c])); }
    float s_qs[NC], s_ks[NC], s_qi[NC], s_kt[NC];
    if (MIXER != MIX_D) {
#pragma unroll
      for (int c = 0; c < NC; ++c) {
        const float gc = (MIXER == MIX_C) ? g[c] : incl_scan_add(g[c]);
        const float gref = rdlane(gc, 31), glast = rdlane(gc, 63);
        const float a = __expf(gc - gref), ia = __builtin_amdgcn_rcpf(a);
        s_qs[c] = a; s_ks[c] = ia; s_qi[c] = a * __expf(gref); s_kt[c] = ia * __expf(glast - gref);
        if (lane == 63) DEC[(MIXER == MIX_C) ? (c < 4 ? c0 + c : 32 + c0 + c - 4) : c0 + c] = __expf(glast);
      }
    } else {
      const float li = g_li;
      const float lf = logsigmoidf_(g_lf + fgb);
      const float bc = incl_scan_add(lf);
      const float u = li - bc;
      const float pm = incl_scan_max(u);
      const float cmax = rdlane(pm, 63), blast = rdlane(bc, 63);
      const float a_i = bc + m_st, m_i = fmaxf(a_i, bc + pm);
      const float alpha = __expf(bc - m_i + cmax), beta = __expf(u - cmax), sint = __expf(a_i - m_i);
      const float m_new = fmaxf(blast + m_st, blast + cmax);
      const float s_old = __expf(blast + m_st - m_new), wks = __expf(blast + u - m_new);
      m_st = m_new;
#pragma unroll
      for (int c = 0; c < NC; ++c) { s_qs[c] = alpha; s_ks[c] = beta; s_qi[c] = sint; s_kt[c] = wks; }
      if (wid == 0) EM[lane] = __expf(-m_i);
      if (lane == 63) {
#pragma unroll
        for (int c = 0; c < NC; ++c) DEC[c0 + c] = s_old;
      }
    }
    {
      unsigned wq[NC / 2], wk[NC / 2], wi[NC / 2];
#pragma unroll
      for (int c = 0; c < NC / 2; ++c) { wq[c] = pk(q[2 * c] * s_qs[2 * c], q[2 * c + 1] * s_qs[2 * c + 1]); wk[c] = pk(k[2 * c] * s_ks[2 * c], k[2 * c + 1] * s_ks[2 * c + 1]); wi[c] = pk(q[2 * c] * s_qi[2 * c], q[2 * c + 1] * s_qi[2 * c + 1]); }
      if (MIXER == MIX_C) {
        *(u32x2*)(QS + lane * LD_D + c0 * 2) = (u32x2){wq[0], wq[1]}; *(u32x2*)(QS + lane * LD_D + (32 + c0) * 2) = (u32x2){wq[2], wq[3]};
        *(u32x2*)(KS + lane * LD_D + c0 * 2) = (u32x2){wk[0], wk[1]}; *(u32x2*)(KS + lane * LD_D + (32 + c0) * 2) = (u32x2){wk[2], wk[3]};
        *(u32x2*)(QI + lane * LD_D + c0 * 2) = (u32x2){wi[0], wi[1]}; *(u32x2*)(QI + lane * LD_D + (32 + c0) * 2) = (u32x2){wi[2], wi[3]};
      } else {
#pragma unroll
        for (int c = 0; c < NC / 8; ++c) {
          *(u32x4*)(QS + lane * LD_D + (c0 + 8 * c) * 2) = (u32x4){wq[4 * c], wq[4 * c + 1], wq[4 * c + 2], wq[4 * c + 3]};
          *(u32x4*)(KS + lane * LD_D + (c0 + 8 * c) * 2) = (u32x4){wk[4 * c], wk[4 * c + 1], wk[4 * c + 2], wk[4 * c + 3]};
          *(u32x4*)(QI + lane * LD_D + (c0 + 8 * c) * 2) = (u32x4){wi[4 * c], wi[4 * c + 1], wi[4 * c + 2], wi[4 * c + 3]};
        }
      }
#pragma unroll
      for (int c = 0; c < NC; ++c) { const int d = (MIXER == MIX_C) ? (c < 4 ? c0 + c : 32 + c0 + c - 4) : c0 + c; *(bf16_t*)(KT + d * LD_T + lane * 2) = f2bf(k[c] * s_kt[c]); }
      *(bf16_t*)(VT + (wid * 4 + 0) * LD_T + lane * 2) = (bf16_t)(vv.x & 0xffff); *(bf16_t*)(VT + (wid * 4 + 1) * LD_T + lane * 2) = (bf16_t)(vv.x >> 16);
      *(bf16_t*)(VT + (wid * 4 + 2) * LD_T + lane * 2) = (bf16_t)(vv.y & 0xffff); *(bf16_t*)(VT + (wid * 4 + 3) * LD_T + lane * 2) = (bf16_t)(vv.y >> 16);
    }
    }
    lds_barrier();
    {
      const int it = wid & 3;
#pragma unroll
      for (int jj = 0; jj < 2; ++jj) {
        const int jt = 2 * (wid >> 2) + jj;
        if (jt <= it) {
          f32x4 acc = (f32x4){0.f, 0.f, 0.f, 0.f};
#pragma unroll
          for (int ks = 0; ks < NKD; ++ks) acc = __builtin_amdgcn_mfma_f32_16x16x32_bf16(ldfrag(KS, LD_D, jt * 16 + fr, ks * 64 + fq * 16), ldfrag(QS, LD_D, it * 16 + fr, ks * 64 + fq * 16), acc, 0, 0, 0);
          const int i = it * 16 + fr, j0 = jt * 16 + fq * 4;
          const float v0 = (j0 + 0 <= i) ? acc[0] : 0.f, v1 = (j0 + 1 <= i) ? acc[1] : 0.f, v2 = (j0 + 2 <= i) ? acc[2] : 0.f, v3 = (j0 + 3 <= i) ? acc[3] : 0.f;
          *(u32x2*)(SC + i * LD_T + j0 * 2) = (u32x2){pk(v0, v1), pk(v2, v3)};
        } else {
          const int i = it * 16 + fr, j0 = jt * 16 + fq * 4;
          *(u32x2*)(SC + i * LD_T + j0 * 2) = (u32x2){0u, 0u};
        }
      }
    }
    f32x4 oacc = (f32x4){0.f, 0.f, 0.f, 0.f}, dacc = (f32x4){0.f, 0.f, 0.f, 0.f};
    {
      const int vt = wid >> 2, it = wid & 3;
#pragma unroll
      for (int ks = 0; ks < NKD; ++ks) oacc = __builtin_amdgcn_mfma_f32_16x16x32_bf16(ldfrag(ST, LD_D, vt * 16 + fr, ks * 64 + fq * 16), ldfrag(QI, LD_D, it * 16 + fr, ks * 64 + fq * 16), oacc, 0, 0, 0);
      if (NVT == 3 && wid < 4) {
#pragma unroll
        for (int ks = 0; ks < NKD; ++ks) dacc = __builtin_amdgcn_mfma_f32_16x16x32_bf16(ldfrag(ST, LD_D, 32 + fr, ks * 64 + fq * 16), ldfrag(QI, LD_D, wid * 16 + fr, ks * 64 + fq * 16), dacc, 0, 0, 0);
      }
    }
    lds_barrier();
    {
      const int vt = wid >> 2, it = wid & 3;
#pragma unroll
      for (int ks = 0; ks < 2; ++ks) oacc = __builtin_amdgcn_mfma_f32_16x16x32_bf16(ldfrag(VT, LD_T, vt * 16 + fr, ks * 64 + fq * 16), ldfrag(SC, LD_T, it * 16 + fr, ks * 64 + fq * 16), oacc, 0, 0, 0);
      if (NVT == 3) {
        if (wid < 4) {
#pragma unroll
          for (int ks = 0; ks < 2; ++ks) dacc = __builtin_amdgcn_mfma_f32_16x16x32_bf16(ldfrag(VT, LD_T, 32 + fr, ks * 64 + fq * 16), ldfrag(SC, LD_T, wid * 16 + fr, ks * 64 + fq * 16), dacc, 0, 0, 0);
          if (fq == 0) DEN[wid * 16 + fr] = dacc[0];
        }
        lds_barrier();
        const int i = it * 16 + fr;
        const float dn = 1.0f / fmaxf(fabsf(DEN[i]), EM[i]);
        oacc *= dn;
      }
      const int i = it * 16 + fr;
      const int ti = dir ? (SEQ - 1 - (n * 64 + i)) : (n * 64 + i);
      *(u32x2*)(O + (tokbase + ti) * 1024 + ocol + vt * 16 + fq * 4) = (u32x2){pk(oacc[0], oacc[1]), pk(oacc[2], oacc[3])};
    }
    {
      constexpr int NST = (DK == 128) ? NVT : 1;
#pragma unroll
      for (int s = 0; s < NST; ++s) {
        const int dt = (DK == 128) ? wid : (wid & 3), vt = (DK == 128) ? s : (wid >> 2);
        const f32x4 dc = *(const f32x4*)(DEC + dt * 16 + fq * 4);
        f32x4 acc = sacc[s] * dc;
#pragma unroll
        for (int ks = 0; ks < 2; ++ks) acc = __builtin_amdgcn_mfma_f32_16x16x32_bf16(ldfrag(KT, LD_T, dt * 16 + fr, ks * 64 + fq * 16), ldfrag(VT, LD_T, vt * 16 + fr, ks * 64 + fq * 16), acc, 0, 0, 0);
        sacc[s] = acc;
        *(u32x2*)(ST + (vt * 16 + fr) * LD_D + (dt * 16 + fq * 4) * 2) = (u32x2){pk(acc[0], acc[1]), pk(acc[2], acc[3])};
      }
    }
    lds_barrier();
  }
}

template <int MIXER>
__device__ __forceinline__ void scan_dispatch(unsigned char* lds, int wv, const Params& p, int id) {
  const int vs = id & 3, dir = (id >> 2) & 1, h = (id >> 3) & 3, b = id >> 5;
  scan_item<MIXER>(lds, wv, p, b, h, dir, vs);
}
}

__device__ __forceinline__ void convd_phase(unsigned char* lds_, int wv, const Params& p) {
  const Ctx c = make_ctx(lds_, wv);
  bf16_t* P = (bf16_t*)(p.ws + WS_R1); bf16_t* QD = (bf16_t*)(p.ws + WS_LFB);
  const float* cw = p.in[I_CONV_W]; const float* cb = p.in[I_CONV_B];
  const int ch = c.lane * 16;
  float w0[16], w1[16], w2[16], bb[16];
#pragma unroll
  for (int j = 0; j < 16; ++j) { w0[j] = cw[ch + j]; w1[j] = cw[1024 + ch + j]; w2[j] = cw[2048 + ch + j]; bb[j] = cb[ch + j]; }
  for (int tok = c.bid * 8 + c.wid; tok < NTOK; tok += c.G * 8) {
    const int t = tok % SEQ;
    const bf16_t* row = P + PIDX(tok, 1536 + ch);
    float x0[16], x1[16], x2[16];
    { const u32x4* r1 = (const u32x4*)row; unpack8(r1[0], x1); unpack8(r1[1], x1 + 8); }
    if (t > 0) { const u32x4* r0 = (const u32x4*)(row - 128); unpack8(r0[0], x0); unpack8(r0[1], x0 + 8); }
    else {
#pragma unroll
      for (int j = 0; j < 16; ++j) x0[j] = 0.f; }
    if (t < SEQ - 1) { const u32x4* r2 = (const u32x4*)(row + 128); unpack8(r2[0], x2); unpack8(r2[1], x2 + 8); }
    else {
#pragma unroll
      for (int j = 0; j < 16; ++j) x2[j] = 0.f; }
    const float sc = ch < 512 ? 0.08838834764831845f : 1.0f;
    unsigned w[8];
#pragma unroll
    for (int j = 0; j < 8; ++j) {
      const float a0 = bb[2 * j] + w0[2 * j] * x0[2 * j] + w1[2 * j] * x1[2 * j] + w2[2 * j] * x2[2 * j];
      const float a1 = bb[2 * j + 1] + w0[2 * j + 1] * x0[2 * j + 1] + w1[2 * j + 1] * x1[2 * j + 1] + w2[2 * j + 1] * x2[2 * j + 1];
      w[j] = pk2(fsilu(a0) * sc, fsilu(a1) * sc);
    }
    u32x4* d = (ch < 512) ? (u32x4*)(QD + PIDX(tok, ch)) : (u32x4*)(P + PIDX(tok, 3584 + (ch - 512)));
    d[0] = (u32x4){w[0], w[1], w[2], w[3]}; d[1] = (u32x4){w[4], w[5], w[6], w[7]};
  }
}

__device__ __forceinline__ void scan_phase(unsigned char* lds, int wv, const Params& p, int layer) {
  for (int item = blockIdx.x; item < 256; item += gridDim.x) {
    if (layer == 0) { if (item < 128) scan::scan_dispatch<scan::MIX_A>(lds, wv, p, item); else scan::scan_dispatch<scan::MIX_B>(lds, wv, p, item - 128); }
    else { if (item < 128) scan::scan_dispatch<scan::MIX_D>(lds, wv, p, item); else scan::scan_dispatch<scan::MIX_C>(lds, wv, p, item - 128); }
    __syncthreads();
  }
}
#endif
#ifndef CPU_EMU
namespace scan2 {
using namespace scan;
constexpr int S_QS = 0, S_KS = 17408, S_QI = 34816, S_KT = 52224  , S_VT = 89088  , S_SC = 102912, S_ST = 112128  , S_DEC = 138240  , S_EM = 139264  , S_END = 139776;

constexpr int U_QI = 0, U_KS = 34816, U_KT = 69632, U_VT = 106496, U_SC = 120320, U_ST = 129536, U_DEC = 155648, U_EM = 156672, U_END = 157184;
template <int MIXER>
__device__ __forceinline__ void scan_item2(unsigned char* lds, int wv, const Params& p, int b, int h, int dir, int vs) {
  constexpr int DK = (MIXER == MIX_A || MIXER == MIX_D) ? 128 : 64;
  constexpr int NC = DK / 8;
  constexpr int LD_D = DK * 2 + 16;
  constexpr int NVT = MIXER == MIX_D ? 3 : 2;
  constexpr int NKD = DK / 32;
  constexpr int NST = (DK == 128) ? NVT : 1;
  constexpr int NCH = SEQ / 64;
  const int tid = opaque_tid(wv), lane0 = tid & 63, wid = __builtin_amdgcn_readfirstlane(tid >> 6);
  unsigned char* ws = p.ws;
  const bf16_t* P = (const bf16_t*)(ws + WS_R1);
  const bf16_t* LFBp = (const bf16_t*)(ws + WS_LFB);
  const float* side = (const float*)(ws + WS_SIDE);
  const float* rope = (const float*)(ws + WS_ROPE);
  bf16_t* O = (bf16_t*)(ws + WS_R2) + (size_t)dir * NTOK * 1024;
  unsigned char* SC = lds + U_SC;
  int qcol, kcol, lfcol, vcol, ocol;
  if (MIXER == MIX_A) { qcol = h * 128; kcol = 0; lfcol = 512 + dir * 512 + h * 128; vcol = 1536 + h * 128 + vs * 32; ocol = h * 128 + vs * 32; }
  else if (MIXER == MIX_B) { qcol = 2560 + h * 64; kcol = 2816 + h * 64; lfcol = dir * 256 + h * 64; vcol = 3072 + h * 128 + vs * 32; ocol = 512 + h * 128 + vs * 32; }
  else if (MIXER == MIX_C) { qcol = h * 64; kcol = 256 + h * 64; lfcol = 0; vcol = 512 + h * 128 + vs * 32; ocol = h * 128 + vs * 32; }
  else { qcol = h * 128; kcol = 3584 + h * 128; lfcol = 0; vcol = 2560 + h * 128 + vs * 32; ocol = 512 + h * 128 + vs * 32; }
  const size_t tokbase = (size_t)b * SEQ;
  const int c0 = (MIXER == MIX_C) ? wid * 4 : wid * NC;
  for (int i = tid; i < 2 * 13056 / 4; i += NTHREADS) ((unsigned*)(lds + U_ST))[i] = 0u;
  for (int i = tid; i < 9216 / 4; i += NTHREADS) ((unsigned*)(lds + U_SC))[i] = 0u;
  if (MIXER == MIX_D) { for (int i = tid; i < 2 * 16 * 64; i += NTHREADS) { const int bf = i >> 10, r = 32 + ((i >> 6) & 15), j = i & 63; *(bf16_t*)(lds + U_VT + bf * 6912 + r * LD_T + j * 2) = (r == 32) ? (bf16_t)0x3F80 : (bf16_t)0; } }
  const float lgam2 = (MIXER == MIX_C) ? log1pf(-exp2f(-(5.0f + 2.0f * (float)h + (float)dir))) * 1.4426950408889634f : 0.f;
  const float fgb = (MIXER == MIX_D) ? p.in[I_FGATE_B][dir * 4 + h] : 0.f;
  float m_st = 0.f;
  __syncthreads();

  Raw R, Rn; u32x2 Rv, Rvn;
#define A_LOAD(R, Rv, n_) do { \
    const int ln_ = lane0; \
    const int t_ = dir ? (SEQ - 1 - ((n_) * 64 + ln_)) : ((n_) * 64 + ln_); \
    const size_t tk_ = tokbase + t_; \
    if (MIXER == MIX_A) { const u32x4* qp_ = (const u32x4*)(P + PIDX(tk_, qcol + c0)); const u32x4* lp_ = (const u32x4*)(P + PIDX(tk_, lfcol + c0)); R.a0 = qp_[0]; R.a1 = qp_[1]; R.b0 = lp_[0]; R.b1 = lp_[1]; } \
    else if (MIXER == MIX_B) { R.a0 = *(const u32x4*)(P + PIDX(tk_, qcol + c0)); R.a1 = *(const u32x4*)(P + PIDX(tk_, kcol + c0)); R.b0 = *(const u32x4*)(LFBp + PIDX(tk_, lfcol + c0)); } \
    else if (MIXER == MIX_C) { const u32x2 qa_ = *(const u32x2*)(P + PIDX(tk_, qcol + c0)), qb_ = *(const u32x2*)(P + PIDX(tk_, qcol + 32 + c0)), ka_ = *(const u32x2*)(P + PIDX(tk_, kcol + c0)), kb_ = *(const u32x2*)(P + PIDX(tk_, kcol + 32 + c0)); \
      R.a0 = (u32x4){qa_.x, qa_.y, qb_.x, qb_.y}; R.a1 = (u32x4){ka_.x, ka_.y, kb_.x, kb_.y}; \
      R.r0 = *(const f32x4*)(rope + ((size_t)t_ * 32 + c0) * 2); R.r1 = *(const f32x4*)(rope + ((size_t)t_ * 32 + c0) * 2 + 4); } \
    else { const u32x4* qp_ = (const u32x4*)(LFBp + PIDX(tk_, qcol + c0)); const u32x4* kp_ = (const u32x4*)(P + PIDX(tk_, kcol + c0)); R.a0 = qp_[0]; R.a1 = qp_[1]; R.b0 = kp_[0]; R.b1 = kp_[1]; \
      R.s0 = side[tk_ * 32 + dir * 8 + h]; R.s1 = side[tk_ * 32 + dir * 8 + 4 + h]; } \
    Rv = *(const u32x2*)(P + PIDX(tk_, vcol + wid * 4)); } while (0)

  float rr_next = 1.f, rr_cur = 1.f;
#define A_PREP(buf_, R, Rv) do { \
    const int lane = lane0; \
    unsigned char* KTb = lds + U_KT + (buf_) * 18432; float* DECb = (float*)(lds + U_DEC + (buf_) * 512); float* EMb = (float*)(lds + U_EM + (buf_) * 256); \
    unsigned char* QIb = lds + U_QI + (buf_) * 17408; unsigned char* KSb = lds + U_KS + (buf_) * 17408; \
    float q[NC], k[NC], g[NC], ktv[NC]; \
    if (MIXER == MIX_A) { \
      const unsigned qw[8] = {R.a0.x, R.a0.y, R.a0.z, R.a0.w, R.a1.x, R.a1.y, R.a1.z, R.a1.w}, lw[8] = {R.b0.x, R.b0.y, R.b0.z, R.b0.w, R.b1.x, R.b1.y, R.b1.z, R.b1.w}; \
      _Pragma("unroll") for (int c = 0; c < 8; ++c) { q[2 * c] = lo16(qw[c]); q[2 * c + 1] = hi16(qw[c]); g[2 * c] = lo16(lw[c]); g[2 * c + 1] = hi16(lw[c]); } \
      _Pragma("unroll") for (int c = 0; c < NC; ++c) k[c] = 1.0f - __builtin_amdgcn_exp2f(g[c]); \
    } else if (MIXER == MIX_B) { \
      const unsigned qw[4] = {R.a0.x, R.a0.y, R.a0.z, R.a0.w}, kw[4] = {R.a1.x, R.a1.y, R.a1.z, R.a1.w}, lw[4] = {R.b0.x, R.b0.y, R.b0.z, R.b0.w}; \
      _Pragma("unroll") for (int c = 0; c < 4; ++c) { q[2 * c] = lo16(qw[c]); q[2 * c + 1] = hi16(qw[c]); k[2 * c] = lo16(kw[c]); k[2 * c + 1] = hi16(kw[c]); g[2 * c] = lo16(lw[c]); g[2 * c + 1] = hi16(lw[c]); } \
    } else if (MIXER == MIX_C) { \
      const float cs[4] = {R.r0[0], R.r0[2], R.r1[0], R.r1[2]}, sn[4] = {R.r0[1], R.r0[3], R.r1[1], R.r1[3]}; \
      const float q1[4] = {lo16(R.a0.x), hi16(R.a0.x), lo16(R.a0.y), hi16(R.a0.y)}, q2[4] = {lo16(R.a0.z), hi16(R.a0.z), lo16(R.a0.w), hi16(R.a0.w)}; \
      const float k1[4] = {lo16(R.a1.x), hi16(R.a1.x), lo16(R.a1.y), hi16(R.a1.y)}, k2[4] = {lo16(R.a1.z), hi16(R.a1.z), lo16(R.a1.w), hi16(R.a1.w)}; \
      _Pragma("unroll") for (int c = 0; c < 4; ++c) { q[c] = (q1[c] * cs[c] - q2[c] * sn[c]) * 0.125f; q[4 + c] = (q1[c] * sn[c] + q2[c] * cs[c]) * 0.125f; k[c] = k1[c] * cs[c] - k2[c] * sn[c]; k[4 + c] = k1[c] * sn[c] + k2[c] * cs[c]; } \
    } else { \
      const unsigned qw[8] = {R.a0.x, R.a0.y, R.a0.z, R.a0.w, R.a1.x, R.a1.y, R.a1.z, R.a1.w}, kw[8] = {R.b0.x, R.b0.y, R.b0.z, R.b0.w, R.b1.x, R.b1.y, R.b1.z, R.b1.w}; \
      _Pragma("unroll") for (int c = 0; c < 8; ++c) { q[2 * c] = lo16(qw[c]); q[2 * c + 1] = hi16(qw[c]); k[2 * c] = lo16(kw[c]); k[2 * c + 1] = hi16(kw[c]); } \
    } \
    if (MIXER == MIX_A || MIXER == MIX_B) { \
        \
      _Pragma("unroll") for (int c = 0; c < NC; ++c) g[c] += __builtin_bit_cast(float, __builtin_amdgcn_update_dpp(0, __builtin_bit_cast(int, g[c]), 0x111, 0xf, 0xf, false)); \
      _Pragma("unroll") for (int c = 0; c < NC; ++c) g[c] += __builtin_bit_cast(float, __builtin_amdgcn_update_dpp(0, __builtin_bit_cast(int, g[c]), 0x112, 0xf, 0xf, false)); \
      _Pragma("unroll") for (int c = 0; c < NC; ++c) g[c] += __builtin_bit_cast(float, __builtin_amdgcn_update_dpp(0, __builtin_bit_cast(int, g[c]), 0x114, 0xf, 0xf, false)); \
      _Pragma("unroll") for (int c = 0; c < NC; ++c) g[c] += __builtin_bit_cast(float, __builtin_amdgcn_update_dpp(0, __builtin_bit_cast(int, g[c]), 0x118, 0xf, 0xf, false)); \
      _Pragma("unroll") for (int c = 0; c < NC; ++c) g[c] += __builtin_bit_cast(float, __builtin_amdgcn_update_dpp(0, __builtin_bit_cast(int, g[c]), 0x142, 0xa, 0xf, false)); \
      _Pragma("unroll") for (int c = 0; c < NC; ++c) g[c] += __builtin_bit_cast(float, __builtin_amdgcn_update_dpp(0, __builtin_bit_cast(int, g[c]), 0x143, 0xc, 0xf, false)); \
      float ev[NC]; \
      _Pragma("unroll") for (int c = 0; c < NC; ++c) { \
          \
        const float e = __builtin_amdgcn_exp2f(g[c]), r = __builtin_amdgcn_rcpf(e); \
        const float e63 = rdlane(e, 63); \
        q[c] *= e; k[c] *= r; ktv[c] = k[c] * e63;     \
        ev[c] = e; } \
      if (lane == 63) { _Pragma("unroll") for (int c = 0; c < NC / 4; ++c) *(f32x4*)(DECb + c0 + 4 * c) = (f32x4){ev[4 * c], ev[4 * c + 1], ev[4 * c + 2], ev[4 * c + 3]}; } \
    } else if (MIXER == MIX_C) { \
        \
      const float gl = (float)(lane + 1) * lgam2; \
      const float e = __builtin_amdgcn_exp2f(gl), r = __builtin_amdgcn_rcpf(e); \
      const float e63 = rdlane(e, 63); const float f_kt = r * e63; \
      _Pragma("unroll") for (int c = 0; c < NC; ++c) { q[c] *= e; ktv[c] = k[c] * f_kt; k[c] *= r; } \
      if (lane < 4) { DECb[c0 + lane] = e63; DECb[32 + c0 + lane] = e63; } \
    } else { \
      const float li = R.s0, lf = R.s1;     \
      const float bc = incl_scan_add(lf); const float u = li - bc; const float pm = incl_scan_max(u); \
      const float cmax = rdlane(pm, 63), blast = rdlane(bc, 63); \
      const float a_i = bc + m_st, m_i = fmaxf(a_i, bc + pm); \
      const float d_alpha = __builtin_amdgcn_exp2f(bc - m_i + cmax), d_beta = __builtin_amdgcn_exp2f(u - cmax); \
      rr_next = __builtin_amdgcn_exp2f(m_st - cmax);     \
      const float m_new = fmaxf(blast + m_st, blast + cmax); \
      const float d_sold = __builtin_amdgcn_exp2f(blast + m_st - m_new), d_wks = __builtin_amdgcn_exp2f(blast + u - m_new); m_st = m_new; \
      _Pragma("unroll") for (int c = 0; c < NC; ++c) { ktv[c] = k[c] * d_wks; q[c] *= d_alpha; k[c] *= d_beta; if (lane == 63) DECb[c0 + c] = d_sold; } \
      if (wid == 0) EMb[lane] = __builtin_amdgcn_exp2f(-m_i); \
    } \
    _Pragma("unroll") for (int c = 0; c < NC / 2; ++c) { const unsigned w_ = pk_hw(ktv[2 * c], ktv[2 * c + 1]); \
      const int d0_ = (MIXER == MIX_C) ? (2 * c < 4 ? c0 + 2 * c : 32 + c0 + 2 * c - 4) : c0 + 2 * c; \
      *(bf16_t*)(KTb + d0_ * LD_T + lane * 2) = (bf16_t)(w_ & 0xffff); *(bf16_t*)(KTb + (d0_ + 1) * LD_T + lane * 2) = (bf16_t)(w_ >> 16); } \
    { unsigned pq[NC / 2], pks[NC / 2]; \
      _Pragma("unroll") for (int c = 0; c < NC / 2; ++c) { pq[c] = pk_hw(q[2 * c], q[2 * c + 1]); pks[c] = pk_hw(k[2 * c], k[2 * c + 1]); } \
      if (MIXER == MIX_C) { \
        *(u32x2*)(QIb + lane * LD_D + c0 * 2) = (u32x2){pq[0], pq[1]}; *(u32x2*)(QIb + lane * LD_D + (32 + c0) * 2) = (u32x2){pq[2], pq[3]}; \
        *(u32x2*)(KSb + lane * LD_D + c0 * 2) = (u32x2){pks[0], pks[1]}; *(u32x2*)(KSb + lane * LD_D + (32 + c0) * 2) = (u32x2){pks[2], pks[3]}; \
      } else { \
        _Pragma("unroll") for (int c = 0; c < NC / 8; ++c) { \
          *(u32x4*)(QIb + lane * LD_D + (c0 + 8 * c) * 2) = (u32x4){pq[4 * c], pq[4 * c + 1], pq[4 * c + 2], pq[4 * c + 3]}; \
          *(u32x4*)(KSb + lane * LD_D + (c0 + 8 * c) * 2) = (u32x4){pks[4 * c], pks[4 * c + 1], pks[4 * c + 2], pks[4 * c + 3]}; } } } \
    { unsigned char* VTb = lds + U_VT + (buf_) * 6912 + (wid * 4) * LD_T + lane * 2; \
      *(bf16_t*)(VTb + 0 * LD_T) = (bf16_t)(Rv.x & 0xffff); *(bf16_t*)(VTb + 1 * LD_T) = (bf16_t)(Rv.x >> 16); *(bf16_t*)(VTb + 2 * LD_T) = (bf16_t)(Rv.y & 0xffff); *(bf16_t*)(VTb + 3 * LD_T) = (bf16_t)(Rv.y >> 16); } \
  } while (0)
  f32x4 sacc[NST];
#pragma unroll
  for (int i = 0; i < NST; ++i) sacc[i] = (f32x4){0.f, 0.f, 0.f, 0.f};
  A_LOAD(R, Rv, 0);
  A_PREP(0, R, Rv);
  A_LOAD(R, Rv, 1);
  A_LOAD(Rn, Rvn, 2);
  rr_cur = rr_next;
  lds_barrier();
#define SCAN_ITER(n_, RX, RvX) do { const int n = (n_); \
    const int cb = n & 1, nb = (n + 1) & 1; \
    if (n + 1 < NCH) { A_PREP(nb, RX, RvX); if (n + 3 < NCH) A_LOAD(RX, RvX, n + 3); } \
    { { \
      const int lane = lane0; \
      const int fr = lane & 15, fq = lane >> 4; \
      const int it = wid & 3, vt = wid >> 2; \
      const unsigned char* STc = lds + U_ST + cb * 13056; unsigned char* STn = lds + U_ST + nb * 13056; \
      const unsigned char* KTc = lds + U_KT + cb * 18432; const unsigned char* VTc = lds + U_VT + cb * 6912; \
      const unsigned char* QI = lds + U_QI + cb * 17408; const unsigned char* KS = lds + U_KS + cb * 17408; \
      const float* DECc = (const float*)(lds + U_DEC + cb * 512); const float* EMc = (const float*)(lds + U_EM + cb * 256); \
_Pragma("unroll") \
      for (int jt = 0; jt < 4; ++jt) { \
        if (jt <= it) { \
          f32x4 acc = (f32x4){0.f, 0.f, 0.f, 0.f}; \
_Pragma("unroll") \
          for (int ks = 0; ks < NKD; ++ks) acc = __builtin_amdgcn_mfma_f32_16x16x32_bf16(ldfrag(KS, LD_D, jt * 16 + fr, ks * 64 + fq * 16), ldfrag(QI, LD_D, it * 16 + fr, ks * 64 + fq * 16), acc, 0, 0, 0); \
          const int i = it * 16 + fr, j0 = jt * 16 + fq * 4; \
          if (jt == it) { const float v0 = (j0 + 0 <= i) ? acc[0] : 0.f, v1 = (j0 + 1 <= i) ? acc[1] : 0.f, v2 = (j0 + 2 <= i) ? acc[2] : 0.f, v3 = (j0 + 3 <= i) ? acc[3] : 0.f; \
            *(u32x2*)(SC + i * LD_T + j0 * 2) = (u32x2){pk_hw(v0, v1), pk_hw(v2, v3)}; } \
          else *(u32x2*)(SC + i * LD_T + j0 * 2) = (u32x2){pk_hw(acc[0], acc[1]), pk_hw(acc[2], acc[3])}; \
        } \
      } \
      f32x4 oacc = (f32x4){0.f, 0.f, 0.f, 0.f}, dacc = (f32x4){0.f, 0.f, 0.f, 0.f}; \
_Pragma("unroll") \
      for (int ks = 0; ks < NKD; ++ks) oacc = __builtin_amdgcn_mfma_f32_16x16x32_bf16(ldfrag(STc, LD_D, vt * 16 + fr, ks * 64 + fq * 16), ldfrag(QI, LD_D, it * 16 + fr, ks * 64 + fq * 16), oacc, 0, 0, 0); \
      if (NVT == 3) { \
_Pragma("unroll") \
        for (int ks = 0; ks < NKD; ++ks) dacc = __builtin_amdgcn_mfma_f32_16x16x32_bf16(ldfrag(STc, LD_D, 32 + fr, ks * 64 + fq * 16), ldfrag(QI, LD_D, it * 16 + fr, ks * 64 + fq * 16), dacc, 0, 0, 0); \
      } \
      if (MIXER == MIX_D) { oacc *= rr_cur; dacc *= rr_cur; } \
      asm volatile("s_waitcnt lgkmcnt(0)" ::: "memory"); \
      oacc = __builtin_amdgcn_mfma_f32_16x16x32_bf16(ldfrag(VTc, LD_T, vt * 16 + fr, fq * 16), ldfrag(SC, LD_T, it * 16 + fr, fq * 16), oacc, 0, 0, 0); \
      if (it >= 2) oacc = __builtin_amdgcn_mfma_f32_16x16x32_bf16(ldfrag(VTc, LD_T, vt * 16 + fr, 64 + fq * 16), ldfrag(SC, LD_T, it * 16 + fr, 64 + fq * 16), oacc, 0, 0, 0); \
      float dn = 1.0f; \
      if (NVT == 3) { \
        dacc = __builtin_amdgcn_mfma_f32_16x16x32_bf16(ldfrag(VTc, LD_T, 32 + fr, fq * 16), ldfrag(SC, LD_T, it * 16 + fr, fq * 16), dacc, 0, 0, 0); \
        if (it >= 2) dacc = __builtin_amdgcn_mfma_f32_16x16x32_bf16(ldfrag(VTc, LD_T, 32 + fr, 64 + fq * 16), ldfrag(SC, LD_T, it * 16 + fr, 64 + fq * 16), dacc, 0, 0, 0); \
        const float den = __shfl(dacc[0], fr); \
        dn = 1.0f / fmaxf(fabsf(den), EMc[it * 16 + fr]); \
      } \
      { \
        const int i = it * 16 + fr; \
        const int ti = dir ? (SEQ - 1 - (n * 64 + i)) : (n * 64 + i); \
        const f32x4 o = oacc * dn; \
        *(u32x2*)(O + PIDX(tokbase + ti, ocol + vt * 16 + fq * 4)) = (u32x2){pk_hw(o[0], o[1]), pk_hw(o[2], o[3])}; \
      } \
_Pragma("unroll") \
      for (int s = 0; s < NST; ++s) { \
        const int dt = (DK == 128) ? wid : (wid & 3), vt2 = (DK == 128) ? s : (wid >> 2); \
        const f32x4 dc = *(const f32x4*)(DECc + dt * 16 + fq * 4); \
        f32x4 acc = sacc[s] * dc; \
_Pragma("unroll") \
        for (int ks = 0; ks < 2; ++ks) acc = __builtin_amdgcn_mfma_f32_16x16x32_bf16(ldfrag(KTc, LD_T, dt * 16 + fr, ks * 64 + fq * 16), ldfrag(VTc, LD_T, vt2 * 16 + fr, ks * 64 + fq * 16), acc, 0, 0, 0); \
        sacc[s] = acc; \
        *(u32x2*)(STn + (vt2 * 16 + fr) * LD_D + (dt * 16 + fq * 4) * 2) = (u32x2){pk_hw(acc[0], acc[1]), pk_hw(acc[2], acc[3])}; \
      } \
    } \
    } \
    rr_cur = rr_next; \
    lds_barrier(); \
  } while (0)
  static_assert(NCH % 2 == 0, "chunk count must be even");
#pragma unroll 1
  for (int n2 = 0; n2 < NCH; n2 += 2) { SCAN_ITER(n2, R, Rv); SCAN_ITER(n2 + 1, Rn, Rvn); }
#undef SCAN_ITER
#undef A_LOAD
#undef A_PREP
}

template <int MIXER>
__device__ __forceinline__ void scan_dispatch2(unsigned char* lds, int wv, const Params& p, int id) {
  const int vs = id & 3, dir = (id >> 2) & 1, h = (id >> 3) & 3, b = id >> 5;
  scan_item2<MIXER>(lds, wv, p, b, h, dir, vs);
}
}

__device__ __forceinline__ void scan_phase2(unsigned char* lds, int wv, const Params& p, int layer) {
  for (int it0 = blockIdx.x; it0 < 256; it0 += gridDim.x) {
    const int xq = it0 & 7, yq = it0 >> 3, stream = (yq >> 2) * 8 + xq;
    const int item = (stream >> 5) * 128 + (stream & 31) * 4 + (yq & 3);
    if (layer == 0) { if (item < 128) scan2::scan_dispatch2<scan::MIX_A>(lds, wv, p, item); else scan2::scan_dispatch2<scan::MIX_B>(lds, wv, p, item - 128); }
    else { if (item < 128) scan2::scan_dispatch2<scan::MIX_D>(lds, wv, p, item); else scan2::scan_dispatch2<scan::MIX_C>(lds, wv, p, item - 128); }
    __syncthreads();
  }
}
#endif
#ifndef CPU_EMU
__device__ __forceinline__ void grid_bar(unsigned* ctr, unsigned& epoch, unsigned G, int wv) {
  asm volatile("s_waitcnt vmcnt(0)" ::: "memory");
  __syncthreads();
  epoch += G;
  if (wv == 0 && lane_id() == 0) {
    __builtin_amdgcn_fence(__ATOMIC_RELEASE, "agent");
    asm volatile("s_waitcnt vmcnt(0)" ::: "memory");
    __hip_atomic_fetch_add(ctr, 1u, __ATOMIC_RELAXED, __HIP_MEMORY_SCOPE_AGENT);
    unsigned spins = 0;
    while (__hip_atomic_load(ctr, __ATOMIC_RELAXED, __HIP_MEMORY_SCOPE_AGENT) < epoch) { __builtin_amdgcn_s_sleep(2); if (++spins > (1u << 26)) break; }
    __builtin_amdgcn_fence(__ATOMIC_ACQUIRE, "agent");
    asm volatile("s_waitcnt vmcnt(0)" ::: "memory");
  }
  __syncthreads();
}
#if (PROBE_DUP & 16)
#define grid_bar(a, b, c, d) do { grid_bar(a, b, c, d); grid_bar(a, b, c, d); } while (0)
#endif

__global__ void __launch_bounds__(NTHREADS) mk_fwd(Params p) {
  extern __shared__ __attribute__((aligned(16))) unsigned char lds_raw[];
  cg::grid_group grid = cg::this_grid();
  const int G = gridDim.x, bid = blockIdx.x;
  const int wv = __builtin_amdgcn_readfirstlane(threadIdx.x >> 6);
  PG8_LAS unsigned char* lds = (PG8_LAS unsigned char*)lds_raw;
  unsigned char* ws = p.ws;

  p0_prologue(lds_raw, wv, p);
#if (PROBE_DUP & 128)
  p0_prologue(lds_raw, wv, p);
#endif
  grid.sync();
  unsigned* bar = (unsigned*)(ws + WS_CTL) + 1024;
  unsigned epoch = 0;
  for (int layer = 0; layer < 2; ++layer) {
    { ProbInProj pr; pr.so.init(NTOK, layer == 0 ? PM_AB : PM_CD, G, bid); pr.A = (const char*)(ws + WS_HB); pr.Bt = (const char*)(ws + (layer == 0 ? WS_WIN_AB : WS_WIN_CD));
      pr.P = (bf16_t*)(ws + WS_R1); pr.bias = p.in[layer == 0 ? I_AB_B_IN : I_CD_B_IN]; pr.lb = (const float*)(ws + WS_LB); pr.layer = layer;
      pg8::gemm_phase(lds, pr, wv);
#if (PROBE_DUP & 1)
      pg8::gemm_phase(lds, pr, wv);
#endif
      if (layer == 0) side_phase<32>(lds_raw, wv, p, 0); else side_phase<16>(lds_raw, wv, p, 1);
#if (PROBE_DUP & 256)
      if (layer == 0) side_phase<32>(lds_raw, wv, p, 0); else side_phase<16>(lds_raw, wv, p, 1);
#endif
 }
    grid_bar(bar, epoch, (unsigned)G, wv);
    if (layer == 1) { convd_phase(lds_raw, wv, p); grid_bar(bar, epoch, (unsigned)G, wv); }
    scan_phase2(lds_raw, wv, p, layer);
#if (PROBE_DUP & 2)
    scan_phase2(lds_raw, wv, p, layer);
#endif
#if (PROBE_DUP & 512)
    if (layer == 0) scan_phase2(lds_raw, wv, p, layer);
#endif
#if (PROBE_DUP & 1024)
    if (layer == 1) scan_phase2(lds_raw, wv, p, layer);
#endif
    grid_bar(bar, epoch, (unsigned)G, wv);
    headnorm_phase(lds_raw, wv, p, layer);
#if (PROBE_DUP & 8)
    headnorm_phase(lds_raw, wv, p, layer);
#endif
    grid_bar(bar, epoch, (unsigned)G, wv);
    { ProbOutProj pr; pr.so.init(NTOK, 1024, G, bid); pr.A = (const char*)(ws + WS_HB); pr.Bt = (const char*)(ws + (layer == 0 ? WS_WOUT_AB : WS_WOUT_CD)); pr.Y = (float*)(ws + WS_R2); pr.Hres = layer == 0 ? p.in[I_X] : p.out;
      pg8::gemm_phase(lds, pr, wv);
#if (PROBE_DUP & 1)
      pg8::gemm_phase(lds, pr, wv);
#endif
      moe_weight_convert(lds_raw, wv, p, layer);
#if (PROBE_DUP & 4)
      moe_weight_convert(lds_raw, wv, p, layer);
#endif
 }
    grid_bar(bar, epoch, (unsigned)G, wv);
#if (PROBE_DUP & 32)
    ln_phase(lds_raw, wv, p, layer, 0, 1);
#endif
    ln_phase(lds_raw, wv, p, layer, 0);
    grid_bar(bar, epoch, (unsigned)G, wv);
    { ProbMoe1 pr; pr.mo.init((const int*)((const unsigned*)(ws + WS_CTL) + CW_CNT(layer)), 8, G, bid, lds_raw, wv);
      pr.A = (const char*)(ws + WS_HB); pr.W13 = (const char*)(ws + WS_WMOE); pr.list = (const int*)(ws + WS_LIST) + (size_t)layer * NEXP * NTOK; pr.H = (bf16_t*)(ws + WS_H);
      pg8::gemm_phase(lds, pr, wv);
#if (PROBE_DUP & 1)
      pg8::gemm_phase(lds, pr, wv);
#endif
 }
    grid_bar(bar, epoch, (unsigned)G, wv);
    { ProbMoe2 pr; pr.mo.init((const int*)((const unsigned*)(ws + WS_CTL) + CW_CNT(layer)), 4, G, bid, lds_raw, wv);
      pr.A = (const char*)(ws + WS_H); pr.W2 = (const char*)(ws + WS_WMOE) + (size_t)NEXP * 2048 * 1024 * 2; pr.Y = (bf16_t*)(ws + WS_R2);
      pg8::gemm_phase(lds, pr, wv);
#if (PROBE_DUP & 1)
      pg8::gemm_phase(lds, pr, wv);
#endif
 }
    grid_bar(bar, epoch, (unsigned)G, wv);
#if (PROBE_DUP & 64)
    ln_phase(lds_raw, wv, p, layer, 1, 1);
#endif
    ln_phase(lds_raw, wv, p, layer, 1);
    if (layer == 0) grid_bar(bar, epoch, (unsigned)G, wv);
  }
}

extern "C" void kernel_launch(void* const* d_in, const int* in_sizes, int n_in, void* d_out, int out_size, void* d_ws, size_t ws_size, hipStream_t stream) {
  static int grid_blocks = 0;
  if (grid_blocks == 0) {
    if (n_in != N_IN || ws_size < WS_END || out_size != NTOK * 1024) { fprintf(stderr, "kernel_launch: bad shapes: n_in %d ws %zu (need %zu) out %d\n", n_in, ws_size, (size_t)WS_END, out_size); grid_blocks = -1; return; }
    int dev = 0, cus = 0, per_cu = 0;
    hipGetDevice(&dev); hipDeviceGetAttribute(&cus, hipDeviceAttributeMultiprocessorCount, dev);
    if (hipFuncSetAttribute((const void*)mk_fwd, hipFuncAttributeMaxDynamicSharedMemorySize, LDS_BYTES) != hipSuccess) { fprintf(stderr, "kernel_launch: hipFuncSetAttribute failed\n"); grid_blocks = -1; return; }
    if (hipOccupancyMaxActiveBlocksPerMultiprocessor(&per_cu, (const void*)mk_fwd, NTHREADS, LDS_BYTES) != hipSuccess || per_cu < 1) { fprintf(stderr, "kernel_launch: occupancy query failed (%d)\n", per_cu); grid_blocks = -1; return; }
    grid_blocks = cus;
    (void)in_sizes;
  }
  if (grid_blocks < 0) return;
  Params p{};
  for (int i = 0; i < N_IN; ++i) p.in[i] = (const float*)d_in[i];
  p.out = (float*)d_out; p.ws = (unsigned char*)d_ws;
  void* args[] = {&p};
  hipError_t e = hipLaunchCooperativeKernel((const void*)mk_fwd, dim3(grid_blocks), dim3(NTHREADS), args, LDS_BYTES, stream);
  if (e != hipSuccess) fprintf(stderr, "cooperative launch failed: %s (grid %d)\n", hipGetErrorString(e), grid_blocks);
}
#endif
#ifdef CPU_EMU
#include <vector>
void dbg_cmp(const char* name, const float* p, long n);
template <class F> static void run_functor(const F& f, long n) {
#pragma omp parallel for schedule(dynamic, 16)
  for (long g = 0; g < n; ++g) f(g);
}
static void cpu_round_w(const float* src, size_t n, std::vector<float>& dst) { dst.resize(n); for (size_t i = 0; i < n; ++i) dst[i] = bf2f(f2bf(src[i])); }

extern "C" void kernel_launch(void* const* d_in, const int* in_sizes, int n_in, void* d_out, int out_size, void* d_ws, size_t ws_size, hipStream_t) {
  (void)in_sizes; (void)n_in; (void)out_size;
  if (ws_size < WS_END) { printf("ws too small %zu < %zu\n", ws_size, (size_t)WS_END); return; }
  Params p{}; for (int i = 0; i < N_IN; ++i) p.in[i] = (const float*)d_in[i];
  p.out = (float*)d_out; p.ws = (unsigned char*)d_ws;
  unsigned char* ws = p.ws;
  bf16_t* HB = (bf16_t*)(ws + WS_HB); bf16_t* P = (bf16_t*)(ws + WS_R1); bf16_t* LFB = (bf16_t*)(ws + WS_LFB);
  bf16_t* O = (bf16_t*)(ws + WS_R2); float* yf = (float*)(ws + WS_R2); bf16_t* Y = (bf16_t*)(ws + WS_R2); bf16_t* H = (bf16_t*)(ws + WS_H);
  float* side = (float*)(ws + WS_SIDE); float* oside = (float*)(ws + WS_OSIDE); float* rope = (float*)(ws + WS_ROPE); float* lb = (float*)(ws + WS_LB);
  int* assign = (int*)(ws + WS_ASSIGN); float* gate = (float*)(ws + WS_GATE);
  for (size_t i = 0; i < (size_t)NTOK * 1024; ++i) HB[i] = f2bf(p.in[I_X][i]);
  for (int i = 0; i < SEQ * 32; ++i) { int t = i >> 5, f = i & 31; float freq = powf(10000.0f, -(float)f / 32.0f); float ang = (float)t * freq; rope[i * 2] = cosf(ang); rope[i * 2 + 1] = sinf(ang); }
  for (int cc = 0; cc < 512; ++cc) { const float* hl = p.in[I_HGRN_LB]; float a0 = hl[cc], a1 = hl[512 + cc], a2 = hl[1024 + cc]; float mx = fmaxf(a0, fmaxf(a1, a2));
    float e0 = expf(a0 - mx), e1 = expf(a1 - mx), e2 = expf(a2 - mx); lb[cc] = e0 / (e0 + e1 + e2); }
  std::vector<float> wr;
  for (int layer = 0; layer < 2; ++layer) {
    const int PW = layer == 0 ? P_AB : P_CD, PM = layer == 0 ? PM_AB : PM_CD;
    const float* bias = p.in[layer == 0 ? I_AB_B_IN : I_CD_B_IN];
    cpu_round_w(p.in[layer == 0 ? I_AB_W_IN : I_CD_W_IN], (size_t)1024 * PW, wr);
#pragma omp parallel for
    for (long tok = 0; tok < NTOK; ++tok) {
      std::vector<float> acc(PW, 0.f);
      for (int k = 0; k < 1024; ++k) { float a = bf2f(HB[tok * 1024 + k]); const float* w = &wr[(size_t)k * PW]; for (int n = 0; n < PW; ++n) acc[n] += a * w[n]; }
      for (int n = 0; n < PM; ++n) { float v = acc[n] + bias[n]; if (layer == 0) v = epi_ab(n, v, lb); P[tok * PSTRIDE + n] = f2bf(v); }
      for (int n = PM; n < PW; ++n) side[tok * 32 + (n - PM)] = acc[n] + bias[n];
      if (layer == 0) for (int dir = 0; dir < 2; ++dir) for (int cc = 0; cc < 256; ++cc) {
        float z = p.in[I_GK_B][dir * 256 + cc];
        for (int r = 0; r < 16; ++r) z += side[tok * 32 + dir * 16 + r] * p.in[I_GK_UP][(dir * 16 + r) * 256 + cc];
        LFB[tok * 512 + dir * 256 + cc] = f2bf(logsigmoidf_(z) * 0.0625f); }
    }
    if (layer == 0) { ScanAB2 s{}; s.P = P; s.LFB = LFB; s.O = O; run_functor(s, (long)BATCH * 2048); }
    else { PrepCD2 pc{}; pc.P = P; pc.QD = LFB; pc.rope = rope; pc.conv_w = p.in[I_CONV_W]; pc.conv_b = p.in[I_CONV_B]; run_functor(pc, (long)NTOK * 1280);
      ScanCD2 s{}; s.P = P; s.QD = LFB; s.side = side; s.fgate_b = p.in[I_FGATE_B]; s.O = O; s.oside = oside; run_functor(s, (long)BATCH * 2056); }
#pragma omp parallel for
    for (long tok = 0; tok < NTOK; ++tok) for (int h8 = 0; h8 < 8; ++h8) {
      float sf = 1.f, sb = 1.f;
      if (layer == 1 && h8 >= 4) { int h = h8 - 4; const float* s0 = oside + tok * 8 + h * 2; const float* s1 = oside + (size_t)(NTOK + tok) * 8 + h * 2;
        sf = 1.0f / fmaxf(fabsf(s0[0]), expf(-s0[1])); sb = 1.0f / fmaxf(fabsf(s1[0]), expf(-s1[1])); }
      float o[128]; float ss = 0.f;
      for (int j = 0; j < 128; ++j) { int c = h8 * 128 + j; o[j] = bf2f(O[tok * 1024 + c]) * sf + bf2f(O[(size_t)(NTOK + tok) * 1024 + c]) * sb; ss += o[j] * o[j]; }
      float r = 1.0f / sqrtf(ss * (1.0f / 128.0f) + NORM_EPS_F);
      for (int j = 0; j < 128; ++j) { int c = h8 * 128 + j; float gn, gt;
        if (layer == 0) { gn = h8 < 4 ? p.in[I_HGRN_NORM][c] : p.in[I_GLA_NORM][c - 512]; gt = siluf_(bf2f(P[tok * PSTRIDE + (h8 < 4 ? 2048 + c : 3584 + c - 512)])); }
        else { gn = h8 < 4 ? p.in[I_RET_NORM][c] : p.in[I_MLSTM_NORM][c - 512]; float gr = bf2f(P[tok * PSTRIDE + (h8 < 4 ? 1024 + c : 3072 + c - 512)]); gt = h8 < 4 ? siluf_(gr) : sigmoidf_(gr); }
        HB[tok * 1024 + c] = f2bf(o[j] * r * gn * gt); }
    }
    cpu_round_w(p.in[layer == 0 ? I_AB_W_OUT : I_CD_W_OUT], (size_t)1024 * 1024, wr);
#pragma omp parallel for
    for (long tok = 0; tok < NTOK; ++tok) { std::vector<float> acc(1024, 0.f);
      for (int k = 0; k < 1024; ++k) { float a = bf2f(HB[tok * 1024 + k]); const float* w = &wr[(size_t)k * 1024]; for (int n = 0; n < 1024; ++n) acc[n] += a * w[n]; }
      for (int n = 0; n < 1024; ++n) yf[tok * 1024 + n] = acc[n]; }
    dbg_cmp(layer == 0 ? "y_mix0" : "y_mix1", yf, (long)NTOK * 1024);
    int cnt[NEXP] = {0}; std::vector<int> list((size_t)NEXP * NTOK);
    const float* hin = layer == 0 ? p.in[I_X] : p.out;
    for (long tok = 0; tok < NTOK; ++tok) {
      float v[1024]; double s = 0; for (int c = 0; c < 1024; ++c) { v[c] = ALPHA_F * hin[tok * 1024 + c] + yf[tok * 1024 + c]; s += v[c]; }
      float mean = (float)(s / 1024); double q = 0; for (int c = 0; c < 1024; ++c) { v[c] -= mean; q += (double)v[c] * v[c]; }
      float r = 1.0f / sqrtf((float)(q / 1024) + LN_EPS_F);
      float lg[16] = {0};
      for (int c = 0; c < 1024; ++c) { v[c] = v[c] * r * p.in[I_LN_MIX_G][layer * 1024 + c] + p.in[I_LN_MIX_B][layer * 1024 + c]; p.out[tok * 1024 + c] = v[c]; HB[tok * 1024 + c] = f2bf(v[c]);
        for (int e = 0; e < 16; ++e) lg[e] += v[c] * p.in[I_ROUTER_W][c * 16 + e]; }
      int eo[2]; float go[2]; route_from_logits(lg, p.in[I_ROUTER_B], eo, go);
      int r1 = cnt[eo[0]]++, r2 = cnt[eo[1]]++;
      list[(size_t)eo[0] * NTOK + r1] = (int)tok; list[(size_t)eo[1] * NTOK + r2] = (int)tok;
      assign[tok * 4] = eo[0]; assign[tok * 4 + 1] = r1; assign[tok * 4 + 2] = eo[1]; assign[tok * 4 + 3] = r2; gate[tok * 2] = go[0]; gate[tok * 2 + 1] = go[1];
    }
    dbg_cmp(layer == 0 ? "h_mix0" : "h_mix1", p.out, (long)NTOK * 1024);
    int pad[NEXP]; { int a = 0; for (int e = 0; e < NEXP; ++e) { pad[e] = a; a += ((cnt[e] + 255) >> 8) << 8; } }
    const size_t lo = (size_t)layer * NEXP * 1024 * 1024;
    for (int e = 0; e < NEXP; ++e) {
      std::vector<float> w1, w3, w2; cpu_round_w(p.in[I_MOE_W1] + lo + (size_t)e * 1048576, 1048576, w1); cpu_round_w(p.in[I_MOE_W3] + lo + (size_t)e * 1048576, 1048576, w3); cpu_round_w(p.in[I_MOE_W2] + lo + (size_t)e * 1048576, 1048576, w2);
#pragma omp parallel for
      for (int rr = 0; rr < cnt[e]; ++rr) { int tok = list[(size_t)e * NTOK + rr]; size_t pos = pad[e] + rr;
        std::vector<float> a1(1024, 0.f), a3(1024, 0.f), a2(1024, 0.f);
        for (int k = 0; k < 1024; ++k) { float a = bf2f(HB[(size_t)tok * 1024 + k]); const float* p1 = &w1[(size_t)k * 1024]; const float* p3 = &w3[(size_t)k * 1024]; for (int n = 0; n < 1024; ++n) { a1[n] += a * p1[n]; a3[n] += a * p3[n]; } }
        for (int n = 0; n < 1024; ++n) H[pos * 1024 + n] = f2bf(siluf_(a1[n]) * a3[n]);
        for (int k = 0; k < 1024; ++k) { float a = bf2f(H[pos * 1024 + k]); const float* p2 = &w2[(size_t)k * 1024]; for (int n = 0; n < 1024; ++n) a2[n] += a * p2[n]; }
        for (int n = 0; n < 1024; ++n) Y[pos * 1024 + n] = f2bf(a2[n]); }
    }
    for (long tok = 0; tok < NTOK; ++tok) {
      size_t p0 = pad[assign[tok * 4]] + assign[tok * 4 + 1], p1 = pad[assign[tok * 4 + 2]] + assign[tok * 4 + 3];
      float v[1024]; double s = 0; for (int c = 0; c < 1024; ++c) { v[c] = ALPHA_F * p.out[tok * 1024 + c] + gate[tok * 2] * bf2f(Y[p0 * 1024 + c]) + gate[tok * 2 + 1] * bf2f(Y[p1 * 1024 + c]); s += v[c]; }
      float mean = (float)(s / 1024); double q = 0; for (int c = 0; c < 1024; ++c) { v[c] -= mean; q += (double)v[c] * v[c]; }
      float r = 1.0f / sqrtf((float)(q / 1024) + LN_EPS_F);
      for (int c = 0; c < 1024; ++c) { v[c] = v[c] * r * p.in[I_LN_FFN_G][layer * 1024 + c] + p.in[I_LN_FFN_B][layer * 1024 + c]; p.out[tok * 1024 + c] = v[c]; HB[tok * 1024 + c] = f2bf(v[c]); }
    }
    dbg_cmp(layer == 0 ? "h_ffn0" : "h_ffn1", p.out, (long)NTOK * 1024);
  }
}
#endif
```

```cpp
#ifdef CPU_EMU
#include <cmath>
#include <cstdio>
#include <cstring>
#include <cstdlib>
#include <cstddef>
#define DEV
#define DEV_INLINE static inline
typedef void* hipStream_t;
#else
#include <hip/hip_runtime.h>
#include <hip/hip_bf16.h>
#include <cstdio>
#define DEV __device__ __forceinline__
#define DEV_INLINE __device__ __forceinline__
#endif
#ifndef PROBE_DUP
#define PROBE_DUP 0
#endif
#ifndef BATCH
#define BATCH 4
#endif
#ifndef SEQ
#define SEQ 8192
#endif
#define DM 1024
#define NTOK (BATCH * SEQ)
#define P_AB 4128
#define P_CD 3600
#define PM_AB 4096
#define PM_CD 3584
#define NEXP 16
#define ALPHA_F 1.4142135623730951f
#define LN_EPS_F 1e-5f
#define NORM_EPS_F 1e-6f
#define HROWS (2 * NTOK + NEXP * 256)

typedef unsigned short bf16_t;

DEV_INLINE float bf2f(bf16_t b) { unsigned u = ((unsigned)b) << 16; float f; memcpy(&f, &u, 4); return f; }
DEV_INLINE bf16_t f2bf(float f) { unsigned u; memcpy(&u, &f, 4); u += 0x7FFFu + ((u >> 16) & 1u); return (bf16_t)(u >> 16); }
DEV_INLINE float sigmoidf_(float x) { return 1.0f / (1.0f + expf(-x)); }
DEV_INLINE float siluf_(float x) { return x / (1.0f + expf(-x)); }
DEV_INLINE float logsigmoidf_(float x) { return fminf(x, 0.0f) - log1pf(expf(-fabsf(x))); }

#define AL256(x) (((size_t)(x) + 255) & ~(size_t)255)
#define WS_CTL    ((size_t)0)
#define WS_HB     ((size_t)65536)
#define WS_R1     (WS_HB + (size_t)NTOK * 1024 * 2)
#define R1_P_BYTES ((size_t)NTOK * 4096 * 2)
#define R1_MIN    (AL256((size_t)HROWS * 1024 * 2) + (size_t)NEXP * 3072 * 1024 * 2)
#define R1_PL     (R1_P_BYTES + (size_t)NTOK * 512 * 2)
#define R1_BYTES  (R1_PL > R1_MIN ? R1_PL : R1_MIN)
#define WS_LFB    (WS_R1 + R1_P_BYTES)
#define WS_H      (WS_R1)
#define WS_WMOE   (WS_R1 + AL256((size_t)HROWS * 1024 * 2))
#define WMOE_BYTES ((size_t)NEXP * 3072 * 1024 * 2)
#define WS_R2     (WS_R1 + R1_BYTES)
#define R2_BYTES  ((size_t)HROWS * 1024 * 2 > (size_t)NTOK * 1024 * 4 ? (size_t)HROWS * 1024 * 2 : (size_t)NTOK * 1024 * 4)
#define WS_SIDE   (WS_R2 + AL256(R2_BYTES))
#define WS_OSIDE  (WS_SIDE + (size_t)NTOK * 32 * 4)
#define WS_WIN_AB (WS_OSIDE + (size_t)2 * NTOK * 8 * 4)
#define WS_WIN_CD (WS_WIN_AB + (size_t)4128 * 1024 * 2)
#define WS_WOUT_AB (WS_WIN_CD + (size_t)3600 * 1024 * 2)
#define WS_WOUT_CD (WS_WOUT_AB + (size_t)1024 * 1024 * 2)
#define WS_ROPE   (WS_WOUT_CD + (size_t)1024 * 1024 * 2)
#define WS_LB     (WS_ROPE + (size_t)SEQ * 64 * 4)
#define WS_LIST   (WS_LB + 4096)
#define WS_ASSIGN (WS_LIST + (size_t)2 * NEXP * NTOK * 4)
#define WS_GATE   (WS_ASSIGN + (size_t)NTOK * 16)
#define WS_END    (WS_GATE + (size_t)NTOK * 8)
#define CW_CNT(layer) (64 + 256 * (layer))

#define PSTRIDE 4096
#define PIDX(tok, col) ((((size_t)((col) >> 7)) * NTOK + (size_t)(tok)) * 128 + (size_t)((col) & 127))

enum { I_X, I_AB_W_IN, I_AB_B_IN, I_HGRN_LB, I_GK_UP, I_GK_B, I_HGRN_NORM, I_GLA_NORM, I_AB_W_OUT,
       I_CD_W_IN, I_CD_B_IN, I_CONV_W, I_CONV_B, I_FGATE_B, I_RET_NORM, I_MLSTM_NORM, I_CD_W_OUT,
       I_LN_MIX_G, I_LN_MIX_B, I_LN_FFN_G, I_LN_FFN_B, I_ROUTER_W, I_ROUTER_B, I_MOE_W1, I_MOE_W3, I_MOE_W2, N_IN };

struct Params {
  const float* in[N_IN];
  float* out;
  unsigned char* ws;
};

DEV_INLINE float epi_ab(int col, float v, const float* lb) {
  if (col < 512) return siluf_(v);
  if (col < 1536) { float l = lb[(col - 512) & 511]; return logf(l + (1.0f - l) * sigmoidf_(v)); }
  if (col >= 2560 && col < 2816) return v * 0.125f;
  return v;
}

DEV_INLINE void route_from_logits(const float* lg, const float* rb, int* e_out, float* g_out) {
  float mx = lg[0];
#pragma unroll
  for (int e = 1; e < 16; ++e) mx = fmaxf(mx, lg[e]);
  float sc[16]; float sum = 0.f;
#pragma unroll
  for (int e = 0; e < 16; ++e) { sc[e] = expf(lg[e] - mx); sum += sc[e]; }
  float inv = 1.0f / sum;
  float best_gs = -1e30f; int be1 = 0, be2 = 1; float bs1 = 0.f, bs2 = 0.f;
#pragma unroll
  for (int gq = 0; gq < 4; ++gq) {
    float m1 = -1e30f, m2 = -1e30f, s1 = 0.f, s2 = 0.f; int i1 = 0, i2 = 0;
#pragma unroll
    for (int i = 0; i < 4; ++i) {
      float s = sc[gq * 4 + i] * inv; float v = s + rb[gq * 4 + i];
      if (v > m1) { m2 = m1; i2 = i1; s2 = s1; m1 = v; i1 = gq * 4 + i; s1 = s; }
      else if (v > m2) { m2 = v; i2 = gq * 4 + i; s2 = s; }
    }
    float gs = m1 + m2;
    if (gs > best_gs) { best_gs = gs; be1 = i1; be2 = i2; bs1 = s1; bs2 = s2; }
  }
  e_out[0] = be1; e_out[1] = be2; g_out[0] = bs1 / (bs1 + bs2); g_out[1] = bs2 / (bs1 + bs2);
}
struct ScanAB2 {
  const bf16_t* P; const bf16_t* LFB; bf16_t* O;
  DEV void operator()(long gid) const {
    int j = (int)(gid & 127), h = (int)((gid >> 7) & 3), dir = (int)((gid >> 9) & 1), mixer = (int)((gid >> 10) & 1), b = (int)(gid >> 11);
    bf16_t* Od = O + (size_t)dir * NTOK * 1024;
    if (mixer == 0) {
      float S[128];
#pragma unroll
      for (int d = 0; d < 128; ++d) S[d] = 0.f;
      for (int s = 0; s < SEQ; ++s) {
        size_t t = (size_t)b * SEQ + (dir ? (SEQ - 1 - s) : s);
        const bf16_t* row = P + t * PSTRIDE;
        const bf16_t* q = row + h * 128; const bf16_t* lf = row + 512 + dir * 512 + h * 128;
        float v = bf2f(row[1536 + h * 128 + j]);
        float o = 0.f;
#pragma unroll
        for (int d = 0; d < 128; ++d) { float fd = expf(bf2f(lf[d])); S[d] = fd * S[d] + (1.0f - fd) * v; o += bf2f(q[d]) * S[d]; }
        Od[t * 1024 + h * 128 + j] = f2bf(o);
      }
    } else {
      float S[64];
#pragma unroll
      for (int d = 0; d < 64; ++d) S[d] = 0.f;
      for (int s = 0; s < SEQ; ++s) {
        size_t t = (size_t)b * SEQ + (dir ? (SEQ - 1 - s) : s);
        const bf16_t* row = P + t * PSTRIDE;
        const bf16_t* q = row + 2560 + h * 64; const bf16_t* k = row + 2816 + h * 64;
        const bf16_t* lf = LFB + t * 512 + dir * 256 + h * 64;
        float v = bf2f(row[3072 + h * 128 + j]);
        float o = 0.f;
#pragma unroll
        for (int d = 0; d < 64; ++d) { S[d] = expf(bf2f(lf[d])) * S[d] + bf2f(k[d]) * v; o += bf2f(q[d]) * S[d]; }
        Od[t * 1024 + 512 + h * 128 + j] = f2bf(o);
      }
    }
  }
};

struct PrepCD2 {
  bf16_t* P; bf16_t* QD; const float* rope; const float* conv_w; const float* conv_b;
  DEV void operator()(long gid) const {
    size_t tok = (size_t)(gid / 1280); int c = (int)(gid % 1280); int t = (int)(tok % SEQ);
    bf16_t* row = P + tok * PSTRIDE;
    if (c < 256) {
      int isk = c >> 7, hh = (c >> 5) & 3, i = c & 31;
      float cs = rope[(t * 32 + i) * 2], sn = rope[(t * 32 + i) * 2 + 1];
      bf16_t* base = row + isk * 256 + hh * 64;
      float a1 = bf2f(base[i]), a2 = bf2f(base[i + 32]);
      float sc = isk ? 1.0f : 0.125f;
      base[i] = f2bf((a1 * cs - a2 * sn) * sc); base[i + 32] = f2bf((a1 * sn + a2 * cs) * sc);
    } else {
      int cc = c - 256;
      float acc = conv_b[cc] + bf2f(row[1536 + cc]) * conv_w[1024 + cc];
      if (t > 0) acc += bf2f(row[1536 + cc - PSTRIDE]) * conv_w[cc];
      if (t < SEQ - 1) acc += bf2f(row[1536 + cc + PSTRIDE]) * conv_w[2048 + cc];
      float s = siluf_(acc);
      if (cc < 512) QD[tok * 512 + cc] = f2bf(s * 0.08838834764831845f);
      else row[3584 + (cc - 512)] = f2bf(s);
    }
  }
};

struct ScanCD2 {
  const bf16_t* P; const bf16_t* QD; const float* side; const float* fgate_b; bf16_t* O; float* oside;
  DEV void operator()(long gid) const {
    int b = (int)(gid / 2056); int g = (int)(gid % 2056);
    if (g < 1024) {
      int j = g & 127, h = (g >> 7) & 3, dir = (g >> 9) & 1;
      bf16_t* Od = O + (size_t)dir * NTOK * 1024;
      float gamma = 1.0f - exp2f(-(5.0f + 2.0f * (float)h + (float)dir));
      float S[64];
#pragma unroll
      for (int d = 0; d < 64; ++d) S[d] = 0.f;
      for (int s = 0; s < SEQ; ++s) {
        size_t t = (size_t)b * SEQ + (dir ? (SEQ - 1 - s) : s);
        const bf16_t* row = P + t * PSTRIDE;
        const bf16_t* q = row + h * 64; const bf16_t* k = row + 256 + h * 64;
        float v = bf2f(row[512 + h * 128 + j]);
        float o = 0.f;
#pragma unroll
        for (int d = 0; d < 64; ++d) { S[d] = gamma * S[d] + bf2f(k[d]) * v; o += bf2f(q[d]) * S[d]; }
        Od[t * 1024 + h * 128 + j] = f2bf(o);
      }
    } else {
      g -= 1024;
      int j = g % 129, h = (g / 129) & 3, dir = g / (129 * 4);
      bf16_t* Od = O + (size_t)dir * NTOK * 1024; float* os = oside + (size_t)dir * NTOK * 8;
      float fb = fgate_b[dir * 4 + h];
      float S[128];
#pragma unroll
      for (int d = 0; d < 128; ++d) S[d] = 0.f;
      float m = 0.f;
      for (int s = 0; s < SEQ; ++s) {
        size_t t = (size_t)b * SEQ + (dir ? (SEQ - 1 - s) : s);
        const bf16_t* row = P + t * PSTRIDE;
        const bf16_t* q = QD + t * 512 + h * 128; const bf16_t* k = row + 3584 + h * 128;
        float v = (j < 128) ? bf2f(row[2560 + h * 128 + j]) : 1.0f;
        float li = side[t * 32 + dir * 8 + h];
        float lf = logsigmoidf_(side[t * 32 + dir * 8 + 4 + h] + fb);
        float mn = fmaxf(lf + m, li);
        float fs = expf(lf + m - mn), is = expf(li - mn) * v;
        m = mn;
        float o = 0.f;
#pragma unroll
        for (int d = 0; d < 128; ++d) { S[d] = fs * S[d] + is * bf2f(k[d]); o += bf2f(q[d]) * S[d]; }
        if (j < 128) Od[t * 1024 + 512 + h * 128 + j] = f2bf(o);
        else { os[t * 8 + h * 2] = o; os[t * 8 + h * 2 + 1] = m; }
      }
    }
  }
};
#ifndef CPU_EMU
namespace pg8 {
#define PG8_LAS __attribute__((address_space(3)))
typedef short bf16x8 __attribute__((ext_vector_type(8)));
typedef float f32x4 __attribute__((ext_vector_type(4)));
typedef unsigned u32x4 __attribute__((ext_vector_type(4)));
typedef unsigned u32x2 __attribute__((ext_vector_type(2)));
constexpr int BM = 256, BK = 64, HALF = 128, HTB = HALF * BK * 2, STAGE_BYTES = 8 * HTB, NXCD = 8, WGM = 8, GK = 1024;

__device__ __forceinline__ int lds_byte(int r, int c) { const int st = (r >> 4) * 2 + (c >> 5), rr = r & 15, cc = c & 31, ob = rr * 64 + cc * 2; return st * 1024 + (ob ^ (((ob >> 9) & 1) << 5)); }
__device__ __forceinline__ void stage_rc(int b, int& R, int& C) { const int st = b / 1024, sb = b % 1024, swz = sb ^ (((sb >> 9) & 1) << 5); R = (st >> 1) * 16 + swz / 64; C = (st & 1) * 32 + (swz % 64) / 2; }
__device__ __forceinline__ int perm32(int rho) { const int n = rho >> 4, i = rho & 15; return 8 * (i >> 2) + 4 * n + (i & 3); }
__device__ __forceinline__ unsigned cvt_pk_bf16(float lo, float hi) { unsigned r; asm volatile("v_cvt_pk_bf16_f32 %0, %1, %2" : "=v"(r) : "v"(lo), "v"(hi)); return r; }

struct Unit { int pm, pn, e, row0, ne, ui; };

struct StaticOrder {
  int nM, nN, nwg, G, c;
  __device__ void init(int M, int N, int G_, int c_) { nM = M / BM; nN = N / BM; nwg = nM * nN; G = G_; c = c_; }
  __device__ bool next(int i, Unit& u) const {
    const long L = (long)i * G + c; if (L >= nwg) return false;
    int wgid = (int)L; { const int q = nwg / NXCD, r = nwg % NXCD, xcd = wgid % NXCD, off = wgid / NXCD; wgid = (xcd < r ? xcd * (q + 1) : r * (q + 1) + (xcd - r) * q) + off; }
    const int nig = WGM * nN, gid = wgid / nig, fm = gid * WGM, gsz = (nM - fm) < WGM ? (nM - fm) : WGM;
    u.pm = fm + ((wgid % nig) % gsz); u.pn = (wgid % nig) / gsz; u.e = 0; u.row0 = u.pm * BM; u.ne = 0; u.ui = i; return true;
  }
};

template <class Prob>
__device__ __forceinline__ void gemm_phase(PG8_LAS unsigned char* lds, const Prob& S, int wv) {
  int wv_ = wv; asm volatile("" : "+s"(wv_));
  int l_; asm volatile("v_mbcnt_lo_u32_b32 %0, -1, 0\n\tv_mbcnt_hi_u32_b32 %0, -1, %0" : "=v"(l_));
  int tid_ = wv_ * 64 + l_;
  const int tid = tid_, wid = __builtin_amdgcn_readfirstlane(tid >> 6), lane = tid & 63, wr = wid >> 2, wc = wid & 3, fr = lane & 15, fq = lane >> 4;
  constexpr int K = GK, nt = K / BK;
  int sR[2], sC[2]; unsigned voffB[2];
#pragma unroll
  for (int i = 0; i < 2; ++i) { int R, C; stage_rc(tid * 16 + i * 8192, R, C); sR[i] = R; sC[i] = C; const int Rb = Prob::PERM ? ((R & ~31) + perm32(R & 31)) : R; voffB[i] = (unsigned)(Rb * K + C) * 2u; }
  const size_t kstep = (size_t)(BK * 2);
  const size_t hstep = (size_t)HALF * K * 2;
  const unsigned ldsw = (unsigned)wid * 1024u;
  const int aoff = lds_byte(wr * 64 + fr, fq * 8), boff = lds_byte(wc * 32 + fr, fq * 8);
#define PG8_SA(b, h) (((b) * 2 + (h)) * HTB)
#define PG8_SB(b, h) ((4 + (b) * 2 + (h)) * HTB)
#define PG8_STAGE(bufoff, gbase, voff) do { _Pragma("unroll") for (int _i = 0; _i < 2; ++_i) \
    __builtin_amdgcn_global_load_lds((const unsigned*)((const char*)(gbase) + (voff)[_i]), (PG8_LAS unsigned*)(lds + (bufoff) + ldsw + _i * 8192), 16, 0, 0); } while (0)
#define PG8_LDA(dst, b, h) do { _Pragma("unroll") for (int m = 0; m < 4; ++m) _Pragma("unroll") for (int k = 0; k < 2; ++k) dst[m][k] = *(const PG8_LAS bf16x8*)(lds + PG8_SA(b, h) + aoff + m * 2048 + k * 1024); } while (0)
#define PG8_LDB(dst, b, h) do { _Pragma("unroll") for (int n = 0; n < 2; ++n) _Pragma("unroll") for (int k = 0; k < 2; ++k) dst[n][k] = *(const PG8_LAS bf16x8*)(lds + PG8_SB(b, h) + boff + n * 2048 + k * 1024); } while (0)
#define PG8_MMA(ai, bj, At, Bt) do { __builtin_amdgcn_s_setprio(1); _Pragma("unroll") for (int m = 0; m < 4; ++m) _Pragma("unroll") for (int n = 0; n < 2; ++n) _Pragma("unroll") for (int k = 0; k < 2; ++k) \
    acc[ai][bj][m][n] = __builtin_amdgcn_mfma_f32_16x16x32_bf16(Bt[n][k], At[m][k], acc[ai][bj][m][n], 0, 0, 0); __builtin_amdgcn_s_setprio(0); } while (0)
#define PG8_WAIT_V(n) asm volatile("s_waitcnt vmcnt(" #n ")" ::: "memory")
#define PG8_WAIT_L(n) asm volatile("s_waitcnt lgkmcnt(" #n ")" ::: "memory")
#define PG8_BAR __builtin_amdgcn_s_barrier()
#define PG8_SCHED __builtin_amdgcn_sched_barrier(0)
  Unit cur, nxt; int ui = 0;
  if (!S.next(0, cur)) return;
  f32x4 acc[2][2][4][2];
#pragma unroll
  for (int a = 0; a < 2; ++a)
#pragma unroll
    for (int b = 0; b < 2; ++b)
#pragma unroll
      for (int m = 0; m < 4; ++m)
#pragma unroll
        for (int n = 0; n < 2; ++n) acc[a][b][m][n] = (f32x4){0.f, 0.f, 0.f, 0.f};
  bf16x8 At[4][2], B0[2][2], B1[2][2];
  unsigned oc0[2], oc1[2], on0[2], on1[2];
#pragma unroll
  for (int i = 0; i < 2; ++i) { oc0[i] = S.a_off(cur, sR[i]) + (unsigned)sC[i] * 2u; oc1[i] = S.a_off(cur, HALF + sR[i]) + (unsigned)sC[i] * 2u; }
  const char* const Ab = S.a_base();
  const char* cB = S.b_base(cur);
  PG8_STAGE(PG8_SB(0, 0), cB, voffB); PG8_STAGE(PG8_SB(0, 1), cB + hstep, voffB); PG8_STAGE(PG8_SA(0, 0), Ab, oc0); PG8_STAGE(PG8_SA(0, 1), Ab, oc1);
  if (wr == 1) PG8_BAR;
  PG8_WAIT_V(2); PG8_BAR;
  PG8_STAGE(PG8_SB(1, 0), cB + kstep, voffB); PG8_STAGE(PG8_SA(1, 0), Ab + kstep, oc0); PG8_STAGE(PG8_SB(1, 1), cB + hstep + kstep, voffB);
  PG8_WAIT_V(6); PG8_BAR;
  for (;;) {
    const bool has_next = S.next(ui + 1, nxt);
    const char* nB = cB;
    if (has_next) {
      nB = S.b_base(nxt);
      int l2_; asm volatile("v_mbcnt_lo_u32_b32 %0, -1, 0\n\tv_mbcnt_hi_u32_b32 %0, -1, %0" : "=v"(l2_));
      const int tid2 = wid * 64 + l2_;
#pragma unroll
      for (int i = 0; i < 2; ++i) { int R, C; stage_rc(tid2 * 16 + i * 8192, R, C); on0[i] = S.a_off(nxt, R) + (unsigned)C * 2u; on1[i] = S.a_off(nxt, HALF + R) + (unsigned)C * 2u; }
    } else {
#pragma unroll
      for (int i = 0; i < 2; ++i) { on0[i] = oc0[i]; on1[i] = oc1[i]; }
    }
    for (int t = 0; t < nt; t += 2) {
      const bool last = (t == nt - 2);
      const char* a1 = Ab + (size_t)(t + 1) * kstep;
      const char* a2 = last ? Ab : Ab + (size_t)(t + 2) * kstep; const char* b2 = last ? nB : cB + (size_t)(t + 2) * kstep;
      const char* a3 = a2 + kstep; const char* b3 = b2 + kstep;
      unsigned o20[2], o21[2];
#pragma unroll
      for (int i = 0; i < 2; ++i) { o20[i] = last ? on0[i] : oc0[i]; o21[i] = last ? on1[i] : oc1[i]; }
      PG8_LDB(B0, 0, 0); PG8_LDB(B1, 0, 1); PG8_SCHED; PG8_LDA(At, 0, 0); PG8_STAGE(PG8_SA(1, 1), a1, oc1);
      PG8_WAIT_V(8); PG8_WAIT_L(0); PG8_BAR; PG8_MMA(0, 0, At, B0); PG8_MMA(0, 1, At, B1); PG8_BAR; PG8_SCHED;
      PG8_LDA(At, 0, 1); PG8_STAGE(PG8_SB(0, 0), b2, voffB); PG8_STAGE(PG8_SB(0, 1), b2 + hstep, voffB); PG8_STAGE(PG8_SA(0, 0), a2, o20);
      PG8_WAIT_V(8); PG8_WAIT_L(0); PG8_BAR; PG8_MMA(1, 0, At, B0); PG8_MMA(1, 1, At, B1); PG8_BAR; PG8_SCHED;
      PG8_LDB(B0, 1, 0); PG8_LDB(B1, 1, 1); PG8_SCHED; PG8_LDA(At, 1, 0); PG8_STAGE(PG8_SA(0, 1), a2, o21);
      PG8_WAIT_V(8); PG8_WAIT_L(0); PG8_BAR; PG8_MMA(0, 0, At, B0); PG8_MMA(0, 1, At, B1); PG8_BAR; PG8_SCHED;
      PG8_LDA(At, 1, 1); PG8_STAGE(PG8_SB(1, 0), b3, voffB); PG8_STAGE(PG8_SB(1, 1), b3 + hstep, voffB); PG8_STAGE(PG8_SA(1, 0), a3, o20);
      PG8_WAIT_V(8); PG8_WAIT_L(0); PG8_BAR; PG8_MMA(1, 0, At, B0); PG8_MMA(1, 1, At, B1); PG8_BAR; PG8_SCHED;
    }
    if (wr == 0) PG8_BAR;
    { int l3_; asm volatile("v_mbcnt_lo_u32_b32 %0, -1, 0\n\tv_mbcnt_hi_u32_b32 %0, -1, %0" : "=v"(l3_));
      S.epi(acc, cur, wr, wc, l3_ & 15, l3_ >> 4); }
    if (!has_next) break;
#pragma unroll
    for (int a = 0; a < 2; ++a)
#pragma unroll
      for (int b = 0; b < 2; ++b)
#pragma unroll
        for (int m = 0; m < 4; ++m)
#pragma unroll
          for (int n = 0; n < 2; ++n) acc[a][b][m][n] = (f32x4){0.f, 0.f, 0.f, 0.f};
    cur = nxt; cB = nB; ++ui;
#pragma unroll
    for (int i = 0; i < 2; ++i) { oc0[i] = on0[i]; oc1[i] = on1[i]; }
    if (wr == 1) PG8_BAR;
  }
  PG8_WAIT_V(0);
  PG8_BAR;
#undef PG8_SA
#undef PG8_SB
#undef PG8_STAGE
#undef PG8_LDA
#undef PG8_LDB
#undef PG8_MMA
#undef PG8_WAIT_V
#undef PG8_WAIT_L
#undef PG8_BAR
#undef PG8_SCHED
}
}
#endif
#ifndef CPU_EMU
#include <hip/hip_cooperative_groups.h>
namespace cg = cooperative_groups;
#define LAS __attribute__((address_space(3)))
#define NTHREADS 512
#define LDS_BYTES (154 * 1024)
typedef float f32x4 __attribute__((ext_vector_type(4)));
typedef short bf16x8 __attribute__((ext_vector_type(8)));
typedef unsigned u32x4 __attribute__((ext_vector_type(4)));
typedef unsigned u32x2 __attribute__((ext_vector_type(2)));

struct Ctx { int tid, lane, wid, G, bid; unsigned char* lds; };
__device__ __forceinline__ int lane_id() { int l; asm volatile("v_mbcnt_lo_u32_b32 %0, -1, 0\n\tv_mbcnt_hi_u32_b32 %0, -1, %0" : "=v"(l)); return l; }
__device__ __forceinline__ int opaque_tid(int wv) { int w = wv; asm volatile("" : "+s"(w)); int t = w * 64 + lane_id(); asm volatile("" : "+v"(t)); return t; }
__device__ __forceinline__ Ctx make_ctx(unsigned char* lds, int wv) { Ctx c; c.tid = opaque_tid(wv); c.lane = c.tid & 63; c.wid = __builtin_amdgcn_readfirstlane(c.tid >> 6); c.G = gridDim.x; c.bid = blockIdx.x; c.lds = lds; return c; }

__device__ __forceinline__ float wave_sum(float x) {
  x += __builtin_bit_cast(float, __builtin_amdgcn_update_dpp(0, __builtin_bit_cast(int, x), 0x111, 0xf, 0xf, false));
  x += __builtin_bit_cast(float, __builtin_amdgcn_update_dpp(0, __builtin_bit_cast(int, x), 0x112, 0xf, 0xf, false));
  x += __builtin_bit_cast(float, __builtin_amdgcn_update_dpp(0, __builtin_bit_cast(int, x), 0x114, 0xf, 0xf, false));
  x += __builtin_bit_cast(float, __builtin_amdgcn_update_dpp(0, __builtin_bit_cast(int, x), 0x118, 0xf, 0xf, false));
  x += __builtin_bit_cast(float, __builtin_amdgcn_update_dpp(0, __builtin_bit_cast(int, x), 0x142, 0xa, 0xf, false));
  x += __builtin_bit_cast(float, __builtin_amdgcn_update_dpp(0, __builtin_bit_cast(int, x), 0x143, 0xc, 0xf, false));
  return __builtin_bit_cast(float, __builtin_amdgcn_readlane(__builtin_bit_cast(int, x), 63));
}
__device__ __forceinline__ float fsigmoid(float x) { return __builtin_amdgcn_rcpf(1.0f + __builtin_amdgcn_exp2f(-1.4426950408889634f * x)); }
__device__ __forceinline__ float fsilu(float x) { return x * fsigmoid(x); }
__device__ __forceinline__ float flog2sigmoid(float x) { const float y = x * 1.4426950408889634f; return fminf(y, 0.f) - __builtin_amdgcn_logf(1.0f + __builtin_amdgcn_exp2f(-fabsf(y))); }
typedef float f32x2_t __attribute__((ext_vector_type(2)));
typedef __bf16 bf16x2_t __attribute__((ext_vector_type(2)));
__device__ __forceinline__ unsigned pk_hw(float a, float b) { const f32x2_t v = {a, b}; return __builtin_bit_cast(unsigned, __builtin_convertvector(v, bf16x2_t)); }
__device__ __forceinline__ unsigned pk2(float a, float b) { return pk_hw(a, b); }
__device__ __forceinline__ void unpack8(u32x4 w, float* f) {
  f[0] = __uint_as_float(w.x << 16); f[1] = __uint_as_float(w.x & 0xffff0000u); f[2] = __uint_as_float(w.y << 16); f[3] = __uint_as_float(w.y & 0xffff0000u);
  f[4] = __uint_as_float(w.z << 16); f[5] = __uint_as_float(w.z & 0xffff0000u); f[6] = __uint_as_float(w.w << 16); f[7] = __uint_as_float(w.w & 0xffff0000u);
}

__device__ __forceinline__ void transpose_job(const Ctx& c, const float* src, int N, bf16_t* dst, int rs, int ro, int tile0, int tile_stride) {
  float* t = (float*)c.lds;
  const int ntn = (N + 63) / 64, ntiles = ntn * 16;
  for (int tl = tile0; tl < ntiles; tl += tile_stride) {
    const int kt = tl / ntn, nt_ = tl % ntn, k0 = kt * 64, n0 = nt_ * 64;
    __syncthreads();
#pragma unroll
    for (int i = 0; i < 8; ++i) { const int idx = c.tid + i * 512, kk = idx >> 6, nn = idx & 63; t[kk * 65 + nn] = (n0 + nn < N) ? src[(size_t)(k0 + kk) * N + n0 + nn] : 0.f; }
    __syncthreads();
#pragma unroll
    for (int i = 0; i < 4; ++i) { const int idx = c.tid + i * 512, nn = idx >> 5, kp = (idx & 31) * 2;
      if (n0 + nn < N) *(unsigned*)(dst + (size_t)((n0 + nn) * rs + ro) * 1024 + k0 + kp) = pk2(t[kp * 65 + nn], t[(kp + 1) * 65 + nn]); }
  }
  __syncthreads();
}
__device__ __forceinline__ void p0_prologue(unsigned char* lds_, int wv, const Params& p) {
  const Ctx c = make_ctx(lds_, wv);
  unsigned char* ws = p.ws;
  if (c.bid == 0) { ((unsigned*)(ws + WS_CTL))[64 + c.tid] = 0u; }
  if (c.bid == 0) { for (int i = c.tid; i < 3456; i += NTHREADS) ((unsigned*)(ws + WS_CTL))[2048 + i] = 0u; }
  { const float* x = p.in[I_X]; bf16_t* hb = (bf16_t*)(ws + WS_HB);
    for (size_t i = (size_t)c.bid * NTHREADS + c.tid; i < (size_t)NTOK * 1024 / 8; i += (size_t)c.G * NTHREADS) {
      const f32x4 a = *(const f32x4*)(x + i * 8), b = *(const f32x4*)(x + i * 8 + 4);
      u32x4 w; w.x = pk2(a[0], a[1]); w.y = pk2(a[2], a[3]); w.z = pk2(b[0], b[1]); w.w = pk2(b[2], b[3]);
      *(u32x4*)(hb + i * 8) = w; } }
  transpose_job(c, p.in[I_AB_W_IN], P_AB, (bf16_t*)(ws + WS_WIN_AB), 1, 0, c.bid, c.G);
  transpose_job(c, p.in[I_CD_W_IN], P_CD, (bf16_t*)(ws + WS_WIN_CD), 1, 0, c.bid, c.G);
  transpose_job(c, p.in[I_AB_W_OUT], 1024, (bf16_t*)(ws + WS_WOUT_AB), 1, 0, c.bid, c.G);
  transpose_job(c, p.in[I_CD_W_OUT], 1024, (bf16_t*)(ws + WS_WOUT_CD), 1, 0, c.bid, c.G);
  { float* rope = (float*)(ws + WS_ROPE);
    for (int i = c.bid * NTHREADS + c.tid; i < SEQ * 32; i += c.G * NTHREADS) { const int t = i >> 5, f = i & 31;
      const float freq = powf(10000.0f, -(float)f / 32.0f); const float ang = (float)t * freq; rope[i * 2] = cosf(ang); rope[i * 2 + 1] = sinf(ang); }
    if (c.bid == 1) { const float* hl = p.in[I_HGRN_LB]; float* lb = (float*)(ws + WS_LB);
      const int cc = c.tid; const float a0 = hl[cc], a1 = hl[512 + cc], a2 = hl[1024 + cc]; const float mx = fmaxf(a0, fmaxf(a1, a2));
      const float e0 = expf(a0 - mx), e1 = expf(a1 - mx), e2 = expf(a2 - mx); lb[cc] = e0 / (e0 + e1 + e2); } }
}
__device__ __forceinline__ void moe_weight_convert(unsigned char* lds_, int wv, const Params& p, int layer) {
  const Ctx c = make_ctx(lds_, wv);
  bf16_t* w13 = (bf16_t*)(p.ws + WS_WMOE); bf16_t* w2 = w13 + (size_t)NEXP * 2048 * 1024;
  const size_t lo = (size_t)layer * NEXP * 1024 * 1024;
  const float* W1 = p.in[I_MOE_W1] + lo; const float* W3 = p.in[I_MOE_W3] + lo; const float* W2 = p.in[I_MOE_W2] + lo;
  float* t = (float*)c.lds;
  constexpr int NT = 48 * 128;
  const int lk = c.tid >> 5, ln4 = (c.tid & 31) * 4;
  const int sn = c.tid & 127, sk = (c.tid >> 7) * 8;
  f32x4 r[4];
#define MW_SRC(g_) ((((g_) >> 7) % 3 == 0 ? W1 : (((g_) >> 7) % 3 == 1 ? W3 : W2)) + (size_t)(((g_) >> 7) / 3) * 1048576 + (size_t)((((g_) & 127) >> 3) * 64) * 1024 + ((g_) & 7) * 128)
#define MW_LOAD(g_) do { const float* s_ = MW_SRC(g_); _Pragma("unroll") for (int i = 0; i < 4; ++i) r[i] = *(const f32x4*)(s_ + (size_t)(lk + 16 * i) * 1024 + ln4); } while (0)
  int g0 = c.bid;
  if (g0 < NT) MW_LOAD(g0);
  for (; g0 < NT; g0 += c.G) {
    __syncthreads();
#pragma unroll
    for (int i = 0; i < 4; ++i) { float* d = t + (lk + 16 * i) * 129 + ln4; d[0] = r[i][0]; d[1] = r[i][1]; d[2] = r[i][2]; d[3] = r[i][3]; }
    __syncthreads();
    const int gn = g0 + c.G;
    if (gn < NT) MW_LOAD(gn);
    const int m = g0 >> 7, e = m / 3, which = m % 3, k0 = ((g0 & 127) >> 3) * 64, n0 = (g0 & 7) * 128;
    bf16_t* drow = (which == 2) ? w2 + ((size_t)e * 1024 + n0 + sn) * 1024 : w13 + ((size_t)e * 2048 + 2 * (n0 + sn) + which) * 1024;
#pragma unroll
    for (int j = 0; j < 2; ++j) { const int kk = sk + 32 * j; const float* s = t + kk * 129 + sn;
      u32x4 w; w.x = pk2(s[0], s[129]); w.y = pk2(s[2 * 129], s[3 * 129]); w.z = pk2(s[4 * 129], s[5 * 129]); w.w = pk2(s[6 * 129], s[7 * 129]);
      *(u32x4*)(drow + k0 + kk) = w; }
  }
#undef MW_SRC
#undef MW_LOAD
  __syncthreads();
}

struct ProbInProj {
  static constexpr bool PERM = true;
  pg8::StaticOrder so; const char* A; const char* Bt; bf16_t* P; const float* bias; const float* lb; int layer;
  __device__ __forceinline__ bool next(int i, pg8::Unit& u) const { return so.next(i, u); }
  __device__ __forceinline__ const char* a_base() const { return A; }
  __device__ __forceinline__ unsigned a_off(const pg8::Unit& u, int r) const { return (unsigned)(u.pm * 256 + r) * 2048u; }
  __device__ __forceinline__ const char* b_base(const pg8::Unit& u) const { return Bt + (size_t)u.pn * 256 * 2048; }
  __device__ __forceinline__ void epi(const f32x4 (&acc)[2][2][4][2], const pg8::Unit& u, int wr, int wc, int fr, int fq) const {
    const int row0 = u.row0 + wr * 64 + fr, colb = u.pn * 256 + wc * 32 + 8 * fq;
    int mode = 0;
    if (layer == 0) { mode = u.pn < 2 ? 1 : (u.pn < 6 ? 2 : (u.pn == 10 ? 3 : 0)); }
#pragma unroll
    for (int bj = 0; bj < 2; ++bj) {
      const int col0 = colb + bj * 128;
      const f32x4 b0 = *(const f32x4*)(bias + col0), b1 = *(const f32x4*)(bias + col0 + 4);
      f32x4 l0 = (f32x4){0.f, 0.f, 0.f, 0.f}, l1 = l0;
      if (mode == 2) { l0 = *(const f32x4*)(lb + ((col0 - 512) & 511)); l1 = *(const f32x4*)(lb + ((col0 - 512) & 511) + 4); }
#pragma unroll
      for (int ai = 0; ai < 2; ++ai)
#pragma unroll
        for (int m = 0; m < 4; ++m) {
          f32x4 v0 = acc[ai][bj][m][0] + b0, v1 = acc[ai][bj][m][1] + b1;
          if (mode == 1) {
#pragma unroll
            for (int j = 0; j < 4; ++j) { v0[j] = fsilu(v0[j]); v1[j] = fsilu(v1[j]); }
          } else if (mode == 2) {
#pragma unroll
            for (int j = 0; j < 4; ++j) { v0[j] = __builtin_amdgcn_logf(l0[j] + (1.0f - l0[j]) * fsigmoid(v0[j])); v1[j] = __builtin_amdgcn_logf(l1[j] + (1.0f - l1[j]) * fsigmoid(v1[j])); }
          } else if (mode == 3) { v0 *= 0.125f; v1 *= 0.125f; }
          u32x4 w; w.x = pk2(v0[0], v0[1]); w.y = pk2(v0[2], v0[3]); w.z = pk2(v1[0], v1[1]); w.w = pk2(v1[2], v1[3]);
          *(u32x4*)(P + PIDX(row0 + ai * 128 + m * 16, col0)) = w;
        }
    }
  }
};
struct ProbOutProj {
  static constexpr bool PERM = false;
  pg8::StaticOrder so; const char* A; const char* Bt; float* Y; const float* Hres;
  __device__ __forceinline__ bool next(int i, pg8::Unit& u) const { return so.next(i, u); }
  __device__ __forceinline__ const char* a_base() const { return A; }
  __device__ __forceinline__ unsigned a_off(const pg8::Unit& u, int r) const { return (unsigned)(u.pm * 256 + r) * 2048u; }
  __device__ __forceinline__ const char* b_base(const pg8::Unit& u) const { return Bt + (size_t)u.pn * 256 * 2048; }
  __device__ __forceinline__ void epi(const f32x4 (&acc)[2][2][4][2], const pg8::Unit& u, int wr, int wc, int fr, int fq) const {
    const int row0 = u.row0 + wr * 64 + fr, col0 = u.pn * 256 + wc * 32 + 4 * fq;
#pragma unroll
    for (int ai = 0; ai < 2; ++ai)
#pragma unroll
      for (int m = 0; m < 4; ++m) { const size_t ro = (size_t)(row0 + ai * 128 + m * 16) * 1024 + col0; float* rowp = Y + ro; const float* hp = Hres + ro;
#pragma unroll
        for (int bj = 0; bj < 2; ++bj)
#pragma unroll
          for (int n = 0; n < 2; ++n) *(f32x4*)(rowp + bj * 128 + n * 16) = acc[ai][bj][m][n] + ALPHA_F * *(const f32x4*)(hp + bj * 128 + n * 16); }
  }
};
#define MOE_TAB_OFF (128 * 1024)
struct MoeOrder {
  const int* tab;
  __device__ __forceinline__ void init(const int* cnt, int ntn, int G, int c, unsigned char* lds, int wv) {
    int* t = (int*)(lds + MOE_TAB_OFF);
    const int tid = opaque_tid(wv);
    if (tid < 64) {
      int L = tid * G + c, pad = 0, found = 0, ue = 0, upn = 0, upm = 0, urow = 0, une = 0;
      for (int e = 0; e < NEXP; ++e) { const int n = cnt[e * 16], mt = (n + 255) >> 8, tiles = mt * ntn;
        if (!found && L < tiles) { ue = e; upn = L / mt; upm = L % mt; urow = pad + upm * 256; une = n; found = 1; }
        if (!found) { L -= tiles; pad += mt * 256; } }
      t[tid * 8 + 0] = found; t[tid * 8 + 1] = ue; t[tid * 8 + 2] = upn; t[tid * 8 + 3] = upm; t[tid * 8 + 4] = urow; t[tid * 8 + 5] = une;
    }
    __syncthreads();
    tab = t;
  }
  __device__ __forceinline__ bool next(int i, pg8::Unit& u) const {
    if (i >= 64) return false;
    const int* t = tab + i * 8;
    if (!__builtin_amdgcn_readfirstlane(t[0])) return false;
    u.e = __builtin_amdgcn_readfirstlane(t[1]); u.pn = __builtin_amdgcn_readfirstlane(t[2]); u.pm = __builtin_amdgcn_readfirstlane(t[3]);
    u.row0 = __builtin_amdgcn_readfirstlane(t[4]); u.ne = __builtin_amdgcn_readfirstlane(t[5]); u.ui = i; return true;
  }
};
struct ProbMoe1 {
  static constexpr bool PERM = true;
  MoeOrder mo; const char* A; const char* W13; const int* list; bf16_t* H; const int* ltok;
  __device__ __forceinline__ void stage_tokens(unsigned char* lds, int wv) {
    int* lt = (int*)(lds + MOE_TAB_OFF + 2048);
    const int tid = opaque_tid(wv);
    pg8::Unit u;
    for (int i = 0; i < 16 && mo.next(i, u); ++i) { if (tid < 256) { const int rr = u.pm * 256 + tid; lt[i * 256 + tid] = rr < u.ne ? list[u.e * NTOK + rr] : 0; } }
    __syncthreads();
    ltok = lt;
  }
  __device__ __forceinline__ bool next(int i, pg8::Unit& u) const { return mo.next(i, u); }
  __device__ __forceinline__ const char* a_base() const { return A; }
  __device__ __forceinline__ unsigned a_off(const pg8::Unit& u, int r) const { const int rr = u.pm * 256 + r; const int tok = rr < u.ne ? list[u.e * NTOK + rr] : 0; return (unsigned)tok * 2048u; }
  __device__ __forceinline__ const char* b_base(const pg8::Unit& u) const { return W13 + ((size_t)u.e * 2048 + (size_t)u.pn * 256) * 2048; }
  __device__ __forceinline__ void epi(const f32x4 (&acc)[2][2][4][2], const pg8::Unit& u, int wr, int wc, int fr, int fq) const {
    const int row0 = u.row0 + wr * 64 + fr, colb = u.pn * 128 + wc * 16 + 4 * fq;
#pragma unroll
    for (int ai = 0; ai < 2; ++ai)
#pragma unroll
      for (int m = 0; m < 4; ++m)
#pragma unroll
        for (int bj = 0; bj < 2; ++bj) {
          const f32x4 v0 = acc[ai][bj][m][0], v1 = acc[ai][bj][m][1];
          u32x2 w; w.x = pk2(fsilu(v0[0]) * v0[1], fsilu(v0[2]) * v0[3]); w.y = pk2(fsilu(v1[0]) * v1[1], fsilu(v1[2]) * v1[3]);
          *(u32x2*)(H + (size_t)(row0 + ai * 128 + m * 16) * 1024 + colb + bj * 64) = w;
        }
  }
};
struct ProbMoe2 {
  static constexpr bool PERM = true;
  MoeOrder mo; const char* A; const char* W2; bf16_t* Y;
  __device__ __forceinline__ bool next(int i, pg8::Unit& u) const { return mo.next(i, u); }
  __device__ __forceinline__ const char* a_base() const { return A; }
  __device__ __forceinline__ unsigned a_off(const pg8::Unit& u, int r) const { return (unsigned)(u.row0 + r) * 2048u; }
  __device__ __forceinline__ const char* b_base(const pg8::Unit& u) const { return W2 + ((size_t)u.e * 1024 + (size_t)u.pn * 256) * 2048; }
  __device__ __forceinline__ void epi(const f32x4 (&acc)[2][2][4][2], const pg8::Unit& u, int wr, int wc, int fr, int fq) const {
    const int row0 = u.row0 + wr * 64 + fr, colb = u.pn * 256 + wc * 32 + 8 * fq;
#pragma unroll
    for (int ai = 0; ai < 2; ++ai)
#pragma unroll
      for (int m = 0; m < 4; ++m)
#pragma unroll
        for (int bj = 0; bj < 2; ++bj) {
          const f32x4 v0 = acc[ai][bj][m][0], v1 = acc[ai][bj][m][1];
          u32x4 w; w.x = pk2(v0[0], v0[1]); w.y = pk2(v0[2], v0[3]); w.z = pk2(v1[0], v1[1]); w.w = pk2(v1[2], v1[3]);
          *(u32x4*)(Y + (size_t)(row0 + ai * 128 + m * 16) * 1024 + colb + bj * 128) = w;
        }
  }
};

template <int NS>
__device__ __forceinline__ void side_phase(unsigned char* lds_, int wv, const Params& p, int layer) {
  const Ctx c = make_ctx(lds_, wv);
  const bf16_t* hb = (const bf16_t*)(p.ws + WS_HB);
  const bf16_t* wt = (const bf16_t*)(p.ws + (layer == 0 ? WS_WIN_AB : WS_WIN_CD)) + (size_t)(layer == 0 ? PM_AB : PM_CD) * 1024;
  const float* bias = p.in[layer == 0 ? I_AB_B_IN : I_CD_B_IN] + (layer == 0 ? PM_AB : PM_CD);
  float* side = (float*)(p.ws + WS_SIDE);
  float* tl = (float*)c.lds + c.wid * (16 * 33);
  const int fr = c.lane & 15, fq = c.lane >> 4;
  for (int g = c.bid * 8 + c.wid; g < NTOK / 16; g += c.G * 8) {
    const int r0 = g * 16;
    f32x4 acc0 = (f32x4){0.f, 0.f, 0.f, 0.f}, acc1 = acc0;
    const bf16_t* ap = hb + (size_t)(r0 + fr) * 1024 + fq * 8;
    const bf16_t* bp0 = wt + (size_t)fr * 1024 + fq * 8; const bf16_t* bp1 = bp0 + 16 * 1024;
#pragma unroll 4
    for (int k = 0; k < 1024; k += 32) {
      const bf16x8 a = *(const bf16x8*)(ap + k), b0 = *(const bf16x8*)(bp0 + k);
      acc0 = __builtin_amdgcn_mfma_f32_16x16x32_bf16(a, b0, acc0, 0, 0, 0);
      if (NS == 32) { const bf16x8 b1 = *(const bf16x8*)(bp1 + k); acc1 = __builtin_amdgcn_mfma_f32_16x16x32_bf16(a, b1, acc1, 0, 0, 0); }
    }
    float gsc = 1.f, gfb = 0.f; bool gls = false;
    if (NS == 16) { gsc = 1.4426950408889634f; gls = (fr & 4) != 0; gfb = gls ? p.in[I_FGATE_B][(fr >> 3) * 4 + (fr & 3)] : 0.f; }
#pragma unroll
    for (int j = 0; j < 4; ++j) { float v0 = acc0[j] + bias[fr]; if (NS == 16) v0 = gls ? flog2sigmoid(v0 + gfb) : v0 * gsc; side[(size_t)(r0 + fq * 4 + j) * 32 + fr] = v0; tl[(fq * 4 + j) * 33 + fr] = v0;
      if (NS == 32) { const float v1 = acc1[j] + bias[16 + fr]; side[(size_t)(r0 + fq * 4 + j) * 32 + 16 + fr] = v1; tl[(fq * 4 + j) * 33 + 16 + fr] = v1; } }
    if (NS == 32) {
      __builtin_amdgcn_s_waitcnt(0xC07F);
      const float* gu = p.in[I_GK_UP]; const float* gb = p.in[I_GK_B]; bf16_t* lfb = (bf16_t*)(p.ws + WS_LFB);
      const int cb = c.lane * 8, dir = cb >> 8, cc = cb & 255;
      float w[16][8];
#pragma unroll
      for (int r = 0; r < 16; ++r)
#pragma unroll
        for (int j = 0; j < 8; ++j) w[r][j] = gu[(dir * 16 + r) * 256 + cc + j];
      float bb[8];
#pragma unroll
      for (int j = 0; j < 8; ++j) bb[j] = gb[dir * 256 + cc + j];
      for (int row = 0; row < 16; ++row) {
        float z[8];
#pragma unroll
        for (int j = 0; j < 8; ++j) z[j] = bb[j];
#pragma unroll
        for (int r = 0; r < 16; ++r) { const float s = tl[row * 33 + dir * 16 + r];
#pragma unroll
          for (int j = 0; j < 8; ++j) z[j] += s * w[r][j]; }
        u32x4 o; o.x = pk2(flog2sigmoid(z[0]) * 0.0625f, flog2sigmoid(z[1]) * 0.0625f); o.y = pk2(flog2sigmoid(z[2]) * 0.0625f, flog2sigmoid(z[3]) * 0.0625f);
        o.z = pk2(flog2sigmoid(z[4]) * 0.0625f, flog2sigmoid(z[5]) * 0.0625f); o.w = pk2(flog2sigmoid(z[6]) * 0.0625f, flog2sigmoid(z[7]) * 0.0625f);
        *(u32x4*)(lfb + PIDX(r0 + row, cb)) = o;
      }
    }
  }
}

__device__ __forceinline__ void headnorm_phase(unsigned char* lds_, int wv, const Params& p, int layer) {
  const Ctx c = make_ctx(lds_, wv);
  const bf16_t* P = (const bf16_t*)(p.ws + WS_R1); const bf16_t* O = (const bf16_t*)(p.ws + WS_R2);
  bf16_t* mixed = (bf16_t*)(p.ws + WS_HB);
  const int c0 = c.lane * 16, h8 = c.lane >> 3;
  const float* gain = layer == 0 ? (h8 < 4 ? p.in[I_HGRN_NORM] + c0 : p.in[I_GLA_NORM] + c0 - 512) : (h8 < 4 ? p.in[I_RET_NORM] + c0 : p.in[I_MLSTM_NORM] + c0 - 512);
  const int gcol = layer == 0 ? (h8 < 4 ? 2048 + c0 : 3584 + c0 - 512) : (h8 < 4 ? 1024 + c0 : 3072 + c0 - 512);
  float gn[16];
#pragma unroll
  for (int j = 0; j < 16; ++j) gn[j] = gain[j];
  for (int tok = c.bid * 8 + c.wid; tok < NTOK; tok += c.G * 8) {
    float of[16], ob[16], gt[16];
    { const u32x4* a = (const u32x4*)(O + PIDX(tok, c0)); unpack8(a[0], of); unpack8(a[1], of + 8);
      const u32x4* b = (const u32x4*)(O + (size_t)NTOK * 1024 + PIDX(tok, c0)); unpack8(b[0], ob); unpack8(b[1], ob + 8);
      const u32x4* g = (const u32x4*)(P + PIDX(tok, gcol)); unpack8(g[0], gt); unpack8(g[1], gt + 8); }
    const float sf = 1.f, sb = 1.f;
    float o[16]; float ss = 0.f;
#pragma unroll
    for (int j = 0; j < 16; ++j) { o[j] = of[j] * sf + ob[j] * sb; ss += o[j] * o[j]; }
    ss += __shfl_xor(ss, 1); ss += __shfl_xor(ss, 2); ss += __shfl_xor(ss, 4);
    const float r = 1.0f / sqrtf(ss * (1.0f / 128.0f) + NORM_EPS_F);
    unsigned w[8];
#pragma unroll
    for (int j = 0; j < 8; ++j) {
      float g0 = gt[2 * j], g1 = gt[2 * j + 1];
      if (layer == 1 && h8 >= 4) { g0 = fsigmoid(g0); g1 = fsigmoid(g1); } else { g0 = fsilu(g0); g1 = fsilu(g1); }
      w[j] = pk2(o[2 * j] * r * gn[2 * j] * g0, o[2 * j + 1] * r * gn[2 * j + 1] * g1);
    }
    u32x4* d = (u32x4*)(mixed + (size_t)tok * 1024 + c0);
    d[0] = (u32x4){w[0], w[1], w[2], w[3]}; d[1] = (u32x4){w[4], w[5], w[6], w[7]};
  }
}

__device__ __forceinline__ void ln_phase(unsigned char* lds_, int wv, const Params& p, int layer, int mode, int dry = 0) {
  const Ctx c = make_ctx(lds_, wv);
  unsigned char* ws = p.ws;
  const float* hin = (mode == 0 && layer == 0) ? p.in[I_X] : p.out;
  float* hout = dry ? (float*)(ws + WS_H) : p.out; bf16_t* hb = (bf16_t*)(ws + WS_HB);
  const float* g = p.in[mode == 0 ? I_LN_MIX_G : I_LN_FFN_G] + layer * 1024; const float* b = p.in[mode == 0 ? I_LN_MIX_B : I_LN_FFN_B] + layer * 1024;
  unsigned* cnt = (unsigned*)(ws + WS_CTL) + CW_CNT(layer);
  int* list = (int*)(ws + WS_LIST) + (size_t)layer * NEXP * NTOK;
  int* assign = (int*)(ws + WS_ASSIGN); float* gate = (float*)(ws + WS_GATE);
  float* rwT = (float*)c.lds;
  int* lcnt = (int*)(c.lds + 65536); int* lbase = lcnt + 16; int* rec = lcnt + 32; float* recg = (float*)(rec + 4 * 2048);
  int pad[NEXP];
  if (mode == 0) { const float* r = p.in[I_ROUTER_W];
    for (int i = c.tid; i < 1024 * 16; i += NTHREADS) rwT[(i & 15) * 1024 + (i >> 4)] = r[i];
    if (c.tid < 16) lcnt[c.tid] = 0;
    __syncthreads(); }
  else { int acc = 0;
#pragma unroll
    for (int e = 0; e < NEXP; ++e) { pad[e] = acc; acc += (((int)cnt[e * 16] + 255) >> 8) << 8; } }
  const int c0 = c.lane * 4;
  float gv[16], bv[16];
#pragma unroll
  for (int q = 0; q < 4; ++q) { const f32x4 t0 = *(const f32x4*)(g + q * 256 + c0), t1 = *(const f32x4*)(b + q * 256 + c0);
#pragma unroll
    for (int j = 0; j < 4; ++j) { gv[4 * q + j] = t0[j]; bv[4 * q + j] = t1[j]; } }
  const int tstride = c.G * 8;
  int it = 0;
  for (int tok0 = c.bid * 8 + c.wid; tok0 < NTOK; tok0 += 2 * tstride, it += 2) {
    float v[2][16];
    float gy0[2], gy1[2];
#pragma unroll
    for (int u = 0; u < 2; ++u) {
      const int tok = tok0 + u * tstride;
      if (tok < NTOK) {
        if (mode == 0) {
#pragma unroll
          for (int q = 0; q < 4; ++q) { const f32x4 t = *(const f32x4*)((const float*)(ws + WS_R2) + (size_t)tok * 1024 + q * 256 + c0); v[u][4 * q] = t[0]; v[u][4 * q + 1] = t[1]; v[u][4 * q + 2] = t[2]; v[u][4 * q + 3] = t[3]; }
        } else {
#pragma unroll
          for (int q = 0; q < 4; ++q) { const f32x4 t = *(const f32x4*)(hin + (size_t)tok * 1024 + q * 256 + c0); v[u][4 * q] = ALPHA_F * t[0]; v[u][4 * q + 1] = ALPHA_F * t[1]; v[u][4 * q + 2] = ALPHA_F * t[2]; v[u][4 * q + 3] = ALPHA_F * t[3]; }
          const int a0 = assign[tok * 4], a1 = assign[tok * 4 + 1], a2 = assign[tok * 4 + 2], a3 = assign[tok * 4 + 3];
          gy0[u] = gate[tok * 2]; gy1[u] = gate[tok * 2 + 1];
          int p0 = 0, p1 = 0;
#pragma unroll
          for (int e = 0; e < NEXP; ++e) { if (e == a0) p0 = pad[e]; if (e == a2) p1 = pad[e]; }
          p0 += a1; p1 += a3;
          const bf16_t* Y = (const bf16_t*)(ws + WS_R2);
#pragma unroll
          for (int q = 0; q < 4; ++q) { const u32x2 y0 = *(const u32x2*)(Y + (size_t)p0 * 1024 + q * 256 + c0), y1 = *(const u32x2*)(Y + (size_t)p1 * 1024 + q * 256 + c0);
            v[u][4 * q] += gy0[u] * __uint_as_float(y0.x << 16) + gy1[u] * __uint_as_float(y1.x << 16); v[u][4 * q + 1] += gy0[u] * __uint_as_float(y0.x & 0xffff0000u) + gy1[u] * __uint_as_float(y1.x & 0xffff0000u);
            v[u][4 * q + 2] += gy0[u] * __uint_as_float(y0.y << 16) + gy1[u] * __uint_as_float(y1.y << 16); v[u][4 * q + 3] += gy0[u] * __uint_as_float(y0.y & 0xffff0000u) + gy1[u] * __uint_as_float(y1.y & 0xffff0000u); }
        }
      } else {
#pragma unroll
        for (int j = 0; j < 16; ++j) v[u][j] = 0.f;
      }
    }
#pragma unroll
    for (int u = 0; u < 2; ++u) {
      const int tok = tok0 + u * tstride;
      float s = 0.f;
#pragma unroll
      for (int j = 0; j < 16; ++j) s += v[u][j];
      const float mean = wave_sum(s) * (1.0f / 1024.0f);
      float qq = 0.f;
#pragma unroll
      for (int j = 0; j < 16; ++j) { v[u][j] -= mean; qq += v[u][j] * v[u][j]; }
      const float r = 1.0f / sqrtf(wave_sum(qq) * (1.0f / 1024.0f) + LN_EPS_F);
#pragma unroll
      for (int j = 0; j < 16; ++j) v[u][j] = v[u][j] * r * gv[j] + bv[j];
      if (tok < NTOK) {
#pragma unroll
        for (int q = 0; q < 4; ++q) *(f32x4*)(hout + (size_t)tok * 1024 + q * 256 + c0) = (f32x4){v[u][4 * q], v[u][4 * q + 1], v[u][4 * q + 2], v[u][4 * q + 3]};
        if (!(mode == 1 && layer == 1) && !dry) {
#pragma unroll
          for (int q = 0; q < 4; ++q) *(u32x2*)(hb + (size_t)tok * 1024 + q * 256 + c0) = (u32x2){pk2(v[u][4 * q], v[u][4 * q + 1]), pk2(v[u][4 * q + 2], v[u][4 * q + 3])}; }
      }
      if (mode == 0) {
        float lg[16];
#pragma unroll
        for (int e = 0; e < 16; ++e) { float a = 0.f;
#pragma unroll
          for (int q = 0; q < 4; ++q) { const f32x4 w = *(const f32x4*)(rwT + e * 1024 + q * 256 + c0); a += v[u][4 * q] * w[0] + v[u][4 * q + 1] * w[1] + v[u][4 * q + 2] * w[2] + v[u][4 * q + 3] * w[3]; }
          lg[e] = a; }
#pragma unroll
        for (int e = 0; e < 16; ++e) lg[e] = wave_sum(lg[e]);
        int eo[2]; float go[2];
        route_from_logits(lg, p.in[I_ROUTER_B], eo, go);
        if (c.lane == 0 && tok < NTOK && !dry) {
          const int r1 = atomicAdd(lcnt + eo[0], 1), r2 = atomicAdd(lcnt + eo[1], 1);
          const int ri = (it + u) * 8 + c.wid;
          rec[ri * 4] = eo[0]; rec[ri * 4 + 1] = r1; rec[ri * 4 + 2] = eo[1]; rec[ri * 4 + 3] = r2; recg[ri * 2] = go[0]; recg[ri * 2 + 1] = go[1];
        }
      }
    }
  }
  if (mode == 0 && !dry) {
    __syncthreads();
    if (c.tid < 16) lbase[c.tid] = (int)atomicAdd(cnt + c.tid * 16, (unsigned)lcnt[c.tid]);
    __syncthreads();
    const int nrec = ((NTOK + c.G * 8 - 1) / (c.G * 8)) * 8;
    for (int ri = c.tid; ri < nrec; ri += NTHREADS) {
      const int tok = c.bid * 8 + (ri & 7) + (ri >> 3) * c.G * 8;
      if (tok < NTOK) {
        const int e1 = rec[ri * 4], e2 = rec[ri * 4 + 2]; const int r1 = rec[ri * 4 + 1] + lbase[e1], r2 = rec[ri * 4 + 3] + lbase[e2];
        list[e1 * NTOK + r1] = tok; list[e2 * NTOK + r2] = tok;
        assign[tok * 4] = e1; assign[tok * 4 + 1] = r1; assign[tok * 4 + 2] = e2; assign[tok * 4 + 3] = r2;
        gate[tok * 2] = recg[ri * 2]; gate[tok * 2 + 1] = recg[ri * 2 + 1];
      }
    }
  }
  __syncthreads();
}
#endif
#ifndef CPU_EMU
namespace scan {
typedef short bf16x8 __attribute__((ext_vector_type(8)));
typedef float f32x4 __attribute__((ext_vector_type(4)));
typedef unsigned u32x4 __attribute__((ext_vector_type(4)));
typedef unsigned u32x2 __attribute__((ext_vector_type(2)));
enum { MIX_A = 0, MIX_B = 1, MIX_C = 2, MIX_D = 3 };
constexpr int LD_T = 144;
constexpr int OFF_QS = 0, OFF_KS = 17408, OFF_QI = 34816, OFF_KT = 52224, OFF_VT = 70656, OFF_SC = 77568, OFF_ST = 86784, OFF_DEC = 99840, OFF_EM = 100352, OFF_DEN = 100608, OFF_CW = 100864, SCAN_LDS = 104960;

__device__ __forceinline__ float incl_scan_add(float x) {
  x += __builtin_bit_cast(float, __builtin_amdgcn_update_dpp(0, __builtin_bit_cast(int, x), 0x111, 0xf, 0xf, false));
  x += __builtin_bit_cast(float, __builtin_amdgcn_update_dpp(0, __builtin_bit_cast(int, x), 0x112, 0xf, 0xf, false));
  x += __builtin_bit_cast(float, __builtin_amdgcn_update_dpp(0, __builtin_bit_cast(int, x), 0x114, 0xf, 0xf, false));
  x += __builtin_bit_cast(float, __builtin_amdgcn_update_dpp(0, __builtin_bit_cast(int, x), 0x118, 0xf, 0xf, false));
  x += __builtin_bit_cast(float, __builtin_amdgcn_update_dpp(0, __builtin_bit_cast(int, x), 0x142, 0xa, 0xf, false));
  x += __builtin_bit_cast(float, __builtin_amdgcn_update_dpp(0, __builtin_bit_cast(int, x), 0x143, 0xc, 0xf, false));
  return x;
}
__device__ __forceinline__ float incl_scan_max(float x) {
  const int ninf = (int)0xff800000u;
  x = fmaxf(x, __builtin_bit_cast(float, __builtin_amdgcn_update_dpp(ninf, __builtin_bit_cast(int, x), 0x111, 0xf, 0xf, false)));
  x = fmaxf(x, __builtin_bit_cast(float, __builtin_amdgcn_update_dpp(ninf, __builtin_bit_cast(int, x), 0x112, 0xf, 0xf, false)));
  x = fmaxf(x, __builtin_bit_cast(float, __builtin_amdgcn_update_dpp(ninf, __builtin_bit_cast(int, x), 0x114, 0xf, 0xf, false)));
  x = fmaxf(x, __builtin_bit_cast(float, __builtin_amdgcn_update_dpp(ninf, __builtin_bit_cast(int, x), 0x118, 0xf, 0xf, false)));
  x = fmaxf(x, __builtin_bit_cast(float, __builtin_amdgcn_update_dpp(ninf, __builtin_bit_cast(int, x), 0x142, 0xa, 0xf, false)));
  x = fmaxf(x, __builtin_bit_cast(float, __builtin_amdgcn_update_dpp(ninf, __builtin_bit_cast(int, x), 0x143, 0xc, 0xf, false)));
  return x;
}
__device__ __forceinline__ float rdlane(float x, int l) { return __builtin_bit_cast(float, __builtin_amdgcn_readlane(__builtin_bit_cast(int, x), l)); }
__device__ __forceinline__ bf16x8 ldfrag(const unsigned char* base, int ld, int row, int kbyte) { return *(const bf16x8*)(base + row * ld + kbyte); }
__device__ __forceinline__ unsigned pk(float a, float b) { return pk_hw(a, b); }
__device__ __forceinline__ float lo16(unsigned w) { return __uint_as_float(w << 16); }
__device__ __forceinline__ float hi16(unsigned w) { return __uint_as_float(w & 0xffff0000u); }

__device__ __forceinline__ void lds_barrier() { asm volatile("s_waitcnt lgkmcnt(0)" ::: "memory"); __builtin_amdgcn_s_barrier(); asm volatile("" ::: "memory"); }
struct Raw { u32x4 a0, a1, b0, b1; f32x4 r0, r1; u32x2 v; float s0, s1; };

template <int MIXER>
__device__ __forceinline__ void scan_item(unsigned char* lds, int wv, const Params& p, int b, int h, int dir, int vs) {
  constexpr int DK = (MIXER == MIX_A || MIXER == MIX_D) ? 128 : 64;
  constexpr int NC = DK / 8;
  constexpr int LD_D = DK * 2 + 16;
  constexpr int NVT = MIXER == MIX_D ? 3 : 2;
  constexpr int NKD = DK / 32;
  const int tid = opaque_tid(wv), lane0 = tid & 63, wid = __builtin_amdgcn_readfirstlane(tid >> 6);
  unsigned char* ws = p.ws;
  const bf16_t* P = (const bf16_t*)(ws + WS_R1);
  const bf16_t* LFBp = (const bf16_t*)(ws + WS_LFB);
  const float* side = (const float*)(ws + WS_SIDE);
  const float* rope = (const float*)(ws + WS_ROPE);
  bf16_t* O = (bf16_t*)(ws + WS_R2) + (size_t)dir * NTOK * 1024;
  unsigned char* QS = lds + OFF_QS; unsigned char* KS = lds + OFF_KS; unsigned char* QI = lds + OFF_QI; unsigned char* KT = lds + OFF_KT;
  unsigned char* VT = lds + OFF_VT; unsigned char* SC = lds + OFF_SC; unsigned char* ST = lds + OFF_ST;
  float* DEC = (float*)(lds + OFF_DEC); float* EM = (float*)(lds + OFF_EM); float* DEN = (float*)(lds + OFF_DEN);

  int qcol, kcol, lfcol, vcol, ocol;
  if (MIXER == MIX_A) { qcol = h * 128; kcol = 0; lfcol = 512 + dir * 512 + h * 128; vcol = 1536 + h * 128 + vs * 32; ocol = h * 128 + vs * 32; }
  else if (MIXER == MIX_B) { qcol = 2560 + h * 64; kcol = 2816 + h * 64; lfcol = dir * 256 + h * 64; vcol = 3072 + h * 128 + vs * 32; ocol = 512 + h * 128 + vs * 32; }
  else if (MIXER == MIX_C) { qcol = h * 64; kcol = 256 + h * 64; lfcol = 0; vcol = 512 + h * 128 + vs * 32; ocol = h * 128 + vs * 32; }
  else { qcol = h * 128  ; kcol = 3584 + h * 128  ; lfcol = 0; vcol = 2560 + h * 128 + vs * 32; ocol = 512 + h * 128 + vs * 32; }
  const int c0 = (MIXER == MIX_C) ? wid * 4 : wid * NC;
  const float lgam = (MIXER == MIX_C) ? log1pf(-exp2f(-(5.0f + 2.0f * (float)h + (float)dir))) : 0.f;
  const float fgb = (MIXER == MIX_D) ? p.in[I_FGATE_B][dir * 4 + h] : 0.f;
  for (int i = tid; i < 48 * LD_D / 4; i += NTHREADS) ((unsigned*)ST)[i] = 0u;
  if (MIXER == MIX_D) {
    for (int i = tid; i < 16 * 64; i += NTHREADS) { const int r = 32 + (i >> 6), j = i & 63; *(bf16_t*)(VT + r * LD_T + j * 2) = (r == 32) ? (bf16_t)0x3F80 : (bf16_t)0; }
  }
  f32x4 sacc[NVT == 3 ? 3 : 2];
#pragma unroll
  for (int i = 0; i < (NVT == 3 ? 3 : 2); ++i) sacc[i] = (f32x4){0.f, 0.f, 0.f, 0.f};
  float m_st = 0.f;
  const size_t tokbase = (size_t)b * SEQ;
  const int sgn = dir ? -1 : 1;
  __syncthreads();

  Raw R;
#define SCAN_LOAD(n_) do { \
    int ln_ = lane0; asm volatile("" : "+v"(ln_)); \
    const int t_ = dir ? (SEQ - 1 - ((n_) * 64 + ln_)) : ((n_) * 64 + ln_); \
    const bf16_t* row_ = P + (tokbase + t_) * PSTRIDE; \
    if (MIXER == MIX_A) { const u32x4* qp_ = (const u32x4*)(row_ + qcol + c0); const u32x4* lp_ = (const u32x4*)(row_ + lfcol + c0); R.a0 = qp_[0]; R.a1 = qp_[1]; R.b0 = lp_[0]; R.b1 = lp_[1]; } \
    else if (MIXER == MIX_B) { R.a0 = *(const u32x4*)(row_ + qcol + c0); R.a1 = *(const u32x4*)(row_ + kcol + c0); R.b0 = *(const u32x4*)(LFBp + (tokbase + t_) * 512 + lfcol + c0); } \
    else if (MIXER == MIX_C) { const u32x2 qa_ = *(const u32x2*)(row_ + qcol + c0), qb_ = *(const u32x2*)(row_ + qcol + 32 + c0), ka_ = *(const u32x2*)(row_ + kcol + c0), kb_ = *(const u32x2*)(row_ + kcol + 32 + c0); \
      R.a0 = (u32x4){qa_.x, qa_.y, qb_.x, qb_.y}; R.a1 = (u32x4){ka_.x, ka_.y, kb_.x, kb_.y}; \
      R.r0 = *(const f32x4*)(rope + ((size_t)t_ * 32 + c0) * 2); R.r1 = *(const f32x4*)(rope + ((size_t)t_ * 32 + c0) * 2 + 4); } \
    else { const u32x4* qp_ = (const u32x4*)(LFBp + (tokbase + t_) * 512 + qcol + c0); const u32x4* kp_ = (const u32x4*)(row_ + kcol + c0); R.a0 = qp_[0]; R.a1 = qp_[1]; R.b0 = kp_[0]; R.b1 = kp_[1]; \
      R.s0 = side[(tokbase + t_) * 32 + dir * 8 + h]; R.s1 = side[(tokbase + t_) * 32 + dir * 8 + 4 + h]; } \
    R.v = *(const u32x2*)(row_ + vcol + wid * 4); } while (0)

  SCAN_LOAD(0);
  for (int n = 0; n < SEQ / 64; ++n) {
    int lane = lane0; asm volatile("" : "+v"(lane));
    const int fr = lane & 15, fq = lane >> 4;
    float q[NC], k[NC], g[NC];
    const u32x2 vv = R.v;
    float g_li = 0.f, g_lf = 0.f;
    if (MIXER == MIX_A) {
      const unsigned qw[8] = {R.a0.x, R.a0.y, R.a0.z, R.a0.w, R.a1.x, R.a1.y, R.a1.z, R.a1.w}, lw[8] = {R.b0.x, R.b0.y, R.b0.z, R.b0.w, R.b1.x, R.b1.y, R.b1.z, R.b1.w};
#pragma unroll
      for (int c = 0; c < 8; ++c) { q[2 * c] = lo16(qw[c]); q[2 * c + 1] = hi16(qw[c]); g[2 * c] = lo16(lw[c]); g[2 * c + 1] = hi16(lw[c]); }
#pragma unroll
      for (int c = 0; c < NC; ++c) k[c] = 1.0f - __expf(g[c]);
    } else if (MIXER == MIX_B) {
      const unsigned qw[4] = {R.a0.x, R.a0.y, R.a0.z, R.a0.w}, kw[4] = {R.a1.x, R.a1.y, R.a1.z, R.a1.w}, lw[4] = {R.b0.x, R.b0.y, R.b0.z, R.b0.w};
#pragma unroll
      for (int c = 0; c < 4; ++c) { q[2 * c] = lo16(qw[c]); q[2 * c + 1] = hi16(qw[c]); k[2 * c] = lo16(kw[c]); k[2 * c + 1] = hi16(kw[c]); g[2 * c] = lo16(lw[c]); g[2 * c + 1] = hi16(lw[c]); }
    } else if (MIXER == MIX_C) {
      const float cs[4] = {R.r0[0], R.r0[2], R.r1[0], R.r1[2]}, sn[4] = {R.r0[1], R.r0[3], R.r1[1], R.r1[3]};
      const float q1[4] = {lo16(R.a0.x), hi16(R.a0.x), lo16(R.a0.y), hi16(R.a0.y)}, q2[4] = {lo16(R.a0.z), hi16(R.a0.z), lo16(R.a0.w), hi16(R.a0.w)};
      const float k1[4] = {lo16(R.a1.x), hi16(R.a1.x), lo16(R.a1.y), hi16(R.a1.y)}, k2[4] = {lo16(R.a1.z), hi16(R.a1.z), lo16(R.a1.w), hi16(R.a1.w)};
#pragma unroll
      for (int c = 0; c < 4; ++c) { q[c] = (q1[c] * cs[c] - q2[c] * sn[c]) * 0.125f; q[4 + c] = (q1[c] * sn[c] + q2[c] * cs[c]) * 0.125f; k[c] = k1[c] * cs[c] - k2[c] * sn[c]; k[4 + c] = k1[c] * sn[c] + k2[c] * cs[c]; }
#pragma unroll
      for (int c = 0; c < NC; ++c) g[c] = (float)(lane + 1) * lgam;
    } else {
      const unsigned qw[8] = {R.a0.x, R.a0.y, R.a0.z, R.a0.w, R.a1.x, R.a1.y, R.a1.z, R.a1.w}, kw[8] = {R.b0.x, R.b0.y, R.b0.z, R.b0.w, R.b1.x, R.b1.y, R.b1.z, R.b1.w};
      g_li = R.s0; g_lf = R.s1;
#pragma unroll
      for (int c = 0; c < 8; ++c) { q[2 * c] = lo16(qw[c]); q[2 * c + 1] = hi16(qw[c]); k[2 * c] = lo16(kw[c]); k[2 * c + 1] = hi16(kw[c]); }
#pragma unroll
      for (int c = 0; c < NC; ++c) g[c] = 0.f;
    }
    if (n + 1 < SEQ / 64) SCAN_LOAD(n + 1);

#ifndef PROBE_REPA
#define PROBE_REPA 1
#endif
    const float m_save = m_st;
#pragma unroll 1
    for (int rep = 0; rep < PROBE_REPA; ++rep) {
    if (PROBE_REPA > 1) { m_st = m_save;
#pragma unroll
      for (int c = 0; c < NC; ++c) asm volatile("" : "+v"(g[c]), "+v"(q[c]), "+v"(k[c])); }
    float s_qs[NC], s_ks[NC], s_qi[NC], s_kt[NC];
    if (MIXER != MIX_D) {
#pragma unroll
      for (int c = 0; c < NC; ++c) {
        const float gc = (MIXER == MIX_C) ? g[c] : incl_scan_add(g[c]);
        const float gref = rdlane(gc, 31), glast = rdlane(gc, 63);
        const float a = __expf(gc - gref), ia = __builtin_amdgcn_rcpf(a);
        s_qs[c] = a; s_ks[c] = ia; s_qi[c] = a * __expf(gref); s_kt[c] = ia * __expf(glast - gref);
        if (lane == 63) DEC[(MIXER == MIX_C) ? (c < 4 ? c0 + c : 32 + c0 + c - 4) : c0 + c] = __expf(glast);
      }
    } else {
      const float li = g_li;
      const float lf = logsigmoidf_(g_lf + fgb);
      const float bc = incl_scan_add(lf);
      const float u = li - bc;
      const float pm = incl_scan_max(u);
      const float cmax = rdlane(pm, 63), blast = rdlane(bc, 63);
      const float a_i = bc + m_st, m_i = fmaxf(a_i, bc + pm);
      const float alpha = __expf(bc - m_i + cmax), beta = __expf(u - cmax), sint = __expf(a_i - m_i);
      const float m_new = fmaxf(blast + m_st, blast + cmax);
      const float s_old = __expf(blast + m_st - m_new), wks = __expf(blast + u - m_new);
      m_st = m_new;
#pragma unroll
      for (int c = 0; c < NC; ++c) { s_qs[c] = alpha; s_ks[c] = beta; s_qi[c] = sint; s_kt[c] = wks; }
      if (wid == 0) EM[lane] = __expf(-m_i);
      if (lane == 63) {
#pragma unroll
        for (int c = 0; c < NC; ++c) DEC[c0 + c] = s_old;
      }
    }
    {
      unsigned wq[NC / 2], wk[NC / 2], wi[NC / 2];
#pragma unroll
      for (int c = 0; c < NC / 2; ++c) { wq[c] = pk(q[2 * c] * s_qs[2 * c], q[2 * c + 1] * s_qs[2 * c + 1]); wk[c] = pk(k[2 * c] * s_ks[2 * c], k[2 * c + 1] * s_ks[2 * c + 1]); wi[c] = pk(q[2 * c] * s_qi[2 * c], q[2 * c + 1] * s_qi[2 * c + 1]); }
      if (MIXER == MIX_C) {
        *(u32x2*)(QS + lane * LD_D + c0 * 2) = (u32x2){wq[0], wq[1]}; *(u32x2*)(QS + lane * LD_D + (32 + c0) * 2) = (u32x2){wq[2], wq[3]};
        *(u32x2*)(KS + lane * LD_D + c0 * 2) = (u32x2){wk[0], wk[1]}; *(u32x2*)(KS + lane * LD_D + (32 + c0) * 2) = (u32x2){wk[2], wk[3]};
        *(u32x2*)(QI + lane * LD_D + c0 * 2) = (u32x2){wi[0], wi[1]}; *(u32x2*)(QI + lane * LD_D + (32 + c0) * 2) = (u32x2){wi[2], wi[3]};
      } else {
#pragma unroll
        for (int c = 0; c < NC / 8; ++c) {
          *(u32x4*)(QS + lane * LD_D + (c0 + 8 * c) * 2) = (u32x4){wq[4 * c], wq[4 * c + 1], wq[4 * c + 2], wq[4 * c + 3]};
          *(u32x4*)(KS + lane * LD_D + (c0 + 8 * c) * 2) = (u32x4){wk[4 * c], wk[4 * c + 1], wk[4 * c + 2], wk[4 * c + 3]};
          *(u32x4*)(QI + lane * LD_D + (c0 + 8 * c) * 2) = (u32x4){wi[4 * c], wi[4 * c + 1], wi[4 * c + 2], wi[4 * c + 3]};
        }
      }
#pragma unroll
      for (int c = 0; c < NC; ++c) { const int d = (MIXER == MIX_C) ? (c < 4 ? c0 + c : 32 + c0 + c - 4) : c0 + c; *(bf16_t*)(KT + d * LD_T + lane * 2) = f2bf(k[c] * s_kt[c]); }
      *(bf16_t*)(VT + (wid * 4 + 0) * LD_T + lane * 2) = (bf16_t)(vv.x & 0xffff); *(bf16_t*)(VT + (wid * 4 + 1) * LD_T + lane * 2) = (bf16_t)(vv.x >> 16);
      *(bf16_t*)(VT + (wid * 4 + 2) * LD_T + lane * 2) = (bf16_t)(vv.y & 0xffff); *(bf16_t*)(VT + (wid * 4 + 3) * LD_T + lane * 2) = (bf16_t)(vv.y >> 16);
    }
    }
    lds_barrier();
    {
      const int it = wid & 3;
#pragma unroll
      for (int jj = 0; jj < 2; ++jj) {
        const int jt = 2 * (wid >> 2) + jj;
        if (jt <= it) {
          f32x4 acc = (f32x4){0.f, 0.f, 0.f, 0.f};
#pragma unroll
          for (int ks = 0; ks < NKD; ++ks) acc = __builtin_amdgcn_mfma_f32_16x16x32_bf16(ldfrag(KS, LD_D, jt * 16 + fr, ks * 64 + fq * 16), ldfrag(QS, LD_D, it * 16 + fr, ks * 64 + fq * 16), acc, 0, 0, 0);
          const int i = it * 16 + fr, j0 = jt * 16 + fq * 4;
          const float v0 = (j0 + 0 <= i) ? acc[0] : 0.f, v1 = (j0 + 1 <= i) ? acc[1] : 0.f, v2 = (j0 + 2 <= i) ? acc[2] : 0.f, v3 = (j0 + 3 <= i) ? acc[3] : 0.f;
          *(u32x2*)(SC + i * LD_T + j0 * 2) = (u32x2){pk(v0, v1), pk(v2, v3)};
        } else {
          const int i = it * 16 + fr, j0 = jt * 16 + fq * 4;
          *(u32x2*)(SC + i * LD_T + j0 * 2) = (u32x2){0u, 0u};
        }
      }
    }
    f32x4 oacc = (f32x4){0.f, 0.f, 0.f, 0.f}, dacc = (f32x4){0.f, 0.f, 0.f, 0.f};
    {
      const int vt = wid >> 2, it = wid & 3;
#pragma unroll
      for (int ks = 0; ks < NKD; ++ks) oacc = __builtin_amdgcn_mfma_f32_16x16x32_bf16(ldfrag(ST, LD_D, vt * 16 + fr, ks * 64 + fq * 16), ldfrag(QI, LD_D, it * 16 + fr, ks * 64 + fq * 16), oacc, 0, 0, 0);
      if (NVT == 3 && wid < 4) {
#pragma unroll
        for (int ks = 0; ks < NKD; ++ks) dacc = __builtin_amdgcn_mfma_f32_16x16x32_bf16(ldfrag(ST, LD_D, 32 + fr, ks * 64 + fq * 16), ldfrag(QI, LD_D, wid * 16 + fr, ks * 64 + fq * 16), dacc, 0, 0, 0);
      }
    }
    lds_barrier();
    {
      const int vt = wid >> 2, it = wid & 3;
#pragma unroll
      for (int ks = 0; ks < 2; ++ks) oacc = __builtin_amdgcn_mfma_f32_16x16x32_bf16(ldfrag(VT, LD_T, vt * 16 + fr, ks * 64 + fq * 16), ldfrag(SC, LD_T, it * 16 + fr, ks * 64 + fq * 16), oacc, 0, 0, 0);
      if (NVT == 3) {
        if (wid < 4) {
#pragma unroll
          for (int ks = 0; ks < 2; ++ks) dacc = __builtin_amdgcn_mfma_f32_16x16x32_bf16(ldfrag(VT, LD_T, 32 + fr, ks * 64 + fq * 16), ldfrag(SC, LD_T, wid * 16 + fr, ks * 64 + fq * 16), dacc, 0, 0, 0);
          if (fq == 0) DEN[wid * 16 + fr] = dacc[0];
        }
        lds_barrier();
        const int i = it * 16 + fr;
        const float dn = 1.0f / fmaxf(fabsf(DEN[i]), EM[i]);
        oacc *= dn;
      }
      const int i = it * 16 + fr;
      const int ti = dir ? (SEQ - 1 - (n * 64 + i)) : (n * 64 + i);
      *(u32x2*)(O + (tokbase + ti) * 1024 + ocol + vt * 16 + fq * 4) = (u32x2){pk(oacc[0], oacc[1]), pk(oacc[2], oacc[3])};
    }
    {
      constexpr int NST = (DK == 128) ? NVT : 1;
#pragma unroll
      for (int s = 0; s < NST; ++s) {
        const int dt = (DK == 128) ? wid : (wid & 3), vt = (DK == 128) ? s : (wid >> 2);
        const f32x4 dc = *(const f32x4*)(DEC + dt * 16 + fq * 4);
        f32x4 acc = sacc[s] * dc;
#pragma unroll
        for (int ks = 0; ks < 2; ++ks) acc = __builtin_amdgcn_mfma_f32_16x16x32_bf16(ldfrag(KT, LD_T, dt * 16 + fr, ks * 64 + fq * 16), ldfrag(VT, LD_T, vt * 16 + fr, ks * 64 + fq * 16), acc, 0, 0, 0);
        sacc[s] = acc;
        *(u32x2*)(ST + (vt * 16 + fr) * LD_D + (dt * 16 + fq * 4) * 2) = (u32x2){pk(acc[0], acc[1]), pk(acc[2], acc[3])};
      }
    }
    lds_barrier();
  }
}

template <int MIXER>
__device__ __forceinline__ void scan_dispatch(unsigned char* lds, int wv, const Params& p, int id) {
  const int vs = id & 3, dir = (id >> 2) & 1, h = (id >> 3) & 3, b = id >> 5;
  scan_item<MIXER>(lds, wv, p, b, h, dir, vs);
}
}

__device__ __forceinline__ void convd_phase(unsigned char* lds_, int wv, const Params& p) {
  const Ctx c = make_ctx(lds_, wv);
  bf16_t* P = (bf16_t*)(p.ws + WS_R1); bf16_t* QD = (bf16_t*)(p.ws + WS_LFB);
  const float* cw = p.in[I_CONV_W]; const float* cb = p.in[I_CONV_B];
  const int ch = c.lane * 16;
  float w0[16], w1[16], w2[16], bb[16];
#pragma unroll
  for (int j = 0; j < 16; ++j) { w0[j] = cw[ch + j]; w1[j] = cw[1024 + ch + j]; w2[j] = cw[2048 + ch + j]; bb[j] = cb[ch + j]; }
  for (int tok = c.bid * 8 + c.wid; tok < NTOK; tok += c.G * 8) {
    const int t = tok % SEQ;
    const bf16_t* row = P + PIDX(tok, 1536 + ch);
    float x0[16], x1[16], x2[16];
    { const u32x4* r1 = (const u32x4*)row; unpack8(r1[0], x1); unpack8(r1[1], x1 + 8); }
    if (t > 0) { const u32x4* r0 = (const u32x4*)(row - 128); unpack8(r0[0], x0); unpack8(r0[1], x0 + 8); }
    else {
#pragma unroll
      for (int j = 0; j < 16; ++j) x0[j] = 0.f; }
    if (t < SEQ - 1) { const u32x4* r2 = (const u32x4*)(row + 128); unpack8(r2[0], x2); unpack8(r2[1], x2 + 8); }
    else {
#pragma unroll
      for (int j = 0; j < 16; ++j) x2[j] = 0.f; }
    const float sc = ch < 512 ? 0.08838834764831845f : 1.0f;
    unsigned w[8];
#pragma unroll
    for (int j = 0; j < 8; ++j) {
      const float a0 = bb[2 * j] + w0[2 * j] * x0[2 * j] + w1[2 * j] * x1[2 * j] + w2[2 * j] * x2[2 * j];
      const float a1 = bb[2 * j + 1] + w0[2 * j + 1] * x0[2 * j + 1] + w1[2 * j + 1] * x1[2 * j + 1] + w2[2 * j + 1] * x2[2 * j + 1];
      w[j] = pk2(fsilu(a0) * sc, fsilu(a1) * sc);
    }
    u32x4* d = (ch < 512) ? (u32x4*)(QD + PIDX(tok, ch)) : (u32x4*)(P + PIDX(tok, 3584 + (ch - 512)));
    d[0] = (u32x4){w[0], w[1], w[2], w[3]}; d[1] = (u32x4){w[4], w[5], w[6], w[7]};
  }
}

__device__ __forceinline__ void scan_phase(unsigned char* lds, int wv, const Params& p, int layer) {
  for (int item = blockIdx.x; item < 256; item += gridDim.x) {
    if (layer == 0) { if (item < 128) scan::scan_dispatch<scan::MIX_A>(lds, wv, p, item); else scan::scan_dispatch<scan::MIX_B>(lds, wv, p, item - 128); }
    else { if (item < 128) scan::scan_dispatch<scan::MIX_D>(lds, wv, p, item); else scan::scan_dispatch<scan::MIX_C>(lds, wv, p, item - 128); }
    __syncthreads();
  }
}
#endif
#ifndef CPU_EMU
namespace scan2 {
using namespace scan;
constexpr int S_QS = 0, S_KS = 17408, S_QI = 34816, S_KT = 52224  , S_VT = 89088  , S_SC = 102912, S_ST = 112128  , S_DEC = 138240  , S_EM = 139264  , S_END = 139776;

constexpr int U_QI = 0, U_KS = 34816, U_KT = 69632, U_VT = 106496, U_SC = 120320, U_ST = 129536, U_DEC = 155648, U_EM = 156672, U_END = 157184;
template <int MIXER>
__device__ __forceinline__ void scan_item2(unsigned char* lds, int wv, const Params& p, int b, int h, int dir, int vs) {
  constexpr int DK = (MIXER == MIX_A || MIXER == MIX_D) ? 128 : 64;
  constexpr int NC = DK / 8;
  constexpr int LD_D = DK * 2 + 16;
  constexpr int NVT = MIXER == MIX_D ? 3 : 2;
  constexpr int NKD = DK / 32;
  constexpr int NST = (DK == 128) ? NVT : 1;
  constexpr int NCH = SEQ / 64;
  const int tid = opaque_tid(wv), lane0 = tid & 63, wid = __builtin_amdgcn_readfirstlane(tid >> 6);
  unsigned char* ws = p.ws;
  const bf16_t* P = (const bf16_t*)(ws + WS_R1);
  const bf16_t* LFBp = (const bf16_t*)(ws + WS_LFB);
  const float* side = (const float*)(ws + WS_SIDE);
  const float* rope = (const float*)(ws + WS_ROPE);
  bf16_t* O = (bf16_t*)(ws + WS_R2) + (size_t)dir * NTOK * 1024;
  unsigned char* SC = lds + U_SC;
  int qcol, kcol, lfcol, vcol, ocol;
  if (MIXER == MIX_A) { qcol = h * 128; kcol = 0; lfcol = 512 + dir * 512 + h * 128; vcol = 1536 + h * 128 + vs * 32; ocol = h * 128 + vs * 32; }
  else if (MIXER == MIX_B) { qcol = 2560 + h * 64; kcol = 2816 + h * 64; lfcol = dir * 256 + h * 64; vcol = 3072 + h * 128 + vs * 32; ocol = 512 + h * 128 + vs * 32; }
  else if (MIXER == MIX_C) { qcol = h * 64; kcol = 256 + h * 64; lfcol = 0; vcol = 512 + h * 128 + vs * 32; ocol = h * 128 + vs * 32; }
  else { qcol = h * 128; kcol = 3584 + h * 128; lfcol = 0; vcol = 2560 + h * 128 + vs * 32; ocol = 512 + h * 128 + vs * 32; }
  const size_t tokbase = (size_t)b * SEQ;
  const int c0 = (MIXER == MIX_C) ? wid * 4 : wid * NC;
  for (int i = tid; i < 2 * 13056 / 4; i += NTHREADS) ((unsigned*)(lds + U_ST))[i] = 0u;
  for (int i = tid; i < 9216 / 4; i += NTHREADS) ((unsigned*)(lds + U_SC))[i] = 0u;
  if (MIXER == MIX_D) { for (int i = tid; i < 2 * 16 * 64; i += NTHREADS) { const int bf = i >> 10, r = 32 + ((i >> 6) & 15), j = i & 63; *(bf16_t*)(lds + U_VT + bf * 6912 + r * LD_T + j * 2) = (r == 32) ? (bf16_t)0x3F80 : (bf16_t)0; } }
  const float lgam2 = (MIXER == MIX_C) ? log1pf(-exp2f(-(5.0f + 2.0f * (float)h + (float)dir))) * 1.4426950408889634f : 0.f;
  const float fgb = (MIXER == MIX_D) ? p.in[I_FGATE_B][dir * 4 + h] : 0.f;
  float m_st = 0.f;
  __syncthreads();

  Raw R, Rn; u32x2 Rv, Rvn;
#define A_LOAD(R, Rv, n_) do { \
    const int ln_ = lane0; \
    const int t_ = dir ? (SEQ - 1 - ((n_) * 64 + ln_)) : ((n_) * 64 + ln_); \
    const size_t tk_ = tokbase + t_; \
    if (MIXER == MIX_A) { const u32x4* qp_ = (const u32x4*)(P + PIDX(tk_, qcol + c0)); const u32x4* lp_ = (const u32x4*)(P + PIDX(tk_, lfcol + c0)); R.a0 = qp_[0]; R.a1 = qp_[1]; R.b0 = lp_[0]; R.b1 = lp_[1]; } \
    else if (MIXER == MIX_B) { R.a0 = *(const u32x4*)(P + PIDX(tk_, qcol + c0)); R.a1 = *(const u32x4*)(P + PIDX(tk_, kcol + c0)); R.b0 = *(const u32x4*)(LFBp + PIDX(tk_, lfcol + c0)); } \
    else if (MIXER == MIX_C) { const u32x2 qa_ = *(const u32x2*)(P + PIDX(tk_, qcol + c0)), qb_ = *(const u32x2*)(P + PIDX(tk_, qcol + 32 + c0)), ka_ = *(const u32x2*)(P + PIDX(tk_, kcol + c0)), kb_ = *(const u32x2*)(P + PIDX(tk_, kcol + 32 + c0)); \
      R.a0 = (u32x4){qa_.x, qa_.y, qb_.x, qb_.y}; R.a1 = (u32x4){ka_.x, ka_.y, kb_.x, kb_.y}; \
      R.r0 = *(const f32x4*)(rope + ((size_t)t_ * 32 + c0) * 2); R.r1 = *(const f32x4*)(rope + ((size_t)t_ * 32 + c0) * 2 + 4); } \
    else { const u32x4* qp_ = (const u32x4*)(LFBp + PIDX(tk_, qcol + c0)); const u32x4* kp_ = (const u32x4*)(P + PIDX(tk_, kcol + c0)); R.a0 = qp_[0]; R.a1 = qp_[1]; R.b0 = kp_[0]; R.b1 = kp_[1]; \
      R.s0 = side[tk_ * 32 + dir * 8 + h]; R.s1 = side[tk_ * 32 + dir * 8 + 4 + h]; } \
    Rv = *(const u32x2*)(P + PIDX(tk_, vcol + wid * 4)); } while (0)

  float rr_next = 1.f, rr_cur = 1.f;
#define A_PREP(buf_, R, Rv) do { \
    const int lane = lane0; \
    unsigned char* KTb = lds + U_KT + (buf_) * 18432; float* DECb = (float*)(lds + U_DEC + (buf_) * 512); float* EMb = (float*)(lds + U_EM + (buf_) * 256); \
    unsigned char* QIb = lds + U_QI + (buf_) * 17408; unsigned char* KSb = lds + U_KS + (buf_) * 17408; \
    float q[NC], k[NC], g[NC], ktv[NC]; \
    if (MIXER == MIX_A) { \
      const unsigned qw[8] = {R.a0.x, R.a0.y, R.a0.z, R.a0.w, R.a1.x, R.a1.y, R.a1.z, R.a1.w}, lw[8] = {R.b0.x, R.b0.y, R.b0.z, R.b0.w, R.b1.x, R.b1.y, R.b1.z, R.b1.w}; \
      _Pragma("unroll") for (int c = 0; c < 8; ++c) { q[2 * c] = lo16(qw[c]); q[2 * c + 1] = hi16(qw[c]); g[2 * c] = lo16(lw[c]); g[2 * c + 1] = hi16(lw[c]); } \
      _Pragma("unroll") for (int c = 0; c < NC; ++c) k[c] = 1.0f - __builtin_amdgcn_exp2f(g[c]); \
    } else if (MIXER == MIX_B) { \
      const unsigned qw[4] = {R.a0.x, R.a0.y, R.a0.z, R.a0.w}, kw[4] = {R.a1.x, R.a1.y, R.a1.z, R.a1.w}, lw[4] = {R.b0.x, R.b0.y, R.b0.z, R.b0.w}; \
      _Pragma("unroll") for (int c = 0; c < 4; ++c) { q[2 * c] = lo16(qw[c]); q[2 * c + 1] = hi16(qw[c]); k[2 * c] = lo16(kw[c]); k[2 * c + 1] = hi16(kw[c]); g[2 * c] = lo16(lw[c]); g[2 * c + 1] = hi16(lw[c]); } \
    } else if (MIXER == MIX_C) { \
      const float cs[4] = {R.r0[0], R.r0[2], R.r1[0], R.r1[2]}, sn[4] = {R.r0[1], R.r0[3], R.r1[1], R.r1[3]}; \
      const float q1[4] = {lo16(R.a0.x), hi16(R.a0.x), lo16(R.a0.y), hi16(R.a0.y)}, q2[4] = {lo16(R.a0.z), hi16(R.a0.z), lo16(R.a0.w), hi16(R.a0.w)}; \
      const float k1[4] = {lo16(R.a1.x), hi16(R.a1.x), lo16(R.a1.y), hi16(R.a1.y)}, k2[4] = {lo16(R.a1.z), hi16(R.a1.z), lo16(R.a1.w), hi16(R.a1.w)}; \
      _Pragma("unroll") for (int c = 0; c < 4; ++c) { q[c] = (q1[c] * cs[c] - q2[c] * sn[c]) * 0.125f; q[4 + c] = (q1[c] * sn[c] + q2[c] * cs[c]) * 0.125f; k[c] = k1[c] * cs[c] - k2[c] * sn[c]; k[4 + c] = k1[c] * sn[c] + k2[c] * cs[c]; } \
    } else { \
      const unsigned qw[8] = {R.a0.x, R.a0.y, R.a0.z, R.a0.w, R.a1.x, R.a1.y, R.a1.z, R.a1.w}, kw[8] = {R.b0.x, R.b0.y, R.b0.z, R.b0.w, R.b1.x, R.b1.y, R.b1.z, R.b1.w}; \
      _Pragma("unroll") for (int c = 0; c < 8; ++c) { q[2 * c] = lo16(qw[c]); q[2 * c + 1] = hi16(qw[c]); k[2 * c] = lo16(kw[c]); k[2 * c + 1] = hi16(kw[c]); } \
    } \
    if (MIXER == MIX_A || MIXER == MIX_B) { \
        \
      _Pragma("unroll") for (int c = 0; c < NC; ++c) g[c] += __builtin_bit_cast(float, __builtin_amdgcn_update_dpp(0, __builtin_bit_cast(int, g[c]), 0x111, 0xf, 0xf, false)); \
      _Pragma("unroll") for (int c = 0; c < NC; ++c) g[c] += __builtin_bit_cast(float, __builtin_amdgcn_update_dpp(0, __builtin_bit_cast(int, g[c]), 0x112, 0xf, 0xf, false)); \
      _Pragma("unroll") for (int c = 0; c < NC; ++c) g[c] += __builtin_bit_cast(float, __builtin_amdgcn_update_dpp(0, __builtin_bit_cast(int, g[c]), 0x114, 0xf, 0xf, false)); \
      _Pragma("unroll") for (int c = 0; c < NC; ++c) g[c] += __builtin_bit_cast(float, __builtin_amdgcn_update_dpp(0, __builtin_bit_cast(int, g[c]), 0x118, 0xf, 0xf, false)); \
      _Pragma("unroll") for (int c = 0; c < NC; ++c) g[c] += __builtin_bit_cast(float, __builtin_amdgcn_update_dpp(0, __builtin_bit_cast(int, g[c]), 0x142, 0xa, 0xf, false)); \
      _Pragma("unroll") for (int c = 0; c < NC; ++c) g[c] += __builtin_bit_cast(float, __builtin_amdgcn_update_dpp(0, __builtin_bit_cast(int, g[c]), 0x143, 0xc, 0xf, false)); \
      float ev[NC]; \
      _Pragma("unroll") for (int c = 0; c < NC; ++c) { \
          \
        const float e = __builtin_amdgcn_exp2f(g[c]), r = __builtin_amdgcn_rcpf(e); \
        const float e63 = rdlane(e, 63); \
        q[c] *= e; k[c] *= r; ktv[c] = k[c] * e63;     \
        ev[c] = e; } \
      if (lane == 63) { _Pragma("unroll") for (int c = 0; c < NC / 4; ++c) *(f32x4*)(DECb + c0 + 4 * c) = (f32x4){ev[4 * c], ev[4 * c + 1], ev[4 * c + 2], ev[4 * c + 3]}; } \
    } else if (MIXER == MIX_C) { \
        \
      const float gl = (float)(lane + 1) * lgam2; \
      const float e = __builtin_amdgcn_exp2f(gl), r = __builtin_amdgcn_rcpf(e); \
      const float e63 = rdlane(e, 63); const float f_kt = r * e63; \
      _Pragma("unroll") for (int c = 0; c < NC; ++c) { q[c] *= e; ktv[c] = k[c] * f_kt; k[c] *= r; } \
      if (lane < 4) { DECb[c0 + lane] = e63; DECb[32 + c0 + lane] = e63; } \
    } else { \
      const float li = R.s0, lf = R.s1;     \
      const float bc = incl_scan_add(lf); const float u = li - bc; const float pm = incl_scan_max(u); \
      const float cmax = rdlane(pm, 63), blast = rdlane(bc, 63); \
      const float a_i = bc + m_st, m_i = fmaxf(a_i, bc + pm); \
      const float d_alpha = __builtin_amdgcn_exp2f(bc - m_i + cmax), d_beta = __builtin_amdgcn_exp2f(u - cmax); \
      rr_next = __builtin_amdgcn_exp2f(m_st - cmax);     \
      const float m_new = fmaxf(blast + m_st, blast + cmax); \
      const float d_sold = __builtin_amdgcn_exp2f(blast + m_st - m_new), d_wks = __builtin_amdgcn_exp2f(blast + u - m_new); m_st = m_new; \
      _Pragma("unroll") for (int c = 0; c < NC; ++c) { ktv[c] = k[c] * d_wks; q[c] *= d_alpha; k[c] *= d_beta; if (lane == 63) DECb[c0 + c] = d_sold; } \
      if (wid == 0) EMb[lane] = __builtin_amdgcn_exp2f(-m_i); \
    } \
    _Pragma("unroll") for (int c = 0; c < NC / 2; ++c) { const unsigned w_ = pk_hw(ktv[2 * c], ktv[2 * c + 1]); \
      const int d0_ = (MIXER == MIX_C) ? (2 * c < 4 ? c0 + 2 * c : 32 + c0 + 2 * c - 4) : c0 + 2 * c; \
      *(bf16_t*)(KTb + d0_ * LD_T + lane * 2) = (bf16_t)(w_ & 0xffff); *(bf16_t*)(KTb + (d0_ + 1) * LD_T + lane * 2) = (bf16_t)(w_ >> 16); } \
    { unsigned pq[NC / 2], pks[NC / 2]; \
      _Pragma("unroll") for (int c = 0; c < NC / 2; ++c) { pq[c] = pk_hw(q[2 * c], q[2 * c + 1]); pks[c] = pk_hw(k[2 * c], k[2 * c + 1]); } \
      if (MIXER == MIX_C) { \
        *(u32x2*)(QIb + lane * LD_D + c0 * 2) = (u32x2){pq[0], pq[1]}; *(u32x2*)(QIb + lane * LD_D + (32 + c0) * 2) = (u32x2){pq[2], pq[3]}; \
        *(u32x2*)(KSb + lane * LD_D + c0 * 2) = (u32x2){pks[0], pks[1]}; *(u32x2*)(KSb + lane * LD_D + (32 + c0) * 2) = (u32x2){pks[2], pks[3]}; \
      } else { \
        _Pragma("unroll") for (int c = 0; c < NC / 8; ++c) { \
          *(u32x4*)(QIb + lane * LD_D + (c0 + 8 * c) * 2) = (u32x4){pq[4 * c], pq[4 * c + 1], pq[4 * c + 2], pq[4 * c + 3]}; \
          *(u32x4*)(KSb + lane * LD_D + (c0 + 8 * c) * 2) = (u32x4){pks[4 * c], pks[4 * c + 1], pks[4 * c + 2], pks[4 * c + 3]}; } } } \
    { unsigned char* VTb = lds + U_VT + (buf_) * 6912 + (wid * 4) * LD_T + lane * 2; \
      *(bf16_t*)(VTb + 0 * LD_T) = (bf16_t)(Rv.x & 0xffff); *(bf16_t*)(VTb + 1 * LD_T) = (bf16_t)(Rv.x >> 16); *(bf16_t*)(VTb + 2 * LD_T) = (bf16_t)(Rv.y & 0xffff); *(bf16_t*)(VTb + 3 * LD_T) = (bf16_t)(Rv.y >> 16); } \
  } while (0)
  f32x4 sacc[NST];
#pragma unroll
  for (int i = 0; i < NST; ++i) sacc[i] = (f32x4){0.f, 0.f, 0.f, 0.f};
  A_LOAD(R, Rv, 0);
  A_PREP(0, R, Rv);
  A_LOAD(R, Rv, 1);
  A_LOAD(Rn, Rvn, 2);
  rr_cur = rr_next;
  lds_barrier();
#define SCAN_ITER(n_, RX, RvX) do { const int n = (n_); \
    const int cb = n & 1, nb = (n + 1) & 1; \
    if (n + 1 < NCH) { A_PREP(nb, RX, RvX); if (n + 3 < NCH) A_LOAD(RX, RvX, n + 3); } \
    { { \
      const int lane = lane0; \
      const int fr = lane & 15, fq = lane >> 4; \
      const int it = wid & 3, vt = wid >> 2; \
      const unsigned char* STc = lds + U_ST + cb * 13056; unsigned char* STn = lds + U_ST + nb * 13056; \
      const unsigned char* KTc = lds + U_KT + cb * 18432; const unsigned char* VTc = lds + U_VT + cb * 6912; \
      const unsigned char* QI = lds + U_QI + cb * 17408; const unsigned char* KS = lds + U_KS + cb * 17408; \
      const float* DECc = (const float*)(lds + U_DEC + cb * 512); const float* EMc = (const float*)(lds + U_EM + cb * 256); \
_Pragma("unroll") \
      for (int jt = 0; jt < 4; ++jt) { \
        if (jt <= it) { \
          f32x4 acc = (f32x4){0.f, 0.f, 0.f, 0.f}; \
_Pragma("unroll") \
          for (int ks = 0; ks < NKD; ++ks) acc = __builtin_amdgcn_mfma_f32_16x16x32_bf16(ldfrag(KS, LD_D, jt * 16 + fr, ks * 64 + fq * 16), ldfrag(QI, LD_D, it * 16 + fr, ks * 64 + fq * 16), acc, 0, 0, 0); \
          const int i = it * 16 + fr, j0 = jt * 16 + fq * 4; \
          if (jt == it) { const float v0 = (j0 + 0 <= i) ? acc[0] : 0.f, v1 = (j0 + 1 <= i) ? acc[1] : 0.f, v2 = (j0 + 2 <= i) ? acc[2] : 0.f, v3 = (j0 + 3 <= i) ? acc[3] : 0.f; \
            *(u32x2*)(SC + i * LD_T + j0 * 2) = (u32x2){pk_hw(v0, v1), pk_hw(v2, v3)}; } \
          else *(u32x2*)(SC + i * LD_T + j0 * 2) = (u32x2){pk_hw(acc[0], acc[1]), pk_hw(acc[2], acc[3])}; \
        } \
      } \
      f32x4 oacc = (f32x4){0.f, 0.f, 0.f, 0.f}, dacc = (f32x4){0.f, 0.f, 0.f, 0.f}; \
_Pragma("unroll") \
      for (int ks = 0; ks < NKD; ++ks) oacc = __builtin_amdgcn_mfma_f32_16x16x32_bf16(ldfrag(STc, LD_D, vt * 16 + fr, ks * 64 + fq * 16), ldfrag(QI, LD_D, it * 16 + fr, ks * 64 + fq * 16), oacc, 0, 0, 0); \
      if (NVT == 3) { \
_Pragma("unroll") \
        for (int ks = 0; ks < NKD; ++ks) dacc = __builtin_amdgcn_mfma_f32_16x16x32_bf16(ldfrag(STc, LD_D, 32 + fr, ks * 64 + fq * 16), ldfrag(QI, LD_D, it * 16 + fr, ks * 64 + fq * 16), dacc, 0, 0, 0); \
      } \
      if (MIXER == MIX_D) { oacc *= rr_cur; dacc *= rr_cur; } \
      asm volatile("s_waitcnt lgkmcnt(0)" ::: "memory"); \
      oacc = __builtin_amdgcn_mfma_f32_16x16x32_bf16(ldfrag(VTc, LD_T, vt * 16 + fr, fq * 16), ldfrag(SC, LD_T, it * 16 + fr, fq * 16), oacc, 0, 0, 0); \
      if (it >= 2) oacc = __builtin_amdgcn_mfma_f32_16x16x32_bf16(ldfrag(VTc, LD_T, vt * 16 + fr, 64 + fq * 16), ldfrag(SC, LD_T, it * 16 + fr, 64 + fq * 16), oacc, 0, 0, 0); \
      float dn = 1.0f; \
      if (NVT == 3) { \
        dacc = __builtin_amdgcn_mfma_f32_16x16x32_bf16(ldfrag(VTc, LD_T, 32 + fr, fq * 16), ldfrag(SC, LD_T, it * 16 + fr, fq * 16), dacc, 0, 0, 0); \
        if (it >= 2) dacc = __builtin_amdgcn_mfma_f32_16x16x32_bf16(ldfrag(VTc, LD_T, 32 + fr, 64 + fq * 16), ldfrag(SC, LD_T, it * 16 + fr, 64 + fq * 16), dacc, 0, 0, 0); \
        const float den = __shfl(dacc[0], fr); \
        dn = 1.0f / fmaxf(fabsf(den), EMc[it * 16 + fr]); \
      } \
      { \
        const int i = it * 16 + fr; \
        const int ti = dir ? (SEQ - 1 - (n * 64 + i)) : (n * 64 + i); \
        const f32x4 o = oacc * dn; \
        *(u32x2*)(O + PIDX(tokbase + ti, ocol + vt * 16 + fq * 4)) = (u32x2){pk_hw(o[0], o[1]), pk_hw(o[2], o[3])}; \
      } \
_Pragma("unroll") \
      for (int s = 0; s < NST; ++s) { \
        const int dt = (DK == 128) ? wid : (wid & 3), vt2 = (DK == 128) ? s : (wid >> 2); \
        const f32x4 dc = *(const f32x4*)(DECc + dt * 16 + fq * 4); \
        f32x4 acc = sacc[s] * dc; \
_Pragma("unroll") \
        for (int ks = 0; ks < 2; ++ks) acc = __builtin_amdgcn_mfma_f32_16x16x32_bf16(ldfrag(KTc, LD_T, dt * 16 + fr, ks * 64 + fq * 16), ldfrag(VTc, LD_T, vt2 * 16 + fr, ks * 64 + fq * 16), acc, 0, 0, 0); \
        sacc[s] = acc; \
        *(u32x2*)(STn + (vt2 * 16 + fr) * LD_D + (dt * 16 + fq * 4) * 2) = (u32x2){pk_hw(acc[0], acc[1]), pk_hw(acc[2], acc[3])}; \
      } \
    } \
    } \
    rr_cur = rr_next; \
    lds_barrier(); \
  } while (0)
  static_assert(NCH % 2 == 0, "chunk count must be even");
#pragma unroll 1
  for (int n2 = 0; n2 < NCH; n2 += 2) { SCAN_ITER(n2, R, Rv); SCAN_ITER(n2 + 1, Rn, Rvn); }
#undef SCAN_ITER
#undef A_LOAD
#undef A_PREP
}

template <int MIXER>
__device__ __forceinline__ void scan_dispatch2(unsigned char* lds, int wv, const Params& p, int id) {
  const int vs = id & 3, dir = (id >> 2) & 1, h = (id >> 3) & 3, b = id >> 5;
  scan_item2<MIXER>(lds, wv, p, b, h, dir, vs);
}
}

__device__ __forceinline__ void scan_phase2(unsigned char* lds, int wv, const Params& p, int layer) {
  for (int it0 = blockIdx.x; it0 < 256; it0 += gridDim.x) {
    const int xq = it0 & 7, yq = it0 >> 3, stream = (yq >> 2) * 8 + xq;
    const int item = (stream >> 5) * 128 + (stream & 31) * 4 + (yq & 3);
    if (layer == 0) { if (item < 128) scan2::scan_dispatch2<scan::MIX_A>(lds, wv, p, item); else scan2::scan_dispatch2<scan::MIX_B>(lds, wv, p, item - 128); }
    else { if (item < 128) scan2::scan_dispatch2<scan::MIX_D>(lds, wv, p, item); else scan2::scan_dispatch2<scan::MIX_C>(lds, wv, p, item - 128); }
    __syncthreads();
  }
}
#endif
#ifndef CPU_EMU
#define XB_BASE     2048
#define XB_TMO      (XB_BASE + 128)
#define XB_XCNT(j)  (XB_BASE + 256  + 64 * (j))
#define XB_XSUB(j)  (XB_BASE + 1280 + 64 * (j))
#define XB_XGEN(j)  (XB_BASE + 2304 + 64 * (j))
#define XB_TOP      (XB_BASE + 3328)
#define XB_TOPGEN   (XB_BASE + 3392)
#define XB_WORDS    3456
#define XB_SPIN_CAP (1u << 22)
#define XB_LDS_OFF  (LDS_BYTES - 16)
__device__ __forceinline__ unsigned xb_ld(unsigned* p)              { return __hip_atomic_load(p, __ATOMIC_RELAXED, __HIP_MEMORY_SCOPE_AGENT); }
__device__ __forceinline__ unsigned xb_add(unsigned* p, unsigned v) { return __hip_atomic_fetch_add(p, v, __ATOMIC_RELAXED, __HIP_MEMORY_SCOPE_AGENT); }
__device__ __forceinline__ unsigned xb_xcc_id() { return (unsigned)__builtin_amdgcn_s_getreg((3 << 11) | 20) & 0xFu; }
#define XB_SPIN(cond, bar) do { unsigned _sp = 0; while (cond) { __builtin_amdgcn_s_sleep(1); \
    if ((++_sp & 255u) == 0u) { if (xb_ld(&(bar)[XB_TMO])) break; if (_sp > XB_SPIN_CAP) { atomicAdd(&(bar)[XB_TMO], 1u); break; } } } } while (0)
__device__ __forceinline__ void grid_bar(unsigned* bar, unsigned char* lds_raw, int wv) {
  asm volatile("s_waitcnt vmcnt(0)" ::: "memory");
  __syncthreads();
  if (wv == 0 && lane_id() == 0) {
    volatile unsigned* st = (volatile unsigned*)(lds_raw + XB_LDS_OFF);
    __builtin_amdgcn_s_waitcnt(0);
    const unsigned x = xb_xcc_id();
    unsigned nloc = st[0], nx = st[1];
    if (nloc == 0u) {
      const unsigned G = gridDim.x; unsigned sum, cnt, mine, sp = 0u;
      for (;;) { sum = 0u; cnt = 0u; mine = 0u;
#pragma unroll
        for (unsigned j = 0; j < 16; ++j) { const unsigned c = xb_ld(&bar[XB_XCNT(j)]); sum += c; cnt += (c > 0u) ? 1u : 0u; mine = (j == x) ? c : mine; }
        if (sum == G) break;
        __builtin_amdgcn_s_sleep(1);
        if ((++sp & 255u) == 0u) { if (xb_ld(&bar[XB_TMO])) break; if (sp > XB_SPIN_CAP) { atomicAdd(&bar[XB_TMO], 1u); break; } } }
      nloc = mine > 0u ? mine : 1u; nx = cnt > 0u ? cnt : 1u; st[0] = nloc; st[1] = nx;
    }
    const unsigned old = xb_add(&bar[XB_XSUB(x)], 1u);
    const unsigned gen = old / nloc;
    if (old + 1u == (gen + 1u) * nloc) {
      __builtin_amdgcn_fence(__ATOMIC_RELEASE, "agent");
      asm volatile("s_waitcnt vmcnt(0)" ::: "memory");
      const unsigned og = xb_add(&bar[XB_TOP], 1u);
      const unsigned tg = og / nx;
      if (og + 1u == (tg + 1u) * nx) xb_add(&bar[XB_TOPGEN], 1u);
      else XB_SPIN(xb_ld(&bar[XB_TOPGEN]) == tg, bar);
      __builtin_amdgcn_fence(__ATOMIC_ACQUIRE, "agent");
      xb_add(&bar[XB_XGEN(x)], 1u);
      asm volatile("s_waitcnt vmcnt(0)" ::: "memory");
    } else {
      XB_SPIN(xb_ld(&bar[XB_XGEN(x)]) == gen, bar);
      __builtin_amdgcn_fence(__ATOMIC_ACQUIRE, "agent");
      asm volatile("s_waitcnt vmcnt(0)" ::: "memory");
    }
  }
  __syncthreads();
}
#if (PROBE_DUP & 16)
#define grid_bar(a, b, c) do { grid_bar(a, b, c); grid_bar(a, b, c); } while (0)
#endif

__global__ void __launch_bounds__(NTHREADS) mk_fwd(Params p) {
  extern __shared__ __attribute__((aligned(16))) unsigned char lds_raw[];
  cg::grid_group grid = cg::this_grid();
  const int G = gridDim.x, bid = blockIdx.x;
  const int wv = __builtin_amdgcn_readfirstlane(threadIdx.x >> 6);
  PG8_LAS unsigned char* lds = (PG8_LAS unsigned char*)lds_raw;
  unsigned char* ws = p.ws;

  if (threadIdx.x < 4) ((unsigned*)(lds_raw + XB_LDS_OFF))[threadIdx.x] = 0u;
  p0_prologue(lds_raw, wv, p);
#if (PROBE_DUP & 128)
  p0_prologue(lds_raw, wv, p);
#endif
  grid.sync();
  unsigned* bar = (unsigned*)(ws + WS_CTL);
  if (wv == 0 && lane_id() == 0) (void)xb_add(&bar[XB_XCNT(xb_xcc_id())], 1u);
  for (int layer = 0; layer < 2; ++layer) {
    { ProbInProj pr; pr.so.init(NTOK, layer == 0 ? PM_AB : PM_CD, G, bid); pr.A = (const char*)(ws + WS_HB); pr.Bt = (const char*)(ws + (layer == 0 ? WS_WIN_AB : WS_WIN_CD));
      pr.P = (bf16_t*)(ws + WS_R1); pr.bias = p.in[layer == 0 ? I_AB_B_IN : I_CD_B_IN]; pr.lb = (const float*)(ws + WS_LB); pr.layer = layer;
      pg8::gemm_phase(lds, pr, wv);
#if (PROBE_DUP & 1)
      pg8::gemm_phase(lds, pr, wv);
#endif
      if (layer == 0) side_phase<32>(lds_raw, wv, p, 0); else side_phase<16>(lds_raw, wv, p, 1);
#if (PROBE_DUP & 256)
      if (layer == 0) side_phase<32>(lds_raw, wv, p, 0); else side_phase<16>(lds_raw, wv, p, 1);
#endif
 }
    grid_bar(bar, lds_raw, wv);
    if (layer == 1) { convd_phase(lds_raw, wv, p); grid_bar(bar, lds_raw, wv); }
    scan_phase2(lds_raw, wv, p, layer);
#if (PROBE_DUP & 2)
    scan_phase2(lds_raw, wv, p, layer);
#endif
#if (PROBE_DUP & 512)
    if (layer == 0) scan_phase2(lds_raw, wv, p, layer);
#endif
#if (PROBE_DUP & 1024)
    if (layer == 1) scan_phase2(lds_raw, wv, p, layer);
#endif
    grid_bar(bar, lds_raw, wv);
    headnorm_phase(lds_raw, wv, p, layer);
#if (PROBE_DUP & 8)
    headnorm_phase(lds_raw, wv, p, layer);
#endif
    grid_bar(bar, lds_raw, wv);
    { ProbOutProj pr; pr.so.init(NTOK, 1024, G, bid); pr.A = (const char*)(ws + WS_HB); pr.Bt = (const char*)(ws + (layer == 0 ? WS_WOUT_AB : WS_WOUT_CD)); pr.Y = (float*)(ws + WS_R2); pr.Hres = layer == 0 ? p.in[I_X] : p.out;
      pg8::gemm_phase(lds, pr, wv);
#if (PROBE_DUP & 1)
      pg8::gemm_phase(lds, pr, wv);
#endif
      moe_weight_convert(lds_raw, wv, p, layer);
#if (PROBE_DUP & 4)
      moe_weight_convert(lds_raw, wv, p, layer);
#endif
 }
    grid_bar(bar, lds_raw, wv);
#if (PROBE_DUP & 32)
    ln_phase(lds_raw, wv, p, layer, 0, 1);
#endif
    ln_phase(lds_raw, wv, p, layer, 0);
    grid_bar(bar, lds_raw, wv);
    { ProbMoe1 pr; pr.mo.init((const int*)((const unsigned*)(ws + WS_CTL) + CW_CNT(layer)), 8, G, bid, lds_raw, wv);
      pr.A = (const char*)(ws + WS_HB); pr.W13 = (const char*)(ws + WS_WMOE); pr.list = (const int*)(ws + WS_LIST) + (size_t)layer * NEXP * NTOK; pr.H = (bf16_t*)(ws + WS_H);
      pg8::gemm_phase(lds, pr, wv);
#if (PROBE_DUP & 1)
      pg8::gemm_phase(lds, pr, wv);
#endif
 }
    grid_bar(bar, lds_raw, wv);
    { ProbMoe2 pr; pr.mo.init((const int*)((const unsigned*)(ws + WS_CTL) + CW_CNT(layer)), 4, G, bid, lds_raw, wv);
      pr.A = (const char*)(ws + WS_H); pr.W2 = (const char*)(ws + WS_WMOE) + (size_t)NEXP * 2048 * 1024 * 2; pr.Y = (bf16_t*)(ws + WS_R2);
      pg8::gemm_phase(lds, pr, wv);
#if (PROBE_DUP & 1)
      pg8::gemm_phase(lds, pr, wv);
#endif
 }
    grid_bar(bar, lds_raw, wv);
#if (PROBE_DUP & 64)
    ln_phase(lds_raw, wv, p, layer, 1, 1);
#endif
    ln_phase(lds_raw, wv, p, layer, 1);
    if (layer == 0) grid_bar(bar, lds_raw, wv);
  }
}

extern "C" void kernel_launch(void* const* d_in, const int* in_sizes, int n_in, void* d_out, int out_size, void* d_ws, size_t ws_size, hipStream_t stream) {
  static int grid_blocks = 0;
  if (grid_blocks == 0) {
    if (n_in != N_IN || ws_size < WS_END || out_size != NTOK * 1024) { fprintf(stderr, "kernel_launch: bad shapes: n_in %d ws %zu (need %zu) out %d\n", n_in, ws_size, (size_t)WS_END, out_size); grid_blocks = -1; return; }
    int dev = 0, cus = 0, per_cu = 0;
    hipGetDevice(&dev); hipDeviceGetAttribute(&cus, hipDeviceAttributeMultiprocessorCount, dev);
    if (hipFuncSetAttribute((const void*)mk_fwd, hipFuncAttributeMaxDynamicSharedMemorySize, LDS_BYTES) != hipSuccess) { fprintf(stderr, "kernel_launch: hipFuncSetAttribute failed\n"); grid_blocks = -1; return; }
    if (hipOccupancyMaxActiveBlocksPerMultiprocessor(&per_cu, (const void*)mk_fwd, NTHREADS, LDS_BYTES) != hipSuccess || per_cu < 1) { fprintf(stderr, "kernel_launch: occupancy query failed (%d)\n", per_cu); grid_blocks = -1; return; }
    grid_blocks = cus;
    (void)in_sizes;
  }
  if (grid_blocks < 0) return;
  Params p{};
  for (int i = 0; i < N_IN; ++i) p.in[i] = (const float*)d_in[i];
  p.out = (float*)d_out; p.ws = (unsigned char*)d_ws;
  void* args[] = {&p};
  hipError_t e = hipLaunchCooperativeKernel((const void*)mk_fwd, dim3(grid_blocks), dim3(NTHREADS), args, LDS_BYTES, stream);
  if (e != hipSuccess) fprintf(stderr, "cooperative launch failed: %s (grid %d)\n", hipGetErrorString(e), grid_blocks);
}
#endif
#ifdef CPU_EMU
#include <vector>
void dbg_cmp(const char* name, const float* p, long n);
template <class F> static void run_functor(const F& f, long n) {
#pragma omp parallel for schedule(dynamic, 16)
  for (long g = 0; g < n; ++g) f(g);
}
static void cpu_round_w(const float* src, size_t n, std::vector<float>& dst) { dst.resize(n); for (size_t i = 0; i < n; ++i) dst[i] = bf2f(f2bf(src[i])); }

extern "C" void kernel_launch(void* const* d_in, const int* in_sizes, int n_in, void* d_out, int out_size, void* d_ws, size_t ws_size, hipStream_t) {
  (void)in_sizes; (void)n_in; (void)out_size;
  if (ws_size < WS_END) { printf("ws too small %zu < %zu\n", ws_size, (size_t)WS_END); return; }
  Params p{}; for (int i = 0; i < N_IN; ++i) p.in[i] = (const float*)d_in[i];
  p.out = (float*)d_out; p.ws = (unsigned char*)d_ws;
  unsigned char* ws = p.ws;
  bf16_t* HB = (bf16_t*)(ws + WS_HB); bf16_t* P = (bf16_t*)(ws + WS_R1); bf16_t* LFB = (bf16_t*)(ws + WS_LFB);
  bf16_t* O = (bf16_t*)(ws + WS_R2); float* yf = (float*)(ws + WS_R2); bf16_t* Y = (bf16_t*)(ws + WS_R2); bf16_t* H = (bf16_t*)(ws + WS_H);
  float* side = (float*)(ws + WS_SIDE); float* oside = (float*)(ws + WS_OSIDE); float* rope = (float*)(ws + WS_ROPE); float* lb = (float*)(ws + WS_LB);
  int* assign = (int*)(ws + WS_ASSIGN); float* gate = (float*)(ws + WS_GATE);
  for (size_t i = 0; i < (size_t)NTOK * 1024; ++i) HB[i] = f2bf(p.in[I_X][i]);
  for (int i = 0; i < SEQ * 32; ++i) { int t = i >> 5, f = i & 31; float freq = powf(10000.0f, -(float)f / 32.0f); float ang = (float)t * freq; rope[i * 2] = cosf(ang); rope[i * 2 + 1] = sinf(ang); }
  for (int cc = 0; cc < 512; ++cc) { const float* hl = p.in[I_HGRN_LB]; float a0 = hl[cc], a1 = hl[512 + cc], a2 = hl[1024 + cc]; float mx = fmaxf(a0, fmaxf(a1, a2));
    float e0 = expf(a0 - mx), e1 = expf(a1 - mx), e2 = expf(a2 - mx); lb[cc] = e0 / (e0 + e1 + e2); }
  std::vector<float> wr;
  for (int layer = 0; layer < 2; ++layer) {
    const int PW = layer == 0 ? P_AB : P_CD, PM = layer == 0 ? PM_AB : PM_CD;
    const float* bias = p.in[layer == 0 ? I_AB_B_IN : I_CD_B_IN];
    cpu_round_w(p.in[layer == 0 ? I_AB_W_IN : I_CD_W_IN], (size_t)1024 * PW, wr);
#pragma omp parallel for
    for (long tok = 0; tok < NTOK; ++tok) {
      std::vector<float> acc(PW, 0.f);
      for (int k = 0; k < 1024; ++k) { float a = bf2f(HB[tok * 1024 + k]); const float* w = &wr[(size_t)k * PW]; for (int n = 0; n < PW; ++n) acc[n] += a * w[n]; }
      for (int n = 0; n < PM; ++n) { float v = acc[n] + bias[n]; if (layer == 0) v = epi_ab(n, v, lb); P[tok * PSTRIDE + n] = f2bf(v); }
      for (int n = PM; n < PW; ++n) side[tok * 32 + (n - PM)] = acc[n] + bias[n];
      if (layer == 0) for (int dir = 0; dir < 2; ++dir) for (int cc = 0; cc < 256; ++cc) {
        float z = p.in[I_GK_B][dir * 256 + cc];
        for (int r = 0; r < 16; ++r) z += side[tok * 32 + dir * 16 + r] * p.in[I_GK_UP][(dir * 16 + r) * 256 + cc];
        LFB[tok * 512 + dir * 256 + cc] = f2bf(logsigmoidf_(z) * 0.0625f); }
    }
    if (layer == 0) { ScanAB2 s{}; s.P = P; s.LFB = LFB; s.O = O; run_functor(s, (long)BATCH * 2048); }
    else { PrepCD2 pc{}; pc.P = P; pc.QD = LFB; pc.rope = rope; pc.conv_w = p.in[I_CONV_W]; pc.conv_b = p.in[I_CONV_B]; run_functor(pc, (long)NTOK * 1280);
      ScanCD2 s{}; s.P = P; s.QD = LFB; s.side = side; s.fgate_b = p.in[I_FGATE_B]; s.O = O; s.oside = oside; run_functor(s, (long)BATCH * 2056); }
#pragma omp parallel for
    for (long tok = 0; tok < NTOK; ++tok) for (int h8 = 0; h8 < 8; ++h8) {
      float sf = 1.f, sb = 1.f;
      if (layer == 1 && h8 >= 4) { int h = h8 - 4; const float* s0 = oside + tok * 8 + h * 2; const float* s1 = oside + (size_t)(NTOK + tok) * 8 + h * 2;
        sf = 1.0f / fmaxf(fabsf(s0[0]), expf(-s0[1])); sb = 1.0f / fmaxf(fabsf(s1[0]), expf(-s1[1])); }
      float o[128]; float ss = 0.f;
      for (int j = 0; j < 128; ++j) { int c = h8 * 128 + j; o[j] = bf2f(O[tok * 1024 + c]) * sf + bf2f(O[(size_t)(NTOK + tok) * 1024 + c]) * sb; ss += o[j] * o[j]; }
      float r = 1.0f / sqrtf(ss * (1.0f / 128.0f) + NORM_EPS_F);
      for (int j = 0; j < 128; ++j) { int c = h8 * 128 + j; float gn, gt;
        if (layer == 0) { gn = h8 < 4 ? p.in[I_HGRN_NORM][c] : p.in[I_GLA_NORM][c - 512]; gt = siluf_(bf2f(P[tok * PSTRIDE + (h8 < 4 ? 2048 + c : 3584 + c - 512)])); }
        else { gn = h8 < 4 ? p.in[I_RET_NORM][c] : p.in[I_MLSTM_NORM][c - 512]; float gr = bf2f(P[tok * PSTRIDE + (h8 < 4 ? 1024 + c : 3072 + c - 512)]); gt = h8 < 4 ? siluf_(gr) : sigmoidf_(gr); }
        HB[tok * 1024 + c] = f2bf(o[j] * r * gn * gt); }
    }
    cpu_round_w(p.in[layer == 0 ? I_AB_W_OUT : I_CD_W_OUT], (size_t)1024 * 1024, wr);
#pragma omp parallel for
    for (long tok = 0; tok < NTOK; ++tok) { std::vector<float> acc(1024, 0.f);
      for (int k = 0; k < 1024; ++k) { float a = bf2f(HB[tok * 1024 + k]); const float* w = &wr[(size_t)k * 1024]; for (int n = 0; n < 1024; ++n) acc[n] += a * w[n]; }
      for (int n = 0; n < 1024; ++n) yf[tok * 1024 + n] = acc[n]; }
    dbg_cmp(layer == 0 ? "y_mix0" : "y_mix1", yf, (long)NTOK * 1024);
    int cnt[NEXP] = {0}; std::vector<int> list((size_t)NEXP * NTOK);
    const float* hin = layer == 0 ? p.in[I_X] : p.out;
    for (long tok = 0; tok < NTOK; ++tok) {
      float v[1024]; double s = 0; for (int c = 0; c < 1024; ++c) { v[c] = ALPHA_F * hin[tok * 1024 + c] + yf[tok * 1024 + c]; s += v[c]; }
      float mean = (float)(s / 1024); double q = 0; for (int c = 0; c < 1024; ++c) { v[c] -= mean; q += (double)v[c] * v[c]; }
      float r = 1.0f / sqrtf((float)(q / 1024) + LN_EPS_F);
      float lg[16] = {0};
      for (int c = 0; c < 1024; ++c) { v[c] = v[c] * r * p.in[I_LN_MIX_G][layer * 1024 + c] + p.in[I_LN_MIX_B][layer * 1024 + c]; p.out[tok * 1024 + c] = v[c]; HB[tok * 1024 + c] = f2bf(v[c]);
        for (int e = 0; e < 16; ++e) lg[e] += v[c] * p.in[I_ROUTER_W][c * 16 + e]; }
      int eo[2]; float go[2]; route_from_logits(lg, p.in[I_ROUTER_B], eo, go);
      int r1 = cnt[eo[0]]++, r2 = cnt[eo[1]]++;
      list[(size_t)eo[0] * NTOK + r1] = (int)tok; list[(size_t)eo[1] * NTOK + r2] = (int)tok;
      assign[tok * 4] = eo[0]; assign[tok * 4 + 1] = r1; assign[tok * 4 + 2] = eo[1]; assign[tok * 4 + 3] = r2; gate[tok * 2] = go[0]; gate[tok * 2 + 1] = go[1];
    }
    dbg_cmp(layer == 0 ? "h_mix0" : "h_mix1", p.out, (long)NTOK * 1024);
    int pad[NEXP]; { int a = 0; for (int e = 0; e < NEXP; ++e) { pad[e] = a; a += ((cnt[e] + 255) >> 8) << 8; } }
    const size_t lo = (size_t)layer * NEXP * 1024 * 1024;
    for (int e = 0; e < NEXP; ++e) {
      std::vector<float> w1, w3, w2; cpu_round_w(p.in[I_MOE_W1] + lo + (size_t)e * 1048576, 1048576, w1); cpu_round_w(p.in[I_MOE_W3] + lo + (size_t)e * 1048576, 1048576, w3); cpu_round_w(p.in[I_MOE_W2] + lo + (size_t)e * 1048576, 1048576, w2);
#pragma omp parallel for
      for (int rr = 0; rr < cnt[e]; ++rr) { int tok = list[(size_t)e * NTOK + rr]; size_t pos = pad[e] + rr;
        std::vector<float> a1(1024, 0.f), a3(1024, 0.f), a2(1024, 0.f);
        for (int k = 0; k < 1024; ++k) { float a = bf2f(HB[(size_t)tok * 1024 + k]); const float* p1 = &w1[(size_t)k * 1024]; const float* p3 = &w3[(size_t)k * 1024]; for (int n = 0; n < 1024; ++n) { a1[n] += a * p1[n]; a3[n] += a * p3[n]; } }
        for (int n = 0; n < 1024; ++n) H[pos * 1024 + n] = f2bf(siluf_(a1[n]) * a3[n]);
        for (int k = 0; k < 1024; ++k) { float a = bf2f(H[pos * 1024 + k]); const float* p2 = &w2[(size_t)k * 1024]; for (int n = 0; n < 1024; ++n) a2[n] += a * p2[n]; }
        for (int n = 0; n < 1024; ++n) Y[pos * 1024 + n] = f2bf(a2[n]); }
    }
    for (long tok = 0; tok < NTOK; ++tok) {
      size_t p0 = pad[assign[tok * 4]] + assign[tok * 4 + 1], p1 = pad[assign[tok * 4 + 2]] + assign[tok * 4 + 3];
      float v[1024]; double s = 0; for (int c = 0; c < 1024; ++c) { v[c] = ALPHA_F * p.out[tok * 1024 + c] + gate[tok * 2] * bf2f(Y[p0 * 1024 + c]) + gate[tok * 2 + 1] * bf2f(Y[p1 * 1024 + c]); s += v[c]; }
      float mean = (float)(s / 1024); double q = 0; for (int c = 0; c < 1024; ++c) { v[c] -= mean; q += (double)v[c] * v[c]; }
      float r = 1.0f / sqrtf((float)(q / 1024) + LN_EPS_F);
      for (int c = 0; c < 1024; ++c) { v[c] = v[c] * r * p.in[I_LN_FFN_G][layer * 1024 + c] + p.in[I_LN_FFN_B][layer * 1024 + c]; p.out[tok * 1024 + c] = v[c]; HB[tok * 1024 + c] = f2bf(v[c]); }
    }
    dbg_cmp(layer == 0 ? "h_ffn0" : "h_ffn1", p.out, (long)NTOK * 1024);
  }
}
#endif
```

```cpp
#ifdef CPU_EMU
#include <cmath>
#include <cstdio>
#include <cstring>
#include <cstdlib>
#include <cstddef>
#define DEV
#define DEV_INLINE static inline
typedef void* hipStream_t;
#else
#include <hip/hip_runtime.h>
#include <hip/hip_bf16.h>
#include <cstdio>
#define DEV __device__ __forceinline__
#define DEV_INLINE __device__ __forceinline__
#endif
#ifndef PROBE_DUP
#define PROBE_DUP 0
#endif
#ifndef BATCH
#define BATCH 4
#endif
#ifndef SEQ
#define SEQ 8192
#endif
#define DM 1024
#define NTOK (BATCH * SEQ)
#define P_AB 4128
#define P_CD 3600
#define PM_AB 4096
#define PM_CD 3584
#define NEXP 16
#define ALPHA_F 1.4142135623730951f
#define LN_EPS_F 1e-5f
#define NORM_EPS_F 1e-6f
#define HROWS (2 * NTOK + NEXP * 256)

typedef unsigned short bf16_t;

DEV_INLINE float bf2f(bf16_t b) { unsigned u = ((unsigned)b) << 16; float f; memcpy(&f, &u, 4); return f; }
DEV_INLINE bf16_t f2bf(float f) { unsigned u; memcpy(&u, &f, 4); u += 0x7FFFu + ((u >> 16) & 1u); return (bf16_t)(u >> 16); }
DEV_INLINE float sigmoidf_(float x) { return 1.0f / (1.0f + expf(-x)); }
DEV_INLINE float siluf_(float x) { return x / (1.0f + expf(-x)); }
DEV_INLINE float logsigmoidf_(float x) { return fminf(x, 0.0f) - log1pf(expf(-fabsf(x))); }

#define AL256(x) (((size_t)(x) + 255) & ~(size_t)255)
#define WS_CTL    ((size_t)0)
#define WS_HB     ((size_t)65536)
#define WS_R1     (WS_HB + (size_t)NTOK * 1024 * 2)
#define R1_P_BYTES ((size_t)NTOK * 4096 * 2)
#define R1_MIN    (AL256((size_t)HROWS * 1024 * 2) + (size_t)NEXP * 3072 * 1024 * 2)
#define R1_PL     (R1_P_BYTES + (size_t)NTOK * 512 * 2)
#define R1_BYTES  (R1_PL > R1_MIN ? R1_PL : R1_MIN)
#define WS_LFB    (WS_R1 + R1_P_BYTES)
#define WS_H      (WS_R1)
#define WS_WMOE   (WS_R1 + AL256((size_t)HROWS * 1024 * 2))
#define WMOE_BYTES ((size_t)NEXP * 3072 * 1024 * 2)
#define WS_R2     (WS_R1 + R1_BYTES)
#define R2_BYTES  ((size_t)HROWS * 1024 * 2 > (size_t)NTOK * 1024 * 4 ? (size_t)HROWS * 1024 * 2 : (size_t)NTOK * 1024 * 4)
#define WS_SIDE   (WS_R2 + AL256(R2_BYTES))
#define WS_OSIDE  (WS_SIDE + (size_t)NTOK * 32 * 4)
#define WS_WIN_AB (WS_OSIDE + (size_t)2 * NTOK * 8 * 4)
#define WS_WIN_CD (WS_WIN_AB + (size_t)4128 * 1024 * 2)
#define WS_WOUT_AB (WS_WIN_CD + (size_t)3600 * 1024 * 2)
#define WS_WOUT_CD (WS_WOUT_AB + (size_t)1024 * 1024 * 2)
#define WS_ROPE   (WS_WOUT_CD + (size_t)1024 * 1024 * 2)
#define WS_LB     (WS_ROPE + (size_t)SEQ * 64 * 4)
#define WS_LIST   (WS_LB + 4096)
#define WS_ASSIGN (WS_LIST + (size_t)2 * NEXP * NTOK * 4)
#define WS_GATE   (WS_ASSIGN + (size_t)NTOK * 16)
#define WS_END    (WS_GATE + (size_t)NTOK * 8)
#define CW_CNT(layer) (64 + 256 * (layer))

#define PSTRIDE 4096
#define PIDX(tok, col) ((((size_t)((col) >> 7)) * NTOK + (size_t)(tok)) * 128 + (size_t)((col) & 127))

enum { I_X, I_AB_W_IN, I_AB_B_IN, I_HGRN_LB, I_GK_UP, I_GK_B, I_HGRN_NORM, I_GLA_NORM, I_AB_W_OUT,
       I_CD_W_IN, I_CD_B_IN, I_CONV_W, I_CONV_B, I_FGATE_B, I_RET_NORM, I_MLSTM_NORM, I_CD_W_OUT,
       I_LN_MIX_G, I_LN_MIX_B, I_LN_FFN_G, I_LN_FFN_B, I_ROUTER_W, I_ROUTER_B, I_MOE_W1, I_MOE_W3, I_MOE_W2, N_IN };

struct Params {
  const float* in[N_IN];
  float* out;
  unsigned char* ws;
};

DEV_INLINE float epi_ab(int col, float v, const float* lb) {
  if (col < 512) return siluf_(v);
  if (col < 1536) { float l = lb[(col - 512) & 511]; return logf(l + (1.0f - l) * sigmoidf_(v)); }
  if (col >= 2560 && col < 2816) return v * 0.125f;
  return v;
}

DEV_INLINE void route_from_logits(const float* lg, const float* rb, int* e_out, float* g_out) {
  float mx = lg[0];
#pragma unroll
  for (int e = 1; e < 16; ++e) mx = fmaxf(mx, lg[e]);
  float sc[16]; float sum = 0.f;
#pragma unroll
  for (int e = 0; e < 16; ++e) { sc[e] = expf(lg[e] - mx); sum += sc[e]; }
  float inv = 1.0f / sum;
  float best_gs = -1e30f; int be1 = 0, be2 = 1; float bs1 = 0.f, bs2 = 0.f;
#pragma unroll
  for (int gq = 0; gq < 4; ++gq) {
    float m1 = -1e30f, m2 = -1e30f, s1 = 0.f, s2 = 0.f; int i1 = 0, i2 = 0;
#pragma unroll
    for (int i = 0; i < 4; ++i) {
      float s = sc[gq * 4 + i] * inv; float v = s + rb[gq * 4 + i];
      if (v > m1) { m2 = m1; i2 = i1; s2 = s1; m1 = v; i1 = gq * 4 + i; s1 = s; }
      else if (v > m2) { m2 = v; i2 = gq * 4 + i; s2 = s; }
    }
    float gs = m1 + m2;
    if (gs > best_gs) { best_gs = gs; be1 = i1; be2 = i2; bs1 = s1; bs2 = s2; }
  }
  e_out[0] = be1; e_out[1] = be2; g_out[0] = bs1 / (bs1 + bs2); g_out[1] = bs2 / (bs1 + bs2);
}
struct ScanAB2 {
  const bf16_t* P; const bf16_t* LFB; bf16_t* O;
  DEV void operator()(long gid) const {
    int j = (int)(gid & 127), h = (int)((gid >> 7) & 3), dir = (int)((gid >> 9) & 1), mixer = (int)((gid >> 10) & 1), b = (int)(gid >> 11);
    bf16_t* Od = O + (size_t)dir * NTOK * 1024;
    if (mixer == 0) {
      float S[128];
#pragma unroll
      for (int d = 0; d < 128; ++d) S[d] = 0.f;
      for (int s = 0; s < SEQ; ++s) {
        size_t t = (size_t)b * SEQ + (dir ? (SEQ - 1 - s) : s);
        const bf16_t* row = P + t * PSTRIDE;
        const bf16_t* q = row + h * 128; const bf16_t* lf = row + 512 + dir * 512 + h * 128;
        float v = bf2f(row[1536 + h * 128 + j]);
        float o = 0.f;
#pragma unroll
        for (int d = 0; d < 128; ++d) { float fd = expf(bf2f(lf[d])); S[d] = fd * S[d] + (1.0f - fd) * v; o += bf2f(q[d]) * S[d]; }
        Od[t * 1024 + h * 128 + j] = f2bf(o);
      }
    } else {
      float S[64];
#pragma unroll
      for (int d = 0; d < 64; ++d) S[d] = 0.f;
      for (int s = 0; s < SEQ; ++s) {
        size_t t = (size_t)b * SEQ + (dir ? (SEQ - 1 - s) : s);
        const bf16_t* row = P + t * PSTRIDE;
        const bf16_t* q = row + 2560 + h * 64; const bf16_t* k = row + 2816 + h * 64;
        const bf16_t* lf = LFB + t * 512 + dir * 256 + h * 64;
        float v = bf2f(row[3072 + h * 128 + j]);
        float o = 0.f;
#pragma unroll
        for (int d = 0; d < 64; ++d) { S[d] = expf(bf2f(lf[d])) * S[d] + bf2f(k[d]) * v; o += bf2f(q[d]) * S[d]; }
        Od[t * 1024 + 512 + h * 128 + j] = f2bf(o);
      }
    }
  }
};

struct PrepCD2 {
  bf16_t* P; bf16_t* QD; const float* rope; const float* conv_w; const float* conv_b;
  DEV void operator()(long gid) const {
    size_t tok = (size_t)(gid / 1280); int c = (int)(gid % 1280); int t = (int)(tok % SEQ);
    bf16_t* row = P + tok * PSTRIDE;
    if (c < 256) {
      int isk = c >> 7, hh = (c >> 5) & 3, i = c & 31;
      float cs = rope[(t * 32 + i) * 2], sn = rope[(t * 32 + i) * 2 + 1];
      bf16_t* base = row + isk * 256 + hh * 64;
      float a1 = bf2f(base[i]), a2 = bf2f(base[i + 32]);
      float sc = isk ? 1.0f : 0.125f;
      base[i] = f2bf((a1 * cs - a2 * sn) * sc); base[i + 32] = f2bf((a1 * sn + a2 * cs) * sc);
    } else {
      int cc = c - 256;
      float acc = conv_b[cc] + bf2f(row[1536 + cc]) * conv_w[1024 + cc];
      if (t > 0) acc += bf2f(row[1536 + cc - PSTRIDE]) * conv_w[cc];
      if (t < SEQ - 1) acc += bf2f(row[1536 + cc + PSTRIDE]) * conv_w[2048 + cc];
      float s = siluf_(acc);
      if (cc < 512) QD[tok * 512 + cc] = f2bf(s * 0.08838834764831845f);
      else row[3584 + (cc - 512)] = f2bf(s);
    }
  }
};

struct ScanCD2 {
  const bf16_t* P; const bf16_t* QD; const float* side; const float* fgate_b; bf16_t* O; float* oside;
  DEV void operator()(long gid) const {
    int b = (int)(gid / 2056); int g = (int)(gid % 2056);
    if (g < 1024) {
      int j = g & 127, h = (g >> 7) & 3, dir = (g >> 9) & 1;
      bf16_t* Od = O + (size_t)dir * NTOK * 1024;
      float gamma = 1.0f - exp2f(-(5.0f + 2.0f * (float)h + (float)dir));
      float S[64];
#pragma unroll
      for (int d = 0; d < 64; ++d) S[d] = 0.f;
      for (int s = 0; s < SEQ; ++s) {
        size_t t = (size_t)b * SEQ + (dir ? (SEQ - 1 - s) : s);
        const bf16_t* row = P + t * PSTRIDE;
        const bf16_t* q = row + h * 64; const bf16_t* k = row + 256 + h * 64;
        float v = bf2f(row[512 + h * 128 + j]);
        float o = 0.f;
#pragma unroll
        for (int d = 0; d < 64; ++d) { S[d] = gamma * S[d] + bf2f(k[d]) * v; o += bf2f(q[d]) * S[d]; }
        Od[t * 1024 + h * 128 + j] = f2bf(o);
      }
    } else {
      g -= 1024;
      int j = g % 129, h = (g / 129) & 3, dir = g / (129 * 4);
      bf16_t* Od = O + (size_t)dir * NTOK * 1024; float* os = oside + (size_t)dir * NTOK * 8;
      float fb = fgate_b[dir * 4 + h];
      float S[128];
#pragma unroll
      for (int d = 0; d < 128; ++d) S[d] = 0.f;
      float m = 0.f;
      for (int s = 0; s < SEQ; ++s) {
        size_t t = (size_t)b * SEQ + (dir ? (SEQ - 1 - s) : s);
        const bf16_t* row = P + t * PSTRIDE;
        const bf16_t* q = QD + t * 512 + h * 128; const bf16_t* k = row + 3584 + h * 128;
        float v = (j < 128) ? bf2f(row[2560 + h * 128 + j]) : 1.0f;
        float li = side[t * 32 + dir * 8 + h];
        float lf = logsigmoidf_(side[t * 32 + dir * 8 + 4 + h] + fb);
        float mn = fmaxf(lf + m, li);
        float fs = expf(lf + m - mn), is = expf(li - mn) * v;
        m = mn;
        float o = 0.f;
#pragma unroll
        for (int d = 0; d < 128; ++d) { S[d] = fs * S[d] + is * bf2f(k[d]); o += bf2f(q[d]) * S[d]; }
        if (j < 128) Od[t * 1024 + 512 + h * 128 + j] = f2bf(o);
        else { os[t * 8 + h * 2] = o; os[t * 8 + h * 2 + 1] = m; }
      }
    }
  }
};
#ifndef CPU_EMU
namespace pg8 {
#define PG8_LAS __attribute__((address_space(3)))
typedef short bf16x8 __attribute__((ext_vector_type(8)));
typedef float f32x4 __attribute__((ext_vector_type(4)));
typedef unsigned u32x4 __attribute__((ext_vector_type(4)));
typedef unsigned u32x2 __attribute__((ext_vector_type(2)));
constexpr int BM = 256, BK = 64, HALF = 128, HTB = HALF * BK * 2, STAGE_BYTES = 8 * HTB, NXCD = 8, WGM = 8, GK = 1024;

__device__ __forceinline__ int lds_byte(int r, int c) { const int st = (r >> 4) * 2 + (c >> 5), rr = r & 15, cc = c & 31, ob = rr * 64 + cc * 2; return st * 1024 + (ob ^ (((ob >> 9) & 1) << 5)); }
__device__ __forceinline__ void stage_rc(int b, int& R, int& C) { const int st = b / 1024, sb = b % 1024, swz = sb ^ (((sb >> 9) & 1) << 5); R = (st >> 1) * 16 + swz / 64; C = (st & 1) * 32 + (swz % 64) / 2; }
__device__ __forceinline__ int perm32(int rho) { const int n = rho >> 4, i = rho & 15; return 8 * (i >> 2) + 4 * n + (i & 3); }
__device__ __forceinline__ unsigned cvt_pk_bf16(float lo, float hi) { unsigned r; asm volatile("v_cvt_pk_bf16_f32 %0, %1, %2" : "=v"(r) : "v"(lo), "v"(hi)); return r; }

struct Unit { int pm, pn, e, row0, ne, ui; };

struct StaticOrder {
  int nM, nN, nwg, G, c;
  __device__ void init(int M, int N, int G_, int c_) { nM = M / BM; nN = N / BM; nwg = nM * nN; G = G_; c = c_; }
  __device__ bool next(int i, Unit& u) const {
    const long L = (long)i * G + c; if (L >= nwg) return false;
    int wgid = (int)L; { const int q = nwg / NXCD, r = nwg % NXCD, xcd = wgid % NXCD, off = wgid / NXCD; wgid = (xcd < r ? xcd * (q + 1) : r * (q + 1) + (xcd - r) * q) + off; }
    const int nig = WGM * nN, gid = wgid / nig, fm = gid * WGM, gsz = (nM - fm) < WGM ? (nM - fm) : WGM;
    u.pm = fm + ((wgid % nig) % gsz); u.pn = (wgid % nig) / gsz; u.e = 0; u.row0 = u.pm * BM; u.ne = 0; u.ui = i; return true;
  }
};

template <class Prob>
__device__ __forceinline__ void gemm_phase(PG8_LAS unsigned char* lds, const Prob& S, int wv) {
  int wv_ = wv; asm volatile("" : "+s"(wv_));
  int l_; asm volatile("v_mbcnt_lo_u32_b32 %0, -1, 0\n\tv_mbcnt_hi_u32_b32 %0, -1, %0" : "=v"(l_));
  int tid_ = wv_ * 64 + l_;
  const int tid = tid_, wid = __builtin_amdgcn_readfirstlane(tid >> 6), lane = tid & 63, wr = wid >> 2, wc = wid & 3, fr = lane & 15, fq = lane >> 4;
  constexpr int K = GK, nt = K / BK;
  int sR[2], sC[2]; unsigned voffB[2];
#pragma unroll
  for (int i = 0; i < 2; ++i) { int R, C; stage_rc(tid * 16 + i * 8192, R, C); sR[i] = R; sC[i] = C; const int Rb = Prob::PERM ? ((R & ~31) + perm32(R & 31)) : R; voffB[i] = (unsigned)(Rb * K + C) * 2u; }
  const size_t kstep = (size_t)(BK * 2);
  const size_t hstep = (size_t)HALF * K * 2;
  const unsigned ldsw = (unsigned)wid * 1024u;
  const int aoff = lds_byte(wr * 64 + fr, fq * 8), boff = lds_byte(wc * 32 + fr, fq * 8);
#define PG8_SA(b, h) (((b) * 2 + (h)) * HTB)
#define PG8_SB(b, h) ((4 + (b) * 2 + (h)) * HTB)
#define PG8_STAGE(bufoff, gbase, voff) do { _Pragma("unroll") for (int _i = 0; _i < 2; ++_i) \
    __builtin_amdgcn_global_load_lds((const unsigned*)((const char*)(gbase) + (voff)[_i]), (PG8_LAS unsigned*)(lds + (bufoff) + ldsw + _i * 8192), 16, 0, 0); } while (0)
#define PG8_LDA(dst, b, h) do { _Pragma("unroll") for (int m = 0; m < 4; ++m) _Pragma("unroll") for (int k = 0; k < 2; ++k) dst[m][k] = *(const PG8_LAS bf16x8*)(lds + PG8_SA(b, h) + aoff + m * 2048 + k * 1024); } while (0)
#define PG8_LDB(dst, b, h) do { _Pragma("unroll") for (int n = 0; n < 2; ++n) _Pragma("unroll") for (int k = 0; k < 2; ++k) dst[n][k] = *(const PG8_LAS bf16x8*)(lds + PG8_SB(b, h) + boff + n * 2048 + k * 1024); } while (0)
#define PG8_MMA(ai, bj, At, Bt) do { __builtin_amdgcn_s_setprio(1); _Pragma("unroll") for (int m = 0; m < 4; ++m) _Pragma("unroll") for (int n = 0; n < 2; ++n) _Pragma("unroll") for (int k = 0; k < 2; ++k) \
    acc[ai][bj][m][n] = __builtin_amdgcn_mfma_f32_16x16x32_bf16(Bt[n][k], At[m][k], acc[ai][bj][m][n], 0, 0, 0); __builtin_amdgcn_s_setprio(0); } while (0)
#define PG8_WAIT_V(n) asm volatile("s_waitcnt vmcnt(" #n ")" ::: "memory")
#define PG8_WAIT_L(n) asm volatile("s_waitcnt lgkmcnt(" #n ")" ::: "memory")
#define PG8_BAR __builtin_amdgcn_s_barrier()
#define PG8_SCHED __builtin_amdgcn_sched_barrier(0)
  Unit cur, nxt; int ui = 0;
  if (!S.next(0, cur)) return;
  f32x4 acc[2][2][4][2];
#pragma unroll
  for (int a = 0; a < 2; ++a)
#pragma unroll
    for (int b = 0; b < 2; ++b)
#pragma unroll
      for (int m = 0; m < 4; ++m)
#pragma unroll
        for (int n = 0; n < 2; ++n) acc[a][b][m][n] = (f32x4){0.f, 0.f, 0.f, 0.f};
  bf16x8 At[4][2], B0[2][2], B1[2][2];
  unsigned oc0[2], oc1[2], on0[2], on1[2];
#pragma unroll
  for (int i = 0; i < 2; ++i) { oc0[i] = S.a_off(cur, sR[i]) + (unsigned)sC[i] * 2u; oc1[i] = S.a_off(cur, HALF + sR[i]) + (unsigned)sC[i] * 2u; }
  const char* const Ab = S.a_base();
  const char* cB = S.b_base(cur);
  PG8_STAGE(PG8_SB(0, 0), cB, voffB); PG8_STAGE(PG8_SB(0, 1), cB + hstep, voffB); PG8_STAGE(PG8_SA(0, 0), Ab, oc0); PG8_STAGE(PG8_SA(0, 1), Ab, oc1);
  if (wr == 1) PG8_BAR;
  PG8_WAIT_V(2); PG8_BAR;
  PG8_STAGE(PG8_SB(1, 0), cB + kstep, voffB); PG8_STAGE(PG8_SA(1, 0), Ab + kstep, oc0); PG8_STAGE(PG8_SB(1, 1), cB + hstep + kstep, voffB);
  PG8_WAIT_V(6); PG8_BAR;
  for (;;) {
    const bool has_next = S.next(ui + 1, nxt);
    const char* nB = cB;
    if (has_next) {
      nB = S.b_base(nxt);
      int l2_; asm volatile("v_mbcnt_lo_u32_b32 %0, -1, 0\n\tv_mbcnt_hi_u32_b32 %0, -1, %0" : "=v"(l2_));
      const int tid2 = wid * 64 + l2_;
#pragma unroll
      for (int i = 0; i < 2; ++i) { int R, C; stage_rc(tid2 * 16 + i * 8192, R, C); on0[i] = S.a_off(nxt, R) + (unsigned)C * 2u; on1[i] = S.a_off(nxt, HALF + R) + (unsigned)C * 2u; }
    } else {
#pragma unroll
      for (int i = 0; i < 2; ++i) { on0[i] = oc0[i]; on1[i] = oc1[i]; }
    }
    for (int t = 0; t < nt; t += 2) {
      const bool last = (t == nt - 2);
      const char* a1 = Ab + (size_t)(t + 1) * kstep;
      const char* a2 = last ? Ab : Ab + (size_t)(t + 2) * kstep; const char* b2 = last ? nB : cB + (size_t)(t + 2) * kstep;
      const char* a3 = a2 + kstep; const char* b3 = b2 + kstep;
      unsigned o20[2], o21[2];
#pragma unroll
      for (int i = 0; i < 2; ++i) { o20[i] = last ? on0[i] : oc0[i]; o21[i] = last ? on1[i] : oc1[i]; }
      PG8_LDB(B0, 0, 0); PG8_LDB(B1, 0, 1); PG8_SCHED; PG8_LDA(At, 0, 0); PG8_STAGE(PG8_SA(1, 1), a1, oc1);
      PG8_WAIT_V(8); PG8_WAIT_L(0); PG8_BAR; PG8_MMA(0, 0, At, B0); PG8_MMA(0, 1, At, B1); PG8_BAR; PG8_SCHED;
      PG8_LDA(At, 0, 1); PG8_STAGE(PG8_SB(0, 0), b2, voffB); PG8_STAGE(PG8_SB(0, 1), b2 + hstep, voffB); PG8_STAGE(PG8_SA(0, 0), a2, o20);
      PG8_WAIT_V(8); PG8_WAIT_L(0); PG8_BAR; PG8_MMA(1, 0, At, B0); PG8_MMA(1, 1, At, B1); PG8_BAR; PG8_SCHED;
      PG8_LDB(B0, 1, 0); PG8_LDB(B1, 1, 1); PG8_SCHED; PG8_LDA(At, 1, 0); PG8_STAGE(PG8_SA(0, 1), a2, o21);
      PG8_WAIT_V(8); PG8_WAIT_L(0); PG8_BAR; PG8_MMA(0, 0, At, B0); PG8_MMA(0, 1, At, B1); PG8_BAR; PG8_SCHED;
      PG8_LDA(At, 1, 1); PG8_STAGE(PG8_SB(1, 0), b3, voffB); PG8_STAGE(PG8_SB(1, 1), b3 + hstep, voffB); PG8_STAGE(PG8_SA(1, 0), a3, o20);
      PG8_WAIT_V(8); PG8_WAIT_L(0); PG8_BAR; PG8_MMA(1, 0, At, B0); PG8_MMA(1, 1, At, B1); PG8_BAR; PG8_SCHED;
    }
    if (wr == 0) PG8_BAR;
    { int l3_; asm volatile("v_mbcnt_lo_u32_b32 %0, -1, 0\n\tv_mbcnt_hi_u32_b32 %0, -1, %0" : "=v"(l3_));
      S.epi(acc, cur, wr, wc, l3_ & 15, l3_ >> 4); }
    if (!has_next) break;
#pragma unroll
    for (int a = 0; a < 2; ++a)
#pragma unroll
      for (int b = 0; b < 2; ++b)
#pragma unroll
        for (int m = 0; m < 4; ++m)
#pragma unroll
          for (int n = 0; n < 2; ++n) acc[a][b][m][n] = (f32x4){0.f, 0.f, 0.f, 0.f};
    cur = nxt; cB = nB; ++ui;
#pragma unroll
    for (int i = 0; i < 2; ++i) { oc0[i] = on0[i]; oc1[i] = on1[i]; }
    if (wr == 1) PG8_BAR;
  }
  PG8_WAIT_V(0);
  PG8_BAR;
#undef PG8_SA
#undef PG8_SB
#undef PG8_STAGE
#undef PG8_LDA
#undef PG8_LDB
#undef PG8_MMA
#undef PG8_WAIT_V
#undef PG8_WAIT_L
#undef PG8_BAR
#undef PG8_SCHED
}
}
#endif
#ifndef CPU_EMU
#include <hip/hip_cooperative_groups.h>
namespace cg = cooperative_groups;
#define LAS __attribute__((address_space(3)))
#define NTHREADS 512
#define LDS_BYTES (154 * 1024)
typedef float f32x4 __attribute__((ext_vector_type(4)));
typedef short bf16x8 __attribute__((ext_vector_type(8)));
typedef unsigned u32x4 __attribute__((ext_vector_type(4)));
typedef unsigned u32x2 __attribute__((ext_vector_type(2)));

struct Ctx { int tid, lane, wid, G, bid; unsigned char* lds; };
__device__ __forceinline__ int lane_id() { int l; asm volatile("v_mbcnt_lo_u32_b32 %0, -1, 0\n\tv_mbcnt_hi_u32_b32 %0, -1, %0" : "=v"(l)); return l; }
__device__ __forceinline__ int opaque_tid(int wv) { int w = wv; asm volatile("" : "+s"(w)); int t = w * 64 + lane_id(); asm volatile("" : "+v"(t)); return t; }
__device__ __forceinline__ Ctx make_ctx(unsigned char* lds, int wv) { Ctx c; c.tid = opaque_tid(wv); c.lane = c.tid & 63; c.wid = __builtin_amdgcn_readfirstlane(c.tid >> 6); c.G = gridDim.x; c.bid = blockIdx.x; c.lds = lds; return c; }

__device__ __forceinline__ float wave_sum(float x) {
  x += __builtin_bit_cast(float, __builtin_amdgcn_update_dpp(0, __builtin_bit_cast(int, x), 0x111, 0xf, 0xf, false));
  x += __builtin_bit_cast(float, __builtin_amdgcn_update_dpp(0, __builtin_bit_cast(int, x), 0x112, 0xf, 0xf, false));
  x += __builtin_bit_cast(float, __builtin_amdgcn_update_dpp(0, __builtin_bit_cast(int, x), 0x114, 0xf, 0xf, false));
  x += __builtin_bit_cast(float, __builtin_amdgcn_update_dpp(0, __builtin_bit_cast(int, x), 0x118, 0xf, 0xf, false));
  x += __builtin_bit_cast(float, __builtin_amdgcn_update_dpp(0, __builtin_bit_cast(int, x), 0x142, 0xa, 0xf, false));
  x += __builtin_bit_cast(float, __builtin_amdgcn_update_dpp(0, __builtin_bit_cast(int, x), 0x143, 0xc, 0xf, false));
  return __builtin_bit_cast(float, __builtin_amdgcn_readlane(__builtin_bit_cast(int, x), 63));
}
__device__ __forceinline__ float fsigmoid(float x) { return __builtin_amdgcn_rcpf(1.0f + __builtin_amdgcn_exp2f(-1.4426950408889634f * x)); }
__device__ __forceinline__ float fsilu(float x) { return x * fsigmoid(x); }
__device__ __forceinline__ float flog2sigmoid(float x) { const float y = x * 1.4426950408889634f; return fminf(y, 0.f) - __builtin_amdgcn_logf(1.0f + __builtin_amdgcn_exp2f(-fabsf(y))); }
typedef float f32x2_t __attribute__((ext_vector_type(2)));
typedef __bf16 bf16x2_t __attribute__((ext_vector_type(2)));
__device__ __forceinline__ unsigned pk_hw(float a, float b) { const f32x2_t v = {a, b}; return __builtin_bit_cast(unsigned, __builtin_convertvector(v, bf16x2_t)); }
__device__ __forceinline__ unsigned pk2(float a, float b) { return pk_hw(a, b); }
__device__ __forceinline__ void unpack8(u32x4 w, float* f) {
  f[0] = __uint_as_float(w.x << 16); f[1] = __uint_as_float(w.x & 0xffff0000u); f[2] = __uint_as_float(w.y << 16); f[3] = __uint_as_float(w.y & 0xffff0000u);
  f[4] = __uint_as_float(w.z << 16); f[5] = __uint_as_float(w.z & 0xffff0000u); f[6] = __uint_as_float(w.w << 16); f[7] = __uint_as_float(w.w & 0xffff0000u);
}

__device__ __forceinline__ void transpose_job(const Ctx& c, const float* src, int N, bf16_t* dst, int rs, int ro, int tile0, int tile_stride) {
  float* t = (float*)c.lds;
  const int ntn = (N + 63) / 64, ntiles = ntn * 16;
  for (int tl = tile0; tl < ntiles; tl += tile_stride) {
    const int kt = tl / ntn, nt_ = tl % ntn, k0 = kt * 64, n0 = nt_ * 64;
    __syncthreads();
#pragma unroll
    for (int i = 0; i < 8; ++i) { const int idx = c.tid + i * 512, kk = idx >> 6, nn = idx & 63; t[kk * 65 + nn] = (n0 + nn < N) ? src[(size_t)(k0 + kk) * N + n0 + nn] : 0.f; }
    __syncthreads();
#pragma unroll
    for (int i = 0; i < 4; ++i) { const int idx = c.tid + i * 512, nn = idx >> 5, kp = (idx & 31) * 2;
      if (n0 + nn < N) *(unsigned*)(dst + (size_t)((n0 + nn) * rs + ro) * 1024 + k0 + kp) = pk2(t[kp * 65 + nn], t[(kp + 1) * 65 + nn]); }
  }
  __syncthreads();
}
__device__ __forceinline__ void p0_prologue(unsigned char* lds_, int wv, const Params& p) {
  const Ctx c = make_ctx(lds_, wv);
  unsigned char* ws = p.ws;
  if (c.bid == 0) { ((unsigned*)(ws + WS_CTL))[64 + c.tid] = 0u; }
  if (c.bid == 0) { for (int i = c.tid; i < 3456; i += NTHREADS) ((unsigned*)(ws + WS_CTL))[2048 + i] = 0u; }
  { const float* x = p.in[I_X]; bf16_t* hb = (bf16_t*)(ws + WS_HB);
    for (size_t i = (size_t)c.bid * NTHREADS + c.tid; i < (size_t)NTOK * 1024 / 8; i += (size_t)c.G * NTHREADS) {
      const f32x4 a = *(const f32x4*)(x + i * 8), b = *(const f32x4*)(x + i * 8 + 4);
      u32x4 w; w.x = pk2(a[0], a[1]); w.y = pk2(a[2], a[3]); w.z = pk2(b[0], b[1]); w.w = pk2(b[2], b[3]);
      *(u32x4*)(hb + i * 8) = w; } }
  transpose_job(c, p.in[I_AB_W_IN], P_AB, (bf16_t*)(ws + WS_WIN_AB), 1, 0, c.bid, c.G);
  transpose_job(c, p.in[I_CD_W_IN], P_CD, (bf16_t*)(ws + WS_WIN_CD), 1, 0, c.bid, c.G);
  transpose_job(c, p.in[I_AB_W_OUT], 1024, (bf16_t*)(ws + WS_WOUT_AB), 1, 0, c.bid, c.G);
  transpose_job(c, p.in[I_CD_W_OUT], 1024, (bf16_t*)(ws + WS_WOUT_CD), 1, 0, c.bid, c.G);
  { float* rope = (float*)(ws + WS_ROPE);
    for (int i = c.bid * NTHREADS + c.tid; i < SEQ * 32; i += c.G * NTHREADS) { const int t = i >> 5, f = i & 31;
      const float freq = powf(10000.0f, -(float)f / 32.0f); const float ang = (float)t * freq; rope[i * 2] = cosf(ang); rope[i * 2 + 1] = sinf(ang); }
    if (c.bid == 1) { const float* hl = p.in[I_HGRN_LB]; float* lb = (float*)(ws + WS_LB);
      const int cc = c.tid; const float a0 = hl[cc], a1 = hl[512 + cc], a2 = hl[1024 + cc]; const float mx = fmaxf(a0, fmaxf(a1, a2));
      const float e0 = expf(a0 - mx), e1 = expf(a1 - mx), e2 = expf(a2 - mx); lb[cc] = e0 / (e0 + e1 + e2); } }
}
__device__ __forceinline__ void moe_weight_convert(unsigned char* lds_, int wv, const Params& p, int layer) {
  const Ctx c = make_ctx(lds_, wv);
  bf16_t* w13 = (bf16_t*)(p.ws + WS_WMOE); bf16_t* w2 = w13 + (size_t)NEXP * 2048 * 1024;
  const size_t lo = (size_t)layer * NEXP * 1024 * 1024;
  const float* W1 = p.in[I_MOE_W1] + lo; const float* W3 = p.in[I_MOE_W3] + lo; const float* W2 = p.in[I_MOE_W2] + lo;
  float* t = (float*)c.lds;
  constexpr int NT = 48 * 128;
  const int lk = c.tid >> 5, ln4 = (c.tid & 31) * 4;
  const int sn = c.tid & 127, sk = (c.tid >> 7) * 8;
  f32x4 r[4];
#define MW_SRC(g_) ((((g_) >> 7) % 3 == 0 ? W1 : (((g_) >> 7) % 3 == 1 ? W3 : W2)) + (size_t)(((g_) >> 7) / 3) * 1048576 + (size_t)((((g_) & 127) >> 3) * 64) * 1024 + ((g_) & 7) * 128)
#define MW_LOAD(g_) do { const float* s_ = MW_SRC(g_); _Pragma("unroll") for (int i = 0; i < 4; ++i) r[i] = *(const f32x4*)(s_ + (size_t)(lk + 16 * i) * 1024 + ln4); } while (0)
  int g0 = c.bid;
  if (g0 < NT) MW_LOAD(g0);
  for (; g0 < NT; g0 += c.G) {
    __syncthreads();
#pragma unroll
    for (int i = 0; i < 4; ++i) { float* d = t + (lk + 16 * i) * 129 + ln4; d[0] = r[i][0]; d[1] = r[i][1]; d[2] = r[i][2]; d[3] = r[i][3]; }
    __syncthreads();
    const int gn = g0 + c.G;
    if (gn < NT) MW_LOAD(gn);
    const int m = g0 >> 7, e = m / 3, which = m % 3, k0 = ((g0 & 127) >> 3) * 64, n0 = (g0 & 7) * 128;
    bf16_t* drow = (which == 2) ? w2 + ((size_t)e * 1024 + n0 + sn) * 1024 : w13 + ((size_t)e * 2048 + 2 * (n0 + sn) + which) * 1024;
#pragma unroll
    for (int j = 0; j < 2; ++j) { const int kk = sk + 32 * j; const float* s = t + kk * 129 + sn;
      u32x4 w; w.x = pk2(s[0], s[129]); w.y = pk2(s[2 * 129], s[3 * 129]); w.z = pk2(s[4 * 129], s[5 * 129]); w.w = pk2(s[6 * 129], s[7 * 129]);
      *(u32x4*)(drow + k0 + kk) = w; }
  }
#undef MW_SRC
#undef MW_LOAD
  __syncthreads();
}

struct ProbInProj {
  static constexpr bool PERM = true;
  pg8::StaticOrder so; const char* A; const char* Bt; bf16_t* P; const float* bias; const float* lb; int layer;
  __device__ __forceinline__ bool next(int i, pg8::Unit& u) const { return so.next(i, u); }
  __device__ __forceinline__ const char* a_base() const { return A; }
  __device__ __forceinline__ unsigned a_off(const pg8::Unit& u, int r) const { return (unsigned)(u.pm * 256 + r) * 2048u; }
  __device__ __forceinline__ const char* b_base(const pg8::Unit& u) const { return Bt + (size_t)u.pn * 256 * 2048; }
  __device__ __forceinline__ void epi(const f32x4 (&acc)[2][2][4][2], const pg8::Unit& u, int wr, int wc, int fr, int fq) const {
    const int row0 = u.row0 + wr * 64 + fr, colb = u.pn * 256 + wc * 32 + 8 * fq;
    int mode = 0;
    if (layer == 0) { mode = u.pn < 2 ? 1 : (u.pn < 6 ? 2 : (u.pn == 10 ? 3 : 0)); }
#pragma unroll
    for (int bj = 0; bj < 2; ++bj) {
      const int col0 = colb + bj * 128;
      const f32x4 b0 = *(const f32x4*)(bias + col0), b1 = *(const f32x4*)(bias + col0 + 4);
      f32x4 l0 = (f32x4){0.f, 0.f, 0.f, 0.f}, l1 = l0;
      if (mode == 2) { l0 = *(const f32x4*)(lb + ((col0 - 512) & 511)); l1 = *(const f32x4*)(lb + ((col0 - 512) & 511) + 4); }
#pragma unroll
      for (int ai = 0; ai < 2; ++ai)
#pragma unroll
        for (int m = 0; m < 4; ++m) {
          f32x4 v0 = acc[ai][bj][m][0] + b0, v1 = acc[ai][bj][m][1] + b1;
          if (mode == 1) {
#pragma unroll
            for (int j = 0; j < 4; ++j) { v0[j] = fsilu(v0[j]); v1[j] = fsilu(v1[j]); }
          } else if (mode == 2) {
#pragma unroll
            for (int j = 0; j < 4; ++j) { v0[j] = __builtin_amdgcn_logf(l0[j] + (1.0f - l0[j]) * fsigmoid(v0[j])); v1[j] = __builtin_amdgcn_logf(l1[j] + (1.0f - l1[j]) * fsigmoid(v1[j])); }
          } else if (mode == 3) { v0 *= 0.125f; v1 *= 0.125f; }
          u32x4 w; w.x = pk2(v0[0], v0[1]); w.y = pk2(v0[2], v0[3]); w.z = pk2(v1[0], v1[1]); w.w = pk2(v1[2], v1[3]);
          *(u32x4*)(P + PIDX(row0 + ai * 128 + m * 16, col0)) = w;
        }
    }
  }
};
struct ProbOutProj {
  static constexpr bool PERM = false;
  pg8::StaticOrder so; const char* A; const char* Bt; float* Y; const float* Hres;
  __device__ __forceinline__ bool next(int i, pg8::Unit& u) const { return so.next(i, u); }
  __device__ __forceinline__ const char* a_base() const { return A; }
  __device__ __forceinline__ unsigned a_off(const pg8::Unit& u, int r) const { return (unsigned)(u.pm * 256 + r) * 2048u; }
  __device__ __forceinline__ const char* b_base(const pg8::Unit& u) const { return Bt + (size_t)u.pn * 256 * 2048; }
  __device__ __forceinline__ void epi(const f32x4 (&acc)[2][2][4][2], const pg8::Unit& u, int wr, int wc, int fr, int fq) const {
    const int row0 = u.row0 + wr * 64 + fr, col0 = u.pn * 256 + wc * 32 + 4 * fq;
#pragma unroll
    for (int ai = 0; ai < 2; ++ai)
#pragma unroll
      for (int m = 0; m < 4; ++m) { const size_t ro = (size_t)(row0 + ai * 128 + m * 16) * 1024 + col0; float* rowp = Y + ro; const float* hp = Hres + ro;
#pragma unroll
        for (int bj = 0; bj < 2; ++bj)
#pragma unroll
          for (int n = 0; n < 2; ++n) *(f32x4*)(rowp + bj * 128 + n * 16) = acc[ai][bj][m][n] + ALPHA_F * *(const f32x4*)(hp + bj * 128 + n * 16); }
  }
};
#define MOE_TAB_OFF (128 * 1024)
struct MoeOrder {
  const int* tab;
  __device__ __forceinline__ void init(const int* cnt, int ntn, int G, int c, unsigned char* lds, int wv) {
    int* t = (int*)(lds + MOE_TAB_OFF);
    const int tid = opaque_tid(wv);
    if (tid < 64) {
      int pad = 0, found = 0, ue = 0, upn = 0, upm = 0, urow = 0, une = 0;
      if ((G & 7) == 0) {
        const int x = c & 7; int q = tid * (G >> 3) + (c >> 3);
        for (int e = 0; e < NEXP; ++e) { const int n = cnt[e * 16], mt = (n + 255) >> 8; const int r = ((x - e) % 8 + 8) % 8; const int m = mt > r ? (mt - r - 1) / 8 + 1 : 0; const int units = m * ntn;
          if (!found && q < units) { ue = e; upm = r + 8 * (q % m); upn = q / m; urow = pad + upm * 256; une = n; found = 1; }
          if (!found) { q -= units; pad += mt * 256; } }
      } else {
        int L = tid * G + c;
        for (int e = 0; e < NEXP; ++e) { const int n = cnt[e * 16], mt = (n + 255) >> 8, tiles = mt * ntn;
          if (!found && L < tiles) { ue = e; upn = L / mt; upm = L % mt; urow = pad + upm * 256; une = n; found = 1; }
          if (!found) { L -= tiles; pad += mt * 256; } }
      }
      t[tid * 8 + 0] = found; t[tid * 8 + 1] = ue; t[tid * 8 + 2] = upn; t[tid * 8 + 3] = upm; t[tid * 8 + 4] = urow; t[tid * 8 + 5] = une;
    }
    __syncthreads();
    tab = t;
  }
  __device__ __forceinline__ bool next(int i, pg8::Unit& u) const {
    if (i >= 64) return false;
    const int* t = tab + i * 8;
    if (!__builtin_amdgcn_readfirstlane(t[0])) return false;
    u.e = __builtin_amdgcn_readfirstlane(t[1]); u.pn = __builtin_amdgcn_readfirstlane(t[2]); u.pm = __builtin_amdgcn_readfirstlane(t[3]);
    u.row0 = __builtin_amdgcn_readfirstlane(t[4]); u.ne = __builtin_amdgcn_readfirstlane(t[5]); u.ui = i; return true;
  }
};
struct ProbMoe1 {
  static constexpr bool PERM = true;
  MoeOrder mo; const char* A; const char* W13; const int* list; bf16_t* H; const int* ltok;
  __device__ __forceinline__ void stage_tokens(unsigned char* lds, int wv) {
    int* lt = (int*)(lds + MOE_TAB_OFF + 2048);
    const int tid = opaque_tid(wv);
    pg8::Unit u;
    for (int i = 0; i < 16 && mo.next(i, u); ++i) { if (tid < 256) { const int rr = u.pm * 256 + tid; lt[i * 256 + tid] = rr < u.ne ? list[u.e * NTOK + rr] : 0; } }
    __syncthreads();
    ltok = lt;
  }
  __device__ __forceinline__ bool next(int i, pg8::Unit& u) const { return mo.next(i, u); }
  __device__ __forceinline__ const char* a_base() const { return A; }
  __device__ __forceinline__ unsigned a_off(const pg8::Unit& u, int r) const { const int rr = u.pm * 256 + r; const int tok = rr < u.ne ? list[u.e * NTOK + rr] : 0; return (unsigned)tok * 2048u; }
  __device__ __forceinline__ const char* b_base(const pg8::Unit& u) const { return W13 + ((size_t)u.e * 2048 + (size_t)u.pn * 256) * 2048; }
  __device__ __forceinline__ void epi(const f32x4 (&acc)[2][2][4][2], const pg8::Unit& u, int wr, int wc, int fr, int fq) const {
    const int row0 = u.row0 + wr * 64 + fr, colb = u.pn * 128 + wc * 16 + 4 * fq;
#pragma unroll
    for (int ai = 0; ai < 2; ++ai)
#pragma unroll
      for (int m = 0; m < 4; ++m)
#pragma unroll
        for (int bj = 0; bj < 2; ++bj) {
          const f32x4 v0 = acc[ai][bj][m][0], v1 = acc[ai][bj][m][1];
          u32x2 w; w.x = pk2(fsilu(v0[0]) * v0[1], fsilu(v0[2]) * v0[3]); w.y = pk2(fsilu(v1[0]) * v1[1], fsilu(v1[2]) * v1[3]);
          *(u32x2*)(H + (size_t)(row0 + ai * 128 + m * 16) * 1024 + colb + bj * 64) = w;
        }
  }
};
struct ProbMoe2 {
  static constexpr bool PERM = true;
  MoeOrder mo; const char* A; const char* W2; bf16_t* Y;
  __device__ __forceinline__ bool next(int i, pg8::Unit& u) const { return mo.next(i, u); }
  __device__ __forceinline__ const char* a_base() const { return A; }
  __device__ __forceinline__ unsigned a_off(const pg8::Unit& u, int r) const { return (unsigned)(u.row0 + r) * 2048u; }
  __device__ __forceinline__ const char* b_base(const pg8::Unit& u) const { return W2 + ((size_t)u.e * 1024 + (size_t)u.pn * 256) * 2048; }
  __device__ __forceinline__ void epi(const f32x4 (&acc)[2][2][4][2], const pg8::Unit& u, int wr, int wc, int fr, int fq) const {
    const int row0 = u.row0 + wr * 64 + fr, colb = u.pn * 256 + wc * 32 + 8 * fq;
#pragma unroll
    for (int ai = 0; ai < 2; ++ai)
#pragma unroll
      for (int m = 0; m < 4; ++m)
#pragma unroll
        for (int bj = 0; bj < 2; ++bj) {
          const f32x4 v0 = acc[ai][bj][m][0], v1 = acc[ai][bj][m][1];
          u32x4 w; w.x = pk2(v0[0], v0[1]); w.y = pk2(v0[2], v0[3]); w.z = pk2(v1[0], v1[1]); w.w = pk2(v1[2], v1[3]);
          *(u32x4*)(Y + (size_t)(row0 + ai * 128 + m * 16) * 1024 + colb + bj * 128) = w;
        }
  }
};

template <int NS>
__device__ __forceinline__ void side_phase(unsigned char* lds_, int wv, const Params& p, int layer) {
  const Ctx c = make_ctx(lds_, wv);
  const bf16_t* hb = (const bf16_t*)(p.ws + WS_HB);
  const bf16_t* wt = (const bf16_t*)(p.ws + (layer == 0 ? WS_WIN_AB : WS_WIN_CD)) + (size_t)(layer == 0 ? PM_AB : PM_CD) * 1024;
  const float* bias = p.in[layer == 0 ? I_AB_B_IN : I_CD_B_IN] + (layer == 0 ? PM_AB : PM_CD);
  float* side = (float*)(p.ws + WS_SIDE);
  float* tl = (float*)c.lds + c.wid * (16 * 33);
  const int fr = c.lane & 15, fq = c.lane >> 4;
  for (int g = c.bid * 8 + c.wid; g < NTOK / 16; g += c.G * 8) {
    const int r0 = g * 16;
    f32x4 acc0 = (f32x4){0.f, 0.f, 0.f, 0.f}, acc1 = acc0;
    const bf16_t* ap = hb + (size_t)(r0 + fr) * 1024 + fq * 8;
    const bf16_t* bp0 = wt + (size_t)fr * 1024 + fq * 8; const bf16_t* bp1 = bp0 + 16 * 1024;
#pragma unroll 4
    for (int k = 0; k < 1024; k += 32) {
      const bf16x8 a = *(const bf16x8*)(ap + k), b0 = *(const bf16x8*)(bp0 + k);
      acc0 = __builtin_amdgcn_mfma_f32_16x16x32_bf16(a, b0, acc0, 0, 0, 0);
      if (NS == 32) { const bf16x8 b1 = *(const bf16x8*)(bp1 + k); acc1 = __builtin_amdgcn_mfma_f32_16x16x32_bf16(a, b1, acc1, 0, 0, 0); }
    }
    float gsc = 1.f, gfb = 0.f; bool gls = false;
    if (NS == 16) { gsc = 1.4426950408889634f; gls = (fr & 4) != 0; gfb = gls ? p.in[I_FGATE_B][(fr >> 3) * 4 + (fr & 3)] : 0.f; }
#pragma unroll
    for (int j = 0; j < 4; ++j) { float v0 = acc0[j] + bias[fr]; if (NS == 16) v0 = gls ? flog2sigmoid(v0 + gfb) : v0 * gsc; side[(size_t)(r0 + fq * 4 + j) * 32 + fr] = v0; tl[(fq * 4 + j) * 33 + fr] = v0;
      if (NS == 32) { const float v1 = acc1[j] + bias[16 + fr]; side[(size_t)(r0 + fq * 4 + j) * 32 + 16 + fr] = v1; tl[(fq * 4 + j) * 33 + 16 + fr] = v1; } }
    if (NS == 32) {
      __builtin_amdgcn_s_waitcnt(0xC07F);
      const float* gu = p.in[I_GK_UP]; const float* gb = p.in[I_GK_B]; bf16_t* lfb = (bf16_t*)(p.ws + WS_LFB);
      const int cb = c.lane * 8, dir = cb >> 8, cc = cb & 255;
      float w[16][8];
#pragma unroll
      for (int r = 0; r < 16; ++r)
#pragma unroll
        for (int j = 0; j < 8; ++j) w[r][j] = gu[(dir * 16 + r) * 256 + cc + j];
      float bb[8];
#pragma unroll
      for (int j = 0; j < 8; ++j) bb[j] = gb[dir * 256 + cc + j];
      for (int row = 0; row < 16; ++row) {
        float z[8];
#pragma unroll
        for (int j = 0; j < 8; ++j) z[j] = bb[j];
#pragma unroll
        for (int r = 0; r < 16; ++r) { const float s = tl[row * 33 + dir * 16 + r];
#pragma unroll
          for (int j = 0; j < 8; ++j) z[j] += s * w[r][j]; }
        u32x4 o; o.x = pk2(flog2sigmoid(z[0]) * 0.0625f, flog2sigmoid(z[1]) * 0.0625f); o.y = pk2(flog2sigmoid(z[2]) * 0.0625f, flog2sigmoid(z[3]) * 0.0625f);
        o.z = pk2(flog2sigmoid(z[4]) * 0.0625f, flog2sigmoid(z[5]) * 0.0625f); o.w = pk2(flog2sigmoid(z[6]) * 0.0625f, flog2sigmoid(z[7]) * 0.0625f);
        *(u32x4*)(lfb + PIDX(r0 + row, cb)) = o;
      }
    }
  }
}

__device__ __forceinline__ void headnorm_phase(unsigned char* lds_, int wv, const Params& p, int layer) {
  const Ctx c = make_ctx(lds_, wv);
  const bf16_t* P = (const bf16_t*)(p.ws + WS_R1); const bf16_t* O = (const bf16_t*)(p.ws + WS_R2);
  bf16_t* mixed = (bf16_t*)(p.ws + WS_HB);
  const int c0 = c.lane * 16, h8 = c.lane >> 3;
  const float* gain = layer == 0 ? (h8 < 4 ? p.in[I_HGRN_NORM] + c0 : p.in[I_GLA_NORM] + c0 - 512) : (h8 < 4 ? p.in[I_RET_NORM] + c0 : p.in[I_MLSTM_NORM] + c0 - 512);
  const int gcol = layer == 0 ? (h8 < 4 ? 2048 + c0 : 3584 + c0 - 512) : (h8 < 4 ? 1024 + c0 : 3072 + c0 - 512);
  float gn[16];
#pragma unroll
  for (int j = 0; j < 16; ++j) gn[j] = gain[j];
  for (int tok = c.bid * 8 + c.wid; tok < NTOK; tok += c.G * 8) {
    float of[16], ob[16], gt[16];
    { const u32x4* a = (const u32x4*)(O + PIDX(tok, c0)); unpack8(a[0], of); unpack8(a[1], of + 8);
      const u32x4* b = (const u32x4*)(O + (size_t)NTOK * 1024 + PIDX(tok, c0)); unpack8(b[0], ob); unpack8(b[1], ob + 8);
      const u32x4* g = (const u32x4*)(P + PIDX(tok, gcol)); unpack8(g[0], gt); unpack8(g[1], gt + 8); }
    const float sf = 1.f, sb = 1.f;
    float o[16]; float ss = 0.f;
#pragma unroll
    for (int j = 0; j < 16; ++j) { o[j] = of[j] * sf + ob[j] * sb; ss += o[j] * o[j]; }
    ss += __shfl_xor(ss, 1); ss += __shfl_xor(ss, 2); ss += __shfl_xor(ss, 4);
    const float r = 1.0f / sqrtf(ss * (1.0f / 128.0f) + NORM_EPS_F);
    unsigned w[8];
#pragma unroll
    for (int j = 0; j < 8; ++j) {
      float g0 = gt[2 * j], g1 = gt[2 * j + 1];
      if (layer == 1 && h8 >= 4) { g0 = fsigmoid(g0); g1 = fsigmoid(g1); } else { g0 = fsilu(g0); g1 = fsilu(g1); }
      w[j] = pk2(o[2 * j] * r * gn[2 * j] * g0, o[2 * j + 1] * r * gn[2 * j + 1] * g1);
    }
    u32x4* d = (u32x4*)(mixed + (size_t)tok * 1024 + c0);
    d[0] = (u32x4){w[0], w[1], w[2], w[3]}; d[1] = (u32x4){w[4], w[5], w[6], w[7]};
  }
}

__device__ __forceinline__ void ln_phase(unsigned char* lds_, int wv, const Params& p, int layer, int mode, int dry = 0) {
  const Ctx c = make_ctx(lds_, wv);
  unsigned char* ws = p.ws;
  const float* hin = (mode == 0 && layer == 0) ? p.in[I_X] : p.out;
  float* hout = dry ? (float*)(ws + WS_H) : p.out; bf16_t* hb = (bf16_t*)(ws + WS_HB);
  const float* g = p.in[mode == 0 ? I_LN_MIX_G : I_LN_FFN_G] + layer * 1024; const float* b = p.in[mode == 0 ? I_LN_MIX_B : I_LN_FFN_B] + layer * 1024;
  unsigned* cnt = (unsigned*)(ws + WS_CTL) + CW_CNT(layer);
  int* list = (int*)(ws + WS_LIST) + (size_t)layer * NEXP * NTOK;
  int* assign = (int*)(ws + WS_ASSIGN); float* gate = (float*)(ws + WS_GATE);
  float* rwT = (float*)c.lds;
  int* lcnt = (int*)(c.lds + 65536); int* lbase = lcnt + 16; int* rec = lcnt + 32; float* recg = (float*)(rec + 4 * 2048);
  int pad[NEXP];
  if (mode == 0) { const float* r = p.in[I_ROUTER_W];
    for (int i = c.tid; i < 1024 * 16; i += NTHREADS) rwT[(i & 15) * 1024 + (i >> 4)] = r[i];
    if (c.tid < 16) lcnt[c.tid] = 0;
    __syncthreads(); }
  else { int acc = 0;
#pragma unroll
    for (int e = 0; e < NEXP; ++e) { pad[e] = acc; acc += (((int)cnt[e * 16] + 255) >> 8) << 8; } }
  const int c0 = c.lane * 4;
  float gv[16], bv[16];
#pragma unroll
  for (int q = 0; q < 4; ++q) { const f32x4 t0 = *(const f32x4*)(g + q * 256 + c0), t1 = *(const f32x4*)(b + q * 256 + c0);
#pragma unroll
    for (int j = 0; j < 4; ++j) { gv[4 * q + j] = t0[j]; bv[4 * q + j] = t1[j]; } }
  const int tstride = c.G * 8;
  int it = 0;
  for (int tok0 = c.bid * 8 + c.wid; tok0 < NTOK; tok0 += 2 * tstride, it += 2) {
    float v[2][16];
    float gy0[2], gy1[2];
#pragma unroll
    for (int u = 0; u < 2; ++u) {
      const int tok = tok0 + u * tstride;
      if (tok < NTOK) {
        if (mode == 0) {
#pragma unroll
          for (int q = 0; q < 4; ++q) { const f32x4 t = *(const f32x4*)((const float*)(ws + WS_R2) + (size_t)tok * 1024 + q * 256 + c0); v[u][4 * q] = t[0]; v[u][4 * q + 1] = t[1]; v[u][4 * q + 2] = t[2]; v[u][4 * q + 3] = t[3]; }
        } else {
#pragma unroll
          for (int q = 0; q < 4; ++q) { const f32x4 t = *(const f32x4*)(hin + (size_t)tok * 1024 + q * 256 + c0); v[u][4 * q] = ALPHA_F * t[0]; v[u][4 * q + 1] = ALPHA_F * t[1]; v[u][4 * q + 2] = ALPHA_F * t[2]; v[u][4 * q + 3] = ALPHA_F * t[3]; }
          const int a0 = assign[tok * 4], a1 = assign[tok * 4 + 1], a2 = assign[tok * 4 + 2], a3 = assign[tok * 4 + 3];
          gy0[u] = gate[tok * 2]; gy1[u] = gate[tok * 2 + 1];
          int p0 = 0, p1 = 0;
#pragma unroll
          for (int e = 0; e < NEXP; ++e) { if (e == a0) p0 = pad[e]; if (e == a2) p1 = pad[e]; }
          p0 += a1; p1 += a3;
          const bf16_t* Y = (const bf16_t*)(ws + WS_R2);
#pragma unroll
          for (int q = 0; q < 4; ++q) { const u32x2 y0 = *(const u32x2*)(Y + (size_t)p0 * 1024 + q * 256 + c0), y1 = *(const u32x2*)(Y + (size_t)p1 * 1024 + q * 256 + c0);
            v[u][4 * q] += gy0[u] * __uint_as_float(y0.x << 16) + gy1[u] * __uint_as_float(y1.x << 16); v[u][4 * q + 1] += gy0[u] * __uint_as_float(y0.x & 0xffff0000u) + gy1[u] * __uint_as_float(y1.x & 0xffff0000u);
            v[u][4 * q + 2] += gy0[u] * __uint_as_float(y0.y << 16) + gy1[u] * __uint_as_float(y1.y << 16); v[u][4 * q + 3] += gy0[u] * __uint_as_float(y0.y & 0xffff0000u) + gy1[u] * __uint_as_float(y1.y & 0xffff0000u); }
        }
      } else {
#pragma unroll
        for (int j = 0; j < 16; ++j) v[u][j] = 0.f;
      }
    }
#pragma unroll
    for (int u = 0; u < 2; ++u) {
      const int tok = tok0 + u * tstride;
      float s = 0.f;
#pragma unroll
      for (int j = 0; j < 16; ++j) s += v[u][j];
      const float mean = wave_sum(s) * (1.0f / 1024.0f);
      float qq = 0.f;
#pragma unroll
      for (int j = 0; j < 16; ++j) { v[u][j] -= mean; qq += v[u][j] * v[u][j]; }
      const float r = 1.0f / sqrtf(wave_sum(qq) * (1.0f / 1024.0f) + LN_EPS_F);
#pragma unroll
      for (int j = 0; j < 16; ++j) v[u][j] = v[u][j] * r * gv[j] + bv[j];
      if (tok < NTOK) {
#pragma unroll
        for (int q = 0; q < 4; ++q) *(f32x4*)(hout + (size_t)tok * 1024 + q * 256 + c0) = (f32x4){v[u][4 * q], v[u][4 * q + 1], v[u][4 * q + 2], v[u][4 * q + 3]};
        if (!(mode == 1 && layer == 1) && !dry) {
#pragma unroll
          for (int q = 0; q < 4; ++q) *(u32x2*)(hb + (size_t)tok * 1024 + q * 256 + c0) = (u32x2){pk2(v[u][4 * q], v[u][4 * q + 1]), pk2(v[u][4 * q + 2], v[u][4 * q + 3])}; }
      }
      if (mode == 0) {
        float lg[16];
#pragma unroll
        for (int e = 0; e < 16; ++e) { float a = 0.f;
#pragma unroll
          for (int q = 0; q < 4; ++q) { const f32x4 w = *(const f32x4*)(rwT + e * 1024 + q * 256 + c0); a += v[u][4 * q] * w[0] + v[u][4 * q + 1] * w[1] + v[u][4 * q + 2] * w[2] + v[u][4 * q + 3] * w[3]; }
          lg[e] = a; }
#pragma unroll
        for (int e = 0; e < 16; ++e) lg[e] = wave_sum(lg[e]);
        int eo[2]; float go[2];
        route_from_logits(lg, p.in[I_ROUTER_B], eo, go);
        if (c.lane == 0 && tok < NTOK && !dry) {
          const int r1 = atomicAdd(lcnt + eo[0], 1), r2 = atomicAdd(lcnt + eo[1], 1);
          const int ri = (it + u) * 8 + c.wid;
          rec[ri * 4] = eo[0]; rec[ri * 4 + 1] = r1; rec[ri * 4 + 2] = eo[1]; rec[ri * 4 + 3] = r2; recg[ri * 2] = go[0]; recg[ri * 2 + 1] = go[1];
        }
      }
    }
  }
  if (mode == 0 && !dry) {
    __syncthreads();
    if (c.tid < 16) lbase[c.tid] = (int)atomicAdd(cnt + c.tid * 16, (unsigned)lcnt[c.tid]);
    __syncthreads();
    const int nrec = ((NTOK + c.G * 8 - 1) / (c.G * 8)) * 8;
    for (int ri = c.tid; ri < nrec; ri += NTHREADS) {
      const int tok = c.bid * 8 + (ri & 7) + (ri >> 3) * c.G * 8;
      if (tok < NTOK) {
        const int e1 = rec[ri * 4], e2 = rec[ri * 4 + 2]; const int r1 = rec[ri * 4 + 1] + lbase[e1], r2 = rec[ri * 4 + 3] + lbase[e2];
        list[e1 * NTOK + r1] = tok; list[e2 * NTOK + r2] = tok;
        assign[tok * 4] = e1; assign[tok * 4 + 1] = r1; assign[tok * 4 + 2] = e2; assign[tok * 4 + 3] = r2;
        gate[tok * 2] = recg[ri * 2]; gate[tok * 2 + 1] = recg[ri * 2 + 1];
      }
    }
  }
  __syncthreads();
}
#endif
#ifndef CPU_EMU
namespace scan {
typedef short bf16x8 __attribute__((ext_vector_type(8)));
typedef float f32x4 __attribute__((ext_vector_type(4)));
typedef unsigned u32x4 __attribute__((ext_vector_type(4)));
typedef unsigned u32x2 __attribute__((ext_vector_type(2)));
enum { MIX_A = 0, MIX_B = 1, MIX_C = 2, MIX_D = 3 };
constexpr int LD_T = 144;
constexpr int OFF_QS = 0, OFF_KS = 17408, OFF_QI = 34816, OFF_KT = 52224, OFF_VT = 70656, OFF_SC = 77568, OFF_ST = 86784, OFF_DEC = 99840, OFF_EM = 100352, OFF_DEN = 100608, OFF_CW = 100864, SCAN_LDS = 104960;

__device__ __forceinline__ float incl_scan_add(float x) {
  x += __builtin_bit_cast(float, __builtin_amdgcn_update_dpp(0, __builtin_bit_cast(int, x), 0x111, 0xf, 0xf, false));
  x += __builtin_bit_cast(float, __builtin_amdgcn_update_dpp(0, __builtin_bit_cast(int, x), 0x112, 0xf, 0xf, false));
  x += __builtin_bit_cast(float, __builtin_amdgcn_update_dpp(0, __builtin_bit_cast(int, x), 0x114, 0xf, 0xf, false));
  x += __builtin_bit_cast(float, __builtin_amdgcn_update_dpp(0, __builtin_bit_cast(int, x), 0x118, 0xf, 0xf, false));
  x += __builtin_bit_cast(float, __builtin_amdgcn_update_dpp(0, __builtin_bit_cast(int, x), 0x142, 0xa, 0xf, false));
  x += __builtin_bit_cast(float, __builtin_amdgcn_update_dpp(0, __builtin_bit_cast(int, x), 0x143, 0xc, 0xf, false));
  return x;
}
__device__ __forceinline__ float incl_scan_max(float x) {
  const int ninf = (int)0xff800000u;
  x = fmaxf(x, __builtin_bit_cast(float, __builtin_amdgcn_update_dpp(ninf, __builtin_bit_cast(int, x), 0x111, 0xf, 0xf, false)));
  x = fmaxf(x, __builtin_bit_cast(float, __builtin_amdgcn_update_dpp(ninf, __builtin_bit_cast(int, x), 0x112, 0xf, 0xf, false)));
  x = fmaxf(x, __builtin_bit_cast(float, __builtin_amdgcn_update_dpp(ninf, __builtin_bit_cast(int, x), 0x114, 0xf, 0xf, false)));
  x = fmaxf(x, __builtin_bit_cast(float, __builtin_amdgcn_update_dpp(ninf, __builtin_bit_cast(int, x), 0x118, 0xf, 0xf, false)));
  x = fmaxf(x, __builtin_bit_cast(float, __builtin_amdgcn_update_dpp(ninf, __builtin_bit_cast(int, x), 0x142, 0xa, 0xf, false)));
  x = fmaxf(x, __builtin_bit_cast(float, __builtin_amdgcn_update_dpp(ninf, __builtin_bit_cast(int, x), 0x143, 0xc, 0xf, false)));
  return x;
}
__device__ __forceinline__ float rdlane(float x, int l) { return __builtin_bit_cast(float, __builtin_amdgcn_readlane(__builtin_bit_cast(int, x), l)); }
__device__ __forceinline__ bf16x8 ldfrag(const unsigned char* base, int ld, int row, int kbyte) { return *(const bf16x8*)(base + row * ld + kbyte); }
__device__ __forceinline__ unsigned pk(float a, float b) { return pk_hw(a, b); }
__device__ __forceinline__ float lo16(unsigned w) { return __uint_as_float(w << 16); }
__device__ __forceinline__ float hi16(unsigned w) { return __uint_as_float(w & 0xffff0000u); }

__device__ __forceinline__ void lds_barrier() { asm volatile("s_waitcnt lgkmcnt(0)" ::: "memory"); __builtin_amdgcn_s_barrier(); asm volatile("" ::: "memory"); }
struct Raw { u32x4 a0, a1, b0, b1; f32x4 r0, r1; u32x2 v; float s0, s1; };

template <int MIXER>
__device__ __forceinline__ void scan_item(unsigned char* lds, int wv, const Params& p, int b, int h, int dir, int vs) {
  constexpr int DK = (MIXER == MIX_A || MIXER == MIX_D) ? 128 : 64;
  constexpr int NC = DK / 8;
  constexpr int LD_D = DK * 2 + 16;
  constexpr int NVT = MIXER == MIX_D ? 3 : 2;
  constexpr int NKD = DK / 32;
  const int tid = opaque_tid(wv), lane0 = tid & 63, wid = __builtin_amdgcn_readfirstlane(tid >> 6);
  unsigned char* ws = p.ws;
  const bf16_t* P = (const bf16_t*)(ws + WS_R1);
  const bf16_t* LFBp = (const bf16_t*)(ws + WS_LFB);
  const float* side = (const float*)(ws + WS_SIDE);
  const float* rope = (const float*)(ws + WS_ROPE);
  bf16_t* O = (bf16_t*)(ws + WS_R2) + (size_t)dir * NTOK * 1024;
  unsigned char* QS = lds + OFF_QS; unsigned char* KS = lds + OFF_KS; unsigned char* QI = lds + OFF_QI; unsigned char* KT = lds + OFF_KT;
  unsigned char* VT = lds + OFF_VT; unsigned char* SC = lds + OFF_SC; unsigned char* ST = lds + OFF_ST;
  float* DEC = (float*)(lds + OFF_DEC); float* EM = (float*)(lds + OFF_EM); float* DEN = (float*)(lds + OFF_DEN);

  int qcol, kcol, lfcol, vcol, ocol;
  if (MIXER == MIX_A) { qcol = h * 128; kcol = 0; lfcol = 512 + dir * 512 + h * 128; vcol = 1536 + h * 128 + vs * 32; ocol = h * 128 + vs * 32; }
  else if (MIXER == MIX_B) { qcol = 2560 + h * 64; kcol = 2816 + h * 64; lfcol = dir * 256 + h * 64; vcol = 3072 + h * 128 + vs * 32; ocol = 512 + h * 128 + vs * 32; }
  else if (MIXER == MIX_C) { qcol = h * 64; kcol = 256 + h * 64; lfcol = 0; vcol = 512 + h * 128 + vs * 32; ocol = h * 128 + vs * 32; }
  else { qcol = h * 128  ; kcol = 3584 + h * 128  ; lfcol = 0; vcol = 2560 + h * 128 + vs * 32; ocol = 512 + h * 128 + vs * 32; }
  const int c0 = (MIXER == MIX_C) ? wid * 4 : wid * NC;
  const float lgam = (MIXER == MIX_C) ? log1pf(-exp2f(-(5.0f + 2.0f * (float)h + (float)dir))) : 0.f;
  const float fgb = (MIXER == MIX_D) ? p.in[I_FGATE_B][dir * 4 + h] : 0.f;
  for (int i = tid; i < 48 * LD_D / 4; i += NTHREADS) ((unsigned*)ST)[i] = 0u;
  if (MIXER == MIX_D) {
    for (int i = tid; i < 16 * 64; i += NTHREADS) { const int r = 32 + (i >> 6), j = i & 63; *(bf16_t*)(VT + r * LD_T + j * 2) = (r == 32) ? (bf16_t)0x3F80 : (bf16_t)0; }
  }
  f32x4 sacc[NVT == 3 ? 3 : 2];
#pragma unroll
  for (int i = 0; i < (NVT == 3 ? 3 : 2); ++i) sacc[i] = (f32x4){0.f, 0.f, 0.f, 0.f};
  float m_st = 0.f;
  const size_t tokbase = (size_t)b * SEQ;
  const int sgn = dir ? -1 : 1;
  __syncthreads();

  Raw R;
#define SCAN_LOAD(n_) do { \
    int ln_ = lane0; asm volatile("" : "+v"(ln_)); \
    const int t_ = dir ? (SEQ - 1 - ((n_) * 64 + ln_)) : ((n_) * 64 + ln_); \
    const bf16_t* row_ = P + (tokbase + t_) * PSTRIDE; \
    if (MIXER == MIX_A) { const u32x4* qp_ = (const u32x4*)(row_ + qcol + c0); const u32x4* lp_ = (const u32x4*)(row_ + lfcol + c0); R.a0 = qp_[0]; R.a1 = qp_[1]; R.b0 = lp_[0]; R.b1 = lp_[1]; } \
    else if (MIXER == MIX_B) { R.a0 = *(const u32x4*)(row_ + qcol + c0); R.a1 = *(const u32x4*)(row_ + kcol + c0); R.b0 = *(const u32x4*)(LFBp + (tokbase + t_) * 512 + lfcol + c0); } \
    else if (MIXER == MIX_C) { const u32x2 qa_ = *(const u32x2*)(row_ + qcol + c0), qb_ = *(const u32x2*)(row_ + qcol + 32 + c0), ka_ = *(const u32x2*)(row_ + kcol + c0), kb_ = *(const u32x2*)(row_ + kcol + 32 + c0); \
      R.a0 = (u32x4){qa_.x, qa_.y, qb_.x, qb_.y}; R.a1 = (u32x4){ka_.x, ka_.y, kb_.x, kb_.y}; \
      R.r0 = *(const f32x4*)(rope + ((size_t)t_ * 32 + c0) * 2); R.r1 = *(const f32x4*)(rope + ((size_t)t_ * 32 + c0) * 2 + 4); } \
    else { const u32x4* qp_ = (const u32x4*)(LFBp + (tokbase + t_) * 512 + qcol + c0); const u32x4* kp_ = (const u32x4*)(row_ + kcol + c0); R.a0 = qp_[0]; R.a1 = qp_[1]; R.b0 = kp_[0]; R.b1 = kp_[1]; \
      R.s0 = side[(tokbase + t_) * 32 + dir * 8 + h]; R.s1 = side[(tokbase + t_) * 32 + dir * 8 + 4 + h]; } \
    R.v = *(const u32x2*)(row_ + vcol + wid * 4); } while (0)

  SCAN_LOAD(0);
  for (int n = 0; n < SEQ / 64; ++n) {
    int lane = lane0; asm volatile("" : "+v"(lane));
    const int fr = lane & 15, fq = lane >> 4;
    float q[NC], k[NC], g[NC];
    const u32x2 vv = R.v;
    float g_li = 0.f, g_lf = 0.f;
    if (MIXER == MIX_A) {
      const unsigned qw[8] = {R.a0.x, R.a0.y, R.a0.z, R.a0.w, R.a1.x, R.a1.y, R.a1.z, R.a1.w}, lw[8] = {R.b0.x, R.b0.y, R.b0.z, R.b0.w, R.b1.x, R.b1.y, R.b1.z, R.b1.w};
#pragma unroll
      for (int c = 0; c < 8; ++c) { q[2 * c] = lo16(qw[c]); q[2 * c + 1] = hi16(qw[c]); g[2 * c] = lo16(lw[c]); g[2 * c + 1] = hi16(lw[c]); }
#pragma unroll
      for (int c = 0; c < NC; ++c) k[c] = 1.0f - __expf(g[c]);
    } else if (MIXER == MIX_B) {
      const unsigned qw[4] = {R.a0.x, R.a0.y, R.a0.z, R.a0.w}, kw[4] = {R.a1.x, R.a1.y, R.a1.z, R.a1.w}, lw[4] = {R.b0.x, R.b0.y, R.b0.z, R.b0.w};
#pragma unroll
      for (int c = 0; c < 4; ++c) { q[2 * c] = lo16(qw[c]); q[2 * c + 1] = hi16(qw[c]); k[2 * c] = lo16(kw[c]); k[2 * c + 1] = hi16(kw[c]); g[2 * c] = lo16(lw[c]); g[2 * c + 1] = hi16(lw[c]); }
    } else if (MIXER == MIX_C) {
      const float cs[4] = {R.r0[0], R.r0[2], R.r1[0], R.r1[2]}, sn[4] = {R.r0[1], R.r0[3], R.r1[1], R.r1[3]};
      const float q1[4] = {lo16(R.a0.x), hi16(R.a0.x), lo16(R.a0.y), hi16(R.a0.y)}, q2[4] = {lo16(R.a0.z), hi16(R.a0.z), lo16(R.a0.w), hi16(R.a0.w)};
      const float k1[4] = {lo16(R.a1.x), hi16(R.a1.x), lo16(R.a1.y), hi16(R.a1.y)}, k2[4] = {lo16(R.a1.z), hi16(R.a1.z), lo16(R.a1.w), hi16(R.a1.w)};
#pragma unroll
      for (int c = 0; c < 4; ++c) { q[c] = (q1[c] * cs[c] - q2[c] * sn[c]) * 0.125f; q[4 + c] = (q1[c] * sn[c] + q2[c] * cs[c]) * 0.125f; k[c] = k1[c] * cs[c] - k2[c] * sn[c]; k[4 + c] = k1[c] * sn[c] + k2[c] * cs[c]; }
#pragma unroll
      for (int c = 0; c < NC; ++c) g[c] = (float)(lane + 1) * lgam;
    } else {
      const unsigned qw[8] = {R.a0.x, R.a0.y, R.a0.z, R.a0.w, R.a1.x, R.a1.y, R.a1.z, R.a1.w}, kw[8] = {R.b0.x, R.b0.y, R.b0.z, R.b0.w, R.b1.x, R.b1.y, R.b1.z, R.b1.w};
      g_li = R.s0; g_lf = R.s1;
#pragma unroll
      for (int c = 0; c < 8; ++c) { q[2 * c] = lo16(qw[c]); q[2 * c + 1] = hi16(qw[c]); k[2 * c] = lo16(kw[c]); k[2 * c + 1] = hi16(kw[c]); }
#pragma unroll
      for (int c = 0; c < NC; ++c) g[c] = 0.f;
    }
    if (n + 1 < SEQ / 64) SCAN_LOAD(n + 1);

#ifndef PROBE_REPA
#define PROBE_REPA 1
#endif
    const float m_save = m_st;
#pragma unroll 1
    for (int rep = 0; rep < PROBE_REPA; ++rep) {
    if (PROBE_REPA > 1) { m_st = m_save;
#pragma unroll
      for (int c = 0; c < NC; ++c) asm volatile("" : "+v"(g[c]), "+v"(q[c]), "+v"(k[c])); }
    float s_qs[NC], s_ks[NC], s_qi[NC], s_kt[NC];
    if (MIXER != MIX_D) {
#pragma unroll
      for (int c = 0; c < NC; ++c) {
        const float gc = (MIXER == MIX_C) ? g[c] : incl_scan_add(g[c]);
        const float gref = rdlane(gc, 31), glast = rdlane(gc, 63);
        const float a = __expf(gc - gref), ia = __builtin_amdgcn_rcpf(a);
        s_qs[c] = a; s_ks[c] = ia; s_qi[c] = a * __expf(gref); s_kt[c] = ia * __expf(glast - gref);
        if (lane == 63) DEC[(MIXER == MIX_C) ? (c < 4 ? c0 + c : 32 + c0 + c - 4) : c0 + c] = __expf(glast);
      }
    } else {
      const float li = g_li;
      const float lf = logsigmoidf_(g_lf + fgb);
      const float bc = incl_scan_add(lf);
      const float u = li - bc;
      const float pm = incl_scan_max(u);
      const float cmax = rdlane(pm, 63), blast = rdlane(bc, 63);
      const float a_i = bc + m_st, m_i = fmaxf(a_i, bc + pm);
      const float alpha = __expf(bc - m_i + cmax), beta = __expf(u - cmax), sint = __expf(a_i - m_i);
      const float m_new = fmaxf(blast + m_st, blast + cmax);
      const float s_old = __expf(blast + m_st - m_new), wks = __expf(blast + u - m_new);
      m_st = m_new;
#pragma unroll
      for (int c = 0; c < NC; ++c) { s_qs[c] = alpha; s_ks[c] = beta; s_qi[c] = sint; s_kt[c] = wks; }
      if (wid == 0) EM[lane] = __expf(-m_i);
      if (lane == 63) {
#pragma unroll
        for (int c = 0; c < NC; ++c) DEC[c0 + c] = s_old;
      }
    }
    {
      unsigned wq[NC / 2], wk[NC / 2], wi[NC / 2];
#pragma unroll
      for (int c = 0; c < NC / 2; ++c) { wq[c] = pk(q[2 * c] * s_qs[2 * c], q[2 * c + 1] * s_qs[2 * c + 1]); wk[c] = pk(k[2 * c] * s_ks[2 * c], k[2 * c + 1] * s_ks[2 * c + 1]); wi[c] = pk(q[2 * c] * s_qi[2 * c], q[2 * c + 1] * s_qi[2 * c + 1]); }
      if (MIXER == MIX_C) {
        *(u32x2*)(QS + lane * LD_D + c0 * 2) = (u32x2){wq[0], wq[1]}; *(u32x2*)(QS + lane * LD_D + (32 + c0) * 2) = (u32x2){wq[2], wq[3]};
        *(u32x2*)(KS + lane * LD_D + c0 * 2) = (u32x2){wk[0], wk[1]}; *(u32x2*)(KS + lane * LD_D + (32 + c0) * 2) = (u32x2){wk[2], wk[3]};
        *(u32x2*)(QI + lane * LD_D + c0 * 2) = (u32x2){wi[0], wi[1]}; *(u32x2*)(QI + lane * LD_D + (32 + c0) * 2) = (u32x2){wi[2], wi[3]};
      } else {
#pragma unroll
        for (int c = 0; c < NC / 8; ++c) {
          *(u32x4*)(QS + lane * LD_D + (c0 + 8 * c) * 2) = (u32x4){wq[4 * c], wq[4 * c + 1], wq[4 * c + 2], wq[4 * c + 3]};
          *(u32x4*)(KS + lane * LD_D + (c0 + 8 * c) * 2) = (u32x4){wk[4 * c], wk[4 * c + 1], wk[4 * c + 2], wk[4 * c + 3]};
          *(u32x4*)(QI + lane * LD_D + (c0 + 8 * c) * 2) = (u32x4){wi[4 * c], wi[4 * c + 1], wi[4 * c + 2], wi[4 * c + 3]};
        }
      }
#pragma unroll
      for (int c = 0; c < NC; ++c) { const int d = (MIXER == MIX_C) ? (c < 4 ? c0 + c : 32 + c0 + c - 4) : c0 + c; *(bf16_t*)(KT + d * LD_T + lane * 2) = f2bf(k[c] * s_kt[c]); }
      *(bf16_t*)(VT + (wid * 4 + 0) * LD_T + lane * 2) = (bf16_t)(vv.x & 0xffff); *(bf16_t*)(VT + (wid * 4 + 1) * LD_T + lane * 2) = (bf16_t)(vv.x >> 16);
      *(bf16_t*)(VT + (wid * 4 + 2) * LD_T + lane * 2) = (bf16_t)(vv.y & 0xffff); *(bf16_t*)(VT + (wid * 4 + 3) * LD_T + lane * 2) = (bf16_t)(vv.y >> 16);
    }
    }
    lds_barrier();
    {
      const int it = wid & 3;
#pragma unroll
      for (int jj = 0; jj < 2; ++jj) {
        const int jt = 2 * (wid >> 2) + jj;
        if (jt <= it) {
          f32x4 acc = (f32x4){0.f, 0.f, 0.f, 0.f};
#pragma unroll
          for (int ks = 0; ks < NKD; ++ks) acc = __builtin_amdgcn_mfma_f32_16x16x32_bf16(ldfrag(KS, LD_D, jt * 16 + fr, ks * 64 + fq * 16), ldfrag(QS, LD_D, it * 16 + fr, ks * 64 + fq * 16), acc, 0, 0, 0);
          const int i = it * 16 + fr, j0 = jt * 16 + fq * 4;
          const float v0 = (j0 + 0 <= i) ? acc[0] : 0.f, v1 = (j0 + 1 <= i) ? acc[1] : 0.f, v2 = (j0 + 2 <= i) ? acc[2] : 0.f, v3 = (j0 + 3 <= i) ? acc[3] : 0.f;
          *(u32x2*)(SC + i * LD_T + j0 * 2) = (u32x2){pk(v0, v1), pk(v2, v3)};
        } else {
          const int i = it * 16 + fr, j0 = jt * 16 + fq * 4;
          *(u32x2*)(SC + i * LD_T + j0 * 2) = (u32x2){0u, 0u};
        }
      }
    }
    f32x4 oacc = (f32x4){0.f, 0.f, 0.f, 0.f}, dacc = (f32x4){0.f, 0.f, 0.f, 0.f};
    {
      const int vt = wid >> 2, it = wid & 3;
#pragma unroll
      for (int ks = 0; ks < NKD; ++ks) oacc = __builtin_amdgcn_mfma_f32_16x16x32_bf16(ldfrag(ST, LD_D, vt * 16 + fr, ks * 64 + fq * 16), ldfrag(QI, LD_D, it * 16 + fr, ks * 64 + fq * 16), oacc, 0, 0, 0);
      if (NVT == 3 && wid < 4) {
#pragma unroll
        for (int ks = 0; ks < NKD; ++ks) dacc = __builtin_amdgcn_mfma_f32_16x16x32_bf16(ldfrag(ST, LD_D, 32 + fr, ks * 64 + fq * 16), ldfrag(QI, LD_D, wid * 16 + fr, ks * 64 + fq * 16), dacc, 0, 0, 0);
      }
    }
    lds_barrier();
    {
      const int vt = wid >> 2, it = wid & 3;
#pragma unroll
      for (int ks = 0; ks < 2; ++ks) oacc = __builtin_amdgcn_mfma_f32_16x16x32_bf16(ldfrag(VT, LD_T, vt * 16 + fr, ks * 64 + fq * 16), ldfrag(SC, LD_T, it * 16 + fr, ks * 64 + fq * 16), oacc, 0, 0, 0);
      if (NVT == 3) {
        if (wid < 4) {
#pragma unroll
          for (int ks = 0; ks < 2; ++ks) dacc = __builtin_amdgcn_mfma_f32_16x16x32_bf16(ldfrag(VT, LD_T, 32 + fr, ks * 64 + fq * 16), ldfrag(SC, LD_T, wid * 16 + fr, ks * 64 + fq * 16), dacc, 0, 0, 0);
          if (fq == 0) DEN[wid * 16 + fr] = dacc[0];
        }
        lds_barrier();
        const int i = it * 16 + fr;
        const float dn = 1.0f / fmaxf(fabsf(DEN[i]), EM[i]);
        oacc *= dn;
      }
      const int i = it * 16 + fr;
      const int ti = dir ? (SEQ - 1 - (n * 64 + i)) : (n * 64 + i);
      *(u32x2*)(O + (tokbase + ti) * 1024 + ocol + vt * 16 + fq * 4) = (u32x2){pk(oacc[0], oacc[1]), pk(oacc[2], oacc[3])};
    }
    {
      constexpr int NST = (DK == 128) ? NVT : 1;
#pragma unroll
      for (int s = 0; s < NST; ++s) {
        const int dt = (DK == 128) ? wid : (wid & 3), vt = (DK == 128) ? s : (wid >> 2);
        const f32x4 dc = *(const f32x4*)(DEC + dt * 16 + fq * 4);
        f32x4 acc = sacc[s] * dc;
#pragma unroll
        for (int ks = 0; ks < 2; ++ks) acc = __builtin_amdgcn_mfma_f32_16x16x32_bf16(ldfrag(KT, LD_T, dt * 16 + fr, ks * 64 + fq * 16), ldfrag(VT, LD_T, vt * 16 + fr, ks * 64 + fq * 16), acc, 0, 0, 0);
        sacc[s] = acc;
        *(u32x2*)(ST + (vt * 16 + fr) * LD_D + (dt * 16 + fq * 4) * 2) = (u32x2){pk(acc[0], acc[1]), pk(acc[2], acc[3])};
      }
    }
    lds_barrier();
  }
}

template <int MIXER>
__device__ __forceinline__ void scan_dispatch(unsigned char* lds, int wv, const Params& p, int id) {
  const int vs = id & 3, dir = (id >> 2) & 1, h = (id >> 3) & 3, b = id >> 5;
  scan_item<MIXER>(lds, wv, p, b, h, dir, vs);
}
}

__device__ __forceinline__ void convd_phase(unsigned char* lds_, int wv, const Params& p) {
  const Ctx c = make_ctx(lds_, wv);
  bf16_t* P = (bf16_t*)(p.ws + WS_R1); bf16_t* QD = (bf16_t*)(p.ws + WS_LFB);
  const float* cw = p.in[I_CONV_W]; const float* cb = p.in[I_CONV_B];
  const int ch = c.lane * 16;
  float w0[16], w1[16], w2[16], bb[16];
#pragma unroll
  for (int j = 0; j < 16; ++j) { w0[j] = cw[ch + j]; w1[j] = cw[1024 + ch + j]; w2[j] = cw[2048 + ch + j]; bb[j] = cb[ch + j]; }
  for (int tok = c.bid * 8 + c.wid; tok < NTOK; tok += c.G * 8) {
    const int t = tok % SEQ;
    const bf16_t* row = P + PIDX(tok, 1536 + ch);
    float x0[16], x1[16], x2[16];
    { const u32x4* r1 = (const u32x4*)row; unpack8(r1[0], x1); unpack8(r1[1], x1 + 8); }
    if (t > 0) { const u32x4* r0 = (const u32x4*)(row - 128); unpack8(r0[0], x0); unpack8(r0[1], x0 + 8); }
    else {
#pragma unroll
      for (int j = 0; j < 16; ++j) x0[j] = 0.f; }
    if (t < SEQ - 1) { const u32x4* r2 = (const u32x4*)(row + 128); unpack8(r2[0], x2); unpack8(r2[1], x2 + 8); }
    else {
#pragma unroll
      for (int j = 0; j < 16; ++j) x2[j] = 0.f; }
    const float sc = ch < 512 ? 0.08838834764831845f : 1.0f;
    unsigned w[8];
#pragma unroll
    for (int j = 0; j < 8; ++j) {
      const float a0 = bb[2 * j] + w0[2 * j] * x0[2 * j] + w1[2 * j] * x1[2 * j] + w2[2 * j] * x2[2 * j];
      const float a1 = bb[2 * j + 1] + w0[2 * j + 1] * x0[2 * j + 1] + w1[2 * j + 1] * x1[2 * j + 1] + w2[2 * j + 1] * x2[2 * j + 1];
      w[j] = pk2(fsilu(a0) * sc, fsilu(a1) * sc);
    }
    u32x4* d = (ch < 512) ? (u32x4*)(QD + PIDX(tok, ch)) : (u32x4*)(P + PIDX(tok, 3584 + (ch - 512)));
    d[0] = (u32x4){w[0], w[1], w[2], w[3]}; d[1] = (u32x4){w[4], w[5], w[6], w[7]};
  }
}

__device__ __forceinline__ void scan_phase(unsigned char* lds, int wv, const Params& p, int layer) {
  for (int item = blockIdx.x; item < 256; item += gridDim.x) {
    if (layer == 0) { if (item < 128) scan::scan_dispatch<scan::MIX_A>(lds, wv, p, item); else scan::scan_dispatch<scan::MIX_B>(lds, wv, p, item - 128); }
    else { if (item < 128) scan::scan_dispatch<scan::MIX_D>(lds, wv, p, item); else scan::scan_dispatch<scan::MIX_C>(lds, wv, p, item - 128); }
    __syncthreads();
  }
}
#endif
#ifndef CPU_EMU
namespace scan2 {
using namespace scan;
constexpr int S_QS = 0, S_KS = 17408, S_QI = 34816, S_KT = 52224  , S_VT = 89088  , S_SC = 102912, S_ST = 112128  , S_DEC = 138240  , S_EM = 139264  , S_END = 139776;

constexpr int U_QI = 0, U_KS = 34816, U_KT = 69632, U_VT = 106496, U_SC = 120320, U_ST = 129536, U_DEC = 155648, U_EM = 156672, U_END = 157184;
template <int MIXER>
__device__ __forceinline__ void scan_item2(unsigned char* lds, int wv, const Params& p, int b, int h, int dir, int vs) {
  constexpr int DK = (MIXER == MIX_A || MIXER == MIX_D) ? 128 : 64;
  constexpr int NC = DK / 8;
  constexpr int LD_D = DK * 2 + 16;
  constexpr int NVT = MIXER == MIX_D ? 3 : 2;
  constexpr int NKD = DK / 32;
  constexpr int NST = (DK == 128) ? NVT : 1;
  constexpr int NCH = SEQ / 64;
  const int tid = opaque_tid(wv), lane0 = tid & 63, wid = __builtin_amdgcn_readfirstlane(tid >> 6);
  unsigned char* ws = p.ws;
  const bf16_t* P = (const bf16_t*)(ws + WS_R1);
  const bf16_t* LFBp = (const bf16_t*)(ws + WS_LFB);
  const float* side = (const float*)(ws + WS_SIDE);
  const float* rope = (const float*)(ws + WS_ROPE);
  bf16_t* O = (bf16_t*)(ws + WS_R2) + (size_t)dir * NTOK * 1024;
  unsigned char* SC = lds + U_SC;
  int qcol, kcol, lfcol, vcol, ocol;
  if (MIXER == MIX_A) { qcol = h * 128; kcol = 0; lfcol = 512 + dir * 512 + h * 128; vcol = 1536 + h * 128 + vs * 32; ocol = h * 128 + vs * 32; }
  else if (MIXER == MIX_B) { qcol = 2560 + h * 64; kcol = 2816 + h * 64; lfcol = dir * 256 + h * 64; vcol = 3072 + h * 128 + vs * 32; ocol = 512 + h * 128 + vs * 32; }
  else if (MIXER == MIX_C) { qcol = h * 64; kcol = 256 + h * 64; lfcol = 0; vcol = 512 + h * 128 + vs * 32; ocol = h * 128 + vs * 32; }
  else { qcol = h * 128; kcol = 3584 + h * 128; lfcol = 0; vcol = 2560 + h * 128 + vs * 32; ocol = 512 + h * 128 + vs * 32; }
  const size_t tokbase = (size_t)b * SEQ;
  const int c0 = (MIXER == MIX_C) ? wid * 4 : wid * NC;
  for (int i = tid; i < 2 * 13056 / 4; i += NTHREADS) ((unsigned*)(lds + U_ST))[i] = 0u;
  for (int i = tid; i < 9216 / 4; i += NTHREADS) ((unsigned*)(lds + U_SC))[i] = 0u;
  if (MIXER == MIX_D) { for (int i = tid; i < 2 * 16 * 64; i += NTHREADS) { const int bf = i >> 10, r = 32 + ((i >> 6) & 15), j = i & 63; *(bf16_t*)(lds + U_VT + bf * 6912 + r * LD_T + j * 2) = (r == 32) ? (bf16_t)0x3F80 : (bf16_t)0; } }
  const float lgam2 = (MIXER == MIX_C) ? log1pf(-exp2f(-(5.0f + 2.0f * (float)h + (float)dir))) * 1.4426950408889634f : 0.f;
  const float fgb = (MIXER == MIX_D) ? p.in[I_FGATE_B][dir * 4 + h] : 0.f;
  float m_st = 0.f;
  __syncthreads();

  Raw R, Rn; u32x2 Rv, Rvn;
#define A_LOAD(R, Rv, n_) do { \
    const int ln_ = lane0; \
    const int t_ = dir ? (SEQ - 1 - ((n_) * 64 + ln_)) : ((n_) * 64 + ln_); \
    const size_t tk_ = tokbase + t_; \
    if (MIXER == MIX_A) { const u32x4* qp_ = (const u32x4*)(P + PIDX(tk_, qcol + c0)); const u32x4* lp_ = (const u32x4*)(P + PIDX(tk_, lfcol + c0)); R.a0 = qp_[0]; R.a1 = qp_[1]; R.b0 = lp_[0]; R.b1 = lp_[1]; } \
    else if (MIXER == MIX_B) { R.a0 = *(const u32x4*)(P + PIDX(tk_, qcol + c0)); R.a1 = *(const u32x4*)(P + PIDX(tk_, kcol + c0)); R.b0 = *(const u32x4*)(LFBp + PIDX(tk_, lfcol + c0)); } \
    else if (MIXER == MIX_C) { const u32x2 qa_ = *(const u32x2*)(P + PIDX(tk_, qcol + c0)), qb_ = *(const u32x2*)(P + PIDX(tk_, qcol + 32 + c0)), ka_ = *(const u32x2*)(P + PIDX(tk_, kcol + c0)), kb_ = *(const u32x2*)(P + PIDX(tk_, kcol + 32 + c0)); \
      R.a0 = (u32x4){qa_.x, qa_.y, qb_.x, qb_.y}; R.a1 = (u32x4){ka_.x, ka_.y, kb_.x, kb_.y}; \
      R.r0 = *(const f32x4*)(rope + ((size_t)t_ * 32 + c0) * 2); R.r1 = *(const f32x4*)(rope + ((size_t)t_ * 32 + c0) * 2 + 4); } \
    else { const u32x4* qp_ = (const u32x4*)(LFBp + PIDX(tk_, qcol + c0)); const u32x4* kp_ = (const u32x4*)(P + PIDX(tk_, kcol + c0)); R.a0 = qp_[0]; R.a1 = qp_[1]; R.b0 = kp_[0]; R.b1 = kp_[1]; \
      R.s0 = side[tk_ * 32 + dir * 8 + h]; R.s1 = side[tk_ * 32 + dir * 8 + 4 + h]; } \
    Rv = *(const u32x2*)(P + PIDX(tk_, vcol + wid * 4)); } while (0)

  float rr_next = 1.f, rr_cur = 1.f;
#define A_PREP(buf_, R, Rv) do { \
    const int lane = lane0; \
    unsigned char* KTb = lds + U_KT + (buf_) * 18432; float* DECb = (float*)(lds + U_DEC + (buf_) * 512); float* EMb = (float*)(lds + U_EM + (buf_) * 256); \
    unsigned char* QIb = lds + U_QI + (buf_) * 17408; unsigned char* KSb = lds + U_KS + (buf_) * 17408; \
    float q[NC], k[NC], g[NC], ktv[NC]; \
    if (MIXER == MIX_A) { \
      const unsigned qw[8] = {R.a0.x, R.a0.y, R.a0.z, R.a0.w, R.a1.x, R.a1.y, R.a1.z, R.a1.w}, lw[8] = {R.b0.x, R.b0.y, R.b0.z, R.b0.w, R.b1.x, R.b1.y, R.b1.z, R.b1.w}; \
      _Pragma("unroll") for (int c = 0; c < 8; ++c) { q[2 * c] = lo16(qw[c]); q[2 * c + 1] = hi16(qw[c]); g[2 * c] = lo16(lw[c]); g[2 * c + 1] = hi16(lw[c]); } \
      _Pragma("unroll") for (int c = 0; c < NC; ++c) k[c] = 1.0f - __builtin_amdgcn_exp2f(g[c]); \
    } else if (MIXER == MIX_B) { \
      const unsigned qw[4] = {R.a0.x, R.a0.y, R.a0.z, R.a0.w}, kw[4] = {R.a1.x, R.a1.y, R.a1.z, R.a1.w}, lw[4] = {R.b0.x, R.b0.y, R.b0.z, R.b0.w}; \
      _Pragma("unroll") for (int c = 0; c < 4; ++c) { q[2 * c] = lo16(qw[c]); q[2 * c + 1] = hi16(qw[c]); k[2 * c] = lo16(kw[c]); k[2 * c + 1] = hi16(kw[c]); g[2 * c] = lo16(lw[c]); g[2 * c + 1] = hi16(lw[c]); } \
    } else if (MIXER == MIX_C) { \
      const float cs[4] = {R.r0[0], R.r0[2], R.r1[0], R.r1[2]}, sn[4] = {R.r0[1], R.r0[3], R.r1[1], R.r1[3]}; \
      const float q1[4] = {lo16(R.a0.x), hi16(R.a0.x), lo16(R.a0.y), hi16(R.a0.y)}, q2[4] = {lo16(R.a0.z), hi16(R.a0.z), lo16(R.a0.w), hi16(R.a0.w)}; \
      const float k1[4] = {lo16(R.a1.x), hi16(R.a1.x), lo16(R.a1.y), hi16(R.a1.y)}, k2[4] = {lo16(R.a1.z), hi16(R.a1.z), lo16(R.a1.w), hi16(R.a1.w)}; \
      _Pragma("unroll") for (int c = 0; c < 4; ++c) { q[c] = (q1[c] * cs[c] - q2[c] * sn[c]) * 0.125f; q[4 + c] = (q1[c] * sn[c] + q2[c] * cs[c]) * 0.125f; k[c] = k1[c] * cs[c] - k2[c] * sn[c]; k[4 + c] = k1[c] * sn[c] + k2[c] * cs[c]; } \
    } else { \
      const unsigned qw[8] = {R.a0.x, R.a0.y, R.a0.z, R.a0.w, R.a1.x, R.a1.y, R.a1.z, R.a1.w}, kw[8] = {R.b0.x, R.b0.y, R.b0.z, R.b0.w, R.b1.x, R.b1.y, R.b1.z, R.b1.w}; \
      _Pragma("unroll") for (int c = 0; c < 8; ++c) { q[2 * c] = lo16(qw[c]); q[2 * c + 1] = hi16(qw[c]); k[2 * c] = lo16(kw[c]); k[2 * c + 1] = hi16(kw[c]); } \
    } \
    if (MIXER == MIX_A || MIXER == MIX_B) { \
        \
      _Pragma("unroll") for (int c = 0; c < NC; ++c) g[c] += __builtin_bit_cast(float, __builtin_amdgcn_update_dpp(0, __builtin_bit_cast(int, g[c]), 0x111, 0xf, 0xf, false)); \
      _Pragma("unroll") for (int c = 0; c < NC; ++c) g[c] += __builtin_bit_cast(float, __builtin_amdgcn_update_dpp(0, __builtin_bit_cast(int, g[c]), 0x112, 0xf, 0xf, false)); \
      _Pragma("unroll") for (int c = 0; c < NC; ++c) g[c] += __builtin_bit_cast(float, __builtin_amdgcn_update_dpp(0, __builtin_bit_cast(int, g[c]), 0x114, 0xf, 0xf, false)); \
      _Pragma("unroll") for (int c = 0; c < NC; ++c) g[c] += __builtin_bit_cast(float, __builtin_amdgcn_update_dpp(0, __builtin_bit_cast(int, g[c]), 0x118, 0xf, 0xf, false)); \
      _Pragma("unroll") for (int c = 0; c < NC; ++c) g[c] += __builtin_bit_cast(float, __builtin_amdgcn_update_dpp(0, __builtin_bit_cast(int, g[c]), 0x142, 0xa, 0xf, false)); \
      _Pragma("unroll") for (int c = 0; c < NC; ++c) g[c] += __builtin_bit_cast(float, __builtin_amdgcn_update_dpp(0, __builtin_bit_cast(int, g[c]), 0x143, 0xc, 0xf, false)); \
      float ev[NC]; \
      _Pragma("unroll") for (int c = 0; c < NC; ++c) { \
          \
        const float e = __builtin_amdgcn_exp2f(g[c]), r = __builtin_amdgcn_rcpf(e); \
        const float e63 = rdlane(e, 63); \
        q[c] *= e; k[c] *= r; ktv[c] = k[c] * e63;     \
        ev[c] = e; } \
      if (lane == 63) { _Pragma("unroll") for (int c = 0; c < NC / 4; ++c) *(f32x4*)(DECb + c0 + 4 * c) = (f32x4){ev[4 * c], ev[4 * c + 1], ev[4 * c + 2], ev[4 * c + 3]}; } \
    } else if (MIXER == MIX_C) { \
        \
      const float gl = (float)(lane + 1) * lgam2; \
      const float e = __builtin_amdgcn_exp2f(gl), r = __builtin_amdgcn_rcpf(e); \
      const float e63 = rdlane(e, 63); const float f_kt = r * e63; \
      _Pragma("unroll") for (int c = 0; c < NC; ++c) { q[c] *= e; ktv[c] = k[c] * f_kt; k[c] *= r; } \
      if (lane < 4) { DECb[c0 + lane] = e63; DECb[32 + c0 + lane] = e63; } \
    } else { \
      const float li = R.s0, lf = R.s1;     \
      const float bc = incl_scan_add(lf); const float u = li - bc; const float pm = incl_scan_max(u); \
      const float cmax = rdlane(pm, 63), blast = rdlane(bc, 63); \
      const float a_i = bc + m_st, m_i = fmaxf(a_i, bc + pm); \
      const float d_alpha = __builtin_amdgcn_exp2f(bc - m_i + cmax), d_beta = __builtin_amdgcn_exp2f(u - cmax); \
      rr_next = __builtin_amdgcn_exp2f(m_st - cmax);     \
      const float m_new = fmaxf(blast + m_st, blast + cmax); \
      const float d_sold = __builtin_amdgcn_exp2f(blast + m_st - m_new), d_wks = __builtin_amdgcn_exp2f(blast + u - m_new); m_st = m_new; \
      _Pragma("unroll") for (int c = 0; c < NC; ++c) { ktv[c] = k[c] * d_wks; q[c] *= d_alpha; k[c] *= d_beta; if (lane == 63) DECb[c0 + c] = d_sold; } \
      if (wid == 0) EMb[lane] = __builtin_amdgcn_exp2f(-m_i); \
    } \
    _Pragma("unroll") for (int c = 0; c < NC / 2; ++c) { const unsigned w_ = pk_hw(ktv[2 * c], ktv[2 * c + 1]); \
      const int d0_ = (MIXER == MIX_C) ? (2 * c < 4 ? c0 + 2 * c : 32 + c0 + 2 * c - 4) : c0 + 2 * c; \
      *(bf16_t*)(KTb + d0_ * LD_T + lane * 2) = (bf16_t)(w_ & 0xffff); *(bf16_t*)(KTb + (d0_ + 1) * LD_T + lane * 2) = (bf16_t)(w_ >> 16); } \
    { unsigned pq[NC / 2], pks[NC / 2]; \
      _Pragma("unroll") for (int c = 0; c < NC / 2; ++c) { pq[c] = pk_hw(q[2 * c], q[2 * c + 1]); pks[c] = pk_hw(k[2 * c], k[2 * c + 1]); } \
      if (MIXER == MIX_C) { \
        *(u32x2*)(QIb + lane * LD_D + c0 * 2) = (u32x2){pq[0], pq[1]}; *(u32x2*)(QIb + lane * LD_D + (32 + c0) * 2) = (u32x2){pq[2], pq[3]}; \
        *(u32x2*)(KSb + lane * LD_D + c0 * 2) = (u32x2){pks[0], pks[1]}; *(u32x2*)(KSb + lane * LD_D + (32 + c0) * 2) = (u32x2){pks[2], pks[3]}; \
      } else { \
        _Pragma("unroll") for (int c = 0; c < NC / 8; ++c) { \
          *(u32x4*)(QIb + lane * LD_D + (c0 + 8 * c) * 2) = (u32x4){pq[4 * c], pq[4 * c + 1], pq[4 * c + 2], pq[4 * c + 3]}; \
          *(u32x4*)(KSb + lane * LD_D + (c0 + 8 * c) * 2) = (u32x4){pks[4 * c], pks[4 * c + 1], pks[4 * c + 2], pks[4 * c + 3]}; } } } \
    { unsigned char* VTb = lds + U_VT + (buf_) * 6912 + (wid * 4) * LD_T + lane * 2; \
      *(bf16_t*)(VTb + 0 * LD_T) = (bf16_t)(Rv.x & 0xffff); *(bf16_t*)(VTb + 1 * LD_T) = (bf16_t)(Rv.x >> 16); *(bf16_t*)(VTb + 2 * LD_T) = (bf16_t)(Rv.y & 0xffff); *(bf16_t*)(VTb + 3 * LD_T) = (bf16_t)(Rv.y >> 16); } \
  } while (0)
  f32x4 sacc[NST];
#pragma unroll
  for (int i = 0; i < NST; ++i) sacc[i] = (f32x4){0.f, 0.f, 0.f, 0.f};
  A_LOAD(R, Rv, 0);
  A_PREP(0, R, Rv);
  A_LOAD(R, Rv, 1);
  A_LOAD(Rn, Rvn, 2);
  rr_cur = rr_next;
  lds_barrier();
#define SCAN_ITER(n_, RX, RvX) do { const int n = (n_); \
    const int cb = n & 1, nb = (n + 1) & 1; \
    if (n + 1 < NCH) { A_PREP(nb, RX, RvX); if (n + 3 < NCH) A_LOAD(RX, RvX, n + 3); } \
    { { \
      const int lane = lane0; \
      const int fr = lane & 15, fq = lane >> 4; \
      const int it = wid & 3, vt = wid >> 2; \
      const unsigned char* STc = lds + U_ST + cb * 13056; unsigned char* STn = lds + U_ST + nb * 13056; \
      const unsigned char* KTc = lds + U_KT + cb * 18432; const unsigned char* VTc = lds + U_VT + cb * 6912; \
      const unsigned char* QI = lds + U_QI + cb * 17408; const unsigned char* KS = lds + U_KS + cb * 17408; \
      const float* DECc = (const float*)(lds + U_DEC + cb * 512); const float* EMc = (const float*)(lds + U_EM + cb * 256); \
_Pragma("unroll") \
      for (int jt = 0; jt < 4; ++jt) { \
        if (jt <= it) { \
          f32x4 acc = (f32x4){0.f, 0.f, 0.f, 0.f}; \
_Pragma("unroll") \
          for (int ks = 0; ks < NKD; ++ks) acc = __builtin_amdgcn_mfma_f32_16x16x32_bf16(ldfrag(KS, LD_D, jt * 16 + fr, ks * 64 + fq * 16), ldfrag(QI, LD_D, it * 16 + fr, ks * 64 + fq * 16), acc, 0, 0, 0); \
          const int i = it * 16 + fr, j0 = jt * 16 + fq * 4; \
          if (jt == it) { const float v0 = (j0 + 0 <= i) ? acc[0] : 0.f, v1 = (j0 + 1 <= i) ? acc[1] : 0.f, v2 = (j0 + 2 <= i) ? acc[2] : 0.f, v3 = (j0 + 3 <= i) ? acc[3] : 0.f; \
            *(u32x2*)(SC + i * LD_T + j0 * 2) = (u32x2){pk_hw(v0, v1), pk_hw(v2, v3)}; } \
          else *(u32x2*)(SC + i * LD_T + j0 * 2) = (u32x2){pk_hw(acc[0], acc[1]), pk_hw(acc[2], acc[3])}; \
        } \
      } \
      f32x4 oacc = (f32x4){0.f, 0.f, 0.f, 0.f}, dacc = (f32x4){0.f, 0.f, 0.f, 0.f}; \
_Pragma("unroll") \
      for (int ks = 0; ks < NKD; ++ks) oacc = __builtin_amdgcn_mfma_f32_16x16x32_bf16(ldfrag(STc, LD_D, vt * 16 + fr, ks * 64 + fq * 16), ldfrag(QI, LD_D, it * 16 + fr, ks * 64 + fq * 16), oacc, 0, 0, 0); \
      if (NVT == 3) { \
_Pragma("unroll") \
        for (int ks = 0; ks < NKD; ++ks) dacc = __builtin_amdgcn_mfma_f32_16x16x32_bf16(ldfrag(STc, LD_D, 32 + fr, ks * 64 + fq * 16), ldfrag(QI, LD_D, it * 16 + fr, ks * 64 + fq * 16), dacc, 0, 0, 0); \
      } \
      if (MIXER == MIX_D) { oacc *= rr_cur; dacc *= rr_cur; } \
      asm volatile("s_waitcnt lgkmcnt(0)" ::: "memory"); \
      oacc = __builtin_amdgcn_mfma_f32_16x16x32_bf16(ldfrag(VTc, LD_T, vt * 16 + fr, fq * 16), ldfrag(SC, LD_T, it * 16 + fr, fq * 16), oacc, 0, 0, 0); \
      if (it >= 2) oacc = __builtin_amdgcn_mfma_f32_16x16x32_bf16(ldfrag(VTc, LD_T, vt * 16 + fr, 64 + fq * 16), ldfrag(SC, LD_T, it * 16 + fr, 64 + fq * 16), oacc, 0, 0, 0); \
      float dn = 1.0f; \
      if (NVT == 3) { \
        dacc = __builtin_amdgcn_mfma_f32_16x16x32_bf16(ldfrag(VTc, LD_T, 32 + fr, fq * 16), ldfrag(SC, LD_T, it * 16 + fr, fq * 16), dacc, 0, 0, 0); \
        if (it >= 2) dacc = __builtin_amdgcn_mfma_f32_16x16x32_bf16(ldfrag(VTc, LD_T, 32 + fr, 64 + fq * 16), ldfrag(SC, LD_T, it * 16 + fr, 64 + fq * 16), dacc, 0, 0, 0); \
        const float den = __shfl(dacc[0], fr); \
        dn = 1.0f / fmaxf(fabsf(den), EMc[it * 16 + fr]); \
      } \
      { \
        const int i = it * 16 + fr; \
        const int ti = dir ? (SEQ - 1 - (n * 64 + i)) : (n * 64 + i); \
        const f32x4 o = oacc * dn; \
        *(u32x2*)(O + PIDX(tokbase + ti, ocol + vt * 16 + fq * 4)) = (u32x2){pk_hw(o[0], o[1]), pk_hw(o[2], o[3])}; \
      } \
_Pragma("unroll") \
      for (int s = 0; s < NST; ++s) { \
        const int dt = (DK == 128) ? wid : (wid & 3), vt2 = (DK == 128) ? s : (wid >> 2); \
        const f32x4 dc = *(const f32x4*)(DECc + dt * 16 + fq * 4); \
        f32x4 acc = sacc[s] * dc; \
_Pragma("unroll") \
        for (int ks = 0; ks < 2; ++ks) acc = __builtin_amdgcn_mfma_f32_16x16x32_bf16(ldfrag(KTc, LD_T, dt * 16 + fr, ks * 64 + fq * 16), ldfrag(VTc, LD_T, vt2 * 16 + fr, ks * 64 + fq * 16), acc, 0, 0, 0); \
        sacc[s] = acc; \
        *(u32x2*)(STn + (vt2 * 16 + fr) * LD_D + (dt * 16 + fq * 4) * 2) = (u32x2){pk_hw(acc[0], acc[1]), pk_hw(acc[2], acc[3])}; \
      } \
    } \
    } \
    rr_cur = rr_next; \
    lds_barrier(); \
  } while (0)
  static_assert(NCH % 2 == 0, "chunk count must be even");
#pragma unroll 1
  for (int n2 = 0; n2 < NCH; n2 += 2) { SCAN_ITER(n2, R, Rv); SCAN_ITER(n2 + 1, Rn, Rvn); }
#undef SCAN_ITER
#undef A_LOAD
#undef A_PREP
}

template <int MIXER>
__device__ __forceinline__ void scan_dispatch2(unsigned char* lds, int wv, const Params& p, int id) {
  const int vs = id & 3, dir = (id >> 2) & 1, h = (id >> 3) & 3, b = id >> 5;
  scan_item2<MIXER>(lds, wv, p, b, h, dir, vs);
}
}

__device__ __forceinline__ void scan_phase2(unsigned char* lds, int wv, const Params& p, int layer) {
  for (int it0 = blockIdx.x; it0 < 256; it0 += gridDim.x) {
    const int xq = it0 & 7, yq = it0 >> 3, stream = (yq >> 2) * 8 + xq;
    const int item = (stream >> 5) * 128 + (stream & 31) * 4 + (yq & 3);
    if (layer == 0) { if (item < 128) scan2::scan_dispatch2<scan::MIX_A>(lds, wv, p, item); else scan2::scan_dispatch2<scan::MIX_B>(lds, wv, p, item - 128); }
    else { if (item < 128) scan2::scan_dispatch2<scan::MIX_D>(lds, wv, p, item); else scan2::scan_dispatch2<scan::MIX_C>(lds, wv, p, item - 128); }
    __syncthreads();
  }
}
#endif
#ifndef CPU_EMU
#define XB_BASE     2048
#define XB_TMO      (XB_BASE + 128)
#define XB_XCNT(j)  (XB_BASE + 256  + 64 * (j))
#define XB_XSUB(j)  (XB_BASE + 1280 + 64 * (j))
#define XB_XGEN(j)  (XB_BASE + 2304 + 64 * (j))
#define XB_TOP      (XB_BASE + 3328)
#define XB_TOPGEN   (XB_BASE + 3392)
#define XB_WORDS    3456
#define XB_SPIN_CAP (1u << 22)
#define XB_LDS_OFF  (LDS_BYTES - 16)
__device__ __forceinline__ unsigned xb_ld(unsigned* p)              { return __hip_atomic_load(p, __ATOMIC_RELAXED, __HIP_MEMORY_SCOPE_AGENT); }
__device__ __forceinline__ unsigned xb_add(unsigned* p, unsigned v) { return __hip_atomic_fetch_add(p, v, __ATOMIC_RELAXED, __HIP_MEMORY_SCOPE_AGENT); }
__device__ __forceinline__ unsigned xb_xcc_id() { return (unsigned)__builtin_amdgcn_s_getreg((3 << 11) | 20) & 0xFu; }
#define XB_SPIN(cond, bar) do { unsigned _sp = 0; while (cond) { __builtin_amdgcn_s_sleep(1); \
    if ((++_sp & 255u) == 0u) { if (xb_ld(&(bar)[XB_TMO])) break; if (_sp > XB_SPIN_CAP) { atomicAdd(&(bar)[XB_TMO], 1u); break; } } } } while (0)
__device__ __forceinline__ void grid_bar(unsigned* bar, unsigned char* lds_raw, int wv) {
  asm volatile("s_waitcnt vmcnt(0)" ::: "memory");
  __syncthreads();
  if (wv == 0 && lane_id() == 0) {
    volatile unsigned* st = (volatile unsigned*)(lds_raw + XB_LDS_OFF);
    __builtin_amdgcn_s_waitcnt(0);
    const unsigned x = xb_xcc_id();
    unsigned nloc = st[0], nx = st[1];
    if (nloc == 0u) {
      const unsigned G = gridDim.x; unsigned sum, cnt, mine, sp = 0u;
      for (;;) { sum = 0u; cnt = 0u; mine = 0u;
#pragma unroll
        for (unsigned j = 0; j < 16; ++j) { const unsigned c = xb_ld(&bar[XB_XCNT(j)]); sum += c; cnt += (c > 0u) ? 1u : 0u; mine = (j == x) ? c : mine; }
        if (sum == G) break;
        __builtin_amdgcn_s_sleep(1);
        if ((++sp & 255u) == 0u) { if (xb_ld(&bar[XB_TMO])) break; if (sp > XB_SPIN_CAP) { atomicAdd(&bar[XB_TMO], 1u); break; } } }
      nloc = mine > 0u ? mine : 1u; nx = cnt > 0u ? cnt : 1u; st[0] = nloc; st[1] = nx;
    }
    const unsigned old = xb_add(&bar[XB_XSUB(x)], 1u);
    const unsigned gen = old / nloc;
    if (old + 1u == (gen + 1u) * nloc) {
      __builtin_amdgcn_fence(__ATOMIC_RELEASE, "agent");
      asm volatile("s_waitcnt vmcnt(0)" ::: "memory");
      const unsigned og = xb_add(&bar[XB_TOP], 1u);
      const unsigned tg = og / nx;
      if (og + 1u == (tg + 1u) * nx) xb_add(&bar[XB_TOPGEN], 1u);
      else XB_SPIN(xb_ld(&bar[XB_TOPGEN]) == tg, bar);
      __builtin_amdgcn_fence(__ATOMIC_ACQUIRE, "agent");
      xb_add(&bar[XB_XGEN(x)], 1u);
      asm volatile("s_waitcnt vmcnt(0)" ::: "memory");
    } else {
      XB_SPIN(xb_ld(&bar[XB_XGEN(x)]) == gen, bar);
      __builtin_amdgcn_fence(__ATOMIC_ACQUIRE, "agent");
      asm volatile("s_waitcnt vmcnt(0)" ::: "memory");
    }
  }
  __syncthreads();
}
#if (PROBE_DUP & 16)
#define grid_bar(a, b, c) do { grid_bar(a, b, c); grid_bar(a, b, c); } while (0)
#endif

__global__ void __launch_bounds__(NTHREADS) mk_fwd(Params p) {
  extern __shared__ __attribute__((aligned(16))) unsigned char lds_raw[];
  cg::grid_group grid = cg::this_grid();
  const int G = gridDim.x, bid = blockIdx.x;
  const int wv = __builtin_amdgcn_readfirstlane(threadIdx.x >> 6);
  PG8_LAS unsigned char* lds = (PG8_LAS unsigned char*)lds_raw;
  unsigned char* ws = p.ws;

  if (threadIdx.x < 4) ((unsigned*)(lds_raw + XB_LDS_OFF))[threadIdx.x] = 0u;
  p0_prologue(lds_raw, wv, p);
#if (PROBE_DUP & 128)
  p0_prologue(lds_raw, wv, p);
#endif
  grid.sync();
  unsigned* bar = (unsigned*)(ws + WS_CTL);
  if (wv == 0 && lane_id() == 0) (void)xb_add(&bar[XB_XCNT(xb_xcc_id())], 1u);
  for (int layer = 0; layer < 2; ++layer) {
    { ProbInProj pr; pr.so.init(NTOK, layer == 0 ? PM_AB : PM_CD, G, bid); pr.A = (const char*)(ws + WS_HB); pr.Bt = (const char*)(ws + (layer == 0 ? WS_WIN_AB : WS_WIN_CD));
      pr.P = (bf16_t*)(ws + WS_R1); pr.bias = p.in[layer == 0 ? I_AB_B_IN : I_CD_B_IN]; pr.lb = (const float*)(ws + WS_LB); pr.layer = layer;
      pg8::gemm_phase(lds, pr, wv);
#if (PROBE_DUP & (1 | 2048))
      pg8::gemm_phase(lds, pr, wv);
#endif
      if (layer == 0) side_phase<32>(lds_raw, wv, p, 0); else side_phase<16>(lds_raw, wv, p, 1);
#if (PROBE_DUP & 256)
      if (layer == 0) side_phase<32>(lds_raw, wv, p, 0); else side_phase<16>(lds_raw, wv, p, 1);
#endif
 }
    grid_bar(bar, lds_raw, wv);
    if (layer == 1) { convd_phase(lds_raw, wv, p); grid_bar(bar, lds_raw, wv); }
    scan_phase2(lds_raw, wv, p, layer);
#if (PROBE_DUP & 2)
    scan_phase2(lds_raw, wv, p, layer);
#endif
#if (PROBE_DUP & 512)
    if (layer == 0) scan_phase2(lds_raw, wv, p, layer);
#endif
#if (PROBE_DUP & 1024)
    if (layer == 1) scan_phase2(lds_raw, wv, p, layer);
#endif
    grid_bar(bar, lds_raw, wv);
    headnorm_phase(lds_raw, wv, p, layer);
#if (PROBE_DUP & 8)
    headnorm_phase(lds_raw, wv, p, layer);
#endif
    grid_bar(bar, lds_raw, wv);
    { ProbOutProj pr; pr.so.init(NTOK, 1024, G, bid); pr.A = (const char*)(ws + WS_HB); pr.Bt = (const char*)(ws + (layer == 0 ? WS_WOUT_AB : WS_WOUT_CD)); pr.Y = (float*)(ws + WS_R2); pr.Hres = layer == 0 ? p.in[I_X] : p.out;
      pg8::gemm_phase(lds, pr, wv);
#if (PROBE_DUP & (1 | 16384))
      pg8::gemm_phase(lds, pr, wv);
#endif
      moe_weight_convert(lds_raw, wv, p, layer);
#if (PROBE_DUP & 4)
      moe_weight_convert(lds_raw, wv, p, layer);
#endif
 }
    grid_bar(bar, lds_raw, wv);
#if (PROBE_DUP & 32)
    ln_phase(lds_raw, wv, p, layer, 0, 1);
#endif
    ln_phase(lds_raw, wv, p, layer, 0);
    grid_bar(bar, lds_raw, wv);
    { ProbMoe1 pr; pr.mo.init((const int*)((const unsigned*)(ws + WS_CTL) + CW_CNT(layer)), 8, G, bid, lds_raw, wv);
      pr.A = (const char*)(ws + WS_HB); pr.W13 = (const char*)(ws + WS_WMOE); pr.list = (const int*)(ws + WS_LIST) + (size_t)layer * NEXP * NTOK; pr.H = (bf16_t*)(ws + WS_H);
      pg8::gemm_phase(lds, pr, wv);
#if (PROBE_DUP & (1 | 4096))
      pg8::gemm_phase(lds, pr, wv);
#endif
 }
    grid_bar(bar, lds_raw, wv);
    { ProbMoe2 pr; pr.mo.init((const int*)((const unsigned*)(ws + WS_CTL) + CW_CNT(layer)), 4, G, bid, lds_raw, wv);
      pr.A = (const char*)(ws + WS_H); pr.W2 = (const char*)(ws + WS_WMOE) + (size_t)NEXP * 2048 * 1024 * 2; pr.Y = (bf16_t*)(ws + WS_R2);
      pg8::gemm_phase(lds, pr, wv);
#if (PROBE_DUP & (1 | 8192))
      pg8::gemm_phase(lds, pr, wv);
#endif
 }
    grid_bar(bar, lds_raw, wv);
#if (PROBE_DUP & 64)
    ln_phase(lds_raw, wv, p, layer, 1, 1);
#endif
    ln_phase(lds_raw, wv, p, layer, 1);
    if (layer == 0) grid_bar(bar, lds_raw, wv);
  }
}

extern "C" void kernel_launch(void* const* d_in, const int* in_sizes, int n_in, void* d_out, int out_size, void* d_ws, size_t ws_size, hipStream_t stream) {
  static int grid_blocks = 0;
  if (grid_blocks == 0) {
    if (n_in != N_IN || ws_size < WS_END || out_size != NTOK * 1024) { fprintf(stderr, "kernel_launch: bad shapes: n_in %d ws %zu (need %zu) out %d\n", n_in, ws_size, (size_t)WS_END, out_size); grid_blocks = -1; return; }
    int dev = 0, cus = 0, per_cu = 0;
    hipGetDevice(&dev); hipDeviceGetAttribute(&cus, hipDeviceAttributeMultiprocessorCount, dev);
    if (hipFuncSetAttribute((const void*)mk_fwd, hipFuncAttributeMaxDynamicSharedMemorySize, LDS_BYTES) != hipSuccess) { fprintf(stderr, "kernel_launch: hipFuncSetAttribute failed\n"); grid_blocks = -1; return; }
    if (hipOccupancyMaxActiveBlocksPerMultiprocessor(&per_cu, (const void*)mk_fwd, NTHREADS, LDS_BYTES) != hipSuccess || per_cu < 1) { fprintf(stderr, "kernel_launch: occupancy query failed (%d)\n", per_cu); grid_blocks = -1; return; }
    grid_blocks = cus;
    (void)in_sizes;
  }
  if (grid_blocks < 0) return;
  Params p{};
  for (int i = 0; i < N_IN; ++i) p.in[i] = (const float*)d_in[i];
  p.out = (float*)d_out; p.ws = (unsigned char*)d_ws;
  void* args[] = {&p};
  hipError_t e = hipLaunchCooperativeKernel((const void*)mk_fwd, dim3(grid_blocks), dim3(NTHREADS), args, LDS_BYTES, stream);
  if (e != hipSuccess) fprintf(stderr, "cooperative launch failed: %s (grid %d)\n", hipGetErrorString(e), grid_blocks);
}
#endif
#ifdef CPU_EMU
#include <vector>
void dbg_cmp(const char* name, const float* p, long n);
template <class F> static void run_functor(const F& f, long n) {
#pragma omp parallel for schedule(dynamic, 16)
  for (long g = 0; g < n; ++g) f(g);
}
static void cpu_round_w(const float* src, size_t n, std::vector<float>& dst) { dst.resize(n); for (size_t i = 0; i < n; ++i) dst[i] = bf2f(f2bf(src[i])); }

extern "C" void kernel_launch(void* const* d_in, const int* in_sizes, int n_in, void* d_out, int out_size, void* d_ws, size_t ws_size, hipStream_t) {
  (void)in_sizes; (void)n_in; (void)out_size;
  if (ws_size < WS_END) { printf("ws too small %zu < %zu\n", ws_size, (size_t)WS_END); return; }
  Params p{}; for (int i = 0; i < N_IN; ++i) p.in[i] = (const float*)d_in[i];
  p.out = (float*)d_out; p.ws = (unsigned char*)d_ws;
  unsigned char* ws = p.ws;
  bf16_t* HB = (bf16_t*)(ws + WS_HB); bf16_t* P = (bf16_t*)(ws + WS_R1); bf16_t* LFB = (bf16_t*)(ws + WS_LFB);
  bf16_t* O = (bf16_t*)(ws + WS_R2); float* yf = (float*)(ws + WS_R2); bf16_t* Y = (bf16_t*)(ws + WS_R2); bf16_t* H = (bf16_t*)(ws + WS_H);
  float* side = (float*)(ws + WS_SIDE); float* oside = (float*)(ws + WS_OSIDE); float* rope = (float*)(ws + WS_ROPE); float* lb = (float*)(ws + WS_LB);
  int* assign = (int*)(ws + WS_ASSIGN); float* gate = (float*)(ws + WS_GATE);
  for (size_t i = 0; i < (size_t)NTOK * 1024; ++i) HB[i] = f2bf(p.in[I_X][i]);
  for (int i = 0; i < SEQ * 32; ++i) { int t = i >> 5, f = i & 31; float freq = powf(10000.0f, -(float)f / 32.0f); float ang = (float)t * freq; rope[i * 2] = cosf(ang); rope[i * 2 + 1] = sinf(ang); }
  for (int cc = 0; cc < 512; ++cc) { const float* hl = p.in[I_HGRN_LB]; float a0 = hl[cc], a1 = hl[512 + cc], a2 = hl[1024 + cc]; float mx = fmaxf(a0, fmaxf(a1, a2));
    float e0 = expf(a0 - mx), e1 = expf(a1 - mx), e2 = expf(a2 - mx); lb[cc] = e0 / (e0 + e1 + e2); }
  std::vector<float> wr;
  for (int layer = 0; layer < 2; ++layer) {
    const int PW = layer == 0 ? P_AB : P_CD, PM = layer == 0 ? PM_AB : PM_CD;
    const float* bias = p.in[layer == 0 ? I_AB_B_IN : I_CD_B_IN];
    cpu_round_w(p.in[layer == 0 ? I_AB_W_IN : I_CD_W_IN], (size_t)1024 * PW, wr);
#pragma omp parallel for
    for (long tok = 0; tok < NTOK; ++tok) {
      std::vector<float> acc(PW, 0.f);
      for (int k = 0; k < 1024; ++k) { float a = bf2f(HB[tok * 1024 + k]); const float* w = &wr[(size_t)k * PW]; for (int n = 0; n < PW; ++n) acc[n] += a * w[n]; }
      for (int n = 0; n < PM; ++n) { float v = acc[n] + bias[n]; if (layer == 0) v = epi_ab(n, v, lb); P[tok * PSTRIDE + n] = f2bf(v); }
      for (int n = PM; n < PW; ++n) side[tok * 32 + (n - PM)] = acc[n] + bias[n];
      if (layer == 0) for (int dir = 0; dir < 2; ++dir) for (int cc = 0; cc < 256; ++cc) {
        float z = p.in[I_GK_B][dir * 256 + cc];
        for (int r = 0; r < 16; ++r) z += side[tok * 32 + dir * 16 + r] * p.in[I_GK_UP][(dir * 16 + r) * 256 + cc];
        LFB[tok * 512 + dir * 256 + cc] = f2bf(logsigmoidf_(z) * 0.0625f); }
    }
    if (layer == 0) { ScanAB2 s{}; s.P = P; s.LFB = LFB; s.O = O; run_functor(s, (long)BATCH * 2048); }
    else { PrepCD2 pc{}; pc.P = P; pc.QD = LFB; pc.rope = rope; pc.conv_w = p.in[I_CONV_W]; pc.conv_b = p.in[I_CONV_B]; run_functor(pc, (long)NTOK * 1280);
      ScanCD2 s{}; s.P = P; s.QD = LFB; s.side = side; s.fgate_b = p.in[I_FGATE_B]; s.O = O; s.oside = oside; run_functor(s, (long)BATCH * 2056); }
#pragma omp parallel for
    for (long tok = 0; tok < NTOK; ++tok) for (int h8 = 0; h8 < 8; ++h8) {
      float sf = 1.f, sb = 1.f;
      if (layer == 1 && h8 >= 4) { int h = h8 - 4; const float* s0 = oside + tok * 8 + h * 2; const float* s1 = oside + (size_t)(NTOK + tok) * 8 + h * 2;
        sf = 1.0f / fmaxf(fabsf(s0[0]), expf(-s0[1])); sb = 1.0f / fmaxf(fabsf(s1[0]), expf(-s1[1])); }
      float o[128]; float ss = 0.f;
      for (int j = 0; j < 128; ++j) { int c = h8 * 128 + j; o[j] = bf2f(O[tok * 1024 + c]) * sf + bf2f(O[(size_t)(NTOK + tok) * 1024 + c]) * sb; ss += o[j] * o[j]; }
      float r = 1.0f / sqrtf(ss * (1.0f / 128.0f) + NORM_EPS_F);
      for (int j = 0; j < 128; ++j) { int c = h8 * 128 + j; float gn, gt;
        if (layer == 0) { gn = h8 < 4 ? p.in[I_HGRN_NORM][c] : p.in[I_GLA_NORM][c - 512]; gt = siluf_(bf2f(P[tok * PSTRIDE + (h8 < 4 ? 2048 + c : 3584 + c - 512)])); }
        else { gn = h8 < 4 ? p.in[I_RET_NORM][c] : p.in[I_MLSTM_NORM][c - 512]; float gr = bf2f(P[tok * PSTRIDE + (h8 < 4 ? 1024 + c : 3072 + c - 512)]); gt = h8 < 4 ? siluf_(gr) : sigmoidf_(gr); }
        HB[tok * 1024 + c] = f2bf(o[j] * r * gn * gt); }
    }
    cpu_round_w(p.in[layer == 0 ? I_AB_W_OUT : I_CD_W_OUT], (size_t)1024 * 1024, wr);
#pragma omp parallel for
    for (long tok = 0; tok < NTOK; ++tok) { std::vector<float> acc(1024, 0.f);
      for (int k = 0; k < 1024; ++k) { float a = bf2f(HB[tok * 1024 + k]); const float* w = &wr[(size_t)k * 1024]; for (int n = 0; n < 1024; ++n) acc[n] += a * w[n]; }
      for (int n = 0; n < 1024; ++n) yf[tok * 1024 + n] = acc[n]; }
    dbg_cmp(layer == 0 ? "y_mix0" : "y_mix1", yf, (long)NTOK * 1024);
    int cnt[NEXP] = {0}; std::vector<int> list((size_t)NEXP * NTOK);
    const float* hin = layer == 0 ? p.in[I_X] : p.out;
    for (long tok = 0; tok < NTOK; ++tok) {
      float v[1024]; double s = 0; for (int c = 0; c < 1024; ++c) { v[c] = ALPHA_F * hin[tok * 1024 + c] + yf[tok * 1024 + c]; s += v[c]; }
      float mean = (float)(s / 1024); double q = 0; for (int c = 0; c < 1024; ++c) { v[c] -= mean; q += (double)v[c] * v[c]; }
      float r = 1.0f / sqrtf((float)(q / 1024) + LN_EPS_F);
      float lg[16] = {0};
      for (int c = 0; c < 1024; ++c) { v[c] = v[c] * r * p.in[I_LN_MIX_G][layer * 1024 + c] + p.in[I_LN_MIX_B][layer * 1024 + c]; p.out[tok * 1024 + c] = v[c]; HB[tok * 1024 + c] = f2bf(v[c]);
        for (int e = 0; e < 16; ++e) lg[e] += v[c] * p.in[I_ROUTER_W][c * 16 + e]; }
      int eo[2]; float go[2]; route_from_logits(lg, p.in[I_ROUTER_B], eo, go);
      int r1 = cnt[eo[0]]++, r2 = cnt[eo[1]]++;
      list[(size_t)eo[0] * NTOK + r1] = (int)tok; list[(size_t)eo[1] * NTOK + r2] = (int)tok;
      assign[tok * 4] = eo[0]; assign[tok * 4 + 1] = r1; assign[tok * 4 + 2] = eo[1]; assign[tok * 4 + 3] = r2; gate[tok * 2] = go[0]; gate[tok * 2 + 1] = go[1];
    }
    dbg_cmp(layer == 0 ? "h_mix0" : "h_mix1", p.out, (long)NTOK * 1024);
    int pad[NEXP]; { int a = 0; for (int e = 0; e < NEXP; ++e) { pad[e] = a; a += ((cnt[e] + 255) >> 8) << 8; } }
    const size_t lo = (size_t)layer * NEXP * 1024 * 1024;
    for (int e = 0; e < NEXP; ++e) {
      std::vector<float> w1, w3, w2; cpu_round_w(p.in[I_MOE_W1] + lo + (size_t)e * 1048576, 1048576, w1); cpu_round_w(p.in[I_MOE_W3] + lo + (size_t)e * 1048576, 1048576, w3); cpu_round_w(p.in[I_MOE_W2] + lo + (size_t)e * 1048576, 1048576, w2);
#pragma omp parallel for
      for (int rr = 0; rr < cnt[e]; ++rr) { int tok = list[(size_t)e * NTOK + rr]; size_t pos = pad[e] + rr;
        std::vector<float> a1(1024, 0.f), a3(1024, 0.f), a2(1024, 0.f);
        for (int k = 0; k < 1024; ++k) { float a = bf2f(HB[(size_t)tok * 1024 + k]); const float* p1 = &w1[(size_t)k * 1024]; const float* p3 = &w3[(size_t)k * 1024]; for (int n = 0; n < 1024; ++n) { a1[n] += a * p1[n]; a3[n] += a * p3[n]; } }
        for (int n = 0; n < 1024; ++n) H[pos * 1024 + n] = f2bf(siluf_(a1[n]) * a3[n]);
        for (int k = 0; k < 1024; ++k) { float a = bf2f(H[pos * 1024 + k]); const float* p2 = &w2[(size_t)k * 1024]; for (int n = 0; n < 1024; ++n) a2[n] += a * p2[n]; }
        for (int n = 0; n < 1024; ++n) Y[pos * 1024 + n] = f2bf(a2[n]); }
    }
    for (long tok = 0; tok < NTOK; ++tok) {
      size_t p0 = pad[assign[tok * 4]] + assign[tok * 4 + 1], p1 = pad[assign[tok * 4 + 2]] + assign[tok * 4 + 3];
      float v[1024]; double s = 0; for (int c = 0; c < 1024; ++c) { v[c] = ALPHA_F * p.out[tok * 1024 + c] + gate[tok * 2] * bf2f(Y[p0 * 1024 + c]) + gate[tok * 2 + 1] * bf2f(Y[p1 * 1024 + c]); s += v[c]; }
      float mean = (float)(s / 1024); double q = 0; for (int c = 0; c < 1024; ++c) { v[c] -= mean; q += (double)v[c] * v[c]; }
      float r = 1.0f / sqrtf((float)(q / 1024) + LN_EPS_F);
      for (int c = 0; c < 1024; ++c) { v[c] = v[c] * r * p.in[I_LN_FFN_G][layer * 1024 + c] + p.in[I_LN_FFN_B][layer * 1024 + c]; p.out[tok * 1024 + c] = v[c]; HB[tok * 1024 + c] = f2bf(v[c]); }
    }
    dbg_cmp(layer == 0 ? "h_ffn0" : "h_ffn1", p.out, (long)NTOK * 1024);
  }
}
#endif
```

```cpp
#ifdef CPU_EMU
#include <cmath>
#include <cstdio>
#include <cstring>
#include <cstdlib>
#include <cstddef>
#define DEV
#define DEV_INLINE static inline
typedef void* hipStream_t;
#else
#include <hip/hip_runtime.h>
#include <hip/hip_bf16.h>
#include <cstdio>
#define DEV __device__ __forceinline__
#define DEV_INLINE __device__ __forceinline__
#endif
#ifndef PROBE_DUP
#define PROBE_DUP 0
#endif
#ifndef BATCH
#define BATCH 4
#endif
#ifndef SEQ
#define SEQ 8192
#endif
#define DM 1024
#define NTOK (BATCH * SEQ)
#define P_AB 4128
#define P_CD 3600
#define PM_AB 4096
#define PM_CD 3584
#define NEXP 16
#define ALPHA_F 1.4142135623730951f
#define LN_EPS_F 1e-5f
#define NORM_EPS_F 1e-6f
#define HROWS (2 * NTOK + NEXP * 256)

typedef unsigned short bf16_t;

DEV_INLINE float bf2f(bf16_t b) { unsigned u = ((unsigned)b) << 16; float f; memcpy(&f, &u, 4); return f; }
DEV_INLINE bf16_t f2bf(float f) { unsigned u; memcpy(&u, &f, 4); u += 0x7FFFu + ((u >> 16) & 1u); return (bf16_t)(u >> 16); }
DEV_INLINE float sigmoidf_(float x) { return 1.0f / (1.0f + expf(-x)); }
DEV_INLINE float siluf_(float x) { return x / (1.0f + expf(-x)); }
DEV_INLINE float logsigmoidf_(float x) { return fminf(x, 0.0f) - log1pf(expf(-fabsf(x))); }

#define AL256(x) (((size_t)(x) + 255) & ~(size_t)255)
#define WS_CTL    ((size_t)0)
#define WS_HB     ((size_t)65536)
#define WS_R1     (WS_HB + (size_t)NTOK * 1024 * 2)
#define R1_P_BYTES ((size_t)NTOK * 4096 * 2)
#define R1_MIN    (AL256((size_t)HROWS * 1024 * 2) + (size_t)NEXP * 3072 * 1024 * 2)
#define R1_PL     (R1_P_BYTES + (size_t)NTOK * 512 * 2)
#define R1_BYTES  (R1_PL > R1_MIN ? R1_PL : R1_MIN)
#define WS_LFB    (WS_R1 + R1_P_BYTES)
#define WS_H      (WS_R1)
#define WS_WMOE   (WS_R1 + AL256((size_t)HROWS * 1024 * 2))
#define WMOE_BYTES ((size_t)NEXP * 3072 * 1024 * 2)
#define WS_R2     (WS_R1 + R1_BYTES)
#define R2_BYTES  ((size_t)HROWS * 1024 * 2 > (size_t)NTOK * 1024 * 4 ? (size_t)HROWS * 1024 * 2 : (size_t)NTOK * 1024 * 4)
#define WS_SIDE   (WS_R2 + AL256(R2_BYTES))
#define WS_OSIDE  (WS_SIDE + (size_t)NTOK * 32 * 4)
#define WS_WIN_AB (WS_OSIDE + (size_t)2 * NTOK * 8 * 4)
#define WS_WIN_CD (WS_WIN_AB + (size_t)4128 * 1024 * 2)
#define WS_WOUT_AB (WS_WIN_CD + (size_t)3600 * 1024 * 2)
#define WS_WOUT_CD (WS_WOUT_AB + (size_t)1024 * 1024 * 2)
#define WS_ROPE   (WS_WOUT_CD + (size_t)1024 * 1024 * 2)
#define WS_LB     (WS_ROPE + (size_t)SEQ * 64 * 4)
#define WS_LIST   (WS_LB + 4096)
#define WS_ASSIGN (WS_LIST + (size_t)2 * NEXP * NTOK * 4)
#define WS_GATE   (WS_ASSIGN + (size_t)NTOK * 16)
#define WS_END    (WS_GATE + (size_t)NTOK * 8)
#define CW_CNT(layer) (64 + 256 * (layer))

#define PSTRIDE 4096
#define PIDX(tok, col) ((((size_t)((col) >> 7)) * NTOK + (size_t)(tok)) * 128 + (size_t)((col) & 127))

enum { I_X, I_AB_W_IN, I_AB_B_IN, I_HGRN_LB, I_GK_UP, I_GK_B, I_HGRN_NORM, I_GLA_NORM, I_AB_W_OUT,
       I_CD_W_IN, I_CD_B_IN, I_CONV_W, I_CONV_B, I_FGATE_B, I_RET_NORM, I_MLSTM_NORM, I_CD_W_OUT,
       I_LN_MIX_G, I_LN_MIX_B, I_LN_FFN_G, I_LN_FFN_B, I_ROUTER_W, I_ROUTER_B, I_MOE_W1, I_MOE_W3, I_MOE_W2, N_IN };

struct Params {
  const float* in[N_IN];
  float* out;
  unsigned char* ws;
};

DEV_INLINE float epi_ab(int col, float v, const float* lb) {
  if (col < 512) return siluf_(v);
  if (col < 1536) { float l = lb[(col - 512) & 511]; return logf(l + (1.0f - l) * sigmoidf_(v)); }
  if (col >= 2560 && col < 2816) return v * 0.125f;
  return v;
}

DEV_INLINE void route_from_logits(const float* lg, const float* rb, int* e_out, float* g_out) {
  float mx = lg[0];
#pragma unroll
  for (int e = 1; e < 16; ++e) mx = fmaxf(mx, lg[e]);
  float sc[16]; float sum = 0.f;
#pragma unroll
  for (int e = 0; e < 16; ++e) { sc[e] = expf(lg[e] - mx); sum += sc[e]; }
  float inv = 1.0f / sum;
  float best_gs = -1e30f; int be1 = 0, be2 = 1; float bs1 = 0.f, bs2 = 0.f;
#pragma unroll
  for (int gq = 0; gq < 4; ++gq) {
    float m1 = -1e30f, m2 = -1e30f, s1 = 0.f, s2 = 0.f; int i1 = 0, i2 = 0;
#pragma unroll
    for (int i = 0; i < 4; ++i) {
      float s = sc[gq * 4 + i] * inv; float v = s + rb[gq * 4 + i];
      if (v > m1) { m2 = m1; i2 = i1; s2 = s1; m1 = v; i1 = gq * 4 + i; s1 = s; }
      else if (v > m2) { m2 = v; i2 = gq * 4 + i; s2 = s; }
    }
    float gs = m1 + m2;
    if (gs > best_gs) { best_gs = gs; be1 = i1; be2 = i2; bs1 = s1; bs2 = s2; }
  }
  e_out[0] = be1; e_out[1] = be2; g_out[0] = bs1 / (bs1 + bs2); g_out[1] = bs2 / (bs1 + bs2);
}
struct ScanAB2 {
  const bf16_t* P; const bf16_t* LFB; bf16_t* O;
  DEV void operator()(long gid) const {
    int j = (int)(gid & 127), h = (int)((gid >> 7) & 3), dir = (int)((gid >> 9) & 1), mixer = (int)((gid >> 10) & 1), b = (int)(gid >> 11);
    bf16_t* Od = O + (size_t)dir * NTOK * 1024;
    if (mixer == 0) {
      float S[128];
#pragma unroll
      for (int d = 0; d < 128; ++d) S[d] = 0.f;
      for (int s = 0; s < SEQ; ++s) {
        size_t t = (size_t)b * SEQ + (dir ? (SEQ - 1 - s) : s);
        const bf16_t* row = P + t * PSTRIDE;
        const bf16_t* q = row + h * 128; const bf16_t* lf = row + 512 + dir * 512 + h * 128;
        float v = bf2f(row[1536 + h * 128 + j]);
        float o = 0.f;
#pragma unroll
        for (int d = 0; d < 128; ++d) { float fd = expf(bf2f(lf[d])); S[d] = fd * S[d] + (1.0f - fd) * v; o += bf2f(q[d]) * S[d]; }
        Od[t * 1024 + h * 128 + j] = f2bf(o);
      }
    } else {
      float S[64];
#pragma unroll
      for (int d = 0; d < 64; ++d) S[d] = 0.f;
      for (int s = 0; s < SEQ; ++s) {
        size_t t = (size_t)b * SEQ + (dir ? (SEQ - 1 - s) : s);
        const bf16_t* row = P + t * PSTRIDE;
        const bf16_t* q = row + 2560 + h * 64; const bf16_t* k = row + 2816 + h * 64;
        const bf16_t* lf = LFB + t * 512 + dir * 256 + h * 64;
        float v = bf2f(row[3072 + h * 128 + j]);
        float o = 0.f;
#pragma unroll
        for (int d = 0; d < 64; ++d) { S[d] = expf(bf2f(lf[d])) * S[d] + bf2f(k[d]) * v; o += bf2f(q[d]) * S[d]; }
        Od[t * 1024 + 512 + h * 128 + j] = f2bf(o);
      }
    }
  }
};

struct PrepCD2 {
  bf16_t* P; bf16_t* QD; const float* rope; const float* conv_w; const float* conv_b;
  DEV void operator()(long gid) const {
    size_t tok = (size_t)(gid / 1280); int c = (int)(gid % 1280); int t = (int)(tok % SEQ);
    bf16_t* row = P + tok * PSTRIDE;
    if (c < 256) {
      int isk = c >> 7, hh = (c >> 5) & 3, i = c & 31;
      float cs = rope[(t * 32 + i) * 2], sn = rope[(t * 32 + i) * 2 + 1];
      bf16_t* base = row + isk * 256 + hh * 64;
      float a1 = bf2f(base[i]), a2 = bf2f(base[i + 32]);
      float sc = isk ? 1.0f : 0.125f;
      base[i] = f2bf((a1 * cs - a2 * sn) * sc); base[i + 32] = f2bf((a1 * sn + a2 * cs) * sc);
    } else {
      int cc = c - 256;
      float acc = conv_b[cc] + bf2f(row[1536 + cc]) * conv_w[1024 + cc];
      if (t > 0) acc += bf2f(row[1536 + cc - PSTRIDE]) * conv_w[cc];
      if (t < SEQ - 1) acc += bf2f(row[1536 + cc + PSTRIDE]) * conv_w[2048 + cc];
      float s = siluf_(acc);
      if (cc < 512) QD[tok * 512 + cc] = f2bf(s * 0.08838834764831845f);
      else row[3584 + (cc - 512)] = f2bf(s);
    }
  }
};

struct ScanCD2 {
  const bf16_t* P; const bf16_t* QD; const float* side; const float* fgate_b; bf16_t* O; float* oside;
  DEV void operator()(long gid) const {
    int b = (int)(gid / 2056); int g = (int)(gid % 2056);
    if (g < 1024) {
      int j = g & 127, h = (g >> 7) & 3, dir = (g >> 9) & 1;
      bf16_t* Od = O + (size_t)dir * NTOK * 1024;
      float gamma = 1.0f - exp2f(-(5.0f + 2.0f * (float)h + (float)dir));
      float S[64];
#pragma unroll
      for (int d = 0; d < 64; ++d) S[d] = 0.f;
      for (int s = 0; s < SEQ; ++s) {
        size_t t = (size_t)b * SEQ + (dir ? (SEQ - 1 - s) : s);
        const bf16_t* row = P + t * PSTRIDE;
        const bf16_t* q = row + h * 64; const bf16_t* k = row + 256 + h * 64;
        float v = bf2f(row[512 + h * 128 + j]);
        float o = 0.f;
#pragma unroll
        for (int d = 0; d < 64; ++d) { S[d] = gamma * S[d] + bf2f(k[d]) * v; o += bf2f(q[d]) * S[d]; }
        Od[t * 1024 + h * 128 + j] = f2bf(o);
      }
    } else {
      g -= 1024;
      int j = g % 129, h = (g / 129) & 3, dir = g / (129 * 4);
      bf16_t* Od = O + (size_t)dir * NTOK * 1024; float* os = oside + (size_t)dir * NTOK * 8;
      float fb = fgate_b[dir * 4 + h];
      float S[128];
#pragma unroll
      for (int d = 0; d < 128; ++d) S[d] = 0.f;
      float m = 0.f;
      for (int s = 0; s < SEQ; ++s) {
        size_t t = (size_t)b * SEQ + (dir ? (SEQ - 1 - s) : s);
        const bf16_t* row = P + t * PSTRIDE;
        const bf16_t* q = QD + t * 512 + h * 128; const bf16_t* k = row + 3584 + h * 128;
        float v = (j < 128) ? bf2f(row[2560 + h * 128 + j]) : 1.0f;
        float li = side[t * 32 + dir * 8 + h];
        float lf = logsigmoidf_(side[t * 32 + dir * 8 + 4 + h] + fb);
        float mn = fmaxf(lf + m, li);
        float fs = expf(lf + m - mn), is = expf(li - mn) * v;
        m = mn;
        float o = 0.f;
#pragma unroll
        for (int d = 0; d < 128; ++d) { S[d] = fs * S[d] + is * bf2f(k[d]); o += bf2f(q[d]) * S[d]; }
        if (j < 128) Od[t * 1024 + 512 + h * 128 + j] = f2bf(o);
        else { os[t * 8 + h * 2] = o; os[t * 8 + h * 2 + 1] = m; }
      }
    }
  }
};
#ifndef CPU_EMU
namespace pg8 {
#define PG8_LAS __attribute__((address_space(3)))
typedef short bf16x8 __attribute__((ext_vector_type(8)));
typedef float f32x4 __attribute__((ext_vector_type(4)));
typedef unsigned u32x4 __attribute__((ext_vector_type(4)));
typedef unsigned u32x2 __attribute__((ext_vector_type(2)));
constexpr int BM = 256, BK = 64, HALF = 128, HTB = HALF * BK * 2, STAGE_BYTES = 8 * HTB, NXCD = 8, WGM = 8, GK = 1024;

__device__ __forceinline__ int lds_byte(int r, int c) { const int st = (r >> 4) * 2 + (c >> 5), rr = r & 15, cc = c & 31, ob = rr * 64 + cc * 2; return st * 1024 + (ob ^ (((ob >> 9) & 1) << 5)); }
__device__ __forceinline__ void stage_rc(int b, int& R, int& C) { const int st = b / 1024, sb = b % 1024, swz = sb ^ (((sb >> 9) & 1) << 5); R = (st >> 1) * 16 + swz / 64; C = (st & 1) * 32 + (swz % 64) / 2; }
__device__ __forceinline__ int perm32(int rho) { const int n = rho >> 4, i = rho & 15; return 8 * (i >> 2) + 4 * n + (i & 3); }
__device__ __forceinline__ unsigned cvt_pk_bf16(float lo, float hi) { unsigned r; asm volatile("v_cvt_pk_bf16_f32 %0, %1, %2" : "=v"(r) : "v"(lo), "v"(hi)); return r; }

struct Unit { int pm, pn, e, row0, ne, ui; };

struct StaticOrder {
  int nM, nN, nwg, G, c;
  __device__ void init(int M, int N, int G_, int c_) { nM = M / BM; nN = N / BM; nwg = nM * nN; G = G_; c = c_; }
  __device__ bool next(int i, Unit& u) const {
    const long L = (long)i * G + c; if (L >= nwg) return false;
    int wgid = (int)L; { const int q = nwg / NXCD, r = nwg % NXCD, xcd = wgid % NXCD, off = wgid / NXCD; wgid = (xcd < r ? xcd * (q + 1) : r * (q + 1) + (xcd - r) * q) + off; }
    const int nig = WGM * nN, gid = wgid / nig, fm = gid * WGM, gsz = (nM - fm) < WGM ? (nM - fm) : WGM;
    u.pm = fm + ((wgid % nig) % gsz); u.pn = (wgid % nig) / gsz; u.e = 0; u.row0 = u.pm * BM; u.ne = 0; u.ui = i; return true;
  }
};

template <class Prob>
__device__ __forceinline__ void gemm_phase(PG8_LAS unsigned char* lds, const Prob& S, int wv) {
  int wv_ = wv; asm volatile("" : "+s"(wv_));
  int l_; asm volatile("v_mbcnt_lo_u32_b32 %0, -1, 0\n\tv_mbcnt_hi_u32_b32 %0, -1, %0" : "=v"(l_));
  int tid_ = wv_ * 64 + l_;
  const int tid = tid_, wid = __builtin_amdgcn_readfirstlane(tid >> 6), lane = tid & 63, wr = wid >> 2, wc = wid & 3, fr = lane & 15, fq = lane >> 4;
  constexpr int K = GK, nt = K / BK;
  int sR[2], sC[2]; unsigned voffB[2];
#pragma unroll
  for (int i = 0; i < 2; ++i) { int R, C; stage_rc(tid * 16 + i * 8192, R, C); sR[i] = R; sC[i] = C; const int Rb = Prob::PERM ? ((R & ~31) + perm32(R & 31)) : R; voffB[i] = (unsigned)(Rb * K + C) * 2u; }
  const size_t kstep = (size_t)(BK * 2);
  const size_t hstep = (size_t)HALF * K * 2;
  const unsigned ldsw = (unsigned)wid * 1024u;
  const int aoff = lds_byte(wr * 64 + fr, fq * 8), boff = lds_byte(wc * 32 + fr, fq * 8);
#define PG8_SA(b, h) (((b) * 2 + (h)) * HTB)
#define PG8_SB(b, h) ((4 + (b) * 2 + (h)) * HTB)
#define PG8_STAGE(bufoff, gbase, voff) do { _Pragma("unroll") for (int _i = 0; _i < 2; ++_i) \
    __builtin_amdgcn_global_load_lds((const unsigned*)((const char*)(gbase) + (voff)[_i]), (PG8_LAS unsigned*)(lds + (bufoff) + ldsw + _i * 8192), 16, 0, 0); } while (0)
#define PG8_LDA(dst, b, h) do { _Pragma("unroll") for (int m = 0; m < 4; ++m) _Pragma("unroll") for (int k = 0; k < 2; ++k) dst[m][k] = *(const PG8_LAS bf16x8*)(lds + PG8_SA(b, h) + aoff + m * 2048 + k * 1024); } while (0)
#define PG8_LDB(dst, b, h) do { _Pragma("unroll") for (int n = 0; n < 2; ++n) _Pragma("unroll") for (int k = 0; k < 2; ++k) dst[n][k] = *(const PG8_LAS bf16x8*)(lds + PG8_SB(b, h) + boff + n * 2048 + k * 1024); } while (0)
#define PG8_MMA(ai, bj, At, Bt) do { __builtin_amdgcn_s_setprio(1); _Pragma("unroll") for (int m = 0; m < 4; ++m) _Pragma("unroll") for (int n = 0; n < 2; ++n) _Pragma("unroll") for (int k = 0; k < 2; ++k) \
    acc[ai][bj][m][n] = __builtin_amdgcn_mfma_f32_16x16x32_bf16(Bt[n][k], At[m][k], acc[ai][bj][m][n], 0, 0, 0); __builtin_amdgcn_s_setprio(0); } while (0)
#define PG8_WAIT_V(n) asm volatile("s_waitcnt vmcnt(" #n ")" ::: "memory")
#define PG8_WAIT_L(n) asm volatile("s_waitcnt lgkmcnt(" #n ")" ::: "memory")
#define PG8_BAR __builtin_amdgcn_s_barrier()
#define PG8_SCHED __builtin_amdgcn_sched_barrier(0)
  Unit cur, nxt; int ui = 0;
  if (!S.next(0, cur)) return;
  f32x4 acc[2][2][4][2];
#pragma unroll
  for (int a = 0; a < 2; ++a)
#pragma unroll
    for (int b = 0; b < 2; ++b)
#pragma unroll
      for (int m = 0; m < 4; ++m)
#pragma unroll
        for (int n = 0; n < 2; ++n) acc[a][b][m][n] = (f32x4){0.f, 0.f, 0.f, 0.f};
  bf16x8 At[4][2], B0[2][2], B1[2][2];
  unsigned oc0[2], oc1[2], on0[2], on1[2];
#pragma unroll
  for (int i = 0; i < 2; ++i) { oc0[i] = S.a_off(cur, sR[i]) + (unsigned)sC[i] * 2u; oc1[i] = S.a_off(cur, HALF + sR[i]) + (unsigned)sC[i] * 2u; }
  const char* const Ab = S.a_base();
  const char* cB = S.b_base(cur);
  PG8_STAGE(PG8_SB(0, 0), cB, voffB); PG8_STAGE(PG8_SB(0, 1), cB + hstep, voffB); PG8_STAGE(PG8_SA(0, 0), Ab, oc0); PG8_STAGE(PG8_SA(0, 1), Ab, oc1);
  if (wr == 1) PG8_BAR;
  PG8_WAIT_V(2); PG8_BAR;
  PG8_STAGE(PG8_SB(1, 0), cB + kstep, voffB); PG8_STAGE(PG8_SA(1, 0), Ab + kstep, oc0); PG8_STAGE(PG8_SB(1, 1), cB + hstep + kstep, voffB);
  PG8_WAIT_V(6); PG8_BAR;
  for (;;) {
    const bool has_next = S.next(ui + 1, nxt);
    const char* nB = cB;
    if (has_next) {
      nB = S.b_base(nxt);
      int l2_; asm volatile("v_mbcnt_lo_u32_b32 %0, -1, 0\n\tv_mbcnt_hi_u32_b32 %0, -1, %0" : "=v"(l2_));
      const int tid2 = wid * 64 + l2_;
#pragma unroll
      for (int i = 0; i < 2; ++i) { int R, C; stage_rc(tid2 * 16 + i * 8192, R, C); on0[i] = S.a_off(nxt, R) + (unsigned)C * 2u; on1[i] = S.a_off(nxt, HALF + R) + (unsigned)C * 2u; }
    } else {
#pragma unroll
      for (int i = 0; i < 2; ++i) { on0[i] = oc0[i]; on1[i] = oc1[i]; }
    }
    for (int t = 0; t < nt; t += 2) {
      const bool last = (t == nt - 2);
      const char* a1 = Ab + (size_t)(t + 1) * kstep;
      const char* a2 = last ? Ab : Ab + (size_t)(t + 2) * kstep; const char* b2 = last ? nB : cB + (size_t)(t + 2) * kstep;
      const char* a3 = a2 + kstep; const char* b3 = b2 + kstep;
      unsigned o20[2], o21[2];
#pragma unroll
      for (int i = 0; i < 2; ++i) { o20[i] = last ? on0[i] : oc0[i]; o21[i] = last ? on1[i] : oc1[i]; }
      PG8_LDB(B0, 0, 0); PG8_LDB(B1, 0, 1); PG8_SCHED; PG8_LDA(At, 0, 0); PG8_STAGE(PG8_SA(1, 1), a1, oc1);
      PG8_WAIT_V(8); PG8_WAIT_L(0); PG8_BAR; PG8_MMA(0, 0, At, B0); PG8_MMA(0, 1, At, B1); PG8_BAR; PG8_SCHED;
      PG8_LDA(At, 0, 1); PG8_STAGE(PG8_SB(0, 0), b2, voffB); PG8_STAGE(PG8_SB(0, 1), b2 + hstep, voffB); PG8_STAGE(PG8_SA(0, 0), a2, o20);
      PG8_WAIT_V(8); PG8_WAIT_L(0); PG8_BAR; PG8_MMA(1, 0, At, B0); PG8_MMA(1, 1, At, B1); PG8_BAR; PG8_SCHED;
      PG8_LDB(B0, 1, 0); PG8_LDB(B1, 1, 1); PG8_SCHED; PG8_LDA(At, 1, 0); PG8_STAGE(PG8_SA(0, 1), a2, o21);
      PG8_WAIT_V(8); PG8_WAIT_L(0); PG8_BAR; PG8_MMA(0, 0, At, B0); PG8_MMA(0, 1, At, B1); PG8_BAR; PG8_SCHED;
      PG8_LDA(At, 1, 1); PG8_STAGE(PG8_SB(1, 0), b3, voffB); PG8_STAGE(PG8_SB(1, 1), b3 + hstep, voffB); PG8_STAGE(PG8_SA(1, 0), a3, o20);
      PG8_WAIT_V(8); PG8_WAIT_L(0); PG8_BAR; PG8_MMA(1, 0, At, B0); PG8_MMA(1, 1, At, B1); PG8_BAR; PG8_SCHED;
    }
    if (wr == 0) PG8_BAR;
    { int l3_; asm volatile("v_mbcnt_lo_u32_b32 %0, -1, 0\n\tv_mbcnt_hi_u32_b32 %0, -1, %0" : "=v"(l3_));
      S.epi(acc, cur, wr, wc, l3_ & 15, l3_ >> 4); }
    if (!has_next) break;
#pragma unroll
    for (int a = 0; a < 2; ++a)
#pragma unroll
      for (int b = 0; b < 2; ++b)
#pragma unroll
        for (int m = 0; m < 4; ++m)
#pragma unroll
          for (int n = 0; n < 2; ++n) acc[a][b][m][n] = (f32x4){0.f, 0.f, 0.f, 0.f};
    cur = nxt; cB = nB; ++ui;
#pragma unroll
    for (int i = 0; i < 2; ++i) { oc0[i] = on0[i]; oc1[i] = on1[i]; }
    if (wr == 1) PG8_BAR;
  }
  PG8_WAIT_V(0);
  PG8_BAR;
#undef PG8_SA
#undef PG8_SB
#undef PG8_STAGE
#undef PG8_LDA
#undef PG8_LDB
#undef PG8_MMA
#undef PG8_WAIT_V
#undef PG8_WAIT_L
#undef PG8_BAR
#undef PG8_SCHED
}
}
#endif
#ifndef CPU_EMU
#include <hip/hip_cooperative_groups.h>
namespace cg = cooperative_groups;
#define LAS __attribute__((address_space(3)))
#define NTHREADS 512
#define LDS_BYTES (154 * 1024)
typedef float f32x4 __attribute__((ext_vector_type(4)));
typedef short bf16x8 __attribute__((ext_vector_type(8)));
typedef unsigned u32x4 __attribute__((ext_vector_type(4)));
typedef unsigned u32x2 __attribute__((ext_vector_type(2)));

struct Ctx { int tid, lane, wid, G, bid; unsigned char* lds; };
__device__ __forceinline__ int lane_id() { int l; asm volatile("v_mbcnt_lo_u32_b32 %0, -1, 0\n\tv_mbcnt_hi_u32_b32 %0, -1, %0" : "=v"(l)); return l; }
__device__ __forceinline__ int opaque_tid(int wv) { int w = wv; asm volatile("" : "+s"(w)); int t = w * 64 + lane_id(); asm volatile("" : "+v"(t)); return t; }
__device__ __forceinline__ Ctx make_ctx(unsigned char* lds, int wv) { Ctx c; c.tid = opaque_tid(wv); c.lane = c.tid & 63; c.wid = __builtin_amdgcn_readfirstlane(c.tid >> 6); c.G = gridDim.x; c.bid = blockIdx.x; c.lds = lds; return c; }

__device__ __forceinline__ float wave_sum(float x) {
  x += __builtin_bit_cast(float, __builtin_amdgcn_update_dpp(0, __builtin_bit_cast(int, x), 0x111, 0xf, 0xf, false));
  x += __builtin_bit_cast(float, __builtin_amdgcn_update_dpp(0, __builtin_bit_cast(int, x), 0x112, 0xf, 0xf, false));
  x += __builtin_bit_cast(float, __builtin_amdgcn_update_dpp(0, __builtin_bit_cast(int, x), 0x114, 0xf, 0xf, false));
  x += __builtin_bit_cast(float, __builtin_amdgcn_update_dpp(0, __builtin_bit_cast(int, x), 0x118, 0xf, 0xf, false));
  x += __builtin_bit_cast(float, __builtin_amdgcn_update_dpp(0, __builtin_bit_cast(int, x), 0x142, 0xa, 0xf, false));
  x += __builtin_bit_cast(float, __builtin_amdgcn_update_dpp(0, __builtin_bit_cast(int, x), 0x143, 0xc, 0xf, false));
  return __builtin_bit_cast(float, __builtin_amdgcn_readlane(__builtin_bit_cast(int, x), 63));
}
__device__ __forceinline__ float fsigmoid(float x) { return __builtin_amdgcn_rcpf(1.0f + __builtin_amdgcn_exp2f(-1.4426950408889634f * x)); }
__device__ __forceinline__ float fsilu(float x) { return x * fsigmoid(x); }
__device__ __forceinline__ float flog2sigmoid(float x) { const float y = x * 1.4426950408889634f; return fminf(y, 0.f) - __builtin_amdgcn_logf(1.0f + __builtin_amdgcn_exp2f(-fabsf(y))); }
typedef float f32x2_t __attribute__((ext_vector_type(2)));
typedef __bf16 bf16x2_t __attribute__((ext_vector_type(2)));
__device__ __forceinline__ unsigned pk_hw(float a, float b) { const f32x2_t v = {a, b}; return __builtin_bit_cast(unsigned, __builtin_convertvector(v, bf16x2_t)); }
__device__ __forceinline__ unsigned pk2(float a, float b) { return pk_hw(a, b); }
__device__ __forceinline__ void unpack8(u32x4 w, float* f) {
  f[0] = __uint_as_float(w.x << 16); f[1] = __uint_as_float(w.x & 0xffff0000u); f[2] = __uint_as_float(w.y << 16); f[3] = __uint_as_float(w.y & 0xffff0000u);
  f[4] = __uint_as_float(w.z << 16); f[5] = __uint_as_float(w.z & 0xffff0000u); f[6] = __uint_as_float(w.w << 16); f[7] = __uint_as_float(w.w & 0xffff0000u);
}

__device__ __forceinline__ void transpose_job(const Ctx& c, const float* src, int N, bf16_t* dst, int rs, int ro, int tile0, int tile_stride) {
  float* t = (float*)c.lds;
  const int ntn = (N + 63) / 64, ntiles = ntn * 16;
  for (int tl = tile0; tl < ntiles; tl += tile_stride) {
    const int kt = tl / ntn, nt_ = tl % ntn, k0 = kt * 64, n0 = nt_ * 64;
    __syncthreads();
#pragma unroll
    for (int i = 0; i < 8; ++i) { const int idx = c.tid + i * 512, kk = idx >> 6, nn = idx & 63; t[kk * 65 + nn] = (n0 + nn < N) ? src[(size_t)(k0 + kk) * N + n0 + nn] : 0.f; }
    __syncthreads();
#pragma unroll
    for (int i = 0; i < 4; ++i) { const int idx = c.tid + i * 512, nn = idx >> 5, kp = (idx & 31) * 2;
      if (n0 + nn < N) *(unsigned*)(dst + (size_t)((n0 + nn) * rs + ro) * 1024 + k0 + kp) = pk2(t[kp * 65 + nn], t[(kp + 1) * 65 + nn]); }
  }
  __syncthreads();
}
__device__ __forceinline__ void p0_prologue(unsigned char* lds_, int wv, const Params& p) {
  const Ctx c = make_ctx(lds_, wv);
  unsigned char* ws = p.ws;
  if (c.bid == 0) { ((unsigned*)(ws + WS_CTL))[64 + c.tid] = 0u; }
  if (c.bid == 0) { for (int i = c.tid; i < 3456; i += NTHREADS) ((unsigned*)(ws + WS_CTL))[2048 + i] = 0u; }
  { const float* x = p.in[I_X]; bf16_t* hb = (bf16_t*)(ws + WS_HB);
    for (size_t i = (size_t)c.bid * NTHREADS + c.tid; i < (size_t)NTOK * 1024 / 8; i += (size_t)c.G * NTHREADS) {
      const f32x4 a = __builtin_nontemporal_load((const f32x4*)(x + i * 8)), b = __builtin_nontemporal_load((const f32x4*)(x + i * 8 + 4));
      u32x4 w; w.x = pk2(a[0], a[1]); w.y = pk2(a[2], a[3]); w.z = pk2(b[0], b[1]); w.w = pk2(b[2], b[3]);
      *(u32x4*)(hb + i * 8) = w; } }
  transpose_job(c, p.in[I_AB_W_IN], P_AB, (bf16_t*)(ws + WS_WIN_AB), 1, 0, c.bid, c.G);
  transpose_job(c, p.in[I_CD_W_IN], P_CD, (bf16_t*)(ws + WS_WIN_CD), 1, 0, c.bid, c.G);
  transpose_job(c, p.in[I_AB_W_OUT], 1024, (bf16_t*)(ws + WS_WOUT_AB), 1, 0, c.bid, c.G);
  transpose_job(c, p.in[I_CD_W_OUT], 1024, (bf16_t*)(ws + WS_WOUT_CD), 1, 0, c.bid, c.G);
  { float* rope = (float*)(ws + WS_ROPE);
    for (int i = c.bid * NTHREADS + c.tid; i < SEQ * 32; i += c.G * NTHREADS) { const int t = i >> 5, f = i & 31;
      const float freq = powf(10000.0f, -(float)f / 32.0f); const float ang = (float)t * freq; rope[i * 2] = cosf(ang); rope[i * 2 + 1] = sinf(ang); }
    if (c.bid == 1) { const float* hl = p.in[I_HGRN_LB]; float* lb = (float*)(ws + WS_LB);
      const int cc = c.tid; const float a0 = hl[cc], a1 = hl[512 + cc], a2 = hl[1024 + cc]; const float mx = fmaxf(a0, fmaxf(a1, a2));
      const float e0 = expf(a0 - mx), e1 = expf(a1 - mx), e2 = expf(a2 - mx); lb[cc] = e0 / (e0 + e1 + e2); } }
}
__device__ __forceinline__ void moe_weight_convert(unsigned char* lds_, int wv, const Params& p, int layer) {
  const Ctx c = make_ctx(lds_, wv);
  bf16_t* w13 = (bf16_t*)(p.ws + WS_WMOE); bf16_t* w2 = w13 + (size_t)NEXP * 2048 * 1024;
  const size_t lo = (size_t)layer * NEXP * 1024 * 1024;
  const float* W1 = p.in[I_MOE_W1] + lo; const float* W3 = p.in[I_MOE_W3] + lo; const float* W2 = p.in[I_MOE_W2] + lo;
  float* t = (float*)c.lds;
  constexpr int NT = 48 * 128;
  const int lk = c.tid >> 5, ln4 = (c.tid & 31) * 4;
  const int sn = c.tid & 127, sk = (c.tid >> 7) * 8;
  f32x4 r[4];
#define MW_SRC(g_) ((((g_) >> 7) % 3 == 0 ? W1 : (((g_) >> 7) % 3 == 1 ? W3 : W2)) + (size_t)(((g_) >> 7) / 3) * 1048576 + (size_t)((((g_) & 127) >> 3) * 64) * 1024 + ((g_) & 7) * 128)
#define MW_LOAD(g_) do { const float* s_ = MW_SRC(g_); _Pragma("unroll") for (int i = 0; i < 4; ++i) r[i] = __builtin_nontemporal_load((const f32x4*)(s_ + (size_t)(lk + 16 * i) * 1024 + ln4)); } while (0)
  int g0 = c.bid;
  if (g0 < NT) MW_LOAD(g0);
  for (; g0 < NT; g0 += c.G) {
    __syncthreads();
#pragma unroll
    for (int i = 0; i < 4; ++i) { float* d = t + (lk + 16 * i) * 129 + ln4; d[0] = r[i][0]; d[1] = r[i][1]; d[2] = r[i][2]; d[3] = r[i][3]; }
    __syncthreads();
    const int gn = g0 + c.G;
    if (gn < NT) MW_LOAD(gn);
    const int m = g0 >> 7, e = m / 3, which = m % 3, k0 = ((g0 & 127) >> 3) * 64, n0 = (g0 & 7) * 128;
    bf16_t* drow = (which == 2) ? w2 + ((size_t)e * 1024 + n0 + sn) * 1024 : w13 + ((size_t)e * 2048 + 2 * (n0 + sn) + which) * 1024;
#pragma unroll
    for (int j = 0; j < 2; ++j) { const int kk = sk + 32 * j; const float* s = t + kk * 129 + sn;
      u32x4 w; w.x = pk2(s[0], s[129]); w.y = pk2(s[2 * 129], s[3 * 129]); w.z = pk2(s[4 * 129], s[5 * 129]); w.w = pk2(s[6 * 129], s[7 * 129]);
      *(u32x4*)(drow + k0 + kk) = w; }
  }
#undef MW_SRC
#undef MW_LOAD
  __syncthreads();
}

struct ProbInProj {
  static constexpr bool PERM = true;
  pg8::StaticOrder so; const char* A; const char* Bt; bf16_t* P; const float* bias; const float* lb; int layer;
  __device__ __forceinline__ bool next(int i, pg8::Unit& u) const { return so.next(i, u); }
  __device__ __forceinline__ const char* a_base() const { return A; }
  __device__ __forceinline__ unsigned a_off(const pg8::Unit& u, int r) const { return (unsigned)(u.pm * 256 + r) * 2048u; }
  __device__ __forceinline__ const char* b_base(const pg8::Unit& u) const { return Bt + (size_t)u.pn * 256 * 2048; }
  __device__ __forceinline__ void epi(const f32x4 (&acc)[2][2][4][2], const pg8::Unit& u, int wr, int wc, int fr, int fq) const {
    const int row0 = u.row0 + wr * 64 + fr, colb = u.pn * 256 + wc * 32 + 8 * fq;
    int mode = 0;
    if (layer == 0) { mode = u.pn < 2 ? 1 : (u.pn < 6 ? 2 : (u.pn == 10 ? 3 : 0)); }
#pragma unroll
    for (int bj = 0; bj < 2; ++bj) {
      const int col0 = colb + bj * 128;
      const f32x4 b0 = *(const f32x4*)(bias + col0), b1 = *(const f32x4*)(bias + col0 + 4);
      f32x4 l0 = (f32x4){0.f, 0.f, 0.f, 0.f}, l1 = l0;
      if (mode == 2) { l0 = *(const f32x4*)(lb + ((col0 - 512) & 511)); l1 = *(const f32x4*)(lb + ((col0 - 512) & 511) + 4); }
#pragma unroll
      for (int ai = 0; ai < 2; ++ai)
#pragma unroll
        for (int m = 0; m < 4; ++m) {
          f32x4 v0 = acc[ai][bj][m][0] + b0, v1 = acc[ai][bj][m][1] + b1;
          if (mode == 1) {
#pragma unroll
            for (int j = 0; j < 4; ++j) { v0[j] = fsilu(v0[j]); v1[j] = fsilu(v1[j]); }
          } else if (mode == 2) {
#pragma unroll
            for (int j = 0; j < 4; ++j) { v0[j] = __builtin_amdgcn_logf(l0[j] + (1.0f - l0[j]) * fsigmoid(v0[j])); v1[j] = __builtin_amdgcn_logf(l1[j] + (1.0f - l1[j]) * fsigmoid(v1[j])); }
          } else if (mode == 3) { v0 *= 0.125f; v1 *= 0.125f; }
          u32x4 w; w.x = pk2(v0[0], v0[1]); w.y = pk2(v0[2], v0[3]); w.z = pk2(v1[0], v1[1]); w.w = pk2(v1[2], v1[3]);
          *(u32x4*)(P + PIDX(row0 + ai * 128 + m * 16, col0)) = w;
        }
    }
  }
};
struct ProbOutProj {
  static constexpr bool PERM = false;
  pg8::StaticOrder so; const char* A; const char* Bt; float* Y; const float* Hres;
  __device__ __forceinline__ bool next(int i, pg8::Unit& u) const { return so.next(i, u); }
  __device__ __forceinline__ const char* a_base() const { return A; }
  __device__ __forceinline__ unsigned a_off(const pg8::Unit& u, int r) const { return (unsigned)(u.pm * 256 + r) * 2048u; }
  __device__ __forceinline__ const char* b_base(const pg8::Unit& u) const { return Bt + (size_t)u.pn * 256 * 2048; }
  __device__ __forceinline__ void epi(const f32x4 (&acc)[2][2][4][2], const pg8::Unit& u, int wr, int wc, int fr, int fq) const {
    const int row0 = u.row0 + wr * 64 + fr, col0 = u.pn * 256 + wc * 32 + 4 * fq;
#pragma unroll
    for (int ai = 0; ai < 2; ++ai)
#pragma unroll
      for (int m = 0; m < 4; ++m) { const size_t ro = (size_t)(row0 + ai * 128 + m * 16) * 1024 + col0; float* rowp = Y + ro; const float* hp = Hres + ro;
#pragma unroll
        for (int bj = 0; bj < 2; ++bj)
#pragma unroll
          for (int n = 0; n < 2; ++n) *(f32x4*)(rowp + bj * 128 + n * 16) = acc[ai][bj][m][n] + ALPHA_F * *(const f32x4*)(hp + bj * 128 + n * 16); }
  }
};
#define MOE_TAB_OFF (128 * 1024)
struct MoeOrder {
  const int* tab;
  __device__ __forceinline__ void init(const int* cnt, int ntn, int G, int c, unsigned char* lds, int wv) {
    int* t = (int*)(lds + MOE_TAB_OFF);
    const int tid = opaque_tid(wv);
    if (tid < 64) {
      int pad = 0, found = 0, ue = 0, upn = 0, upm = 0, urow = 0, une = 0;
      if ((G & 7) == 0) {
        const int x = c & 7; int q = tid * (G >> 3) + (c >> 3);
        for (int e = 0; e < NEXP; ++e) { const int n = cnt[e * 16], mt = (n + 255) >> 8; const int r = ((x - e) % 8 + 8) % 8; const int m = mt > r ? (mt - r - 1) / 8 + 1 : 0; const int units = m * ntn;
          if (!found && q < units) { ue = e; upm = r + 8 * (q % m); upn = q / m; urow = pad + upm * 256; une = n; found = 1; }
          if (!found) { q -= units; pad += mt * 256; } }
      } else {
        int L = tid * G + c;
        for (int e = 0; e < NEXP; ++e) { const int n = cnt[e * 16], mt = (n + 255) >> 8, tiles = mt * ntn;
          if (!found && L < tiles) { ue = e; upn = L / mt; upm = L % mt; urow = pad + upm * 256; une = n; found = 1; }
          if (!found) { L -= tiles; pad += mt * 256; } }
      }
      t[tid * 8 + 0] = found; t[tid * 8 + 1] = ue; t[tid * 8 + 2] = upn; t[tid * 8 + 3] = upm; t[tid * 8 + 4] = urow; t[tid * 8 + 5] = une;
    }
    __syncthreads();
    tab = t;
  }
  __device__ __forceinline__ bool next(int i, pg8::Unit& u) const {
    if (i >= 64) return false;
    const int* t = tab + i * 8;
    if (!__builtin_amdgcn_readfirstlane(t[0])) return false;
    u.e = __builtin_amdgcn_readfirstlane(t[1]); u.pn = __builtin_amdgcn_readfirstlane(t[2]); u.pm = __builtin_amdgcn_readfirstlane(t[3]);
    u.row0 = __builtin_amdgcn_readfirstlane(t[4]); u.ne = __builtin_amdgcn_readfirstlane(t[5]); u.ui = i; return true;
  }
};
struct ProbMoe1 {
  static constexpr bool PERM = true;
  MoeOrder mo; const char* A; const char* W13; const int* list; bf16_t* H; const int* ltok;
  __device__ __forceinline__ void stage_tokens(unsigned char* lds, int wv) {
    int* lt = (int*)(lds + MOE_TAB_OFF + 2048);
    const int tid = opaque_tid(wv);
    pg8::Unit u;
    for (int i = 0; i < 16 && mo.next(i, u); ++i) { if (tid < 256) { const int rr = u.pm * 256 + tid; lt[i * 256 + tid] = rr < u.ne ? list[u.e * NTOK + rr] : 0; } }
    __syncthreads();
    ltok = lt;
  }
  __device__ __forceinline__ bool next(int i, pg8::Unit& u) const { return mo.next(i, u); }
  __device__ __forceinline__ const char* a_base() const { return A; }
  __device__ __forceinline__ unsigned a_off(const pg8::Unit& u, int r) const { const int rr = u.pm * 256 + r; const int tok = rr < u.ne ? list[u.e * NTOK + rr] : 0; return (unsigned)tok * 2048u; }
  __device__ __forceinline__ const char* b_base(const pg8::Unit& u) const { return W13 + ((size_t)u.e * 2048 + (size_t)u.pn * 256) * 2048; }
  __device__ __forceinline__ void epi(const f32x4 (&acc)[2][2][4][2], const pg8::Unit& u, int wr, int wc, int fr, int fq) const {
    const int row0 = u.row0 + wr * 64 + fr, colb = u.pn * 128 + wc * 16 + 4 * fq;
#pragma unroll
    for (int ai = 0; ai < 2; ++ai)
#pragma unroll
      for (int m = 0; m < 4; ++m)
#pragma unroll
        for (int bj = 0; bj < 2; ++bj) {
          const f32x4 v0 = acc[ai][bj][m][0], v1 = acc[ai][bj][m][1];
          u32x2 w; w.x = pk2(fsilu(v0[0]) * v0[1], fsilu(v0[2]) * v0[3]); w.y = pk2(fsilu(v1[0]) * v1[1], fsilu(v1[2]) * v1[3]);
          *(u32x2*)(H + (size_t)(row0 + ai * 128 + m * 16) * 1024 + colb + bj * 64) = w;
        }
  }
};
struct ProbMoe2 {
  static constexpr bool PERM = true;
  MoeOrder mo; const char* A; const char* W2; bf16_t* Y;
  __device__ __forceinline__ bool next(int i, pg8::Unit& u) const { return mo.next(i, u); }
  __device__ __forceinline__ const char* a_base() const { return A; }
  __device__ __forceinline__ unsigned a_off(const pg8::Unit& u, int r) const { return (unsigned)(u.row0 + r) * 2048u; }
  __device__ __forceinline__ const char* b_base(const pg8::Unit& u) const { return W2 + ((size_t)u.e * 1024 + (size_t)u.pn * 256) * 2048; }
  __device__ __forceinline__ void epi(const f32x4 (&acc)[2][2][4][2], const pg8::Unit& u, int wr, int wc, int fr, int fq) const {
    const int row0 = u.row0 + wr * 64 + fr, colb = u.pn * 256 + wc * 32 + 8 * fq;
#pragma unroll
    for (int ai = 0; ai < 2; ++ai)
#pragma unroll
      for (int m = 0; m < 4; ++m)
#pragma unroll
        for (int bj = 0; bj < 2; ++bj) {
          const f32x4 v0 = acc[ai][bj][m][0], v1 = acc[ai][bj][m][1];
          u32x4 w; w.x = pk2(v0[0], v0[1]); w.y = pk2(v0[2], v0[3]); w.z = pk2(v1[0], v1[1]); w.w = pk2(v1[2], v1[3]);
          *(u32x4*)(Y + (size_t)(row0 + ai * 128 + m * 16) * 1024 + colb + bj * 128) = w;
        }
  }
};

template <int NS>
__device__ __forceinline__ void side_phase(unsigned char* lds_, int wv, const Params& p, int layer) {
  const Ctx c = make_ctx(lds_, wv);
  const bf16_t* hb = (const bf16_t*)(p.ws + WS_HB);
  const bf16_t* wt = (const bf16_t*)(p.ws + (layer == 0 ? WS_WIN_AB : WS_WIN_CD)) + (size_t)(layer == 0 ? PM_AB : PM_CD) * 1024;
  const float* bias = p.in[layer == 0 ? I_AB_B_IN : I_CD_B_IN] + (layer == 0 ? PM_AB : PM_CD);
  float* side = (float*)(p.ws + WS_SIDE);
  float* tl = (float*)c.lds + c.wid * (16 * 33);
  const int fr = c.lane & 15, fq = c.lane >> 4;
  for (int g = c.bid * 8 + c.wid; g < NTOK / 16; g += c.G * 8) {
    const int r0 = g * 16;
    f32x4 acc0 = (f32x4){0.f, 0.f, 0.f, 0.f}, acc1 = acc0;
    const bf16_t* ap = hb + (size_t)(r0 + fr) * 1024 + fq * 8;
    const bf16_t* bp0 = wt + (size_t)fr * 1024 + fq * 8; const bf16_t* bp1 = bp0 + 16 * 1024;
#pragma unroll 4
    for (int k = 0; k < 1024; k += 32) {
      const bf16x8 a = *(const bf16x8*)(ap + k), b0 = *(const bf16x8*)(bp0 + k);
      acc0 = __builtin_amdgcn_mfma_f32_16x16x32_bf16(a, b0, acc0, 0, 0, 0);
      if (NS == 32) { const bf16x8 b1 = *(const bf16x8*)(bp1 + k); acc1 = __builtin_amdgcn_mfma_f32_16x16x32_bf16(a, b1, acc1, 0, 0, 0); }
    }
    float gsc = 1.f, gfb = 0.f; bool gls = false;
    if (NS == 16) { gsc = 1.4426950408889634f; gls = (fr & 4) != 0; gfb = gls ? p.in[I_FGATE_B][(fr >> 3) * 4 + (fr & 3)] : 0.f; }
#pragma unroll
    for (int j = 0; j < 4; ++j) { float v0 = acc0[j] + bias[fr]; if (NS == 16) v0 = gls ? flog2sigmoid(v0 + gfb) : v0 * gsc; side[(size_t)(r0 + fq * 4 + j) * 32 + fr] = v0; tl[(fq * 4 + j) * 33 + fr] = v0;
      if (NS == 32) { const float v1 = acc1[j] + bias[16 + fr]; side[(size_t)(r0 + fq * 4 + j) * 32 + 16 + fr] = v1; tl[(fq * 4 + j) * 33 + 16 + fr] = v1; } }
    if (NS == 32) {
      __builtin_amdgcn_s_waitcnt(0xC07F);
      const float* gu = p.in[I_GK_UP]; const float* gb = p.in[I_GK_B]; bf16_t* lfb = (bf16_t*)(p.ws + WS_LFB);
      const int cb = c.lane * 8, dir = cb >> 8, cc = cb & 255;
      float w[16][8];
#pragma unroll
      for (int r = 0; r < 16; ++r)
#pragma unroll
        for (int j = 0; j < 8; ++j) w[r][j] = gu[(dir * 16 + r) * 256 + cc + j];
      float bb[8];
#pragma unroll
      for (int j = 0; j < 8; ++j) bb[j] = gb[dir * 256 + cc + j];
      for (int row = 0; row < 16; ++row) {
        float z[8];
#pragma unroll
        for (int j = 0; j < 8; ++j) z[j] = bb[j];
#pragma unroll
        for (int r = 0; r < 16; ++r) { const float s = tl[row * 33 + dir * 16 + r];
#pragma unroll
          for (int j = 0; j < 8; ++j) z[j] += s * w[r][j]; }
        u32x4 o; o.x = pk2(flog2sigmoid(z[0]) * 0.0625f, flog2sigmoid(z[1]) * 0.0625f); o.y = pk2(flog2sigmoid(z[2]) * 0.0625f, flog2sigmoid(z[3]) * 0.0625f);
        o.z = pk2(flog2sigmoid(z[4]) * 0.0625f, flog2sigmoid(z[5]) * 0.0625f); o.w = pk2(flog2sigmoid(z[6]) * 0.0625f, flog2sigmoid(z[7]) * 0.0625f);
        *(u32x4*)(lfb + PIDX(r0 + row, cb)) = o;
      }
    }
  }
}

__device__ __forceinline__ void headnorm_phase(unsigned char* lds_, int wv, const Params& p, int layer) {
  const Ctx c = make_ctx(lds_, wv);
  const bf16_t* P = (const bf16_t*)(p.ws + WS_R1); const bf16_t* O = (const bf16_t*)(p.ws + WS_R2);
  bf16_t* mixed = (bf16_t*)(p.ws + WS_HB);
  const int c0 = c.lane * 16, h8 = c.lane >> 3;
  const float* gain = layer == 0 ? (h8 < 4 ? p.in[I_HGRN_NORM] + c0 : p.in[I_GLA_NORM] + c0 - 512) : (h8 < 4 ? p.in[I_RET_NORM] + c0 : p.in[I_MLSTM_NORM] + c0 - 512);
  const int gcol = layer == 0 ? (h8 < 4 ? 2048 + c0 : 3584 + c0 - 512) : (h8 < 4 ? 1024 + c0 : 3072 + c0 - 512);
  float gn[16];
#pragma unroll
  for (int j = 0; j < 16; ++j) gn[j] = gain[j];
  for (int tok = c.bid * 8 + c.wid; tok < NTOK; tok += c.G * 8) {
    float of[16], ob[16], gt[16];
    { const u32x4* a = (const u32x4*)(O + PIDX(tok, c0)); unpack8(__builtin_nontemporal_load(a), of); unpack8(__builtin_nontemporal_load(a + 1), of + 8);
      const u32x4* b = (const u32x4*)(O + (size_t)NTOK * 1024 + PIDX(tok, c0)); unpack8(__builtin_nontemporal_load(b), ob); unpack8(__builtin_nontemporal_load(b + 1), ob + 8);
      const u32x4* g = (const u32x4*)(P + PIDX(tok, gcol)); unpack8(__builtin_nontemporal_load(g), gt); unpack8(__builtin_nontemporal_load(g + 1), gt + 8); }
    const float sf = 1.f, sb = 1.f;
    float o[16]; float ss = 0.f;
#pragma unroll
    for (int j = 0; j < 16; ++j) { o[j] = of[j] * sf + ob[j] * sb; ss += o[j] * o[j]; }
    ss += __shfl_xor(ss, 1); ss += __shfl_xor(ss, 2); ss += __shfl_xor(ss, 4);
    const float r = 1.0f / sqrtf(ss * (1.0f / 128.0f) + NORM_EPS_F);
    unsigned w[8];
#pragma unroll
    for (int j = 0; j < 8; ++j) {
      float g0 = gt[2 * j], g1 = gt[2 * j + 1];
      if (layer == 1 && h8 >= 4) { g0 = fsigmoid(g0); g1 = fsigmoid(g1); } else { g0 = fsilu(g0); g1 = fsilu(g1); }
      w[j] = pk2(o[2 * j] * r * gn[2 * j] * g0, o[2 * j + 1] * r * gn[2 * j + 1] * g1);
    }
    u32x4* d = (u32x4*)(mixed + (size_t)tok * 1024 + c0);
    d[0] = (u32x4){w[0], w[1], w[2], w[3]}; d[1] = (u32x4){w[4], w[5], w[6], w[7]};
  }
}

__device__ __forceinline__ void ln_phase(unsigned char* lds_, int wv, const Params& p, int layer, int mode, int dry = 0) {
  const Ctx c = make_ctx(lds_, wv);
  unsigned char* ws = p.ws;
  const float* hin = (mode == 0 && layer == 0) ? p.in[I_X] : p.out;
  float* hout = dry ? (float*)(ws + WS_H) : p.out; bf16_t* hb = (bf16_t*)(ws + WS_HB);
  const float* g = p.in[mode == 0 ? I_LN_MIX_G : I_LN_FFN_G] + layer * 1024; const float* b = p.in[mode == 0 ? I_LN_MIX_B : I_LN_FFN_B] + layer * 1024;
  unsigned* cnt = (unsigned*)(ws + WS_CTL) + CW_CNT(layer);
  int* list = (int*)(ws + WS_LIST) + (size_t)layer * NEXP * NTOK;
  int* assign = (int*)(ws + WS_ASSIGN); float* gate = (float*)(ws + WS_GATE);
  float* rwT = (float*)c.lds;
  int* lcnt = (int*)(c.lds + 65536); int* lbase = lcnt + 16; int* rec = lcnt + 32; float* recg = (float*)(rec + 4 * 2048);
  int pad[NEXP];
  if (mode == 0) { const float* r = p.in[I_ROUTER_W];
    for (int i = c.tid; i < 1024 * 16; i += NTHREADS) rwT[(i & 15) * 1024 + (i >> 4)] = r[i];
    if (c.tid < 16) lcnt[c.tid] = 0;
    __syncthreads(); }
  else { int acc = 0;
#pragma unroll
    for (int e = 0; e < NEXP; ++e) { pad[e] = acc; acc += (((int)cnt[e * 16] + 255) >> 8) << 8; } }
  const int c0 = c.lane * 4;
  float gv[16], bv[16];
#pragma unroll
  for (int q = 0; q < 4; ++q) { const f32x4 t0 = *(const f32x4*)(g + q * 256 + c0), t1 = *(const f32x4*)(b + q * 256 + c0);
#pragma unroll
    for (int j = 0; j < 4; ++j) { gv[4 * q + j] = t0[j]; bv[4 * q + j] = t1[j]; } }
  const int tstride = c.G * 8;
  int it = 0;
  for (int tok0 = c.bid * 8 + c.wid; tok0 < NTOK; tok0 += 2 * tstride, it += 2) {
    float v[2][16];
    float gy0[2], gy1[2];
#pragma unroll
    for (int u = 0; u < 2; ++u) {
      const int tok = tok0 + u * tstride;
      if (tok < NTOK) {
        if (mode == 0) {
#pragma unroll
          for (int q = 0; q < 4; ++q) { const f32x4 t = __builtin_nontemporal_load((const f32x4*)((const float*)(ws + WS_R2) + (size_t)tok * 1024 + q * 256 + c0)); v[u][4 * q] = t[0]; v[u][4 * q + 1] = t[1]; v[u][4 * q + 2] = t[2]; v[u][4 * q + 3] = t[3]; }
        } else {
#pragma unroll
          for (int q = 0; q < 4; ++q) { const f32x4 t = *(const f32x4*)(hin + (size_t)tok * 1024 + q * 256 + c0); v[u][4 * q] = ALPHA_F * t[0]; v[u][4 * q + 1] = ALPHA_F * t[1]; v[u][4 * q + 2] = ALPHA_F * t[2]; v[u][4 * q + 3] = ALPHA_F * t[3]; }
          const int a0 = assign[tok * 4], a1 = assign[tok * 4 + 1], a2 = assign[tok * 4 + 2], a3 = assign[tok * 4 + 3];
          gy0[u] = gate[tok * 2]; gy1[u] = gate[tok * 2 + 1];
          int p0 = 0, p1 = 0;
#pragma unroll
          for (int e = 0; e < NEXP; ++e) { if (e == a0) p0 = pad[e]; if (e == a2) p1 = pad[e]; }
          p0 += a1; p1 += a3;
          const bf16_t* Y = (const bf16_t*)(ws + WS_R2);
#pragma unroll
          for (int q = 0; q < 4; ++q) { const u32x2 y0 = __builtin_nontemporal_load((const u32x2*)(Y + (size_t)p0 * 1024 + q * 256 + c0)), y1 = __builtin_nontemporal_load((const u32x2*)(Y + (size_t)p1 * 1024 + q * 256 + c0));
            v[u][4 * q] += gy0[u] * __uint_as_float(y0.x << 16) + gy1[u] * __uint_as_float(y1.x << 16); v[u][4 * q + 1] += gy0[u] * __uint_as_float(y0.x & 0xffff0000u) + gy1[u] * __uint_as_float(y1.x & 0xffff0000u);
            v[u][4 * q + 2] += gy0[u] * __uint_as_float(y0.y << 16) + gy1[u] * __uint_as_float(y1.y << 16); v[u][4 * q + 3] += gy0[u] * __uint_as_float(y0.y & 0xffff0000u) + gy1[u] * __uint_as_float(y1.y & 0xffff0000u); }
        }
      } else {
#pragma unroll
        for (int j = 0; j < 16; ++j) v[u][j] = 0.f;
      }
    }
#pragma unroll
    for (int u = 0; u < 2; ++u) {
      const int tok = tok0 + u * tstride;
      float s = 0.f;
#pragma unroll
      for (int j = 0; j < 16; ++j) s += v[u][j];
      const float mean = wave_sum(s) * (1.0f / 1024.0f);
      float qq = 0.f;
#pragma unroll
      for (int j = 0; j < 16; ++j) { v[u][j] -= mean; qq += v[u][j] * v[u][j]; }
      const float r = 1.0f / sqrtf(wave_sum(qq) * (1.0f / 1024.0f) + LN_EPS_F);
#pragma unroll
      for (int j = 0; j < 16; ++j) v[u][j] = v[u][j] * r * gv[j] + bv[j];
      if (tok < NTOK) {
#pragma unroll
        for (int q = 0; q < 4; ++q) __builtin_nontemporal_store((f32x4){v[u][4 * q], v[u][4 * q + 1], v[u][4 * q + 2], v[u][4 * q + 3]}, (f32x4*)(hout + (size_t)tok * 1024 + q * 256 + c0));
        if (!(mode == 1 && layer == 1) && !dry) {
#pragma unroll
          for (int q = 0; q < 4; ++q) *(u32x2*)(hb + (size_t)tok * 1024 + q * 256 + c0) = (u32x2){pk2(v[u][4 * q], v[u][4 * q + 1]), pk2(v[u][4 * q + 2], v[u][4 * q + 3])}; }
      }
      if (mode == 0) {
        float lg[16];
#pragma unroll
        for (int e = 0; e < 16; ++e) { float a = 0.f;
#pragma unroll
          for (int q = 0; q < 4; ++q) { const f32x4 w = *(const f32x4*)(rwT + e * 1024 + q * 256 + c0); a += v[u][4 * q] * w[0] + v[u][4 * q + 1] * w[1] + v[u][4 * q + 2] * w[2] + v[u][4 * q + 3] * w[3]; }
          lg[e] = a; }
#pragma unroll
        for (int e = 0; e < 16; ++e) lg[e] = wave_sum(lg[e]);
        int eo[2]; float go[2];
        route_from_logits(lg, p.in[I_ROUTER_B], eo, go);
        if (c.lane == 0 && tok < NTOK && !dry) {
          const int r1 = atomicAdd(lcnt + eo[0], 1), r2 = atomicAdd(lcnt + eo[1], 1);
          const int ri = (it + u) * 8 + c.wid;
          rec[ri * 4] = eo[0]; rec[ri * 4 + 1] = r1; rec[ri * 4 + 2] = eo[1]; rec[ri * 4 + 3] = r2; recg[ri * 2] = go[0]; recg[ri * 2 + 1] = go[1];
        }
      }
    }
  }
  if (mode == 0 && !dry) {
    __syncthreads();
    if (c.tid < 16) lbase[c.tid] = (int)atomicAdd(cnt + c.tid * 16, (unsigned)lcnt[c.tid]);
    __syncthreads();
    const int nrec = ((NTOK + c.G * 8 - 1) / (c.G * 8)) * 8;
    for (int ri = c.tid; ri < nrec; ri += NTHREADS) {
      const int tok = c.bid * 8 + (ri & 7) + (ri >> 3) * c.G * 8;
      if (tok < NTOK) {
        const int e1 = rec[ri * 4], e2 = rec[ri * 4 + 2]; const int r1 = rec[ri * 4 + 1] + lbase[e1], r2 = rec[ri * 4 + 3] + lbase[e2];
        list[e1 * NTOK + r1] = tok; list[e2 * NTOK + r2] = tok;
        assign[tok * 4] = e1; assign[tok * 4 + 1] = r1; assign[tok * 4 + 2] = e2; assign[tok * 4 + 3] = r2;
        gate[tok * 2] = recg[ri * 2]; gate[tok * 2 + 1] = recg[ri * 2 + 1];
      }
    }
  }
  __syncthreads();
}
#endif
#ifndef CPU_EMU
namespace scan {
typedef short bf16x8 __attribute__((ext_vector_type(8)));
typedef float f32x4 __attribute__((ext_vector_type(4)));
typedef unsigned u32x4 __attribute__((ext_vector_type(4)));
typedef unsigned u32x2 __attribute__((ext_vector_type(2)));
enum { MIX_A = 0, MIX_B = 1, MIX_C = 2, MIX_D = 3 };
constexpr int LD_T = 144;
constexpr int OFF_QS = 0, OFF_KS = 17408, OFF_QI = 34816, OFF_KT = 52224, OFF_VT = 70656, OFF_SC = 77568, OFF_ST = 86784, OFF_DEC = 99840, OFF_EM = 100352, OFF_DEN = 100608, OFF_CW = 100864, SCAN_LDS = 104960;

__device__ __forceinline__ float incl_scan_add(float x) {
  x += __builtin_bit_cast(float, __builtin_amdgcn_update_dpp(0, __builtin_bit_cast(int, x), 0x111, 0xf, 0xf, false));
  x += __builtin_bit_cast(float, __builtin_amdgcn_update_dpp(0, __builtin_bit_cast(int, x), 0x112, 0xf, 0xf, false));
  x += __builtin_bit_cast(float, __builtin_amdgcn_update_dpp(0, __builtin_bit_cast(int, x), 0x114, 0xf, 0xf, false));
  x += __builtin_bit_cast(float, __builtin_amdgcn_update_dpp(0, __builtin_bit_cast(int, x), 0x118, 0xf, 0xf, false));
  x += __builtin_bit_cast(float, __builtin_amdgcn_update_dpp(0, __builtin_bit_cast(int, x), 0x142, 0xa, 0xf, false));
  x += __builtin_bit_cast(float, __builtin_amdgcn_update_dpp(0, __builtin_bit_cast(int, x), 0x143, 0xc, 0xf, false));
  return x;
}
__device__ __forceinline__ float incl_scan_max(float x) {
  const int ninf = (int)0xff800000u;
  x = fmaxf(x, __builtin_bit_cast(float, __builtin_amdgcn_update_dpp(ninf, __builtin_bit_cast(int, x), 0x111, 0xf, 0xf, false)));
  x = fmaxf(x, __builtin_bit_cast(float, __builtin_amdgcn_update_dpp(ninf, __builtin_bit_cast(int, x), 0x112, 0xf, 0xf, false)));
  x = fmaxf(x, __builtin_bit_cast(float, __builtin_amdgcn_update_dpp(ninf, __builtin_bit_cast(int, x), 0x114, 0xf, 0xf, false)));
  x = fmaxf(x, __builtin_bit_cast(float, __builtin_amdgcn_update_dpp(ninf, __builtin_bit_cast(int, x), 0x118, 0xf, 0xf, false)));
  x = fmaxf(x, __builtin_bit_cast(float, __builtin_amdgcn_update_dpp(ninf, __builtin_bit_cast(int, x), 0x142, 0xa, 0xf, false)));
  x = fmaxf(x, __builtin_bit_cast(float, __builtin_amdgcn_update_dpp(ninf, __builtin_bit_cast(int, x), 0x143, 0xc, 0xf, false)));
  return x;
}
__device__ __forceinline__ float rdlane(float x, int l) { return __builtin_bit_cast(float, __builtin_amdgcn_readlane(__builtin_bit_cast(int, x), l)); }
__device__ __forceinline__ bf16x8 ldfrag(const unsigned char* base, int ld, int row, int kbyte) { return *(const bf16x8*)(base + row * ld + kbyte); }
__device__ __forceinline__ unsigned pk(float a, float b) { return pk_hw(a, b); }
__device__ __forceinline__ float lo16(unsigned w) { return __uint_as_float(w << 16); }
__device__ __forceinline__ float hi16(unsigned w) { return __uint_as_float(w & 0xffff0000u); }

__device__ __forceinline__ void lds_barrier() { asm volatile("s_waitcnt lgkmcnt(0)" ::: "memory"); __builtin_amdgcn_s_barrier(); asm volatile("" ::: "memory"); }
struct Raw { u32x4 a0, a1, b0, b1; f32x4 r0, r1; u32x2 v; float s0, s1; };

template <int MIXER>
__device__ __forceinline__ void scan_item(unsigned char* lds, int wv, const Params& p, int b, int h, int dir, int vs) {
  constexpr int DK = (MIXER == MIX_A || MIXER == MIX_D) ? 128 : 64;
  constexpr int NC = DK / 8;
  constexpr int LD_D = DK * 2 + 16;
  constexpr int NVT = MIXER == MIX_D ? 3 : 2;
  constexpr int NKD = DK / 32;
  const int tid = opaque_tid(wv), lane0 = tid & 63, wid = __builtin_amdgcn_readfirstlane(tid >> 6);
  unsigned char* ws = p.ws;
  const bf16_t* P = (const bf16_t*)(ws + WS_R1);
  const bf16_t* LFBp = (const bf16_t*)(ws + WS_LFB);
  const float* side = (const float*)(ws + WS_SIDE);
  const float* rope = (const float*)(ws + WS_ROPE);
  bf16_t* O = (bf16_t*)(ws + WS_R2) + (size_t)dir * NTOK * 1024;
  unsigned char* QS = lds + OFF_QS; unsigned char* KS = lds + OFF_KS; unsigned char* QI = lds + OFF_QI; unsigned char* KT = lds + OFF_KT;
  unsigned char* VT = lds + OFF_VT; unsigned char* SC = lds + OFF_SC; unsigned char* ST = lds + OFF_ST;
  float* DEC = (float*)(lds + OFF_DEC); float* EM = (float*)(lds + OFF_EM); float* DEN = (float*)(lds + OFF_DEN);

  int qcol, kcol, lfcol, vcol, ocol;
  if (MIXER == MIX_A) { qcol = h * 128; kcol = 0; lfcol = 512 + dir * 512 + h * 128; vcol = 1536 + h * 128 + vs * 32; ocol = h * 128 + vs * 32; }
  else if (MIXER == MIX_B) { qcol = 2560 + h * 64; kcol = 2816 + h * 64; lfcol = dir * 256 + h * 64; vcol = 3072 + h * 128 + vs * 32; ocol = 512 + h * 128 + vs * 32; }
  else if (MIXER == MIX_C) { qcol = h * 64; kcol = 256 + h * 64; lfcol = 0; vcol = 512 + h * 128 + vs * 32; ocol = h * 128 + vs * 32; }
  else { qcol = h * 128  ; kcol = 3584 + h * 128  ; lfcol = 0; vcol = 2560 + h * 128 + vs * 32; ocol = 512 + h * 128 + vs * 32; }
  const int c0 = (MIXER == MIX_C) ? wid * 4 : wid * NC;
  const float lgam = (MIXER == MIX_C) ? log1pf(-exp2f(-(5.0f + 2.0f * (float)h + (float)dir))) : 0.f;
  const float fgb = (MIXER == MIX_D) ? p.in[I_FGATE_B][dir * 4 + h] : 0.f;
  for (int i = tid; i < 48 * LD_D / 4; i += NTHREADS) ((unsigned*)ST)[i] = 0u;
  if (MIXER == MIX_D) {
    for (int i = tid; i < 16 * 64; i += NTHREADS) { const int r = 32 + (i >> 6), j = i & 63; *(bf16_t*)(VT + r * LD_T + j * 2) = (r == 32) ? (bf16_t)0x3F80 : (bf16_t)0; }
  }
  f32x4 sacc[NVT == 3 ? 3 : 2];
#pragma unroll
  for (int i = 0; i < (NVT == 3 ? 3 : 2); ++i) sacc[i] = (f32x4){0.f, 0.f, 0.f, 0.f};
  float m_st = 0.f;
  const size_t tokbase = (size_t)b * SEQ;
  const int sgn = dir ? -1 : 1;
  __syncthreads();

  Raw R;
#define SCAN_LOAD(n_) do { \
    int ln_ = lane0; asm volatile("" : "+v"(ln_)); \
    const int t_ = dir ? (SEQ - 1 - ((n_) * 64 + ln_)) : ((n_) * 64 + ln_); \
    const bf16_t* row_ = P + (tokbase + t_) * PSTRIDE; \
    if (MIXER == MIX_A) { const u32x4* qp_ = (const u32x4*)(row_ + qcol + c0); const u32x4* lp_ = (const u32x4*)(row_ + lfcol + c0); R.a0 = qp_[0]; R.a1 = qp_[1]; R.b0 = lp_[0]; R.b1 = lp_[1]; } \
    else if (MIXER == MIX_B) { R.a0 = *(const u32x4*)(row_ + qcol + c0); R.a1 = *(const u32x4*)(row_ + kcol + c0); R.b0 = *(const u32x4*)(LFBp + (tokbase + t_) * 512 + lfcol + c0); } \
    else if (MIXER == MIX_C) { const u32x2 qa_ = *(const u32x2*)(row_ + qcol + c0), qb_ = *(const u32x2*)(row_ + qcol + 32 + c0), ka_ = *(const u32x2*)(row_ + kcol + c0), kb_ = *(const u32x2*)(row_ + kcol + 32 + c0); \
      R.a0 = (u32x4){qa_.x, qa_.y, qb_.x, qb_.y}; R.a1 = (u32x4){ka_.x, ka_.y, kb_.x, kb_.y}; \
      R.r0 = *(const f32x4*)(rope + ((size_t)t_ * 32 + c0) * 2); R.r1 = *(const f32x4*)(rope + ((size_t)t_ * 32 + c0) * 2 + 4); } \
    else { const u32x4* qp_ = (const u32x4*)(LFBp + (tokbase + t_) * 512 + qcol + c0); const u32x4* kp_ = (const u32x4*)(row_ + kcol + c0); R.a0 = qp_[0]; R.a1 = qp_[1]; R.b0 = kp_[0]; R.b1 = kp_[1]; \
      R.s0 = side[(tokbase + t_) * 32 + dir * 8 + h]; R.s1 = side[(tokbase + t_) * 32 + dir * 8 + 4 + h]; } \
    R.v = *(const u32x2*)(row_ + vcol + wid * 4); } while (0)

  SCAN_LOAD(0);
  for (int n = 0; n < SEQ / 64; ++n) {
    int lane = lane0; asm volatile("" : "+v"(lane));
    const int fr = lane & 15, fq = lane >> 4;
    float q[NC], k[NC], g[NC];
    const u32x2 vv = R.v;
    float g_li = 0.f, g_lf = 0.f;
    if (MIXER == MIX_A) {
      const unsigned qw[8] = {R.a0.x, R.a0.y, R.a0.z, R.a0.w, R.a1.x, R.a1.y, R.a1.z, R.a1.w}, lw[8] = {R.b0.x, R.b0.y, R.b0.z, R.b0.w, R.b1.x, R.b1.y, R.b1.z, R.b1.w};
#pragma unroll
      for (int c = 0; c < 8; ++c) { q[2 * c] = lo16(qw[c]); q[2 * c + 1] = hi16(qw[c]); g[2 * c] = lo16(lw[c]); g[2 * c + 1] = hi16(lw[c]); }
#pragma unroll
      for (int c = 0; c < NC; ++c) k[c] = 1.0f - __expf(g[c]);
    } else if (MIXER == MIX_B) {
      const unsigned qw[4] = {R.a0.x, R.a0.y, R.a0.z, R.a0.w}, kw[4] = {R.a1.x, R.a1.y, R.a1.z, R.a1.w}, lw[4] = {R.b0.x, R.b0.y, R.b0.z, R.b0.w};
#pragma unroll
      for (int c = 0; c < 4; ++c) { q[2 * c] = lo16(qw[c]); q[2 * c + 1] = hi16(qw[c]); k[2 * c] = lo16(kw[c]); k[2 * c + 1] = hi16(kw[c]); g[2 * c] = lo16(lw[c]); g[2 * c + 1] = hi16(lw[c]); }
    } else if (MIXER == MIX_C) {
      const float cs[4] = {R.r0[0], R.r0[2], R.r1[0], R.r1[2]}, sn[4] = {R.r0[1], R.r0[3], R.r1[1], R.r1[3]};
      const float q1[4] = {lo16(R.a0.x), hi16(R.a0.x), lo16(R.a0.y), hi16(R.a0.y)}, q2[4] = {lo16(R.a0.z), hi16(R.a0.z), lo16(R.a0.w), hi16(R.a0.w)};
      const float k1[4] = {lo16(R.a1.x), hi16(R.a1.x), lo16(R.a1.y), hi16(R.a1.y)}, k2[4] = {lo16(R.a1.z), hi16(R.a1.z), lo16(R.a1.w), hi16(R.a1.w)};
#pragma unroll
      for (int c = 0; c < 4; ++c) { q[c] = (q1[c] * cs[c] - q2[c] * sn[c]) * 0.125f; q[4 + c] = (q1[c] * sn[c] + q2[c] * cs[c]) * 0.125f; k[c] = k1[c] * cs[c] - k2[c] * sn[c]; k[4 + c] = k1[c] * sn[c] + k2[c] * cs[c]; }
#pragma unroll
      for (int c = 0; c < NC; ++c) g[c] = (float)(lane + 1) * lgam;
    } else {
      const unsigned qw[8] = {R.a0.x, R.a0.y, R.a0.z, R.a0.w, R.a1.x, R.a1.y, R.a1.z, R.a1.w}, kw[8] = {R.b0.x, R.b0.y, R.b0.z, R.b0.w, R.b1.x, R.b1.y, R.b1.z, R.b1.w};
      g_li = R.s0; g_lf = R.s1;
#pragma unroll
      for (int c = 0; c < 8; ++c) { q[2 * c] = lo16(qw[c]); q[2 * c + 1] = hi16(qw[c]); k[2 * c] = lo16(kw[c]); k[2 * c + 1] = hi16(kw[c]); }
#pragma unroll
      for (int c = 0; c < NC; ++c) g[c] = 0.f;
    }
    if (n + 1 < SEQ / 64) SCAN_LOAD(n + 1);

#ifndef PROBE_REPA
#define PROBE_REPA 1
#endif
    const float m_save = m_st;
#pragma unroll 1
    for (int rep = 0; rep < PROBE_REPA; ++rep) {
    if (PROBE_REPA > 1) { m_st = m_save;
#pragma unroll
      for (int c = 0; c < NC; ++c) asm volatile("" : "+v"(g[c]), "+v"(q[c]), "+v"(k[c])); }
    float s_qs[NC], s_ks[NC], s_qi[NC], s_kt[NC];
    if (MIXER != MIX_D) {
#pragma unroll
      for (int c = 0; c < NC; ++c) {
        const float gc = (MIXER == MIX_C) ? g[c] : incl_scan_add(g[c]);
        const float gref = rdlane(gc, 31), glast = rdlane(gc, 63);
        const float a = __expf(gc - gref), ia = __builtin_amdgcn_rcpf(a);
        s_qs[c] = a; s_ks[c] = ia; s_qi[c] = a * __expf(gref); s_kt[c] = ia * __expf(glast - gref);
        if (lane == 63) DEC[(MIXER == MIX_C) ? (c < 4 ? c0 + c : 32 + c0 + c - 4) : c0 + c] = __expf(glast);
      }
    } else {
      const float li = g_li;
      const float lf = logsigmoidf_(g_lf + fgb);
      const float bc = incl_scan_add(lf);
      const float u = li - bc;
      const float pm = incl_scan_max(u);
      const float cmax = rdlane(pm, 63), blast = rdlane(bc, 63);
      const float a_i = bc + m_st, m_i = fmaxf(a_i, bc + pm);
      const float alpha = __expf(bc - m_i + cmax), beta = __expf(u - cmax), sint = __expf(a_i - m_i);
      const float m_new = fmaxf(blast + m_st, blast + cmax);
      const float s_old = __expf(blast + m_st - m_new), wks = __expf(blast + u - m_new);
      m_st = m_new;
#pragma unroll
      for (int c = 0; c < NC; ++c) { s_qs[c] = alpha; s_ks[c] = beta; s_qi[c] = sint; s_kt[c] = wks; }
      if (wid == 0) EM[lane] = __expf(-m_i);
      if (lane == 63) {
#pragma unroll
        for (int c = 0; c < NC; ++c) DEC[c0 + c] = s_old;
      }
    }
    {
      unsigned wq[NC / 2], wk[NC / 2], wi[NC / 2];
#pragma unroll
      for (int c = 0; c < NC / 2; ++c) { wq[c] = pk(q[2 * c] * s_qs[2 * c], q[2 * c + 1] * s_qs[2 * c + 1]); wk[c] = pk(k[2 * c] * s_ks[2 * c], k[2 * c + 1] * s_ks[2 * c + 1]); wi[c] = pk(q[2 * c] * s_qi[2 * c], q[2 * c + 1] * s_qi[2 * c + 1]); }
      if (MIXER == MIX_C) {
        *(u32x2*)(QS + lane * LD_D + c0 * 2) = (u32x2){wq[0], wq[1]}; *(u32x2*)(QS + lane * LD_D + (32 + c0) * 2) = (u32x2){wq[2], wq[3]};
        *(u32x2*)(KS + lane * LD_D + c0 * 2) = (u32x2){wk[0], wk[1]}; *(u32x2*)(KS + lane * LD_D + (32 + c0) * 2) = (u32x2){wk[2], wk[3]};
        *(u32x2*)(QI + lane * LD_D + c0 * 2) = (u32x2){wi[0], wi[1]}; *(u32x2*)(QI + lane * LD_D + (32 + c0) * 2) = (u32x2){wi[2], wi[3]};
      } else {
#pragma unroll
        for (int c = 0; c < NC / 8; ++c) {
          *(u32x4*)(QS + lane * LD_D + (c0 + 8 * c) * 2) = (u32x4){wq[4 * c], wq[4 * c + 1], wq[4 * c + 2], wq[4 * c + 3]};
          *(u32x4*)(KS + lane * LD_D + (c0 + 8 * c) * 2) = (u32x4){wk[4 * c], wk[4 * c + 1], wk[4 * c + 2], wk[4 * c + 3]};
          *(u32x4*)(QI + lane * LD_D + (c0 + 8 * c) * 2) = (u32x4){wi[4 * c], wi[4 * c + 1], wi[4 * c + 2], wi[4 * c + 3]};
        }
      }
#pragma unroll
      for (int c = 0; c < NC; ++c) { const int d = (MIXER == MIX_C) ? (c < 4 ? c0 + c : 32 + c0 + c - 4) : c0 + c; *(bf16_t*)(KT + d * LD_T + lane * 2) = f2bf(k[c] * s_kt[c]); }
      *(bf16_t*)(VT + (wid * 4 + 0) * LD_T + lane * 2) = (bf16_t)(vv.x & 0xffff); *(bf16_t*)(VT + (wid * 4 + 1) * LD_T + lane * 2) = (bf16_t)(vv.x >> 16);
      *(bf16_t*)(VT + (wid * 4 + 2) * LD_T + lane * 2) = (bf16_t)(vv.y & 0xffff); *(bf16_t*)(VT + (wid * 4 + 3) * LD_T + lane * 2) = (bf16_t)(vv.y >> 16);
    }
    }
    lds_barrier();
    {
      const int it = wid & 3;
#pragma unroll
      for (int jj = 0; jj < 2; ++jj) {
        const int jt = 2 * (wid >> 2) + jj;
        if (jt <= it) {
          f32x4 acc = (f32x4){0.f, 0.f, 0.f, 0.f};
#pragma unroll
          for (int ks = 0; ks < NKD; ++ks) acc = __builtin_amdgcn_mfma_f32_16x16x32_bf16(ldfrag(KS, LD_D, jt * 16 + fr, ks * 64 + fq * 16), ldfrag(QS, LD_D, it * 16 + fr, ks * 64 + fq * 16), acc, 0, 0, 0);
          const int i = it * 16 + fr, j0 = jt * 16 + fq * 4;
          const float v0 = (j0 + 0 <= i) ? acc[0] : 0.f, v1 = (j0 + 1 <= i) ? acc[1] : 0.f, v2 = (j0 + 2 <= i) ? acc[2] : 0.f, v3 = (j0 + 3 <= i) ? acc[3] : 0.f;
          *(u32x2*)(SC + i * LD_T + j0 * 2) = (u32x2){pk(v0, v1), pk(v2, v3)};
        } else {
          const int i = it * 16 + fr, j0 = jt * 16 + fq * 4;
          *(u32x2*)(SC + i * LD_T + j0 * 2) = (u32x2){0u, 0u};
        }
      }
    }
    f32x4 oacc = (f32x4){0.f, 0.f, 0.f, 0.f}, dacc = (f32x4){0.f, 0.f, 0.f, 0.f};
    {
      const int vt = wid >> 2, it = wid & 3;
#pragma unroll
      for (int ks = 0; ks < NKD; ++ks) oacc = __builtin_amdgcn_mfma_f32_16x16x32_bf16(ldfrag(ST, LD_D, vt * 16 + fr, ks * 64 + fq * 16), ldfrag(QI, LD_D, it * 16 + fr, ks * 64 + fq * 16), oacc, 0, 0, 0);
      if (NVT == 3 && wid < 4) {
#pragma unroll
        for (int ks = 0; ks < NKD; ++ks) dacc = __builtin_amdgcn_mfma_f32_16x16x32_bf16(ldfrag(ST, LD_D, 32 + fr, ks * 64 + fq * 16), ldfrag(QI, LD_D, wid * 16 + fr, ks * 64 + fq * 16), dacc, 0, 0, 0);
      }
    }
    lds_barrier();
    {
      const int vt = wid >> 2, it = wid & 3;
#pragma unroll
      for (int ks = 0; ks < 2; ++ks) oacc = __builtin_amdgcn_mfma_f32_16x16x32_bf16(ldfrag(VT, LD_T, vt * 16 + fr, ks * 64 + fq * 16), ldfrag(SC, LD_T, it * 16 + fr, ks * 64 + fq * 16), oacc, 0, 0, 0);
      if (NVT == 3) {
        if (wid < 4) {
#pragma unroll
          for (int ks = 0; ks < 2; ++ks) dacc = __builtin_amdgcn_mfma_f32_16x16x32_bf16(ldfrag(VT, LD_T, 32 + fr, ks * 64 + fq * 16), ldfrag(SC, LD_T, wid * 16 + fr, ks * 64 + fq * 16), dacc, 0, 0, 0);
          if (fq == 0) DEN[wid * 16 + fr] = dacc[0];
        }
        lds_barrier();
        const int i = it * 16 + fr;
        const float dn = 1.0f / fmaxf(fabsf(DEN[i]), EM[i]);
        oacc *= dn;
      }
      const int i = it * 16 + fr;
      const int ti = dir ? (SEQ - 1 - (n * 64 + i)) : (n * 64 + i);
      *(u32x2*)(O + (tokbase + ti) * 1024 + ocol + vt * 16 + fq * 4) = (u32x2){pk(oacc[0], oacc[1]), pk(oacc[2], oacc[3])};
    }
    {
      constexpr int NST = (DK == 128) ? NVT : 1;
#pragma unroll
      for (int s = 0; s < NST; ++s) {
        const int dt = (DK == 128) ? wid : (wid & 3), vt = (DK == 128) ? s : (wid >> 2);
        const f32x4 dc = *(const f32x4*)(DEC + dt * 16 + fq * 4);
        f32x4 acc = sacc[s] * dc;
#pragma unroll
        for (int ks = 0; ks < 2; ++ks) acc = __builtin_amdgcn_mfma_f32_16x16x32_bf16(ldfrag(KT, LD_T, dt * 16 + fr, ks * 64 + fq * 16), ldfrag(VT, LD_T, vt * 16 + fr, ks * 64 + fq * 16), acc, 0, 0, 0);
        sacc[s] = acc;
        *(u32x2*)(ST + (vt * 16 + fr) * LD_D + (dt * 16 + fq * 4) * 2) = (u32x2){pk(acc[0], acc[1]), pk(acc[2], acc[3])};
      }
    }
    lds_barrier();
  }
}

template <int MIXER>
__device__ __forceinline__ void scan_dispatch(unsigned char* lds, int wv, const Params& p, int id) {
  const int vs = id & 3, dir = (id >> 2) & 1, h = (id >> 3) & 3, b = id >> 5;
  scan_item<MIXER>(lds, wv, p, b, h, dir, vs);
}
}

__device__ __forceinline__ void convd_phase(unsigned char* lds_, int wv, const Params& p) {
  const Ctx c = make_ctx(lds_, wv);
  bf16_t* P = (bf16_t*)(p.ws + WS_R1); bf16_t* QD = (bf16_t*)(p.ws + WS_LFB);
  const float* cw = p.in[I_CONV_W]; const float* cb = p.in[I_CONV_B];
  const int ch = c.lane * 16;
  float w0[16], w1[16], w2[16], bb[16];
#pragma unroll
  for (int j = 0; j < 16; ++j) { w0[j] = cw[ch + j]; w1[j] = cw[1024 + ch + j]; w2[j] = cw[2048 + ch + j]; bb[j] = cb[ch + j]; }
  for (int tok = c.bid * 8 + c.wid; tok < NTOK; tok += c.G * 8) {
    const int t = tok % SEQ;
    const bf16_t* row = P + PIDX(tok, 1536 + ch);
    float x0[16], x1[16], x2[16];
    { const u32x4* r1 = (const u32x4*)row; unpack8(r1[0], x1); unpack8(r1[1], x1 + 8); }
    if (t > 0) { const u32x4* r0 = (const u32x4*)(row - 128); unpack8(r0[0], x0); unpack8(r0[1], x0 + 8); }
    else {
#pragma unroll
      for (int j = 0; j < 16; ++j) x0[j] = 0.f; }
    if (t < SEQ - 1) { const u32x4* r2 = (const u32x4*)(row + 128); unpack8(r2[0], x2); unpack8(r2[1], x2 + 8); }
    else {
#pragma unroll
      for (int j = 0; j < 16; ++j) x2[j] = 0.f; }
    const float sc = ch < 512 ? 0.08838834764831845f : 1.0f;
    unsigned w[8];
#pragma unroll
    for (int j = 0; j < 8; ++j) {
      const float a0 = bb[2 * j] + w0[2 * j] * x0[2 * j] + w1[2 * j] * x1[2 * j] + w2[2 * j] * x2[2 * j];
      const float a1 = bb[2 * j + 1] + w0[2 * j + 1] * x0[2 * j + 1] + w1[2 * j + 1] * x1[2 * j + 1] + w2[2 * j + 1] * x2[2 * j + 1];
      w[j] = pk2(fsilu(a0) * sc, fsilu(a1) * sc);
    }
    u32x4* d = (ch < 512) ? (u32x4*)(QD + PIDX(tok, ch)) : (u32x4*)(P + PIDX(tok, 3584 + (ch - 512)));
    d[0] = (u32x4){w[0], w[1], w[2], w[3]}; d[1] = (u32x4){w[4], w[5], w[6], w[7]};
  }
}

__device__ __forceinline__ void scan_phase(unsigned char* lds, int wv, const Params& p, int layer) {
  for (int item = blockIdx.x; item < 256; item += gridDim.x) {
    if (layer == 0) { if (item < 128) scan::scan_dispatch<scan::MIX_A>(lds, wv, p, item); else scan::scan_dispatch<scan::MIX_B>(lds, wv, p, item - 128); }
    else { if (item < 128) scan::scan_dispatch<scan::MIX_D>(lds, wv, p, item); else scan::scan_dispatch<scan::MIX_C>(lds, wv, p, item - 128); }
    __syncthreads();
  }
}
#endif
#ifndef CPU_EMU
namespace scan2 {
using namespace scan;
constexpr int S_QS = 0, S_KS = 17408, S_QI = 34816, S_KT = 52224  , S_VT = 89088  , S_SC = 102912, S_ST = 112128  , S_DEC = 138240  , S_EM = 139264  , S_END = 139776;

constexpr int U_QI = 0, U_KS = 34816, U_KT = 69632, U_VT = 106496, U_SC = 120320, U_ST = 129536, U_DEC = 155648, U_EM = 156672, U_END = 157184;
template <int MIXER>
__device__ __forceinline__ void scan_item2(unsigned char* lds, int wv, const Params& p, int b, int h, int dir, int vs) {
  constexpr int DK = (MIXER == MIX_A || MIXER == MIX_D) ? 128 : 64;
  constexpr int NC = DK / 8;
  constexpr int LD_D = DK * 2 + 16;
  constexpr int NVT = MIXER == MIX_D ? 3 : 2;
  constexpr int NKD = DK / 32;
  constexpr int NST = (DK == 128) ? NVT : 1;
  constexpr int NCH = SEQ / 64;
  const int tid = opaque_tid(wv), lane0 = tid & 63, wid = __builtin_amdgcn_readfirstlane(tid >> 6);
  unsigned char* ws = p.ws;
  const bf16_t* P = (const bf16_t*)(ws + WS_R1);
  const bf16_t* LFBp = (const bf16_t*)(ws + WS_LFB);
  const float* side = (const float*)(ws + WS_SIDE);
  const float* rope = (const float*)(ws + WS_ROPE);
  bf16_t* O = (bf16_t*)(ws + WS_R2) + (size_t)dir * NTOK * 1024;
  unsigned char* SC = lds + U_SC;
  int qcol, kcol, lfcol, vcol, ocol;
  if (MIXER == MIX_A) { qcol = h * 128; kcol = 0; lfcol = 512 + dir * 512 + h * 128; vcol = 1536 + h * 128 + vs * 32; ocol = h * 128 + vs * 32; }
  else if (MIXER == MIX_B) { qcol = 2560 + h * 64; kcol = 2816 + h * 64; lfcol = dir * 256 + h * 64; vcol = 3072 + h * 128 + vs * 32; ocol = 512 + h * 128 + vs * 32; }
  else if (MIXER == MIX_C) { qcol = h * 64; kcol = 256 + h * 64; lfcol = 0; vcol = 512 + h * 128 + vs * 32; ocol = h * 128 + vs * 32; }
  else { qcol = h * 128; kcol = 3584 + h * 128; lfcol = 0; vcol = 2560 + h * 128 + vs * 32; ocol = 512 + h * 128 + vs * 32; }
  const size_t tokbase = (size_t)b * SEQ;
  const int c0 = (MIXER == MIX_C) ? wid * 4 : wid * NC;
  for (int i = tid; i < 2 * 13056 / 4; i += NTHREADS) ((unsigned*)(lds + U_ST))[i] = 0u;
  for (int i = tid; i < 9216 / 4; i += NTHREADS) ((unsigned*)(lds + U_SC))[i] = 0u;
  if (MIXER == MIX_D) { for (int i = tid; i < 2 * 16 * 64; i += NTHREADS) { const int bf = i >> 10, r = 32 + ((i >> 6) & 15), j = i & 63; *(bf16_t*)(lds + U_VT + bf * 6912 + r * LD_T + j * 2) = (r == 32) ? (bf16_t)0x3F80 : (bf16_t)0; } }
  const float lgam2 = (MIXER == MIX_C) ? log1pf(-exp2f(-(5.0f + 2.0f * (float)h + (float)dir))) * 1.4426950408889634f : 0.f;
  const float fgb = (MIXER == MIX_D) ? p.in[I_FGATE_B][dir * 4 + h] : 0.f;
  float m_st = 0.f;
  __syncthreads();

  Raw R, Rn; u32x2 Rv, Rvn;
#define A_LOAD(R, Rv, n_) do { \
    const int ln_ = lane0; \
    const int t_ = dir ? (SEQ - 1 - ((n_) * 64 + ln_)) : ((n_) * 64 + ln_); \
    const size_t tk_ = tokbase + t_; \
    if (MIXER == MIX_A) { const u32x4* qp_ = (const u32x4*)(P + PIDX(tk_, qcol + c0)); const u32x4* lp_ = (const u32x4*)(P + PIDX(tk_, lfcol + c0)); R.a0 = qp_[0]; R.a1 = qp_[1]; R.b0 = lp_[0]; R.b1 = lp_[1]; } \
    else if (MIXER == MIX_B) { R.a0 = *(const u32x4*)(P + PIDX(tk_, qcol + c0)); R.a1 = *(const u32x4*)(P + PIDX(tk_, kcol + c0)); R.b0 = *(const u32x4*)(LFBp + PIDX(tk_, lfcol + c0)); } \
    else if (MIXER == MIX_C) { const u32x2 qa_ = *(const u32x2*)(P + PIDX(tk_, qcol + c0)), qb_ = *(const u32x2*)(P + PIDX(tk_, qcol + 32 + c0)), ka_ = *(const u32x2*)(P + PIDX(tk_, kcol + c0)), kb_ = *(const u32x2*)(P + PIDX(tk_, kcol + 32 + c0)); \
      R.a0 = (u32x4){qa_.x, qa_.y, qb_.x, qb_.y}; R.a1 = (u32x4){ka_.x, ka_.y, kb_.x, kb_.y}; \
      R.r0 = *(const f32x4*)(rope + ((size_t)t_ * 32 + c0) * 2); R.r1 = *(const f32x4*)(rope + ((size_t)t_ * 32 + c0) * 2 + 4); } \
    else { const u32x4* qp_ = (const u32x4*)(LFBp + PIDX(tk_, qcol + c0)); const u32x4* kp_ = (const u32x4*)(P + PIDX(tk_, kcol + c0)); R.a0 = qp_[0]; R.a1 = qp_[1]; R.b0 = kp_[0]; R.b1 = kp_[1]; \
      R.s0 = side[tk_ * 32 + dir * 8 + h]; R.s1 = side[tk_ * 32 + dir * 8 + 4 + h]; } \
    Rv = *(const u32x2*)(P + PIDX(tk_, vcol + wid * 4)); } while (0)

  float rr_next = 1.f, rr_cur = 1.f;
#define A_PREP(buf_, R, Rv) do { \
    const int lane = lane0; \
    unsigned char* KTb = lds + U_KT + (buf_) * 18432; float* DECb = (float*)(lds + U_DEC + (buf_) * 512); float* EMb = (float*)(lds + U_EM + (buf_) * 256); \
    unsigned char* QIb = lds + U_QI + (buf_) * 17408; unsigned char* KSb = lds + U_KS + (buf_) * 17408; \
    float q[NC], k[NC], g[NC], ktv[NC]; \
    if (MIXER == MIX_A) { \
      const unsigned qw[8] = {R.a0.x, R.a0.y, R.a0.z, R.a0.w, R.a1.x, R.a1.y, R.a1.z, R.a1.w}, lw[8] = {R.b0.x, R.b0.y, R.b0.z, R.b0.w, R.b1.x, R.b1.y, R.b1.z, R.b1.w}; \
      _Pragma("unroll") for (int c = 0; c < 8; ++c) { q[2 * c] = lo16(qw[c]); q[2 * c + 1] = hi16(qw[c]); g[2 * c] = lo16(lw[c]); g[2 * c + 1] = hi16(lw[c]); } \
      _Pragma("unroll") for (int c = 0; c < NC; ++c) k[c] = 1.0f - __builtin_amdgcn_exp2f(g[c]); \
    } else if (MIXER == MIX_B) { \
      const unsigned qw[4] = {R.a0.x, R.a0.y, R.a0.z, R.a0.w}, kw[4] = {R.a1.x, R.a1.y, R.a1.z, R.a1.w}, lw[4] = {R.b0.x, R.b0.y, R.b0.z, R.b0.w}; \
      _Pragma("unroll") for (int c = 0; c < 4; ++c) { q[2 * c] = lo16(qw[c]); q[2 * c + 1] = hi16(qw[c]); k[2 * c] = lo16(kw[c]); k[2 * c + 1] = hi16(kw[c]); g[2 * c] = lo16(lw[c]); g[2 * c + 1] = hi16(lw[c]); } \
    } else if (MIXER == MIX_C) { \
      const float cs[4] = {R.r0[0], R.r0[2], R.r1[0], R.r1[2]}, sn[4] = {R.r0[1], R.r0[3], R.r1[1], R.r1[3]}; \
      const float q1[4] = {lo16(R.a0.x), hi16(R.a0.x), lo16(R.a0.y), hi16(R.a0.y)}, q2[4] = {lo16(R.a0.z), hi16(R.a0.z), lo16(R.a0.w), hi16(R.a0.w)}; \
      const float k1[4] = {lo16(R.a1.x), hi16(R.a1.x), lo16(R.a1.y), hi16(R.a1.y)}, k2[4] = {lo16(R.a1.z), hi16(R.a1.z), lo16(R.a1.w), hi16(R.a1.w)}; \
      _Pragma("unroll") for (int c = 0; c < 4; ++c) { q[c] = (q1[c] * cs[c] - q2[c] * sn[c]) * 0.125f; q[4 + c] = (q1[c] * sn[c] + q2[c] * cs[c]) * 0.125f; k[c] = k1[c] * cs[c] - k2[c] * sn[c]; k[4 + c] = k1[c] * sn[c] + k2[c] * cs[c]; } \
    } else { \
      const unsigned qw[8] = {R.a0.x, R.a0.y, R.a0.z, R.a0.w, R.a1.x, R.a1.y, R.a1.z, R.a1.w}, kw[8] = {R.b0.x, R.b0.y, R.b0.z, R.b0.w, R.b1.x, R.b1.y, R.b1.z, R.b1.w}; \
      _Pragma("unroll") for (int c = 0; c < 8; ++c) { q[2 * c] = lo16(qw[c]); q[2 * c + 1] = hi16(qw[c]); k[2 * c] = lo16(kw[c]); k[2 * c + 1] = hi16(kw[c]); } \
    } \
    if (MIXER == MIX_A || MIXER == MIX_B) { \
        \
      _Pragma("unroll") for (int c = 0; c < NC; ++c) g[c] += __builtin_bit_cast(float, __builtin_amdgcn_update_dpp(0, __builtin_bit_cast(int, g[c]), 0x111, 0xf, 0xf, false)); \
      _Pragma("unroll") for (int c = 0; c < NC; ++c) g[c] += __builtin_bit_cast(float, __builtin_amdgcn_update_dpp(0, __builtin_bit_cast(int, g[c]), 0x112, 0xf, 0xf, false)); \
      _Pragma("unroll") for (int c = 0; c < NC; ++c) g[c] += __builtin_bit_cast(float, __builtin_amdgcn_update_dpp(0, __builtin_bit_cast(int, g[c]), 0x114, 0xf, 0xf, false)); \
      _Pragma("unroll") for (int c = 0; c < NC; ++c) g[c] += __builtin_bit_cast(float, __builtin_amdgcn_update_dpp(0, __builtin_bit_cast(int, g[c]), 0x118, 0xf, 0xf, false)); \
      _Pragma("unroll") for (int c = 0; c < NC; ++c) g[c] += __builtin_bit_cast(float, __builtin_amdgcn_update_dpp(0, __builtin_bit_cast(int, g[c]), 0x142, 0xa, 0xf, false)); \
      _Pragma("unroll") for (int c = 0; c < NC; ++c) g[c] += __builtin_bit_cast(float, __builtin_amdgcn_update_dpp(0, __builtin_bit_cast(int, g[c]), 0x143, 0xc, 0xf, false)); \
      float ev[NC]; \
      _Pragma("unroll") for (int c = 0; c < NC; ++c) { \
          \
        const float e = __builtin_amdgcn_exp2f(g[c]), r = __builtin_amdgcn_rcpf(e); \
        const float e63 = rdlane(e, 63); \
        q[c] *= e; k[c] *= r; ktv[c] = k[c] * e63;     \
        ev[c] = e; } \
      if (lane == 63) { _Pragma("unroll") for (int c = 0; c < NC / 4; ++c) *(f32x4*)(DECb + c0 + 4 * c) = (f32x4){ev[4 * c], ev[4 * c + 1], ev[4 * c + 2], ev[4 * c + 3]}; } \
    } else if (MIXER == MIX_C) { \
        \
      const float gl = (float)(lane + 1) * lgam2; \
      const float e = __builtin_amdgcn_exp2f(gl), r = __builtin_amdgcn_rcpf(e); \
      const float e63 = rdlane(e, 63); const float f_kt = r * e63; \
      _Pragma("unroll") for (int c = 0; c < NC; ++c) { q[c] *= e; ktv[c] = k[c] * f_kt; k[c] *= r; } \
      if (lane < 4) { DECb[c0 + lane] = e63; DECb[32 + c0 + lane] = e63; } \
    } else { \
      const float li = R.s0, lf = R.s1;     \
      const float bc = incl_scan_add(lf); const float u = li - bc; const float pm = incl_scan_max(u); \
      const float cmax = rdlane(pm, 63), blast = rdlane(bc, 63); \
      const float a_i = bc + m_st, m_i = fmaxf(a_i, bc + pm); \
      const float d_alpha = __builtin_amdgcn_exp2f(bc - m_i + cmax), d_beta = __builtin_amdgcn_exp2f(u - cmax); \
      rr_next = __builtin_amdgcn_exp2f(m_st - cmax);     \
      const float m_new = fmaxf(blast + m_st, blast + cmax); \
      const float d_sold = __builtin_amdgcn_exp2f(blast + m_st - m_new), d_wks = __builtin_amdgcn_exp2f(blast + u - m_new); m_st = m_new; \
      _Pragma("unroll") for (int c = 0; c < NC; ++c) { ktv[c] = k[c] * d_wks; q[c] *= d_alpha; k[c] *= d_beta; if (lane == 63) DECb[c0 + c] = d_sold; } \
      if (wid == 0) EMb[lane] = __builtin_amdgcn_exp2f(-m_i); \
    } \
    _Pragma("unroll") for (int c = 0; c < NC / 2; ++c) { const unsigned w_ = pk_hw(ktv[2 * c], ktv[2 * c + 1]); \
      const int d0_ = (MIXER == MIX_C) ? (2 * c < 4 ? c0 + 2 * c : 32 + c0 + 2 * c - 4) : c0 + 2 * c; \
      *(bf16_t*)(KTb + d0_ * LD_T + lane * 2) = (bf16_t)(w_ & 0xffff); *(bf16_t*)(KTb + (d0_ + 1) * LD_T + lane * 2) = (bf16_t)(w_ >> 16); } \
    { unsigned pq[NC / 2], pks[NC / 2]; \
      _Pragma("unroll") for (int c = 0; c < NC / 2; ++c) { pq[c] = pk_hw(q[2 * c], q[2 * c + 1]); pks[c] = pk_hw(k[2 * c], k[2 * c + 1]); } \
      if (MIXER == MIX_C) { \
        *(u32x2*)(QIb + lane * LD_D + c0 * 2) = (u32x2){pq[0], pq[1]}; *(u32x2*)(QIb + lane * LD_D + (32 + c0) * 2) = (u32x2){pq[2], pq[3]}; \
        *(u32x2*)(KSb + lane * LD_D + c0 * 2) = (u32x2){pks[0], pks[1]}; *(u32x2*)(KSb + lane * LD_D + (32 + c0) * 2) = (u32x2){pks[2], pks[3]}; \
      } else { \
        _Pragma("unroll") for (int c = 0; c < NC / 8; ++c) { \
          *(u32x4*)(QIb + lane * LD_D + (c0 + 8 * c) * 2) = (u32x4){pq[4 * c], pq[4 * c + 1], pq[4 * c + 2], pq[4 * c + 3]}; \
          *(u32x4*)(KSb + lane * LD_D + (c0 + 8 * c) * 2) = (u32x4){pks[4 * c], pks[4 * c + 1], pks[4 * c + 2], pks[4 * c + 3]}; } } } \
    { unsigned char* VTb = lds + U_VT + (buf_) * 6912 + (wid * 4) * LD_T + lane * 2; \
      *(bf16_t*)(VTb + 0 * LD_T) = (bf16_t)(Rv.x & 0xffff); *(bf16_t*)(VTb + 1 * LD_T) = (bf16_t)(Rv.x >> 16); *(bf16_t*)(VTb + 2 * LD_T) = (bf16_t)(Rv.y & 0xffff); *(bf16_t*)(VTb + 3 * LD_T) = (bf16_t)(Rv.y >> 16); } \
  } while (0)
  f32x4 sacc[NST];
#pragma unroll
  for (int i = 0; i < NST; ++i) sacc[i] = (f32x4){0.f, 0.f, 0.f, 0.f};
  A_LOAD(R, Rv, 0);
  A_PREP(0, R, Rv);
  A_LOAD(R, Rv, 1);
  A_LOAD(Rn, Rvn, 2);
  rr_cur = rr_next;
  lds_barrier();
#define SCAN_ITER(n_, RX, RvX) do { const int n = (n_); \
    const int cb = n & 1, nb = (n + 1) & 1; \
    if (n + 1 < NCH) { A_PREP(nb, RX, RvX); if (n + 3 < NCH) A_LOAD(RX, RvX, n + 3); } \
    { { \
      const int lane = lane0; \
      const int fr = lane & 15, fq = lane >> 4; \
      const int it = wid & 3, vt = wid >> 2; \
      const unsigned char* STc = lds + U_ST + cb * 13056; unsigned char* STn = lds + U_ST + nb * 13056; \
      const unsigned char* KTc = lds + U_KT + cb * 18432; const unsigned char* VTc = lds + U_VT + cb * 6912; \
      const unsigned char* QI = lds + U_QI + cb * 17408; const unsigned char* KS = lds + U_KS + cb * 17408; \
      const float* DECc = (const float*)(lds + U_DEC + cb * 512); const float* EMc = (const float*)(lds + U_EM + cb * 256); \
      bf16x8 qf[NKD]; \
_Pragma("unroll") \
      for (int ks = 0; ks < NKD; ++ks) qf[ks] = ldfrag(QI, LD_D, it * 16 + fr, ks * 64 + fq * 16); \
_Pragma("unroll") \
      for (int jt = 0; jt < 4; ++jt) { \
        if (jt <= it) { \
          f32x4 acc = (f32x4){0.f, 0.f, 0.f, 0.f}; \
_Pragma("unroll") \
          for (int ks = 0; ks < NKD; ++ks) acc = __builtin_amdgcn_mfma_f32_16x16x32_bf16(ldfrag(KS, LD_D, jt * 16 + fr, ks * 64 + fq * 16), qf[ks], acc, 0, 0, 0); \
          const int i = it * 16 + fr, j0 = jt * 16 + fq * 4; \
          if (jt == it) { const float v0 = (j0 + 0 <= i) ? acc[0] : 0.f, v1 = (j0 + 1 <= i) ? acc[1] : 0.f, v2 = (j0 + 2 <= i) ? acc[2] : 0.f, v3 = (j0 + 3 <= i) ? acc[3] : 0.f; \
            *(u32x2*)(SC + i * LD_T + j0 * 2) = (u32x2){pk_hw(v0, v1), pk_hw(v2, v3)}; } \
          else *(u32x2*)(SC + i * LD_T + j0 * 2) = (u32x2){pk_hw(acc[0], acc[1]), pk_hw(acc[2], acc[3])}; \
        } \
      } \
      f32x4 oacc = (f32x4){0.f, 0.f, 0.f, 0.f}, dacc = (f32x4){0.f, 0.f, 0.f, 0.f}; \
_Pragma("unroll") \
      for (int ks = 0; ks < NKD; ++ks) oacc = __builtin_amdgcn_mfma_f32_16x16x32_bf16(ldfrag(STc, LD_D, vt * 16 + fr, ks * 64 + fq * 16), qf[ks], oacc, 0, 0, 0); \
      if (NVT == 3) { \
_Pragma("unroll") \
        for (int ks = 0; ks < NKD; ++ks) dacc = __builtin_amdgcn_mfma_f32_16x16x32_bf16(ldfrag(STc, LD_D, 32 + fr, ks * 64 + fq * 16), qf[ks], dacc, 0, 0, 0); \
      } \
      if (MIXER == MIX_D) { oacc *= rr_cur; dacc *= rr_cur; } \
      asm volatile("s_waitcnt lgkmcnt(0)" ::: "memory"); \
      oacc = __builtin_amdgcn_mfma_f32_16x16x32_bf16(ldfrag(VTc, LD_T, vt * 16 + fr, fq * 16), ldfrag(SC, LD_T, it * 16 + fr, fq * 16), oacc, 0, 0, 0); \
      if (it >= 2) oacc = __builtin_amdgcn_mfma_f32_16x16x32_bf16(ldfrag(VTc, LD_T, vt * 16 + fr, 64 + fq * 16), ldfrag(SC, LD_T, it * 16 + fr, 64 + fq * 16), oacc, 0, 0, 0); \
      float dn = 1.0f; \
      if (NVT == 3) { \
        dacc = __builtin_amdgcn_mfma_f32_16x16x32_bf16(ldfrag(VTc, LD_T, 32 + fr, fq * 16), ldfrag(SC, LD_T, it * 16 + fr, fq * 16), dacc, 0, 0, 0); \
        if (it >= 2) dacc = __builtin_amdgcn_mfma_f32_16x16x32_bf16(ldfrag(VTc, LD_T, 32 + fr, 64 + fq * 16), ldfrag(SC, LD_T, it * 16 + fr, 64 + fq * 16), dacc, 0, 0, 0); \
        const float den = __shfl(dacc[0], fr); \
        dn = 1.0f / fmaxf(fabsf(den), EMc[it * 16 + fr]); \
      } \
      { \
        const int i = it * 16 + fr; \
        const int ti = dir ? (SEQ - 1 - (n * 64 + i)) : (n * 64 + i); \
        const f32x4 o = oacc * dn; \
        *(u32x2*)(O + PIDX(tokbase + ti, ocol + vt * 16 + fq * 4)) = (u32x2){pk_hw(o[0], o[1]), pk_hw(o[2], o[3])}; \
      } \
      const int dts = (DK == 128) ? wid : (wid & 3); \
      const bf16x8 kf0 = ldfrag(KTc, LD_T, dts * 16 + fr, fq * 16), kf1 = ldfrag(KTc, LD_T, dts * 16 + fr, 64 + fq * 16); \
      const f32x4 dc = *(const f32x4*)(DECc + dts * 16 + fq * 4); \
_Pragma("unroll") \
      for (int s = 0; s < NST; ++s) { \
        const int dt = dts, vt2 = (DK == 128) ? s : (wid >> 2); \
        f32x4 acc = sacc[s] * dc; \
        acc = __builtin_amdgcn_mfma_f32_16x16x32_bf16(kf0, ldfrag(VTc, LD_T, vt2 * 16 + fr, fq * 16), acc, 0, 0, 0); \
        acc = __builtin_amdgcn_mfma_f32_16x16x32_bf16(kf1, ldfrag(VTc, LD_T, vt2 * 16 + fr, 64 + fq * 16), acc, 0, 0, 0); \
        sacc[s] = acc; \
        *(u32x2*)(STn + (vt2 * 16 + fr) * LD_D + (dt * 16 + fq * 4) * 2) = (u32x2){pk_hw(acc[0], acc[1]), pk_hw(acc[2], acc[3])}; \
      } \
    } \
    } \
    rr_cur = rr_next; \
    lds_barrier(); \
  } while (0)
  static_assert(NCH % 2 == 0, "chunk count must be even");
#pragma unroll 1
  for (int n2 = 0; n2 < NCH; n2 += 2) { SCAN_ITER(n2, R, Rv); SCAN_ITER(n2 + 1, Rn, Rvn); }
#undef SCAN_ITER
#undef A_LOAD
#undef A_PREP
}

template <int MIXER>
__device__ __forceinline__ void scan_dispatch2(unsigned char* lds, int wv, const Params& p, int id) {
  const int vs = id & 3, dir = (id >> 2) & 1, h = (id >> 3) & 3, b = id >> 5;
  scan_item2<MIXER>(lds, wv, p, b, h, dir, vs);
}
}

__device__ __forceinline__ void scan_phase2(unsigned char* lds, int wv, const Params& p, int layer) {
  for (int it0 = blockIdx.x; it0 < 256; it0 += gridDim.x) {
    const int xq = it0 & 7, yq = it0 >> 3, stream = (yq >> 2) * 8 + xq;
    const int item = (stream >> 5) * 128 + (stream & 31) * 4 + (yq & 3);
    if (layer == 0) { if (item < 128) scan2::scan_dispatch2<scan::MIX_A>(lds, wv, p, item); else scan2::scan_dispatch2<scan::MIX_B>(lds, wv, p, item - 128); }
    else { if (item < 128) scan2::scan_dispatch2<scan::MIX_D>(lds, wv, p, item); else scan2::scan_dispatch2<scan::MIX_C>(lds, wv, p, item - 128); }
    __syncthreads();
  }
}
#endif
#ifndef CPU_EMU
#define XB_BASE     2048
#define XB_TMO      (XB_BASE + 128)
#define XB_XCNT(j)  (XB_BASE + 256  + 64 * (j))
#define XB_XSUB(j)  (XB_BASE + 1280 + 64 * (j))
#define XB_XGEN(j)  (XB_BASE + 2304 + 64 * (j))
#define XB_TOP      (XB_BASE + 3328)
#define XB_TOPGEN   (XB_BASE + 3392)
#define XB_WORDS    3456
#define XB_SPIN_CAP (1u << 22)
#define XB_LDS_OFF  (LDS_BYTES - 16)
__device__ __forceinline__ unsigned xb_ld(unsigned* p)              { return __hip_atomic_load(p, __ATOMIC_RELAXED, __HIP_MEMORY_SCOPE_AGENT); }
__device__ __forceinline__ unsigned xb_add(unsigned* p, unsigned v) { return __hip_atomic_fetch_add(p, v, __ATOMIC_RELAXED, __HIP_MEMORY_SCOPE_AGENT); }
__device__ __forceinline__ unsigned xb_xcc_id() { return (unsigned)__builtin_amdgcn_s_getreg((3 << 11) | 20) & 0xFu; }
#define XB_SPIN(cond, bar) do { unsigned _sp = 0; while (cond) { __builtin_amdgcn_s_sleep(1); \
    if ((++_sp & 255u) == 0u) { if (xb_ld(&(bar)[XB_TMO])) break; if (_sp > XB_SPIN_CAP) { atomicAdd(&(bar)[XB_TMO], 1u); break; } } } } while (0)
__device__ __forceinline__ void grid_bar(unsigned* bar, unsigned char* lds_raw, int wv) {
  asm volatile("s_waitcnt vmcnt(0)" ::: "memory");
  __syncthreads();
  if (wv == 0 && lane_id() == 0) {
    volatile unsigned* st = (volatile unsigned*)(lds_raw + XB_LDS_OFF);
    __builtin_amdgcn_s_waitcnt(0);
    const unsigned x = xb_xcc_id();
    unsigned nloc = st[0], nx = st[1];
    if (nloc == 0u) {
      const unsigned G = gridDim.x; unsigned sum, cnt, mine, sp = 0u;
      for (;;) { sum = 0u; cnt = 0u; mine = 0u;
#pragma unroll
        for (unsigned j = 0; j < 16; ++j) { const unsigned c = xb_ld(&bar[XB_XCNT(j)]); sum += c; cnt += (c > 0u) ? 1u : 0u; mine = (j == x) ? c : mine; }
        if (sum == G) break;
        __builtin_amdgcn_s_sleep(1);
        if ((++sp & 255u) == 0u) { if (xb_ld(&bar[XB_TMO])) break; if (sp > XB_SPIN_CAP) { atomicAdd(&bar[XB_TMO], 1u); break; } } }
      nloc = mine > 0u ? mine : 1u; nx = cnt > 0u ? cnt : 1u; st[0] = nloc; st[1] = nx;
    }
    const unsigned old = xb_add(&bar[XB_XSUB(x)], 1u);
    const unsigned gen = old / nloc;
    if (old + 1u == (gen + 1u) * nloc) {
      __builtin_amdgcn_fence(__ATOMIC_RELEASE, "agent");
      asm volatile("s_waitcnt vmcnt(0)" ::: "memory");
      const unsigned og = xb_add(&bar[XB_TOP], 1u);
      const unsigned tg = og / nx;
      if (og + 1u == (tg + 1u) * nx) xb_add(&bar[XB_TOPGEN], 1u);
      else XB_SPIN(xb_ld(&bar[XB_TOPGEN]) == tg, bar);
      __builtin_amdgcn_fence(__ATOMIC_ACQUIRE, "agent");
      xb_add(&bar[XB_XGEN(x)], 1u);
      asm volatile("s_waitcnt vmcnt(0)" ::: "memory");
    } else {
      XB_SPIN(xb_ld(&bar[XB_XGEN(x)]) == gen, bar);
      __builtin_amdgcn_fence(__ATOMIC_ACQUIRE, "agent");
      asm volatile("s_waitcnt vmcnt(0)" ::: "memory");
    }
  }
  __syncthreads();
}
#if (PROBE_DUP & 16)
#define grid_bar(a, b, c) do { grid_bar(a, b, c); grid_bar(a, b, c); } while (0)
#endif

__global__ void __launch_bounds__(NTHREADS) mk_fwd(Params p) {
  extern __shared__ __attribute__((aligned(16))) unsigned char lds_raw[];
  cg::grid_group grid = cg::this_grid();
  const int G = gridDim.x, bid = blockIdx.x;
  const int wv = __builtin_amdgcn_readfirstlane(threadIdx.x >> 6);
  PG8_LAS unsigned char* lds = (PG8_LAS unsigned char*)lds_raw;
  unsigned char* ws = p.ws;

  if (threadIdx.x < 4) ((unsigned*)(lds_raw + XB_LDS_OFF))[threadIdx.x] = 0u;
  p0_prologue(lds_raw, wv, p);
#if (PROBE_DUP & 128)
  p0_prologue(lds_raw, wv, p);
#endif
  grid.sync();
  unsigned* bar = (unsigned*)(ws + WS_CTL);
  if (wv == 0 && lane_id() == 0) (void)xb_add(&bar[XB_XCNT(xb_xcc_id())], 1u);
  for (int layer = 0; layer < 2; ++layer) {
    { ProbInProj pr; pr.so.init(NTOK, layer == 0 ? PM_AB : PM_CD, G, bid); pr.A = (const char*)(ws + WS_HB); pr.Bt = (const char*)(ws + (layer == 0 ? WS_WIN_AB : WS_WIN_CD));
      pr.P = (bf16_t*)(ws + WS_R1); pr.bias = p.in[layer == 0 ? I_AB_B_IN : I_CD_B_IN]; pr.lb = (const float*)(ws + WS_LB); pr.layer = layer;
      pg8::gemm_phase(lds, pr, wv);
#if (PROBE_DUP & (1 | 2048))
      pg8::gemm_phase(lds, pr, wv);
#endif
      if (layer == 0) side_phase<32>(lds_raw, wv, p, 0); else side_phase<16>(lds_raw, wv, p, 1);
#if (PROBE_DUP & 256)
      if (layer == 0) side_phase<32>(lds_raw, wv, p, 0); else side_phase<16>(lds_raw, wv, p, 1);
#endif
 }
    grid_bar(bar, lds_raw, wv);
    if (layer == 1) { convd_phase(lds_raw, wv, p); grid_bar(bar, lds_raw, wv); }
    scan_phase2(lds_raw, wv, p, layer);
#if (PROBE_DUP & 2)
    scan_phase2(lds_raw, wv, p, layer);
#endif
#if (PROBE_DUP & 512)
    if (layer == 0) scan_phase2(lds_raw, wv, p, layer);
#endif
#if (PROBE_DUP & 1024)
    if (layer == 1) scan_phase2(lds_raw, wv, p, layer);
#endif
    grid_bar(bar, lds_raw, wv);
    headnorm_phase(lds_raw, wv, p, layer);
#if (PROBE_DUP & 8)
    headnorm_phase(lds_raw, wv, p, layer);
#endif
    grid_bar(bar, lds_raw, wv);
    { ProbOutProj pr; pr.so.init(NTOK, 1024, G, bid); pr.A = (const char*)(ws + WS_HB); pr.Bt = (const char*)(ws + (layer == 0 ? WS_WOUT_AB : WS_WOUT_CD)); pr.Y = (float*)(ws + WS_R2); pr.Hres = layer == 0 ? p.in[I_X] : p.out;
      pg8::gemm_phase(lds, pr, wv);
#if (PROBE_DUP & (1 | 16384))
      pg8::gemm_phase(lds, pr, wv);
#endif
      moe_weight_convert(lds_raw, wv, p, layer);
#if (PROBE_DUP & 4)
      moe_weight_convert(lds_raw, wv, p, layer);
#endif
 }
    grid_bar(bar, lds_raw, wv);
#if (PROBE_DUP & 32)
    ln_phase(lds_raw, wv, p, layer, 0, 1);
#endif
    ln_phase(lds_raw, wv, p, layer, 0);
    grid_bar(bar, lds_raw, wv);
    { ProbMoe1 pr; pr.mo.init((const int*)((const unsigned*)(ws + WS_CTL) + CW_CNT(layer)), 8, G, bid, lds_raw, wv);
      pr.A = (const char*)(ws + WS_HB); pr.W13 = (const char*)(ws + WS_WMOE); pr.list = (const int*)(ws + WS_LIST) + (size_t)layer * NEXP * NTOK; pr.H = (bf16_t*)(ws + WS_H);
      pg8::gemm_phase(lds, pr, wv);
#if (PROBE_DUP & (1 | 4096))
      pg8::gemm_phase(lds, pr, wv);
#endif
 }
    grid_bar(bar, lds_raw, wv);
    { ProbMoe2 pr; pr.mo.init((const int*)((const unsigned*)(ws + WS_CTL) + CW_CNT(layer)), 4, G, bid, lds_raw, wv);
      pr.A = (const char*)(ws + WS_H); pr.W2 = (const char*)(ws + WS_WMOE) + (size_t)NEXP * 2048 * 1024 * 2; pr.Y = (bf16_t*)(ws + WS_R2);
      pg8::gemm_phase(lds, pr, wv);
#if (PROBE_DUP & (1 | 8192))
      pg8::gemm_phase(lds, pr, wv);
#endif
 }
    grid_bar(bar, lds_raw, wv);
#if (PROBE_DUP & 64)
    ln_phase(lds_raw, wv, p, layer, 1, 1);
#endif
    ln_phase(lds_raw, wv, p, layer, 1);
    if (layer == 0) grid_bar(bar, lds_raw, wv);
  }
}

extern "C" void kernel_launch(void* const* d_in, const int* in_sizes, int n_in, void* d_out, int out_size, void* d_ws, size_t ws_size, hipStream_t stream) {
  static int grid_blocks = 0;
  if (grid_blocks == 0) {
    if (n_in != N_IN || ws_size < WS_END || out_size != NTOK * 1024) { fprintf(stderr, "kernel_launch: bad shapes: n_in %d ws %zu (need %zu) out %d\n", n_in, ws_size, (size_t)WS_END, out_size); grid_blocks = -1; return; }
    int dev = 0, cus = 0, per_cu = 0;
    hipGetDevice(&dev); hipDeviceGetAttribute(&cus, hipDeviceAttributeMultiprocessorCount, dev);
    if (hipFuncSetAttribute((const void*)mk_fwd, hipFuncAttributeMaxDynamicSharedMemorySize, LDS_BYTES) != hipSuccess) { fprintf(stderr, "kernel_launch: hipFuncSetAttribute failed\n"); grid_blocks = -1; return; }
    if (hipOccupancyMaxActiveBlocksPerMultiprocessor(&per_cu, (const void*)mk_fwd, NTHREADS, LDS_BYTES) != hipSuccess || per_cu < 1) { fprintf(stderr, "kernel_launch: occupancy query failed (%d)\n", per_cu); grid_blocks = -1; return; }
    grid_blocks = cus;
    (void)in_sizes;
  }
  if (grid_blocks < 0) return;
  Params p{};
  for (int i = 0; i < N_IN; ++i) p.in[i] = (const float*)d_in[i];
  p.out = (float*)d_out; p.ws = (unsigned char*)d_ws;
  void* args[] = {&p};
  hipError_t e = hipLaunchCooperativeKernel((const void*)mk_fwd, dim3(grid_blocks), dim3(NTHREADS), args, LDS_BYTES, stream);
  if (e != hipSuccess) fprintf(stderr, "cooperative launch failed: %s (grid %d)\n", hipGetErrorString(e), grid_blocks);
}
#endif
#ifdef CPU_EMU
#include <vector>
void dbg_cmp(const char* name, const float* p, long n);
template <class F> static void run_functor(const F& f, long n) {
#pragma omp parallel for schedule(dynamic, 16)
  for (long g = 0; g < n; ++g) f(g);
}
static void cpu_round_w(const float* src, size_t n, std::vector<float>& dst) { dst.resize(n); for (size_t i = 0; i < n; ++i) dst[i] = bf2f(f2bf(src[i])); }

extern "C" void kernel_launch(void* const* d_in, const int* in_sizes, int n_in, void* d_out, int out_size, void* d_ws, size_t ws_size, hipStream_t) {
  (void)in_sizes; (void)n_in; (void)out_size;
  if (ws_size < WS_END) { printf("ws too small %zu < %zu\n", ws_size, (size_t)WS_END); return; }
  Params p{}; for (int i = 0; i < N_IN; ++i) p.in[i] = (const float*)d_in[i];
  p.out = (float*)d_out; p.ws = (unsigned char*)d_ws;
  unsigned char* ws = p.ws;
  bf16_t* HB = (bf16_t*)(ws + WS_HB); bf16_t* P = (bf16_t*)(ws + WS_R1); bf16_t* LFB = (bf16_t*)(ws + WS_LFB);
  bf16_t* O = (bf16_t*)(ws + WS_R2); float* yf = (float*)(ws + WS_R2); bf16_t* Y = (bf16_t*)(ws + WS_R2); bf16_t* H = (bf16_t*)(ws + WS_H);
  float* side = (float*)(ws + WS_SIDE); float* oside = (float*)(ws + WS_OSIDE); float* rope = (float*)(ws + WS_ROPE); float* lb = (float*)(ws + WS_LB);
  int* assign = (int*)(ws + WS_ASSIGN); float* gate = (float*)(ws + WS_GATE);
  for (size_t i = 0; i < (size_t)NTOK * 1024; ++i) HB[i] = f2bf(p.in[I_X][i]);
  for (int i = 0; i < SEQ * 32; ++i) { int t = i >> 5, f = i & 31; float freq = powf(10000.0f, -(float)f / 32.0f); float ang = (float)t * freq; rope[i * 2] = cosf(ang); rope[i * 2 + 1] = sinf(ang); }
  for (int cc = 0; cc < 512; ++cc) { const float* hl = p.in[I_HGRN_LB]; float a0 = hl[cc], a1 = hl[512 + cc], a2 = hl[1024 + cc]; float mx = fmaxf(a0, fmaxf(a1, a2));
    float e0 = expf(a0 - mx), e1 = expf(a1 - mx), e2 = expf(a2 - mx); lb[cc] = e0 / (e0 + e1 + e2); }
  std::vector<float> wr;
  for (int layer = 0; layer < 2; ++layer) {
    const int PW = layer == 0 ? P_AB : P_CD, PM = layer == 0 ? PM_AB : PM_CD;
    const float* bias = p.in[layer == 0 ? I_AB_B_IN : I_CD_B_IN];
    cpu_round_w(p.in[layer == 0 ? I_AB_W_IN : I_CD_W_IN], (size_t)1024 * PW, wr);
#pragma omp parallel for
    for (long tok = 0; tok < NTOK; ++tok) {
      std::vector<float> acc(PW, 0.f);
      for (int k = 0; k < 1024; ++k) { float a = bf2f(HB[tok * 1024 + k]); const float* w = &wr[(size_t)k * PW]; for (int n = 0; n < PW; ++n) acc[n] += a * w[n]; }
      for (int n = 0; n < PM; ++n) { float v = acc[n] + bias[n]; if (layer == 0) v = epi_ab(n, v, lb); P[tok * PSTRIDE + n] = f2bf(v); }
      for (int n = PM; n < PW; ++n) side[tok * 32 + (n - PM)] = acc[n] + bias[n];
      if (layer == 0) for (int dir = 0; dir < 2; ++dir) for (int cc = 0; cc < 256; ++cc) {
        float z = p.in[I_GK_B][dir * 256 + cc];
        for (int r = 0; r < 16; ++r) z += side[tok * 32 + dir * 16 + r] * p.in[I_GK_UP][(dir * 16 + r) * 256 + cc];
        LFB[tok * 512 + dir * 256 + cc] = f2bf(logsigmoidf_(z) * 0.0625f); }
    }
    if (layer == 0) { ScanAB2 s{}; s.P = P; s.LFB = LFB; s.O = O; run_functor(s, (long)BATCH * 2048); }
    else { PrepCD2 pc{}; pc.P = P; pc.QD = LFB; pc.rope = rope; pc.conv_w = p.in[I_CONV_W]; pc.conv_b = p.in[I_CONV_B]; run_functor(pc, (long)NTOK * 1280);
      ScanCD2 s{}; s.P = P; s.QD = LFB; s.side = side; s.fgate_b = p.in[I_FGATE_B]; s.O = O; s.oside = oside; run_functor(s, (long)BATCH * 2056); }
#pragma omp parallel for
    for (long tok = 0; tok < NTOK; ++tok) for (int h8 = 0; h8 < 8; ++h8) {
      float sf = 1.f, sb = 1.f;
      if (layer == 1 && h8 >= 4) { int h = h8 - 4; const float* s0 = oside + tok * 8 + h * 2; const float* s1 = oside + (size_t)(NTOK + tok) * 8 + h * 2;
        sf = 1.0f / fmaxf(fabsf(s0[0]), expf(-s0[1])); sb = 1.0f / fmaxf(fabsf(s1[0]), expf(-s1[1])); }
      float o[128]; float ss = 0.f;
      for (int j = 0; j < 128; ++j) { int c = h8 * 128 + j; o[j] = bf2f(O[tok * 1024 + c]) * sf + bf2f(O[(size_t)(NTOK + tok) * 1024 + c]) * sb; ss += o[j] * o[j]; }
      float r = 1.0f / sqrtf(ss * (1.0f / 128.0f) + NORM_EPS_F);
      for (int j = 0; j < 128; ++j) { int c = h8 * 128 + j; float gn, gt;
        if (layer == 0) { gn = h8 < 4 ? p.in[I_HGRN_NORM][c] : p.in[I_GLA_NORM][c - 512]; gt = siluf_(bf2f(P[tok * PSTRIDE + (h8 < 4 ? 2048 + c : 3584 + c - 512)])); }
        else { gn = h8 < 4 ? p.in[I_RET_NORM][c] : p.in[I_MLSTM_NORM][c - 512]; float gr = bf2f(P[tok * PSTRIDE + (h8 < 4 ? 1024 + c : 3072 + c - 512)]); gt = h8 < 4 ? siluf_(gr) : sigmoidf_(gr); }
        HB[tok * 1024 + c] = f2bf(o[j] * r * gn * gt); }
    }
    cpu_round_w(p.in[layer == 0 ? I_AB_W_OUT : I_CD_W_OUT], (size_t)1024 * 1024, wr);
#pragma omp parallel for
    for (long tok = 0; tok < NTOK; ++tok) { std::vector<float> acc(1024, 0.f);
      for (int k = 0; k < 1024; ++k) { float a = bf2f(HB[tok * 1024 + k]); const float* w = &wr[(size_t)k * 1024]; for (int n = 0; n < 1024; ++n) acc[n] += a * w[n]; }
      for (int n = 0; n < 1024; ++n) yf[tok * 1024 + n] = acc[n]; }
    dbg_cmp(layer == 0 ? "y_mix0" : "y_mix1", yf, (long)NTOK * 1024);
    int cnt[NEXP] = {0}; std::vector<int> list((size_t)NEXP * NTOK);
    const float* hin = layer == 0 ? p.in[I_X] : p.out;
    for (long tok = 0; tok < NTOK; ++tok) {
      float v[1024]; double s = 0; for (int c = 0; c < 1024; ++c) { v[c] = ALPHA_F * hin[tok * 1024 + c] + yf[tok * 1024 + c]; s += v[c]; }
      float mean = (float)(s / 1024); double q = 0; for (int c = 0; c < 1024; ++c) { v[c] -= mean; q += (double)v[c] * v[c]; }
      float r = 1.0f / sqrtf((float)(q / 1024) + LN_EPS_F);
      float lg[16] = {0};
      for (int c = 0; c < 1024; ++c) { v[c] = v[c] * r * p.in[I_LN_MIX_G][layer * 1024 + c] + p.in[I_LN_MIX_B][layer * 1024 + c]; p.out[tok * 1024 + c] = v[c]; HB[tok * 1024 + c] = f2bf(v[c]);
        for (int e = 0; e < 16; ++e) lg[e] += v[c] * p.in[I_ROUTER_W][c * 16 + e]; }
      int eo[2]; float go[2]; route_from_logits(lg, p.in[I_ROUTER_B], eo, go);
      int r1 = cnt[eo[0]]++, r2 = cnt[eo[1]]++;
      list[(size_t)eo[0] * NTOK + r1] = (int)tok; list[(size_t)eo[1] * NTOK + r2] = (int)tok;
      assign[tok * 4] = eo[0]; assign[tok * 4 + 1] = r1; assign[tok * 4 + 2] = eo[1]; assign[tok * 4 + 3] = r2; gate[tok * 2] = go[0]; gate[tok * 2 + 1] = go[1];
    }
    dbg_cmp(layer == 0 ? "h_mix0" : "h_mix1", p.out, (long)NTOK * 1024);
    int pad[NEXP]; { int a = 0; for (int e = 0; e < NEXP; ++e) { pad[e] = a; a += ((cnt[e] + 255) >> 8) << 8; } }
    const size_t lo = (size_t)layer * NEXP * 1024 * 1024;
    for (int e = 0; e < NEXP; ++e) {
      std::vector<float> w1, w3, w2; cpu_round_w(p.in[I_MOE_W1] + lo + (size_t)e * 1048576, 1048576, w1); cpu_round_w(p.in[I_MOE_W3] + lo + (size_t)e * 1048576, 1048576, w3); cpu_round_w(p.in[I_MOE_W2] + lo + (size_t)e * 1048576, 1048576, w2);
#pragma omp parallel for
      for (int rr = 0; rr < cnt[e]; ++rr) { int tok = list[(size_t)e * NTOK + rr]; size_t pos = pad[e] + rr;
        std::vector<float> a1(1024, 0.f), a3(1024, 0.f), a2(1024, 0.f);
        for (int k = 0; k < 1024; ++k) { float a = bf2f(HB[(size_t)tok * 1024 + k]); const float* p1 = &w1[(size_t)k * 1024]; const float* p3 = &w3[(size_t)k * 1024]; for (int n = 0; n < 1024; ++n) { a1[n] += a * p1[n]; a3[n] += a * p3[n]; } }
        for (int n = 0; n < 1024; ++n) H[pos * 1024 + n] = f2bf(siluf_(a1[n]) * a3[n]);
        for (int k = 0; k < 1024; ++k) { float a = bf2f(H[pos * 1024 + k]); const float* p2 = &w2[(size_t)k * 1024]; for (int n = 0; n < 1024; ++n) a2[n] += a * p2[n]; }
        for (int n = 0; n < 1024; ++n) Y[pos * 1024 + n] = f2bf(a2[n]); }
    }
    for (long tok = 0; tok < NTOK; ++tok) {
      size_t p0 = pad[assign[tok * 4]] + assign[tok * 4 + 1], p1 = pad[assign[tok * 4 + 2]] + assign[tok * 4 + 3];
      float v[1024]; double s = 0; for (int c = 0; c < 1024; ++c) { v[c] = ALPHA_F * p.out[tok * 1024 + c] + gate[tok * 2] * bf2f(Y[p0 * 1024 + c]) + gate[tok * 2 + 1] * bf2f(Y[p1 * 1024 + c]); s += v[c]; }
      float mean = (float)(s / 1024); double q = 0; for (int c = 0; c < 1024; ++c) { v[c] -= mean; q += (double)v[c] * v[c]; }
      float r = 1.0f / sqrtf((float)(q / 1024) + LN_EPS_F);
      for (int c = 0; c < 1024; ++c) { v[c] = v[c] * r * p.in[I_LN_FFN_G][layer * 1024 + c] + p.in[I_LN_FFN_B][layer * 1024 + c]; p.out[tok * 1024 + c] = v[c]; HB[tok * 1024 + c] = f2bf(v[c]); }
    }
    dbg_cmp(layer == 0 ? "h_ffn0" : "h_ffn1", p.out, (long)NTOK * 1024);
  }
}
#endif
```

```cpp
#ifdef CPU_EMU
#include <cmath>
#include <cstdio>
#include <cstring>
#include <cstdlib>
#include <cstddef>
#define DEV
#define DEV_INLINE static inline
typedef void* hipStream_t;
#else
#include <hip/hip_runtime.h>
#include <hip/hip_bf16.h>
#include <cstdio>
#define DEV __device__ __forceinline__
#define DEV_INLINE __device__ __forceinline__
#endif
#ifndef PROBE_DUP
#define PROBE_DUP 0
#endif
#ifndef BATCH
#define BATCH 4
#endif
#ifndef SEQ
#define SEQ 8192
#endif
#define DM 1024
#define NTOK (BATCH * SEQ)
#define P_AB 4128
#define P_CD 3600
#define PM_AB 4096
#define PM_CD 3584
#define NEXP 16
#define ALPHA_F 1.4142135623730951f
#define LN_EPS_F 1e-5f
#define NORM_EPS_F 1e-6f
#define HROWS (2 * NTOK + NEXP * 256)

typedef unsigned short bf16_t;

DEV_INLINE float bf2f(bf16_t b) { unsigned u = ((unsigned)b) << 16; float f; memcpy(&f, &u, 4); return f; }
DEV_INLINE bf16_t f2bf(float f) { unsigned u; memcpy(&u, &f, 4); u += 0x7FFFu + ((u >> 16) & 1u); return (bf16_t)(u >> 16); }
DEV_INLINE float sigmoidf_(float x) { return 1.0f / (1.0f + expf(-x)); }
DEV_INLINE float siluf_(float x) { return x / (1.0f + expf(-x)); }
DEV_INLINE float logsigmoidf_(float x) { return fminf(x, 0.0f) - log1pf(expf(-fabsf(x))); }

#define AL256(x) (((size_t)(x) + 255) & ~(size_t)255)
#define WS_CTL    ((size_t)0)
#define WS_HB     ((size_t)65536)
#define WS_R1     (WS_HB + (size_t)NTOK * 1024 * 2)
#define R1_P_BYTES ((size_t)NTOK * 4096 * 2)
#define R1_MIN    (AL256((size_t)HROWS * 1024 * 2) + (size_t)NEXP * 3072 * 1024 * 2)
#define R1_PL     (R1_P_BYTES + (size_t)NTOK * 512 * 2)
#define R1_BYTES  (R1_PL > R1_MIN ? R1_PL : R1_MIN)
#define WS_LFB    (WS_R1 + R1_P_BYTES)
#define WS_H      (WS_R1)
#define WS_WMOE   (WS_R1 + AL256((size_t)HROWS * 1024 * 2))
#define WMOE_BYTES ((size_t)NEXP * 3072 * 1024 * 2)
#define WS_R2     (WS_R1 + R1_BYTES)
#define R2_BYTES  ((size_t)HROWS * 1024 * 2 > (size_t)NTOK * 1024 * 4 ? (size_t)HROWS * 1024 * 2 : (size_t)NTOK * 1024 * 4)
#define WS_SIDE   (WS_R2 + AL256(R2_BYTES))
#define WS_OSIDE  (WS_SIDE + (size_t)NTOK * 32 * 4)
#define WS_WIN_AB (WS_OSIDE + (size_t)2 * NTOK * 8 * 4)
#define WS_WIN_CD (WS_WIN_AB + (size_t)4128 * 1024 * 2)
#define WS_WOUT_AB (WS_WIN_CD + (size_t)3600 * 1024 * 2)
#define WS_WOUT_CD (WS_WOUT_AB + (size_t)1024 * 1024 * 2)
#define WS_ROPE   (WS_WOUT_CD + (size_t)1024 * 1024 * 2)
#define WS_LB     (WS_ROPE + (size_t)SEQ * 64 * 4)
#define WS_LIST   (WS_LB + 4096)
#define WS_ASSIGN (WS_LIST + (size_t)2 * NEXP * NTOK * 4)
#define WS_GATE   (WS_ASSIGN + (size_t)NTOK * 16)
#define WS_END    (WS_GATE + (size_t)NTOK * 8)
#define CW_CNT(layer) (64 + 256 * (layer))

#define PSTRIDE 4096
#define PIDX(tok, col) ((((size_t)((col) >> 7)) * NTOK + (size_t)(tok)) * 128 + (size_t)((col) & 127))

enum { I_X, I_AB_W_IN, I_AB_B_IN, I_HGRN_LB, I_GK_UP, I_GK_B, I_HGRN_NORM, I_GLA_NORM, I_AB_W_OUT,
       I_CD_W_IN, I_CD_B_IN, I_CONV_W, I_CONV_B, I_FGATE_B, I_RET_NORM, I_MLSTM_NORM, I_CD_W_OUT,
       I_LN_MIX_G, I_LN_MIX_B, I_LN_FFN_G, I_LN_FFN_B, I_ROUTER_W, I_ROUTER_B, I_MOE_W1, I_MOE_W3, I_MOE_W2, N_IN };

struct Params {
  const float* in[N_IN];
  float* out;
  unsigned char* ws;
};

DEV_INLINE float epi_ab(int col, float v, const float* lb) {
  if (col < 512) return siluf_(v);
  if (col < 1536) { float l = lb[(col - 512) & 511]; return logf(l + (1.0f - l) * sigmoidf_(v)); }
  if (col >= 2560 && col < 2816) return v * 0.125f;
  return v;
}

DEV_INLINE void route_from_logits(const float* lg, const float* rb, int* e_out, float* g_out) {
  float mx = lg[0];
#pragma unroll
  for (int e = 1; e < 16; ++e) mx = fmaxf(mx, lg[e]);
  float sc[16]; float sum = 0.f;
#pragma unroll
  for (int e = 0; e < 16; ++e) { sc[e] = expf(lg[e] - mx); sum += sc[e]; }
  float inv = 1.0f / sum;
  float best_gs = -1e30f; int be1 = 0, be2 = 1; float bs1 = 0.f, bs2 = 0.f;
#pragma unroll
  for (int gq = 0; gq < 4; ++gq) {
    float m1 = -1e30f, m2 = -1e30f, s1 = 0.f, s2 = 0.f; int i1 = 0, i2 = 0;
#pragma unroll
    for (int i = 0; i < 4; ++i) {
      float s = sc[gq * 4 + i] * inv; float v = s + rb[gq * 4 + i];
      if (v > m1) { m2 = m1; i2 = i1; s2 = s1; m1 = v; i1 = gq * 4 + i; s1 = s; }
      else if (v > m2) { m2 = v; i2 = gq * 4 + i; s2 = s; }
    }
    float gs = m1 + m2;
    if (gs > best_gs) { best_gs = gs; be1 = i1; be2 = i2; bs1 = s1; bs2 = s2; }
  }
  e_out[0] = be1; e_out[1] = be2; g_out[0] = bs1 / (bs1 + bs2); g_out[1] = bs2 / (bs1 + bs2);
}
#ifndef CPU_EMU
namespace pg8 {
#define PG8_LAS __attribute__((address_space(3)))
typedef short bf16x8 __attribute__((ext_vector_type(8)));
typedef float f32x4 __attribute__((ext_vector_type(4)));
typedef unsigned u32x4 __attribute__((ext_vector_type(4)));
typedef unsigned u32x2 __attribute__((ext_vector_type(2)));
constexpr int BM = 256, BK = 64, HALF = 128, HTB = HALF * BK * 2, STAGE_BYTES = 8 * HTB, NXCD = 8, WGM = 8, GK = 1024;

__device__ __forceinline__ int lds_byte(int r, int c) { const int st = (r >> 4) * 2 + (c >> 5), rr = r & 15, cc = c & 31, ob = rr * 64 + cc * 2; return st * 1024 + (ob ^ (((ob >> 9) & 1) << 5)); }
__device__ __forceinline__ void stage_rc(int b, int& R, int& C) { const int st = b / 1024, sb = b % 1024, swz = sb ^ (((sb >> 9) & 1) << 5); R = (st >> 1) * 16 + swz / 64; C = (st & 1) * 32 + (swz % 64) / 2; }
__device__ __forceinline__ int perm32(int rho) { const int n = rho >> 4, i = rho & 15; return 8 * (i >> 2) + 4 * n + (i & 3); }
__device__ __forceinline__ unsigned cvt_pk_bf16(float lo, float hi) { unsigned r; asm volatile("v_cvt_pk_bf16_f32 %0, %1, %2" : "=v"(r) : "v"(lo), "v"(hi)); return r; }

struct Unit { int pm, pn, e, row0, ne, ui; };

struct StaticOrder {
  int nM, nN, nwg, G, c;
  __device__ void init(int M, int N, int G_, int c_) { nM = M / BM; nN = N / BM; nwg = nM * nN; G = G_; c = c_; }
  __device__ bool next(int i, Unit& u) const {
    const long L = (long)i * G + c; if (L >= nwg) return false;
    int wgid = (int)L; { const int q = nwg / NXCD, r = nwg % NXCD, xcd = wgid % NXCD, off = wgid / NXCD; wgid = (xcd < r ? xcd * (q + 1) : r * (q + 1) + (xcd - r) * q) + off; }
    const int nig = WGM * nN, gid = wgid / nig, fm = gid * WGM, gsz = (nM - fm) < WGM ? (nM - fm) : WGM;
    u.pm = fm + ((wgid % nig) % gsz); u.pn = (wgid % nig) / gsz; u.e = 0; u.row0 = u.pm * BM; u.ne = 0; u.ui = i; return true;
  }
};

template <class Prob>
__device__ __forceinline__ void gemm_phase(PG8_LAS unsigned char* lds, const Prob& S, int wv) {
  int wv_ = wv; asm volatile("" : "+s"(wv_));
  int l_; asm volatile("v_mbcnt_lo_u32_b32 %0, -1, 0\n\tv_mbcnt_hi_u32_b32 %0, -1, %0" : "=v"(l_));
  int tid_ = wv_ * 64 + l_;
  const int tid = tid_, wid = __builtin_amdgcn_readfirstlane(tid >> 6), lane = tid & 63, wr = wid >> 2, wc = wid & 3, fr = lane & 15, fq = lane >> 4;
  constexpr int K = GK, nt = K / BK;
  int sR[2], sC[2]; unsigned voffB[2];
#pragma unroll
  for (int i = 0; i < 2; ++i) { int R, C; stage_rc(tid * 16 + i * 8192, R, C); sR[i] = R; sC[i] = C; const int Rb = Prob::PERM ? ((R & ~31) + perm32(R & 31)) : R; voffB[i] = (unsigned)(Rb * K + C) * 2u; }
  const size_t kstep = (size_t)(BK * 2);
  const size_t hstep = (size_t)HALF * K * 2;
  const unsigned ldsw = (unsigned)wid * 1024u;
  const int aoff = lds_byte(wr * 64 + fr, fq * 8), boff = lds_byte(wc * 32 + fr, fq * 8);
#define PG8_SA(b, h) (((b) * 2 + (h)) * HTB)
#define PG8_SB(b, h) ((4 + (b) * 2 + (h)) * HTB)
#define PG8_STAGE(bufoff, gbase, voff) do { _Pragma("unroll") for (int _i = 0; _i < 2; ++_i) \
    __builtin_amdgcn_global_load_lds((const unsigned*)((const char*)(gbase) + (voff)[_i]), (PG8_LAS unsigned*)(lds + (bufoff) + ldsw + _i * 8192), 16, 0, 0); } while (0)
#define PG8_LDA(dst, b, h) do { _Pragma("unroll") for (int m = 0; m < 4; ++m) _Pragma("unroll") for (int k = 0; k < 2; ++k) dst[m][k] = *(const PG8_LAS bf16x8*)(lds + PG8_SA(b, h) + aoff + m * 2048 + k * 1024); } while (0)
#define PG8_LDB(dst, b, h) do { _Pragma("unroll") for (int n = 0; n < 2; ++n) _Pragma("unroll") for (int k = 0; k < 2; ++k) dst[n][k] = *(const PG8_LAS bf16x8*)(lds + PG8_SB(b, h) + boff + n * 2048 + k * 1024); } while (0)
#define PG8_MMA(ai, bj, At, Bt) do { __builtin_amdgcn_s_setprio(1); _Pragma("unroll") for (int m = 0; m < 4; ++m) _Pragma("unroll") for (int n = 0; n < 2; ++n) _Pragma("unroll") for (int k = 0; k < 2; ++k) \
    acc[ai][bj][m][n] = __builtin_amdgcn_mfma_f32_16x16x32_bf16(Bt[n][k], At[m][k], acc[ai][bj][m][n], 0, 0, 0); __builtin_amdgcn_s_setprio(0); } while (0)
#define PG8_WAIT_V(n) asm volatile("s_waitcnt vmcnt(" #n ")" ::: "memory")
#define PG8_WAIT_L(n) asm volatile("s_waitcnt lgkmcnt(" #n ")" ::: "memory")
#define PG8_BAR __builtin_amdgcn_s_barrier()
#define PG8_SCHED __builtin_amdgcn_sched_barrier(0)
  Unit cur, nxt; int ui = 0;
  if (!S.next(0, cur)) return;
  f32x4 acc[2][2][4][2];
#pragma unroll
  for (int a = 0; a < 2; ++a)
#pragma unroll
    for (int b = 0; b < 2; ++b)
#pragma unroll
      for (int m = 0; m < 4; ++m)
#pragma unroll
        for (int n = 0; n < 2; ++n) acc[a][b][m][n] = (f32x4){0.f, 0.f, 0.f, 0.f};
  bf16x8 At[4][2], B0[2][2], B1[2][2];
  unsigned oc0[2], oc1[2], on0[2], on1[2];
#pragma unroll
  for (int i = 0; i < 2; ++i) { oc0[i] = S.a_off(cur, sR[i]) + (unsigned)sC[i] * 2u; oc1[i] = S.a_off(cur, HALF + sR[i]) + (unsigned)sC[i] * 2u; }
  const char* const Ab = S.a_base();
  const char* cB = S.b_base(cur);
  PG8_STAGE(PG8_SB(0, 0), cB, voffB); PG8_STAGE(PG8_SB(0, 1), cB + hstep, voffB); PG8_STAGE(PG8_SA(0, 0), Ab, oc0); PG8_STAGE(PG8_SA(0, 1), Ab, oc1);
  if (wr == 1) PG8_BAR;
  PG8_WAIT_V(2); PG8_BAR;
  PG8_STAGE(PG8_SB(1, 0), cB + kstep, voffB); PG8_STAGE(PG8_SA(1, 0), Ab + kstep, oc0); PG8_STAGE(PG8_SB(1, 1), cB + hstep + kstep, voffB);
  PG8_WAIT_V(6); PG8_BAR;
  for (;;) {
    const bool has_next = S.next(ui + 1, nxt);
    const char* nB = cB;
    if (has_next) {
      nB = S.b_base(nxt);
      int l2_; asm volatile("v_mbcnt_lo_u32_b32 %0, -1, 0\n\tv_mbcnt_hi_u32_b32 %0, -1, %0" : "=v"(l2_));
      const int tid2 = wid * 64 + l2_;
#pragma unroll
      for (int i = 0; i < 2; ++i) { int R, C; stage_rc(tid2 * 16 + i * 8192, R, C); on0[i] = S.a_off(nxt, R) + (unsigned)C * 2u; on1[i] = S.a_off(nxt, HALF + R) + (unsigned)C * 2u; }
    } else {
#pragma unroll
      for (int i = 0; i < 2; ++i) { on0[i] = oc0[i]; on1[i] = oc1[i]; }
    }
    for (int t = 0; t < nt; t += 2) {
      const bool last = (t == nt - 2);
      const char* a1 = Ab + (size_t)(t + 1) * kstep;
      const char* a2 = last ? Ab : Ab + (size_t)(t + 2) * kstep; const char* b2 = last ? nB : cB + (size_t)(t + 2) * kstep;
      const char* a3 = a2 + kstep; const char* b3 = b2 + kstep;
      unsigned o20[2], o21[2];
#pragma unroll
      for (int i = 0; i < 2; ++i) { o20[i] = last ? on0[i] : oc0[i]; o21[i] = last ? on1[i] : oc1[i]; }
      PG8_LDB(B0, 0, 0); PG8_LDB(B1, 0, 1); PG8_SCHED; PG8_LDA(At, 0, 0); PG8_STAGE(PG8_SA(1, 1), a1, oc1);
      PG8_WAIT_V(8); PG8_WAIT_L(0); PG8_BAR; PG8_MMA(0, 0, At, B0); PG8_MMA(0, 1, At, B1); PG8_BAR; PG8_SCHED;
      PG8_LDA(At, 0, 1); PG8_STAGE(PG8_SB(0, 0), b2, voffB); PG8_STAGE(PG8_SB(0, 1), b2 + hstep, voffB); PG8_STAGE(PG8_SA(0, 0), a2, o20);
      PG8_WAIT_V(8); PG8_WAIT_L(0); PG8_BAR; PG8_MMA(1, 0, At, B0); PG8_MMA(1, 1, At, B1); PG8_BAR; PG8_SCHED;
      PG8_LDB(B0, 1, 0); PG8_LDB(B1, 1, 1); PG8_SCHED; PG8_LDA(At, 1, 0); PG8_STAGE(PG8_SA(0, 1), a2, o21);
      PG8_WAIT_V(8); PG8_WAIT_L(0); PG8_BAR; PG8_MMA(0, 0, At, B0); PG8_MMA(0, 1, At, B1); PG8_BAR; PG8_SCHED;
      PG8_LDA(At, 1, 1); PG8_STAGE(PG8_SB(1, 0), b3, voffB); PG8_STAGE(PG8_SB(1, 1), b3 + hstep, voffB); PG8_STAGE(PG8_SA(1, 0), a3, o20);
      PG8_WAIT_V(8); PG8_WAIT_L(0); PG8_BAR; PG8_MMA(1, 0, At, B0); PG8_MMA(1, 1, At, B1); PG8_BAR; PG8_SCHED;
    }
    if (wr == 0) PG8_BAR;
    { int l3_; asm volatile("v_mbcnt_lo_u32_b32 %0, -1, 0\n\tv_mbcnt_hi_u32_b32 %0, -1, %0" : "=v"(l3_));
      S.epi(acc, cur, wr, wc, l3_ & 15, l3_ >> 4); }
    if (!has_next) break;
#pragma unroll
    for (int a = 0; a < 2; ++a)
#pragma unroll
      for (int b = 0; b < 2; ++b)
#pragma unroll
        for (int m = 0; m < 4; ++m)
#pragma unroll
          for (int n = 0; n < 2; ++n) acc[a][b][m][n] = (f32x4){0.f, 0.f, 0.f, 0.f};
    cur = nxt; cB = nB; ++ui;
#pragma unroll
    for (int i = 0; i < 2; ++i) { oc0[i] = on0[i]; oc1[i] = on1[i]; }
    if (wr == 1) PG8_BAR;
  }
  PG8_WAIT_V(0);
  PG8_BAR;
#undef PG8_SA
#undef PG8_SB
#undef PG8_STAGE
#undef PG8_LDA
#undef PG8_LDB
#undef PG8_MMA
#undef PG8_WAIT_V
#undef PG8_WAIT_L
#undef PG8_BAR
#undef PG8_SCHED
}
}
#endif
#ifndef CPU_EMU
#include <hip/hip_cooperative_groups.h>
namespace cg = cooperative_groups;
#define LAS __attribute__((address_space(3)))
#define NTHREADS 512
#define LDS_BYTES (154 * 1024)
typedef float f32x4 __attribute__((ext_vector_type(4)));
typedef short bf16x8 __attribute__((ext_vector_type(8)));
typedef unsigned u32x4 __attribute__((ext_vector_type(4)));
typedef unsigned u32x2 __attribute__((ext_vector_type(2)));

struct Ctx { int tid, lane, wid, G, bid; unsigned char* lds; };
__device__ __forceinline__ int lane_id() { int l; asm volatile("v_mbcnt_lo_u32_b32 %0, -1, 0\n\tv_mbcnt_hi_u32_b32 %0, -1, %0" : "=v"(l)); return l; }
__device__ __forceinline__ int opaque_tid(int wv) { int w = wv; asm volatile("" : "+s"(w)); int t = w * 64 + lane_id(); asm volatile("" : "+v"(t)); return t; }
__device__ __forceinline__ Ctx make_ctx(unsigned char* lds, int wv) { Ctx c; c.tid = opaque_tid(wv); c.lane = c.tid & 63; c.wid = __builtin_amdgcn_readfirstlane(c.tid >> 6); c.G = gridDim.x; c.bid = blockIdx.x; c.lds = lds; return c; }

__device__ __forceinline__ float wave_sum(float x) {
  x += __builtin_bit_cast(float, __builtin_amdgcn_update_dpp(0, __builtin_bit_cast(int, x), 0x111, 0xf, 0xf, false));
  x += __builtin_bit_cast(float, __builtin_amdgcn_update_dpp(0, __builtin_bit_cast(int, x), 0x112, 0xf, 0xf, false));
  x += __builtin_bit_cast(float, __builtin_amdgcn_update_dpp(0, __builtin_bit_cast(int, x), 0x114, 0xf, 0xf, false));
  x += __builtin_bit_cast(float, __builtin_amdgcn_update_dpp(0, __builtin_bit_cast(int, x), 0x118, 0xf, 0xf, false));
  x += __builtin_bit_cast(float, __builtin_amdgcn_update_dpp(0, __builtin_bit_cast(int, x), 0x142, 0xa, 0xf, false));
  x += __builtin_bit_cast(float, __builtin_amdgcn_update_dpp(0, __builtin_bit_cast(int, x), 0x143, 0xc, 0xf, false));
  return __builtin_bit_cast(float, __builtin_amdgcn_readlane(__builtin_bit_cast(int, x), 63));
}
__device__ __forceinline__ float fsigmoid(float x) { return __builtin_amdgcn_rcpf(1.0f + __builtin_amdgcn_exp2f(-1.4426950408889634f * x)); }
__device__ __forceinline__ float fsilu(float x) { return x * fsigmoid(x); }
__device__ __forceinline__ float flog2sigmoid(float x) { const float y = x * 1.4426950408889634f; return fminf(y, 0.f) - __builtin_amdgcn_logf(1.0f + __builtin_amdgcn_exp2f(-fabsf(y))); }
typedef float f32x2_t __attribute__((ext_vector_type(2)));
typedef __bf16 bf16x2_t __attribute__((ext_vector_type(2)));
__device__ __forceinline__ unsigned pk_hw(float a, float b) { const f32x2_t v = {a, b}; return __builtin_bit_cast(unsigned, __builtin_convertvector(v, bf16x2_t)); }
__device__ __forceinline__ unsigned pk2(float a, float b) { return pk_hw(a, b); }
__device__ __forceinline__ void unpack8(u32x4 w, float* f) {
  f[0] = __uint_as_float(w.x << 16); f[1] = __uint_as_float(w.x & 0xffff0000u); f[2] = __uint_as_float(w.y << 16); f[3] = __uint_as_float(w.y & 0xffff0000u);
  f[4] = __uint_as_float(w.z << 16); f[5] = __uint_as_float(w.z & 0xffff0000u); f[6] = __uint_as_float(w.w << 16); f[7] = __uint_as_float(w.w & 0xffff0000u);
}

__device__ __forceinline__ void transpose_job(const Ctx& c, const float* src, int N, bf16_t* dst, int rs, int ro, int tile0, int tile_stride) {
  float* t = (float*)c.lds;
  const int ntn = (N + 63) / 64, ntiles = ntn * 16;
  for (int tl = tile0; tl < ntiles; tl += tile_stride) {
    const int kt = tl / ntn, nt_ = tl % ntn, k0 = kt * 64, n0 = nt_ * 64;
    __syncthreads();
#pragma unroll
    for (int i = 0; i < 8; ++i) { const int idx = c.tid + i * 512, kk = idx >> 6, nn = idx & 63; t[kk * 65 + nn] = (n0 + nn < N) ? src[(size_t)(k0 + kk) * N + n0 + nn] : 0.f; }
    __syncthreads();
#pragma unroll
    for (int i = 0; i < 4; ++i) { const int idx = c.tid + i * 512, nn = idx >> 5, kp = (idx & 31) * 2;
      if (n0 + nn < N) *(unsigned*)(dst + (size_t)((n0 + nn) * rs + ro) * 1024 + k0 + kp) = pk2(t[kp * 65 + nn], t[(kp + 1) * 65 + nn]); }
  }
  __syncthreads();
}
__device__ __forceinline__ void p0_prologue(unsigned char* lds_, int wv, const Params& p) {
  const Ctx c = make_ctx(lds_, wv);
  unsigned char* ws = p.ws;
  if (c.bid == 0) { ((unsigned*)(ws + WS_CTL))[64 + c.tid] = 0u; }
  if (c.bid == 0) { for (int i = c.tid; i < 3456; i += NTHREADS) ((unsigned*)(ws + WS_CTL))[2048 + i] = 0u; }
  { const float* x = p.in[I_X]; bf16_t* hb = (bf16_t*)(ws + WS_HB);
    for (size_t i = (size_t)c.bid * NTHREADS + c.tid; i < (size_t)NTOK * 1024 / 8; i += (size_t)c.G * NTHREADS) {
      const f32x4 a = __builtin_nontemporal_load((const f32x4*)(x + i * 8)), b = __builtin_nontemporal_load((const f32x4*)(x + i * 8 + 4));
      u32x4 w; w.x = pk2(a[0], a[1]); w.y = pk2(a[2], a[3]); w.z = pk2(b[0], b[1]); w.w = pk2(b[2], b[3]);
      *(u32x4*)(hb + i * 8) = w; } }
  transpose_job(c, p.in[I_AB_W_IN], P_AB, (bf16_t*)(ws + WS_WIN_AB), 1, 0, c.bid, c.G);
  transpose_job(c, p.in[I_CD_W_IN], P_CD, (bf16_t*)(ws + WS_WIN_CD), 1, 0, c.bid, c.G);
  transpose_job(c, p.in[I_AB_W_OUT], 1024, (bf16_t*)(ws + WS_WOUT_AB), 1, 0, c.bid, c.G);
  transpose_job(c, p.in[I_CD_W_OUT], 1024, (bf16_t*)(ws + WS_WOUT_CD), 1, 0, c.bid, c.G);
  { float* rope = (float*)(ws + WS_ROPE);
    for (int i = c.bid * NTHREADS + c.tid; i < SEQ * 32; i += c.G * NTHREADS) { const int t = i >> 5, f = i & 31;
      const float freq = powf(10000.0f, -(float)f / 32.0f); const float ang = (float)t * freq; rope[i * 2] = cosf(ang); rope[i * 2 + 1] = sinf(ang); }
    if (c.bid == 1) { const float* hl = p.in[I_HGRN_LB]; float* lb = (float*)(ws + WS_LB);
      const int cc = c.tid; const float a0 = hl[cc], a1 = hl[512 + cc], a2 = hl[1024 + cc]; const float mx = fmaxf(a0, fmaxf(a1, a2));
      const float e0 = expf(a0 - mx), e1 = expf(a1 - mx), e2 = expf(a2 - mx); lb[cc] = e0 / (e0 + e1 + e2); } }
}
__device__ __forceinline__ void moe_weight_convert(unsigned char* lds_, int wv, const Params& p, int layer) {
  const Ctx c = make_ctx(lds_, wv);
  bf16_t* w13 = (bf16_t*)(p.ws + WS_WMOE); bf16_t* w2 = w13 + (size_t)NEXP * 2048 * 1024;
  const size_t lo = (size_t)layer * NEXP * 1024 * 1024;
  const float* W1 = p.in[I_MOE_W1] + lo; const float* W3 = p.in[I_MOE_W3] + lo; const float* W2 = p.in[I_MOE_W2] + lo;
  float* t = (float*)c.lds;
  constexpr int NT = 48 * 128;
  const int lk = c.tid >> 5, ln4 = (c.tid & 31) * 4;
  const int sn = c.tid & 127, sk = (c.tid >> 7) * 8;
  f32x4 r[4];
#define MW_SRC(g_) ((((g_) >> 7) % 3 == 0 ? W1 : (((g_) >> 7) % 3 == 1 ? W3 : W2)) + (size_t)(((g_) >> 7) / 3) * 1048576 + (size_t)((((g_) & 127) >> 3) * 64) * 1024 + ((g_) & 7) * 128)
#define MW_LOAD(g_) do { const float* s_ = MW_SRC(g_); _Pragma("unroll") for (int i = 0; i < 4; ++i) r[i] = __builtin_nontemporal_load((const f32x4*)(s_ + (size_t)(lk + 16 * i) * 1024 + ln4)); } while (0)
  int g0 = c.bid;
  if (g0 < NT) MW_LOAD(g0);
  for (; g0 < NT; g0 += c.G) {
    __syncthreads();
#pragma unroll
    for (int i = 0; i < 4; ++i) { float* d = t + (lk + 16 * i) * 129 + ln4; d[0] = r[i][0]; d[1] = r[i][1]; d[2] = r[i][2]; d[3] = r[i][3]; }
    __syncthreads();
    const int gn = g0 + c.G;
    if (gn < NT) MW_LOAD(gn);
    const int m = g0 >> 7, e = m / 3, which = m % 3, k0 = ((g0 & 127) >> 3) * 64, n0 = (g0 & 7) * 128;
    bf16_t* drow = (which == 2) ? w2 + ((size_t)e * 1024 + n0 + sn) * 1024 : w13 + ((size_t)e * 2048 + 2 * (n0 + sn) + which) * 1024;
#pragma unroll
    for (int j = 0; j < 2; ++j) { const int kk = sk + 32 * j; const float* s = t + kk * 129 + sn;
      u32x4 w; w.x = pk2(s[0], s[129]); w.y = pk2(s[2 * 129], s[3 * 129]); w.z = pk2(s[4 * 129], s[5 * 129]); w.w = pk2(s[6 * 129], s[7 * 129]);
      *(u32x4*)(drow + k0 + kk) = w; }
  }
#undef MW_SRC
#undef MW_LOAD
  __syncthreads();
}

struct ProbInProj {
  static constexpr bool PERM = true;
  pg8::StaticOrder so; const char* A; const char* Bt; bf16_t* P; const float* bias; const float* lb; int layer;
  __device__ __forceinline__ bool next(int i, pg8::Unit& u) const { return so.next(i, u); }
  __device__ __forceinline__ const char* a_base() const { return A; }
  __device__ __forceinline__ unsigned a_off(const pg8::Unit& u, int r) const { return (unsigned)(u.pm * 256 + r) * 2048u; }
  __device__ __forceinline__ const char* b_base(const pg8::Unit& u) const { return Bt + (size_t)u.pn * 256 * 2048; }
  __device__ __forceinline__ void epi(const f32x4 (&acc)[2][2][4][2], const pg8::Unit& u, int wr, int wc, int fr, int fq) const {
    const int row0 = u.row0 + wr * 64 + fr, colb = u.pn * 256 + wc * 32 + 8 * fq;
    int mode = 0;
    if (layer == 0) { mode = u.pn < 2 ? 1 : (u.pn < 6 ? 2 : (u.pn == 10 ? 3 : 0)); }
#pragma unroll
    for (int bj = 0; bj < 2; ++bj) {
      const int col0 = colb + bj * 128;
      const f32x4 b0 = *(const f32x4*)(bias + col0), b1 = *(const f32x4*)(bias + col0 + 4);
      f32x4 l0 = (f32x4){0.f, 0.f, 0.f, 0.f}, l1 = l0;
      if (mode == 2) { l0 = *(const f32x4*)(lb + ((col0 - 512) & 511)); l1 = *(const f32x4*)(lb + ((col0 - 512) & 511) + 4); }
#pragma unroll
      for (int ai = 0; ai < 2; ++ai)
#pragma unroll
        for (int m = 0; m < 4; ++m) {
          f32x4 v0 = acc[ai][bj][m][0] + b0, v1 = acc[ai][bj][m][1] + b1;
          if (mode == 1) {
#pragma unroll
            for (int j = 0; j < 4; ++j) { v0[j] = fsilu(v0[j]); v1[j] = fsilu(v1[j]); }
          } else if (mode == 2) {
#pragma unroll
            for (int j = 0; j < 4; ++j) { v0[j] = __builtin_amdgcn_logf(l0[j] + (1.0f - l0[j]) * fsigmoid(v0[j])); v1[j] = __builtin_amdgcn_logf(l1[j] + (1.0f - l1[j]) * fsigmoid(v1[j])); }
          } else if (mode == 3) { v0 *= 0.125f; v1 *= 0.125f; }
          u32x4 w; w.x = pk2(v0[0], v0[1]); w.y = pk2(v0[2], v0[3]); w.z = pk2(v1[0], v1[1]); w.w = pk2(v1[2], v1[3]);
          *(u32x4*)(P + PIDX(row0 + ai * 128 + m * 16, col0)) = w;
        }
    }
  }
};
struct ProbOutProj {
  static constexpr bool PERM = false;
  pg8::StaticOrder so; const char* A; const char* Bt; float* Y; const float* Hres;
  __device__ __forceinline__ bool next(int i, pg8::Unit& u) const { return so.next(i, u); }
  __device__ __forceinline__ const char* a_base() const { return A; }
  __device__ __forceinline__ unsigned a_off(const pg8::Unit& u, int r) const { return (unsigned)(u.pm * 256 + r) * 2048u; }
  __device__ __forceinline__ const char* b_base(const pg8::Unit& u) const { return Bt + (size_t)u.pn * 256 * 2048; }
  __device__ __forceinline__ void epi(const f32x4 (&acc)[2][2][4][2], const pg8::Unit& u, int wr, int wc, int fr, int fq) const {
    const int row0 = u.row0 + wr * 64 + fr, col0 = u.pn * 256 + wc * 32 + 4 * fq;
#pragma unroll
    for (int ai = 0; ai < 2; ++ai)
#pragma unroll
      for (int m = 0; m < 4; ++m) { const size_t ro = (size_t)(row0 + ai * 128 + m * 16) * 1024 + col0; float* rowp = Y + ro; const float* hp = Hres + ro;
#pragma unroll
        for (int bj = 0; bj < 2; ++bj)
#pragma unroll
          for (int n = 0; n < 2; ++n) *(f32x4*)(rowp + bj * 128 + n * 16) = acc[ai][bj][m][n] + ALPHA_F * *(const f32x4*)(hp + bj * 128 + n * 16); }
  }
};
#define MOE_TAB_OFF (128 * 1024)
struct MoeOrder {
  const int* tab;
  __device__ __forceinline__ void init(const int* cnt, int ntn, int G, int c, unsigned char* lds, int wv) {
    int* t = (int*)(lds + MOE_TAB_OFF);
    const int tid = opaque_tid(wv);
    if (tid < 64) {
      int pad = 0, found = 0, ue = 0, upn = 0, upm = 0, urow = 0, une = 0;
      if ((G & 7) == 0) {
        const int x = c & 7; int q = tid * (G >> 3) + (c >> 3);
        for (int e = 0; e < NEXP; ++e) { const int n = cnt[e * 16], mt = (n + 255) >> 8; const int r = ((x - e) % 8 + 8) % 8; const int m = mt > r ? (mt - r - 1) / 8 + 1 : 0; const int units = m * ntn;
          if (!found && q < units) { ue = e; upm = r + 8 * (q % m); upn = q / m; urow = pad + upm * 256; une = n; found = 1; }
          if (!found) { q -= units; pad += mt * 256; } }
      } else {
        int L = tid * G + c;
        for (int e = 0; e < NEXP; ++e) { const int n = cnt[e * 16], mt = (n + 255) >> 8, tiles = mt * ntn;
          if (!found && L < tiles) { ue = e; upn = L / mt; upm = L % mt; urow = pad + upm * 256; une = n; found = 1; }
          if (!found) { L -= tiles; pad += mt * 256; } }
      }
      t[tid * 8 + 0] = found; t[tid * 8 + 1] = ue; t[tid * 8 + 2] = upn; t[tid * 8 + 3] = upm; t[tid * 8 + 4] = urow; t[tid * 8 + 5] = une;
    }
    __syncthreads();
    tab = t;
  }
  __device__ __forceinline__ bool next(int i, pg8::Unit& u) const {
    if (i >= 64) return false;
    const int* t = tab + i * 8;
    if (!__builtin_amdgcn_readfirstlane(t[0])) return false;
    u.e = __builtin_amdgcn_readfirstlane(t[1]); u.pn = __builtin_amdgcn_readfirstlane(t[2]); u.pm = __builtin_amdgcn_readfirstlane(t[3]);
    u.row0 = __builtin_amdgcn_readfirstlane(t[4]); u.ne = __builtin_amdgcn_readfirstlane(t[5]); u.ui = i; return true;
  }
};
struct ProbMoe1 {
  static constexpr bool PERM = true;
  MoeOrder mo; const char* A; const char* W13; const int* list; bf16_t* H; const int* ltok;
  __device__ __forceinline__ void stage_tokens(unsigned char* lds, int wv) {
    int* lt = (int*)(lds + MOE_TAB_OFF + 2048);
    const int tid = opaque_tid(wv);
    pg8::Unit u;
    for (int i = 0; i < 16 && mo.next(i, u); ++i) { if (tid < 256) { const int rr = u.pm * 256 + tid; lt[i * 256 + tid] = rr < u.ne ? list[u.e * NTOK + rr] : 0; } }
    __syncthreads();
    ltok = lt;
  }
  __device__ __forceinline__ bool next(int i, pg8::Unit& u) const { return mo.next(i, u); }
  __device__ __forceinline__ const char* a_base() const { return A; }
  __device__ __forceinline__ unsigned a_off(const pg8::Unit& u, int r) const { const int rr = u.pm * 256 + r; const int tok = rr < u.ne ? list[u.e * NTOK + rr] : 0; return (unsigned)tok * 2048u; }
  __device__ __forceinline__ const char* b_base(const pg8::Unit& u) const { return W13 + ((size_t)u.e * 2048 + (size_t)u.pn * 256) * 2048; }
  __device__ __forceinline__ void epi(const f32x4 (&acc)[2][2][4][2], const pg8::Unit& u, int wr, int wc, int fr, int fq) const {
    const int row0 = u.row0 + wr * 64 + fr, colb = u.pn * 128 + wc * 16 + 4 * fq;
#pragma unroll
    for (int ai = 0; ai < 2; ++ai)
#pragma unroll
      for (int m = 0; m < 4; ++m)
#pragma unroll
        for (int bj = 0; bj < 2; ++bj) {
          const f32x4 v0 = acc[ai][bj][m][0], v1 = acc[ai][bj][m][1];
          u32x2 w; w.x = pk2(fsilu(v0[0]) * v0[1], fsilu(v0[2]) * v0[3]); w.y = pk2(fsilu(v1[0]) * v1[1], fsilu(v1[2]) * v1[3]);
          *(u32x2*)(H + (size_t)(row0 + ai * 128 + m * 16) * 1024 + colb + bj * 64) = w;
        }
  }
};
struct ProbMoe2 {
  static constexpr bool PERM = true;
  MoeOrder mo; const char* A; const char* W2; bf16_t* Y;
  __device__ __forceinline__ bool next(int i, pg8::Unit& u) const { return mo.next(i, u); }
  __device__ __forceinline__ const char* a_base() const { return A; }
  __device__ __forceinline__ unsigned a_off(const pg8::Unit& u, int r) const { return (unsigned)(u.row0 + r) * 2048u; }
  __device__ __forceinline__ const char* b_base(const pg8::Unit& u) const { return W2 + ((size_t)u.e * 1024 + (size_t)u.pn * 256) * 2048; }
  __device__ __forceinline__ void epi(const f32x4 (&acc)[2][2][4][2], const pg8::Unit& u, int wr, int wc, int fr, int fq) const {
    const int row0 = u.row0 + wr * 64 + fr, colb = u.pn * 256 + wc * 32 + 8 * fq;
#pragma unroll
    for (int ai = 0; ai < 2; ++ai)
#pragma unroll
      for (int m = 0; m < 4; ++m)
#pragma unroll
        for (int bj = 0; bj < 2; ++bj) {
          const f32x4 v0 = acc[ai][bj][m][0], v1 = acc[ai][bj][m][1];
          u32x4 w; w.x = pk2(v0[0], v0[1]); w.y = pk2(v0[2], v0[3]); w.z = pk2(v1[0], v1[1]); w.w = pk2(v1[2], v1[3]);
          *(u32x4*)(Y + (size_t)(row0 + ai * 128 + m * 16) * 1024 + colb + bj * 128) = w;
        }
  }
};

template <int NS>
__device__ __forceinline__ void side_phase(unsigned char* lds_, int wv, const Params& p, int layer) {
  const Ctx c = make_ctx(lds_, wv);
  const bf16_t* hb = (const bf16_t*)(p.ws + WS_HB);
  const bf16_t* wt = (const bf16_t*)(p.ws + (layer == 0 ? WS_WIN_AB : WS_WIN_CD)) + (size_t)(layer == 0 ? PM_AB : PM_CD) * 1024;
  const float* bias = p.in[layer == 0 ? I_AB_B_IN : I_CD_B_IN] + (layer == 0 ? PM_AB : PM_CD);
  float* side = (float*)(p.ws + WS_SIDE);
  float* tl = (float*)c.lds + c.wid * (16 * 33);
  const int fr = c.lane & 15, fq = c.lane >> 4;
  for (int g = c.bid * 8 + c.wid; g < NTOK / 16; g += c.G * 8) {
    const int r0 = g * 16;
    f32x4 acc0 = (f32x4){0.f, 0.f, 0.f, 0.f}, acc1 = acc0;
    const bf16_t* ap = hb + (size_t)(r0 + fr) * 1024 + fq * 8;
    const bf16_t* bp0 = wt + (size_t)fr * 1024 + fq * 8; const bf16_t* bp1 = bp0 + 16 * 1024;
#pragma unroll 4
    for (int k = 0; k < 1024; k += 32) {
      const bf16x8 a = *(const bf16x8*)(ap + k), b0 = *(const bf16x8*)(bp0 + k);
      acc0 = __builtin_amdgcn_mfma_f32_16x16x32_bf16(a, b0, acc0, 0, 0, 0);
      if (NS == 32) { const bf16x8 b1 = *(const bf16x8*)(bp1 + k); acc1 = __builtin_amdgcn_mfma_f32_16x16x32_bf16(a, b1, acc1, 0, 0, 0); }
    }
    float gsc = 1.f, gfb = 0.f; bool gls = false;
    if (NS == 16) { gsc = 1.4426950408889634f; gls = (fr & 4) != 0; gfb = gls ? p.in[I_FGATE_B][(fr >> 3) * 4 + (fr & 3)] : 0.f; }
#pragma unroll
    for (int j = 0; j < 4; ++j) { float v0 = acc0[j] + bias[fr]; if (NS == 16) v0 = gls ? flog2sigmoid(v0 + gfb) : v0 * gsc; side[(size_t)(r0 + fq * 4 + j) * 32 + fr] = v0; tl[(fq * 4 + j) * 33 + fr] = v0;
      if (NS == 32) { const float v1 = acc1[j] + bias[16 + fr]; side[(size_t)(r0 + fq * 4 + j) * 32 + 16 + fr] = v1; tl[(fq * 4 + j) * 33 + 16 + fr] = v1; } }
    if (NS == 32) {
      __builtin_amdgcn_s_waitcnt(0xC07F);
      const float* gu = p.in[I_GK_UP]; const float* gb = p.in[I_GK_B]; bf16_t* lfb = (bf16_t*)(p.ws + WS_LFB);
      const int cb = c.lane * 8, dir = cb >> 8, cc = cb & 255;
      float w[16][8];
#pragma unroll
      for (int r = 0; r < 16; ++r)
#pragma unroll
        for (int j = 0; j < 8; ++j) w[r][j] = gu[(dir * 16 + r) * 256 + cc + j];
      float bb[8];
#pragma unroll
      for (int j = 0; j < 8; ++j) bb[j] = gb[dir * 256 + cc + j];
      for (int row = 0; row < 16; ++row) {
        float z[8];
#pragma unroll
        for (int j = 0; j < 8; ++j) z[j] = bb[j];
#pragma unroll
        for (int r = 0; r < 16; ++r) { const float s = tl[row * 33 + dir * 16 + r];
#pragma unroll
          for (int j = 0; j < 8; ++j) z[j] += s * w[r][j]; }
        u32x4 o; o.x = pk2(flog2sigmoid(z[0]) * 0.0625f, flog2sigmoid(z[1]) * 0.0625f); o.y = pk2(flog2sigmoid(z[2]) * 0.0625f, flog2sigmoid(z[3]) * 0.0625f);
        o.z = pk2(flog2sigmoid(z[4]) * 0.0625f, flog2sigmoid(z[5]) * 0.0625f); o.w = pk2(flog2sigmoid(z[6]) * 0.0625f, flog2sigmoid(z[7]) * 0.0625f);
        *(u32x4*)(lfb + PIDX(r0 + row, cb)) = o;
      }
    }
  }
}

__device__ __forceinline__ void headnorm_phase(unsigned char* lds_, int wv, const Params& p, int layer) {
  const Ctx c = make_ctx(lds_, wv);
  const bf16_t* P = (const bf16_t*)(p.ws + WS_R1); const bf16_t* O = (const bf16_t*)(p.ws + WS_R2);
  bf16_t* mixed = (bf16_t*)(p.ws + WS_HB);
  const int c0 = c.lane * 16, h8 = c.lane >> 3;
  const float* gain = layer == 0 ? (h8 < 4 ? p.in[I_HGRN_NORM] + c0 : p.in[I_GLA_NORM] + c0 - 512) : (h8 < 4 ? p.in[I_RET_NORM] + c0 : p.in[I_MLSTM_NORM] + c0 - 512);
  const int gcol = layer == 0 ? (h8 < 4 ? 2048 + c0 : 3584 + c0 - 512) : (h8 < 4 ? 1024 + c0 : 3072 + c0 - 512);
  float gn[16];
#pragma unroll
  for (int j = 0; j < 16; ++j) gn[j] = gain[j];
  for (int tok = c.bid * 8 + c.wid; tok < NTOK; tok += c.G * 8) {
    float of[16], ob[16], gt[16];
    { const u32x4* a = (const u32x4*)(O + PIDX(tok, c0)); unpack8(__builtin_nontemporal_load(a), of); unpack8(__builtin_nontemporal_load(a + 1), of + 8);
      const u32x4* b = (const u32x4*)(O + (size_t)NTOK * 1024 + PIDX(tok, c0)); unpack8(__builtin_nontemporal_load(b), ob); unpack8(__builtin_nontemporal_load(b + 1), ob + 8);
      const u32x4* g = (const u32x4*)(P + PIDX(tok, gcol)); unpack8(__builtin_nontemporal_load(g), gt); unpack8(__builtin_nontemporal_load(g + 1), gt + 8); }
    const float sf = 1.f, sb = 1.f;
    float o[16]; float ss = 0.f;
#pragma unroll
    for (int j = 0; j < 16; ++j) { o[j] = of[j] * sf + ob[j] * sb; ss += o[j] * o[j]; }
    ss += __shfl_xor(ss, 1); ss += __shfl_xor(ss, 2); ss += __shfl_xor(ss, 4);
    const float r = 1.0f / sqrtf(ss * (1.0f / 128.0f) + NORM_EPS_F);
    unsigned w[8];
#pragma unroll
    for (int j = 0; j < 8; ++j) {
      float g0 = gt[2 * j], g1 = gt[2 * j + 1];
      if (layer == 1 && h8 >= 4) { g0 = fsigmoid(g0); g1 = fsigmoid(g1); } else { g0 = fsilu(g0); g1 = fsilu(g1); }
      w[j] = pk2(o[2 * j] * r * gn[2 * j] * g0, o[2 * j + 1] * r * gn[2 * j + 1] * g1);
    }
    u32x4* d = (u32x4*)(mixed + (size_t)tok * 1024 + c0);
    d[0] = (u32x4){w[0], w[1], w[2], w[3]}; d[1] = (u32x4){w[4], w[5], w[6], w[7]};
  }
}

__device__ __forceinline__ void ln_phase(unsigned char* lds_, int wv, const Params& p, int layer, int mode, int dry = 0) {
  const Ctx c = make_ctx(lds_, wv);
  unsigned char* ws = p.ws;
  const float* hin = (mode == 0 && layer == 0) ? p.in[I_X] : p.out;
  float* hout = dry ? (float*)(ws + WS_H) : p.out; bf16_t* hb = (bf16_t*)(ws + WS_HB);
  const float* g = p.in[mode == 0 ? I_LN_MIX_G : I_LN_FFN_G] + layer * 1024; const float* b = p.in[mode == 0 ? I_LN_MIX_B : I_LN_FFN_B] + layer * 1024;
  unsigned* cnt = (unsigned*)(ws + WS_CTL) + CW_CNT(layer);
  int* list = (int*)(ws + WS_LIST) + (size_t)layer * NEXP * NTOK;
  int* assign = (int*)(ws + WS_ASSIGN); float* gate = (float*)(ws + WS_GATE);
  float* rwT = (float*)c.lds;
  int* lcnt = (int*)(c.lds + 65536); int* lbase = lcnt + 16; int* rec = lcnt + 32; float* recg = (float*)(rec + 4 * 2048);
  int pad[NEXP];
  if (mode == 0) { const float* r = p.in[I_ROUTER_W];
    for (int i = c.tid; i < 1024 * 16; i += NTHREADS) rwT[(i & 15) * 1024 + (i >> 4)] = r[i];
    if (c.tid < 16) lcnt[c.tid] = 0;
    __syncthreads(); }
  else { int acc = 0;
#pragma unroll
    for (int e = 0; e < NEXP; ++e) { pad[e] = acc; acc += (((int)cnt[e * 16] + 255) >> 8) << 8; } }
  const int c0 = c.lane * 4;
  float gv[16], bv[16];
#pragma unroll
  for (int q = 0; q < 4; ++q) { const f32x4 t0 = *(const f32x4*)(g + q * 256 + c0), t1 = *(const f32x4*)(b + q * 256 + c0);
#pragma unroll
    for (int j = 0; j < 4; ++j) { gv[4 * q + j] = t0[j]; bv[4 * q + j] = t1[j]; } }
  const int tstride = c.G * 8;
  int it = 0;
  for (int tok0 = c.bid * 8 + c.wid; tok0 < NTOK; tok0 += 2 * tstride, it += 2) {
    float v[2][16];
    float gy0[2], gy1[2];
#pragma unroll
    for (int u = 0; u < 2; ++u) {
      const int tok = tok0 + u * tstride;
      if (tok < NTOK) {
        if (mode == 0) {
#pragma unroll
          for (int q = 0; q < 4; ++q) { const f32x4 t = __builtin_nontemporal_load((const f32x4*)((const float*)(ws + WS_R2) + (size_t)tok * 1024 + q * 256 + c0)); v[u][4 * q] = t[0]; v[u][4 * q + 1] = t[1]; v[u][4 * q + 2] = t[2]; v[u][4 * q + 3] = t[3]; }
        } else {
#pragma unroll
          for (int q = 0; q < 4; ++q) { const f32x4 t = *(const f32x4*)(hin + (size_t)tok * 1024 + q * 256 + c0); v[u][4 * q] = ALPHA_F * t[0]; v[u][4 * q + 1] = ALPHA_F * t[1]; v[u][4 * q + 2] = ALPHA_F * t[2]; v[u][4 * q + 3] = ALPHA_F * t[3]; }
          const int a0 = assign[tok * 4], a1 = assign[tok * 4 + 1], a2 = assign[tok * 4 + 2], a3 = assign[tok * 4 + 3];
          gy0[u] = gate[tok * 2]; gy1[u] = gate[tok * 2 + 1];
          int p0 = 0, p1 = 0;
#pragma unroll
          for (int e = 0; e < NEXP; ++e) { if (e == a0) p0 = pad[e]; if (e == a2) p1 = pad[e]; }
          p0 += a1; p1 += a3;
          const bf16_t* Y = (const bf16_t*)(ws + WS_R2);
#pragma unroll
          for (int q = 0; q < 4; ++q) { const u32x2 y0 = __builtin_nontemporal_load((const u32x2*)(Y + (size_t)p0 * 1024 + q * 256 + c0)), y1 = __builtin_nontemporal_load((const u32x2*)(Y + (size_t)p1 * 1024 + q * 256 + c0));
            v[u][4 * q] += gy0[u] * __uint_as_float(y0.x << 16) + gy1[u] * __uint_as_float(y1.x << 16); v[u][4 * q + 1] += gy0[u] * __uint_as_float(y0.x & 0xffff0000u) + gy1[u] * __uint_as_float(y1.x & 0xffff0000u);
            v[u][4 * q + 2] += gy0[u] * __uint_as_float(y0.y << 16) + gy1[u] * __uint_as_float(y1.y << 16); v[u][4 * q + 3] += gy0[u] * __uint_as_float(y0.y & 0xffff0000u) + gy1[u] * __uint_as_float(y1.y & 0xffff0000u); }
        }
      } else {
#pragma unroll
        for (int j = 0; j < 16; ++j) v[u][j] = 0.f;
      }
    }
#pragma unroll
    for (int u = 0; u < 2; ++u) {
      const int tok = tok0 + u * tstride;
      float s = 0.f;
#pragma unroll
      for (int j = 0; j < 16; ++j) s += v[u][j];
      const float mean = wave_sum(s) * (1.0f / 1024.0f);
      float qq = 0.f;
#pragma unroll
      for (int j = 0; j < 16; ++j) { v[u][j] -= mean; qq += v[u][j] * v[u][j]; }
      const float r = 1.0f / sqrtf(wave_sum(qq) * (1.0f / 1024.0f) + LN_EPS_F);
#pragma unroll
      for (int j = 0; j < 16; ++j) v[u][j] = v[u][j] * r * gv[j] + bv[j];
      if (tok < NTOK) {
#pragma unroll
        for (int q = 0; q < 4; ++q) __builtin_nontemporal_store((f32x4){v[u][4 * q], v[u][4 * q + 1], v[u][4 * q + 2], v[u][4 * q + 3]}, (f32x4*)(hout + (size_t)tok * 1024 + q * 256 + c0));
        if (!(mode == 1 && layer == 1) && !dry) {
#pragma unroll
          for (int q = 0; q < 4; ++q) *(u32x2*)(hb + (size_t)tok * 1024 + q * 256 + c0) = (u32x2){pk2(v[u][4 * q], v[u][4 * q + 1]), pk2(v[u][4 * q + 2], v[u][4 * q + 3])}; }
      }
      if (mode == 0) {
        float lg[16];
#pragma unroll
        for (int e = 0; e < 16; ++e) { float a = 0.f;
#pragma unroll
          for (int q = 0; q < 4; ++q) { const f32x4 w = *(const f32x4*)(rwT + e * 1024 + q * 256 + c0); a += v[u][4 * q] * w[0] + v[u][4 * q + 1] * w[1] + v[u][4 * q + 2] * w[2] + v[u][4 * q + 3] * w[3]; }
          lg[e] = a; }
#pragma unroll
        for (int e = 0; e < 16; ++e) lg[e] = wave_sum(lg[e]);
        int eo[2]; float go[2];
        route_from_logits(lg, p.in[I_ROUTER_B], eo, go);
        if (c.lane == 0 && tok < NTOK && !dry) {
          const int r1 = atomicAdd(lcnt + eo[0], 1), r2 = atomicAdd(lcnt + eo[1], 1);
          const int ri = (it + u) * 8 + c.wid;
          rec[ri * 4] = eo[0]; rec[ri * 4 + 1] = r1; rec[ri * 4 + 2] = eo[1]; rec[ri * 4 + 3] = r2; recg[ri * 2] = go[0]; recg[ri * 2 + 1] = go[1];
        }
      }
    }
  }
  if (mode == 0 && !dry) {
    __syncthreads();
    if (c.tid < 16) lbase[c.tid] = (int)atomicAdd(cnt + c.tid * 16, (unsigned)lcnt[c.tid]);
    __syncthreads();
    const int nrec = ((NTOK + c.G * 8 - 1) / (c.G * 8)) * 8;
    for (int ri = c.tid; ri < nrec; ri += NTHREADS) {
      const int tok = c.bid * 8 + (ri & 7) + (ri >> 3) * c.G * 8;
      if (tok < NTOK) {
        const int e1 = rec[ri * 4], e2 = rec[ri * 4 + 2]; const int r1 = rec[ri * 4 + 1] + lbase[e1], r2 = rec[ri * 4 + 3] + lbase[e2];
        list[e1 * NTOK + r1] = tok; list[e2 * NTOK + r2] = tok;
        assign[tok * 4] = e1; assign[tok * 4 + 1] = r1; assign[tok * 4 + 2] = e2; assign[tok * 4 + 3] = r2;
        gate[tok * 2] = recg[ri * 2]; gate[tok * 2 + 1] = recg[ri * 2 + 1];
      }
    }
  }
  __syncthreads();
}
#endif
#ifndef CPU_EMU
namespace scan {
typedef short bf16x8 __attribute__((ext_vector_type(8)));
typedef float f32x4 __attribute__((ext_vector_type(4)));
typedef unsigned u32x4 __attribute__((ext_vector_type(4)));
typedef unsigned u32x2 __attribute__((ext_vector_type(2)));
enum { MIX_A = 0, MIX_B = 1, MIX_C = 2, MIX_D = 3 };
constexpr int LD_T = 144;
constexpr int OFF_QS = 0, OFF_KS = 17408, OFF_QI = 34816, OFF_KT = 52224, OFF_VT = 70656, OFF_SC = 77568, OFF_ST = 86784, OFF_DEC = 99840, OFF_EM = 100352, OFF_DEN = 100608, OFF_CW = 100864, SCAN_LDS = 104960;

__device__ __forceinline__ float incl_scan_add(float x) {
  x += __builtin_bit_cast(float, __builtin_amdgcn_update_dpp(0, __builtin_bit_cast(int, x), 0x111, 0xf, 0xf, false));
  x += __builtin_bit_cast(float, __builtin_amdgcn_update_dpp(0, __builtin_bit_cast(int, x), 0x112, 0xf, 0xf, false));
  x += __builtin_bit_cast(float, __builtin_amdgcn_update_dpp(0, __builtin_bit_cast(int, x), 0x114, 0xf, 0xf, false));
  x += __builtin_bit_cast(float, __builtin_amdgcn_update_dpp(0, __builtin_bit_cast(int, x), 0x118, 0xf, 0xf, false));
  x += __builtin_bit_cast(float, __builtin_amdgcn_update_dpp(0, __builtin_bit_cast(int, x), 0x142, 0xa, 0xf, false));
  x += __builtin_bit_cast(float, __builtin_amdgcn_update_dpp(0, __builtin_bit_cast(int, x), 0x143, 0xc, 0xf, false));
  return x;
}
__device__ __forceinline__ float incl_scan_max(float x) {
  const int ninf = (int)0xff800000u;
  x = fmaxf(x, __builtin_bit_cast(float, __builtin_amdgcn_update_dpp(ninf, __builtin_bit_cast(int, x), 0x111, 0xf, 0xf, false)));
  x = fmaxf(x, __builtin_bit_cast(float, __builtin_amdgcn_update_dpp(ninf, __builtin_bit_cast(int, x), 0x112, 0xf, 0xf, false)));
  x = fmaxf(x, __builtin_bit_cast(float, __builtin_amdgcn_update_dpp(ninf, __builtin_bit_cast(int, x), 0x114, 0xf, 0xf, false)));
  x = fmaxf(x, __builtin_bit_cast(float, __builtin_amdgcn_update_dpp(ninf, __builtin_bit_cast(int, x), 0x118, 0xf, 0xf, false)));
  x = fmaxf(x, __builtin_bit_cast(float, __builtin_amdgcn_update_dpp(ninf, __builtin_bit_cast(int, x), 0x142, 0xa, 0xf, false)));
  x = fmaxf(x, __builtin_bit_cast(float, __builtin_amdgcn_update_dpp(ninf, __builtin_bit_cast(int, x), 0x143, 0xc, 0xf, false)));
  return x;
}
__device__ __forceinline__ float rdlane(float x, int l) { return __builtin_bit_cast(float, __builtin_amdgcn_readlane(__builtin_bit_cast(int, x), l)); }
__device__ __forceinline__ bf16x8 ldfrag(const unsigned char* base, int ld, int row, int kbyte) { return *(const bf16x8*)(base + row * ld + kbyte); }
__device__ __forceinline__ unsigned pk(float a, float b) { return pk_hw(a, b); }
__device__ __forceinline__ float lo16(unsigned w) { return __uint_as_float(w << 16); }
__device__ __forceinline__ float hi16(unsigned w) { return __uint_as_float(w & 0xffff0000u); }

__device__ __forceinline__ void lds_barrier() { asm volatile("s_waitcnt lgkmcnt(0)" ::: "memory"); __builtin_amdgcn_s_barrier(); asm volatile("" ::: "memory"); }
struct Raw { u32x4 a0, a1, b0, b1; f32x4 r0, r1; u32x2 v; float s0, s1; };

}

__device__ __forceinline__ void convd_phase(unsigned char* lds_, int wv, const Params& p) {
  const Ctx c = make_ctx(lds_, wv);
  bf16_t* P = (bf16_t*)(p.ws + WS_R1); bf16_t* QD = (bf16_t*)(p.ws + WS_LFB);
  const float* cw = p.in[I_CONV_W]; const float* cb = p.in[I_CONV_B];
  const int ch = c.lane * 16;
  float w0[16], w1[16], w2[16], bb[16];
#pragma unroll
  for (int j = 0; j < 16; ++j) { w0[j] = cw[ch + j]; w1[j] = cw[1024 + ch + j]; w2[j] = cw[2048 + ch + j]; bb[j] = cb[ch + j]; }
  for (int tok = c.bid * 8 + c.wid; tok < NTOK; tok += c.G * 8) {
    const int t = tok % SEQ;
    const bf16_t* row = P + PIDX(tok, 1536 + ch);
    float x0[16], x1[16], x2[16];
    { const u32x4* r1 = (const u32x4*)row; unpack8(r1[0], x1); unpack8(r1[1], x1 + 8); }
    if (t > 0) { const u32x4* r0 = (const u32x4*)(row - 128); unpack8(r0[0], x0); unpack8(r0[1], x0 + 8); }
    else {
#pragma unroll
      for (int j = 0; j < 16; ++j) x0[j] = 0.f; }
    if (t < SEQ - 1) { const u32x4* r2 = (const u32x4*)(row + 128); unpack8(r2[0], x2); unpack8(r2[1], x2 + 8); }
    else {
#pragma unroll
      for (int j = 0; j < 16; ++j) x2[j] = 0.f; }
    const float sc = ch < 512 ? 0.08838834764831845f : 1.0f;
    unsigned w[8];
#pragma unroll
    for (int j = 0; j < 8; ++j) {
      const float a0 = bb[2 * j] + w0[2 * j] * x0[2 * j] + w1[2 * j] * x1[2 * j] + w2[2 * j] * x2[2 * j];
      const float a1 = bb[2 * j + 1] + w0[2 * j + 1] * x0[2 * j + 1] + w1[2 * j + 1] * x1[2 * j + 1] + w2[2 * j + 1] * x2[2 * j + 1];
      w[j] = pk2(fsilu(a0) * sc, fsilu(a1) * sc);
    }
    u32x4* d = (ch < 512) ? (u32x4*)(QD + PIDX(tok, ch)) : (u32x4*)(P + PIDX(tok, 3584 + (ch - 512)));
    d[0] = (u32x4){w[0], w[1], w[2], w[3]}; d[1] = (u32x4){w[4], w[5], w[6], w[7]};
  }
}

#endif
#ifndef CPU_EMU
namespace scan2 {
using namespace scan;
constexpr int U_QI = 0, U_KS = 34816, U_KT = 69632, U_VT = 106496, U_SC = 120320, U_ST = 129536, U_DEC = 155648, U_EM = 156672, U_END = 157184;
template <int MIXER>
__device__ __forceinline__ void scan_item2(unsigned char* lds, int wv, const Params& p, int b, int h, int dir, int vs) {
  constexpr int DK = (MIXER == MIX_A || MIXER == MIX_D) ? 128 : 64;
  constexpr int NC = DK / 8;
  constexpr int LD_D = DK * 2 + 16;
  constexpr int NVT = MIXER == MIX_D ? 3 : 2;
  constexpr int NKD = DK / 32;
  constexpr int NST = (DK == 128) ? NVT : 1;
  constexpr int NCH = SEQ / 64;
  const int tid = opaque_tid(wv), lane0 = tid & 63, wid = __builtin_amdgcn_readfirstlane(tid >> 6);
  unsigned char* ws = p.ws;
  const bf16_t* P = (const bf16_t*)(ws + WS_R1);
  const bf16_t* LFBp = (const bf16_t*)(ws + WS_LFB);
  const float* side = (const float*)(ws + WS_SIDE);
  const float* rope = (const float*)(ws + WS_ROPE);
  bf16_t* O = (bf16_t*)(ws + WS_R2) + (size_t)dir * NTOK * 1024;
  unsigned char* SC = lds + U_SC;
  int qcol, kcol, lfcol, vcol, ocol;
  if (MIXER == MIX_A) { qcol = h * 128; kcol = 0; lfcol = 512 + dir * 512 + h * 128; vcol = 1536 + h * 128 + vs * 32; ocol = h * 128 + vs * 32; }
  else if (MIXER == MIX_B) { qcol = 2560 + h * 64; kcol = 2816 + h * 64; lfcol = dir * 256 + h * 64; vcol = 3072 + h * 128 + vs * 32; ocol = 512 + h * 128 + vs * 32; }
  else if (MIXER == MIX_C) { qcol = h * 64; kcol = 256 + h * 64; lfcol = 0; vcol = 512 + h * 128 + vs * 32; ocol = h * 128 + vs * 32; }
  else { qcol = h * 128; kcol = 3584 + h * 128; lfcol = 0; vcol = 2560 + h * 128 + vs * 32; ocol = 512 + h * 128 + vs * 32; }
  const size_t tokbase = (size_t)b * SEQ;
  const int c0 = (MIXER == MIX_C) ? wid * 4 : wid * NC;
  for (int i = tid; i < 2 * 13056 / 4; i += NTHREADS) ((unsigned*)(lds + U_ST))[i] = 0u;
  for (int i = tid; i < 9216 / 4; i += NTHREADS) ((unsigned*)(lds + U_SC))[i] = 0u;
  if (MIXER == MIX_D) { for (int i = tid; i < 2 * 16 * 64; i += NTHREADS) { const int bf = i >> 10, r = 32 + ((i >> 6) & 15), j = i & 63; *(bf16_t*)(lds + U_VT + bf * 6912 + r * LD_T + j * 2) = (r == 32) ? (bf16_t)0x3F80 : (bf16_t)0; } }
  const float lgam2 = (MIXER == MIX_C) ? log1pf(-exp2f(-(5.0f + 2.0f * (float)h + (float)dir))) * 1.4426950408889634f : 0.f;
  const float fgb = (MIXER == MIX_D) ? p.in[I_FGATE_B][dir * 4 + h] : 0.f;
  float m_st = 0.f;
  __syncthreads();

  Raw R, Rn; u32x2 Rv, Rvn;
#define A_LOAD(R, Rv, n_) do { \
    const int ln_ = lane0; \
    const int t_ = dir ? (SEQ - 1 - ((n_) * 64 + ln_)) : ((n_) * 64 + ln_); \
    const size_t tk_ = tokbase + t_; \
    if (MIXER == MIX_A) { const u32x4* qp_ = (const u32x4*)(P + PIDX(tk_, qcol + c0)); const u32x4* lp_ = (const u32x4*)(P + PIDX(tk_, lfcol + c0)); R.a0 = qp_[0]; R.a1 = qp_[1]; R.b0 = lp_[0]; R.b1 = lp_[1]; } \
    else if (MIXER == MIX_B) { R.a0 = *(const u32x4*)(P + PIDX(tk_, qcol + c0)); R.a1 = *(const u32x4*)(P + PIDX(tk_, kcol + c0)); R.b0 = *(const u32x4*)(LFBp + PIDX(tk_, lfcol + c0)); } \
    else if (MIXER == MIX_C) { const u32x2 qa_ = *(const u32x2*)(P + PIDX(tk_, qcol + c0)), qb_ = *(const u32x2*)(P + PIDX(tk_, qcol + 32 + c0)), ka_ = *(const u32x2*)(P + PIDX(tk_, kcol + c0)), kb_ = *(const u32x2*)(P + PIDX(tk_, kcol + 32 + c0)); \
      R.a0 = (u32x4){qa_.x, qa_.y, qb_.x, qb_.y}; R.a1 = (u32x4){ka_.x, ka_.y, kb_.x, kb_.y}; \
      R.r0 = *(const f32x4*)(rope + ((size_t)t_ * 32 + c0) * 2); R.r1 = *(const f32x4*)(rope + ((size_t)t_ * 32 + c0) * 2 + 4); } \
    else { const u32x4* qp_ = (const u32x4*)(LFBp + PIDX(tk_, qcol + c0)); const u32x4* kp_ = (const u32x4*)(P + PIDX(tk_, kcol + c0)); R.a0 = qp_[0]; R.a1 = qp_[1]; R.b0 = kp_[0]; R.b1 = kp_[1]; \
      R.s0 = side[tk_ * 32 + dir * 8 + h]; R.s1 = side[tk_ * 32 + dir * 8 + 4 + h]; } \
    Rv = *(const u32x2*)(P + PIDX(tk_, vcol + wid * 4)); } while (0)

  float rr_next = 1.f, rr_cur = 1.f;
#define A_PREP(buf_, R, Rv) do { \
    const int lane = lane0; \
    unsigned char* KTb = lds + U_KT + (buf_) * 18432; float* DECb = (float*)(lds + U_DEC + (buf_) * 512); float* EMb = (float*)(lds + U_EM + (buf_) * 256); \
    unsigned char* QIb = lds + U_QI + (buf_) * 17408; unsigned char* KSb = lds + U_KS + (buf_) * 17408; \
    float q[NC], k[NC], g[NC], ktv[NC]; \
    if (MIXER == MIX_A) { \
      const unsigned qw[8] = {R.a0.x, R.a0.y, R.a0.z, R.a0.w, R.a1.x, R.a1.y, R.a1.z, R.a1.w}, lw[8] = {R.b0.x, R.b0.y, R.b0.z, R.b0.w, R.b1.x, R.b1.y, R.b1.z, R.b1.w}; \
      _Pragma("unroll") for (int c = 0; c < 8; ++c) { q[2 * c] = lo16(qw[c]); q[2 * c + 1] = hi16(qw[c]); g[2 * c] = lo16(lw[c]); g[2 * c + 1] = hi16(lw[c]); } \
      _Pragma("unroll") for (int c = 0; c < NC; ++c) k[c] = 1.0f - __builtin_amdgcn_exp2f(g[c]); \
    } else if (MIXER == MIX_B) { \
      const unsigned qw[4] = {R.a0.x, R.a0.y, R.a0.z, R.a0.w}, kw[4] = {R.a1.x, R.a1.y, R.a1.z, R.a1.w}, lw[4] = {R.b0.x, R.b0.y, R.b0.z, R.b0.w}; \
      _Pragma("unroll") for (int c = 0; c < 4; ++c) { q[2 * c] = lo16(qw[c]); q[2 * c + 1] = hi16(qw[c]); k[2 * c] = lo16(kw[c]); k[2 * c + 1] = hi16(kw[c]); g[2 * c] = lo16(lw[c]); g[2 * c + 1] = hi16(lw[c]); } \
    } else if (MIXER == MIX_C) { \
      const float cs[4] = {R.r0[0], R.r0[2], R.r1[0], R.r1[2]}, sn[4] = {R.r0[1], R.r0[3], R.r1[1], R.r1[3]}; \
      const float q1[4] = {lo16(R.a0.x), hi16(R.a0.x), lo16(R.a0.y), hi16(R.a0.y)}, q2[4] = {lo16(R.a0.z), hi16(R.a0.z), lo16(R.a0.w), hi16(R.a0.w)}; \
      const float k1[4] = {lo16(R.a1.x), hi16(R.a1.x), lo16(R.a1.y), hi16(R.a1.y)}, k2[4] = {lo16(R.a1.z), hi16(R.a1.z), lo16(R.a1.w), hi16(R.a1.w)}; \
      _Pragma("unroll") for (int c = 0; c < 4; ++c) { q[c] = (q1[c] * cs[c] - q2[c] * sn[c]) * 0.125f; q[4 + c] = (q1[c] * sn[c] + q2[c] * cs[c]) * 0.125f; k[c] = k1[c] * cs[c] - k2[c] * sn[c]; k[4 + c] = k1[c] * sn[c] + k2[c] * cs[c]; } \
    } else { \
      const unsigned qw[8] = {R.a0.x, R.a0.y, R.a0.z, R.a0.w, R.a1.x, R.a1.y, R.a1.z, R.a1.w}, kw[8] = {R.b0.x, R.b0.y, R.b0.z, R.b0.w, R.b1.x, R.b1.y, R.b1.z, R.b1.w}; \
      _Pragma("unroll") for (int c = 0; c < 8; ++c) { q[2 * c] = lo16(qw[c]); q[2 * c + 1] = hi16(qw[c]); k[2 * c] = lo16(kw[c]); k[2 * c + 1] = hi16(kw[c]); } \
    } \
    if (MIXER == MIX_A || MIXER == MIX_B) { \
        \
      _Pragma("unroll") for (int c = 0; c < NC; ++c) g[c] += __builtin_bit_cast(float, __builtin_amdgcn_update_dpp(0, __builtin_bit_cast(int, g[c]), 0x111, 0xf, 0xf, false)); \
      _Pragma("unroll") for (int c = 0; c < NC; ++c) g[c] += __builtin_bit_cast(float, __builtin_amdgcn_update_dpp(0, __builtin_bit_cast(int, g[c]), 0x112, 0xf, 0xf, false)); \
      _Pragma("unroll") for (int c = 0; c < NC; ++c) g[c] += __builtin_bit_cast(float, __builtin_amdgcn_update_dpp(0, __builtin_bit_cast(int, g[c]), 0x114, 0xf, 0xf, false)); \
      _Pragma("unroll") for (int c = 0; c < NC; ++c) g[c] += __builtin_bit_cast(float, __builtin_amdgcn_update_dpp(0, __builtin_bit_cast(int, g[c]), 0x118, 0xf, 0xf, false)); \
      _Pragma("unroll") for (int c = 0; c < NC; ++c) g[c] += __builtin_bit_cast(float, __builtin_amdgcn_update_dpp(0, __builtin_bit_cast(int, g[c]), 0x142, 0xa, 0xf, false)); \
      _Pragma("unroll") for (int c = 0; c < NC; ++c) g[c] += __builtin_bit_cast(float, __builtin_amdgcn_update_dpp(0, __builtin_bit_cast(int, g[c]), 0x143, 0xc, 0xf, false)); \
      float ev[NC]; \
      _Pragma("unroll") for (int c = 0; c < NC; ++c) { \
          \
        const float e = __builtin_amdgcn_exp2f(g[c]), r = __builtin_amdgcn_rcpf(e); \
        const float e63 = rdlane(e, 63); \
        q[c] *= e; k[c] *= r; ktv[c] = k[c] * e63;     \
        ev[c] = e; } \
      if (lane == 63) { _Pragma("unroll") for (int c = 0; c < NC / 4; ++c) *(f32x4*)(DECb + c0 + 4 * c) = (f32x4){ev[4 * c], ev[4 * c + 1], ev[4 * c + 2], ev[4 * c + 3]}; } \
    } else if (MIXER == MIX_C) { \
        \
      const float gl = (float)(lane + 1) * lgam2; \
      const float e = __builtin_amdgcn_exp2f(gl), r = __builtin_amdgcn_rcpf(e); \
      const float e63 = rdlane(e, 63); const float f_kt = r * e63; \
      _Pragma("unroll") for (int c = 0; c < NC; ++c) { q[c] *= e; ktv[c] = k[c] * f_kt; k[c] *= r; } \
      if (lane < 4) { DECb[c0 + lane] = e63; DECb[32 + c0 + lane] = e63; } \
    } else { \
      const float li = R.s0, lf = R.s1;     \
      const float bc = incl_scan_add(lf); const float u = li - bc; const float pm = incl_scan_max(u); \
      const float cmax = rdlane(pm, 63), blast = rdlane(bc, 63); \
      const float a_i = bc + m_st, m_i = fmaxf(a_i, bc + pm); \
      const float d_alpha = __builtin_amdgcn_exp2f(bc - m_i + cmax), d_beta = __builtin_amdgcn_exp2f(u - cmax); \
      rr_next = __builtin_amdgcn_exp2f(m_st - cmax);     \
      const float m_new = fmaxf(blast + m_st, blast + cmax); \
      const float d_sold = __builtin_amdgcn_exp2f(blast + m_st - m_new), d_wks = __builtin_amdgcn_exp2f(blast + u - m_new); m_st = m_new; \
      _Pragma("unroll") for (int c = 0; c < NC; ++c) { ktv[c] = k[c] * d_wks; q[c] *= d_alpha; k[c] *= d_beta; if (lane == 63) DECb[c0 + c] = d_sold; } \
      if (wid == 0) EMb[lane] = __builtin_amdgcn_exp2f(-m_i); \
    } \
    _Pragma("unroll") for (int c = 0; c < NC / 2; ++c) { const unsigned w_ = pk_hw(ktv[2 * c], ktv[2 * c + 1]); \
      const int d0_ = (MIXER == MIX_C) ? (2 * c < 4 ? c0 + 2 * c : 32 + c0 + 2 * c - 4) : c0 + 2 * c; \
      *(bf16_t*)(KTb + d0_ * LD_T + lane * 2) = (bf16_t)(w_ & 0xffff); *(bf16_t*)(KTb + (d0_ + 1) * LD_T + lane * 2) = (bf16_t)(w_ >> 16); } \
    { unsigned pq[NC / 2], pks[NC / 2]; \
      _Pragma("unroll") for (int c = 0; c < NC / 2; ++c) { pq[c] = pk_hw(q[2 * c], q[2 * c + 1]); pks[c] = pk_hw(k[2 * c], k[2 * c + 1]); } \
      if (MIXER == MIX_C) { \
        *(u32x2*)(QIb + lane * LD_D + c0 * 2) = (u32x2){pq[0], pq[1]}; *(u32x2*)(QIb + lane * LD_D + (32 + c0) * 2) = (u32x2){pq[2], pq[3]}; \
        *(u32x2*)(KSb + lane * LD_D + c0 * 2) = (u32x2){pks[0], pks[1]}; *(u32x2*)(KSb + lane * LD_D + (32 + c0) * 2) = (u32x2){pks[2], pks[3]}; \
      } else { \
        _Pragma("unroll") for (int c = 0; c < NC / 8; ++c) { \
          *(u32x4*)(QIb + lane * LD_D + (c0 + 8 * c) * 2) = (u32x4){pq[4 * c], pq[4 * c + 1], pq[4 * c + 2], pq[4 * c + 3]}; \
          *(u32x4*)(KSb + lane * LD_D + (c0 + 8 * c) * 2) = (u32x4){pks[4 * c], pks[4 * c + 1], pks[4 * c + 2], pks[4 * c + 3]}; } } } \
    { unsigned char* VTb = lds + U_VT + (buf_) * 6912 + (wid * 4) * LD_T + lane * 2; \
      *(bf16_t*)(VTb + 0 * LD_T) = (bf16_t)(Rv.x & 0xffff); *(bf16_t*)(VTb + 1 * LD_T) = (bf16_t)(Rv.x >> 16); *(bf16_t*)(VTb + 2 * LD_T) = (bf16_t)(Rv.y & 0xffff); *(bf16_t*)(VTb + 3 * LD_T) = (bf16_t)(Rv.y >> 16); } \
  } while (0)
  f32x4 sacc[NST];
#pragma unroll
  for (int i = 0; i < NST; ++i) sacc[i] = (f32x4){0.f, 0.f, 0.f, 0.f};
  A_LOAD(R, Rv, 0);
  A_PREP(0, R, Rv);
  A_LOAD(R, Rv, 1);
  A_LOAD(Rn, Rvn, 2);
  rr_cur = rr_next;
  lds_barrier();
#define SCAN_ITER(n_, RX, RvX) do { const int n = (n_); \
    const int cb = n & 1, nb = (n + 1) & 1; \
    if (n + 1 < NCH) { A_PREP(nb, RX, RvX); if (n + 3 < NCH) A_LOAD(RX, RvX, n + 3); } \
    { { \
      const int lane = lane0; \
      const int fr = lane & 15, fq = lane >> 4; \
      const int it = wid & 3, vt = wid >> 2; \
      const unsigned char* STc = lds + U_ST + cb * 13056; unsigned char* STn = lds + U_ST + nb * 13056; \
      const unsigned char* KTc = lds + U_KT + cb * 18432; const unsigned char* VTc = lds + U_VT + cb * 6912; \
      const unsigned char* QI = lds + U_QI + cb * 17408; const unsigned char* KS = lds + U_KS + cb * 17408; \
      const float* DECc = (const float*)(lds + U_DEC + cb * 512); const float* EMc = (const float*)(lds + U_EM + cb * 256); \
      bf16x8 qf[NKD]; \
_Pragma("unroll") \
      for (int ks = 0; ks < NKD; ++ks) qf[ks] = ldfrag(QI, LD_D, it * 16 + fr, ks * 64 + fq * 16); \
_Pragma("unroll") \
      for (int jt = 0; jt < 4; ++jt) { \
        if (jt <= it) { \
          f32x4 acc = (f32x4){0.f, 0.f, 0.f, 0.f}; \
_Pragma("unroll") \
          for (int ks = 0; ks < NKD; ++ks) acc = __builtin_amdgcn_mfma_f32_16x16x32_bf16(ldfrag(KS, LD_D, jt * 16 + fr, ks * 64 + fq * 16), qf[ks], acc, 0, 0, 0); \
          const int i = it * 16 + fr, j0 = jt * 16 + fq * 4; \
          if (jt == it) { const float v0 = (j0 + 0 <= i) ? acc[0] : 0.f, v1 = (j0 + 1 <= i) ? acc[1] : 0.f, v2 = (j0 + 2 <= i) ? acc[2] : 0.f, v3 = (j0 + 3 <= i) ? acc[3] : 0.f; \
            *(u32x2*)(SC + i * LD_T + j0 * 2) = (u32x2){pk_hw(v0, v1), pk_hw(v2, v3)}; } \
          else *(u32x2*)(SC + i * LD_T + j0 * 2) = (u32x2){pk_hw(acc[0], acc[1]), pk_hw(acc[2], acc[3])}; \
        } \
      } \
      f32x4 oacc = (f32x4){0.f, 0.f, 0.f, 0.f}, dacc = (f32x4){0.f, 0.f, 0.f, 0.f}; \
_Pragma("unroll") \
      for (int ks = 0; ks < NKD; ++ks) oacc = __builtin_amdgcn_mfma_f32_16x16x32_bf16(ldfrag(STc, LD_D, vt * 16 + fr, ks * 64 + fq * 16), qf[ks], oacc, 0, 0, 0); \
      if (NVT == 3) { \
_Pragma("unroll") \
        for (int ks = 0; ks < NKD; ++ks) dacc = __builtin_amdgcn_mfma_f32_16x16x32_bf16(ldfrag(STc, LD_D, 32 + fr, ks * 64 + fq * 16), qf[ks], dacc, 0, 0, 0); \
      } \
      if (MIXER == MIX_D) { oacc *= rr_cur; dacc *= rr_cur; } \
      asm volatile("s_waitcnt lgkmcnt(0)" ::: "memory"); \
      oacc = __builtin_amdgcn_mfma_f32_16x16x32_bf16(ldfrag(VTc, LD_T, vt * 16 + fr, fq * 16), ldfrag(SC, LD_T, it * 16 + fr, fq * 16), oacc, 0, 0, 0); \
      if (it >= 2) oacc = __builtin_amdgcn_mfma_f32_16x16x32_bf16(ldfrag(VTc, LD_T, vt * 16 + fr, 64 + fq * 16), ldfrag(SC, LD_T, it * 16 + fr, 64 + fq * 16), oacc, 0, 0, 0); \
      float dn = 1.0f; \
      if (NVT == 3) { \
        dacc = __builtin_amdgcn_mfma_f32_16x16x32_bf16(ldfrag(VTc, LD_T, 32 + fr, fq * 16), ldfrag(SC, LD_T, it * 16 + fr, fq * 16), dacc, 0, 0, 0); \
        if (it >= 2) dacc = __builtin_amdgcn_mfma_f32_16x16x32_bf16(ldfrag(VTc, LD_T, 32 + fr, 64 + fq * 16), ldfrag(SC, LD_T, it * 16 + fr, 64 + fq * 16), dacc, 0, 0, 0); \
        const float den = __shfl(dacc[0], fr); \
        dn = 1.0f / fmaxf(fabsf(den), EMc[it * 16 + fr]); \
      } \
      { \
        const int i = it * 16 + fr; \
        const int ti = dir ? (SEQ - 1 - (n * 64 + i)) : (n * 64 + i); \
        const f32x4 o = oacc * dn; \
        *(u32x2*)(O + PIDX(tokbase + ti, ocol + vt * 16 + fq * 4)) = (u32x2){pk_hw(o[0], o[1]), pk_hw(o[2], o[3])}; \
      } \
      const int dts = (DK == 128) ? wid : (wid & 3); \
      const bf16x8 kf0 = ldfrag(KTc, LD_T, dts * 16 + fr, fq * 16), kf1 = ldfrag(KTc, LD_T, dts * 16 + fr, 64 + fq * 16); \
      const f32x4 dc = *(const f32x4*)(DECc + dts * 16 + fq * 4); \
_Pragma("unroll") \
      for (int s = 0; s < NST; ++s) { \
        const int dt = dts, vt2 = (DK == 128) ? s : (wid >> 2); \
        f32x4 acc = sacc[s] * dc; \
        acc = __builtin_amdgcn_mfma_f32_16x16x32_bf16(kf0, ldfrag(VTc, LD_T, vt2 * 16 + fr, fq * 16), acc, 0, 0, 0); \
        acc = __builtin_amdgcn_mfma_f32_16x16x32_bf16(kf1, ldfrag(VTc, LD_T, vt2 * 16 + fr, 64 + fq * 16), acc, 0, 0, 0); \
        sacc[s] = acc; \
        *(u32x2*)(STn + (vt2 * 16 + fr) * LD_D + (dt * 16 + fq * 4) * 2) = (u32x2){pk_hw(acc[0], acc[1]), pk_hw(acc[2], acc[3])}; \
      } \
    } \
    } \
    rr_cur = rr_next; \
    lds_barrier(); \
  } while (0)
  static_assert(NCH % 2 == 0, "chunk count must be even");
#pragma unroll 1
  for (int n2 = 0; n2 < NCH; n2 += 2) { SCAN_ITER(n2, R, Rv); SCAN_ITER(n2 + 1, Rn, Rvn); }
#undef SCAN_ITER
#undef A_LOAD
#undef A_PREP
}

template <int MIXER>
__device__ __forceinline__ void scan_dispatch2(unsigned char* lds, int wv, const Params& p, int id) {
  const int vs = id & 3, dir = (id >> 2) & 1, h = (id >> 3) & 3, b = id >> 5;
  scan_item2<MIXER>(lds, wv, p, b, h, dir, vs);
}
}

__device__ __forceinline__ void scan_phase2(unsigned char* lds, int wv, const Params& p, int layer) {
  for (int it0 = blockIdx.x; it0 < 256; it0 += gridDim.x) {
    const int xq = it0 & 7, yq = it0 >> 3, stream = (yq >> 2) * 8 + xq;
    const int item = (stream >> 5) * 128 + (stream & 31) * 4 + (yq & 3);
    if (layer == 0) { if (item < 128) scan2::scan_dispatch2<scan::MIX_A>(lds, wv, p, item); else scan2::scan_dispatch2<scan::MIX_B>(lds, wv, p, item - 128); }
    else { if (item < 128) scan2::scan_dispatch2<scan::MIX_D>(lds, wv, p, item); else scan2::scan_dispatch2<scan::MIX_C>(lds, wv, p, item - 128); }
    __syncthreads();
  }
}
#endif
#ifndef CPU_EMU
#define XB_BASE     2048
#define XB_TMO      (XB_BASE + 128)
#define XB_XCNT(j)  (XB_BASE + 256  + 64 * (j))
#define XB_XSUB(j)  (XB_BASE + 1280 + 64 * (j))
#define XB_XGEN(j)  (XB_BASE + 2304 + 64 * (j))
#define XB_TOP      (XB_BASE + 3328)
#define XB_TOPGEN   (XB_BASE + 3392)
#define XB_WORDS    3456
#define XB_SPIN_CAP (1u << 22)
#define XB_LDS_OFF  (LDS_BYTES - 16)
__device__ __forceinline__ unsigned xb_ld(unsigned* p)              { return __hip_atomic_load(p, __ATOMIC_RELAXED, __HIP_MEMORY_SCOPE_AGENT); }
__device__ __forceinline__ unsigned xb_add(unsigned* p, unsigned v) { return __hip_atomic_fetch_add(p, v, __ATOMIC_RELAXED, __HIP_MEMORY_SCOPE_AGENT); }
__device__ __forceinline__ unsigned xb_xcc_id() { return (unsigned)__builtin_amdgcn_s_getreg((3 << 11) | 20) & 0xFu; }
#define XB_SPIN(cond, bar) do { unsigned _sp = 0; while (cond) { __builtin_amdgcn_s_sleep(1); \
    if ((++_sp & 255u) == 0u) { if (xb_ld(&(bar)[XB_TMO])) break; if (_sp > XB_SPIN_CAP) { atomicAdd(&(bar)[XB_TMO], 1u); break; } } } } while (0)
__device__ __forceinline__ void grid_bar(unsigned* bar, unsigned char* lds_raw, int wv) {
  asm volatile("s_waitcnt vmcnt(0)" ::: "memory");
  __syncthreads();
  if (wv == 0 && lane_id() == 0) {
    volatile unsigned* st = (volatile unsigned*)(lds_raw + XB_LDS_OFF);
    __builtin_amdgcn_s_waitcnt(0);
    const unsigned x = xb_xcc_id();
    unsigned nloc = st[0], nx = st[1];
    if (nloc == 0u) {
      const unsigned G = gridDim.x; unsigned sum, cnt, mine, sp = 0u;
      for (;;) { sum = 0u; cnt = 0u; mine = 0u;
#pragma unroll
        for (unsigned j = 0; j < 16; ++j) { const unsigned c = xb_ld(&bar[XB_XCNT(j)]); sum += c; cnt += (c > 0u) ? 1u : 0u; mine = (j == x) ? c : mine; }
        if (sum == G) break;
        __builtin_amdgcn_s_sleep(1);
        if ((++sp & 255u) == 0u) { if (xb_ld(&bar[XB_TMO])) break; if (sp > XB_SPIN_CAP) { atomicAdd(&bar[XB_TMO], 1u); break; } } }
      nloc = mine > 0u ? mine : 1u; nx = cnt > 0u ? cnt : 1u; st[0] = nloc; st[1] = nx;
    }
    const unsigned old = xb_add(&bar[XB_XSUB(x)], 1u);
    const unsigned gen = old / nloc;
    if (old + 1u == (gen + 1u) * nloc) {
      __builtin_amdgcn_fence(__ATOMIC_RELEASE, "agent");
      asm volatile("s_waitcnt vmcnt(0)" ::: "memory");
      const unsigned og = xb_add(&bar[XB_TOP], 1u);
      const unsigned tg = og / nx;
      if (og + 1u == (tg + 1u) * nx) xb_add(&bar[XB_TOPGEN], 1u);
      else XB_SPIN(xb_ld(&bar[XB_TOPGEN]) == tg, bar);
      __builtin_amdgcn_fence(__ATOMIC_ACQUIRE, "agent");
      xb_add(&bar[XB_XGEN(x)], 1u);
      asm volatile("s_waitcnt vmcnt(0)" ::: "memory");
    } else {
      XB_SPIN(xb_ld(&bar[XB_XGEN(x)]) == gen, bar);
      __builtin_amdgcn_fence(__ATOMIC_ACQUIRE, "agent");
      asm volatile("s_waitcnt vmcnt(0)" ::: "memory");
    }
  }
  __syncthreads();
}
#if (PROBE_DUP & 16)
#define grid_bar(a, b, c) do { grid_bar(a, b, c); grid_bar(a, b, c); } while (0)
#endif

__global__ void __launch_bounds__(NTHREADS) mk_fwd(Params p) {
  extern __shared__ __attribute__((aligned(16))) unsigned char lds_raw[];
  cg::grid_group grid = cg::this_grid();
  const int G = gridDim.x, bid = blockIdx.x;
  const int wv = __builtin_amdgcn_readfirstlane(threadIdx.x >> 6);
  PG8_LAS unsigned char* lds = (PG8_LAS unsigned char*)lds_raw;
  unsigned char* ws = p.ws;

  if (threadIdx.x < 4) ((unsigned*)(lds_raw + XB_LDS_OFF))[threadIdx.x] = 0u;
  p0_prologue(lds_raw, wv, p);
#if (PROBE_DUP & 128)
  p0_prologue(lds_raw, wv, p);
#endif
  grid.sync();
  unsigned* bar = (unsigned*)(ws + WS_CTL);
  if (wv == 0 && lane_id() == 0) (void)xb_add(&bar[XB_XCNT(xb_xcc_id())], 1u);
  for (int layer = 0; layer < 2; ++layer) {
    { ProbInProj pr; pr.so.init(NTOK, layer == 0 ? PM_AB : PM_CD, G, bid); pr.A = (const char*)(ws + WS_HB); pr.Bt = (const char*)(ws + (layer == 0 ? WS_WIN_AB : WS_WIN_CD));
      pr.P = (bf16_t*)(ws + WS_R1); pr.bias = p.in[layer == 0 ? I_AB_B_IN : I_CD_B_IN]; pr.lb = (const float*)(ws + WS_LB); pr.layer = layer;
      pg8::gemm_phase(lds, pr, wv);
#if (PROBE_DUP & (1 | 2048))
      pg8::gemm_phase(lds, pr, wv);
#endif
      if (layer == 0) side_phase<32>(lds_raw, wv, p, 0); else side_phase<16>(lds_raw, wv, p, 1);
#if (PROBE_DUP & 256)
      if (layer == 0) side_phase<32>(lds_raw, wv, p, 0); else side_phase<16>(lds_raw, wv, p, 1);
#endif
 }
    grid_bar(bar, lds_raw, wv);
    if (layer == 1) { convd_phase(lds_raw, wv, p); grid_bar(bar, lds_raw, wv); }
    scan_phase2(lds_raw, wv, p, layer);
#if (PROBE_DUP & 2)
    scan_phase2(lds_raw, wv, p, layer);
#endif
#if (PROBE_DUP & 512)
    if (layer == 0) scan_phase2(lds_raw, wv, p, layer);
#endif
#if (PROBE_DUP & 1024)
    if (layer == 1) scan_phase2(lds_raw, wv, p, layer);
#endif
    grid_bar(bar, lds_raw, wv);
    headnorm_phase(lds_raw, wv, p, layer);
#if (PROBE_DUP & 8)
    headnorm_phase(lds_raw, wv, p, layer);
#endif
    grid_bar(bar, lds_raw, wv);
    { ProbOutProj pr; pr.so.init(NTOK, 1024, G, bid); pr.A = (const char*)(ws + WS_HB); pr.Bt = (const char*)(ws + (layer == 0 ? WS_WOUT_AB : WS_WOUT_CD)); pr.Y = (float*)(ws + WS_R2); pr.Hres = layer == 0 ? p.in[I_X] : p.out;
      pg8::gemm_phase(lds, pr, wv);
#if (PROBE_DUP & (1 | 16384))
      pg8::gemm_phase(lds, pr, wv);
#endif
      moe_weight_convert(lds_raw, wv, p, layer);
#if (PROBE_DUP & 4)
      moe_weight_convert(lds_raw, wv, p, layer);
#endif
 }
    grid_bar(bar, lds_raw, wv);
#if (PROBE_DUP & 32)
    ln_phase(lds_raw, wv, p, layer, 0, 1);
#endif
    ln_phase(lds_raw, wv, p, layer, 0);
    grid_bar(bar, lds_raw, wv);
    { ProbMoe1 pr; pr.mo.init((const int*)((const unsigned*)(ws + WS_CTL) + CW_CNT(layer)), 8, G, bid, lds_raw, wv);
      pr.A = (const char*)(ws + WS_HB); pr.W13 = (const char*)(ws + WS_WMOE); pr.list = (const int*)(ws + WS_LIST) + (size_t)layer * NEXP * NTOK; pr.H = (bf16_t*)(ws + WS_H);
      pg8::gemm_phase(lds, pr, wv);
#if (PROBE_DUP & (1 | 4096))
      pg8::gemm_phase(lds, pr, wv);
#endif
 }
    grid_bar(bar, lds_raw, wv);
    { ProbMoe2 pr; pr.mo.init((const int*)((const unsigned*)(ws + WS_CTL) + CW_CNT(layer)), 4, G, bid, lds_raw, wv);
      pr.A = (const char*)(ws + WS_H); pr.W2 = (const char*)(ws + WS_WMOE) + (size_t)NEXP * 2048 * 1024 * 2; pr.Y = (bf16_t*)(ws + WS_R2);
      pg8::gemm_phase(lds, pr, wv);
#if (PROBE_DUP & (1 | 8192))
      pg8::gemm_phase(lds, pr, wv);
#endif
 }
    grid_bar(bar, lds_raw, wv);
#if (PROBE_DUP & 64)
    ln_phase(lds_raw, wv, p, layer, 1, 1);
#endif
    ln_phase(lds_raw, wv, p, layer, 1);
    if (layer == 0) grid_bar(bar, lds_raw, wv);
  }
}

extern "C" void kernel_launch(void* const* d_in, const int* in_sizes, int n_in, void* d_out, int out_size, void* d_ws, size_t ws_size, hipStream_t stream) {
  static int grid_blocks = 0;
  if (grid_blocks == 0) {
    if (n_in != N_IN || ws_size < WS_END || out_size != NTOK * 1024) { fprintf(stderr, "kernel_launch: bad shapes: n_in %d ws %zu (need %zu) out %d\n", n_in, ws_size, (size_t)WS_END, out_size); grid_blocks = -1; return; }
    int dev = 0, cus = 0, per_cu = 0;
    hipGetDevice(&dev); hipDeviceGetAttribute(&cus, hipDeviceAttributeMultiprocessorCount, dev);
    if (hipFuncSetAttribute((const void*)mk_fwd, hipFuncAttributeMaxDynamicSharedMemorySize, LDS_BYTES) != hipSuccess) { fprintf(stderr, "kernel_launch: hipFuncSetAttribute failed\n"); grid_blocks = -1; return; }
    if (hipOccupancyMaxActiveBlocksPerMultiprocessor(&per_cu, (const void*)mk_fwd, NTHREADS, LDS_BYTES) != hipSuccess || per_cu < 1) { fprintf(stderr, "kernel_launch: occupancy query failed (%d)\n", per_cu); grid_blocks = -1; return; }
    grid_blocks = cus;
    (void)in_sizes;
  }
  if (grid_blocks < 0) return;
  Params p{};
  for (int i = 0; i < N_IN; ++i) p.in[i] = (const float*)d_in[i];
  p.out = (float*)d_out; p.ws = (unsigned char*)d_ws;
  void* args[] = {&p};
  hipError_t e = hipLaunchCooperativeKernel((const void*)mk_fwd, dim3(grid_blocks), dim3(NTHREADS), args, LDS_BYTES, stream);
  if (e != hipSuccess) fprintf(stderr, "cooperative launch failed: %s (grid %d)\n", hipGetErrorString(e), grid_blocks);
}
#endif
```

```cpp
#ifdef CPU_EMU
#include <cmath>
#include <cstdio>
#include <cstring>
#include <cstdlib>
#include <cstddef>
#define DEV
#define DEV_INLINE static inline
typedef void* hipStream_t;
#else
#include <hip/hip_runtime.h>
#include <hip/hip_bf16.h>
#include <cstdio>
#define DEV __device__ __forceinline__
#define DEV_INLINE __device__ __forceinline__
#endif
#ifndef PROBE_DUP
#define PROBE_DUP 0
#endif
#ifndef BATCH
#define BATCH 4
#endif
#ifndef SEQ
#define SEQ 8192
#endif
#define DM 1024
#define NTOK (BATCH * SEQ)
#define P_AB 4128
#define P_CD 3600
#define PM_AB 4096
#define PM_CD 3584
#define NEXP 16
#define ALPHA_F 1.4142135623730951f
#define LN_EPS_F 1e-5f
#define NORM_EPS_F 1e-6f
#define HROWS (2 * NTOK + NEXP * 256)

typedef unsigned short bf16_t;

DEV_INLINE float bf2f(bf16_t b) { unsigned u = ((unsigned)b) << 16; float f; memcpy(&f, &u, 4); return f; }
DEV_INLINE bf16_t f2bf(float f) { unsigned u; memcpy(&u, &f, 4); u += 0x7FFFu + ((u >> 16) & 1u); return (bf16_t)(u >> 16); }
DEV_INLINE float sigmoidf_(float x) { return 1.0f / (1.0f + expf(-x)); }
DEV_INLINE float siluf_(float x) { return x / (1.0f + expf(-x)); }
DEV_INLINE float logsigmoidf_(float x) { return fminf(x, 0.0f) - log1pf(expf(-fabsf(x))); }

#define AL256(x) (((size_t)(x) + 255) & ~(size_t)255)
#define WS_CTL    ((size_t)0)
#define WS_HB     ((size_t)65536)
#define WS_R1     (WS_HB + (size_t)NTOK * 1024 * 2)
#define R1_P_BYTES ((size_t)NTOK * 4096 * 2)
#define R1_MIN    (AL256((size_t)HROWS * 1024 * 2) + (size_t)NEXP * 3072 * 1024 * 2)
#define R1_PL     (R1_P_BYTES + (size_t)NTOK * 512 * 2)
#define R1_BYTES  (R1_PL > R1_MIN ? R1_PL : R1_MIN)
#define WS_LFB    (WS_R1 + R1_P_BYTES)
#define WS_H      (WS_R1)
#define WS_WMOE   (WS_R1 + AL256((size_t)HROWS * 1024 * 2))
#define WMOE_BYTES ((size_t)NEXP * 3072 * 1024 * 2)
#define WS_R2     (WS_R1 + R1_BYTES)
#define R2_BYTES  ((size_t)HROWS * 1024 * 2 > (size_t)NTOK * 1024 * 4 ? (size_t)HROWS * 1024 * 2 : (size_t)NTOK * 1024 * 4)
#define WS_SIDE   (WS_R2 + AL256(R2_BYTES))
#define WS_OSIDE  (WS_SIDE + (size_t)NTOK * 32 * 4)
#define WS_WIN_AB (WS_OSIDE + (size_t)2 * NTOK * 8 * 4)
#define WS_WIN_CD (WS_WIN_AB + (size_t)4128 * 1024 * 2)
#define WS_WOUT_AB (WS_WIN_CD + (size_t)3600 * 1024 * 2)
#define WS_WOUT_CD (WS_WOUT_AB + (size_t)1024 * 1024 * 2)
#define WS_ROPE   (WS_WOUT_CD + (size_t)1024 * 1024 * 2)
#define WS_LB     (WS_ROPE + (size_t)SEQ * 64 * 4)
#define WS_LIST   (WS_LB + 4096)
#define WS_ASSIGN (WS_LIST + (size_t)2 * NEXP * NTOK * 4)
#define WS_GATE   (WS_ASSIGN + (size_t)NTOK * 16)
#define WS_END    (WS_GATE + (size_t)NTOK * 8)
#define CW_CNT(layer) (64 + 256 * (layer))

#define PSTRIDE 4096
#define PIDX(tok, col) ((((size_t)((col) >> 7)) * NTOK + (size_t)(tok)) * 128 + (size_t)((col) & 127))

enum { I_X, I_AB_W_IN, I_AB_B_IN, I_HGRN_LB, I_GK_UP, I_GK_B, I_HGRN_NORM, I_GLA_NORM, I_AB_W_OUT,
       I_CD_W_IN, I_CD_B_IN, I_CONV_W, I_CONV_B, I_FGATE_B, I_RET_NORM, I_MLSTM_NORM, I_CD_W_OUT,
       I_LN_MIX_G, I_LN_MIX_B, I_LN_FFN_G, I_LN_FFN_B, I_ROUTER_W, I_ROUTER_B, I_MOE_W1, I_MOE_W3, I_MOE_W2, N_IN };

struct Params {
  const float* in[N_IN];
  float* out;
  unsigned char* ws;
};

DEV_INLINE float epi_ab(int col, float v, const float* lb) {
  if (col < 512) return siluf_(v);
  if (col < 1536) { float l = lb[(col - 512) & 511]; return logf(l + (1.0f - l) * sigmoidf_(v)); }
  if (col >= 2560 && col < 2816) return v * 0.125f;
  return v;
}

DEV_INLINE void route_from_logits(const float* lg, const float* rb, int* e_out, float* g_out) {
  float mx = lg[0];
#pragma unroll
  for (int e = 1; e < 16; ++e) mx = fmaxf(mx, lg[e]);
  float sc[16]; float sum = 0.f;
#pragma unroll
  for (int e = 0; e < 16; ++e) { sc[e] = expf(lg[e] - mx); sum += sc[e]; }
  float inv = 1.0f / sum;
  float best_gs = -1e30f; int be1 = 0, be2 = 1; float bs1 = 0.f, bs2 = 0.f;
#pragma unroll
  for (int gq = 0; gq < 4; ++gq) {
    float m1 = -1e30f, m2 = -1e30f, s1 = 0.f, s2 = 0.f; int i1 = 0, i2 = 0;
#pragma unroll
    for (int i = 0; i < 4; ++i) {
      float s = sc[gq * 4 + i] * inv; float v = s + rb[gq * 4 + i];
      if (v > m1) { m2 = m1; i2 = i1; s2 = s1; m1 = v; i1 = gq * 4 + i; s1 = s; }
      else if (v > m2) { m2 = v; i2 = gq * 4 + i; s2 = s; }
    }
    float gs = m1 + m2;
    if (gs > best_gs) { best_gs = gs; be1 = i1; be2 = i2; bs1 = s1; bs2 = s2; }
  }
  e_out[0] = be1; e_out[1] = be2; g_out[0] = bs1 / (bs1 + bs2); g_out[1] = bs2 / (bs1 + bs2);
}
#ifndef CPU_EMU
namespace pg8 {
#define PG8_LAS __attribute__((address_space(3)))
typedef short bf16x8 __attribute__((ext_vector_type(8)));
typedef float f32x4 __attribute__((ext_vector_type(4)));
typedef unsigned u32x4 __attribute__((ext_vector_type(4)));
typedef unsigned u32x2 __attribute__((ext_vector_type(2)));
constexpr int BM = 256, BK = 64, HALF = 128, HTB = HALF * BK * 2, STAGE_BYTES = 8 * HTB, NXCD = 8, WGM = 8, GK = 1024;

__device__ __forceinline__ int lds_byte(int r, int c) { const int st = (r >> 4) * 2 + (c >> 5), rr = r & 15, cc = c & 31, ob = rr * 64 + cc * 2; return st * 1024 + (ob ^ (((ob >> 9) & 1) << 5)); }
__device__ __forceinline__ void stage_rc(int b, int& R, int& C) { const int st = b / 1024, sb = b % 1024, swz = sb ^ (((sb >> 9) & 1) << 5); R = (st >> 1) * 16 + swz / 64; C = (st & 1) * 32 + (swz % 64) / 2; }
__device__ __forceinline__ int perm32(int rho) { const int n = rho >> 4, i = rho & 15; return 8 * (i >> 2) + 4 * n + (i & 3); }
__device__ __forceinline__ unsigned cvt_pk_bf16(float lo, float hi) { unsigned r; asm volatile("v_cvt_pk_bf16_f32 %0, %1, %2" : "=v"(r) : "v"(lo), "v"(hi)); return r; }

struct Unit { int pm, pn, e, row0, ne, ui; };

struct StaticOrder {
  int nM, nN, nwg, G, c;
  __device__ void init(int M, int N, int G_, int c_) { nM = M / BM; nN = N / BM; nwg = nM * nN; G = G_; c = c_; }
  __device__ bool next(int i, Unit& u) const {
    const long L = (long)i * G + c; if (L >= nwg) return false;
    int wgid = (int)L; { const int q = nwg / NXCD, r = nwg % NXCD, xcd = wgid % NXCD, off = wgid / NXCD; wgid = (xcd < r ? xcd * (q + 1) : r * (q + 1) + (xcd - r) * q) + off; }
    const int nig = WGM * nN, gid = wgid / nig, fm = gid * WGM, gsz = (nM - fm) < WGM ? (nM - fm) : WGM;
    u.pm = fm + ((wgid % nig) % gsz); u.pn = (wgid % nig) / gsz; u.e = 0; u.row0 = u.pm * BM; u.ne = 0; u.ui = i; return true;
  }
};

template <class Prob>
__device__ __forceinline__ void gemm_phase(PG8_LAS unsigned char* lds, const Prob& S, int wv) {
  int wv_ = wv; asm volatile("" : "+s"(wv_));
  int l_; asm volatile("v_mbcnt_lo_u32_b32 %0, -1, 0\n\tv_mbcnt_hi_u32_b32 %0, -1, %0" : "=v"(l_));
  int tid_ = wv_ * 64 + l_;
  const int tid = tid_, wid = __builtin_amdgcn_readfirstlane(tid >> 6), lane = tid & 63, wr = wid >> 2, wc = wid & 3, fr = lane & 15, fq = lane >> 4;
  constexpr int K = GK, nt = K / BK;
  int sR[2], sC[2]; unsigned voffB[2];
#pragma unroll
  for (int i = 0; i < 2; ++i) { int R, C; stage_rc(tid * 16 + i * 8192, R, C); sR[i] = R; sC[i] = C; const int Rb = Prob::PERM ? ((R & ~31) + perm32(R & 31)) : R; voffB[i] = (unsigned)(Rb * K + C) * 2u; }
  const size_t kstep = (size_t)(BK * 2);
  const size_t hstep = (size_t)HALF * K * 2;
  const unsigned ldsw = (unsigned)wid * 1024u;
  const int aoff = lds_byte(wr * 64 + fr, fq * 8), boff = lds_byte(wc * 32 + fr, fq * 8);
#define PG8_SA(b, h) (((b) * 2 + (h)) * HTB)
#define PG8_SB(b, h) ((4 + (b) * 2 + (h)) * HTB)
#define PG8_STAGE(bufoff, gbase, voff) do { _Pragma("unroll") for (int _i = 0; _i < 2; ++_i) \
    __builtin_amdgcn_global_load_lds((const unsigned*)((const char*)(gbase) + (voff)[_i]), (PG8_LAS unsigned*)(lds + (bufoff) + ldsw + _i * 8192), 16, 0, 0); } while (0)
#define PG8_LDA(dst, b, h) do { _Pragma("unroll") for (int m = 0; m < 4; ++m) _Pragma("unroll") for (int k = 0; k < 2; ++k) dst[m][k] = *(const PG8_LAS bf16x8*)(lds + PG8_SA(b, h) + aoff + m * 2048 + k * 1024); } while (0)
#define PG8_LDB(dst, b, h) do { _Pragma("unroll") for (int n = 0; n < 2; ++n) _Pragma("unroll") for (int k = 0; k < 2; ++k) dst[n][k] = *(const PG8_LAS bf16x8*)(lds + PG8_SB(b, h) + boff + n * 2048 + k * 1024); } while (0)
#define PG8_MMA(ai, bj, At, Bt) do { __builtin_amdgcn_s_setprio(1); _Pragma("unroll") for (int m = 0; m < 4; ++m) _Pragma("unroll") for (int n = 0; n < 2; ++n) _Pragma("unroll") for (int k = 0; k < 2; ++k) \
    acc[ai][bj][m][n] = __builtin_amdgcn_mfma_f32_16x16x32_bf16(Bt[n][k], At[m][k], acc[ai][bj][m][n], 0, 0, 0); __builtin_amdgcn_s_setprio(0); } while (0)
#define PG8_WAIT_V(n) asm volatile("s_waitcnt vmcnt(" #n ")" ::: "memory")
#define PG8_WAIT_L(n) asm volatile("s_waitcnt lgkmcnt(" #n ")" ::: "memory")
#define PG8_BAR __builtin_amdgcn_s_barrier()
#define PG8_SCHED __builtin_amdgcn_sched_barrier(0)
  Unit cur, nxt; int ui = 0;
  if (!S.next(0, cur)) return;
  f32x4 acc[2][2][4][2];
#pragma unroll
  for (int a = 0; a < 2; ++a)
#pragma unroll
    for (int b = 0; b < 2; ++b)
#pragma unroll
      for (int m = 0; m < 4; ++m)
#pragma unroll
        for (int n = 0; n < 2; ++n) acc[a][b][m][n] = (f32x4){0.f, 0.f, 0.f, 0.f};
  bf16x8 At[4][2], B0[2][2], B1[2][2];
  unsigned oc0[2], oc1[2], on0[2], on1[2];
#pragma unroll
  for (int i = 0; i < 2; ++i) { oc0[i] = S.a_off(cur, sR[i]) + (unsigned)sC[i] * 2u; oc1[i] = S.a_off(cur, HALF + sR[i]) + (unsigned)sC[i] * 2u; }
  const char* const Ab = S.a_base();
  const char* cB = S.b_base(cur);
  PG8_STAGE(PG8_SB(0, 0), cB, voffB); PG8_STAGE(PG8_SB(0, 1), cB + hstep, voffB); PG8_STAGE(PG8_SA(0, 0), Ab, oc0); PG8_STAGE(PG8_SA(0, 1), Ab, oc1);
  if (wr == 1) PG8_BAR;
  PG8_WAIT_V(2); PG8_BAR;
  PG8_STAGE(PG8_SB(1, 0), cB + kstep, voffB); PG8_STAGE(PG8_SA(1, 0), Ab + kstep, oc0); PG8_STAGE(PG8_SB(1, 1), cB + hstep + kstep, voffB);
  PG8_WAIT_V(6); PG8_BAR;
  for (;;) {
    const bool has_next = S.next(ui + 1, nxt);
    const char* nB = cB;
    if (has_next) {
      nB = S.b_base(nxt);
      int l2_; asm volatile("v_mbcnt_lo_u32_b32 %0, -1, 0\n\tv_mbcnt_hi_u32_b32 %0, -1, %0" : "=v"(l2_));
      const int tid2 = wid * 64 + l2_;
#pragma unroll
      for (int i = 0; i < 2; ++i) { int R, C; stage_rc(tid2 * 16 + i * 8192, R, C); on0[i] = S.a_off(nxt, R) + (unsigned)C * 2u; on1[i] = S.a_off(nxt, HALF + R) + (unsigned)C * 2u; }
    } else {
#pragma unroll
      for (int i = 0; i < 2; ++i) { on0[i] = oc0[i]; on1[i] = oc1[i]; }
    }
    for (int t = 0; t < nt; t += 2) {
      const bool last = (t == nt - 2);
      const char* a1 = Ab + (size_t)(t + 1) * kstep;
      const char* a2 = last ? Ab : Ab + (size_t)(t + 2) * kstep; const char* b2 = last ? nB : cB + (size_t)(t + 2) * kstep;
      const char* a3 = a2 + kstep; const char* b3 = b2 + kstep;
      unsigned o20[2], o21[2];
#pragma unroll
      for (int i = 0; i < 2; ++i) { o20[i] = last ? on0[i] : oc0[i]; o21[i] = last ? on1[i] : oc1[i]; }
      PG8_LDB(B0, 0, 0); PG8_LDB(B1, 0, 1); PG8_SCHED; PG8_LDA(At, 0, 0); PG8_STAGE(PG8_SA(1, 1), a1, oc1);
      PG8_WAIT_V(8); PG8_WAIT_L(0); PG8_BAR; PG8_MMA(0, 0, At, B0); PG8_MMA(0, 1, At, B1); PG8_BAR; PG8_SCHED;
      PG8_LDA(At, 0, 1); PG8_STAGE(PG8_SB(0, 0), b2, voffB); PG8_STAGE(PG8_SB(0, 1), b2 + hstep, voffB); PG8_STAGE(PG8_SA(0, 0), a2, o20);
      PG8_WAIT_V(8); PG8_WAIT_L(0); PG8_BAR; PG8_MMA(1, 0, At, B0); PG8_MMA(1, 1, At, B1); PG8_BAR; PG8_SCHED;
      PG8_LDB(B0, 1, 0); PG8_LDB(B1, 1, 1); PG8_SCHED; PG8_LDA(At, 1, 0); PG8_STAGE(PG8_SA(0, 1), a2, o21);
      PG8_WAIT_V(8); PG8_WAIT_L(0); PG8_BAR; PG8_MMA(0, 0, At, B0); PG8_MMA(0, 1, At, B1); PG8_BAR; PG8_SCHED;
      PG8_LDA(At, 1, 1); PG8_STAGE(PG8_SB(1, 0), b3, voffB); PG8_STAGE(PG8_SB(1, 1), b3 + hstep, voffB); PG8_STAGE(PG8_SA(1, 0), a3, o20);
      PG8_WAIT_V(8); PG8_WAIT_L(0); PG8_BAR; PG8_MMA(1, 0, At, B0); PG8_MMA(1, 1, At, B1); PG8_BAR; PG8_SCHED;
    }
    if (wr == 0) PG8_BAR;
    { int l3_; asm volatile("v_mbcnt_lo_u32_b32 %0, -1, 0\n\tv_mbcnt_hi_u32_b32 %0, -1, %0" : "=v"(l3_));
      S.epi(acc, cur, wr, wc, l3_ & 15, l3_ >> 4); }
    if (!has_next) break;
#pragma unroll
    for (int a = 0; a < 2; ++a)
#pragma unroll
      for (int b = 0; b < 2; ++b)
#pragma unroll
        for (int m = 0; m < 4; ++m)
#pragma unroll
          for (int n = 0; n < 2; ++n) acc[a][b][m][n] = (f32x4){0.f, 0.f, 0.f, 0.f};
    cur = nxt; cB = nB; ++ui;
#pragma unroll
    for (int i = 0; i < 2; ++i) { oc0[i] = on0[i]; oc1[i] = on1[i]; }
    if (wr == 1) PG8_BAR;
  }
  PG8_WAIT_V(0);
  PG8_BAR;
#undef PG8_SA
#undef PG8_SB
#undef PG8_STAGE
#undef PG8_LDA
#undef PG8_LDB
#undef PG8_MMA
#undef PG8_WAIT_V
#undef PG8_WAIT_L
#undef PG8_BAR
#undef PG8_SCHED
}
}
#endif
#ifndef CPU_EMU
#include <hip/hip_cooperative_groups.h>
namespace cg = cooperative_groups;
#define LAS __attribute__((address_space(3)))
#define NTHREADS 512
#define LDS_BYTES (154 * 1024)
typedef float f32x4 __attribute__((ext_vector_type(4)));
typedef short bf16x8 __attribute__((ext_vector_type(8)));
typedef unsigned u32x4 __attribute__((ext_vector_type(4)));
typedef unsigned u32x2 __attribute__((ext_vector_type(2)));

struct Ctx { int tid, lane, wid, G, bid; unsigned char* lds; };
__device__ __forceinline__ int lane_id() { int l; asm volatile("v_mbcnt_lo_u32_b32 %0, -1, 0\n\tv_mbcnt_hi_u32_b32 %0, -1, %0" : "=v"(l)); return l; }
__device__ __forceinline__ int opaque_tid(int wv) { int w = wv; asm volatile("" : "+s"(w)); int t = w * 64 + lane_id(); asm volatile("" : "+v"(t)); return t; }
__device__ __forceinline__ Ctx make_ctx(unsigned char* lds, int wv) { Ctx c; c.tid = opaque_tid(wv); c.lane = c.tid & 63; c.wid = __builtin_amdgcn_readfirstlane(c.tid >> 6); c.G = gridDim.x; c.bid = blockIdx.x; c.lds = lds; return c; }

__device__ __forceinline__ float wave_sum(float x) {
  x += __builtin_bit_cast(float, __builtin_amdgcn_update_dpp(0, __builtin_bit_cast(int, x), 0x111, 0xf, 0xf, false));
  x += __builtin_bit_cast(float, __builtin_amdgcn_update_dpp(0, __builtin_bit_cast(int, x), 0x112, 0xf, 0xf, false));
  x += __builtin_bit_cast(float, __builtin_amdgcn_update_dpp(0, __builtin_bit_cast(int, x), 0x114, 0xf, 0xf, false));
  x += __builtin_bit_cast(float, __builtin_amdgcn_update_dpp(0, __builtin_bit_cast(int, x), 0x118, 0xf, 0xf, false));
  x += __builtin_bit_cast(float, __builtin_amdgcn_update_dpp(0, __builtin_bit_cast(int, x), 0x142, 0xa, 0xf, false));
  x += __builtin_bit_cast(float, __builtin_amdgcn_update_dpp(0, __builtin_bit_cast(int, x), 0x143, 0xc, 0xf, false));
  return __builtin_bit_cast(float, __builtin_amdgcn_readlane(__builtin_bit_cast(int, x), 63));
}
__device__ __forceinline__ float fsigmoid(float x) { return __builtin_amdgcn_rcpf(1.0f + __builtin_amdgcn_exp2f(-1.4426950408889634f * x)); }
__device__ __forceinline__ float fsilu(float x) { return x * fsigmoid(x); }
__device__ __forceinline__ float flog2sigmoid(float x) { const float y = x * 1.4426950408889634f; return fminf(y, 0.f) - __builtin_amdgcn_logf(1.0f + __builtin_amdgcn_exp2f(-fabsf(y))); }
typedef float f32x2_t __attribute__((ext_vector_type(2)));
typedef __bf16 bf16x2_t __attribute__((ext_vector_type(2)));
__device__ __forceinline__ unsigned pk_hw(float a, float b) { const f32x2_t v = {a, b}; return __builtin_bit_cast(unsigned, __builtin_convertvector(v, bf16x2_t)); }
__device__ __forceinline__ unsigned pk2(float a, float b) { return pk_hw(a, b); }
__device__ __forceinline__ void unpack8(u32x4 w, float* f) {
  f[0] = __uint_as_float(w.x << 16); f[1] = __uint_as_float(w.x & 0xffff0000u); f[2] = __uint_as_float(w.y << 16); f[3] = __uint_as_float(w.y & 0xffff0000u);
  f[4] = __uint_as_float(w.z << 16); f[5] = __uint_as_float(w.z & 0xffff0000u); f[6] = __uint_as_float(w.w << 16); f[7] = __uint_as_float(w.w & 0xffff0000u);
}

__device__ __forceinline__ void transpose_job(const Ctx& c, const float* src, int N, bf16_t* dst, int rs, int ro, int tile0, int tile_stride) {
  float* t = (float*)c.lds;
  const int ntn = (N + 63) / 64, ntiles = ntn * 16;
  for (int tl = tile0; tl < ntiles; tl += tile_stride) {
    const int kt = tl / ntn, nt_ = tl % ntn, k0 = kt * 64, n0 = nt_ * 64;
    __syncthreads();
#pragma unroll
    for (int i = 0; i < 8; ++i) { const int idx = c.tid + i * 512, kk = idx >> 6, nn = idx & 63; t[kk * 65 + nn] = (n0 + nn < N) ? src[(size_t)(k0 + kk) * N + n0 + nn] : 0.f; }
    __syncthreads();
#pragma unroll
    for (int i = 0; i < 4; ++i) { const int idx = c.tid + i * 512, nn = idx >> 5, kp = (idx & 31) * 2;
      if (n0 + nn < N) *(unsigned*)(dst + (size_t)((n0 + nn) * rs + ro) * 1024 + k0 + kp) = pk2(t[kp * 65 + nn], t[(kp + 1) * 65 + nn]); }
  }
  __syncthreads();
}
__device__ __forceinline__ void p0_prologue(unsigned char* lds_, int wv, const Params& p) {
  const Ctx c = make_ctx(lds_, wv);
  unsigned char* ws = p.ws;
  if (c.bid == 0) { ((unsigned*)(ws + WS_CTL))[64 + c.tid] = 0u; }
  if (c.bid == 0) { for (int i = c.tid; i < 3456; i += NTHREADS) ((unsigned*)(ws + WS_CTL))[2048 + i] = 0u; }
  { const float* x = p.in[I_X]; bf16_t* hb = (bf16_t*)(ws + WS_HB);
    for (size_t i = (size_t)c.bid * NTHREADS + c.tid; i < (size_t)NTOK * 1024 / 8; i += (size_t)c.G * NTHREADS) {
      const f32x4 a = __builtin_nontemporal_load((const f32x4*)(x + i * 8)), b = __builtin_nontemporal_load((const f32x4*)(x + i * 8 + 4));
      u32x4 w; w.x = pk2(a[0], a[1]); w.y = pk2(a[2], a[3]); w.z = pk2(b[0], b[1]); w.w = pk2(b[2], b[3]);
      *(u32x4*)(hb + i * 8) = w; } }
  transpose_job(c, p.in[I_AB_W_IN], P_AB, (bf16_t*)(ws + WS_WIN_AB), 1, 0, c.bid, c.G);
  transpose_job(c, p.in[I_CD_W_IN], P_CD, (bf16_t*)(ws + WS_WIN_CD), 1, 0, c.bid, c.G);
  transpose_job(c, p.in[I_AB_W_OUT], 1024, (bf16_t*)(ws + WS_WOUT_AB), 1, 0, c.bid, c.G);
  transpose_job(c, p.in[I_CD_W_OUT], 1024, (bf16_t*)(ws + WS_WOUT_CD), 1, 0, c.bid, c.G);
  { float* rope = (float*)(ws + WS_ROPE);
    for (int i = c.bid * NTHREADS + c.tid; i < SEQ * 32; i += c.G * NTHREADS) { const int t = i >> 5, f = i & 31;
      const float freq = powf(10000.0f, -(float)f / 32.0f); const float ang = (float)t * freq; rope[i * 2] = cosf(ang); rope[i * 2 + 1] = sinf(ang); }
    if (c.bid == 1) { const float* hl = p.in[I_HGRN_LB]; float* lb = (float*)(ws + WS_LB);
      const int cc = c.tid; const float a0 = hl[cc], a1 = hl[512 + cc], a2 = hl[1024 + cc]; const float mx = fmaxf(a0, fmaxf(a1, a2));
      const float e0 = expf(a0 - mx), e1 = expf(a1 - mx), e2 = expf(a2 - mx); lb[cc] = e0 / (e0 + e1 + e2); } }
}
__device__ __forceinline__ void moe_weight_convert(unsigned char* lds_, int wv, const Params& p, int layer) {
  const Ctx c = make_ctx(lds_, wv);
  bf16_t* w13 = (bf16_t*)(p.ws + WS_WMOE); bf16_t* w2 = w13 + (size_t)NEXP * 2048 * 1024;
  const size_t lo = (size_t)layer * NEXP * 1024 * 1024;
  const float* W1 = p.in[I_MOE_W1] + lo; const float* W3 = p.in[I_MOE_W3] + lo; const float* W2 = p.in[I_MOE_W2] + lo;
  float* t = (float*)c.lds;
  constexpr int NT = 48 * 128;
  const int lk = c.tid >> 5, ln4 = (c.tid & 31) * 4;
  const int sn = c.tid & 127, sk = (c.tid >> 7) * 8;
  f32x4 r[4];
#define MW_SRC(g_) ((((g_) >> 7) % 3 == 0 ? W1 : (((g_) >> 7) % 3 == 1 ? W3 : W2)) + (size_t)(((g_) >> 7) / 3) * 1048576 + (size_t)((((g_) & 127) >> 3) * 64) * 1024 + ((g_) & 7) * 128)
#define MW_LOAD(g_) do { const float* s_ = MW_SRC(g_); _Pragma("unroll") for (int i = 0; i < 4; ++i) r[i] = __builtin_nontemporal_load((const f32x4*)(s_ + (size_t)(lk + 16 * i) * 1024 + ln4)); } while (0)
  int g0 = c.bid;
  if (g0 < NT) MW_LOAD(g0);
  for (; g0 < NT; g0 += c.G) {
    __syncthreads();
#pragma unroll
    for (int i = 0; i < 4; ++i) { float* d = t + (lk + 16 * i) * 129 + ln4; d[0] = r[i][0]; d[1] = r[i][1]; d[2] = r[i][2]; d[3] = r[i][3]; }
    __syncthreads();
    const int gn = g0 + c.G;
    if (gn < NT) MW_LOAD(gn);
    const int m = g0 >> 7, e = m / 3, which = m % 3, k0 = ((g0 & 127) >> 3) * 64, n0 = (g0 & 7) * 128;
    bf16_t* drow = (which == 2) ? w2 + ((size_t)e * 1024 + n0 + sn) * 1024 : w13 + ((size_t)e * 2048 + 2 * (n0 + sn) + which) * 1024;
#pragma unroll
    for (int j = 0; j < 2; ++j) { const int kk = sk + 32 * j; const float* s = t + kk * 129 + sn;
      u32x4 w; w.x = pk2(s[0], s[129]); w.y = pk2(s[2 * 129], s[3 * 129]); w.z = pk2(s[4 * 129], s[5 * 129]); w.w = pk2(s[6 * 129], s[7 * 129]);
      *(u32x4*)(drow + k0 + kk) = w; }
  }
#undef MW_SRC
#undef MW_LOAD
  __syncthreads();
}

struct ProbInProj {
  static constexpr bool PERM = true;
  pg8::StaticOrder so; const char* A; const char* Bt; bf16_t* P; const float* bias; const float* lb; int layer;
  __device__ __forceinline__ bool next(int i, pg8::Unit& u) const { return so.next(i, u); }
  __device__ __forceinline__ const char* a_base() const { return A; }
  __device__ __forceinline__ unsigned a_off(const pg8::Unit& u, int r) const { return (unsigned)(u.pm * 256 + r) * 2048u; }
  __device__ __forceinline__ const char* b_base(const pg8::Unit& u) const { return Bt + (size_t)u.pn * 256 * 2048; }
  __device__ __forceinline__ void epi(const f32x4 (&acc)[2][2][4][2], const pg8::Unit& u, int wr, int wc, int fr, int fq) const {
    const int row0 = u.row0 + wr * 64 + fr, colb = u.pn * 256 + wc * 32 + 8 * fq;
    int mode = 0;
    if (layer == 0) { mode = u.pn < 2 ? 1 : (u.pn < 6 ? 2 : (u.pn == 10 ? 3 : 0)); }
#pragma unroll
    for (int bj = 0; bj < 2; ++bj) {
      const int col0 = colb + bj * 128;
      const f32x4 b0 = *(const f32x4*)(bias + col0), b1 = *(const f32x4*)(bias + col0 + 4);
      f32x4 l0 = (f32x4){0.f, 0.f, 0.f, 0.f}, l1 = l0;
      if (mode == 2) { l0 = *(const f32x4*)(lb + ((col0 - 512) & 511)); l1 = *(const f32x4*)(lb + ((col0 - 512) & 511) + 4); }
#pragma unroll
      for (int ai = 0; ai < 2; ++ai)
#pragma unroll
        for (int m = 0; m < 4; ++m) {
          f32x4 v0 = acc[ai][bj][m][0] + b0, v1 = acc[ai][bj][m][1] + b1;
          if (mode == 1) {
#pragma unroll
            for (int j = 0; j < 4; ++j) { v0[j] = fsilu(v0[j]); v1[j] = fsilu(v1[j]); }
          } else if (mode == 2) {
#pragma unroll
            for (int j = 0; j < 4; ++j) { v0[j] = __builtin_amdgcn_logf(l0[j] + (1.0f - l0[j]) * fsigmoid(v0[j])); v1[j] = __builtin_amdgcn_logf(l1[j] + (1.0f - l1[j]) * fsigmoid(v1[j])); }
          } else if (mode == 3) { v0 *= 0.125f; v1 *= 0.125f; }
          u32x4 w; w.x = pk2(v0[0], v0[1]); w.y = pk2(v0[2], v0[3]); w.z = pk2(v1[0], v1[1]); w.w = pk2(v1[2], v1[3]);
          *(u32x4*)(P + PIDX(row0 + ai * 128 + m * 16, col0)) = w;
        }
    }
  }
};
struct ProbOutProj {
  static constexpr bool PERM = false;
  pg8::StaticOrder so; const char* A; const char* Bt; float* Y; const float* Hres;
  __device__ __forceinline__ bool next(int i, pg8::Unit& u) const { return so.next(i, u); }
  __device__ __forceinline__ const char* a_base() const { return A; }
  __device__ __forceinline__ unsigned a_off(const pg8::Unit& u, int r) const { return (unsigned)(u.pm * 256 + r) * 2048u; }
  __device__ __forceinline__ const char* b_base(const pg8::Unit& u) const { return Bt + (size_t)u.pn * 256 * 2048; }
  __device__ __forceinline__ void epi(const f32x4 (&acc)[2][2][4][2], const pg8::Unit& u, int wr, int wc, int fr, int fq) const {
    const int row0 = u.row0 + wr * 64 + fr, col0 = u.pn * 256 + wc * 32 + 4 * fq;
#pragma unroll
    for (int ai = 0; ai < 2; ++ai)
#pragma unroll
      for (int m = 0; m < 4; ++m) { const size_t ro = (size_t)(row0 + ai * 128 + m * 16) * 1024 + col0; float* rowp = Y + ro; const float* hp = Hres + ro;
#pragma unroll
        for (int bj = 0; bj < 2; ++bj)
#pragma unroll
          for (int n = 0; n < 2; ++n) *(f32x4*)(rowp + bj * 128 + n * 16) = acc[ai][bj][m][n] + ALPHA_F * *(const f32x4*)(hp + bj * 128 + n * 16); }
  }
};
#define MOE_TAB_OFF (128 * 1024)
struct MoeOrder {
  const int* tab;
  __device__ __forceinline__ void init(const int* cnt, int ntn, int G, int c, unsigned char* lds, int wv) {
    int* t = (int*)(lds + MOE_TAB_OFF);
    const int tid = opaque_tid(wv);
    if (tid < 64) {
      int pad = 0, found = 0, ue = 0, upn = 0, upm = 0, urow = 0, une = 0;
      if ((G & 7) == 0) {
        const int x = c & 7; int q = tid * (G >> 3) + (c >> 3);
        for (int e = 0; e < NEXP; ++e) { const int n = cnt[e * 16], mt = (n + 255) >> 8; const int r = ((x - e) % 8 + 8) % 8; const int m = mt > r ? (mt - r - 1) / 8 + 1 : 0; const int units = m * ntn;
          if (!found && q < units) { ue = e; upm = r + 8 * (q % m); upn = q / m; urow = pad + upm * 256; une = n; found = 1; }
          if (!found) { q -= units; pad += mt * 256; } }
      } else {
        int L = tid * G + c;
        for (int e = 0; e < NEXP; ++e) { const int n = cnt[e * 16], mt = (n + 255) >> 8, tiles = mt * ntn;
          if (!found && L < tiles) { ue = e; upn = L / mt; upm = L % mt; urow = pad + upm * 256; une = n; found = 1; }
          if (!found) { L -= tiles; pad += mt * 256; } }
      }
      t[tid * 8 + 0] = found; t[tid * 8 + 1] = ue; t[tid * 8 + 2] = upn; t[tid * 8 + 3] = upm; t[tid * 8 + 4] = urow; t[tid * 8 + 5] = une;
    }
    __syncthreads();
    tab = t;
  }
  __device__ __forceinline__ bool next(int i, pg8::Unit& u) const {
    if (i >= 64) return false;
    const int* t = tab + i * 8;
    if (!__builtin_amdgcn_readfirstlane(t[0])) return false;
    u.e = __builtin_amdgcn_readfirstlane(t[1]); u.pn = __builtin_amdgcn_readfirstlane(t[2]); u.pm = __builtin_amdgcn_readfirstlane(t[3]);
    u.row0 = __builtin_amdgcn_readfirstlane(t[4]); u.ne = __builtin_amdgcn_readfirstlane(t[5]); u.ui = i; return true;
  }
};
struct ProbMoe1 {
  static constexpr bool PERM = true;
  MoeOrder mo; const char* A; const char* W13; const int* list; bf16_t* H; const int* ltok;
  __device__ __forceinline__ void stage_tokens(unsigned char* lds, int wv) {
    int* lt = (int*)(lds + MOE_TAB_OFF + 2048);
    const int tid = opaque_tid(wv);
    pg8::Unit u;
    for (int i = 0; i < 16 && mo.next(i, u); ++i) { if (tid < 256) { const int rr = u.pm * 256 + tid; lt[i * 256 + tid] = rr < u.ne ? list[u.e * NTOK + rr] : 0; } }
    __syncthreads();
    ltok = lt;
  }
  __device__ __forceinline__ bool next(int i, pg8::Unit& u) const { return mo.next(i, u); }
  __device__ __forceinline__ const char* a_base() const { return A; }
  __device__ __forceinline__ unsigned a_off(const pg8::Unit& u, int r) const { const int rr = u.pm * 256 + r; const int tok = rr < u.ne ? list[u.e * NTOK + rr] : 0; return (unsigned)tok * 2048u; }
  __device__ __forceinline__ const char* b_base(const pg8::Unit& u) const { return W13 + ((size_t)u.e * 2048 + (size_t)u.pn * 256) * 2048; }
  __device__ __forceinline__ void epi(const f32x4 (&acc)[2][2][4][2], const pg8::Unit& u, int wr, int wc, int fr, int fq) const {
    const int row0 = u.row0 + wr * 64 + fr, colb = u.pn * 128 + wc * 16 + 4 * fq;
#pragma unroll
    for (int ai = 0; ai < 2; ++ai)
#pragma unroll
      for (int m = 0; m < 4; ++m)
#pragma unroll
        for (int bj = 0; bj < 2; ++bj) {
          const f32x4 v0 = acc[ai][bj][m][0], v1 = acc[ai][bj][m][1];
          u32x2 w; w.x = pk2(fsilu(v0[0]) * v0[1], fsilu(v0[2]) * v0[3]); w.y = pk2(fsilu(v1[0]) * v1[1], fsilu(v1[2]) * v1[3]);
          *(u32x2*)(H + (size_t)(row0 + ai * 128 + m * 16) * 1024 + colb + bj * 64) = w;
        }
  }
};
struct ProbMoe2 {
  static constexpr bool PERM = true;
  MoeOrder mo; const char* A; const char* W2; bf16_t* Y;
  __device__ __forceinline__ bool next(int i, pg8::Unit& u) const { return mo.next(i, u); }
  __device__ __forceinline__ const char* a_base() const { return A; }
  __device__ __forceinline__ unsigned a_off(const pg8::Unit& u, int r) const { return (unsigned)(u.row0 + r) * 2048u; }
  __device__ __forceinline__ const char* b_base(const pg8::Unit& u) const { return W2 + ((size_t)u.e * 1024 + (size_t)u.pn * 256) * 2048; }
  __device__ __forceinline__ void epi(const f32x4 (&acc)[2][2][4][2], const pg8::Unit& u, int wr, int wc, int fr, int fq) const {
    const int row0 = u.row0 + wr * 64 + fr, colb = u.pn * 256 + wc * 32 + 8 * fq;
#pragma unroll
    for (int ai = 0; ai < 2; ++ai)
#pragma unroll
      for (int m = 0; m < 4; ++m)
#pragma unroll
        for (int bj = 0; bj < 2; ++bj) {
          const f32x4 v0 = acc[ai][bj][m][0], v1 = acc[ai][bj][m][1];
          u32x4 w; w.x = pk2(v0[0], v0[1]); w.y = pk2(v0[2], v0[3]); w.z = pk2(v1[0], v1[1]); w.w = pk2(v1[2], v1[3]);
          *(u32x4*)(Y + (size_t)(row0 + ai * 128 + m * 16) * 1024 + colb + bj * 128) = w;
        }
  }
};

template <int NS>
__device__ __forceinline__ void side_phase(unsigned char* lds_, int wv, const Params& p, int layer) {
  const Ctx c = make_ctx(lds_, wv);
  const bf16_t* hb = (const bf16_t*)(p.ws + WS_HB);
  const bf16_t* wt = (const bf16_t*)(p.ws + (layer == 0 ? WS_WIN_AB : WS_WIN_CD)) + (size_t)(layer == 0 ? PM_AB : PM_CD) * 1024;
  const float* bias = p.in[layer == 0 ? I_AB_B_IN : I_CD_B_IN] + (layer == 0 ? PM_AB : PM_CD);
  float* side = (float*)(p.ws + WS_SIDE);
  float* tl = (float*)c.lds + c.wid * (16 * 33);
  const int fr = c.lane & 15, fq = c.lane >> 4;
  for (int g = c.bid * 8 + c.wid; g < NTOK / 16; g += c.G * 8) {
    const int r0 = g * 16;
    f32x4 acc0 = (f32x4){0.f, 0.f, 0.f, 0.f}, acc1 = acc0;
    const bf16_t* ap = hb + (size_t)(r0 + fr) * 1024 + fq * 8;
    const bf16_t* bp0 = wt + (size_t)fr * 1024 + fq * 8; const bf16_t* bp1 = bp0 + 16 * 1024;
#pragma unroll 4
    for (int k = 0; k < 1024; k += 32) {
      const bf16x8 a = *(const bf16x8*)(ap + k), b0 = *(const bf16x8*)(bp0 + k);
      acc0 = __builtin_amdgcn_mfma_f32_16x16x32_bf16(a, b0, acc0, 0, 0, 0);
      if (NS == 32) { const bf16x8 b1 = *(const bf16x8*)(bp1 + k); acc1 = __builtin_amdgcn_mfma_f32_16x16x32_bf16(a, b1, acc1, 0, 0, 0); }
    }
    float gsc = 1.f, gfb = 0.f; bool gls = false;
    if (NS == 16) { gsc = 1.4426950408889634f; gls = (fr & 4) != 0; gfb = gls ? p.in[I_FGATE_B][(fr >> 3) * 4 + (fr & 3)] : 0.f; }
#pragma unroll
    for (int j = 0; j < 4; ++j) { float v0 = acc0[j] + bias[fr]; if (NS == 16) v0 = gls ? flog2sigmoid(v0 + gfb) : v0 * gsc; side[(size_t)(r0 + fq * 4 + j) * 32 + fr] = v0; tl[(fq * 4 + j) * 33 + fr] = v0;
      if (NS == 32) { const float v1 = acc1[j] + bias[16 + fr]; side[(size_t)(r0 + fq * 4 + j) * 32 + 16 + fr] = v1; tl[(fq * 4 + j) * 33 + 16 + fr] = v1; } }
    if (NS == 32) {
      __builtin_amdgcn_s_waitcnt(0xC07F);
      const float* gu = p.in[I_GK_UP]; const float* gb = p.in[I_GK_B]; bf16_t* lfb = (bf16_t*)(p.ws + WS_LFB);
      const int cb = c.lane * 8, dir = cb >> 8, cc = cb & 255;
      float w[16][8];
#pragma unroll
      for (int r = 0; r < 16; ++r)
#pragma unroll
        for (int j = 0; j < 8; ++j) w[r][j] = gu[(dir * 16 + r) * 256 + cc + j];
      float bb[8];
#pragma unroll
      for (int j = 0; j < 8; ++j) bb[j] = gb[dir * 256 + cc + j];
      for (int row = 0; row < 16; ++row) {
        float z[8];
#pragma unroll
        for (int j = 0; j < 8; ++j) z[j] = bb[j];
#pragma unroll
        for (int r = 0; r < 16; ++r) { const float s = tl[row * 33 + dir * 16 + r];
#pragma unroll
          for (int j = 0; j < 8; ++j) z[j] += s * w[r][j]; }
        u32x4 o; o.x = pk2(flog2sigmoid(z[0]) * 0.0625f, flog2sigmoid(z[1]) * 0.0625f); o.y = pk2(flog2sigmoid(z[2]) * 0.0625f, flog2sigmoid(z[3]) * 0.0625f);
        o.z = pk2(flog2sigmoid(z[4]) * 0.0625f, flog2sigmoid(z[5]) * 0.0625f); o.w = pk2(flog2sigmoid(z[6]) * 0.0625f, flog2sigmoid(z[7]) * 0.0625f);
        *(u32x4*)(lfb + PIDX(r0 + row, cb)) = o;
      }
    }
  }
}

__device__ __forceinline__ void headnorm_phase(unsigned char* lds_, int wv, const Params& p, int layer) {
  const Ctx c = make_ctx(lds_, wv);
  const bf16_t* P = (const bf16_t*)(p.ws + WS_R1); const bf16_t* O = (const bf16_t*)(p.ws + WS_R2);
  bf16_t* mixed = (bf16_t*)(p.ws + WS_HB);
  const int c0 = c.lane * 16, h8 = c.lane >> 3;
  const float* gain = layer == 0 ? (h8 < 4 ? p.in[I_HGRN_NORM] + c0 : p.in[I_GLA_NORM] + c0 - 512) : (h8 < 4 ? p.in[I_RET_NORM] + c0 : p.in[I_MLSTM_NORM] + c0 - 512);
  const int gcol = layer == 0 ? (h8 < 4 ? 2048 + c0 : 3584 + c0 - 512) : (h8 < 4 ? 1024 + c0 : 3072 + c0 - 512);
  float gn[16];
#pragma unroll
  for (int j = 0; j < 16; ++j) gn[j] = gain[j];
  for (int tok = c.bid * 8 + c.wid; tok < NTOK; tok += c.G * 8) {
    float of[16], ob[16], gt[16];
    { const u32x4* a = (const u32x4*)(O + PIDX(tok, c0)); unpack8(__builtin_nontemporal_load(a), of); unpack8(__builtin_nontemporal_load(a + 1), of + 8);
      const u32x4* b = (const u32x4*)(O + (size_t)NTOK * 1024 + PIDX(tok, c0)); unpack8(__builtin_nontemporal_load(b), ob); unpack8(__builtin_nontemporal_load(b + 1), ob + 8);
      const u32x4* g = (const u32x4*)(P + PIDX(tok, gcol)); unpack8(__builtin_nontemporal_load(g), gt); unpack8(__builtin_nontemporal_load(g + 1), gt + 8); }
    const float sf = 1.f, sb = 1.f;
    float o[16]; float ss = 0.f;
#pragma unroll
    for (int j = 0; j < 16; ++j) { o[j] = of[j] * sf + ob[j] * sb; ss += o[j] * o[j]; }
    ss += __shfl_xor(ss, 1); ss += __shfl_xor(ss, 2); ss += __shfl_xor(ss, 4);
    const float r = 1.0f / sqrtf(ss * (1.0f / 128.0f) + NORM_EPS_F);
    unsigned w[8];
#pragma unroll
    for (int j = 0; j < 8; ++j) {
      float g0 = gt[2 * j], g1 = gt[2 * j + 1];
      if (layer == 1 && h8 >= 4) { g0 = fsigmoid(g0); g1 = fsigmoid(g1); } else { g0 = fsilu(g0); g1 = fsilu(g1); }
      w[j] = pk2(o[2 * j] * r * gn[2 * j] * g0, o[2 * j + 1] * r * gn[2 * j + 1] * g1);
    }
    u32x4* d = (u32x4*)(mixed + (size_t)tok * 1024 + c0);
    d[0] = (u32x4){w[0], w[1], w[2], w[3]}; d[1] = (u32x4){w[4], w[5], w[6], w[7]};
  }
}

__device__ __forceinline__ void ln_phase(unsigned char* lds_, int wv, const Params& p, int layer, int mode, int dry = 0) {
  const Ctx c = make_ctx(lds_, wv);
  unsigned char* ws = p.ws;
  const float* hin = (mode == 0 && layer == 0) ? p.in[I_X] : p.out;
  float* hout = dry ? (float*)(ws + WS_H) : p.out; bf16_t* hb = (bf16_t*)(ws + WS_HB);
  const float* g = p.in[mode == 0 ? I_LN_MIX_G : I_LN_FFN_G] + layer * 1024; const float* b = p.in[mode == 0 ? I_LN_MIX_B : I_LN_FFN_B] + layer * 1024;
  unsigned* cnt = (unsigned*)(ws + WS_CTL) + CW_CNT(layer);
  int* list = (int*)(ws + WS_LIST) + (size_t)layer * NEXP * NTOK;
  int* assign = (int*)(ws + WS_ASSIGN); float* gate = (float*)(ws + WS_GATE);
  float* rwT = (float*)c.lds;
  int* lcnt = (int*)(c.lds + 65536); int* lbase = lcnt + 16; int* rec = lcnt + 32; float* recg = (float*)(rec + 4 * 2048);
  int pad[NEXP];
  if (mode == 0) { const float* r = p.in[I_ROUTER_W];
    for (int i = c.tid; i < 1024 * 16; i += NTHREADS) rwT[(i & 15) * 1024 + (i >> 4)] = r[i];
    if (c.tid < 16) lcnt[c.tid] = 0;
    __syncthreads(); }
  else { int acc = 0;
#pragma unroll
    for (int e = 0; e < NEXP; ++e) { pad[e] = acc; acc += (((int)cnt[e * 16] + 255) >> 8) << 8; } }
  const int c0 = c.lane * 4;
  float gv[16], bv[16];
#pragma unroll
  for (int q = 0; q < 4; ++q) { const f32x4 t0 = *(const f32x4*)(g + q * 256 + c0), t1 = *(const f32x4*)(b + q * 256 + c0);
#pragma unroll
    for (int j = 0; j < 4; ++j) { gv[4 * q + j] = t0[j]; bv[4 * q + j] = t1[j]; } }
  const int tstride = c.G * 8;
  int it = 0;
  for (int tok0 = c.bid * 8 + c.wid; tok0 < NTOK; tok0 += 2 * tstride, it += 2) {
    float v[2][16];
    float gy0[2], gy1[2];
#pragma unroll
    for (int u = 0; u < 2; ++u) {
      const int tok = tok0 + u * tstride;
      if (tok < NTOK) {
        if (mode == 0) {
#pragma unroll
          for (int q = 0; q < 4; ++q) { const f32x4 t = __builtin_nontemporal_load((const f32x4*)((const float*)(ws + WS_R2) + (size_t)tok * 1024 + q * 256 + c0)); v[u][4 * q] = t[0]; v[u][4 * q + 1] = t[1]; v[u][4 * q + 2] = t[2]; v[u][4 * q + 3] = t[3]; }
        } else {
#pragma unroll
          for (int q = 0; q < 4; ++q) { const f32x4 t = *(const f32x4*)(hin + (size_t)tok * 1024 + q * 256 + c0); v[u][4 * q] = ALPHA_F * t[0]; v[u][4 * q + 1] = ALPHA_F * t[1]; v[u][4 * q + 2] = ALPHA_F * t[2]; v[u][4 * q + 3] = ALPHA_F * t[3]; }
          const int a0 = assign[tok * 4], a1 = assign[tok * 4 + 1], a2 = assign[tok * 4 + 2], a3 = assign[tok * 4 + 3];
          gy0[u] = gate[tok * 2]; gy1[u] = gate[tok * 2 + 1];
          int p0 = 0, p1 = 0;
#pragma unroll
          for (int e = 0; e < NEXP; ++e) { if (e == a0) p0 = pad[e]; if (e == a2) p1 = pad[e]; }
          p0 += a1; p1 += a3;
          const bf16_t* Y = (const bf16_t*)(ws + WS_R2);
#pragma unroll
          for (int q = 0; q < 4; ++q) { const u32x2 y0 = __builtin_nontemporal_load((const u32x2*)(Y + (size_t)p0 * 1024 + q * 256 + c0)), y1 = __builtin_nontemporal_load((const u32x2*)(Y + (size_t)p1 * 1024 + q * 256 + c0));
            v[u][4 * q] += gy0[u] * __uint_as_float(y0.x << 16) + gy1[u] * __uint_as_float(y1.x << 16); v[u][4 * q + 1] += gy0[u] * __uint_as_float(y0.x & 0xffff0000u) + gy1[u] * __uint_as_float(y1.x & 0xffff0000u);
            v[u][4 * q + 2] += gy0[u] * __uint_as_float(y0.y << 16) + gy1[u] * __uint_as_float(y1.y << 16); v[u][4 * q + 3] += gy0[u] * __uint_as_float(y0.y & 0xffff0000u) + gy1[u] * __uint_as_float(y1.y & 0xffff0000u); }
        }
      } else {
#pragma unroll
        for (int j = 0; j < 16; ++j) v[u][j] = 0.f;
      }
    }
#pragma unroll
    for (int u = 0; u < 2; ++u) {
      const int tok = tok0 + u * tstride;
      float s = 0.f;
#pragma unroll
      for (int j = 0; j < 16; ++j) s += v[u][j];
      const float mean = wave_sum(s) * (1.0f / 1024.0f);
      float qq = 0.f;
#pragma unroll
      for (int j = 0; j < 16; ++j) { v[u][j] -= mean; qq += v[u][j] * v[u][j]; }
      const float r = 1.0f / sqrtf(wave_sum(qq) * (1.0f / 1024.0f) + LN_EPS_F);
#pragma unroll
      for (int j = 0; j < 16; ++j) v[u][j] = v[u][j] * r * gv[j] + bv[j];
      if (tok < NTOK) {
#pragma unroll
        for (int q = 0; q < 4; ++q) __builtin_nontemporal_store((f32x4){v[u][4 * q], v[u][4 * q + 1], v[u][4 * q + 2], v[u][4 * q + 3]}, (f32x4*)(hout + (size_t)tok * 1024 + q * 256 + c0));
        if (!(mode == 1 && layer == 1) && !dry) {
#pragma unroll
          for (int q = 0; q < 4; ++q) *(u32x2*)(hb + (size_t)tok * 1024 + q * 256 + c0) = (u32x2){pk2(v[u][4 * q], v[u][4 * q + 1]), pk2(v[u][4 * q + 2], v[u][4 * q + 3])}; }
      }
      if (mode == 0) {
        float lg[16];
#pragma unroll
        for (int e = 0; e < 16; ++e) { float a = 0.f;
#pragma unroll
          for (int q = 0; q < 4; ++q) { const f32x4 w = *(const f32x4*)(rwT + e * 1024 + q * 256 + c0); a += v[u][4 * q] * w[0] + v[u][4 * q + 1] * w[1] + v[u][4 * q + 2] * w[2] + v[u][4 * q + 3] * w[3]; }
          lg[e] = a; }
#pragma unroll
        for (int e = 0; e < 16; ++e) lg[e] = wave_sum(lg[e]);
        int eo[2]; float go[2];
        route_from_logits(lg, p.in[I_ROUTER_B], eo, go);
        if (c.lane == 0 && tok < NTOK && !dry) {
          const int r1 = atomicAdd(lcnt + eo[0], 1), r2 = atomicAdd(lcnt + eo[1], 1);
          const int ri = (it + u) * 8 + c.wid;
          rec[ri * 4] = eo[0]; rec[ri * 4 + 1] = r1; rec[ri * 4 + 2] = eo[1]; rec[ri * 4 + 3] = r2; recg[ri * 2] = go[0]; recg[ri * 2 + 1] = go[1];
        }
      }
    }
  }
  if (mode == 0 && !dry) {
    __syncthreads();
    if (c.tid < 16) lbase[c.tid] = (int)atomicAdd(cnt + c.tid * 16, (unsigned)lcnt[c.tid]);
    __syncthreads();
    const int nrec = ((NTOK + c.G * 8 - 1) / (c.G * 8)) * 8;
    for (int ri = c.tid; ri < nrec; ri += NTHREADS) {
      const int tok = c.bid * 8 + (ri & 7) + (ri >> 3) * c.G * 8;
      if (tok < NTOK) {
        const int e1 = rec[ri * 4], e2 = rec[ri * 4 + 2]; const int r1 = rec[ri * 4 + 1] + lbase[e1], r2 = rec[ri * 4 + 3] + lbase[e2];
        list[e1 * NTOK + r1] = tok; list[e2 * NTOK + r2] = tok;
        assign[tok * 4] = e1; assign[tok * 4 + 1] = r1; assign[tok * 4 + 2] = e2; assign[tok * 4 + 3] = r2;
        gate[tok * 2] = recg[ri * 2]; gate[tok * 2 + 1] = recg[ri * 2 + 1];
      }
    }
  }
  __syncthreads();
}
#endif
#ifndef CPU_EMU
namespace scan {
typedef short bf16x8 __attribute__((ext_vector_type(8)));
typedef float f32x4 __attribute__((ext_vector_type(4)));
typedef unsigned u32x4 __attribute__((ext_vector_type(4)));
typedef unsigned u32x2 __attribute__((ext_vector_type(2)));
enum { MIX_A = 0, MIX_B = 1, MIX_C = 2, MIX_D = 3 };
constexpr int LD_T = 144;
constexpr int OFF_QS = 0, OFF_KS = 17408, OFF_QI = 34816, OFF_KT = 52224, OFF_VT = 70656, OFF_SC = 77568, OFF_ST = 86784, OFF_DEC = 99840, OFF_EM = 100352, OFF_DEN = 100608, OFF_CW = 100864, SCAN_LDS = 104960;

__device__ __forceinline__ float incl_scan_add(float x) {
  x += __builtin_bit_cast(float, __builtin_amdgcn_update_dpp(0, __builtin_bit_cast(int, x), 0x111, 0xf, 0xf, false));
  x += __builtin_bit_cast(float, __builtin_amdgcn_update_dpp(0, __builtin_bit_cast(int, x), 0x112, 0xf, 0xf, false));
  x += __builtin_bit_cast(float, __builtin_amdgcn_update_dpp(0, __builtin_bit_cast(int, x), 0x114, 0xf, 0xf, false));
  x += __builtin_bit_cast(float, __builtin_amdgcn_update_dpp(0, __builtin_bit_cast(int, x), 0x118, 0xf, 0xf, false));
  x += __builtin_bit_cast(float, __builtin_amdgcn_update_dpp(0, __builtin_bit_cast(int, x), 0x142, 0xa, 0xf, false));
  x += __builtin_bit_cast(float, __builtin_amdgcn_update_dpp(0, __builtin_bit_cast(int, x), 0x143, 0xc, 0xf, false));
  return x;
}
__device__ __forceinline__ float incl_scan_max(float x) {
  const int ninf = (int)0xff800000u;
  x = fmaxf(x, __builtin_bit_cast(float, __builtin_amdgcn_update_dpp(ninf, __builtin_bit_cast(int, x), 0x111, 0xf, 0xf, false)));
  x = fmaxf(x, __builtin_bit_cast(float, __builtin_amdgcn_update_dpp(ninf, __builtin_bit_cast(int, x), 0x112, 0xf, 0xf, false)));
  x = fmaxf(x, __builtin_bit_cast(float, __builtin_amdgcn_update_dpp(ninf, __builtin_bit_cast(int, x), 0x114, 0xf, 0xf, false)));
  x = fmaxf(x, __builtin_bit_cast(float, __builtin_amdgcn_update_dpp(ninf, __builtin_bit_cast(int, x), 0x118, 0xf, 0xf, false)));
  x = fmaxf(x, __builtin_bit_cast(float, __builtin_amdgcn_update_dpp(ninf, __builtin_bit_cast(int, x), 0x142, 0xa, 0xf, false)));
  x = fmaxf(x, __builtin_bit_cast(float, __builtin_amdgcn_update_dpp(ninf, __builtin_bit_cast(int, x), 0x143, 0xc, 0xf, false)));
  return x;
}
__device__ __forceinline__ float rdlane(float x, int l) { return __builtin_bit_cast(float, __builtin_amdgcn_readlane(__builtin_bit_cast(int, x), l)); }
__device__ __forceinline__ bf16x8 ldfrag(const unsigned char* base, int ld, int row, int kbyte) { return *(const bf16x8*)(base + row * ld + kbyte); }
__device__ __forceinline__ bf16x8 ldfrag2(const unsigned char* base, int ld, int row, int b0, int b1) {
  const u32x2 lo = *(const u32x2*)(base + row * ld + b0), hi = *(const u32x2*)(base + row * ld + b1);
  return __builtin_bit_cast(bf16x8, (u32x4){lo.x, lo.y, hi.x, hi.y}); }
__device__ __forceinline__ unsigned pk(float a, float b) { return pk_hw(a, b); }
__device__ __forceinline__ float lo16(unsigned w) { return __uint_as_float(w << 16); }
__device__ __forceinline__ float hi16(unsigned w) { return __uint_as_float(w & 0xffff0000u); }

__device__ __forceinline__ void lds_barrier() { asm volatile("s_waitcnt lgkmcnt(0)" ::: "memory"); __builtin_amdgcn_s_barrier(); asm volatile("" ::: "memory"); }
struct Raw { u32x4 a0, a1, b0, b1; f32x4 r0, r1; u32x2 v; float s0, s1; };

}

__device__ __forceinline__ void convd_phase(unsigned char* lds_, int wv, const Params& p) {
  const Ctx c = make_ctx(lds_, wv);
  bf16_t* P = (bf16_t*)(p.ws + WS_R1); bf16_t* QD = (bf16_t*)(p.ws + WS_LFB);
  const float* cw = p.in[I_CONV_W]; const float* cb = p.in[I_CONV_B];
  const int ch = c.lane * 16;
  float w0[16], w1[16], w2[16], bb[16];
#pragma unroll
  for (int j = 0; j < 16; ++j) { w0[j] = cw[ch + j]; w1[j] = cw[1024 + ch + j]; w2[j] = cw[2048 + ch + j]; bb[j] = cb[ch + j]; }
  for (int tok = c.bid * 8 + c.wid; tok < NTOK; tok += c.G * 8) {
    const int t = tok % SEQ;
    const bf16_t* row = P + PIDX(tok, 1536 + ch);
    float x0[16], x1[16], x2[16];
    { const u32x4* r1 = (const u32x4*)row; unpack8(r1[0], x1); unpack8(r1[1], x1 + 8); }
    if (t > 0) { const u32x4* r0 = (const u32x4*)(row - 128); unpack8(r0[0], x0); unpack8(r0[1], x0 + 8); }
    else {
#pragma unroll
      for (int j = 0; j < 16; ++j) x0[j] = 0.f; }
    if (t < SEQ - 1) { const u32x4* r2 = (const u32x4*)(row + 128); unpack8(r2[0], x2); unpack8(r2[1], x2 + 8); }
    else {
#pragma unroll
      for (int j = 0; j < 16; ++j) x2[j] = 0.f; }
    const float sc = ch < 512 ? 0.08838834764831845f : 1.0f;
    unsigned w[8];
#pragma unroll
    for (int j = 0; j < 8; ++j) {
      const float a0 = bb[2 * j] + w0[2 * j] * x0[2 * j] + w1[2 * j] * x1[2 * j] + w2[2 * j] * x2[2 * j];
      const float a1 = bb[2 * j + 1] + w0[2 * j + 1] * x0[2 * j + 1] + w1[2 * j + 1] * x1[2 * j + 1] + w2[2 * j + 1] * x2[2 * j + 1];
      w[j] = pk2(fsilu(a0) * sc, fsilu(a1) * sc);
    }
    u32x4* d = (ch < 512) ? (u32x4*)(QD + PIDX(tok, ch)) : (u32x4*)(P + PIDX(tok, 3584 + (ch - 512)));
    d[0] = (u32x4){w[0], w[1], w[2], w[3]}; d[1] = (u32x4){w[4], w[5], w[6], w[7]};
  }
}

#endif
#ifndef CPU_EMU
namespace scan2 {
using namespace scan;
__device__ __forceinline__ float FMUL(float a, float b) { float r = a * b; asm("" : "+v"(r)); return r; }
constexpr int U_QI = 0, U_KS = 34816, U_KT = 69632, U_VT = 106496, U_SC = 120320, U_ST = 129536, U_DEC = 155648, U_EM = 156672, U_END = 157184;
template <int MIXER>
__device__ __forceinline__ void scan_item2(unsigned char* lds, int wv, const Params& p, int b, int h, int dir, int vs) {
  constexpr int DK = (MIXER == MIX_A || MIXER == MIX_D) ? 128 : 64;
  constexpr int NC = DK / 8;
  constexpr int LD_D = DK * 2 + 16;
  constexpr int NVT = MIXER == MIX_D ? 3 : 2;
  constexpr int NKD = DK / 32;
  constexpr int NST = (DK == 128) ? NVT : 1;
  constexpr int NCH = SEQ / 64;
  const int tid = opaque_tid(wv), lane0 = tid & 63, wid = __builtin_amdgcn_readfirstlane(tid >> 6);
  unsigned char* ws = p.ws;
  const bf16_t* P = (const bf16_t*)(ws + WS_R1);
  const bf16_t* LFBp = (const bf16_t*)(ws + WS_LFB);
  const float* side = (const float*)(ws + WS_SIDE);
  const float* rope = (const float*)(ws + WS_ROPE);
  bf16_t* O = (bf16_t*)(ws + WS_R2) + (size_t)dir * NTOK * 1024;
  unsigned char* SC = lds + U_SC;
  int qcol, kcol, lfcol, vcol, ocol;
  if (MIXER == MIX_A) { qcol = h * 128; kcol = 0; lfcol = 512 + dir * 512 + h * 128; vcol = 1536 + h * 128 + vs * 32; ocol = h * 128 + vs * 32; }
  else if (MIXER == MIX_B) { qcol = 2560 + h * 64; kcol = 2816 + h * 64; lfcol = dir * 256 + h * 64; vcol = 3072 + h * 128 + vs * 32; ocol = 512 + h * 128 + vs * 32; }
  else if (MIXER == MIX_C) { qcol = h * 64; kcol = 256 + h * 64; lfcol = 0; vcol = 512 + h * 128 + vs * 32; ocol = h * 128 + vs * 32; }
  else { qcol = h * 128; kcol = 3584 + h * 128; lfcol = 0; vcol = 2560 + h * 128 + vs * 32; ocol = 512 + h * 128 + vs * 32; }
  const size_t tokbase = (size_t)b * SEQ;
  const int c0 = (MIXER == MIX_C) ? wid * 4 : wid * NC;
  for (int i = tid; i < 2 * 13056 / 4; i += NTHREADS) ((unsigned*)(lds + U_ST))[i] = 0u;
  for (int i = tid; i < 9216 / 4; i += NTHREADS) ((unsigned*)(lds + U_SC))[i] = 0u;
  if (MIXER == MIX_D) { for (int i = tid; i < 2 * 16 * 64; i += NTHREADS) { const int bf = i >> 10, r = 32 + ((i >> 6) & 15), j = i & 63; *(bf16_t*)(lds + U_VT + bf * 6912 + r * LD_T + j * 2) = (r == 32) ? (bf16_t)0x3F80 : (bf16_t)0; } }
  const float lgam2 = (MIXER == MIX_C) ? log1pf(-exp2f(-(5.0f + 2.0f * (float)h + (float)dir))) * 1.4426950408889634f : 0.f;
  const float fgb = (MIXER == MIX_D) ? p.in[I_FGATE_B][dir * 4 + h] : 0.f;
  float m_st = 0.f;
  __syncthreads();

  Raw R, Rn; u32x2 Rv, Rvn;
#define A_LOAD(R, Rv, n_) do { \
    const int ln_ = lane0; \
    const int t_ = dir ? (SEQ - 1 - ((n_) * 64 + ln_)) : ((n_) * 64 + ln_); \
    const size_t tk_ = tokbase + t_; \
    if (MIXER == MIX_A) { const u32x4* qp_ = (const u32x4*)(P + PIDX(tk_, qcol + c0)); const u32x4* lp_ = (const u32x4*)(P + PIDX(tk_, lfcol + c0)); R.a0 = qp_[0]; R.a1 = qp_[1]; R.b0 = lp_[0]; R.b1 = lp_[1]; } \
    else if (MIXER == MIX_B) { R.a0 = *(const u32x4*)(P + PIDX(tk_, qcol + c0)); R.a1 = *(const u32x4*)(P + PIDX(tk_, kcol + c0)); R.b0 = *(const u32x4*)(LFBp + PIDX(tk_, lfcol + c0)); } \
    else if (MIXER == MIX_C) { const u32x2 qa_ = *(const u32x2*)(P + PIDX(tk_, qcol + c0)), qb_ = *(const u32x2*)(P + PIDX(tk_, qcol + 32 + c0)), ka_ = *(const u32x2*)(P + PIDX(tk_, kcol + c0)), kb_ = *(const u32x2*)(P + PIDX(tk_, kcol + 32 + c0)); \
      R.a0 = (u32x4){qa_.x, qa_.y, qb_.x, qb_.y}; R.a1 = (u32x4){ka_.x, ka_.y, kb_.x, kb_.y}; \
      R.r0 = *(const f32x4*)(rope + ((size_t)t_ * 32 + c0) * 2); R.r1 = *(const f32x4*)(rope + ((size_t)t_ * 32 + c0) * 2 + 4); } \
    else { const u32x4* qp_ = (const u32x4*)(LFBp + PIDX(tk_, qcol + c0)); const u32x4* kp_ = (const u32x4*)(P + PIDX(tk_, kcol + c0)); R.a0 = qp_[0]; R.a1 = qp_[1]; R.b0 = kp_[0]; R.b1 = kp_[1]; \
      R.s0 = side[tk_ * 32 + dir * 8 + h]; R.s1 = side[tk_ * 32 + dir * 8 + 4 + h]; } \
    Rv = *(const u32x2*)(P + PIDX(tk_, vcol + wid * 4)); } while (0)

  float rr_next = 1.f, rr_cur = 1.f;
#define A_PREP(buf_, R, Rv) do { \
    const int lane = lane0; \
    unsigned char* KTb = lds + U_KT + (buf_) * 18432; float* DECb = (float*)(lds + U_DEC + (buf_) * 512); float* EMb = (float*)(lds + U_EM + (buf_) * 256); \
    unsigned char* QIb = lds + U_QI + (buf_) * 17408; unsigned char* KSb = lds + U_KS + (buf_) * 17408; \
    float q[NC], k[NC], g[NC], ktv[NC]; \
    if (MIXER == MIX_A) { \
      const unsigned qw[8] = {R.a0.x, R.a0.y, R.a0.z, R.a0.w, R.a1.x, R.a1.y, R.a1.z, R.a1.w}, lw[8] = {R.b0.x, R.b0.y, R.b0.z, R.b0.w, R.b1.x, R.b1.y, R.b1.z, R.b1.w}; \
      _Pragma("unroll") for (int c = 0; c < 8; ++c) { q[2 * c] = lo16(qw[c]); q[2 * c + 1] = hi16(qw[c]); g[2 * c] = lo16(lw[c]); g[2 * c + 1] = hi16(lw[c]); } \
      _Pragma("unroll") for (int c = 0; c < NC; ++c) k[c] = 1.0f - __builtin_amdgcn_exp2f(g[c]); \
    } else if (MIXER == MIX_B) { \
      const unsigned qw[4] = {R.a0.x, R.a0.y, R.a0.z, R.a0.w}, kw[4] = {R.a1.x, R.a1.y, R.a1.z, R.a1.w}, lw[4] = {R.b0.x, R.b0.y, R.b0.z, R.b0.w}; \
      _Pragma("unroll") for (int c = 0; c < 4; ++c) { q[2 * c] = lo16(qw[c]); q[2 * c + 1] = hi16(qw[c]); k[2 * c] = lo16(kw[c]); k[2 * c + 1] = hi16(kw[c]); g[2 * c] = lo16(lw[c]); g[2 * c + 1] = hi16(lw[c]); } \
    } else if (MIXER == MIX_C) { \
      const float cs[4] = {R.r0[0], R.r0[2], R.r1[0], R.r1[2]}, sn[4] = {R.r0[1], R.r0[3], R.r1[1], R.r1[3]}; \
      const float q1[4] = {lo16(R.a0.x), hi16(R.a0.x), lo16(R.a0.y), hi16(R.a0.y)}, q2[4] = {lo16(R.a0.z), hi16(R.a0.z), lo16(R.a0.w), hi16(R.a0.w)}; \
      const float k1[4] = {lo16(R.a1.x), hi16(R.a1.x), lo16(R.a1.y), hi16(R.a1.y)}, k2[4] = {lo16(R.a1.z), hi16(R.a1.z), lo16(R.a1.w), hi16(R.a1.w)}; \
      _Pragma("unroll") for (int c = 0; c < 4; ++c) { q[c] = (q1[c] * cs[c] - q2[c] * sn[c]) * 0.125f; q[4 + c] = (q1[c] * sn[c] + q2[c] * cs[c]) * 0.125f; k[c] = k1[c] * cs[c] - k2[c] * sn[c]; k[4 + c] = k1[c] * sn[c] + k2[c] * cs[c]; } \
    } else { \
      const unsigned qw[8] = {R.a0.x, R.a0.y, R.a0.z, R.a0.w, R.a1.x, R.a1.y, R.a1.z, R.a1.w}, kw[8] = {R.b0.x, R.b0.y, R.b0.z, R.b0.w, R.b1.x, R.b1.y, R.b1.z, R.b1.w}; \
      _Pragma("unroll") for (int c = 0; c < 8; ++c) { q[2 * c] = lo16(qw[c]); q[2 * c + 1] = hi16(qw[c]); k[2 * c] = lo16(kw[c]); k[2 * c + 1] = hi16(kw[c]); } \
    } \
    if (MIXER == MIX_A || MIXER == MIX_B) { \
        \
      _Pragma("unroll") for (int c = 0; c < NC; ++c) g[c] += __builtin_bit_cast(float, __builtin_amdgcn_update_dpp(0, __builtin_bit_cast(int, g[c]), 0x111, 0xf, 0xf, false)); \
      _Pragma("unroll") for (int c = 0; c < NC; ++c) g[c] += __builtin_bit_cast(float, __builtin_amdgcn_update_dpp(0, __builtin_bit_cast(int, g[c]), 0x112, 0xf, 0xf, false)); \
      _Pragma("unroll") for (int c = 0; c < NC; ++c) g[c] += __builtin_bit_cast(float, __builtin_amdgcn_update_dpp(0, __builtin_bit_cast(int, g[c]), 0x114, 0xf, 0xf, false)); \
      _Pragma("unroll") for (int c = 0; c < NC; ++c) g[c] += __builtin_bit_cast(float, __builtin_amdgcn_update_dpp(0, __builtin_bit_cast(int, g[c]), 0x118, 0xf, 0xf, false)); \
      _Pragma("unroll") for (int c = 0; c < NC; ++c) g[c] += __builtin_bit_cast(float, __builtin_amdgcn_update_dpp(0, __builtin_bit_cast(int, g[c]), 0x142, 0xa, 0xf, false)); \
      _Pragma("unroll") for (int c = 0; c < NC; ++c) g[c] += __builtin_bit_cast(float, __builtin_amdgcn_update_dpp(0, __builtin_bit_cast(int, g[c]), 0x143, 0xc, 0xf, false)); \
      float ev[NC]; \
      _Pragma("unroll") for (int c = 0; c < NC; ++c) { \
          \
        const float e = __builtin_amdgcn_exp2f(g[c]), r = __builtin_amdgcn_rcpf(e); \
        const float e63 = rdlane(e, 63); \
        q[c] = FMUL(q[c], e); k[c] = FMUL(k[c], r); ktv[c] = FMUL(k[c], e63);     \
        ev[c] = e; } \
      if (lane == 63) { _Pragma("unroll") for (int c = 0; c < NC / 4; ++c) *(f32x4*)(DECb + c0 + 4 * c) = (f32x4){ev[4 * c], ev[4 * c + 1], ev[4 * c + 2], ev[4 * c + 3]}; } \
    } else if (MIXER == MIX_C) { \
        \
      const float gl = (float)(lane + 1) * lgam2; \
      const float e = __builtin_amdgcn_exp2f(gl), r = __builtin_amdgcn_rcpf(e); \
      const float e63 = rdlane(e, 63); const float f_kt = r * e63; \
      _Pragma("unroll") for (int c = 0; c < NC; ++c) { q[c] = FMUL(q[c], e); ktv[c] = FMUL(k[c], f_kt); k[c] = FMUL(k[c], r); } \
      if (lane < 4) { DECb[c0 + lane] = e63; DECb[32 + c0 + lane] = e63; } \
    } else { \
      const float li = R.s0, lf = R.s1;     \
      const float bc = incl_scan_add(lf); const float u = li - bc; const float pm = incl_scan_max(u); \
      const float cmax = rdlane(pm, 63), blast = rdlane(bc, 63); \
      const float a_i = bc + m_st, m_i = fmaxf(a_i, bc + pm); \
      const float d_alpha = __builtin_amdgcn_exp2f(bc - m_i + cmax), d_beta = __builtin_amdgcn_exp2f(u - cmax); \
      rr_next = __builtin_amdgcn_exp2f(m_st - cmax);     \
      const float m_new = fmaxf(blast + m_st, blast + cmax); \
      const float d_sold = __builtin_amdgcn_exp2f(blast + m_st - m_new), d_wks = __builtin_amdgcn_exp2f(blast + u - m_new); m_st = m_new; \
      _Pragma("unroll") for (int c = 0; c < NC; ++c) { ktv[c] = FMUL(k[c], d_wks); q[c] = FMUL(q[c], d_alpha); k[c] = FMUL(k[c], d_beta); if (lane == 63) DECb[c0 + c] = d_sold; } \
      if (wid == 0) EMb[lane] = __builtin_amdgcn_exp2f(-m_i); \
    } \
    _Pragma("unroll") for (int c = 0; c < NC / 2; ++c) { const unsigned w_ = pk_hw(ktv[2 * c], ktv[2 * c + 1]); \
      const int d0_ = (MIXER == MIX_C) ? (2 * c < 4 ? c0 + 2 * c : 32 + c0 + 2 * c - 4) : c0 + 2 * c; \
      *(bf16_t*)(KTb + d0_ * LD_T + lane * 2) = (bf16_t)(w_ & 0xffff); *(bf16_t*)(KTb + (d0_ + 1) * LD_T + lane * 2) = (bf16_t)(w_ >> 16); } \
    { unsigned pq[NC / 2], pks[NC / 2]; \
      _Pragma("unroll") for (int c = 0; c < NC / 2; ++c) { pq[c] = pk_hw(q[2 * c], q[2 * c + 1]); pks[c] = pk_hw(k[2 * c], k[2 * c + 1]); } \
      if (MIXER == MIX_C) { \
        *(u32x2*)(QIb + lane * LD_D + c0 * 2) = (u32x2){pq[0], pq[1]}; *(u32x2*)(QIb + lane * LD_D + (32 + c0) * 2) = (u32x2){pq[2], pq[3]}; \
        *(u32x2*)(KSb + lane * LD_D + c0 * 2) = (u32x2){pks[0], pks[1]}; *(u32x2*)(KSb + lane * LD_D + (32 + c0) * 2) = (u32x2){pks[2], pks[3]}; \
      } else { \
        _Pragma("unroll") for (int c = 0; c < NC / 8; ++c) { \
          *(u32x4*)(QIb + lane * LD_D + (c0 + 8 * c) * 2) = (u32x4){pq[4 * c], pq[4 * c + 1], pq[4 * c + 2], pq[4 * c + 3]}; \
          *(u32x4*)(KSb + lane * LD_D + (c0 + 8 * c) * 2) = (u32x4){pks[4 * c], pks[4 * c + 1], pks[4 * c + 2], pks[4 * c + 3]}; } } } \
    { unsigned char* VTb = lds + U_VT + (buf_) * 6912 + (wid * 4) * LD_T + lane * 2; \
      *(bf16_t*)(VTb + 0 * LD_T) = (bf16_t)(Rv.x & 0xffff); *(bf16_t*)(VTb + 1 * LD_T) = (bf16_t)(Rv.x >> 16); *(bf16_t*)(VTb + 2 * LD_T) = (bf16_t)(Rv.y & 0xffff); *(bf16_t*)(VTb + 3 * LD_T) = (bf16_t)(Rv.y >> 16); } \
  } while (0)
  f32x4 sacc[NST];
#pragma unroll
  for (int i = 0; i < NST; ++i) sacc[i] = (f32x4){0.f, 0.f, 0.f, 0.f};
  A_LOAD(R, Rv, 0);
  A_PREP(0, R, Rv);
  A_LOAD(R, Rv, 1);
  A_LOAD(Rn, Rvn, 2);
  rr_cur = rr_next;
  lds_barrier();
#define SCAN_ITER(n_, RX, RvX) do { const int n = (n_); \
    const int cb = n & 1, nb = (n + 1) & 1; \
    if (n + 1 < NCH) { A_PREP(nb, RX, RvX); if (n + 3 < NCH) A_LOAD(RX, RvX, n + 3); } \
    { { \
      const int lane = lane0; \
      const int fr = lane & 15, fq = lane >> 4; \
      const int it = wid & 3, vt = wid >> 2; \
      const unsigned char* STc = lds + U_ST + cb * 13056; unsigned char* STn = lds + U_ST + nb * 13056; \
      const unsigned char* KTc = lds + U_KT + cb * 18432; const unsigned char* VTc = lds + U_VT + cb * 6912; \
      const unsigned char* QI = lds + U_QI + cb * 17408; const unsigned char* KS = lds + U_KS + cb * 17408; \
      const float* DECc = (const float*)(lds + U_DEC + cb * 512); const float* EMc = (const float*)(lds + U_EM + cb * 256); \
      bf16x8 qf[NKD]; \
_Pragma("unroll") \
      for (int ks = 0; ks < NKD; ++ks) qf[ks] = ldfrag(QI, LD_D, it * 16 + fr, ks * 64 + fq * 16); \
        \
      u32x2 sp[4]; \
_Pragma("unroll") \
      for (int jt = 0; jt < 4; ++jt) { \
        sp[jt] = (u32x2){0u, 0u}; \
        if (jt <= it) { \
          f32x4 acc = (f32x4){0.f, 0.f, 0.f, 0.f}; \
_Pragma("unroll") \
          for (int ks = 0; ks < NKD; ++ks) acc = __builtin_amdgcn_mfma_f32_16x16x32_bf16(ldfrag(KS, LD_D, jt * 16 + fr, ks * 64 + fq * 16), qf[ks], acc, 0, 0, 0); \
          if (jt == it) { const int i = fr, j0 = fq * 4; \
            const float v0 = (j0 + 0 <= i) ? acc[0] : 0.f, v1 = (j0 + 1 <= i) ? acc[1] : 0.f, v2 = (j0 + 2 <= i) ? acc[2] : 0.f, v3 = (j0 + 3 <= i) ? acc[3] : 0.f; \
            sp[jt] = (u32x2){pk_hw(v0, v1), pk_hw(v2, v3)}; } \
          else sp[jt] = (u32x2){pk_hw(acc[0], acc[1]), pk_hw(acc[2], acc[3])}; \
        } \
      } \
        \
        \
      const u32x4 sb0 = (u32x4){sp[0].x, sp[0].y, sp[1].x, sp[1].y}, sb1 = (u32x4){sp[2].x, sp[2].y, sp[3].x, sp[3].y}; \
      f32x4 oacc = (f32x4){0.f, 0.f, 0.f, 0.f}, dacc = (f32x4){0.f, 0.f, 0.f, 0.f}; \
_Pragma("unroll") \
      for (int ks = 0; ks < NKD; ++ks) oacc = __builtin_amdgcn_mfma_f32_16x16x32_bf16(ldfrag(STc, LD_D, vt * 16 + fr, ks * 64 + fq * 16), qf[ks], oacc, 0, 0, 0); \
      if (NVT == 3) { \
_Pragma("unroll") \
        for (int ks = 0; ks < NKD; ++ks) dacc = __builtin_amdgcn_mfma_f32_16x16x32_bf16(ldfrag(STc, LD_D, 32 + fr, ks * 64 + fq * 16), qf[ks], dacc, 0, 0, 0); \
      } \
      if (MIXER == MIX_D) { _Pragma("unroll") for (int e_ = 0; e_ < 4; ++e_) { oacc[e_] = FMUL(oacc[e_], rr_cur); dacc[e_] = FMUL(dacc[e_], rr_cur); } } \
      oacc = __builtin_amdgcn_mfma_f32_16x16x32_bf16(ldfrag2(VTc, LD_T, vt * 16 + fr, fq * 8, 32 + fq * 8), __builtin_bit_cast(bf16x8, sb0), oacc, 0, 0, 0); \
      if (it >= 2) oacc = __builtin_amdgcn_mfma_f32_16x16x32_bf16(ldfrag2(VTc, LD_T, vt * 16 + fr, 64 + fq * 8, 96 + fq * 8), __builtin_bit_cast(bf16x8, sb1), oacc, 0, 0, 0); \
      float dn = 1.0f; \
      if (NVT == 3) { \
        dacc = __builtin_amdgcn_mfma_f32_16x16x32_bf16(ldfrag2(VTc, LD_T, 32 + fr, fq * 8, 32 + fq * 8), __builtin_bit_cast(bf16x8, sb0), dacc, 0, 0, 0); \
        if (it >= 2) dacc = __builtin_amdgcn_mfma_f32_16x16x32_bf16(ldfrag2(VTc, LD_T, 32 + fr, 64 + fq * 8, 96 + fq * 8), __builtin_bit_cast(bf16x8, sb1), dacc, 0, 0, 0); \
        const float den = __shfl(dacc[0], fr); \
        dn = 1.0f / fmaxf(fabsf(den), EMc[it * 16 + fr]); \
      } \
      { \
        const int i = it * 16 + fr; \
        const int ti = dir ? (SEQ - 1 - (n * 64 + i)) : (n * 64 + i); \
        const f32x4 o = (f32x4){FMUL(oacc[0], dn), FMUL(oacc[1], dn), FMUL(oacc[2], dn), FMUL(oacc[3], dn)}; \
        *(u32x2*)(O + PIDX(tokbase + ti, ocol + vt * 16 + fq * 4)) = (u32x2){pk_hw(o[0], o[1]), pk_hw(o[2], o[3])}; \
      } \
      const int dts = (DK == 128) ? wid : (wid & 3); \
      const bf16x8 kf0 = ldfrag(KTc, LD_T, dts * 16 + fr, fq * 16), kf1 = ldfrag(KTc, LD_T, dts * 16 + fr, 64 + fq * 16); \
      const f32x4 dc = *(const f32x4*)(DECc + dts * 16 + fq * 4); \
_Pragma("unroll") \
      for (int s = 0; s < NST; ++s) { \
        const int dt = dts, vt2 = (DK == 128) ? s : (wid >> 2); \
        f32x4 acc = (f32x4){FMUL(sacc[s][0], dc[0]), FMUL(sacc[s][1], dc[1]), FMUL(sacc[s][2], dc[2]), FMUL(sacc[s][3], dc[3])}; \
        acc = __builtin_amdgcn_mfma_f32_16x16x32_bf16(kf0, ldfrag(VTc, LD_T, vt2 * 16 + fr, fq * 16), acc, 0, 0, 0); \
        acc = __builtin_amdgcn_mfma_f32_16x16x32_bf16(kf1, ldfrag(VTc, LD_T, vt2 * 16 + fr, 64 + fq * 16), acc, 0, 0, 0); \
        sacc[s] = acc; \
        *(u32x2*)(STn + (vt2 * 16 + fr) * LD_D + (dt * 16 + fq * 4) * 2) = (u32x2){pk_hw(acc[0], acc[1]), pk_hw(acc[2], acc[3])}; \
      } \
    } \
    } \
    rr_cur = rr_next; \
    lds_barrier(); \
  } while (0)
  static_assert(NCH % 2 == 0, "chunk count must be even");
#pragma unroll 1
  for (int n2 = 0; n2 < NCH; n2 += 2) { SCAN_ITER(n2, R, Rv); SCAN_ITER(n2 + 1, Rn, Rvn); }
#undef SCAN_ITER
#undef A_LOAD
#undef A_PREP
}

template <int MIXER>
__device__ __forceinline__ void scan_dispatch2(unsigned char* lds, int wv, const Params& p, int id) {
  const int vs = id & 3, dir = (id >> 2) & 1, h = (id >> 3) & 3, b = id >> 5;
  scan_item2<MIXER>(lds, wv, p, b, h, dir, vs);
}
}

__device__ __forceinline__ void scan_phase2(unsigned char* lds, int wv, const Params& p, int layer) {
  for (int it0 = blockIdx.x; it0 < 256; it0 += gridDim.x) {
    const int xq = it0 & 7, yq = it0 >> 3, stream = (yq >> 2) * 8 + xq;
    const int item = (stream >> 5) * 128 + (stream & 31) * 4 + (yq & 3);
    if (layer == 0) { if (item < 128) scan2::scan_dispatch2<scan::MIX_A>(lds, wv, p, item); else scan2::scan_dispatch2<scan::MIX_B>(lds, wv, p, item - 128); }
    else { if (item < 128) scan2::scan_dispatch2<scan::MIX_D>(lds, wv, p, item); else scan2::scan_dispatch2<scan::MIX_C>(lds, wv, p, item - 128); }
    __syncthreads();
  }
}
#endif
#ifndef CPU_EMU
#define XB_BASE     2048
#define XB_TMO      (XB_BASE + 128)
#define XB_XCNT(j)  (XB_BASE + 256  + 64 * (j))
#define XB_XSUB(j)  (XB_BASE + 1280 + 64 * (j))
#define XB_XGEN(j)  (XB_BASE + 2304 + 64 * (j))
#define XB_TOP      (XB_BASE + 3328)
#define XB_TOPGEN   (XB_BASE + 3392)
#define XB_WORDS    3456
#define XB_SPIN_CAP (1u << 22)
#define XB_LDS_OFF  (LDS_BYTES - 16)
__device__ __forceinline__ unsigned xb_ld(unsigned* p)              { return __hip_atomic_load(p, __ATOMIC_RELAXED, __HIP_MEMORY_SCOPE_AGENT); }
__device__ __forceinline__ unsigned xb_add(unsigned* p, unsigned v) { return __hip_atomic_fetch_add(p, v, __ATOMIC_RELAXED, __HIP_MEMORY_SCOPE_AGENT); }
__device__ __forceinline__ unsigned xb_xcc_id() { return (unsigned)__builtin_amdgcn_s_getreg((3 << 11) | 20) & 0xFu; }
#define XB_SPIN(cond, bar) do { unsigned _sp = 0; while (cond) { __builtin_amdgcn_s_sleep(1); \
    if ((++_sp & 255u) == 0u) { if (xb_ld(&(bar)[XB_TMO])) break; if (_sp > XB_SPIN_CAP) { atomicAdd(&(bar)[XB_TMO], 1u); break; } } } } while (0)
__device__ __forceinline__ void grid_bar(unsigned* bar, unsigned char* lds_raw, int wv) {
  asm volatile("s_waitcnt vmcnt(0)" ::: "memory");
  __syncthreads();
  if (wv == 0 && lane_id() == 0) {
    volatile unsigned* st = (volatile unsigned*)(lds_raw + XB_LDS_OFF);
    __builtin_amdgcn_s_waitcnt(0);
    const unsigned x = xb_xcc_id();
    unsigned nloc = st[0], nx = st[1];
    if (nloc == 0u) {
      const unsigned G = gridDim.x; unsigned sum, cnt, mine, sp = 0u;
      for (;;) { sum = 0u; cnt = 0u; mine = 0u;
#pragma unroll
        for (unsigned j = 0; j < 16; ++j) { const unsigned c = xb_ld(&bar[XB_XCNT(j)]); sum += c; cnt += (c > 0u) ? 1u : 0u; mine = (j == x) ? c : mine; }
        if (sum == G) break;
        __builtin_amdgcn_s_sleep(1);
        if ((++sp & 255u) == 0u) { if (xb_ld(&bar[XB_TMO])) break; if (sp > XB_SPIN_CAP) { atomicAdd(&bar[XB_TMO], 1u); break; } } }
      nloc = mine > 0u ? mine : 1u; nx = cnt > 0u ? cnt : 1u; st[0] = nloc; st[1] = nx;
    }
    const unsigned old = xb_add(&bar[XB_XSUB(x)], 1u);
    const unsigned gen = old / nloc;
    if (old + 1u == (gen + 1u) * nloc) {
      __builtin_amdgcn_fence(__ATOMIC_RELEASE, "agent");
      asm volatile("s_waitcnt vmcnt(0)" ::: "memory");
      const unsigned og = xb_add(&bar[XB_TOP], 1u);
      const unsigned tg = og / nx;
      if (og + 1u == (tg + 1u) * nx) xb_add(&bar[XB_TOPGEN], 1u);
      else XB_SPIN(xb_ld(&bar[XB_TOPGEN]) == tg, bar);
      __builtin_amdgcn_fence(__ATOMIC_ACQUIRE, "agent");
      xb_add(&bar[XB_XGEN(x)], 1u);
      asm volatile("s_waitcnt vmcnt(0)" ::: "memory");
    } else {
      XB_SPIN(xb_ld(&bar[XB_XGEN(x)]) == gen, bar);
      __builtin_amdgcn_fence(__ATOMIC_ACQUIRE, "agent");
      asm volatile("s_waitcnt vmcnt(0)" ::: "memory");
    }
  }
  __syncthreads();
}
#if (PROBE_DUP & 16)
#define grid_bar(a, b, c) do { grid_bar(a, b, c); grid_bar(a, b, c); } while (0)
#endif

__global__ void __launch_bounds__(NTHREADS) mk_fwd(Params p) {
  extern __shared__ __attribute__((aligned(16))) unsigned char lds_raw[];
  cg::grid_group grid = cg::this_grid();
  const int G = gridDim.x, bid = blockIdx.x;
  const int wv = __builtin_amdgcn_readfirstlane(threadIdx.x >> 6);
  PG8_LAS unsigned char* lds = (PG8_LAS unsigned char*)lds_raw;
  unsigned char* ws = p.ws;

  if (threadIdx.x < 4) ((unsigned*)(lds_raw + XB_LDS_OFF))[threadIdx.x] = 0u;
  p0_prologue(lds_raw, wv, p);
#if (PROBE_DUP & 128)
  p0_prologue(lds_raw, wv, p);
#endif
  grid.sync();
  unsigned* bar = (unsigned*)(ws + WS_CTL);
  if (wv == 0 && lane_id() == 0) (void)xb_add(&bar[XB_XCNT(xb_xcc_id())], 1u);
  for (int layer = 0; layer < 2; ++layer) {
    { ProbInProj pr; pr.so.init(NTOK, layer == 0 ? PM_AB : PM_CD, G, bid); pr.A = (const char*)(ws + WS_HB); pr.Bt = (const char*)(ws + (layer == 0 ? WS_WIN_AB : WS_WIN_CD));
      pr.P = (bf16_t*)(ws + WS_R1); pr.bias = p.in[layer == 0 ? I_AB_B_IN : I_CD_B_IN]; pr.lb = (const float*)(ws + WS_LB); pr.layer = layer;
      pg8::gemm_phase(lds, pr, wv);
#if (PROBE_DUP & (1 | 2048))
      pg8::gemm_phase(lds, pr, wv);
#endif
      if (layer == 0) side_phase<32>(lds_raw, wv, p, 0); else side_phase<16>(lds_raw, wv, p, 1);
#if (PROBE_DUP & 256)
      if (layer == 0) side_phase<32>(lds_raw, wv, p, 0); else side_phase<16>(lds_raw, wv, p, 1);
#endif
 }
    grid_bar(bar, lds_raw, wv);
    if (layer == 1) { convd_phase(lds_raw, wv, p); grid_bar(bar, lds_raw, wv); }
    scan_phase2(lds_raw, wv, p, layer);
#if (PROBE_DUP & 2)
    scan_phase2(lds_raw, wv, p, layer);
#endif
#if (PROBE_DUP & 512)
    if (layer == 0) scan_phase2(lds_raw, wv, p, layer);
#endif
#if (PROBE_DUP & 1024)
    if (layer == 1) scan_phase2(lds_raw, wv, p, layer);
#endif
    grid_bar(bar, lds_raw, wv);
    headnorm_phase(lds_raw, wv, p, layer);
#if (PROBE_DUP & 8)
    headnorm_phase(lds_raw, wv, p, layer);
#endif
    grid_bar(bar, lds_raw, wv);
    { ProbOutProj pr; pr.so.init(NTOK, 1024, G, bid); pr.A = (const char*)(ws + WS_HB); pr.Bt = (const char*)(ws + (layer == 0 ? WS_WOUT_AB : WS_WOUT_CD)); pr.Y = (float*)(ws + WS_R2); pr.Hres = layer == 0 ? p.in[I_X] : p.out;
      pg8::gemm_phase(lds, pr, wv);
#if (PROBE_DUP & (1 | 16384))
      pg8::gemm_phase(lds, pr, wv);
#endif
      moe_weight_convert(lds_raw, wv, p, layer);
#if (PROBE_DUP & 4)
      moe_weight_convert(lds_raw, wv, p, layer);
#endif
 }
    grid_bar(bar, lds_raw, wv);
#if (PROBE_DUP & 32)
    ln_phase(lds_raw, wv, p, layer, 0, 1);
#endif
    ln_phase(lds_raw, wv, p, layer, 0);
    grid_bar(bar, lds_raw, wv);
    { ProbMoe1 pr; pr.mo.init((const int*)((const unsigned*)(ws + WS_CTL) + CW_CNT(layer)), 8, G, bid, lds_raw, wv);
      pr.A = (const char*)(ws + WS_HB); pr.W13 = (const char*)(ws + WS_WMOE); pr.list = (const int*)(ws + WS_LIST) + (size_t)layer * NEXP * NTOK; pr.H = (bf16_t*)(ws + WS_H);
      pg8::gemm_phase(lds, pr, wv);
#if (PROBE_DUP & (1 | 4096))
      pg8::gemm_phase(lds, pr, wv);
#endif
 }
    grid_bar(bar, lds_raw, wv);
    { ProbMoe2 pr; pr.mo.init((const int*)((const unsigned*)(ws + WS_CTL) + CW_CNT(layer)), 4, G, bid, lds_raw, wv);
      pr.A = (const char*)(ws + WS_H); pr.W2 = (const char*)(ws + WS_WMOE) + (size_t)NEXP * 2048 * 1024 * 2; pr.Y = (bf16_t*)(ws + WS_R2);
      pg8::gemm_phase(lds, pr, wv);
#if (PROBE_DUP & (1 | 8192))
      pg8::gemm_phase(lds, pr, wv);
#endif
 }
    grid_bar(bar, lds_raw, wv);
#if (PROBE_DUP & 64)
    ln_phase(lds_raw, wv, p, layer, 1, 1);
#endif
    ln_phase(lds_raw, wv, p, layer, 1);
    if (layer == 0) grid_bar(bar, lds_raw, wv);
  }
}

extern "C" void kernel_launch(void* const* d_in, const int* in_sizes, int n_in, void* d_out, int out_size, void* d_ws, size_t ws_size, hipStream_t stream) {
  static int grid_blocks = 0;
  if (grid_blocks == 0) {
    if (n_in != N_IN || ws_size < WS_END || out_size != NTOK * 1024) { fprintf(stderr, "kernel_launch: bad shapes: n_in %d ws %zu (need %zu) out %d\n", n_in, ws_size, (size_t)WS_END, out_size); grid_blocks = -1; return; }
    int dev = 0, cus = 0, per_cu = 0;
    hipGetDevice(&dev); hipDeviceGetAttribute(&cus, hipDeviceAttributeMultiprocessorCount, dev);
    if (hipFuncSetAttribute((const void*)mk_fwd, hipFuncAttributeMaxDynamicSharedMemorySize, LDS_BYTES) != hipSuccess) { fprintf(stderr, "kernel_launch: hipFuncSetAttribute failed\n"); grid_blocks = -1; return; }
    if (hipOccupancyMaxActiveBlocksPerMultiprocessor(&per_cu, (const void*)mk_fwd, NTHREADS, LDS_BYTES) != hipSuccess || per_cu < 1) { fprintf(stderr, "kernel_launch: occupancy query failed (%d)\n", per_cu); grid_blocks = -1; return; }
    grid_blocks = cus;
    (void)in_sizes;
  }
  if (grid_blocks < 0) return;
  Params p{};
  for (int i = 0; i < N_IN; ++i) p.in[i] = (const float*)d_in[i];
  p.out = (float*)d_out; p.ws = (unsigned char*)d_ws;
  void* args[] = {&p};
  hipError_t e = hipLaunchCooperativeKernel((const void*)mk_fwd, dim3(grid_blocks), dim3(NTHREADS), args, LDS_BYTES, stream);
  if (e != hipSuccess) fprintf(stderr, "cooperative launch failed: %s (grid %d)\n", hipGetErrorString(e), grid_blocks);
}
#endif
```

```cpp
#ifdef CPU_EMU
#include <cmath>
#include <cstdio>
#include <cstring>
#include <cstdlib>
#include <cstddef>
#define DEV
#define DEV_INLINE static inline
typedef void* hipStream_t;
#else
#include <hip/hip_runtime.h>
#include <hip/hip_bf16.h>
#include <cstdio>
#define DEV __device__ __forceinline__
#define DEV_INLINE __device__ __forceinline__
#endif
#ifndef PROBE_DUP
#define PROBE_DUP 0
#endif
#ifndef BATCH
#define BATCH 4
#endif
#ifndef SEQ
#define SEQ 8192
#endif
#define DM 1024
#define NTOK (BATCH * SEQ)
#define P_AB 4128
#define P_CD 3600
#define PM_AB 4096
#define PM_CD 3584
#define NEXP 16
#define ALPHA_F 1.4142135623730951f
#define LN_EPS_F 1e-5f
#define NORM_EPS_F 1e-6f
#define HROWS (2 * NTOK + NEXP * 256)

typedef unsigned short bf16_t;

DEV_INLINE float bf2f(bf16_t b) { unsigned u = ((unsigned)b) << 16; float f; memcpy(&f, &u, 4); return f; }
DEV_INLINE bf16_t f2bf(float f) { unsigned u; memcpy(&u, &f, 4); u += 0x7FFFu + ((u >> 16) & 1u); return (bf16_t)(u >> 16); }
DEV_INLINE float sigmoidf_(float x) { return 1.0f / (1.0f + expf(-x)); }
DEV_INLINE float siluf_(float x) { return x / (1.0f + expf(-x)); }
DEV_INLINE float logsigmoidf_(float x) { return fminf(x, 0.0f) - log1pf(expf(-fabsf(x))); }

#define AL256(x) (((size_t)(x) + 255) & ~(size_t)255)
#define WS_CTL    ((size_t)0)
#define WS_HB     ((size_t)65536)
#define WS_R1     (WS_HB + (size_t)NTOK * 1024 * 2)
#define R1_P_BYTES ((size_t)NTOK * 4096 * 2)
#define R1_MIN    (AL256((size_t)HROWS * 1024 * 2) + (size_t)NEXP * 3072 * 1024 * 2)
#define R1_PL     (R1_P_BYTES + (size_t)NTOK * 512 * 2)
#define R1_BYTES  (R1_PL > R1_MIN ? R1_PL : R1_MIN)
#define WS_LFB    (WS_R1 + R1_P_BYTES)
#define WS_H      (WS_R1)
#define WS_WMOE   (WS_R1 + AL256((size_t)HROWS * 1024 * 2))
#define WMOE_BYTES ((size_t)NEXP * 3072 * 1024 * 2)
#define WS_R2     (WS_R1 + R1_BYTES)
#define R2_BYTES  ((size_t)HROWS * 1024 * 2 > (size_t)NTOK * 1024 * 4 ? (size_t)HROWS * 1024 * 2 : (size_t)NTOK * 1024 * 4)
#define WS_SIDE   (WS_R2 + AL256(R2_BYTES))
#define WS_OSIDE  (WS_SIDE + (size_t)NTOK * 32 * 4)
#define WS_WIN_AB (WS_OSIDE + (size_t)2 * NTOK * 8 * 4)
#define WS_WIN_CD (WS_WIN_AB + (size_t)4128 * 1024 * 2)
#define WS_WOUT_AB (WS_WIN_CD + (size_t)3600 * 1024 * 2)
#define WS_WOUT_CD (WS_WOUT_AB + (size_t)1024 * 1024 * 2)
#define WS_ROPE   (WS_WOUT_CD + (size_t)1024 * 1024 * 2)
#define WS_LB     (WS_ROPE + (size_t)SEQ * 64 * 4)
#define WS_LIST   (WS_LB + 4096)
#define WS_ASSIGN (WS_LIST + (size_t)2 * NEXP * NTOK * 4)
#define WS_GATE   (WS_ASSIGN + (size_t)NTOK * 16)
#define WS_END    (WS_GATE + (size_t)NTOK * 8)
#define CW_CNT(layer) (64 + 256 * (layer))

#define PSTRIDE 4096
#define PIDX(tok, col) ((((size_t)((col) >> 7)) * NTOK + (size_t)(tok)) * 128 + (size_t)((col) & 127))

enum { I_X, I_AB_W_IN, I_AB_B_IN, I_HGRN_LB, I_GK_UP, I_GK_B, I_HGRN_NORM, I_GLA_NORM, I_AB_W_OUT,
       I_CD_W_IN, I_CD_B_IN, I_CONV_W, I_CONV_B, I_FGATE_B, I_RET_NORM, I_MLSTM_NORM, I_CD_W_OUT,
       I_LN_MIX_G, I_LN_MIX_B, I_LN_FFN_G, I_LN_FFN_B, I_ROUTER_W, I_ROUTER_B, I_MOE_W1, I_MOE_W3, I_MOE_W2, N_IN };

struct Params {
  const float* in[N_IN];
  float* out;
  unsigned char* ws;
};

DEV_INLINE float epi_ab(int col, float v, const float* lb) {
  if (col < 512) return siluf_(v);
  if (col < 1536) { float l = lb[(col - 512) & 511]; return logf(l + (1.0f - l) * sigmoidf_(v)); }
  if (col >= 2560 && col < 2816) return v * 0.125f;
  return v;
}

DEV_INLINE void route_from_logits(const float* lg, const float* rb, int* e_out, float* g_out) {
  float mx = lg[0];
#pragma unroll
  for (int e = 1; e < 16; ++e) mx = fmaxf(mx, lg[e]);
  float sc[16]; float sum = 0.f;
#pragma unroll
  for (int e = 0; e < 16; ++e) { sc[e] = expf(lg[e] - mx); sum += sc[e]; }
  float inv = 1.0f / sum;
  float best_gs = -1e30f; int be1 = 0, be2 = 1; float bs1 = 0.f, bs2 = 0.f;
#pragma unroll
  for (int gq = 0; gq < 4; ++gq) {
    float m1 = -1e30f, m2 = -1e30f, s1 = 0.f, s2 = 0.f; int i1 = 0, i2 = 0;
#pragma unroll
    for (int i = 0; i < 4; ++i) {
      float s = sc[gq * 4 + i] * inv; float v = s + rb[gq * 4 + i];
      if (v > m1) { m2 = m1; i2 = i1; s2 = s1; m1 = v; i1 = gq * 4 + i; s1 = s; }
      else if (v > m2) { m2 = v; i2 = gq * 4 + i; s2 = s; }
    }
    float gs = m1 + m2;
    if (gs > best_gs) { best_gs = gs; be1 = i1; be2 = i2; bs1 = s1; bs2 = s2; }
  }
  e_out[0] = be1; e_out[1] = be2; g_out[0] = bs1 / (bs1 + bs2); g_out[1] = bs2 / (bs1 + bs2);
}
#ifndef CPU_EMU
namespace pg8 {
#define PG8_LAS __attribute__((address_space(3)))
typedef short bf16x8 __attribute__((ext_vector_type(8)));
typedef float f32x4 __attribute__((ext_vector_type(4)));
typedef unsigned u32x4 __attribute__((ext_vector_type(4)));
typedef unsigned u32x2 __attribute__((ext_vector_type(2)));
constexpr int BM = 256, BK = 64, HALF = 128, HTB = HALF * BK * 2, STAGE_BYTES = 8 * HTB, NXCD = 8, WGM = 8, GK = 1024;

__device__ __forceinline__ int lds_byte(int r, int c) { const int st = (r >> 4) * 2 + (c >> 5), rr = r & 15, cc = c & 31, ob = rr * 64 + cc * 2; return st * 1024 + (ob ^ (((ob >> 9) & 1) << 5)); }
__device__ __forceinline__ void stage_rc(int b, int& R, int& C) { const int st = b / 1024, sb = b % 1024, swz = sb ^ (((sb >> 9) & 1) << 5); R = (st >> 1) * 16 + swz / 64; C = (st & 1) * 32 + (swz % 64) / 2; }
__device__ __forceinline__ int perm32(int rho) { const int n = rho >> 4, i = rho & 15; return 8 * (i >> 2) + 4 * n + (i & 3); }
__device__ __forceinline__ unsigned cvt_pk_bf16(float lo, float hi) { unsigned r; asm volatile("v_cvt_pk_bf16_f32 %0, %1, %2" : "=v"(r) : "v"(lo), "v"(hi)); return r; }

struct Unit { int pm, pn, e, row0, ne, ui; };

struct StaticOrder {
  int nM, nN, nwg, G, c;
  __device__ void init(int M, int N, int G_, int c_) { nM = M / BM; nN = N / BM; nwg = nM * nN; G = G_; c = c_; }
  __device__ bool next(int i, Unit& u) const {
    const long L = (long)i * G + c; if (L >= nwg) return false;
    int wgid = (int)L; { const int q = nwg / NXCD, r = nwg % NXCD, xcd = wgid % NXCD, off = wgid / NXCD; wgid = (xcd < r ? xcd * (q + 1) : r * (q + 1) + (xcd - r) * q) + off; }
    const int nig = WGM * nN, gid = wgid / nig, fm = gid * WGM, gsz = (nM - fm) < WGM ? (nM - fm) : WGM;
    u.pm = fm + ((wgid % nig) % gsz); u.pn = (wgid % nig) / gsz; u.e = 0; u.row0 = u.pm * BM; u.ne = 0; u.ui = i; return true;
  }
};

template <class Prob>
__device__ __forceinline__ void gemm_phase(PG8_LAS unsigned char* lds, const Prob& S, int wv) {
  int wv_ = wv; asm volatile("" : "+s"(wv_));
  int l_; asm volatile("v_mbcnt_lo_u32_b32 %0, -1, 0\n\tv_mbcnt_hi_u32_b32 %0, -1, %0" : "=v"(l_));
  int tid_ = wv_ * 64 + l_;
  const int tid = tid_, wid = __builtin_amdgcn_readfirstlane(tid >> 6), lane = tid & 63, wr = wid >> 2, wc = wid & 3, fr = lane & 15, fq = lane >> 4;
  constexpr int K = GK, nt = K / BK;
  int sR[2], sC[2]; unsigned voffB[2];
#pragma unroll
  for (int i = 0; i < 2; ++i) { int R, C; stage_rc(tid * 16 + i * 8192, R, C); sR[i] = R; sC[i] = C; const int Rb = Prob::PERM ? ((R & ~31) + perm32(R & 31)) : R; voffB[i] = (unsigned)(Rb * K + C) * 2u; }
  const size_t kstep = (size_t)(BK * 2);
  const size_t hstep = (size_t)HALF * K * 2;
  const unsigned ldsw = (unsigned)wid * 1024u;
  const int aoff = lds_byte(wr * 64 + fr, fq * 8), boff = lds_byte(wc * 32 + fr, fq * 8);
#define PG8_SA(b, h) (((b) * 2 + (h)) * HTB)
#define PG8_SB(b, h) ((4 + (b) * 2 + (h)) * HTB)
#define PG8_STAGE(bufoff, gbase, voff) do { _Pragma("unroll") for (int _i = 0; _i < 2; ++_i) \
    __builtin_amdgcn_global_load_lds((const unsigned*)((const char*)(gbase) + (voff)[_i]), (PG8_LAS unsigned*)(lds + (bufoff) + ldsw + _i * 8192), 16, 0, 0); } while (0)
#define PG8_LDA(dst, b, h) do { _Pragma("unroll") for (int m = 0; m < 4; ++m) _Pragma("unroll") for (int k = 0; k < 2; ++k) dst[m][k] = *(const PG8_LAS bf16x8*)(lds + PG8_SA(b, h) + aoff + m * 2048 + k * 1024); } while (0)
#define PG8_LDB(dst, b, h) do { _Pragma("unroll") for (int n = 0; n < 2; ++n) _Pragma("unroll") for (int k = 0; k < 2; ++k) dst[n][k] = *(const PG8_LAS bf16x8*)(lds + PG8_SB(b, h) + boff + n * 2048 + k * 1024); } while (0)
#define PG8_MMA(ai, bj, At, Bt) do { __builtin_amdgcn_s_setprio(1); _Pragma("unroll") for (int m = 0; m < 4; ++m) _Pragma("unroll") for (int n = 0; n < 2; ++n) _Pragma("unroll") for (int k = 0; k < 2; ++k) \
    acc[ai][bj][m][n] = __builtin_amdgcn_mfma_f32_16x16x32_bf16(Bt[n][k], At[m][k], acc[ai][bj][m][n], 0, 0, 0); __builtin_amdgcn_s_setprio(0); } while (0)
#define PG8_WAIT_V(n) asm volatile("s_waitcnt vmcnt(" #n ")" ::: "memory")
#define PG8_WAIT_L(n) asm volatile("s_waitcnt lgkmcnt(" #n ")" ::: "memory")
#define PG8_BAR __builtin_amdgcn_s_barrier()
#define PG8_SCHED __builtin_amdgcn_sched_barrier(0)
  Unit cur, nxt; int ui = 0;
  if (!S.next(0, cur)) return;
  f32x4 acc[2][2][4][2];
#pragma unroll
  for (int a = 0; a < 2; ++a)
#pragma unroll
    for (int b = 0; b < 2; ++b)
#pragma unroll
      for (int m = 0; m < 4; ++m)
#pragma unroll
        for (int n = 0; n < 2; ++n) acc[a][b][m][n] = (f32x4){0.f, 0.f, 0.f, 0.f};
  bf16x8 At[4][2], B0[2][2], B1[2][2];
  unsigned oc0[2], oc1[2], on0[2], on1[2];
#pragma unroll
  for (int i = 0; i < 2; ++i) { oc0[i] = S.a_off(cur, sR[i]) + (unsigned)sC[i] * 2u; oc1[i] = S.a_off(cur, HALF + sR[i]) + (unsigned)sC[i] * 2u; }
  const char* const Ab = S.a_base();
  const char* cB = S.b_base(cur);
  PG8_STAGE(PG8_SB(0, 0), cB, voffB); PG8_STAGE(PG8_SB(0, 1), cB + hstep, voffB); PG8_STAGE(PG8_SA(0, 0), Ab, oc0); PG8_STAGE(PG8_SA(0, 1), Ab, oc1);
  if (wr == 1) PG8_BAR;
  PG8_WAIT_V(2); PG8_BAR;
  PG8_STAGE(PG8_SB(1, 0), cB + kstep, voffB); PG8_STAGE(PG8_SA(1, 0), Ab + kstep, oc0); PG8_STAGE(PG8_SB(1, 1), cB + hstep + kstep, voffB);
  PG8_WAIT_V(6); PG8_BAR;
  for (;;) {
    const bool has_next = S.next(ui + 1, nxt);
    const char* nB = cB;
    if (has_next) {
      nB = S.b_base(nxt);
      int l2_; asm volatile("v_mbcnt_lo_u32_b32 %0, -1, 0\n\tv_mbcnt_hi_u32_b32 %0, -1, %0" : "=v"(l2_));
      const int tid2 = wid * 64 + l2_;
#pragma unroll
      for (int i = 0; i < 2; ++i) { int R, C; stage_rc(tid2 * 16 + i * 8192, R, C); on0[i] = S.a_off(nxt, R) + (unsigned)C * 2u; on1[i] = S.a_off(nxt, HALF + R) + (unsigned)C * 2u; }
    } else {
#pragma unroll
      for (int i = 0; i < 2; ++i) { on0[i] = oc0[i]; on1[i] = oc1[i]; }
    }
    for (int t = 0; t < nt; t += 2) {
      const bool last = (t == nt - 2);
      const char* a1 = Ab + (size_t)(t + 1) * kstep;
      const char* a2 = last ? Ab : Ab + (size_t)(t + 2) * kstep; const char* b2 = last ? nB : cB + (size_t)(t + 2) * kstep;
      const char* a3 = a2 + kstep; const char* b3 = b2 + kstep;
      unsigned o20[2], o21[2];
#pragma unroll
      for (int i = 0; i < 2; ++i) { o20[i] = last ? on0[i] : oc0[i]; o21[i] = last ? on1[i] : oc1[i]; }
      PG8_LDB(B0, 0, 0); PG8_LDB(B1, 0, 1); PG8_SCHED; PG8_LDA(At, 0, 0); PG8_STAGE(PG8_SA(1, 1), a1, oc1);
      PG8_WAIT_V(8); PG8_WAIT_L(0); PG8_BAR; PG8_MMA(0, 0, At, B0); PG8_MMA(0, 1, At, B1); PG8_BAR; PG8_SCHED;
      PG8_LDA(At, 0, 1); PG8_STAGE(PG8_SB(0, 0), b2, voffB); PG8_STAGE(PG8_SB(0, 1), b2 + hstep, voffB); PG8_STAGE(PG8_SA(0, 0), a2, o20);
      PG8_WAIT_V(8); PG8_WAIT_L(0); PG8_BAR; PG8_MMA(1, 0, At, B0); PG8_MMA(1, 1, At, B1); PG8_BAR; PG8_SCHED;
      PG8_LDB(B0, 1, 0); PG8_LDB(B1, 1, 1); PG8_SCHED; PG8_LDA(At, 1, 0); PG8_STAGE(PG8_SA(0, 1), a2, o21);
      PG8_WAIT_V(8); PG8_WAIT_L(0); PG8_BAR; PG8_MMA(0, 0, At, B0); PG8_MMA(0, 1, At, B1); PG8_BAR; PG8_SCHED;
      PG8_LDA(At, 1, 1); PG8_STAGE(PG8_SB(1, 0), b3, voffB); PG8_STAGE(PG8_SB(1, 1), b3 + hstep, voffB); PG8_STAGE(PG8_SA(1, 0), a3, o20);
      PG8_WAIT_V(8); PG8_WAIT_L(0); PG8_BAR; PG8_MMA(1, 0, At, B0); PG8_MMA(1, 1, At, B1); PG8_BAR; PG8_SCHED;
    }
    if (wr == 0) PG8_BAR;
    { int l3_; asm volatile("v_mbcnt_lo_u32_b32 %0, -1, 0\n\tv_mbcnt_hi_u32_b32 %0, -1, %0" : "=v"(l3_));
      S.epi(acc, cur, wr, wc, l3_ & 15, l3_ >> 4); }
    if (!has_next) break;
#pragma unroll
    for (int a = 0; a < 2; ++a)
#pragma unroll
      for (int b = 0; b < 2; ++b)
#pragma unroll
        for (int m = 0; m < 4; ++m)
#pragma unroll
          for (int n = 0; n < 2; ++n) acc[a][b][m][n] = (f32x4){0.f, 0.f, 0.f, 0.f};
    cur = nxt; cB = nB; ++ui;
#pragma unroll
    for (int i = 0; i < 2; ++i) { oc0[i] = on0[i]; oc1[i] = on1[i]; }
    if (wr == 1) PG8_BAR;
  }
  PG8_WAIT_V(0);
  PG8_BAR;
#undef PG8_SA
#undef PG8_SB
#undef PG8_STAGE
#undef PG8_LDA
#undef PG8_LDB
#undef PG8_MMA
#undef PG8_WAIT_V
#undef PG8_WAIT_L
#undef PG8_BAR
#undef PG8_SCHED
}
}
#endif
#ifndef CPU_EMU
#include <hip/hip_cooperative_groups.h>
namespace cg = cooperative_groups;
#define LAS __attribute__((address_space(3)))
#define NTHREADS 512
#define LDS_BYTES (154 * 1024)
typedef float f32x4 __attribute__((ext_vector_type(4)));
typedef short bf16x8 __attribute__((ext_vector_type(8)));
typedef unsigned u32x4 __attribute__((ext_vector_type(4)));
typedef unsigned u32x2 __attribute__((ext_vector_type(2)));

struct Ctx { int tid, lane, wid, G, bid; unsigned char* lds; };
__device__ __forceinline__ int lane_id() { int l; asm volatile("v_mbcnt_lo_u32_b32 %0, -1, 0\n\tv_mbcnt_hi_u32_b32 %0, -1, %0" : "=v"(l)); return l; }
__device__ __forceinline__ int opaque_tid(int wv) { int w = wv; asm volatile("" : "+s"(w)); int t = w * 64 + lane_id(); asm volatile("" : "+v"(t)); return t; }
__device__ __forceinline__ Ctx make_ctx(unsigned char* lds, int wv) { Ctx c; c.tid = opaque_tid(wv); c.lane = c.tid & 63; c.wid = __builtin_amdgcn_readfirstlane(c.tid >> 6); c.G = gridDim.x; c.bid = blockIdx.x; c.lds = lds; return c; }

__device__ __forceinline__ float wave_sum(float x) {
  x += __builtin_bit_cast(float, __builtin_amdgcn_update_dpp(0, __builtin_bit_cast(int, x), 0x111, 0xf, 0xf, false));
  x += __builtin_bit_cast(float, __builtin_amdgcn_update_dpp(0, __builtin_bit_cast(int, x), 0x112, 0xf, 0xf, false));
  x += __builtin_bit_cast(float, __builtin_amdgcn_update_dpp(0, __builtin_bit_cast(int, x), 0x114, 0xf, 0xf, false));
  x += __builtin_bit_cast(float, __builtin_amdgcn_update_dpp(0, __builtin_bit_cast(int, x), 0x118, 0xf, 0xf, false));
  x += __builtin_bit_cast(float, __builtin_amdgcn_update_dpp(0, __builtin_bit_cast(int, x), 0x142, 0xa, 0xf, false));
  x += __builtin_bit_cast(float, __builtin_amdgcn_update_dpp(0, __builtin_bit_cast(int, x), 0x143, 0xc, 0xf, false));
  return __builtin_bit_cast(float, __builtin_amdgcn_readlane(__builtin_bit_cast(int, x), 63));
}
__device__ __forceinline__ float fsigmoid(float x) { return __builtin_amdgcn_rcpf(1.0f + __builtin_amdgcn_exp2f(-1.4426950408889634f * x)); }
__device__ __forceinline__ float fsilu(float x) { return x * fsigmoid(x); }
__device__ __forceinline__ float flog2sigmoid(float x) { const float y = x * 1.4426950408889634f; return fminf(y, 0.f) - __builtin_amdgcn_logf(1.0f + __builtin_amdgcn_exp2f(-fabsf(y))); }
typedef float f32x2_t __attribute__((ext_vector_type(2)));
typedef __bf16 bf16x2_t __attribute__((ext_vector_type(2)));
__device__ __forceinline__ unsigned pk_hw(float a, float b) { const f32x2_t v = {a, b}; return __builtin_bit_cast(unsigned, __builtin_convertvector(v, bf16x2_t)); }
__device__ __forceinline__ unsigned pk2(float a, float b) { return pk_hw(a, b); }
__device__ __forceinline__ void unpack8(u32x4 w, float* f) {
  f[0] = __uint_as_float(w.x << 16); f[1] = __uint_as_float(w.x & 0xffff0000u); f[2] = __uint_as_float(w.y << 16); f[3] = __uint_as_float(w.y & 0xffff0000u);
  f[4] = __uint_as_float(w.z << 16); f[5] = __uint_as_float(w.z & 0xffff0000u); f[6] = __uint_as_float(w.w << 16); f[7] = __uint_as_float(w.w & 0xffff0000u);
}

__device__ __forceinline__ void transpose_job(const Ctx& c, const float* src, int N, bf16_t* dst, int rs, int ro, int tile0, int tile_stride) {
  float* t = (float*)c.lds;
  const int ntn = (N + 63) / 64, ntiles = ntn * 16;
  for (int tl = tile0; tl < ntiles; tl += tile_stride) {
    const int kt = tl / ntn, nt_ = tl % ntn, k0 = kt * 64, n0 = nt_ * 64;
    __syncthreads();
#pragma unroll
    for (int i = 0; i < 8; ++i) { const int idx = c.tid + i * 512, kk = idx >> 6, nn = idx & 63; t[kk * 65 + nn] = (n0 + nn < N) ? src[(size_t)(k0 + kk) * N + n0 + nn] : 0.f; }
    __syncthreads();
#pragma unroll
    for (int i = 0; i < 4; ++i) { const int idx = c.tid + i * 512, nn = idx >> 5, kp = (idx & 31) * 2;
      if (n0 + nn < N) *(unsigned*)(dst + (size_t)((n0 + nn) * rs + ro) * 1024 + k0 + kp) = pk2(t[kp * 65 + nn], t[(kp + 1) * 65 + nn]); }
  }
  __syncthreads();
}
__device__ __forceinline__ void p0_prologue(unsigned char* lds_, int wv, const Params& p) {
  const Ctx c = make_ctx(lds_, wv);
  unsigned char* ws = p.ws;
  if (c.bid == 0) { ((unsigned*)(ws + WS_CTL))[64 + c.tid] = 0u; }
  if (c.bid == 0) { for (int i = c.tid; i < 3456; i += NTHREADS) ((unsigned*)(ws + WS_CTL))[2048 + i] = 0u; }
  { const float* x = p.in[I_X]; bf16_t* hb = (bf16_t*)(ws + WS_HB);
    for (size_t i = (size_t)c.bid * NTHREADS + c.tid; i < (size_t)NTOK * 1024 / 8; i += (size_t)c.G * NTHREADS) {
      const f32x4 a = __builtin_nontemporal_load((const f32x4*)(x + i * 8)), b = __builtin_nontemporal_load((const f32x4*)(x + i * 8 + 4));
      u32x4 w; w.x = pk2(a[0], a[1]); w.y = pk2(a[2], a[3]); w.z = pk2(b[0], b[1]); w.w = pk2(b[2], b[3]);
      *(u32x4*)(hb + i * 8) = w; } }
  transpose_job(c, p.in[I_AB_W_IN], P_AB, (bf16_t*)(ws + WS_WIN_AB), 1, 0, c.bid, c.G);
  transpose_job(c, p.in[I_CD_W_IN], P_CD, (bf16_t*)(ws + WS_WIN_CD), 1, 0, c.bid, c.G);
  transpose_job(c, p.in[I_AB_W_OUT], 1024, (bf16_t*)(ws + WS_WOUT_AB), 1, 0, c.bid, c.G);
  transpose_job(c, p.in[I_CD_W_OUT], 1024, (bf16_t*)(ws + WS_WOUT_CD), 1, 0, c.bid, c.G);
  { float* rope = (float*)(ws + WS_ROPE);
    for (int i = c.bid * NTHREADS + c.tid; i < SEQ * 32; i += c.G * NTHREADS) { const int t = i >> 5, f = i & 31;
      const float freq = powf(10000.0f, -(float)f / 32.0f); const float ang = (float)t * freq; rope[i * 2] = cosf(ang); rope[i * 2 + 1] = sinf(ang); }
    if (c.bid == 1) { const float* hl = p.in[I_HGRN_LB]; float* lb = (float*)(ws + WS_LB);
      const int cc = c.tid; const float a0 = hl[cc], a1 = hl[512 + cc], a2 = hl[1024 + cc]; const float mx = fmaxf(a0, fmaxf(a1, a2));
      const float e0 = expf(a0 - mx), e1 = expf(a1 - mx), e2 = expf(a2 - mx); lb[cc] = e0 / (e0 + e1 + e2); } }
}
__device__ __forceinline__ void moe_weight_convert(unsigned char* lds_, int wv, const Params& p, int layer) {
  const Ctx c = make_ctx(lds_, wv);
  bf16_t* w13 = (bf16_t*)(p.ws + WS_WMOE); bf16_t* w2 = w13 + (size_t)NEXP * 2048 * 1024;
  const size_t lo = (size_t)layer * NEXP * 1024 * 1024;
  const float* W1 = p.in[I_MOE_W1] + lo; const float* W3 = p.in[I_MOE_W3] + lo; const float* W2 = p.in[I_MOE_W2] + lo;
  float* t = (float*)c.lds;
  constexpr int NT = 48 * 128;
  const int lk = c.tid >> 5, ln4 = (c.tid & 31) * 4;
  const int sn = c.tid & 127, sk = (c.tid >> 7) * 8;
  f32x4 r[4];
#define MW_SRC(g_) ((((g_) >> 7) % 3 == 0 ? W1 : (((g_) >> 7) % 3 == 1 ? W3 : W2)) + (size_t)(((g_) >> 7) / 3) * 1048576 + (size_t)((((g_) & 127) >> 3) * 64) * 1024 + ((g_) & 7) * 128)
#define MW_LOAD(g_) do { const float* s_ = MW_SRC(g_); _Pragma("unroll") for (int i = 0; i < 4; ++i) r[i] = __builtin_nontemporal_load((const f32x4*)(s_ + (size_t)(lk + 16 * i) * 1024 + ln4)); } while (0)
  int g0 = c.bid;
  if (g0 < NT) MW_LOAD(g0);
  for (; g0 < NT; g0 += c.G) {
    __syncthreads();
#pragma unroll
    for (int i = 0; i < 4; ++i) { float* d = t + (lk + 16 * i) * 129 + ln4; d[0] = r[i][0]; d[1] = r[i][1]; d[2] = r[i][2]; d[3] = r[i][3]; }
    __syncthreads();
    const int gn = g0 + c.G;
    if (gn < NT) MW_LOAD(gn);
    const int m = g0 >> 7, e = m / 3, which = m % 3, k0 = ((g0 & 127) >> 3) * 64, n0 = (g0 & 7) * 128;
    bf16_t* drow = (which == 2) ? w2 + ((size_t)e * 1024 + n0 + sn) * 1024 : w13 + ((size_t)e * 2048 + 2 * (n0 + sn) + which) * 1024;
#pragma unroll
    for (int j = 0; j < 2; ++j) { const int kk = sk + 32 * j; const float* s = t + kk * 129 + sn;
      u32x4 w; w.x = pk2(s[0], s[129]); w.y = pk2(s[2 * 129], s[3 * 129]); w.z = pk2(s[4 * 129], s[5 * 129]); w.w = pk2(s[6 * 129], s[7 * 129]);
      *(u32x4*)(drow + k0 + kk) = w; }
  }
#undef MW_SRC
#undef MW_LOAD
  __syncthreads();
}

struct ProbInProj {
  static constexpr bool PERM = true;
  pg8::StaticOrder so; const char* A; const char* Bt; bf16_t* P; const float* bias; const float* lb; int layer;
  __device__ __forceinline__ bool next(int i, pg8::Unit& u) const { return so.next(i, u); }
  __device__ __forceinline__ const char* a_base() const { return A; }
  __device__ __forceinline__ unsigned a_off(const pg8::Unit& u, int r) const { return (unsigned)(u.pm * 256 + r) * 2048u; }
  __device__ __forceinline__ const char* b_base(const pg8::Unit& u) const { return Bt + (size_t)u.pn * 256 * 2048; }
  __device__ __forceinline__ void epi(const f32x4 (&acc)[2][2][4][2], const pg8::Unit& u, int wr, int wc, int fr, int fq) const {
    const int row0 = u.row0 + wr * 64 + fr, colb = u.pn * 256 + wc * 32 + 8 * fq;
    int mode = 0;
    if (layer == 0) { mode = u.pn < 2 ? 1 : (u.pn < 6 ? 2 : (u.pn == 10 ? 3 : 0)); }
#pragma unroll
    for (int bj = 0; bj < 2; ++bj) {
      const int col0 = colb + bj * 128;
      const f32x4 b0 = *(const f32x4*)(bias + col0), b1 = *(const f32x4*)(bias + col0 + 4);
      f32x4 l0 = (f32x4){0.f, 0.f, 0.f, 0.f}, l1 = l0;
      if (mode == 2) { l0 = *(const f32x4*)(lb + ((col0 - 512) & 511)); l1 = *(const f32x4*)(lb + ((col0 - 512) & 511) + 4); }
#pragma unroll
      for (int ai = 0; ai < 2; ++ai)
#pragma unroll
        for (int m = 0; m < 4; ++m) {
          f32x4 v0 = acc[ai][bj][m][0] + b0, v1 = acc[ai][bj][m][1] + b1;
          if (mode == 1) {
#pragma unroll
            for (int j = 0; j < 4; ++j) { v0[j] = fsilu(v0[j]); v1[j] = fsilu(v1[j]); }
          } else if (mode == 2) {
#pragma unroll
            for (int j = 0; j < 4; ++j) { v0[j] = __builtin_amdgcn_logf(l0[j] + (1.0f - l0[j]) * fsigmoid(v0[j])); v1[j] = __builtin_amdgcn_logf(l1[j] + (1.0f - l1[j]) * fsigmoid(v1[j])); }
          } else if (mode == 3) { v0 *= 0.125f; v1 *= 0.125f; }
          u32x4 w; w.x = pk2(v0[0], v0[1]); w.y = pk2(v0[2], v0[3]); w.z = pk2(v1[0], v1[1]); w.w = pk2(v1[2], v1[3]);
          *(u32x4*)(P + PIDX(row0 + ai * 128 + m * 16, col0)) = w;
        }
    }
  }
};
struct ProbOutProj {
  static constexpr bool PERM = false;
  pg8::StaticOrder so; const char* A; const char* Bt; float* Y; const float* Hres;
  __device__ __forceinline__ bool next(int i, pg8::Unit& u) const { return so.next(i, u); }
  __device__ __forceinline__ const char* a_base() const { return A; }
  __device__ __forceinline__ unsigned a_off(const pg8::Unit& u, int r) const { return (unsigned)(u.pm * 256 + r) * 2048u; }
  __device__ __forceinline__ const char* b_base(const pg8::Unit& u) const { return Bt + (size_t)u.pn * 256 * 2048; }
  __device__ __forceinline__ void epi(const f32x4 (&acc)[2][2][4][2], const pg8::Unit& u, int wr, int wc, int fr, int fq) const {
    const int row0 = u.row0 + wr * 64 + fr, col0 = u.pn * 256 + wc * 32 + 4 * fq;
#pragma unroll
    for (int ai = 0; ai < 2; ++ai)
#pragma unroll
      for (int m = 0; m < 4; ++m) { const size_t ro = (size_t)(row0 + ai * 128 + m * 16) * 1024 + col0; float* rowp = Y + ro; const float* hp = Hres + ro;
#pragma unroll
        for (int bj = 0; bj < 2; ++bj)
#pragma unroll
          for (int n = 0; n < 2; ++n) *(f32x4*)(rowp + bj * 128 + n * 16) = acc[ai][bj][m][n] + ALPHA_F * *(const f32x4*)(hp + bj * 128 + n * 16); }
  }
};
#define MOE_TAB_OFF (128 * 1024)
struct MoeOrder {
  const int* tab;
  __device__ __forceinline__ void init(const int* cnt, int ntn, int G, int c, unsigned char* lds, int wv) {
    int* t = (int*)(lds + MOE_TAB_OFF);
    const int tid = opaque_tid(wv);
    if (tid < 64) {
      int pad = 0, found = 0, ue = 0, upn = 0, upm = 0, urow = 0, une = 0;
      if ((G & 7) == 0) {
        const int x = c & 7; int q = tid * (G >> 3) + (c >> 3);
        for (int e = 0; e < NEXP; ++e) { const int n = cnt[e * 16], mt = (n + 255) >> 8; const int r = ((x - e) % 8 + 8) % 8; const int m = mt > r ? (mt - r - 1) / 8 + 1 : 0; const int units = m * ntn;
          if (!found && q < units) { ue = e; upm = r + 8 * (q % m); upn = q / m; urow = pad + upm * 256; une = n; found = 1; }
          if (!found) { q -= units; pad += mt * 256; } }
      } else {
        int L = tid * G + c;
        for (int e = 0; e < NEXP; ++e) { const int n = cnt[e * 16], mt = (n + 255) >> 8, tiles = mt * ntn;
          if (!found && L < tiles) { ue = e; upn = L / mt; upm = L % mt; urow = pad + upm * 256; une = n; found = 1; }
          if (!found) { L -= tiles; pad += mt * 256; } }
      }
      t[tid * 8 + 0] = found; t[tid * 8 + 1] = ue; t[tid * 8 + 2] = upn; t[tid * 8 + 3] = upm; t[tid * 8 + 4] = urow; t[tid * 8 + 5] = une;
    }
    __syncthreads();
    tab = t;
  }
  __device__ __forceinline__ bool next(int i, pg8::Unit& u) const {
    if (i >= 64) return false;
    const int* t = tab + i * 8;
    if (!__builtin_amdgcn_readfirstlane(t[0])) return false;
    u.e = __builtin_amdgcn_readfirstlane(t[1]); u.pn = __builtin_amdgcn_readfirstlane(t[2]); u.pm = __builtin_amdgcn_readfirstlane(t[3]);
    u.row0 = __builtin_amdgcn_readfirstlane(t[4]); u.ne = __builtin_amdgcn_readfirstlane(t[5]); u.ui = i; return true;
  }
};
struct ProbMoe1 {
  static constexpr bool PERM = true;
  MoeOrder mo; const char* A; const char* W13; const int* list; bf16_t* H; const int* ltok;
  __device__ __forceinline__ void stage_tokens(unsigned char* lds, int wv) {
    int* lt = (int*)(lds + MOE_TAB_OFF + 2048);
    const int tid = opaque_tid(wv);
    pg8::Unit u;
    for (int i = 0; i < 16 && mo.next(i, u); ++i) { if (tid < 256) { const int rr = u.pm * 256 + tid; lt[i * 256 + tid] = rr < u.ne ? list[u.e * NTOK + rr] : 0; } }
    __syncthreads();
    ltok = lt;
  }
  __device__ __forceinline__ bool next(int i, pg8::Unit& u) const { return mo.next(i, u); }
  __device__ __forceinline__ const char* a_base() const { return A; }
  __device__ __forceinline__ unsigned a_off(const pg8::Unit& u, int r) const { const int rr = u.pm * 256 + r; const int tok = rr < u.ne ? list[u.e * NTOK + rr] : 0; return (unsigned)tok * 2048u; }
  __device__ __forceinline__ const char* b_base(const pg8::Unit& u) const { return W13 + ((size_t)u.e * 2048 + (size_t)u.pn * 256) * 2048; }
  __device__ __forceinline__ void epi(const f32x4 (&acc)[2][2][4][2], const pg8::Unit& u, int wr, int wc, int fr, int fq) const {
    const int row0 = u.row0 + wr * 64 + fr, colb = u.pn * 128 + wc * 16 + 4 * fq;
#pragma unroll
    for (int ai = 0; ai < 2; ++ai)
#pragma unroll
      for (int m = 0; m < 4; ++m)
#pragma unroll
        for (int bj = 0; bj < 2; ++bj) {
          const f32x4 v0 = acc[ai][bj][m][0], v1 = acc[ai][bj][m][1];
          u32x2 w; w.x = pk2(fsilu(v0[0]) * v0[1], fsilu(v0[2]) * v0[3]); w.y = pk2(fsilu(v1[0]) * v1[1], fsilu(v1[2]) * v1[3]);
          *(u32x2*)(H + (size_t)(row0 + ai * 128 + m * 16) * 1024 + colb + bj * 64) = w;
        }
  }
};
struct ProbMoe2 {
  static constexpr bool PERM = true;
  MoeOrder mo; const char* A; const char* W2; bf16_t* Y;
  __device__ __forceinline__ bool next(int i, pg8::Unit& u) const { return mo.next(i, u); }
  __device__ __forceinline__ const char* a_base() const { return A; }
  __device__ __forceinline__ unsigned a_off(const pg8::Unit& u, int r) const { return (unsigned)(u.row0 + r) * 2048u; }
  __device__ __forceinline__ const char* b_base(const pg8::Unit& u) const { return W2 + ((size_t)u.e * 1024 + (size_t)u.pn * 256) * 2048; }
  __device__ __forceinline__ void epi(const f32x4 (&acc)[2][2][4][2], const pg8::Unit& u, int wr, int wc, int fr, int fq) const {
    const int row0 = u.row0 + wr * 64 + fr, colb = u.pn * 256 + wc * 32 + 8 * fq;
#pragma unroll
    for (int ai = 0; ai < 2; ++ai)
#pragma unroll
      for (int m = 0; m < 4; ++m)
#pragma unroll
        for (int bj = 0; bj < 2; ++bj) {
          const f32x4 v0 = acc[ai][bj][m][0], v1 = acc[ai][bj][m][1];
          u32x4 w; w.x = pk2(v0[0], v0[1]); w.y = pk2(v0[2], v0[3]); w.z = pk2(v1[0], v1[1]); w.w = pk2(v1[2], v1[3]);
          *(u32x4*)(Y + (size_t)(row0 + ai * 128 + m * 16) * 1024 + colb + bj * 128) = w;
        }
  }
};

template <int NS>
__device__ __forceinline__ void side_phase(unsigned char* lds_, int wv, const Params& p, int layer) {
  const Ctx c = make_ctx(lds_, wv);
  const bf16_t* hb = (const bf16_t*)(p.ws + WS_HB);
  const bf16_t* wt = (const bf16_t*)(p.ws + (layer == 0 ? WS_WIN_AB : WS_WIN_CD)) + (size_t)(layer == 0 ? PM_AB : PM_CD) * 1024;
  const float* bias = p.in[layer == 0 ? I_AB_B_IN : I_CD_B_IN] + (layer == 0 ? PM_AB : PM_CD);
  float* side = (float*)(p.ws + WS_SIDE);
  float* tl = (float*)c.lds + c.wid * (16 * 33);
  const int fr = c.lane & 15, fq = c.lane >> 4;
  for (int g = c.bid * 8 + c.wid; g < NTOK / 16; g += c.G * 8) {
    const int r0 = g * 16;
    f32x4 acc0 = (f32x4){0.f, 0.f, 0.f, 0.f}, acc1 = acc0;
    const bf16_t* ap = hb + (size_t)(r0 + fr) * 1024 + fq * 8;
    const bf16_t* bp0 = wt + (size_t)fr * 1024 + fq * 8; const bf16_t* bp1 = bp0 + 16 * 1024;
#pragma unroll 16
    for (int k = 0; k < 1024; k += 32) {
      const bf16x8 a = *(const bf16x8*)(ap + k), b0 = *(const bf16x8*)(bp0 + k);
      acc0 = __builtin_amdgcn_mfma_f32_16x16x32_bf16(a, b0, acc0, 0, 0, 0);
      if (NS == 32) { const bf16x8 b1 = *(const bf16x8*)(bp1 + k); acc1 = __builtin_amdgcn_mfma_f32_16x16x32_bf16(a, b1, acc1, 0, 0, 0); }
    }
    float gsc = 1.f, gfb = 0.f; bool gls = false;
    if (NS == 16) { gsc = 1.4426950408889634f; gls = (fr & 4) != 0; gfb = gls ? p.in[I_FGATE_B][(fr >> 3) * 4 + (fr & 3)] : 0.f; }
#pragma unroll
    for (int j = 0; j < 4; ++j) { float v0 = acc0[j] + bias[fr]; if (NS == 16) v0 = gls ? flog2sigmoid(v0 + gfb) : v0 * gsc; side[(size_t)(r0 + fq * 4 + j) * 32 + fr] = v0; tl[(fq * 4 + j) * 33 + fr] = v0;
      if (NS == 32) { const float v1 = acc1[j] + bias[16 + fr]; side[(size_t)(r0 + fq * 4 + j) * 32 + 16 + fr] = v1; tl[(fq * 4 + j) * 33 + 16 + fr] = v1; } }
    if (NS == 32) {
      __builtin_amdgcn_s_waitcnt(0xC07F);
      const float* gu = p.in[I_GK_UP]; const float* gb = p.in[I_GK_B]; bf16_t* lfb = (bf16_t*)(p.ws + WS_LFB);
      const int cb = c.lane * 8, dir = cb >> 8, cc = cb & 255;
      float w[16][8];
#pragma unroll
      for (int r = 0; r < 16; ++r)
#pragma unroll
        for (int j = 0; j < 8; ++j) w[r][j] = gu[(dir * 16 + r) * 256 + cc + j];
      float bb[8];
#pragma unroll
      for (int j = 0; j < 8; ++j) bb[j] = gb[dir * 256 + cc + j];
      for (int row = 0; row < 16; ++row) {
        float z[8];
#pragma unroll
        for (int j = 0; j < 8; ++j) z[j] = bb[j];
#pragma unroll
        for (int r = 0; r < 16; ++r) { const float s = tl[row * 33 + dir * 16 + r];
#pragma unroll
          for (int j = 0; j < 8; ++j) z[j] += s * w[r][j]; }
        u32x4 o; o.x = pk2(flog2sigmoid(z[0]) * 0.0625f, flog2sigmoid(z[1]) * 0.0625f); o.y = pk2(flog2sigmoid(z[2]) * 0.0625f, flog2sigmoid(z[3]) * 0.0625f);
        o.z = pk2(flog2sigmoid(z[4]) * 0.0625f, flog2sigmoid(z[5]) * 0.0625f); o.w = pk2(flog2sigmoid(z[6]) * 0.0625f, flog2sigmoid(z[7]) * 0.0625f);
        *(u32x4*)(lfb + PIDX(r0 + row, cb)) = o;
      }
    }
  }
}

__device__ __forceinline__ void headnorm_phase(unsigned char* lds_, int wv, const Params& p, int layer) {
  const Ctx c = make_ctx(lds_, wv);
  const bf16_t* P = (const bf16_t*)(p.ws + WS_R1); const bf16_t* O = (const bf16_t*)(p.ws + WS_R2);
  bf16_t* mixed = (bf16_t*)(p.ws + WS_HB);
  const int c0 = c.lane * 16, h8 = c.lane >> 3;
  const float* gain = layer == 0 ? (h8 < 4 ? p.in[I_HGRN_NORM] + c0 : p.in[I_GLA_NORM] + c0 - 512) : (h8 < 4 ? p.in[I_RET_NORM] + c0 : p.in[I_MLSTM_NORM] + c0 - 512);
  const int gcol = layer == 0 ? (h8 < 4 ? 2048 + c0 : 3584 + c0 - 512) : (h8 < 4 ? 1024 + c0 : 3072 + c0 - 512);
  float gn[16];
#pragma unroll
  for (int j = 0; j < 16; ++j) gn[j] = gain[j];
  for (int tok = c.bid * 8 + c.wid; tok < NTOK; tok += c.G * 8) {
    float of[16], ob[16], gt[16];
    { const u32x4* a = (const u32x4*)(O + PIDX(tok, c0)); unpack8(__builtin_nontemporal_load(a), of); unpack8(__builtin_nontemporal_load(a + 1), of + 8);
      const u32x4* b = (const u32x4*)(O + (size_t)NTOK * 1024 + PIDX(tok, c0)); unpack8(__builtin_nontemporal_load(b), ob); unpack8(__builtin_nontemporal_load(b + 1), ob + 8);
      const u32x4* g = (const u32x4*)(P + PIDX(tok, gcol)); unpack8(__builtin_nontemporal_load(g), gt); unpack8(__builtin_nontemporal_load(g + 1), gt + 8); }
    const float sf = 1.f, sb = 1.f;
    float o[16]; float ss = 0.f;
#pragma unroll
    for (int j = 0; j < 16; ++j) { o[j] = of[j] * sf + ob[j] * sb; ss += o[j] * o[j]; }
    ss += __shfl_xor(ss, 1); ss += __shfl_xor(ss, 2); ss += __shfl_xor(ss, 4);
    const float r = 1.0f / sqrtf(ss * (1.0f / 128.0f) + NORM_EPS_F);
    unsigned w[8];
#pragma unroll
    for (int j = 0; j < 8; ++j) {
      float g0 = gt[2 * j], g1 = gt[2 * j + 1];
      if (layer == 1 && h8 >= 4) { g0 = fsigmoid(g0); g1 = fsigmoid(g1); } else { g0 = fsilu(g0); g1 = fsilu(g1); }
      w[j] = pk2(o[2 * j] * r * gn[2 * j] * g0, o[2 * j + 1] * r * gn[2 * j + 1] * g1);
    }
    u32x4* d = (u32x4*)(mixed + (size_t)tok * 1024 + c0);
    d[0] = (u32x4){w[0], w[1], w[2], w[3]}; d[1] = (u32x4){w[4], w[5], w[6], w[7]};
  }
}

__device__ __forceinline__ void ln_phase(unsigned char* lds_, int wv, const Params& p, int layer, int mode, int dry = 0) {
  const Ctx c = make_ctx(lds_, wv);
  unsigned char* ws = p.ws;
  const float* hin = (mode == 0 && layer == 0) ? p.in[I_X] : p.out;
  float* hout = dry ? (float*)(ws + WS_H) : p.out; bf16_t* hb = (bf16_t*)(ws + WS_HB);
  const float* g = p.in[mode == 0 ? I_LN_MIX_G : I_LN_FFN_G] + layer * 1024; const float* b = p.in[mode == 0 ? I_LN_MIX_B : I_LN_FFN_B] + layer * 1024;
  unsigned* cnt = (unsigned*)(ws + WS_CTL) + CW_CNT(layer);
  int* list = (int*)(ws + WS_LIST) + (size_t)layer * NEXP * NTOK;
  int* assign = (int*)(ws + WS_ASSIGN); float* gate = (float*)(ws + WS_GATE);
  float* rwT = (float*)c.lds;
  int* lcnt = (int*)(c.lds + 65536); int* lbase = lcnt + 16; int* rec = lcnt + 32; float* recg = (float*)(rec + 4 * 2048);
  int pad[NEXP];
  if (mode == 0) { const float* r = p.in[I_ROUTER_W];
    for (int i = c.tid; i < 1024 * 16; i += NTHREADS) rwT[(i & 15) * 1024 + (i >> 4)] = r[i];
    if (c.tid < 16) lcnt[c.tid] = 0;
    __syncthreads(); }
  else { int acc = 0;
#pragma unroll
    for (int e = 0; e < NEXP; ++e) { pad[e] = acc; acc += (((int)cnt[e * 16] + 255) >> 8) << 8; } }
  const int c0 = c.lane * 4;
  float gv[16], bv[16];
#pragma unroll
  for (int q = 0; q < 4; ++q) { const f32x4 t0 = *(const f32x4*)(g + q * 256 + c0), t1 = *(const f32x4*)(b + q * 256 + c0);
#pragma unroll
    for (int j = 0; j < 4; ++j) { gv[4 * q + j] = t0[j]; bv[4 * q + j] = t1[j]; } }
  const int tstride = c.G * 8;
  int it = 0;
  for (int tok0 = c.bid * 8 + c.wid; tok0 < NTOK; tok0 += 2 * tstride, it += 2) {
    float v[2][16];
    float gy0[2], gy1[2];
#pragma unroll
    for (int u = 0; u < 2; ++u) {
      const int tok = tok0 + u * tstride;
      if (tok < NTOK) {
        if (mode == 0) {
#pragma unroll
          for (int q = 0; q < 4; ++q) { const f32x4 t = __builtin_nontemporal_load((const f32x4*)((const float*)(ws + WS_R2) + (size_t)tok * 1024 + q * 256 + c0)); v[u][4 * q] = t[0]; v[u][4 * q + 1] = t[1]; v[u][4 * q + 2] = t[2]; v[u][4 * q + 3] = t[3]; }
        } else {
#pragma unroll
          for (int q = 0; q < 4; ++q) { const f32x4 t = *(const f32x4*)(hin + (size_t)tok * 1024 + q * 256 + c0); v[u][4 * q] = ALPHA_F * t[0]; v[u][4 * q + 1] = ALPHA_F * t[1]; v[u][4 * q + 2] = ALPHA_F * t[2]; v[u][4 * q + 3] = ALPHA_F * t[3]; }
          const int a0 = assign[tok * 4], a1 = assign[tok * 4 + 1], a2 = assign[tok * 4 + 2], a3 = assign[tok * 4 + 3];
          gy0[u] = gate[tok * 2]; gy1[u] = gate[tok * 2 + 1];
          int p0 = 0, p1 = 0;
#pragma unroll
          for (int e = 0; e < NEXP; ++e) { if (e == a0) p0 = pad[e]; if (e == a2) p1 = pad[e]; }
          p0 += a1; p1 += a3;
          const bf16_t* Y = (const bf16_t*)(ws + WS_R2);
#pragma unroll
          for (int q = 0; q < 4; ++q) { const u32x2 y0 = __builtin_nontemporal_load((const u32x2*)(Y + (size_t)p0 * 1024 + q * 256 + c0)), y1 = __builtin_nontemporal_load((const u32x2*)(Y + (size_t)p1 * 1024 + q * 256 + c0));
            v[u][4 * q] += gy0[u] * __uint_as_float(y0.x << 16) + gy1[u] * __uint_as_float(y1.x << 16); v[u][4 * q + 1] += gy0[u] * __uint_as_float(y0.x & 0xffff0000u) + gy1[u] * __uint_as_float(y1.x & 0xffff0000u);
            v[u][4 * q + 2] += gy0[u] * __uint_as_float(y0.y << 16) + gy1[u] * __uint_as_float(y1.y << 16); v[u][4 * q + 3] += gy0[u] * __uint_as_float(y0.y & 0xffff0000u) + gy1[u] * __uint_as_float(y1.y & 0xffff0000u); }
        }
      } else {
#pragma unroll
        for (int j = 0; j < 16; ++j) v[u][j] = 0.f;
      }
    }
#pragma unroll
    for (int u = 0; u < 2; ++u) {
      const int tok = tok0 + u * tstride;
      float s = 0.f;
#pragma unroll
      for (int j = 0; j < 16; ++j) s += v[u][j];
      const float mean = wave_sum(s) * (1.0f / 1024.0f);
      float qq = 0.f;
#pragma unroll
      for (int j = 0; j < 16; ++j) { v[u][j] -= mean; qq += v[u][j] * v[u][j]; }
      const float r = 1.0f / sqrtf(wave_sum(qq) * (1.0f / 1024.0f) + LN_EPS_F);
#pragma unroll
      for (int j = 0; j < 16; ++j) v[u][j] = v[u][j] * r * gv[j] + bv[j];
      if (tok < NTOK) {
#pragma unroll
        for (int q = 0; q < 4; ++q) __builtin_nontemporal_store((f32x4){v[u][4 * q], v[u][4 * q + 1], v[u][4 * q + 2], v[u][4 * q + 3]}, (f32x4*)(hout + (size_t)tok * 1024 + q * 256 + c0));
        if (!(mode == 1 && layer == 1) && !dry) {
#pragma unroll
          for (int q = 0; q < 4; ++q) *(u32x2*)(hb + (size_t)tok * 1024 + q * 256 + c0) = (u32x2){pk2(v[u][4 * q], v[u][4 * q + 1]), pk2(v[u][4 * q + 2], v[u][4 * q + 3])}; }
      }
      if (mode == 0) {
        float lg[16];
#pragma unroll
        for (int e = 0; e < 16; ++e) { float a = 0.f;
#pragma unroll
          for (int q = 0; q < 4; ++q) { const f32x4 w = *(const f32x4*)(rwT + e * 1024 + q * 256 + c0); a += v[u][4 * q] * w[0] + v[u][4 * q + 1] * w[1] + v[u][4 * q + 2] * w[2] + v[u][4 * q + 3] * w[3]; }
          lg[e] = a; }
#pragma unroll
        for (int e = 0; e < 16; ++e) lg[e] = wave_sum(lg[e]);
        int eo[2]; float go[2];
        route_from_logits(lg, p.in[I_ROUTER_B], eo, go);
        if (c.lane == 0 && tok < NTOK && !dry) {
          const int r1 = atomicAdd(lcnt + eo[0], 1), r2 = atomicAdd(lcnt + eo[1], 1);
          const int ri = (it + u) * 8 + c.wid;
          rec[ri * 4] = eo[0]; rec[ri * 4 + 1] = r1; rec[ri * 4 + 2] = eo[1]; rec[ri * 4 + 3] = r2; recg[ri * 2] = go[0]; recg[ri * 2 + 1] = go[1];
        }
      }
    }
  }
  if (mode == 0 && !dry) {
    __syncthreads();
    if (c.tid < 16) lbase[c.tid] = (int)atomicAdd(cnt + c.tid * 16, (unsigned)lcnt[c.tid]);
    __syncthreads();
    const int nrec = ((NTOK + c.G * 8 - 1) / (c.G * 8)) * 8;
    for (int ri = c.tid; ri < nrec; ri += NTHREADS) {
      const int tok = c.bid * 8 + (ri & 7) + (ri >> 3) * c.G * 8;
      if (tok < NTOK) {
        const int e1 = rec[ri * 4], e2 = rec[ri * 4 + 2]; const int r1 = rec[ri * 4 + 1] + lbase[e1], r2 = rec[ri * 4 + 3] + lbase[e2];
        list[e1 * NTOK + r1] = tok; list[e2 * NTOK + r2] = tok;
        assign[tok * 4] = e1; assign[tok * 4 + 1] = r1; assign[tok * 4 + 2] = e2; assign[tok * 4 + 3] = r2;
        gate[tok * 2] = recg[ri * 2]; gate[tok * 2 + 1] = recg[ri * 2 + 1];
      }
    }
  }
  __syncthreads();
}
#endif
#ifndef CPU_EMU
namespace scan {
typedef short bf16x8 __attribute__((ext_vector_type(8)));
typedef float f32x4 __attribute__((ext_vector_type(4)));
typedef unsigned u32x4 __attribute__((ext_vector_type(4)));
typedef unsigned u32x2 __attribute__((ext_vector_type(2)));
enum { MIX_A = 0, MIX_B = 1, MIX_C = 2, MIX_D = 3 };
constexpr int LD_T = 144;
constexpr int OFF_QS = 0, OFF_KS = 17408, OFF_QI = 34816, OFF_KT = 52224, OFF_VT = 70656, OFF_SC = 77568, OFF_ST = 86784, OFF_DEC = 99840, OFF_EM = 100352, OFF_DEN = 100608, OFF_CW = 100864, SCAN_LDS = 104960;

__device__ __forceinline__ float incl_scan_add(float x) {
  x += __builtin_bit_cast(float, __builtin_amdgcn_update_dpp(0, __builtin_bit_cast(int, x), 0x111, 0xf, 0xf, false));
  x += __builtin_bit_cast(float, __builtin_amdgcn_update_dpp(0, __builtin_bit_cast(int, x), 0x112, 0xf, 0xf, false));
  x += __builtin_bit_cast(float, __builtin_amdgcn_update_dpp(0, __builtin_bit_cast(int, x), 0x114, 0xf, 0xf, false));
  x += __builtin_bit_cast(float, __builtin_amdgcn_update_dpp(0, __builtin_bit_cast(int, x), 0x118, 0xf, 0xf, false));
  x += __builtin_bit_cast(float, __builtin_amdgcn_update_dpp(0, __builtin_bit_cast(int, x), 0x142, 0xa, 0xf, false));
  x += __builtin_bit_cast(float, __builtin_amdgcn_update_dpp(0, __builtin_bit_cast(int, x), 0x143, 0xc, 0xf, false));
  return x;
}
__device__ __forceinline__ float incl_scan_max(float x) {
  const int ninf = (int)0xff800000u;
  x = fmaxf(x, __builtin_bit_cast(float, __builtin_amdgcn_update_dpp(ninf, __builtin_bit_cast(int, x), 0x111, 0xf, 0xf, false)));
  x = fmaxf(x, __builtin_bit_cast(float, __builtin_amdgcn_update_dpp(ninf, __builtin_bit_cast(int, x), 0x112, 0xf, 0xf, false)));
  x = fmaxf(x, __builtin_bit_cast(float, __builtin_amdgcn_update_dpp(ninf, __builtin_bit_cast(int, x), 0x114, 0xf, 0xf, false)));
  x = fmaxf(x, __builtin_bit_cast(float, __builtin_amdgcn_update_dpp(ninf, __builtin_bit_cast(int, x), 0x118, 0xf, 0xf, false)));
  x = fmaxf(x, __builtin_bit_cast(float, __builtin_amdgcn_update_dpp(ninf, __builtin_bit_cast(int, x), 0x142, 0xa, 0xf, false)));
  x = fmaxf(x, __builtin_bit_cast(float, __builtin_amdgcn_update_dpp(ninf, __builtin_bit_cast(int, x), 0x143, 0xc, 0xf, false)));
  return x;
}
__device__ __forceinline__ float rdlane(float x, int l) { return __builtin_bit_cast(float, __builtin_amdgcn_readlane(__builtin_bit_cast(int, x), l)); }
__device__ __forceinline__ bf16x8 ldfrag(const unsigned char* base, int ld, int row, int kbyte) { return *(const bf16x8*)(base + row * ld + kbyte); }
__device__ __forceinline__ bf16x8 ldfrag2(const unsigned char* base, int ld, int row, int b0, int b1) {
  const u32x2 lo = *(const u32x2*)(base + row * ld + b0), hi = *(const u32x2*)(base + row * ld + b1);
  return __builtin_bit_cast(bf16x8, (u32x4){lo.x, lo.y, hi.x, hi.y}); }
__device__ __forceinline__ unsigned pk(float a, float b) { return pk_hw(a, b); }
__device__ __forceinline__ float lo16(unsigned w) { return __uint_as_float(w << 16); }
__device__ __forceinline__ float hi16(unsigned w) { return __uint_as_float(w & 0xffff0000u); }

__device__ __forceinline__ void lds_barrier() { asm volatile("s_waitcnt lgkmcnt(0)" ::: "memory"); __builtin_amdgcn_s_barrier(); asm volatile("" ::: "memory"); }
struct Raw { u32x4 a0, a1, b0, b1; f32x4 r0, r1; u32x2 v; float s0, s1; };

}

__device__ __forceinline__ void convd_phase(unsigned char* lds_, int wv, const Params& p) {
  const Ctx c = make_ctx(lds_, wv);
  bf16_t* P = (bf16_t*)(p.ws + WS_R1); bf16_t* QD = (bf16_t*)(p.ws + WS_LFB);
  const float* cw = p.in[I_CONV_W]; const float* cb = p.in[I_CONV_B];
  const int ch = c.lane * 16;
  float w0[16], w1[16], w2[16], bb[16];
#pragma unroll
  for (int j = 0; j < 16; ++j) { w0[j] = cw[ch + j]; w1[j] = cw[1024 + ch + j]; w2[j] = cw[2048 + ch + j]; bb[j] = cb[ch + j]; }
  for (int tok = c.bid * 8 + c.wid; tok < NTOK; tok += c.G * 8) {
    const int t = tok % SEQ;
    const bf16_t* row = P + PIDX(tok, 1536 + ch);
    float x0[16], x1[16], x2[16];
    { const u32x4* r1 = (const u32x4*)row; unpack8(r1[0], x1); unpack8(r1[1], x1 + 8); }
    if (t > 0) { const u32x4* r0 = (const u32x4*)(row - 128); unpack8(r0[0], x0); unpack8(r0[1], x0 + 8); }
    else {
#pragma unroll
      for (int j = 0; j < 16; ++j) x0[j] = 0.f; }
    if (t < SEQ - 1) { const u32x4* r2 = (const u32x4*)(row + 128); unpack8(r2[0], x2); unpack8(r2[1], x2 + 8); }
    else {
#pragma unroll
      for (int j = 0; j < 16; ++j) x2[j] = 0.f; }
    const float sc = ch < 512 ? 0.08838834764831845f : 1.0f;
    unsigned w[8];
#pragma unroll
    for (int j = 0; j < 8; ++j) {
      const float a0 = bb[2 * j] + w0[2 * j] * x0[2 * j] + w1[2 * j] * x1[2 * j] + w2[2 * j] * x2[2 * j];
      const float a1 = bb[2 * j + 1] + w0[2 * j + 1] * x0[2 * j + 1] + w1[2 * j + 1] * x1[2 * j + 1] + w2[2 * j + 1] * x2[2 * j + 1];
      w[j] = pk2(fsilu(a0) * sc, fsilu(a1) * sc);
    }
    u32x4* d = (ch < 512) ? (u32x4*)(QD + PIDX(tok, ch)) : (u32x4*)(P + PIDX(tok, 3584 + (ch - 512)));
    d[0] = (u32x4){w[0], w[1], w[2], w[3]}; d[1] = (u32x4){w[4], w[5], w[6], w[7]};
  }
}

#endif
#ifndef CPU_EMU
namespace scan2 {
using namespace scan;
__device__ __forceinline__ float FMUL(float a, float b) { float r = a * b; asm("" : "+v"(r)); return r; }
constexpr int U_QI = 0, U_KS = 34816, U_KT = 69632, U_VT = 106496, U_SC = 120320, U_ST = 129536, U_DEC = 155648, U_EM = 156672, U_END = 157184;
template <int MIXER>
__device__ __forceinline__ void scan_item2(unsigned char* lds, int wv, const Params& p, int b, int h, int dir, int vs) {
  constexpr int DK = (MIXER == MIX_A || MIXER == MIX_D) ? 128 : 64;
  constexpr int NC = DK / 8;
  constexpr int LD_D = DK * 2 + 16;
  constexpr int NVT = MIXER == MIX_D ? 3 : 2;
  constexpr int NKD = DK / 32;
  constexpr int NST = (DK == 128) ? NVT : 1;
  constexpr int NCH = SEQ / 64;
  const int tid = opaque_tid(wv), lane0 = tid & 63, wid = __builtin_amdgcn_readfirstlane(tid >> 6);
  unsigned char* ws = p.ws;
  const bf16_t* P = (const bf16_t*)(ws + WS_R1);
  const bf16_t* LFBp = (const bf16_t*)(ws + WS_LFB);
  const float* side = (const float*)(ws + WS_SIDE);
  const float* rope = (const float*)(ws + WS_ROPE);
  bf16_t* O = (bf16_t*)(ws + WS_R2) + (size_t)dir * NTOK * 1024;
  unsigned char* SC = lds + U_SC;
  int qcol, kcol, lfcol, vcol, ocol;
  if (MIXER == MIX_A) { qcol = h * 128; kcol = 0; lfcol = 512 + dir * 512 + h * 128; vcol = 1536 + h * 128 + vs * 32; ocol = h * 128 + vs * 32; }
  else if (MIXER == MIX_B) { qcol = 2560 + h * 64; kcol = 2816 + h * 64; lfcol = dir * 256 + h * 64; vcol = 3072 + h * 128 + vs * 32; ocol = 512 + h * 128 + vs * 32; }
  else if (MIXER == MIX_C) { qcol = h * 64; kcol = 256 + h * 64; lfcol = 0; vcol = 512 + h * 128 + vs * 32; ocol = h * 128 + vs * 32; }
  else { qcol = h * 128; kcol = 3584 + h * 128; lfcol = 0; vcol = 2560 + h * 128 + vs * 32; ocol = 512 + h * 128 + vs * 32; }
  const size_t tokbase = (size_t)b * SEQ;
  const int c0 = (MIXER == MIX_C) ? wid * 4 : wid * NC;
  for (int i = tid; i < 2 * 13056 / 4; i += NTHREADS) ((unsigned*)(lds + U_ST))[i] = 0u;
  for (int i = tid; i < 9216 / 4; i += NTHREADS) ((unsigned*)(lds + U_SC))[i] = 0u;
  if (MIXER == MIX_D) { for (int i = tid; i < 2 * 16 * 64; i += NTHREADS) { const int bf = i >> 10, r = 32 + ((i >> 6) & 15), j = i & 63; *(bf16_t*)(lds + U_VT + bf * 6912 + r * LD_T + j * 2) = (r == 32) ? (bf16_t)0x3F80 : (bf16_t)0; } }
  const float lgam2 = (MIXER == MIX_C) ? log1pf(-exp2f(-(5.0f + 2.0f * (float)h + (float)dir))) * 1.4426950408889634f : 0.f;
  const float fgb = (MIXER == MIX_D) ? p.in[I_FGATE_B][dir * 4 + h] : 0.f;
  float m_st = 0.f;
  __syncthreads();

  Raw R, Rn; u32x2 Rv, Rvn;
#define A_LOAD(R, Rv, n_) do { \
    const int ln_ = lane0; \
    const int t_ = dir ? (SEQ - 1 - ((n_) * 64 + ln_)) : ((n_) * 64 + ln_); \
    const size_t tk_ = tokbase + t_; \
    if (MIXER == MIX_A) { const u32x4* qp_ = (const u32x4*)(P + PIDX(tk_, qcol + c0)); const u32x4* lp_ = (const u32x4*)(P + PIDX(tk_, lfcol + c0)); R.a0 = qp_[0]; R.a1 = qp_[1]; R.b0 = lp_[0]; R.b1 = lp_[1]; } \
    else if (MIXER == MIX_B) { R.a0 = *(const u32x4*)(P + PIDX(tk_, qcol + c0)); R.a1 = *(const u32x4*)(P + PIDX(tk_, kcol + c0)); R.b0 = *(const u32x4*)(LFBp + PIDX(tk_, lfcol + c0)); } \
    else if (MIXER == MIX_C) { const u32x2 qa_ = *(const u32x2*)(P + PIDX(tk_, qcol + c0)), qb_ = *(const u32x2*)(P + PIDX(tk_, qcol + 32 + c0)), ka_ = *(const u32x2*)(P + PIDX(tk_, kcol + c0)), kb_ = *(const u32x2*)(P + PIDX(tk_, kcol + 32 + c0)); \
      R.a0 = (u32x4){qa_.x, qa_.y, qb_.x, qb_.y}; R.a1 = (u32x4){ka_.x, ka_.y, kb_.x, kb_.y}; \
      R.r0 = *(const f32x4*)(rope + ((size_t)t_ * 32 + c0) * 2); R.r1 = *(const f32x4*)(rope + ((size_t)t_ * 32 + c0) * 2 + 4); } \
    else { const u32x4* qp_ = (const u32x4*)(LFBp + PIDX(tk_, qcol + c0)); const u32x4* kp_ = (const u32x4*)(P + PIDX(tk_, kcol + c0)); R.a0 = qp_[0]; R.a1 = qp_[1]; R.b0 = kp_[0]; R.b1 = kp_[1]; \
      R.s0 = side[tk_ * 32 + dir * 8 + h]; R.s1 = side[tk_ * 32 + dir * 8 + 4 + h]; } \
    Rv = *(const u32x2*)(P + PIDX(tk_, vcol + wid * 4)); } while (0)

  float rr_next = 1.f, rr_cur = 1.f;
#define A_PREP(buf_, R, Rv) do { \
    const int lane = lane0; \
    unsigned char* KTb = lds + U_KT + (buf_) * 18432; float* DECb = (float*)(lds + U_DEC + (buf_) * 512); float* EMb = (float*)(lds + U_EM + (buf_) * 256); \
    unsigned char* QIb = lds + U_QI + (buf_) * 17408; unsigned char* KSb = lds + U_KS + (buf_) * 17408; \
    float q[NC], k[NC], g[NC], ktv[NC]; \
    if (MIXER == MIX_A) { \
      const unsigned qw[8] = {R.a0.x, R.a0.y, R.a0.z, R.a0.w, R.a1.x, R.a1.y, R.a1.z, R.a1.w}, lw[8] = {R.b0.x, R.b0.y, R.b0.z, R.b0.w, R.b1.x, R.b1.y, R.b1.z, R.b1.w}; \
      _Pragma("unroll") for (int c = 0; c < 8; ++c) { q[2 * c] = lo16(qw[c]); q[2 * c + 1] = hi16(qw[c]); g[2 * c] = lo16(lw[c]); g[2 * c + 1] = hi16(lw[c]); } \
      _Pragma("unroll") for (int c = 0; c < NC; ++c) k[c] = 1.0f - __builtin_amdgcn_exp2f(g[c]); \
    } else if (MIXER == MIX_B) { \
      const unsigned qw[4] = {R.a0.x, R.a0.y, R.a0.z, R.a0.w}, kw[4] = {R.a1.x, R.a1.y, R.a1.z, R.a1.w}, lw[4] = {R.b0.x, R.b0.y, R.b0.z, R.b0.w}; \
      _Pragma("unroll") for (int c = 0; c < 4; ++c) { q[2 * c] = lo16(qw[c]); q[2 * c + 1] = hi16(qw[c]); k[2 * c] = lo16(kw[c]); k[2 * c + 1] = hi16(kw[c]); g[2 * c] = lo16(lw[c]); g[2 * c + 1] = hi16(lw[c]); } \
    } else if (MIXER == MIX_C) { \
      const float cs[4] = {R.r0[0], R.r0[2], R.r1[0], R.r1[2]}, sn[4] = {R.r0[1], R.r0[3], R.r1[1], R.r1[3]}; \
      const float q1[4] = {lo16(R.a0.x), hi16(R.a0.x), lo16(R.a0.y), hi16(R.a0.y)}, q2[4] = {lo16(R.a0.z), hi16(R.a0.z), lo16(R.a0.w), hi16(R.a0.w)}; \
      const float k1[4] = {lo16(R.a1.x), hi16(R.a1.x), lo16(R.a1.y), hi16(R.a1.y)}, k2[4] = {lo16(R.a1.z), hi16(R.a1.z), lo16(R.a1.w), hi16(R.a1.w)}; \
      _Pragma("unroll") for (int c = 0; c < 4; ++c) { q[c] = (q1[c] * cs[c] - q2[c] * sn[c]) * 0.125f; q[4 + c] = (q1[c] * sn[c] + q2[c] * cs[c]) * 0.125f; k[c] = k1[c] * cs[c] - k2[c] * sn[c]; k[4 + c] = k1[c] * sn[c] + k2[c] * cs[c]; } \
    } else { \
      const unsigned qw[8] = {R.a0.x, R.a0.y, R.a0.z, R.a0.w, R.a1.x, R.a1.y, R.a1.z, R.a1.w}, kw[8] = {R.b0.x, R.b0.y, R.b0.z, R.b0.w, R.b1.x, R.b1.y, R.b1.z, R.b1.w}; \
      _Pragma("unroll") for (int c = 0; c < 8; ++c) { q[2 * c] = lo16(qw[c]); q[2 * c + 1] = hi16(qw[c]); k[2 * c] = lo16(kw[c]); k[2 * c + 1] = hi16(kw[c]); } \
    } \
    if (MIXER == MIX_A || MIXER == MIX_B) { \
        \
      _Pragma("unroll") for (int c = 0; c < NC; ++c) g[c] += __builtin_bit_cast(float, __builtin_amdgcn_update_dpp(0, __builtin_bit_cast(int, g[c]), 0x111, 0xf, 0xf, false)); \
      _Pragma("unroll") for (int c = 0; c < NC; ++c) g[c] += __builtin_bit_cast(float, __builtin_amdgcn_update_dpp(0, __builtin_bit_cast(int, g[c]), 0x112, 0xf, 0xf, false)); \
      _Pragma("unroll") for (int c = 0; c < NC; ++c) g[c] += __builtin_bit_cast(float, __builtin_amdgcn_update_dpp(0, __builtin_bit_cast(int, g[c]), 0x114, 0xf, 0xf, false)); \
      _Pragma("unroll") for (int c = 0; c < NC; ++c) g[c] += __builtin_bit_cast(float, __builtin_amdgcn_update_dpp(0, __builtin_bit_cast(int, g[c]), 0x118, 0xf, 0xf, false)); \
      _Pragma("unroll") for (int c = 0; c < NC; ++c) g[c] += __builtin_bit_cast(float, __builtin_amdgcn_update_dpp(0, __builtin_bit_cast(int, g[c]), 0x142, 0xa, 0xf, false)); \
      _Pragma("unroll") for (int c = 0; c < NC; ++c) g[c] += __builtin_bit_cast(float, __builtin_amdgcn_update_dpp(0, __builtin_bit_cast(int, g[c]), 0x143, 0xc, 0xf, false)); \
      float ev[NC]; \
      _Pragma("unroll") for (int c = 0; c < NC; ++c) { \
          \
        const float e = __builtin_amdgcn_exp2f(g[c]), r = __builtin_amdgcn_rcpf(e); \
        const float e63 = rdlane(e, 63); \
        q[c] = FMUL(q[c], e); k[c] = FMUL(k[c], r); ktv[c] = FMUL(k[c], e63);     \
        ev[c] = e; } \
      if (lane == 63) { _Pragma("unroll") for (int c = 0; c < NC / 4; ++c) *(f32x4*)(DECb + c0 + 4 * c) = (f32x4){ev[4 * c], ev[4 * c + 1], ev[4 * c + 2], ev[4 * c + 3]}; } \
    } else if (MIXER == MIX_C) { \
        \
      const float gl = (float)(lane + 1) * lgam2; \
      const float e = __builtin_amdgcn_exp2f(gl), r = __builtin_amdgcn_rcpf(e); \
      const float e63 = rdlane(e, 63); const float f_kt = r * e63; \
      _Pragma("unroll") for (int c = 0; c < NC; ++c) { q[c] = FMUL(q[c], e); ktv[c] = FMUL(k[c], f_kt); k[c] = FMUL(k[c], r); } \
      if (lane < 4) { DECb[c0 + lane] = e63; DECb[32 + c0 + lane] = e63; } \
    } else { \
      const float li = R.s0, lf = R.s1;     \
      const float bc = incl_scan_add(lf); const float u = li - bc; const float pm = incl_scan_max(u); \
      const float cmax = rdlane(pm, 63), blast = rdlane(bc, 63); \
      const float a_i = bc + m_st, m_i = fmaxf(a_i, bc + pm); \
      const float d_alpha = __builtin_amdgcn_exp2f(bc - m_i + cmax), d_beta = __builtin_amdgcn_exp2f(u - cmax); \
      rr_next = __builtin_amdgcn_exp2f(m_st - cmax);     \
      const float m_new = fmaxf(blast + m_st, blast + cmax); \
      const float d_sold = __builtin_amdgcn_exp2f(blast + m_st - m_new), d_wks = __builtin_amdgcn_exp2f(blast + u - m_new); m_st = m_new; \
      _Pragma("unroll") for (int c = 0; c < NC; ++c) { ktv[c] = FMUL(k[c], d_wks); q[c] = FMUL(q[c], d_alpha); k[c] = FMUL(k[c], d_beta); if (lane == 63) DECb[c0 + c] = d_sold; } \
      if (wid == 0) EMb[lane] = __builtin_amdgcn_exp2f(-m_i); \
    } \
    _Pragma("unroll") for (int c = 0; c < NC / 2; ++c) { const unsigned w_ = pk_hw(ktv[2 * c], ktv[2 * c + 1]); \
      const int d0_ = (MIXER == MIX_C) ? (2 * c < 4 ? c0 + 2 * c : 32 + c0 + 2 * c - 4) : c0 + 2 * c; \
      *(bf16_t*)(KTb + d0_ * LD_T + lane * 2) = (bf16_t)(w_ & 0xffff); *(bf16_t*)(KTb + (d0_ + 1) * LD_T + lane * 2) = (bf16_t)(w_ >> 16); } \
    { unsigned pq[NC / 2], pks[NC / 2]; \
      _Pragma("unroll") for (int c = 0; c < NC / 2; ++c) { pq[c] = pk_hw(q[2 * c], q[2 * c + 1]); pks[c] = pk_hw(k[2 * c], k[2 * c + 1]); } \
      if (MIXER == MIX_C) { \
        *(u32x2*)(QIb + lane * LD_D + c0 * 2) = (u32x2){pq[0], pq[1]}; *(u32x2*)(QIb + lane * LD_D + (32 + c0) * 2) = (u32x2){pq[2], pq[3]}; \
        *(u32x2*)(KSb + lane * LD_D + c0 * 2) = (u32x2){pks[0], pks[1]}; *(u32x2*)(KSb + lane * LD_D + (32 + c0) * 2) = (u32x2){pks[2], pks[3]}; \
      } else { \
        _Pragma("unroll") for (int c = 0; c < NC / 8; ++c) { \
          *(u32x4*)(QIb + lane * LD_D + (c0 + 8 * c) * 2) = (u32x4){pq[4 * c], pq[4 * c + 1], pq[4 * c + 2], pq[4 * c + 3]}; \
          *(u32x4*)(KSb + lane * LD_D + (c0 + 8 * c) * 2) = (u32x4){pks[4 * c], pks[4 * c + 1], pks[4 * c + 2], pks[4 * c + 3]}; } } } \
    { unsigned char* VTb = lds + U_VT + (buf_) * 6912 + (wid * 4) * LD_T + lane * 2; \
      *(bf16_t*)(VTb + 0 * LD_T) = (bf16_t)(Rv.x & 0xffff); *(bf16_t*)(VTb + 1 * LD_T) = (bf16_t)(Rv.x >> 16); *(bf16_t*)(VTb + 2 * LD_T) = (bf16_t)(Rv.y & 0xffff); *(bf16_t*)(VTb + 3 * LD_T) = (bf16_t)(Rv.y >> 16); } \
  } while (0)
  f32x4 sacc[NST];
#pragma unroll
  for (int i = 0; i < NST; ++i) sacc[i] = (f32x4){0.f, 0.f, 0.f, 0.f};
  A_LOAD(R, Rv, 0);
  A_PREP(0, R, Rv);
  A_LOAD(R, Rv, 1);
  A_LOAD(Rn, Rvn, 2);
  rr_cur = rr_next;
  lds_barrier();
#define SCAN_ITER(n_, RX, RvX) do { const int n = (n_); \
    const int cb = n & 1, nb = (n + 1) & 1; \
    if (n + 1 < NCH) { A_PREP(nb, RX, RvX); if (n + 3 < NCH) A_LOAD(RX, RvX, n + 3); } \
    { { \
      const int lane = lane0; \
      const int fr = lane & 15, fq = lane >> 4; \
      const int it = wid & 3, vt = wid >> 2; \
      const unsigned char* STc = lds + U_ST + cb * 13056; unsigned char* STn = lds + U_ST + nb * 13056; \
      const unsigned char* KTc = lds + U_KT + cb * 18432; const unsigned char* VTc = lds + U_VT + cb * 6912; \
      const unsigned char* QI = lds + U_QI + cb * 17408; const unsigned char* KS = lds + U_KS + cb * 17408; \
      const float* DECc = (const float*)(lds + U_DEC + cb * 512); const float* EMc = (const float*)(lds + U_EM + cb * 256); \
      bf16x8 qf[NKD]; \
_Pragma("unroll") \
      for (int ks = 0; ks < NKD; ++ks) qf[ks] = ldfrag(QI, LD_D, it * 16 + fr, ks * 64 + fq * 16); \
        \
      u32x2 sp[4]; \
_Pragma("unroll") \
      for (int jt = 0; jt < 4; ++jt) { \
        sp[jt] = (u32x2){0u, 0u}; \
        if (jt <= it) { \
          f32x4 acc = (f32x4){0.f, 0.f, 0.f, 0.f}; \
_Pragma("unroll") \
          for (int ks = 0; ks < NKD; ++ks) acc = __builtin_amdgcn_mfma_f32_16x16x32_bf16(ldfrag(KS, LD_D, jt * 16 + fr, ks * 64 + fq * 16), qf[ks], acc, 0, 0, 0); \
          if (jt == it) { const int i = fr, j0 = fq * 4; \
            const float v0 = (j0 + 0 <= i) ? acc[0] : 0.f, v1 = (j0 + 1 <= i) ? acc[1] : 0.f, v2 = (j0 + 2 <= i) ? acc[2] : 0.f, v3 = (j0 + 3 <= i) ? acc[3] : 0.f; \
            sp[jt] = (u32x2){pk_hw(v0, v1), pk_hw(v2, v3)}; } \
          else sp[jt] = (u32x2){pk_hw(acc[0], acc[1]), pk_hw(acc[2], acc[3])}; \
        } \
      } \
        \
        \
      const u32x4 sb0 = (u32x4){sp[0].x, sp[0].y, sp[1].x, sp[1].y}, sb1 = (u32x4){sp[2].x, sp[2].y, sp[3].x, sp[3].y}; \
      f32x4 oacc = (f32x4){0.f, 0.f, 0.f, 0.f}, dacc = (f32x4){0.f, 0.f, 0.f, 0.f}; \
_Pragma("unroll") \
      for (int ks = 0; ks < NKD; ++ks) oacc = __builtin_amdgcn_mfma_f32_16x16x32_bf16(ldfrag(STc, LD_D, vt * 16 + fr, ks * 64 + fq * 16), qf[ks], oacc, 0, 0, 0); \
      if (NVT == 3) { \
_Pragma("unroll") \
        for (int ks = 0; ks < NKD; ++ks) dacc = __builtin_amdgcn_mfma_f32_16x16x32_bf16(ldfrag(STc, LD_D, 32 + fr, ks * 64 + fq * 16), qf[ks], dacc, 0, 0, 0); \
      } \
      if (MIXER == MIX_D) { _Pragma("unroll") for (int e_ = 0; e_ < 4; ++e_) { oacc[e_] = FMUL(oacc[e_], rr_cur); dacc[e_] = FMUL(dacc[e_], rr_cur); } } \
      oacc = __builtin_amdgcn_mfma_f32_16x16x32_bf16(ldfrag2(VTc, LD_T, vt * 16 + fr, fq * 8, 32 + fq * 8), __builtin_bit_cast(bf16x8, sb0), oacc, 0, 0, 0); \
      if (it >= 2) oacc = __builtin_amdgcn_mfma_f32_16x16x32_bf16(ldfrag2(VTc, LD_T, vt * 16 + fr, 64 + fq * 8, 96 + fq * 8), __builtin_bit_cast(bf16x8, sb1), oacc, 0, 0, 0); \
      float dn = 1.0f; \
      if (NVT == 3) { \
        dacc = __builtin_amdgcn_mfma_f32_16x16x32_bf16(ldfrag2(VTc, LD_T, 32 + fr, fq * 8, 32 + fq * 8), __builtin_bit_cast(bf16x8, sb0), dacc, 0, 0, 0); \
        if (it >= 2) dacc = __builtin_amdgcn_mfma_f32_16x16x32_bf16(ldfrag2(VTc, LD_T, 32 + fr, 64 + fq * 8, 96 + fq * 8), __builtin_bit_cast(bf16x8, sb1), dacc, 0, 0, 0); \
        const float den = __shfl(dacc[0], fr); \
        dn = 1.0f / fmaxf(fabsf(den), EMc[it * 16 + fr]); \
      } \
      { \
        const int i = it * 16 + fr; \
        const int ti = dir ? (SEQ - 1 - (n * 64 + i)) : (n * 64 + i); \
        const f32x4 o = (f32x4){FMUL(oacc[0], dn), FMUL(oacc[1], dn), FMUL(oacc[2], dn), FMUL(oacc[3], dn)}; \
        *(u32x2*)(O + PIDX(tokbase + ti, ocol + vt * 16 + fq * 4)) = (u32x2){pk_hw(o[0], o[1]), pk_hw(o[2], o[3])}; \
      } \
      const int dts = (DK == 128) ? wid : (wid & 3); \
      const bf16x8 kf0 = ldfrag(KTc, LD_T, dts * 16 + fr, fq * 16), kf1 = ldfrag(KTc, LD_T, dts * 16 + fr, 64 + fq * 16); \
      const f32x4 dc = *(const f32x4*)(DECc + dts * 16 + fq * 4); \
_Pragma("unroll") \
      for (int s = 0; s < NST; ++s) { \
        const int dt = dts, vt2 = (DK == 128) ? s : (wid >> 2); \
        f32x4 acc = (f32x4){FMUL(sacc[s][0], dc[0]), FMUL(sacc[s][1], dc[1]), FMUL(sacc[s][2], dc[2]), FMUL(sacc[s][3], dc[3])}; \
        acc = __builtin_amdgcn_mfma_f32_16x16x32_bf16(kf0, ldfrag(VTc, LD_T, vt2 * 16 + fr, fq * 16), acc, 0, 0, 0); \
        acc = __builtin_amdgcn_mfma_f32_16x16x32_bf16(kf1, ldfrag(VTc, LD_T, vt2 * 16 + fr, 64 + fq * 16), acc, 0, 0, 0); \
        sacc[s] = acc; \
        *(u32x2*)(STn + (vt2 * 16 + fr) * LD_D + (dt * 16 + fq * 4) * 2) = (u32x2){pk_hw(acc[0], acc[1]), pk_hw(acc[2], acc[3])}; \
      } \
    } \
    } \
    rr_cur = rr_next; \
    lds_barrier(); \
  } while (0)
  static_assert(NCH % 2 == 0, "chunk count must be even");
#pragma unroll 1
  for (int n2 = 0; n2 < NCH; n2 += 2) { SCAN_ITER(n2, R, Rv); SCAN_ITER(n2 + 1, Rn, Rvn); }
#undef SCAN_ITER
#undef A_LOAD
#undef A_PREP
}

template <int MIXER>
__device__ __forceinline__ void scan_dispatch2(unsigned char* lds, int wv, const Params& p, int id) {
  const int vs = id & 3, dir = (id >> 2) & 1, h = (id >> 3) & 3, b = id >> 5;
  scan_item2<MIXER>(lds, wv, p, b, h, dir, vs);
}
}

__device__ __forceinline__ void scan_phase2(unsigned char* lds, int wv, const Params& p, int layer) {
  for (int it0 = blockIdx.x; it0 < 256; it0 += gridDim.x) {
    const int xq = it0 & 7, yq = it0 >> 3, stream = (yq >> 2) * 8 + xq;
    const int item = (stream >> 5) * 128 + (stream & 31) * 4 + (yq & 3);
    if (layer == 0) { if (item < 128) scan2::scan_dispatch2<scan::MIX_A>(lds, wv, p, item); else scan2::scan_dispatch2<scan::MIX_B>(lds, wv, p, item - 128); }
    else { if (item < 128) scan2::scan_dispatch2<scan::MIX_D>(lds, wv, p, item); else scan2::scan_dispatch2<scan::MIX_C>(lds, wv, p, item - 128); }
    __syncthreads();
  }
}
#endif
#ifndef CPU_EMU
#define XB_BASE     2048
#define XB_TMO      (XB_BASE + 128)
#define XB_XCNT(j)  (XB_BASE + 256  + 64 * (j))
#define XB_XSUB(j)  (XB_BASE + 1280 + 64 * (j))
#define XB_XGEN(j)  (XB_BASE + 2304 + 64 * (j))
#define XB_TOP      (XB_BASE + 3328)
#define XB_TOPGEN   (XB_BASE + 3392)
#define XB_WORDS    3456
#define XB_SPIN_CAP (1u << 22)
#define XB_LDS_OFF  (LDS_BYTES - 16)
__device__ __forceinline__ unsigned xb_ld(unsigned* p)              { return __hip_atomic_load(p, __ATOMIC_RELAXED, __HIP_MEMORY_SCOPE_AGENT); }
__device__ __forceinline__ unsigned xb_add(unsigned* p, unsigned v) { return __hip_atomic_fetch_add(p, v, __ATOMIC_RELAXED, __HIP_MEMORY_SCOPE_AGENT); }
__device__ __forceinline__ unsigned xb_xcc_id() { return (unsigned)__builtin_amdgcn_s_getreg((3 << 11) | 20) & 0xFu; }
#define XB_SPIN(cond, bar) do { unsigned _sp = 0; while (cond) { __builtin_amdgcn_s_sleep(1); \
    if ((++_sp & 255u) == 0u) { if (xb_ld(&(bar)[XB_TMO])) break; if (_sp > XB_SPIN_CAP) { atomicAdd(&(bar)[XB_TMO], 1u); break; } } } } while (0)
__device__ __forceinline__ void grid_bar(unsigned* bar, unsigned char* lds_raw, int wv) {
  asm volatile("s_waitcnt vmcnt(0)" ::: "memory");
  __syncthreads();
  if (wv == 0 && lane_id() == 0) {
    volatile unsigned* st = (volatile unsigned*)(lds_raw + XB_LDS_OFF);
    __builtin_amdgcn_s_waitcnt(0);
    const unsigned x = xb_xcc_id();
    unsigned nloc = st[0], nx = st[1];
    if (nloc == 0u) {
      const unsigned G = gridDim.x; unsigned sum, cnt, mine, sp = 0u;
      for (;;) { sum = 0u; cnt = 0u; mine = 0u;
#pragma unroll
        for (unsigned j = 0; j < 16; ++j) { const unsigned c = xb_ld(&bar[XB_XCNT(j)]); sum += c; cnt += (c > 0u) ? 1u : 0u; mine = (j == x) ? c : mine; }
        if (sum == G) break;
        __builtin_amdgcn_s_sleep(1);
        if ((++sp & 255u) == 0u) { if (xb_ld(&bar[XB_TMO])) break; if (sp > XB_SPIN_CAP) { atomicAdd(&bar[XB_TMO], 1u); break; } } }
      nloc = mine > 0u ? mine : 1u; nx = cnt > 0u ? cnt : 1u; st[0] = nloc; st[1] = nx;
    }
    const unsigned old = xb_add(&bar[XB_XSUB(x)], 1u);
    const unsigned gen = old / nloc;
    if (old + 1u == (gen + 1u) * nloc) {
      __builtin_amdgcn_fence(__ATOMIC_RELEASE, "agent");
      asm volatile("s_waitcnt vmcnt(0)" ::: "memory");
      const unsigned og = xb_add(&bar[XB_TOP], 1u);
      const unsigned tg = og / nx;
      if (og + 1u == (tg + 1u) * nx) xb_add(&bar[XB_TOPGEN], 1u);
      else XB_SPIN(xb_ld(&bar[XB_TOPGEN]) == tg, bar);
      __builtin_amdgcn_fence(__ATOMIC_ACQUIRE, "agent");
      xb_add(&bar[XB_XGEN(x)], 1u);
      asm volatile("s_waitcnt vmcnt(0)" ::: "memory");
    } else {
      XB_SPIN(xb_ld(&bar[XB_XGEN(x)]) == gen, bar);
      __builtin_amdgcn_fence(__ATOMIC_ACQUIRE, "agent");
      asm volatile("s_waitcnt vmcnt(0)" ::: "memory");
    }
  }
  __syncthreads();
}
#if (PROBE_DUP & 16)
#define grid_bar(a, b, c) do { grid_bar(a, b, c); grid_bar(a, b, c); } while (0)
#endif

__global__ void __launch_bounds__(NTHREADS) mk_fwd(Params p) {
  extern __shared__ __attribute__((aligned(16))) unsigned char lds_raw[];
  cg::grid_group grid = cg::this_grid();
  const int G = gridDim.x, bid = blockIdx.x;
  const int wv = __builtin_amdgcn_readfirstlane(threadIdx.x >> 6);
  PG8_LAS unsigned char* lds = (PG8_LAS unsigned char*)lds_raw;
  unsigned char* ws = p.ws;

  if (threadIdx.x < 4) ((unsigned*)(lds_raw + XB_LDS_OFF))[threadIdx.x] = 0u;
  p0_prologue(lds_raw, wv, p);
#if (PROBE_DUP & 128)
  p0_prologue(lds_raw, wv, p);
#endif
  grid.sync();
  unsigned* bar = (unsigned*)(ws + WS_CTL);
  if (wv == 0 && lane_id() == 0) (void)xb_add(&bar[XB_XCNT(xb_xcc_id())], 1u);
  for (int layer = 0; layer < 2; ++layer) {
    { ProbInProj pr; pr.so.init(NTOK, layer == 0 ? PM_AB : PM_CD, G, bid); pr.A = (const char*)(ws + WS_HB); pr.Bt = (const char*)(ws + (layer == 0 ? WS_WIN_AB : WS_WIN_CD));
      pr.P = (bf16_t*)(ws + WS_R1); pr.bias = p.in[layer == 0 ? I_AB_B_IN : I_CD_B_IN]; pr.lb = (const float*)(ws + WS_LB); pr.layer = layer;
      pg8::gemm_phase(lds, pr, wv);
#if (PROBE_DUP & (1 | 2048))
      pg8::gemm_phase(lds, pr, wv);
#endif
      if (layer == 0) side_phase<32>(lds_raw, wv, p, 0); else side_phase<16>(lds_raw, wv, p, 1);
#if (PROBE_DUP & 256)
      if (layer == 0) side_phase<32>(lds_raw, wv, p, 0); else side_phase<16>(lds_raw, wv, p, 1);
#endif
 }
    grid_bar(bar, lds_raw, wv);
    if (layer == 1) { convd_phase(lds_raw, wv, p); grid_bar(bar, lds_raw, wv); }
    scan_phase2(lds_raw, wv, p, layer);
#if (PROBE_DUP & 2)
    scan_phase2(lds_raw, wv, p, layer);
#endif
#if (PROBE_DUP & 512)
    if (layer == 0) scan_phase2(lds_raw, wv, p, layer);
#endif
#if (PROBE_DUP & 1024)
    if (layer == 1) scan_phase2(lds_raw, wv, p, layer);
#endif
    grid_bar(bar, lds_raw, wv);
    headnorm_phase(lds_raw, wv, p, layer);
#if (PROBE_DUP & 8)
    headnorm_phase(lds_raw, wv, p, layer);
#endif
    grid_bar(bar, lds_raw, wv);
    { ProbOutProj pr; pr.so.init(NTOK, 1024, G, bid); pr.A = (const char*)(ws + WS_HB); pr.Bt = (const char*)(ws + (layer == 0 ? WS_WOUT_AB : WS_WOUT_CD)); pr.Y = (float*)(ws + WS_R2); pr.Hres = layer == 0 ? p.in[I_X] : p.out;
      pg8::gemm_phase(lds, pr, wv);
#if (PROBE_DUP & (1 | 16384))
      pg8::gemm_phase(lds, pr, wv);
#endif
      moe_weight_convert(lds_raw, wv, p, layer);
#if (PROBE_DUP & 4)
      moe_weight_convert(lds_raw, wv, p, layer);
#endif
 }
    grid_bar(bar, lds_raw, wv);
#if (PROBE_DUP & 32)
    ln_phase(lds_raw, wv, p, layer, 0, 1);
#endif
    ln_phase(lds_raw, wv, p, layer, 0);
    grid_bar(bar, lds_raw, wv);
    { ProbMoe1 pr; pr.mo.init((const int*)((const unsigned*)(ws + WS_CTL) + CW_CNT(layer)), 8, G, bid, lds_raw, wv);
      pr.A = (const char*)(ws + WS_HB); pr.W13 = (const char*)(ws + WS_WMOE); pr.list = (const int*)(ws + WS_LIST) + (size_t)layer * NEXP * NTOK; pr.H = (bf16_t*)(ws + WS_H);
      pg8::gemm_phase(lds, pr, wv);
#if (PROBE_DUP & (1 | 4096))
      pg8::gemm_phase(lds, pr, wv);
#endif
 }
    grid_bar(bar, lds_raw, wv);
    { ProbMoe2 pr; pr.mo.init((const int*)((const unsigned*)(ws + WS_CTL) + CW_CNT(layer)), 4, G, bid, lds_raw, wv);
      pr.A = (const char*)(ws + WS_H); pr.W2 = (const char*)(ws + WS_WMOE) + (size_t)NEXP * 2048 * 1024 * 2; pr.Y = (bf16_t*)(ws + WS_R2);
      pg8::gemm_phase(lds, pr, wv);
#if (PROBE_DUP & (1 | 8192))
      pg8::gemm_phase(lds, pr, wv);
#endif
 }
    grid_bar(bar, lds_raw, wv);
#if (PROBE_DUP & 64)
    ln_phase(lds_raw, wv, p, layer, 1, 1);
#endif
    ln_phase(lds_raw, wv, p, layer, 1);
    if (layer == 0) grid_bar(bar, lds_raw, wv);
  }
}

extern "C" void kernel_launch(void* const* d_in, const int* in_sizes, int n_in, void* d_out, int out_size, void* d_ws, size_t ws_size, hipStream_t stream) {
  static int grid_blocks = 0;
  if (grid_blocks == 0) {
    if (n_in != N_IN || ws_size < WS_END || out_size != NTOK * 1024) { fprintf(stderr, "kernel_launch: bad shapes: n_in %d ws %zu (need %zu) out %d\n", n_in, ws_size, (size_t)WS_END, out_size); grid_blocks = -1; return; }
    int dev = 0, cus = 0, per_cu = 0;
    hipGetDevice(&dev); hipDeviceGetAttribute(&cus, hipDeviceAttributeMultiprocessorCount, dev);
    if (hipFuncSetAttribute((const void*)mk_fwd, hipFuncAttributeMaxDynamicSharedMemorySize, LDS_BYTES) != hipSuccess) { fprintf(stderr, "kernel_launch: hipFuncSetAttribute failed\n"); grid_blocks = -1; return; }
    if (hipOccupancyMaxActiveBlocksPerMultiprocessor(&per_cu, (const void*)mk_fwd, NTHREADS, LDS_BYTES) != hipSuccess || per_cu < 1) { fprintf(stderr, "kernel_launch: occupancy query failed (%d)\n", per_cu); grid_blocks = -1; return; }
    grid_blocks = cus;
    (void)in_sizes;
  }
  if (grid_blocks < 0) return;
  Params p{};
  for (int i = 0; i < N_IN; ++i) p.in[i] = (const float*)d_in[i];
  p.out = (float*)d_out; p.ws = (unsigned char*)d_ws;
  void* args[] = {&p};
  hipError_t e = hipLaunchCooperativeKernel((const void*)mk_fwd, dim3(grid_blocks), dim3(NTHREADS), args, LDS_BYTES, stream);
  if (e != hipSuccess) fprintf(stderr, "cooperative launch failed: %s (grid %d)\n", hipGetErrorString(e), grid_blocks);
}
#endif
```

```cpp
#ifdef CPU_EMU
#include <cmath>
#include <cstdio>
#include <cstring>
#include <cstdlib>
#include <cstddef>
#define DEV
#define DEV_INLINE static inline
typedef void* hipStream_t;
#else
#include <hip/hip_runtime.h>
#include <hip/hip_bf16.h>
#include <cstdio>
#define DEV __device__ __forceinline__
#define DEV_INLINE __device__ __forceinline__
#endif
#ifndef PROBE_DUP
#define PROBE_DUP 0
#endif
#ifndef BATCH
#define BATCH 4
#endif
#ifndef SEQ
#define SEQ 8192
#endif
#define DM 1024
#define NTOK (BATCH * SEQ)
#define P_AB 4128
#define P_CD 3600
#define PM_AB 4096
#define PM_CD 3584
#define NEXP 16
#define ALPHA_F 1.4142135623730951f
#define LN_EPS_F 1e-5f
#define NORM_EPS_F 1e-6f
#define HROWS (2 * NTOK + NEXP * 256)

typedef unsigned short bf16_t;

DEV_INLINE float bf2f(bf16_t b) { unsigned u = ((unsigned)b) << 16; float f; memcpy(&f, &u, 4); return f; }
DEV_INLINE bf16_t f2bf(float f) { unsigned u; memcpy(&u, &f, 4); u += 0x7FFFu + ((u >> 16) & 1u); return (bf16_t)(u >> 16); }
DEV_INLINE float sigmoidf_(float x) { return 1.0f / (1.0f + expf(-x)); }
DEV_INLINE float siluf_(float x) { return x / (1.0f + expf(-x)); }
DEV_INLINE float logsigmoidf_(float x) { return fminf(x, 0.0f) - log1pf(expf(-fabsf(x))); }

#define AL256(x) (((size_t)(x) + 255) & ~(size_t)255)
#define WS_CTL    ((size_t)0)
#define WS_HB     ((size_t)65536)
#define WS_R1     (WS_HB + (size_t)NTOK * 1024 * 2)
#define R1_P_BYTES ((size_t)NTOK * 4096 * 2)
#define R1_MIN    ((size_t)NTOK * 1024 * 2 + AL256((size_t)HROWS * 1024 * 2))
#define R1_PL     (R1_P_BYTES + (size_t)NTOK * 512 * 2)
#define R1_BYTES  (R1_PL > R1_MIN ? R1_PL : R1_MIN)
#define WS_LFB    (WS_R1 + R1_P_BYTES)
#define WS_MIX    (WS_R1)
#define WS_H      (WS_R1 + (size_t)NTOK * 1024 * 2)
#define WS_W13    (WS_HB)
#define WS_W2     (WS_LFB)
#define WMOE_BYTES ((size_t)NEXP * 3072 * 1024 * 2)
#define WS_R2     (WS_R1 + R1_BYTES)
#define R2_BYTES  ((size_t)HROWS * 1024 * 2 > (size_t)NTOK * 1024 * 4 ? (size_t)HROWS * 1024 * 2 : (size_t)NTOK * 1024 * 4)
#define WS_SIDE   (WS_R2 + AL256(R2_BYTES))
#define WS_OSIDE  (WS_SIDE + (size_t)NTOK * 32 * 4)
#define WS_WIN_AB (WS_OSIDE + (size_t)2 * NTOK * 8 * 4)
#define WS_WIN_CD (WS_WIN_AB + (size_t)4128 * 1024 * 2)
#define WS_WOUT_AB (WS_WIN_CD + (size_t)3600 * 1024 * 2)
#define WS_WOUT_CD (WS_WOUT_AB + (size_t)1024 * 1024 * 2)
#define WS_ROPE   (WS_WOUT_CD + (size_t)1024 * 1024 * 2)
#define WS_LB     (WS_ROPE + (size_t)SEQ * 64 * 4)
#define WS_LIST   (WS_LB + 4096)
#define WS_ASSIGN (WS_LIST + (size_t)2 * NEXP * NTOK * 4)
#define WS_GATE   (WS_ASSIGN + (size_t)NTOK * 16)
#define WS_END    (WS_GATE + (size_t)NTOK * 8)
#define CW_CNT(layer) (64 + 256 * (layer))

#define PSTRIDE 4096
#define PIDX(tok, col) ((((size_t)((col) >> 7)) * NTOK + (size_t)(tok)) * 128 + (size_t)((col) & 127))

enum { I_X, I_AB_W_IN, I_AB_B_IN, I_HGRN_LB, I_GK_UP, I_GK_B, I_HGRN_NORM, I_GLA_NORM, I_AB_W_OUT,
       I_CD_W_IN, I_CD_B_IN, I_CONV_W, I_CONV_B, I_FGATE_B, I_RET_NORM, I_MLSTM_NORM, I_CD_W_OUT,
       I_LN_MIX_G, I_LN_MIX_B, I_LN_FFN_G, I_LN_FFN_B, I_ROUTER_W, I_ROUTER_B, I_MOE_W1, I_MOE_W3, I_MOE_W2, N_IN };

struct Params {
  const float* in[N_IN];
  float* out;
  unsigned char* ws;
};

DEV_INLINE float epi_ab(int col, float v, const float* lb) {
  if (col < 512) return siluf_(v);
  if (col < 1536) { float l = lb[(col - 512) & 511]; return logf(l + (1.0f - l) * sigmoidf_(v)); }
  if (col >= 2560 && col < 2816) return v * 0.125f;
  return v;
}

DEV_INLINE void route_from_logits(const float* lg, const float* rb, int* e_out, float* g_out) {
  float mx = lg[0];
#pragma unroll
  for (int e = 1; e < 16; ++e) mx = fmaxf(mx, lg[e]);
  float sc[16]; float sum = 0.f;
#pragma unroll
  for (int e = 0; e < 16; ++e) { sc[e] = expf(lg[e] - mx); sum += sc[e]; }
  float inv = 1.0f / sum;
  float best_gs = -1e30f; int be1 = 0, be2 = 1; float bs1 = 0.f, bs2 = 0.f;
#pragma unroll
  for (int gq = 0; gq < 4; ++gq) {
    float m1 = -1e30f, m2 = -1e30f, s1 = 0.f, s2 = 0.f; int i1 = 0, i2 = 0;
#pragma unroll
    for (int i = 0; i < 4; ++i) {
      float s = sc[gq * 4 + i] * inv; float v = s + rb[gq * 4 + i];
      if (v > m1) { m2 = m1; i2 = i1; s2 = s1; m1 = v; i1 = gq * 4 + i; s1 = s; }
      else if (v > m2) { m2 = v; i2 = gq * 4 + i; s2 = s; }
    }
    float gs = m1 + m2;
    if (gs > best_gs) { best_gs = gs; be1 = i1; be2 = i2; bs1 = s1; bs2 = s2; }
  }
  e_out[0] = be1; e_out[1] = be2; g_out[0] = bs1 / (bs1 + bs2); g_out[1] = bs2 / (bs1 + bs2);
}
#ifndef CPU_EMU
namespace pg8 {
#define PG8_LAS __attribute__((address_space(3)))
typedef short bf16x8 __attribute__((ext_vector_type(8)));
typedef float f32x4 __attribute__((ext_vector_type(4)));
typedef unsigned u32x4 __attribute__((ext_vector_type(4)));
typedef unsigned u32x2 __attribute__((ext_vector_type(2)));
constexpr int BM = 256, BK = 64, HALF = 128, HTB = HALF * BK * 2, STAGE_BYTES = 8 * HTB, NXCD = 8, WGM = 8, GK = 1024;

__device__ __forceinline__ int lds_byte(int r, int c) { const int st = (r >> 4) * 2 + (c >> 5), rr = r & 15, cc = c & 31, ob = rr * 64 + cc * 2; return st * 1024 + (ob ^ (((ob >> 9) & 1) << 5)); }
__device__ __forceinline__ void stage_rc(int b, int& R, int& C) { const int st = b / 1024, sb = b % 1024, swz = sb ^ (((sb >> 9) & 1) << 5); R = (st >> 1) * 16 + swz / 64; C = (st & 1) * 32 + (swz % 64) / 2; }
__device__ __forceinline__ int perm32(int rho) { const int n = rho >> 4, i = rho & 15; return 8 * (i >> 2) + 4 * n + (i & 3); }
__device__ __forceinline__ unsigned cvt_pk_bf16(float lo, float hi) { unsigned r; asm volatile("v_cvt_pk_bf16_f32 %0, %1, %2" : "=v"(r) : "v"(lo), "v"(hi)); return r; }

struct Unit { int pm, pn, e, row0, ne, ui; };

struct StaticOrder {
  int nM, nN, nwg, G, c;
  __device__ void init(int M, int N, int G_, int c_) { nM = M / BM; nN = N / BM; nwg = nM * nN; G = G_; c = c_; }
  __device__ bool next(int i, Unit& u) const {
    const long L = (long)i * G + c; if (L >= nwg) return false;
    int wgid = (int)L; { const int q = nwg / NXCD, r = nwg % NXCD, xcd = wgid % NXCD, off = wgid / NXCD; wgid = (xcd < r ? xcd * (q + 1) : r * (q + 1) + (xcd - r) * q) + off; }
    const int nig = WGM * nN, gid = wgid / nig, fm = gid * WGM, gsz = (nM - fm) < WGM ? (nM - fm) : WGM;
    u.pm = fm + ((wgid % nig) % gsz); u.pn = (wgid % nig) / gsz; u.e = 0; u.row0 = u.pm * BM; u.ne = 0; u.ui = i; return true;
  }
};

template <class Prob>
__device__ __forceinline__ void gemm_phase(PG8_LAS unsigned char* lds, const Prob& S, int wv) {
  int wv_ = wv; asm volatile("" : "+s"(wv_));
  int l_; asm volatile("v_mbcnt_lo_u32_b32 %0, -1, 0\n\tv_mbcnt_hi_u32_b32 %0, -1, %0" : "=v"(l_));
  int tid_ = wv_ * 64 + l_;
  const int tid = tid_, wid = __builtin_amdgcn_readfirstlane(tid >> 6), lane = tid & 63, wr = wid >> 2, wc = wid & 3, fr = lane & 15, fq = lane >> 4;
  constexpr int K = GK, nt = K / BK;
  int sR[2], sC[2]; unsigned voffB[2];
#pragma unroll
  for (int i = 0; i < 2; ++i) { int R, C; stage_rc(tid * 16 + i * 8192, R, C); sR[i] = R; sC[i] = C; const int Rb = Prob::PERM ? ((R & ~31) + perm32(R & 31)) : R; voffB[i] = (unsigned)(Rb * K + C) * 2u; }
  const size_t kstep = (size_t)(BK * 2);
  const size_t hstep = (size_t)HALF * K * 2;
  const unsigned ldsw = (unsigned)wid * 1024u;
  const int aoff = lds_byte(wr * 64 + fr, fq * 8), boff = lds_byte(wc * 32 + fr, fq * 8);
#define PG8_SA(b, h) (((b) * 2 + (h)) * HTB)
#define PG8_SB(b, h) ((4 + (b) * 2 + (h)) * HTB)
#define PG8_STAGE(bufoff, gbase, voff) do { _Pragma("unroll") for (int _i = 0; _i < 2; ++_i) \
    __builtin_amdgcn_global_load_lds((const unsigned*)((const char*)(gbase) + (voff)[_i]), (PG8_LAS unsigned*)(lds + (bufoff) + ldsw + _i * 8192), 16, 0, 0); } while (0)
#define PG8_LDA(dst, b, h) do { _Pragma("unroll") for (int m = 0; m < 4; ++m) _Pragma("unroll") for (int k = 0; k < 2; ++k) dst[m][k] = *(const PG8_LAS bf16x8*)(lds + PG8_SA(b, h) + aoff + m * 2048 + k * 1024); } while (0)
#define PG8_LDB(dst, b, h) do { _Pragma("unroll") for (int n = 0; n < 2; ++n) _Pragma("unroll") for (int k = 0; k < 2; ++k) dst[n][k] = *(const PG8_LAS bf16x8*)(lds + PG8_SB(b, h) + boff + n * 2048 + k * 1024); } while (0)
#define PG8_MMA(ai, bj, At, Bt) do { __builtin_amdgcn_s_setprio(1); _Pragma("unroll") for (int m = 0; m < 4; ++m) _Pragma("unroll") for (int n = 0; n < 2; ++n) _Pragma("unroll") for (int k = 0; k < 2; ++k) \
    acc[ai][bj][m][n] = __builtin_amdgcn_mfma_f32_16x16x32_bf16(Bt[n][k], At[m][k], acc[ai][bj][m][n], 0, 0, 0); __builtin_amdgcn_s_setprio(0); } while (0)
#define PG8_WAIT_V(n) asm volatile("s_waitcnt vmcnt(" #n ")" ::: "memory")
#define PG8_WAIT_L(n) asm volatile("s_waitcnt lgkmcnt(" #n ")" ::: "memory")
#define PG8_BAR __builtin_amdgcn_s_barrier()
#define PG8_SCHED __builtin_amdgcn_sched_barrier(0)
  Unit cur, nxt; int ui = 0;
  if (!S.next(0, cur)) return;
  f32x4 acc[2][2][4][2];
#pragma unroll
  for (int a = 0; a < 2; ++a)
#pragma unroll
    for (int b = 0; b < 2; ++b)
#pragma unroll
      for (int m = 0; m < 4; ++m)
#pragma unroll
        for (int n = 0; n < 2; ++n) acc[a][b][m][n] = (f32x4){0.f, 0.f, 0.f, 0.f};
  bf16x8 At[4][2], B0[2][2], B1[2][2];
  unsigned oc0[2], oc1[2], on0[2], on1[2];
#pragma unroll
  for (int i = 0; i < 2; ++i) { oc0[i] = S.a_off(cur, sR[i]) + (unsigned)sC[i] * 2u; oc1[i] = S.a_off(cur, HALF + sR[i]) + (unsigned)sC[i] * 2u; }
  const char* const Ab = S.a_base();
  const char* cB = S.b_base(cur);
  PG8_STAGE(PG8_SB(0, 0), cB, voffB); PG8_STAGE(PG8_SB(0, 1), cB + hstep, voffB); PG8_STAGE(PG8_SA(0, 0), Ab, oc0); PG8_STAGE(PG8_SA(0, 1), Ab, oc1);
  if (wr == 1) PG8_BAR;
  PG8_WAIT_V(2); PG8_BAR;
  PG8_STAGE(PG8_SB(1, 0), cB + kstep, voffB); PG8_STAGE(PG8_SA(1, 0), Ab + kstep, oc0); PG8_STAGE(PG8_SB(1, 1), cB + hstep + kstep, voffB);
  PG8_WAIT_V(6); PG8_BAR;
  for (;;) {
    const bool has_next = S.next(ui + 1, nxt);
    const char* nB = cB;
    if (has_next) {
      nB = S.b_base(nxt);
      int l2_; asm volatile("v_mbcnt_lo_u32_b32 %0, -1, 0\n\tv_mbcnt_hi_u32_b32 %0, -1, %0" : "=v"(l2_));
      const int tid2 = wid * 64 + l2_;
#pragma unroll
      for (int i = 0; i < 2; ++i) { int R, C; stage_rc(tid2 * 16 + i * 8192, R, C); on0[i] = S.a_off(nxt, R) + (unsigned)C * 2u; on1[i] = S.a_off(nxt, HALF + R) + (unsigned)C * 2u; }
    } else {
#pragma unroll
      for (int i = 0; i < 2; ++i) { on0[i] = oc0[i]; on1[i] = oc1[i]; }
    }
    for (int t = 0; t < nt; t += 2) {
      const bool last = (t == nt - 2);
      const char* a1 = Ab + (size_t)(t + 1) * kstep;
      const char* a2 = last ? Ab : Ab + (size_t)(t + 2) * kstep; const char* b2 = last ? nB : cB + (size_t)(t + 2) * kstep;
      const char* a3 = a2 + kstep; const char* b3 = b2 + kstep;
      unsigned o20[2], o21[2];
#pragma unroll
      for (int i = 0; i < 2; ++i) { o20[i] = last ? on0[i] : oc0[i]; o21[i] = last ? on1[i] : oc1[i]; }
      PG8_LDB(B0, 0, 0); PG8_LDB(B1, 0, 1); PG8_SCHED; PG8_LDA(At, 0, 0); PG8_STAGE(PG8_SA(1, 1), a1, oc1);
      PG8_WAIT_V(8); PG8_WAIT_L(0); PG8_BAR; PG8_MMA(0, 0, At, B0); PG8_MMA(0, 1, At, B1); PG8_BAR; PG8_SCHED;
      PG8_LDA(At, 0, 1); PG8_STAGE(PG8_SB(0, 0), b2, voffB); PG8_STAGE(PG8_SB(0, 1), b2 + hstep, voffB); PG8_STAGE(PG8_SA(0, 0), a2, o20);
      PG8_WAIT_V(8); PG8_WAIT_L(0); PG8_BAR; PG8_MMA(1, 0, At, B0); PG8_MMA(1, 1, At, B1); PG8_BAR; PG8_SCHED;
      PG8_LDB(B0, 1, 0); PG8_LDB(B1, 1, 1); PG8_SCHED; PG8_LDA(At, 1, 0); PG8_STAGE(PG8_SA(0, 1), a2, o21);
      PG8_WAIT_V(8); PG8_WAIT_L(0); PG8_BAR; PG8_MMA(0, 0, At, B0); PG8_MMA(0, 1, At, B1); PG8_BAR; PG8_SCHED;
      PG8_LDA(At, 1, 1); PG8_STAGE(PG8_SB(1, 0), b3, voffB); PG8_STAGE(PG8_SB(1, 1), b3 + hstep, voffB); PG8_STAGE(PG8_SA(1, 0), a3, o20);
      PG8_WAIT_V(8); PG8_WAIT_L(0); PG8_BAR; PG8_MMA(1, 0, At, B0); PG8_MMA(1, 1, At, B1); PG8_BAR; PG8_SCHED;
    }
    if (wr == 0) PG8_BAR;
    { int l3_; asm volatile("v_mbcnt_lo_u32_b32 %0, -1, 0\n\tv_mbcnt_hi_u32_b32 %0, -1, %0" : "=v"(l3_));
      S.epi(acc, cur, wr, wc, l3_ & 15, l3_ >> 4); }
    if (!has_next) break;
#pragma unroll
    for (int a = 0; a < 2; ++a)
#pragma unroll
      for (int b = 0; b < 2; ++b)
#pragma unroll
        for (int m = 0; m < 4; ++m)
#pragma unroll
          for (int n = 0; n < 2; ++n) acc[a][b][m][n] = (f32x4){0.f, 0.f, 0.f, 0.f};
    cur = nxt; cB = nB; ++ui;
#pragma unroll
    for (int i = 0; i < 2; ++i) { oc0[i] = on0[i]; oc1[i] = on1[i]; }
    if (wr == 1) PG8_BAR;
  }
  PG8_WAIT_V(0);
  PG8_BAR;
#undef PG8_SA
#undef PG8_SB
#undef PG8_STAGE
#undef PG8_LDA
#undef PG8_LDB
#undef PG8_MMA
#undef PG8_WAIT_V
#undef PG8_WAIT_L
#undef PG8_BAR
#undef PG8_SCHED
}
}
#endif
#ifndef CPU_EMU
#include <hip/hip_cooperative_groups.h>
namespace cg = cooperative_groups;
#define LAS __attribute__((address_space(3)))
#define NTHREADS 512
#define LDS_BYTES (154 * 1024)
typedef float f32x4 __attribute__((ext_vector_type(4)));
typedef short bf16x8 __attribute__((ext_vector_type(8)));
typedef unsigned u32x4 __attribute__((ext_vector_type(4)));
typedef unsigned u32x2 __attribute__((ext_vector_type(2)));

struct Ctx { int tid, lane, wid, G, bid; unsigned char* lds; };
__device__ __forceinline__ int lane_id() { int l; asm volatile("v_mbcnt_lo_u32_b32 %0, -1, 0\n\tv_mbcnt_hi_u32_b32 %0, -1, %0" : "=v"(l)); return l; }
__device__ __forceinline__ int opaque_tid(int wv) { int w = wv; asm volatile("" : "+s"(w)); int t = w * 64 + lane_id(); asm volatile("" : "+v"(t)); return t; }
__device__ __forceinline__ Ctx make_ctx(unsigned char* lds, int wv) { Ctx c; c.tid = opaque_tid(wv); c.lane = c.tid & 63; c.wid = __builtin_amdgcn_readfirstlane(c.tid >> 6); c.G = gridDim.x; c.bid = blockIdx.x; c.lds = lds; return c; }

__device__ __forceinline__ float wave_sum(float x) {
  x += __builtin_bit_cast(float, __builtin_amdgcn_update_dpp(0, __builtin_bit_cast(int, x), 0x111, 0xf, 0xf, false));
  x += __builtin_bit_cast(float, __builtin_amdgcn_update_dpp(0, __builtin_bit_cast(int, x), 0x112, 0xf, 0xf, false));
  x += __builtin_bit_cast(float, __builtin_amdgcn_update_dpp(0, __builtin_bit_cast(int, x), 0x114, 0xf, 0xf, false));
  x += __builtin_bit_cast(float, __builtin_amdgcn_update_dpp(0, __builtin_bit_cast(int, x), 0x118, 0xf, 0xf, false));
  x += __builtin_bit_cast(float, __builtin_amdgcn_update_dpp(0, __builtin_bit_cast(int, x), 0x142, 0xa, 0xf, false));
  x += __builtin_bit_cast(float, __builtin_amdgcn_update_dpp(0, __builtin_bit_cast(int, x), 0x143, 0xc, 0xf, false));
  return __builtin_bit_cast(float, __builtin_amdgcn_readlane(__builtin_bit_cast(int, x), 63));
}
__device__ __forceinline__ float fsigmoid(float x) { return __builtin_amdgcn_rcpf(1.0f + __builtin_amdgcn_exp2f(-1.4426950408889634f * x)); }
__device__ __forceinline__ float fsilu(float x) { return x * fsigmoid(x); }
__device__ __forceinline__ float flog2sigmoid(float x) { const float y = x * 1.4426950408889634f; return fminf(y, 0.f) - __builtin_amdgcn_logf(1.0f + __builtin_amdgcn_exp2f(-fabsf(y))); }
typedef float f32x2_t __attribute__((ext_vector_type(2)));
typedef __bf16 bf16x2_t __attribute__((ext_vector_type(2)));
__device__ __forceinline__ unsigned pk_hw(float a, float b) { const f32x2_t v = {a, b}; return __builtin_bit_cast(unsigned, __builtin_convertvector(v, bf16x2_t)); }
__device__ __forceinline__ unsigned pk2(float a, float b) { return pk_hw(a, b); }
__device__ __forceinline__ void unpack8(u32x4 w, float* f) {
  f[0] = __uint_as_float(w.x << 16); f[1] = __uint_as_float(w.x & 0xffff0000u); f[2] = __uint_as_float(w.y << 16); f[3] = __uint_as_float(w.y & 0xffff0000u);
  f[4] = __uint_as_float(w.z << 16); f[5] = __uint_as_float(w.z & 0xffff0000u); f[6] = __uint_as_float(w.w << 16); f[7] = __uint_as_float(w.w & 0xffff0000u);
}

__device__ __forceinline__ void transpose_job(const Ctx& c, const float* src, int N, bf16_t* dst, int rs, int ro, int tile0, int tile_stride) {
  float* t = (float*)c.lds;
  const int ntn = (N + 63) / 64, ntiles = ntn * 16;
  for (int tl = tile0; tl < ntiles; tl += tile_stride) {
    const int kt = tl / ntn, nt_ = tl % ntn, k0 = kt * 64, n0 = nt_ * 64;
    __syncthreads();
#pragma unroll
    for (int i = 0; i < 8; ++i) { const int idx = c.tid + i * 512, kk = idx >> 6, nn = idx & 63; t[kk * 65 + nn] = (n0 + nn < N) ? src[(size_t)(k0 + kk) * N + n0 + nn] : 0.f; }
    __syncthreads();
#pragma unroll
    for (int i = 0; i < 4; ++i) { const int idx = c.tid + i * 512, nn = idx >> 5, kp = (idx & 31) * 2;
      if (n0 + nn < N) *(unsigned*)(dst + (size_t)((n0 + nn) * rs + ro) * 1024 + k0 + kp) = pk2(t[kp * 65 + nn], t[(kp + 1) * 65 + nn]); }
  }
  __syncthreads();
}
__device__ __forceinline__ void p0_prologue(unsigned char* lds_, int wv, const Params& p) {
  const Ctx c = make_ctx(lds_, wv);
  unsigned char* ws = p.ws;
  if (c.bid == 0) { ((unsigned*)(ws + WS_CTL))[64 + c.tid] = 0u; }
  if (c.bid == 0) { for (int i = c.tid; i < 3456; i += NTHREADS) ((unsigned*)(ws + WS_CTL))[2048 + i] = 0u; }
  { const float* x = p.in[I_X]; bf16_t* hb = (bf16_t*)(ws + WS_HB);
    for (size_t i = (size_t)c.bid * NTHREADS + c.tid; i < (size_t)NTOK * 1024 / 8; i += (size_t)c.G * NTHREADS) {
      const f32x4 a = __builtin_nontemporal_load((const f32x4*)(x + i * 8)), b = __builtin_nontemporal_load((const f32x4*)(x + i * 8 + 4));
      u32x4 w; w.x = pk2(a[0], a[1]); w.y = pk2(a[2], a[3]); w.z = pk2(b[0], b[1]); w.w = pk2(b[2], b[3]);
      *(u32x4*)(hb + i * 8) = w; } }
  transpose_job(c, p.in[I_AB_W_IN], P_AB, (bf16_t*)(ws + WS_WIN_AB), 1, 0, c.bid, c.G);
  transpose_job(c, p.in[I_CD_W_IN], P_CD, (bf16_t*)(ws + WS_WIN_CD), 1, 0, c.bid, c.G);
  transpose_job(c, p.in[I_AB_W_OUT], 1024, (bf16_t*)(ws + WS_WOUT_AB), 1, 0, c.bid, c.G);
  transpose_job(c, p.in[I_CD_W_OUT], 1024, (bf16_t*)(ws + WS_WOUT_CD), 1, 0, c.bid, c.G);
  { float* rope = (float*)(ws + WS_ROPE);
    for (int i = c.bid * NTHREADS + c.tid; i < SEQ * 32; i += c.G * NTHREADS) { const int t = i >> 5, f = i & 31;
      const float freq = powf(10000.0f, -(float)f / 32.0f); const float ang = (float)t * freq; rope[i * 2] = cosf(ang); rope[i * 2 + 1] = sinf(ang); }
    if (c.bid == 1) { const float* hl = p.in[I_HGRN_LB]; float* lb = (float*)(ws + WS_LB);
      const int cc = c.tid; const float a0 = hl[cc], a1 = hl[512 + cc], a2 = hl[1024 + cc]; const float mx = fmaxf(a0, fmaxf(a1, a2));
      const float e0 = expf(a0 - mx), e1 = expf(a1 - mx), e2 = expf(a2 - mx); lb[cc] = e0 / (e0 + e1 + e2); } }
}
__device__ __forceinline__ void moe_weight_convert(unsigned char* lds_, int wv, const Params& p, int layer, int part, int bidx, int nblk) {
  const Ctx c = make_ctx(lds_, wv);
  bf16_t* w13 = (bf16_t*)(p.ws + WS_W13); bf16_t* w2 = (bf16_t*)(p.ws + WS_W2);
  const size_t lo = (size_t)layer * NEXP * 1024 * 1024;
  const float* W1 = p.in[I_MOE_W1] + lo; const float* W3 = p.in[I_MOE_W3] + lo; const float* W2 = p.in[I_MOE_W2] + lo;
  float* t = (float*)c.lds;
  const int NT = (part == 0 ? 32 : 16) * 128;
  const int lk = c.tid >> 5, ln4 = (c.tid & 31) * 4;
  const int sn = c.tid & 127, sk = (c.tid >> 7) * 8;
  f32x4 r[4];
#define MW_SRC(g_) ((part == 0 ? ((((g_) >> 7) & 1) ? W3 : W1) + (size_t)((g_) >> 8) * 1048576 : W2 + (size_t)((g_) >> 7) * 1048576) + (size_t)((((g_) & 127) >> 3) * 64) * 1024 + ((g_) & 7) * 128)
#define MW_LOAD(g_) do { const float* s_ = MW_SRC(g_); _Pragma("unroll") for (int i = 0; i < 4; ++i) r[i] = __builtin_nontemporal_load((const f32x4*)(s_ + (size_t)(lk + 16 * i) * 1024 + ln4)); } while (0)
  int g0 = bidx;
  if (g0 < NT) MW_LOAD(g0);
  for (; g0 < NT; g0 += nblk) {
    __syncthreads();
#pragma unroll
    for (int i = 0; i < 4; ++i) { float* d = t + (lk + 16 * i) * 129 + ln4; d[0] = r[i][0]; d[1] = r[i][1]; d[2] = r[i][2]; d[3] = r[i][3]; }
    __syncthreads();
    const int gn = g0 + nblk;
    if (gn < NT) MW_LOAD(gn);
    const int m = g0 >> 7, k0 = ((g0 & 127) >> 3) * 64, n0 = (g0 & 7) * 128;
    bf16_t* drow = (part == 1) ? w2 + ((size_t)m * 1024 + n0 + sn) * 1024 : w13 + ((size_t)(m >> 1) * 2048 + 2 * (n0 + sn) + (m & 1)) * 1024;
#pragma unroll
    for (int j = 0; j < 2; ++j) { const int kk = sk + 32 * j; const float* s = t + kk * 129 + sn;
      u32x4 w; w.x = pk2(s[0], s[129]); w.y = pk2(s[2 * 129], s[3 * 129]); w.z = pk2(s[4 * 129], s[5 * 129]); w.w = pk2(s[6 * 129], s[7 * 129]);
      *(u32x4*)(drow + k0 + kk) = w; }
  }
#undef MW_SRC
#undef MW_LOAD
  __syncthreads();
}

struct ProbInProj {
  static constexpr bool PERM = true;
  pg8::StaticOrder so; const char* A; const char* Bt; bf16_t* P; const float* bias; const float* lb; int layer;
  __device__ __forceinline__ bool next(int i, pg8::Unit& u) const { return so.next(i, u); }
  __device__ __forceinline__ const char* a_base() const { return A; }
  __device__ __forceinline__ unsigned a_off(const pg8::Unit& u, int r) const { return (unsigned)(u.pm * 256 + r) * 2048u; }
  __device__ __forceinline__ const char* b_base(const pg8::Unit& u) const { return Bt + (size_t)u.pn * 256 * 2048; }
  __device__ __forceinline__ void epi(const f32x4 (&acc)[2][2][4][2], const pg8::Unit& u, int wr, int wc, int fr, int fq) const {
    const int row0 = u.row0 + wr * 64 + fr, colb = u.pn * 256 + wc * 32 + 8 * fq;
    int mode = 0;
    if (layer == 0) { mode = u.pn < 2 ? 1 : (u.pn < 6 ? 2 : (u.pn == 10 ? 3 : 0)); }
#pragma unroll
    for (int bj = 0; bj < 2; ++bj) {
      const int col0 = colb + bj * 128;
      const f32x4 b0 = *(const f32x4*)(bias + col0), b1 = *(const f32x4*)(bias + col0 + 4);
      f32x4 l0 = (f32x4){0.f, 0.f, 0.f, 0.f}, l1 = l0;
      if (mode == 2) { l0 = *(const f32x4*)(lb + ((col0 - 512) & 511)); l1 = *(const f32x4*)(lb + ((col0 - 512) & 511) + 4); }
#pragma unroll
      for (int ai = 0; ai < 2; ++ai)
#pragma unroll
        for (int m = 0; m < 4; ++m) {
          f32x4 v0 = acc[ai][bj][m][0] + b0, v1 = acc[ai][bj][m][1] + b1;
          if (mode == 1) {
#pragma unroll
            for (int j = 0; j < 4; ++j) { v0[j] = fsilu(v0[j]); v1[j] = fsilu(v1[j]); }
          } else if (mode == 2) {
#pragma unroll
            for (int j = 0; j < 4; ++j) { v0[j] = __builtin_amdgcn_logf(l0[j] + (1.0f - l0[j]) * fsigmoid(v0[j])); v1[j] = __builtin_amdgcn_logf(l1[j] + (1.0f - l1[j]) * fsigmoid(v1[j])); }
          } else if (mode == 3) { v0 *= 0.125f; v1 *= 0.125f; }
          u32x4 w; w.x = pk2(v0[0], v0[1]); w.y = pk2(v0[2], v0[3]); w.z = pk2(v1[0], v1[1]); w.w = pk2(v1[2], v1[3]);
          *(u32x4*)(P + PIDX(row0 + ai * 128 + m * 16, col0)) = w;
        }
    }
  }
};
struct ProbOutProj {
  static constexpr bool PERM = false;
  pg8::StaticOrder so; const char* A; const char* Bt; float* Y; const float* Hres;
  __device__ __forceinline__ bool next(int i, pg8::Unit& u) const { return so.next(i, u); }
  __device__ __forceinline__ const char* a_base() const { return A; }
  __device__ __forceinline__ unsigned a_off(const pg8::Unit& u, int r) const { return (unsigned)(u.pm * 256 + r) * 2048u; }
  __device__ __forceinline__ const char* b_base(const pg8::Unit& u) const { return Bt + (size_t)u.pn * 256 * 2048; }
  __device__ __forceinline__ void epi(const f32x4 (&acc)[2][2][4][2], const pg8::Unit& u, int wr, int wc, int fr, int fq) const {
    const int row0 = u.row0 + wr * 64 + fr, col0 = u.pn * 256 + wc * 32 + 4 * fq;
#pragma unroll
    for (int ai = 0; ai < 2; ++ai)
#pragma unroll
      for (int m = 0; m < 4; ++m) { const size_t ro = (size_t)(row0 + ai * 128 + m * 16) * 1024 + col0; float* rowp = Y + ro; const float* hp = Hres + ro;
#pragma unroll
        for (int bj = 0; bj < 2; ++bj)
#pragma unroll
          for (int n = 0; n < 2; ++n) *(f32x4*)(rowp + bj * 128 + n * 16) = acc[ai][bj][m][n] + ALPHA_F * *(const f32x4*)(hp + bj * 128 + n * 16); }
  }
};
#define MOE_TAB_OFF (128 * 1024)
struct MoeOrder {
  const int* tab;
  __device__ __forceinline__ void init(const int* cnt, int ntn, int G, int c, unsigned char* lds, int wv) {
    int* t = (int*)(lds + MOE_TAB_OFF);
    const int tid = opaque_tid(wv);
    if (tid < 64) {
      int pad = 0, found = 0, ue = 0, upn = 0, upm = 0, urow = 0, une = 0;
      if ((G & 7) == 0) {
        const int x = c & 7; int q = tid * (G >> 3) + (c >> 3);
        for (int e = 0; e < NEXP; ++e) { const int n = cnt[e * 16], mt = (n + 255) >> 8; const int r = ((x - e) % 8 + 8) % 8; const int m = mt > r ? (mt - r - 1) / 8 + 1 : 0; const int units = m * ntn;
          if (!found && q < units) { ue = e; upm = r + 8 * (q % m); upn = q / m; urow = pad + upm * 256; une = n; found = 1; }
          if (!found) { q -= units; pad += mt * 256; } }
      } else {
        int L = tid * G + c;
        for (int e = 0; e < NEXP; ++e) { const int n = cnt[e * 16], mt = (n + 255) >> 8, tiles = mt * ntn;
          if (!found && L < tiles) { ue = e; upn = L / mt; upm = L % mt; urow = pad + upm * 256; une = n; found = 1; }
          if (!found) { L -= tiles; pad += mt * 256; } }
      }
      t[tid * 8 + 0] = found; t[tid * 8 + 1] = ue; t[tid * 8 + 2] = upn; t[tid * 8 + 3] = upm; t[tid * 8 + 4] = urow; t[tid * 8 + 5] = une;
    }
    __syncthreads();
    tab = t;
  }
  __device__ __forceinline__ bool next(int i, pg8::Unit& u) const {
    if (i >= 64) return false;
    const int* t = tab + i * 8;
    if (!__builtin_amdgcn_readfirstlane(t[0])) return false;
    u.e = __builtin_amdgcn_readfirstlane(t[1]); u.pn = __builtin_amdgcn_readfirstlane(t[2]); u.pm = __builtin_amdgcn_readfirstlane(t[3]);
    u.row0 = __builtin_amdgcn_readfirstlane(t[4]); u.ne = __builtin_amdgcn_readfirstlane(t[5]); u.ui = i; return true;
  }
};
struct ProbMoe1 {
  static constexpr bool PERM = true;
  MoeOrder mo; const char* A; const char* W13; const int* list; bf16_t* H; const int* ltok;
  __device__ __forceinline__ void stage_tokens(unsigned char* lds, int wv) {
    int* lt = (int*)(lds + MOE_TAB_OFF + 2048);
    const int tid = opaque_tid(wv);
    pg8::Unit u;
    for (int i = 0; i < 16 && mo.next(i, u); ++i) { if (tid < 256) { const int rr = u.pm * 256 + tid; lt[i * 256 + tid] = rr < u.ne ? list[u.e * NTOK + rr] : 0; } }
    __syncthreads();
    ltok = lt;
  }
  __device__ __forceinline__ bool next(int i, pg8::Unit& u) const { return mo.next(i, u); }
  __device__ __forceinline__ const char* a_base() const { return A; }
  __device__ __forceinline__ unsigned a_off(const pg8::Unit& u, int r) const { const int rr = u.pm * 256 + r; const int tok = rr < u.ne ? list[u.e * NTOK + rr] : 0; return (unsigned)tok * 2048u; }
  __device__ __forceinline__ const char* b_base(const pg8::Unit& u) const { return W13 + ((size_t)u.e * 2048 + (size_t)u.pn * 256) * 2048; }
  __device__ __forceinline__ void epi(const f32x4 (&acc)[2][2][4][2], const pg8::Unit& u, int wr, int wc, int fr, int fq) const {
    const int row0 = u.row0 + wr * 64 + fr, colb = u.pn * 128 + wc * 16 + 4 * fq;
#pragma unroll
    for (int ai = 0; ai < 2; ++ai)
#pragma unroll
      for (int m = 0; m < 4; ++m)
#pragma unroll
        for (int bj = 0; bj < 2; ++bj) {
          const f32x4 v0 = acc[ai][bj][m][0], v1 = acc[ai][bj][m][1];
          u32x2 w; w.x = pk2(fsilu(v0[0]) * v0[1], fsilu(v0[2]) * v0[3]); w.y = pk2(fsilu(v1[0]) * v1[1], fsilu(v1[2]) * v1[3]);
          *(u32x2*)(H + (size_t)(row0 + ai * 128 + m * 16) * 1024 + colb + bj * 64) = w;
        }
  }
};
struct ProbMoe2 {
  static constexpr bool PERM = true;
  MoeOrder mo; const char* A; const char* W2; bf16_t* Y;
  __device__ __forceinline__ bool next(int i, pg8::Unit& u) const { return mo.next(i, u); }
  __device__ __forceinline__ const char* a_base() const { return A; }
  __device__ __forceinline__ unsigned a_off(const pg8::Unit& u, int r) const { return (unsigned)(u.row0 + r) * 2048u; }
  __device__ __forceinline__ const char* b_base(const pg8::Unit& u) const { return W2 + ((size_t)u.e * 1024 + (size_t)u.pn * 256) * 2048; }
  __device__ __forceinline__ void epi(const f32x4 (&acc)[2][2][4][2], const pg8::Unit& u, int wr, int wc, int fr, int fq) const {
    const int row0 = u.row0 + wr * 64 + fr, colb = u.pn * 256 + wc * 32 + 8 * fq;
#pragma unroll
    for (int ai = 0; ai < 2; ++ai)
#pragma unroll
      for (int m = 0; m < 4; ++m)
#pragma unroll
        for (int bj = 0; bj < 2; ++bj) {
          const f32x4 v0 = acc[ai][bj][m][0], v1 = acc[ai][bj][m][1];
          u32x4 w; w.x = pk2(v0[0], v0[1]); w.y = pk2(v0[2], v0[3]); w.z = pk2(v1[0], v1[1]); w.w = pk2(v1[2], v1[3]);
          *(u32x4*)(Y + (size_t)(row0 + ai * 128 + m * 16) * 1024 + colb + bj * 128) = w;
        }
  }
};

template <int NS>
__device__ __forceinline__ void side_phase(unsigned char* lds_, int wv, const Params& p, int layer) {
  const Ctx c = make_ctx(lds_, wv);
  const bf16_t* hb = (const bf16_t*)(p.ws + WS_HB);
  const bf16_t* wt = (const bf16_t*)(p.ws + (layer == 0 ? WS_WIN_AB : WS_WIN_CD)) + (size_t)(layer == 0 ? PM_AB : PM_CD) * 1024;
  const float* bias = p.in[layer == 0 ? I_AB_B_IN : I_CD_B_IN] + (layer == 0 ? PM_AB : PM_CD);
  float* side = (float*)(p.ws + WS_SIDE);
  float* tl = (float*)c.lds + c.wid * (16 * 33);
  const int fr = c.lane & 15, fq = c.lane >> 4;
  for (int g = c.bid * 8 + c.wid; g < NTOK / 16; g += c.G * 8) {
    const int r0 = g * 16;
    f32x4 acc0 = (f32x4){0.f, 0.f, 0.f, 0.f}, acc1 = acc0;
    const bf16_t* ap = hb + (size_t)(r0 + fr) * 1024 + fq * 8;
    const bf16_t* bp0 = wt + (size_t)fr * 1024 + fq * 8; const bf16_t* bp1 = bp0 + 16 * 1024;
#pragma unroll 16
    for (int k = 0; k < 1024; k += 32) {
      const bf16x8 a = *(const bf16x8*)(ap + k), b0 = *(const bf16x8*)(bp0 + k);
      acc0 = __builtin_amdgcn_mfma_f32_16x16x32_bf16(a, b0, acc0, 0, 0, 0);
      if (NS == 32) { const bf16x8 b1 = *(const bf16x8*)(bp1 + k); acc1 = __builtin_amdgcn_mfma_f32_16x16x32_bf16(a, b1, acc1, 0, 0, 0); }
    }
    float gsc = 1.f, gfb = 0.f; bool gls = false;
    if (NS == 16) { gsc = 1.4426950408889634f; gls = (fr & 4) != 0; gfb = gls ? p.in[I_FGATE_B][(fr >> 3) * 4 + (fr & 3)] : 0.f; }
#pragma unroll
    for (int j = 0; j < 4; ++j) { float v0 = acc0[j] + bias[fr]; if (NS == 16) v0 = gls ? flog2sigmoid(v0 + gfb) : v0 * gsc; side[(size_t)(r0 + fq * 4 + j) * 32 + fr] = v0; tl[(fq * 4 + j) * 33 + fr] = v0;
      if (NS == 32) { const float v1 = acc1[j] + bias[16 + fr]; side[(size_t)(r0 + fq * 4 + j) * 32 + 16 + fr] = v1; tl[(fq * 4 + j) * 33 + 16 + fr] = v1; } }
    if (NS == 32) {
      __builtin_amdgcn_s_waitcnt(0xC07F);
      const float* gu = p.in[I_GK_UP]; const float* gb = p.in[I_GK_B]; bf16_t* lfb = (bf16_t*)(p.ws + WS_LFB);
      const int cb = c.lane * 8, dir = cb >> 8, cc = cb & 255;
      float w[16][8];
#pragma unroll
      for (int r = 0; r < 16; ++r)
#pragma unroll
        for (int j = 0; j < 8; ++j) w[r][j] = gu[(dir * 16 + r) * 256 + cc + j];
      float bb[8];
#pragma unroll
      for (int j = 0; j < 8; ++j) bb[j] = gb[dir * 256 + cc + j];
      for (int row = 0; row < 16; ++row) {
        float z[8];
#pragma unroll
        for (int j = 0; j < 8; ++j) z[j] = bb[j];
#pragma unroll
        for (int r = 0; r < 16; ++r) { const float s = tl[row * 33 + dir * 16 + r];
#pragma unroll
          for (int j = 0; j < 8; ++j) z[j] += s * w[r][j]; }
        u32x4 o; o.x = pk2(flog2sigmoid(z[0]) * 0.0625f, flog2sigmoid(z[1]) * 0.0625f); o.y = pk2(flog2sigmoid(z[2]) * 0.0625f, flog2sigmoid(z[3]) * 0.0625f);
        o.z = pk2(flog2sigmoid(z[4]) * 0.0625f, flog2sigmoid(z[5]) * 0.0625f); o.w = pk2(flog2sigmoid(z[6]) * 0.0625f, flog2sigmoid(z[7]) * 0.0625f);
        *(u32x4*)(lfb + PIDX(r0 + row, cb)) = o;
      }
    }
  }
}

__device__ __forceinline__ void headnorm_phase(unsigned char* lds_, int wv, const Params& p, int layer) {
  const Ctx c = make_ctx(lds_, wv);
  const bf16_t* P = (const bf16_t*)(p.ws + WS_R1); const bf16_t* O = (const bf16_t*)(p.ws + WS_R2);
  bf16_t* mixed = (bf16_t*)(p.ws + WS_MIX);
  const int c0 = c.lane * 16, h8 = c.lane >> 3;
  const float* gain = layer == 0 ? (h8 < 4 ? p.in[I_HGRN_NORM] + c0 : p.in[I_GLA_NORM] + c0 - 512) : (h8 < 4 ? p.in[I_RET_NORM] + c0 : p.in[I_MLSTM_NORM] + c0 - 512);
  const int gcol = layer == 0 ? (h8 < 4 ? 2048 + c0 : 3584 + c0 - 512) : (h8 < 4 ? 1024 + c0 : 3072 + c0 - 512);
  float gn[16];
#pragma unroll
  for (int j = 0; j < 16; ++j) gn[j] = gain[j];
  for (int tok = c.bid * 8 + c.wid; tok < NTOK; tok += c.G * 8) {
    float of[16], ob[16], gt[16];
    { const u32x4* a = (const u32x4*)(O + PIDX(tok, c0)); unpack8(__builtin_nontemporal_load(a), of); unpack8(__builtin_nontemporal_load(a + 1), of + 8);
      const u32x4* b = (const u32x4*)(O + (size_t)NTOK * 1024 + PIDX(tok, c0)); unpack8(__builtin_nontemporal_load(b), ob); unpack8(__builtin_nontemporal_load(b + 1), ob + 8);
      const u32x4* g = (const u32x4*)(P + PIDX(tok, gcol)); unpack8(__builtin_nontemporal_load(g), gt); unpack8(__builtin_nontemporal_load(g + 1), gt + 8); }
    const float sf = 1.f, sb = 1.f;
    float o[16]; float ss = 0.f;
#pragma unroll
    for (int j = 0; j < 16; ++j) { o[j] = of[j] * sf + ob[j] * sb; ss += o[j] * o[j]; }
    ss += __shfl_xor(ss, 1); ss += __shfl_xor(ss, 2); ss += __shfl_xor(ss, 4);
    const float r = 1.0f / sqrtf(ss * (1.0f / 128.0f) + NORM_EPS_F);
    unsigned w[8];
#pragma unroll
    for (int j = 0; j < 8; ++j) {
      float g0 = gt[2 * j], g1 = gt[2 * j + 1];
      if (layer == 1 && h8 >= 4) { g0 = fsigmoid(g0); g1 = fsigmoid(g1); } else { g0 = fsilu(g0); g1 = fsilu(g1); }
      w[j] = pk2(o[2 * j] * r * gn[2 * j] * g0, o[2 * j + 1] * r * gn[2 * j + 1] * g1);
    }
    u32x4* d = (u32x4*)(mixed + (size_t)tok * 1024 + c0);
    d[0] = (u32x4){w[0], w[1], w[2], w[3]}; d[1] = (u32x4){w[4], w[5], w[6], w[7]};
  }
}

__device__ __forceinline__ void ln_phase(unsigned char* lds_, int wv, const Params& p, int layer, int mode, int dry = 0) {
  const Ctx c = make_ctx(lds_, wv);
  unsigned char* ws = p.ws;
  const float* hin = (mode == 0 && layer == 0) ? p.in[I_X] : p.out;
  float* hout = dry ? (float*)(ws + WS_H) : p.out; bf16_t* hb = (bf16_t*)(ws + (mode == 0 ? WS_MIX : WS_HB));
  const float* g = p.in[mode == 0 ? I_LN_MIX_G : I_LN_FFN_G] + layer * 1024; const float* b = p.in[mode == 0 ? I_LN_MIX_B : I_LN_FFN_B] + layer * 1024;
  unsigned* cnt = (unsigned*)(ws + WS_CTL) + CW_CNT(layer);
  int* list = (int*)(ws + WS_LIST) + (size_t)layer * NEXP * NTOK;
  int* assign = (int*)(ws + WS_ASSIGN); float* gate = (float*)(ws + WS_GATE);
  float* rwT = (float*)c.lds;
  int* lcnt = (int*)(c.lds + 65536); int* lbase = lcnt + 16; int* rec = lcnt + 32; float* recg = (float*)(rec + 4 * 2048);
  int pad[NEXP];
  if (mode == 0) { const float* r = p.in[I_ROUTER_W];
    for (int i = c.tid; i < 1024 * 16; i += NTHREADS) rwT[(i & 15) * 1024 + (i >> 4)] = r[i];
    if (c.tid < 16) lcnt[c.tid] = 0;
    __syncthreads(); }
  else { int acc = 0;
#pragma unroll
    for (int e = 0; e < NEXP; ++e) { pad[e] = acc; acc += (((int)cnt[e * 16] + 255) >> 8) << 8; } }
  const int c0 = c.lane * 4;
  float gv[16], bv[16];
#pragma unroll
  for (int q = 0; q < 4; ++q) { const f32x4 t0 = *(const f32x4*)(g + q * 256 + c0), t1 = *(const f32x4*)(b + q * 256 + c0);
#pragma unroll
    for (int j = 0; j < 4; ++j) { gv[4 * q + j] = t0[j]; bv[4 * q + j] = t1[j]; } }
  const int tstride = c.G * 8;
  int it = 0;
  for (int tok0 = c.bid * 8 + c.wid; tok0 < NTOK; tok0 += 2 * tstride, it += 2) {
    float v[2][16];
    float gy0[2], gy1[2];
#pragma unroll
    for (int u = 0; u < 2; ++u) {
      const int tok = tok0 + u * tstride;
      if (tok < NTOK) {
        if (mode == 0) {
#pragma unroll
          for (int q = 0; q < 4; ++q) { const f32x4 t = __builtin_nontemporal_load((const f32x4*)((const float*)(ws + WS_R2) + (size_t)tok * 1024 + q * 256 + c0)); v[u][4 * q] = t[0]; v[u][4 * q + 1] = t[1]; v[u][4 * q + 2] = t[2]; v[u][4 * q + 3] = t[3]; }
        } else {
#pragma unroll
          for (int q = 0; q < 4; ++q) { const f32x4 t = *(const f32x4*)(hin + (size_t)tok * 1024 + q * 256 + c0); v[u][4 * q] = ALPHA_F * t[0]; v[u][4 * q + 1] = ALPHA_F * t[1]; v[u][4 * q + 2] = ALPHA_F * t[2]; v[u][4 * q + 3] = ALPHA_F * t[3]; }
          const int a0 = assign[tok * 4], a1 = assign[tok * 4 + 1], a2 = assign[tok * 4 + 2], a3 = assign[tok * 4 + 3];
          gy0[u] = gate[tok * 2]; gy1[u] = gate[tok * 2 + 1];
          int p0 = 0, p1 = 0;
#pragma unroll
          for (int e = 0; e < NEXP; ++e) { if (e == a0) p0 = pad[e]; if (e == a2) p1 = pad[e]; }
          p0 += a1; p1 += a3;
          const bf16_t* Y = (const bf16_t*)(ws + WS_R2);
#pragma unroll
          for (int q = 0; q < 4; ++q) { const u32x2 y0 = __builtin_nontemporal_load((const u32x2*)(Y + (size_t)p0 * 1024 + q * 256 + c0)), y1 = __builtin_nontemporal_load((const u32x2*)(Y + (size_t)p1 * 1024 + q * 256 + c0));
            v[u][4 * q] += gy0[u] * __uint_as_float(y0.x << 16) + gy1[u] * __uint_as_float(y1.x << 16); v[u][4 * q + 1] += gy0[u] * __uint_as_float(y0.x & 0xffff0000u) + gy1[u] * __uint_as_float(y1.x & 0xffff0000u);
            v[u][4 * q + 2] += gy0[u] * __uint_as_float(y0.y << 16) + gy1[u] * __uint_as_float(y1.y << 16); v[u][4 * q + 3] += gy0[u] * __uint_as_float(y0.y & 0xffff0000u) + gy1[u] * __uint_as_float(y1.y & 0xffff0000u); }
        }
      } else {
#pragma unroll
        for (int j = 0; j < 16; ++j) v[u][j] = 0.f;
      }
    }
#pragma unroll
    for (int u = 0; u < 2; ++u) {
      const int tok = tok0 + u * tstride;
      float s = 0.f;
#pragma unroll
      for (int j = 0; j < 16; ++j) s += v[u][j];
      const float mean = wave_sum(s) * (1.0f / 1024.0f);
      float qq = 0.f;
#pragma unroll
      for (int j = 0; j < 16; ++j) { v[u][j] -= mean; qq += v[u][j] * v[u][j]; }
      const float r = 1.0f / sqrtf(wave_sum(qq) * (1.0f / 1024.0f) + LN_EPS_F);
#pragma unroll
      for (int j = 0; j < 16; ++j) v[u][j] = v[u][j] * r * gv[j] + bv[j];
      if (tok < NTOK) {
#pragma unroll
        for (int q = 0; q < 4; ++q) __builtin_nontemporal_store((f32x4){v[u][4 * q], v[u][4 * q + 1], v[u][4 * q + 2], v[u][4 * q + 3]}, (f32x4*)(hout + (size_t)tok * 1024 + q * 256 + c0));
        if (!(mode == 1 && layer == 1) && !dry) {
#pragma unroll
          for (int q = 0; q < 4; ++q) *(u32x2*)(hb + (size_t)tok * 1024 + q * 256 + c0) = (u32x2){pk2(v[u][4 * q], v[u][4 * q + 1]), pk2(v[u][4 * q + 2], v[u][4 * q + 3])}; }
      }
      if (mode == 0) {
        float lg[16];
#pragma unroll
        for (int e = 0; e < 16; ++e) { float a = 0.f;
#pragma unroll
          for (int q = 0; q < 4; ++q) { const f32x4 w = *(const f32x4*)(rwT + e * 1024 + q * 256 + c0); a += v[u][4 * q] * w[0] + v[u][4 * q + 1] * w[1] + v[u][4 * q + 2] * w[2] + v[u][4 * q + 3] * w[3]; }
          lg[e] = a; }
#pragma unroll
        for (int e = 0; e < 16; ++e) lg[e] = wave_sum(lg[e]);
        int eo[2]; float go[2];
        route_from_logits(lg, p.in[I_ROUTER_B], eo, go);
        if (c.lane == 0 && tok < NTOK && !dry) {
          const int r1 = atomicAdd(lcnt + eo[0], 1), r2 = atomicAdd(lcnt + eo[1], 1);
          const int ri = (it + u) * 8 + c.wid;
          rec[ri * 4] = eo[0]; rec[ri * 4 + 1] = r1; rec[ri * 4 + 2] = eo[1]; rec[ri * 4 + 3] = r2; recg[ri * 2] = go[0]; recg[ri * 2 + 1] = go[1];
        }
      }
    }
  }
  if (mode == 0 && !dry) {
    __syncthreads();
    if (c.tid < 16) lbase[c.tid] = (int)atomicAdd(cnt + c.tid * 16, (unsigned)lcnt[c.tid]);
    __syncthreads();
    const int nrec = ((NTOK + c.G * 8 - 1) / (c.G * 8)) * 8;
    for (int ri = c.tid; ri < nrec; ri += NTHREADS) {
      const int tok = c.bid * 8 + (ri & 7) + (ri >> 3) * c.G * 8;
      if (tok < NTOK) {
        const int e1 = rec[ri * 4], e2 = rec[ri * 4 + 2]; const int r1 = rec[ri * 4 + 1] + lbase[e1], r2 = rec[ri * 4 + 3] + lbase[e2];
        list[e1 * NTOK + r1] = tok; list[e2 * NTOK + r2] = tok;
        assign[tok * 4] = e1; assign[tok * 4 + 1] = r1; assign[tok * 4 + 2] = e2; assign[tok * 4 + 3] = r2;
        gate[tok * 2] = recg[ri * 2]; gate[tok * 2 + 1] = recg[ri * 2 + 1];
      }
    }
  }
  __syncthreads();
}
#endif
#ifndef CPU_EMU
namespace scan {
typedef short bf16x8 __attribute__((ext_vector_type(8)));
typedef float f32x4 __attribute__((ext_vector_type(4)));
typedef unsigned u32x4 __attribute__((ext_vector_type(4)));
typedef unsigned u32x2 __attribute__((ext_vector_type(2)));
enum { MIX_A = 0, MIX_B = 1, MIX_C = 2, MIX_D = 3 };
constexpr int LD_T = 144;
constexpr int OFF_QS = 0, OFF_KS = 17408, OFF_QI = 34816, OFF_KT = 52224, OFF_VT = 70656, OFF_SC = 77568, OFF_ST = 86784, OFF_DEC = 99840, OFF_EM = 100352, OFF_DEN = 100608, OFF_CW = 100864, SCAN_LDS = 104960;

__device__ __forceinline__ float incl_scan_add(float x) {
  x += __builtin_bit_cast(float, __builtin_amdgcn_update_dpp(0, __builtin_bit_cast(int, x), 0x111, 0xf, 0xf, false));
  x += __builtin_bit_cast(float, __builtin_amdgcn_update_dpp(0, __builtin_bit_cast(int, x), 0x112, 0xf, 0xf, false));
  x += __builtin_bit_cast(float, __builtin_amdgcn_update_dpp(0, __builtin_bit_cast(int, x), 0x114, 0xf, 0xf, false));
  x += __builtin_bit_cast(float, __builtin_amdgcn_update_dpp(0, __builtin_bit_cast(int, x), 0x118, 0xf, 0xf, false));
  x += __builtin_bit_cast(float, __builtin_amdgcn_update_dpp(0, __builtin_bit_cast(int, x), 0x142, 0xa, 0xf, false));
  x += __builtin_bit_cast(float, __builtin_amdgcn_update_dpp(0, __builtin_bit_cast(int, x), 0x143, 0xc, 0xf, false));
  return x;
}
__device__ __forceinline__ float incl_scan_max(float x) {
  const int ninf = (int)0xff800000u;
  x = fmaxf(x, __builtin_bit_cast(float, __builtin_amdgcn_update_dpp(ninf, __builtin_bit_cast(int, x), 0x111, 0xf, 0xf, false)));
  x = fmaxf(x, __builtin_bit_cast(float, __builtin_amdgcn_update_dpp(ninf, __builtin_bit_cast(int, x), 0x112, 0xf, 0xf, false)));
  x = fmaxf(x, __builtin_bit_cast(float, __builtin_amdgcn_update_dpp(ninf, __builtin_bit_cast(int, x), 0x114, 0xf, 0xf, false)));
  x = fmaxf(x, __builtin_bit_cast(float, __builtin_amdgcn_update_dpp(ninf, __builtin_bit_cast(int, x), 0x118, 0xf, 0xf, false)));
  x = fmaxf(x, __builtin_bit_cast(float, __builtin_amdgcn_update_dpp(ninf, __builtin_bit_cast(int, x), 0x142, 0xa, 0xf, false)));
  x = fmaxf(x, __builtin_bit_cast(float, __builtin_amdgcn_update_dpp(ninf, __builtin_bit_cast(int, x), 0x143, 0xc, 0xf, false)));
  return x;
}
__device__ __forceinline__ float rdlane(float x, int l) { return __builtin_bit_cast(float, __builtin_amdgcn_readlane(__builtin_bit_cast(int, x), l)); }
__device__ __forceinline__ bf16x8 ldfrag(const unsigned char* base, int ld, int row, int kbyte) { return *(const bf16x8*)(base + row * ld + kbyte); }
__device__ __forceinline__ bf16x8 ldfrag2(const unsigned char* base, int ld, int row, int b0, int b1) {
  const u32x2 lo = *(const u32x2*)(base + row * ld + b0), hi = *(const u32x2*)(base + row * ld + b1);
  return __builtin_bit_cast(bf16x8, (u32x4){lo.x, lo.y, hi.x, hi.y}); }
__device__ __forceinline__ unsigned pk(float a, float b) { return pk_hw(a, b); }
__device__ __forceinline__ float lo16(unsigned w) { return __uint_as_float(w << 16); }
__device__ __forceinline__ float hi16(unsigned w) { return __uint_as_float(w & 0xffff0000u); }

__device__ __forceinline__ void lds_barrier() { asm volatile("s_waitcnt lgkmcnt(0)" ::: "memory"); __builtin_amdgcn_s_barrier(); asm volatile("" ::: "memory"); }
struct Raw { u32x4 a0, a1, b0, b1; f32x4 r0, r1; u32x2 v; float s0, s1; };

}

__device__ __forceinline__ void convd_phase(unsigned char* lds_, int wv, const Params& p) {
  const Ctx c = make_ctx(lds_, wv);
  bf16_t* P = (bf16_t*)(p.ws + WS_R1); bf16_t* QD = (bf16_t*)(p.ws + WS_LFB);
  const float* cw = p.in[I_CONV_W]; const float* cb = p.in[I_CONV_B];
  const int ch = c.lane * 16;
  float w0[16], w1[16], w2[16], bb[16];
#pragma unroll
  for (int j = 0; j < 16; ++j) { w0[j] = cw[ch + j]; w1[j] = cw[1024 + ch + j]; w2[j] = cw[2048 + ch + j]; bb[j] = cb[ch + j]; }
  for (int tok = c.bid * 8 + c.wid; tok < NTOK; tok += c.G * 8) {
    const int t = tok % SEQ;
    const bf16_t* row = P + PIDX(tok, 1536 + ch);
    float x0[16], x1[16], x2[16];
    { const u32x4* r1 = (const u32x4*)row; unpack8(r1[0], x1); unpack8(r1[1], x1 + 8); }
    if (t > 0) { const u32x4* r0 = (const u32x4*)(row - 128); unpack8(r0[0], x0); unpack8(r0[1], x0 + 8); }
    else {
#pragma unroll
      for (int j = 0; j < 16; ++j) x0[j] = 0.f; }
    if (t < SEQ - 1) { const u32x4* r2 = (const u32x4*)(row + 128); unpack8(r2[0], x2); unpack8(r2[1], x2 + 8); }
    else {
#pragma unroll
      for (int j = 0; j < 16; ++j) x2[j] = 0.f; }
    const float sc = ch < 512 ? 0.08838834764831845f : 1.0f;
    unsigned w[8];
#pragma unroll
    for (int j = 0; j < 8; ++j) {
      const float a0 = bb[2 * j] + w0[2 * j] * x0[2 * j] + w1[2 * j] * x1[2 * j] + w2[2 * j] * x2[2 * j];
      const float a1 = bb[2 * j + 1] + w0[2 * j + 1] * x0[2 * j + 1] + w1[2 * j + 1] * x1[2 * j + 1] + w2[2 * j + 1] * x2[2 * j + 1];
      w[j] = pk2(fsilu(a0) * sc, fsilu(a1) * sc);
    }
    u32x4* d = (ch < 512) ? (u32x4*)(QD + PIDX(tok, ch)) : (u32x4*)(P + PIDX(tok, 3584 + (ch - 512)));
    d[0] = (u32x4){w[0], w[1], w[2], w[3]}; d[1] = (u32x4){w[4], w[5], w[6], w[7]};
  }
}

#endif
#ifndef CPU_EMU
namespace scan2 {
using namespace scan;
#ifndef PROBE_ALLTILES
#define PROBE_ALLTILES 0
#endif
__device__ __forceinline__ float FMUL(float a, float b) { float r = a * b; asm("" : "+v"(r)); return r; }
constexpr int U_QI = 0, U_KS = 34816, U_KT = 69632, U_VT = 106496, U_SC = 120320, U_ST = 129536, U_DEC = 155648, U_EM = 156672, U_END = 157184;
template <int MIXER>
__device__ __forceinline__ void scan_item2(unsigned char* lds, int wv, const Params& p, int b, int h, int dir, int vs) {
  constexpr int DK = (MIXER == MIX_A || MIXER == MIX_D) ? 128 : 64;
  constexpr int NC = DK / 8;
  constexpr int LD_D = DK * 2 + 16;
  constexpr int NVT = MIXER == MIX_D ? 3 : 2;
  constexpr int NKD = DK / 32;
  constexpr int NST = (DK == 128) ? NVT : 1;
  constexpr int NCH = SEQ / 64;
  const int tid = opaque_tid(wv), lane0 = tid & 63, wid = __builtin_amdgcn_readfirstlane(tid >> 6);
  unsigned char* ws = p.ws;
  const bf16_t* P = (const bf16_t*)(ws + WS_R1);
  const bf16_t* LFBp = (const bf16_t*)(ws + WS_LFB);
  const float* side = (const float*)(ws + WS_SIDE);
  const float* rope = (const float*)(ws + WS_ROPE);
  bf16_t* O = (bf16_t*)(ws + WS_R2) + (size_t)dir * NTOK * 1024;
  unsigned char* SC = lds + U_SC;
  int qcol, kcol, lfcol, vcol, ocol;
  if (MIXER == MIX_A) { qcol = h * 128; kcol = 0; lfcol = 512 + dir * 512 + h * 128; vcol = 1536 + h * 128 + vs * 32; ocol = h * 128 + vs * 32; }
  else if (MIXER == MIX_B) { qcol = 2560 + h * 64; kcol = 2816 + h * 64; lfcol = dir * 256 + h * 64; vcol = 3072 + h * 128 + vs * 32; ocol = 512 + h * 128 + vs * 32; }
  else if (MIXER == MIX_C) { qcol = h * 64; kcol = 256 + h * 64; lfcol = 0; vcol = 512 + h * 128 + vs * 32; ocol = h * 128 + vs * 32; }
  else { qcol = h * 128; kcol = 3584 + h * 128; lfcol = 0; vcol = 2560 + h * 128 + vs * 32; ocol = 512 + h * 128 + vs * 32; }
  const size_t tokbase = (size_t)b * SEQ;
  const int c0 = (MIXER == MIX_C) ? wid * 4 : wid * NC;
  for (int i = tid; i < 2 * 13056 / 4; i += NTHREADS) ((unsigned*)(lds + U_ST))[i] = 0u;
  for (int i = tid; i < 9216 / 4; i += NTHREADS) ((unsigned*)(lds + U_SC))[i] = 0u;
  if (MIXER == MIX_D) { for (int i = tid; i < 2 * 16 * 64; i += NTHREADS) { const int bf = i >> 10, r = 32 + ((i >> 6) & 15), j = i & 63; *(bf16_t*)(lds + U_VT + bf * 6912 + r * LD_T + j * 2) = (r == 32) ? (bf16_t)0x3F80 : (bf16_t)0; } }
  const float lgam2 = (MIXER == MIX_C) ? log1pf(-exp2f(-(5.0f + 2.0f * (float)h + (float)dir))) * 1.4426950408889634f : 0.f;
  const float fgb = (MIXER == MIX_D) ? p.in[I_FGATE_B][dir * 4 + h] : 0.f;
  float m_st = 0.f;
  __syncthreads();

  Raw R, Rn; u32x2 Rv, Rvn;
#define A_LOAD(R, Rv, n_) do { \
    const int ln_ = lane0; \
    const int t_ = dir ? (SEQ - 1 - ((n_) * 64 + ln_)) : ((n_) * 64 + ln_); \
    const size_t tk_ = tokbase + t_; \
    if (MIXER == MIX_A) { const u32x4* qp_ = (const u32x4*)(P + PIDX(tk_, qcol + c0)); const u32x4* lp_ = (const u32x4*)(P + PIDX(tk_, lfcol + c0)); R.a0 = qp_[0]; R.a1 = qp_[1]; R.b0 = lp_[0]; R.b1 = lp_[1]; } \
    else if (MIXER == MIX_B) { R.a0 = *(const u32x4*)(P + PIDX(tk_, qcol + c0)); R.a1 = *(const u32x4*)(P + PIDX(tk_, kcol + c0)); R.b0 = *(const u32x4*)(LFBp + PIDX(tk_, lfcol + c0)); } \
    else if (MIXER == MIX_C) { const u32x2 qa_ = *(const u32x2*)(P + PIDX(tk_, qcol + c0)), qb_ = *(const u32x2*)(P + PIDX(tk_, qcol + 32 + c0)), ka_ = *(const u32x2*)(P + PIDX(tk_, kcol + c0)), kb_ = *(const u32x2*)(P + PIDX(tk_, kcol + 32 + c0)); \
      R.a0 = (u32x4){qa_.x, qa_.y, qb_.x, qb_.y}; R.a1 = (u32x4){ka_.x, ka_.y, kb_.x, kb_.y}; \
      R.r0 = *(const f32x4*)(rope + ((size_t)t_ * 32 + c0) * 2); R.r1 = *(const f32x4*)(rope + ((size_t)t_ * 32 + c0) * 2 + 4); } \
    else { const u32x4* qp_ = (const u32x4*)(LFBp + PIDX(tk_, qcol + c0)); const u32x4* kp_ = (const u32x4*)(P + PIDX(tk_, kcol + c0)); R.a0 = qp_[0]; R.a1 = qp_[1]; R.b0 = kp_[0]; R.b1 = kp_[1]; \
      R.s0 = side[tk_ * 32 + dir * 8 + h]; R.s1 = side[tk_ * 32 + dir * 8 + 4 + h]; } \
    Rv = *(const u32x2*)(P + PIDX(tk_, vcol + wid * 4)); } while (0)

  float rr_next = 1.f, rr_cur = 1.f;
#define A_PREP(buf_, R, Rv) do { \
    const int lane = lane0; \
    unsigned char* KTb = lds + U_KT + (buf_) * 18432; float* DECb = (float*)(lds + U_DEC + (buf_) * 512); float* EMb = (float*)(lds + U_EM + (buf_) * 256); \
    unsigned char* QIb = lds + U_QI + (buf_) * 17408; unsigned char* KSb = lds + U_KS + (buf_) * 17408; \
    float q[NC], k[NC], g[NC], ktv[NC]; \
    if (MIXER == MIX_A) { \
      const unsigned qw[8] = {R.a0.x, R.a0.y, R.a0.z, R.a0.w, R.a1.x, R.a1.y, R.a1.z, R.a1.w}, lw[8] = {R.b0.x, R.b0.y, R.b0.z, R.b0.w, R.b1.x, R.b1.y, R.b1.z, R.b1.w}; \
      _Pragma("unroll") for (int c = 0; c < 8; ++c) { q[2 * c] = lo16(qw[c]); q[2 * c + 1] = hi16(qw[c]); g[2 * c] = lo16(lw[c]); g[2 * c + 1] = hi16(lw[c]); } \
      _Pragma("unroll") for (int c = 0; c < NC; ++c) k[c] = 1.0f - __builtin_amdgcn_exp2f(g[c]); \
    } else if (MIXER == MIX_B) { \
      const unsigned qw[4] = {R.a0.x, R.a0.y, R.a0.z, R.a0.w}, kw[4] = {R.a1.x, R.a1.y, R.a1.z, R.a1.w}, lw[4] = {R.b0.x, R.b0.y, R.b0.z, R.b0.w}; \
      _Pragma("unroll") for (int c = 0; c < 4; ++c) { q[2 * c] = lo16(qw[c]); q[2 * c + 1] = hi16(qw[c]); k[2 * c] = lo16(kw[c]); k[2 * c + 1] = hi16(kw[c]); g[2 * c] = lo16(lw[c]); g[2 * c + 1] = hi16(lw[c]); } \
    } else if (MIXER == MIX_C) { \
      const float cs[4] = {R.r0[0], R.r0[2], R.r1[0], R.r1[2]}, sn[4] = {R.r0[1], R.r0[3], R.r1[1], R.r1[3]}; \
      const float q1[4] = {lo16(R.a0.x), hi16(R.a0.x), lo16(R.a0.y), hi16(R.a0.y)}, q2[4] = {lo16(R.a0.z), hi16(R.a0.z), lo16(R.a0.w), hi16(R.a0.w)}; \
      const float k1[4] = {lo16(R.a1.x), hi16(R.a1.x), lo16(R.a1.y), hi16(R.a1.y)}, k2[4] = {lo16(R.a1.z), hi16(R.a1.z), lo16(R.a1.w), hi16(R.a1.w)}; \
      _Pragma("unroll") for (int c = 0; c < 4; ++c) { q[c] = (q1[c] * cs[c] - q2[c] * sn[c]) * 0.125f; q[4 + c] = (q1[c] * sn[c] + q2[c] * cs[c]) * 0.125f; k[c] = k1[c] * cs[c] - k2[c] * sn[c]; k[4 + c] = k1[c] * sn[c] + k2[c] * cs[c]; } \
    } else { \
      const unsigned qw[8] = {R.a0.x, R.a0.y, R.a0.z, R.a0.w, R.a1.x, R.a1.y, R.a1.z, R.a1.w}, kw[8] = {R.b0.x, R.b0.y, R.b0.z, R.b0.w, R.b1.x, R.b1.y, R.b1.z, R.b1.w}; \
      _Pragma("unroll") for (int c = 0; c < 8; ++c) { q[2 * c] = lo16(qw[c]); q[2 * c + 1] = hi16(qw[c]); k[2 * c] = lo16(kw[c]); k[2 * c + 1] = hi16(kw[c]); } \
    } \
    if (MIXER == MIX_A || MIXER == MIX_B) { \
        \
      _Pragma("unroll") for (int c = 0; c < NC; ++c) g[c] += __builtin_bit_cast(float, __builtin_amdgcn_update_dpp(0, __builtin_bit_cast(int, g[c]), 0x111, 0xf, 0xf, false)); \
      _Pragma("unroll") for (int c = 0; c < NC; ++c) g[c] += __builtin_bit_cast(float, __builtin_amdgcn_update_dpp(0, __builtin_bit_cast(int, g[c]), 0x112, 0xf, 0xf, false)); \
      _Pragma("unroll") for (int c = 0; c < NC; ++c) g[c] += __builtin_bit_cast(float, __builtin_amdgcn_update_dpp(0, __builtin_bit_cast(int, g[c]), 0x114, 0xf, 0xf, false)); \
      _Pragma("unroll") for (int c = 0; c < NC; ++c) g[c] += __builtin_bit_cast(float, __builtin_amdgcn_update_dpp(0, __builtin_bit_cast(int, g[c]), 0x118, 0xf, 0xf, false)); \
      _Pragma("unroll") for (int c = 0; c < NC; ++c) g[c] += __builtin_bit_cast(float, __builtin_amdgcn_update_dpp(0, __builtin_bit_cast(int, g[c]), 0x142, 0xa, 0xf, false)); \
      _Pragma("unroll") for (int c = 0; c < NC; ++c) g[c] += __builtin_bit_cast(float, __builtin_amdgcn_update_dpp(0, __builtin_bit_cast(int, g[c]), 0x143, 0xc, 0xf, false)); \
      float ev[NC]; \
      _Pragma("unroll") for (int c = 0; c < NC; ++c) { \
          \
        const float e = __builtin_amdgcn_exp2f(g[c]), r = __builtin_amdgcn_rcpf(e); \
        const float e63 = rdlane(e, 63); \
        q[c] = FMUL(q[c], e); k[c] = FMUL(k[c], r); ktv[c] = FMUL(k[c], e63);     \
        ev[c] = e; } \
      if (lane == 63) { _Pragma("unroll") for (int c = 0; c < NC / 4; ++c) *(f32x4*)(DECb + c0 + 4 * c) = (f32x4){ev[4 * c], ev[4 * c + 1], ev[4 * c + 2], ev[4 * c + 3]}; } \
    } else if (MIXER == MIX_C) { \
        \
      const float gl = (float)(lane + 1) * lgam2; \
      const float e = __builtin_amdgcn_exp2f(gl), r = __builtin_amdgcn_rcpf(e); \
      const float e63 = rdlane(e, 63); const float f_kt = r * e63; \
      _Pragma("unroll") for (int c = 0; c < NC; ++c) { q[c] = FMUL(q[c], e); ktv[c] = FMUL(k[c], f_kt); k[c] = FMUL(k[c], r); } \
      if (lane < 4) { DECb[c0 + lane] = e63; DECb[32 + c0 + lane] = e63; } \
    } else { \
      const float li = R.s0, lf = R.s1;     \
      const float bc = incl_scan_add(lf); const float u = li - bc; const float pm = incl_scan_max(u); \
      const float cmax = rdlane(pm, 63), blast = rdlane(bc, 63); \
      const float a_i = bc + m_st, m_i = fmaxf(a_i, bc + pm); \
      const float d_alpha = __builtin_amdgcn_exp2f(bc - m_i + cmax), d_beta = __builtin_amdgcn_exp2f(u - cmax); \
      rr_next = __builtin_amdgcn_exp2f(m_st - cmax);     \
      const float m_new = fmaxf(blast + m_st, blast + cmax); \
      const float d_sold = __builtin_amdgcn_exp2f(blast + m_st - m_new), d_wks = __builtin_amdgcn_exp2f(blast + u - m_new); m_st = m_new; \
      _Pragma("unroll") for (int c = 0; c < NC; ++c) { ktv[c] = FMUL(k[c], d_wks); q[c] = FMUL(q[c], d_alpha); k[c] = FMUL(k[c], d_beta); if (lane == 63) DECb[c0 + c] = d_sold; } \
      if (wid == 0) EMb[lane] = __builtin_amdgcn_exp2f(-m_i); \
    } \
    _Pragma("unroll") for (int c = 0; c < NC / 2; ++c) { const unsigned w_ = pk_hw(ktv[2 * c], ktv[2 * c + 1]); \
      const int d0_ = (MIXER == MIX_C) ? (2 * c < 4 ? c0 + 2 * c : 32 + c0 + 2 * c - 4) : c0 + 2 * c; \
      *(bf16_t*)(KTb + d0_ * LD_T + lane * 2) = (bf16_t)(w_ & 0xffff); *(bf16_t*)(KTb + (d0_ + 1) * LD_T + lane * 2) = (bf16_t)(w_ >> 16); } \
    { unsigned pq[NC / 2], pks[NC / 2]; \
      _Pragma("unroll") for (int c = 0; c < NC / 2; ++c) { pq[c] = pk_hw(q[2 * c], q[2 * c + 1]); pks[c] = pk_hw(k[2 * c], k[2 * c + 1]); } \
      if (MIXER == MIX_C) { \
        *(u32x2*)(QIb + lane * LD_D + c0 * 2) = (u32x2){pq[0], pq[1]}; *(u32x2*)(QIb + lane * LD_D + (32 + c0) * 2) = (u32x2){pq[2], pq[3]}; \
        *(u32x2*)(KSb + lane * LD_D + c0 * 2) = (u32x2){pks[0], pks[1]}; *(u32x2*)(KSb + lane * LD_D + (32 + c0) * 2) = (u32x2){pks[2], pks[3]}; \
      } else { \
        _Pragma("unroll") for (int c = 0; c < NC / 8; ++c) { \
          *(u32x4*)(QIb + lane * LD_D + (c0 + 8 * c) * 2) = (u32x4){pq[4 * c], pq[4 * c + 1], pq[4 * c + 2], pq[4 * c + 3]}; \
          *(u32x4*)(KSb + lane * LD_D + (c0 + 8 * c) * 2) = (u32x4){pks[4 * c], pks[4 * c + 1], pks[4 * c + 2], pks[4 * c + 3]}; } } } \
    { unsigned char* VTb = lds + U_VT + (buf_) * 6912 + (wid * 4) * LD_T + lane * 2; \
      *(bf16_t*)(VTb + 0 * LD_T) = (bf16_t)(Rv.x & 0xffff); *(bf16_t*)(VTb + 1 * LD_T) = (bf16_t)(Rv.x >> 16); *(bf16_t*)(VTb + 2 * LD_T) = (bf16_t)(Rv.y & 0xffff); *(bf16_t*)(VTb + 3 * LD_T) = (bf16_t)(Rv.y >> 16); } \
  } while (0)
  f32x4 sacc[NST];
#pragma unroll
  for (int i = 0; i < NST; ++i) sacc[i] = (f32x4){0.f, 0.f, 0.f, 0.f};
  A_LOAD(R, Rv, 0);
  A_PREP(0, R, Rv);
  A_LOAD(R, Rv, 1);
  A_LOAD(Rn, Rvn, 2);
  rr_cur = rr_next;
  lds_barrier();
#define SCAN_ITER(n_, RX, RvX) do { const int n = (n_); \
    const int cb = n & 1, nb = (n + 1) & 1; \
    if (n + 1 < NCH) { A_PREP(nb, RX, RvX); if (n + 3 < NCH) A_LOAD(RX, RvX, n + 3); } \
    { { \
      const int lane = lane0; \
      const int fr = lane & 15, fq = lane >> 4; \
      const int it = wid & 3, vt = wid >> 2; \
      const unsigned char* STc = lds + U_ST + cb * 13056; unsigned char* STn = lds + U_ST + nb * 13056; \
      const unsigned char* KTc = lds + U_KT + cb * 18432; const unsigned char* VTc = lds + U_VT + cb * 6912; \
      const unsigned char* QI = lds + U_QI + cb * 17408; const unsigned char* KS = lds + U_KS + cb * 17408; \
      const float* DECc = (const float*)(lds + U_DEC + cb * 512); const float* EMc = (const float*)(lds + U_EM + cb * 256); \
      bf16x8 qf[NKD]; \
_Pragma("unroll") \
      for (int ks = 0; ks < NKD; ++ks) qf[ks] = ldfrag(QI, LD_D, it * 16 + fr, ks * 64 + fq * 16); \
        \
      u32x2 sp[4]; \
_Pragma("unroll") \
      for (int jt = 0; jt < 4; ++jt) { \
        sp[jt] = (u32x2){0u, 0u}; \
        if (PROBE_ALLTILES || jt <= it) { \
          f32x4 acc = (f32x4){0.f, 0.f, 0.f, 0.f}; \
_Pragma("unroll") \
          for (int ks = 0; ks < NKD; ++ks) acc = __builtin_amdgcn_mfma_f32_16x16x32_bf16(ldfrag(KS, LD_D, jt * 16 + fr, ks * 64 + fq * 16), qf[ks], acc, 0, 0, 0); \
          if (jt == it) { const int i = fr, j0 = fq * 4; \
            const float v0 = (j0 + 0 <= i) ? acc[0] : 0.f, v1 = (j0 + 1 <= i) ? acc[1] : 0.f, v2 = (j0 + 2 <= i) ? acc[2] : 0.f, v3 = (j0 + 3 <= i) ? acc[3] : 0.f; \
            sp[jt] = (u32x2){pk_hw(v0, v1), pk_hw(v2, v3)}; } \
          else if (jt < it) sp[jt] = (u32x2){pk_hw(acc[0], acc[1]), pk_hw(acc[2], acc[3])}; \
          else asm volatile("" :: "v"(acc)); \
        } \
      } \
        \
        \
      const u32x4 sb0 = (u32x4){sp[0].x, sp[0].y, sp[1].x, sp[1].y}, sb1 = (u32x4){sp[2].x, sp[2].y, sp[3].x, sp[3].y}; \
      f32x4 oacc = (f32x4){0.f, 0.f, 0.f, 0.f}, dacc = (f32x4){0.f, 0.f, 0.f, 0.f}; \
_Pragma("unroll") \
      for (int ks = 0; ks < NKD; ++ks) oacc = __builtin_amdgcn_mfma_f32_16x16x32_bf16(ldfrag(STc, LD_D, vt * 16 + fr, ks * 64 + fq * 16), qf[ks], oacc, 0, 0, 0); \
      if (NVT == 3) { \
_Pragma("unroll") \
        for (int ks = 0; ks < NKD; ++ks) dacc = __builtin_amdgcn_mfma_f32_16x16x32_bf16(ldfrag(STc, LD_D, 32 + fr, ks * 64 + fq * 16), qf[ks], dacc, 0, 0, 0); \
      } \
      if (MIXER == MIX_D) { _Pragma("unroll") for (int e_ = 0; e_ < 4; ++e_) { oacc[e_] = FMUL(oacc[e_], rr_cur); dacc[e_] = FMUL(dacc[e_], rr_cur); } } \
      oacc = __builtin_amdgcn_mfma_f32_16x16x32_bf16(ldfrag2(VTc, LD_T, vt * 16 + fr, fq * 8, 32 + fq * 8), __builtin_bit_cast(bf16x8, sb0), oacc, 0, 0, 0); \
      if (it >= 2) oacc = __builtin_amdgcn_mfma_f32_16x16x32_bf16(ldfrag2(VTc, LD_T, vt * 16 + fr, 64 + fq * 8, 96 + fq * 8), __builtin_bit_cast(bf16x8, sb1), oacc, 0, 0, 0); \
      float dn = 1.0f; \
      if (NVT == 3) { \
        dacc = __builtin_amdgcn_mfma_f32_16x16x32_bf16(ldfrag2(VTc, LD_T, 32 + fr, fq * 8, 32 + fq * 8), __builtin_bit_cast(bf16x8, sb0), dacc, 0, 0, 0); \
        if (it >= 2) dacc = __builtin_amdgcn_mfma_f32_16x16x32_bf16(ldfrag2(VTc, LD_T, 32 + fr, 64 + fq * 8, 96 + fq * 8), __builtin_bit_cast(bf16x8, sb1), dacc, 0, 0, 0); \
        const float den = __shfl(dacc[0], fr); \
        dn = 1.0f / fmaxf(fabsf(den), EMc[it * 16 + fr]); \
      } \
      { \
        const int i = it * 16 + fr; \
        const int ti = dir ? (SEQ - 1 - (n * 64 + i)) : (n * 64 + i); \
        const f32x4 o = (f32x4){FMUL(oacc[0], dn), FMUL(oacc[1], dn), FMUL(oacc[2], dn), FMUL(oacc[3], dn)}; \
        *(u32x2*)(O + PIDX(tokbase + ti, ocol + vt * 16 + fq * 4)) = (u32x2){pk_hw(o[0], o[1]), pk_hw(o[2], o[3])}; \
      } \
      const int dts = (DK == 128) ? wid : (wid & 3); \
      const bf16x8 kf0 = ldfrag(KTc, LD_T, dts * 16 + fr, fq * 16), kf1 = ldfrag(KTc, LD_T, dts * 16 + fr, 64 + fq * 16); \
      const f32x4 dc = *(const f32x4*)(DECc + dts * 16 + fq * 4); \
_Pragma("unroll") \
      for (int s = 0; s < NST; ++s) { \
        const int dt = dts, vt2 = (DK == 128) ? s : (wid >> 2); \
        f32x4 acc = (f32x4){FMUL(sacc[s][0], dc[0]), FMUL(sacc[s][1], dc[1]), FMUL(sacc[s][2], dc[2]), FMUL(sacc[s][3], dc[3])}; \
        acc = __builtin_amdgcn_mfma_f32_16x16x32_bf16(kf0, ldfrag(VTc, LD_T, vt2 * 16 + fr, fq * 16), acc, 0, 0, 0); \
        acc = __builtin_amdgcn_mfma_f32_16x16x32_bf16(kf1, ldfrag(VTc, LD_T, vt2 * 16 + fr, 64 + fq * 16), acc, 0, 0, 0); \
        sacc[s] = acc; \
        *(u32x2*)(STn + (vt2 * 16 + fr) * LD_D + (dt * 16 + fq * 4) * 2) = (u32x2){pk_hw(acc[0], acc[1]), pk_hw(acc[2], acc[3])}; \
      } \
    } \
    } \
    rr_cur = rr_next; \
    lds_barrier(); \
  } while (0)
  static_assert(NCH % 2 == 0, "chunk count must be even");
#pragma unroll 1
  for (int n2 = 0; n2 < NCH; n2 += 2) { SCAN_ITER(n2, R, Rv); SCAN_ITER(n2 + 1, Rn, Rvn); }
#undef SCAN_ITER
#undef A_LOAD
#undef A_PREP
}

template <int MIXER>
__device__ __forceinline__ void scan_dispatch2(unsigned char* lds, int wv, const Params& p, int id) {
  const int vs = id & 3, dir = (id >> 2) & 1, h = (id >> 3) & 3, b = id >> 5;
  scan_item2<MIXER>(lds, wv, p, b, h, dir, vs);
}
}

__device__ __forceinline__ void scan_phase2(unsigned char* lds, int wv, const Params& p, int layer, int convert) {
  bool light = false;
  for (int it0 = blockIdx.x; it0 < 256; it0 += gridDim.x) {
    const int xq = it0 & 7, yq = it0 >> 3, stream = (yq >> 2) * 8 + xq;
    const int item = (stream >> 5) * 128 + (stream & 31) * 4 + (yq & 3);
    if (layer == 0) { if (item < 128) scan2::scan_dispatch2<scan::MIX_A>(lds, wv, p, item); else scan2::scan_dispatch2<scan::MIX_B>(lds, wv, p, item - 128); }
    else { if (item < 128) scan2::scan_dispatch2<scan::MIX_D>(lds, wv, p, item); else scan2::scan_dispatch2<scan::MIX_C>(lds, wv, p, item - 128); }
    light = item >= 128;
    __syncthreads();
  }
  if (convert) {
    const int G = gridDim.x, b = blockIdx.x;
    if (G == 256) { if (light) moe_weight_convert(lds, wv, p, layer, 0, b - 128, 128); }
    else moe_weight_convert(lds, wv, p, layer, 0, b, G);
  }
}
#endif
#ifndef CPU_EMU
#define XB_BASE     2048
#define XB_TMO      (XB_BASE + 128)
#define XB_XCNT(j)  (XB_BASE + 256  + 64 * (j))
#define XB_XSUB(j)  (XB_BASE + 1280 + 64 * (j))
#define XB_XGEN(j)  (XB_BASE + 2304 + 64 * (j))
#define XB_TOP      (XB_BASE + 3328)
#define XB_TOPGEN   (XB_BASE + 3392)
#define XB_WORDS    3456
#define XB_SPIN_CAP (1u << 22)
#define XB_LDS_OFF  (LDS_BYTES - 16)
__device__ __forceinline__ unsigned xb_ld(unsigned* p)              { return __hip_atomic_load(p, __ATOMIC_RELAXED, __HIP_MEMORY_SCOPE_AGENT); }
__device__ __forceinline__ unsigned xb_add(unsigned* p, unsigned v) { return __hip_atomic_fetch_add(p, v, __ATOMIC_RELAXED, __HIP_MEMORY_SCOPE_AGENT); }
__device__ __forceinline__ unsigned xb_xcc_id() { return (unsigned)__builtin_amdgcn_s_getreg((3 << 11) | 20) & 0xFu; }
#define XB_SPIN(cond, bar) do { unsigned _sp = 0; while (cond) { __builtin_amdgcn_s_sleep(1); \
    if ((++_sp & 255u) == 0u) { if (xb_ld(&(bar)[XB_TMO])) break; if (_sp > XB_SPIN_CAP) { atomicAdd(&(bar)[XB_TMO], 1u); break; } } } } while (0)
__device__ __forceinline__ void grid_bar(unsigned* bar, unsigned char* lds_raw, int wv) {
  asm volatile("s_waitcnt vmcnt(0)" ::: "memory");
  __syncthreads();
  if (wv == 0 && lane_id() == 0) {
    volatile unsigned* st = (volatile unsigned*)(lds_raw + XB_LDS_OFF);
    __builtin_amdgcn_s_waitcnt(0);
    const unsigned x = xb_xcc_id();
    unsigned nloc = st[0], nx = st[1];
    if (nloc == 0u) {
      const unsigned G = gridDim.x; unsigned sum, cnt, mine, sp = 0u;
      for (;;) { sum = 0u; cnt = 0u; mine = 0u;
#pragma unroll
        for (unsigned j = 0; j < 16; ++j) { const unsigned c = xb_ld(&bar[XB_XCNT(j)]); sum += c; cnt += (c > 0u) ? 1u : 0u; mine = (j == x) ? c : mine; }
        if (sum == G) break;
        __builtin_amdgcn_s_sleep(1);
        if ((++sp & 255u) == 0u) { if (xb_ld(&bar[XB_TMO])) break; if (sp > XB_SPIN_CAP) { atomicAdd(&bar[XB_TMO], 1u); break; } } }
      nloc = mine > 0u ? mine : 1u; nx = cnt > 0u ? cnt : 1u; st[0] = nloc; st[1] = nx;
    }
    const unsigned old = xb_add(&bar[XB_XSUB(x)], 1u);
    const unsigned gen = old / nloc;
    if (old + 1u == (gen + 1u) * nloc) {
      __builtin_amdgcn_fence(__ATOMIC_RELEASE, "agent");
      asm volatile("s_waitcnt vmcnt(0)" ::: "memory");
      const unsigned og = xb_add(&bar[XB_TOP], 1u);
      const unsigned tg = og / nx;
      if (og + 1u == (tg + 1u) * nx) xb_add(&bar[XB_TOPGEN], 1u);
      else XB_SPIN(xb_ld(&bar[XB_TOPGEN]) == tg, bar);
      __builtin_amdgcn_fence(__ATOMIC_ACQUIRE, "agent");
      xb_add(&bar[XB_XGEN(x)], 1u);
      asm volatile("s_waitcnt vmcnt(0)" ::: "memory");
    } else {
      XB_SPIN(xb_ld(&bar[XB_XGEN(x)]) == gen, bar);
      __builtin_amdgcn_fence(__ATOMIC_ACQUIRE, "agent");
      asm volatile("s_waitcnt vmcnt(0)" ::: "memory");
    }
  }
  __syncthreads();
}
#if (PROBE_DUP & 16)
#define grid_bar(a, b, c) do { grid_bar(a, b, c); grid_bar(a, b, c); } while (0)
#endif

__global__ void __launch_bounds__(NTHREADS) mk_fwd(Params p) {
  extern __shared__ __attribute__((aligned(16))) unsigned char lds_raw[];
  cg::grid_group grid = cg::this_grid();
  const int G = gridDim.x, bid = blockIdx.x;
  const int wv = __builtin_amdgcn_readfirstlane(threadIdx.x >> 6);
  PG8_LAS unsigned char* lds = (PG8_LAS unsigned char*)lds_raw;
  unsigned char* ws = p.ws;

  if (threadIdx.x < 4) ((unsigned*)(lds_raw + XB_LDS_OFF))[threadIdx.x] = 0u;
  p0_prologue(lds_raw, wv, p);
#if (PROBE_DUP & 128)
  p0_prologue(lds_raw, wv, p);
#endif
  grid.sync();
  unsigned* bar = (unsigned*)(ws + WS_CTL);
  if (wv == 0 && lane_id() == 0) (void)xb_add(&bar[XB_XCNT(xb_xcc_id())], 1u);
  for (int layer = 0; layer < 2; ++layer) {
    { ProbInProj pr; pr.so.init(NTOK, layer == 0 ? PM_AB : PM_CD, G, bid); pr.A = (const char*)(ws + WS_HB); pr.Bt = (const char*)(ws + (layer == 0 ? WS_WIN_AB : WS_WIN_CD));
      pr.P = (bf16_t*)(ws + WS_R1); pr.bias = p.in[layer == 0 ? I_AB_B_IN : I_CD_B_IN]; pr.lb = (const float*)(ws + WS_LB); pr.layer = layer;
      pg8::gemm_phase(lds, pr, wv);
#if (PROBE_DUP & (1 | 2048))
      pg8::gemm_phase(lds, pr, wv);
#endif
      if (layer == 0) side_phase<32>(lds_raw, wv, p, 0); else side_phase<16>(lds_raw, wv, p, 1);
#if (PROBE_DUP & 256)
      if (layer == 0) side_phase<32>(lds_raw, wv, p, 0); else side_phase<16>(lds_raw, wv, p, 1);
#endif
 }
    grid_bar(bar, lds_raw, wv);
    if (layer == 1) { convd_phase(lds_raw, wv, p); grid_bar(bar, lds_raw, wv); }
    scan_phase2(lds_raw, wv, p, layer, 1);
#if (PROBE_DUP & 2)
    scan_phase2(lds_raw, wv, p, layer, 0);
#endif
#if (PROBE_DUP & 512)
    if (layer == 0) scan_phase2(lds_raw, wv, p, layer, 0);
#endif
#if (PROBE_DUP & 1024)
    if (layer == 1) scan_phase2(lds_raw, wv, p, layer, 0);
#endif
    grid_bar(bar, lds_raw, wv);
    headnorm_phase(lds_raw, wv, p, layer);
#if (PROBE_DUP & 8)
    headnorm_phase(lds_raw, wv, p, layer);
#endif
    grid_bar(bar, lds_raw, wv);
    { ProbOutProj pr; pr.so.init(NTOK, 1024, G, bid); pr.A = (const char*)(ws + WS_MIX); pr.Bt = (const char*)(ws + (layer == 0 ? WS_WOUT_AB : WS_WOUT_CD)); pr.Y = (float*)(ws + WS_R2); pr.Hres = layer == 0 ? p.in[I_X] : p.out;
      pg8::gemm_phase(lds, pr, wv);
#if (PROBE_DUP & (1 | 16384))
      pg8::gemm_phase(lds, pr, wv);
#endif
      moe_weight_convert(lds_raw, wv, p, layer, 1, bid, G);
 }
    grid_bar(bar, lds_raw, wv);
#if (PROBE_DUP & 32)
    ln_phase(lds_raw, wv, p, layer, 0, 1);
#endif
    ln_phase(lds_raw, wv, p, layer, 0);
    grid_bar(bar, lds_raw, wv);
    { ProbMoe1 pr; pr.mo.init((const int*)((const unsigned*)(ws + WS_CTL) + CW_CNT(layer)), 8, G, bid, lds_raw, wv);
      pr.A = (const char*)(ws + WS_MIX); pr.W13 = (const char*)(ws + WS_W13); pr.list = (const int*)(ws + WS_LIST) + (size_t)layer * NEXP * NTOK; pr.H = (bf16_t*)(ws + WS_H);
      pg8::gemm_phase(lds, pr, wv);
#if (PROBE_DUP & (1 | 4096))
      pg8::gemm_phase(lds, pr, wv);
#endif
 }
    grid_bar(bar, lds_raw, wv);
    { ProbMoe2 pr; pr.mo.init((const int*)((const unsigned*)(ws + WS_CTL) + CW_CNT(layer)), 4, G, bid, lds_raw, wv);
      pr.A = (const char*)(ws + WS_H); pr.W2 = (const char*)(ws + WS_W2); pr.Y = (bf16_t*)(ws + WS_R2);
      pg8::gemm_phase(lds, pr, wv);
#if (PROBE_DUP & (1 | 8192))
      pg8::gemm_phase(lds, pr, wv);
#endif
 }
    grid_bar(bar, lds_raw, wv);
#if (PROBE_DUP & 64)
    ln_phase(lds_raw, wv, p, layer, 1, 1);
#endif
    ln_phase(lds_raw, wv, p, layer, 1);
    if (layer == 0) grid_bar(bar, lds_raw, wv);
  }
}

extern "C" void kernel_launch(void* const* d_in, const int* in_sizes, int n_in, void* d_out, int out_size, void* d_ws, size_t ws_size, hipStream_t stream) {
  static int grid_blocks = 0;
  if (grid_blocks == 0) {
    if (n_in != N_IN || ws_size < WS_END || out_size != NTOK * 1024) { fprintf(stderr, "kernel_launch: bad shapes: n_in %d ws %zu (need %zu) out %d\n", n_in, ws_size, (size_t)WS_END, out_size); grid_blocks = -1; return; }
    int dev = 0, cus = 0, per_cu = 0;
    hipGetDevice(&dev); hipDeviceGetAttribute(&cus, hipDeviceAttributeMultiprocessorCount, dev);
    if (hipFuncSetAttribute((const void*)mk_fwd, hipFuncAttributeMaxDynamicSharedMemorySize, LDS_BYTES) != hipSuccess) { fprintf(stderr, "kernel_launch: hipFuncSetAttribute failed\n"); grid_blocks = -1; return; }
    if (hipOccupancyMaxActiveBlocksPerMultiprocessor(&per_cu, (const void*)mk_fwd, NTHREADS, LDS_BYTES) != hipSuccess || per_cu < 1) { fprintf(stderr, "kernel_launch: occupancy query failed (%d)\n", per_cu); grid_blocks = -1; return; }
    grid_blocks = cus;
    (void)in_sizes;
  }
  if (grid_blocks < 0) return;
  Params p{};
  for (int i = 0; i < N_IN; ++i) p.in[i] = (const float*)d_in[i];
  p.out = (float*)d_out; p.ws = (unsigned char*)d_ws;
  void* args[] = {&p};
  hipError_t e = hipLaunchCooperativeKernel((const void*)mk_fwd, dim3(grid_blocks), dim3(NTHREADS), args, LDS_BYTES, stream);
  if (e != hipSuccess) fprintf(stderr, "cooperative launch failed: %s (grid %d)\n", hipGetErrorString(e), grid_blocks);
}
#endif
```

```cpp
#ifdef CPU_EMU
#include <cmath>
#include <cstdio>
#include <cstring>
#include <cstdlib>
#include <cstddef>
#define DEV
#define DEV_INLINE static inline
typedef void* hipStream_t;
#else
#include <hip/hip_runtime.h>
#include <hip/hip_bf16.h>
#include <cstdio>
#define DEV __device__ __forceinline__
#define DEV_INLINE __device__ __forceinline__
#endif
#ifndef PROBE_DUP
#define PROBE_DUP 0
#endif
#ifndef BATCH
#define BATCH 4
#endif
#ifndef SEQ
#define SEQ 8192
#endif
#define DM 1024
#define NTOK (BATCH * SEQ)
#define P_AB 4128
#define P_CD 3600
#define PM_AB 4096
#define PM_CD 3584
#define NEXP 16
#define ALPHA_F 1.4142135623730951f
#define LN_EPS_F 1e-5f
#define NORM_EPS_F 1e-6f
#define HROWS (2 * NTOK + NEXP * 256)

typedef unsigned short bf16_t;

DEV_INLINE float bf2f(bf16_t b) { unsigned u = ((unsigned)b) << 16; float f; memcpy(&f, &u, 4); return f; }
DEV_INLINE bf16_t f2bf(float f) { unsigned u; memcpy(&u, &f, 4); u += 0x7FFFu + ((u >> 16) & 1u); return (bf16_t)(u >> 16); }
DEV_INLINE float sigmoidf_(float x) { return 1.0f / (1.0f + expf(-x)); }
DEV_INLINE float siluf_(float x) { return x / (1.0f + expf(-x)); }
DEV_INLINE float logsigmoidf_(float x) { return fminf(x, 0.0f) - log1pf(expf(-fabsf(x))); }

#define AL256(x) (((size_t)(x) + 255) & ~(size_t)255)
#define WS_CTL    ((size_t)0)
#define WS_HB     ((size_t)65536)
#define WS_R1     (WS_HB + (size_t)NTOK * 1024 * 2)
#define R1_P_BYTES ((size_t)NTOK * 4096 * 2)
#define R1_MIN    ((size_t)NTOK * 1024 * 2 + AL256((size_t)HROWS * 1024 * 2))
#define R1_PL     (R1_P_BYTES + (size_t)NTOK * 512 * 2)
#define R1_BYTES  (R1_PL > R1_MIN ? R1_PL : R1_MIN)
#define WS_LFB    (WS_R1 + R1_P_BYTES)
#define WS_MIX    (WS_R1)
#define WS_H      (WS_R1 + (size_t)NTOK * 1024 * 2)
#define WS_W13    (WS_HB)
#define WS_W2     (WS_LFB)
#define WMOE_BYTES ((size_t)NEXP * 3072 * 1024 * 2)
#define WS_R2     (WS_R1 + R1_BYTES)
#define R2_BYTES  ((size_t)HROWS * 1024 * 2 > (size_t)NTOK * 1024 * 4 ? (size_t)HROWS * 1024 * 2 : (size_t)NTOK * 1024 * 4)
#define WS_SIDE   (WS_R2 + AL256(R2_BYTES))
#define WS_WIN_AB (WS_SIDE + (size_t)NTOK * 32 * 4)
#define WS_WIN_CD (WS_WIN_AB + (size_t)4128 * 1024 * 2)
#define WS_WOUT_AB (WS_WIN_CD + (size_t)3600 * 1024 * 2)
#define WS_WOUT_CD (WS_WOUT_AB + (size_t)1024 * 1024 * 2)
#define WS_ROPE   (WS_WOUT_CD + (size_t)1024 * 1024 * 2)
#define WS_LB     (WS_ROPE + (size_t)SEQ * 64 * 4)
#define WS_LIST   (WS_LB + 4096)
#define WS_ASSIGN (WS_LIST + (size_t)2 * NEXP * NTOK * 4)
#define WS_GATE   (WS_ASSIGN + (size_t)NTOK * 16)
#define WS_END    (WS_GATE + (size_t)NTOK * 8)
#define WS_W2X    (AL256(WS_END))
#define WS_END_BIG (WS_W2X + (size_t)NEXP * 1024 * 1024 * 2)
#define CW_CNT(layer) (64 + 256 * (layer))

#define PSTRIDE 4096
#define PIDX(tok, col) ((((size_t)((col) >> 7)) * NTOK + (size_t)(tok)) * 128 + (size_t)((col) & 127))

enum { I_X, I_AB_W_IN, I_AB_B_IN, I_HGRN_LB, I_GK_UP, I_GK_B, I_HGRN_NORM, I_GLA_NORM, I_AB_W_OUT,
       I_CD_W_IN, I_CD_B_IN, I_CONV_W, I_CONV_B, I_FGATE_B, I_RET_NORM, I_MLSTM_NORM, I_CD_W_OUT,
       I_LN_MIX_G, I_LN_MIX_B, I_LN_FFN_G, I_LN_FFN_B, I_ROUTER_W, I_ROUTER_B, I_MOE_W1, I_MOE_W3, I_MOE_W2, N_IN };

struct Params {
  const float* in[N_IN];
  float* out;
  unsigned char* ws;
  long long big_ws;
};

DEV_INLINE float epi_ab(int col, float v, const float* lb) {
  if (col < 512) return siluf_(v);
  if (col < 1536) { float l = lb[(col - 512) & 511]; return logf(l + (1.0f - l) * sigmoidf_(v)); }
  if (col >= 2560 && col < 2816) return v * 0.125f;
  return v;
}

DEV_INLINE void route_from_logits(const float* lg, const float* rb, int* e_out, float* g_out) {
  float mx = lg[0];
#pragma unroll
  for (int e = 1; e < 16; ++e) mx = fmaxf(mx, lg[e]);
  float sc[16]; float sum = 0.f;
#pragma unroll
  for (int e = 0; e < 16; ++e) { sc[e] = expf(lg[e] - mx); sum += sc[e]; }
  float inv = 1.0f / sum;
  float best_gs = -1e30f; int be1 = 0, be2 = 1; float bs1 = 0.f, bs2 = 0.f;
#pragma unroll
  for (int gq = 0; gq < 4; ++gq) {
    float m1 = -1e30f, m2 = -1e30f, s1 = 0.f, s2 = 0.f; int i1 = 0, i2 = 0;
#pragma unroll
    for (int i = 0; i < 4; ++i) {
      float s = sc[gq * 4 + i] * inv; float v = s + rb[gq * 4 + i];
      if (v > m1) { m2 = m1; i2 = i1; s2 = s1; m1 = v; i1 = gq * 4 + i; s1 = s; }
      else if (v > m2) { m2 = v; i2 = gq * 4 + i; s2 = s; }
    }
    float gs = m1 + m2;
    if (gs > best_gs) { best_gs = gs; be1 = i1; be2 = i2; bs1 = s1; bs2 = s2; }
  }
  e_out[0] = be1; e_out[1] = be2; g_out[0] = bs1 / (bs1 + bs2); g_out[1] = bs2 / (bs1 + bs2);
}
#ifndef CPU_EMU
namespace pg8 {
#define PG8_LAS __attribute__((address_space(3)))
typedef short bf16x8 __attribute__((ext_vector_type(8)));
typedef float f32x4 __attribute__((ext_vector_type(4)));
typedef unsigned u32x4 __attribute__((ext_vector_type(4)));
typedef unsigned u32x2 __attribute__((ext_vector_type(2)));
constexpr int BM = 256, BK = 64, HALF = 128, HTB = HALF * BK * 2, STAGE_BYTES = 8 * HTB, NXCD = 8, WGM = 8, GK = 1024;

__device__ __forceinline__ int lds_byte(int r, int c) { const int st = (r >> 4) * 2 + (c >> 5), rr = r & 15, cc = c & 31, ob = rr * 64 + cc * 2; return st * 1024 + (ob ^ (((ob >> 9) & 1) << 5)); }
__device__ __forceinline__ void stage_rc(int b, int& R, int& C) { const int st = b / 1024, sb = b % 1024, swz = sb ^ (((sb >> 9) & 1) << 5); R = (st >> 1) * 16 + swz / 64; C = (st & 1) * 32 + (swz % 64) / 2; }
__device__ __forceinline__ int perm32(int rho) { const int n = rho >> 4, i = rho & 15; return 8 * (i >> 2) + 4 * n + (i & 3); }
__device__ __forceinline__ unsigned cvt_pk_bf16(float lo, float hi) { unsigned r; asm volatile("v_cvt_pk_bf16_f32 %0, %1, %2" : "=v"(r) : "v"(lo), "v"(hi)); return r; }

struct Unit { int pm, pn, e, row0, ne, ui; };

struct StaticOrder {
  int nM, nN, nwg, G, c;
  __device__ void init(int M, int N, int G_, int c_) { nM = M / BM; nN = N / BM; nwg = nM * nN; G = G_; c = c_; }
  __device__ bool next(int i, Unit& u) const {
    const long L = (long)i * G + c; if (L >= nwg) return false;
    int wgid = (int)L; { const int q = nwg / NXCD, r = nwg % NXCD, xcd = wgid % NXCD, off = wgid / NXCD; wgid = (xcd < r ? xcd * (q + 1) : r * (q + 1) + (xcd - r) * q) + off; }
    const int nig = WGM * nN, gid = wgid / nig, fm = gid * WGM, gsz = (nM - fm) < WGM ? (nM - fm) : WGM;
    u.pm = fm + ((wgid % nig) % gsz); u.pn = (wgid % nig) / gsz; u.e = 0; u.row0 = u.pm * BM; u.ne = 0; u.ui = i; return true;
  }
};

template <class Prob>
__device__ __forceinline__ void gemm_phase(PG8_LAS unsigned char* lds, const Prob& S, int wv) {
  int wv_ = wv; asm volatile("" : "+s"(wv_));
  int l_; asm volatile("v_mbcnt_lo_u32_b32 %0, -1, 0\n\tv_mbcnt_hi_u32_b32 %0, -1, %0" : "=v"(l_));
  int tid_ = wv_ * 64 + l_;
  const int tid = tid_, wid = __builtin_amdgcn_readfirstlane(tid >> 6), lane = tid & 63, wr = wid >> 2, wc = wid & 3, fr = lane & 15, fq = lane >> 4;
  constexpr int K = GK, nt = K / BK;
  int sR[2], sC[2]; unsigned voffB[2];
#pragma unroll
  for (int i = 0; i < 2; ++i) { int R, C; stage_rc(tid * 16 + i * 8192, R, C); sR[i] = R; sC[i] = C; const int Rb = Prob::PERM ? ((R & ~31) + perm32(R & 31)) : R; voffB[i] = (unsigned)(Rb * K + C) * 2u; }
  const size_t kstep = (size_t)(BK * 2);
  const size_t hstep = (size_t)HALF * K * 2;
  const unsigned ldsw = (unsigned)wid * 1024u;
  const int aoff = lds_byte(wr * 64 + fr, fq * 8), boff = lds_byte(wc * 32 + fr, fq * 8);
#define PG8_SA(b, h) (((b) * 2 + (h)) * HTB)
#define PG8_SB(b, h) ((4 + (b) * 2 + (h)) * HTB)
#define PG8_STAGE(bufoff, gbase, voff) do { _Pragma("unroll") for (int _i = 0; _i < 2; ++_i) \
    __builtin_amdgcn_global_load_lds((const unsigned*)((const char*)(gbase) + (voff)[_i]), (PG8_LAS unsigned*)(lds + (bufoff) + ldsw + _i * 8192), 16, 0, 0); } while (0)
#define PG8_LDA(dst, b, h) do { _Pragma("unroll") for (int m = 0; m < 4; ++m) _Pragma("unroll") for (int k = 0; k < 2; ++k) dst[m][k] = *(const PG8_LAS bf16x8*)(lds + PG8_SA(b, h) + aoff + m * 2048 + k * 1024); } while (0)
#define PG8_LDB(dst, b, h) do { _Pragma("unroll") for (int n = 0; n < 2; ++n) _Pragma("unroll") for (int k = 0; k < 2; ++k) dst[n][k] = *(const PG8_LAS bf16x8*)(lds + PG8_SB(b, h) + boff + n * 2048 + k * 1024); } while (0)
#define PG8_MMA(ai, bj, At, Bt) do { __builtin_amdgcn_s_setprio(1); _Pragma("unroll") for (int m = 0; m < 4; ++m) _Pragma("unroll") for (int n = 0; n < 2; ++n) _Pragma("unroll") for (int k = 0; k < 2; ++k) \
    acc[ai][bj][m][n] = __builtin_amdgcn_mfma_f32_16x16x32_bf16(Bt[n][k], At[m][k], acc[ai][bj][m][n], 0, 0, 0); __builtin_amdgcn_s_setprio(0); } while (0)
#define PG8_WAIT_V(n) asm volatile("s_waitcnt vmcnt(" #n ")" ::: "memory")
#define PG8_WAIT_L(n) asm volatile("s_waitcnt lgkmcnt(" #n ")" ::: "memory")
#define PG8_BAR __builtin_amdgcn_s_barrier()
#define PG8_SCHED __builtin_amdgcn_sched_barrier(0)
  Unit cur, nxt; int ui = 0;
  if (!S.next(0, cur)) return;
  f32x4 acc[2][2][4][2];
#pragma unroll
  for (int a = 0; a < 2; ++a)
#pragma unroll
    for (int b = 0; b < 2; ++b)
#pragma unroll
      for (int m = 0; m < 4; ++m)
#pragma unroll
        for (int n = 0; n < 2; ++n) acc[a][b][m][n] = (f32x4){0.f, 0.f, 0.f, 0.f};
  bf16x8 At[4][2], B0[2][2], B1[2][2];
  unsigned oc0[2], oc1[2], on0[2], on1[2];
#pragma unroll
  for (int i = 0; i < 2; ++i) { oc0[i] = S.a_off(cur, sR[i]) + (unsigned)sC[i] * 2u; oc1[i] = S.a_off(cur, HALF + sR[i]) + (unsigned)sC[i] * 2u; }
  const char* const Ab = S.a_base();
  const char* cB = S.b_base(cur);
  PG8_STAGE(PG8_SB(0, 0), cB, voffB); PG8_STAGE(PG8_SB(0, 1), cB + hstep, voffB); PG8_STAGE(PG8_SA(0, 0), Ab, oc0); PG8_STAGE(PG8_SA(0, 1), Ab, oc1);
  if (wr == 1) PG8_BAR;
  PG8_WAIT_V(2); PG8_BAR;
  PG8_STAGE(PG8_SB(1, 0), cB + kstep, voffB); PG8_STAGE(PG8_SA(1, 0), Ab + kstep, oc0); PG8_STAGE(PG8_SB(1, 1), cB + hstep + kstep, voffB);
  PG8_WAIT_V(6); PG8_BAR;
  for (;;) {
    const bool has_next = S.next(ui + 1, nxt);
    const char* nB = cB;
    if (has_next) {
      nB = S.b_base(nxt);
      int l2_; asm volatile("v_mbcnt_lo_u32_b32 %0, -1, 0\n\tv_mbcnt_hi_u32_b32 %0, -1, %0" : "=v"(l2_));
      const int tid2 = wid * 64 + l2_;
#pragma unroll
      for (int i = 0; i < 2; ++i) { int R, C; stage_rc(tid2 * 16 + i * 8192, R, C); on0[i] = S.a_off(nxt, R) + (unsigned)C * 2u; on1[i] = S.a_off(nxt, HALF + R) + (unsigned)C * 2u; }
    } else {
#pragma unroll
      for (int i = 0; i < 2; ++i) { on0[i] = oc0[i]; on1[i] = oc1[i]; }
    }
    for (int t = 0; t < nt; t += 2) {
      const bool last = (t == nt - 2);
      const char* a1 = Ab + (size_t)(t + 1) * kstep;
      const char* a2 = last ? Ab : Ab + (size_t)(t + 2) * kstep; const char* b2 = last ? nB : cB + (size_t)(t + 2) * kstep;
      const char* a3 = a2 + kstep; const char* b3 = b2 + kstep;
      unsigned o20[2], o21[2];
#pragma unroll
      for (int i = 0; i < 2; ++i) { o20[i] = last ? on0[i] : oc0[i]; o21[i] = last ? on1[i] : oc1[i]; }
      PG8_LDB(B0, 0, 0); PG8_LDB(B1, 0, 1); PG8_SCHED; PG8_LDA(At, 0, 0); PG8_STAGE(PG8_SA(1, 1), a1, oc1);
      PG8_WAIT_V(8); PG8_WAIT_L(0); PG8_BAR; PG8_MMA(0, 0, At, B0); PG8_MMA(0, 1, At, B1); PG8_BAR; PG8_SCHED;
      PG8_LDA(At, 0, 1); PG8_STAGE(PG8_SB(0, 0), b2, voffB); PG8_STAGE(PG8_SB(0, 1), b2 + hstep, voffB); PG8_STAGE(PG8_SA(0, 0), a2, o20);
      PG8_WAIT_V(8); PG8_WAIT_L(0); PG8_BAR; PG8_MMA(1, 0, At, B0); PG8_MMA(1, 1, At, B1); PG8_BAR; PG8_SCHED;
      PG8_LDB(B0, 1, 0); PG8_LDB(B1, 1, 1); PG8_SCHED; PG8_LDA(At, 1, 0); PG8_STAGE(PG8_SA(0, 1), a2, o21);
      PG8_WAIT_V(8); PG8_WAIT_L(0); PG8_BAR; PG8_MMA(0, 0, At, B0); PG8_MMA(0, 1, At, B1); PG8_BAR; PG8_SCHED;
      PG8_LDA(At, 1, 1); PG8_STAGE(PG8_SB(1, 0), b3, voffB); PG8_STAGE(PG8_SB(1, 1), b3 + hstep, voffB); PG8_STAGE(PG8_SA(1, 0), a3, o20);
      PG8_WAIT_V(8); PG8_WAIT_L(0); PG8_BAR; PG8_MMA(1, 0, At, B0); PG8_MMA(1, 1, At, B1); PG8_BAR; PG8_SCHED;
    }
    if (wr == 0) PG8_BAR;
    { int l3_; asm volatile("v_mbcnt_lo_u32_b32 %0, -1, 0\n\tv_mbcnt_hi_u32_b32 %0, -1, %0" : "=v"(l3_));
      S.epi(acc, cur, wr, wc, l3_ & 15, l3_ >> 4); }
    if (!has_next) break;
#pragma unroll
    for (int a = 0; a < 2; ++a)
#pragma unroll
      for (int b = 0; b < 2; ++b)
#pragma unroll
        for (int m = 0; m < 4; ++m)
#pragma unroll
          for (int n = 0; n < 2; ++n) acc[a][b][m][n] = (f32x4){0.f, 0.f, 0.f, 0.f};
    cur = nxt; cB = nB; ++ui;
#pragma unroll
    for (int i = 0; i < 2; ++i) { oc0[i] = on0[i]; oc1[i] = on1[i]; }
    if (wr == 1) PG8_BAR;
  }
  PG8_WAIT_V(0);
  PG8_BAR;
#undef PG8_SA
#undef PG8_SB
#undef PG8_STAGE
#undef PG8_LDA
#undef PG8_LDB
#undef PG8_MMA
#undef PG8_WAIT_V
#undef PG8_WAIT_L
#undef PG8_BAR
#undef PG8_SCHED
}
}
#endif
#ifndef CPU_EMU
#include <hip/hip_cooperative_groups.h>
namespace cg = cooperative_groups;
#define LAS __attribute__((address_space(3)))
#define NTHREADS 512
#define LDS_BYTES (154 * 1024)
typedef float f32x4 __attribute__((ext_vector_type(4)));
typedef short bf16x8 __attribute__((ext_vector_type(8)));
typedef unsigned u32x4 __attribute__((ext_vector_type(4)));
typedef unsigned u32x2 __attribute__((ext_vector_type(2)));

struct Ctx { int tid, lane, wid, G, bid; unsigned char* lds; };
__device__ __forceinline__ int lane_id() { int l; asm volatile("v_mbcnt_lo_u32_b32 %0, -1, 0\n\tv_mbcnt_hi_u32_b32 %0, -1, %0" : "=v"(l)); return l; }
__device__ __forceinline__ int opaque_tid(int wv) { int w = wv; asm volatile("" : "+s"(w)); int t = w * 64 + lane_id(); asm volatile("" : "+v"(t)); return t; }
__device__ __forceinline__ Ctx make_ctx(unsigned char* lds, int wv) { Ctx c; c.tid = opaque_tid(wv); c.lane = c.tid & 63; c.wid = __builtin_amdgcn_readfirstlane(c.tid >> 6); c.G = gridDim.x; c.bid = blockIdx.x; c.lds = lds; return c; }

__device__ __forceinline__ float wave_sum(float x) {
  x += __builtin_bit_cast(float, __builtin_amdgcn_update_dpp(0, __builtin_bit_cast(int, x), 0x111, 0xf, 0xf, false));
  x += __builtin_bit_cast(float, __builtin_amdgcn_update_dpp(0, __builtin_bit_cast(int, x), 0x112, 0xf, 0xf, false));
  x += __builtin_bit_cast(float, __builtin_amdgcn_update_dpp(0, __builtin_bit_cast(int, x), 0x114, 0xf, 0xf, false));
  x += __builtin_bit_cast(float, __builtin_amdgcn_update_dpp(0, __builtin_bit_cast(int, x), 0x118, 0xf, 0xf, false));
  x += __builtin_bit_cast(float, __builtin_amdgcn_update_dpp(0, __builtin_bit_cast(int, x), 0x142, 0xa, 0xf, false));
  x += __builtin_bit_cast(float, __builtin_amdgcn_update_dpp(0, __builtin_bit_cast(int, x), 0x143, 0xc, 0xf, false));
  return __builtin_bit_cast(float, __builtin_amdgcn_readlane(__builtin_bit_cast(int, x), 63));
}
__device__ __forceinline__ float fsigmoid(float x) { return __builtin_amdgcn_rcpf(1.0f + __builtin_amdgcn_exp2f(-1.4426950408889634f * x)); }
__device__ __forceinline__ float fsilu(float x) { return x * fsigmoid(x); }
__device__ __forceinline__ float flog2sigmoid(float x) { const float y = x * 1.4426950408889634f; return fminf(y, 0.f) - __builtin_amdgcn_logf(1.0f + __builtin_amdgcn_exp2f(-fabsf(y))); }
typedef float f32x2_t __attribute__((ext_vector_type(2)));
typedef __bf16 bf16x2_t __attribute__((ext_vector_type(2)));
__device__ __forceinline__ unsigned pk_hw(float a, float b) { const f32x2_t v = {a, b}; return __builtin_bit_cast(unsigned, __builtin_convertvector(v, bf16x2_t)); }
__device__ __forceinline__ unsigned pk2(float a, float b) { return pk_hw(a, b); }
__device__ __forceinline__ void unpack8(u32x4 w, float* f) {
  f[0] = __uint_as_float(w.x << 16); f[1] = __uint_as_float(w.x & 0xffff0000u); f[2] = __uint_as_float(w.y << 16); f[3] = __uint_as_float(w.y & 0xffff0000u);
  f[4] = __uint_as_float(w.z << 16); f[5] = __uint_as_float(w.z & 0xffff0000u); f[6] = __uint_as_float(w.w << 16); f[7] = __uint_as_float(w.w & 0xffff0000u);
}

__device__ __forceinline__ void transpose_job(const Ctx& c, const float* src, int N, bf16_t* dst, int rs, int ro, int tile0, int tile_stride) {
  float* t = (float*)c.lds;
  const int ntn = (N + 63) / 64, ntiles = ntn * 16;
  for (int tl = tile0; tl < ntiles; tl += tile_stride) {
    const int kt = tl / ntn, nt_ = tl % ntn, k0 = kt * 64, n0 = nt_ * 64;
    __syncthreads();
#pragma unroll
    for (int i = 0; i < 8; ++i) { const int idx = c.tid + i * 512, kk = idx >> 6, nn = idx & 63; t[kk * 65 + nn] = (n0 + nn < N) ? src[(size_t)(k0 + kk) * N + n0 + nn] : 0.f; }
    __syncthreads();
#pragma unroll
    for (int i = 0; i < 4; ++i) { const int idx = c.tid + i * 512, nn = idx >> 5, kp = (idx & 31) * 2;
      if (n0 + nn < N) *(unsigned*)(dst + (size_t)((n0 + nn) * rs + ro) * 1024 + k0 + kp) = pk2(t[kp * 65 + nn], t[(kp + 1) * 65 + nn]); }
  }
  __syncthreads();
}
__device__ __forceinline__ void p0_prologue(unsigned char* lds_, int wv, const Params& p) {
  const Ctx c = make_ctx(lds_, wv);
  unsigned char* ws = p.ws;
  if (c.bid == 0) { ((unsigned*)(ws + WS_CTL))[64 + c.tid] = 0u; }
  if (c.bid == 0) { for (int i = c.tid; i < 3456; i += NTHREADS) ((unsigned*)(ws + WS_CTL))[2048 + i] = 0u; }
  { const float* x = p.in[I_X]; bf16_t* hb = (bf16_t*)(ws + WS_HB);
    for (size_t i = (size_t)c.bid * NTHREADS + c.tid; i < (size_t)NTOK * 1024 / 8; i += (size_t)c.G * NTHREADS) {
      const f32x4 a = __builtin_nontemporal_load((const f32x4*)(x + i * 8)), b = __builtin_nontemporal_load((const f32x4*)(x + i * 8 + 4));
      u32x4 w; w.x = pk2(a[0], a[1]); w.y = pk2(a[2], a[3]); w.z = pk2(b[0], b[1]); w.w = pk2(b[2], b[3]);
      *(u32x4*)(hb + i * 8) = w; } }
  transpose_job(c, p.in[I_AB_W_IN], P_AB, (bf16_t*)(ws + WS_WIN_AB), 1, 0, c.bid, c.G);
  transpose_job(c, p.in[I_CD_W_IN], P_CD, (bf16_t*)(ws + WS_WIN_CD), 1, 0, c.bid, c.G);
  transpose_job(c, p.in[I_AB_W_OUT], 1024, (bf16_t*)(ws + WS_WOUT_AB), 1, 0, c.bid, c.G);
  transpose_job(c, p.in[I_CD_W_OUT], 1024, (bf16_t*)(ws + WS_WOUT_CD), 1, 0, c.bid, c.G);
  { float* rope = (float*)(ws + WS_ROPE);
    for (int i = c.bid * NTHREADS + c.tid; i < SEQ * 32; i += c.G * NTHREADS) { const int t = i >> 5, f = i & 31;
      const float freq = powf(10000.0f, -(float)f / 32.0f); const float ang = (float)t * freq; rope[i * 2] = cosf(ang); rope[i * 2 + 1] = sinf(ang); }
    if (c.bid == 1) { const float* hl = p.in[I_HGRN_LB]; float* lb = (float*)(ws + WS_LB);
      const int cc = c.tid; const float a0 = hl[cc], a1 = hl[512 + cc], a2 = hl[1024 + cc]; const float mx = fmaxf(a0, fmaxf(a1, a2));
      const float e0 = expf(a0 - mx), e1 = expf(a1 - mx), e2 = expf(a2 - mx); lb[cc] = e0 / (e0 + e1 + e2); } }
}
__device__ __forceinline__ void moe_weight_convert(unsigned char* lds_, int wv, const Params& p, int layer, int part, int bidx, int nblk) {
  const Ctx c = make_ctx(lds_, wv);
  bf16_t* w13 = (bf16_t*)(p.ws + WS_W13); bf16_t* w2 = (bf16_t*)(p.ws + (p.big_ws ? WS_W2X : WS_W2));
  const size_t lo = (size_t)layer * NEXP * 1024 * 1024;
  const float* W1 = p.in[I_MOE_W1] + lo; const float* W3 = p.in[I_MOE_W3] + lo; const float* W2 = p.in[I_MOE_W2] + lo;
  float* t = (float*)c.lds;
  const int NT = (part == 0 ? 32 : 16) * 128;
  const int lk = c.tid >> 5, ln4 = (c.tid & 31) * 4;
  const int sn = c.tid & 127, sk = (c.tid >> 7) * 8;
  f32x4 r[4];
#define MW_SRC(g_) ((part == 0 ? ((((g_) >> 7) & 1) ? W3 : W1) + (size_t)((g_) >> 8) * 1048576 : W2 + (size_t)((g_) >> 7) * 1048576) + (size_t)((((g_) & 127) >> 3) * 64) * 1024 + ((g_) & 7) * 128)
#define MW_LOAD(g_) do { const float* s_ = MW_SRC(g_); _Pragma("unroll") for (int i = 0; i < 4; ++i) r[i] = __builtin_nontemporal_load((const f32x4*)(s_ + (size_t)(lk + 16 * i) * 1024 + ln4)); } while (0)
  int g0 = bidx;
  if (g0 < NT) MW_LOAD(g0);
  for (; g0 < NT; g0 += nblk) {
    __syncthreads();
#pragma unroll
    for (int i = 0; i < 4; ++i) { float* d = t + (lk + 16 * i) * 129 + ln4; d[0] = r[i][0]; d[1] = r[i][1]; d[2] = r[i][2]; d[3] = r[i][3]; }
    __syncthreads();
    const int gn = g0 + nblk;
    if (gn < NT) MW_LOAD(gn);
    const int m = g0 >> 7, k0 = ((g0 & 127) >> 3) * 64, n0 = (g0 & 7) * 128;
    bf16_t* drow = (part == 1) ? w2 + ((size_t)m * 1024 + n0 + sn) * 1024 : w13 + ((size_t)(m >> 1) * 2048 + 2 * (n0 + sn) + (m & 1)) * 1024;
#pragma unroll
    for (int j = 0; j < 2; ++j) { const int kk = sk + 32 * j; const float* s = t + kk * 129 + sn;
      u32x4 w; w.x = pk2(s[0], s[129]); w.y = pk2(s[2 * 129], s[3 * 129]); w.z = pk2(s[4 * 129], s[5 * 129]); w.w = pk2(s[6 * 129], s[7 * 129]);
      *(u32x4*)(drow + k0 + kk) = w; }
  }
#undef MW_SRC
#undef MW_LOAD
  __syncthreads();
}

struct ProbInProj {
  static constexpr bool PERM = true;
  pg8::StaticOrder so; const char* A; const char* Bt; bf16_t* P; const float* bias; const float* lb; int layer;
  __device__ __forceinline__ bool next(int i, pg8::Unit& u) const { return so.next(i, u); }
  __device__ __forceinline__ const char* a_base() const { return A; }
  __device__ __forceinline__ unsigned a_off(const pg8::Unit& u, int r) const { return (unsigned)(u.pm * 256 + r) * 2048u; }
  __device__ __forceinline__ const char* b_base(const pg8::Unit& u) const { return Bt + (size_t)u.pn * 256 * 2048; }
  __device__ __forceinline__ void epi(const f32x4 (&acc)[2][2][4][2], const pg8::Unit& u, int wr, int wc, int fr, int fq) const {
    const int row0 = u.row0 + wr * 64 + fr, colb = u.pn * 256 + wc * 32 + 8 * fq;
    int mode = 0;
    if (layer == 0) { mode = u.pn < 2 ? 1 : (u.pn < 6 ? 2 : (u.pn == 10 ? 3 : 0)); }
#pragma unroll
    for (int bj = 0; bj < 2; ++bj) {
      const int col0 = colb + bj * 128;
      const f32x4 b0 = *(const f32x4*)(bias + col0), b1 = *(const f32x4*)(bias + col0 + 4);
      f32x4 l0 = (f32x4){0.f, 0.f, 0.f, 0.f}, l1 = l0;
      if (mode == 2) { l0 = *(const f32x4*)(lb + ((col0 - 512) & 511)); l1 = *(const f32x4*)(lb + ((col0 - 512) & 511) + 4); }
#pragma unroll
      for (int ai = 0; ai < 2; ++ai)
#pragma unroll
        for (int m = 0; m < 4; ++m) {
          f32x4 v0 = acc[ai][bj][m][0] + b0, v1 = acc[ai][bj][m][1] + b1;
          if (mode == 1) {
#pragma unroll
            for (int j = 0; j < 4; ++j) { v0[j] = fsilu(v0[j]); v1[j] = fsilu(v1[j]); }
          } else if (mode == 2) {
#pragma unroll
            for (int j = 0; j < 4; ++j) { v0[j] = __builtin_amdgcn_logf(l0[j] + (1.0f - l0[j]) * fsigmoid(v0[j])); v1[j] = __builtin_amdgcn_logf(l1[j] + (1.0f - l1[j]) * fsigmoid(v1[j])); }
          } else if (mode == 3) { v0 *= 0.125f; v1 *= 0.125f; }
          u32x4 w; w.x = pk2(v0[0], v0[1]); w.y = pk2(v0[2], v0[3]); w.z = pk2(v1[0], v1[1]); w.w = pk2(v1[2], v1[3]);
          *(u32x4*)(P + PIDX(row0 + ai * 128 + m * 16, col0)) = w;
        }
    }
  }
};
struct ProbOutProj {
  static constexpr bool PERM = false;
  pg8::StaticOrder so; const char* A; const char* Bt; float* Y; const float* Hres;
  __device__ __forceinline__ bool next(int i, pg8::Unit& u) const { return so.next(i, u); }
  __device__ __forceinline__ const char* a_base() const { return A; }
  __device__ __forceinline__ unsigned a_off(const pg8::Unit& u, int r) const { return (unsigned)(u.pm * 256 + r) * 2048u; }
  __device__ __forceinline__ const char* b_base(const pg8::Unit& u) const { return Bt + (size_t)u.pn * 256 * 2048; }
  __device__ __forceinline__ void epi(const f32x4 (&acc)[2][2][4][2], const pg8::Unit& u, int wr, int wc, int fr, int fq) const {
    const int row0 = u.row0 + wr * 64 + fr, col0 = u.pn * 256 + wc * 32 + 4 * fq;
#pragma unroll
    for (int ai = 0; ai < 2; ++ai)
#pragma unroll
      for (int m = 0; m < 4; ++m) { const size_t ro = (size_t)(row0 + ai * 128 + m * 16) * 1024 + col0; float* rowp = Y + ro; const float* hp = Hres + ro;
#pragma unroll
        for (int bj = 0; bj < 2; ++bj)
#pragma unroll
          for (int n = 0; n < 2; ++n) *(f32x4*)(rowp + bj * 128 + n * 16) = acc[ai][bj][m][n] + ALPHA_F * *(const f32x4*)(hp + bj * 128 + n * 16); }
  }
};
#define MOE_TAB_OFF (128 * 1024)
struct MoeOrder {
  const int* tab;
  __device__ __forceinline__ void init(const int* cnt, int ntn, int G, int c, unsigned char* lds, int wv) {
    int* t = (int*)(lds + MOE_TAB_OFF);
    const int tid = opaque_tid(wv);
    if (tid < 64) {
      int pad = 0, found = 0, ue = 0, upn = 0, upm = 0, urow = 0, une = 0;
      if ((G & 7) == 0) {
        const int x = c & 7; int q = tid * (G >> 3) + (c >> 3);
        for (int e = 0; e < NEXP; ++e) { const int n = cnt[e * 16], mt = (n + 255) >> 8; const int r = ((x - e) % 8 + 8) % 8; const int m = mt > r ? (mt - r - 1) / 8 + 1 : 0; const int units = m * ntn;
          if (!found && q < units) { ue = e; upm = r + 8 * (q % m); upn = q / m; urow = pad + upm * 256; une = n; found = 1; }
          if (!found) { q -= units; pad += mt * 256; } }
      } else {
        int L = tid * G + c;
        for (int e = 0; e < NEXP; ++e) { const int n = cnt[e * 16], mt = (n + 255) >> 8, tiles = mt * ntn;
          if (!found && L < tiles) { ue = e; upn = L / mt; upm = L % mt; urow = pad + upm * 256; une = n; found = 1; }
          if (!found) { L -= tiles; pad += mt * 256; } }
      }
      t[tid * 8 + 0] = found; t[tid * 8 + 1] = ue; t[tid * 8 + 2] = upn; t[tid * 8 + 3] = upm; t[tid * 8 + 4] = urow; t[tid * 8 + 5] = une;
    }
    __syncthreads();
    tab = t;
  }
  __device__ __forceinline__ bool next(int i, pg8::Unit& u) const {
    if (i >= 64) return false;
    const int* t = tab + i * 8;
    if (!__builtin_amdgcn_readfirstlane(t[0])) return false;
    u.e = __builtin_amdgcn_readfirstlane(t[1]); u.pn = __builtin_amdgcn_readfirstlane(t[2]); u.pm = __builtin_amdgcn_readfirstlane(t[3]);
    u.row0 = __builtin_amdgcn_readfirstlane(t[4]); u.ne = __builtin_amdgcn_readfirstlane(t[5]); u.ui = i; return true;
  }
};
struct ProbMoe1 {
  static constexpr bool PERM = true;
  MoeOrder mo; const char* A; const char* W13; const int* list; bf16_t* H; const int* ltok;
  __device__ __forceinline__ void stage_tokens(unsigned char* lds, int wv) {
    int* lt = (int*)(lds + MOE_TAB_OFF + 2048);
    const int tid = opaque_tid(wv);
    pg8::Unit u;
    for (int i = 0; i < 16 && mo.next(i, u); ++i) { if (tid < 256) { const int rr = u.pm * 256 + tid; lt[i * 256 + tid] = rr < u.ne ? list[u.e * NTOK + rr] : 0; } }
    __syncthreads();
    ltok = lt;
  }
  __device__ __forceinline__ bool next(int i, pg8::Unit& u) const { return mo.next(i, u); }
  __device__ __forceinline__ const char* a_base() const { return A; }
  __device__ __forceinline__ unsigned a_off(const pg8::Unit& u, int r) const { const int rr = u.pm * 256 + r; const int tok = rr < u.ne ? list[u.e * NTOK + rr] : 0; return (unsigned)tok * 2048u; }
  __device__ __forceinline__ const char* b_base(const pg8::Unit& u) const { return W13 + ((size_t)u.e * 2048 + (size_t)u.pn * 256) * 2048; }
  __device__ __forceinline__ void epi(const f32x4 (&acc)[2][2][4][2], const pg8::Unit& u, int wr, int wc, int fr, int fq) const {
    const int row0 = u.row0 + wr * 64 + fr, colb = u.pn * 128 + wc * 16 + 4 * fq;
#pragma unroll
    for (int ai = 0; ai < 2; ++ai)
#pragma unroll
      for (int m = 0; m < 4; ++m)
#pragma unroll
        for (int bj = 0; bj < 2; ++bj) {
          const f32x4 v0 = acc[ai][bj][m][0], v1 = acc[ai][bj][m][1];
          u32x2 w; w.x = pk2(fsilu(v0[0]) * v0[1], fsilu(v0[2]) * v0[3]); w.y = pk2(fsilu(v1[0]) * v1[1], fsilu(v1[2]) * v1[3]);
          *(u32x2*)(H + (size_t)(row0 + ai * 128 + m * 16) * 1024 + colb + bj * 64) = w;
        }
  }
};
struct ProbMoe2 {
  static constexpr bool PERM = true;
  MoeOrder mo; const char* A; const char* W2; bf16_t* Y;
  __device__ __forceinline__ bool next(int i, pg8::Unit& u) const { return mo.next(i, u); }
  __device__ __forceinline__ const char* a_base() const { return A; }
  __device__ __forceinline__ unsigned a_off(const pg8::Unit& u, int r) const { return (unsigned)(u.row0 + r) * 2048u; }
  __device__ __forceinline__ const char* b_base(const pg8::Unit& u) const { return W2 + ((size_t)u.e * 1024 + (size_t)u.pn * 256) * 2048; }
  __device__ __forceinline__ void epi(const f32x4 (&acc)[2][2][4][2], const pg8::Unit& u, int wr, int wc, int fr, int fq) const {
    const int row0 = u.row0 + wr * 64 + fr, colb = u.pn * 256 + wc * 32 + 8 * fq;
#pragma unroll
    for (int ai = 0; ai < 2; ++ai)
#pragma unroll
      for (int m = 0; m < 4; ++m)
#pragma unroll
        for (int bj = 0; bj < 2; ++bj) {
          const f32x4 v0 = acc[ai][bj][m][0], v1 = acc[ai][bj][m][1];
          u32x4 w; w.x = pk2(v0[0], v0[1]); w.y = pk2(v0[2], v0[3]); w.z = pk2(v1[0], v1[1]); w.w = pk2(v1[2], v1[3]);
          *(u32x4*)(Y + (size_t)(row0 + ai * 128 + m * 16) * 1024 + colb + bj * 128) = w;
        }
  }
};

template <int NS>
__device__ __forceinline__ void side_phase(unsigned char* lds_, int wv, const Params& p, int layer) {
  const Ctx c = make_ctx(lds_, wv);
  const bf16_t* hb = (const bf16_t*)(p.ws + WS_HB);
  const bf16_t* wt = (const bf16_t*)(p.ws + (layer == 0 ? WS_WIN_AB : WS_WIN_CD)) + (size_t)(layer == 0 ? PM_AB : PM_CD) * 1024;
  const float* bias = p.in[layer == 0 ? I_AB_B_IN : I_CD_B_IN] + (layer == 0 ? PM_AB : PM_CD);
  float* side = (float*)(p.ws + WS_SIDE);
  float* tl = (float*)c.lds + c.wid * (16 * 33);
  const int fr = c.lane & 15, fq = c.lane >> 4;
  for (int g = c.bid * 8 + c.wid; g < NTOK / 16; g += c.G * 8) {
    const int r0 = g * 16;
    f32x4 acc0 = (f32x4){0.f, 0.f, 0.f, 0.f}, acc1 = acc0;
    const bf16_t* ap = hb + (size_t)(r0 + fr) * 1024 + fq * 8;
    const bf16_t* bp0 = wt + (size_t)fr * 1024 + fq * 8; const bf16_t* bp1 = bp0 + 16 * 1024;
#pragma unroll 16
    for (int k = 0; k < 1024; k += 32) {
      const bf16x8 a = *(const bf16x8*)(ap + k), b0 = *(const bf16x8*)(bp0 + k);
      acc0 = __builtin_amdgcn_mfma_f32_16x16x32_bf16(a, b0, acc0, 0, 0, 0);
      if (NS == 32) { const bf16x8 b1 = *(const bf16x8*)(bp1 + k); acc1 = __builtin_amdgcn_mfma_f32_16x16x32_bf16(a, b1, acc1, 0, 0, 0); }
    }
    float gsc = 1.f, gfb = 0.f; bool gls = false;
    if (NS == 16) { gsc = 1.4426950408889634f; gls = (fr & 4) != 0; gfb = gls ? p.in[I_FGATE_B][(fr >> 3) * 4 + (fr & 3)] : 0.f; }
#pragma unroll
    for (int j = 0; j < 4; ++j) { float v0 = acc0[j] + bias[fr]; if (NS == 16) v0 = gls ? flog2sigmoid(v0 + gfb) : v0 * gsc; side[(size_t)(r0 + fq * 4 + j) * 32 + fr] = v0; tl[(fq * 4 + j) * 33 + fr] = v0;
      if (NS == 32) { const float v1 = acc1[j] + bias[16 + fr]; side[(size_t)(r0 + fq * 4 + j) * 32 + 16 + fr] = v1; tl[(fq * 4 + j) * 33 + 16 + fr] = v1; } }
    if (NS == 32) {
      __builtin_amdgcn_s_waitcnt(0xC07F);
      const float* gu = p.in[I_GK_UP]; const float* gb = p.in[I_GK_B]; bf16_t* lfb = (bf16_t*)(p.ws + WS_LFB);
      const int cb = c.lane * 8, dir = cb >> 8, cc = cb & 255;
      float w[16][8];
#pragma unroll
      for (int r = 0; r < 16; ++r)
#pragma unroll
        for (int j = 0; j < 8; ++j) w[r][j] = gu[(dir * 16 + r) * 256 + cc + j];
      float bb[8];
#pragma unroll
      for (int j = 0; j < 8; ++j) bb[j] = gb[dir * 256 + cc + j];
      for (int row = 0; row < 16; ++row) {
        float z[8];
#pragma unroll
        for (int j = 0; j < 8; ++j) z[j] = bb[j];
#pragma unroll
        for (int r = 0; r < 16; ++r) { const float s = tl[row * 33 + dir * 16 + r];
#pragma unroll
          for (int j = 0; j < 8; ++j) z[j] += s * w[r][j]; }
        u32x4 o; o.x = pk2(flog2sigmoid(z[0]) * 0.0625f, flog2sigmoid(z[1]) * 0.0625f); o.y = pk2(flog2sigmoid(z[2]) * 0.0625f, flog2sigmoid(z[3]) * 0.0625f);
        o.z = pk2(flog2sigmoid(z[4]) * 0.0625f, flog2sigmoid(z[5]) * 0.0625f); o.w = pk2(flog2sigmoid(z[6]) * 0.0625f, flog2sigmoid(z[7]) * 0.0625f);
        *(u32x4*)(lfb + PIDX(r0 + row, cb)) = o;
      }
    }
  }
}

__device__ __forceinline__ void headnorm_phase(unsigned char* lds_, int wv, const Params& p, int layer) {
  const Ctx c = make_ctx(lds_, wv);
  const bf16_t* P = (const bf16_t*)(p.ws + WS_R1); const bf16_t* O = (const bf16_t*)(p.ws + WS_R2);
  bf16_t* mixed = (bf16_t*)(p.ws + WS_MIX);
  const int c0 = c.lane * 16, h8 = c.lane >> 3;
  const float* gain = layer == 0 ? (h8 < 4 ? p.in[I_HGRN_NORM] + c0 : p.in[I_GLA_NORM] + c0 - 512) : (h8 < 4 ? p.in[I_RET_NORM] + c0 : p.in[I_MLSTM_NORM] + c0 - 512);
  const int gcol = layer == 0 ? (h8 < 4 ? 2048 + c0 : 3584 + c0 - 512) : (h8 < 4 ? 1024 + c0 : 3072 + c0 - 512);
  float gn[16];
#pragma unroll
  for (int j = 0; j < 16; ++j) gn[j] = gain[j];
  for (int tok = c.bid * 8 + c.wid; tok < NTOK; tok += c.G * 8) {
    float of[16], ob[16], gt[16];
    { const u32x4* a = (const u32x4*)(O + PIDX(tok, c0)); unpack8(__builtin_nontemporal_load(a), of); unpack8(__builtin_nontemporal_load(a + 1), of + 8);
      const u32x4* b = (const u32x4*)(O + (size_t)NTOK * 1024 + PIDX(tok, c0)); unpack8(__builtin_nontemporal_load(b), ob); unpack8(__builtin_nontemporal_load(b + 1), ob + 8);
      const u32x4* g = (const u32x4*)(P + PIDX(tok, gcol)); unpack8(__builtin_nontemporal_load(g), gt); unpack8(__builtin_nontemporal_load(g + 1), gt + 8); }
    const float sf = 1.f, sb = 1.f;
    float o[16]; float ss = 0.f;
#pragma unroll
    for (int j = 0; j < 16; ++j) { o[j] = of[j] * sf + ob[j] * sb; ss += o[j] * o[j]; }
    ss += __shfl_xor(ss, 1); ss += __shfl_xor(ss, 2); ss += __shfl_xor(ss, 4);
    const float r = 1.0f / sqrtf(ss * (1.0f / 128.0f) + NORM_EPS_F);
    unsigned w[8];
#pragma unroll
    for (int j = 0; j < 8; ++j) {
      float g0 = gt[2 * j], g1 = gt[2 * j + 1];
      if (layer == 1 && h8 >= 4) { g0 = fsigmoid(g0); g1 = fsigmoid(g1); } else { g0 = fsilu(g0); g1 = fsilu(g1); }
      w[j] = pk2(o[2 * j] * r * gn[2 * j] * g0, o[2 * j + 1] * r * gn[2 * j + 1] * g1);
    }
    u32x4* d = (u32x4*)(mixed + (size_t)tok * 1024 + c0);
    d[0] = (u32x4){w[0], w[1], w[2], w[3]}; d[1] = (u32x4){w[4], w[5], w[6], w[7]};
  }
}

__device__ __forceinline__ void ln_phase(unsigned char* lds_, int wv, const Params& p, int layer, int mode, int dry = 0) {
  const Ctx c = make_ctx(lds_, wv);
  unsigned char* ws = p.ws;
  const float* hin = (mode == 0 && layer == 0) ? p.in[I_X] : p.out;
  float* hout = dry ? (float*)(ws + WS_H) : p.out; bf16_t* hb = (bf16_t*)(ws + (mode == 0 ? WS_MIX : WS_HB));
  const float* g = p.in[mode == 0 ? I_LN_MIX_G : I_LN_FFN_G] + layer * 1024; const float* b = p.in[mode == 0 ? I_LN_MIX_B : I_LN_FFN_B] + layer * 1024;
  unsigned* cnt = (unsigned*)(ws + WS_CTL) + CW_CNT(layer);
  int* list = (int*)(ws + WS_LIST) + (size_t)layer * NEXP * NTOK;
  int* assign = (int*)(ws + WS_ASSIGN); float* gate = (float*)(ws + WS_GATE);
  float* rwT = (float*)c.lds;
  int* lcnt = (int*)(c.lds + 65536); int* lbase = lcnt + 16; int* rec = lcnt + 32; float* recg = (float*)(rec + 4 * 2048);
  int pad[NEXP];
  if (mode == 0) { const float* r = p.in[I_ROUTER_W];
    for (int i = c.tid; i < 1024 * 16; i += NTHREADS) rwT[(i & 15) * 1024 + (i >> 4)] = r[i];
    if (c.tid < 16) lcnt[c.tid] = 0;
    __syncthreads(); }
  else { int acc = 0;
#pragma unroll
    for (int e = 0; e < NEXP; ++e) { pad[e] = acc; acc += (((int)cnt[e * 16] + 255) >> 8) << 8; } }
  const int c0 = c.lane * 4;
  float gv[16], bv[16];
#pragma unroll
  for (int q = 0; q < 4; ++q) { const f32x4 t0 = *(const f32x4*)(g + q * 256 + c0), t1 = *(const f32x4*)(b + q * 256 + c0);
#pragma unroll
    for (int j = 0; j < 4; ++j) { gv[4 * q + j] = t0[j]; bv[4 * q + j] = t1[j]; } }
  const int tstride = c.G * 8;
  int it = 0;
  for (int tok0 = c.bid * 8 + c.wid; tok0 < NTOK; tok0 += 2 * tstride, it += 2) {
    float v[2][16];
    float gy0[2], gy1[2];
#pragma unroll
    for (int u = 0; u < 2; ++u) {
      const int tok = tok0 + u * tstride;
      if (tok < NTOK) {
        if (mode == 0) {
#pragma unroll
          for (int q = 0; q < 4; ++q) { const f32x4 t = __builtin_nontemporal_load((const f32x4*)((const float*)(ws + WS_R2) + (size_t)tok * 1024 + q * 256 + c0)); v[u][4 * q] = t[0]; v[u][4 * q + 1] = t[1]; v[u][4 * q + 2] = t[2]; v[u][4 * q + 3] = t[3]; }
        } else {
#pragma unroll
          for (int q = 0; q < 4; ++q) { const f32x4 t = *(const f32x4*)(hin + (size_t)tok * 1024 + q * 256 + c0); v[u][4 * q] = ALPHA_F * t[0]; v[u][4 * q + 1] = ALPHA_F * t[1]; v[u][4 * q + 2] = ALPHA_F * t[2]; v[u][4 * q + 3] = ALPHA_F * t[3]; }
          const int a0 = assign[tok * 4], a1 = assign[tok * 4 + 1], a2 = assign[tok * 4 + 2], a3 = assign[tok * 4 + 3];
          gy0[u] = gate[tok * 2]; gy1[u] = gate[tok * 2 + 1];
          int p0 = 0, p1 = 0;
#pragma unroll
          for (int e = 0; e < NEXP; ++e) { if (e == a0) p0 = pad[e]; if (e == a2) p1 = pad[e]; }
          p0 += a1; p1 += a3;
          const bf16_t* Y = (const bf16_t*)(ws + WS_R2);
#pragma unroll
          for (int q = 0; q < 4; ++q) { const u32x2 y0 = __builtin_nontemporal_load((const u32x2*)(Y + (size_t)p0 * 1024 + q * 256 + c0)), y1 = __builtin_nontemporal_load((const u32x2*)(Y + (size_t)p1 * 1024 + q * 256 + c0));
            v[u][4 * q] += gy0[u] * __uint_as_float(y0.x << 16) + gy1[u] * __uint_as_float(y1.x << 16); v[u][4 * q + 1] += gy0[u] * __uint_as_float(y0.x & 0xffff0000u) + gy1[u] * __uint_as_float(y1.x & 0xffff0000u);
            v[u][4 * q + 2] += gy0[u] * __uint_as_float(y0.y << 16) + gy1[u] * __uint_as_float(y1.y << 16); v[u][4 * q + 3] += gy0[u] * __uint_as_float(y0.y & 0xffff0000u) + gy1[u] * __uint_as_float(y1.y & 0xffff0000u); }
        }
      } else {
#pragma unroll
        for (int j = 0; j < 16; ++j) v[u][j] = 0.f;
      }
    }
#pragma unroll
    for (int u = 0; u < 2; ++u) {
      const int tok = tok0 + u * tstride;
      float s = 0.f;
#pragma unroll
      for (int j = 0; j < 16; ++j) s += v[u][j];
      const float mean = wave_sum(s) * (1.0f / 1024.0f);
      float qq = 0.f;
#pragma unroll
      for (int j = 0; j < 16; ++j) { v[u][j] -= mean; qq += v[u][j] * v[u][j]; }
      const float r = 1.0f / sqrtf(wave_sum(qq) * (1.0f / 1024.0f) + LN_EPS_F);
#pragma unroll
      for (int j = 0; j < 16; ++j) v[u][j] = v[u][j] * r * gv[j] + bv[j];
      if (tok < NTOK) {
#pragma unroll
        for (int q = 0; q < 4; ++q) __builtin_nontemporal_store((f32x4){v[u][4 * q], v[u][4 * q + 1], v[u][4 * q + 2], v[u][4 * q + 3]}, (f32x4*)(hout + (size_t)tok * 1024 + q * 256 + c0));
        if (!(mode == 1 && layer == 1) && !dry) {
#pragma unroll
          for (int q = 0; q < 4; ++q) *(u32x2*)(hb + (size_t)tok * 1024 + q * 256 + c0) = (u32x2){pk2(v[u][4 * q], v[u][4 * q + 1]), pk2(v[u][4 * q + 2], v[u][4 * q + 3])}; }
      }
      if (mode == 0) {
        float lg[16];
#pragma unroll
        for (int e = 0; e < 16; ++e) { float a = 0.f;
#pragma unroll
          for (int q = 0; q < 4; ++q) { const f32x4 w = *(const f32x4*)(rwT + e * 1024 + q * 256 + c0); a += v[u][4 * q] * w[0] + v[u][4 * q + 1] * w[1] + v[u][4 * q + 2] * w[2] + v[u][4 * q + 3] * w[3]; }
          lg[e] = a; }
#pragma unroll
        for (int e = 0; e < 16; ++e) lg[e] = wave_sum(lg[e]);
        int eo[2]; float go[2];
        route_from_logits(lg, p.in[I_ROUTER_B], eo, go);
        if (c.lane == 0 && tok < NTOK && !dry) {
          const int r1 = atomicAdd(lcnt + eo[0], 1), r2 = atomicAdd(lcnt + eo[1], 1);
          const int ri = (it + u) * 8 + c.wid;
          rec[ri * 4] = eo[0]; rec[ri * 4 + 1] = r1; rec[ri * 4 + 2] = eo[1]; rec[ri * 4 + 3] = r2; recg[ri * 2] = go[0]; recg[ri * 2 + 1] = go[1];
        }
      }
    }
  }
  if (mode == 0 && !dry) {
    __syncthreads();
    if (c.tid < 16) lbase[c.tid] = (int)atomicAdd(cnt + c.tid * 16, (unsigned)lcnt[c.tid]);
    __syncthreads();
    const int nrec = ((NTOK + c.G * 8 - 1) / (c.G * 8)) * 8;
    for (int ri = c.tid; ri < nrec; ri += NTHREADS) {
      const int tok = c.bid * 8 + (ri & 7) + (ri >> 3) * c.G * 8;
      if (tok < NTOK) {
        const int e1 = rec[ri * 4], e2 = rec[ri * 4 + 2]; const int r1 = rec[ri * 4 + 1] + lbase[e1], r2 = rec[ri * 4 + 3] + lbase[e2];
        list[e1 * NTOK + r1] = tok; list[e2 * NTOK + r2] = tok;
        assign[tok * 4] = e1; assign[tok * 4 + 1] = r1; assign[tok * 4 + 2] = e2; assign[tok * 4 + 3] = r2;
        gate[tok * 2] = recg[ri * 2]; gate[tok * 2 + 1] = recg[ri * 2 + 1];
      }
    }
  }
  __syncthreads();
}
#endif
#ifndef CPU_EMU
namespace scan {
typedef short bf16x8 __attribute__((ext_vector_type(8)));
typedef float f32x4 __attribute__((ext_vector_type(4)));
typedef unsigned u32x4 __attribute__((ext_vector_type(4)));
typedef unsigned u32x2 __attribute__((ext_vector_type(2)));
enum { MIX_A = 0, MIX_B = 1, MIX_C = 2, MIX_D = 3 };
constexpr int LD_T = 144;
constexpr int OFF_QS = 0, OFF_KS = 17408, OFF_QI = 34816, OFF_KT = 52224, OFF_VT = 70656, OFF_SC = 77568, OFF_ST = 86784, OFF_DEC = 99840, OFF_EM = 100352, OFF_DEN = 100608, OFF_CW = 100864, SCAN_LDS = 104960;

__device__ __forceinline__ float incl_scan_add(float x) {
  x += __builtin_bit_cast(float, __builtin_amdgcn_update_dpp(0, __builtin_bit_cast(int, x), 0x111, 0xf, 0xf, false));
  x += __builtin_bit_cast(float, __builtin_amdgcn_update_dpp(0, __builtin_bit_cast(int, x), 0x112, 0xf, 0xf, false));
  x += __builtin_bit_cast(float, __builtin_amdgcn_update_dpp(0, __builtin_bit_cast(int, x), 0x114, 0xf, 0xf, false));
  x += __builtin_bit_cast(float, __builtin_amdgcn_update_dpp(0, __builtin_bit_cast(int, x), 0x118, 0xf, 0xf, false));
  x += __builtin_bit_cast(float, __builtin_amdgcn_update_dpp(0, __builtin_bit_cast(int, x), 0x142, 0xa, 0xf, false));
  x += __builtin_bit_cast(float, __builtin_amdgcn_update_dpp(0, __builtin_bit_cast(int, x), 0x143, 0xc, 0xf, false));
  return x;
}
__device__ __forceinline__ float incl_scan_max(float x) {
  const int ninf = (int)0xff800000u;
  x = fmaxf(x, __builtin_bit_cast(float, __builtin_amdgcn_update_dpp(ninf, __builtin_bit_cast(int, x), 0x111, 0xf, 0xf, false)));
  x = fmaxf(x, __builtin_bit_cast(float, __builtin_amdgcn_update_dpp(ninf, __builtin_bit_cast(int, x), 0x112, 0xf, 0xf, false)));
  x = fmaxf(x, __builtin_bit_cast(float, __builtin_amdgcn_update_dpp(ninf, __builtin_bit_cast(int, x), 0x114, 0xf, 0xf, false)));
  x = fmaxf(x, __builtin_bit_cast(float, __builtin_amdgcn_update_dpp(ninf, __builtin_bit_cast(int, x), 0x118, 0xf, 0xf, false)));
  x = fmaxf(x, __builtin_bit_cast(float, __builtin_amdgcn_update_dpp(ninf, __builtin_bit_cast(int, x), 0x142, 0xa, 0xf, false)));
  x = fmaxf(x, __builtin_bit_cast(float, __builtin_amdgcn_update_dpp(ninf, __builtin_bit_cast(int, x), 0x143, 0xc, 0xf, false)));
  return x;
}
__device__ __forceinline__ float rdlane(float x, int l) { return __builtin_bit_cast(float, __builtin_amdgcn_readlane(__builtin_bit_cast(int, x), l)); }
__device__ __forceinline__ bf16x8 ldfrag(const unsigned char* base, int ld, int row, int kbyte) { return *(const bf16x8*)(base + row * ld + kbyte); }
__device__ __forceinline__ bf16x8 ldfrag2(const unsigned char* base, int ld, int row, int b0, int b1) {
  const u32x2 lo = *(const u32x2*)(base + row * ld + b0), hi = *(const u32x2*)(base + row * ld + b1);
  return __builtin_bit_cast(bf16x8, (u32x4){lo.x, lo.y, hi.x, hi.y}); }
__device__ __forceinline__ unsigned pk(float a, float b) { return pk_hw(a, b); }
__device__ __forceinline__ float lo16(unsigned w) { return __uint_as_float(w << 16); }
__device__ __forceinline__ float hi16(unsigned w) { return __uint_as_float(w & 0xffff0000u); }

__device__ __forceinline__ void lds_barrier() { asm volatile("s_waitcnt lgkmcnt(0)" ::: "memory"); __builtin_amdgcn_s_barrier(); asm volatile("" ::: "memory"); }
struct Raw { u32x4 a0, a1, b0, b1; f32x4 r0, r1; u32x2 v; float s0, s1; };

}

__device__ __forceinline__ void convd_phase(unsigned char* lds_, int wv, const Params& p) {
  const Ctx c = make_ctx(lds_, wv);
  bf16_t* P = (bf16_t*)(p.ws + WS_R1); bf16_t* QD = (bf16_t*)(p.ws + WS_LFB);
  const float* cw = p.in[I_CONV_W]; const float* cb = p.in[I_CONV_B];
  const int ch = c.lane * 16;
  float w0[16], w1[16], w2[16], bb[16];
#pragma unroll
  for (int j = 0; j < 16; ++j) { w0[j] = cw[ch + j]; w1[j] = cw[1024 + ch + j]; w2[j] = cw[2048 + ch + j]; bb[j] = cb[ch + j]; }
  for (int tok = c.bid * 8 + c.wid; tok < NTOK; tok += c.G * 8) {
    const int t = tok % SEQ;
    const bf16_t* row = P + PIDX(tok, 1536 + ch);
    float x0[16], x1[16], x2[16];
    { const u32x4* r1 = (const u32x4*)row; unpack8(r1[0], x1); unpack8(r1[1], x1 + 8); }
    if (t > 0) { const u32x4* r0 = (const u32x4*)(row - 128); unpack8(r0[0], x0); unpack8(r0[1], x0 + 8); }
    else {
#pragma unroll
      for (int j = 0; j < 16; ++j) x0[j] = 0.f; }
    if (t < SEQ - 1) { const u32x4* r2 = (const u32x4*)(row + 128); unpack8(r2[0], x2); unpack8(r2[1], x2 + 8); }
    else {
#pragma unroll
      for (int j = 0; j < 16; ++j) x2[j] = 0.f; }
    const float sc = ch < 512 ? 0.08838834764831845f : 1.0f;
    unsigned w[8];
#pragma unroll
    for (int j = 0; j < 8; ++j) {
      const float a0 = bb[2 * j] + w0[2 * j] * x0[2 * j] + w1[2 * j] * x1[2 * j] + w2[2 * j] * x2[2 * j];
      const float a1 = bb[2 * j + 1] + w0[2 * j + 1] * x0[2 * j + 1] + w1[2 * j + 1] * x1[2 * j + 1] + w2[2 * j + 1] * x2[2 * j + 1];
      w[j] = pk2(fsilu(a0) * sc, fsilu(a1) * sc);
    }
    u32x4* d = (ch < 512) ? (u32x4*)(QD + PIDX(tok, ch)) : (u32x4*)(P + PIDX(tok, 3584 + (ch - 512)));
    d[0] = (u32x4){w[0], w[1], w[2], w[3]}; d[1] = (u32x4){w[4], w[5], w[6], w[7]};
  }
}

#endif
#ifndef CPU_EMU
namespace scan2 {
using namespace scan;
#ifndef PROBE_ALLTILES
#define PROBE_ALLTILES 0
#endif
__device__ __forceinline__ float FMUL(float a, float b) { float r = a * b; asm("" : "+v"(r)); return r; }
constexpr int U_QI = 0, U_KS = 34816, U_KT = 69632, U_VT = 106496, U_SC = 120320, U_ST = 129536, U_DEC = 155648, U_EM = 156672, U_END = 157184;
template <int MIXER>
__device__ __forceinline__ void scan_item2(unsigned char* lds, int wv, const Params& p, int b, int h, int dir, int vs) {
  constexpr int DK = (MIXER == MIX_A || MIXER == MIX_D) ? 128 : 64;
  constexpr int NC = DK / 8;
  constexpr int LD_D = DK * 2 + 16;
  constexpr int NVT = MIXER == MIX_D ? 3 : 2;
  constexpr int NKD = DK / 32;
  constexpr int NST = (DK == 128) ? NVT : 1;
  constexpr int NCH = SEQ / 64;
  const int tid = opaque_tid(wv), lane0 = tid & 63, wid = __builtin_amdgcn_readfirstlane(tid >> 6);
  unsigned char* ws = p.ws;
  const bf16_t* P = (const bf16_t*)(ws + WS_R1);
  const bf16_t* LFBp = (const bf16_t*)(ws + WS_LFB);
  const float* side = (const float*)(ws + WS_SIDE);
  const float* rope = (const float*)(ws + WS_ROPE);
  bf16_t* O = (bf16_t*)(ws + WS_R2) + (size_t)dir * NTOK * 1024;
  unsigned char* SC = lds + U_SC;
  int qcol, kcol, lfcol, vcol, ocol;
  if (MIXER == MIX_A) { qcol = h * 128; kcol = 0; lfcol = 512 + dir * 512 + h * 128; vcol = 1536 + h * 128 + vs * 32; ocol = h * 128 + vs * 32; }
  else if (MIXER == MIX_B) { qcol = 2560 + h * 64; kcol = 2816 + h * 64; lfcol = dir * 256 + h * 64; vcol = 3072 + h * 128 + vs * 32; ocol = 512 + h * 128 + vs * 32; }
  else if (MIXER == MIX_C) { qcol = h * 64; kcol = 256 + h * 64; lfcol = 0; vcol = 512 + h * 128 + vs * 32; ocol = h * 128 + vs * 32; }
  else { qcol = h * 128; kcol = 3584 + h * 128; lfcol = 0; vcol = 2560 + h * 128 + vs * 32; ocol = 512 + h * 128 + vs * 32; }
  const size_t tokbase = (size_t)b * SEQ;
  const int c0 = (MIXER == MIX_C) ? wid * 4 : wid * NC;
  for (int i = tid; i < 2 * 13056 / 4; i += NTHREADS) ((unsigned*)(lds + U_ST))[i] = 0u;
  for (int i = tid; i < 9216 / 4; i += NTHREADS) ((unsigned*)(lds + U_SC))[i] = 0u;
  if (MIXER == MIX_D) { for (int i = tid; i < 2 * 16 * 64; i += NTHREADS) { const int bf = i >> 10, r = 32 + ((i >> 6) & 15), j = i & 63; *(bf16_t*)(lds + U_VT + bf * 6912 + r * LD_T + j * 2) = (r == 32) ? (bf16_t)0x3F80 : (bf16_t)0; } }
  const float lgam2 = (MIXER == MIX_C) ? log1pf(-exp2f(-(5.0f + 2.0f * (float)h + (float)dir))) * 1.4426950408889634f : 0.f;
  const float fgb = (MIXER == MIX_D) ? p.in[I_FGATE_B][dir * 4 + h] : 0.f;
  float m_st = 0.f;
  __syncthreads();

  Raw R, Rn; u32x2 Rv, Rvn;
#define A_LOAD(R, Rv, n_) do { \
    const int ln_ = lane0; \
    const int t_ = dir ? (SEQ - 1 - ((n_) * 64 + ln_)) : ((n_) * 64 + ln_); \
    const size_t tk_ = tokbase + t_; \
    if (MIXER == MIX_A) { const u32x4* qp_ = (const u32x4*)(P + PIDX(tk_, qcol + c0)); const u32x4* lp_ = (const u32x4*)(P + PIDX(tk_, lfcol + c0)); R.a0 = qp_[0]; R.a1 = qp_[1]; R.b0 = lp_[0]; R.b1 = lp_[1]; } \
    else if (MIXER == MIX_B) { R.a0 = *(const u32x4*)(P + PIDX(tk_, qcol + c0)); R.a1 = *(const u32x4*)(P + PIDX(tk_, kcol + c0)); R.b0 = *(const u32x4*)(LFBp + PIDX(tk_, lfcol + c0)); } \
    else if (MIXER == MIX_C) { const u32x2 qa_ = *(const u32x2*)(P + PIDX(tk_, qcol + c0)), qb_ = *(const u32x2*)(P + PIDX(tk_, qcol + 32 + c0)), ka_ = *(const u32x2*)(P + PIDX(tk_, kcol + c0)), kb_ = *(const u32x2*)(P + PIDX(tk_, kcol + 32 + c0)); \
      R.a0 = (u32x4){qa_.x, qa_.y, qb_.x, qb_.y}; R.a1 = (u32x4){ka_.x, ka_.y, kb_.x, kb_.y}; \
      R.r0 = *(const f32x4*)(rope + ((size_t)t_ * 32 + c0) * 2); R.r1 = *(const f32x4*)(rope + ((size_t)t_ * 32 + c0) * 2 + 4); } \
    else { const u32x4* qp_ = (const u32x4*)(LFBp + PIDX(tk_, qcol + c0)); const u32x4* kp_ = (const u32x4*)(P + PIDX(tk_, kcol + c0)); R.a0 = qp_[0]; R.a1 = qp_[1]; R.b0 = kp_[0]; R.b1 = kp_[1]; \
      R.s0 = side[tk_ * 32 + dir * 8 + h]; R.s1 = side[tk_ * 32 + dir * 8 + 4 + h]; } \
    Rv = *(const u32x2*)(P + PIDX(tk_, vcol + wid * 4)); } while (0)

  float rr_next = 1.f, rr_cur = 1.f;
#define A_PREP(buf_, R, Rv) do { \
    const int lane = lane0; \
    unsigned char* KTb = lds + U_KT + (buf_) * 18432; float* DECb = (float*)(lds + U_DEC + (buf_) * 512); float* EMb = (float*)(lds + U_EM + (buf_) * 256); \
    unsigned char* QIb = lds + U_QI + (buf_) * 17408; unsigned char* KSb = lds + U_KS + (buf_) * 17408; \
    float q[NC], k[NC], g[NC], ktv[NC]; \
    if (MIXER == MIX_A) { \
      const unsigned qw[8] = {R.a0.x, R.a0.y, R.a0.z, R.a0.w, R.a1.x, R.a1.y, R.a1.z, R.a1.w}, lw[8] = {R.b0.x, R.b0.y, R.b0.z, R.b0.w, R.b1.x, R.b1.y, R.b1.z, R.b1.w}; \
      _Pragma("unroll") for (int c = 0; c < 8; ++c) { q[2 * c] = lo16(qw[c]); q[2 * c + 1] = hi16(qw[c]); g[2 * c] = lo16(lw[c]); g[2 * c + 1] = hi16(lw[c]); } \
      _Pragma("unroll") for (int c = 0; c < NC; ++c) k[c] = 1.0f - __builtin_amdgcn_exp2f(g[c]); \
    } else if (MIXER == MIX_B) { \
      const unsigned qw[4] = {R.a0.x, R.a0.y, R.a0.z, R.a0.w}, kw[4] = {R.a1.x, R.a1.y, R.a1.z, R.a1.w}, lw[4] = {R.b0.x, R.b0.y, R.b0.z, R.b0.w}; \
      _Pragma("unroll") for (int c = 0; c < 4; ++c) { q[2 * c] = lo16(qw[c]); q[2 * c + 1] = hi16(qw[c]); k[2 * c] = lo16(kw[c]); k[2 * c + 1] = hi16(kw[c]); g[2 * c] = lo16(lw[c]); g[2 * c + 1] = hi16(lw[c]); } \
    } else if (MIXER == MIX_C) { \
      const float cs[4] = {R.r0[0], R.r0[2], R.r1[0], R.r1[2]}, sn[4] = {R.r0[1], R.r0[3], R.r1[1], R.r1[3]}; \
      const float q1[4] = {lo16(R.a0.x), hi16(R.a0.x), lo16(R.a0.y), hi16(R.a0.y)}, q2[4] = {lo16(R.a0.z), hi16(R.a0.z), lo16(R.a0.w), hi16(R.a0.w)}; \
      const float k1[4] = {lo16(R.a1.x), hi16(R.a1.x), lo16(R.a1.y), hi16(R.a1.y)}, k2[4] = {lo16(R.a1.z), hi16(R.a1.z), lo16(R.a1.w), hi16(R.a1.w)}; \
      _Pragma("unroll") for (int c = 0; c < 4; ++c) { q[c] = (q1[c] * cs[c] - q2[c] * sn[c]) * 0.125f; q[4 + c] = (q1[c] * sn[c] + q2[c] * cs[c]) * 0.125f; k[c] = k1[c] * cs[c] - k2[c] * sn[c]; k[4 + c] = k1[c] * sn[c] + k2[c] * cs[c]; } \
    } else { \
      const unsigned qw[8] = {R.a0.x, R.a0.y, R.a0.z, R.a0.w, R.a1.x, R.a1.y, R.a1.z, R.a1.w}, kw[8] = {R.b0.x, R.b0.y, R.b0.z, R.b0.w, R.b1.x, R.b1.y, R.b1.z, R.b1.w}; \
      _Pragma("unroll") for (int c = 0; c < 8; ++c) { q[2 * c] = lo16(qw[c]); q[2 * c + 1] = hi16(qw[c]); k[2 * c] = lo16(kw[c]); k[2 * c + 1] = hi16(kw[c]); } \
    } \
    if (MIXER == MIX_A || MIXER == MIX_B) { \
        \
      _Pragma("unroll") for (int c = 0; c < NC; ++c) g[c] += __builtin_bit_cast(float, __builtin_amdgcn_update_dpp(0, __builtin_bit_cast(int, g[c]), 0x111, 0xf, 0xf, false)); \
      _Pragma("unroll") for (int c = 0; c < NC; ++c) g[c] += __builtin_bit_cast(float, __builtin_amdgcn_update_dpp(0, __builtin_bit_cast(int, g[c]), 0x112, 0xf, 0xf, false)); \
      _Pragma("unroll") for (int c = 0; c < NC; ++c) g[c] += __builtin_bit_cast(float, __builtin_amdgcn_update_dpp(0, __builtin_bit_cast(int, g[c]), 0x114, 0xf, 0xf, false)); \
      _Pragma("unroll") for (int c = 0; c < NC; ++c) g[c] += __builtin_bit_cast(float, __builtin_amdgcn_update_dpp(0, __builtin_bit_cast(int, g[c]), 0x118, 0xf, 0xf, false)); \
      _Pragma("unroll") for (int c = 0; c < NC; ++c) g[c] += __builtin_bit_cast(float, __builtin_amdgcn_update_dpp(0, __builtin_bit_cast(int, g[c]), 0x142, 0xa, 0xf, false)); \
      _Pragma("unroll") for (int c = 0; c < NC; ++c) g[c] += __builtin_bit_cast(float, __builtin_amdgcn_update_dpp(0, __builtin_bit_cast(int, g[c]), 0x143, 0xc, 0xf, false)); \
      float ev[NC]; \
      _Pragma("unroll") for (int c = 0; c < NC; ++c) { \
          \
        const float e = __builtin_amdgcn_exp2f(g[c]), r = __builtin_amdgcn_rcpf(e); \
        const float e63 = rdlane(e, 63); \
        q[c] = FMUL(q[c], e); k[c] = FMUL(k[c], r); ktv[c] = FMUL(k[c], e63);     \
        ev[c] = e; } \
      if (lane == 63) { _Pragma("unroll") for (int c = 0; c < NC / 4; ++c) *(f32x4*)(DECb + c0 + 4 * c) = (f32x4){ev[4 * c], ev[4 * c + 1], ev[4 * c + 2], ev[4 * c + 3]}; } \
    } else if (MIXER == MIX_C) { \
        \
      const float gl = (float)(lane + 1) * lgam2; \
      const float e = __builtin_amdgcn_exp2f(gl), r = __builtin_amdgcn_rcpf(e); \
      const float e63 = rdlane(e, 63); const float f_kt = r * e63; \
      _Pragma("unroll") for (int c = 0; c < NC; ++c) { q[c] = FMUL(q[c], e); ktv[c] = FMUL(k[c], f_kt); k[c] = FMUL(k[c], r); } \
      if (lane < 4) { DECb[c0 + lane] = e63; DECb[32 + c0 + lane] = e63; } \
    } else { \
      const float li = R.s0, lf = R.s1;     \
      const float bc = incl_scan_add(lf); const float u = li - bc; const float pm = incl_scan_max(u); \
      const float cmax = rdlane(pm, 63), blast = rdlane(bc, 63); \
      const float a_i = bc + m_st, m_i = fmaxf(a_i, bc + pm); \
      const float d_alpha = __builtin_amdgcn_exp2f(bc - m_i + cmax), d_beta = __builtin_amdgcn_exp2f(u - cmax); \
      rr_next = __builtin_amdgcn_exp2f(m_st - cmax);     \
      const float m_new = fmaxf(blast + m_st, blast + cmax); \
      const float d_sold = __builtin_amdgcn_exp2f(blast + m_st - m_new), d_wks = __builtin_amdgcn_exp2f(blast + u - m_new); m_st = m_new; \
      _Pragma("unroll") for (int c = 0; c < NC; ++c) { ktv[c] = FMUL(k[c], d_wks); q[c] = FMUL(q[c], d_alpha); k[c] = FMUL(k[c], d_beta); if (lane == 63) DECb[c0 + c] = d_sold; } \
      if (wid == 0) EMb[lane] = __builtin_amdgcn_exp2f(-m_i); \
    } \
    _Pragma("unroll") for (int c = 0; c < NC / 2; ++c) { const unsigned w_ = pk_hw(ktv[2 * c], ktv[2 * c + 1]); \
      const int d0_ = (MIXER == MIX_C) ? (2 * c < 4 ? c0 + 2 * c : 32 + c0 + 2 * c - 4) : c0 + 2 * c; \
      *(bf16_t*)(KTb + d0_ * LD_T + lane * 2) = (bf16_t)(w_ & 0xffff); *(bf16_t*)(KTb + (d0_ + 1) * LD_T + lane * 2) = (bf16_t)(w_ >> 16); } \
    { unsigned pq[NC / 2], pks[NC / 2]; \
      _Pragma("unroll") for (int c = 0; c < NC / 2; ++c) { pq[c] = pk_hw(q[2 * c], q[2 * c + 1]); pks[c] = pk_hw(k[2 * c], k[2 * c + 1]); } \
      if (MIXER == MIX_C) { \
        *(u32x2*)(QIb + lane * LD_D + c0 * 2) = (u32x2){pq[0], pq[1]}; *(u32x2*)(QIb + lane * LD_D + (32 + c0) * 2) = (u32x2){pq[2], pq[3]}; \
        *(u32x2*)(KSb + lane * LD_D + c0 * 2) = (u32x2){pks[0], pks[1]}; *(u32x2*)(KSb + lane * LD_D + (32 + c0) * 2) = (u32x2){pks[2], pks[3]}; \
      } else { \
        _Pragma("unroll") for (int c = 0; c < NC / 8; ++c) { \
          *(u32x4*)(QIb + lane * LD_D + (c0 + 8 * c) * 2) = (u32x4){pq[4 * c], pq[4 * c + 1], pq[4 * c + 2], pq[4 * c + 3]}; \
          *(u32x4*)(KSb + lane * LD_D + (c0 + 8 * c) * 2) = (u32x4){pks[4 * c], pks[4 * c + 1], pks[4 * c + 2], pks[4 * c + 3]}; } } } \
    { unsigned char* VTb = lds + U_VT + (buf_) * 6912 + (wid * 4) * LD_T + lane * 2; \
      *(bf16_t*)(VTb + 0 * LD_T) = (bf16_t)(Rv.x & 0xffff); *(bf16_t*)(VTb + 1 * LD_T) = (bf16_t)(Rv.x >> 16); *(bf16_t*)(VTb + 2 * LD_T) = (bf16_t)(Rv.y & 0xffff); *(bf16_t*)(VTb + 3 * LD_T) = (bf16_t)(Rv.y >> 16); } \
  } while (0)
  f32x4 sacc[NST];
#pragma unroll
  for (int i = 0; i < NST; ++i) sacc[i] = (f32x4){0.f, 0.f, 0.f, 0.f};
  A_LOAD(R, Rv, 0);
  A_PREP(0, R, Rv);
  A_LOAD(R, Rv, 1);
  A_LOAD(Rn, Rvn, 2);
  rr_cur = rr_next;
  lds_barrier();
#define SCAN_ITER(n_, RX, RvX) do { const int n = (n_); \
    const int cb = n & 1, nb = (n + 1) & 1; \
    if (n + 1 < NCH) { A_PREP(nb, RX, RvX); if (n + 3 < NCH) A_LOAD(RX, RvX, n + 3); } \
    { { \
      const int lane = lane0; \
      const int fr = lane & 15, fq = lane >> 4; \
      const int it = wid & 3, vt = wid >> 2; \
      const unsigned char* STc = lds + U_ST + cb * 13056; unsigned char* STn = lds + U_ST + nb * 13056; \
      const unsigned char* KTc = lds + U_KT + cb * 18432; const unsigned char* VTc = lds + U_VT + cb * 6912; \
      const unsigned char* QI = lds + U_QI + cb * 17408; const unsigned char* KS = lds + U_KS + cb * 17408; \
      const float* DECc = (const float*)(lds + U_DEC + cb * 512); const float* EMc = (const float*)(lds + U_EM + cb * 256); \
      bf16x8 qf[NKD]; \
_Pragma("unroll") \
      for (int ks = 0; ks < NKD; ++ks) qf[ks] = ldfrag(QI, LD_D, it * 16 + fr, ks * 64 + fq * 16); \
        \
      u32x2 sp[4]; \
_Pragma("unroll") \
      for (int jt = 0; jt < 4; ++jt) { \
        sp[jt] = (u32x2){0u, 0u}; \
        if (PROBE_ALLTILES || jt <= it) { \
          f32x4 acc = (f32x4){0.f, 0.f, 0.f, 0.f}; \
_Pragma("unroll") \
          for (int ks = 0; ks < NKD; ++ks) acc = __builtin_amdgcn_mfma_f32_16x16x32_bf16(ldfrag(KS, LD_D, jt * 16 + fr, ks * 64 + fq * 16), qf[ks], acc, 0, 0, 0); \
          if (jt == it) { const int i = fr, j0 = fq * 4; \
            const float v0 = (j0 + 0 <= i) ? acc[0] : 0.f, v1 = (j0 + 1 <= i) ? acc[1] : 0.f, v2 = (j0 + 2 <= i) ? acc[2] : 0.f, v3 = (j0 + 3 <= i) ? acc[3] : 0.f; \
            sp[jt] = (u32x2){pk_hw(v0, v1), pk_hw(v2, v3)}; } \
          else if (jt < it) sp[jt] = (u32x2){pk_hw(acc[0], acc[1]), pk_hw(acc[2], acc[3])}; \
          else asm volatile("" :: "v"(acc)); \
        } \
      } \
        \
        \
      const u32x4 sb0 = (u32x4){sp[0].x, sp[0].y, sp[1].x, sp[1].y}, sb1 = (u32x4){sp[2].x, sp[2].y, sp[3].x, sp[3].y}; \
      f32x4 oacc = (f32x4){0.f, 0.f, 0.f, 0.f}, dacc = (f32x4){0.f, 0.f, 0.f, 0.f}; \
_Pragma("unroll") \
      for (int ks = 0; ks < NKD; ++ks) oacc = __builtin_amdgcn_mfma_f32_16x16x32_bf16(ldfrag(STc, LD_D, vt * 16 + fr, ks * 64 + fq * 16), qf[ks], oacc, 0, 0, 0); \
      if (NVT == 3) { \
_Pragma("unroll") \
        for (int ks = 0; ks < NKD; ++ks) dacc = __builtin_amdgcn_mfma_f32_16x16x32_bf16(ldfrag(STc, LD_D, 32 + fr, ks * 64 + fq * 16), qf[ks], dacc, 0, 0, 0); \
      } \
      if (MIXER == MIX_D) { _Pragma("unroll") for (int e_ = 0; e_ < 4; ++e_) { oacc[e_] = FMUL(oacc[e_], rr_cur); dacc[e_] = FMUL(dacc[e_], rr_cur); } } \
      oacc = __builtin_amdgcn_mfma_f32_16x16x32_bf16(ldfrag2(VTc, LD_T, vt * 16 + fr, fq * 8, 32 + fq * 8), __builtin_bit_cast(bf16x8, sb0), oacc, 0, 0, 0); \
      if (it >= 2) oacc = __builtin_amdgcn_mfma_f32_16x16x32_bf16(ldfrag2(VTc, LD_T, vt * 16 + fr, 64 + fq * 8, 96 + fq * 8), __builtin_bit_cast(bf16x8, sb1), oacc, 0, 0, 0); \
      float dn = 1.0f; \
      if (NVT == 3) { \
        dacc = __builtin_amdgcn_mfma_f32_16x16x32_bf16(ldfrag2(VTc, LD_T, 32 + fr, fq * 8, 32 + fq * 8), __builtin_bit_cast(bf16x8, sb0), dacc, 0, 0, 0); \
        if (it >= 2) dacc = __builtin_amdgcn_mfma_f32_16x16x32_bf16(ldfrag2(VTc, LD_T, 32 + fr, 64 + fq * 8, 96 + fq * 8), __builtin_bit_cast(bf16x8, sb1), dacc, 0, 0, 0); \
        const float den = __shfl(dacc[0], fr); \
        dn = 1.0f / fmaxf(fabsf(den), EMc[it * 16 + fr]); \
      } \
      { \
        const int i = it * 16 + fr; \
        const int ti = dir ? (SEQ - 1 - (n * 64 + i)) : (n * 64 + i); \
        const f32x4 o = (f32x4){FMUL(oacc[0], dn), FMUL(oacc[1], dn), FMUL(oacc[2], dn), FMUL(oacc[3], dn)}; \
        *(u32x2*)(O + PIDX(tokbase + ti, ocol + vt * 16 + fq * 4)) = (u32x2){pk_hw(o[0], o[1]), pk_hw(o[2], o[3])}; \
      } \
      const int dts = (DK == 128) ? wid : (wid & 3); \
      const bf16x8 kf0 = ldfrag(KTc, LD_T, dts * 16 + fr, fq * 16), kf1 = ldfrag(KTc, LD_T, dts * 16 + fr, 64 + fq * 16); \
      const f32x4 dc = *(const f32x4*)(DECc + dts * 16 + fq * 4); \
_Pragma("unroll") \
      for (int s = 0; s < NST; ++s) { \
        const int dt = dts, vt2 = (DK == 128) ? s : (wid >> 2); \
        f32x4 acc = (f32x4){FMUL(sacc[s][0], dc[0]), FMUL(sacc[s][1], dc[1]), FMUL(sacc[s][2], dc[2]), FMUL(sacc[s][3], dc[3])}; \
        acc = __builtin_amdgcn_mfma_f32_16x16x32_bf16(kf0, ldfrag(VTc, LD_T, vt2 * 16 + fr, fq * 16), acc, 0, 0, 0); \
        acc = __builtin_amdgcn_mfma_f32_16x16x32_bf16(kf1, ldfrag(VTc, LD_T, vt2 * 16 + fr, 64 + fq * 16), acc, 0, 0, 0); \
        sacc[s] = acc; \
        *(u32x2*)(STn + (vt2 * 16 + fr) * LD_D + (dt * 16 + fq * 4) * 2) = (u32x2){pk_hw(acc[0], acc[1]), pk_hw(acc[2], acc[3])}; \
      } \
    } \
    } \
    rr_cur = rr_next; \
    lds_barrier(); \
  } while (0)
  static_assert(NCH % 2 == 0, "chunk count must be even");
#pragma unroll 1
  for (int n2 = 0; n2 < NCH; n2 += 2) { SCAN_ITER(n2, R, Rv); SCAN_ITER(n2 + 1, Rn, Rvn); }
#undef SCAN_ITER
#undef A_LOAD
#undef A_PREP
}

template <int MIXER>
__device__ __forceinline__ void scan_dispatch2(unsigned char* lds, int wv, const Params& p, int id) {
  const int vs = id & 3, dir = (id >> 2) & 1, h = (id >> 3) & 3, b = id >> 5;
  scan_item2<MIXER>(lds, wv, p, b, h, dir, vs);
}
}

__device__ __forceinline__ void scan_phase2(unsigned char* lds, int wv, const Params& p, int layer, int convert) {
  bool light = false;
  for (int it0 = blockIdx.x; it0 < 256; it0 += gridDim.x) {
    const int xq = it0 & 7, yq = it0 >> 3, stream = (yq >> 2) * 8 + xq;
    const int item = (stream >> 5) * 128 + (stream & 31) * 4 + (yq & 3);
    if (layer == 0) { if (item < 128) scan2::scan_dispatch2<scan::MIX_A>(lds, wv, p, item); else scan2::scan_dispatch2<scan::MIX_B>(lds, wv, p, item - 128); }
    else { if (item < 128) scan2::scan_dispatch2<scan::MIX_D>(lds, wv, p, item); else scan2::scan_dispatch2<scan::MIX_C>(lds, wv, p, item - 128); }
    light = item >= 128;
    __syncthreads();
  }
  if (convert) {
    const int G = gridDim.x, b = blockIdx.x;
    if (G == 256) { if (light) { moe_weight_convert(lds, wv, p, layer, 0, b - 128, 128); if (p.big_ws) moe_weight_convert(lds, wv, p, layer, 1, b - 128, 128); } }
    else { moe_weight_convert(lds, wv, p, layer, 0, b, G); if (p.big_ws) moe_weight_convert(lds, wv, p, layer, 1, b, G); }
  }
}
#endif
#ifndef CPU_EMU
#define XB_BASE     2048
#define XB_TMO      (XB_BASE + 128)
#define XB_XCNT(j)  (XB_BASE + 256  + 64 * (j))
#define XB_XSUB(j)  (XB_BASE + 1280 + 64 * (j))
#define XB_XGEN(j)  (XB_BASE + 2304 + 64 * (j))
#define XB_TOP      (XB_BASE + 3328)
#define XB_TOPGEN   (XB_BASE + 3392)
#define XB_WORDS    3456
#define XB_SPIN_CAP (1u << 22)
#define XB_LDS_OFF  (LDS_BYTES - 16)
__device__ __forceinline__ unsigned xb_ld(unsigned* p)              { return __hip_atomic_load(p, __ATOMIC_RELAXED, __HIP_MEMORY_SCOPE_AGENT); }
__device__ __forceinline__ unsigned xb_add(unsigned* p, unsigned v) { return __hip_atomic_fetch_add(p, v, __ATOMIC_RELAXED, __HIP_MEMORY_SCOPE_AGENT); }
__device__ __forceinline__ unsigned xb_xcc_id() { return (unsigned)__builtin_amdgcn_s_getreg((3 << 11) | 20) & 0xFu; }
#define XB_SPIN(cond, bar) do { unsigned _sp = 0; while (cond) { __builtin_amdgcn_s_sleep(1); \
    if ((++_sp & 255u) == 0u) { if (xb_ld(&(bar)[XB_TMO])) break; if (_sp > XB_SPIN_CAP) { atomicAdd(&(bar)[XB_TMO], 1u); break; } } } } while (0)
__device__ __forceinline__ void grid_bar(unsigned* bar, unsigned char* lds_raw, int wv) {
  asm volatile("s_waitcnt vmcnt(0)" ::: "memory");
  __syncthreads();
  if (wv == 0 && lane_id() == 0) {
    volatile unsigned* st = (volatile unsigned*)(lds_raw + XB_LDS_OFF);
    __builtin_amdgcn_s_waitcnt(0);
    const unsigned x = xb_xcc_id();
    unsigned nloc = st[0], nx = st[1];
    if (nloc == 0u) {
      const unsigned G = gridDim.x; unsigned sum, cnt, mine, sp = 0u;
      for (;;) { sum = 0u; cnt = 0u; mine = 0u;
#pragma unroll
        for (unsigned j = 0; j < 16; ++j) { const unsigned c = xb_ld(&bar[XB_XCNT(j)]); sum += c; cnt += (c > 0u) ? 1u : 0u; mine = (j == x) ? c : mine; }
        if (sum == G) break;
        __builtin_amdgcn_s_sleep(1);
        if ((++sp & 255u) == 0u) { if (xb_ld(&bar[XB_TMO])) break; if (sp > XB_SPIN_CAP) { atomicAdd(&bar[XB_TMO], 1u); break; } } }
      nloc = mine > 0u ? mine : 1u; nx = cnt > 0u ? cnt : 1u; st[0] = nloc; st[1] = nx;
    }
    const unsigned old = xb_add(&bar[XB_XSUB(x)], 1u);
    const unsigned gen = old / nloc;
    if (old + 1u == (gen + 1u) * nloc) {
      __builtin_amdgcn_fence(__ATOMIC_RELEASE, "agent");
      asm volatile("s_waitcnt vmcnt(0)" ::: "memory");
      const unsigned og = xb_add(&bar[XB_TOP], 1u);
      const unsigned tg = og / nx;
      if (og + 1u == (tg + 1u) * nx) xb_add(&bar[XB_TOPGEN], 1u);
      else XB_SPIN(xb_ld(&bar[XB_TOPGEN]) == tg, bar);
      __builtin_amdgcn_fence(__ATOMIC_ACQUIRE, "agent");
      xb_add(&bar[XB_XGEN(x)], 1u);
      asm volatile("s_waitcnt vmcnt(0)" ::: "memory");
    } else {
      XB_SPIN(xb_ld(&bar[XB_XGEN(x)]) == gen, bar);
      __builtin_amdgcn_fence(__ATOMIC_ACQUIRE, "agent");
      asm volatile("s_waitcnt vmcnt(0)" ::: "memory");
    }
  }
  __syncthreads();
}
#if (PROBE_DUP & 16)
#define grid_bar(a, b, c) do { grid_bar(a, b, c); grid_bar(a, b, c); } while (0)
#endif

__global__ void __launch_bounds__(NTHREADS) mk_fwd(Params p) {
  extern __shared__ __attribute__((aligned(16))) unsigned char lds_raw[];
  cg::grid_group grid = cg::this_grid();
  const int G = gridDim.x, bid = blockIdx.x;
  const int wv = __builtin_amdgcn_readfirstlane(threadIdx.x >> 6);
  PG8_LAS unsigned char* lds = (PG8_LAS unsigned char*)lds_raw;
  unsigned char* ws = p.ws;

  if (threadIdx.x < 4) ((unsigned*)(lds_raw + XB_LDS_OFF))[threadIdx.x] = 0u;
  p0_prologue(lds_raw, wv, p);
#if (PROBE_DUP & 128)
  p0_prologue(lds_raw, wv, p);
#endif
  grid.sync();
  unsigned* bar = (unsigned*)(ws + WS_CTL);
  if (wv == 0 && lane_id() == 0) (void)xb_add(&bar[XB_XCNT(xb_xcc_id())], 1u);
  for (int layer = 0; layer < 2; ++layer) {
    { ProbInProj pr; pr.so.init(NTOK, layer == 0 ? PM_AB : PM_CD, G, bid); pr.A = (const char*)(ws + WS_HB); pr.Bt = (const char*)(ws + (layer == 0 ? WS_WIN_AB : WS_WIN_CD));
      pr.P = (bf16_t*)(ws + WS_R1); pr.bias = p.in[layer == 0 ? I_AB_B_IN : I_CD_B_IN]; pr.lb = (const float*)(ws + WS_LB); pr.layer = layer;
      pg8::gemm_phase(lds, pr, wv);
#if (PROBE_DUP & (1 | 2048))
      pg8::gemm_phase(lds, pr, wv);
#endif
      if (layer == 0) side_phase<32>(lds_raw, wv, p, 0); else side_phase<16>(lds_raw, wv, p, 1);
#if (PROBE_DUP & 256)
      if (layer == 0) side_phase<32>(lds_raw, wv, p, 0); else side_phase<16>(lds_raw, wv, p, 1);
#endif
 }
    grid_bar(bar, lds_raw, wv);
    if (layer == 1) { convd_phase(lds_raw, wv, p); grid_bar(bar, lds_raw, wv); }
    scan_phase2(lds_raw, wv, p, layer, 1);
#if (PROBE_DUP & 2)
    scan_phase2(lds_raw, wv, p, layer, 0);
#endif
#if (PROBE_DUP & 512)
    if (layer == 0) scan_phase2(lds_raw, wv, p, layer, 0);
#endif
#if (PROBE_DUP & 1024)
    if (layer == 1) scan_phase2(lds_raw, wv, p, layer, 0);
#endif
    grid_bar(bar, lds_raw, wv);
    headnorm_phase(lds_raw, wv, p, layer);
#if (PROBE_DUP & 8)
    headnorm_phase(lds_raw, wv, p, layer);
#endif
    grid_bar(bar, lds_raw, wv);
    { ProbOutProj pr; pr.so.init(NTOK, 1024, G, bid); pr.A = (const char*)(ws + WS_MIX); pr.Bt = (const char*)(ws + (layer == 0 ? WS_WOUT_AB : WS_WOUT_CD)); pr.Y = (float*)(ws + WS_R2); pr.Hres = layer == 0 ? p.in[I_X] : p.out;
      pg8::gemm_phase(lds, pr, wv);
#if (PROBE_DUP & (1 | 16384))
      pg8::gemm_phase(lds, pr, wv);
#endif
      if (!p.big_ws) moe_weight_convert(lds_raw, wv, p, layer, 1, bid, G);
 }
    grid_bar(bar, lds_raw, wv);
#if (PROBE_DUP & 32)
    ln_phase(lds_raw, wv, p, layer, 0, 1);
#endif
    ln_phase(lds_raw, wv, p, layer, 0);
    grid_bar(bar, lds_raw, wv);
    { ProbMoe1 pr; pr.mo.init((const int*)((const unsigned*)(ws + WS_CTL) + CW_CNT(layer)), 8, G, bid, lds_raw, wv);
      pr.A = (const char*)(ws + WS_MIX); pr.W13 = (const char*)(ws + WS_W13); pr.list = (const int*)(ws + WS_LIST) + (size_t)layer * NEXP * NTOK; pr.H = (bf16_t*)(ws + WS_H);
      pg8::gemm_phase(lds, pr, wv);
#if (PROBE_DUP & (1 | 4096))
      pg8::gemm_phase(lds, pr, wv);
#endif
 }
    grid_bar(bar, lds_raw, wv);
    { ProbMoe2 pr; pr.mo.init((const int*)((const unsigned*)(ws + WS_CTL) + CW_CNT(layer)), 4, G, bid, lds_raw, wv);
      pr.A = (const char*)(ws + WS_H); pr.W2 = (const char*)(ws + (p.big_ws ? WS_W2X : WS_W2)); pr.Y = (bf16_t*)(ws + WS_R2);
      pg8::gemm_phase(lds, pr, wv);
#if (PROBE_DUP & (1 | 8192))
      pg8::gemm_phase(lds, pr, wv);
#endif
 }
    grid_bar(bar, lds_raw, wv);
#if (PROBE_DUP & 64)
    ln_phase(lds_raw, wv, p, layer, 1, 1);
#endif
    ln_phase(lds_raw, wv, p, layer, 1);
    if (layer == 0) grid_bar(bar, lds_raw, wv);
  }
}

extern "C" void kernel_launch(void* const* d_in, const int* in_sizes, int n_in, void* d_out, int out_size, void* d_ws, size_t ws_size, hipStream_t stream) {
  static int grid_blocks = 0;
  if (grid_blocks == 0) {
    if (n_in != N_IN || ws_size < WS_END || out_size != NTOK * 1024) { fprintf(stderr, "kernel_launch: bad shapes: n_in %d ws %zu (need %zu) out %d\n", n_in, ws_size, (size_t)WS_END, out_size); grid_blocks = -1; return; }
    int dev = 0, cus = 0, per_cu = 0;
    hipGetDevice(&dev); hipDeviceGetAttribute(&cus, hipDeviceAttributeMultiprocessorCount, dev);
    if (hipFuncSetAttribute((const void*)mk_fwd, hipFuncAttributeMaxDynamicSharedMemorySize, LDS_BYTES) != hipSuccess) { fprintf(stderr, "kernel_launch: hipFuncSetAttribute failed\n"); grid_blocks = -1; return; }
    if (hipOccupancyMaxActiveBlocksPerMultiprocessor(&per_cu, (const void*)mk_fwd, NTHREADS, LDS_BYTES) != hipSuccess || per_cu < 1) { fprintf(stderr, "kernel_launch: occupancy query failed (%d)\n", per_cu); grid_blocks = -1; return; }
    grid_blocks = cus;
    (void)in_sizes;
  }
  if (grid_blocks < 0) return;
  Params p{};
  for (int i = 0; i < N_IN; ++i) p.in[i] = (const float*)d_in[i];
  p.out = (float*)d_out; p.ws = (unsigned char*)d_ws; p.big_ws = ws_size >= (size_t)WS_END_BIG ? 1 : 0;
  void* args[] = {&p};
  hipError_t e = hipLaunchCooperativeKernel((const void*)mk_fwd, dim3(grid_blocks), dim3(NTHREADS), args, LDS_BYTES, stream);
  if (e != hipSuccess) fprintf(stderr, "cooperative launch failed: %s (grid %d)\n", hipGetErrorString(e), grid_blocks);
}
#endif
```

```cpp
#ifdef CPU_EMU
#include <cmath>
#include <cstdio>
#include <cstring>
#include <cstdlib>
#include <cstddef>
#define DEV
#define DEV_INLINE static inline
typedef void* hipStream_t;
#else
#include <hip/hip_runtime.h>
#include <hip/hip_bf16.h>
#include <cstdio>
#define DEV __device__ __forceinline__
#define DEV_INLINE __device__ __forceinline__
#endif
#ifndef PROBE_DUP
#define PROBE_DUP 0
#endif
#ifndef BATCH
#define BATCH 4
#endif
#ifndef SEQ
#define SEQ 8192
#endif
#define DM 1024
#define NTOK (BATCH * SEQ)
#define P_AB 4128
#define P_CD 3600
#define PM_AB 4096
#define PM_CD 3584
#define NEXP 16
#define ALPHA_F 1.4142135623730951f
#define LN_EPS_F 1e-5f
#define NORM_EPS_F 1e-6f
#define HROWS (2 * NTOK + NEXP * 256)

typedef unsigned short bf16_t;

DEV_INLINE float bf2f(bf16_t b) { unsigned u = ((unsigned)b) << 16; float f; memcpy(&f, &u, 4); return f; }
DEV_INLINE bf16_t f2bf(float f) { unsigned u; memcpy(&u, &f, 4); u += 0x7FFFu + ((u >> 16) & 1u); return (bf16_t)(u >> 16); }
DEV_INLINE float sigmoidf_(float x) { return 1.0f / (1.0f + expf(-x)); }
DEV_INLINE float siluf_(float x) { return x / (1.0f + expf(-x)); }
DEV_INLINE float logsigmoidf_(float x) { return fminf(x, 0.0f) - log1pf(expf(-fabsf(x))); }

#define AL256(x) (((size_t)(x) + 255) & ~(size_t)255)
#define WS_CTL    ((size_t)0)
#define WS_HB     ((size_t)65536)
#define WS_R1     (WS_HB + (size_t)NTOK * 1024 * 2)
#define R1_P_BYTES ((size_t)NTOK * 4096 * 2)
#define R1_MIN    ((size_t)NTOK * 1024 * 2 + AL256((size_t)HROWS * 1024 * 2))
#define R1_PL     (R1_P_BYTES + (size_t)NTOK * 512 * 2)
#define R1_BYTES  (R1_PL > R1_MIN ? R1_PL : R1_MIN)
#define WS_LFB    (WS_R1 + R1_P_BYTES)
#define WS_MIX    (WS_R1)
#define WS_H      (WS_R1 + (size_t)NTOK * 1024 * 2)
#define WS_W13    (WS_HB)
#define WS_W2     (WS_LFB)
#define WMOE_BYTES ((size_t)NEXP * 3072 * 1024 * 2)
#define WS_R2     (WS_R1 + R1_BYTES)
#define R2_BYTES  ((size_t)HROWS * 1024 * 2 > (size_t)NTOK * 1024 * 4 ? (size_t)HROWS * 1024 * 2 : (size_t)NTOK * 1024 * 4)
#define WS_SIDE   (WS_R2 + AL256(R2_BYTES))
#define WS_WIN_AB (WS_SIDE + (size_t)NTOK * 32 * 4)
#define WS_WIN_CD (WS_WIN_AB + (size_t)4128 * 1024 * 2)
#define WS_WOUT_AB (WS_WIN_CD + (size_t)3600 * 1024 * 2)
#define WS_WOUT_CD (WS_WOUT_AB + (size_t)1024 * 1024 * 2)
#define WS_ROPE   (WS_WOUT_CD + (size_t)1024 * 1024 * 2)
#define WS_LB     (WS_ROPE + (size_t)SEQ * 64 * 4)
#define WS_LIST   (WS_LB + 4096)
#define WS_ASSIGN (WS_LIST + (size_t)2 * NEXP * NTOK * 4)
#define WS_GATE   (WS_ASSIGN + (size_t)NTOK * 16)
#define WS_END    (WS_GATE + (size_t)NTOK * 8)
#define WS_W2X    (AL256(WS_END))
#define WS_END_BIG (WS_W2X + (size_t)NEXP * 1024 * 1024 * 2)
#define CW_CNT(layer) (64 + 256 * (layer))

#define PSTRIDE 4096
#define PIDX(tok, col) ((((size_t)((col) >> 7)) * NTOK + (size_t)(tok)) * 128 + (size_t)((col) & 127))

enum { I_X, I_AB_W_IN, I_AB_B_IN, I_HGRN_LB, I_GK_UP, I_GK_B, I_HGRN_NORM, I_GLA_NORM, I_AB_W_OUT,
       I_CD_W_IN, I_CD_B_IN, I_CONV_W, I_CONV_B, I_FGATE_B, I_RET_NORM, I_MLSTM_NORM, I_CD_W_OUT,
       I_LN_MIX_G, I_LN_MIX_B, I_LN_FFN_G, I_LN_FFN_B, I_ROUTER_W, I_ROUTER_B, I_MOE_W1, I_MOE_W3, I_MOE_W2, N_IN };

struct Params {
  const float* in[N_IN];
  float* out;
  unsigned char* ws;
  long long big_ws;
};

DEV_INLINE float epi_ab(int col, float v, const float* lb) {
  if (col < 512) return siluf_(v);
  if (col < 1536) { float l = lb[(col - 512) & 511]; return logf(l + (1.0f - l) * sigmoidf_(v)); }
  if (col >= 2560 && col < 2816) return v * 0.125f;
  return v;
}

DEV_INLINE void route_from_logits(const float* lg, const float* rb, int* e_out, float* g_out) {
  float mx = lg[0];
#pragma unroll
  for (int e = 1; e < 16; ++e) mx = fmaxf(mx, lg[e]);
  float sc[16]; float sum = 0.f;
#pragma unroll
  for (int e = 0; e < 16; ++e) { sc[e] = expf(lg[e] - mx); sum += sc[e]; }
  float inv = 1.0f / sum;
  float best_gs = -1e30f; int be1 = 0, be2 = 1; float bs1 = 0.f, bs2 = 0.f;
#pragma unroll
  for (int gq = 0; gq < 4; ++gq) {
    float m1 = -1e30f, m2 = -1e30f, s1 = 0.f, s2 = 0.f; int i1 = 0, i2 = 0;
#pragma unroll
    for (int i = 0; i < 4; ++i) {
      float s = sc[gq * 4 + i] * inv; float v = s + rb[gq * 4 + i];
      if (v > m1) { m2 = m1; i2 = i1; s2 = s1; m1 = v; i1 = gq * 4 + i; s1 = s; }
      else if (v > m2) { m2 = v; i2 = gq * 4 + i; s2 = s; }
    }
    float gs = m1 + m2;
    if (gs > best_gs) { best_gs = gs; be1 = i1; be2 = i2; bs1 = s1; bs2 = s2; }
  }
  e_out[0] = be1; e_out[1] = be2; g_out[0] = bs1 / (bs1 + bs2); g_out[1] = bs2 / (bs1 + bs2);
}
#ifndef CPU_EMU
namespace pg8 {
#define PG8_LAS __attribute__((address_space(3)))
typedef short bf16x8 __attribute__((ext_vector_type(8)));
typedef float f32x4 __attribute__((ext_vector_type(4)));
typedef unsigned u32x4 __attribute__((ext_vector_type(4)));
typedef unsigned u32x2 __attribute__((ext_vector_type(2)));
constexpr int BM = 256, BK = 64, HALF = 128, HTB = HALF * BK * 2, STAGE_BYTES = 8 * HTB, NXCD = 8, WGM = 8, GK = 1024;

__device__ __forceinline__ int lds_byte(int r, int c) { const int st = (r >> 4) * 2 + (c >> 5), rr = r & 15, cc = c & 31, ob = rr * 64 + cc * 2; return st * 1024 + (ob ^ (((ob >> 9) & 1) << 5)); }
__device__ __forceinline__ void stage_rc(int b, int& R, int& C) { const int st = b / 1024, sb = b % 1024, swz = sb ^ (((sb >> 9) & 1) << 5); R = (st >> 1) * 16 + swz / 64; C = (st & 1) * 32 + (swz % 64) / 2; }
__device__ __forceinline__ int perm32(int rho) { const int n = rho >> 4, i = rho & 15; return 8 * (i >> 2) + 4 * n + (i & 3); }
__device__ __forceinline__ unsigned cvt_pk_bf16(float lo, float hi) { unsigned r; asm volatile("v_cvt_pk_bf16_f32 %0, %1, %2" : "=v"(r) : "v"(lo), "v"(hi)); return r; }

struct Unit { int pm, pn, e, row0, ne, ui; };

struct StaticOrder {
  int nM, nN, nwg, G, c;
  __device__ void init(int M, int N, int G_, int c_) { nM = M / BM; nN = N / BM; nwg = nM * nN; G = G_; c = c_; }
  __device__ bool next(int i, Unit& u) const {
    const long L = (long)i * G + c; if (L >= nwg) return false;
    int wgid = (int)L; { const int q = nwg / NXCD, r = nwg % NXCD, xcd = wgid % NXCD, off = wgid / NXCD; wgid = (xcd < r ? xcd * (q + 1) : r * (q + 1) + (xcd - r) * q) + off; }
    const int nig = WGM * nN, gid = wgid / nig, fm = gid * WGM, gsz = (nM - fm) < WGM ? (nM - fm) : WGM;
    u.pm = fm + ((wgid % nig) % gsz); u.pn = (wgid % nig) / gsz; u.e = 0; u.row0 = u.pm * BM; u.ne = 0; u.ui = i; return true;
  }
};

template <class Prob>
__device__ __forceinline__ void gemm_phase(PG8_LAS unsigned char* lds, const Prob& S, int wv) {
  int wv_ = wv; asm volatile("" : "+s"(wv_));
  int l_; asm volatile("v_mbcnt_lo_u32_b32 %0, -1, 0\n\tv_mbcnt_hi_u32_b32 %0, -1, %0" : "=v"(l_));
  int tid_ = wv_ * 64 + l_;
  const int tid = tid_, wid = __builtin_amdgcn_readfirstlane(tid >> 6), lane = tid & 63, wr = wid >> 2, wc = wid & 3, fr = lane & 15, fq = lane >> 4;
  constexpr int K = GK, nt = K / BK;
  int sR[2], sC[2]; unsigned voffB[2];
#pragma unroll
  for (int i = 0; i < 2; ++i) { int R, C; stage_rc(tid * 16 + i * 8192, R, C); sR[i] = R; sC[i] = C; const int Rb = Prob::PERM ? ((R & ~31) + perm32(R & 31)) : R; voffB[i] = (unsigned)(Rb * K + C) * 2u; }
  const size_t kstep = (size_t)(BK * 2);
  const size_t hstep = (size_t)HALF * K * 2;
  const unsigned ldsw = (unsigned)wid * 1024u;
  const int aoff = lds_byte(wr * 64 + fr, fq * 8), boff = lds_byte(wc * 32 + fr, fq * 8);
#define PG8_SA(b, h) (((b) * 2 + (h)) * HTB)
#define PG8_SB(b, h) ((4 + (b) * 2 + (h)) * HTB)
#define PG8_STAGE(bufoff, gbase, voff) do { _Pragma("unroll") for (int _i = 0; _i < 2; ++_i) \
    __builtin_amdgcn_global_load_lds((const unsigned*)((const char*)(gbase) + (voff)[_i]), (PG8_LAS unsigned*)(lds + (bufoff) + ldsw + _i * 8192), 16, 0, 0); } while (0)
#define PG8_LDA(dst, b, h) do { _Pragma("unroll") for (int m = 0; m < 4; ++m) _Pragma("unroll") for (int k = 0; k < 2; ++k) dst[m][k] = *(const PG8_LAS bf16x8*)(lds + PG8_SA(b, h) + aoff + m * 2048 + k * 1024); } while (0)
#define PG8_LDB(dst, b, h) do { _Pragma("unroll") for (int n = 0; n < 2; ++n) _Pragma("unroll") for (int k = 0; k < 2; ++k) dst[n][k] = *(const PG8_LAS bf16x8*)(lds + PG8_SB(b, h) + boff + n * 2048 + k * 1024); } while (0)
#define PG8_MMA(ai, bj, At, Bt) do { __builtin_amdgcn_s_setprio(1); _Pragma("unroll") for (int m = 0; m < 4; ++m) _Pragma("unroll") for (int n = 0; n < 2; ++n) _Pragma("unroll") for (int k = 0; k < 2; ++k) \
    acc[ai][bj][m][n] = __builtin_amdgcn_mfma_f32_16x16x32_bf16(Bt[n][k], At[m][k], acc[ai][bj][m][n], 0, 0, 0); __builtin_amdgcn_s_setprio(0); } while (0)
#define PG8_WAIT_V(n) asm volatile("s_waitcnt vmcnt(" #n ")" ::: "memory")
#define PG8_WAIT_L(n) asm volatile("s_waitcnt lgkmcnt(" #n ")" ::: "memory")
#define PG8_BAR __builtin_amdgcn_s_barrier()
#define PG8_SCHED __builtin_amdgcn_sched_barrier(0)
  Unit cur, nxt; int ui = 0;
  if (!S.next(0, cur)) return;
  f32x4 acc[2][2][4][2];
#pragma unroll
  for (int a = 0; a < 2; ++a)
#pragma unroll
    for (int b = 0; b < 2; ++b)
#pragma unroll
      for (int m = 0; m < 4; ++m)
#pragma unroll
        for (int n = 0; n < 2; ++n) acc[a][b][m][n] = (f32x4){0.f, 0.f, 0.f, 0.f};
  bf16x8 At[4][2], B0[2][2], B1[2][2];
  unsigned oc0[2], oc1[2], on0[2], on1[2];
#pragma unroll
  for (int i = 0; i < 2; ++i) { oc0[i] = S.a_off(cur, sR[i]) + (unsigned)sC[i] * 2u; oc1[i] = S.a_off(cur, HALF + sR[i]) + (unsigned)sC[i] * 2u; }
  const char* const Ab = S.a_base();
  const char* cB = S.b_base(cur);
  PG8_STAGE(PG8_SB(0, 0), cB, voffB); PG8_STAGE(PG8_SB(0, 1), cB + hstep, voffB); PG8_STAGE(PG8_SA(0, 0), Ab, oc0); PG8_STAGE(PG8_SA(0, 1), Ab, oc1);
  if (wr == 1) PG8_BAR;
  PG8_WAIT_V(2); PG8_BAR;
  PG8_STAGE(PG8_SB(1, 0), cB + kstep, voffB); PG8_STAGE(PG8_SA(1, 0), Ab + kstep, oc0); PG8_STAGE(PG8_SB(1, 1), cB + hstep + kstep, voffB);
  PG8_WAIT_V(6); PG8_BAR;
  for (;;) {
    const bool has_next = S.next(ui + 1, nxt);
    const char* nB = cB;
    if (has_next) {
      nB = S.b_base(nxt);
      int l2_; asm volatile("v_mbcnt_lo_u32_b32 %0, -1, 0\n\tv_mbcnt_hi_u32_b32 %0, -1, %0" : "=v"(l2_));
      const int tid2 = wid * 64 + l2_;
#pragma unroll
      for (int i = 0; i < 2; ++i) { int R, C; stage_rc(tid2 * 16 + i * 8192, R, C); on0[i] = S.a_off(nxt, R) + (unsigned)C * 2u; on1[i] = S.a_off(nxt, HALF + R) + (unsigned)C * 2u; }
    } else {
#pragma unroll
      for (int i = 0; i < 2; ++i) { on0[i] = oc0[i]; on1[i] = oc1[i]; }
    }
    for (int t = 0; t < nt; t += 2) {
      const bool last = (t == nt - 2);
      const char* a1 = Ab + (size_t)(t + 1) * kstep;
      const char* a2 = last ? Ab : Ab + (size_t)(t + 2) * kstep; const char* b2 = last ? nB : cB + (size_t)(t + 2) * kstep;
      const char* a3 = a2 + kstep; const char* b3 = b2 + kstep;
      unsigned o20[2], o21[2];
#pragma unroll
      for (int i = 0; i < 2; ++i) { o20[i] = last ? on0[i] : oc0[i]; o21[i] = last ? on1[i] : oc1[i]; }
      PG8_LDB(B0, 0, 0); PG8_LDB(B1, 0, 1); PG8_SCHED; PG8_LDA(At, 0, 0); PG8_STAGE(PG8_SA(1, 1), a1, oc1);
      PG8_WAIT_V(8); PG8_WAIT_L(0); PG8_BAR; PG8_MMA(0, 0, At, B0); PG8_MMA(0, 1, At, B1); PG8_BAR; PG8_SCHED;
      PG8_LDA(At, 0, 1); PG8_STAGE(PG8_SB(0, 0), b2, voffB); PG8_STAGE(PG8_SB(0, 1), b2 + hstep, voffB); PG8_STAGE(PG8_SA(0, 0), a2, o20);
      PG8_WAIT_V(8); PG8_WAIT_L(0); PG8_BAR; PG8_MMA(1, 0, At, B0); PG8_MMA(1, 1, At, B1); PG8_BAR; PG8_SCHED;
      PG8_LDB(B0, 1, 0); PG8_LDB(B1, 1, 1); PG8_SCHED; PG8_LDA(At, 1, 0); PG8_STAGE(PG8_SA(0, 1), a2, o21);
      PG8_WAIT_V(8); PG8_WAIT_L(0); PG8_BAR; PG8_MMA(0, 0, At, B0); PG8_MMA(0, 1, At, B1); PG8_BAR; PG8_SCHED;
      PG8_LDA(At, 1, 1); PG8_STAGE(PG8_SB(1, 0), b3, voffB); PG8_STAGE(PG8_SB(1, 1), b3 + hstep, voffB); PG8_STAGE(PG8_SA(1, 0), a3, o20);
      PG8_WAIT_V(8); PG8_WAIT_L(0); PG8_BAR; PG8_MMA(1, 0, At, B0); PG8_MMA(1, 1, At, B1); PG8_BAR; PG8_SCHED;
    }
    if (wr == 0) PG8_BAR;
    { int l3_; asm volatile("v_mbcnt_lo_u32_b32 %0, -1, 0\n\tv_mbcnt_hi_u32_b32 %0, -1, %0" : "=v"(l3_));
      S.epi(acc, cur, wr, wc, l3_ & 15, l3_ >> 4); }
    if (!has_next) break;
#pragma unroll
    for (int a = 0; a < 2; ++a)
#pragma unroll
      for (int b = 0; b < 2; ++b)
#pragma unroll
        for (int m = 0; m < 4; ++m)
#pragma unroll
          for (int n = 0; n < 2; ++n) acc[a][b][m][n] = (f32x4){0.f, 0.f, 0.f, 0.f};
    cur = nxt; cB = nB; ++ui;
#pragma unroll
    for (int i = 0; i < 2; ++i) { oc0[i] = on0[i]; oc1[i] = on1[i]; }
    if (wr == 1) PG8_BAR;
  }
  PG8_WAIT_V(0);
  PG8_BAR;
#undef PG8_SA
#undef PG8_SB
#undef PG8_STAGE
#undef PG8_LDA
#undef PG8_LDB
#undef PG8_MMA
#undef PG8_WAIT_V
#undef PG8_WAIT_L
#undef PG8_BAR
#undef PG8_SCHED
}
}
#endif
#ifndef CPU_EMU
#include <hip/hip_cooperative_groups.h>
namespace cg = cooperative_groups;
#define LAS __attribute__((address_space(3)))
#define NTHREADS 512
#define LDS_BYTES (154 * 1024)
typedef float f32x4 __attribute__((ext_vector_type(4)));
typedef short bf16x8 __attribute__((ext_vector_type(8)));
typedef unsigned u32x4 __attribute__((ext_vector_type(4)));
typedef unsigned u32x2 __attribute__((ext_vector_type(2)));

struct Ctx { int tid, lane, wid, G, bid; unsigned char* lds; };
__device__ __forceinline__ int lane_id() { int l; asm volatile("v_mbcnt_lo_u32_b32 %0, -1, 0\n\tv_mbcnt_hi_u32_b32 %0, -1, %0" : "=v"(l)); return l; }
__device__ __forceinline__ int opaque_tid(int wv) { int w = wv; asm volatile("" : "+s"(w)); int t = w * 64 + lane_id(); asm volatile("" : "+v"(t)); return t; }
__device__ __forceinline__ Ctx make_ctx(unsigned char* lds, int wv) { Ctx c; c.tid = opaque_tid(wv); c.lane = c.tid & 63; c.wid = __builtin_amdgcn_readfirstlane(c.tid >> 6); c.G = gridDim.x; c.bid = blockIdx.x; c.lds = lds; return c; }

__device__ __forceinline__ float wave_sum(float x) {
  x += __builtin_bit_cast(float, __builtin_amdgcn_update_dpp(0, __builtin_bit_cast(int, x), 0x111, 0xf, 0xf, false));
  x += __builtin_bit_cast(float, __builtin_amdgcn_update_dpp(0, __builtin_bit_cast(int, x), 0x112, 0xf, 0xf, false));
  x += __builtin_bit_cast(float, __builtin_amdgcn_update_dpp(0, __builtin_bit_cast(int, x), 0x114, 0xf, 0xf, false));
  x += __builtin_bit_cast(float, __builtin_amdgcn_update_dpp(0, __builtin_bit_cast(int, x), 0x118, 0xf, 0xf, false));
  x += __builtin_bit_cast(float, __builtin_amdgcn_update_dpp(0, __builtin_bit_cast(int, x), 0x142, 0xa, 0xf, false));
  x += __builtin_bit_cast(float, __builtin_amdgcn_update_dpp(0, __builtin_bit_cast(int, x), 0x143, 0xc, 0xf, false));
  return __builtin_bit_cast(float, __builtin_amdgcn_readlane(__builtin_bit_cast(int, x), 63));
}
__device__ __forceinline__ float fsigmoid(float x) { return __builtin_amdgcn_rcpf(1.0f + __builtin_amdgcn_exp2f(-1.4426950408889634f * x)); }
__device__ __forceinline__ float fsilu(float x) { return x * fsigmoid(x); }
__device__ __forceinline__ float flog2sigmoid(float x) { const float y = x * 1.4426950408889634f; return fminf(y, 0.f) - __builtin_amdgcn_logf(1.0f + __builtin_amdgcn_exp2f(-fabsf(y))); }
typedef float f32x2_t __attribute__((ext_vector_type(2)));
typedef __bf16 bf16x2_t __attribute__((ext_vector_type(2)));
__device__ __forceinline__ unsigned pk_hw(float a, float b) { const f32x2_t v = {a, b}; return __builtin_bit_cast(unsigned, __builtin_convertvector(v, bf16x2_t)); }
__device__ __forceinline__ unsigned pk2(float a, float b) { return pk_hw(a, b); }
__device__ __forceinline__ void unpack8(u32x4 w, float* f) {
  f[0] = __uint_as_float(w.x << 16); f[1] = __uint_as_float(w.x & 0xffff0000u); f[2] = __uint_as_float(w.y << 16); f[3] = __uint_as_float(w.y & 0xffff0000u);
  f[4] = __uint_as_float(w.z << 16); f[5] = __uint_as_float(w.z & 0xffff0000u); f[6] = __uint_as_float(w.w << 16); f[7] = __uint_as_float(w.w & 0xffff0000u);
}

__device__ __forceinline__ void transpose_job(const Ctx& c, const float* src, int N, bf16_t* dst, int rs, int ro, int tile0, int tile_stride) {
  float* t = (float*)c.lds;
  const int ntn = (N + 63) / 64, ntiles = ntn * 16;
  for (int tl = tile0; tl < ntiles; tl += tile_stride) {
    const int kt = tl / ntn, nt_ = tl % ntn, k0 = kt * 64, n0 = nt_ * 64;
    __syncthreads();
#pragma unroll
    for (int i = 0; i < 8; ++i) { const int idx = c.tid + i * 512, kk = idx >> 6, nn = idx & 63; t[kk * 65 + nn] = (n0 + nn < N) ? src[(size_t)(k0 + kk) * N + n0 + nn] : 0.f; }
    __syncthreads();
#pragma unroll
    for (int i = 0; i < 4; ++i) { const int idx = c.tid + i * 512, nn = idx >> 5, kp = (idx & 31) * 2;
      if (n0 + nn < N) *(unsigned*)(dst + (size_t)((n0 + nn) * rs + ro) * 1024 + k0 + kp) = pk2(t[kp * 65 + nn], t[(kp + 1) * 65 + nn]); }
  }
  __syncthreads();
}
__device__ __forceinline__ void p0_prologue(unsigned char* lds_, int wv, const Params& p) {
  const Ctx c = make_ctx(lds_, wv);
  unsigned char* ws = p.ws;
  if (c.bid == 0) { ((unsigned*)(ws + WS_CTL))[64 + c.tid] = 0u; }
  if (c.bid == 0) { for (int i = c.tid; i < 3456; i += NTHREADS) ((unsigned*)(ws + WS_CTL))[2048 + i] = 0u; }
  { const float* x = p.in[I_X]; bf16_t* hb = (bf16_t*)(ws + WS_HB);
    for (size_t i = (size_t)c.bid * NTHREADS + c.tid; i < (size_t)NTOK * 1024 / 8; i += (size_t)c.G * NTHREADS) {
      const f32x4 a = __builtin_nontemporal_load((const f32x4*)(x + i * 8)), b = __builtin_nontemporal_load((const f32x4*)(x + i * 8 + 4));
      u32x4 w; w.x = pk2(a[0], a[1]); w.y = pk2(a[2], a[3]); w.z = pk2(b[0], b[1]); w.w = pk2(b[2], b[3]);
      *(u32x4*)(hb + i * 8) = w; } }
  transpose_job(c, p.in[I_AB_W_IN], P_AB, (bf16_t*)(ws + WS_WIN_AB), 1, 0, c.bid, c.G);
  transpose_job(c, p.in[I_CD_W_IN], P_CD, (bf16_t*)(ws + WS_WIN_CD), 1, 0, c.bid, c.G);
  transpose_job(c, p.in[I_AB_W_OUT], 1024, (bf16_t*)(ws + WS_WOUT_AB), 1, 0, c.bid, c.G);
  transpose_job(c, p.in[I_CD_W_OUT], 1024, (bf16_t*)(ws + WS_WOUT_CD), 1, 0, c.bid, c.G);
  { float* rope = (float*)(ws + WS_ROPE);
    for (int i = c.bid * NTHREADS + c.tid; i < SEQ * 32; i += c.G * NTHREADS) { const int t = i >> 5, f = i & 31;
      const float freq = powf(10000.0f, -(float)f / 32.0f); const float ang = (float)t * freq; rope[i * 2] = cosf(ang); rope[i * 2 + 1] = sinf(ang); }
    if (c.bid == 1) { const float* hl = p.in[I_HGRN_LB]; float* lb = (float*)(ws + WS_LB);
      const int cc = c.tid; const float a0 = hl[cc], a1 = hl[512 + cc], a2 = hl[1024 + cc]; const float mx = fmaxf(a0, fmaxf(a1, a2));
      const float e0 = expf(a0 - mx), e1 = expf(a1 - mx), e2 = expf(a2 - mx); lb[cc] = e0 / (e0 + e1 + e2); } }
}
__device__ __forceinline__ void moe_weight_convert(unsigned char* lds_, int wv, const Params& p, int layer, int part, int bidx, int nblk) {
  const Ctx c = make_ctx(lds_, wv);
  bf16_t* w13 = (bf16_t*)(p.ws + WS_W13); bf16_t* w2 = (bf16_t*)(p.ws + (p.big_ws ? WS_W2X : WS_W2));
  const size_t lo = (size_t)layer * NEXP * 1024 * 1024;
  const float* W1 = p.in[I_MOE_W1] + lo; const float* W3 = p.in[I_MOE_W3] + lo; const float* W2 = p.in[I_MOE_W2] + lo;
  float* t = (float*)c.lds;
  const int NT = (part == 0 ? 32 : 16) * 128;
  const int lk = c.tid >> 5, ln4 = (c.tid & 31) * 4;
  const int sn = c.tid & 127, sk = (c.tid >> 7) * 8;
  f32x4 r[4];
#define MW_SRC(g_) ((part == 0 ? ((((g_) >> 7) & 1) ? W3 : W1) + (size_t)((g_) >> 8) * 1048576 : W2 + (size_t)((g_) >> 7) * 1048576) + (size_t)((((g_) & 127) >> 3) * 64) * 1024 + ((g_) & 7) * 128)
#define MW_LOAD(g_) do { const float* s_ = MW_SRC(g_); _Pragma("unroll") for (int i = 0; i < 4; ++i) r[i] = __builtin_nontemporal_load((const f32x4*)(s_ + (size_t)(lk + 16 * i) * 1024 + ln4)); } while (0)
  int g0 = bidx;
  if (g0 < NT) MW_LOAD(g0);
  for (; g0 < NT; g0 += nblk) {
    __syncthreads();
#pragma unroll
    for (int i = 0; i < 4; ++i) { float* d = t + (lk + 16 * i) * 129 + ln4; d[0] = r[i][0]; d[1] = r[i][1]; d[2] = r[i][2]; d[3] = r[i][3]; }
    __syncthreads();
    const int gn = g0 + nblk;
    if (gn < NT) MW_LOAD(gn);
    const int m = g0 >> 7, k0 = ((g0 & 127) >> 3) * 64, n0 = (g0 & 7) * 128;
    bf16_t* drow = (part == 1) ? w2 + ((size_t)m * 1024 + n0 + sn) * 1024 : w13 + ((size_t)(m >> 1) * 2048 + 2 * (n0 + sn) + (m & 1)) * 1024;
#pragma unroll
    for (int j = 0; j < 2; ++j) { const int kk = sk + 32 * j; const float* s = t + kk * 129 + sn;
      u32x4 w; w.x = pk2(s[0], s[129]); w.y = pk2(s[2 * 129], s[3 * 129]); w.z = pk2(s[4 * 129], s[5 * 129]); w.w = pk2(s[6 * 129], s[7 * 129]);
      *(u32x4*)(drow + k0 + kk) = w; }
  }
#undef MW_SRC
#undef MW_LOAD
  __syncthreads();
}

struct ProbInProj {
  static constexpr bool PERM = true;
  pg8::StaticOrder so; const char* A; const char* Bt; bf16_t* P; const float* bias; const float* lb; int layer;
  __device__ __forceinline__ bool next(int i, pg8::Unit& u) const { return so.next(i, u); }
  __device__ __forceinline__ const char* a_base() const { return A; }
  __device__ __forceinline__ unsigned a_off(const pg8::Unit& u, int r) const { return (unsigned)(u.pm * 256 + r) * 2048u; }
  __device__ __forceinline__ const char* b_base(const pg8::Unit& u) const { return Bt + (size_t)u.pn * 256 * 2048; }
  __device__ __forceinline__ void epi(const f32x4 (&acc)[2][2][4][2], const pg8::Unit& u, int wr, int wc, int fr, int fq) const {
    const int row0 = u.row0 + wr * 64 + fr, colb = u.pn * 256 + wc * 32 + 8 * fq;
    int mode = 0;
    if (layer == 0) { mode = u.pn < 2 ? 1 : (u.pn < 6 ? 2 : (u.pn == 10 ? 3 : 0)); }
#pragma unroll
    for (int bj = 0; bj < 2; ++bj) {
      const int col0 = colb + bj * 128;
      const f32x4 b0 = *(const f32x4*)(bias + col0), b1 = *(const f32x4*)(bias + col0 + 4);
      f32x4 l0 = (f32x4){0.f, 0.f, 0.f, 0.f}, l1 = l0;
      if (mode == 2) { l0 = *(const f32x4*)(lb + ((col0 - 512) & 511)); l1 = *(const f32x4*)(lb + ((col0 - 512) & 511) + 4); }
#pragma unroll
      for (int ai = 0; ai < 2; ++ai)
#pragma unroll
        for (int m = 0; m < 4; ++m) {
          f32x4 v0 = acc[ai][bj][m][0] + b0, v1 = acc[ai][bj][m][1] + b1;
          if (mode == 1) {
#pragma unroll
            for (int j = 0; j < 4; ++j) { v0[j] = fsilu(v0[j]); v1[j] = fsilu(v1[j]); }
          } else if (mode == 2) {
#pragma unroll
            for (int j = 0; j < 4; ++j) { v0[j] = __builtin_amdgcn_logf(l0[j] + (1.0f - l0[j]) * fsigmoid(v0[j])); v1[j] = __builtin_amdgcn_logf(l1[j] + (1.0f - l1[j]) * fsigmoid(v1[j])); }
          } else if (mode == 3) { v0 *= 0.125f; v1 *= 0.125f; }
          u32x4 w; w.x = pk2(v0[0], v0[1]); w.y = pk2(v0[2], v0[3]); w.z = pk2(v1[0], v1[1]); w.w = pk2(v1[2], v1[3]);
          *(u32x4*)(P + PIDX(row0 + ai * 128 + m * 16, col0)) = w;
        }
    }
  }
};
struct ProbOutProj {
  static constexpr bool PERM = false;
  pg8::StaticOrder so; const char* A; const char* Bt; float* Y; const float* Hres;
  __device__ __forceinline__ bool next(int i, pg8::Unit& u) const { return so.next(i, u); }
  __device__ __forceinline__ const char* a_base() const { return A; }
  __device__ __forceinline__ unsigned a_off(const pg8::Unit& u, int r) const { return (unsigned)(u.pm * 256 + r) * 2048u; }
  __device__ __forceinline__ const char* b_base(const pg8::Unit& u) const { return Bt + (size_t)u.pn * 256 * 2048; }
  __device__ __forceinline__ void epi(const f32x4 (&acc)[2][2][4][2], const pg8::Unit& u, int wr, int wc, int fr, int fq) const {
    const int row0 = u.row0 + wr * 64 + fr, col0 = u.pn * 256 + wc * 32 + 4 * fq;
#pragma unroll
    for (int ai = 0; ai < 2; ++ai)
#pragma unroll
      for (int m = 0; m < 4; ++m) { const size_t ro = (size_t)(row0 + ai * 128 + m * 16) * 1024 + col0; float* rowp = Y + ro; const float* hp = Hres + ro;
#pragma unroll
        for (int bj = 0; bj < 2; ++bj)
#pragma unroll
          for (int n = 0; n < 2; ++n) *(f32x4*)(rowp + bj * 128 + n * 16) = acc[ai][bj][m][n] + ALPHA_F * *(const f32x4*)(hp + bj * 128 + n * 16); }
  }
};
#define MOE_TAB_OFF (128 * 1024)
struct MoeOrder {
  const int* tab;
  __device__ __forceinline__ void init(const int* cnt, int ntn, int G, int c, unsigned char* lds, int wv) {
    int* t = (int*)(lds + MOE_TAB_OFF);
    const int tid = opaque_tid(wv);
    if (tid < 64) {
      int pad = 0, found = 0, ue = 0, upn = 0, upm = 0, urow = 0, une = 0;
      if ((G & 7) == 0) {
        const int x = c & 7; int q = tid * (G >> 3) + (c >> 3);
        for (int e = 0; e < NEXP; ++e) { const int n = cnt[e * 16], mt = (n + 255) >> 8; const int r = ((x - e) % 8 + 8) % 8; const int m = mt > r ? (mt - r - 1) / 8 + 1 : 0; const int units = m * ntn;
          if (!found && q < units) { ue = e; upm = r + 8 * (q % m); upn = q / m; urow = pad + upm * 256; une = n; found = 1; }
          if (!found) { q -= units; pad += mt * 256; } }
      } else {
        int L = tid * G + c;
        for (int e = 0; e < NEXP; ++e) { const int n = cnt[e * 16], mt = (n + 255) >> 8, tiles = mt * ntn;
          if (!found && L < tiles) { ue = e; upn = L / mt; upm = L % mt; urow = pad + upm * 256; une = n; found = 1; }
          if (!found) { L -= tiles; pad += mt * 256; } }
      }
      t[tid * 8 + 0] = found; t[tid * 8 + 1] = ue; t[tid * 8 + 2] = upn; t[tid * 8 + 3] = upm; t[tid * 8 + 4] = urow; t[tid * 8 + 5] = une;
    }
    __syncthreads();
    tab = t;
  }
  __device__ __forceinline__ bool next(int i, pg8::Unit& u) const {
    if (i >= 64) return false;
    const int* t = tab + i * 8;
    if (!__builtin_amdgcn_readfirstlane(t[0])) return false;
    u.e = __builtin_amdgcn_readfirstlane(t[1]); u.pn = __builtin_amdgcn_readfirstlane(t[2]); u.pm = __builtin_amdgcn_readfirstlane(t[3]);
    u.row0 = __builtin_amdgcn_readfirstlane(t[4]); u.ne = __builtin_amdgcn_readfirstlane(t[5]); u.ui = i; return true;
  }
};
struct ProbMoe1 {
  static constexpr bool PERM = true;
  MoeOrder mo; const char* A; const char* W13; const int* list; bf16_t* H; const int* ltok;
  __device__ __forceinline__ void stage_tokens(unsigned char* lds, int wv) {
    int* lt = (int*)(lds + MOE_TAB_OFF + 2048);
    const int tid = opaque_tid(wv);
    pg8::Unit u;
    for (int i = 0; i < 16 && mo.next(i, u); ++i) { if (tid < 256) { const int rr = u.pm * 256 + tid; lt[i * 256 + tid] = rr < u.ne ? list[u.e * NTOK + rr] : 0; } }
    __syncthreads();
    ltok = lt;
  }
  __device__ __forceinline__ bool next(int i, pg8::Unit& u) const { return mo.next(i, u); }
  __device__ __forceinline__ const char* a_base() const { return A; }
  __device__ __forceinline__ unsigned a_off(const pg8::Unit& u, int r) const { const int rr = u.pm * 256 + r; const int tok = rr < u.ne ? list[u.e * NTOK + rr] : 0; return (unsigned)tok * 2048u; }
  __device__ __forceinline__ const char* b_base(const pg8::Unit& u) const { return W13 + ((size_t)u.e * 2048 + (size_t)u.pn * 256) * 2048; }
  __device__ __forceinline__ void epi(const f32x4 (&acc)[2][2][4][2], const pg8::Unit& u, int wr, int wc, int fr, int fq) const {
    const int row0 = u.row0 + wr * 64 + fr, colb = u.pn * 128 + wc * 16 + 4 * fq;
#pragma unroll
    for (int ai = 0; ai < 2; ++ai)
#pragma unroll
      for (int m = 0; m < 4; ++m)
#pragma unroll
        for (int bj = 0; bj < 2; ++bj) {
          const f32x4 v0 = acc[ai][bj][m][0], v1 = acc[ai][bj][m][1];
          u32x2 w; w.x = pk2(fsilu(v0[0]) * v0[1], fsilu(v0[2]) * v0[3]); w.y = pk2(fsilu(v1[0]) * v1[1], fsilu(v1[2]) * v1[3]);
          *(u32x2*)(H + (size_t)(row0 + ai * 128 + m * 16) * 1024 + colb + bj * 64) = w;
        }
  }
};
struct ProbMoe2 {
  static constexpr bool PERM = true;
  MoeOrder mo; const char* A; const char* W2; bf16_t* Y;
  __device__ __forceinline__ bool next(int i, pg8::Unit& u) const { return mo.next(i, u); }
  __device__ __forceinline__ const char* a_base() const { return A; }
  __device__ __forceinline__ unsigned a_off(const pg8::Unit& u, int r) const { return (unsigned)(u.row0 + r) * 2048u; }
  __device__ __forceinline__ const char* b_base(const pg8::Unit& u) const { return W2 + ((size_t)u.e * 1024 + (size_t)u.pn * 256) * 2048; }
  __device__ __forceinline__ void epi(const f32x4 (&acc)[2][2][4][2], const pg8::Unit& u, int wr, int wc, int fr, int fq) const {
    const int row0 = u.row0 + wr * 64 + fr, colb = u.pn * 256 + wc * 32 + 8 * fq;
#pragma unroll
    for (int ai = 0; ai < 2; ++ai)
#pragma unroll
      for (int m = 0; m < 4; ++m)
#pragma unroll
        for (int bj = 0; bj < 2; ++bj) {
          const f32x4 v0 = acc[ai][bj][m][0], v1 = acc[ai][bj][m][1];
          u32x4 w; w.x = pk2(v0[0], v0[1]); w.y = pk2(v0[2], v0[3]); w.z = pk2(v1[0], v1[1]); w.w = pk2(v1[2], v1[3]);
          *(u32x4*)(Y + (size_t)(row0 + ai * 128 + m * 16) * 1024 + colb + bj * 128) = w;
        }
  }
};

template <int NS>
__device__ __forceinline__ void side_phase(unsigned char* lds_, int wv, const Params& p, int layer) {
  const Ctx c = make_ctx(lds_, wv);
  const bf16_t* hb = (const bf16_t*)(p.ws + WS_HB);
  const bf16_t* wt = (const bf16_t*)(p.ws + (layer == 0 ? WS_WIN_AB : WS_WIN_CD)) + (size_t)(layer == 0 ? PM_AB : PM_CD) * 1024;
  const float* bias = p.in[layer == 0 ? I_AB_B_IN : I_CD_B_IN] + (layer == 0 ? PM_AB : PM_CD);
  float* side = (float*)(p.ws + WS_SIDE);
  float* tl = (float*)c.lds + c.wid * (16 * 33);
  const int fr = c.lane & 15, fq = c.lane >> 4;
  for (int g = c.bid * 8 + c.wid; g < NTOK / 16; g += c.G * 8) {
    const int r0 = g * 16;
    f32x4 acc0 = (f32x4){0.f, 0.f, 0.f, 0.f}, acc1 = acc0;
    const bf16_t* ap = hb + (size_t)(r0 + fr) * 1024 + fq * 8;
    const bf16_t* bp0 = wt + (size_t)fr * 1024 + fq * 8; const bf16_t* bp1 = bp0 + 16 * 1024;
#pragma unroll 16
    for (int k = 0; k < 1024; k += 32) {
      const bf16x8 a = *(const bf16x8*)(ap + k), b0 = *(const bf16x8*)(bp0 + k);
      acc0 = __builtin_amdgcn_mfma_f32_16x16x32_bf16(a, b0, acc0, 0, 0, 0);
      if (NS == 32) { const bf16x8 b1 = *(const bf16x8*)(bp1 + k); acc1 = __builtin_amdgcn_mfma_f32_16x16x32_bf16(a, b1, acc1, 0, 0, 0); }
    }
    float gsc = 1.f, gfb = 0.f; bool gls = false;
    if (NS == 16) { gsc = 1.4426950408889634f; gls = (fr & 4) != 0; gfb = gls ? p.in[I_FGATE_B][(fr >> 3) * 4 + (fr & 3)] : 0.f; }
#pragma unroll
    for (int j = 0; j < 4; ++j) { float v0 = acc0[j] + bias[fr]; if (NS == 16) v0 = gls ? flog2sigmoid(v0 + gfb) : v0 * gsc; side[(size_t)(r0 + fq * 4 + j) * 32 + fr] = v0; tl[(fq * 4 + j) * 33 + fr] = v0;
      if (NS == 32) { const float v1 = acc1[j] + bias[16 + fr]; side[(size_t)(r0 + fq * 4 + j) * 32 + 16 + fr] = v1; tl[(fq * 4 + j) * 33 + 16 + fr] = v1; } }
    if (NS == 32) {
      __builtin_amdgcn_s_waitcnt(0xC07F);
      const float* gu = p.in[I_GK_UP]; const float* gb = p.in[I_GK_B]; bf16_t* lfb = (bf16_t*)(p.ws + WS_LFB);
      const int cb = c.lane * 8, dir = cb >> 8, cc = cb & 255;
      float w[16][8];
#pragma unroll
      for (int r = 0; r < 16; ++r)
#pragma unroll
        for (int j = 0; j < 8; ++j) w[r][j] = gu[(dir * 16 + r) * 256 + cc + j];
      float bb[8];
#pragma unroll
      for (int j = 0; j < 8; ++j) bb[j] = gb[dir * 256 + cc + j];
      for (int row = 0; row < 16; ++row) {
        float z[8];
#pragma unroll
        for (int j = 0; j < 8; ++j) z[j] = bb[j];
#pragma unroll
        for (int r = 0; r < 16; ++r) { const float s = tl[row * 33 + dir * 16 + r];
#pragma unroll
          for (int j = 0; j < 8; ++j) z[j] += s * w[r][j]; }
        u32x4 o; o.x = pk2(flog2sigmoid(z[0]) * 0.0625f, flog2sigmoid(z[1]) * 0.0625f); o.y = pk2(flog2sigmoid(z[2]) * 0.0625f, flog2sigmoid(z[3]) * 0.0625f);
        o.z = pk2(flog2sigmoid(z[4]) * 0.0625f, flog2sigmoid(z[5]) * 0.0625f); o.w = pk2(flog2sigmoid(z[6]) * 0.0625f, flog2sigmoid(z[7]) * 0.0625f);
        *(u32x4*)(lfb + PIDX(r0 + row, cb)) = o;
      }
    }
  }
}

__device__ __forceinline__ void headnorm_phase(unsigned char* lds_, int wv, const Params& p, int layer) {
  const Ctx c = make_ctx(lds_, wv);
  const bf16_t* P = (const bf16_t*)(p.ws + WS_R1); const bf16_t* O = (const bf16_t*)(p.ws + WS_R2);
  bf16_t* mixed = (bf16_t*)(p.ws + WS_MIX);
  const int c0 = c.lane * 16, h8 = c.lane >> 3;
  const float* gain = layer == 0 ? (h8 < 4 ? p.in[I_HGRN_NORM] + c0 : p.in[I_GLA_NORM] + c0 - 512) : (h8 < 4 ? p.in[I_RET_NORM] + c0 : p.in[I_MLSTM_NORM] + c0 - 512);
  const int gcol = layer == 0 ? (h8 < 4 ? 2048 + c0 : 3584 + c0 - 512) : (h8 < 4 ? 1024 + c0 : 3072 + c0 - 512);
  float gn[16];
#pragma unroll
  for (int j = 0; j < 16; ++j) gn[j] = gain[j];
  for (int tok = c.bid * 8 + c.wid; tok < NTOK; tok += c.G * 8) {
    float of[16], ob[16], gt[16];
    { const u32x4* a = (const u32x4*)(O + PIDX(tok, c0)); unpack8(__builtin_nontemporal_load(a), of); unpack8(__builtin_nontemporal_load(a + 1), of + 8);
      const u32x4* b = (const u32x4*)(O + (size_t)NTOK * 1024 + PIDX(tok, c0)); unpack8(__builtin_nontemporal_load(b), ob); unpack8(__builtin_nontemporal_load(b + 1), ob + 8);
      const u32x4* g = (const u32x4*)(P + PIDX(tok, gcol)); unpack8(__builtin_nontemporal_load(g), gt); unpack8(__builtin_nontemporal_load(g + 1), gt + 8); }
    const float sf = 1.f, sb = 1.f;
    float o[16]; float ss = 0.f;
#pragma unroll
    for (int j = 0; j < 16; ++j) { o[j] = of[j] * sf + ob[j] * sb; ss += o[j] * o[j]; }
    ss += __shfl_xor(ss, 1); ss += __shfl_xor(ss, 2); ss += __shfl_xor(ss, 4);
    const float r = 1.0f / sqrtf(ss * (1.0f / 128.0f) + NORM_EPS_F);
    unsigned w[8];
#pragma unroll
    for (int j = 0; j < 8; ++j) {
      float g0 = gt[2 * j], g1 = gt[2 * j + 1];
      if (layer == 1 && h8 >= 4) { g0 = fsigmoid(g0); g1 = fsigmoid(g1); } else { g0 = fsilu(g0); g1 = fsilu(g1); }
      w[j] = pk2(o[2 * j] * r * gn[2 * j] * g0, o[2 * j + 1] * r * gn[2 * j + 1] * g1);
    }
    u32x4* d = (u32x4*)(mixed + (size_t)tok * 1024 + c0);
    d[0] = (u32x4){w[0], w[1], w[2], w[3]}; d[1] = (u32x4){w[4], w[5], w[6], w[7]};
  }
}

__device__ __forceinline__ void ln_phase(unsigned char* lds_, int wv, const Params& p, int layer, int mode, int dry = 0) {
  const Ctx c = make_ctx(lds_, wv);
  unsigned char* ws = p.ws;
  const float* hin = (mode == 0 && layer == 0) ? p.in[I_X] : p.out;
  float* hout = dry ? (float*)(ws + WS_H) : p.out; bf16_t* hb = (bf16_t*)(ws + (mode == 0 ? WS_MIX : WS_HB));
  const float* g = p.in[mode == 0 ? I_LN_MIX_G : I_LN_FFN_G] + layer * 1024; const float* b = p.in[mode == 0 ? I_LN_MIX_B : I_LN_FFN_B] + layer * 1024;
  unsigned* cnt = (unsigned*)(ws + WS_CTL) + CW_CNT(layer);
  int* list = (int*)(ws + WS_LIST) + (size_t)layer * NEXP * NTOK;
  int* assign = (int*)(ws + WS_ASSIGN); float* gate = (float*)(ws + WS_GATE);
  float* rwT = (float*)c.lds;
  int* lcnt = (int*)(c.lds + 65536); int* lbase = lcnt + 16; int* rec = lcnt + 32; float* recg = (float*)(rec + 4 * 2048);
  int pad[NEXP];
  if (mode == 0) { const float* r = p.in[I_ROUTER_W];
    for (int i = c.tid; i < 1024 * 16; i += NTHREADS) rwT[(i & 15) * 1024 + (i >> 4)] = r[i];
    if (c.tid < 16) lcnt[c.tid] = 0;
    __syncthreads(); }
  else { int acc = 0;
#pragma unroll
    for (int e = 0; e < NEXP; ++e) { pad[e] = acc; acc += (((int)cnt[e * 16] + 255) >> 8) << 8; } }
  const int c0 = c.lane * 4;
  float gv[16], bv[16];
#pragma unroll
  for (int q = 0; q < 4; ++q) { const f32x4 t0 = *(const f32x4*)(g + q * 256 + c0), t1 = *(const f32x4*)(b + q * 256 + c0);
#pragma unroll
    for (int j = 0; j < 4; ++j) { gv[4 * q + j] = t0[j]; bv[4 * q + j] = t1[j]; } }
  const int tstride = c.G * 8;
  int it = 0;
  for (int tok0 = c.bid * 8 + c.wid; tok0 < NTOK; tok0 += 2 * tstride, it += 2) {
    float v[2][16];
    float gy0[2], gy1[2];
#pragma unroll
    for (int u = 0; u < 2; ++u) {
      const int tok = tok0 + u * tstride;
      if (tok < NTOK) {
        if (mode == 0) {
#pragma unroll
          for (int q = 0; q < 4; ++q) { const f32x4 t = __builtin_nontemporal_load((const f32x4*)((const float*)(ws + WS_R2) + (size_t)tok * 1024 + q * 256 + c0)); v[u][4 * q] = t[0]; v[u][4 * q + 1] = t[1]; v[u][4 * q + 2] = t[2]; v[u][4 * q + 3] = t[3]; }
        } else {
#pragma unroll
          for (int q = 0; q < 4; ++q) { const f32x4 t = *(const f32x4*)(hin + (size_t)tok * 1024 + q * 256 + c0); v[u][4 * q] = ALPHA_F * t[0]; v[u][4 * q + 1] = ALPHA_F * t[1]; v[u][4 * q + 2] = ALPHA_F * t[2]; v[u][4 * q + 3] = ALPHA_F * t[3]; }
          const int a0 = assign[tok * 4], a1 = assign[tok * 4 + 1], a2 = assign[tok * 4 + 2], a3 = assign[tok * 4 + 3];
          gy0[u] = gate[tok * 2]; gy1[u] = gate[tok * 2 + 1];
          int p0 = 0, p1 = 0;
#pragma unroll
          for (int e = 0; e < NEXP; ++e) { if (e == a0) p0 = pad[e]; if (e == a2) p1 = pad[e]; }
          p0 += a1; p1 += a3;
          const bf16_t* Y = (const bf16_t*)(ws + WS_R2);
#pragma unroll
          for (int q = 0; q < 4; ++q) { const u32x2 y0 = __builtin_nontemporal_load((const u32x2*)(Y + (size_t)p0 * 1024 + q * 256 + c0)), y1 = __builtin_nontemporal_load((const u32x2*)(Y + (size_t)p1 * 1024 + q * 256 + c0));
            v[u][4 * q] += gy0[u] * __uint_as_float(y0.x << 16) + gy1[u] * __uint_as_float(y1.x << 16); v[u][4 * q + 1] += gy0[u] * __uint_as_float(y0.x & 0xffff0000u) + gy1[u] * __uint_as_float(y1.x & 0xffff0000u);
            v[u][4 * q + 2] += gy0[u] * __uint_as_float(y0.y << 16) + gy1[u] * __uint_as_float(y1.y << 16); v[u][4 * q + 3] += gy0[u] * __uint_as_float(y0.y & 0xffff0000u) + gy1[u] * __uint_as_float(y1.y & 0xffff0000u); }
        }
      } else {
#pragma unroll
        for (int j = 0; j < 16; ++j) v[u][j] = 0.f;
      }
    }
#pragma unroll
    for (int u = 0; u < 2; ++u) {
      const int tok = tok0 + u * tstride;
      float s = 0.f;
#pragma unroll
      for (int j = 0; j < 16; ++j) s += v[u][j];
      const float mean = wave_sum(s) * (1.0f / 1024.0f);
      float qq = 0.f;
#pragma unroll
      for (int j = 0; j < 16; ++j) { v[u][j] -= mean; qq += v[u][j] * v[u][j]; }
      const float r = 1.0f / sqrtf(wave_sum(qq) * (1.0f / 1024.0f) + LN_EPS_F);
#pragma unroll
      for (int j = 0; j < 16; ++j) v[u][j] = v[u][j] * r * gv[j] + bv[j];
      if (tok < NTOK) {
#pragma unroll
        for (int q = 0; q < 4; ++q) __builtin_nontemporal_store((f32x4){v[u][4 * q], v[u][4 * q + 1], v[u][4 * q + 2], v[u][4 * q + 3]}, (f32x4*)(hout + (size_t)tok * 1024 + q * 256 + c0));
        if (!(mode == 1 && layer == 1) && !dry) {
#pragma unroll
          for (int q = 0; q < 4; ++q) *(u32x2*)(hb + (size_t)tok * 1024 + q * 256 + c0) = (u32x2){pk2(v[u][4 * q], v[u][4 * q + 1]), pk2(v[u][4 * q + 2], v[u][4 * q + 3])}; }
      }
      if (mode == 0) {
        float lg[16];
#pragma unroll
        for (int e = 0; e < 16; ++e) { float a = 0.f;
#pragma unroll
          for (int q = 0; q < 4; ++q) { const f32x4 w = *(const f32x4*)(rwT + e * 1024 + q * 256 + c0); a += v[u][4 * q] * w[0] + v[u][4 * q + 1] * w[1] + v[u][4 * q + 2] * w[2] + v[u][4 * q + 3] * w[3]; }
          lg[e] = a; }
#pragma unroll
        for (int e = 0; e < 16; ++e) lg[e] = wave_sum(lg[e]);
        int eo[2]; float go[2];
        route_from_logits(lg, p.in[I_ROUTER_B], eo, go);
        if (c.lane == 0 && tok < NTOK && !dry) {
          const int r1 = atomicAdd(lcnt + eo[0], 1), r2 = atomicAdd(lcnt + eo[1], 1);
          const int ri = (it + u) * 8 + c.wid;
          rec[ri * 4] = eo[0]; rec[ri * 4 + 1] = r1; rec[ri * 4 + 2] = eo[1]; rec[ri * 4 + 3] = r2; recg[ri * 2] = go[0]; recg[ri * 2 + 1] = go[1];
        }
      }
    }
  }
  if (mode == 0 && !dry) {
    __syncthreads();
    if (c.tid < 16) lbase[c.tid] = (int)atomicAdd(cnt + c.tid * 16, (unsigned)lcnt[c.tid]);
    __syncthreads();
    const int nrec = ((NTOK + c.G * 8 - 1) / (c.G * 8)) * 8;
    for (int ri = c.tid; ri < nrec; ri += NTHREADS) {
      const int tok = c.bid * 8 + (ri & 7) + (ri >> 3) * c.G * 8;
      if (tok < NTOK) {
        const int e1 = rec[ri * 4], e2 = rec[ri * 4 + 2]; const int r1 = rec[ri * 4 + 1] + lbase[e1], r2 = rec[ri * 4 + 3] + lbase[e2];
        list[e1 * NTOK + r1] = tok; list[e2 * NTOK + r2] = tok;
        assign[tok * 4] = e1; assign[tok * 4 + 1] = r1; assign[tok * 4 + 2] = e2; assign[tok * 4 + 3] = r2;
        gate[tok * 2] = recg[ri * 2]; gate[tok * 2 + 1] = recg[ri * 2 + 1];
      }
    }
  }
  __syncthreads();
}
#endif
#ifndef CPU_EMU
namespace scan {
typedef short bf16x8 __attribute__((ext_vector_type(8)));
typedef float f32x4 __attribute__((ext_vector_type(4)));
typedef unsigned u32x4 __attribute__((ext_vector_type(4)));
typedef unsigned u32x2 __attribute__((ext_vector_type(2)));
enum { MIX_A = 0, MIX_B = 1, MIX_C = 2, MIX_D = 3 };
constexpr int LD_T = 144;
constexpr int OFF_QS = 0, OFF_KS = 17408, OFF_QI = 34816, OFF_KT = 52224, OFF_VT = 70656, OFF_SC = 77568, OFF_ST = 86784, OFF_DEC = 99840, OFF_EM = 100352, OFF_DEN = 100608, OFF_CW = 100864, SCAN_LDS = 104960;

__device__ __forceinline__ float incl_scan_add(float x) {
  x += __builtin_bit_cast(float, __builtin_amdgcn_update_dpp(0, __builtin_bit_cast(int, x), 0x111, 0xf, 0xf, false));
  x += __builtin_bit_cast(float, __builtin_amdgcn_update_dpp(0, __builtin_bit_cast(int, x), 0x112, 0xf, 0xf, false));
  x += __builtin_bit_cast(float, __builtin_amdgcn_update_dpp(0, __builtin_bit_cast(int, x), 0x114, 0xf, 0xf, false));
  x += __builtin_bit_cast(float, __builtin_amdgcn_update_dpp(0, __builtin_bit_cast(int, x), 0x118, 0xf, 0xf, false));
  x += __builtin_bit_cast(float, __builtin_amdgcn_update_dpp(0, __builtin_bit_cast(int, x), 0x142, 0xa, 0xf, false));
  x += __builtin_bit_cast(float, __builtin_amdgcn_update_dpp(0, __builtin_bit_cast(int, x), 0x143, 0xc, 0xf, false));
  return x;
}
__device__ __forceinline__ float incl_scan_max(float x) {
  const int ninf = (int)0xff800000u;
  x = fmaxf(x, __builtin_bit_cast(float, __builtin_amdgcn_update_dpp(ninf, __builtin_bit_cast(int, x), 0x111, 0xf, 0xf, false)));
  x = fmaxf(x, __builtin_bit_cast(float, __builtin_amdgcn_update_dpp(ninf, __builtin_bit_cast(int, x), 0x112, 0xf, 0xf, false)));
  x = fmaxf(x, __builtin_bit_cast(float, __builtin_amdgcn_update_dpp(ninf, __builtin_bit_cast(int, x), 0x114, 0xf, 0xf, false)));
  x = fmaxf(x, __builtin_bit_cast(float, __builtin_amdgcn_update_dpp(ninf, __builtin_bit_cast(int, x), 0x118, 0xf, 0xf, false)));
  x = fmaxf(x, __builtin_bit_cast(float, __builtin_amdgcn_update_dpp(ninf, __builtin_bit_cast(int, x), 0x142, 0xa, 0xf, false)));
  x = fmaxf(x, __builtin_bit_cast(float, __builtin_amdgcn_update_dpp(ninf, __builtin_bit_cast(int, x), 0x143, 0xc, 0xf, false)));
  return x;
}
__device__ __forceinline__ float rdlane(float x, int l) { return __builtin_bit_cast(float, __builtin_amdgcn_readlane(__builtin_bit_cast(int, x), l)); }
__device__ __forceinline__ bf16x8 ldfrag(const unsigned char* base, int ld, int row, int kbyte) { return *(const bf16x8*)(base + row * ld + kbyte); }
__device__ __forceinline__ bf16x8 ldfrag2(const unsigned char* base, int ld, int row, int b0, int b1) {
  const u32x2 lo = *(const u32x2*)(base + row * ld + b0), hi = *(const u32x2*)(base + row * ld + b1);
  return __builtin_bit_cast(bf16x8, (u32x4){lo.x, lo.y, hi.x, hi.y}); }
__device__ __forceinline__ unsigned pk(float a, float b) { return pk_hw(a, b); }
__device__ __forceinline__ float lo16(unsigned w) { return __uint_as_float(w << 16); }
__device__ __forceinline__ float hi16(unsigned w) { return __uint_as_float(w & 0xffff0000u); }

__device__ __forceinline__ void lds_barrier() { asm volatile("s_waitcnt lgkmcnt(0)" ::: "memory"); __builtin_amdgcn_s_barrier(); asm volatile("" ::: "memory"); }
struct Raw { u32x4 a0, a1, b0, b1; f32x4 r0, r1; u32x2 v; float s0, s1; };

}

__device__ __forceinline__ void convd_phase(unsigned char* lds_, int wv, const Params& p) {
  const Ctx c = make_ctx(lds_, wv);
  bf16_t* P = (bf16_t*)(p.ws + WS_R1); bf16_t* QD = (bf16_t*)(p.ws + WS_LFB);
  const float* cw = p.in[I_CONV_W]; const float* cb = p.in[I_CONV_B];
  const int ch = c.lane * 16;
  float w0[16], w1[16], w2[16], bb[16];
#pragma unroll
  for (int j = 0; j < 16; ++j) { w0[j] = cw[ch + j]; w1[j] = cw[1024 + ch + j]; w2[j] = cw[2048 + ch + j]; bb[j] = cb[ch + j]; }
  for (int tok = c.bid * 8 + c.wid; tok < NTOK; tok += c.G * 8) {
    const int t = tok % SEQ;
    const bf16_t* row = P + PIDX(tok, 1536 + ch);
    float x0[16], x1[16], x2[16];
    { const u32x4* r1 = (const u32x4*)row; unpack8(r1[0], x1); unpack8(r1[1], x1 + 8); }
    if (t > 0) { const u32x4* r0 = (const u32x4*)(row - 128); unpack8(r0[0], x0); unpack8(r0[1], x0 + 8); }
    else {
#pragma unroll
      for (int j = 0; j < 16; ++j) x0[j] = 0.f; }
    if (t < SEQ - 1) { const u32x4* r2 = (const u32x4*)(row + 128); unpack8(r2[0], x2); unpack8(r2[1], x2 + 8); }
    else {
#pragma unroll
      for (int j = 0; j < 16; ++j) x2[j] = 0.f; }
    const float sc = ch < 512 ? 0.08838834764831845f : 1.0f;
    unsigned w[8];
#pragma unroll
    for (int j = 0; j < 8; ++j) {
      const float a0 = bb[2 * j] + w0[2 * j] * x0[2 * j] + w1[2 * j] * x1[2 * j] + w2[2 * j] * x2[2 * j];
      const float a1 = bb[2 * j + 1] + w0[2 * j + 1] * x0[2 * j + 1] + w1[2 * j + 1] * x1[2 * j + 1] + w2[2 * j + 1] * x2[2 * j + 1];
      w[j] = pk2(fsilu(a0) * sc, fsilu(a1) * sc);
    }
    u32x4* d = (ch < 512) ? (u32x4*)(QD + PIDX(tok, ch)) : (u32x4*)(P + PIDX(tok, 3584 + (ch - 512)));
    d[0] = (u32x4){w[0], w[1], w[2], w[3]}; d[1] = (u32x4){w[4], w[5], w[6], w[7]};
  }
}

#endif
#ifndef CPU_EMU
namespace scan2 {
using namespace scan;
#ifndef PROBE_ALLTILES
#define PROBE_ALLTILES 0
#endif
__device__ __forceinline__ float FMUL(float a, float b) { float r = a * b; asm("" : "+v"(r)); return r; }
constexpr int U_QI = 0, U_KS = 34816, U_KT = 69632, U_VT = 106496, U_SC = 120320, U_ST = 129536, U_DEC = 155648, U_EM = 156672, U_END = 157184;
template <int MIXER>
__device__ __forceinline__ void scan_item2(unsigned char* lds, int wv, const Params& p, int b, int h, int dir, int vs) {
  constexpr int DK = (MIXER == MIX_A || MIXER == MIX_D) ? 128 : 64;
  constexpr int NC = DK / 8;
  constexpr int LD_D = DK * 2 + 16;
  constexpr int NVT = MIXER == MIX_D ? 3 : 2;
  constexpr int NKD = DK / 32;
  constexpr int NST = (DK == 128) ? NVT : 1;
  constexpr int NCH = SEQ / 64;
  const int tid = opaque_tid(wv), lane0 = tid & 63, wid = __builtin_amdgcn_readfirstlane(tid >> 6);
  unsigned char* ws = p.ws;
  const bf16_t* P = (const bf16_t*)(ws + WS_R1);
  const bf16_t* LFBp = (const bf16_t*)(ws + WS_LFB);
  const float* side = (const float*)(ws + WS_SIDE);
  const float* rope = (const float*)(ws + WS_ROPE);
  bf16_t* O = (bf16_t*)(ws + WS_R2) + (size_t)dir * NTOK * 1024;
  int qcol, kcol, lfcol, vcol, ocol;
  if (MIXER == MIX_A) { qcol = h * 128; kcol = 0; lfcol = 512 + dir * 512 + h * 128; vcol = 1536 + h * 128 + vs * 32; ocol = h * 128 + vs * 32; }
  else if (MIXER == MIX_B) { qcol = 2560 + h * 64; kcol = 2816 + h * 64; lfcol = dir * 256 + h * 64; vcol = 3072 + h * 128 + vs * 32; ocol = 512 + h * 128 + vs * 32; }
  else if (MIXER == MIX_C) { qcol = h * 64; kcol = 256 + h * 64; lfcol = 0; vcol = 512 + h * 128 + vs * 32; ocol = h * 128 + vs * 32; }
  else { qcol = h * 128; kcol = 3584 + h * 128; lfcol = 0; vcol = 2560 + h * 128 + vs * 32; ocol = 512 + h * 128 + vs * 32; }
  const size_t tokbase = (size_t)b * SEQ;
  const int c0 = (MIXER == MIX_C) ? wid * 4 : wid * NC;
  for (int i = tid; i < 2 * 13056 / 4; i += NTHREADS) ((unsigned*)(lds + U_ST))[i] = 0u;

  if (MIXER == MIX_D) { for (int i = tid; i < 2 * 16 * 64; i += NTHREADS) { const int bf = i >> 10, r = 32 + ((i >> 6) & 15), j = i & 63; *(bf16_t*)(lds + U_VT + bf * 6912 + r * LD_T + j * 2) = (r == 32) ? (bf16_t)0x3F80 : (bf16_t)0; } }
  const float lgam2 = (MIXER == MIX_C) ? log1pf(-exp2f(-(5.0f + 2.0f * (float)h + (float)dir))) * 1.4426950408889634f : 0.f;
  const float fgb = (MIXER == MIX_D) ? p.in[I_FGATE_B][dir * 4 + h] : 0.f;
  float m_st = 0.f;
  __syncthreads();

  Raw R, Rn; u32x2 Rv, Rvn;
#define A_LOAD(R, Rv, n_) do { \
    const int ln_ = lane0; \
    const int t_ = dir ? (SEQ - 1 - ((n_) * 64 + ln_)) : ((n_) * 64 + ln_); \
    const size_t tk_ = tokbase + t_; \
    if (MIXER == MIX_A) { const u32x4* qp_ = (const u32x4*)(P + PIDX(tk_, qcol + c0)); const u32x4* lp_ = (const u32x4*)(P + PIDX(tk_, lfcol + c0)); R.a0 = qp_[0]; R.a1 = qp_[1]; R.b0 = lp_[0]; R.b1 = lp_[1]; } \
    else if (MIXER == MIX_B) { R.a0 = *(const u32x4*)(P + PIDX(tk_, qcol + c0)); R.a1 = *(const u32x4*)(P + PIDX(tk_, kcol + c0)); R.b0 = *(const u32x4*)(LFBp + PIDX(tk_, lfcol + c0)); } \
    else if (MIXER == MIX_C) { const u32x2 qa_ = *(const u32x2*)(P + PIDX(tk_, qcol + c0)), qb_ = *(const u32x2*)(P + PIDX(tk_, qcol + 32 + c0)), ka_ = *(const u32x2*)(P + PIDX(tk_, kcol + c0)), kb_ = *(const u32x2*)(P + PIDX(tk_, kcol + 32 + c0)); \
      R.a0 = (u32x4){qa_.x, qa_.y, qb_.x, qb_.y}; R.a1 = (u32x4){ka_.x, ka_.y, kb_.x, kb_.y}; \
      R.r0 = *(const f32x4*)(rope + ((size_t)t_ * 32 + c0) * 2); R.r1 = *(const f32x4*)(rope + ((size_t)t_ * 32 + c0) * 2 + 4); } \
    else { const u32x4* qp_ = (const u32x4*)(LFBp + PIDX(tk_, qcol + c0)); const u32x4* kp_ = (const u32x4*)(P + PIDX(tk_, kcol + c0)); R.a0 = qp_[0]; R.a1 = qp_[1]; R.b0 = kp_[0]; R.b1 = kp_[1]; \
      R.s0 = side[tk_ * 32 + dir * 8 + h]; R.s1 = side[tk_ * 32 + dir * 8 + 4 + h]; } \
    Rv = *(const u32x2*)(P + PIDX(tk_, vcol + wid * 4)); } while (0)

  float rr_next = 1.f, rr_cur = 1.f;
#define A_PREP(buf_, R, Rv) do { \
    const int lane = lane0; \
    unsigned char* KTb = lds + U_KT + (buf_) * 18432; float* DECb = (float*)(lds + U_DEC + (buf_) * 512); float* EMb = (float*)(lds + U_EM + (buf_) * 256); \
    unsigned char* QIb = lds + U_QI + (buf_) * 17408; unsigned char* KSb = lds + U_KS + (buf_) * 17408; \
    float q[NC], k[NC], g[NC], ktv[NC]; \
    if (MIXER == MIX_A) { \
      const unsigned qw[8] = {R.a0.x, R.a0.y, R.a0.z, R.a0.w, R.a1.x, R.a1.y, R.a1.z, R.a1.w}, lw[8] = {R.b0.x, R.b0.y, R.b0.z, R.b0.w, R.b1.x, R.b1.y, R.b1.z, R.b1.w}; \
      _Pragma("unroll") for (int c = 0; c < 8; ++c) { q[2 * c] = lo16(qw[c]); q[2 * c + 1] = hi16(qw[c]); g[2 * c] = lo16(lw[c]); g[2 * c + 1] = hi16(lw[c]); } \
      _Pragma("unroll") for (int c = 0; c < NC; ++c) k[c] = 1.0f - __builtin_amdgcn_exp2f(g[c]); \
    } else if (MIXER == MIX_B) { \
      const unsigned qw[4] = {R.a0.x, R.a0.y, R.a0.z, R.a0.w}, kw[4] = {R.a1.x, R.a1.y, R.a1.z, R.a1.w}, lw[4] = {R.b0.x, R.b0.y, R.b0.z, R.b0.w}; \
      _Pragma("unroll") for (int c = 0; c < 4; ++c) { q[2 * c] = lo16(qw[c]); q[2 * c + 1] = hi16(qw[c]); k[2 * c] = lo16(kw[c]); k[2 * c + 1] = hi16(kw[c]); g[2 * c] = lo16(lw[c]); g[2 * c + 1] = hi16(lw[c]); } \
    } else if (MIXER == MIX_C) { \
      const float cs[4] = {R.r0[0], R.r0[2], R.r1[0], R.r1[2]}, sn[4] = {R.r0[1], R.r0[3], R.r1[1], R.r1[3]}; \
      const float q1[4] = {lo16(R.a0.x), hi16(R.a0.x), lo16(R.a0.y), hi16(R.a0.y)}, q2[4] = {lo16(R.a0.z), hi16(R.a0.z), lo16(R.a0.w), hi16(R.a0.w)}; \
      const float k1[4] = {lo16(R.a1.x), hi16(R.a1.x), lo16(R.a1.y), hi16(R.a1.y)}, k2[4] = {lo16(R.a1.z), hi16(R.a1.z), lo16(R.a1.w), hi16(R.a1.w)}; \
      _Pragma("unroll") for (int c = 0; c < 4; ++c) { q[c] = (q1[c] * cs[c] - q2[c] * sn[c]) * 0.125f; q[4 + c] = (q1[c] * sn[c] + q2[c] * cs[c]) * 0.125f; k[c] = k1[c] * cs[c] - k2[c] * sn[c]; k[4 + c] = k1[c] * sn[c] + k2[c] * cs[c]; } \
    } else { \
      const unsigned qw[8] = {R.a0.x, R.a0.y, R.a0.z, R.a0.w, R.a1.x, R.a1.y, R.a1.z, R.a1.w}, kw[8] = {R.b0.x, R.b0.y, R.b0.z, R.b0.w, R.b1.x, R.b1.y, R.b1.z, R.b1.w}; \
      _Pragma("unroll") for (int c = 0; c < 8; ++c) { q[2 * c] = lo16(qw[c]); q[2 * c + 1] = hi16(qw[c]); k[2 * c] = lo16(kw[c]); k[2 * c + 1] = hi16(kw[c]); } \
    } \
    if (MIXER == MIX_A || MIXER == MIX_B) { \
        \
      _Pragma("unroll") for (int c = 0; c < NC; ++c) g[c] += __builtin_bit_cast(float, __builtin_amdgcn_update_dpp(0, __builtin_bit_cast(int, g[c]), 0x111, 0xf, 0xf, false)); \
      _Pragma("unroll") for (int c = 0; c < NC; ++c) g[c] += __builtin_bit_cast(float, __builtin_amdgcn_update_dpp(0, __builtin_bit_cast(int, g[c]), 0x112, 0xf, 0xf, false)); \
      _Pragma("unroll") for (int c = 0; c < NC; ++c) g[c] += __builtin_bit_cast(float, __builtin_amdgcn_update_dpp(0, __builtin_bit_cast(int, g[c]), 0x114, 0xf, 0xf, false)); \
      _Pragma("unroll") for (int c = 0; c < NC; ++c) g[c] += __builtin_bit_cast(float, __builtin_amdgcn_update_dpp(0, __builtin_bit_cast(int, g[c]), 0x118, 0xf, 0xf, false)); \
      _Pragma("unroll") for (int c = 0; c < NC; ++c) g[c] += __builtin_bit_cast(float, __builtin_amdgcn_update_dpp(0, __builtin_bit_cast(int, g[c]), 0x142, 0xa, 0xf, false)); \
      _Pragma("unroll") for (int c = 0; c < NC; ++c) g[c] += __builtin_bit_cast(float, __builtin_amdgcn_update_dpp(0, __builtin_bit_cast(int, g[c]), 0x143, 0xc, 0xf, false)); \
      float ev[NC]; \
      _Pragma("unroll") for (int c = 0; c < NC; ++c) { \
          \
        const float e = __builtin_amdgcn_exp2f(g[c]), r = __builtin_amdgcn_rcpf(e); \
        const float e63 = rdlane(e, 63); \
        q[c] = FMUL(q[c], e); k[c] = FMUL(k[c], r); ktv[c] = FMUL(k[c], e63);     \
        ev[c] = e; } \
      if (lane == 63) { _Pragma("unroll") for (int c = 0; c < NC / 4; ++c) *(f32x4*)(DECb + c0 + 4 * c) = (f32x4){ev[4 * c], ev[4 * c + 1], ev[4 * c + 2], ev[4 * c + 3]}; } \
    } else if (MIXER == MIX_C) { \
        \
      const float gl = (float)(lane + 1) * lgam2; \
      const float e = __builtin_amdgcn_exp2f(gl), r = __builtin_amdgcn_rcpf(e); \
      const float e63 = rdlane(e, 63); const float f_kt = r * e63; \
      _Pragma("unroll") for (int c = 0; c < NC; ++c) { q[c] = FMUL(q[c], e); ktv[c] = FMUL(k[c], f_kt); k[c] = FMUL(k[c], r); } \
      if (lane < 4) { DECb[c0 + lane] = e63; DECb[32 + c0 + lane] = e63; } \
    } else { \
      const float li = R.s0, lf = R.s1;     \
      const float bc = incl_scan_add(lf); const float u = li - bc; const float pm = incl_scan_max(u); \
      const float cmax = rdlane(pm, 63), blast = rdlane(bc, 63); \
      const float a_i = bc + m_st, m_i = fmaxf(a_i, bc + pm); \
      const float d_alpha = __builtin_amdgcn_exp2f(bc - m_i + cmax), d_beta = __builtin_amdgcn_exp2f(u - cmax); \
      rr_next = __builtin_amdgcn_exp2f(m_st - cmax);     \
      const float m_new = fmaxf(blast + m_st, blast + cmax); \
      const float d_sold = __builtin_amdgcn_exp2f(blast + m_st - m_new), d_wks = __builtin_amdgcn_exp2f(blast + u - m_new); m_st = m_new; \
      _Pragma("unroll") for (int c = 0; c < NC; ++c) { ktv[c] = FMUL(k[c], d_wks); q[c] = FMUL(q[c], d_alpha); k[c] = FMUL(k[c], d_beta); if (lane == 63) DECb[c0 + c] = d_sold; } \
      if (wid == 0) EMb[lane] = __builtin_amdgcn_exp2f(-m_i); \
    } \
    _Pragma("unroll") for (int c = 0; c < NC / 2; ++c) { const unsigned w_ = pk_hw(ktv[2 * c], ktv[2 * c + 1]); \
      const int d0_ = (MIXER == MIX_C) ? (2 * c < 4 ? c0 + 2 * c : 32 + c0 + 2 * c - 4) : c0 + 2 * c; \
      *(bf16_t*)(KTb + d0_ * LD_T + lane * 2) = (bf16_t)(w_ & 0xffff); *(bf16_t*)(KTb + (d0_ + 1) * LD_T + lane * 2) = (bf16_t)(w_ >> 16); } \
    { unsigned pq[NC / 2], pks[NC / 2]; \
      _Pragma("unroll") for (int c = 0; c < NC / 2; ++c) { pq[c] = pk_hw(q[2 * c], q[2 * c + 1]); pks[c] = pk_hw(k[2 * c], k[2 * c + 1]); } \
      if (MIXER == MIX_C) { \
        *(u32x2*)(QIb + lane * LD_D + c0 * 2) = (u32x2){pq[0], pq[1]}; *(u32x2*)(QIb + lane * LD_D + (32 + c0) * 2) = (u32x2){pq[2], pq[3]}; \
        *(u32x2*)(KSb + lane * LD_D + c0 * 2) = (u32x2){pks[0], pks[1]}; *(u32x2*)(KSb + lane * LD_D + (32 + c0) * 2) = (u32x2){pks[2], pks[3]}; \
      } else { \
        _Pragma("unroll") for (int c = 0; c < NC / 8; ++c) { \
          *(u32x4*)(QIb + lane * LD_D + (c0 + 8 * c) * 2) = (u32x4){pq[4 * c], pq[4 * c + 1], pq[4 * c + 2], pq[4 * c + 3]}; \
          *(u32x4*)(KSb + lane * LD_D + (c0 + 8 * c) * 2) = (u32x4){pks[4 * c], pks[4 * c + 1], pks[4 * c + 2], pks[4 * c + 3]}; } } } \
    { unsigned char* VTb = lds + U_VT + (buf_) * 6912 + (wid * 4) * LD_T + lane * 2; \
      *(bf16_t*)(VTb + 0 * LD_T) = (bf16_t)(Rv.x & 0xffff); *(bf16_t*)(VTb + 1 * LD_T) = (bf16_t)(Rv.x >> 16); *(bf16_t*)(VTb + 2 * LD_T) = (bf16_t)(Rv.y & 0xffff); *(bf16_t*)(VTb + 3 * LD_T) = (bf16_t)(Rv.y >> 16); } \
  } while (0)
  f32x4 sacc[NST];
#pragma unroll
  for (int i = 0; i < NST; ++i) sacc[i] = (f32x4){0.f, 0.f, 0.f, 0.f};
  A_LOAD(R, Rv, 0);
  A_PREP(0, R, Rv);
  A_LOAD(R, Rv, 1);
  A_LOAD(Rn, Rvn, 2);
  rr_cur = rr_next;
  lds_barrier();
#define SCAN_ITER(n_, RX, RvX) do { const int n = (n_); \
    const int cb = n & 1, nb = (n + 1) & 1; \
    if (n + 1 < NCH) { A_PREP(nb, RX, RvX); if (n + 3 < NCH) A_LOAD(RX, RvX, n + 3); } \
    { { \
      const int lane = lane0; \
      const int fr = lane & 15, fq = lane >> 4; \
      const int it = wid & 3, vt = wid >> 2; \
      const unsigned char* STc = lds + U_ST + cb * 13056; unsigned char* STn = lds + U_ST + nb * 13056; \
      const unsigned char* KTc = lds + U_KT + cb * 18432; const unsigned char* VTc = lds + U_VT + cb * 6912; \
      const unsigned char* QI = lds + U_QI + cb * 17408; const unsigned char* KS = lds + U_KS + cb * 17408; \
      const float* DECc = (const float*)(lds + U_DEC + cb * 512); const float* EMc = (const float*)(lds + U_EM + cb * 256); \
      bf16x8 qf[NKD]; \
_Pragma("unroll") \
      for (int ks = 0; ks < NKD; ++ks) qf[ks] = ldfrag(QI, LD_D, it * 16 + fr, ks * 64 + fq * 16); \
        \
      u32x2 sp[4]; \
_Pragma("unroll") \
      for (int jt = 0; jt < 4; ++jt) { \
        sp[jt] = (u32x2){0u, 0u}; \
        if (PROBE_ALLTILES || jt <= it) { \
          f32x4 acc = (f32x4){0.f, 0.f, 0.f, 0.f}; \
_Pragma("unroll") \
          for (int ks = 0; ks < NKD; ++ks) acc = __builtin_amdgcn_mfma_f32_16x16x32_bf16(ldfrag(KS, LD_D, jt * 16 + fr, ks * 64 + fq * 16), qf[ks], acc, 0, 0, 0); \
          if (jt == it) { const int i = fr, j0 = fq * 4; \
            const float v0 = (j0 + 0 <= i) ? acc[0] : 0.f, v1 = (j0 + 1 <= i) ? acc[1] : 0.f, v2 = (j0 + 2 <= i) ? acc[2] : 0.f, v3 = (j0 + 3 <= i) ? acc[3] : 0.f; \
            sp[jt] = (u32x2){pk_hw(v0, v1), pk_hw(v2, v3)}; } \
          else if (jt < it) sp[jt] = (u32x2){pk_hw(acc[0], acc[1]), pk_hw(acc[2], acc[3])}; \
          else asm volatile("" :: "v"(acc)); \
        } \
      } \
        \
        \
      const u32x4 sb0 = (u32x4){sp[0].x, sp[0].y, sp[1].x, sp[1].y}, sb1 = (u32x4){sp[2].x, sp[2].y, sp[3].x, sp[3].y}; \
      f32x4 oacc = (f32x4){0.f, 0.f, 0.f, 0.f}, dacc = (f32x4){0.f, 0.f, 0.f, 0.f}; \
_Pragma("unroll") \
      for (int ks = 0; ks < NKD; ++ks) oacc = __builtin_amdgcn_mfma_f32_16x16x32_bf16(ldfrag(STc, LD_D, vt * 16 + fr, ks * 64 + fq * 16), qf[ks], oacc, 0, 0, 0); \
      if (NVT == 3) { \
_Pragma("unroll") \
        for (int ks = 0; ks < NKD; ++ks) dacc = __builtin_amdgcn_mfma_f32_16x16x32_bf16(ldfrag(STc, LD_D, 32 + fr, ks * 64 + fq * 16), qf[ks], dacc, 0, 0, 0); \
      } \
      if (MIXER == MIX_D) { _Pragma("unroll") for (int e_ = 0; e_ < 4; ++e_) { oacc[e_] = FMUL(oacc[e_], rr_cur); dacc[e_] = FMUL(dacc[e_], rr_cur); } } \
      oacc = __builtin_amdgcn_mfma_f32_16x16x32_bf16(ldfrag2(VTc, LD_T, vt * 16 + fr, fq * 8, 32 + fq * 8), __builtin_bit_cast(bf16x8, sb0), oacc, 0, 0, 0); \
      if (it >= 2) oacc = __builtin_amdgcn_mfma_f32_16x16x32_bf16(ldfrag2(VTc, LD_T, vt * 16 + fr, 64 + fq * 8, 96 + fq * 8), __builtin_bit_cast(bf16x8, sb1), oacc, 0, 0, 0); \
      float dn = 1.0f; \
      if (NVT == 3) { \
        dacc = __builtin_amdgcn_mfma_f32_16x16x32_bf16(ldfrag2(VTc, LD_T, 32 + fr, fq * 8, 32 + fq * 8), __builtin_bit_cast(bf16x8, sb0), dacc, 0, 0, 0); \
        if (it >= 2) dacc = __builtin_amdgcn_mfma_f32_16x16x32_bf16(ldfrag2(VTc, LD_T, 32 + fr, 64 + fq * 8, 96 + fq * 8), __builtin_bit_cast(bf16x8, sb1), dacc, 0, 0, 0); \
        const float den = __shfl(dacc[0], fr); \
        dn = 1.0f / fmaxf(fabsf(den), EMc[it * 16 + fr]); \
      } \
      { \
        const int i = it * 16 + fr; \
        const int ti = dir ? (SEQ - 1 - (n * 64 + i)) : (n * 64 + i); \
        const f32x4 o = (f32x4){FMUL(oacc[0], dn), FMUL(oacc[1], dn), FMUL(oacc[2], dn), FMUL(oacc[3], dn)}; \
        *(u32x2*)(O + PIDX(tokbase + ti, ocol + vt * 16 + fq * 4)) = (u32x2){pk_hw(o[0], o[1]), pk_hw(o[2], o[3])}; \
      } \
      const int dts = (DK == 128) ? wid : (wid & 3); \
      const bf16x8 kf0 = ldfrag(KTc, LD_T, dts * 16 + fr, fq * 16), kf1 = ldfrag(KTc, LD_T, dts * 16 + fr, 64 + fq * 16); \
      const f32x4 dc = *(const f32x4*)(DECc + dts * 16 + fq * 4); \
_Pragma("unroll") \
      for (int s = 0; s < NST; ++s) { \
        const int dt = dts, vt2 = (DK == 128) ? s : (wid >> 2); \
        f32x4 acc = (f32x4){FMUL(sacc[s][0], dc[0]), FMUL(sacc[s][1], dc[1]), FMUL(sacc[s][2], dc[2]), FMUL(sacc[s][3], dc[3])}; \
        acc = __builtin_amdgcn_mfma_f32_16x16x32_bf16(kf0, ldfrag(VTc, LD_T, vt2 * 16 + fr, fq * 16), acc, 0, 0, 0); \
        acc = __builtin_amdgcn_mfma_f32_16x16x32_bf16(kf1, ldfrag(VTc, LD_T, vt2 * 16 + fr, 64 + fq * 16), acc, 0, 0, 0); \
        sacc[s] = acc; \
        *(u32x2*)(STn + (vt2 * 16 + fr) * LD_D + (dt * 16 + fq * 4) * 2) = (u32x2){pk_hw(acc[0], acc[1]), pk_hw(acc[2], acc[3])}; \
      } \
    } \
    } \
    rr_cur = rr_next; \
    lds_barrier(); \
  } while (0)
  static_assert(NCH % 2 == 0, "chunk count must be even");
#pragma unroll 1
  for (int n2 = 0; n2 < NCH; n2 += 2) { SCAN_ITER(n2, R, Rv); SCAN_ITER(n2 + 1, Rn, Rvn); }
#undef SCAN_ITER
#undef A_LOAD
#undef A_PREP
}

template <int MIXER>
__device__ __forceinline__ void scan_dispatch2(unsigned char* lds, int wv, const Params& p, int id) {
  const int vs = id & 3, dir = (id >> 2) & 1, h = (id >> 3) & 3, b = id >> 5;
  scan_item2<MIXER>(lds, wv, p, b, h, dir, vs);
}
}

__device__ __forceinline__ void scan_phase2(unsigned char* lds, int wv, const Params& p, int layer, int convert) {
  bool light = false;
  for (int it0 = blockIdx.x; it0 < 256; it0 += gridDim.x) {
    const int xq = it0 & 7, yq = it0 >> 3, stream = (yq >> 2) * 8 + xq;
    const int item = (stream >> 5) * 128 + (stream & 31) * 4 + (yq & 3);
    if (layer == 0) { if (item < 128) scan2::scan_dispatch2<scan::MIX_A>(lds, wv, p, item); else scan2::scan_dispatch2<scan::MIX_B>(lds, wv, p, item - 128); }
    else { if (item < 128) scan2::scan_dispatch2<scan::MIX_D>(lds, wv, p, item); else scan2::scan_dispatch2<scan::MIX_C>(lds, wv, p, item - 128); }
    light = item >= 128;
    __syncthreads();
  }
  if (convert) {
    const int G = gridDim.x, b = blockIdx.x;
    if (G == 256) { if (light) { moe_weight_convert(lds, wv, p, layer, 0, b - 128, 128); if (p.big_ws) moe_weight_convert(lds, wv, p, layer, 1, b - 128, 128); } }
    else { moe_weight_convert(lds, wv, p, layer, 0, b, G); if (p.big_ws) moe_weight_convert(lds, wv, p, layer, 1, b, G); }
  }
}
#endif
#ifndef CPU_EMU
#define XB_BASE     2048
#define XB_TMO      (XB_BASE + 128)
#define XB_XCNT(j)  (XB_BASE + 256  + 64 * (j))
#define XB_XSUB(j)  (XB_BASE + 1280 + 64 * (j))
#define XB_XGEN(j)  (XB_BASE + 2304 + 64 * (j))
#define XB_TOP      (XB_BASE + 3328)
#define XB_TOPGEN   (XB_BASE + 3392)
#define XB_WORDS    3456
#define XB_SPIN_CAP (1u << 22)
#define XB_LDS_OFF  (LDS_BYTES - 16)
__device__ __forceinline__ unsigned xb_ld(unsigned* p)              { return __hip_atomic_load(p, __ATOMIC_RELAXED, __HIP_MEMORY_SCOPE_AGENT); }
__device__ __forceinline__ unsigned xb_add(unsigned* p, unsigned v) { return __hip_atomic_fetch_add(p, v, __ATOMIC_RELAXED, __HIP_MEMORY_SCOPE_AGENT); }
__device__ __forceinline__ unsigned xb_xcc_id() { return (unsigned)__builtin_amdgcn_s_getreg((3 << 11) | 20) & 0xFu; }
#define XB_SPIN(cond, bar) do { unsigned _sp = 0; while (cond) { __builtin_amdgcn_s_sleep(1); \
    if ((++_sp & 255u) == 0u) { if (xb_ld(&(bar)[XB_TMO])) break; if (_sp > XB_SPIN_CAP) { atomicAdd(&(bar)[XB_TMO], 1u); break; } } } } while (0)
__device__ __forceinline__ void grid_bar(unsigned* bar, unsigned char* lds_raw, int wv) {
  asm volatile("s_waitcnt vmcnt(0)" ::: "memory");
  __syncthreads();
  if (wv == 0 && lane_id() == 0) {
    volatile unsigned* st = (volatile unsigned*)(lds_raw + XB_LDS_OFF);
    __builtin_amdgcn_s_waitcnt(0);
    const unsigned x = xb_xcc_id();
    unsigned nloc = st[0], nx = st[1];
    if (nloc == 0u) {
      const unsigned G = gridDim.x; unsigned sum, cnt, mine, sp = 0u;
      for (;;) { sum = 0u; cnt = 0u; mine = 0u;
#pragma unroll
        for (unsigned j = 0; j < 16; ++j) { const unsigned c = xb_ld(&bar[XB_XCNT(j)]); sum += c; cnt += (c > 0u) ? 1u : 0u; mine = (j == x) ? c : mine; }
        if (sum == G) break;
        __builtin_amdgcn_s_sleep(1);
        if ((++sp & 255u) == 0u) { if (xb_ld(&bar[XB_TMO])) break; if (sp > XB_SPIN_CAP) { atomicAdd(&bar[XB_TMO], 1u); break; } } }
      nloc = mine > 0u ? mine : 1u; nx = cnt > 0u ? cnt : 1u; st[0] = nloc; st[1] = nx;
    }
    const unsigned old = xb_add(&bar[XB_XSUB(x)], 1u);
    const unsigned gen = old / nloc;
    if (old + 1u == (gen + 1u) * nloc) {
      __builtin_amdgcn_fence(__ATOMIC_RELEASE, "agent");
      asm volatile("s_waitcnt vmcnt(0)" ::: "memory");
      const unsigned og = xb_add(&bar[XB_TOP], 1u);
      const unsigned tg = og / nx;
      if (og + 1u == (tg + 1u) * nx) xb_add(&bar[XB_TOPGEN], 1u);
      else XB_SPIN(xb_ld(&bar[XB_TOPGEN]) == tg, bar);
      __builtin_amdgcn_fence(__ATOMIC_ACQUIRE, "agent");
      xb_add(&bar[XB_XGEN(x)], 1u);
      asm volatile("s_waitcnt vmcnt(0)" ::: "memory");
    } else {
      XB_SPIN(xb_ld(&bar[XB_XGEN(x)]) == gen, bar);
      __builtin_amdgcn_fence(__ATOMIC_ACQUIRE, "agent");
      asm volatile("s_waitcnt vmcnt(0)" ::: "memory");
    }
  }
  __syncthreads();
}
#if (PROBE_DUP & 16)
#define grid_bar(a, b, c) do { grid_bar(a, b, c); grid_bar(a, b, c); } while (0)
#endif

__global__ void __launch_bounds__(NTHREADS) mk_fwd(Params p) {
  extern __shared__ __attribute__((aligned(16))) unsigned char lds_raw[];
  cg::grid_group grid = cg::this_grid();
  const int G = gridDim.x, bid = blockIdx.x;
  const int wv = __builtin_amdgcn_readfirstlane(threadIdx.x >> 6);
  PG8_LAS unsigned char* lds = (PG8_LAS unsigned char*)lds_raw;
  unsigned char* ws = p.ws;

  if (threadIdx.x < 4) ((unsigned*)(lds_raw + XB_LDS_OFF))[threadIdx.x] = 0u;
  p0_prologue(lds_raw, wv, p);
#if (PROBE_DUP & 128)
  p0_prologue(lds_raw, wv, p);
#endif
  grid.sync();
  unsigned* bar = (unsigned*)(ws + WS_CTL);
  if (wv == 0 && lane_id() == 0) (void)xb_add(&bar[XB_XCNT(xb_xcc_id())], 1u);
  for (int layer = 0; layer < 2; ++layer) {
    { ProbInProj pr; pr.so.init(NTOK, layer == 0 ? PM_AB : PM_CD, G, bid); pr.A = (const char*)(ws + WS_HB); pr.Bt = (const char*)(ws + (layer == 0 ? WS_WIN_AB : WS_WIN_CD));
      pr.P = (bf16_t*)(ws + WS_R1); pr.bias = p.in[layer == 0 ? I_AB_B_IN : I_CD_B_IN]; pr.lb = (const float*)(ws + WS_LB); pr.layer = layer;
      pg8::gemm_phase(lds, pr, wv);
#if (PROBE_DUP & (1 | 2048))
      pg8::gemm_phase(lds, pr, wv);
#endif
      if (layer == 0) side_phase<32>(lds_raw, wv, p, 0); else side_phase<16>(lds_raw, wv, p, 1);
#if (PROBE_DUP & 256)
      if (layer == 0) side_phase<32>(lds_raw, wv, p, 0); else side_phase<16>(lds_raw, wv, p, 1);
#endif
 }
    grid_bar(bar, lds_raw, wv);
    if (layer == 1) { convd_phase(lds_raw, wv, p); grid_bar(bar, lds_raw, wv); }
    scan_phase2(lds_raw, wv, p, layer, 1);
#if (PROBE_DUP & 2)
    scan_phase2(lds_raw, wv, p, layer, 0);
#endif
#if (PROBE_DUP & 512)
    if (layer == 0) scan_phase2(lds_raw, wv, p, layer, 0);
#endif
#if (PROBE_DUP & 1024)
    if (layer == 1) scan_phase2(lds_raw, wv, p, layer, 0);
#endif
    grid_bar(bar, lds_raw, wv);
    headnorm_phase(lds_raw, wv, p, layer);
#if (PROBE_DUP & 8)
    headnorm_phase(lds_raw, wv, p, layer);
#endif
    grid_bar(bar, lds_raw, wv);
    { ProbOutProj pr; pr.so.init(NTOK, 1024, G, bid); pr.A = (const char*)(ws + WS_MIX); pr.Bt = (const char*)(ws + (layer == 0 ? WS_WOUT_AB : WS_WOUT_CD)); pr.Y = (float*)(ws + WS_R2); pr.Hres = layer == 0 ? p.in[I_X] : p.out;
      pg8::gemm_phase(lds, pr, wv);
#if (PROBE_DUP & (1 | 16384))
      pg8::gemm_phase(lds, pr, wv);
#endif
      if (!p.big_ws) moe_weight_convert(lds_raw, wv, p, layer, 1, bid, G);
 }
    grid_bar(bar, lds_raw, wv);
#if (PROBE_DUP & 32)
    ln_phase(lds_raw, wv, p, layer, 0, 1);
#endif
    ln_phase(lds_raw, wv, p, layer, 0);
    grid_bar(bar, lds_raw, wv);
    { ProbMoe1 pr; pr.mo.init((const int*)((const unsigned*)(ws + WS_CTL) + CW_CNT(layer)), 8, G, bid, lds_raw, wv);
      pr.A = (const char*)(ws + WS_MIX); pr.W13 = (const char*)(ws + WS_W13); pr.list = (const int*)(ws + WS_LIST) + (size_t)layer * NEXP * NTOK; pr.H = (bf16_t*)(ws + WS_H);
      pg8::gemm_phase(lds, pr, wv);
#if (PROBE_DUP & (1 | 4096))
      pg8::gemm_phase(lds, pr, wv);
#endif
 }
    grid_bar(bar, lds_raw, wv);
    { ProbMoe2 pr; pr.mo.init((const int*)((const unsigned*)(ws + WS_CTL) + CW_CNT(layer)), 4, G, bid, lds_raw, wv);
      pr.A = (const char*)(ws + WS_H); pr.W2 = (const char*)(ws + (p.big_ws ? WS_W2X : WS_W2)); pr.Y = (bf16_t*)(ws + WS_R2);
      pg8::gemm_phase(lds, pr, wv);
#if (PROBE_DUP & (1 | 8192))
      pg8::gemm_phase(lds, pr, wv);
#endif
 }
    grid_bar(bar, lds_raw, wv);
#if (PROBE_DUP & 64)
    ln_phase(lds_raw, wv, p, layer, 1, 1);
#endif
    ln_phase(lds_raw, wv, p, layer, 1);
    if (layer == 0) grid_bar(bar, lds_raw, wv);
  }
}

extern "C" void kernel_launch(void* const* d_in, const int* in_sizes, int n_in, void* d_out, int out_size, void* d_ws, size_t ws_size, hipStream_t stream) {
  static int grid_blocks = 0;
  if (grid_blocks == 0) {
    if (n_in != N_IN || ws_size < WS_END || out_size != NTOK * 1024) { fprintf(stderr, "kernel_launch: bad shapes: n_in %d ws %zu (need %zu) out %d\n", n_in, ws_size, (size_t)WS_END, out_size); grid_blocks = -1; return; }
    int dev = 0, cus = 0, per_cu = 0;
    hipGetDevice(&dev); hipDeviceGetAttribute(&cus, hipDeviceAttributeMultiprocessorCount, dev);
    if (hipFuncSetAttribute((const void*)mk_fwd, hipFuncAttributeMaxDynamicSharedMemorySize, LDS_BYTES) != hipSuccess) { fprintf(stderr, "kernel_launch: hipFuncSetAttribute failed\n"); grid_blocks = -1; return; }
    if (hipOccupancyMaxActiveBlocksPerMultiprocessor(&per_cu, (const void*)mk_fwd, NTHREADS, LDS_BYTES) != hipSuccess || per_cu < 1) { fprintf(stderr, "kernel_launch: occupancy query failed (%d)\n", per_cu); grid_blocks = -1; return; }
    grid_blocks = cus;
    (void)in_sizes;
  }
  if (grid_blocks < 0) return;
  Params p{};
  for (int i = 0; i < N_IN; ++i) p.in[i] = (const float*)d_in[i];
  p.out = (float*)d_out; p.ws = (unsigned char*)d_ws; p.big_ws = ws_size >= (size_t)WS_END_BIG ? 1 : 0;
  void* args[] = {&p};
  hipError_t e = hipLaunchCooperativeKernel((const void*)mk_fwd, dim3(grid_blocks), dim3(NTHREADS), args, LDS_BYTES, stream);
  if (e != hipSuccess) fprintf(stderr, "cooperative launch failed: %s (grid %d)\n", hipGetErrorString(e), grid_blocks);
}
#endif
```

```cpp
#ifdef CPU_EMU
#include <cmath>
#include <cstdio>
#include <cstring>
#include <cstdlib>
#include <cstddef>
#define DEV
#define DEV_INLINE static inline
typedef void* hipStream_t;
#else
#include <hip/hip_runtime.h>
#include <hip/hip_bf16.h>
#include <cstdio>
#define DEV __device__ __forceinline__
#define DEV_INLINE __device__ __forceinline__
#endif
#ifndef PROBE_DUP
#define PROBE_DUP 0
#endif
#ifndef BATCH
#define BATCH 4
#endif
#ifndef SEQ
#define SEQ 8192
#endif
#define DM 1024
#define NTOK (BATCH * SEQ)
#define P_AB 4128
#define P_CD 3600
#define PM_AB 4096
#define PM_CD 3584
#define NEXP 16
#define ALPHA_F 1.4142135623730951f
#define LN_EPS_F 1e-5f
#define NORM_EPS_F 1e-6f
#define HROWS (2 * NTOK + NEXP * 256)

typedef unsigned short bf16_t;

DEV_INLINE float bf2f(bf16_t b) { unsigned u = ((unsigned)b) << 16; float f; memcpy(&f, &u, 4); return f; }
DEV_INLINE bf16_t f2bf(float f) { unsigned u; memcpy(&u, &f, 4); u += 0x7FFFu + ((u >> 16) & 1u); return (bf16_t)(u >> 16); }
DEV_INLINE float sigmoidf_(float x) { return 1.0f / (1.0f + expf(-x)); }
DEV_INLINE float siluf_(float x) { return x / (1.0f + expf(-x)); }
DEV_INLINE float logsigmoidf_(float x) { return fminf(x, 0.0f) - log1pf(expf(-fabsf(x))); }

#define AL256(x) (((size_t)(x) + 255) & ~(size_t)255)
#define WS_CTL    ((size_t)0)
#define WS_HB     ((size_t)65536)
#define WS_R1     (WS_HB + (size_t)NTOK * 1024 * 2)
#define R1_P_BYTES ((size_t)NTOK * 4096 * 2)
#define R1_MIN    ((size_t)NTOK * 1024 * 2 + AL256((size_t)HROWS * 1024 * 2))
#define R1_PL     (R1_P_BYTES + (size_t)NTOK * 512 * 2)
#define R1_BYTES  (R1_PL > R1_MIN ? R1_PL : R1_MIN)
#define WS_LFB    (WS_R1 + R1_P_BYTES)
#define WS_MIX    (WS_R1)
#define WS_H      (WS_R1 + (size_t)NTOK * 1024 * 2)
#define WS_W13    (WS_HB)
#define WS_W2     (WS_LFB)
#define WMOE_BYTES ((size_t)NEXP * 3072 * 1024 * 2)
#define WS_R2     (WS_R1 + R1_BYTES)
#define R2_BYTES  ((size_t)HROWS * 1024 * 2 > (size_t)NTOK * 1024 * 4 ? (size_t)HROWS * 1024 * 2 : (size_t)NTOK * 1024 * 4)
#define WS_SIDE   (WS_R2 + AL256(R2_BYTES))
#define WS_WIN_AB (WS_SIDE + (size_t)NTOK * 32 * 4)
#define WS_WIN_CD (WS_WIN_AB + (size_t)4128 * 1024 * 2)
#define WS_WOUT_AB (WS_WIN_CD + (size_t)3600 * 1024 * 2)
#define WS_WOUT_CD (WS_WOUT_AB + (size_t)1024 * 1024 * 2)
#define WS_ROPE   (WS_WOUT_CD + (size_t)1024 * 1024 * 2)
#define WS_LB     (WS_ROPE + (size_t)SEQ * 64 * 4)
#define WS_LIST   (WS_LB + 4096)
#define WS_ASSIGN (WS_LIST + (size_t)2 * NEXP * NTOK * 4)
#define WS_GATE   (WS_ASSIGN + (size_t)NTOK * 16)
#define WS_END    (WS_GATE + (size_t)NTOK * 8)
#define WS_W2X    (AL256(WS_END))
#define WS_END_BIG (WS_W2X + (size_t)NEXP * 1024 * 1024 * 2)
#define CW_CNT(layer) (64 + 256 * (layer))

#define PSTRIDE 4096
#define PIDX(tok, col) ((((size_t)((col) >> 7)) * NTOK + (size_t)(tok)) * 128 + (size_t)((col) & 127))

enum { I_X, I_AB_W_IN, I_AB_B_IN, I_HGRN_LB, I_GK_UP, I_GK_B, I_HGRN_NORM, I_GLA_NORM, I_AB_W_OUT,
       I_CD_W_IN, I_CD_B_IN, I_CONV_W, I_CONV_B, I_FGATE_B, I_RET_NORM, I_MLSTM_NORM, I_CD_W_OUT,
       I_LN_MIX_G, I_LN_MIX_B, I_LN_FFN_G, I_LN_FFN_B, I_ROUTER_W, I_ROUTER_B, I_MOE_W1, I_MOE_W3, I_MOE_W2, N_IN };

struct Params {
  const float* in[N_IN];
  float* out;
  unsigned char* ws;
  long long big_ws;
};

DEV_INLINE float epi_ab(int col, float v, const float* lb) {
  if (col < 512) return siluf_(v);
  if (col < 1536) { float l = lb[(col - 512) & 511]; return logf(l + (1.0f - l) * sigmoidf_(v)); }
  if (col >= 2560 && col < 2816) return v * 0.125f;
  return v;
}

DEV_INLINE void route_from_logits(const float* lg, const float* rb, int* e_out, float* g_out) {
  float mx = lg[0];
#pragma unroll
  for (int e = 1; e < 16; ++e) mx = fmaxf(mx, lg[e]);
  float sc[16]; float sum = 0.f;
#pragma unroll
  for (int e = 0; e < 16; ++e) { sc[e] = expf(lg[e] - mx); sum += sc[e]; }
  float inv = 1.0f / sum;
  float best_gs = -1e30f; int be1 = 0, be2 = 1; float bs1 = 0.f, bs2 = 0.f;
#pragma unroll
  for (int gq = 0; gq < 4; ++gq) {
    float m1 = -1e30f, m2 = -1e30f, s1 = 0.f, s2 = 0.f; int i1 = 0, i2 = 0;
#pragma unroll
    for (int i = 0; i < 4; ++i) {
      float s = sc[gq * 4 + i] * inv; float v = s + rb[gq * 4 + i];
      if (v > m1) { m2 = m1; i2 = i1; s2 = s1; m1 = v; i1 = gq * 4 + i; s1 = s; }
      else if (v > m2) { m2 = v; i2 = gq * 4 + i; s2 = s; }
    }
    float gs = m1 + m2;
    if (gs > best_gs) { best_gs = gs; be1 = i1; be2 = i2; bs1 = s1; bs2 = s2; }
  }
  e_out[0] = be1; e_out[1] = be2; g_out[0] = bs1 / (bs1 + bs2); g_out[1] = bs2 / (bs1 + bs2);
}
#ifndef CPU_EMU
namespace pg8 {
#define PG8_LAS __attribute__((address_space(3)))
typedef short bf16x8 __attribute__((ext_vector_type(8)));
typedef float f32x4 __attribute__((ext_vector_type(4)));
typedef unsigned u32x4 __attribute__((ext_vector_type(4)));
typedef unsigned u32x2 __attribute__((ext_vector_type(2)));
constexpr int BM = 256, BK = 64, HALF = 128, HTB = HALF * BK * 2, STAGE_BYTES = 8 * HTB, NXCD = 8, WGM = 8, GK = 1024;

__device__ __forceinline__ int lds_byte(int r, int c) { const int st = (r >> 4) * 2 + (c >> 5), rr = r & 15, cc = c & 31, ob = rr * 64 + cc * 2; return st * 1024 + (ob ^ (((ob >> 9) & 1) << 5)); }
__device__ __forceinline__ void stage_rc(int b, int& R, int& C) { const int st = b / 1024, sb = b % 1024, swz = sb ^ (((sb >> 9) & 1) << 5); R = (st >> 1) * 16 + swz / 64; C = (st & 1) * 32 + (swz % 64) / 2; }
__device__ __forceinline__ int perm32(int rho) { const int n = rho >> 4, i = rho & 15; return 8 * (i >> 2) + 4 * n + (i & 3); }
__device__ __forceinline__ unsigned cvt_pk_bf16(float lo, float hi) { unsigned r; asm volatile("v_cvt_pk_bf16_f32 %0, %1, %2" : "=v"(r) : "v"(lo), "v"(hi)); return r; }

struct Unit { int pm, pn, e, row0, ne, ui; };

struct StaticOrder {
  int nM, nN, nwg, G, c;
  __device__ void init(int M, int N, int G_, int c_) { nM = M / BM; nN = N / BM; nwg = nM * nN; G = G_; c = c_; }
  __device__ bool next(int i, Unit& u) const {
    const long L = (long)i * G + c; if (L >= nwg) return false;
    int wgid = (int)L; { const int q = nwg / NXCD, r = nwg % NXCD, xcd = wgid % NXCD, off = wgid / NXCD; wgid = (xcd < r ? xcd * (q + 1) : r * (q + 1) + (xcd - r) * q) + off; }
    const int nig = WGM * nN, gid = wgid / nig, fm = gid * WGM, gsz = (nM - fm) < WGM ? (nM - fm) : WGM;
    u.pm = fm + ((wgid % nig) % gsz); u.pn = (wgid % nig) / gsz; u.e = 0; u.row0 = u.pm * BM; u.ne = 0; u.ui = i; return true;
  }
};

template <class Prob>
__device__ __forceinline__ void gemm_phase(PG8_LAS unsigned char* lds, const Prob& S, int wv) {
  int wv_ = wv; asm volatile("" : "+s"(wv_));
  int l_; asm volatile("v_mbcnt_lo_u32_b32 %0, -1, 0\n\tv_mbcnt_hi_u32_b32 %0, -1, %0" : "=v"(l_));
  int tid_ = wv_ * 64 + l_;
  const int tid = tid_, wid = __builtin_amdgcn_readfirstlane(tid >> 6), lane = tid & 63, wr = wid >> 2, wc = wid & 3, fr = lane & 15, fq = lane >> 4;
  constexpr int K = GK, nt = K / BK;
  int sR[2], sC[2]; unsigned voffB[2];
#pragma unroll
  for (int i = 0; i < 2; ++i) { int R, C; stage_rc(tid * 16 + i * 8192, R, C); sR[i] = R; sC[i] = C; const int Rb = Prob::PERM ? ((R & ~31) + perm32(R & 31)) : R; voffB[i] = (unsigned)(Rb * K + C) * 2u; }
  const size_t kstep = (size_t)(BK * 2);
  const size_t hstep = (size_t)HALF * K * 2;
  const unsigned ldsw = (unsigned)wid * 1024u;
  const int aoff = lds_byte(wr * 64 + fr, fq * 8), boff = lds_byte(wc * 32 + fr, fq * 8);
#define PG8_SA(b, h) (((b) * 2 + (h)) * HTB)
#define PG8_SB(b, h) ((4 + (b) * 2 + (h)) * HTB)
#define PG8_STAGE(bufoff, gbase, voff) do { _Pragma("unroll") for (int _i = 0; _i < 2; ++_i) \
    __builtin_amdgcn_global_load_lds((const unsigned*)((const char*)(gbase) + (voff)[_i]), (PG8_LAS unsigned*)(lds + (bufoff) + ldsw + _i * 8192), 16, 0, 0); } while (0)
#define PG8_LDA(dst, b, h) do { _Pragma("unroll") for (int m = 0; m < 4; ++m) _Pragma("unroll") for (int k = 0; k < 2; ++k) dst[m][k] = *(const PG8_LAS bf16x8*)(lds + PG8_SA(b, h) + aoff + m * 2048 + k * 1024); } while (0)
#define PG8_LDB(dst, b, h) do { _Pragma("unroll") for (int n = 0; n < 2; ++n) _Pragma("unroll") for (int k = 0; k < 2; ++k) dst[n][k] = *(const PG8_LAS bf16x8*)(lds + PG8_SB(b, h) + boff + n * 2048 + k * 1024); } while (0)
#define PG8_MMA(ai, bj, At, Bt) do { __builtin_amdgcn_s_setprio(1); _Pragma("unroll") for (int m = 0; m < 4; ++m) _Pragma("unroll") for (int n = 0; n < 2; ++n) _Pragma("unroll") for (int k = 0; k < 2; ++k) \
    acc[ai][bj][m][n] = __builtin_amdgcn_mfma_f32_16x16x32_bf16(Bt[n][k], At[m][k], acc[ai][bj][m][n], 0, 0, 0); __builtin_amdgcn_s_setprio(0); } while (0)
#define PG8_WAIT_V(n) asm volatile("s_waitcnt vmcnt(" #n ")" ::: "memory")
#define PG8_WAIT_L(n) asm volatile("s_waitcnt lgkmcnt(" #n ")" ::: "memory")
#define PG8_BAR __builtin_amdgcn_s_barrier()
#define PG8_SCHED __builtin_amdgcn_sched_barrier(0)
  Unit cur, nxt; int ui = 0;
  if (!S.next(0, cur)) return;
  f32x4 acc[2][2][4][2];
#pragma unroll
  for (int a = 0; a < 2; ++a)
#pragma unroll
    for (int b = 0; b < 2; ++b)
#pragma unroll
      for (int m = 0; m < 4; ++m)
#pragma unroll
        for (int n = 0; n < 2; ++n) acc[a][b][m][n] = (f32x4){0.f, 0.f, 0.f, 0.f};
  bf16x8 At[4][2], B0[2][2], B1[2][2];
  unsigned oc0[2], oc1[2], on0[2], on1[2];
#pragma unroll
  for (int i = 0; i < 2; ++i) { oc0[i] = S.a_off(cur, sR[i]) + (unsigned)sC[i] * 2u; oc1[i] = S.a_off(cur, HALF + sR[i]) + (unsigned)sC[i] * 2u; }
  const char* const Ab = S.a_base();
  const char* cB = S.b_base(cur);
  PG8_STAGE(PG8_SB(0, 0), cB, voffB); PG8_STAGE(PG8_SB(0, 1), cB + hstep, voffB); PG8_STAGE(PG8_SA(0, 0), Ab, oc0); PG8_STAGE(PG8_SA(0, 1), Ab, oc1);
  if (wr == 1) PG8_BAR;
  PG8_WAIT_V(2); PG8_BAR;
  PG8_STAGE(PG8_SB(1, 0), cB + kstep, voffB); PG8_STAGE(PG8_SA(1, 0), Ab + kstep, oc0); PG8_STAGE(PG8_SB(1, 1), cB + hstep + kstep, voffB);
  PG8_WAIT_V(6); PG8_BAR;
  for (;;) {
    const bool has_next = S.next(ui + 1, nxt);
    const char* nB = cB;
    if (has_next) {
      nB = S.b_base(nxt);
      int l2_; asm volatile("v_mbcnt_lo_u32_b32 %0, -1, 0\n\tv_mbcnt_hi_u32_b32 %0, -1, %0" : "=v"(l2_));
      const int tid2 = wid * 64 + l2_;
#pragma unroll
      for (int i = 0; i < 2; ++i) { int R, C; stage_rc(tid2 * 16 + i * 8192, R, C); on0[i] = S.a_off(nxt, R) + (unsigned)C * 2u; on1[i] = S.a_off(nxt, HALF + R) + (unsigned)C * 2u; }
    } else {
#pragma unroll
      for (int i = 0; i < 2; ++i) { on0[i] = oc0[i]; on1[i] = oc1[i]; }
    }
    for (int t = 0; t < nt; t += 2) {
      const bool last = (t == nt - 2);
      const char* a1 = Ab + (size_t)(t + 1) * kstep;
      const char* a2 = last ? Ab : Ab + (size_t)(t + 2) * kstep; const char* b2 = last ? nB : cB + (size_t)(t + 2) * kstep;
      const char* a3 = a2 + kstep; const char* b3 = b2 + kstep;
      unsigned o20[2], o21[2];
#pragma unroll
      for (int i = 0; i < 2; ++i) { o20[i] = last ? on0[i] : oc0[i]; o21[i] = last ? on1[i] : oc1[i]; }
      PG8_LDB(B0, 0, 0); PG8_LDB(B1, 0, 1); PG8_SCHED; PG8_LDA(At, 0, 0); PG8_STAGE(PG8_SA(1, 1), a1, oc1);
      PG8_WAIT_V(8); PG8_WAIT_L(0); PG8_BAR; PG8_MMA(0, 0, At, B0); PG8_MMA(0, 1, At, B1); PG8_BAR; PG8_SCHED;
      PG8_LDA(At, 0, 1); PG8_STAGE(PG8_SB(0, 0), b2, voffB); PG8_STAGE(PG8_SB(0, 1), b2 + hstep, voffB); PG8_STAGE(PG8_SA(0, 0), a2, o20);
      PG8_WAIT_V(8); PG8_WAIT_L(0); PG8_BAR; PG8_MMA(1, 0, At, B0); PG8_MMA(1, 1, At, B1); PG8_BAR; PG8_SCHED;
      PG8_LDB(B0, 1, 0); PG8_LDB(B1, 1, 1); PG8_SCHED; PG8_LDA(At, 1, 0); PG8_STAGE(PG8_SA(0, 1), a2, o21);
      PG8_WAIT_V(8); PG8_WAIT_L(0); PG8_BAR; PG8_MMA(0, 0, At, B0); PG8_MMA(0, 1, At, B1); PG8_BAR; PG8_SCHED;
      PG8_LDA(At, 1, 1); PG8_STAGE(PG8_SB(1, 0), b3, voffB); PG8_STAGE(PG8_SB(1, 1), b3 + hstep, voffB); PG8_STAGE(PG8_SA(1, 0), a3, o20);
      PG8_WAIT_V(8); PG8_WAIT_L(0); PG8_BAR; PG8_MMA(1, 0, At, B0); PG8_MMA(1, 1, At, B1); PG8_BAR; PG8_SCHED;
    }
    if (wr == 0) PG8_BAR;
    { int l3_; asm volatile("v_mbcnt_lo_u32_b32 %0, -1, 0\n\tv_mbcnt_hi_u32_b32 %0, -1, %0" : "=v"(l3_));
      S.epi(acc, cur, wr, wc, l3_ & 15, l3_ >> 4); }
    if (!has_next) break;
#pragma unroll
    for (int a = 0; a < 2; ++a)
#pragma unroll
      for (int b = 0; b < 2; ++b)
#pragma unroll
        for (int m = 0; m < 4; ++m)
#pragma unroll
          for (int n = 0; n < 2; ++n) acc[a][b][m][n] = (f32x4){0.f, 0.f, 0.f, 0.f};
    cur = nxt; cB = nB; ++ui;
#pragma unroll
    for (int i = 0; i < 2; ++i) { oc0[i] = on0[i]; oc1[i] = on1[i]; }
    if (wr == 1) PG8_BAR;
  }
  PG8_WAIT_V(0);
  PG8_BAR;
#undef PG8_SA
#undef PG8_SB
#undef PG8_STAGE
#undef PG8_LDA
#undef PG8_LDB
#undef PG8_MMA
#undef PG8_WAIT_V
#undef PG8_WAIT_L
#undef PG8_BAR
#undef PG8_SCHED
}
}
#endif
#ifndef CPU_EMU
#include <hip/hip_cooperative_groups.h>
namespace cg = cooperative_groups;
#define LAS __attribute__((address_space(3)))
#define NTHREADS 512
#define LDS_BYTES (154 * 1024)
typedef float f32x4 __attribute__((ext_vector_type(4)));
typedef short bf16x8 __attribute__((ext_vector_type(8)));
typedef unsigned u32x4 __attribute__((ext_vector_type(4)));
typedef unsigned u32x2 __attribute__((ext_vector_type(2)));

struct Ctx { int tid, lane, wid, G, bid; unsigned char* lds; };
__device__ __forceinline__ int lane_id() { int l; asm volatile("v_mbcnt_lo_u32_b32 %0, -1, 0\n\tv_mbcnt_hi_u32_b32 %0, -1, %0" : "=v"(l)); return l; }
__device__ __forceinline__ int opaque_tid(int wv) { int w = wv; asm volatile("" : "+s"(w)); int t = w * 64 + lane_id(); asm volatile("" : "+v"(t)); return t; }
__device__ __forceinline__ Ctx make_ctx(unsigned char* lds, int wv) { Ctx c; c.tid = opaque_tid(wv); c.lane = c.tid & 63; c.wid = __builtin_amdgcn_readfirstlane(c.tid >> 6); c.G = gridDim.x; c.bid = blockIdx.x; c.lds = lds; return c; }

__device__ __forceinline__ float wave_sum(float x) {
  x += __builtin_bit_cast(float, __builtin_amdgcn_update_dpp(0, __builtin_bit_cast(int, x), 0x111, 0xf, 0xf, false));
  x += __builtin_bit_cast(float, __builtin_amdgcn_update_dpp(0, __builtin_bit_cast(int, x), 0x112, 0xf, 0xf, false));
  x += __builtin_bit_cast(float, __builtin_amdgcn_update_dpp(0, __builtin_bit_cast(int, x), 0x114, 0xf, 0xf, false));
  x += __builtin_bit_cast(float, __builtin_amdgcn_update_dpp(0, __builtin_bit_cast(int, x), 0x118, 0xf, 0xf, false));
  x += __builtin_bit_cast(float, __builtin_amdgcn_update_dpp(0, __builtin_bit_cast(int, x), 0x142, 0xa, 0xf, false));
  x += __builtin_bit_cast(float, __builtin_amdgcn_update_dpp(0, __builtin_bit_cast(int, x), 0x143, 0xc, 0xf, false));
  return __builtin_bit_cast(float, __builtin_amdgcn_readlane(__builtin_bit_cast(int, x), 63));
}
__device__ __forceinline__ float fsigmoid(float x) { return __builtin_amdgcn_rcpf(1.0f + __builtin_amdgcn_exp2f(-1.4426950408889634f * x)); }
__device__ __forceinline__ float fsilu(float x) { return x * fsigmoid(x); }
__device__ __forceinline__ float flog2sigmoid(float x) { const float y = x * 1.4426950408889634f; return fminf(y, 0.f) - __builtin_amdgcn_logf(1.0f + __builtin_amdgcn_exp2f(-fabsf(y))); }
typedef float f32x2_t __attribute__((ext_vector_type(2)));
typedef __bf16 bf16x2_t __attribute__((ext_vector_type(2)));
__device__ __forceinline__ unsigned pk_hw(float a, float b) { const f32x2_t v = {a, b}; return __builtin_bit_cast(unsigned, __builtin_convertvector(v, bf16x2_t)); }
__device__ __forceinline__ unsigned pk2(float a, float b) { return pk_hw(a, b); }
__device__ __forceinline__ void unpack8(u32x4 w, float* f) {
  f[0] = __uint_as_float(w.x << 16); f[1] = __uint_as_float(w.x & 0xffff0000u); f[2] = __uint_as_float(w.y << 16); f[3] = __uint_as_float(w.y & 0xffff0000u);
  f[4] = __uint_as_float(w.z << 16); f[5] = __uint_as_float(w.z & 0xffff0000u); f[6] = __uint_as_float(w.w << 16); f[7] = __uint_as_float(w.w & 0xffff0000u);
}

__device__ __forceinline__ void transpose_job(const Ctx& c, const float* src, int N, bf16_t* dst, int rs, int ro, int tile0, int tile_stride) {
  float* t = (float*)c.lds;
  const int ntn = (N + 63) / 64, ntiles = ntn * 16;
  for (int tl = tile0; tl < ntiles; tl += tile_stride) {
    const int kt = tl / ntn, nt_ = tl % ntn, k0 = kt * 64, n0 = nt_ * 64;
    __syncthreads();
#pragma unroll
    for (int i = 0; i < 8; ++i) { const int idx = c.tid + i * 512, kk = idx >> 6, nn = idx & 63; t[kk * 65 + nn] = (n0 + nn < N) ? src[(size_t)(k0 + kk) * N + n0 + nn] : 0.f; }
    __syncthreads();
#pragma unroll
    for (int i = 0; i < 4; ++i) { const int idx = c.tid + i * 512, nn = idx >> 5, kp = (idx & 31) * 2;
      if (n0 + nn < N) *(unsigned*)(dst + (size_t)((n0 + nn) * rs + ro) * 1024 + k0 + kp) = pk2(t[kp * 65 + nn], t[(kp + 1) * 65 + nn]); }
  }
  __syncthreads();
}
__device__ __forceinline__ void p0_prologue(unsigned char* lds_, int wv, const Params& p) {
  const Ctx c = make_ctx(lds_, wv);
  unsigned char* ws = p.ws;
  if (c.bid == 0) { ((unsigned*)(ws + WS_CTL))[64 + c.tid] = 0u; }
  if (c.bid == 0) { for (int i = c.tid; i < 3456; i += NTHREADS) ((unsigned*)(ws + WS_CTL))[2048 + i] = 0u; }
  { const float* x = p.in[I_X]; bf16_t* hb = (bf16_t*)(ws + WS_HB);
    for (size_t i = (size_t)c.bid * NTHREADS + c.tid; i < (size_t)NTOK * 1024 / 8; i += (size_t)c.G * NTHREADS) {
      const f32x4 a = __builtin_nontemporal_load((const f32x4*)(x + i * 8)), b = __builtin_nontemporal_load((const f32x4*)(x + i * 8 + 4));
      u32x4 w; w.x = pk2(a[0], a[1]); w.y = pk2(a[2], a[3]); w.z = pk2(b[0], b[1]); w.w = pk2(b[2], b[3]);
      *(u32x4*)(hb + i * 8) = w; } }
  transpose_job(c, p.in[I_AB_W_IN], P_AB, (bf16_t*)(ws + WS_WIN_AB), 1, 0, c.bid, c.G);
  transpose_job(c, p.in[I_CD_W_IN], P_CD, (bf16_t*)(ws + WS_WIN_CD), 1, 0, c.bid, c.G);
  transpose_job(c, p.in[I_AB_W_OUT], 1024, (bf16_t*)(ws + WS_WOUT_AB), 1, 0, c.bid, c.G);
  transpose_job(c, p.in[I_CD_W_OUT], 1024, (bf16_t*)(ws + WS_WOUT_CD), 1, 0, c.bid, c.G);
  { float* rope = (float*)(ws + WS_ROPE);
    for (int i = c.bid * NTHREADS + c.tid; i < SEQ * 32; i += c.G * NTHREADS) { const int t = i >> 5, f = i & 31;
      const float freq = powf(10000.0f, -(float)f / 32.0f); const float ang = (float)t * freq; rope[i * 2] = cosf(ang); rope[i * 2 + 1] = sinf(ang); }
    if (c.bid == 1) { const float* hl = p.in[I_HGRN_LB]; float* lb = (float*)(ws + WS_LB);
      const int cc = c.tid; const float a0 = hl[cc], a1 = hl[512 + cc], a2 = hl[1024 + cc]; const float mx = fmaxf(a0, fmaxf(a1, a2));
      const float e0 = expf(a0 - mx), e1 = expf(a1 - mx), e2 = expf(a2 - mx); lb[cc] = e0 / (e0 + e1 + e2); } }
}
__device__ __forceinline__ void moe_weight_convert(unsigned char* lds_, int wv, const Params& p, int layer, int part, int bidx, int nblk) {
  const Ctx c = make_ctx(lds_, wv);
  bf16_t* w13 = (bf16_t*)(p.ws + WS_W13); bf16_t* w2 = (bf16_t*)(p.ws + (p.big_ws ? WS_W2X : WS_W2));
  const size_t lo = (size_t)layer * NEXP * 1024 * 1024;
  const float* W1 = p.in[I_MOE_W1] + lo; const float* W3 = p.in[I_MOE_W3] + lo; const float* W2 = p.in[I_MOE_W2] + lo;
  float* t = (float*)c.lds;
  const int NT = (part == 0 ? 32 : 16) * 128;
  const int lk = c.tid >> 5, ln4 = (c.tid & 31) * 4;
  const int sn = c.tid & 127, sk = (c.tid >> 7) * 8;
  f32x4 r[4];
#define MW_SRC(g_) ((part == 0 ? ((((g_) >> 7) & 1) ? W3 : W1) + (size_t)((g_) >> 8) * 1048576 : W2 + (size_t)((g_) >> 7) * 1048576) + (size_t)((((g_) & 127) >> 3) * 64) * 1024 + ((g_) & 7) * 128)
#define MW_LOAD(g_) do { const float* s_ = MW_SRC(g_); _Pragma("unroll") for (int i = 0; i < 4; ++i) r[i] = __builtin_nontemporal_load((const f32x4*)(s_ + (size_t)(lk + 16 * i) * 1024 + ln4)); } while (0)
  int g0 = bidx;
  if (g0 < NT) MW_LOAD(g0);
  for (; g0 < NT; g0 += nblk) {
    __syncthreads();
#pragma unroll
    for (int i = 0; i < 4; ++i) { float* d = t + (lk + 16 * i) * 129 + ln4; d[0] = r[i][0]; d[1] = r[i][1]; d[2] = r[i][2]; d[3] = r[i][3]; }
    __syncthreads();
    const int gn = g0 + nblk;
    if (gn < NT) MW_LOAD(gn);
    const int m = g0 >> 7, k0 = ((g0 & 127) >> 3) * 64, n0 = (g0 & 7) * 128;
    bf16_t* drow = (part == 1) ? w2 + ((size_t)m * 1024 + n0 + sn) * 1024 : w13 + ((size_t)(m >> 1) * 2048 + 2 * (n0 + sn) + (m & 1)) * 1024;
#pragma unroll
    for (int j = 0; j < 2; ++j) { const int kk = sk + 32 * j; const float* s = t + kk * 129 + sn;
      u32x4 w; w.x = pk2(s[0], s[129]); w.y = pk2(s[2 * 129], s[3 * 129]); w.z = pk2(s[4 * 129], s[5 * 129]); w.w = pk2(s[6 * 129], s[7 * 129]);
      *(u32x4*)(drow + k0 + kk) = w; }
  }
#undef MW_SRC
#undef MW_LOAD
  __syncthreads();
}

struct ProbInProj {
  static constexpr bool PERM = true;
  pg8::StaticOrder so; const char* A; const char* Bt; bf16_t* P; const float* bias; const float* lb; int layer;
  __device__ __forceinline__ bool next(int i, pg8::Unit& u) const { return so.next(i, u); }
  __device__ __forceinline__ const char* a_base() const { return A; }
  __device__ __forceinline__ unsigned a_off(const pg8::Unit& u, int r) const { return (unsigned)(u.pm * 256 + r) * 2048u; }
  __device__ __forceinline__ const char* b_base(const pg8::Unit& u) const { return Bt + (size_t)u.pn * 256 * 2048; }
  __device__ __forceinline__ void epi(const f32x4 (&acc)[2][2][4][2], const pg8::Unit& u, int wr, int wc, int fr, int fq) const {
    const int row0 = u.row0 + wr * 64 + fr, colb = u.pn * 256 + wc * 32 + 8 * fq;
    int mode = 0;
    if (layer == 0) { mode = u.pn < 2 ? 1 : (u.pn < 6 ? 2 : (u.pn == 10 ? 3 : 0)); }
#pragma unroll
    for (int bj = 0; bj < 2; ++bj) {
      const int col0 = colb + bj * 128;
      const f32x4 b0 = *(const f32x4*)(bias + col0), b1 = *(const f32x4*)(bias + col0 + 4);
      f32x4 l0 = (f32x4){0.f, 0.f, 0.f, 0.f}, l1 = l0;
      if (mode == 2) { l0 = *(const f32x4*)(lb + ((col0 - 512) & 511)); l1 = *(const f32x4*)(lb + ((col0 - 512) & 511) + 4); }
#pragma unroll
      for (int ai = 0; ai < 2; ++ai)
#pragma unroll
        for (int m = 0; m < 4; ++m) {
          f32x4 v0 = acc[ai][bj][m][0] + b0, v1 = acc[ai][bj][m][1] + b1;
          if (mode == 1) {
#pragma unroll
            for (int j = 0; j < 4; ++j) { v0[j] = fsilu(v0[j]); v1[j] = fsilu(v1[j]); }
          } else if (mode == 2) {
#pragma unroll
            for (int j = 0; j < 4; ++j) { v0[j] = __builtin_amdgcn_logf(l0[j] + (1.0f - l0[j]) * fsigmoid(v0[j])); v1[j] = __builtin_amdgcn_logf(l1[j] + (1.0f - l1[j]) * fsigmoid(v1[j])); }
          } else if (mode == 3) { v0 *= 0.125f; v1 *= 0.125f; }
          u32x4 w; w.x = pk2(v0[0], v0[1]); w.y = pk2(v0[2], v0[3]); w.z = pk2(v1[0], v1[1]); w.w = pk2(v1[2], v1[3]);
          *(u32x4*)(P + PIDX(row0 + ai * 128 + m * 16, col0)) = w;
        }
    }
  }
};
struct ProbOutProj {
  static constexpr bool PERM = false;
  pg8::StaticOrder so; const char* A; const char* Bt; float* Y; const float* Hres;
  __device__ __forceinline__ bool next(int i, pg8::Unit& u) const { return so.next(i, u); }
  __device__ __forceinline__ const char* a_base() const { return A; }
  __device__ __forceinline__ unsigned a_off(const pg8::Unit& u, int r) const { return (unsigned)(u.pm * 256 + r) * 2048u; }
  __device__ __forceinline__ const char* b_base(const pg8::Unit& u) const { return Bt + (size_t)u.pn * 256 * 2048; }
  __device__ __forceinline__ void epi(const f32x4 (&acc)[2][2][4][2], const pg8::Unit& u, int wr, int wc, int fr, int fq) const {
    const int row0 = u.row0 + wr * 64 + fr, col0 = u.pn * 256 + wc * 32 + 4 * fq;
#pragma unroll
    for (int ai = 0; ai < 2; ++ai)
#pragma unroll
      for (int m = 0; m < 4; ++m) { const size_t ro = (size_t)(row0 + ai * 128 + m * 16) * 1024 + col0; float* rowp = Y + ro; const float* hp = Hres + ro;
#pragma unroll
        for (int bj = 0; bj < 2; ++bj)
#pragma unroll
          for (int n = 0; n < 2; ++n) *(f32x4*)(rowp + bj * 128 + n * 16) = acc[ai][bj][m][n] + ALPHA_F * *(const f32x4*)(hp + bj * 128 + n * 16); }
  }
};
#define MOE_TAB_OFF (128 * 1024)
struct MoeOrder {
  const int* tab;
  __device__ __forceinline__ void init(const int* cnt, int ntn, int G, int c, unsigned char* lds, int wv) {
    int* t = (int*)(lds + MOE_TAB_OFF);
    const int tid = opaque_tid(wv);
    if (tid < 64) {
      int pad = 0, found = 0, ue = 0, upn = 0, upm = 0, urow = 0, une = 0;
      if ((G & 7) == 0) {
        const int x = c & 7; int q = tid * (G >> 3) + (c >> 3);
        for (int e = 0; e < NEXP; ++e) { const int n = cnt[e * 16], mt = (n + 255) >> 8; const int r = ((x - e) % 8 + 8) % 8; const int m = mt > r ? (mt - r - 1) / 8 + 1 : 0; const int units = m * ntn;
          if (!found && q < units) { ue = e; upm = r + 8 * (q % m); upn = q / m; urow = pad + upm * 256; une = n; found = 1; }
          if (!found) { q -= units; pad += mt * 256; } }
      } else {
        int L = tid * G + c;
        for (int e = 0; e < NEXP; ++e) { const int n = cnt[e * 16], mt = (n + 255) >> 8, tiles = mt * ntn;
          if (!found && L < tiles) { ue = e; upn = L / mt; upm = L % mt; urow = pad + upm * 256; une = n; found = 1; }
          if (!found) { L -= tiles; pad += mt * 256; } }
      }
      t[tid * 8 + 0] = found; t[tid * 8 + 1] = ue; t[tid * 8 + 2] = upn; t[tid * 8 + 3] = upm; t[tid * 8 + 4] = urow; t[tid * 8 + 5] = une;
    }
    __syncthreads();
    tab = t;
  }
  __device__ __forceinline__ bool next(int i, pg8::Unit& u) const {
    if (i >= 64) return false;
    const int* t = tab + i * 8;
    if (!__builtin_amdgcn_readfirstlane(t[0])) return false;
    u.e = __builtin_amdgcn_readfirstlane(t[1]); u.pn = __builtin_amdgcn_readfirstlane(t[2]); u.pm = __builtin_amdgcn_readfirstlane(t[3]);
    u.row0 = __builtin_amdgcn_readfirstlane(t[4]); u.ne = __builtin_amdgcn_readfirstlane(t[5]); u.ui = i; return true;
  }
};
struct ProbMoe1 {
  static constexpr bool PERM = true;
  MoeOrder mo; const char* A; const char* W13; const int* list; bf16_t* H; const int* ltok;
  __device__ __forceinline__ void stage_tokens(unsigned char* lds, int wv) {
    int* lt = (int*)(lds + MOE_TAB_OFF + 2048);
    const int tid = opaque_tid(wv);
    pg8::Unit u;
    for (int i = 0; i < 16 && mo.next(i, u); ++i) { if (tid < 256) { const int rr = u.pm * 256 + tid; lt[i * 256 + tid] = rr < u.ne ? list[u.e * NTOK + rr] : 0; } }
    __syncthreads();
    ltok = lt;
  }
  __device__ __forceinline__ bool next(int i, pg8::Unit& u) const { return mo.next(i, u); }
  __device__ __forceinline__ const char* a_base() const { return A; }
  __device__ __forceinline__ unsigned a_off(const pg8::Unit& u, int r) const { const int rr = u.pm * 256 + r; const int tok = rr < u.ne ? list[u.e * NTOK + rr] : 0; return (unsigned)tok * 2048u; }
  __device__ __forceinline__ const char* b_base(const pg8::Unit& u) const { return W13 + ((size_t)u.e * 2048 + (size_t)u.pn * 256) * 2048; }
  __device__ __forceinline__ void epi(const f32x4 (&acc)[2][2][4][2], const pg8::Unit& u, int wr, int wc, int fr, int fq) const {
    const int row0 = u.row0 + wr * 64 + fr, colb = u.pn * 128 + wc * 16 + 4 * fq;
#pragma unroll
    for (int ai = 0; ai < 2; ++ai)
#pragma unroll
      for (int m = 0; m < 4; ++m)
#pragma unroll
        for (int bj = 0; bj < 2; ++bj) {
          const f32x4 v0 = acc[ai][bj][m][0], v1 = acc[ai][bj][m][1];
          u32x2 w; w.x = pk2(fsilu(v0[0]) * v0[1], fsilu(v0[2]) * v0[3]); w.y = pk2(fsilu(v1[0]) * v1[1], fsilu(v1[2]) * v1[3]);
          *(u32x2*)(H + (size_t)(row0 + ai * 128 + m * 16) * 1024 + colb + bj * 64) = w;
        }
  }
};
struct ProbMoe2 {
  static constexpr bool PERM = true;
  MoeOrder mo; const char* A; const char* W2; bf16_t* Y;
  __device__ __forceinline__ bool next(int i, pg8::Unit& u) const { return mo.next(i, u); }
  __device__ __forceinline__ const char* a_base() const { return A; }
  __device__ __forceinline__ unsigned a_off(const pg8::Unit& u, int r) const { return (unsigned)(u.row0 + r) * 2048u; }
  __device__ __forceinline__ const char* b_base(const pg8::Unit& u) const { return W2 + ((size_t)u.e * 1024 + (size_t)u.pn * 256) * 2048; }
  __device__ __forceinline__ void epi(const f32x4 (&acc)[2][2][4][2], const pg8::Unit& u, int wr, int wc, int fr, int fq) const {
    const int row0 = u.row0 + wr * 64 + fr, colb = u.pn * 256 + wc * 32 + 8 * fq;
#pragma unroll
    for (int ai = 0; ai < 2; ++ai)
#pragma unroll
      for (int m = 0; m < 4; ++m)
#pragma unroll
        for (int bj = 0; bj < 2; ++bj) {
          const f32x4 v0 = acc[ai][bj][m][0], v1 = acc[ai][bj][m][1];
          u32x4 w; w.x = pk2(v0[0], v0[1]); w.y = pk2(v0[2], v0[3]); w.z = pk2(v1[0], v1[1]); w.w = pk2(v1[2], v1[3]);
          *(u32x4*)(Y + (size_t)(row0 + ai * 128 + m * 16) * 1024 + colb + bj * 128) = w;
        }
  }
};

template <int NS>
__device__ __forceinline__ void side_phase(unsigned char* lds_, int wv, const Params& p, int layer) {
  const Ctx c = make_ctx(lds_, wv);
  const bf16_t* hb = (const bf16_t*)(p.ws + WS_HB);
  const bf16_t* wt = (const bf16_t*)(p.ws + (layer == 0 ? WS_WIN_AB : WS_WIN_CD)) + (size_t)(layer == 0 ? PM_AB : PM_CD) * 1024;
  const float* bias = p.in[layer == 0 ? I_AB_B_IN : I_CD_B_IN] + (layer == 0 ? PM_AB : PM_CD);
  float* side = (float*)(p.ws + WS_SIDE);
  float* tl = (float*)c.lds + c.wid * (16 * 33);
  const int fr = c.lane & 15, fq = c.lane >> 4;
  for (int g = c.bid * 8 + c.wid; g < NTOK / 16; g += c.G * 8) {
    const int r0 = g * 16;
    f32x4 acc0 = (f32x4){0.f, 0.f, 0.f, 0.f}, acc1 = acc0;
    const bf16_t* ap = hb + (size_t)(r0 + fr) * 1024 + fq * 8;
    const bf16_t* bp0 = wt + (size_t)fr * 1024 + fq * 8; const bf16_t* bp1 = bp0 + 16 * 1024;
#pragma unroll 16
    for (int k = 0; k < 1024; k += 32) {
      const bf16x8 a = *(const bf16x8*)(ap + k), b0 = *(const bf16x8*)(bp0 + k);
      acc0 = __builtin_amdgcn_mfma_f32_16x16x32_bf16(a, b0, acc0, 0, 0, 0);
      if (NS == 32) { const bf16x8 b1 = *(const bf16x8*)(bp1 + k); acc1 = __builtin_amdgcn_mfma_f32_16x16x32_bf16(a, b1, acc1, 0, 0, 0); }
    }
    float gsc = 1.f, gfb = 0.f; bool gls = false;
    if (NS == 16) { gsc = 1.4426950408889634f; gls = (fr & 4) != 0; gfb = gls ? p.in[I_FGATE_B][(fr >> 3) * 4 + (fr & 3)] : 0.f; }
#pragma unroll
    for (int j = 0; j < 4; ++j) { float v0 = acc0[j] + bias[fr]; if (NS == 16) v0 = gls ? flog2sigmoid(v0 + gfb) : v0 * gsc; side[(size_t)(r0 + fq * 4 + j) * 32 + fr] = v0; tl[(fq * 4 + j) * 33 + fr] = v0;
      if (NS == 32) { const float v1 = acc1[j] + bias[16 + fr]; side[(size_t)(r0 + fq * 4 + j) * 32 + 16 + fr] = v1; tl[(fq * 4 + j) * 33 + 16 + fr] = v1; } }
    if (NS == 32) {
      __builtin_amdgcn_s_waitcnt(0xC07F);
      const float* gu = p.in[I_GK_UP]; const float* gb = p.in[I_GK_B]; bf16_t* lfb = (bf16_t*)(p.ws + WS_LFB);
      const int cb = c.lane * 8, dir = cb >> 8, cc = cb & 255;
      float w[16][8];
#pragma unroll
      for (int r = 0; r < 16; ++r)
#pragma unroll
        for (int j = 0; j < 8; ++j) w[r][j] = gu[(dir * 16 + r) * 256 + cc + j];
      float bb[8];
#pragma unroll
      for (int j = 0; j < 8; ++j) bb[j] = gb[dir * 256 + cc + j];
      for (int row = 0; row < 16; ++row) {
        float z[8];
#pragma unroll
        for (int j = 0; j < 8; ++j) z[j] = bb[j];
#pragma unroll
        for (int r = 0; r < 16; ++r) { const float s = tl[row * 33 + dir * 16 + r];
#pragma unroll
          for (int j = 0; j < 8; ++j) z[j] += s * w[r][j]; }
        u32x4 o; o.x = pk2(flog2sigmoid(z[0]) * 0.0625f, flog2sigmoid(z[1]) * 0.0625f); o.y = pk2(flog2sigmoid(z[2]) * 0.0625f, flog2sigmoid(z[3]) * 0.0625f);
        o.z = pk2(flog2sigmoid(z[4]) * 0.0625f, flog2sigmoid(z[5]) * 0.0625f); o.w = pk2(flog2sigmoid(z[6]) * 0.0625f, flog2sigmoid(z[7]) * 0.0625f);
        *(u32x4*)(lfb + PIDX(r0 + row, cb)) = o;
      }
    }
  }
}

__device__ __forceinline__ void headnorm_phase(unsigned char* lds_, int wv, const Params& p, int layer) {
  const Ctx c = make_ctx(lds_, wv);
  const bf16_t* P = (const bf16_t*)(p.ws + WS_R1); const bf16_t* O = (const bf16_t*)(p.ws + WS_R2);
  bf16_t* mixed = (bf16_t*)(p.ws + WS_MIX);
  const int c0 = c.lane * 16, h8 = c.lane >> 3;
  const float* gain = layer == 0 ? (h8 < 4 ? p.in[I_HGRN_NORM] + c0 : p.in[I_GLA_NORM] + c0 - 512) : (h8 < 4 ? p.in[I_RET_NORM] + c0 : p.in[I_MLSTM_NORM] + c0 - 512);
  const int gcol = layer == 0 ? (h8 < 4 ? 2048 + c0 : 3584 + c0 - 512) : (h8 < 4 ? 1024 + c0 : 3072 + c0 - 512);
  float gn[16];
#pragma unroll
  for (int j = 0; j < 16; ++j) gn[j] = gain[j];
  const int tstride = c.G * 8;
  for (int tok0 = c.bid * 8 + c.wid; tok0 < NTOK; tok0 += 2 * tstride) {
    u32x4 ra[2][2], rb[2][2], rg[2][2];
#pragma unroll
    for (int u = 0; u < 2; ++u) { const int tok = tok0 + u * tstride < NTOK ? tok0 + u * tstride : tok0;
      const u32x4* a = (const u32x4*)(O + PIDX(tok, c0)); const u32x4* b = (const u32x4*)(O + (size_t)NTOK * 1024 + PIDX(tok, c0)); const u32x4* g = (const u32x4*)(P + PIDX(tok, gcol));
      ra[u][0] = __builtin_nontemporal_load(a); ra[u][1] = __builtin_nontemporal_load(a + 1); rb[u][0] = __builtin_nontemporal_load(b); rb[u][1] = __builtin_nontemporal_load(b + 1);
      rg[u][0] = __builtin_nontemporal_load(g); rg[u][1] = __builtin_nontemporal_load(g + 1); }
#pragma unroll
    for (int u = 0; u < 2; ++u) {
      const int tok = tok0 + u * tstride;
      float of[16], ob[16], gt[16];
      unpack8(ra[u][0], of); unpack8(ra[u][1], of + 8); unpack8(rb[u][0], ob); unpack8(rb[u][1], ob + 8); unpack8(rg[u][0], gt); unpack8(rg[u][1], gt + 8);
      float o[16]; float ss = 0.f;
#pragma unroll
      for (int j = 0; j < 16; ++j) { o[j] = of[j] + ob[j]; ss += o[j] * o[j]; }
      ss += __shfl_xor(ss, 1); ss += __shfl_xor(ss, 2); ss += __shfl_xor(ss, 4);
      const float r = 1.0f / sqrtf(ss * (1.0f / 128.0f) + NORM_EPS_F);
      unsigned w[8];
#pragma unroll
      for (int j = 0; j < 8; ++j) {
        float g0 = gt[2 * j], g1 = gt[2 * j + 1];
        if (layer == 1 && h8 >= 4) { g0 = fsigmoid(g0); g1 = fsigmoid(g1); } else { g0 = fsilu(g0); g1 = fsilu(g1); }
        w[j] = pk2(o[2 * j] * r * gn[2 * j] * g0, o[2 * j + 1] * r * gn[2 * j + 1] * g1);
      }
      if (tok < NTOK) { u32x4* d = (u32x4*)(mixed + (size_t)tok * 1024 + c0);
        d[0] = (u32x4){w[0], w[1], w[2], w[3]}; d[1] = (u32x4){w[4], w[5], w[6], w[7]}; }
    }
  }
}

__device__ __forceinline__ void ln_phase(unsigned char* lds_, int wv, const Params& p, int layer, int mode, int dry = 0) {
  const Ctx c = make_ctx(lds_, wv);
  unsigned char* ws = p.ws;
  const float* hin = (mode == 0 && layer == 0) ? p.in[I_X] : p.out;
  float* hout = dry ? (float*)(ws + WS_H) : p.out; bf16_t* hb = (bf16_t*)(ws + (mode == 0 ? WS_MIX : WS_HB));
  const float* g = p.in[mode == 0 ? I_LN_MIX_G : I_LN_FFN_G] + layer * 1024; const float* b = p.in[mode == 0 ? I_LN_MIX_B : I_LN_FFN_B] + layer * 1024;
  unsigned* cnt = (unsigned*)(ws + WS_CTL) + CW_CNT(layer);
  int* list = (int*)(ws + WS_LIST) + (size_t)layer * NEXP * NTOK;
  int* assign = (int*)(ws + WS_ASSIGN); float* gate = (float*)(ws + WS_GATE);
  float* rwT = (float*)c.lds;
  int* lcnt = (int*)(c.lds + 65536); int* lbase = lcnt + 16; int* rec = lcnt + 32; float* recg = (float*)(rec + 4 * 2048);
  int pad[NEXP];
  if (mode == 0) { const float* r = p.in[I_ROUTER_W];
    for (int i = c.tid; i < 1024 * 16; i += NTHREADS) rwT[(i & 15) * 1024 + (i >> 4)] = r[i];
    if (c.tid < 16) lcnt[c.tid] = 0;
    __syncthreads(); }
  else { int acc = 0;
#pragma unroll
    for (int e = 0; e < NEXP; ++e) { pad[e] = acc; acc += (((int)cnt[e * 16] + 255) >> 8) << 8; } }
  const int c0 = c.lane * 4;
  float gv[16], bv[16];
#pragma unroll
  for (int q = 0; q < 4; ++q) { const f32x4 t0 = *(const f32x4*)(g + q * 256 + c0), t1 = *(const f32x4*)(b + q * 256 + c0);
#pragma unroll
    for (int j = 0; j < 4; ++j) { gv[4 * q + j] = t0[j]; bv[4 * q + j] = t1[j]; } }
  const int tstride = c.G * 8;
  int it = 0;
  for (int tok0 = c.bid * 8 + c.wid; tok0 < NTOK; tok0 += 2 * tstride, it += 2) {
    float v[2][16];
    float gy0[2], gy1[2];
#pragma unroll
    for (int u = 0; u < 2; ++u) {
      const int tok = tok0 + u * tstride;
      if (tok < NTOK) {
        if (mode == 0) {
#pragma unroll
          for (int q = 0; q < 4; ++q) { const f32x4 t = __builtin_nontemporal_load((const f32x4*)((const float*)(ws + WS_R2) + (size_t)tok * 1024 + q * 256 + c0)); v[u][4 * q] = t[0]; v[u][4 * q + 1] = t[1]; v[u][4 * q + 2] = t[2]; v[u][4 * q + 3] = t[3]; }
        } else {
#pragma unroll
          for (int q = 0; q < 4; ++q) { const f32x4 t = *(const f32x4*)(hin + (size_t)tok * 1024 + q * 256 + c0); v[u][4 * q] = ALPHA_F * t[0]; v[u][4 * q + 1] = ALPHA_F * t[1]; v[u][4 * q + 2] = ALPHA_F * t[2]; v[u][4 * q + 3] = ALPHA_F * t[3]; }
          const int a0 = assign[tok * 4], a1 = assign[tok * 4 + 1], a2 = assign[tok * 4 + 2], a3 = assign[tok * 4 + 3];
          gy0[u] = gate[tok * 2]; gy1[u] = gate[tok * 2 + 1];
          int p0 = 0, p1 = 0;
#pragma unroll
          for (int e = 0; e < NEXP; ++e) { if (e == a0) p0 = pad[e]; if (e == a2) p1 = pad[e]; }
          p0 += a1; p1 += a3;
          const bf16_t* Y = (const bf16_t*)(ws + WS_R2);
#pragma unroll
          for (int q = 0; q < 4; ++q) { const u32x2 y0 = __builtin_nontemporal_load((const u32x2*)(Y + (size_t)p0 * 1024 + q * 256 + c0)), y1 = __builtin_nontemporal_load((const u32x2*)(Y + (size_t)p1 * 1024 + q * 256 + c0));
            v[u][4 * q] += gy0[u] * __uint_as_float(y0.x << 16) + gy1[u] * __uint_as_float(y1.x << 16); v[u][4 * q + 1] += gy0[u] * __uint_as_float(y0.x & 0xffff0000u) + gy1[u] * __uint_as_float(y1.x & 0xffff0000u);
            v[u][4 * q + 2] += gy0[u] * __uint_as_float(y0.y << 16) + gy1[u] * __uint_as_float(y1.y << 16); v[u][4 * q + 3] += gy0[u] * __uint_as_float(y0.y & 0xffff0000u) + gy1[u] * __uint_as_float(y1.y & 0xffff0000u); }
        }
      } else {
#pragma unroll
        for (int j = 0; j < 16; ++j) v[u][j] = 0.f;
      }
    }
#pragma unroll
    for (int u = 0; u < 2; ++u) {
      const int tok = tok0 + u * tstride;
      float s = 0.f;
#pragma unroll
      for (int j = 0; j < 16; ++j) s += v[u][j];
      const float mean = wave_sum(s) * (1.0f / 1024.0f);
      float qq = 0.f;
#pragma unroll
      for (int j = 0; j < 16; ++j) { v[u][j] -= mean; qq += v[u][j] * v[u][j]; }
      const float r = 1.0f / sqrtf(wave_sum(qq) * (1.0f / 1024.0f) + LN_EPS_F);
#pragma unroll
      for (int j = 0; j < 16; ++j) v[u][j] = v[u][j] * r * gv[j] + bv[j];
      if (tok < NTOK) {
#pragma unroll
        for (int q = 0; q < 4; ++q) __builtin_nontemporal_store((f32x4){v[u][4 * q], v[u][4 * q + 1], v[u][4 * q + 2], v[u][4 * q + 3]}, (f32x4*)(hout + (size_t)tok * 1024 + q * 256 + c0));
        if (!(mode == 1 && layer == 1) && !dry) {
#pragma unroll
          for (int q = 0; q < 4; ++q) *(u32x2*)(hb + (size_t)tok * 1024 + q * 256 + c0) = (u32x2){pk2(v[u][4 * q], v[u][4 * q + 1]), pk2(v[u][4 * q + 2], v[u][4 * q + 3])}; }
      }
      if (mode == 0) {
        float lg[16];
#pragma unroll
        for (int e = 0; e < 16; ++e) { float a = 0.f;
#pragma unroll
          for (int q = 0; q < 4; ++q) { const f32x4 w = *(const f32x4*)(rwT + e * 1024 + q * 256 + c0); a += v[u][4 * q] * w[0] + v[u][4 * q + 1] * w[1] + v[u][4 * q + 2] * w[2] + v[u][4 * q + 3] * w[3]; }
          lg[e] = a; }
#pragma unroll
        for (int e = 0; e < 16; ++e) lg[e] = wave_sum(lg[e]);
        int eo[2]; float go[2];
        route_from_logits(lg, p.in[I_ROUTER_B], eo, go);
        if (c.lane == 0 && tok < NTOK && !dry) {
          const int r1 = atomicAdd(lcnt + eo[0], 1), r2 = atomicAdd(lcnt + eo[1], 1);
          const int ri = (it + u) * 8 + c.wid;
          rec[ri * 4] = eo[0]; rec[ri * 4 + 1] = r1; rec[ri * 4 + 2] = eo[1]; rec[ri * 4 + 3] = r2; recg[ri * 2] = go[0]; recg[ri * 2 + 1] = go[1];
        }
      }
    }
  }
  if (mode == 0 && !dry) {
    __syncthreads();
    if (c.tid < 16) lbase[c.tid] = (int)atomicAdd(cnt + c.tid * 16, (unsigned)lcnt[c.tid]);
    __syncthreads();
    const int nrec = ((NTOK + c.G * 8 - 1) / (c.G * 8)) * 8;
    for (int ri = c.tid; ri < nrec; ri += NTHREADS) {
      const int tok = c.bid * 8 + (ri & 7) + (ri >> 3) * c.G * 8;
      if (tok < NTOK) {
        const int e1 = rec[ri * 4], e2 = rec[ri * 4 + 2]; const int r1 = rec[ri * 4 + 1] + lbase[e1], r2 = rec[ri * 4 + 3] + lbase[e2];
        list[e1 * NTOK + r1] = tok; list[e2 * NTOK + r2] = tok;
        assign[tok * 4] = e1; assign[tok * 4 + 1] = r1; assign[tok * 4 + 2] = e2; assign[tok * 4 + 3] = r2;
        gate[tok * 2] = recg[ri * 2]; gate[tok * 2 + 1] = recg[ri * 2 + 1];
      }
    }
  }
  __syncthreads();
}
#endif
#ifndef CPU_EMU
namespace scan {
typedef short bf16x8 __attribute__((ext_vector_type(8)));
typedef float f32x4 __attribute__((ext_vector_type(4)));
typedef unsigned u32x4 __attribute__((ext_vector_type(4)));
typedef unsigned u32x2 __attribute__((ext_vector_type(2)));
enum { MIX_A = 0, MIX_B = 1, MIX_C = 2, MIX_D = 3 };
constexpr int LD_T = 144;
constexpr int OFF_QS = 0, OFF_KS = 17408, OFF_QI = 34816, OFF_KT = 52224, OFF_VT = 70656, OFF_SC = 77568, OFF_ST = 86784, OFF_DEC = 99840, OFF_EM = 100352, OFF_DEN = 100608, OFF_CW = 100864, SCAN_LDS = 104960;

__device__ __forceinline__ float incl_scan_add(float x) {
  x += __builtin_bit_cast(float, __builtin_amdgcn_update_dpp(0, __builtin_bit_cast(int, x), 0x111, 0xf, 0xf, false));
  x += __builtin_bit_cast(float, __builtin_amdgcn_update_dpp(0, __builtin_bit_cast(int, x), 0x112, 0xf, 0xf, false));
  x += __builtin_bit_cast(float, __builtin_amdgcn_update_dpp(0, __builtin_bit_cast(int, x), 0x114, 0xf, 0xf, false));
  x += __builtin_bit_cast(float, __builtin_amdgcn_update_dpp(0, __builtin_bit_cast(int, x), 0x118, 0xf, 0xf, false));
  x += __builtin_bit_cast(float, __builtin_amdgcn_update_dpp(0, __builtin_bit_cast(int, x), 0x142, 0xa, 0xf, false));
  x += __builtin_bit_cast(float, __builtin_amdgcn_update_dpp(0, __builtin_bit_cast(int, x), 0x143, 0xc, 0xf, false));
  return x;
}
__device__ __forceinline__ float incl_scan_max(float x) {
  const int ninf = (int)0xff800000u;
  x = fmaxf(x, __builtin_bit_cast(float, __builtin_amdgcn_update_dpp(ninf, __builtin_bit_cast(int, x), 0x111, 0xf, 0xf, false)));
  x = fmaxf(x, __builtin_bit_cast(float, __builtin_amdgcn_update_dpp(ninf, __builtin_bit_cast(int, x), 0x112, 0xf, 0xf, false)));
  x = fmaxf(x, __builtin_bit_cast(float, __builtin_amdgcn_update_dpp(ninf, __builtin_bit_cast(int, x), 0x114, 0xf, 0xf, false)));
  x = fmaxf(x, __builtin_bit_cast(float, __builtin_amdgcn_update_dpp(ninf, __builtin_bit_cast(int, x), 0x118, 0xf, 0xf, false)));
  x = fmaxf(x, __builtin_bit_cast(float, __builtin_amdgcn_update_dpp(ninf, __builtin_bit_cast(int, x), 0x142, 0xa, 0xf, false)));
  x = fmaxf(x, __builtin_bit_cast(float, __builtin_amdgcn_update_dpp(ninf, __builtin_bit_cast(int, x), 0x143, 0xc, 0xf, false)));
  return x;
}
__device__ __forceinline__ float rdlane(float x, int l) { return __builtin_bit_cast(float, __builtin_amdgcn_readlane(__builtin_bit_cast(int, x), l)); }
__device__ __forceinline__ bf16x8 ldfrag(const unsigned char* base, int ld, int row, int kbyte) { return *(const bf16x8*)(base + row * ld + kbyte); }
__device__ __forceinline__ bf16x8 ldfrag2(const unsigned char* base, int ld, int row, int b0, int b1) {
  const u32x2 lo = *(const u32x2*)(base + row * ld + b0), hi = *(const u32x2*)(base + row * ld + b1);
  return __builtin_bit_cast(bf16x8, (u32x4){lo.x, lo.y, hi.x, hi.y}); }
__device__ __forceinline__ unsigned pk(float a, float b) { return pk_hw(a, b); }
__device__ __forceinline__ float lo16(unsigned w) { return __uint_as_float(w << 16); }
__device__ __forceinline__ float hi16(unsigned w) { return __uint_as_float(w & 0xffff0000u); }

__device__ __forceinline__ void lds_barrier() { asm volatile("s_waitcnt lgkmcnt(0)" ::: "memory"); __builtin_amdgcn_s_barrier(); asm volatile("" ::: "memory"); }
struct Raw { u32x4 a0, a1, b0, b1; f32x4 r0, r1; u32x2 v; float s0, s1; };

}

__device__ __forceinline__ void convd_phase(unsigned char* lds_, int wv, const Params& p) {
  const Ctx c = make_ctx(lds_, wv);
  bf16_t* P = (bf16_t*)(p.ws + WS_R1); bf16_t* QD = (bf16_t*)(p.ws + WS_LFB);
  const float* cw = p.in[I_CONV_W]; const float* cb = p.in[I_CONV_B];
  const int ch = c.lane * 16;
  float w0[16], w1[16], w2[16], bb[16];
#pragma unroll
  for (int j = 0; j < 16; ++j) { w0[j] = cw[ch + j]; w1[j] = cw[1024 + ch + j]; w2[j] = cw[2048 + ch + j]; bb[j] = cb[ch + j]; }
  for (int tok = c.bid * 8 + c.wid; tok < NTOK; tok += c.G * 8) {
    const int t = tok % SEQ;
    const bf16_t* row = P + PIDX(tok, 1536 + ch);
    float x0[16], x1[16], x2[16];
    { const u32x4* r1 = (const u32x4*)row; unpack8(r1[0], x1); unpack8(r1[1], x1 + 8); }
    if (t > 0) { const u32x4* r0 = (const u32x4*)(row - 128); unpack8(r0[0], x0); unpack8(r0[1], x0 + 8); }
    else {
#pragma unroll
      for (int j = 0; j < 16; ++j) x0[j] = 0.f; }
    if (t < SEQ - 1) { const u32x4* r2 = (const u32x4*)(row + 128); unpack8(r2[0], x2); unpack8(r2[1], x2 + 8); }
    else {
#pragma unroll
      for (int j = 0; j < 16; ++j) x2[j] = 0.f; }
    const float sc = ch < 512 ? 0.08838834764831845f : 1.0f;
    unsigned w[8];
#pragma unroll
    for (int j = 0; j < 8; ++j) {
      const float a0 = bb[2 * j] + w0[2 * j] * x0[2 * j] + w1[2 * j] * x1[2 * j] + w2[2 * j] * x2[2 * j];
      const float a1 = bb[2 * j + 1] + w0[2 * j + 1] * x0[2 * j + 1] + w1[2 * j + 1] * x1[2 * j + 1] + w2[2 * j + 1] * x2[2 * j + 1];
      w[j] = pk2(fsilu(a0) * sc, fsilu(a1) * sc);
    }
    u32x4* d = (ch < 512) ? (u32x4*)(QD + PIDX(tok, ch)) : (u32x4*)(P + PIDX(tok, 3584 + (ch - 512)));
    d[0] = (u32x4){w[0], w[1], w[2], w[3]}; d[1] = (u32x4){w[4], w[5], w[6], w[7]};
  }
}

#endif
#ifndef CPU_EMU
namespace scan2 {
using namespace scan;
#ifndef PROBE_ALLTILES
#define PROBE_ALLTILES 0
#endif
__device__ __forceinline__ float FMUL(float a, float b) { float r = a * b; asm("" : "+v"(r)); return r; }
constexpr int U_QI = 0, U_KS = 34816, U_KT = 69632, U_VT = 106496, U_SC = 120320, U_ST = 129536, U_DEC = 155648, U_EM = 156672, U_END = 157184;
template <int MIXER>
__device__ __forceinline__ void scan_item2(unsigned char* lds, int wv, const Params& p, int b, int h, int dir, int vs) {
  constexpr int DK = (MIXER == MIX_A || MIXER == MIX_D) ? 128 : 64;
  constexpr int NC = DK / 8;
  constexpr int LD_D = DK * 2 + 16;
  constexpr int NVT = MIXER == MIX_D ? 3 : 2;
  constexpr int NKD = DK / 32;
  constexpr int NST = (DK == 128) ? NVT : 1;
  constexpr int NCH = SEQ / 64;
  const int tid = opaque_tid(wv), lane0 = tid & 63, wid = __builtin_amdgcn_readfirstlane(tid >> 6);
  unsigned char* ws = p.ws;
  const bf16_t* P = (const bf16_t*)(ws + WS_R1);
  const bf16_t* LFBp = (const bf16_t*)(ws + WS_LFB);
  const float* side = (const float*)(ws + WS_SIDE);
  const float* rope = (const float*)(ws + WS_ROPE);
  bf16_t* O = (bf16_t*)(ws + WS_R2) + (size_t)dir * NTOK * 1024;
  int qcol, kcol, lfcol, vcol, ocol;
  if (MIXER == MIX_A) { qcol = h * 128; kcol = 0; lfcol = 512 + dir * 512 + h * 128; vcol = 1536 + h * 128 + vs * 32; ocol = h * 128 + vs * 32; }
  else if (MIXER == MIX_B) { qcol = 2560 + h * 64; kcol = 2816 + h * 64; lfcol = dir * 256 + h * 64; vcol = 3072 + h * 128 + vs * 32; ocol = 512 + h * 128 + vs * 32; }
  else if (MIXER == MIX_C) { qcol = h * 64; kcol = 256 + h * 64; lfcol = 0; vcol = 512 + h * 128 + vs * 32; ocol = h * 128 + vs * 32; }
  else { qcol = h * 128; kcol = 3584 + h * 128; lfcol = 0; vcol = 2560 + h * 128 + vs * 32; ocol = 512 + h * 128 + vs * 32; }
  const size_t tokbase = (size_t)b * SEQ;
  const int c0 = (MIXER == MIX_C) ? wid * 4 : wid * NC;
  for (int i = tid; i < 2 * 13056 / 4; i += NTHREADS) ((unsigned*)(lds + U_ST))[i] = 0u;

  if (MIXER == MIX_D) { for (int i = tid; i < 2 * 16 * 64; i += NTHREADS) { const int bf = i >> 10, r = 32 + ((i >> 6) & 15), j = i & 63; *(bf16_t*)(lds + U_VT + bf * 6912 + r * LD_T + j * 2) = (r == 32) ? (bf16_t)0x3F80 : (bf16_t)0; } }
  const float lgam2 = (MIXER == MIX_C) ? log1pf(-exp2f(-(5.0f + 2.0f * (float)h + (float)dir))) * 1.4426950408889634f : 0.f;
  const float fgb = (MIXER == MIX_D) ? p.in[I_FGATE_B][dir * 4 + h] : 0.f;
  float m_st = 0.f;
  __syncthreads();

  Raw R, Rn; u32x2 Rv, Rvn;
#define A_LOAD(R, Rv, n_) do { \
    const int ln_ = lane0; \
    const int t_ = dir ? (SEQ - 1 - ((n_) * 64 + ln_)) : ((n_) * 64 + ln_); \
    const size_t tk_ = tokbase + t_; \
    if (MIXER == MIX_A) { const u32x4* qp_ = (const u32x4*)(P + PIDX(tk_, qcol + c0)); const u32x4* lp_ = (const u32x4*)(P + PIDX(tk_, lfcol + c0)); R.a0 = qp_[0]; R.a1 = qp_[1]; R.b0 = lp_[0]; R.b1 = lp_[1]; } \
    else if (MIXER == MIX_B) { R.a0 = *(const u32x4*)(P + PIDX(tk_, qcol + c0)); R.a1 = *(const u32x4*)(P + PIDX(tk_, kcol + c0)); R.b0 = *(const u32x4*)(LFBp + PIDX(tk_, lfcol + c0)); } \
    else if (MIXER == MIX_C) { const u32x2 qa_ = *(const u32x2*)(P + PIDX(tk_, qcol + c0)), qb_ = *(const u32x2*)(P + PIDX(tk_, qcol + 32 + c0)), ka_ = *(const u32x2*)(P + PIDX(tk_, kcol + c0)), kb_ = *(const u32x2*)(P + PIDX(tk_, kcol + 32 + c0)); \
      R.a0 = (u32x4){qa_.x, qa_.y, qb_.x, qb_.y}; R.a1 = (u32x4){ka_.x, ka_.y, kb_.x, kb_.y}; \
      R.r0 = *(const f32x4*)(rope + ((size_t)t_ * 32 + c0) * 2); R.r1 = *(const f32x4*)(rope + ((size_t)t_ * 32 + c0) * 2 + 4); } \
    else { const u32x4* qp_ = (const u32x4*)(LFBp + PIDX(tk_, qcol + c0)); const u32x4* kp_ = (const u32x4*)(P + PIDX(tk_, kcol + c0)); R.a0 = qp_[0]; R.a1 = qp_[1]; R.b0 = kp_[0]; R.b1 = kp_[1]; \
      R.s0 = side[tk_ * 32 + dir * 8 + h]; R.s1 = side[tk_ * 32 + dir * 8 + 4 + h]; } \
    Rv = *(const u32x2*)(P + PIDX(tk_, vcol + wid * 4)); } while (0)

  float rr_next = 1.f, rr_cur = 1.f;
#define A_PREP(buf_, R, Rv) do { \
    const int lane = lane0; \
    unsigned char* KTb = lds + U_KT + (buf_) * 18432; float* DECb = (float*)(lds + U_DEC + (buf_) * 512); float* EMb = (float*)(lds + U_EM + (buf_) * 256); \
    unsigned char* QIb = lds + U_QI + (buf_) * 17408; unsigned char* KSb = lds + U_KS + (buf_) * 17408; \
    float q[NC], k[NC], g[NC], ktv[NC]; \
    if (MIXER == MIX_A) { \
      const unsigned qw[8] = {R.a0.x, R.a0.y, R.a0.z, R.a0.w, R.a1.x, R.a1.y, R.a1.z, R.a1.w}, lw[8] = {R.b0.x, R.b0.y, R.b0.z, R.b0.w, R.b1.x, R.b1.y, R.b1.z, R.b1.w}; \
      _Pragma("unroll") for (int c = 0; c < 8; ++c) { q[2 * c] = lo16(qw[c]); q[2 * c + 1] = hi16(qw[c]); g[2 * c] = lo16(lw[c]); g[2 * c + 1] = hi16(lw[c]); } \
      _Pragma("unroll") for (int c = 0; c < NC; ++c) k[c] = 1.0f - __builtin_amdgcn_exp2f(g[c]); \
    } else if (MIXER == MIX_B) { \
      const unsigned qw[4] = {R.a0.x, R.a0.y, R.a0.z, R.a0.w}, kw[4] = {R.a1.x, R.a1.y, R.a1.z, R.a1.w}, lw[4] = {R.b0.x, R.b0.y, R.b0.z, R.b0.w}; \
      _Pragma("unroll") for (int c = 0; c < 4; ++c) { q[2 * c] = lo16(qw[c]); q[2 * c + 1] = hi16(qw[c]); k[2 * c] = lo16(kw[c]); k[2 * c + 1] = hi16(kw[c]); g[2 * c] = lo16(lw[c]); g[2 * c + 1] = hi16(lw[c]); } \
    } else if (MIXER == MIX_C) { \
      const float cs[4] = {R.r0[0], R.r0[2], R.r1[0], R.r1[2]}, sn[4] = {R.r0[1], R.r0[3], R.r1[1], R.r1[3]}; \
      const float q1[4] = {lo16(R.a0.x), hi16(R.a0.x), lo16(R.a0.y), hi16(R.a0.y)}, q2[4] = {lo16(R.a0.z), hi16(R.a0.z), lo16(R.a0.w), hi16(R.a0.w)}; \
      const float k1[4] = {lo16(R.a1.x), hi16(R.a1.x), lo16(R.a1.y), hi16(R.a1.y)}, k2[4] = {lo16(R.a1.z), hi16(R.a1.z), lo16(R.a1.w), hi16(R.a1.w)}; \
      _Pragma("unroll") for (int c = 0; c < 4; ++c) { q[c] = (q1[c] * cs[c] - q2[c] * sn[c]) * 0.125f; q[4 + c] = (q1[c] * sn[c] + q2[c] * cs[c]) * 0.125f; k[c] = k1[c] * cs[c] - k2[c] * sn[c]; k[4 + c] = k1[c] * sn[c] + k2[c] * cs[c]; } \
    } else { \
      const unsigned qw[8] = {R.a0.x, R.a0.y, R.a0.z, R.a0.w, R.a1.x, R.a1.y, R.a1.z, R.a1.w}, kw[8] = {R.b0.x, R.b0.y, R.b0.z, R.b0.w, R.b1.x, R.b1.y, R.b1.z, R.b1.w}; \
      _Pragma("unroll") for (int c = 0; c < 8; ++c) { q[2 * c] = lo16(qw[c]); q[2 * c + 1] = hi16(qw[c]); k[2 * c] = lo16(kw[c]); k[2 * c + 1] = hi16(kw[c]); } \
    } \
    if (MIXER == MIX_A || MIXER == MIX_B) { \
        \
      _Pragma("unroll") for (int c = 0; c < NC; ++c) g[c] += __builtin_bit_cast(float, __builtin_amdgcn_update_dpp(0, __builtin_bit_cast(int, g[c]), 0x111, 0xf, 0xf, false)); \
      _Pragma("unroll") for (int c = 0; c < NC; ++c) g[c] += __builtin_bit_cast(float, __builtin_amdgcn_update_dpp(0, __builtin_bit_cast(int, g[c]), 0x112, 0xf, 0xf, false)); \
      _Pragma("unroll") for (int c = 0; c < NC; ++c) g[c] += __builtin_bit_cast(float, __builtin_amdgcn_update_dpp(0, __builtin_bit_cast(int, g[c]), 0x114, 0xf, 0xf, false)); \
      _Pragma("unroll") for (int c = 0; c < NC; ++c) g[c] += __builtin_bit_cast(float, __builtin_amdgcn_update_dpp(0, __builtin_bit_cast(int, g[c]), 0x118, 0xf, 0xf, false)); \
      _Pragma("unroll") for (int c = 0; c < NC; ++c) g[c] += __builtin_bit_cast(float, __builtin_amdgcn_update_dpp(0, __builtin_bit_cast(int, g[c]), 0x142, 0xa, 0xf, false)); \
      _Pragma("unroll") for (int c = 0; c < NC; ++c) g[c] += __builtin_bit_cast(float, __builtin_amdgcn_update_dpp(0, __builtin_bit_cast(int, g[c]), 0x143, 0xc, 0xf, false)); \
      float ev[NC]; \
      _Pragma("unroll") for (int c = 0; c < NC; ++c) { \
          \
        const float e = __builtin_amdgcn_exp2f(g[c]), r = __builtin_amdgcn_rcpf(e); \
        const float e63 = rdlane(e, 63); \
        q[c] = FMUL(q[c], e); k[c] = FMUL(k[c], r); ktv[c] = FMUL(k[c], e63);     \
        ev[c] = e; } \
      if (lane == 63) { _Pragma("unroll") for (int c = 0; c < NC / 4; ++c) *(f32x4*)(DECb + c0 + 4 * c) = (f32x4){ev[4 * c], ev[4 * c + 1], ev[4 * c + 2], ev[4 * c + 3]}; } \
    } else if (MIXER == MIX_C) { \
        \
      const float gl = (float)(lane + 1) * lgam2; \
      const float e = __builtin_amdgcn_exp2f(gl), r = __builtin_amdgcn_rcpf(e); \
      const float e63 = rdlane(e, 63); const float f_kt = r * e63; \
      _Pragma("unroll") for (int c = 0; c < NC; ++c) { q[c] = FMUL(q[c], e); ktv[c] = FMUL(k[c], f_kt); k[c] = FMUL(k[c], r); } \
      if (lane < 4) { DECb[c0 + lane] = e63; DECb[32 + c0 + lane] = e63; } \
    } else { \
      const float li = R.s0, lf = R.s1;     \
      const float bc = incl_scan_add(lf); const float u = li - bc; const float pm = incl_scan_max(u); \
      const float cmax = rdlane(pm, 63), blast = rdlane(bc, 63); \
      const float a_i = bc + m_st, m_i = fmaxf(a_i, bc + pm); \
      const float d_alpha = __builtin_amdgcn_exp2f(bc - m_i + cmax), d_beta = __builtin_amdgcn_exp2f(u - cmax); \
      rr_next = __builtin_amdgcn_exp2f(m_st - cmax);     \
      const float m_new = fmaxf(blast + m_st, blast + cmax); \
      const float d_sold = __builtin_amdgcn_exp2f(blast + m_st - m_new), d_wks = __builtin_amdgcn_exp2f(blast + u - m_new); m_st = m_new; \
      _Pragma("unroll") for (int c = 0; c < NC; ++c) { ktv[c] = FMUL(k[c], d_wks); q[c] = FMUL(q[c], d_alpha); k[c] = FMUL(k[c], d_beta); if (lane == 63) DECb[c0 + c] = d_sold; } \
      if (wid == 0) EMb[lane] = __builtin_amdgcn_exp2f(-m_i); \
    } \
    _Pragma("unroll") for (int c = 0; c < NC / 2; ++c) { const unsigned w_ = pk_hw(ktv[2 * c], ktv[2 * c + 1]); \
      const int d0_ = (MIXER == MIX_C) ? (2 * c < 4 ? c0 + 2 * c : 32 + c0 + 2 * c - 4) : c0 + 2 * c; \
      *(bf16_t*)(KTb + d0_ * LD_T + lane * 2) = (bf16_t)(w_ & 0xffff); *(bf16_t*)(KTb + (d0_ + 1) * LD_T + lane * 2) = (bf16_t)(w_ >> 16); } \
    { unsigned pq[NC / 2], pks[NC / 2]; \
      _Pragma("unroll") for (int c = 0; c < NC / 2; ++c) { pq[c] = pk_hw(q[2 * c], q[2 * c + 1]); pks[c] = pk_hw(k[2 * c], k[2 * c + 1]); } \
      if (MIXER == MIX_C) { \
        *(u32x2*)(QIb + lane * LD_D + c0 * 2) = (u32x2){pq[0], pq[1]}; *(u32x2*)(QIb + lane * LD_D + (32 + c0) * 2) = (u32x2){pq[2], pq[3]}; \
        *(u32x2*)(KSb + lane * LD_D + c0 * 2) = (u32x2){pks[0], pks[1]}; *(u32x2*)(KSb + lane * LD_D + (32 + c0) * 2) = (u32x2){pks[2], pks[3]}; \
      } else { \
        _Pragma("unroll") for (int c = 0; c < NC / 8; ++c) { \
          *(u32x4*)(QIb + lane * LD_D + (c0 + 8 * c) * 2) = (u32x4){pq[4 * c], pq[4 * c + 1], pq[4 * c + 2], pq[4 * c + 3]}; \
          *(u32x4*)(KSb + lane * LD_D + (c0 + 8 * c) * 2) = (u32x4){pks[4 * c], pks[4 * c + 1], pks[4 * c + 2], pks[4 * c + 3]}; } } } \
    { unsigned char* VTb = lds + U_VT + (buf_) * 6912 + (wid * 4) * LD_T + lane * 2; \
      *(bf16_t*)(VTb + 0 * LD_T) = (bf16_t)(Rv.x & 0xffff); *(bf16_t*)(VTb + 1 * LD_T) = (bf16_t)(Rv.x >> 16); *(bf16_t*)(VTb + 2 * LD_T) = (bf16_t)(Rv.y & 0xffff); *(bf16_t*)(VTb + 3 * LD_T) = (bf16_t)(Rv.y >> 16); } \
  } while (0)
  f32x4 sacc[NST];
#pragma unroll
  for (int i = 0; i < NST; ++i) sacc[i] = (f32x4){0.f, 0.f, 0.f, 0.f};
  A_LOAD(R, Rv, 0);
  A_PREP(0, R, Rv);
  A_LOAD(R, Rv, 1);
  A_LOAD(Rn, Rvn, 2);
  rr_cur = rr_next;
  lds_barrier();
#define SCAN_ITER(n_, RX, RvX) do { const int n = (n_); \
    const int cb = n & 1, nb = (n + 1) & 1; \
    if (n + 1 < NCH) { A_PREP(nb, RX, RvX); if (n + 3 < NCH) A_LOAD(RX, RvX, n + 3); } \
    { { \
      const int lane = lane0; \
      const int fr = lane & 15, fq = lane >> 4; \
      const int it = wid & 3, vt = wid >> 2; \
      const unsigned char* STc = lds + U_ST + cb * 13056; unsigned char* STn = lds + U_ST + nb * 13056; \
      const unsigned char* KTc = lds + U_KT + cb * 18432; const unsigned char* VTc = lds + U_VT + cb * 6912; \
      const unsigned char* QI = lds + U_QI + cb * 17408; const unsigned char* KS = lds + U_KS + cb * 17408; \
      const float* DECc = (const float*)(lds + U_DEC + cb * 512); const float* EMc = (const float*)(lds + U_EM + cb * 256); \
      bf16x8 qf[NKD]; \
_Pragma("unroll") \
      for (int ks = 0; ks < NKD; ++ks) qf[ks] = ldfrag(QI, LD_D, it * 16 + fr, ks * 64 + fq * 16); \
        \
      u32x2 sp[4]; \
_Pragma("unroll") \
      for (int jt = 0; jt < 4; ++jt) { \
        sp[jt] = (u32x2){0u, 0u}; \
        if (PROBE_ALLTILES || jt <= it) { \
          f32x4 acc = (f32x4){0.f, 0.f, 0.f, 0.f}; \
_Pragma("unroll") \
          for (int ks = 0; ks < NKD; ++ks) acc = __builtin_amdgcn_mfma_f32_16x16x32_bf16(ldfrag(KS, LD_D, jt * 16 + fr, ks * 64 + fq * 16), qf[ks], acc, 0, 0, 0); \
          if (jt == it) { const int i = fr, j0 = fq * 4; \
            const float v0 = (j0 + 0 <= i) ? acc[0] : 0.f, v1 = (j0 + 1 <= i) ? acc[1] : 0.f, v2 = (j0 + 2 <= i) ? acc[2] : 0.f, v3 = (j0 + 3 <= i) ? acc[3] : 0.f; \
            sp[jt] = (u32x2){pk_hw(v0, v1), pk_hw(v2, v3)}; } \
          else if (jt < it) sp[jt] = (u32x2){pk_hw(acc[0], acc[1]), pk_hw(acc[2], acc[3])}; \
          else asm volatile("" :: "v"(acc)); \
        } \
      } \
        \
        \
      const u32x4 sb0 = (u32x4){sp[0].x, sp[0].y, sp[1].x, sp[1].y}, sb1 = (u32x4){sp[2].x, sp[2].y, sp[3].x, sp[3].y}; \
      f32x4 oacc = (f32x4){0.f, 0.f, 0.f, 0.f}, dacc = (f32x4){0.f, 0.f, 0.f, 0.f}; \
_Pragma("unroll") \
      for (int ks = 0; ks < NKD; ++ks) oacc = __builtin_amdgcn_mfma_f32_16x16x32_bf16(ldfrag(STc, LD_D, vt * 16 + fr, ks * 64 + fq * 16), qf[ks], oacc, 0, 0, 0); \
      if (NVT == 3) { \
_Pragma("unroll") \
        for (int ks = 0; ks < NKD; ++ks) dacc = __builtin_amdgcn_mfma_f32_16x16x32_bf16(ldfrag(STc, LD_D, 32 + fr, ks * 64 + fq * 16), qf[ks], dacc, 0, 0, 0); \
      } \
      if (MIXER == MIX_D) { _Pragma("unroll") for (int e_ = 0; e_ < 4; ++e_) { oacc[e_] = FMUL(oacc[e_], rr_cur); dacc[e_] = FMUL(dacc[e_], rr_cur); } } \
      oacc = __builtin_amdgcn_mfma_f32_16x16x32_bf16(ldfrag2(VTc, LD_T, vt * 16 + fr, fq * 8, 32 + fq * 8), __builtin_bit_cast(bf16x8, sb0), oacc, 0, 0, 0); \
      if (it >= 2) oacc = __builtin_amdgcn_mfma_f32_16x16x32_bf16(ldfrag2(VTc, LD_T, vt * 16 + fr, 64 + fq * 8, 96 + fq * 8), __builtin_bit_cast(bf16x8, sb1), oacc, 0, 0, 0); \
      float dn = 1.0f; \
      if (NVT == 3) { \
        dacc = __builtin_amdgcn_mfma_f32_16x16x32_bf16(ldfrag2(VTc, LD_T, 32 + fr, fq * 8, 32 + fq * 8), __builtin_bit_cast(bf16x8, sb0), dacc, 0, 0, 0); \
        if (it >= 2) dacc = __builtin_amdgcn_mfma_f32_16x16x32_bf16(ldfrag2(VTc, LD_T, 32 + fr, 64 + fq * 8, 96 + fq * 8), __builtin_bit_cast(bf16x8, sb1), dacc, 0, 0, 0); \
        const float den = __shfl(dacc[0], fr); \
        dn = 1.0f / fmaxf(fabsf(den), EMc[it * 16 + fr]); \
      } \
      { \
        const int i = it * 16 + fr; \
        const int ti = dir ? (SEQ - 1 - (n * 64 + i)) : (n * 64 + i); \
        const f32x4 o = (f32x4){FMUL(oacc[0], dn), FMUL(oacc[1], dn), FMUL(oacc[2], dn), FMUL(oacc[3], dn)}; \
        *(u32x2*)(O + PIDX(tokbase + ti, ocol + vt * 16 + fq * 4)) = (u32x2){pk_hw(o[0], o[1]), pk_hw(o[2], o[3])}; \
      } \
      const int dts = (DK == 128) ? wid : (wid & 3); \
      const bf16x8 kf0 = ldfrag(KTc, LD_T, dts * 16 + fr, fq * 16), kf1 = ldfrag(KTc, LD_T, dts * 16 + fr, 64 + fq * 16); \
      const f32x4 dc = *(const f32x4*)(DECc + dts * 16 + fq * 4); \
_Pragma("unroll") \
      for (int s = 0; s < NST; ++s) { \
        const int dt = dts, vt2 = (DK == 128) ? s : (wid >> 2); \
        f32x4 acc = (f32x4){FMUL(sacc[s][0], dc[0]), FMUL(sacc[s][1], dc[1]), FMUL(sacc[s][2], dc[2]), FMUL(sacc[s][3], dc[3])}; \
        acc = __builtin_amdgcn_mfma_f32_16x16x32_bf16(kf0, ldfrag(VTc, LD_T, vt2 * 16 + fr, fq * 16), acc, 0, 0, 0); \
        acc = __builtin_amdgcn_mfma_f32_16x16x32_bf16(kf1, ldfrag(VTc, LD_T, vt2 * 16 + fr, 64 + fq * 16), acc, 0, 0, 0); \
        sacc[s] = acc; \
        *(u32x2*)(STn + (vt2 * 16 + fr) * LD_D + (dt * 16 + fq * 4) * 2) = (u32x2){pk_hw(acc[0], acc[1]), pk_hw(acc[2], acc[3])}; \
      } \
    } \
    } \
    rr_cur = rr_next; \
    lds_barrier(); \
  } while (0)
  static_assert(NCH % 2 == 0, "chunk count must be even");
#pragma unroll 1
  for (int n2 = 0; n2 < NCH; n2 += 2) { SCAN_ITER(n2, R, Rv); SCAN_ITER(n2 + 1, Rn, Rvn); }
#undef SCAN_ITER
#undef A_LOAD
#undef A_PREP
}

template <int MIXER>
__device__ __forceinline__ void scan_dispatch2(unsigned char* lds, int wv, const Params& p, int id) {
  const int vs = id & 3, dir = (id >> 2) & 1, h = (id >> 3) & 3, b = id >> 5;
  scan_item2<MIXER>(lds, wv, p, b, h, dir, vs);
}
}

__device__ __forceinline__ void scan_phase2(unsigned char* lds, int wv, const Params& p, int layer, int convert) {
  bool light = false;
  for (int it0 = blockIdx.x; it0 < 256; it0 += gridDim.x) {
    const int xq = it0 & 7, yq = it0 >> 3, stream = (yq >> 2) * 8 + xq;
    const int item = (stream >> 5) * 128 + (stream & 31) * 4 + (yq & 3);
    if (layer == 0) { if (item < 128) scan2::scan_dispatch2<scan::MIX_A>(lds, wv, p, item); else scan2::scan_dispatch2<scan::MIX_B>(lds, wv, p, item - 128); }
    else { if (item < 128) scan2::scan_dispatch2<scan::MIX_D>(lds, wv, p, item); else scan2::scan_dispatch2<scan::MIX_C>(lds, wv, p, item - 128); }
    light = item >= 128;
    __syncthreads();
  }
  if (convert) {
    const int G = gridDim.x, b = blockIdx.x;
    if (G == 256) { if (light) { moe_weight_convert(lds, wv, p, layer, 0, b - 128, 128); if (p.big_ws) moe_weight_convert(lds, wv, p, layer, 1, b - 128, 128); } }
    else { moe_weight_convert(lds, wv, p, layer, 0, b, G); if (p.big_ws) moe_weight_convert(lds, wv, p, layer, 1, b, G); }
  }
}
#endif
#ifndef CPU_EMU
#define XB_BASE     2048
#define XB_TMO      (XB_BASE + 128)
#define XB_XCNT(j)  (XB_BASE + 256  + 64 * (j))
#define XB_XSUB(j)  (XB_BASE + 1280 + 64 * (j))
#define XB_XGEN(j)  (XB_BASE + 2304 + 64 * (j))
#define XB_TOP      (XB_BASE + 3328)
#define XB_TOPGEN   (XB_BASE + 3392)
#define XB_WORDS    3456
#define XB_SPIN_CAP (1u << 22)
#define XB_LDS_OFF  (LDS_BYTES - 16)
__device__ __forceinline__ unsigned xb_ld(unsigned* p)              { return __hip_atomic_load(p, __ATOMIC_RELAXED, __HIP_MEMORY_SCOPE_AGENT); }
__device__ __forceinline__ unsigned xb_add(unsigned* p, unsigned v) { return __hip_atomic_fetch_add(p, v, __ATOMIC_RELAXED, __HIP_MEMORY_SCOPE_AGENT); }
__device__ __forceinline__ unsigned xb_xcc_id() { return (unsigned)__builtin_amdgcn_s_getreg((3 << 11) | 20) & 0xFu; }
#define XB_SPIN(cond, bar) do { unsigned _sp = 0; while (cond) { __builtin_amdgcn_s_sleep(1); \
    if ((++_sp & 255u) == 0u) { if (xb_ld(&(bar)[XB_TMO])) break; if (_sp > XB_SPIN_CAP) { atomicAdd(&(bar)[XB_TMO], 1u); break; } } } } while (0)
__device__ __forceinline__ void grid_bar(unsigned* bar, unsigned char* lds_raw, int wv) {
  asm volatile("s_waitcnt vmcnt(0)" ::: "memory");
  __syncthreads();
  if (wv == 0 && lane_id() == 0) {
    volatile unsigned* st = (volatile unsigned*)(lds_raw + XB_LDS_OFF);
    __builtin_amdgcn_s_waitcnt(0);
    const unsigned x = xb_xcc_id();
    unsigned nloc = st[0], nx = st[1];
    if (nloc == 0u) {
      const unsigned G = gridDim.x; unsigned sum, cnt, mine, sp = 0u;
      for (;;) { sum = 0u; cnt = 0u; mine = 0u;
#pragma unroll
        for (unsigned j = 0; j < 16; ++j) { const unsigned c = xb_ld(&bar[XB_XCNT(j)]); sum += c; cnt += (c > 0u) ? 1u : 0u; mine = (j == x) ? c : mine; }
        if (sum == G) break;
        __builtin_amdgcn_s_sleep(1);
        if ((++sp & 255u) == 0u) { if (xb_ld(&bar[XB_TMO])) break; if (sp > XB_SPIN_CAP) { atomicAdd(&bar[XB_TMO], 1u); break; } } }
      nloc = mine > 0u ? mine : 1u; nx = cnt > 0u ? cnt : 1u; st[0] = nloc; st[1] = nx;
    }
    const unsigned old = xb_add(&bar[XB_XSUB(x)], 1u);
    const unsigned gen = old / nloc;
    if (old + 1u == (gen + 1u) * nloc) {
      __builtin_amdgcn_fence(__ATOMIC_RELEASE, "agent");
      asm volatile("s_waitcnt vmcnt(0)" ::: "memory");
      const unsigned og = xb_add(&bar[XB_TOP], 1u);
      const unsigned tg = og / nx;
      if (og + 1u == (tg + 1u) * nx) xb_add(&bar[XB_TOPGEN], 1u);
      else XB_SPIN(xb_ld(&bar[XB_TOPGEN]) == tg, bar);
      __builtin_amdgcn_fence(__ATOMIC_ACQUIRE, "agent");
      xb_add(&bar[XB_XGEN(x)], 1u);
      asm volatile("s_waitcnt vmcnt(0)" ::: "memory");
    } else {
      XB_SPIN(xb_ld(&bar[XB_XGEN(x)]) == gen, bar);
      __builtin_amdgcn_fence(__ATOMIC_ACQUIRE, "agent");
      asm volatile("s_waitcnt vmcnt(0)" ::: "memory");
    }
  }
  __syncthreads();
}
#if (PROBE_DUP & 16)
#define grid_bar(a, b, c) do { grid_bar(a, b, c); grid_bar(a, b, c); } while (0)
#endif

__global__ void __launch_bounds__(NTHREADS) mk_fwd(Params p) {
  extern __shared__ __attribute__((aligned(16))) unsigned char lds_raw[];
  cg::grid_group grid = cg::this_grid();
  const int G = gridDim.x, bid = blockIdx.x;
  const int wv = __builtin_amdgcn_readfirstlane(threadIdx.x >> 6);
  PG8_LAS unsigned char* lds = (PG8_LAS unsigned char*)lds_raw;
  unsigned char* ws = p.ws;

  if (threadIdx.x < 4) ((unsigned*)(lds_raw + XB_LDS_OFF))[threadIdx.x] = 0u;
  p0_prologue(lds_raw, wv, p);
#if (PROBE_DUP & 128)
  p0_prologue(lds_raw, wv, p);
#endif
  grid.sync();
  unsigned* bar = (unsigned*)(ws + WS_CTL);
  if (wv == 0 && lane_id() == 0) (void)xb_add(&bar[XB_XCNT(xb_xcc_id())], 1u);
  for (int layer = 0; layer < 2; ++layer) {
    { ProbInProj pr; pr.so.init(NTOK, layer == 0 ? PM_AB : PM_CD, G, bid); pr.A = (const char*)(ws + WS_HB); pr.Bt = (const char*)(ws + (layer == 0 ? WS_WIN_AB : WS_WIN_CD));
      pr.P = (bf16_t*)(ws + WS_R1); pr.bias = p.in[layer == 0 ? I_AB_B_IN : I_CD_B_IN]; pr.lb = (const float*)(ws + WS_LB); pr.layer = layer;
      pg8::gemm_phase(lds, pr, wv);
#if (PROBE_DUP & (1 | 2048))
      pg8::gemm_phase(lds, pr, wv);
#endif
      if (layer == 0) side_phase<32>(lds_raw, wv, p, 0); else side_phase<16>(lds_raw, wv, p, 1);
#if (PROBE_DUP & 256)
      if (layer == 0) side_phase<32>(lds_raw, wv, p, 0); else side_phase<16>(lds_raw, wv, p, 1);
#endif
 }
    grid_bar(bar, lds_raw, wv);
    if (layer == 1) { convd_phase(lds_raw, wv, p); grid_bar(bar, lds_raw, wv); }
    scan_phase2(lds_raw, wv, p, layer, 1);
#if (PROBE_DUP & 2)
    scan_phase2(lds_raw, wv, p, layer, 0);
#endif
#if (PROBE_DUP & 512)
    if (layer == 0) scan_phase2(lds_raw, wv, p, layer, 0);
#endif
#if (PROBE_DUP & 1024)
    if (layer == 1) scan_phase2(lds_raw, wv, p, layer, 0);
#endif
    grid_bar(bar, lds_raw, wv);
    headnorm_phase(lds_raw, wv, p, layer);
#if (PROBE_DUP & 8)
    headnorm_phase(lds_raw, wv, p, layer);
#endif
    grid_bar(bar, lds_raw, wv);
    { ProbOutProj pr; pr.so.init(NTOK, 1024, G, bid); pr.A = (const char*)(ws + WS_MIX); pr.Bt = (const char*)(ws + (layer == 0 ? WS_WOUT_AB : WS_WOUT_CD)); pr.Y = (float*)(ws + WS_R2); pr.Hres = layer == 0 ? p.in[I_X] : p.out;
      pg8::gemm_phase(lds, pr, wv);
#if (PROBE_DUP & (1 | 16384))
      pg8::gemm_phase(lds, pr, wv);
#endif
      if (!p.big_ws) moe_weight_convert(lds_raw, wv, p, layer, 1, bid, G);
 }
    grid_bar(bar, lds_raw, wv);
#if (PROBE_DUP & 32)
    ln_phase(lds_raw, wv, p, layer, 0, 1);
#endif
    ln_phase(lds_raw, wv, p, layer, 0);
    grid_bar(bar, lds_raw, wv);
    { ProbMoe1 pr; pr.mo.init((const int*)((const unsigned*)(ws + WS_CTL) + CW_CNT(layer)), 8, G, bid, lds_raw, wv);
      pr.A = (const char*)(ws + WS_MIX); pr.W13 = (const char*)(ws + WS_W13); pr.list = (const int*)(ws + WS_LIST) + (size_t)layer * NEXP * NTOK; pr.H = (bf16_t*)(ws + WS_H);
      pg8::gemm_phase(lds, pr, wv);
#if (PROBE_DUP & (1 | 4096))
      pg8::gemm_phase(lds, pr, wv);
#endif
 }
    grid_bar(bar, lds_raw, wv);
    { ProbMoe2 pr; pr.mo.init((const int*)((const unsigned*)(ws + WS_CTL) + CW_CNT(layer)), 4, G, bid, lds_raw, wv);
      pr.A = (const char*)(ws + WS_H); pr.W2 = (const char*)(ws + (p.big_ws ? WS_W2X : WS_W2)); pr.Y = (bf16_t*)(ws + WS_R2);
      pg8::gemm_phase(lds, pr, wv);
#if (PROBE_DUP & (1 | 8192))
      pg8::gemm_phase(lds, pr, wv);
#endif
 }
    grid_bar(bar, lds_raw, wv);
#if (PROBE_DUP & 64)
    ln_phase(lds_raw, wv, p, layer, 1, 1);
#endif
    ln_phase(lds_raw, wv, p, layer, 1);
    if (layer == 0) grid_bar(bar, lds_raw, wv);
  }
}

extern "C" void kernel_launch(void* const* d_in, const int* in_sizes, int n_in, void* d_out, int out_size, void* d_ws, size_t ws_size, hipStream_t stream) {
  static int grid_blocks = 0;
  if (grid_blocks == 0) {
    if (n_in != N_IN || ws_size < WS_END || out_size != NTOK * 1024) { fprintf(stderr, "kernel_launch: bad shapes: n_in %d ws %zu (need %zu) out %d\n", n_in, ws_size, (size_t)WS_END, out_size); grid_blocks = -1; return; }
    int dev = 0, cus = 0, per_cu = 0;
    hipGetDevice(&dev); hipDeviceGetAttribute(&cus, hipDeviceAttributeMultiprocessorCount, dev);
    if (hipFuncSetAttribute((const void*)mk_fwd, hipFuncAttributeMaxDynamicSharedMemorySize, LDS_BYTES) != hipSuccess) { fprintf(stderr, "kernel_launch: hipFuncSetAttribute failed\n"); grid_blocks = -1; return; }
    if (hipOccupancyMaxActiveBlocksPerMultiprocessor(&per_cu, (const void*)mk_fwd, NTHREADS, LDS_BYTES) != hipSuccess || per_cu < 1) { fprintf(stderr, "kernel_launch: occupancy query failed (%d)\n", per_cu); grid_blocks = -1; return; }
    grid_blocks = cus;
    (void)in_sizes;
  }
  if (grid_blocks < 0) return;
  Params p{};
  for (int i = 0; i < N_IN; ++i) p.in[i] = (const float*)d_in[i];
  p.out = (float*)d_out; p.ws = (unsigned char*)d_ws; p.big_ws = ws_size >= (size_t)WS_END_BIG ? 1 : 0;
  void* args[] = {&p};
  hipError_t e = hipLaunchCooperativeKernel((const void*)mk_fwd, dim3(grid_blocks), dim3(NTHREADS), args, LDS_BYTES, stream);
  if (e != hipSuccess) fprintf(stderr, "cooperative launch failed: %s (grid %d)\n", hipGetErrorString(e), grid_blocks);
}
#endif
```

```cpp
#ifdef CPU_EMU
#include <cmath>
#include <cstdio>
#include <cstring>
#include <cstdlib>
#include <cstddef>
#define DEV
#define DEV_INLINE static inline
typedef void* hipStream_t;
#else
#include <hip/hip_runtime.h>
#include <hip/hip_bf16.h>
#include <cstdio>
#define DEV __device__ __forceinline__
#define DEV_INLINE __device__ __forceinline__
#endif
#ifndef PROBE_DUP
#define PROBE_DUP 0
#endif
#ifndef BATCH
#define BATCH 4
#endif
#ifndef SEQ
#define SEQ 8192
#endif
#define DM 1024
#define NTOK (BATCH * SEQ)
#define P_AB 4128
#define P_CD 3600
#define PM_AB 4096
#define PM_CD 3584
#define NEXP 16
#define ALPHA_F 1.4142135623730951f
#define LN_EPS_F 1e-5f
#define NORM_EPS_F 1e-6f
#define HROWS (2 * NTOK + NEXP * 256)

typedef unsigned short bf16_t;

DEV_INLINE float bf2f(bf16_t b) { unsigned u = ((unsigned)b) << 16; float f; memcpy(&f, &u, 4); return f; }
DEV_INLINE bf16_t f2bf(float f) { unsigned u; memcpy(&u, &f, 4); u += 0x7FFFu + ((u >> 16) & 1u); return (bf16_t)(u >> 16); }
DEV_INLINE float sigmoidf_(float x) { return 1.0f / (1.0f + expf(-x)); }
DEV_INLINE float siluf_(float x) { return x / (1.0f + expf(-x)); }
DEV_INLINE float logsigmoidf_(float x) { return fminf(x, 0.0f) - log1pf(expf(-fabsf(x))); }

#define AL256(x) (((size_t)(x) + 255) & ~(size_t)255)
#define WS_CTL    ((size_t)0)
#define WS_HB     ((size_t)65536)
#define WS_R1     (WS_HB + (size_t)NTOK * 1024 * 2)
#define R1_P_BYTES ((size_t)NTOK * 4096 * 2)
#define R1_MIN    ((size_t)NTOK * 1024 * 2 + AL256((size_t)HROWS * 1024 * 2))
#define R1_PL     (R1_P_BYTES + (size_t)NTOK * 512 * 2)
#define R1_BYTES  (R1_PL > R1_MIN ? R1_PL : R1_MIN)
#define WS_LFB    (WS_R1 + R1_P_BYTES)
#define WS_MIX    (WS_R1)
#define WS_H      (WS_R1 + (size_t)NTOK * 1024 * 2)
#define WS_W13    (WS_HB)
#define WS_W2     (WS_LFB)
#define WMOE_BYTES ((size_t)NEXP * 3072 * 1024 * 2)
#define WS_R2     (WS_R1 + R1_BYTES)
#define R2_BYTES  ((size_t)HROWS * 1024 * 2 > (size_t)NTOK * 1024 * 4 ? (size_t)HROWS * 1024 * 2 : (size_t)NTOK * 1024 * 4)
#define WS_SIDE   (WS_R2 + AL256(R2_BYTES))
#define WS_WIN_AB (WS_SIDE + (size_t)NTOK * 32 * 4)
#define WS_WIN_CD (WS_WIN_AB + (size_t)4128 * 1024 * 2)
#define WS_WOUT_AB (WS_WIN_CD + (size_t)3600 * 1024 * 2)
#define WS_WOUT_CD (WS_WOUT_AB + (size_t)1024 * 1024 * 2)
#define WS_ROPE   (WS_WOUT_CD + (size_t)1024 * 1024 * 2)
#define WS_LB     (WS_ROPE + (size_t)SEQ * 64 * 4)
#define WS_LIST   (WS_LB + 4096)
#define WS_ASSIGN (WS_LIST + (size_t)2 * NEXP * NTOK * 4)
#define WS_GATE   (WS_ASSIGN + (size_t)NTOK * 16)
#define WS_END    (WS_GATE + (size_t)NTOK * 8)
#define WS_W2X    (AL256(WS_END))
#define WS_END_BIG (WS_W2X + (size_t)NEXP * 1024 * 1024 * 2)
#define CW_CNT(layer) (64 + 256 * (layer))

#define PSTRIDE 4096
#define PIDX(tok, col) ((((size_t)((col) >> 7)) * NTOK + (size_t)(tok)) * 128 + (size_t)((col) & 127))

enum { I_X, I_AB_W_IN, I_AB_B_IN, I_HGRN_LB, I_GK_UP, I_GK_B, I_HGRN_NORM, I_GLA_NORM, I_AB_W_OUT,
       I_CD_W_IN, I_CD_B_IN, I_CONV_W, I_CONV_B, I_FGATE_B, I_RET_NORM, I_MLSTM_NORM, I_CD_W_OUT,
       I_LN_MIX_G, I_LN_MIX_B, I_LN_FFN_G, I_LN_FFN_B, I_ROUTER_W, I_ROUTER_B, I_MOE_W1, I_MOE_W3, I_MOE_W2, N_IN };

struct Params {
  const float* in[N_IN];
  float* out;
  unsigned char* ws;
  long long big_ws;
};

DEV_INLINE float epi_ab(int col, float v, const float* lb) {
  if (col < 512) return siluf_(v);
  if (col < 1536) { float l = lb[(col - 512) & 511]; return logf(l + (1.0f - l) * sigmoidf_(v)); }
  if (col >= 2560 && col < 2816) return v * 0.125f;
  return v;
}

DEV_INLINE void route_from_logits(const float* lg, const float* rb, int* e_out, float* g_out) {
  float mx = lg[0];
#pragma unroll
  for (int e = 1; e < 16; ++e) mx = fmaxf(mx, lg[e]);
  float sc[16]; float sum = 0.f;
#pragma unroll
  for (int e = 0; e < 16; ++e) { sc[e] = expf(lg[e] - mx); sum += sc[e]; }
  float inv = 1.0f / sum;
  float best_gs = -1e30f; int be1 = 0, be2 = 1; float bs1 = 0.f, bs2 = 0.f;
#pragma unroll
  for (int gq = 0; gq < 4; ++gq) {
    float m1 = -1e30f, m2 = -1e30f, s1 = 0.f, s2 = 0.f; int i1 = 0, i2 = 0;
#pragma unroll
    for (int i = 0; i < 4; ++i) {
      float s = sc[gq * 4 + i] * inv; float v = s + rb[gq * 4 + i];
      if (v > m1) { m2 = m1; i2 = i1; s2 = s1; m1 = v; i1 = gq * 4 + i; s1 = s; }
      else if (v > m2) { m2 = v; i2 = gq * 4 + i; s2 = s; }
    }
    float gs = m1 + m2;
    if (gs > best_gs) { best_gs = gs; be1 = i1; be2 = i2; bs1 = s1; bs2 = s2; }
  }
  e_out[0] = be1; e_out[1] = be2; g_out[0] = bs1 / (bs1 + bs2); g_out[1] = bs2 / (bs1 + bs2);
}
#ifndef CPU_EMU
namespace pg8 {
#define PG8_LAS __attribute__((address_space(3)))
typedef short bf16x8 __attribute__((ext_vector_type(8)));
typedef float f32x4 __attribute__((ext_vector_type(4)));
typedef unsigned u32x4 __attribute__((ext_vector_type(4)));
typedef unsigned u32x2 __attribute__((ext_vector_type(2)));
constexpr int BM = 256, BK = 64, HALF = 128, HTB = HALF * BK * 2, STAGE_BYTES = 8 * HTB, NXCD = 8, WGM = 8, GK = 1024;

__device__ __forceinline__ int lds_byte(int r, int c) { const int st = (r >> 4) * 2 + (c >> 5), rr = r & 15, cc = c & 31, ob = rr * 64 + cc * 2; return st * 1024 + (ob ^ (((ob >> 9) & 1) << 5)); }
__device__ __forceinline__ void stage_rc(int b, int& R, int& C) { const int st = b / 1024, sb = b % 1024, swz = sb ^ (((sb >> 9) & 1) << 5); R = (st >> 1) * 16 + swz / 64; C = (st & 1) * 32 + (swz % 64) / 2; }
__device__ __forceinline__ int perm32(int rho) { const int n = rho >> 4, i = rho & 15; return 8 * (i >> 2) + 4 * n + (i & 3); }
__device__ __forceinline__ unsigned cvt_pk_bf16(float lo, float hi) { unsigned r; asm volatile("v_cvt_pk_bf16_f32 %0, %1, %2" : "=v"(r) : "v"(lo), "v"(hi)); return r; }

struct Unit { int pm, pn, e, row0, ne, ui; };

struct StaticOrder {
  int nM, nN, nwg, G, c;
  __device__ void init(int M, int N, int G_, int c_) { nM = M / BM; nN = N / BM; nwg = nM * nN; G = G_; c = c_; }
  __device__ bool next(int i, Unit& u) const {
    const long L = (long)i * G + c; if (L >= nwg) return false;
    int wgid = (int)L; { const int q = nwg / NXCD, r = nwg % NXCD, xcd = wgid % NXCD, off = wgid / NXCD; wgid = (xcd < r ? xcd * (q + 1) : r * (q + 1) + (xcd - r) * q) + off; }
    const int nig = WGM * nN, gid = wgid / nig, fm = gid * WGM, gsz = (nM - fm) < WGM ? (nM - fm) : WGM;
    u.pm = fm + ((wgid % nig) % gsz); u.pn = (wgid % nig) / gsz; u.e = 0; u.row0 = u.pm * BM; u.ne = 0; u.ui = i; return true;
  }
};

template <class Prob>
__device__ __forceinline__ void gemm_phase(PG8_LAS unsigned char* lds, const Prob& S, int wv) {
  int wv_ = wv; asm volatile("" : "+s"(wv_));
  int l_; asm volatile("v_mbcnt_lo_u32_b32 %0, -1, 0\n\tv_mbcnt_hi_u32_b32 %0, -1, %0" : "=v"(l_));
  int tid_ = wv_ * 64 + l_;
  const int tid = tid_, wid = __builtin_amdgcn_readfirstlane(tid >> 6), lane = tid & 63, wr = wid >> 2, wc = wid & 3, fr = lane & 15, fq = lane >> 4;
  constexpr int K = GK, nt = K / BK;
  int sR[2], sC[2]; unsigned voffB[2];
#pragma unroll
  for (int i = 0; i < 2; ++i) { int R, C; stage_rc(tid * 16 + i * 8192, R, C); sR[i] = R; sC[i] = C; const int Rb = Prob::PERM ? ((R & ~31) + perm32(R & 31)) : R; voffB[i] = (unsigned)(Rb * K + C) * 2u; }
  const size_t kstep = (size_t)(BK * 2);
  const size_t hstep = (size_t)HALF * K * 2;
  const unsigned ldsw = (unsigned)wid * 1024u;
  const int aoff = lds_byte(wr * 64 + fr, fq * 8), boff = lds_byte(wc * 32 + fr, fq * 8);
#define PG8_SA(b, h) (((b) * 2 + (h)) * HTB)
#define PG8_SB(b, h) ((4 + (b) * 2 + (h)) * HTB)
#define PG8_STAGE(bufoff, gbase, voff) do { _Pragma("unroll") for (int _i = 0; _i < 2; ++_i) \
    __builtin_amdgcn_global_load_lds((const unsigned*)((const char*)(gbase) + (voff)[_i]), (PG8_LAS unsigned*)(lds + (bufoff) + ldsw + _i * 8192), 16, 0, 0); } while (0)
#define PG8_LDA(dst, b, h) do { _Pragma("unroll") for (int m = 0; m < 4; ++m) _Pragma("unroll") for (int k = 0; k < 2; ++k) dst[m][k] = *(const PG8_LAS bf16x8*)(lds + PG8_SA(b, h) + aoff + m * 2048 + k * 1024); } while (0)
#define PG8_LDB(dst, b, h) do { _Pragma("unroll") for (int n = 0; n < 2; ++n) _Pragma("unroll") for (int k = 0; k < 2; ++k) dst[n][k] = *(const PG8_LAS bf16x8*)(lds + PG8_SB(b, h) + boff + n * 2048 + k * 1024); } while (0)
#define PG8_MMA(ai, bj, At, Bt) do { __builtin_amdgcn_s_setprio(1); _Pragma("unroll") for (int m = 0; m < 4; ++m) _Pragma("unroll") for (int n = 0; n < 2; ++n) _Pragma("unroll") for (int k = 0; k < 2; ++k) \
    acc[ai][bj][m][n] = __builtin_amdgcn_mfma_f32_16x16x32_bf16(Bt[n][k], At[m][k], acc[ai][bj][m][n], 0, 0, 0); __builtin_amdgcn_s_setprio(0); } while (0)
#define PG8_WAIT_V(n) asm volatile("s_waitcnt vmcnt(" #n ")" ::: "memory")
#define PG8_WAIT_L(n) asm volatile("s_waitcnt lgkmcnt(" #n ")" ::: "memory")
#define PG8_BAR __builtin_amdgcn_s_barrier()
#define PG8_SCHED __builtin_amdgcn_sched_barrier(0)
  Unit cur, nxt; int ui = 0;
  if (!S.next(0, cur)) return;
  f32x4 acc[2][2][4][2];
#pragma unroll
  for (int a = 0; a < 2; ++a)
#pragma unroll
    for (int b = 0; b < 2; ++b)
#pragma unroll
      for (int m = 0; m < 4; ++m)
#pragma unroll
        for (int n = 0; n < 2; ++n) acc[a][b][m][n] = (f32x4){0.f, 0.f, 0.f, 0.f};
  bf16x8 At[4][2], B0[2][2], B1[2][2];
  unsigned oc0[2], oc1[2], on0[2], on1[2];
#pragma unroll
  for (int i = 0; i < 2; ++i) { oc0[i] = S.a_off(cur, sR[i]) + (unsigned)sC[i] * 2u; oc1[i] = S.a_off(cur, HALF + sR[i]) + (unsigned)sC[i] * 2u; }
  const char* const Ab = S.a_base();
  const char* cB = S.b_base(cur);
  PG8_STAGE(PG8_SB(0, 0), cB, voffB); PG8_STAGE(PG8_SB(0, 1), cB + hstep, voffB); PG8_STAGE(PG8_SA(0, 0), Ab, oc0); PG8_STAGE(PG8_SA(0, 1), Ab, oc1);
  if (wr == 1) PG8_BAR;
  PG8_WAIT_V(2); PG8_BAR;
  PG8_STAGE(PG8_SB(1, 0), cB + kstep, voffB); PG8_STAGE(PG8_SA(1, 0), Ab + kstep, oc0); PG8_STAGE(PG8_SB(1, 1), cB + hstep + kstep, voffB);
  PG8_WAIT_V(6); PG8_BAR;
  for (;;) {
    const bool has_next = S.next(ui + 1, nxt);
    const char* nB = cB;
    if (has_next) {
      nB = S.b_base(nxt);
      int l2_; asm volatile("v_mbcnt_lo_u32_b32 %0, -1, 0\n\tv_mbcnt_hi_u32_b32 %0, -1, %0" : "=v"(l2_));
      const int tid2 = wid * 64 + l2_;
#pragma unroll
      for (int i = 0; i < 2; ++i) { int R, C; stage_rc(tid2 * 16 + i * 8192, R, C); on0[i] = S.a_off(nxt, R) + (unsigned)C * 2u; on1[i] = S.a_off(nxt, HALF + R) + (unsigned)C * 2u; }
    } else {
#pragma unroll
      for (int i = 0; i < 2; ++i) { on0[i] = oc0[i]; on1[i] = oc1[i]; }
    }
    for (int t = 0; t < nt; t += 2) {
      const bool last = (t == nt - 2);
      const char* a1 = Ab + (size_t)(t + 1) * kstep;
      const char* a2 = last ? Ab : Ab + (size_t)(t + 2) * kstep; const char* b2 = last ? nB : cB + (size_t)(t + 2) * kstep;
      const char* a3 = a2 + kstep; const char* b3 = b2 + kstep;
      unsigned o20[2], o21[2];
#pragma unroll
      for (int i = 0; i < 2; ++i) { o20[i] = last ? on0[i] : oc0[i]; o21[i] = last ? on1[i] : oc1[i]; }
      PG8_LDB(B0, 0, 0); PG8_LDB(B1, 0, 1); PG8_SCHED; PG8_LDA(At, 0, 0); PG8_STAGE(PG8_SA(1, 1), a1, oc1);
      PG8_WAIT_V(8); PG8_WAIT_L(0); PG8_BAR; PG8_MMA(0, 0, At, B0); PG8_MMA(0, 1, At, B1); PG8_BAR; PG8_SCHED;
      PG8_LDA(At, 0, 1); PG8_STAGE(PG8_SB(0, 0), b2, voffB); PG8_STAGE(PG8_SB(0, 1), b2 + hstep, voffB); PG8_STAGE(PG8_SA(0, 0), a2, o20);
      PG8_WAIT_V(8); PG8_WAIT_L(0); PG8_BAR; PG8_MMA(1, 0, At, B0); PG8_MMA(1, 1, At, B1); PG8_BAR; PG8_SCHED;
      PG8_LDB(B0, 1, 0); PG8_LDB(B1, 1, 1); PG8_SCHED; PG8_LDA(At, 1, 0); PG8_STAGE(PG8_SA(0, 1), a2, o21);
      PG8_WAIT_V(8); PG8_WAIT_L(0); PG8_BAR; PG8_MMA(0, 0, At, B0); PG8_MMA(0, 1, At, B1); PG8_BAR; PG8_SCHED;
      PG8_LDA(At, 1, 1); PG8_STAGE(PG8_SB(1, 0), b3, voffB); PG8_STAGE(PG8_SB(1, 1), b3 + hstep, voffB); PG8_STAGE(PG8_SA(1, 0), a3, o20);
      PG8_WAIT_V(8); PG8_WAIT_L(0); PG8_BAR; PG8_MMA(1, 0, At, B0); PG8_MMA(1, 1, At, B1); PG8_BAR; PG8_SCHED;
    }
    if (wr == 0) PG8_BAR;
    { int l3_; asm volatile("v_mbcnt_lo_u32_b32 %0, -1, 0\n\tv_mbcnt_hi_u32_b32 %0, -1, %0" : "=v"(l3_));
      S.epi(acc, cur, wr, wc, l3_ & 15, l3_ >> 4); }
    if (!has_next) break;
#pragma unroll
    for (int a = 0; a < 2; ++a)
#pragma unroll
      for (int b = 0; b < 2; ++b)
#pragma unroll
        for (int m = 0; m < 4; ++m)
#pragma unroll
          for (int n = 0; n < 2; ++n) acc[a][b][m][n] = (f32x4){0.f, 0.f, 0.f, 0.f};
    cur = nxt; cB = nB; ++ui;
#pragma unroll
    for (int i = 0; i < 2; ++i) { oc0[i] = on0[i]; oc1[i] = on1[i]; }
    if (wr == 1) PG8_BAR;
  }
  PG8_WAIT_V(0);
  PG8_BAR;
#undef PG8_SA
#undef PG8_SB
#undef PG8_STAGE
#undef PG8_LDA
#undef PG8_LDB
#undef PG8_MMA
#undef PG8_WAIT_V
#undef PG8_WAIT_L
#undef PG8_BAR
#undef PG8_SCHED
}
}
#endif
#ifndef CPU_EMU
#include <hip/hip_cooperative_groups.h>
namespace cg = cooperative_groups;
#define LAS __attribute__((address_space(3)))
#define NTHREADS 512
#define LDS_BYTES (154 * 1024)
typedef float f32x4 __attribute__((ext_vector_type(4)));
typedef short bf16x8 __attribute__((ext_vector_type(8)));
typedef unsigned u32x4 __attribute__((ext_vector_type(4)));
typedef unsigned u32x2 __attribute__((ext_vector_type(2)));

struct Ctx { int tid, lane, wid, G, bid; unsigned char* lds; };
__device__ __forceinline__ int lane_id() { int l; asm volatile("v_mbcnt_lo_u32_b32 %0, -1, 0\n\tv_mbcnt_hi_u32_b32 %0, -1, %0" : "=v"(l)); return l; }
__device__ __forceinline__ int opaque_tid(int wv) { int w = wv; asm volatile("" : "+s"(w)); int t = w * 64 + lane_id(); asm volatile("" : "+v"(t)); return t; }
__device__ __forceinline__ Ctx make_ctx(unsigned char* lds, int wv) { Ctx c; c.tid = opaque_tid(wv); c.lane = c.tid & 63; c.wid = __builtin_amdgcn_readfirstlane(c.tid >> 6); c.G = gridDim.x; c.bid = blockIdx.x; c.lds = lds; return c; }

__device__ __forceinline__ float wave_sum(float x) {
  x += __builtin_bit_cast(float, __builtin_amdgcn_update_dpp(0, __builtin_bit_cast(int, x), 0x111, 0xf, 0xf, false));
  x += __builtin_bit_cast(float, __builtin_amdgcn_update_dpp(0, __builtin_bit_cast(int, x), 0x112, 0xf, 0xf, false));
  x += __builtin_bit_cast(float, __builtin_amdgcn_update_dpp(0, __builtin_bit_cast(int, x), 0x114, 0xf, 0xf, false));
  x += __builtin_bit_cast(float, __builtin_amdgcn_update_dpp(0, __builtin_bit_cast(int, x), 0x118, 0xf, 0xf, false));
  x += __builtin_bit_cast(float, __builtin_amdgcn_update_dpp(0, __builtin_bit_cast(int, x), 0x142, 0xa, 0xf, false));
  x += __builtin_bit_cast(float, __builtin_amdgcn_update_dpp(0, __builtin_bit_cast(int, x), 0x143, 0xc, 0xf, false));
  return __builtin_bit_cast(float, __builtin_amdgcn_readlane(__builtin_bit_cast(int, x), 63));
}
__device__ __forceinline__ float fsigmoid(float x) { return __builtin_amdgcn_rcpf(1.0f + __builtin_amdgcn_exp2f(-1.4426950408889634f * x)); }
__device__ __forceinline__ float fsilu(float x) { return x * fsigmoid(x); }
__device__ __forceinline__ float flog2sigmoid(float x) { const float y = x * 1.4426950408889634f; return fminf(y, 0.f) - __builtin_amdgcn_logf(1.0f + __builtin_amdgcn_exp2f(-fabsf(y))); }
typedef float f32x2_t __attribute__((ext_vector_type(2)));
typedef __bf16 bf16x2_t __attribute__((ext_vector_type(2)));
__device__ __forceinline__ unsigned pk_hw(float a, float b) { const f32x2_t v = {a, b}; return __builtin_bit_cast(unsigned, __builtin_convertvector(v, bf16x2_t)); }
__device__ __forceinline__ unsigned pk2(float a, float b) { return pk_hw(a, b); }
__device__ __forceinline__ void unpack8(u32x4 w, float* f) {
  f[0] = __uint_as_float(w.x << 16); f[1] = __uint_as_float(w.x & 0xffff0000u); f[2] = __uint_as_float(w.y << 16); f[3] = __uint_as_float(w.y & 0xffff0000u);
  f[4] = __uint_as_float(w.z << 16); f[5] = __uint_as_float(w.z & 0xffff0000u); f[6] = __uint_as_float(w.w << 16); f[7] = __uint_as_float(w.w & 0xffff0000u);
}

__device__ __forceinline__ void transpose_job(const Ctx& c, const float* src, int N, bf16_t* dst, int rs, int ro, int tile0, int tile_stride) {
  float* t = (float*)c.lds;
  const int ntn = (N + 63) / 64, ntiles = ntn * 16;
  for (int tl = tile0; tl < ntiles; tl += tile_stride) {
    const int kt = tl / ntn, nt_ = tl % ntn, k0 = kt * 64, n0 = nt_ * 64;
    __syncthreads();
#pragma unroll
    for (int i = 0; i < 8; ++i) { const int idx = c.tid + i * 512, kk = idx >> 6, nn = idx & 63; t[kk * 65 + nn] = (n0 + nn < N) ? src[(size_t)(k0 + kk) * N + n0 + nn] : 0.f; }
    __syncthreads();
#pragma unroll
    for (int i = 0; i < 4; ++i) { const int idx = c.tid + i * 512, nn = idx >> 5, kp = (idx & 31) * 2;
      if (n0 + nn < N) *(unsigned*)(dst + (size_t)((n0 + nn) * rs + ro) * 1024 + k0 + kp) = pk2(t[kp * 65 + nn], t[(kp + 1) * 65 + nn]); }
  }
  __syncthreads();
}
__device__ __forceinline__ void p0_prologue(unsigned char* lds_, int wv, const Params& p) {
  const Ctx c = make_ctx(lds_, wv);
  unsigned char* ws = p.ws;
  if (c.bid == 0) { ((unsigned*)(ws + WS_CTL))[64 + c.tid] = 0u; }
  if (c.bid == 0) { for (int i = c.tid; i < 3456; i += NTHREADS) ((unsigned*)(ws + WS_CTL))[2048 + i] = 0u; }
  { const float* x = p.in[I_X]; bf16_t* hb = (bf16_t*)p.out;
    for (size_t i = (size_t)c.bid * NTHREADS + c.tid; i < (size_t)NTOK * 1024 / 8; i += (size_t)c.G * NTHREADS) {
      const f32x4 a = __builtin_nontemporal_load((const f32x4*)(x + i * 8)), b = __builtin_nontemporal_load((const f32x4*)(x + i * 8 + 4));
      u32x4 w; w.x = pk2(a[0], a[1]); w.y = pk2(a[2], a[3]); w.z = pk2(b[0], b[1]); w.w = pk2(b[2], b[3]);
      *(u32x4*)(hb + i * 8) = w; } }
  transpose_job(c, p.in[I_AB_W_IN], P_AB, (bf16_t*)(ws + WS_WIN_AB), 1, 0, c.bid, c.G);
  transpose_job(c, p.in[I_CD_W_IN], P_CD, (bf16_t*)(ws + WS_WIN_CD), 1, 0, c.bid, c.G);
  transpose_job(c, p.in[I_AB_W_OUT], 1024, (bf16_t*)(ws + WS_WOUT_AB), 1, 0, c.bid, c.G);
  transpose_job(c, p.in[I_CD_W_OUT], 1024, (bf16_t*)(ws + WS_WOUT_CD), 1, 0, c.bid, c.G);
  { float* rope = (float*)(ws + WS_ROPE);
    for (int i = c.bid * NTHREADS + c.tid; i < SEQ * 32; i += c.G * NTHREADS) { const int t = i >> 5, f = i & 31;
      const float freq = powf(10000.0f, -(float)f / 32.0f); const float ang = (float)t * freq; rope[i * 2] = cosf(ang); rope[i * 2 + 1] = sinf(ang); }
    if (c.bid == 1) { const float* hl = p.in[I_HGRN_LB]; float* lb = (float*)(ws + WS_LB);
      const int cc = c.tid; const float a0 = hl[cc], a1 = hl[512 + cc], a2 = hl[1024 + cc]; const float mx = fmaxf(a0, fmaxf(a1, a2));
      const float e0 = expf(a0 - mx), e1 = expf(a1 - mx), e2 = expf(a2 - mx); lb[cc] = e0 / (e0 + e1 + e2); } }
}
__device__ __forceinline__ void moe_weight_convert(unsigned char* lds_, int wv, const Params& p, int layer, int part, int bidx, int nblk) {
  const Ctx c = make_ctx(lds_, wv);
  bf16_t* w13 = (bf16_t*)(p.ws + WS_W13); bf16_t* w2 = (bf16_t*)(p.ws + (p.big_ws ? WS_W2X : WS_W2));
  const size_t lo = (size_t)layer * NEXP * 1024 * 1024;
  const float* W1 = p.in[I_MOE_W1] + lo; const float* W3 = p.in[I_MOE_W3] + lo; const float* W2 = p.in[I_MOE_W2] + lo;
  float* t = (float*)c.lds;
  const int NT = (part == 0 ? 32 : 16) * 128;
  const int lk = c.tid >> 5, ln4 = (c.tid & 31) * 4;
  const int sn = c.tid & 127, sk = (c.tid >> 7) * 8;
  f32x4 r[4];
#define MW_SRC(g_) ((part == 0 ? ((((g_) >> 7) & 1) ? W3 : W1) + (size_t)((g_) >> 8) * 1048576 : W2 + (size_t)((g_) >> 7) * 1048576) + (size_t)((((g_) & 127) >> 3) * 64) * 1024 + ((g_) & 7) * 128)
#define MW_LOAD(g_) do { const float* s_ = MW_SRC(g_); _Pragma("unroll") for (int i = 0; i < 4; ++i) r[i] = __builtin_nontemporal_load((const f32x4*)(s_ + (size_t)(lk + 16 * i) * 1024 + ln4)); } while (0)
  int g0 = bidx;
  if (g0 < NT) MW_LOAD(g0);
  for (; g0 < NT; g0 += nblk) {
    __syncthreads();
#pragma unroll
    for (int i = 0; i < 4; ++i) { float* d = t + (lk + 16 * i) * 129 + ln4; d[0] = r[i][0]; d[1] = r[i][1]; d[2] = r[i][2]; d[3] = r[i][3]; }
    __syncthreads();
    const int gn = g0 + nblk;
    if (gn < NT) MW_LOAD(gn);
    const int m = g0 >> 7, k0 = ((g0 & 127) >> 3) * 64, n0 = (g0 & 7) * 128;
    bf16_t* drow = (part == 1) ? w2 + ((size_t)m * 1024 + n0 + sn) * 1024 : w13 + ((size_t)(m >> 1) * 2048 + 2 * (n0 + sn) + (m & 1)) * 1024;
#pragma unroll
    for (int j = 0; j < 2; ++j) { const int kk = sk + 32 * j; const float* s = t + kk * 129 + sn;
      u32x4 w; w.x = pk2(s[0], s[129]); w.y = pk2(s[2 * 129], s[3 * 129]); w.z = pk2(s[4 * 129], s[5 * 129]); w.w = pk2(s[6 * 129], s[7 * 129]);
      *(u32x4*)(drow + k0 + kk) = w; }
  }
#undef MW_SRC
#undef MW_LOAD
  __syncthreads();
}

struct ProbInProj {
  static constexpr bool PERM = true;
  pg8::StaticOrder so; const char* A; const char* Bt; bf16_t* P; const float* bias; const float* lb; int layer;
  __device__ __forceinline__ bool next(int i, pg8::Unit& u) const { return so.next(i, u); }
  __device__ __forceinline__ const char* a_base() const { return A; }
  __device__ __forceinline__ unsigned a_off(const pg8::Unit& u, int r) const { return (unsigned)(u.pm * 256 + r) * 2048u; }
  __device__ __forceinline__ const char* b_base(const pg8::Unit& u) const { return Bt + (size_t)u.pn * 256 * 2048; }
  __device__ __forceinline__ void epi(const f32x4 (&acc)[2][2][4][2], const pg8::Unit& u, int wr, int wc, int fr, int fq) const {
    const int row0 = u.row0 + wr * 64 + fr, colb = u.pn * 256 + wc * 32 + 8 * fq;
    int mode = 0;
    if (layer == 0) { mode = u.pn < 2 ? 1 : (u.pn < 6 ? 2 : (u.pn == 10 ? 3 : 0)); }
#pragma unroll
    for (int bj = 0; bj < 2; ++bj) {
      const int col0 = colb + bj * 128;
      const f32x4 b0 = *(const f32x4*)(bias + col0), b1 = *(const f32x4*)(bias + col0 + 4);
      f32x4 l0 = (f32x4){0.f, 0.f, 0.f, 0.f}, l1 = l0;
      if (mode == 2) { l0 = *(const f32x4*)(lb + ((col0 - 512) & 511)); l1 = *(const f32x4*)(lb + ((col0 - 512) & 511) + 4); }
#pragma unroll
      for (int ai = 0; ai < 2; ++ai)
#pragma unroll
        for (int m = 0; m < 4; ++m) {
          f32x4 v0 = acc[ai][bj][m][0] + b0, v1 = acc[ai][bj][m][1] + b1;
          if (mode == 1) {
#pragma unroll
            for (int j = 0; j < 4; ++j) { v0[j] = fsilu(v0[j]); v1[j] = fsilu(v1[j]); }
          } else if (mode == 2) {
#pragma unroll
            for (int j = 0; j < 4; ++j) { v0[j] = __builtin_amdgcn_logf(l0[j] + (1.0f - l0[j]) * fsigmoid(v0[j])); v1[j] = __builtin_amdgcn_logf(l1[j] + (1.0f - l1[j]) * fsigmoid(v1[j])); }
          } else if (mode == 3) { v0 *= 0.125f; v1 *= 0.125f; }
          u32x4 w; w.x = pk2(v0[0], v0[1]); w.y = pk2(v0[2], v0[3]); w.z = pk2(v1[0], v1[1]); w.w = pk2(v1[2], v1[3]);
          *(u32x4*)(P + PIDX(row0 + ai * 128 + m * 16, col0)) = w;
        }
    }
  }
};
struct ProbOutProj {
  static constexpr bool PERM = true;
  pg8::StaticOrder so; const char* A; const char* Bt; bf16_t* Y; const bf16_t* Hres;
  __device__ __forceinline__ bool next(int i, pg8::Unit& u) const { return so.next(i, u); }
  __device__ __forceinline__ const char* a_base() const { return A; }
  __device__ __forceinline__ unsigned a_off(const pg8::Unit& u, int r) const { return (unsigned)(u.pm * 256 + r) * 2048u; }
  __device__ __forceinline__ const char* b_base(const pg8::Unit& u) const { return Bt + (size_t)u.pn * 256 * 2048; }
  __device__ __forceinline__ void epi(const f32x4 (&acc)[2][2][4][2], const pg8::Unit& u, int wr, int wc, int fr, int fq) const {
    const int row0 = u.row0 + wr * 64 + fr, colb = u.pn * 256 + wc * 32 + 8 * fq;
#pragma unroll
    for (int ai = 0; ai < 2; ++ai)
#pragma unroll
      for (int m = 0; m < 4; ++m) {
        const size_t ro = (size_t)(row0 + ai * 128 + m * 16) * 1024 + colb;
        const u32x4 h0 = *(const u32x4*)(Hres + ro), h1 = *(const u32x4*)(Hres + ro + 128);
#pragma unroll
        for (int bj = 0; bj < 2; ++bj) {
          float hf[8]; unpack8(bj ? h1 : h0, hf);
          const f32x4 v0 = acc[ai][bj][m][0], v1 = acc[ai][bj][m][1];
          u32x4 w; w.x = pk2(v0[0] + ALPHA_F * hf[0], v0[1] + ALPHA_F * hf[1]); w.y = pk2(v0[2] + ALPHA_F * hf[2], v0[3] + ALPHA_F * hf[3]);
          w.z = pk2(v1[0] + ALPHA_F * hf[4], v1[1] + ALPHA_F * hf[5]); w.w = pk2(v1[2] + ALPHA_F * hf[6], v1[3] + ALPHA_F * hf[7]);
          *(u32x4*)(Y + ro + bj * 128) = w;
        }
      }
  }
};
#define MOE_TAB_OFF (128 * 1024)
struct MoeOrder {
  const int* tab;
  __device__ __forceinline__ void init(const int* cnt, int ntn, int G, int c, unsigned char* lds, int wv) {
    int* t = (int*)(lds + MOE_TAB_OFF);
    const int tid = opaque_tid(wv);
    if (tid < 64) {
      int pad = 0, found = 0, ue = 0, upn = 0, upm = 0, urow = 0, une = 0;
      if ((G & 7) == 0) {
        const int x = c & 7; int q = tid * (G >> 3) + (c >> 3);
        for (int e = 0; e < NEXP; ++e) { const int n = cnt[e * 16], mt = (n + 255) >> 8; const int r = ((x - e) % 8 + 8) % 8; const int m = mt > r ? (mt - r - 1) / 8 + 1 : 0; const int units = m * ntn;
          if (!found && q < units) { ue = e; upm = r + 8 * (q % m); upn = q / m; urow = pad + upm * 256; une = n; found = 1; }
          if (!found) { q -= units; pad += mt * 256; } }
      } else {
        int L = tid * G + c;
        for (int e = 0; e < NEXP; ++e) { const int n = cnt[e * 16], mt = (n + 255) >> 8, tiles = mt * ntn;
          if (!found && L < tiles) { ue = e; upn = L / mt; upm = L % mt; urow = pad + upm * 256; une = n; found = 1; }
          if (!found) { L -= tiles; pad += mt * 256; } }
      }
      t[tid * 8 + 0] = found; t[tid * 8 + 1] = ue; t[tid * 8 + 2] = upn; t[tid * 8 + 3] = upm; t[tid * 8 + 4] = urow; t[tid * 8 + 5] = une;
    }
    __syncthreads();
    tab = t;
  }
  __device__ __forceinline__ bool next(int i, pg8::Unit& u) const {
    if (i >= 64) return false;
    const int* t = tab + i * 8;
    if (!__builtin_amdgcn_readfirstlane(t[0])) return false;
    u.e = __builtin_amdgcn_readfirstlane(t[1]); u.pn = __builtin_amdgcn_readfirstlane(t[2]); u.pm = __builtin_amdgcn_readfirstlane(t[3]);
    u.row0 = __builtin_amdgcn_readfirstlane(t[4]); u.ne = __builtin_amdgcn_readfirstlane(t[5]); u.ui = i; return true;
  }
};
struct ProbMoe1 {
  static constexpr bool PERM = true;
  MoeOrder mo; const char* A; const char* W13; const int* list; bf16_t* H; const int* ltok;
  __device__ __forceinline__ void stage_tokens(unsigned char* lds, int wv) {
    int* lt = (int*)(lds + MOE_TAB_OFF + 2048);
    const int tid = opaque_tid(wv);
    pg8::Unit u;
    for (int i = 0; i < 16 && mo.next(i, u); ++i) { if (tid < 256) { const int rr = u.pm * 256 + tid; lt[i * 256 + tid] = rr < u.ne ? list[u.e * NTOK + rr] : 0; } }
    __syncthreads();
    ltok = lt;
  }
  __device__ __forceinline__ bool next(int i, pg8::Unit& u) const { return mo.next(i, u); }
  __device__ __forceinline__ const char* a_base() const { return A; }
  __device__ __forceinline__ unsigned a_off(const pg8::Unit& u, int r) const { const int rr = u.pm * 256 + r; const int tok = rr < u.ne ? list[u.e * NTOK + rr] : 0; return (unsigned)tok * 2048u; }
  __device__ __forceinline__ const char* b_base(const pg8::Unit& u) const { return W13 + ((size_t)u.e * 2048 + (size_t)u.pn * 256) * 2048; }
  __device__ __forceinline__ void epi(const f32x4 (&acc)[2][2][4][2], const pg8::Unit& u, int wr, int wc, int fr, int fq) const {
    const int row0 = u.row0 + wr * 64 + fr, colb = u.pn * 128 + wc * 16 + 4 * fq;
#pragma unroll
    for (int ai = 0; ai < 2; ++ai)
#pragma unroll
      for (int m = 0; m < 4; ++m)
#pragma unroll
        for (int bj = 0; bj < 2; ++bj) {
          const f32x4 v0 = acc[ai][bj][m][0], v1 = acc[ai][bj][m][1];
          u32x2 w; w.x = pk2(fsilu(v0[0]) * v0[1], fsilu(v0[2]) * v0[3]); w.y = pk2(fsilu(v1[0]) * v1[1], fsilu(v1[2]) * v1[3]);
          *(u32x2*)(H + (size_t)(row0 + ai * 128 + m * 16) * 1024 + colb + bj * 64) = w;
        }
  }
};
struct ProbMoe2 {
  static constexpr bool PERM = true;
  MoeOrder mo; const char* A; const char* W2; bf16_t* Y;
  __device__ __forceinline__ bool next(int i, pg8::Unit& u) const { return mo.next(i, u); }
  __device__ __forceinline__ const char* a_base() const { return A; }
  __device__ __forceinline__ unsigned a_off(const pg8::Unit& u, int r) const { return (unsigned)(u.row0 + r) * 2048u; }
  __device__ __forceinline__ const char* b_base(const pg8::Unit& u) const { return W2 + ((size_t)u.e * 1024 + (size_t)u.pn * 256) * 2048; }
  __device__ __forceinline__ void epi(const f32x4 (&acc)[2][2][4][2], const pg8::Unit& u, int wr, int wc, int fr, int fq) const {
    const int row0 = u.row0 + wr * 64 + fr, colb = u.pn * 256 + wc * 32 + 8 * fq;
#pragma unroll
    for (int ai = 0; ai < 2; ++ai)
#pragma unroll
      for (int m = 0; m < 4; ++m)
#pragma unroll
        for (int bj = 0; bj < 2; ++bj) {
          const f32x4 v0 = acc[ai][bj][m][0], v1 = acc[ai][bj][m][1];
          u32x4 w; w.x = pk2(v0[0], v0[1]); w.y = pk2(v0[2], v0[3]); w.z = pk2(v1[0], v1[1]); w.w = pk2(v1[2], v1[3]);
          *(u32x4*)(Y + (size_t)(row0 + ai * 128 + m * 16) * 1024 + colb + bj * 128) = w;
        }
  }
};

template <int NS>
__device__ __forceinline__ void side_phase(unsigned char* lds_, int wv, const Params& p, int layer) {
  const Ctx c = make_ctx(lds_, wv);
  const bf16_t* hb = (const bf16_t*)p.out;
  const bf16_t* wt = (const bf16_t*)(p.ws + (layer == 0 ? WS_WIN_AB : WS_WIN_CD)) + (size_t)(layer == 0 ? PM_AB : PM_CD) * 1024;
  const float* bias = p.in[layer == 0 ? I_AB_B_IN : I_CD_B_IN] + (layer == 0 ? PM_AB : PM_CD);
  float* side = (float*)(p.ws + WS_SIDE);
  float* tl = (float*)c.lds + c.wid * (16 * 33);
  const int fr = c.lane & 15, fq = c.lane >> 4;
  for (int g = c.bid * 8 + c.wid; g < NTOK / 16; g += c.G * 8) {
    const int r0 = g * 16;
    f32x4 acc0 = (f32x4){0.f, 0.f, 0.f, 0.f}, acc1 = acc0;
    const bf16_t* ap = hb + (size_t)(r0 + fr) * 1024 + fq * 8;
    const bf16_t* bp0 = wt + (size_t)fr * 1024 + fq * 8; const bf16_t* bp1 = bp0 + 16 * 1024;
#pragma unroll 16
    for (int k = 0; k < 1024; k += 32) {
      const bf16x8 a = *(const bf16x8*)(ap + k), b0 = *(const bf16x8*)(bp0 + k);
      acc0 = __builtin_amdgcn_mfma_f32_16x16x32_bf16(a, b0, acc0, 0, 0, 0);
      if (NS == 32) { const bf16x8 b1 = *(const bf16x8*)(bp1 + k); acc1 = __builtin_amdgcn_mfma_f32_16x16x32_bf16(a, b1, acc1, 0, 0, 0); }
    }
    float gsc = 1.f, gfb = 0.f; bool gls = false;
    if (NS == 16) { gsc = 1.4426950408889634f; gls = (fr & 4) != 0; gfb = gls ? p.in[I_FGATE_B][(fr >> 3) * 4 + (fr & 3)] : 0.f; }
#pragma unroll
    for (int j = 0; j < 4; ++j) { float v0 = acc0[j] + bias[fr]; if (NS == 16) v0 = gls ? flog2sigmoid(v0 + gfb) : v0 * gsc; side[(size_t)(r0 + fq * 4 + j) * 32 + fr] = v0; tl[(fq * 4 + j) * 33 + fr] = v0;
      if (NS == 32) { const float v1 = acc1[j] + bias[16 + fr]; side[(size_t)(r0 + fq * 4 + j) * 32 + 16 + fr] = v1; tl[(fq * 4 + j) * 33 + 16 + fr] = v1; } }
    if (NS == 32) {
      __builtin_amdgcn_s_waitcnt(0xC07F);
      const float* gu = p.in[I_GK_UP]; const float* gb = p.in[I_GK_B]; bf16_t* lfb = (bf16_t*)(p.ws + WS_LFB);
      const int cb = c.lane * 8, dir = cb >> 8, cc = cb & 255;
      float w[16][8];
#pragma unroll
      for (int r = 0; r < 16; ++r)
#pragma unroll
        for (int j = 0; j < 8; ++j) w[r][j] = gu[(dir * 16 + r) * 256 + cc + j];
      float bb[8];
#pragma unroll
      for (int j = 0; j < 8; ++j) bb[j] = gb[dir * 256 + cc + j];
      for (int row = 0; row < 16; ++row) {
        float z[8];
#pragma unroll
        for (int j = 0; j < 8; ++j) z[j] = bb[j];
#pragma unroll
        for (int r = 0; r < 16; ++r) { const float s = tl[row * 33 + dir * 16 + r];
#pragma unroll
          for (int j = 0; j < 8; ++j) z[j] += s * w[r][j]; }
        u32x4 o; o.x = pk2(flog2sigmoid(z[0]) * 0.0625f, flog2sigmoid(z[1]) * 0.0625f); o.y = pk2(flog2sigmoid(z[2]) * 0.0625f, flog2sigmoid(z[3]) * 0.0625f);
        o.z = pk2(flog2sigmoid(z[4]) * 0.0625f, flog2sigmoid(z[5]) * 0.0625f); o.w = pk2(flog2sigmoid(z[6]) * 0.0625f, flog2sigmoid(z[7]) * 0.0625f);
        *(u32x4*)(lfb + PIDX(r0 + row, cb)) = o;
      }
    }
  }
}

__device__ __forceinline__ void headnorm_phase(unsigned char* lds_, int wv, const Params& p, int layer) {
  const Ctx c = make_ctx(lds_, wv);
  const bf16_t* P = (const bf16_t*)(p.ws + WS_R1); const bf16_t* O = (const bf16_t*)(p.ws + WS_R2);
  bf16_t* mixed = (bf16_t*)(p.ws + WS_MIX);
  const int c0 = c.lane * 16, h8 = c.lane >> 3;
  const float* gain = layer == 0 ? (h8 < 4 ? p.in[I_HGRN_NORM] + c0 : p.in[I_GLA_NORM] + c0 - 512) : (h8 < 4 ? p.in[I_RET_NORM] + c0 : p.in[I_MLSTM_NORM] + c0 - 512);
  const int gcol = layer == 0 ? (h8 < 4 ? 2048 + c0 : 3584 + c0 - 512) : (h8 < 4 ? 1024 + c0 : 3072 + c0 - 512);
  float gn[16];
#pragma unroll
  for (int j = 0; j < 16; ++j) gn[j] = gain[j];
  const int tstride = c.G * 8;
  for (int tok0 = c.bid * 8 + c.wid; tok0 < NTOK; tok0 += 2 * tstride) {
    u32x4 ra[2][2], rb[2][2], rg[2][2];
#pragma unroll
    for (int u = 0; u < 2; ++u) { const int tok = tok0 + u * tstride < NTOK ? tok0 + u * tstride : tok0;
      const u32x4* a = (const u32x4*)(O + PIDX(tok, c0)); const u32x4* b = (const u32x4*)(O + (size_t)NTOK * 1024 + PIDX(tok, c0)); const u32x4* g = (const u32x4*)(P + PIDX(tok, gcol));
      ra[u][0] = __builtin_nontemporal_load(a); ra[u][1] = __builtin_nontemporal_load(a + 1); rb[u][0] = __builtin_nontemporal_load(b); rb[u][1] = __builtin_nontemporal_load(b + 1);
      rg[u][0] = __builtin_nontemporal_load(g); rg[u][1] = __builtin_nontemporal_load(g + 1); }
#pragma unroll
    for (int u = 0; u < 2; ++u) {
      const int tok = tok0 + u * tstride;
      float of[16], ob[16], gt[16];
      unpack8(ra[u][0], of); unpack8(ra[u][1], of + 8); unpack8(rb[u][0], ob); unpack8(rb[u][1], ob + 8); unpack8(rg[u][0], gt); unpack8(rg[u][1], gt + 8);
      float o[16]; float ss = 0.f;
#pragma unroll
      for (int j = 0; j < 16; ++j) { o[j] = of[j] + ob[j]; ss += o[j] * o[j]; }
      ss += __shfl_xor(ss, 1); ss += __shfl_xor(ss, 2); ss += __shfl_xor(ss, 4);
      const float r = 1.0f / sqrtf(ss * (1.0f / 128.0f) + NORM_EPS_F);
      unsigned w[8];
#pragma unroll
      for (int j = 0; j < 8; ++j) {
        float g0 = gt[2 * j], g1 = gt[2 * j + 1];
        if (layer == 1 && h8 >= 4) { g0 = fsigmoid(g0); g1 = fsigmoid(g1); } else { g0 = fsilu(g0); g1 = fsilu(g1); }
        w[j] = pk2(o[2 * j] * r * gn[2 * j] * g0, o[2 * j + 1] * r * gn[2 * j + 1] * g1);
      }
      if (tok < NTOK) { u32x4* d = (u32x4*)(mixed + (size_t)tok * 1024 + c0);
        d[0] = (u32x4){w[0], w[1], w[2], w[3]}; d[1] = (u32x4){w[4], w[5], w[6], w[7]}; }
    }
  }
}

__device__ __forceinline__ void ln_phase(unsigned char* lds_, int wv, const Params& p, int layer, int mode, int dry = 0) {
  const Ctx c = make_ctx(lds_, wv);
  unsigned char* ws = p.ws;
  const bf16_t* zin = (const bf16_t*)(ws + (mode == 0 ? WS_R2 : WS_MIX));
  const bool f32out = (mode == 1 && layer == 1);
  float* hout = dry ? (float*)(ws + WS_H) : p.out;
  bf16_t* hb = dry ? (bf16_t*)(ws + WS_H) : (mode == 0 ? (bf16_t*)(ws + WS_MIX) : (bf16_t*)p.out);
  const float* g = p.in[mode == 0 ? I_LN_MIX_G : I_LN_FFN_G] + layer * 1024; const float* b = p.in[mode == 0 ? I_LN_MIX_B : I_LN_FFN_B] + layer * 1024;
  unsigned* cnt = (unsigned*)(ws + WS_CTL) + CW_CNT(layer);
  int* list = (int*)(ws + WS_LIST) + (size_t)layer * NEXP * NTOK;
  int* assign = (int*)(ws + WS_ASSIGN); float* gate = (float*)(ws + WS_GATE);
  float* rwT = (float*)c.lds;
  int* lcnt = (int*)(c.lds + 65536); int* lbase = lcnt + 16; int* rec = lcnt + 32; float* recg = (float*)(rec + 4 * 2048);
  int pad[NEXP];
  if (mode == 0) { const float* r = p.in[I_ROUTER_W];
    for (int i = c.tid; i < 1024 * 16; i += NTHREADS) rwT[(i & 15) * 1024 + (i >> 4)] = r[i];
    if (c.tid < 16) lcnt[c.tid] = 0;
    __syncthreads(); }
  else { int acc = 0;
#pragma unroll
    for (int e = 0; e < NEXP; ++e) { pad[e] = acc; acc += (((int)cnt[e * 16] + 255) >> 8) << 8; } }
  const int c0 = c.lane * 4;
  float gv[16], bv[16];
#pragma unroll
  for (int q = 0; q < 4; ++q) { const f32x4 t0 = *(const f32x4*)(g + q * 256 + c0), t1 = *(const f32x4*)(b + q * 256 + c0);
#pragma unroll
    for (int j = 0; j < 4; ++j) { gv[4 * q + j] = t0[j]; bv[4 * q + j] = t1[j]; } }
  const int tstride = c.G * 8;
  int it = 0;
  for (int tok0 = c.bid * 8 + c.wid; tok0 < NTOK; tok0 += 2 * tstride, it += 2) {
    float v[2][16];
    float gy0[2], gy1[2];
#pragma unroll
    for (int u = 0; u < 2; ++u) {
      const int tok = tok0 + u * tstride;
      if (tok < NTOK) {
        const float sc = mode == 0 ? 1.0f : ALPHA_F;
#pragma unroll
        for (int q = 0; q < 4; ++q) { const u32x2 t = __builtin_nontemporal_load((const u32x2*)(zin + (size_t)tok * 1024 + q * 256 + c0));
          v[u][4 * q] = sc * __uint_as_float(t.x << 16); v[u][4 * q + 1] = sc * __uint_as_float(t.x & 0xffff0000u); v[u][4 * q + 2] = sc * __uint_as_float(t.y << 16); v[u][4 * q + 3] = sc * __uint_as_float(t.y & 0xffff0000u); }
        if (mode == 1) {
          const int a0 = assign[tok * 4], a1 = assign[tok * 4 + 1], a2 = assign[tok * 4 + 2], a3 = assign[tok * 4 + 3];
          gy0[u] = gate[tok * 2]; gy1[u] = gate[tok * 2 + 1];
          int p0 = 0, p1 = 0;
#pragma unroll
          for (int e = 0; e < NEXP; ++e) { if (e == a0) p0 = pad[e]; if (e == a2) p1 = pad[e]; }
          p0 += a1; p1 += a3;
          const bf16_t* Y = (const bf16_t*)(ws + WS_R2);
#pragma unroll
          for (int q = 0; q < 4; ++q) { const u32x2 y0 = __builtin_nontemporal_load((const u32x2*)(Y + (size_t)p0 * 1024 + q * 256 + c0)), y1 = __builtin_nontemporal_load((const u32x2*)(Y + (size_t)p1 * 1024 + q * 256 + c0));
            v[u][4 * q] += gy0[u] * __uint_as_float(y0.x << 16) + gy1[u] * __uint_as_float(y1.x << 16); v[u][4 * q + 1] += gy0[u] * __uint_as_float(y0.x & 0xffff0000u) + gy1[u] * __uint_as_float(y1.x & 0xffff0000u);
            v[u][4 * q + 2] += gy0[u] * __uint_as_float(y0.y << 16) + gy1[u] * __uint_as_float(y1.y << 16); v[u][4 * q + 3] += gy0[u] * __uint_as_float(y0.y & 0xffff0000u) + gy1[u] * __uint_as_float(y1.y & 0xffff0000u); }
        }
      } else {
#pragma unroll
        for (int j = 0; j < 16; ++j) v[u][j] = 0.f;
      }
    }
#pragma unroll
    for (int u = 0; u < 2; ++u) {
      const int tok = tok0 + u * tstride;
      float s = 0.f;
#pragma unroll
      for (int j = 0; j < 16; ++j) s += v[u][j];
      const float mean = wave_sum(s) * (1.0f / 1024.0f);
      float qq = 0.f;
#pragma unroll
      for (int j = 0; j < 16; ++j) { v[u][j] -= mean; qq += v[u][j] * v[u][j]; }
      const float r = 1.0f / sqrtf(wave_sum(qq) * (1.0f / 1024.0f) + LN_EPS_F);
#pragma unroll
      for (int j = 0; j < 16; ++j) v[u][j] = v[u][j] * r * gv[j] + bv[j];
      if (tok < NTOK) {
        if (f32out) {
#pragma unroll
          for (int q = 0; q < 4; ++q) __builtin_nontemporal_store((f32x4){v[u][4 * q], v[u][4 * q + 1], v[u][4 * q + 2], v[u][4 * q + 3]}, (f32x4*)(hout + (size_t)tok * 1024 + q * 256 + c0));
        } else {
#pragma unroll
          for (int q = 0; q < 4; ++q) *(u32x2*)(hb + (size_t)tok * 1024 + q * 256 + c0) = (u32x2){pk2(v[u][4 * q], v[u][4 * q + 1]), pk2(v[u][4 * q + 2], v[u][4 * q + 3])}; }
      }
      if (mode == 0) {
        float lg[16];
#pragma unroll
        for (int e = 0; e < 16; ++e) { float a = 0.f;
#pragma unroll
          for (int q = 0; q < 4; ++q) { const f32x4 w = *(const f32x4*)(rwT + e * 1024 + q * 256 + c0); a += v[u][4 * q] * w[0] + v[u][4 * q + 1] * w[1] + v[u][4 * q + 2] * w[2] + v[u][4 * q + 3] * w[3]; }
          lg[e] = a; }
#pragma unroll
        for (int e = 0; e < 16; ++e) lg[e] = wave_sum(lg[e]);
        int eo[2]; float go[2];
        route_from_logits(lg, p.in[I_ROUTER_B], eo, go);
        if (c.lane == 0 && tok < NTOK && !dry) {
          const int r1 = atomicAdd(lcnt + eo[0], 1), r2 = atomicAdd(lcnt + eo[1], 1);
          const int ri = (it + u) * 8 + c.wid;
          rec[ri * 4] = eo[0]; rec[ri * 4 + 1] = r1; rec[ri * 4 + 2] = eo[1]; rec[ri * 4 + 3] = r2; recg[ri * 2] = go[0]; recg[ri * 2 + 1] = go[1];
        }
      }
    }
  }
  if (mode == 0 && !dry) {
    __syncthreads();
    if (c.tid < 16) lbase[c.tid] = (int)atomicAdd(cnt + c.tid * 16, (unsigned)lcnt[c.tid]);
    __syncthreads();
    const int nrec = ((NTOK + c.G * 8 - 1) / (c.G * 8)) * 8;
    for (int ri = c.tid; ri < nrec; ri += NTHREADS) {
      const int tok = c.bid * 8 + (ri & 7) + (ri >> 3) * c.G * 8;
      if (tok < NTOK) {
        const int e1 = rec[ri * 4], e2 = rec[ri * 4 + 2]; const int r1 = rec[ri * 4 + 1] + lbase[e1], r2 = rec[ri * 4 + 3] + lbase[e2];
        list[e1 * NTOK + r1] = tok; list[e2 * NTOK + r2] = tok;
        assign[tok * 4] = e1; assign[tok * 4 + 1] = r1; assign[tok * 4 + 2] = e2; assign[tok * 4 + 3] = r2;
        gate[tok * 2] = recg[ri * 2]; gate[tok * 2 + 1] = recg[ri * 2 + 1];
      }
    }
  }
  __syncthreads();
}
#endif
#ifndef CPU_EMU
namespace scan {
typedef short bf16x8 __attribute__((ext_vector_type(8)));
typedef float f32x4 __attribute__((ext_vector_type(4)));
typedef unsigned u32x4 __attribute__((ext_vector_type(4)));
typedef unsigned u32x2 __attribute__((ext_vector_type(2)));
enum { MIX_A = 0, MIX_B = 1, MIX_C = 2, MIX_D = 3 };
constexpr int LD_T = 144;
constexpr int OFF_QS = 0, OFF_KS = 17408, OFF_QI = 34816, OFF_KT = 52224, OFF_VT = 70656, OFF_SC = 77568, OFF_ST = 86784, OFF_DEC = 99840, OFF_EM = 100352, OFF_DEN = 100608, OFF_CW = 100864, SCAN_LDS = 104960;

__device__ __forceinline__ float incl_scan_add(float x) {
  x += __builtin_bit_cast(float, __builtin_amdgcn_update_dpp(0, __builtin_bit_cast(int, x), 0x111, 0xf, 0xf, false));
  x += __builtin_bit_cast(float, __builtin_amdgcn_update_dpp(0, __builtin_bit_cast(int, x), 0x112, 0xf, 0xf, false));
  x += __builtin_bit_cast(float, __builtin_amdgcn_update_dpp(0, __builtin_bit_cast(int, x), 0x114, 0xf, 0xf, false));
  x += __builtin_bit_cast(float, __builtin_amdgcn_update_dpp(0, __builtin_bit_cast(int, x), 0x118, 0xf, 0xf, false));
  x += __builtin_bit_cast(float, __builtin_amdgcn_update_dpp(0, __builtin_bit_cast(int, x), 0x142, 0xa, 0xf, false));
  x += __builtin_bit_cast(float, __builtin_amdgcn_update_dpp(0, __builtin_bit_cast(int, x), 0x143, 0xc, 0xf, false));
  return x;
}
__device__ __forceinline__ float incl_scan_max(float x) {
  const int ninf = (int)0xff800000u;
  x = fmaxf(x, __builtin_bit_cast(float, __builtin_amdgcn_update_dpp(ninf, __builtin_bit_cast(int, x), 0x111, 0xf, 0xf, false)));
  x = fmaxf(x, __builtin_bit_cast(float, __builtin_amdgcn_update_dpp(ninf, __builtin_bit_cast(int, x), 0x112, 0xf, 0xf, false)));
  x = fmaxf(x, __builtin_bit_cast(float, __builtin_amdgcn_update_dpp(ninf, __builtin_bit_cast(int, x), 0x114, 0xf, 0xf, false)));
  x = fmaxf(x, __builtin_bit_cast(float, __builtin_amdgcn_update_dpp(ninf, __builtin_bit_cast(int, x), 0x118, 0xf, 0xf, false)));
  x = fmaxf(x, __builtin_bit_cast(float, __builtin_amdgcn_update_dpp(ninf, __builtin_bit_cast(int, x), 0x142, 0xa, 0xf, false)));
  x = fmaxf(x, __builtin_bit_cast(float, __builtin_amdgcn_update_dpp(ninf, __builtin_bit_cast(int, x), 0x143, 0xc, 0xf, false)));
  return x;
}
__device__ __forceinline__ float rdlane(float x, int l) { return __builtin_bit_cast(float, __builtin_amdgcn_readlane(__builtin_bit_cast(int, x), l)); }
__device__ __forceinline__ bf16x8 ldfrag(const unsigned char* base, int ld, int row, int kbyte) { return *(const bf16x8*)(base + row * ld + kbyte); }
__device__ __forceinline__ bf16x8 ldfrag2(const unsigned char* base, int ld, int row, int b0, int b1) {
  const u32x2 lo = *(const u32x2*)(base + row * ld + b0), hi = *(const u32x2*)(base + row * ld + b1);
  return __builtin_bit_cast(bf16x8, (u32x4){lo.x, lo.y, hi.x, hi.y}); }
__device__ __forceinline__ unsigned pk(float a, float b) { return pk_hw(a, b); }
__device__ __forceinline__ float lo16(unsigned w) { return __uint_as_float(w << 16); }
__device__ __forceinline__ float hi16(unsigned w) { return __uint_as_float(w & 0xffff0000u); }

__device__ __forceinline__ void lds_barrier() { asm volatile("s_waitcnt lgkmcnt(0)" ::: "memory"); __builtin_amdgcn_s_barrier(); asm volatile("" ::: "memory"); }
struct Raw { u32x4 a0, a1, b0, b1; f32x4 r0, r1; u32x2 v; float s0, s1; };

}

__device__ __forceinline__ void convd_phase(unsigned char* lds_, int wv, const Params& p) {
  const Ctx c = make_ctx(lds_, wv);
  bf16_t* P = (bf16_t*)(p.ws + WS_R1); bf16_t* QD = (bf16_t*)(p.ws + WS_LFB);
  const float* cw = p.in[I_CONV_W]; const float* cb = p.in[I_CONV_B];
  const int ch = c.lane * 16;
  float w0[16], w1[16], w2[16], bb[16];
#pragma unroll
  for (int j = 0; j < 16; ++j) { w0[j] = cw[ch + j]; w1[j] = cw[1024 + ch + j]; w2[j] = cw[2048 + ch + j]; bb[j] = cb[ch + j]; }
  for (int tok = c.bid * 8 + c.wid; tok < NTOK; tok += c.G * 8) {
    const int t = tok % SEQ;
    const bf16_t* row = P + PIDX(tok, 1536 + ch);
    float x0[16], x1[16], x2[16];
    { const u32x4* r1 = (const u32x4*)row; unpack8(r1[0], x1); unpack8(r1[1], x1 + 8); }
    if (t > 0) { const u32x4* r0 = (const u32x4*)(row - 128); unpack8(r0[0], x0); unpack8(r0[1], x0 + 8); }
    else {
#pragma unroll
      for (int j = 0; j < 16; ++j) x0[j] = 0.f; }
    if (t < SEQ - 1) { const u32x4* r2 = (const u32x4*)(row + 128); unpack8(r2[0], x2); unpack8(r2[1], x2 + 8); }
    else {
#pragma unroll
      for (int j = 0; j < 16; ++j) x2[j] = 0.f; }
    const float sc = ch < 512 ? 0.08838834764831845f : 1.0f;
    unsigned w[8];
#pragma unroll
    for (int j = 0; j < 8; ++j) {
      const float a0 = bb[2 * j] + w0[2 * j] * x0[2 * j] + w1[2 * j] * x1[2 * j] + w2[2 * j] * x2[2 * j];
      const float a1 = bb[2 * j + 1] + w0[2 * j + 1] * x0[2 * j + 1] + w1[2 * j + 1] * x1[2 * j + 1] + w2[2 * j + 1] * x2[2 * j + 1];
      w[j] = pk2(fsilu(a0) * sc, fsilu(a1) * sc);
    }
    u32x4* d = (ch < 512) ? (u32x4*)(QD + PIDX(tok, ch)) : (u32x4*)(P + PIDX(tok, 3584 + (ch - 512)));
    d[0] = (u32x4){w[0], w[1], w[2], w[3]}; d[1] = (u32x4){w[4], w[5], w[6], w[7]};
  }
}

#endif
#ifndef CPU_EMU
namespace scan2 {
using namespace scan;
#ifndef PROBE_ALLTILES
#define PROBE_ALLTILES 0
#endif
__device__ __forceinline__ float FMUL(float a, float b) { float r = a * b; asm("" : "+v"(r)); return r; }
constexpr int U_QI = 0, U_KS = 34816, U_KT = 69632, U_VT = 106496, U_SC = 120320, U_ST = 129536, U_DEC = 155648, U_EM = 156672, U_END = 157184;
template <int MIXER>
__device__ __forceinline__ void scan_item2(unsigned char* lds, int wv, const Params& p, int b, int h, int dir, int vs) {
  constexpr int DK = (MIXER == MIX_A || MIXER == MIX_D) ? 128 : 64;
  constexpr int NC = DK / 8;
  constexpr int LD_D = DK * 2 + 16;
  constexpr int NVT = MIXER == MIX_D ? 3 : 2;
  constexpr int NKD = DK / 32;
  constexpr int NST = (DK == 128) ? NVT : 1;
  constexpr int NCH = SEQ / 64;
  const int tid = opaque_tid(wv), lane0 = tid & 63, wid = __builtin_amdgcn_readfirstlane(tid >> 6);
  unsigned char* ws = p.ws;
  const bf16_t* P = (const bf16_t*)(ws + WS_R1);
  const bf16_t* LFBp = (const bf16_t*)(ws + WS_LFB);
  const float* side = (const float*)(ws + WS_SIDE);
  const float* rope = (const float*)(ws + WS_ROPE);
  bf16_t* O = (bf16_t*)(ws + WS_R2) + (size_t)dir * NTOK * 1024;
  int qcol, kcol, lfcol, vcol, ocol;
  if (MIXER == MIX_A) { qcol = h * 128; kcol = 0; lfcol = 512 + dir * 512 + h * 128; vcol = 1536 + h * 128 + vs * 32; ocol = h * 128 + vs * 32; }
  else if (MIXER == MIX_B) { qcol = 2560 + h * 64; kcol = 2816 + h * 64; lfcol = dir * 256 + h * 64; vcol = 3072 + h * 128 + vs * 32; ocol = 512 + h * 128 + vs * 32; }
  else if (MIXER == MIX_C) { qcol = h * 64; kcol = 256 + h * 64; lfcol = 0; vcol = 512 + h * 128 + vs * 32; ocol = h * 128 + vs * 32; }
  else { qcol = h * 128; kcol = 3584 + h * 128; lfcol = 0; vcol = 2560 + h * 128 + vs * 32; ocol = 512 + h * 128 + vs * 32; }
  const size_t tokbase = (size_t)b * SEQ;
  const int c0 = (MIXER == MIX_C) ? wid * 4 : wid * NC;
  for (int i = tid; i < 2 * 13056 / 4; i += NTHREADS) ((unsigned*)(lds + U_ST))[i] = 0u;

  if (MIXER == MIX_D) { for (int i = tid; i < 2 * 16 * 64; i += NTHREADS) { const int bf = i >> 10, r = 32 + ((i >> 6) & 15), j = i & 63; *(bf16_t*)(lds + U_VT + bf * 6912 + r * LD_T + j * 2) = (r == 32) ? (bf16_t)0x3F80 : (bf16_t)0; } }
  const float lgam2 = (MIXER == MIX_C) ? log1pf(-exp2f(-(5.0f + 2.0f * (float)h + (float)dir))) * 1.4426950408889634f : 0.f;
  const float fgb = (MIXER == MIX_D) ? p.in[I_FGATE_B][dir * 4 + h] : 0.f;
  float m_st = 0.f;
  __syncthreads();

  Raw R, Rn; u32x2 Rv, Rvn;
#define A_LOAD(R, Rv, n_) do { \
    const int ln_ = lane0; \
    const int t_ = dir ? (SEQ - 1 - ((n_) * 64 + ln_)) : ((n_) * 64 + ln_); \
    const size_t tk_ = tokbase + t_; \
    if (MIXER == MIX_A) { const u32x4* qp_ = (const u32x4*)(P + PIDX(tk_, qcol + c0)); const u32x4* lp_ = (const u32x4*)(P + PIDX(tk_, lfcol + c0)); R.a0 = qp_[0]; R.a1 = qp_[1]; R.b0 = lp_[0]; R.b1 = lp_[1]; } \
    else if (MIXER == MIX_B) { R.a0 = *(const u32x4*)(P + PIDX(tk_, qcol + c0)); R.a1 = *(const u32x4*)(P + PIDX(tk_, kcol + c0)); R.b0 = *(const u32x4*)(LFBp + PIDX(tk_, lfcol + c0)); } \
    else if (MIXER == MIX_C) { const u32x2 qa_ = *(const u32x2*)(P + PIDX(tk_, qcol + c0)), qb_ = *(const u32x2*)(P + PIDX(tk_, qcol + 32 + c0)), ka_ = *(const u32x2*)(P + PIDX(tk_, kcol + c0)), kb_ = *(const u32x2*)(P + PIDX(tk_, kcol + 32 + c0)); \
      R.a0 = (u32x4){qa_.x, qa_.y, qb_.x, qb_.y}; R.a1 = (u32x4){ka_.x, ka_.y, kb_.x, kb_.y}; \
      R.r0 = *(const f32x4*)(rope + ((size_t)t_ * 32 + c0) * 2); R.r1 = *(const f32x4*)(rope + ((size_t)t_ * 32 + c0) * 2 + 4); } \
    else { const u32x4* qp_ = (const u32x4*)(LFBp + PIDX(tk_, qcol + c0)); const u32x4* kp_ = (const u32x4*)(P + PIDX(tk_, kcol + c0)); R.a0 = qp_[0]; R.a1 = qp_[1]; R.b0 = kp_[0]; R.b1 = kp_[1]; \
      R.s0 = side[tk_ * 32 + dir * 8 + h]; R.s1 = side[tk_ * 32 + dir * 8 + 4 + h]; } \
    Rv = *(const u32x2*)(P + PIDX(tk_, vcol + wid * 4)); } while (0)

  float rr_next = 1.f, rr_cur = 1.f;
#define A_PREP(buf_, R, Rv) do { \
    const int lane = lane0; \
    unsigned char* KTb = lds + U_KT + (buf_) * 18432; float* DECb = (float*)(lds + U_DEC + (buf_) * 512); float* EMb = (float*)(lds + U_EM + (buf_) * 256); \
    unsigned char* QIb = lds + U_QI + (buf_) * 17408; unsigned char* KSb = lds + U_KS + (buf_) * 17408; \
    float q[NC], k[NC], g[NC], ktv[NC]; \
    if (MIXER == MIX_A) { \
      const unsigned qw[8] = {R.a0.x, R.a0.y, R.a0.z, R.a0.w, R.a1.x, R.a1.y, R.a1.z, R.a1.w}, lw[8] = {R.b0.x, R.b0.y, R.b0.z, R.b0.w, R.b1.x, R.b1.y, R.b1.z, R.b1.w}; \
      _Pragma("unroll") for (int c = 0; c < 8; ++c) { q[2 * c] = lo16(qw[c]); q[2 * c + 1] = hi16(qw[c]); g[2 * c] = lo16(lw[c]); g[2 * c + 1] = hi16(lw[c]); } \
      _Pragma("unroll") for (int c = 0; c < NC; ++c) k[c] = 1.0f - __builtin_amdgcn_exp2f(g[c]); \
    } else if (MIXER == MIX_B) { \
      const unsigned qw[4] = {R.a0.x, R.a0.y, R.a0.z, R.a0.w}, kw[4] = {R.a1.x, R.a1.y, R.a1.z, R.a1.w}, lw[4] = {R.b0.x, R.b0.y, R.b0.z, R.b0.w}; \
      _Pragma("unroll") for (int c = 0; c < 4; ++c) { q[2 * c] = lo16(qw[c]); q[2 * c + 1] = hi16(qw[c]); k[2 * c] = lo16(kw[c]); k[2 * c + 1] = hi16(kw[c]); g[2 * c] = lo16(lw[c]); g[2 * c + 1] = hi16(lw[c]); } \
    } else if (MIXER == MIX_C) { \
      const float cs[4] = {R.r0[0], R.r0[2], R.r1[0], R.r1[2]}, sn[4] = {R.r0[1], R.r0[3], R.r1[1], R.r1[3]}; \
      const float q1[4] = {lo16(R.a0.x), hi16(R.a0.x), lo16(R.a0.y), hi16(R.a0.y)}, q2[4] = {lo16(R.a0.z), hi16(R.a0.z), lo16(R.a0.w), hi16(R.a0.w)}; \
      const float k1[4] = {lo16(R.a1.x), hi16(R.a1.x), lo16(R.a1.y), hi16(R.a1.y)}, k2[4] = {lo16(R.a1.z), hi16(R.a1.z), lo16(R.a1.w), hi16(R.a1.w)}; \
      _Pragma("unroll") for (int c = 0; c < 4; ++c) { q[c] = (q1[c] * cs[c] - q2[c] * sn[c]) * 0.125f; q[4 + c] = (q1[c] * sn[c] + q2[c] * cs[c]) * 0.125f; k[c] = k1[c] * cs[c] - k2[c] * sn[c]; k[4 + c] = k1[c] * sn[c] + k2[c] * cs[c]; } \
    } else { \
      const unsigned qw[8] = {R.a0.x, R.a0.y, R.a0.z, R.a0.w, R.a1.x, R.a1.y, R.a1.z, R.a1.w}, kw[8] = {R.b0.x, R.b0.y, R.b0.z, R.b0.w, R.b1.x, R.b1.y, R.b1.z, R.b1.w}; \
      _Pragma("unroll") for (int c = 0; c < 8; ++c) { q[2 * c] = lo16(qw[c]); q[2 * c + 1] = hi16(qw[c]); k[2 * c] = lo16(kw[c]); k[2 * c + 1] = hi16(kw[c]); } \
    } \
    if (MIXER == MIX_A || MIXER == MIX_B) { \
        \
      _Pragma("unroll") for (int c = 0; c < NC; ++c) g[c] += __builtin_bit_cast(float, __builtin_amdgcn_update_dpp(0, __builtin_bit_cast(int, g[c]), 0x111, 0xf, 0xf, false)); \
      _Pragma("unroll") for (int c = 0; c < NC; ++c) g[c] += __builtin_bit_cast(float, __builtin_amdgcn_update_dpp(0, __builtin_bit_cast(int, g[c]), 0x112, 0xf, 0xf, false)); \
      _Pragma("unroll") for (int c = 0; c < NC; ++c) g[c] += __builtin_bit_cast(float, __builtin_amdgcn_update_dpp(0, __builtin_bit_cast(int, g[c]), 0x114, 0xf, 0xf, false)); \
      _Pragma("unroll") for (int c = 0; c < NC; ++c) g[c] += __builtin_bit_cast(float, __builtin_amdgcn_update_dpp(0, __builtin_bit_cast(int, g[c]), 0x118, 0xf, 0xf, false)); \
      _Pragma("unroll") for (int c = 0; c < NC; ++c) g[c] += __builtin_bit_cast(float, __builtin_amdgcn_update_dpp(0, __builtin_bit_cast(int, g[c]), 0x142, 0xa, 0xf, false)); \
      _Pragma("unroll") for (int c = 0; c < NC; ++c) g[c] += __builtin_bit_cast(float, __builtin_amdgcn_update_dpp(0, __builtin_bit_cast(int, g[c]), 0x143, 0xc, 0xf, false)); \
      float ev[NC]; \
      _Pragma("unroll") for (int c = 0; c < NC; ++c) { \
          \
        const float e = __builtin_amdgcn_exp2f(g[c]), r = __builtin_amdgcn_rcpf(e); \
        const float e63 = rdlane(e, 63); \
        q[c] = FMUL(q[c], e); k[c] = FMUL(k[c], r); ktv[c] = FMUL(k[c], e63);     \
        ev[c] = e; } \
      if (lane == 63) { _Pragma("unroll") for (int c = 0; c < NC / 4; ++c) *(f32x4*)(DECb + c0 + 4 * c) = (f32x4){ev[4 * c], ev[4 * c + 1], ev[4 * c + 2], ev[4 * c + 3]}; } \
    } else if (MIXER == MIX_C) { \
        \
      const float gl = (float)(lane + 1) * lgam2; \
      const float e = __builtin_amdgcn_exp2f(gl), r = __builtin_amdgcn_rcpf(e); \
      const float e63 = rdlane(e, 63); const float f_kt = r * e63; \
      _Pragma("unroll") for (int c = 0; c < NC; ++c) { q[c] = FMUL(q[c], e); ktv[c] = FMUL(k[c], f_kt); k[c] = FMUL(k[c], r); } \
      if (lane < 4) { DECb[c0 + lane] = e63; DECb[32 + c0 + lane] = e63; } \
    } else { \
      const float li = R.s0, lf = R.s1;     \
      const float bc = incl_scan_add(lf); const float u = li - bc; const float pm = incl_scan_max(u); \
      const float cmax = rdlane(pm, 63), blast = rdlane(bc, 63); \
      const float a_i = bc + m_st, m_i = fmaxf(a_i, bc + pm); \
      const float d_alpha = __builtin_amdgcn_exp2f(bc - m_i + cmax), d_beta = __builtin_amdgcn_exp2f(u - cmax); \
      rr_next = __builtin_amdgcn_exp2f(m_st - cmax);     \
      const float m_new = fmaxf(blast + m_st, blast + cmax); \
      const float d_sold = __builtin_amdgcn_exp2f(blast + m_st - m_new), d_wks = __builtin_amdgcn_exp2f(blast + u - m_new); m_st = m_new; \
      _Pragma("unroll") for (int c = 0; c < NC; ++c) { ktv[c] = FMUL(k[c], d_wks); q[c] = FMUL(q[c], d_alpha); k[c] = FMUL(k[c], d_beta); if (lane == 63) DECb[c0 + c] = d_sold; } \
      if (wid == 0) EMb[lane] = __builtin_amdgcn_exp2f(-m_i); \
    } \
    _Pragma("unroll") for (int c = 0; c < NC / 2; ++c) { const unsigned w_ = pk_hw(ktv[2 * c], ktv[2 * c + 1]); \
      const int d0_ = (MIXER == MIX_C) ? (2 * c < 4 ? c0 + 2 * c : 32 + c0 + 2 * c - 4) : c0 + 2 * c; \
      *(bf16_t*)(KTb + d0_ * LD_T + lane * 2) = (bf16_t)(w_ & 0xffff); *(bf16_t*)(KTb + (d0_ + 1) * LD_T + lane * 2) = (bf16_t)(w_ >> 16); } \
    { unsigned pq[NC / 2], pks[NC / 2]; \
      _Pragma("unroll") for (int c = 0; c < NC / 2; ++c) { pq[c] = pk_hw(q[2 * c], q[2 * c + 1]); pks[c] = pk_hw(k[2 * c], k[2 * c + 1]); } \
      if (MIXER == MIX_C) { \
        *(u32x2*)(QIb + lane * LD_D + c0 * 2) = (u32x2){pq[0], pq[1]}; *(u32x2*)(QIb + lane * LD_D + (32 + c0) * 2) = (u32x2){pq[2], pq[3]}; \
        *(u32x2*)(KSb + lane * LD_D + c0 * 2) = (u32x2){pks[0], pks[1]}; *(u32x2*)(KSb + lane * LD_D + (32 + c0) * 2) = (u32x2){pks[2], pks[3]}; \
      } else { \
        _Pragma("unroll") for (int c = 0; c < NC / 8; ++c) { \
          *(u32x4*)(QIb + lane * LD_D + (c0 + 8 * c) * 2) = (u32x4){pq[4 * c], pq[4 * c + 1], pq[4 * c + 2], pq[4 * c + 3]}; \
          *(u32x4*)(KSb + lane * LD_D + (c0 + 8 * c) * 2) = (u32x4){pks[4 * c], pks[4 * c + 1], pks[4 * c + 2], pks[4 * c + 3]}; } } } \
    { unsigned char* VTb = lds + U_VT + (buf_) * 6912 + (wid * 4) * LD_T + lane * 2; \
      *(bf16_t*)(VTb + 0 * LD_T) = (bf16_t)(Rv.x & 0xffff); *(bf16_t*)(VTb + 1 * LD_T) = (bf16_t)(Rv.x >> 16); *(bf16_t*)(VTb + 2 * LD_T) = (bf16_t)(Rv.y & 0xffff); *(bf16_t*)(VTb + 3 * LD_T) = (bf16_t)(Rv.y >> 16); } \
  } while (0)
  f32x4 sacc[NST];
#pragma unroll
  for (int i = 0; i < NST; ++i) sacc[i] = (f32x4){0.f, 0.f, 0.f, 0.f};
  A_LOAD(R, Rv, 0);
  A_PREP(0, R, Rv);
  A_LOAD(R, Rv, 1);
  A_LOAD(Rn, Rvn, 2);
  rr_cur = rr_next;
  lds_barrier();
#define SCAN_ITER(n_, RX, RvX) do { const int n = (n_); \
    const int cb = n & 1, nb = (n + 1) & 1; \
    if (n + 1 < NCH) { A_PREP(nb, RX, RvX); if (n + 3 < NCH) A_LOAD(RX, RvX, n + 3); } \
    { { \
      const int lane = lane0; \
      const int fr = lane & 15, fq = lane >> 4; \
      const int it = wid & 3, vt = wid >> 2; \
      const unsigned char* STc = lds + U_ST + cb * 13056; unsigned char* STn = lds + U_ST + nb * 13056; \
      const unsigned char* KTc = lds + U_KT + cb * 18432; const unsigned char* VTc = lds + U_VT + cb * 6912; \
      const unsigned char* QI = lds + U_QI + cb * 17408; const unsigned char* KS = lds + U_KS + cb * 17408; \
      const float* DECc = (const float*)(lds + U_DEC + cb * 512); const float* EMc = (const float*)(lds + U_EM + cb * 256); \
      bf16x8 qf[NKD]; \
_Pragma("unroll") \
      for (int ks = 0; ks < NKD; ++ks) qf[ks] = ldfrag(QI, LD_D, it * 16 + fr, ks * 64 + fq * 16); \
        \
      u32x2 sp[4]; \
_Pragma("unroll") \
      for (int jt = 0; jt < 4; ++jt) { \
        sp[jt] = (u32x2){0u, 0u}; \
        if (PROBE_ALLTILES || jt <= it) { \
          f32x4 acc = (f32x4){0.f, 0.f, 0.f, 0.f}; \
_Pragma("unroll") \
          for (int ks = 0; ks < NKD; ++ks) acc = __builtin_amdgcn_mfma_f32_16x16x32_bf16(ldfrag(KS, LD_D, jt * 16 + fr, ks * 64 + fq * 16), qf[ks], acc, 0, 0, 0); \
          if (jt == it) { const int i = fr, j0 = fq * 4; \
            const float v0 = (j0 + 0 <= i) ? acc[0] : 0.f, v1 = (j0 + 1 <= i) ? acc[1] : 0.f, v2 = (j0 + 2 <= i) ? acc[2] : 0.f, v3 = (j0 + 3 <= i) ? acc[3] : 0.f; \
            sp[jt] = (u32x2){pk_hw(v0, v1), pk_hw(v2, v3)}; } \
          else if (jt < it) sp[jt] = (u32x2){pk_hw(acc[0], acc[1]), pk_hw(acc[2], acc[3])}; \
          else asm volatile("" :: "v"(acc)); \
        } \
      } \
        \
        \
      const u32x4 sb0 = (u32x4){sp[0].x, sp[0].y, sp[1].x, sp[1].y}, sb1 = (u32x4){sp[2].x, sp[2].y, sp[3].x, sp[3].y}; \
      f32x4 oacc = (f32x4){0.f, 0.f, 0.f, 0.f}, dacc = (f32x4){0.f, 0.f, 0.f, 0.f}; \
_Pragma("unroll") \
      for (int ks = 0; ks < NKD; ++ks) oacc = __builtin_amdgcn_mfma_f32_16x16x32_bf16(ldfrag(STc, LD_D, vt * 16 + fr, ks * 64 + fq * 16), qf[ks], oacc, 0, 0, 0); \
      if (NVT == 3) { \
_Pragma("unroll") \
        for (int ks = 0; ks < NKD; ++ks) dacc = __builtin_amdgcn_mfma_f32_16x16x32_bf16(ldfrag(STc, LD_D, 32 + fr, ks * 64 + fq * 16), qf[ks], dacc, 0, 0, 0); \
      } \
      if (MIXER == MIX_D) { _Pragma("unroll") for (int e_ = 0; e_ < 4; ++e_) { oacc[e_] = FMUL(oacc[e_], rr_cur); dacc[e_] = FMUL(dacc[e_], rr_cur); } } \
      oacc = __builtin_amdgcn_mfma_f32_16x16x32_bf16(ldfrag2(VTc, LD_T, vt * 16 + fr, fq * 8, 32 + fq * 8), __builtin_bit_cast(bf16x8, sb0), oacc, 0, 0, 0); \
      if (it >= 2) oacc = __builtin_amdgcn_mfma_f32_16x16x32_bf16(ldfrag2(VTc, LD_T, vt * 16 + fr, 64 + fq * 8, 96 + fq * 8), __builtin_bit_cast(bf16x8, sb1), oacc, 0, 0, 0); \
      float dn = 1.0f; \
      if (NVT == 3) { \
        dacc = __builtin_amdgcn_mfma_f32_16x16x32_bf16(ldfrag2(VTc, LD_T, 32 + fr, fq * 8, 32 + fq * 8), __builtin_bit_cast(bf16x8, sb0), dacc, 0, 0, 0); \
        if (it >= 2) dacc = __builtin_amdgcn_mfma_f32_16x16x32_bf16(ldfrag2(VTc, LD_T, 32 + fr, 64 + fq * 8, 96 + fq * 8), __builtin_bit_cast(bf16x8, sb1), dacc, 0, 0, 0); \
        const float den = __shfl(dacc[0], fr); \
        dn = 1.0f / fmaxf(fabsf(den), EMc[it * 16 + fr]); \
      } \
      { \
        const int i = it * 16 + fr; \
        const int ti = dir ? (SEQ - 1 - (n * 64 + i)) : (n * 64 + i); \
        const f32x4 o = (f32x4){FMUL(oacc[0], dn), FMUL(oacc[1], dn), FMUL(oacc[2], dn), FMUL(oacc[3], dn)}; \
        *(u32x2*)(O + PIDX(tokbase + ti, ocol + vt * 16 + fq * 4)) = (u32x2){pk_hw(o[0], o[1]), pk_hw(o[2], o[3])}; \
      } \
      const int dts = (DK == 128) ? wid : (wid & 3); \
      const bf16x8 kf0 = ldfrag(KTc, LD_T, dts * 16 + fr, fq * 16), kf1 = ldfrag(KTc, LD_T, dts * 16 + fr, 64 + fq * 16); \
      const f32x4 dc = *(const f32x4*)(DECc + dts * 16 + fq * 4); \
_Pragma("unroll") \
      for (int s = 0; s < NST; ++s) { \
        const int dt = dts, vt2 = (DK == 128) ? s : (wid >> 2); \
        f32x4 acc = (f32x4){FMUL(sacc[s][0], dc[0]), FMUL(sacc[s][1], dc[1]), FMUL(sacc[s][2], dc[2]), FMUL(sacc[s][3], dc[3])}; \
        acc = __builtin_amdgcn_mfma_f32_16x16x32_bf16(kf0, ldfrag(VTc, LD_T, vt2 * 16 + fr, fq * 16), acc, 0, 0, 0); \
        acc = __builtin_amdgcn_mfma_f32_16x16x32_bf16(kf1, ldfrag(VTc, LD_T, vt2 * 16 + fr, 64 + fq * 16), acc, 0, 0, 0); \
        sacc[s] = acc; \
        *(u32x2*)(STn + (vt2 * 16 + fr) * LD_D + (dt * 16 + fq * 4) * 2) = (u32x2){pk_hw(acc[0], acc[1]), pk_hw(acc[2], acc[3])}; \
      } \
    } \
    } \
    rr_cur = rr_next; \
    lds_barrier(); \
  } while (0)
  static_assert(NCH % 2 == 0, "chunk count must be even");
#pragma unroll 1
  for (int n2 = 0; n2 < NCH; n2 += 2) { SCAN_ITER(n2, R, Rv); SCAN_ITER(n2 + 1, Rn, Rvn); }
#undef SCAN_ITER
#undef A_LOAD
#undef A_PREP
}

template <int MIXER>
__device__ __forceinline__ void scan_dispatch2(unsigned char* lds, int wv, const Params& p, int id) {
  const int vs = id & 3, dir = (id >> 2) & 1, h = (id >> 3) & 3, b = id >> 5;
  scan_item2<MIXER>(lds, wv, p, b, h, dir, vs);
}
}

__device__ __forceinline__ void scan_phase2(unsigned char* lds, int wv, const Params& p, int layer, int convert) {
  bool light = false;
  for (int it0 = blockIdx.x; it0 < 256; it0 += gridDim.x) {
    const int xq = it0 & 7, yq = it0 >> 3, stream = (yq >> 2) * 8 + xq;
    const int item = (stream >> 5) * 128 + (stream & 31) * 4 + (yq & 3);
    if (layer == 0) { if (item < 128) scan2::scan_dispatch2<scan::MIX_A>(lds, wv, p, item); else scan2::scan_dispatch2<scan::MIX_B>(lds, wv, p, item - 128); }
    else { if (item < 128) scan2::scan_dispatch2<scan::MIX_D>(lds, wv, p, item); else scan2::scan_dispatch2<scan::MIX_C>(lds, wv, p, item - 128); }
    light = item >= 128;
    __syncthreads();
  }
  if (convert) {
    const int G = gridDim.x, b = blockIdx.x;
    if (G == 256) { if (light) { moe_weight_convert(lds, wv, p, layer, 0, b - 128, 128); if (p.big_ws) moe_weight_convert(lds, wv, p, layer, 1, b - 128, 128); } }
    else { moe_weight_convert(lds, wv, p, layer, 0, b, G); if (p.big_ws) moe_weight_convert(lds, wv, p, layer, 1, b, G); }
  }
}
#endif
#ifndef CPU_EMU
#define XB_BASE     2048
#define XB_TMO      (XB_BASE + 128)
#define XB_XCNT(j)  (XB_BASE + 256  + 64 * (j))
#define XB_XSUB(j)  (XB_BASE + 1280 + 64 * (j))
#define XB_XGEN(j)  (XB_BASE + 2304 + 64 * (j))
#define XB_TOP      (XB_BASE + 3328)
#define XB_TOPGEN   (XB_BASE + 3392)
#define XB_WORDS    3456
#define XB_SPIN_CAP (1u << 22)
#define XB_LDS_OFF  (LDS_BYTES - 16)
__device__ __forceinline__ unsigned xb_ld(unsigned* p)              { return __hip_atomic_load(p, __ATOMIC_RELAXED, __HIP_MEMORY_SCOPE_AGENT); }
__device__ __forceinline__ unsigned xb_add(unsigned* p, unsigned v) { return __hip_atomic_fetch_add(p, v, __ATOMIC_RELAXED, __HIP_MEMORY_SCOPE_AGENT); }
__device__ __forceinline__ unsigned xb_xcc_id() { return (unsigned)__builtin_amdgcn_s_getreg((3 << 11) | 20) & 0xFu; }
#define XB_SPIN(cond, bar) do { unsigned _sp = 0; while (cond) { __builtin_amdgcn_s_sleep(1); \
    if ((++_sp & 255u) == 0u) { if (xb_ld(&(bar)[XB_TMO])) break; if (_sp > XB_SPIN_CAP) { atomicAdd(&(bar)[XB_TMO], 1u); break; } } } } while (0)
__device__ __forceinline__ void grid_bar(unsigned* bar, unsigned char* lds_raw, int wv) {
  asm volatile("s_waitcnt vmcnt(0)" ::: "memory");
  __syncthreads();
  if (wv == 0 && lane_id() == 0) {
    volatile unsigned* st = (volatile unsigned*)(lds_raw + XB_LDS_OFF);
    __builtin_amdgcn_s_waitcnt(0);
    const unsigned x = xb_xcc_id();
    unsigned nloc = st[0], nx = st[1];
    if (nloc == 0u) {
      const unsigned G = gridDim.x; unsigned sum, cnt, mine, sp = 0u;
      for (;;) { sum = 0u; cnt = 0u; mine = 0u;
#pragma unroll
        for (unsigned j = 0; j < 16; ++j) { const unsigned c = xb_ld(&bar[XB_XCNT(j)]); sum += c; cnt += (c > 0u) ? 1u : 0u; mine = (j == x) ? c : mine; }
        if (sum == G) break;
        __builtin_amdgcn_s_sleep(1);
        if ((++sp & 255u) == 0u) { if (xb_ld(&bar[XB_TMO])) break; if (sp > XB_SPIN_CAP) { atomicAdd(&bar[XB_TMO], 1u); break; } } }
      nloc = mine > 0u ? mine : 1u; nx = cnt > 0u ? cnt : 1u; st[0] = nloc; st[1] = nx;
    }
    const unsigned old = xb_add(&bar[XB_XSUB(x)], 1u);
    const unsigned gen = old / nloc;
    if (old + 1u == (gen + 1u) * nloc) {
      __builtin_amdgcn_fence(__ATOMIC_RELEASE, "agent");
      asm volatile("s_waitcnt vmcnt(0)" ::: "memory");
      const unsigned og = xb_add(&bar[XB_TOP], 1u);
      const unsigned tg = og / nx;
      if (og + 1u == (tg + 1u) * nx) xb_add(&bar[XB_TOPGEN], 1u);
      else XB_SPIN(xb_ld(&bar[XB_TOPGEN]) == tg, bar);
      __builtin_amdgcn_fence(__ATOMIC_ACQUIRE, "agent");
      xb_add(&bar[XB_XGEN(x)], 1u);
      asm volatile("s_waitcnt vmcnt(0)" ::: "memory");
    } else {
      XB_SPIN(xb_ld(&bar[XB_XGEN(x)]) == gen, bar);
      __builtin_amdgcn_fence(__ATOMIC_ACQUIRE, "agent");
      asm volatile("s_waitcnt vmcnt(0)" ::: "memory");
    }
  }
  __syncthreads();
}
#if (PROBE_DUP & 16)
#define grid_bar(a, b, c) do { grid_bar(a, b, c); grid_bar(a, b, c); } while (0)
#endif

__global__ void __launch_bounds__(NTHREADS) mk_fwd(Params p) {
  extern __shared__ __attribute__((aligned(16))) unsigned char lds_raw[];
  cg::grid_group grid = cg::this_grid();
  const int G = gridDim.x, bid = blockIdx.x;
  const int wv = __builtin_amdgcn_readfirstlane(threadIdx.x >> 6);
  PG8_LAS unsigned char* lds = (PG8_LAS unsigned char*)lds_raw;
  unsigned char* ws = p.ws;

  if (threadIdx.x < 4) ((unsigned*)(lds_raw + XB_LDS_OFF))[threadIdx.x] = 0u;
  p0_prologue(lds_raw, wv, p);
#if (PROBE_DUP & 128)
  p0_prologue(lds_raw, wv, p);
#endif
  grid.sync();
  unsigned* bar = (unsigned*)(ws + WS_CTL);
  if (wv == 0 && lane_id() == 0) (void)xb_add(&bar[XB_XCNT(xb_xcc_id())], 1u);
  for (int layer = 0; layer < 2; ++layer) {
    { ProbInProj pr; pr.so.init(NTOK, layer == 0 ? PM_AB : PM_CD, G, bid); pr.A = (const char*)p.out; pr.Bt = (const char*)(ws + (layer == 0 ? WS_WIN_AB : WS_WIN_CD));
      pr.P = (bf16_t*)(ws + WS_R1); pr.bias = p.in[layer == 0 ? I_AB_B_IN : I_CD_B_IN]; pr.lb = (const float*)(ws + WS_LB); pr.layer = layer;
      pg8::gemm_phase(lds, pr, wv);
#if (PROBE_DUP & (1 | 2048))
      pg8::gemm_phase(lds, pr, wv);
#endif
      if (layer == 0) side_phase<32>(lds_raw, wv, p, 0); else side_phase<16>(lds_raw, wv, p, 1);
#if (PROBE_DUP & 256)
      if (layer == 0) side_phase<32>(lds_raw, wv, p, 0); else side_phase<16>(lds_raw, wv, p, 1);
#endif
 }
    grid_bar(bar, lds_raw, wv);
    if (layer == 1) { convd_phase(lds_raw, wv, p); grid_bar(bar, lds_raw, wv); }
    scan_phase2(lds_raw, wv, p, layer, 1);
#if (PROBE_DUP & 2)
    scan_phase2(lds_raw, wv, p, layer, 0);
#endif
#if (PROBE_DUP & 512)
    if (layer == 0) scan_phase2(lds_raw, wv, p, layer, 0);
#endif
#if (PROBE_DUP & 1024)
    if (layer == 1) scan_phase2(lds_raw, wv, p, layer, 0);
#endif
    grid_bar(bar, lds_raw, wv);
    headnorm_phase(lds_raw, wv, p, layer);
#if (PROBE_DUP & 8)
    headnorm_phase(lds_raw, wv, p, layer);
#endif
    grid_bar(bar, lds_raw, wv);
    { ProbOutProj pr; pr.so.init(NTOK, 1024, G, bid); pr.A = (const char*)(ws + WS_MIX); pr.Bt = (const char*)(ws + (layer == 0 ? WS_WOUT_AB : WS_WOUT_CD)); pr.Y = (bf16_t*)(ws + WS_R2); pr.Hres = (const bf16_t*)p.out;
      pg8::gemm_phase(lds, pr, wv);
#if (PROBE_DUP & (1 | 16384))
      pg8::gemm_phase(lds, pr, wv);
#endif
      if (!p.big_ws) moe_weight_convert(lds_raw, wv, p, layer, 1, bid, G);
 }
    grid_bar(bar, lds_raw, wv);
#if (PROBE_DUP & 32)
    ln_phase(lds_raw, wv, p, layer, 0, 1);
#endif
    ln_phase(lds_raw, wv, p, layer, 0);
    grid_bar(bar, lds_raw, wv);
    { ProbMoe1 pr; pr.mo.init((const int*)((const unsigned*)(ws + WS_CTL) + CW_CNT(layer)), 8, G, bid, lds_raw, wv);
      pr.A = (const char*)(ws + WS_MIX); pr.W13 = (const char*)(ws + WS_W13); pr.list = (const int*)(ws + WS_LIST) + (size_t)layer * NEXP * NTOK; pr.H = (bf16_t*)(ws + WS_H);
      pg8::gemm_phase(lds, pr, wv);
#if (PROBE_DUP & (1 | 4096))
      pg8::gemm_phase(lds, pr, wv);
#endif
 }
    grid_bar(bar, lds_raw, wv);
    { ProbMoe2 pr; pr.mo.init((const int*)((const unsigned*)(ws + WS_CTL) + CW_CNT(layer)), 4, G, bid, lds_raw, wv);
      pr.A = (const char*)(ws + WS_H); pr.W2 = (const char*)(ws + (p.big_ws ? WS_W2X : WS_W2)); pr.Y = (bf16_t*)(ws + WS_R2);
      pg8::gemm_phase(lds, pr, wv);
#if (PROBE_DUP & (1 | 8192))
      pg8::gemm_phase(lds, pr, wv);
#endif
 }
    grid_bar(bar, lds_raw, wv);
#if (PROBE_DUP & 64)
    ln_phase(lds_raw, wv, p, layer, 1, 1);
#endif
    ln_phase(lds_raw, wv, p, layer, 1);
    if (layer == 0) grid_bar(bar, lds_raw, wv);
  }
}

extern "C" void kernel_launch(void* const* d_in, const int* in_sizes, int n_in, void* d_out, int out_size, void* d_ws, size_t ws_size, hipStream_t stream) {
  static int grid_blocks = 0;
  if (grid_blocks == 0) {
    if (n_in != N_IN || ws_size < WS_END || out_size != NTOK * 1024) { fprintf(stderr, "kernel_launch: bad shapes: n_in %d ws %zu (need %zu) out %d\n", n_in, ws_size, (size_t)WS_END, out_size); grid_blocks = -1; return; }
    int dev = 0, cus = 0, per_cu = 0;
    hipGetDevice(&dev); hipDeviceGetAttribute(&cus, hipDeviceAttributeMultiprocessorCount, dev);
    if (hipFuncSetAttribute((const void*)mk_fwd, hipFuncAttributeMaxDynamicSharedMemorySize, LDS_BYTES) != hipSuccess) { fprintf(stderr, "kernel_launch: hipFuncSetAttribute failed\n"); grid_blocks = -1; return; }
    if (hipOccupancyMaxActiveBlocksPerMultiprocessor(&per_cu, (const void*)mk_fwd, NTHREADS, LDS_BYTES) != hipSuccess || per_cu < 1) { fprintf(stderr, "kernel_launch: occupancy query failed (%d)\n", per_cu); grid_blocks = -1; return; }
    grid_blocks = cus;
    (void)in_sizes;
  }
  if (grid_blocks < 0) return;
  Params p{};
  for (int i = 0; i < N_IN; ++i) p.in[i] = (const float*)d_in[i];
  p.out = (float*)d_out; p.ws = (unsigned char*)d_ws; p.big_ws = ws_size >= (size_t)WS_END_BIG ? 1 : 0;
  void* args[] = {&p};
  hipError_t e = hipLaunchCooperativeKernel((const void*)mk_fwd, dim3(grid_blocks), dim3(NTHREADS), args, LDS_BYTES, stream);
  if (e != hipSuccess) fprintf(stderr, "cooperative launch failed: %s (grid %d)\n", hipGetErrorString(e), grid_blocks);
}
#endif
```

```cpp
#ifdef CPU_EMU
#include <cmath>
#include <cstdio>
#include <cstring>
#include <cstdlib>
#include <cstddef>
#define DEV
#define DEV_INLINE static inline
typedef void* hipStream_t;
#else
#include <hip/hip_runtime.h>
#include <hip/hip_bf16.h>
#include <cstdio>
#define DEV __device__ __forceinline__
#define DEV_INLINE __device__ __forceinline__
#endif
#ifndef PROBE_DUP
#define PROBE_DUP 0
#endif
#ifndef BATCH
#define BATCH 4
#endif
#ifndef SEQ
#define SEQ 8192
#endif
#define DM 1024
#define NTOK (BATCH * SEQ)
#define P_AB 4128
#define P_CD 3600
#define PM_AB 4096
#define PM_CD 3584
#define NEXP 16
#define ALPHA_F 1.4142135623730951f
#define LN_EPS_F 1e-5f
#define NORM_EPS_F 1e-6f
#define HROWS (2 * NTOK + NEXP * 256)

typedef unsigned short bf16_t;

DEV_INLINE float bf2f(bf16_t b) { unsigned u = ((unsigned)b) << 16; float f; memcpy(&f, &u, 4); return f; }
DEV_INLINE bf16_t f2bf(float f) { unsigned u; memcpy(&u, &f, 4); u += 0x7FFFu + ((u >> 16) & 1u); return (bf16_t)(u >> 16); }
DEV_INLINE float sigmoidf_(float x) { return 1.0f / (1.0f + expf(-x)); }
DEV_INLINE float siluf_(float x) { return x / (1.0f + expf(-x)); }
DEV_INLINE float logsigmoidf_(float x) { return fminf(x, 0.0f) - log1pf(expf(-fabsf(x))); }

#define AL256(x) (((size_t)(x) + 255) & ~(size_t)255)
#define WS_CTL    ((size_t)0)
#define WS_HB     ((size_t)65536)
#define WS_R1     (WS_HB + (size_t)NTOK * 1024 * 2)
#define R1_P_BYTES ((size_t)NTOK * 4096 * 2)
#define R1_MIN    ((size_t)NTOK * 1024 * 2 + AL256((size_t)HROWS * 1024 * 2))
#define R1_PL     (R1_P_BYTES + (size_t)NTOK * 512 * 2)
#define R1_BYTES  (R1_PL > R1_MIN ? R1_PL : R1_MIN)
#define WS_LFB    (WS_R1 + R1_P_BYTES)
#define WS_MIX    (WS_R1)
#define WS_H      (WS_R1 + (size_t)NTOK * 1024 * 2)
#define WS_W13    (WS_HB)
#define WS_W2     (WS_LFB)
#define WMOE_BYTES ((size_t)NEXP * 3072 * 1024 * 2)
#define WS_R2     (WS_R1 + R1_BYTES)
#define R2_BYTES  ((size_t)HROWS * 1024 * 2 > (size_t)NTOK * 1024 * 4 ? (size_t)HROWS * 1024 * 2 : (size_t)NTOK * 1024 * 4)
#define WS_SIDE   (WS_R2 + AL256(R2_BYTES))
#define WS_WIN_AB (WS_SIDE + (size_t)NTOK * 32 * 4)
#define WS_WIN_CD (WS_WIN_AB + (size_t)4128 * 1024 * 2)
#define WS_WOUT_AB (WS_WIN_CD + (size_t)3600 * 1024 * 2)
#define WS_WOUT_CD (WS_WOUT_AB + (size_t)1024 * 1024 * 2)
#define WS_ROPE   (WS_WOUT_CD + (size_t)1024 * 1024 * 2)
#define WS_LB     (WS_ROPE + (size_t)SEQ * 64 * 4)
#define WS_LIST   (WS_LB + 4096)
#define WS_ASSIGN (WS_LIST + (size_t)2 * NEXP * NTOK * 4)
#define WS_GATE   (WS_ASSIGN + (size_t)NTOK * 16)
#define WS_END    (WS_GATE + (size_t)NTOK * 8)
#define WS_W2X    (AL256(WS_END))
#define WS_END_BIG (WS_W2X + (size_t)NEXP * 1024 * 1024 * 2)
#define CW_CNT(layer) (64 + 256 * (layer))

#define PSTRIDE 4096
#define PIDX(tok, col) ((((size_t)((col) >> 7)) * NTOK + (size_t)(tok)) * 128 + (size_t)((col) & 127))

enum { I_X, I_AB_W_IN, I_AB_B_IN, I_HGRN_LB, I_GK_UP, I_GK_B, I_HGRN_NORM, I_GLA_NORM, I_AB_W_OUT,
       I_CD_W_IN, I_CD_B_IN, I_CONV_W, I_CONV_B, I_FGATE_B, I_RET_NORM, I_MLSTM_NORM, I_CD_W_OUT,
       I_LN_MIX_G, I_LN_MIX_B, I_LN_FFN_G, I_LN_FFN_B, I_ROUTER_W, I_ROUTER_B, I_MOE_W1, I_MOE_W3, I_MOE_W2, N_IN };

struct Params {
  const float* in[N_IN];
  float* out;
  unsigned char* ws;
  long long big_ws;
};

DEV_INLINE float epi_ab(int col, float v, const float* lb) {
  if (col < 512) return siluf_(v);
  if (col < 1536) { float l = lb[(col - 512) & 511]; return logf(l + (1.0f - l) * sigmoidf_(v)); }
  if (col >= 2560 && col < 2816) return v * 0.125f;
  return v;
}

DEV_INLINE void route_from_logits(const float* lg, const float* rb, int* e_out, float* g_out) {
  float mx = lg[0];
#pragma unroll
  for (int e = 1; e < 16; ++e) mx = fmaxf(mx, lg[e]);
  float sc[16]; float sum = 0.f;
#pragma unroll
  for (int e = 0; e < 16; ++e) { sc[e] = expf(lg[e] - mx); sum += sc[e]; }
  float inv = 1.0f / sum;
  float best_gs = -1e30f; int be1 = 0, be2 = 1; float bs1 = 0.f, bs2 = 0.f;
#pragma unroll
  for (int gq = 0; gq < 4; ++gq) {
    float m1 = -1e30f, m2 = -1e30f, s1 = 0.f, s2 = 0.f; int i1 = 0, i2 = 0;
#pragma unroll
    for (int i = 0; i < 4; ++i) {
      float s = sc[gq * 4 + i] * inv; float v = s + rb[gq * 4 + i];
      if (v > m1) { m2 = m1; i2 = i1; s2 = s1; m1 = v; i1 = gq * 4 + i; s1 = s; }
      else if (v > m2) { m2 = v; i2 = gq * 4 + i; s2 = s; }
    }
    float gs = m1 + m2;
    if (gs > best_gs) { best_gs = gs; be1 = i1; be2 = i2; bs1 = s1; bs2 = s2; }
  }
  e_out[0] = be1; e_out[1] = be2; g_out[0] = bs1 / (bs1 + bs2); g_out[1] = bs2 / (bs1 + bs2);
}
#ifndef CPU_EMU
namespace pg8 {
#define PG8_LAS __attribute__((address_space(3)))
typedef short bf16x8 __attribute__((ext_vector_type(8)));
typedef float f32x4 __attribute__((ext_vector_type(4)));
typedef unsigned u32x4 __attribute__((ext_vector_type(4)));
typedef unsigned u32x2 __attribute__((ext_vector_type(2)));
constexpr int BM = 256, BK = 64, HALF = 128, HTB = HALF * BK * 2, STAGE_BYTES = 8 * HTB, NXCD = 8, WGM = 8, GK = 1024;

__device__ __forceinline__ int lds_byte(int r, int c) { const int st = (r >> 4) * 2 + (c >> 5), rr = r & 15, cc = c & 31, ob = rr * 64 + cc * 2; return st * 1024 + (ob ^ (((ob >> 9) & 1) << 5)); }
__device__ __forceinline__ void stage_rc(int b, int& R, int& C) { const int st = b / 1024, sb = b % 1024, swz = sb ^ (((sb >> 9) & 1) << 5); R = (st >> 1) * 16 + swz / 64; C = (st & 1) * 32 + (swz % 64) / 2; }
__device__ __forceinline__ int perm32(int rho) { const int n = rho >> 4, i = rho & 15; return 8 * (i >> 2) + 4 * n + (i & 3); }
__device__ __forceinline__ unsigned cvt_pk_bf16(float lo, float hi) { unsigned r; asm volatile("v_cvt_pk_bf16_f32 %0, %1, %2" : "=v"(r) : "v"(lo), "v"(hi)); return r; }

struct Unit { int pm, pn, e, row0, ne, ui; };

struct StaticOrder {
  int nM, nN, nwg, G, c;
  __device__ void init(int M, int N, int G_, int c_) { nM = M / BM; nN = N / BM; nwg = nM * nN; G = G_; c = c_; }
  __device__ bool next(int i, Unit& u) const {
    const long L = (long)i * G + c; if (L >= nwg) return false;
    int wgid = (int)L; { const int q = nwg / NXCD, r = nwg % NXCD, xcd = wgid % NXCD, off = wgid / NXCD; wgid = (xcd < r ? xcd * (q + 1) : r * (q + 1) + (xcd - r) * q) + off; }
    const int nig = WGM * nN, gid = wgid / nig, fm = gid * WGM, gsz = (nM - fm) < WGM ? (nM - fm) : WGM;
    u.pm = fm + ((wgid % nig) % gsz); u.pn = (wgid % nig) / gsz; u.e = 0; u.row0 = u.pm * BM; u.ne = 0; u.ui = i; return true;
  }
};

template <class Prob>
__device__ __forceinline__ void gemm_phase(PG8_LAS unsigned char* lds, const Prob& S, int wv) {
  int wv_ = wv; asm volatile("" : "+s"(wv_));
  int l_; asm volatile("v_mbcnt_lo_u32_b32 %0, -1, 0\n\tv_mbcnt_hi_u32_b32 %0, -1, %0" : "=v"(l_));
  int tid_ = wv_ * 64 + l_;
  const int tid = tid_, wid = __builtin_amdgcn_readfirstlane(tid >> 6), lane = tid & 63, wr = wid >> 2, wc = wid & 3, fr = lane & 15, fq = lane >> 4;
  constexpr int K = GK, nt = K / BK;
  int sR[2], sC[2]; unsigned voffB[2];
#pragma unroll
  for (int i = 0; i < 2; ++i) { int R, C; stage_rc(tid * 16 + i * 8192, R, C); sR[i] = R; sC[i] = C; const int Rb = Prob::PERM ? ((R & ~31) + perm32(R & 31)) : R; voffB[i] = (unsigned)(Rb * K + C) * 2u; }
  const size_t kstep = (size_t)(BK * 2);
  const size_t hstep = (size_t)HALF * K * 2;
  const unsigned ldsw = (unsigned)wid * 1024u;
  const int aoff = lds_byte(wr * 64 + fr, fq * 8), boff = lds_byte(wc * 32 + fr, fq * 8);
#define PG8_SA(b, h) (((b) * 2 + (h)) * HTB)
#define PG8_SB(b, h) ((4 + (b) * 2 + (h)) * HTB)
#define PG8_STAGE(bufoff, gbase, voff) do { _Pragma("unroll") for (int _i = 0; _i < 2; ++_i) \
    __builtin_amdgcn_global_load_lds((const unsigned*)((const char*)(gbase) + (voff)[_i]), (PG8_LAS unsigned*)(lds + (bufoff) + ldsw + _i * 8192), 16, 0, 0); } while (0)
#define PG8_LDA(dst, b, h) do { _Pragma("unroll") for (int m = 0; m < 4; ++m) _Pragma("unroll") for (int k = 0; k < 2; ++k) dst[m][k] = *(const PG8_LAS bf16x8*)(lds + PG8_SA(b, h) + aoff + m * 2048 + k * 1024); } while (0)
#define PG8_LDB(dst, b, h) do { _Pragma("unroll") for (int n = 0; n < 2; ++n) _Pragma("unroll") for (int k = 0; k < 2; ++k) dst[n][k] = *(const PG8_LAS bf16x8*)(lds + PG8_SB(b, h) + boff + n * 2048 + k * 1024); } while (0)
#define PG8_MMA(ai, bj, At, Bt) do { __builtin_amdgcn_s_setprio(1); _Pragma("unroll") for (int m = 0; m < 4; ++m) _Pragma("unroll") for (int n = 0; n < 2; ++n) _Pragma("unroll") for (int k = 0; k < 2; ++k) \
    acc[ai][bj][m][n] = __builtin_amdgcn_mfma_f32_16x16x32_bf16(Bt[n][k], At[m][k], acc[ai][bj][m][n], 0, 0, 0); __builtin_amdgcn_s_setprio(0); } while (0)
#define PG8_WAIT_V(n) asm volatile("s_waitcnt vmcnt(" #n ")" ::: "memory")
#define PG8_WAIT_L(n) asm volatile("s_waitcnt lgkmcnt(" #n ")" ::: "memory")
#define PG8_BAR __builtin_amdgcn_s_barrier()
#define PG8_SCHED __builtin_amdgcn_sched_barrier(0)
  Unit cur, nxt; int ui = 0;
  if (!S.next(0, cur)) return;
  f32x4 acc[2][2][4][2];
#pragma unroll
  for (int a = 0; a < 2; ++a)
#pragma unroll
    for (int b = 0; b < 2; ++b)
#pragma unroll
      for (int m = 0; m < 4; ++m)
#pragma unroll
        for (int n = 0; n < 2; ++n) acc[a][b][m][n] = (f32x4){0.f, 0.f, 0.f, 0.f};
  bf16x8 At[4][2], B0[2][2], B1[2][2];
  unsigned oc0[2], oc1[2], on0[2], on1[2];
#pragma unroll
  for (int i = 0; i < 2; ++i) { oc0[i] = S.a_off(cur, sR[i]) + (unsigned)sC[i] * 2u; oc1[i] = S.a_off(cur, HALF + sR[i]) + (unsigned)sC[i] * 2u; }
  const char* const Ab = S.a_base();
  const char* cB = S.b_base(cur);
  PG8_STAGE(PG8_SB(0, 0), cB, voffB); PG8_STAGE(PG8_SB(0, 1), cB + hstep, voffB); PG8_STAGE(PG8_SA(0, 0), Ab, oc0); PG8_STAGE(PG8_SA(0, 1), Ab, oc1);
  if (wr == 1) PG8_BAR;
  PG8_WAIT_V(2); PG8_BAR;
  PG8_STAGE(PG8_SB(1, 0), cB + kstep, voffB); PG8_STAGE(PG8_SA(1, 0), Ab + kstep, oc0); PG8_STAGE(PG8_SB(1, 1), cB + hstep + kstep, voffB);
  PG8_WAIT_V(6); PG8_BAR;
  for (;;) {
    const bool has_next = S.next(ui + 1, nxt);
    const char* nB = cB;
    if (has_next) {
      nB = S.b_base(nxt);
      int l2_; asm volatile("v_mbcnt_lo_u32_b32 %0, -1, 0\n\tv_mbcnt_hi_u32_b32 %0, -1, %0" : "=v"(l2_));
      const int tid2 = wid * 64 + l2_;
#pragma unroll
      for (int i = 0; i < 2; ++i) { int R, C; stage_rc(tid2 * 16 + i * 8192, R, C); on0[i] = S.a_off(nxt, R) + (unsigned)C * 2u; on1[i] = S.a_off(nxt, HALF + R) + (unsigned)C * 2u; }
    } else {
#pragma unroll
      for (int i = 0; i < 2; ++i) { on0[i] = oc0[i]; on1[i] = oc1[i]; }
    }
    for (int t = 0; t < nt; t += 2) {
      const bool last = (t == nt - 2);
      const char* a1 = Ab + (size_t)(t + 1) * kstep;
      const char* a2 = last ? Ab : Ab + (size_t)(t + 2) * kstep; const char* b2 = last ? nB : cB + (size_t)(t + 2) * kstep;
      const char* a3 = a2 + kstep; const char* b3 = b2 + kstep;
      unsigned o20[2], o21[2];
#pragma unroll
      for (int i = 0; i < 2; ++i) { o20[i] = last ? on0[i] : oc0[i]; o21[i] = last ? on1[i] : oc1[i]; }
      PG8_LDB(B0, 0, 0); PG8_LDB(B1, 0, 1); PG8_SCHED; PG8_LDA(At, 0, 0); PG8_STAGE(PG8_SA(1, 1), a1, oc1);
      PG8_WAIT_V(8); PG8_WAIT_L(0); PG8_BAR; PG8_MMA(0, 0, At, B0); PG8_MMA(0, 1, At, B1); PG8_BAR; PG8_SCHED;
      PG8_LDA(At, 0, 1); PG8_STAGE(PG8_SB(0, 0), b2, voffB); PG8_STAGE(PG8_SB(0, 1), b2 + hstep, voffB); PG8_STAGE(PG8_SA(0, 0), a2, o20);
      PG8_WAIT_V(8); PG8_WAIT_L(0); PG8_BAR; PG8_MMA(1, 0, At, B0); PG8_MMA(1, 1, At, B1); PG8_BAR; PG8_SCHED;
      PG8_LDB(B0, 1, 0); PG8_LDB(B1, 1, 1); PG8_SCHED; PG8_LDA(At, 1, 0); PG8_STAGE(PG8_SA(0, 1), a2, o21);
      PG8_WAIT_V(8); PG8_WAIT_L(0); PG8_BAR; PG8_MMA(0, 0, At, B0); PG8_MMA(0, 1, At, B1); PG8_BAR; PG8_SCHED;
      PG8_LDA(At, 1, 1); PG8_STAGE(PG8_SB(1, 0), b3, voffB); PG8_STAGE(PG8_SB(1, 1), b3 + hstep, voffB); PG8_STAGE(PG8_SA(1, 0), a3, o20);
      PG8_WAIT_V(8); PG8_WAIT_L(0); PG8_BAR; PG8_MMA(1, 0, At, B0); PG8_MMA(1, 1, At, B1); PG8_BAR; PG8_SCHED;
    }
    if (wr == 0) PG8_BAR;
    { int l3_; asm volatile("v_mbcnt_lo_u32_b32 %0, -1, 0\n\tv_mbcnt_hi_u32_b32 %0, -1, %0" : "=v"(l3_));
      S.epi(acc, cur, wr, wc, l3_ & 15, l3_ >> 4); }
    if (!has_next) break;
#pragma unroll
    for (int a = 0; a < 2; ++a)
#pragma unroll
      for (int b = 0; b < 2; ++b)
#pragma unroll
        for (int m = 0; m < 4; ++m)
#pragma unroll
          for (int n = 0; n < 2; ++n) acc[a][b][m][n] = (f32x4){0.f, 0.f, 0.f, 0.f};
    cur = nxt; cB = nB; ++ui;
#pragma unroll
    for (int i = 0; i < 2; ++i) { oc0[i] = on0[i]; oc1[i] = on1[i]; }
    if (wr == 1) PG8_BAR;
  }
  PG8_WAIT_V(0);
  PG8_BAR;
#undef PG8_SA
#undef PG8_SB
#undef PG8_STAGE
#undef PG8_LDA
#undef PG8_LDB
#undef PG8_MMA
#undef PG8_WAIT_V
#undef PG8_WAIT_L
#undef PG8_BAR
#undef PG8_SCHED
}
}
#endif
#ifndef CPU_EMU
#include <hip/hip_cooperative_groups.h>
namespace cg = cooperative_groups;
#define LAS __attribute__((address_space(3)))
#define NTHREADS 512
#define LDS_BYTES (154 * 1024)
typedef float f32x4 __attribute__((ext_vector_type(4)));
typedef short bf16x8 __attribute__((ext_vector_type(8)));
typedef unsigned u32x4 __attribute__((ext_vector_type(4)));
typedef unsigned u32x2 __attribute__((ext_vector_type(2)));

struct Ctx { int tid, lane, wid, G, bid; unsigned char* lds; };
__device__ __forceinline__ int lane_id() { int l; asm volatile("v_mbcnt_lo_u32_b32 %0, -1, 0\n\tv_mbcnt_hi_u32_b32 %0, -1, %0" : "=v"(l)); return l; }
__device__ __forceinline__ int opaque_tid(int wv) { int w = wv; asm volatile("" : "+s"(w)); int t = w * 64 + lane_id(); asm volatile("" : "+v"(t)); return t; }
__device__ __forceinline__ Ctx make_ctx(unsigned char* lds, int wv) { Ctx c; c.tid = opaque_tid(wv); c.lane = c.tid & 63; c.wid = __builtin_amdgcn_readfirstlane(c.tid >> 6); c.G = gridDim.x; c.bid = blockIdx.x; c.lds = lds; return c; }

__device__ __forceinline__ float wave_sum(float x) {
  x += __builtin_bit_cast(float, __builtin_amdgcn_update_dpp(0, __builtin_bit_cast(int, x), 0x111, 0xf, 0xf, false));
  x += __builtin_bit_cast(float, __builtin_amdgcn_update_dpp(0, __builtin_bit_cast(int, x), 0x112, 0xf, 0xf, false));
  x += __builtin_bit_cast(float, __builtin_amdgcn_update_dpp(0, __builtin_bit_cast(int, x), 0x114, 0xf, 0xf, false));
  x += __builtin_bit_cast(float, __builtin_amdgcn_update_dpp(0, __builtin_bit_cast(int, x), 0x118, 0xf, 0xf, false));
  x += __builtin_bit_cast(float, __builtin_amdgcn_update_dpp(0, __builtin_bit_cast(int, x), 0x142, 0xa, 0xf, false));
  x += __builtin_bit_cast(float, __builtin_amdgcn_update_dpp(0, __builtin_bit_cast(int, x), 0x143, 0xc, 0xf, false));
  return __builtin_bit_cast(float, __builtin_amdgcn_readlane(__builtin_bit_cast(int, x), 63));
}
__device__ __forceinline__ float fsigmoid(float x) { return __builtin_amdgcn_rcpf(1.0f + __builtin_amdgcn_exp2f(-1.4426950408889634f * x)); }
__device__ __forceinline__ float fsilu(float x) { return x * fsigmoid(x); }
__device__ __forceinline__ float flog2sigmoid(float x) { const float y = x * 1.4426950408889634f; return fminf(y, 0.f) - __builtin_amdgcn_logf(1.0f + __builtin_amdgcn_exp2f(-fabsf(y))); }
typedef float f32x2_t __attribute__((ext_vector_type(2)));
typedef __bf16 bf16x2_t __attribute__((ext_vector_type(2)));
__device__ __forceinline__ unsigned pk_hw(float a, float b) { const f32x2_t v = {a, b}; return __builtin_bit_cast(unsigned, __builtin_convertvector(v, bf16x2_t)); }
__device__ __forceinline__ unsigned pk2(float a, float b) { return pk_hw(a, b); }
__device__ __forceinline__ void unpack8(u32x4 w, float* f) {
  f[0] = __uint_as_float(w.x << 16); f[1] = __uint_as_float(w.x & 0xffff0000u); f[2] = __uint_as_float(w.y << 16); f[3] = __uint_as_float(w.y & 0xffff0000u);
  f[4] = __uint_as_float(w.z << 16); f[5] = __uint_as_float(w.z & 0xffff0000u); f[6] = __uint_as_float(w.w << 16); f[7] = __uint_as_float(w.w & 0xffff0000u);
}

__device__ __forceinline__ void transpose_job(const Ctx& c, const float* src, int N, bf16_t* dst, int rs, int ro, int tile0, int tile_stride) {
  float* t = (float*)c.lds;
  const int ntn = (N + 63) / 64, ntiles = ntn * 16;
  for (int tl = tile0; tl < ntiles; tl += tile_stride) {
    const int kt = tl / ntn, nt_ = tl % ntn, k0 = kt * 64, n0 = nt_ * 64;
    __syncthreads();
#pragma unroll
    for (int i = 0; i < 8; ++i) { const int idx = c.tid + i * 512, kk = idx >> 6, nn = idx & 63; t[kk * 65 + nn] = (n0 + nn < N) ? src[(size_t)(k0 + kk) * N + n0 + nn] : 0.f; }
    __syncthreads();
#pragma unroll
    for (int i = 0; i < 4; ++i) { const int idx = c.tid + i * 512, nn = idx >> 5, kp = (idx & 31) * 2;
      if (n0 + nn < N) *(unsigned*)(dst + (size_t)((n0 + nn) * rs + ro) * 1024 + k0 + kp) = pk2(t[kp * 65 + nn], t[(kp + 1) * 65 + nn]); }
  }
  __syncthreads();
}
__device__ __forceinline__ void p0_prologue(unsigned char* lds_, int wv, const Params& p) {
  const Ctx c = make_ctx(lds_, wv);
  unsigned char* ws = p.ws;
  if (c.bid == 0) { ((unsigned*)(ws + WS_CTL))[64 + c.tid] = 0u; }
  if (c.bid == 0) { for (int i = c.tid; i < 3456; i += NTHREADS) ((unsigned*)(ws + WS_CTL))[2048 + i] = 0u; }
  { const float* x = p.in[I_X]; bf16_t* hb = (bf16_t*)p.out;
    for (size_t i = (size_t)c.bid * NTHREADS + c.tid; i < (size_t)NTOK * 1024 / 8; i += (size_t)c.G * NTHREADS) {
      const f32x4 a = __builtin_nontemporal_load((const f32x4*)(x + i * 8)), b = __builtin_nontemporal_load((const f32x4*)(x + i * 8 + 4));
      u32x4 w; w.x = pk2(a[0], a[1]); w.y = pk2(a[2], a[3]); w.z = pk2(b[0], b[1]); w.w = pk2(b[2], b[3]);
      *(u32x4*)(hb + i * 8) = w; } }
  transpose_job(c, p.in[I_AB_W_IN], P_AB, (bf16_t*)(ws + WS_WIN_AB), 1, 0, c.bid, c.G);
  transpose_job(c, p.in[I_CD_W_IN], P_CD, (bf16_t*)(ws + WS_WIN_CD), 1, 0, c.bid, c.G);
  transpose_job(c, p.in[I_AB_W_OUT], 1024, (bf16_t*)(ws + WS_WOUT_AB), 1, 0, c.bid, c.G);
  transpose_job(c, p.in[I_CD_W_OUT], 1024, (bf16_t*)(ws + WS_WOUT_CD), 1, 0, c.bid, c.G);
  { float* rope = (float*)(ws + WS_ROPE);
    for (int i = c.bid * NTHREADS + c.tid; i < SEQ * 32; i += c.G * NTHREADS) { const int t = i >> 5, f = i & 31;
      const float freq = powf(10000.0f, -(float)f / 32.0f); const float ang = (float)t * freq; rope[i * 2] = cosf(ang); rope[i * 2 + 1] = sinf(ang); }
    if (c.bid == 1) { const float* hl = p.in[I_HGRN_LB]; float* lb = (float*)(ws + WS_LB);
      const int cc = c.tid; const float a0 = hl[cc], a1 = hl[512 + cc], a2 = hl[1024 + cc]; const float mx = fmaxf(a0, fmaxf(a1, a2));
      const float e0 = expf(a0 - mx), e1 = expf(a1 - mx), e2 = expf(a2 - mx); lb[cc] = e0 / (e0 + e1 + e2); } }
}
__device__ __forceinline__ void moe_weight_convert(unsigned char* lds_, int wv, const Params& p, int layer, int part, int bidx, int nblk) {
  const Ctx c = make_ctx(lds_, wv);
  bf16_t* w13 = (bf16_t*)(p.ws + WS_W13); bf16_t* w2 = (bf16_t*)(p.ws + (p.big_ws ? WS_W2X : WS_W2));
  const size_t lo = (size_t)layer * NEXP * 1024 * 1024;
  const float* W1 = p.in[I_MOE_W1] + lo; const float* W3 = p.in[I_MOE_W3] + lo; const float* W2 = p.in[I_MOE_W2] + lo;
  float* t = (float*)c.lds;
  const int NT = (part == 0 ? 32 : 16) * 128;
  const int lk = c.tid >> 5, ln4 = (c.tid & 31) * 4;
  const int sn = c.tid & 127, sk = (c.tid >> 7) * 8;
  f32x4 r[4];
#define MW_SRC(g_) ((part == 0 ? ((((g_) >> 7) & 1) ? W3 : W1) + (size_t)((g_) >> 8) * 1048576 : W2 + (size_t)((g_) >> 7) * 1048576) + (size_t)((((g_) & 127) >> 3) * 64) * 1024 + ((g_) & 7) * 128)
#define MW_LOAD(g_) do { const float* s_ = MW_SRC(g_); _Pragma("unroll") for (int i = 0; i < 4; ++i) r[i] = __builtin_nontemporal_load((const f32x4*)(s_ + (size_t)(lk + 16 * i) * 1024 + ln4)); } while (0)
  int g0 = bidx;
  if (g0 < NT) MW_LOAD(g0);
  for (; g0 < NT; g0 += nblk) {
    __syncthreads();
#pragma unroll
    for (int i = 0; i < 4; ++i) { float* d = t + (lk + 16 * i) * 129 + ln4; d[0] = r[i][0]; d[1] = r[i][1]; d[2] = r[i][2]; d[3] = r[i][3]; }
    __syncthreads();
    const int gn = g0 + nblk;
    if (gn < NT) MW_LOAD(gn);
    const int m = g0 >> 7, k0 = ((g0 & 127) >> 3) * 64, n0 = (g0 & 7) * 128;
    bf16_t* drow = (part == 1) ? w2 + ((size_t)m * 1024 + n0 + sn) * 1024 : w13 + ((size_t)(m >> 1) * 2048 + 2 * (n0 + sn) + (m & 1)) * 1024;
#pragma unroll
    for (int j = 0; j < 2; ++j) { const int kk = sk + 32 * j; const float* s = t + kk * 129 + sn;
      u32x4 w; w.x = pk2(s[0], s[129]); w.y = pk2(s[2 * 129], s[3 * 129]); w.z = pk2(s[4 * 129], s[5 * 129]); w.w = pk2(s[6 * 129], s[7 * 129]);
      *(u32x4*)(drow + k0 + kk) = w; }
  }
#undef MW_SRC
#undef MW_LOAD
  __syncthreads();
}

struct ProbInProj {
  static constexpr bool PERM = true;
  pg8::StaticOrder so; const char* A; const char* Bt; bf16_t* P; const float* bias; const float* lb; int layer;
  __device__ __forceinline__ bool next(int i, pg8::Unit& u) const { return so.next(i, u); }
  __device__ __forceinline__ const char* a_base() const { return A; }
  __device__ __forceinline__ unsigned a_off(const pg8::Unit& u, int r) const { return (unsigned)(u.pm * 256 + r) * 2048u; }
  __device__ __forceinline__ const char* b_base(const pg8::Unit& u) const { return Bt + (size_t)u.pn * 256 * 2048; }
  __device__ __forceinline__ void epi(const f32x4 (&acc)[2][2][4][2], const pg8::Unit& u, int wr, int wc, int fr, int fq) const {
    const int row0 = u.row0 + wr * 64 + fr, colb = u.pn * 256 + wc * 32 + 8 * fq;
    int mode = 0;
    if (layer == 0) { mode = u.pn < 2 ? 1 : (u.pn < 6 ? 2 : (u.pn == 10 ? 3 : 0)); }
#pragma unroll
    for (int bj = 0; bj < 2; ++bj) {
      const int col0 = colb + bj * 128;
      const f32x4 b0 = *(const f32x4*)(bias + col0), b1 = *(const f32x4*)(bias + col0 + 4);
      f32x4 l0 = (f32x4){0.f, 0.f, 0.f, 0.f}, l1 = l0;
      if (mode == 2) { l0 = *(const f32x4*)(lb + ((col0 - 512) & 511)); l1 = *(const f32x4*)(lb + ((col0 - 512) & 511) + 4); }
#pragma unroll
      for (int ai = 0; ai < 2; ++ai)
#pragma unroll
        for (int m = 0; m < 4; ++m) {
          f32x4 v0 = acc[ai][bj][m][0] + b0, v1 = acc[ai][bj][m][1] + b1;
          if (mode == 1) {
#pragma unroll
            for (int j = 0; j < 4; ++j) { v0[j] = fsilu(v0[j]); v1[j] = fsilu(v1[j]); }
          } else if (mode == 2) {
#pragma unroll
            for (int j = 0; j < 4; ++j) { v0[j] = __builtin_amdgcn_logf(l0[j] + (1.0f - l0[j]) * fsigmoid(v0[j])); v1[j] = __builtin_amdgcn_logf(l1[j] + (1.0f - l1[j]) * fsigmoid(v1[j])); }
          } else if (mode == 3) { v0 *= 0.125f; v1 *= 0.125f; }
          u32x4 w; w.x = pk2(v0[0], v0[1]); w.y = pk2(v0[2], v0[3]); w.z = pk2(v1[0], v1[1]); w.w = pk2(v1[2], v1[3]);
          *(u32x4*)(P + PIDX(row0 + ai * 128 + m * 16, col0)) = w;
        }
    }
  }
};
struct ProbOutProj {
  static constexpr bool PERM = true;
  pg8::StaticOrder so; const char* A; const char* Bt; bf16_t* Y; const bf16_t* Hres;
  __device__ __forceinline__ bool next(int i, pg8::Unit& u) const { return so.next(i, u); }
  __device__ __forceinline__ const char* a_base() const { return A; }
  __device__ __forceinline__ unsigned a_off(const pg8::Unit& u, int r) const { return (unsigned)(u.pm * 256 + r) * 2048u; }
  __device__ __forceinline__ const char* b_base(const pg8::Unit& u) const { return Bt + (size_t)u.pn * 256 * 2048; }
  __device__ __forceinline__ void epi(const f32x4 (&acc)[2][2][4][2], const pg8::Unit& u, int wr, int wc, int fr, int fq) const {
    const int row0 = u.row0 + wr * 64 + fr, colb = u.pn * 256 + wc * 32 + 8 * fq;
#pragma unroll
    for (int ai = 0; ai < 2; ++ai)
#pragma unroll
      for (int m = 0; m < 4; ++m) {
        const size_t ro = (size_t)(row0 + ai * 128 + m * 16) * 1024 + colb;
        const u32x4 h0 = *(const u32x4*)(Hres + ro), h1 = *(const u32x4*)(Hres + ro + 128);
#pragma unroll
        for (int bj = 0; bj < 2; ++bj) {
          float hf[8]; unpack8(bj ? h1 : h0, hf);
          const f32x4 v0 = acc[ai][bj][m][0], v1 = acc[ai][bj][m][1];
          u32x4 w; w.x = pk2(v0[0] + ALPHA_F * hf[0], v0[1] + ALPHA_F * hf[1]); w.y = pk2(v0[2] + ALPHA_F * hf[2], v0[3] + ALPHA_F * hf[3]);
          w.z = pk2(v1[0] + ALPHA_F * hf[4], v1[1] + ALPHA_F * hf[5]); w.w = pk2(v1[2] + ALPHA_F * hf[6], v1[3] + ALPHA_F * hf[7]);
          *(u32x4*)(Y + ro + bj * 128) = w;
        }
      }
  }
};
#define MOE_TAB_OFF (128 * 1024)
struct MoeOrder {
  const int* tab;
  __device__ __forceinline__ void init(const int* cnt, int ntn, int G, int c, unsigned char* lds, int wv) {
    int* t = (int*)(lds + MOE_TAB_OFF);
    const int tid = opaque_tid(wv);
    if (tid < 64) {
      int pad = 0, found = 0, ue = 0, upn = 0, upm = 0, urow = 0, une = 0;
      if ((G & 7) == 0) {
        const int x = c & 7; int q = tid * (G >> 3) + (c >> 3);
        for (int e = 0; e < NEXP; ++e) { const int n = cnt[e * 16], mt = (n + 255) >> 8; const int r = ((x - e) % 8 + 8) % 8; const int m = mt > r ? (mt - r - 1) / 8 + 1 : 0; const int units = m * ntn;
          if (!found && q < units) { ue = e; upm = r + 8 * (q % m); upn = q / m; urow = pad + upm * 256; une = n; found = 1; }
          if (!found) { q -= units; pad += mt * 256; } }
      } else {
        int L = tid * G + c;
        for (int e = 0; e < NEXP; ++e) { const int n = cnt[e * 16], mt = (n + 255) >> 8, tiles = mt * ntn;
          if (!found && L < tiles) { ue = e; upn = L / mt; upm = L % mt; urow = pad + upm * 256; une = n; found = 1; }
          if (!found) { L -= tiles; pad += mt * 256; } }
      }
      t[tid * 8 + 0] = found; t[tid * 8 + 1] = ue; t[tid * 8 + 2] = upn; t[tid * 8 + 3] = upm; t[tid * 8 + 4] = urow; t[tid * 8 + 5] = une;
    }
    __syncthreads();
    tab = t;
  }
  __device__ __forceinline__ bool next(int i, pg8::Unit& u) const {
    if (i >= 64) return false;
    const int* t = tab + i * 8;
    if (!__builtin_amdgcn_readfirstlane(t[0])) return false;
    u.e = __builtin_amdgcn_readfirstlane(t[1]); u.pn = __builtin_amdgcn_readfirstlane(t[2]); u.pm = __builtin_amdgcn_readfirstlane(t[3]);
    u.row0 = __builtin_amdgcn_readfirstlane(t[4]); u.ne = __builtin_amdgcn_readfirstlane(t[5]); u.ui = i; return true;
  }
};
struct ProbMoe1 {
  static constexpr bool PERM = true;
  MoeOrder mo; const char* A; const char* W13; const int* list; bf16_t* H; const int* ltok;
  __device__ __forceinline__ void stage_tokens(unsigned char* lds, int wv) {
    int* lt = (int*)(lds + MOE_TAB_OFF + 2048);
    const int tid = opaque_tid(wv);
    pg8::Unit u;
    for (int i = 0; i < 16 && mo.next(i, u); ++i) { if (tid < 256) { const int rr = u.pm * 256 + tid; lt[i * 256 + tid] = rr < u.ne ? list[u.e * NTOK + rr] : 0; } }
    __syncthreads();
    ltok = lt;
  }
  __device__ __forceinline__ bool next(int i, pg8::Unit& u) const { return mo.next(i, u); }
  __device__ __forceinline__ const char* a_base() const { return A; }
  __device__ __forceinline__ unsigned a_off(const pg8::Unit& u, int r) const { const int rr = u.pm * 256 + r; const int tok = rr < u.ne ? list[u.e * NTOK + rr] : 0; return (unsigned)tok * 2048u; }
  __device__ __forceinline__ const char* b_base(const pg8::Unit& u) const { return W13 + ((size_t)u.e * 2048 + (size_t)u.pn * 256) * 2048; }
  __device__ __forceinline__ void epi(const f32x4 (&acc)[2][2][4][2], const pg8::Unit& u, int wr, int wc, int fr, int fq) const {
    const int row0 = u.row0 + wr * 64 + fr, colb = u.pn * 128 + wc * 16 + 4 * fq;
#pragma unroll
    for (int ai = 0; ai < 2; ++ai)
#pragma unroll
      for (int m = 0; m < 4; ++m)
#pragma unroll
        for (int bj = 0; bj < 2; ++bj) {
          const f32x4 v0 = acc[ai][bj][m][0], v1 = acc[ai][bj][m][1];
          u32x2 w; w.x = pk2(fsilu(v0[0]) * v0[1], fsilu(v0[2]) * v0[3]); w.y = pk2(fsilu(v1[0]) * v1[1], fsilu(v1[2]) * v1[3]);
          *(u32x2*)(H + (size_t)(row0 + ai * 128 + m * 16) * 1024 + colb + bj * 64) = w;
        }
  }
};
struct ProbMoe2 {
  static constexpr bool PERM = true;
  MoeOrder mo; const char* A; const char* W2; bf16_t* Y;
  __device__ __forceinline__ bool next(int i, pg8::Unit& u) const { return mo.next(i, u); }
  __device__ __forceinline__ const char* a_base() const { return A; }
  __device__ __forceinline__ unsigned a_off(const pg8::Unit& u, int r) const { return (unsigned)(u.row0 + r) * 2048u; }
  __device__ __forceinline__ const char* b_base(const pg8::Unit& u) const { return W2 + ((size_t)u.e * 1024 + (size_t)u.pn * 256) * 2048; }
  __device__ __forceinline__ void epi(const f32x4 (&acc)[2][2][4][2], const pg8::Unit& u, int wr, int wc, int fr, int fq) const {
    const int row0 = u.row0 + wr * 64 + fr, colb = u.pn * 256 + wc * 32 + 8 * fq;
#pragma unroll
    for (int ai = 0; ai < 2; ++ai)
#pragma unroll
      for (int m = 0; m < 4; ++m)
#pragma unroll
        for (int bj = 0; bj < 2; ++bj) {
          const f32x4 v0 = acc[ai][bj][m][0], v1 = acc[ai][bj][m][1];
          u32x4 w; w.x = pk2(v0[0], v0[1]); w.y = pk2(v0[2], v0[3]); w.z = pk2(v1[0], v1[1]); w.w = pk2(v1[2], v1[3]);
          *(u32x4*)(Y + (size_t)(row0 + ai * 128 + m * 16) * 1024 + colb + bj * 128) = w;
        }
  }
};

template <int NS>
__device__ __forceinline__ void side_phase(unsigned char* lds_, int wv, const Params& p, int layer) {
  const Ctx c = make_ctx(lds_, wv);
  const bf16_t* hb = (const bf16_t*)p.out;
  const bf16_t* wt = (const bf16_t*)(p.ws + (layer == 0 ? WS_WIN_AB : WS_WIN_CD)) + (size_t)(layer == 0 ? PM_AB : PM_CD) * 1024;
  const float* bias = p.in[layer == 0 ? I_AB_B_IN : I_CD_B_IN] + (layer == 0 ? PM_AB : PM_CD);
  float* side = (float*)(p.ws + WS_SIDE);
  float* tl = (float*)c.lds + c.wid * (16 * 33);
  const int fr = c.lane & 15, fq = c.lane >> 4;
  for (int g = c.bid * 8 + c.wid; g < NTOK / 16; g += c.G * 8) {
    const int r0 = g * 16;
    f32x4 acc0 = (f32x4){0.f, 0.f, 0.f, 0.f}, acc1 = acc0;
    const bf16_t* ap = hb + (size_t)(r0 + fr) * 1024 + fq * 8;
    const bf16_t* bp0 = wt + (size_t)fr * 1024 + fq * 8; const bf16_t* bp1 = bp0 + 16 * 1024;
#pragma unroll 16
    for (int k = 0; k < 1024; k += 32) {
      const bf16x8 a = *(const bf16x8*)(ap + k), b0 = *(const bf16x8*)(bp0 + k);
      acc0 = __builtin_amdgcn_mfma_f32_16x16x32_bf16(a, b0, acc0, 0, 0, 0);
      if (NS == 32) { const bf16x8 b1 = *(const bf16x8*)(bp1 + k); acc1 = __builtin_amdgcn_mfma_f32_16x16x32_bf16(a, b1, acc1, 0, 0, 0); }
    }
    float gsc = 1.f, gfb = 0.f; bool gls = false;
    if (NS == 16) { gsc = 1.4426950408889634f; gls = (fr & 4) != 0; gfb = gls ? p.in[I_FGATE_B][(fr >> 3) * 4 + (fr & 3)] : 0.f; }
#pragma unroll
    for (int j = 0; j < 4; ++j) { float v0 = acc0[j] + bias[fr]; if (NS == 16) v0 = gls ? flog2sigmoid(v0 + gfb) : v0 * gsc; side[(size_t)(r0 + fq * 4 + j) * 32 + fr] = v0; tl[(fq * 4 + j) * 33 + fr] = v0;
      if (NS == 32) { const float v1 = acc1[j] + bias[16 + fr]; side[(size_t)(r0 + fq * 4 + j) * 32 + 16 + fr] = v1; tl[(fq * 4 + j) * 33 + 16 + fr] = v1; } }
    if (NS == 32) {
      __builtin_amdgcn_s_waitcnt(0xC07F);
      const float* gu = p.in[I_GK_UP]; const float* gb = p.in[I_GK_B]; bf16_t* lfb = (bf16_t*)(p.ws + WS_LFB);
      const int cb = c.lane * 8, dir = cb >> 8, cc = cb & 255;
      float w[16][8];
#pragma unroll
      for (int r = 0; r < 16; ++r)
#pragma unroll
        for (int j = 0; j < 8; ++j) w[r][j] = gu[(dir * 16 + r) * 256 + cc + j];
      float bb[8];
#pragma unroll
      for (int j = 0; j < 8; ++j) bb[j] = gb[dir * 256 + cc + j];
      for (int row = 0; row < 16; ++row) {
        float z[8];
#pragma unroll
        for (int j = 0; j < 8; ++j) z[j] = bb[j];
#pragma unroll
        for (int r = 0; r < 16; ++r) { const float s = tl[row * 33 + dir * 16 + r];
#pragma unroll
          for (int j = 0; j < 8; ++j) z[j] += s * w[r][j]; }
        u32x4 o; o.x = pk2(flog2sigmoid(z[0]) * 0.0625f, flog2sigmoid(z[1]) * 0.0625f); o.y = pk2(flog2sigmoid(z[2]) * 0.0625f, flog2sigmoid(z[3]) * 0.0625f);
        o.z = pk2(flog2sigmoid(z[4]) * 0.0625f, flog2sigmoid(z[5]) * 0.0625f); o.w = pk2(flog2sigmoid(z[6]) * 0.0625f, flog2sigmoid(z[7]) * 0.0625f);
        *(u32x4*)(lfb + PIDX(r0 + row, cb)) = o;
      }
    }
  }
}

__device__ __forceinline__ void headnorm_phase(unsigned char* lds_, int wv, const Params& p, int layer) {
  const Ctx c = make_ctx(lds_, wv);
  const bf16_t* P = (const bf16_t*)(p.ws + WS_R1); const bf16_t* O = (const bf16_t*)(p.ws + WS_R2);
  bf16_t* mixed = (bf16_t*)(p.ws + WS_MIX);
  const int c0 = c.lane * 16, h8 = c.lane >> 3;
  const float* gain = layer == 0 ? (h8 < 4 ? p.in[I_HGRN_NORM] + c0 : p.in[I_GLA_NORM] + c0 - 512) : (h8 < 4 ? p.in[I_RET_NORM] + c0 : p.in[I_MLSTM_NORM] + c0 - 512);
  const int gcol = layer == 0 ? (h8 < 4 ? 2048 + c0 : 3584 + c0 - 512) : (h8 < 4 ? 1024 + c0 : 3072 + c0 - 512);
  float gn[16];
#pragma unroll
  for (int j = 0; j < 16; ++j) gn[j] = gain[j];
  const int tstride = c.G * 8;
  for (int tok0 = c.bid * 8 + c.wid; tok0 < NTOK; tok0 += 2 * tstride) {
    u32x4 ra[2][2], rb[2][2], rg[2][2];
#pragma unroll
    for (int u = 0; u < 2; ++u) { const int tok = tok0 + u * tstride < NTOK ? tok0 + u * tstride : tok0;
      const u32x4* a = (const u32x4*)(O + PIDX(tok, c0)); const u32x4* b = (const u32x4*)(O + (size_t)NTOK * 1024 + PIDX(tok, c0)); const u32x4* g = (const u32x4*)(P + PIDX(tok, gcol));
      ra[u][0] = __builtin_nontemporal_load(a); ra[u][1] = __builtin_nontemporal_load(a + 1); rb[u][0] = __builtin_nontemporal_load(b); rb[u][1] = __builtin_nontemporal_load(b + 1);
      rg[u][0] = __builtin_nontemporal_load(g); rg[u][1] = __builtin_nontemporal_load(g + 1); }
#pragma unroll
    for (int u = 0; u < 2; ++u) {
      const int tok = tok0 + u * tstride;
      float of[16], ob[16], gt[16];
      unpack8(ra[u][0], of); unpack8(ra[u][1], of + 8); unpack8(rb[u][0], ob); unpack8(rb[u][1], ob + 8); unpack8(rg[u][0], gt); unpack8(rg[u][1], gt + 8);
      float o[16]; float ss = 0.f;
#pragma unroll
      for (int j = 0; j < 16; ++j) { o[j] = of[j] + ob[j]; ss += o[j] * o[j]; }
      ss += __shfl_xor(ss, 1); ss += __shfl_xor(ss, 2); ss += __shfl_xor(ss, 4);
      const float r = 1.0f / sqrtf(ss * (1.0f / 128.0f) + NORM_EPS_F);
      unsigned w[8];
#pragma unroll
      for (int j = 0; j < 8; ++j) {
        float g0 = gt[2 * j], g1 = gt[2 * j + 1];
        if (layer == 1 && h8 >= 4) { g0 = fsigmoid(g0); g1 = fsigmoid(g1); } else { g0 = fsilu(g0); g1 = fsilu(g1); }
        w[j] = pk2(o[2 * j] * r * gn[2 * j] * g0, o[2 * j + 1] * r * gn[2 * j + 1] * g1);
      }
      if (tok < NTOK) { u32x4* d = (u32x4*)(mixed + (size_t)tok * 1024 + c0);
        d[0] = (u32x4){w[0], w[1], w[2], w[3]}; d[1] = (u32x4){w[4], w[5], w[6], w[7]}; }
    }
  }
}

__device__ __forceinline__ void ln_phase(unsigned char* lds_, int wv, const Params& p, int layer, int mode, int dry = 0) {
  const Ctx c = make_ctx(lds_, wv);
  unsigned char* ws = p.ws;
  const bf16_t* zin = (const bf16_t*)(ws + (mode == 0 ? WS_R2 : WS_MIX));
  const bool f32out = (mode == 1 && layer == 1);
  float* hout = dry ? (float*)(ws + WS_H) : p.out;
  bf16_t* hb = dry ? (bf16_t*)(ws + WS_H) : (mode == 0 ? (bf16_t*)(ws + WS_MIX) : (bf16_t*)p.out);
  const float* g = p.in[mode == 0 ? I_LN_MIX_G : I_LN_FFN_G] + layer * 1024; const float* b = p.in[mode == 0 ? I_LN_MIX_B : I_LN_FFN_B] + layer * 1024;
  unsigned* cnt = (unsigned*)(ws + WS_CTL) + CW_CNT(layer);
  int* list = (int*)(ws + WS_LIST) + (size_t)layer * NEXP * NTOK;
  int* assign = (int*)(ws + WS_ASSIGN); float* gate = (float*)(ws + WS_GATE);
  float* rwT = (float*)c.lds;
  int* lcnt = (int*)(c.lds + 65536); int* lbase = lcnt + 16; int* rec = lcnt + 32; float* recg = (float*)(rec + 4 * 2048);
  int pad[NEXP];
  if (mode == 0) { const float* r = p.in[I_ROUTER_W];
    for (int i = c.tid; i < 1024 * 16; i += NTHREADS) rwT[(i & 15) * 1024 + (i >> 4)] = r[i];
    if (c.tid < 16) lcnt[c.tid] = 0;
    __syncthreads(); }
  else { int acc = 0;
#pragma unroll
    for (int e = 0; e < NEXP; ++e) { pad[e] = acc; acc += (((int)cnt[e * 16] + 255) >> 8) << 8; } }
  const int c0 = c.lane * 4;
  float gv[16], bv[16];
#pragma unroll
  for (int q = 0; q < 4; ++q) { const f32x4 t0 = *(const f32x4*)(g + q * 256 + c0), t1 = *(const f32x4*)(b + q * 256 + c0);
#pragma unroll
    for (int j = 0; j < 4; ++j) { gv[4 * q + j] = t0[j]; bv[4 * q + j] = t1[j]; } }
  const int tstride = c.G * 8;
  int it = 0;
  for (int tok0 = c.bid * 8 + c.wid; tok0 < NTOK; tok0 += 2 * tstride, it += 2) {
    float v[2][16];
    float gy0[2], gy1[2];
#pragma unroll
    for (int u = 0; u < 2; ++u) {
      const int tok = tok0 + u * tstride;
      if (tok < NTOK) {
        const float sc = mode == 0 ? 1.0f : ALPHA_F;
#pragma unroll
        for (int q = 0; q < 4; ++q) { const u32x2 t = __builtin_nontemporal_load((const u32x2*)(zin + (size_t)tok * 1024 + q * 256 + c0));
          v[u][4 * q] = sc * __uint_as_float(t.x << 16); v[u][4 * q + 1] = sc * __uint_as_float(t.x & 0xffff0000u); v[u][4 * q + 2] = sc * __uint_as_float(t.y << 16); v[u][4 * q + 3] = sc * __uint_as_float(t.y & 0xffff0000u); }
        if (mode == 1) {
          const int a0 = assign[tok * 4], a1 = assign[tok * 4 + 1], a2 = assign[tok * 4 + 2], a3 = assign[tok * 4 + 3];
          gy0[u] = gate[tok * 2]; gy1[u] = gate[tok * 2 + 1];
          int p0 = 0, p1 = 0;
#pragma unroll
          for (int e = 0; e < NEXP; ++e) { if (e == a0) p0 = pad[e]; if (e == a2) p1 = pad[e]; }
          p0 += a1; p1 += a3;
          const bf16_t* Y = (const bf16_t*)(ws + WS_R2);
#pragma unroll
          for (int q = 0; q < 4; ++q) { const u32x2 y0 = __builtin_nontemporal_load((const u32x2*)(Y + (size_t)p0 * 1024 + q * 256 + c0)), y1 = __builtin_nontemporal_load((const u32x2*)(Y + (size_t)p1 * 1024 + q * 256 + c0));
            v[u][4 * q] += gy0[u] * __uint_as_float(y0.x << 16) + gy1[u] * __uint_as_float(y1.x << 16); v[u][4 * q + 1] += gy0[u] * __uint_as_float(y0.x & 0xffff0000u) + gy1[u] * __uint_as_float(y1.x & 0xffff0000u);
            v[u][4 * q + 2] += gy0[u] * __uint_as_float(y0.y << 16) + gy1[u] * __uint_as_float(y1.y << 16); v[u][4 * q + 3] += gy0[u] * __uint_as_float(y0.y & 0xffff0000u) + gy1[u] * __uint_as_float(y1.y & 0xffff0000u); }
        }
      } else {
#pragma unroll
        for (int j = 0; j < 16; ++j) v[u][j] = 0.f;
      }
    }
#pragma unroll
    for (int u = 0; u < 2; ++u) {
      const int tok = tok0 + u * tstride;
      float s = 0.f;
#pragma unroll
      for (int j = 0; j < 16; ++j) s += v[u][j];
      const float mean = wave_sum(s) * (1.0f / 1024.0f);
      float qq = 0.f;
#pragma unroll
      for (int j = 0; j < 16; ++j) { v[u][j] -= mean; qq += v[u][j] * v[u][j]; }
      const float r = 1.0f / sqrtf(wave_sum(qq) * (1.0f / 1024.0f) + LN_EPS_F);
#pragma unroll
      for (int j = 0; j < 16; ++j) v[u][j] = v[u][j] * r * gv[j] + bv[j];
      if (tok < NTOK) {
        if (f32out) {
#pragma unroll
          for (int q = 0; q < 4; ++q) __builtin_nontemporal_store((f32x4){v[u][4 * q], v[u][4 * q + 1], v[u][4 * q + 2], v[u][4 * q + 3]}, (f32x4*)(hout + (size_t)tok * 1024 + q * 256 + c0));
        } else {
#pragma unroll
          for (int q = 0; q < 4; ++q) *(u32x2*)(hb + (size_t)tok * 1024 + q * 256 + c0) = (u32x2){pk2(v[u][4 * q], v[u][4 * q + 1]), pk2(v[u][4 * q + 2], v[u][4 * q + 3])}; }
      }
      if (mode == 0) {
        float lg[16];
#pragma unroll
        for (int e = 0; e < 16; ++e) { float a = 0.f;
#pragma unroll
          for (int q = 0; q < 4; ++q) { const f32x4 w = *(const f32x4*)(rwT + e * 1024 + q * 256 + c0); a += v[u][4 * q] * w[0] + v[u][4 * q + 1] * w[1] + v[u][4 * q + 2] * w[2] + v[u][4 * q + 3] * w[3]; }
          lg[e] = a; }
#pragma unroll
        for (int e = 0; e < 16; ++e) lg[e] = wave_sum(lg[e]);
        int eo[2]; float go[2];
        route_from_logits(lg, p.in[I_ROUTER_B], eo, go);
        if (c.lane == 0 && tok < NTOK && !dry) {
          const int r1 = atomicAdd(lcnt + eo[0], 1), r2 = atomicAdd(lcnt + eo[1], 1);
          const int ri = (it + u) * 8 + c.wid;
          rec[ri * 4] = eo[0]; rec[ri * 4 + 1] = r1; rec[ri * 4 + 2] = eo[1]; rec[ri * 4 + 3] = r2; recg[ri * 2] = go[0]; recg[ri * 2 + 1] = go[1];
        }
      }
    }
  }
  if (mode == 0 && !dry) {
    __syncthreads();
    if (c.tid < 16) lbase[c.tid] = (int)atomicAdd(cnt + c.tid * 16, (unsigned)lcnt[c.tid]);
    __syncthreads();
    const int nrec = ((NTOK + c.G * 8 - 1) / (c.G * 8)) * 8;
    for (int ri = c.tid; ri < nrec; ri += NTHREADS) {
      const int tok = c.bid * 8 + (ri & 7) + (ri >> 3) * c.G * 8;
      if (tok < NTOK) {
        const int e1 = rec[ri * 4], e2 = rec[ri * 4 + 2]; const int r1 = rec[ri * 4 + 1] + lbase[e1], r2 = rec[ri * 4 + 3] + lbase[e2];
        list[e1 * NTOK + r1] = tok; list[e2 * NTOK + r2] = tok;
        assign[tok * 4] = e1; assign[tok * 4 + 1] = r1; assign[tok * 4 + 2] = e2; assign[tok * 4 + 3] = r2;
        gate[tok * 2] = recg[ri * 2]; gate[tok * 2 + 1] = recg[ri * 2 + 1];
      }
    }
  }
  __syncthreads();
}
#endif
#ifndef CPU_EMU
namespace scan {
typedef short bf16x8 __attribute__((ext_vector_type(8)));
typedef float f32x4 __attribute__((ext_vector_type(4)));
typedef unsigned u32x4 __attribute__((ext_vector_type(4)));
typedef unsigned u32x2 __attribute__((ext_vector_type(2)));
enum { MIX_A = 0, MIX_B = 1, MIX_C = 2, MIX_D = 3 };
constexpr int LD_T = 144;
constexpr int OFF_QS = 0, OFF_KS = 17408, OFF_QI = 34816, OFF_KT = 52224, OFF_VT = 70656, OFF_SC = 77568, OFF_ST = 86784, OFF_DEC = 99840, OFF_EM = 100352, OFF_DEN = 100608, OFF_CW = 100864, SCAN_LDS = 104960;

__device__ __forceinline__ float incl_scan_add(float x) {
  x += __builtin_bit_cast(float, __builtin_amdgcn_update_dpp(0, __builtin_bit_cast(int, x), 0x111, 0xf, 0xf, false));
  x += __builtin_bit_cast(float, __builtin_amdgcn_update_dpp(0, __builtin_bit_cast(int, x), 0x112, 0xf, 0xf, false));
  x += __builtin_bit_cast(float, __builtin_amdgcn_update_dpp(0, __builtin_bit_cast(int, x), 0x114, 0xf, 0xf, false));
  x += __builtin_bit_cast(float, __builtin_amdgcn_update_dpp(0, __builtin_bit_cast(int, x), 0x118, 0xf, 0xf, false));
  x += __builtin_bit_cast(float, __builtin_amdgcn_update_dpp(0, __builtin_bit_cast(int, x), 0x142, 0xa, 0xf, false));
  x += __builtin_bit_cast(float, __builtin_amdgcn_update_dpp(0, __builtin_bit_cast(int, x), 0x143, 0xc, 0xf, false));
  return x;
}
__device__ __forceinline__ float incl_scan_max(float x) {
  const int ninf = (int)0xff800000u;
  x = fmaxf(x, __builtin_bit_cast(float, __builtin_amdgcn_update_dpp(ninf, __builtin_bit_cast(int, x), 0x111, 0xf, 0xf, false)));
  x = fmaxf(x, __builtin_bit_cast(float, __builtin_amdgcn_update_dpp(ninf, __builtin_bit_cast(int, x), 0x112, 0xf, 0xf, false)));
  x = fmaxf(x, __builtin_bit_cast(float, __builtin_amdgcn_update_dpp(ninf, __builtin_bit_cast(int, x), 0x114, 0xf, 0xf, false)));
  x = fmaxf(x, __builtin_bit_cast(float, __builtin_amdgcn_update_dpp(ninf, __builtin_bit_cast(int, x), 0x118, 0xf, 0xf, false)));
  x = fmaxf(x, __builtin_bit_cast(float, __builtin_amdgcn_update_dpp(ninf, __builtin_bit_cast(int, x), 0x142, 0xa, 0xf, false)));
  x = fmaxf(x, __builtin_bit_cast(float, __builtin_amdgcn_update_dpp(ninf, __builtin_bit_cast(int, x), 0x143, 0xc, 0xf, false)));
  return x;
}
__device__ __forceinline__ float rdlane(float x, int l) { return __builtin_bit_cast(float, __builtin_amdgcn_readlane(__builtin_bit_cast(int, x), l)); }
__device__ __forceinline__ bf16x8 ldfrag(const unsigned char* base, int ld, int row, int kbyte) { return *(const bf16x8*)(base + row * ld + kbyte); }
__device__ __forceinline__ bf16x8 ldfrag2(const unsigned char* base, int ld, int row, int b0, int b1) {
  const u32x2 lo = *(const u32x2*)(base + row * ld + b0), hi = *(const u32x2*)(base + row * ld + b1);
  return __builtin_bit_cast(bf16x8, (u32x4){lo.x, lo.y, hi.x, hi.y}); }
__device__ __forceinline__ unsigned pk(float a, float b) { return pk_hw(a, b); }
__device__ __forceinline__ float lo16(unsigned w) { return __uint_as_float(w << 16); }
__device__ __forceinline__ float hi16(unsigned w) { return __uint_as_float(w & 0xffff0000u); }

__device__ __forceinline__ void lds_barrier() { asm volatile("s_waitcnt lgkmcnt(0)" ::: "memory"); __builtin_amdgcn_s_barrier(); asm volatile("" ::: "memory"); }
struct Raw { u32x4 a0, a1, b0, b1; f32x4 r0, r1; u32x2 v; float s0, s1; };

}

__device__ __forceinline__ void convd_phase(unsigned char* lds_, int wv, const Params& p) {
  const Ctx c = make_ctx(lds_, wv);
  bf16_t* P = (bf16_t*)(p.ws + WS_R1); bf16_t* QD = (bf16_t*)(p.ws + WS_LFB);
  const float* cw = p.in[I_CONV_W]; const float* cb = p.in[I_CONV_B];
  const int ch = c.lane * 16;
  float w0[16], w1[16], w2[16], bb[16];
#pragma unroll
  for (int j = 0; j < 16; ++j) { w0[j] = cw[ch + j]; w1[j] = cw[1024 + ch + j]; w2[j] = cw[2048 + ch + j]; bb[j] = cb[ch + j]; }
  for (int tok = c.bid * 8 + c.wid; tok < NTOK; tok += c.G * 8) {
    const int t = tok % SEQ;
    const bf16_t* row = P + PIDX(tok, 1536 + ch);
    float x0[16], x1[16], x2[16];
    { const u32x4* r1 = (const u32x4*)row; unpack8(r1[0], x1); unpack8(r1[1], x1 + 8); }
    if (t > 0) { const u32x4* r0 = (const u32x4*)(row - 128); unpack8(r0[0], x0); unpack8(r0[1], x0 + 8); }
    else {
#pragma unroll
      for (int j = 0; j < 16; ++j) x0[j] = 0.f; }
    if (t < SEQ - 1) { const u32x4* r2 = (const u32x4*)(row + 128); unpack8(r2[0], x2); unpack8(r2[1], x2 + 8); }
    else {
#pragma unroll
      for (int j = 0; j < 16; ++j) x2[j] = 0.f; }
    const float sc = ch < 512 ? 0.08838834764831845f : 1.0f;
    unsigned w[8];
#pragma unroll
    for (int j = 0; j < 8; ++j) {
      const float a0 = bb[2 * j] + w0[2 * j] * x0[2 * j] + w1[2 * j] * x1[2 * j] + w2[2 * j] * x2[2 * j];
      const float a1 = bb[2 * j + 1] + w0[2 * j + 1] * x0[2 * j + 1] + w1[2 * j + 1] * x1[2 * j + 1] + w2[2 * j + 1] * x2[2 * j + 1];
      w[j] = pk2(fsilu(a0) * sc, fsilu(a1) * sc);
    }
    u32x4* d = (ch < 512) ? (u32x4*)(QD + PIDX(tok, ch)) : (u32x4*)(P + PIDX(tok, 3584 + (ch - 512)));
    d[0] = (u32x4){w[0], w[1], w[2], w[3]}; d[1] = (u32x4){w[4], w[5], w[6], w[7]};
  }
}

#endif
#ifndef CPU_EMU
namespace scan2 {
using namespace scan;
#ifndef PROBE_ALLTILES
#define PROBE_ALLTILES 0
#endif
__device__ __forceinline__ float FMUL(float a, float b) { float r = a * b; asm("" : "+v"(r)); return r; }
constexpr int U_QI = 0, U_KS = 34816, U_KT = 69632, U_VT = 106496, U_SC = 120320, U_ST = 129536, U_DEC = 155648, U_EM = 156672, U_END = 157184;
template <int MIXER>
__device__ __forceinline__ void scan_item2(unsigned char* lds, int wv, const Params& p, int b, int h, int dir, int vs) {
  constexpr int DK = (MIXER == MIX_A || MIXER == MIX_D) ? 128 : 64;
  constexpr int NC = DK / 8;
  constexpr int LD_D = DK * 2 + 16;
  constexpr int NVT = MIXER == MIX_D ? 3 : 2;
  constexpr int NKD = DK / 32;
  constexpr int NST = (DK == 128) ? NVT : 1;
  constexpr int NCH = SEQ / 64;
  const int tid = opaque_tid(wv), lane0 = tid & 63, wid = __builtin_amdgcn_readfirstlane(tid >> 6);
  unsigned char* ws = p.ws;
  const bf16_t* P = (const bf16_t*)(ws + WS_R1);
  const bf16_t* LFBp = (const bf16_t*)(ws + WS_LFB);
  const float* side = (const float*)(ws + WS_SIDE);
  const float* rope = (const float*)(ws + WS_ROPE);
  bf16_t* O = (bf16_t*)(ws + WS_R2) + (size_t)dir * NTOK * 1024;
  int qcol, kcol, lfcol, vcol, ocol;
  if (MIXER == MIX_A) { qcol = h * 128; kcol = 0; lfcol = 512 + dir * 512 + h * 128; vcol = 1536 + h * 128 + vs * 32; ocol = h * 128 + vs * 32; }
  else if (MIXER == MIX_B) { qcol = 2560 + h * 64; kcol = 2816 + h * 64; lfcol = dir * 256 + h * 64; vcol = 3072 + h * 128 + vs * 32; ocol = 512 + h * 128 + vs * 32; }
  else if (MIXER == MIX_C) { qcol = h * 64; kcol = 256 + h * 64; lfcol = 0; vcol = 512 + h * 128 + vs * 32; ocol = h * 128 + vs * 32; }
  else { qcol = h * 128; kcol = 3584 + h * 128; lfcol = 0; vcol = 2560 + h * 128 + vs * 32; ocol = 512 + h * 128 + vs * 32; }
  const size_t tokbase = (size_t)b * SEQ;
  const int c0 = (MIXER == MIX_C) ? wid * 4 : wid * NC;
  for (int i = tid; i < 2 * 13056 / 4; i += NTHREADS) ((unsigned*)(lds + U_ST))[i] = 0u;

  if (MIXER == MIX_D) { for (int i = tid; i < 2 * 16 * 64; i += NTHREADS) { const int bf = i >> 10, r = 32 + ((i >> 6) & 15), j = i & 63; *(bf16_t*)(lds + U_VT + bf * 6912 + r * LD_T + j * 2) = (r == 32) ? (bf16_t)0x3F80 : (bf16_t)0; } }
  const float lgam2 = (MIXER == MIX_C) ? log1pf(-exp2f(-(5.0f + 2.0f * (float)h + (float)dir))) * 1.4426950408889634f : 0.f;
  const float fgb = (MIXER == MIX_D) ? p.in[I_FGATE_B][dir * 4 + h] : 0.f;
  float m_st = 0.f;
  __syncthreads();

  Raw R, Rn; u32x2 Rv, Rvn;
#define A_LOAD(R, Rv, n_) do { \
    const int ln_ = lane0; \
    const int t_ = dir ? (SEQ - 1 - ((n_) * 64 + ln_)) : ((n_) * 64 + ln_); \
    const size_t tk_ = tokbase + t_; \
    if (MIXER == MIX_A) { const u32x4* qp_ = (const u32x4*)(P + PIDX(tk_, qcol + c0)); const u32x4* lp_ = (const u32x4*)(P + PIDX(tk_, lfcol + c0)); R.a0 = qp_[0]; R.a1 = qp_[1]; R.b0 = lp_[0]; R.b1 = lp_[1]; } \
    else if (MIXER == MIX_B) { R.a0 = *(const u32x4*)(P + PIDX(tk_, qcol + c0)); R.a1 = *(const u32x4*)(P + PIDX(tk_, kcol + c0)); R.b0 = *(const u32x4*)(LFBp + PIDX(tk_, lfcol + c0)); } \
    else if (MIXER == MIX_C) { const u32x2 qa_ = *(const u32x2*)(P + PIDX(tk_, qcol + c0)), qb_ = *(const u32x2*)(P + PIDX(tk_, qcol + 32 + c0)), ka_ = *(const u32x2*)(P + PIDX(tk_, kcol + c0)), kb_ = *(const u32x2*)(P + PIDX(tk_, kcol + 32 + c0)); \
      R.a0 = (u32x4){qa_.x, qa_.y, qb_.x, qb_.y}; R.a1 = (u32x4){ka_.x, ka_.y, kb_.x, kb_.y}; \
      R.r0 = *(const f32x4*)(rope + ((size_t)t_ * 32 + c0) * 2); R.r1 = *(const f32x4*)(rope + ((size_t)t_ * 32 + c0) * 2 + 4); } \
    else { const u32x4* qp_ = (const u32x4*)(LFBp + PIDX(tk_, qcol + c0)); const u32x4* kp_ = (const u32x4*)(P + PIDX(tk_, kcol + c0)); R.a0 = qp_[0]; R.a1 = qp_[1]; R.b0 = kp_[0]; R.b1 = kp_[1]; \
      R.s0 = side[tk_ * 32 + dir * 8 + h]; R.s1 = side[tk_ * 32 + dir * 8 + 4 + h]; } \
    Rv = *(const u32x2*)(P + PIDX(tk_, vcol + wid * 4)); } while (0)

  float rr_next = 1.f, rr_cur = 1.f;
#define A_PREP(buf_, R, Rv) do { \
    const int lane = lane0; \
    unsigned char* KTb = lds + U_KT + (buf_) * 18432; float* DECb = (float*)(lds + U_DEC + (buf_) * 512); float* EMb = (float*)(lds + U_EM + (buf_) * 256); \
    unsigned char* QIb = lds + U_QI + (buf_) * 17408; unsigned char* KSb = lds + U_KS + (buf_) * 17408; \
    float q[NC], k[NC], g[NC], ktv[NC]; \
    if (MIXER == MIX_A) { \
      const unsigned qw[8] = {R.a0.x, R.a0.y, R.a0.z, R.a0.w, R.a1.x, R.a1.y, R.a1.z, R.a1.w}, lw[8] = {R.b0.x, R.b0.y, R.b0.z, R.b0.w, R.b1.x, R.b1.y, R.b1.z, R.b1.w}; \
      _Pragma("unroll") for (int c = 0; c < 8; ++c) { q[2 * c] = lo16(qw[c]); q[2 * c + 1] = hi16(qw[c]); g[2 * c] = lo16(lw[c]); g[2 * c + 1] = hi16(lw[c]); } \
      _Pragma("unroll") for (int c = 0; c < NC; ++c) k[c] = 1.0f - __builtin_amdgcn_exp2f(g[c]); \
    } else if (MIXER == MIX_B) { \
      const unsigned qw[4] = {R.a0.x, R.a0.y, R.a0.z, R.a0.w}, kw[4] = {R.a1.x, R.a1.y, R.a1.z, R.a1.w}, lw[4] = {R.b0.x, R.b0.y, R.b0.z, R.b0.w}; \
      _Pragma("unroll") for (int c = 0; c < 4; ++c) { q[2 * c] = lo16(qw[c]); q[2 * c + 1] = hi16(qw[c]); k[2 * c] = lo16(kw[c]); k[2 * c + 1] = hi16(kw[c]); g[2 * c] = lo16(lw[c]); g[2 * c + 1] = hi16(lw[c]); } \
    } else if (MIXER == MIX_C) { \
      const float cs[4] = {R.r0[0], R.r0[2], R.r1[0], R.r1[2]}, sn[4] = {R.r0[1], R.r0[3], R.r1[1], R.r1[3]}; \
      const float q1[4] = {lo16(R.a0.x), hi16(R.a0.x), lo16(R.a0.y), hi16(R.a0.y)}, q2[4] = {lo16(R.a0.z), hi16(R.a0.z), lo16(R.a0.w), hi16(R.a0.w)}; \
      const float k1[4] = {lo16(R.a1.x), hi16(R.a1.x), lo16(R.a1.y), hi16(R.a1.y)}, k2[4] = {lo16(R.a1.z), hi16(R.a1.z), lo16(R.a1.w), hi16(R.a1.w)}; \
      _Pragma("unroll") for (int c = 0; c < 4; ++c) { q[c] = (q1[c] * cs[c] - q2[c] * sn[c]) * 0.125f; q[4 + c] = (q1[c] * sn[c] + q2[c] * cs[c]) * 0.125f; k[c] = k1[c] * cs[c] - k2[c] * sn[c]; k[4 + c] = k1[c] * sn[c] + k2[c] * cs[c]; } \
    } else { \
      const unsigned qw[8] = {R.a0.x, R.a0.y, R.a0.z, R.a0.w, R.a1.x, R.a1.y, R.a1.z, R.a1.w}, kw[8] = {R.b0.x, R.b0.y, R.b0.z, R.b0.w, R.b1.x, R.b1.y, R.b1.z, R.b1.w}; \
      _Pragma("unroll") for (int c = 0; c < 8; ++c) { q[2 * c] = lo16(qw[c]); q[2 * c + 1] = hi16(qw[c]); k[2 * c] = lo16(kw[c]); k[2 * c + 1] = hi16(kw[c]); } \
    } \
    if (MIXER == MIX_A || MIXER == MIX_B) { \
        \
      _Pragma("unroll") for (int c = 0; c < NC; ++c) g[c] += __builtin_bit_cast(float, __builtin_amdgcn_update_dpp(0, __builtin_bit_cast(int, g[c]), 0x111, 0xf, 0xf, false)); \
      _Pragma("unroll") for (int c = 0; c < NC; ++c) g[c] += __builtin_bit_cast(float, __builtin_amdgcn_update_dpp(0, __builtin_bit_cast(int, g[c]), 0x112, 0xf, 0xf, false)); \
      _Pragma("unroll") for (int c = 0; c < NC; ++c) g[c] += __builtin_bit_cast(float, __builtin_amdgcn_update_dpp(0, __builtin_bit_cast(int, g[c]), 0x114, 0xf, 0xf, false)); \
      _Pragma("unroll") for (int c = 0; c < NC; ++c) g[c] += __builtin_bit_cast(float, __builtin_amdgcn_update_dpp(0, __builtin_bit_cast(int, g[c]), 0x118, 0xf, 0xf, false)); \
      _Pragma("unroll") for (int c = 0; c < NC; ++c) g[c] += __builtin_bit_cast(float, __builtin_amdgcn_update_dpp(0, __builtin_bit_cast(int, g[c]), 0x142, 0xa, 0xf, false)); \
      _Pragma("unroll") for (int c = 0; c < NC; ++c) g[c] += __builtin_bit_cast(float, __builtin_amdgcn_update_dpp(0, __builtin_bit_cast(int, g[c]), 0x143, 0xc, 0xf, false)); \
      float ev[NC]; \
      _Pragma("unroll") for (int c = 0; c < NC; ++c) { \
          \
        const float e = __builtin_amdgcn_exp2f(g[c]), r = __builtin_amdgcn_rcpf(e); \
        const float e63 = rdlane(e, 63); \
        q[c] = FMUL(q[c], e); k[c] = FMUL(k[c], r); ktv[c] = FMUL(k[c], e63);     \
        ev[c] = e; } \
      if (lane == 63) { _Pragma("unroll") for (int c = 0; c < NC / 4; ++c) *(f32x4*)(DECb + c0 + 4 * c) = (f32x4){ev[4 * c], ev[4 * c + 1], ev[4 * c + 2], ev[4 * c + 3]}; } \
    } else if (MIXER == MIX_C) { \
        \
      const float gl = (float)(lane + 1) * lgam2; \
      const float e = __builtin_amdgcn_exp2f(gl), r = __builtin_amdgcn_rcpf(e); \
      const float e63 = rdlane(e, 63); const float f_kt = r * e63; \
      _Pragma("unroll") for (int c = 0; c < NC; ++c) { q[c] = FMUL(q[c], e); ktv[c] = FMUL(k[c], f_kt); k[c] = FMUL(k[c], r); } \
      if (lane < 4) { DECb[c0 + lane] = e63; DECb[32 + c0 + lane] = e63; } \
    } else { \
      const float li = R.s0, lf = R.s1;     \
      const float bc = incl_scan_add(lf); const float u = li - bc; const float pm = incl_scan_max(u); \
      const float cmax = rdlane(pm, 63), blast = rdlane(bc, 63); \
      const float a_i = bc + m_st, m_i = fmaxf(a_i, bc + pm); \
      const float d_alpha = __builtin_amdgcn_exp2f(bc - m_i + cmax), d_beta = __builtin_amdgcn_exp2f(u - cmax); \
      rr_next = __builtin_amdgcn_exp2f(m_st - cmax);     \
      const float m_new = fmaxf(blast + m_st, blast + cmax); \
      const float d_sold = __builtin_amdgcn_exp2f(blast + m_st - m_new), d_wks = __builtin_amdgcn_exp2f(blast + u - m_new); m_st = m_new; \
      _Pragma("unroll") for (int c = 0; c < NC; ++c) { ktv[c] = FMUL(k[c], d_wks); q[c] = FMUL(q[c], d_alpha); k[c] = FMUL(k[c], d_beta); if (lane == 63) DECb[c0 + c] = d_sold; } \
      if (wid == 0) EMb[lane] = __builtin_amdgcn_exp2f(-m_i); \
    } \
    _Pragma("unroll") for (int c = 0; c < NC / 2; ++c) { const unsigned w_ = pk_hw(ktv[2 * c], ktv[2 * c + 1]); \
      const int d0_ = (MIXER == MIX_C) ? (2 * c < 4 ? c0 + 2 * c : 32 + c0 + 2 * c - 4) : c0 + 2 * c; \
      *(bf16_t*)(KTb + d0_ * LD_T + lane * 2) = (bf16_t)(w_ & 0xffff); *(bf16_t*)(KTb + (d0_ + 1) * LD_T + lane * 2) = (bf16_t)(w_ >> 16); } \
    { unsigned pq[NC / 2], pks[NC / 2]; \
      _Pragma("unroll") for (int c = 0; c < NC / 2; ++c) { pq[c] = pk_hw(q[2 * c], q[2 * c + 1]); pks[c] = pk_hw(k[2 * c], k[2 * c + 1]); } \
      if (MIXER == MIX_C) { \
        *(u32x2*)(QIb + lane * LD_D + c0 * 2) = (u32x2){pq[0], pq[1]}; *(u32x2*)(QIb + lane * LD_D + (32 + c0) * 2) = (u32x2){pq[2], pq[3]}; \
        *(u32x2*)(KSb + lane * LD_D + c0 * 2) = (u32x2){pks[0], pks[1]}; *(u32x2*)(KSb + lane * LD_D + (32 + c0) * 2) = (u32x2){pks[2], pks[3]}; \
      } else { \
        _Pragma("unroll") for (int c = 0; c < NC / 8; ++c) { \
          *(u32x4*)(QIb + lane * LD_D + (c0 + 8 * c) * 2) = (u32x4){pq[4 * c], pq[4 * c + 1], pq[4 * c + 2], pq[4 * c + 3]}; \
          *(u32x4*)(KSb + lane * LD_D + (c0 + 8 * c) * 2) = (u32x4){pks[4 * c], pks[4 * c + 1], pks[4 * c + 2], pks[4 * c + 3]}; } } } \
    { unsigned char* VTb = lds + U_VT + (buf_) * 6912 + (wid * 4) * LD_T + lane * 2; \
      *(bf16_t*)(VTb + 0 * LD_T) = (bf16_t)(Rv.x & 0xffff); *(bf16_t*)(VTb + 1 * LD_T) = (bf16_t)(Rv.x >> 16); *(bf16_t*)(VTb + 2 * LD_T) = (bf16_t)(Rv.y & 0xffff); *(bf16_t*)(VTb + 3 * LD_T) = (bf16_t)(Rv.y >> 16); } \
  } while (0)
  f32x4 sacc[NST];
#pragma unroll
  for (int i = 0; i < NST; ++i) sacc[i] = (f32x4){0.f, 0.f, 0.f, 0.f};
  A_LOAD(R, Rv, 0);
  A_PREP(0, R, Rv);
  A_LOAD(R, Rv, 1);
  A_LOAD(Rn, Rvn, 2);
  rr_cur = rr_next;
  lds_barrier();
#define SCAN_ITER(n_, RX, RvX) do { const int n = (n_); \
    const int cb = n & 1, nb = (n + 1) & 1; \
    if (n + 1 < NCH) { A_PREP(nb, RX, RvX); if (n + 3 < NCH) A_LOAD(RX, RvX, n + 3); } \
    { \
      const int lane = lane0; \
      const int fr = lane & 15, fq = lane >> 4; \
      const int it = wid & 3, vt = wid >> 2; \
      const unsigned char* STc = lds + U_ST + cb * 13056; unsigned char* STn = lds + U_ST + nb * 13056; \
      const unsigned char* KTc = lds + U_KT + cb * 18432; const unsigned char* VTc = lds + U_VT + cb * 6912; \
      const unsigned char* QI = lds + U_QI + cb * 17408; const unsigned char* KS = lds + U_KS + cb * 17408; \
      const float* DECc = (const float*)(lds + U_DEC + cb * 512); const float* EMc = (const float*)(lds + U_EM + cb * 256); \
        \
        \
      bf16x8 qf[NKD], stf[NKD], dsf[NKD], ksf[4][NKD]; \
_Pragma("unroll") \
      for (int ks = 0; ks < NKD; ++ks) qf[ks] = ldfrag(QI, LD_D, it * 16 + fr, ks * 64 + fq * 16); \
_Pragma("unroll") \
      for (int ks = 0; ks < NKD; ++ks) stf[ks] = ldfrag(STc, LD_D, vt * 16 + fr, ks * 64 + fq * 16); \
_Pragma("unroll") \
      for (int ks = 0; ks < NKD; ++ks) dsf[ks] = (NVT == 3) ? ldfrag(STc, LD_D, 32 + fr, ks * 64 + fq * 16) : qf[ks]; \
_Pragma("unroll") \
      for (int jt = 0; jt < 4; ++jt) { \
_Pragma("unroll") \
        for (int ks = 0; ks < NKD; ++ks) ksf[jt][ks] = ldfrag(KS, LD_D, jt * 16 + fr, ks * 64 + fq * 16); } \
      __builtin_amdgcn_sched_barrier(0); \
      f32x4 oacc = (f32x4){0.f, 0.f, 0.f, 0.f}, dacc = (f32x4){0.f, 0.f, 0.f, 0.f}; \
_Pragma("unroll") \
      for (int ks = 0; ks < NKD; ++ks) oacc = __builtin_amdgcn_mfma_f32_16x16x32_bf16(stf[ks], qf[ks], oacc, 0, 0, 0); \
      if (NVT == 3) { \
_Pragma("unroll") \
        for (int ks = 0; ks < NKD; ++ks) dacc = __builtin_amdgcn_mfma_f32_16x16x32_bf16(dsf[ks], qf[ks], dacc, 0, 0, 0); \
      } \
        \
      f32x4 sc[4]; \
_Pragma("unroll") \
      for (int jt = 0; jt < 4; ++jt) { \
        f32x4 acc = (f32x4){0.f, 0.f, 0.f, 0.f}; \
_Pragma("unroll") \
        for (int ks = 0; ks < NKD; ++ks) acc = __builtin_amdgcn_mfma_f32_16x16x32_bf16(ksf[jt][ks], qf[ks], acc, 0, 0, 0); \
        sc[jt] = acc; } \
        \
      const bf16x8 va0 = ldfrag2(VTc, LD_T, vt * 16 + fr, fq * 8, 32 + fq * 8), va1 = ldfrag2(VTc, LD_T, vt * 16 + fr, 64 + fq * 8, 96 + fq * 8); \
      const bf16x8 vd0 = (NVT == 3) ? ldfrag2(VTc, LD_T, 32 + fr, fq * 8, 32 + fq * 8) : va0, vd1 = (NVT == 3) ? ldfrag2(VTc, LD_T, 32 + fr, 64 + fq * 8, 96 + fq * 8) : va1; \
      const int dts = (DK == 128) ? wid : (wid & 3); \
      const bf16x8 kf0 = ldfrag(KTc, LD_T, dts * 16 + fr, fq * 16), kf1 = ldfrag(KTc, LD_T, dts * 16 + fr, 64 + fq * 16); \
      const f32x4 dc = *(const f32x4*)(DECc + dts * 16 + fq * 4); \
      bf16x8 vtf[NST][2]; \
_Pragma("unroll") \
      for (int s = 0; s < NST; ++s) { const int vt2 = (DK == 128) ? s : (wid >> 2); vtf[s][0] = ldfrag(VTc, LD_T, vt2 * 16 + fr, fq * 16); vtf[s][1] = ldfrag(VTc, LD_T, vt2 * 16 + fr, 64 + fq * 16); } \
      const float em = (NVT == 3) ? EMc[it * 16 + fr] : 0.f; \
      __builtin_amdgcn_sched_barrier(0); \
        \
_Pragma("unroll") \
      for (int s = 0; s < NST; ++s) { \
        const int dt = dts, vt2 = (DK == 128) ? s : (wid >> 2); \
        f32x4 acc = (f32x4){FMUL(sacc[s][0], dc[0]), FMUL(sacc[s][1], dc[1]), FMUL(sacc[s][2], dc[2]), FMUL(sacc[s][3], dc[3])}; \
        acc = __builtin_amdgcn_mfma_f32_16x16x32_bf16(kf0, vtf[s][0], acc, 0, 0, 0); \
        acc = __builtin_amdgcn_mfma_f32_16x16x32_bf16(kf1, vtf[s][1], acc, 0, 0, 0); \
        sacc[s] = acc; \
        *(u32x2*)(STn + (vt2 * 16 + fr) * LD_D + (dt * 16 + fq * 4) * 2) = (u32x2){pk_hw(acc[0], acc[1]), pk_hw(acc[2], acc[3])}; \
      } \
        \
        \
      const int thr = it * 16 + fr - fq * 4; \
      u32x2 sp[4]; \
_Pragma("unroll") \
      for (int jt = 0; jt < 4; ++jt) { \
        const float v0 = (jt * 16 + 0 <= thr) ? sc[jt][0] : 0.f, v1 = (jt * 16 + 1 <= thr) ? sc[jt][1] : 0.f, v2 = (jt * 16 + 2 <= thr) ? sc[jt][2] : 0.f, v3 = (jt * 16 + 3 <= thr) ? sc[jt][3] : 0.f; \
        sp[jt] = (u32x2){pk_hw(v0, v1), pk_hw(v2, v3)}; } \
      const u32x4 sb0 = (u32x4){sp[0].x, sp[0].y, sp[1].x, sp[1].y}, sb1 = (u32x4){sp[2].x, sp[2].y, sp[3].x, sp[3].y}; \
      if (MIXER == MIX_D) { _Pragma("unroll") for (int e_ = 0; e_ < 4; ++e_) { oacc[e_] = FMUL(oacc[e_], rr_cur); dacc[e_] = FMUL(dacc[e_], rr_cur); } } \
      oacc = __builtin_amdgcn_mfma_f32_16x16x32_bf16(va0, __builtin_bit_cast(bf16x8, sb0), oacc, 0, 0, 0); \
      oacc = __builtin_amdgcn_mfma_f32_16x16x32_bf16(va1, __builtin_bit_cast(bf16x8, sb1), oacc, 0, 0, 0); \
      float dn = 1.0f; \
      if (NVT == 3) { \
        dacc = __builtin_amdgcn_mfma_f32_16x16x32_bf16(vd0, __builtin_bit_cast(bf16x8, sb0), dacc, 0, 0, 0); \
        dacc = __builtin_amdgcn_mfma_f32_16x16x32_bf16(vd1, __builtin_bit_cast(bf16x8, sb1), dacc, 0, 0, 0); \
        const float den = __shfl(dacc[0], fr); \
        dn = 1.0f / fmaxf(fabsf(den), em); \
      } \
      { \
        const int i = it * 16 + fr; \
        const int ti = dir ? (SEQ - 1 - (n * 64 + i)) : (n * 64 + i); \
        const f32x4 o = (f32x4){FMUL(oacc[0], dn), FMUL(oacc[1], dn), FMUL(oacc[2], dn), FMUL(oacc[3], dn)}; \
        *(u32x2*)(O + PIDX(tokbase + ti, ocol + vt * 16 + fq * 4)) = (u32x2){pk_hw(o[0], o[1]), pk_hw(o[2], o[3])}; \
      } \
    } \
    rr_cur = rr_next; \
    lds_barrier(); \
  } while (0)
  static_assert(NCH % 2 == 0, "chunk count must be even");
#pragma unroll 1
  for (int n2 = 0; n2 < NCH; n2 += 2) { SCAN_ITER(n2, R, Rv); SCAN_ITER(n2 + 1, Rn, Rvn); }
#undef SCAN_ITER
#undef A_LOAD
#undef A_PREP
}

template <int MIXER>
__device__ __forceinline__ void scan_dispatch2(unsigned char* lds, int wv, const Params& p, int id) {
  const int vs = id & 3, dir = (id >> 2) & 1, h = (id >> 3) & 3, b = id >> 5;
  scan_item2<MIXER>(lds, wv, p, b, h, dir, vs);
}
}

__device__ __forceinline__ void scan_phase2(unsigned char* lds, int wv, const Params& p, int layer, int convert) {
  bool light = false;
  for (int it0 = blockIdx.x; it0 < 256; it0 += gridDim.x) {
    const int xq = it0 & 7, yq = it0 >> 3, stream = (yq >> 2) * 8 + xq;
    const int item = (stream >> 5) * 128 + (stream & 31) * 4 + (yq & 3);
    if (layer == 0) { if (item < 128) scan2::scan_dispatch2<scan::MIX_A>(lds, wv, p, item); else scan2::scan_dispatch2<scan::MIX_B>(lds, wv, p, item - 128); }
    else { if (item < 128) scan2::scan_dispatch2<scan::MIX_D>(lds, wv, p, item); else scan2::scan_dispatch2<scan::MIX_C>(lds, wv, p, item - 128); }
    light = item >= 128;
    __syncthreads();
  }
  if (convert) {
    const int G = gridDim.x, b = blockIdx.x;
    if (G == 256) { if (light) { moe_weight_convert(lds, wv, p, layer, 0, b - 128, 128); if (p.big_ws) moe_weight_convert(lds, wv, p, layer, 1, b - 128, 128); } }
    else { moe_weight_convert(lds, wv, p, layer, 0, b, G); if (p.big_ws) moe_weight_convert(lds, wv, p, layer, 1, b, G); }
  }
}
#endif
#ifndef CPU_EMU
#define XB_BASE     2048
#define XB_TMO      (XB_BASE + 128)
#define XB_XCNT(j)  (XB_BASE + 256  + 64 * (j))
#define XB_XSUB(j)  (XB_BASE + 1280 + 64 * (j))
#define XB_XGEN(j)  (XB_BASE + 2304 + 64 * (j))
#define XB_TOP      (XB_BASE + 3328)
#define XB_TOPGEN   (XB_BASE + 3392)
#define XB_WORDS    3456
#define XB_SPIN_CAP (1u << 22)
#define XB_LDS_OFF  (LDS_BYTES - 16)
__device__ __forceinline__ unsigned xb_ld(unsigned* p)              { return __hip_atomic_load(p, __ATOMIC_RELAXED, __HIP_MEMORY_SCOPE_AGENT); }
__device__ __forceinline__ unsigned xb_add(unsigned* p, unsigned v) { return __hip_atomic_fetch_add(p, v, __ATOMIC_RELAXED, __HIP_MEMORY_SCOPE_AGENT); }
__device__ __forceinline__ unsigned xb_xcc_id() { return (unsigned)__builtin_amdgcn_s_getreg((3 << 11) | 20) & 0xFu; }
#define XB_SPIN(cond, bar) do { unsigned _sp = 0; while (cond) { __builtin_amdgcn_s_sleep(1); \
    if ((++_sp & 255u) == 0u) { if (xb_ld(&(bar)[XB_TMO])) break; if (_sp > XB_SPIN_CAP) { atomicAdd(&(bar)[XB_TMO], 1u); break; } } } } while (0)
__device__ __forceinline__ void grid_bar(unsigned* bar, unsigned char* lds_raw, int wv) {
  asm volatile("s_waitcnt vmcnt(0)" ::: "memory");
  __syncthreads();
  if (wv == 0 && lane_id() == 0) {
    volatile unsigned* st = (volatile unsigned*)(lds_raw + XB_LDS_OFF);
    __builtin_amdgcn_s_waitcnt(0);
    const unsigned x = xb_xcc_id();
    unsigned nloc = st[0], nx = st[1];
    if (nloc == 0u) {
      const unsigned G = gridDim.x; unsigned sum, cnt, mine, sp = 0u;
      for (;;) { sum = 0u; cnt = 0u; mine = 0u;
#pragma unroll
        for (unsigned j = 0; j < 16; ++j) { const unsigned c = xb_ld(&bar[XB_XCNT(j)]); sum += c; cnt += (c > 0u) ? 1u : 0u; mine = (j == x) ? c : mine; }
        if (sum == G) break;
        __builtin_amdgcn_s_sleep(1);
        if ((++sp & 255u) == 0u) { if (xb_ld(&bar[XB_TMO])) break; if (sp > XB_SPIN_CAP) { atomicAdd(&bar[XB_TMO], 1u); break; } } }
      nloc = mine > 0u ? mine : 1u; nx = cnt > 0u ? cnt : 1u; st[0] = nloc; st[1] = nx;
    }
    const unsigned old = xb_add(&bar[XB_XSUB(x)], 1u);
    const unsigned gen = old / nloc;
    if (old + 1u == (gen + 1u) * nloc) {
      __builtin_amdgcn_fence(__ATOMIC_RELEASE, "agent");
      asm volatile("s_waitcnt vmcnt(0)" ::: "memory");
      const unsigned og = xb_add(&bar[XB_TOP], 1u);
      const unsigned tg = og / nx;
      if (og + 1u == (tg + 1u) * nx) xb_add(&bar[XB_TOPGEN], 1u);
      else XB_SPIN(xb_ld(&bar[XB_TOPGEN]) == tg, bar);
      __builtin_amdgcn_fence(__ATOMIC_ACQUIRE, "agent");
      xb_add(&bar[XB_XGEN(x)], 1u);
      asm volatile("s_waitcnt vmcnt(0)" ::: "memory");
    } else {
      XB_SPIN(xb_ld(&bar[XB_XGEN(x)]) == gen, bar);
      __builtin_amdgcn_fence(__ATOMIC_ACQUIRE, "agent");
      asm volatile("s_waitcnt vmcnt(0)" ::: "memory");
    }
  }
  __syncthreads();
}
#if (PROBE_DUP & 16)
#define grid_bar(a, b, c) do { grid_bar(a, b, c); grid_bar(a, b, c); } while (0)
#endif

__global__ void __launch_bounds__(NTHREADS) mk_fwd(Params p) {
  extern __shared__ __attribute__((aligned(16))) unsigned char lds_raw[];
  cg::grid_group grid = cg::this_grid();
  const int G = gridDim.x, bid = blockIdx.x;
  const int wv = __builtin_amdgcn_readfirstlane(threadIdx.x >> 6);
  PG8_LAS unsigned char* lds = (PG8_LAS unsigned char*)lds_raw;
  unsigned char* ws = p.ws;

  if (threadIdx.x < 4) ((unsigned*)(lds_raw + XB_LDS_OFF))[threadIdx.x] = 0u;
  p0_prologue(lds_raw, wv, p);
#if (PROBE_DUP & 128)
  p0_prologue(lds_raw, wv, p);
#endif
  grid.sync();
  unsigned* bar = (unsigned*)(ws + WS_CTL);
  if (wv == 0 && lane_id() == 0) (void)xb_add(&bar[XB_XCNT(xb_xcc_id())], 1u);
  for (int layer = 0; layer < 2; ++layer) {
    { ProbInProj pr; pr.so.init(NTOK, layer == 0 ? PM_AB : PM_CD, G, bid); pr.A = (const char*)p.out; pr.Bt = (const char*)(ws + (layer == 0 ? WS_WIN_AB : WS_WIN_CD));
      pr.P = (bf16_t*)(ws + WS_R1); pr.bias = p.in[layer == 0 ? I_AB_B_IN : I_CD_B_IN]; pr.lb = (const float*)(ws + WS_LB); pr.layer = layer;
      pg8::gemm_phase(lds, pr, wv);
#if (PROBE_DUP & (1 | 2048))
      pg8::gemm_phase(lds, pr, wv);
#endif
      if (layer == 0) side_phase<32>(lds_raw, wv, p, 0); else side_phase<16>(lds_raw, wv, p, 1);
#if (PROBE_DUP & 256)
      if (layer == 0) side_phase<32>(lds_raw, wv, p, 0); else side_phase<16>(lds_raw, wv, p, 1);
#endif
 }
    grid_bar(bar, lds_raw, wv);
    if (layer == 1) { convd_phase(lds_raw, wv, p); grid_bar(bar, lds_raw, wv); }
    scan_phase2(lds_raw, wv, p, layer, 1);
#if (PROBE_DUP & 2)
    scan_phase2(lds_raw, wv, p, layer, 0);
#endif
#if (PROBE_DUP & 512)
    if (layer == 0) scan_phase2(lds_raw, wv, p, layer, 0);
#endif
#if (PROBE_DUP & 1024)
    if (layer == 1) scan_phase2(lds_raw, wv, p, layer, 0);
#endif
    grid_bar(bar, lds_raw, wv);
    headnorm_phase(lds_raw, wv, p, layer);
#if (PROBE_DUP & 8)
    headnorm_phase(lds_raw, wv, p, layer);
#endif
    grid_bar(bar, lds_raw, wv);
    { ProbOutProj pr; pr.so.init(NTOK, 1024, G, bid); pr.A = (const char*)(ws + WS_MIX); pr.Bt = (const char*)(ws + (layer == 0 ? WS_WOUT_AB : WS_WOUT_CD)); pr.Y = (bf16_t*)(ws + WS_R2); pr.Hres = (const bf16_t*)p.out;
      pg8::gemm_phase(lds, pr, wv);
#if (PROBE_DUP & (1 | 16384))
      pg8::gemm_phase(lds, pr, wv);
#endif
      if (!p.big_ws) moe_weight_convert(lds_raw, wv, p, layer, 1, bid, G);
 }
    grid_bar(bar, lds_raw, wv);
#if (PROBE_DUP & 32)
    ln_phase(lds_raw, wv, p, layer, 0, 1);
#endif
    ln_phase(lds_raw, wv, p, layer, 0);
    grid_bar(bar, lds_raw, wv);
    { ProbMoe1 pr; pr.mo.init((const int*)((const unsigned*)(ws + WS_CTL) + CW_CNT(layer)), 8, G, bid, lds_raw, wv);
      pr.A = (const char*)(ws + WS_MIX); pr.W13 = (const char*)(ws + WS_W13); pr.list = (const int*)(ws + WS_LIST) + (size_t)layer * NEXP * NTOK; pr.H = (bf16_t*)(ws + WS_H);
      pg8::gemm_phase(lds, pr, wv);
#if (PROBE_DUP & (1 | 4096))
      pg8::gemm_phase(lds, pr, wv);
#endif
 }
    grid_bar(bar, lds_raw, wv);
    { ProbMoe2 pr; pr.mo.init((const int*)((const unsigned*)(ws + WS_CTL) + CW_CNT(layer)), 4, G, bid, lds_raw, wv);
      pr.A = (const char*)(ws + WS_H); pr.W2 = (const char*)(ws + (p.big_ws ? WS_W2X : WS_W2)); pr.Y = (bf16_t*)(ws + WS_R2);
      pg8::gemm_phase(lds, pr, wv);
#if (PROBE_DUP & (1 | 8192))
      pg8::gemm_phase(lds, pr, wv);
#endif
 }
    grid_bar(bar, lds_raw, wv);
#if (PROBE_DUP & 64)
    ln_phase(lds_raw, wv, p, layer, 1, 1);
#endif
    ln_phase(lds_raw, wv, p, layer, 1);
    if (layer == 0) grid_bar(bar, lds_raw, wv);
  }
}

extern "C" void kernel_launch(void* const* d_in, const int* in_sizes, int n_in, void* d_out, int out_size, void* d_ws, size_t ws_size, hipStream_t stream) {
  static int grid_blocks = 0;
  if (grid_blocks == 0) {
    if (n_in != N_IN || ws_size < WS_END || out_size != NTOK * 1024) { fprintf(stderr, "kernel_launch: bad shapes: n_in %d ws %zu (need %zu) out %d\n", n_in, ws_size, (size_t)WS_END, out_size); grid_blocks = -1; return; }
    int dev = 0, cus = 0, per_cu = 0;
    hipGetDevice(&dev); hipDeviceGetAttribute(&cus, hipDeviceAttributeMultiprocessorCount, dev);
    if (hipFuncSetAttribute((const void*)mk_fwd, hipFuncAttributeMaxDynamicSharedMemorySize, LDS_BYTES) != hipSuccess) { fprintf(stderr, "kernel_launch: hipFuncSetAttribute failed\n"); grid_blocks = -1; return; }
    if (hipOccupancyMaxActiveBlocksPerMultiprocessor(&per_cu, (const void*)mk_fwd, NTHREADS, LDS_BYTES) != hipSuccess || per_cu < 1) { fprintf(stderr, "kernel_launch: occupancy query failed (%d)\n", per_cu); grid_blocks = -1; return; }
    grid_blocks = cus;
    (void)in_sizes;
  }
  if (grid_blocks < 0) return;
  Params p{};
  for (int i = 0; i < N_IN; ++i) p.in[i] = (const float*)d_in[i];
  p.out = (float*)d_out; p.ws = (unsigned char*)d_ws; p.big_ws = ws_size >= (size_t)WS_END_BIG ? 1 : 0;
  void* args[] = {&p};
  hipError_t e = hipLaunchCooperativeKernel((const void*)mk_fwd, dim3(grid_blocks), dim3(NTHREADS), args, LDS_BYTES, stream);
  if (e != hipSuccess) fprintf(stderr, "cooperative launch failed: %s (grid %d)\n", hipGetErrorString(e), grid_blocks);
}
#endif
```

```cpp
#ifdef CPU_EMU
#include <cmath>
#include <cstdio>
#include <cstring>
#include <cstdlib>
#include <cstddef>
#define DEV
#define DEV_INLINE static inline
typedef void* hipStream_t;
#else
#include <hip/hip_runtime.h>
#include <hip/hip_bf16.h>
#include <cstdio>
#define DEV __device__ __forceinline__
#define DEV_INLINE __device__ __forceinline__
#endif
#ifndef PROBE_DUP
#define PROBE_DUP 0
#endif
#ifndef BATCH
#define BATCH 4
#endif
#ifndef SEQ
#define SEQ 8192
#endif
#define DM 1024
#define NTOK (BATCH * SEQ)
#define P_AB 4128
#define P_CD 3600
#define PM_AB 4096
#define PM_CD 3584
#define NEXP 16
#define ALPHA_F 1.4142135623730951f
#define LN_EPS_F 1e-5f
#define NORM_EPS_F 1e-6f
#define HROWS (2 * NTOK + NEXP * 256)

typedef unsigned short bf16_t;

DEV_INLINE float bf2f(bf16_t b) { unsigned u = ((unsigned)b) << 16; float f; memcpy(&f, &u, 4); return f; }
DEV_INLINE bf16_t f2bf(float f) { unsigned u; memcpy(&u, &f, 4); u += 0x7FFFu + ((u >> 16) & 1u); return (bf16_t)(u >> 16); }
DEV_INLINE float sigmoidf_(float x) { return 1.0f / (1.0f + expf(-x)); }
DEV_INLINE float siluf_(float x) { return x / (1.0f + expf(-x)); }
DEV_INLINE float logsigmoidf_(float x) { return fminf(x, 0.0f) - log1pf(expf(-fabsf(x))); }

#define AL256(x) (((size_t)(x) + 255) & ~(size_t)255)
#define WS_CTL    ((size_t)0)
#define WS_HB     ((size_t)65536)
#define WS_R1     (WS_HB + (size_t)NTOK * 1024 * 2)
#define R1_P_BYTES ((size_t)NTOK * 4096 * 2)
#define R1_MIN    ((size_t)NTOK * 1024 * 2 + AL256((size_t)HROWS * 1024 * 2))
#define R1_PL     (R1_P_BYTES + (size_t)NTOK * 512 * 2)
#define R1_BYTES  (R1_PL > R1_MIN ? R1_PL : R1_MIN)
#define WS_LFB    (WS_R1 + R1_P_BYTES)
#define WS_MIX    (WS_R1)
#define WS_H      (WS_R1 + (size_t)NTOK * 1024 * 2)
#define WS_W13    (WS_HB)
#define WS_W2     (WS_LFB)
#define WMOE_BYTES ((size_t)NEXP * 3072 * 1024 * 2)
#define WS_R2     (WS_R1 + R1_BYTES)
#define R2_BYTES  ((size_t)HROWS * 1024 * 2 > (size_t)NTOK * 1024 * 4 ? (size_t)HROWS * 1024 * 2 : (size_t)NTOK * 1024 * 4)
#define WS_SIDE   (WS_R2 + AL256(R2_BYTES))
#define WS_WIN_AB (WS_SIDE + (size_t)NTOK * 32 * 4)
#define WS_WIN_CD (WS_WIN_AB + (size_t)4128 * 1024 * 2)
#define WS_WOUT_AB (WS_WIN_CD + (size_t)3600 * 1024 * 2)
#define WS_WOUT_CD (WS_WOUT_AB + (size_t)1024 * 1024 * 2)
#define WS_ROPE   (WS_WOUT_CD + (size_t)1024 * 1024 * 2)
#define WS_LB     (WS_ROPE + (size_t)SEQ * 64 * 4)
#define WS_LIST   (WS_LB + 4096)
#define WS_ASSIGN (WS_LIST + (size_t)2 * NEXP * NTOK * 4)
#define WS_GATE   (WS_ASSIGN + (size_t)NTOK * 16)
#define WS_END    (WS_GATE + (size_t)NTOK * 8)
#define WS_W2X    (AL256(WS_END))
#define WS_END_BIG (WS_W2X + (size_t)NEXP * 1024 * 1024 * 2)
#define CW_CNT(layer) (64 + 256 * (layer))

#define PSTRIDE 4096
#define PIDX(tok, col) ((((size_t)((col) >> 7)) * NTOK + (size_t)(tok)) * 128 + (size_t)((col) & 127))

enum { I_X, I_AB_W_IN, I_AB_B_IN, I_HGRN_LB, I_GK_UP, I_GK_B, I_HGRN_NORM, I_GLA_NORM, I_AB_W_OUT,
       I_CD_W_IN, I_CD_B_IN, I_CONV_W, I_CONV_B, I_FGATE_B, I_RET_NORM, I_MLSTM_NORM, I_CD_W_OUT,
       I_LN_MIX_G, I_LN_MIX_B, I_LN_FFN_G, I_LN_FFN_B, I_ROUTER_W, I_ROUTER_B, I_MOE_W1, I_MOE_W3, I_MOE_W2, N_IN };

struct Params {
  const float* in[N_IN];
  float* out;
  unsigned char* ws;
  long long big_ws;
};

DEV_INLINE float epi_ab(int col, float v, const float* lb) {
  if (col < 512) return siluf_(v);
  if (col < 1536) { float l = lb[(col - 512) & 511]; return logf(l + (1.0f - l) * sigmoidf_(v)); }
  if (col >= 2560 && col < 2816) return v * 0.125f;
  return v;
}

DEV_INLINE void route_from_logits(const float* lg, const float* rb, int* e_out, float* g_out) {
  float mx = lg[0];
#pragma unroll
  for (int e = 1; e < 16; ++e) mx = fmaxf(mx, lg[e]);
  float sc[16]; float sum = 0.f;
#pragma unroll
  for (int e = 0; e < 16; ++e) { sc[e] = expf(lg[e] - mx); sum += sc[e]; }
  float inv = 1.0f / sum;
  float best_gs = -1e30f; int be1 = 0, be2 = 1; float bs1 = 0.f, bs2 = 0.f;
#pragma unroll
  for (int gq = 0; gq < 4; ++gq) {
    float m1 = -1e30f, m2 = -1e30f, s1 = 0.f, s2 = 0.f; int i1 = 0, i2 = 0;
#pragma unroll
    for (int i = 0; i < 4; ++i) {
      float s = sc[gq * 4 + i] * inv; float v = s + rb[gq * 4 + i];
      if (v > m1) { m2 = m1; i2 = i1; s2 = s1; m1 = v; i1 = gq * 4 + i; s1 = s; }
      else if (v > m2) { m2 = v; i2 = gq * 4 + i; s2 = s; }
    }
    float gs = m1 + m2;
    if (gs > best_gs) { best_gs = gs; be1 = i1; be2 = i2; bs1 = s1; bs2 = s2; }
  }
  e_out[0] = be1; e_out[1] = be2; g_out[0] = bs1 / (bs1 + bs2); g_out[1] = bs2 / (bs1 + bs2);
}
#ifndef CPU_EMU
namespace pg8 {
#define PG8_LAS __attribute__((address_space(3)))
typedef short bf16x8 __attribute__((ext_vector_type(8)));
typedef float f32x4 __attribute__((ext_vector_type(4)));
typedef unsigned u32x4 __attribute__((ext_vector_type(4)));
typedef unsigned u32x2 __attribute__((ext_vector_type(2)));
constexpr int BM = 256, BK = 64, HALF = 128, HTB = HALF * BK * 2, STAGE_BYTES = 8 * HTB, NXCD = 8, WGM = 8, GK = 1024;

__device__ __forceinline__ int lds_byte(int r, int c) { const int st = (r >> 4) * 2 + (c >> 5), rr = r & 15, cc = c & 31, ob = rr * 64 + cc * 2; return st * 1024 + (ob ^ (((ob >> 9) & 1) << 5)); }
__device__ __forceinline__ void stage_rc(int b, int& R, int& C) { const int st = b / 1024, sb = b % 1024, swz = sb ^ (((sb >> 9) & 1) << 5); R = (st >> 1) * 16 + swz / 64; C = (st & 1) * 32 + (swz % 64) / 2; }
__device__ __forceinline__ int perm32(int rho) { const int n = rho >> 4, i = rho & 15; return 8 * (i >> 2) + 4 * n + (i & 3); }
__device__ __forceinline__ unsigned cvt_pk_bf16(float lo, float hi) { unsigned r; asm volatile("v_cvt_pk_bf16_f32 %0, %1, %2" : "=v"(r) : "v"(lo), "v"(hi)); return r; }

struct Unit { int pm, pn, e, row0, ne, ui; };

struct StaticOrder {
  int nM, nN, nwg, G, c;
  __device__ void init(int M, int N, int G_, int c_) { nM = M / BM; nN = N / BM; nwg = nM * nN; G = G_; c = c_; }
  __device__ bool next(int i, Unit& u) const {
    const long L = (long)i * G + c; if (L >= nwg) return false;
    int wgid = (int)L; { const int q = nwg / NXCD, r = nwg % NXCD, xcd = wgid % NXCD, off = wgid / NXCD; wgid = (xcd < r ? xcd * (q + 1) : r * (q + 1) + (xcd - r) * q) + off; }
    const int nig = WGM * nN, gid = wgid / nig, fm = gid * WGM, gsz = (nM - fm) < WGM ? (nM - fm) : WGM;
    u.pm = fm + ((wgid % nig) % gsz); u.pn = (wgid % nig) / gsz; u.e = 0; u.row0 = u.pm * BM; u.ne = 0; u.ui = i; return true;
  }
};

template <class Prob>
__device__ __forceinline__ void gemm_phase(PG8_LAS unsigned char* lds, const Prob& S, int wv) {
  int wv_ = wv; asm volatile("" : "+s"(wv_));
  int l_; asm volatile("v_mbcnt_lo_u32_b32 %0, -1, 0\n\tv_mbcnt_hi_u32_b32 %0, -1, %0" : "=v"(l_));
  int tid_ = wv_ * 64 + l_;
  const int tid = tid_, wid = __builtin_amdgcn_readfirstlane(tid >> 6), lane = tid & 63, wr = wid >> 2, wc = wid & 3, fr = lane & 15, fq = lane >> 4;
  constexpr int K = GK, nt = K / BK;
  int sR[2], sC[2]; unsigned voffB[2];
#pragma unroll
  for (int i = 0; i < 2; ++i) { int R, C; stage_rc(tid * 16 + i * 8192, R, C); sR[i] = R; sC[i] = C; const int Rb = Prob::PERM ? ((R & ~31) + perm32(R & 31)) : R; voffB[i] = (unsigned)(Rb * K + C) * 2u; }
  const size_t kstep = (size_t)(BK * 2);
  const size_t hstep = (size_t)HALF * K * 2;
  const unsigned ldsw = (unsigned)wid * 1024u;
  const int aoff = lds_byte(wr * 64 + fr, fq * 8), boff = lds_byte(wc * 32 + fr, fq * 8);
#define PG8_SA(b, h) (((b) * 2 + (h)) * HTB)
#define PG8_SB(b, h) ((4 + (b) * 2 + (h)) * HTB)
#define PG8_STAGE(bufoff, gbase, voff) do { _Pragma("unroll") for (int _i = 0; _i < 2; ++_i) \
    __builtin_amdgcn_global_load_lds((const unsigned*)((const char*)(gbase) + (voff)[_i]), (PG8_LAS unsigned*)(lds + (bufoff) + ldsw + _i * 8192), 16, 0, 0); } while (0)
#define PG8_LDA(dst, b, h) do { _Pragma("unroll") for (int m = 0; m < 4; ++m) _Pragma("unroll") for (int k = 0; k < 2; ++k) dst[m][k] = *(const PG8_LAS bf16x8*)(lds + PG8_SA(b, h) + aoff + m * 2048 + k * 1024); } while (0)
#define PG8_LDB(dst, b, h) do { _Pragma("unroll") for (int n = 0; n < 2; ++n) _Pragma("unroll") for (int k = 0; k < 2; ++k) dst[n][k] = *(const PG8_LAS bf16x8*)(lds + PG8_SB(b, h) + boff + n * 2048 + k * 1024); } while (0)
#define PG8_MMA(ai, bj, At, Bt) do { __builtin_amdgcn_s_setprio(1); _Pragma("unroll") for (int m = 0; m < 4; ++m) _Pragma("unroll") for (int n = 0; n < 2; ++n) _Pragma("unroll") for (int k = 0; k < 2; ++k) \
    acc[ai][bj][m][n] = __builtin_amdgcn_mfma_f32_16x16x32_bf16(Bt[n][k], At[m][k], acc[ai][bj][m][n], 0, 0, 0); __builtin_amdgcn_s_setprio(0); } while (0)
#define PG8_WAIT_V(n) asm volatile("s_waitcnt vmcnt(" #n ")" ::: "memory")
#define PG8_WAIT_L(n) asm volatile("s_waitcnt lgkmcnt(" #n ")" ::: "memory")
#define PG8_BAR __builtin_amdgcn_s_barrier()
#define PG8_SCHED __builtin_amdgcn_sched_barrier(0)
  Unit cur, nxt; int ui = 0;
  if (!S.next(0, cur)) return;
  f32x4 acc[2][2][4][2];
#pragma unroll
  for (int a = 0; a < 2; ++a)
#pragma unroll
    for (int b = 0; b < 2; ++b)
#pragma unroll
      for (int m = 0; m < 4; ++m)
#pragma unroll
        for (int n = 0; n < 2; ++n) acc[a][b][m][n] = (f32x4){0.f, 0.f, 0.f, 0.f};
  bf16x8 At[4][2], B0[2][2], B1[2][2];
  unsigned oc0[2], oc1[2], on0[2], on1[2];
#pragma unroll
  for (int i = 0; i < 2; ++i) { oc0[i] = S.a_off(cur, sR[i]) + (unsigned)sC[i] * 2u; oc1[i] = S.a_off(cur, HALF + sR[i]) + (unsigned)sC[i] * 2u; }
  const char* const Ab = S.a_base();
  const char* cB = S.b_base(cur);
  PG8_STAGE(PG8_SB(0, 0), cB, voffB); PG8_STAGE(PG8_SB(0, 1), cB + hstep, voffB); PG8_STAGE(PG8_SA(0, 0), Ab, oc0); PG8_STAGE(PG8_SA(0, 1), Ab, oc1);
  if (wr == 1) PG8_BAR;
  PG8_WAIT_V(2); PG8_BAR;
  PG8_STAGE(PG8_SB(1, 0), cB + kstep, voffB); PG8_STAGE(PG8_SA(1, 0), Ab + kstep, oc0); PG8_STAGE(PG8_SB(1, 1), cB + hstep + kstep, voffB);
  PG8_WAIT_V(6); PG8_BAR;
  for (;;) {
    const bool has_next = S.next(ui + 1, nxt);
    const char* nB = cB;
    if (has_next) {
      nB = S.b_base(nxt);
      int l2_; asm volatile("v_mbcnt_lo_u32_b32 %0, -1, 0\n\tv_mbcnt_hi_u32_b32 %0, -1, %0" : "=v"(l2_));
      const int tid2 = wid * 64 + l2_;
#pragma unroll
      for (int i = 0; i < 2; ++i) { int R, C; stage_rc(tid2 * 16 + i * 8192, R, C); on0[i] = S.a_off(nxt, R) + (unsigned)C * 2u; on1[i] = S.a_off(nxt, HALF + R) + (unsigned)C * 2u; }
    } else {
#pragma unroll
      for (int i = 0; i < 2; ++i) { on0[i] = oc0[i]; on1[i] = oc1[i]; }
    }
    for (int t = 0; t < nt; t += 2) {
      const bool last = (t == nt - 2);
      const char* a1 = Ab + (size_t)(t + 1) * kstep;
      const char* a2 = last ? Ab : Ab + (size_t)(t + 2) * kstep; const char* b2 = last ? nB : cB + (size_t)(t + 2) * kstep;
      const char* a3 = a2 + kstep; const char* b3 = b2 + kstep;
      unsigned o20[2], o21[2];
#pragma unroll
      for (int i = 0; i < 2; ++i) { o20[i] = last ? on0[i] : oc0[i]; o21[i] = last ? on1[i] : oc1[i]; }
      PG8_LDB(B0, 0, 0); PG8_LDB(B1, 0, 1); PG8_SCHED; PG8_LDA(At, 0, 0); PG8_STAGE(PG8_SA(1, 1), a1, oc1);
      PG8_WAIT_V(8); PG8_WAIT_L(0); PG8_BAR; PG8_MMA(0, 0, At, B0); PG8_MMA(0, 1, At, B1); PG8_BAR; PG8_SCHED;
      PG8_LDA(At, 0, 1); PG8_STAGE(PG8_SB(0, 0), b2, voffB); PG8_STAGE(PG8_SB(0, 1), b2 + hstep, voffB); PG8_STAGE(PG8_SA(0, 0), a2, o20);
      PG8_WAIT_V(8); PG8_WAIT_L(0); PG8_BAR; PG8_MMA(1, 0, At, B0); PG8_MMA(1, 1, At, B1); PG8_BAR; PG8_SCHED;
      PG8_LDB(B0, 1, 0); PG8_LDB(B1, 1, 1); PG8_SCHED; PG8_LDA(At, 1, 0); PG8_STAGE(PG8_SA(0, 1), a2, o21);
      PG8_WAIT_V(8); PG8_WAIT_L(0); PG8_BAR; PG8_MMA(0, 0, At, B0); PG8_MMA(0, 1, At, B1); PG8_BAR; PG8_SCHED;
      PG8_LDA(At, 1, 1); PG8_STAGE(PG8_SB(1, 0), b3, voffB); PG8_STAGE(PG8_SB(1, 1), b3 + hstep, voffB); PG8_STAGE(PG8_SA(1, 0), a3, o20);
      PG8_WAIT_V(8); PG8_WAIT_L(0); PG8_BAR; PG8_MMA(1, 0, At, B0); PG8_MMA(1, 1, At, B1); PG8_BAR; PG8_SCHED;
    }
    if (wr == 0) PG8_BAR;
    { int l3_; asm volatile("v_mbcnt_lo_u32_b32 %0, -1, 0\n\tv_mbcnt_hi_u32_b32 %0, -1, %0" : "=v"(l3_));
      S.epi(acc, cur, wr, wc, l3_ & 15, l3_ >> 4); }
    if (!has_next) break;
#pragma unroll
    for (int a = 0; a < 2; ++a)
#pragma unroll
      for (int b = 0; b < 2; ++b)
#pragma unroll
        for (int m = 0; m < 4; ++m)
#pragma unroll
          for (int n = 0; n < 2; ++n) acc[a][b][m][n] = (f32x4){0.f, 0.f, 0.f, 0.f};
    cur = nxt; cB = nB; ++ui;
#pragma unroll
    for (int i = 0; i < 2; ++i) { oc0[i] = on0[i]; oc1[i] = on1[i]; }
    if (wr == 1) PG8_BAR;
  }
  PG8_WAIT_V(0);
  PG8_BAR;
#undef PG8_SA
#undef PG8_SB
#undef PG8_STAGE
#undef PG8_LDA
#undef PG8_LDB
#undef PG8_MMA
#undef PG8_WAIT_V
#undef PG8_WAIT_L
#undef PG8_BAR
#undef PG8_SCHED
}
}
#endif
#ifndef CPU_EMU
#include <hip/hip_cooperative_groups.h>
namespace cg = cooperative_groups;
#define LAS __attribute__((address_space(3)))
#define NTHREADS 512
#define LDS_BYTES (154 * 1024)
typedef float f32x4 __attribute__((ext_vector_type(4)));
typedef short bf16x8 __attribute__((ext_vector_type(8)));
typedef unsigned u32x4 __attribute__((ext_vector_type(4)));
typedef unsigned u32x2 __attribute__((ext_vector_type(2)));

struct Ctx { int tid, lane, wid, G, bid; unsigned char* lds; };
__device__ __forceinline__ int lane_id() { int l; asm volatile("v_mbcnt_lo_u32_b32 %0, -1, 0\n\tv_mbcnt_hi_u32_b32 %0, -1, %0" : "=v"(l)); return l; }
__device__ __forceinline__ int opaque_tid(int wv) { int w = wv; asm volatile("" : "+s"(w)); int t = w * 64 + lane_id(); asm volatile("" : "+v"(t)); return t; }
__device__ __forceinline__ Ctx make_ctx(unsigned char* lds, int wv) { Ctx c; c.tid = opaque_tid(wv); c.lane = c.tid & 63; c.wid = __builtin_amdgcn_readfirstlane(c.tid >> 6); c.G = gridDim.x; c.bid = blockIdx.x; c.lds = lds; return c; }

__device__ __forceinline__ float wave_sum(float x) {
  x += __builtin_bit_cast(float, __builtin_amdgcn_update_dpp(0, __builtin_bit_cast(int, x), 0x111, 0xf, 0xf, false));
  x += __builtin_bit_cast(float, __builtin_amdgcn_update_dpp(0, __builtin_bit_cast(int, x), 0x112, 0xf, 0xf, false));
  x += __builtin_bit_cast(float, __builtin_amdgcn_update_dpp(0, __builtin_bit_cast(int, x), 0x114, 0xf, 0xf, false));
  x += __builtin_bit_cast(float, __builtin_amdgcn_update_dpp(0, __builtin_bit_cast(int, x), 0x118, 0xf, 0xf, false));
  x += __builtin_bit_cast(float, __builtin_amdgcn_update_dpp(0, __builtin_bit_cast(int, x), 0x142, 0xa, 0xf, false));
  x += __builtin_bit_cast(float, __builtin_amdgcn_update_dpp(0, __builtin_bit_cast(int, x), 0x143, 0xc, 0xf, false));
  return __builtin_bit_cast(float, __builtin_amdgcn_readlane(__builtin_bit_cast(int, x), 63));
}
__device__ __forceinline__ float fsigmoid(float x) { return __builtin_amdgcn_rcpf(1.0f + __builtin_amdgcn_exp2f(-1.4426950408889634f * x)); }
__device__ __forceinline__ float fsilu(float x) { return x * fsigmoid(x); }
__device__ __forceinline__ float flog2sigmoid(float x) { const float y = x * 1.4426950408889634f; return fminf(y, 0.f) - __builtin_amdgcn_logf(1.0f + __builtin_amdgcn_exp2f(-fabsf(y))); }
typedef float f32x2_t __attribute__((ext_vector_type(2)));
typedef __bf16 bf16x2_t __attribute__((ext_vector_type(2)));
__device__ __forceinline__ unsigned pk_hw(float a, float b) { const f32x2_t v = {a, b}; return __builtin_bit_cast(unsigned, __builtin_convertvector(v, bf16x2_t)); }
__device__ __forceinline__ unsigned pk2(float a, float b) { return pk_hw(a, b); }
__device__ __forceinline__ void unpack8(u32x4 w, float* f) {
  f[0] = __uint_as_float(w.x << 16); f[1] = __uint_as_float(w.x & 0xffff0000u); f[2] = __uint_as_float(w.y << 16); f[3] = __uint_as_float(w.y & 0xffff0000u);
  f[4] = __uint_as_float(w.z << 16); f[5] = __uint_as_float(w.z & 0xffff0000u); f[6] = __uint_as_float(w.w << 16); f[7] = __uint_as_float(w.w & 0xffff0000u);
}

__device__ __forceinline__ void transpose_job(const Ctx& c, const float* src, int N, bf16_t* dst, int rs, int ro, int tile0, int tile_stride) {
  float* t = (float*)c.lds;
  const int ntn = (N + 63) / 64, ntiles = ntn * 16;
  for (int tl = tile0; tl < ntiles; tl += tile_stride) {
    const int kt = tl / ntn, nt_ = tl % ntn, k0 = kt * 64, n0 = nt_ * 64;
    __syncthreads();
#pragma unroll
    for (int i = 0; i < 8; ++i) { const int idx = c.tid + i * 512, kk = idx >> 6, nn = idx & 63; t[kk * 65 + nn] = (n0 + nn < N) ? src[(size_t)(k0 + kk) * N + n0 + nn] : 0.f; }
    __syncthreads();
#pragma unroll
    for (int i = 0; i < 4; ++i) { const int idx = c.tid + i * 512, nn = idx >> 5, kp = (idx & 31) * 2;
      if (n0 + nn < N) *(unsigned*)(dst + (size_t)((n0 + nn) * rs + ro) * 1024 + k0 + kp) = pk2(t[kp * 65 + nn], t[(kp + 1) * 65 + nn]); }
  }
  __syncthreads();
}
__device__ __forceinline__ void p0_prologue(unsigned char* lds_, int wv, const Params& p) {
  const Ctx c = make_ctx(lds_, wv);
  unsigned char* ws = p.ws;
  if (c.bid == 0) { ((unsigned*)(ws + WS_CTL))[64 + c.tid] = 0u; }
  if (c.bid == 0) { for (int i = c.tid; i < 3456; i += NTHREADS) ((unsigned*)(ws + WS_CTL))[2048 + i] = 0u; }
  { const float* x = p.in[I_X]; bf16_t* hb = (bf16_t*)p.out;
    for (size_t i = (size_t)c.bid * NTHREADS + c.tid; i < (size_t)NTOK * 1024 / 8; i += (size_t)c.G * NTHREADS) {
      const f32x4 a = __builtin_nontemporal_load((const f32x4*)(x + i * 8)), b = __builtin_nontemporal_load((const f32x4*)(x + i * 8 + 4));
      u32x4 w; w.x = pk2(a[0], a[1]); w.y = pk2(a[2], a[3]); w.z = pk2(b[0], b[1]); w.w = pk2(b[2], b[3]);
      *(u32x4*)(hb + i * 8) = w; } }
  transpose_job(c, p.in[I_AB_W_IN], P_AB, (bf16_t*)(ws + WS_WIN_AB), 1, 0, c.bid, c.G);
  transpose_job(c, p.in[I_CD_W_IN], P_CD, (bf16_t*)(ws + WS_WIN_CD), 1, 0, c.bid, c.G);
  transpose_job(c, p.in[I_AB_W_OUT], 1024, (bf16_t*)(ws + WS_WOUT_AB), 1, 0, c.bid, c.G);
  transpose_job(c, p.in[I_CD_W_OUT], 1024, (bf16_t*)(ws + WS_WOUT_CD), 1, 0, c.bid, c.G);
  { float* rope = (float*)(ws + WS_ROPE);
    for (int i = c.bid * NTHREADS + c.tid; i < SEQ * 32; i += c.G * NTHREADS) { const int t = i >> 5, f = i & 31;
      const float freq = powf(10000.0f, -(float)f / 32.0f); const float ang = (float)t * freq; rope[i * 2] = cosf(ang); rope[i * 2 + 1] = sinf(ang); }
    if (c.bid == 1) { const float* hl = p.in[I_HGRN_LB]; float* lb = (float*)(ws + WS_LB);
      const int cc = c.tid; const float a0 = hl[cc], a1 = hl[512 + cc], a2 = hl[1024 + cc]; const float mx = fmaxf(a0, fmaxf(a1, a2));
      const float e0 = expf(a0 - mx), e1 = expf(a1 - mx), e2 = expf(a2 - mx); lb[cc] = e0 / (e0 + e1 + e2); } }
}
__device__ __forceinline__ void moe_weight_convert(unsigned char* lds_, int wv, const Params& p, int layer, int part, int bidx, int nblk) {
  const Ctx c = make_ctx(lds_, wv);
  bf16_t* w13 = (bf16_t*)(p.ws + WS_W13); bf16_t* w2 = (bf16_t*)(p.ws + (p.big_ws ? WS_W2X : WS_W2));
  const size_t lo = (size_t)layer * NEXP * 1024 * 1024;
  const float* W1 = p.in[I_MOE_W1] + lo; const float* W3 = p.in[I_MOE_W3] + lo; const float* W2 = p.in[I_MOE_W2] + lo;
  float* t = (float*)c.lds;
  const int NT = (part == 0 ? 32 : 16) * 128;
  const int lk = c.tid >> 5, ln4 = (c.tid & 31) * 4;
  const int sn = c.tid & 127, sk = (c.tid >> 7) * 8;
  f32x4 r[4];
#define MW_SRC(g_) ((part == 0 ? ((((g_) >> 7) & 1) ? W3 : W1) + (size_t)((g_) >> 8) * 1048576 : W2 + (size_t)((g_) >> 7) * 1048576) + (size_t)((((g_) & 127) >> 3) * 64) * 1024 + ((g_) & 7) * 128)
#define MW_LOAD(g_) do { const float* s_ = MW_SRC(g_); _Pragma("unroll") for (int i = 0; i < 4; ++i) r[i] = __builtin_nontemporal_load((const f32x4*)(s_ + (size_t)(lk + 16 * i) * 1024 + ln4)); } while (0)
  int g0 = bidx;
  if (g0 < NT) MW_LOAD(g0);
  for (; g0 < NT; g0 += nblk) {
    __syncthreads();
#pragma unroll
    for (int i = 0; i < 4; ++i) { float* d = t + (lk + 16 * i) * 129 + ln4; d[0] = r[i][0]; d[1] = r[i][1]; d[2] = r[i][2]; d[3] = r[i][3]; }
    __syncthreads();
    const int gn = g0 + nblk;
    if (gn < NT) MW_LOAD(gn);
    const int m = g0 >> 7, k0 = ((g0 & 127) >> 3) * 64, n0 = (g0 & 7) * 128;
    bf16_t* drow = (part == 1) ? w2 + ((size_t)m * 1024 + n0 + sn) * 1024 : w13 + ((size_t)(m >> 1) * 2048 + 2 * (n0 + sn) + (m & 1)) * 1024;
#pragma unroll
    for (int j = 0; j < 2; ++j) { const int kk = sk + 32 * j; const float* s = t + kk * 129 + sn;
      u32x4 w; w.x = pk2(s[0], s[129]); w.y = pk2(s[2 * 129], s[3 * 129]); w.z = pk2(s[4 * 129], s[5 * 129]); w.w = pk2(s[6 * 129], s[7 * 129]);
      *(u32x4*)(drow + k0 + kk) = w; }
  }
#undef MW_SRC
#undef MW_LOAD
  __syncthreads();
}

struct ProbInProj {
  static constexpr bool PERM = true;
  pg8::StaticOrder so; const char* A; const char* Bt; bf16_t* P; const float* bias; const float* lb; int layer;
  __device__ __forceinline__ bool next(int i, pg8::Unit& u) const { return so.next(i, u); }
  __device__ __forceinline__ const char* a_base() const { return A; }
  __device__ __forceinline__ unsigned a_off(const pg8::Unit& u, int r) const { return (unsigned)(u.pm * 256 + r) * 2048u; }
  __device__ __forceinline__ const char* b_base(const pg8::Unit& u) const { return Bt + (size_t)u.pn * 256 * 2048; }
  __device__ __forceinline__ void epi(const f32x4 (&acc)[2][2][4][2], const pg8::Unit& u, int wr, int wc, int fr, int fq) const {
    const int row0 = u.row0 + wr * 64 + fr, colb = u.pn * 256 + wc * 32 + 8 * fq;
    int mode = 0;
    if (layer == 0) { mode = u.pn < 2 ? 1 : (u.pn < 6 ? 2 : (u.pn == 10 ? 3 : 0)); }
#pragma unroll
    for (int bj = 0; bj < 2; ++bj) {
      const int col0 = colb + bj * 128;
      const f32x4 b0 = *(const f32x4*)(bias + col0), b1 = *(const f32x4*)(bias + col0 + 4);
      f32x4 l0 = (f32x4){0.f, 0.f, 0.f, 0.f}, l1 = l0;
      if (mode == 2) { l0 = *(const f32x4*)(lb + ((col0 - 512) & 511)); l1 = *(const f32x4*)(lb + ((col0 - 512) & 511) + 4); }
#pragma unroll
      for (int ai = 0; ai < 2; ++ai)
#pragma unroll
        for (int m = 0; m < 4; ++m) {
          f32x4 v0 = acc[ai][bj][m][0] + b0, v1 = acc[ai][bj][m][1] + b1;
          if (mode == 1) {
#pragma unroll
            for (int j = 0; j < 4; ++j) { v0[j] = fsilu(v0[j]); v1[j] = fsilu(v1[j]); }
          } else if (mode == 2) {
#pragma unroll
            for (int j = 0; j < 4; ++j) { v0[j] = __builtin_amdgcn_logf(l0[j] + (1.0f - l0[j]) * fsigmoid(v0[j])); v1[j] = __builtin_amdgcn_logf(l1[j] + (1.0f - l1[j]) * fsigmoid(v1[j])); }
          } else if (mode == 3) { v0 *= 0.125f; v1 *= 0.125f; }
          u32x4 w; w.x = pk2(v0[0], v0[1]); w.y = pk2(v0[2], v0[3]); w.z = pk2(v1[0], v1[1]); w.w = pk2(v1[2], v1[3]);
          *(u32x4*)(P + PIDX(row0 + ai * 128 + m * 16, col0)) = w;
        }
    }
  }
};
struct ProbOutProj {
  static constexpr bool PERM = true;
  pg8::StaticOrder so; const char* A; const char* Bt; bf16_t* Y; const bf16_t* Hres;
  __device__ __forceinline__ bool next(int i, pg8::Unit& u) const { return so.next(i, u); }
  __device__ __forceinline__ const char* a_base() const { return A; }
  __device__ __forceinline__ unsigned a_off(const pg8::Unit& u, int r) const { return (unsigned)(u.pm * 256 + r) * 2048u; }
  __device__ __forceinline__ const char* b_base(const pg8::Unit& u) const { return Bt + (size_t)u.pn * 256 * 2048; }
  __device__ __forceinline__ void epi(const f32x4 (&acc)[2][2][4][2], const pg8::Unit& u, int wr, int wc, int fr, int fq) const {
    const int row0 = u.row0 + wr * 64 + fr, colb = u.pn * 256 + wc * 32 + 8 * fq;
#pragma unroll
    for (int ai = 0; ai < 2; ++ai)
#pragma unroll
      for (int m = 0; m < 4; ++m) {
        const size_t ro = (size_t)(row0 + ai * 128 + m * 16) * 1024 + colb;
        const u32x4 h0 = *(const u32x4*)(Hres + ro), h1 = *(const u32x4*)(Hres + ro + 128);
#pragma unroll
        for (int bj = 0; bj < 2; ++bj) {
          float hf[8]; unpack8(bj ? h1 : h0, hf);
          const f32x4 v0 = acc[ai][bj][m][0], v1 = acc[ai][bj][m][1];
          u32x4 w; w.x = pk2(v0[0] + ALPHA_F * hf[0], v0[1] + ALPHA_F * hf[1]); w.y = pk2(v0[2] + ALPHA_F * hf[2], v0[3] + ALPHA_F * hf[3]);
          w.z = pk2(v1[0] + ALPHA_F * hf[4], v1[1] + ALPHA_F * hf[5]); w.w = pk2(v1[2] + ALPHA_F * hf[6], v1[3] + ALPHA_F * hf[7]);
          *(u32x4*)(Y + ro + bj * 128) = w;
        }
      }
  }
};
#define MOE_TAB_OFF (128 * 1024)
struct MoeOrder {
  const int* tab;
  __device__ __forceinline__ void init(const int* cnt, int ntn, int G, int c, unsigned char* lds, int wv) {
    int* t = (int*)(lds + MOE_TAB_OFF);
    const int tid = opaque_tid(wv);
    if (tid < 64) {
      int pad = 0, found = 0, ue = 0, upn = 0, upm = 0, urow = 0, une = 0;
      if ((G & 7) == 0) {
        const int x = c & 7; int q = tid * (G >> 3) + (c >> 3);
        for (int e = 0; e < NEXP; ++e) { const int n = cnt[e * 16], mt = (n + 255) >> 8; const int r = ((x - e) % 8 + 8) % 8; const int m = mt > r ? (mt - r - 1) / 8 + 1 : 0; const int units = m * ntn;
          if (!found && q < units) { ue = e; upm = r + 8 * (q % m); upn = q / m; urow = pad + upm * 256; une = n; found = 1; }
          if (!found) { q -= units; pad += mt * 256; } }
      } else {
        int L = tid * G + c;
        for (int e = 0; e < NEXP; ++e) { const int n = cnt[e * 16], mt = (n + 255) >> 8, tiles = mt * ntn;
          if (!found && L < tiles) { ue = e; upn = L / mt; upm = L % mt; urow = pad + upm * 256; une = n; found = 1; }
          if (!found) { L -= tiles; pad += mt * 256; } }
      }
      t[tid * 8 + 0] = found; t[tid * 8 + 1] = ue; t[tid * 8 + 2] = upn; t[tid * 8 + 3] = upm; t[tid * 8 + 4] = urow; t[tid * 8 + 5] = une;
    }
    __syncthreads();
    tab = t;
  }
  __device__ __forceinline__ bool next(int i, pg8::Unit& u) const {
    if (i >= 64) return false;
    const int* t = tab + i * 8;
    if (!__builtin_amdgcn_readfirstlane(t[0])) return false;
    u.e = __builtin_amdgcn_readfirstlane(t[1]); u.pn = __builtin_amdgcn_readfirstlane(t[2]); u.pm = __builtin_amdgcn_readfirstlane(t[3]);
    u.row0 = __builtin_amdgcn_readfirstlane(t[4]); u.ne = __builtin_amdgcn_readfirstlane(t[5]); u.ui = i; return true;
  }
};
struct ProbMoe1 {
  static constexpr bool PERM = true;
  MoeOrder mo; const char* A; const char* W13; const int* list; bf16_t* H; const int* ltok;
  __device__ __forceinline__ void stage_tokens(unsigned char* lds, int wv) {
    int* lt = (int*)(lds + MOE_TAB_OFF + 2048);
    const int tid = opaque_tid(wv);
    pg8::Unit u;
    for (int i = 0; i < 16 && mo.next(i, u); ++i) { if (tid < 256) { const int rr = u.pm * 256 + tid; lt[i * 256 + tid] = rr < u.ne ? list[u.e * NTOK + rr] : 0; } }
    __syncthreads();
    ltok = lt;
  }
  __device__ __forceinline__ bool next(int i, pg8::Unit& u) const { return mo.next(i, u); }
  __device__ __forceinline__ const char* a_base() const { return A; }
  __device__ __forceinline__ unsigned a_off(const pg8::Unit& u, int r) const { const int rr = u.pm * 256 + r; const int tok = rr < u.ne ? list[u.e * NTOK + rr] : 0; return (unsigned)tok * 2048u; }
  __device__ __forceinline__ const char* b_base(const pg8::Unit& u) const { return W13 + ((size_t)u.e * 2048 + (size_t)u.pn * 256) * 2048; }
  __device__ __forceinline__ void epi(const f32x4 (&acc)[2][2][4][2], const pg8::Unit& u, int wr, int wc, int fr, int fq) const {
    const int row0 = u.row0 + wr * 64 + fr, colb = u.pn * 128 + wc * 16 + 4 * fq;
#pragma unroll
    for (int ai = 0; ai < 2; ++ai)
#pragma unroll
      for (int m = 0; m < 4; ++m)
#pragma unroll
        for (int bj = 0; bj < 2; ++bj) {
          const f32x4 v0 = acc[ai][bj][m][0], v1 = acc[ai][bj][m][1];
          u32x2 w; w.x = pk2(fsilu(v0[0]) * v0[1], fsilu(v0[2]) * v0[3]); w.y = pk2(fsilu(v1[0]) * v1[1], fsilu(v1[2]) * v1[3]);
          *(u32x2*)(H + (size_t)(row0 + ai * 128 + m * 16) * 1024 + colb + bj * 64) = w;
        }
  }
};
struct ProbMoe2 {
  static constexpr bool PERM = true;
  MoeOrder mo; const char* A; const char* W2; bf16_t* Y;
  __device__ __forceinline__ bool next(int i, pg8::Unit& u) const { return mo.next(i, u); }
  __device__ __forceinline__ const char* a_base() const { return A; }
  __device__ __forceinline__ unsigned a_off(const pg8::Unit& u, int r) const { return (unsigned)(u.row0 + r) * 2048u; }
  __device__ __forceinline__ const char* b_base(const pg8::Unit& u) const { return W2 + ((size_t)u.e * 1024 + (size_t)u.pn * 256) * 2048; }
  __device__ __forceinline__ void epi(const f32x4 (&acc)[2][2][4][2], const pg8::Unit& u, int wr, int wc, int fr, int fq) const {
    const int row0 = u.row0 + wr * 64 + fr, colb = u.pn * 256 + wc * 32 + 8 * fq;
#pragma unroll
    for (int ai = 0; ai < 2; ++ai)
#pragma unroll
      for (int m = 0; m < 4; ++m)
#pragma unroll
        for (int bj = 0; bj < 2; ++bj) {
          const f32x4 v0 = acc[ai][bj][m][0], v1 = acc[ai][bj][m][1];
          u32x4 w; w.x = pk2(v0[0], v0[1]); w.y = pk2(v0[2], v0[3]); w.z = pk2(v1[0], v1[1]); w.w = pk2(v1[2], v1[3]);
          *(u32x4*)(Y + (size_t)(row0 + ai * 128 + m * 16) * 1024 + colb + bj * 128) = w;
        }
  }
};

template <int NS>
__device__ __forceinline__ void side_phase(unsigned char* lds_, int wv, const Params& p, int layer) {
  const Ctx c = make_ctx(lds_, wv);
  const bf16_t* hb = (const bf16_t*)p.out;
  const bf16_t* wt = (const bf16_t*)(p.ws + (layer == 0 ? WS_WIN_AB : WS_WIN_CD)) + (size_t)(layer == 0 ? PM_AB : PM_CD) * 1024;
  const float* bias = p.in[layer == 0 ? I_AB_B_IN : I_CD_B_IN] + (layer == 0 ? PM_AB : PM_CD);
  float* side = (float*)(p.ws + WS_SIDE);
  float* tl = (float*)c.lds + c.wid * (16 * 33);
  const int fr = c.lane & 15, fq = c.lane >> 4;
  for (int g = c.bid * 8 + c.wid; g < NTOK / 16; g += c.G * 8) {
    const int r0 = g * 16;
    f32x4 acc0 = (f32x4){0.f, 0.f, 0.f, 0.f}, acc1 = acc0;
    const bf16_t* ap = hb + (size_t)(r0 + fr) * 1024 + fq * 8;
    const bf16_t* bp0 = wt + (size_t)fr * 1024 + fq * 8; const bf16_t* bp1 = bp0 + 16 * 1024;
#pragma unroll 16
    for (int k = 0; k < 1024; k += 32) {
      const bf16x8 a = *(const bf16x8*)(ap + k), b0 = *(const bf16x8*)(bp0 + k);
      acc0 = __builtin_amdgcn_mfma_f32_16x16x32_bf16(a, b0, acc0, 0, 0, 0);
      if (NS == 32) { const bf16x8 b1 = *(const bf16x8*)(bp1 + k); acc1 = __builtin_amdgcn_mfma_f32_16x16x32_bf16(a, b1, acc1, 0, 0, 0); }
    }
    float gsc = 1.f, gfb = 0.f; bool gls = false;
    if (NS == 16) { gsc = 1.4426950408889634f; gls = (fr & 4) != 0; gfb = gls ? p.in[I_FGATE_B][(fr >> 3) * 4 + (fr & 3)] : 0.f; }
#pragma unroll
    for (int j = 0; j < 4; ++j) { float v0 = acc0[j] + bias[fr]; if (NS == 16) v0 = gls ? flog2sigmoid(v0 + gfb) : v0 * gsc; side[(size_t)(r0 + fq * 4 + j) * 32 + fr] = v0; tl[(fq * 4 + j) * 33 + fr] = v0;
      if (NS == 32) { const float v1 = acc1[j] + bias[16 + fr]; side[(size_t)(r0 + fq * 4 + j) * 32 + 16 + fr] = v1; tl[(fq * 4 + j) * 33 + 16 + fr] = v1; } }
    if (NS == 32) {
      __builtin_amdgcn_s_waitcnt(0xC07F);
      const float* gu = p.in[I_GK_UP]; const float* gb = p.in[I_GK_B]; bf16_t* lfb = (bf16_t*)(p.ws + WS_LFB);
      const int cb = c.lane * 8, dir = cb >> 8, cc = cb & 255;
      float w[16][8];
#pragma unroll
      for (int r = 0; r < 16; ++r)
#pragma unroll
        for (int j = 0; j < 8; ++j) w[r][j] = gu[(dir * 16 + r) * 256 + cc + j];
      float bb[8];
#pragma unroll
      for (int j = 0; j < 8; ++j) bb[j] = gb[dir * 256 + cc + j];
      for (int row = 0; row < 16; ++row) {
        float z[8];
#pragma unroll
        for (int j = 0; j < 8; ++j) z[j] = bb[j];
#pragma unroll
        for (int r = 0; r < 16; ++r) { const float s = tl[row * 33 + dir * 16 + r];
#pragma unroll
          for (int j = 0; j < 8; ++j) z[j] += s * w[r][j]; }
        u32x4 o; o.x = pk2(flog2sigmoid(z[0]) * 0.0625f, flog2sigmoid(z[1]) * 0.0625f); o.y = pk2(flog2sigmoid(z[2]) * 0.0625f, flog2sigmoid(z[3]) * 0.0625f);
        o.z = pk2(flog2sigmoid(z[4]) * 0.0625f, flog2sigmoid(z[5]) * 0.0625f); o.w = pk2(flog2sigmoid(z[6]) * 0.0625f, flog2sigmoid(z[7]) * 0.0625f);
        *(u32x4*)(lfb + PIDX(r0 + row, cb)) = o;
      }
    }
  }
}

__device__ __forceinline__ void headnorm_phase(unsigned char* lds_, int wv, const Params& p, int layer) {
  const Ctx c = make_ctx(lds_, wv);
  const bf16_t* P = (const bf16_t*)(p.ws + WS_R1); const bf16_t* O = (const bf16_t*)(p.ws + WS_R2);
  bf16_t* mixed = (bf16_t*)(p.ws + WS_MIX);
  const int c0 = c.lane * 16, h8 = c.lane >> 3;
  const float* gain = layer == 0 ? (h8 < 4 ? p.in[I_HGRN_NORM] + c0 : p.in[I_GLA_NORM] + c0 - 512) : (h8 < 4 ? p.in[I_RET_NORM] + c0 : p.in[I_MLSTM_NORM] + c0 - 512);
  const int gcol = layer == 0 ? (h8 < 4 ? 2048 + c0 : 3584 + c0 - 512) : (h8 < 4 ? 1024 + c0 : 3072 + c0 - 512);
  float gn[16];
#pragma unroll
  for (int j = 0; j < 16; ++j) gn[j] = gain[j];
  const int tstride = c.G * 8;
  for (int tok0 = c.bid * 8 + c.wid; tok0 < NTOK; tok0 += 2 * tstride) {
    u32x4 ra[2][2], rb[2][2], rg[2][2];
#pragma unroll
    for (int u = 0; u < 2; ++u) { const int tok = tok0 + u * tstride < NTOK ? tok0 + u * tstride : tok0;
      const u32x4* a = (const u32x4*)(O + PIDX(tok, c0)); const u32x4* b = (const u32x4*)(O + (size_t)NTOK * 1024 + PIDX(tok, c0)); const u32x4* g = (const u32x4*)(P + PIDX(tok, gcol));
      ra[u][0] = __builtin_nontemporal_load(a); ra[u][1] = __builtin_nontemporal_load(a + 1); rb[u][0] = __builtin_nontemporal_load(b); rb[u][1] = __builtin_nontemporal_load(b + 1);
      rg[u][0] = __builtin_nontemporal_load(g); rg[u][1] = __builtin_nontemporal_load(g + 1); }
#pragma unroll
    for (int u = 0; u < 2; ++u) {
      const int tok = tok0 + u * tstride;
      float of[16], ob[16], gt[16];
      unpack8(ra[u][0], of); unpack8(ra[u][1], of + 8); unpack8(rb[u][0], ob); unpack8(rb[u][1], ob + 8); unpack8(rg[u][0], gt); unpack8(rg[u][1], gt + 8);
      float o[16]; float ss = 0.f;
#pragma unroll
      for (int j = 0; j < 16; ++j) { o[j] = of[j] + ob[j]; ss += o[j] * o[j]; }
      ss += __shfl_xor(ss, 1); ss += __shfl_xor(ss, 2); ss += __shfl_xor(ss, 4);
      const float r = 1.0f / sqrtf(ss * (1.0f / 128.0f) + NORM_EPS_F);
      unsigned w[8];
#pragma unroll
      for (int j = 0; j < 8; ++j) {
        float g0 = gt[2 * j], g1 = gt[2 * j + 1];
        if (layer == 1 && h8 >= 4) { g0 = fsigmoid(g0); g1 = fsigmoid(g1); } else { g0 = fsilu(g0); g1 = fsilu(g1); }
        w[j] = pk2(o[2 * j] * r * gn[2 * j] * g0, o[2 * j + 1] * r * gn[2 * j + 1] * g1);
      }
      if (tok < NTOK) { u32x4* d = (u32x4*)(mixed + (size_t)tok * 1024 + c0);
        d[0] = (u32x4){w[0], w[1], w[2], w[3]}; d[1] = (u32x4){w[4], w[5], w[6], w[7]}; }
    }
  }
}

__device__ __forceinline__ void ln_phase(unsigned char* lds_, int wv, const Params& p, int layer, int mode, int dry = 0) {
  const Ctx c = make_ctx(lds_, wv);
  unsigned char* ws = p.ws;
  const bf16_t* zin = (const bf16_t*)(ws + (mode == 0 ? WS_R2 : WS_MIX));
  const bool f32out = (mode == 1 && layer == 1);
  float* hout = dry ? (float*)(ws + WS_H) : p.out;
  bf16_t* hb = dry ? (bf16_t*)(ws + WS_H) : (mode == 0 ? (bf16_t*)(ws + WS_MIX) : (bf16_t*)p.out);
  const float* g = p.in[mode == 0 ? I_LN_MIX_G : I_LN_FFN_G] + layer * 1024; const float* b = p.in[mode == 0 ? I_LN_MIX_B : I_LN_FFN_B] + layer * 1024;
  unsigned* cnt = (unsigned*)(ws + WS_CTL) + CW_CNT(layer);
  int* list = (int*)(ws + WS_LIST) + (size_t)layer * NEXP * NTOK;
  int* assign = (int*)(ws + WS_ASSIGN); float* gate = (float*)(ws + WS_GATE);
  float* rwT = (float*)c.lds;
  int* lcnt = (int*)(c.lds + 65536); int* lbase = lcnt + 16; int* rec = lcnt + 32; float* recg = (float*)(rec + 4 * 2048);
  int pad[NEXP];
  if (mode == 0) { const float* r = p.in[I_ROUTER_W];
    for (int i = c.tid; i < 1024 * 16; i += NTHREADS) rwT[(i & 15) * 1024 + (i >> 4)] = r[i];
    if (c.tid < 16) lcnt[c.tid] = 0;
    __syncthreads(); }
  else { int acc = 0;
#pragma unroll
    for (int e = 0; e < NEXP; ++e) { pad[e] = acc; acc += (((int)cnt[e * 16] + 255) >> 8) << 8; } }
  const int c0 = c.lane * 4;
  float gv[16], bv[16];
#pragma unroll
  for (int q = 0; q < 4; ++q) { const f32x4 t0 = *(const f32x4*)(g + q * 256 + c0), t1 = *(const f32x4*)(b + q * 256 + c0);
#pragma unroll
    for (int j = 0; j < 4; ++j) { gv[4 * q + j] = t0[j]; bv[4 * q + j] = t1[j]; } }
  const int tstride = c.G * 8;
  int it = 0;
  for (int tok0 = c.bid * 8 + c.wid; tok0 < NTOK; tok0 += 2 * tstride, it += 2) {
    float v[2][16];
    float gy0[2], gy1[2];
#pragma unroll
    for (int u = 0; u < 2; ++u) {
      const int tok = tok0 + u * tstride;
      if (tok < NTOK) {
        const float sc = mode == 0 ? 1.0f : ALPHA_F;
#pragma unroll
        for (int q = 0; q < 4; ++q) { const u32x2 t = __builtin_nontemporal_load((const u32x2*)(zin + (size_t)tok * 1024 + q * 256 + c0));
          v[u][4 * q] = sc * __uint_as_float(t.x << 16); v[u][4 * q + 1] = sc * __uint_as_float(t.x & 0xffff0000u); v[u][4 * q + 2] = sc * __uint_as_float(t.y << 16); v[u][4 * q + 3] = sc * __uint_as_float(t.y & 0xffff0000u); }
        if (mode == 1) {
          const int a0 = assign[tok * 4], a1 = assign[tok * 4 + 1], a2 = assign[tok * 4 + 2], a3 = assign[tok * 4 + 3];
          gy0[u] = gate[tok * 2]; gy1[u] = gate[tok * 2 + 1];
          int p0 = 0, p1 = 0;
#pragma unroll
          for (int e = 0; e < NEXP; ++e) { if (e == a0) p0 = pad[e]; if (e == a2) p1 = pad[e]; }
          p0 += a1; p1 += a3;
          const bf16_t* Y = (const bf16_t*)(ws + WS_R2);
#pragma unroll
          for (int q = 0; q < 4; ++q) { const u32x2 y0 = __builtin_nontemporal_load((const u32x2*)(Y + (size_t)p0 * 1024 + q * 256 + c0)), y1 = __builtin_nontemporal_load((const u32x2*)(Y + (size_t)p1 * 1024 + q * 256 + c0));
            v[u][4 * q] += gy0[u] * __uint_as_float(y0.x << 16) + gy1[u] * __uint_as_float(y1.x << 16); v[u][4 * q + 1] += gy0[u] * __uint_as_float(y0.x & 0xffff0000u) + gy1[u] * __uint_as_float(y1.x & 0xffff0000u);
            v[u][4 * q + 2] += gy0[u] * __uint_as_float(y0.y << 16) + gy1[u] * __uint_as_float(y1.y << 16); v[u][4 * q + 3] += gy0[u] * __uint_as_float(y0.y & 0xffff0000u) + gy1[u] * __uint_as_float(y1.y & 0xffff0000u); }
        }
      } else {
#pragma unroll
        for (int j = 0; j < 16; ++j) v[u][j] = 0.f;
      }
    }
#pragma unroll
    for (int u = 0; u < 2; ++u) {
      const int tok = tok0 + u * tstride;
      float s = 0.f;
#pragma unroll
      for (int j = 0; j < 16; ++j) s += v[u][j];
      const float mean = wave_sum(s) * (1.0f / 1024.0f);
      float qq = 0.f;
#pragma unroll
      for (int j = 0; j < 16; ++j) { v[u][j] -= mean; qq += v[u][j] * v[u][j]; }
      const float r = 1.0f / sqrtf(wave_sum(qq) * (1.0f / 1024.0f) + LN_EPS_F);
#pragma unroll
      for (int j = 0; j < 16; ++j) v[u][j] = v[u][j] * r * gv[j] + bv[j];
      if (tok < NTOK) {
        if (f32out) {
#pragma unroll
          for (int q = 0; q < 4; ++q) __builtin_nontemporal_store((f32x4){v[u][4 * q], v[u][4 * q + 1], v[u][4 * q + 2], v[u][4 * q + 3]}, (f32x4*)(hout + (size_t)tok * 1024 + q * 256 + c0));
        } else {
#pragma unroll
          for (int q = 0; q < 4; ++q) *(u32x2*)(hb + (size_t)tok * 1024 + q * 256 + c0) = (u32x2){pk2(v[u][4 * q], v[u][4 * q + 1]), pk2(v[u][4 * q + 2], v[u][4 * q + 3])}; }
      }
      if (mode == 0) {
        float lg[16];
#pragma unroll
        for (int e = 0; e < 16; ++e) { float a = 0.f;
#pragma unroll
          for (int q = 0; q < 4; ++q) { const f32x4 w = *(const f32x4*)(rwT + e * 1024 + q * 256 + c0); a += v[u][4 * q] * w[0] + v[u][4 * q + 1] * w[1] + v[u][4 * q + 2] * w[2] + v[u][4 * q + 3] * w[3]; }
          lg[e] = a; }
#pragma unroll
        for (int e = 0; e < 16; ++e) lg[e] = wave_sum(lg[e]);
        int eo[2]; float go[2];
        route_from_logits(lg, p.in[I_ROUTER_B], eo, go);
        if (c.lane == 0 && tok < NTOK && !dry) {
          const int r1 = atomicAdd(lcnt + eo[0], 1), r2 = atomicAdd(lcnt + eo[1], 1);
          const int ri = (it + u) * 8 + c.wid;
          rec[ri * 4] = eo[0]; rec[ri * 4 + 1] = r1; rec[ri * 4 + 2] = eo[1]; rec[ri * 4 + 3] = r2; recg[ri * 2] = go[0]; recg[ri * 2 + 1] = go[1];
        }
      }
    }
  }
  if (mode == 0 && !dry) {
    __syncthreads();
    if (c.tid < 16) lbase[c.tid] = (int)atomicAdd(cnt + c.tid * 16, (unsigned)lcnt[c.tid]);
    __syncthreads();
    const int nrec = ((NTOK + c.G * 8 - 1) / (c.G * 8)) * 8;
    for (int ri = c.tid; ri < nrec; ri += NTHREADS) {
      const int tok = c.bid * 8 + (ri & 7) + (ri >> 3) * c.G * 8;
      if (tok < NTOK) {
        const int e1 = rec[ri * 4], e2 = rec[ri * 4 + 2]; const int r1 = rec[ri * 4 + 1] + lbase[e1], r2 = rec[ri * 4 + 3] + lbase[e2];
        list[e1 * NTOK + r1] = tok; list[e2 * NTOK + r2] = tok;
        assign[tok * 4] = e1; assign[tok * 4 + 1] = r1; assign[tok * 4 + 2] = e2; assign[tok * 4 + 3] = r2;
        gate[tok * 2] = recg[ri * 2]; gate[tok * 2 + 1] = recg[ri * 2 + 1];
      }
    }
  }
  __syncthreads();
}
#endif
#ifndef CPU_EMU
namespace scan {
typedef short bf16x8 __attribute__((ext_vector_type(8)));
typedef float f32x4 __attribute__((ext_vector_type(4)));
typedef unsigned u32x4 __attribute__((ext_vector_type(4)));
typedef unsigned u32x2 __attribute__((ext_vector_type(2)));
enum { MIX_A = 0, MIX_B = 1, MIX_C = 2, MIX_D = 3 };
constexpr int LD_T = 144;
constexpr int OFF_QS = 0, OFF_KS = 17408, OFF_QI = 34816, OFF_KT = 52224, OFF_VT = 70656, OFF_SC = 77568, OFF_ST = 86784, OFF_DEC = 99840, OFF_EM = 100352, OFF_DEN = 100608, OFF_CW = 100864, SCAN_LDS = 104960;

__device__ __forceinline__ float incl_scan_add(float x) {
  x += __builtin_bit_cast(float, __builtin_amdgcn_update_dpp(0, __builtin_bit_cast(int, x), 0x111, 0xf, 0xf, false));
  x += __builtin_bit_cast(float, __builtin_amdgcn_update_dpp(0, __builtin_bit_cast(int, x), 0x112, 0xf, 0xf, false));
  x += __builtin_bit_cast(float, __builtin_amdgcn_update_dpp(0, __builtin_bit_cast(int, x), 0x114, 0xf, 0xf, false));
  x += __builtin_bit_cast(float, __builtin_amdgcn_update_dpp(0, __builtin_bit_cast(int, x), 0x118, 0xf, 0xf, false));
  x += __builtin_bit_cast(float, __builtin_amdgcn_update_dpp(0, __builtin_bit_cast(int, x), 0x142, 0xa, 0xf, false));
  x += __builtin_bit_cast(float, __builtin_amdgcn_update_dpp(0, __builtin_bit_cast(int, x), 0x143, 0xc, 0xf, false));
  return x;
}
__device__ __forceinline__ float incl_scan_max(float x) {
  const int ninf = (int)0xff800000u;
  x = fmaxf(x, __builtin_bit_cast(float, __builtin_amdgcn_update_dpp(ninf, __builtin_bit_cast(int, x), 0x111, 0xf, 0xf, false)));
  x = fmaxf(x, __builtin_bit_cast(float, __builtin_amdgcn_update_dpp(ninf, __builtin_bit_cast(int, x), 0x112, 0xf, 0xf, false)));
  x = fmaxf(x, __builtin_bit_cast(float, __builtin_amdgcn_update_dpp(ninf, __builtin_bit_cast(int, x), 0x114, 0xf, 0xf, false)));
  x = fmaxf(x, __builtin_bit_cast(float, __builtin_amdgcn_update_dpp(ninf, __builtin_bit_cast(int, x), 0x118, 0xf, 0xf, false)));
  x = fmaxf(x, __builtin_bit_cast(float, __builtin_amdgcn_update_dpp(ninf, __builtin_bit_cast(int, x), 0x142, 0xa, 0xf, false)));
  x = fmaxf(x, __builtin_bit_cast(float, __builtin_amdgcn_update_dpp(ninf, __builtin_bit_cast(int, x), 0x143, 0xc, 0xf, false)));
  return x;
}
__device__ __forceinline__ float rdlane(float x, int l) { return __builtin_bit_cast(float, __builtin_amdgcn_readlane(__builtin_bit_cast(int, x), l)); }
__device__ __forceinline__ bf16x8 ldfrag(const unsigned char* base, int ld, int row, int kbyte) { return *(const bf16x8*)(base + row * ld + kbyte); }
__device__ __forceinline__ bf16x8 ldfrag2(const unsigned char* base, int ld, int row, int b0, int b1) {
  const u32x2 lo = *(const u32x2*)(base + row * ld + b0), hi = *(const u32x2*)(base + row * ld + b1);
  return __builtin_bit_cast(bf16x8, (u32x4){lo.x, lo.y, hi.x, hi.y}); }
__device__ __forceinline__ unsigned pk(float a, float b) { return pk_hw(a, b); }
__device__ __forceinline__ float lo16(unsigned w) { return __uint_as_float(w << 16); }
__device__ __forceinline__ float hi16(unsigned w) { return __uint_as_float(w & 0xffff0000u); }

__device__ __forceinline__ void lds_barrier() { asm volatile("s_waitcnt lgkmcnt(0)" ::: "memory"); __builtin_amdgcn_s_barrier(); asm volatile("" ::: "memory"); }
struct Raw { u32x4 a0, a1, b0, b1; f32x4 r0, r1; u32x2 v; float s0, s1; };

}

__device__ __forceinline__ void convd_phase(unsigned char* lds_, int wv, const Params& p) {
  const Ctx c = make_ctx(lds_, wv);
  bf16_t* P = (bf16_t*)(p.ws + WS_R1); bf16_t* QD = (bf16_t*)(p.ws + WS_LFB);
  const float* cw = p.in[I_CONV_W]; const float* cb = p.in[I_CONV_B];
  const int ch = c.lane * 16;
  float w0[16], w1[16], w2[16], bb[16];
#pragma unroll
  for (int j = 0; j < 16; ++j) { w0[j] = cw[ch + j]; w1[j] = cw[1024 + ch + j]; w2[j] = cw[2048 + ch + j]; bb[j] = cb[ch + j]; }
  for (int tok = c.bid * 8 + c.wid; tok < NTOK; tok += c.G * 8) {
    const int t = tok % SEQ;
    const bf16_t* row = P + PIDX(tok, 1536 + ch);
    float x0[16], x1[16], x2[16];
    { const u32x4* r1 = (const u32x4*)row; unpack8(r1[0], x1); unpack8(r1[1], x1 + 8); }
    if (t > 0) { const u32x4* r0 = (const u32x4*)(row - 128); unpack8(r0[0], x0); unpack8(r0[1], x0 + 8); }
    else {
#pragma unroll
      for (int j = 0; j < 16; ++j) x0[j] = 0.f; }
    if (t < SEQ - 1) { const u32x4* r2 = (const u32x4*)(row + 128); unpack8(r2[0], x2); unpack8(r2[1], x2 + 8); }
    else {
#pragma unroll
      for (int j = 0; j < 16; ++j) x2[j] = 0.f; }
    const float sc = ch < 512 ? 0.08838834764831845f : 1.0f;
    unsigned w[8];
#pragma unroll
    for (int j = 0; j < 8; ++j) {
      const float a0 = bb[2 * j] + w0[2 * j] * x0[2 * j] + w1[2 * j] * x1[2 * j] + w2[2 * j] * x2[2 * j];
      const float a1 = bb[2 * j + 1] + w0[2 * j + 1] * x0[2 * j + 1] + w1[2 * j + 1] * x1[2 * j + 1] + w2[2 * j + 1] * x2[2 * j + 1];
      w[j] = pk2(fsilu(a0) * sc, fsilu(a1) * sc);
    }
    u32x4* d = (ch < 512) ? (u32x4*)(QD + PIDX(tok, ch)) : (u32x4*)(P + PIDX(tok, 3584 + (ch - 512)));
    d[0] = (u32x4){w[0], w[1], w[2], w[3]}; d[1] = (u32x4){w[4], w[5], w[6], w[7]};
  }
}

#endif
#ifndef CPU_EMU
namespace scan2 {
using namespace scan;
#ifndef PROBE_ALLTILES
#define PROBE_ALLTILES 0
#endif
__device__ __forceinline__ float FMUL(float a, float b) { float r = a * b; asm("" : "+v"(r)); return r; }
constexpr int U_QI = 0, U_KS = 34816, U_VT = 69632, U_ST = 83456, U_DEC = 109568, U_EM = 110592, U_END = 111104;
typedef short s16x4 __attribute__((ext_vector_type(4)));
__device__ __forceinline__ bf16x8 ldfrag_tr(const unsigned char* p, int ld) {
  const s16x4 a = __builtin_amdgcn_ds_read_tr16_b64_v4i16((LAS s16x4*)p), b = __builtin_amdgcn_ds_read_tr16_b64_v4i16((LAS s16x4*)(p + 4 * ld));
  return (bf16x8){a.x, a.y, a.z, a.w, b.x, b.y, b.z, b.w}; }
template <int MIXER>
__device__ __forceinline__ void scan_item2(unsigned char* lds, int wv, const Params& p, int b, int h, int dir, int vs) {
  constexpr int DK = (MIXER == MIX_A || MIXER == MIX_D) ? 128 : 64;
  constexpr int NC = DK / 8;
  constexpr int LD_D = DK * 2 + 16;
  constexpr int NVT = MIXER == MIX_D ? 3 : 2;
  constexpr int NKD = DK / 32;
  constexpr int NST = (DK == 128) ? NVT : 1;
  constexpr int NCH = SEQ / 64;
  const int tid = opaque_tid(wv), lane0 = tid & 63, wid = __builtin_amdgcn_readfirstlane(tid >> 6);
  unsigned char* ws = p.ws;
  const bf16_t* P = (const bf16_t*)(ws + WS_R1);
  const bf16_t* LFBp = (const bf16_t*)(ws + WS_LFB);
  const float* side = (const float*)(ws + WS_SIDE);
  const float* rope = (const float*)(ws + WS_ROPE);
  bf16_t* O = (bf16_t*)(ws + WS_R2) + (size_t)dir * NTOK * 1024;
  int qcol, kcol, lfcol, vcol, ocol;
  if (MIXER == MIX_A) { qcol = h * 128; kcol = 0; lfcol = 512 + dir * 512 + h * 128; vcol = 1536 + h * 128 + vs * 32; ocol = h * 128 + vs * 32; }
  else if (MIXER == MIX_B) { qcol = 2560 + h * 64; kcol = 2816 + h * 64; lfcol = dir * 256 + h * 64; vcol = 3072 + h * 128 + vs * 32; ocol = 512 + h * 128 + vs * 32; }
  else if (MIXER == MIX_C) { qcol = h * 64; kcol = 256 + h * 64; lfcol = 0; vcol = 512 + h * 128 + vs * 32; ocol = h * 128 + vs * 32; }
  else { qcol = h * 128; kcol = 3584 + h * 128; lfcol = 0; vcol = 2560 + h * 128 + vs * 32; ocol = 512 + h * 128 + vs * 32; }
  const size_t tokbase = (size_t)b * SEQ;
  const int c0 = (MIXER == MIX_C) ? wid * 4 : wid * NC;
  for (int i = tid; i < 2 * 13056 / 4; i += NTHREADS) ((unsigned*)(lds + U_ST))[i] = 0u;

  if (MIXER == MIX_D) { for (int i = tid; i < 2 * 16 * 64; i += NTHREADS) { const int bf = i >> 10, r = 32 + ((i >> 6) & 15), j = i & 63; *(bf16_t*)(lds + U_VT + bf * 6912 + r * LD_T + j * 2) = (r == 32) ? (bf16_t)0x3F80 : (bf16_t)0; } }
  const float lgam2 = (MIXER == MIX_C) ? log1pf(-exp2f(-(5.0f + 2.0f * (float)h + (float)dir))) * 1.4426950408889634f : 0.f;
  const float fgb = (MIXER == MIX_D) ? p.in[I_FGATE_B][dir * 4 + h] : 0.f;
  float m_st = 0.f;
  __syncthreads();

  Raw R, Rn; u32x2 Rv, Rvn;
#define A_LOAD(R, Rv, n_) do { \
    const int ln_ = lane0; \
    const int t_ = dir ? (SEQ - 1 - ((n_) * 64 + ln_)) : ((n_) * 64 + ln_); \
    const size_t tk_ = tokbase + t_; \
    if (MIXER == MIX_A) { const u32x4* qp_ = (const u32x4*)(P + PIDX(tk_, qcol + c0)); const u32x4* lp_ = (const u32x4*)(P + PIDX(tk_, lfcol + c0)); R.a0 = qp_[0]; R.a1 = qp_[1]; R.b0 = lp_[0]; R.b1 = lp_[1]; } \
    else if (MIXER == MIX_B) { R.a0 = *(const u32x4*)(P + PIDX(tk_, qcol + c0)); R.a1 = *(const u32x4*)(P + PIDX(tk_, kcol + c0)); R.b0 = *(const u32x4*)(LFBp + PIDX(tk_, lfcol + c0)); } \
    else if (MIXER == MIX_C) { const u32x2 qa_ = *(const u32x2*)(P + PIDX(tk_, qcol + c0)), qb_ = *(const u32x2*)(P + PIDX(tk_, qcol + 32 + c0)), ka_ = *(const u32x2*)(P + PIDX(tk_, kcol + c0)), kb_ = *(const u32x2*)(P + PIDX(tk_, kcol + 32 + c0)); \
      R.a0 = (u32x4){qa_.x, qa_.y, qb_.x, qb_.y}; R.a1 = (u32x4){ka_.x, ka_.y, kb_.x, kb_.y}; \
      R.r0 = *(const f32x4*)(rope + ((size_t)t_ * 32 + c0) * 2); R.r1 = *(const f32x4*)(rope + ((size_t)t_ * 32 + c0) * 2 + 4); } \
    else { const u32x4* qp_ = (const u32x4*)(LFBp + PIDX(tk_, qcol + c0)); const u32x4* kp_ = (const u32x4*)(P + PIDX(tk_, kcol + c0)); R.a0 = qp_[0]; R.a1 = qp_[1]; R.b0 = kp_[0]; R.b1 = kp_[1]; \
      R.s0 = side[tk_ * 32 + dir * 8 + h]; R.s1 = side[tk_ * 32 + dir * 8 + 4 + h]; } \
    Rv = *(const u32x2*)(P + PIDX(tk_, vcol + wid * 4)); } while (0)

  float rr_next = 1.f, rr_cur = 1.f, dsold_next = 1.f, dsold_cur = 1.f, ws_next = 1.f, ws_cur = 1.f;
#define A_PREP(buf_, R, Rv) do { \
    const int lane = lane0; \
    float* DECb = (float*)(lds + U_DEC + (buf_) * 512); float* EMb = (float*)(lds + U_EM + (buf_) * 256); \
    unsigned char* QIb = lds + U_QI + (buf_) * 17408; unsigned char* KSb = lds + U_KS + (buf_) * 17408; \
    float q[NC], k[NC], g[NC]; \
    if (MIXER == MIX_A) { \
      const unsigned qw[8] = {R.a0.x, R.a0.y, R.a0.z, R.a0.w, R.a1.x, R.a1.y, R.a1.z, R.a1.w}, lw[8] = {R.b0.x, R.b0.y, R.b0.z, R.b0.w, R.b1.x, R.b1.y, R.b1.z, R.b1.w}; \
      _Pragma("unroll") for (int c = 0; c < 8; ++c) { q[2 * c] = lo16(qw[c]); q[2 * c + 1] = hi16(qw[c]); g[2 * c] = lo16(lw[c]); g[2 * c + 1] = hi16(lw[c]); } \
      _Pragma("unroll") for (int c = 0; c < NC; ++c) k[c] = 1.0f - __builtin_amdgcn_exp2f(g[c]); \
    } else if (MIXER == MIX_B) { \
      const unsigned qw[4] = {R.a0.x, R.a0.y, R.a0.z, R.a0.w}, kw[4] = {R.a1.x, R.a1.y, R.a1.z, R.a1.w}, lw[4] = {R.b0.x, R.b0.y, R.b0.z, R.b0.w}; \
      _Pragma("unroll") for (int c = 0; c < 4; ++c) { q[2 * c] = lo16(qw[c]); q[2 * c + 1] = hi16(qw[c]); k[2 * c] = lo16(kw[c]); k[2 * c + 1] = hi16(kw[c]); g[2 * c] = lo16(lw[c]); g[2 * c + 1] = hi16(lw[c]); } \
    } else if (MIXER == MIX_C) { \
      const float cs[4] = {R.r0[0], R.r0[2], R.r1[0], R.r1[2]}, sn[4] = {R.r0[1], R.r0[3], R.r1[1], R.r1[3]}; \
      const float q1[4] = {lo16(R.a0.x), hi16(R.a0.x), lo16(R.a0.y), hi16(R.a0.y)}, q2[4] = {lo16(R.a0.z), hi16(R.a0.z), lo16(R.a0.w), hi16(R.a0.w)}; \
      const float k1[4] = {lo16(R.a1.x), hi16(R.a1.x), lo16(R.a1.y), hi16(R.a1.y)}, k2[4] = {lo16(R.a1.z), hi16(R.a1.z), lo16(R.a1.w), hi16(R.a1.w)}; \
      _Pragma("unroll") for (int c = 0; c < 4; ++c) { q[c] = (q1[c] * cs[c] - q2[c] * sn[c]) * 0.125f; q[4 + c] = (q1[c] * sn[c] + q2[c] * cs[c]) * 0.125f; k[c] = k1[c] * cs[c] - k2[c] * sn[c]; k[4 + c] = k1[c] * sn[c] + k2[c] * cs[c]; } \
    } else { \
      const unsigned qw[8] = {R.a0.x, R.a0.y, R.a0.z, R.a0.w, R.a1.x, R.a1.y, R.a1.z, R.a1.w}, kw[8] = {R.b0.x, R.b0.y, R.b0.z, R.b0.w, R.b1.x, R.b1.y, R.b1.z, R.b1.w}; \
      _Pragma("unroll") for (int c = 0; c < 8; ++c) { q[2 * c] = lo16(qw[c]); q[2 * c + 1] = hi16(qw[c]); k[2 * c] = lo16(kw[c]); k[2 * c + 1] = hi16(kw[c]); } \
    } \
    if (MIXER == MIX_A || MIXER == MIX_B) { \
        \
      _Pragma("unroll") for (int c = 0; c < NC; ++c) g[c] += __builtin_bit_cast(float, __builtin_amdgcn_update_dpp(0, __builtin_bit_cast(int, g[c]), 0x111, 0xf, 0xf, false)); \
      _Pragma("unroll") for (int c = 0; c < NC; ++c) g[c] += __builtin_bit_cast(float, __builtin_amdgcn_update_dpp(0, __builtin_bit_cast(int, g[c]), 0x112, 0xf, 0xf, false)); \
      _Pragma("unroll") for (int c = 0; c < NC; ++c) g[c] += __builtin_bit_cast(float, __builtin_amdgcn_update_dpp(0, __builtin_bit_cast(int, g[c]), 0x114, 0xf, 0xf, false)); \
      _Pragma("unroll") for (int c = 0; c < NC; ++c) g[c] += __builtin_bit_cast(float, __builtin_amdgcn_update_dpp(0, __builtin_bit_cast(int, g[c]), 0x118, 0xf, 0xf, false)); \
      _Pragma("unroll") for (int c = 0; c < NC; ++c) g[c] += __builtin_bit_cast(float, __builtin_amdgcn_update_dpp(0, __builtin_bit_cast(int, g[c]), 0x142, 0xa, 0xf, false)); \
      _Pragma("unroll") for (int c = 0; c < NC; ++c) g[c] += __builtin_bit_cast(float, __builtin_amdgcn_update_dpp(0, __builtin_bit_cast(int, g[c]), 0x143, 0xc, 0xf, false)); \
      float ev[NC]; \
      _Pragma("unroll") for (int c = 0; c < NC; ++c) { \
          \
        const float e = __builtin_amdgcn_exp2f(g[c]), r = __builtin_amdgcn_rcpf(e); \
        q[c] = FMUL(q[c], e); k[c] = FMUL(k[c], r);     \
        ev[c] = e; } \
      if (lane == 63) { _Pragma("unroll") for (int c = 0; c < NC / 4; ++c) *(f32x4*)(DECb + c0 + 4 * c) = (f32x4){ev[4 * c], ev[4 * c + 1], ev[4 * c + 2], ev[4 * c + 3]}; } \
    } else if (MIXER == MIX_C) { \
        \
      const float gl = (float)(lane + 1) * lgam2; \
      const float e = __builtin_amdgcn_exp2f(gl), r = __builtin_amdgcn_rcpf(e); \
      const float e63 = rdlane(e, 63); \
      _Pragma("unroll") for (int c = 0; c < NC; ++c) { q[c] = FMUL(q[c], e); k[c] = FMUL(k[c], r); } \
      if (lane < 4) { DECb[c0 + lane] = e63; DECb[32 + c0 + lane] = e63; } \
    } else { \
      const float li = R.s0, lf = R.s1;     \
      const float bc = incl_scan_add(lf); const float u = li - bc; const float pm = incl_scan_max(u); \
      const float cmax = rdlane(pm, 63), blast = rdlane(bc, 63); \
      const float a_i = bc + m_st, m_i = fmaxf(a_i, bc + pm); \
      const float d_alpha = __builtin_amdgcn_exp2f(bc - m_i + cmax), d_beta = __builtin_amdgcn_exp2f(u - cmax); \
      rr_next = __builtin_amdgcn_exp2f(m_st - cmax);     \
      const float m_new = fmaxf(blast + m_st, blast + cmax); \
        \
      dsold_next = __builtin_amdgcn_exp2f(blast + m_st - m_new); ws_next = __builtin_amdgcn_exp2f(blast + cmax - m_new); m_st = m_new; \
      _Pragma("unroll") for (int c = 0; c < NC; ++c) { q[c] = FMUL(q[c], d_alpha); k[c] = FMUL(k[c], d_beta); } \
      if (wid == 0) EMb[lane] = __builtin_amdgcn_exp2f(-m_i); \
    } \
    { unsigned pq[NC / 2], pks[NC / 2]; \
      _Pragma("unroll") for (int c = 0; c < NC / 2; ++c) { pq[c] = pk_hw(q[2 * c], q[2 * c + 1]); pks[c] = pk_hw(k[2 * c], k[2 * c + 1]); } \
      if (MIXER == MIX_C) { \
        *(u32x2*)(QIb + lane * LD_D + c0 * 2) = (u32x2){pq[0], pq[1]}; *(u32x2*)(QIb + lane * LD_D + (32 + c0) * 2) = (u32x2){pq[2], pq[3]}; \
        *(u32x2*)(KSb + lane * LD_D + c0 * 2) = (u32x2){pks[0], pks[1]}; *(u32x2*)(KSb + lane * LD_D + (32 + c0) * 2) = (u32x2){pks[2], pks[3]}; \
      } else { \
        _Pragma("unroll") for (int c = 0; c < NC / 8; ++c) { \
          *(u32x4*)(QIb + lane * LD_D + (c0 + 8 * c) * 2) = (u32x4){pq[4 * c], pq[4 * c + 1], pq[4 * c + 2], pq[4 * c + 3]}; \
          *(u32x4*)(KSb + lane * LD_D + (c0 + 8 * c) * 2) = (u32x4){pks[4 * c], pks[4 * c + 1], pks[4 * c + 2], pks[4 * c + 3]}; } } } \
    { unsigned char* VTb = lds + U_VT + (buf_) * 6912 + (wid * 4) * LD_T + lane * 2; \
      *(bf16_t*)(VTb + 0 * LD_T) = (bf16_t)(Rv.x & 0xffff); *(bf16_t*)(VTb + 1 * LD_T) = (bf16_t)(Rv.x >> 16); *(bf16_t*)(VTb + 2 * LD_T) = (bf16_t)(Rv.y & 0xffff); *(bf16_t*)(VTb + 3 * LD_T) = (bf16_t)(Rv.y >> 16); } \
  } while (0)
  f32x4 sacc[NST];
#pragma unroll
  for (int i = 0; i < NST; ++i) sacc[i] = (f32x4){0.f, 0.f, 0.f, 0.f};
  A_LOAD(R, Rv, 0);
  A_PREP(0, R, Rv);
  A_LOAD(R, Rv, 1);
  A_LOAD(Rn, Rvn, 2);
  rr_cur = rr_next; dsold_cur = dsold_next; ws_cur = ws_next;
  lds_barrier();
#if (PROBE_DUP & 32768)
#define SCAN_PROBE_PREP(RX, RvX) { const float m_sv_ = m_st; A_PREP(nb, RX, RvX); m_st = m_sv_; asm volatile("" : "+v"(RX.a0), "+v"(RX.a1), "+v"(RX.b0), "+v"(RX.b1), "+v"(RvX) :: "memory"); }
#else
#define SCAN_PROBE_PREP(RX, RvX)
#endif
#if (PROBE_DUP & 65536)
#define SCAN_PROBE_MFMA_BEGIN f32x4 sv_[NST]; _Pragma("unroll") for (int s_ = 0; s_ < NST; ++s_) sv_[s_] = sacc[s_]; for (int rep_ = 0; rep_ < 2; ++rep_) { if (rep_ == 1) { _Pragma("unroll") for (int s_ = 0; s_ < NST; ++s_) sacc[s_] = sv_[s_]; } asm volatile("" ::: "memory");
#define SCAN_PROBE_MFMA_END }
#else
#define SCAN_PROBE_MFMA_BEGIN
#define SCAN_PROBE_MFMA_END
#endif
#define SCAN_ITER(n_, RX, RvX) do { const int n = (n_); \
    const int cb = n & 1, nb = (n + 1) & 1; \
    if (n + 1 < NCH) { SCAN_PROBE_PREP(RX, RvX) A_PREP(nb, RX, RvX); if (n + 3 < NCH) A_LOAD(RX, RvX, n + 3); } \
    SCAN_PROBE_MFMA_BEGIN \
    { \
      const int lane = lane0; \
      const int fr = lane & 15, fq = lane >> 4; \
      const int it = wid & 3, vt = wid >> 2; \
      const unsigned char* STc = lds + U_ST + cb * 13056; unsigned char* STn = lds + U_ST + nb * 13056; \
      const unsigned char* VTc = lds + U_VT + cb * 6912; \
      const unsigned char* QI = lds + U_QI + cb * 17408; const unsigned char* KS = lds + U_KS + cb * 17408; \
      const float* DECc = (const float*)(lds + U_DEC + cb * 512); const float* EMc = (const float*)(lds + U_EM + cb * 256); \
        \
        \
      bf16x8 qf[NKD], stf[NKD], dsf[NKD], ksf[4][NKD]; \
_Pragma("unroll") \
      for (int ks = 0; ks < NKD; ++ks) qf[ks] = ldfrag(QI, LD_D, it * 16 + fr, ks * 64 + fq * 16); \
_Pragma("unroll") \
      for (int ks = 0; ks < NKD; ++ks) stf[ks] = ldfrag(STc, LD_D, vt * 16 + fr, ks * 64 + fq * 16); \
_Pragma("unroll") \
      for (int ks = 0; ks < NKD; ++ks) dsf[ks] = (NVT == 3) ? ldfrag(STc, LD_D, 32 + fr, ks * 64 + fq * 16) : qf[ks]; \
_Pragma("unroll") \
      for (int jt = 0; jt < 4; ++jt) { \
_Pragma("unroll") \
        for (int ks = 0; ks < NKD; ++ks) ksf[jt][ks] = ldfrag(KS, LD_D, jt * 16 + fr, ks * 64 + fq * 16); } \
      __builtin_amdgcn_sched_barrier(0); \
      f32x4 oacc = (f32x4){0.f, 0.f, 0.f, 0.f}, dacc = (f32x4){0.f, 0.f, 0.f, 0.f}; \
_Pragma("unroll") \
      for (int ks = 0; ks < NKD; ++ks) oacc = __builtin_amdgcn_mfma_f32_16x16x32_bf16(stf[ks], qf[ks], oacc, 0, 0, 0); \
      if (NVT == 3) { \
_Pragma("unroll") \
        for (int ks = 0; ks < NKD; ++ks) dacc = __builtin_amdgcn_mfma_f32_16x16x32_bf16(dsf[ks], qf[ks], dacc, 0, 0, 0); \
      } \
        \
      f32x4 sc[4]; \
_Pragma("unroll") \
      for (int jt = 0; jt < 4; ++jt) { \
        f32x4 acc = (f32x4){0.f, 0.f, 0.f, 0.f}; \
_Pragma("unroll") \
        for (int ks = 0; ks < NKD; ++ks) acc = __builtin_amdgcn_mfma_f32_16x16x32_bf16(ksf[jt][ks], qf[ks], acc, 0, 0, 0); \
        sc[jt] = acc; } \
        \
      const bf16x8 va0 = ldfrag2(VTc, LD_T, vt * 16 + fr, fq * 8, 32 + fq * 8), va1 = ldfrag2(VTc, LD_T, vt * 16 + fr, 64 + fq * 8, 96 + fq * 8); \
      const bf16x8 vd0 = (NVT == 3) ? ldfrag2(VTc, LD_T, 32 + fr, fq * 8, 32 + fq * 8) : va0, vd1 = (NVT == 3) ? ldfrag2(VTc, LD_T, 32 + fr, 64 + fq * 8, 96 + fq * 8) : va1; \
      const int dts = (DK == 128) ? wid : (wid & 3); \
        \
      const unsigned char* ktp = KS + (fq * 8 + (fr >> 2)) * LD_D + (dts * 16 + (fr & 3) * 4) * 2; \
      const bf16x8 kf0 = ldfrag_tr(ktp, LD_D), kf1 = ldfrag_tr(ktp + 32 * LD_D, LD_D); \
      const f32x4 dc = *(const f32x4*)(DECc + dts * 16 + fq * 4); \
      bf16x8 vtf[NST][2]; \
_Pragma("unroll") \
      for (int s = 0; s < NST; ++s) { const int vt2 = (DK == 128) ? s : (wid >> 2); vtf[s][0] = ldfrag(VTc, LD_T, vt2 * 16 + fr, fq * 16); vtf[s][1] = ldfrag(VTc, LD_T, vt2 * 16 + fr, 64 + fq * 16); } \
      const float em = (NVT == 3) ? EMc[it * 16 + fr] : 0.f; \
      __builtin_amdgcn_sched_barrier(0); \
        \
_Pragma("unroll") \
      for (int s = 0; s < NST; ++s) { \
        const int dt = dts, vt2 = (DK == 128) ? s : (wid >> 2); \
        f32x4 acc = (MIXER == MIX_D) ? (f32x4){0.f, 0.f, 0.f, 0.f} : sacc[s]; \
        acc = __builtin_amdgcn_mfma_f32_16x16x32_bf16(kf0, vtf[s][0], acc, 0, 0, 0); \
        acc = __builtin_amdgcn_mfma_f32_16x16x32_bf16(kf1, vtf[s][1], acc, 0, 0, 0); \
        if (MIXER == MIX_D) { _Pragma("unroll") for (int e_ = 0; e_ < 4; ++e_) acc[e_] = FMUL(sacc[s][e_], dsold_cur) + FMUL(acc[e_], ws_cur); } \
        else { _Pragma("unroll") for (int e_ = 0; e_ < 4; ++e_) acc[e_] = FMUL(acc[e_], dc[e_]); } \
        sacc[s] = acc; \
        *(u32x2*)(STn + (vt2 * 16 + fr) * LD_D + (dt * 16 + fq * 4) * 2) = (u32x2){pk_hw(acc[0], acc[1]), pk_hw(acc[2], acc[3])}; \
      } \
        \
        \
      const int thr = it * 16 + fr - fq * 4; \
      u32x2 sp[4]; \
_Pragma("unroll") \
      for (int jt = 0; jt < 4; ++jt) { \
        const float v0 = (jt * 16 + 0 <= thr) ? sc[jt][0] : 0.f, v1 = (jt * 16 + 1 <= thr) ? sc[jt][1] : 0.f, v2 = (jt * 16 + 2 <= thr) ? sc[jt][2] : 0.f, v3 = (jt * 16 + 3 <= thr) ? sc[jt][3] : 0.f; \
        sp[jt] = (u32x2){pk_hw(v0, v1), pk_hw(v2, v3)}; } \
      const u32x4 sb0 = (u32x4){sp[0].x, sp[0].y, sp[1].x, sp[1].y}, sb1 = (u32x4){sp[2].x, sp[2].y, sp[3].x, sp[3].y}; \
      if (MIXER == MIX_D) { _Pragma("unroll") for (int e_ = 0; e_ < 4; ++e_) { oacc[e_] = FMUL(oacc[e_], rr_cur); dacc[e_] = FMUL(dacc[e_], rr_cur); } } \
      oacc = __builtin_amdgcn_mfma_f32_16x16x32_bf16(va0, __builtin_bit_cast(bf16x8, sb0), oacc, 0, 0, 0); \
      oacc = __builtin_amdgcn_mfma_f32_16x16x32_bf16(va1, __builtin_bit_cast(bf16x8, sb1), oacc, 0, 0, 0); \
      float dn = 1.0f; \
      if (NVT == 3) { \
        dacc = __builtin_amdgcn_mfma_f32_16x16x32_bf16(vd0, __builtin_bit_cast(bf16x8, sb0), dacc, 0, 0, 0); \
        dacc = __builtin_amdgcn_mfma_f32_16x16x32_bf16(vd1, __builtin_bit_cast(bf16x8, sb1), dacc, 0, 0, 0); \
        const float den = __shfl(dacc[0], fr); \
        dn = 1.0f / fmaxf(fabsf(den), em); \
      } \
      { \
        const int i = it * 16 + fr; \
        const int ti = dir ? (SEQ - 1 - (n * 64 + i)) : (n * 64 + i); \
        const f32x4 o = (f32x4){FMUL(oacc[0], dn), FMUL(oacc[1], dn), FMUL(oacc[2], dn), FMUL(oacc[3], dn)}; \
        *(u32x2*)(O + PIDX(tokbase + ti, ocol + vt * 16 + fq * 4)) = (u32x2){pk_hw(o[0], o[1]), pk_hw(o[2], o[3])}; \
      } \
    } \
    SCAN_PROBE_MFMA_END \
    rr_cur = rr_next; dsold_cur = dsold_next; ws_cur = ws_next; \
    lds_barrier(); \
  } while (0)
  static_assert(NCH % 2 == 0, "chunk count must be even");
#pragma unroll 1
  for (int n2 = 0; n2 < NCH; n2 += 2) { SCAN_ITER(n2, R, Rv); SCAN_ITER(n2 + 1, Rn, Rvn); }
#undef SCAN_ITER
#undef A_LOAD
#undef A_PREP
}

template <int MIXER>
__device__ __forceinline__ void scan_dispatch2(unsigned char* lds, int wv, const Params& p, int id) {
  const int vs = id & 3, dir = (id >> 2) & 1, h = (id >> 3) & 3, b = id >> 5;
  scan_item2<MIXER>(lds, wv, p, b, h, dir, vs);
}
}

__device__ __forceinline__ void scan_phase2(unsigned char* lds, int wv, const Params& p, int layer, int convert) {
  bool light = false;
  for (int it0 = blockIdx.x; it0 < 256; it0 += gridDim.x) {
    const int xq = it0 & 7, yq = it0 >> 3, stream = (yq >> 2) * 8 + xq;
    const int item = (stream >> 5) * 128 + (stream & 31) * 4 + (yq & 3);
    if (layer == 0) { if (item < 128) scan2::scan_dispatch2<scan::MIX_A>(lds, wv, p, item); else scan2::scan_dispatch2<scan::MIX_B>(lds, wv, p, item - 128); }
    else { if (item < 128) scan2::scan_dispatch2<scan::MIX_D>(lds, wv, p, item); else scan2::scan_dispatch2<scan::MIX_C>(lds, wv, p, item - 128); }
    light = item >= 128;
    __syncthreads();
  }
  if (convert) {
    const int G = gridDim.x, b = blockIdx.x;
    if (G == 256) { if (light) { moe_weight_convert(lds, wv, p, layer, 0, b - 128, 128); if (p.big_ws) moe_weight_convert(lds, wv, p, layer, 1, b - 128, 128); } }
    else { moe_weight_convert(lds, wv, p, layer, 0, b, G); if (p.big_ws) moe_weight_convert(lds, wv, p, layer, 1, b, G); }
  }
}
#endif
#ifndef CPU_EMU
#define XB_BASE     2048
#define XB_TMO      (XB_BASE + 128)
#define XB_XCNT(j)  (XB_BASE + 256  + 64 * (j))
#define XB_XSUB(j)  (XB_BASE + 1280 + 64 * (j))
#define XB_XGEN(j)  (XB_BASE + 2304 + 64 * (j))
#define XB_TOP      (XB_BASE + 3328)
#define XB_TOPGEN   (XB_BASE + 3392)
#define XB_WORDS    3456
#define XB_SPIN_CAP (1u << 22)
#define XB_LDS_OFF  (LDS_BYTES - 16)
__device__ __forceinline__ unsigned xb_ld(unsigned* p)              { return __hip_atomic_load(p, __ATOMIC_RELAXED, __HIP_MEMORY_SCOPE_AGENT); }
__device__ __forceinline__ unsigned xb_add(unsigned* p, unsigned v) { return __hip_atomic_fetch_add(p, v, __ATOMIC_RELAXED, __HIP_MEMORY_SCOPE_AGENT); }
__device__ __forceinline__ unsigned xb_xcc_id() { return (unsigned)__builtin_amdgcn_s_getreg((3 << 11) | 20) & 0xFu; }
#define XB_SPIN(cond, bar) do { unsigned _sp = 0; while (cond) { __builtin_amdgcn_s_sleep(1); \
    if ((++_sp & 255u) == 0u) { if (xb_ld(&(bar)[XB_TMO])) break; if (_sp > XB_SPIN_CAP) { atomicAdd(&(bar)[XB_TMO], 1u); break; } } } } while (0)
__device__ __forceinline__ void grid_bar(unsigned* bar, unsigned char* lds_raw, int wv) {
  asm volatile("s_waitcnt vmcnt(0)" ::: "memory");
  __syncthreads();
  if (wv == 0 && lane_id() == 0) {
    volatile unsigned* st = (volatile unsigned*)(lds_raw + XB_LDS_OFF);
    __builtin_amdgcn_s_waitcnt(0);
    const unsigned x = xb_xcc_id();
    unsigned nloc = st[0], nx = st[1];
    if (nloc == 0u) {
      const unsigned G = gridDim.x; unsigned sum, cnt, mine, sp = 0u;
      for (;;) { sum = 0u; cnt = 0u; mine = 0u;
#pragma unroll
        for (unsigned j = 0; j < 16; ++j) { const unsigned c = xb_ld(&bar[XB_XCNT(j)]); sum += c; cnt += (c > 0u) ? 1u : 0u; mine = (j == x) ? c : mine; }
        if (sum == G) break;
        __builtin_amdgcn_s_sleep(1);
        if ((++sp & 255u) == 0u) { if (xb_ld(&bar[XB_TMO])) break; if (sp > XB_SPIN_CAP) { atomicAdd(&bar[XB_TMO], 1u); break; } } }
      nloc = mine > 0u ? mine : 1u; nx = cnt > 0u ? cnt : 1u; st[0] = nloc; st[1] = nx;
    }
    const unsigned old = xb_add(&bar[XB_XSUB(x)], 1u);
    const unsigned gen = old / nloc;
    if (old + 1u == (gen + 1u) * nloc) {
      __builtin_amdgcn_fence(__ATOMIC_RELEASE, "agent");
      asm volatile("s_waitcnt vmcnt(0)" ::: "memory");
      const unsigned og = xb_add(&bar[XB_TOP], 1u);
      const unsigned tg = og / nx;
      if (og + 1u == (tg + 1u) * nx) xb_add(&bar[XB_TOPGEN], 1u);
      else XB_SPIN(xb_ld(&bar[XB_TOPGEN]) == tg, bar);
      __builtin_amdgcn_fence(__ATOMIC_ACQUIRE, "agent");
      xb_add(&bar[XB_XGEN(x)], 1u);
      asm volatile("s_waitcnt vmcnt(0)" ::: "memory");
    } else {
      XB_SPIN(xb_ld(&bar[XB_XGEN(x)]) == gen, bar);
      __builtin_amdgcn_fence(__ATOMIC_ACQUIRE, "agent");
      asm volatile("s_waitcnt vmcnt(0)" ::: "memory");
    }
  }
  __syncthreads();
}
#if (PROBE_DUP & 16)
#define grid_bar(a, b, c) do { grid_bar(a, b, c); grid_bar(a, b, c); } while (0)
#endif

__global__ void __launch_bounds__(NTHREADS) mk_fwd(Params p) {
  extern __shared__ __attribute__((aligned(16))) unsigned char lds_raw[];
  cg::grid_group grid = cg::this_grid();
  const int G = gridDim.x, bid = blockIdx.x;
  const int wv = __builtin_amdgcn_readfirstlane(threadIdx.x >> 6);
  PG8_LAS unsigned char* lds = (PG8_LAS unsigned char*)lds_raw;
  unsigned char* ws = p.ws;

  if (threadIdx.x < 4) ((unsigned*)(lds_raw + XB_LDS_OFF))[threadIdx.x] = 0u;
  p0_prologue(lds_raw, wv, p);
#if (PROBE_DUP & 128)
  p0_prologue(lds_raw, wv, p);
#endif
  grid.sync();
  unsigned* bar = (unsigned*)(ws + WS_CTL);
  if (wv == 0 && lane_id() == 0) (void)xb_add(&bar[XB_XCNT(xb_xcc_id())], 1u);
  for (int layer = 0; layer < 2; ++layer) {
    { ProbInProj pr; pr.so.init(NTOK, layer == 0 ? PM_AB : PM_CD, G, bid); pr.A = (const char*)p.out; pr.Bt = (const char*)(ws + (layer == 0 ? WS_WIN_AB : WS_WIN_CD));
      pr.P = (bf16_t*)(ws + WS_R1); pr.bias = p.in[layer == 0 ? I_AB_B_IN : I_CD_B_IN]; pr.lb = (const float*)(ws + WS_LB); pr.layer = layer;
      pg8::gemm_phase(lds, pr, wv);
#if (PROBE_DUP & (1 | 2048))
      pg8::gemm_phase(lds, pr, wv);
#endif
      if (layer == 0) side_phase<32>(lds_raw, wv, p, 0); else side_phase<16>(lds_raw, wv, p, 1);
#if (PROBE_DUP & 256)
      if (layer == 0) side_phase<32>(lds_raw, wv, p, 0); else side_phase<16>(lds_raw, wv, p, 1);
#endif
 }
    grid_bar(bar, lds_raw, wv);
    if (layer == 1) { convd_phase(lds_raw, wv, p); grid_bar(bar, lds_raw, wv); }
    scan_phase2(lds_raw, wv, p, layer, 1);
#if (PROBE_DUP & 2)
    scan_phase2(lds_raw, wv, p, layer, 0);
#endif
#if (PROBE_DUP & 512)
    if (layer == 0) scan_phase2(lds_raw, wv, p, layer, 0);
#endif
#if (PROBE_DUP & 1024)
    if (layer == 1) scan_phase2(lds_raw, wv, p, layer, 0);
#endif
    grid_bar(bar, lds_raw, wv);
    headnorm_phase(lds_raw, wv, p, layer);
#if (PROBE_DUP & 8)
    headnorm_phase(lds_raw, wv, p, layer);
#endif
    grid_bar(bar, lds_raw, wv);
    { ProbOutProj pr; pr.so.init(NTOK, 1024, G, bid); pr.A = (const char*)(ws + WS_MIX); pr.Bt = (const char*)(ws + (layer == 0 ? WS_WOUT_AB : WS_WOUT_CD)); pr.Y = (bf16_t*)(ws + WS_R2); pr.Hres = (const bf16_t*)p.out;
      pg8::gemm_phase(lds, pr, wv);
#if (PROBE_DUP & (1 | 16384))
      pg8::gemm_phase(lds, pr, wv);
#endif
      if (!p.big_ws) moe_weight_convert(lds_raw, wv, p, layer, 1, bid, G);
 }
    grid_bar(bar, lds_raw, wv);
#if (PROBE_DUP & 32)
    ln_phase(lds_raw, wv, p, layer, 0, 1);
#endif
    ln_phase(lds_raw, wv, p, layer, 0);
    grid_bar(bar, lds_raw, wv);
    { ProbMoe1 pr; pr.mo.init((const int*)((const unsigned*)(ws + WS_CTL) + CW_CNT(layer)), 8, G, bid, lds_raw, wv);
      pr.A = (const char*)(ws + WS_MIX); pr.W13 = (const char*)(ws + WS_W13); pr.list = (const int*)(ws + WS_LIST) + (size_t)layer * NEXP * NTOK; pr.H = (bf16_t*)(ws + WS_H);
      pg8::gemm_phase(lds, pr, wv);
#if (PROBE_DUP & (1 | 4096))
      pg8::gemm_phase(lds, pr, wv);
#endif
 }
    grid_bar(bar, lds_raw, wv);
    { ProbMoe2 pr; pr.mo.init((const int*)((const unsigned*)(ws + WS_CTL) + CW_CNT(layer)), 4, G, bid, lds_raw, wv);
      pr.A = (const char*)(ws + WS_H); pr.W2 = (const char*)(ws + (p.big_ws ? WS_W2X : WS_W2)); pr.Y = (bf16_t*)(ws + WS_R2);
      pg8::gemm_phase(lds, pr, wv);
#if (PROBE_DUP & (1 | 8192))
      pg8::gemm_phase(lds, pr, wv);
#endif
 }
    grid_bar(bar, lds_raw, wv);
#if (PROBE_DUP & 64)
    ln_phase(lds_raw, wv, p, layer, 1, 1);
#endif
    ln_phase(lds_raw, wv, p, layer, 1);
    if (layer == 0) grid_bar(bar, lds_raw, wv);
  }
}

extern "C" void kernel_launch(void* const* d_in, const int* in_sizes, int n_in, void* d_out, int out_size, void* d_ws, size_t ws_size, hipStream_t stream) {
  static int grid_blocks = 0;
  if (grid_blocks == 0) {
    if (n_in != N_IN || ws_size < WS_END || out_size != NTOK * 1024) { fprintf(stderr, "kernel_launch: bad shapes: n_in %d ws %zu (need %zu) out %d\n", n_in, ws_size, (size_t)WS_END, out_size); grid_blocks = -1; return; }
    int dev = 0, cus = 0, per_cu = 0;
    hipGetDevice(&dev); hipDeviceGetAttribute(&cus, hipDeviceAttributeMultiprocessorCount, dev);
    if (hipFuncSetAttribute((const void*)mk_fwd, hipFuncAttributeMaxDynamicSharedMemorySize, LDS_BYTES) != hipSuccess) { fprintf(stderr, "kernel_launch: hipFuncSetAttribute failed\n"); grid_blocks = -1; return; }
    if (hipOccupancyMaxActiveBlocksPerMultiprocessor(&per_cu, (const void*)mk_fwd, NTHREADS, LDS_BYTES) != hipSuccess || per_cu < 1) { fprintf(stderr, "kernel_launch: occupancy query failed (%d)\n", per_cu); grid_blocks = -1; return; }
    grid_blocks = cus;
    (void)in_sizes;
  }
  if (grid_blocks < 0) return;
  Params p{};
  for (int i = 0; i < N_IN; ++i) p.in[i] = (const float*)d_in[i];
  p.out = (float*)d_out; p.ws = (unsigned char*)d_ws; p.big_ws = ws_size >= (size_t)WS_END_BIG ? 1 : 0;
  void* args[] = {&p};
  hipError_t e = hipLaunchCooperativeKernel((const void*)mk_fwd, dim3(grid_blocks), dim3(NTHREADS), args, LDS_BYTES, stream);
  if (e != hipSuccess) fprintf(stderr, "cooperative launch failed: %s (grid %d)\n", hipGetErrorString(e), grid_blocks);
}
#endif
```

```cpp
#ifdef CPU_EMU
#include <cmath>
#include <cstdio>
#include <cstring>
#include <cstdlib>
#include <cstddef>
#define DEV
#define DEV_INLINE static inline
typedef void* hipStream_t;
#else
#include <hip/hip_runtime.h>
#include <hip/hip_bf16.h>
#include <cstdio>
#define DEV __device__ __forceinline__
#define DEV_INLINE __device__ __forceinline__
#endif
#ifndef PROBE_DUP
#define PROBE_DUP 0
#endif
#ifndef BATCH
#define BATCH 4
#endif
#ifndef SEQ
#define SEQ 8192
#endif
#define DM 1024
#define NTOK (BATCH * SEQ)
#define P_AB 4128
#define P_CD 3600
#define PM_AB 4096
#define PM_CD 3584
#define NEXP 16
#define ALPHA_F 1.4142135623730951f
#define LN_EPS_F 1e-5f
#define NORM_EPS_F 1e-6f
#define HROWS (2 * NTOK + NEXP * 256)

typedef unsigned short bf16_t;

DEV_INLINE float bf2f(bf16_t b) { unsigned u = ((unsigned)b) << 16; float f; memcpy(&f, &u, 4); return f; }
DEV_INLINE bf16_t f2bf(float f) { unsigned u; memcpy(&u, &f, 4); u += 0x7FFFu + ((u >> 16) & 1u); return (bf16_t)(u >> 16); }
DEV_INLINE float sigmoidf_(float x) { return 1.0f / (1.0f + expf(-x)); }
DEV_INLINE float siluf_(float x) { return x / (1.0f + expf(-x)); }
DEV_INLINE float logsigmoidf_(float x) { return fminf(x, 0.0f) - log1pf(expf(-fabsf(x))); }

#define AL256(x) (((size_t)(x) + 255) & ~(size_t)255)
#define WS_CTL    ((size_t)0)
#define WS_HB     ((size_t)65536)
#define WS_R1     (WS_HB + (size_t)NTOK * 1024 * 2)
#define R1_P_BYTES ((size_t)NTOK * 4096 * 2)
#define R1_MIN    ((size_t)NTOK * 1024 * 2 + AL256((size_t)HROWS * 1024 * 2))
#define R1_PL     (R1_P_BYTES + (size_t)NTOK * 512 * 2)
#define R1_BYTES  (R1_PL > R1_MIN ? R1_PL : R1_MIN)
#define WS_LFB    (WS_R1 + R1_P_BYTES)
#define WS_MIX    (WS_R1)
#define WS_H      (WS_R1 + (size_t)NTOK * 1024 * 2)
#define WS_W13    (WS_HB)
#define WS_W2     (WS_LFB)
#define WMOE_BYTES ((size_t)NEXP * 3072 * 1024 * 2)
#define WS_R2     (WS_R1 + R1_BYTES)
#define R2_BYTES  ((size_t)HROWS * 1024 * 2 > (size_t)NTOK * 1024 * 4 ? (size_t)HROWS * 1024 * 2 : (size_t)NTOK * 1024 * 4)
#define WS_SIDE   (WS_R2 + AL256(R2_BYTES))
#define WS_WIN_AB (WS_SIDE + (size_t)NTOK * 32 * 4)
#define WS_WIN_CD (WS_WIN_AB + (size_t)4128 * 1024 * 2)
#define WS_WOUT_AB (WS_WIN_CD + (size_t)3600 * 1024 * 2)
#define WS_WOUT_CD (WS_WOUT_AB + (size_t)1024 * 1024 * 2)
#define WS_ROPE   (WS_WOUT_CD + (size_t)1024 * 1024 * 2)
#define WS_LB     (WS_ROPE + (size_t)SEQ * 64 * 4)
#define WS_LIST   (WS_LB + 4096)
#define WS_ASSIGN (WS_LIST + (size_t)2 * NEXP * NTOK * 4)
#define WS_GATE   (WS_ASSIGN + (size_t)NTOK * 16)
#define WS_END    (WS_GATE + (size_t)NTOK * 8)
#define CW_CNT(layer) (64 + 256 * (layer))
#define CW_TIX(layer, part) (1024 + 16 * (2 * (layer) + (part)))

#define PSTRIDE 4096
#define PIDX(tok, col) ((((size_t)((col) >> 7)) * NTOK + (size_t)(tok)) * 128 + (size_t)((col) & 127))
#define PIDX8(tok, col) ((((size_t)((col) >> 3)) * NTOK + (size_t)(tok)) * 8 + (size_t)((col) & 7))

enum { I_X, I_AB_W_IN, I_AB_B_IN, I_HGRN_LB, I_GK_UP, I_GK_B, I_HGRN_NORM, I_GLA_NORM, I_AB_W_OUT,
       I_CD_W_IN, I_CD_B_IN, I_CONV_W, I_CONV_B, I_FGATE_B, I_RET_NORM, I_MLSTM_NORM, I_CD_W_OUT,
       I_LN_MIX_G, I_LN_MIX_B, I_LN_FFN_G, I_LN_FFN_B, I_ROUTER_W, I_ROUTER_B, I_MOE_W1, I_MOE_W3, I_MOE_W2, N_IN };

struct Params {
  const float* in[N_IN];
  float* out;
  unsigned char* ws;
};

DEV_INLINE float epi_ab(int col, float v, const float* lb) {
  if (col < 512) return siluf_(v);
  if (col < 1536) { float l = lb[(col - 512) & 511]; return logf(l + (1.0f - l) * sigmoidf_(v)); }
  if (col >= 2560 && col < 2816) return v * 0.125f;
  return v;
}

DEV_INLINE void route_from_logits(const float* lg, const float* rb, int* e_out, float* g_out) {
  float mx = lg[0];
#pragma unroll
  for (int e = 1; e < 16; ++e) mx = fmaxf(mx, lg[e]);
  float sc[16]; float sum = 0.f;
#pragma unroll
  for (int e = 0; e < 16; ++e) { sc[e] = expf(lg[e] - mx); sum += sc[e]; }
  float inv = 1.0f / sum;
  float best_gs = -1e30f; int be1 = 0, be2 = 1; float bs1 = 0.f, bs2 = 0.f;
#pragma unroll
  for (int gq = 0; gq < 4; ++gq) {
    float m1 = -1e30f, m2 = -1e30f, s1 = 0.f, s2 = 0.f; int i1 = 0, i2 = 0;
#pragma unroll
    for (int i = 0; i < 4; ++i) {
      float s = sc[gq * 4 + i] * inv; float v = s + rb[gq * 4 + i];
      if (v > m1) { m2 = m1; i2 = i1; s2 = s1; m1 = v; i1 = gq * 4 + i; s1 = s; }
      else if (v > m2) { m2 = v; i2 = gq * 4 + i; s2 = s; }
    }
    float gs = m1 + m2;
    if (gs > best_gs) { best_gs = gs; be1 = i1; be2 = i2; bs1 = s1; bs2 = s2; }
  }
  e_out[0] = be1; e_out[1] = be2; g_out[0] = bs1 / (bs1 + bs2); g_out[1] = bs2 / (bs1 + bs2);
}
#ifndef CPU_EMU
namespace pg8 {
#define PG8_LAS __attribute__((address_space(3)))
typedef short bf16x8 __attribute__((ext_vector_type(8)));
typedef float f32x4 __attribute__((ext_vector_type(4)));
typedef unsigned u32x4 __attribute__((ext_vector_type(4)));
typedef unsigned u32x2 __attribute__((ext_vector_type(2)));
constexpr int BM = 256, BK = 64, HALF = 128, HTB = HALF * BK * 2, STAGE_BYTES = 8 * HTB, NXCD = 8, WGM = 8, GK = 1024;

__device__ __forceinline__ int lds_byte(int r, int c) { const int st = (r >> 4) * 2 + (c >> 5), rr = r & 15, cc = c & 31, ob = rr * 64 + cc * 2; return st * 1024 + (ob ^ (((ob >> 9) & 1) << 5)); }
__device__ __forceinline__ void stage_rc(int b, int& R, int& C) { const int st = b / 1024, sb = b % 1024, swz = sb ^ (((sb >> 9) & 1) << 5); R = (st >> 1) * 16 + swz / 64; C = (st & 1) * 32 + (swz % 64) / 2; }
__device__ __forceinline__ int perm32(int rho) { const int n = rho >> 4, i = rho & 15; return 8 * (i >> 2) + 4 * n + (i & 3); }
__device__ __forceinline__ unsigned cvt_pk_bf16(float lo, float hi) { unsigned r; asm volatile("v_cvt_pk_bf16_f32 %0, %1, %2" : "=v"(r) : "v"(lo), "v"(hi)); return r; }

struct Unit { int pm, pn, e, row0, ne, ui; };

struct StaticOrder {
  int nM, nN, nwg, G, c;
  __device__ void init(int M, int N, int G_, int c_) { nM = M / BM; nN = N / BM; nwg = nM * nN; G = G_; c = c_; }
  __device__ bool next(int i, Unit& u) const {
    const long L = (long)i * G + c; if (L >= nwg) return false;
    int wgid = (int)L; { const int q = nwg / NXCD, r = nwg % NXCD, xcd = wgid % NXCD, off = wgid / NXCD; wgid = (xcd < r ? xcd * (q + 1) : r * (q + 1) + (xcd - r) * q) + off; }
    const int nig = WGM * nN, gid = wgid / nig, fm = gid * WGM, gsz = (nM - fm) < WGM ? (nM - fm) : WGM;
    u.pm = fm + ((wgid % nig) % gsz); u.pn = (wgid % nig) / gsz; u.e = 0; u.row0 = u.pm * BM; u.ne = 0; u.ui = i; return true;
  }
};

template <class Prob>
__device__ __forceinline__ void gemm_phase(PG8_LAS unsigned char* lds, const Prob& S, int wv) {
  int wv_ = wv; asm volatile("" : "+s"(wv_));
  int l_; asm volatile("v_mbcnt_lo_u32_b32 %0, -1, 0\n\tv_mbcnt_hi_u32_b32 %0, -1, %0" : "=v"(l_));
  int tid_ = wv_ * 64 + l_;
  const int tid = tid_, wid = __builtin_amdgcn_readfirstlane(tid >> 6), lane = tid & 63, wr = wid >> 2, wc = wid & 3, fr = lane & 15, fq = lane >> 4;
  constexpr int K = GK, nt = K / BK;
  int sR[2], sC[2]; unsigned voffB[2];
#pragma unroll
  for (int i = 0; i < 2; ++i) { int R, C; stage_rc(tid * 16 + i * 8192, R, C); sR[i] = R; sC[i] = C; const int Rb = Prob::PERM ? ((R & ~31) + perm32(R & 31)) : R; voffB[i] = (unsigned)(Rb * K + C) * 2u; }
  const size_t kstep = (size_t)(BK * 2);
  const size_t hstep = (size_t)HALF * K * 2;
  const unsigned ldsw = (unsigned)wid * 1024u;
  const int aoff = lds_byte(wr * 64 + fr, fq * 8), boff = lds_byte(wc * 32 + fr, fq * 8);
#define PG8_SA(b, h) (((b) * 2 + (h)) * HTB)
#define PG8_SB(b, h) ((4 + (b) * 2 + (h)) * HTB)
#define PG8_STAGE(bufoff, gbase, voff) do { _Pragma("unroll") for (int _i = 0; _i < 2; ++_i) \
    __builtin_amdgcn_global_load_lds((const unsigned*)((const char*)(gbase) + (voff)[_i]), (PG8_LAS unsigned*)(lds + (bufoff) + ldsw + _i * 8192), 16, 0, 0); } while (0)
#define PG8_LDA(dst, b, h) do { _Pragma("unroll") for (int m = 0; m < 4; ++m) _Pragma("unroll") for (int k = 0; k < 2; ++k) dst[m][k] = *(const PG8_LAS bf16x8*)(lds + PG8_SA(b, h) + aoff + m * 2048 + k * 1024); } while (0)
#define PG8_LDB(dst, b, h) do { _Pragma("unroll") for (int n = 0; n < 2; ++n) _Pragma("unroll") for (int k = 0; k < 2; ++k) dst[n][k] = *(const PG8_LAS bf16x8*)(lds + PG8_SB(b, h) + boff + n * 2048 + k * 1024); } while (0)
#define PG8_MMA(ai, bj, At, Bt) do { __builtin_amdgcn_s_setprio(1); _Pragma("unroll") for (int m = 0; m < 4; ++m) _Pragma("unroll") for (int n = 0; n < 2; ++n) _Pragma("unroll") for (int k = 0; k < 2; ++k) \
    acc[ai][bj][m][n] = __builtin_amdgcn_mfma_f32_16x16x32_bf16(Bt[n][k], At[m][k], acc[ai][bj][m][n], 0, 0, 0); __builtin_amdgcn_s_setprio(0); } while (0)
#define PG8_WAIT_V(n) asm volatile("s_waitcnt vmcnt(" #n ")" ::: "memory")
#define PG8_WAIT_L(n) asm volatile("s_waitcnt lgkmcnt(" #n ")" ::: "memory")
#define PG8_BAR __builtin_amdgcn_s_barrier()
#define PG8_SCHED __builtin_amdgcn_sched_barrier(0)
  Unit cur, nxt; int ui = 0;
  if (!S.next(0, cur)) return;
  f32x4 acc[2][2][4][2];
#pragma unroll
  for (int a = 0; a < 2; ++a)
#pragma unroll
    for (int b = 0; b < 2; ++b)
#pragma unroll
      for (int m = 0; m < 4; ++m)
#pragma unroll
        for (int n = 0; n < 2; ++n) acc[a][b][m][n] = (f32x4){0.f, 0.f, 0.f, 0.f};
  bf16x8 At[4][2], B0[2][2], B1[2][2];
  unsigned oc0[2], oc1[2], on0[2], on1[2];
#pragma unroll
  for (int i = 0; i < 2; ++i) { oc0[i] = S.a_off(cur, sR[i]) + (unsigned)sC[i] * 2u; oc1[i] = S.a_off(cur, HALF + sR[i]) + (unsigned)sC[i] * 2u; }
  const char* const Ab = S.a_base();
  const char* cB = S.b_base(cur);
  PG8_STAGE(PG8_SB(0, 0), cB, voffB); PG8_STAGE(PG8_SB(0, 1), cB + hstep, voffB); PG8_STAGE(PG8_SA(0, 0), Ab, oc0); PG8_STAGE(PG8_SA(0, 1), Ab, oc1);
  if (wr == 1) PG8_BAR;
  PG8_WAIT_V(2); PG8_BAR;
  PG8_STAGE(PG8_SB(1, 0), cB + kstep, voffB); PG8_STAGE(PG8_SA(1, 0), Ab + kstep, oc0); PG8_STAGE(PG8_SB(1, 1), cB + hstep + kstep, voffB);
  PG8_WAIT_V(6); PG8_BAR;
  for (;;) {
    const bool has_next = S.next(ui + 1, nxt);
    const char* nB = cB;
    if (has_next) {
      nB = S.b_base(nxt);
      int l2_; asm volatile("v_mbcnt_lo_u32_b32 %0, -1, 0\n\tv_mbcnt_hi_u32_b32 %0, -1, %0" : "=v"(l2_));
      const int tid2 = wid * 64 + l2_;
#pragma unroll
      for (int i = 0; i < 2; ++i) { int R, C; stage_rc(tid2 * 16 + i * 8192, R, C); on0[i] = S.a_off(nxt, R) + (unsigned)C * 2u; on1[i] = S.a_off(nxt, HALF + R) + (unsigned)C * 2u; }
    } else {
#pragma unroll
      for (int i = 0; i < 2; ++i) { on0[i] = oc0[i]; on1[i] = oc1[i]; }
    }
    for (int t = 0; t < nt; t += 2) {
      const bool last = (t == nt - 2);
      const char* a1 = Ab + (size_t)(t + 1) * kstep;
      const char* a2 = last ? Ab : Ab + (size_t)(t + 2) * kstep; const char* b2 = last ? nB : cB + (size_t)(t + 2) * kstep;
      const char* a3 = a2 + kstep; const char* b3 = b2 + kstep;
      unsigned o20[2], o21[2];
#pragma unroll
      for (int i = 0; i < 2; ++i) { o20[i] = last ? on0[i] : oc0[i]; o21[i] = last ? on1[i] : oc1[i]; }
      PG8_LDB(B0, 0, 0); PG8_LDB(B1, 0, 1); PG8_SCHED; PG8_LDA(At, 0, 0); PG8_STAGE(PG8_SA(1, 1), a1, oc1);
      PG8_WAIT_V(8); PG8_WAIT_L(0); PG8_BAR; PG8_MMA(0, 0, At, B0); PG8_MMA(0, 1, At, B1); PG8_BAR; PG8_SCHED;
      PG8_LDA(At, 0, 1); PG8_STAGE(PG8_SB(0, 0), b2, voffB); PG8_STAGE(PG8_SB(0, 1), b2 + hstep, voffB); PG8_STAGE(PG8_SA(0, 0), a2, o20);
      PG8_WAIT_V(8); PG8_WAIT_L(0); PG8_BAR; PG8_MMA(1, 0, At, B0); PG8_MMA(1, 1, At, B1); PG8_BAR; PG8_SCHED;
      PG8_LDB(B0, 1, 0); PG8_LDB(B1, 1, 1); PG8_SCHED; PG8_LDA(At, 1, 0); PG8_STAGE(PG8_SA(0, 1), a2, o21);
      PG8_WAIT_V(8); PG8_WAIT_L(0); PG8_BAR; PG8_MMA(0, 0, At, B0); PG8_MMA(0, 1, At, B1); PG8_BAR; PG8_SCHED;
      PG8_LDA(At, 1, 1); PG8_STAGE(PG8_SB(1, 0), b3, voffB); PG8_STAGE(PG8_SB(1, 1), b3 + hstep, voffB); PG8_STAGE(PG8_SA(1, 0), a3, o20);
      PG8_WAIT_V(8); PG8_WAIT_L(0); PG8_BAR; PG8_MMA(1, 0, At, B0); PG8_MMA(1, 1, At, B1); PG8_BAR; PG8_SCHED;
    }
    if (wr == 0) PG8_BAR;
    { int l3_; asm volatile("v_mbcnt_lo_u32_b32 %0, -1, 0\n\tv_mbcnt_hi_u32_b32 %0, -1, %0" : "=v"(l3_));
      S.epi(acc, cur, wr, wc, l3_ & 15, l3_ >> 4); }
    if (!has_next) break;
#pragma unroll
    for (int a = 0; a < 2; ++a)
#pragma unroll
      for (int b = 0; b < 2; ++b)
#pragma unroll
        for (int m = 0; m < 4; ++m)
#pragma unroll
          for (int n = 0; n < 2; ++n) acc[a][b][m][n] = (f32x4){0.f, 0.f, 0.f, 0.f};
    cur = nxt; cB = nB; ++ui;
#pragma unroll
    for (int i = 0; i < 2; ++i) { oc0[i] = on0[i]; oc1[i] = on1[i]; }
    if (wr == 1) PG8_BAR;
  }
  PG8_WAIT_V(0);
  PG8_BAR;
#undef PG8_SA
#undef PG8_SB
#undef PG8_STAGE
#undef PG8_LDA
#undef PG8_LDB
#undef PG8_MMA
#undef PG8_WAIT_V
#undef PG8_WAIT_L
#undef PG8_BAR
#undef PG8_SCHED
}
}
#endif
#ifndef CPU_EMU
#include <hip/hip_cooperative_groups.h>
namespace cg = cooperative_groups;
#define LAS __attribute__((address_space(3)))
#define NTHREADS 512
#define LDS_BYTES (154 * 1024)
typedef float f32x4 __attribute__((ext_vector_type(4)));
typedef short bf16x8 __attribute__((ext_vector_type(8)));
typedef unsigned u32x4 __attribute__((ext_vector_type(4)));
typedef unsigned u32x2 __attribute__((ext_vector_type(2)));

struct Ctx { int tid, lane, wid, G, bid; unsigned char* lds; };
__device__ __forceinline__ int lane_id() { int l; asm volatile("v_mbcnt_lo_u32_b32 %0, -1, 0\n\tv_mbcnt_hi_u32_b32 %0, -1, %0" : "=v"(l)); return l; }
__device__ __forceinline__ int opaque_tid(int wv) { int w = wv; asm volatile("" : "+s"(w)); int t = w * 64 + lane_id(); asm volatile("" : "+v"(t)); return t; }
__device__ __forceinline__ Ctx make_ctx(unsigned char* lds, int wv) { Ctx c; c.tid = opaque_tid(wv); c.lane = c.tid & 63; c.wid = __builtin_amdgcn_readfirstlane(c.tid >> 6); c.G = gridDim.x; c.bid = blockIdx.x; c.lds = lds; return c; }

__device__ __forceinline__ void dpp_bcast_add(float& x) {
  asm("s_nop 1\n\tv_add_f32_dpp %0, %0, %0 row_bcast:15 row_mask:0xa\n\ts_nop 1\n\tv_add_f32_dpp %0, %0, %0 row_bcast:31 row_mask:0xc" : "+v"(x)); }
__device__ __forceinline__ void dpp_bcast_max(float& x) {
  asm("s_nop 1\n\tv_max_f32_dpp %0, %0, %0 row_bcast:15 row_mask:0xa\n\ts_nop 1\n\tv_max_f32_dpp %0, %0, %0 row_bcast:31 row_mask:0xc" : "+v"(x)); }
#define DPPB_(i, mod) "v_add_f32_dpp %" #i ", %" #i ", %" #i " " mod "\n\t"
__device__ __forceinline__ void dpp_bcast_add(float (&g)[8]) {
  asm("s_nop 1\n\t" DPPB_(0, "row_bcast:15 row_mask:0xa") DPPB_(1, "row_bcast:15 row_mask:0xa") DPPB_(2, "row_bcast:15 row_mask:0xa") DPPB_(3, "row_bcast:15 row_mask:0xa")
      DPPB_(4, "row_bcast:15 row_mask:0xa") DPPB_(5, "row_bcast:15 row_mask:0xa") DPPB_(6, "row_bcast:15 row_mask:0xa") DPPB_(7, "row_bcast:15 row_mask:0xa")
      DPPB_(0, "row_bcast:31 row_mask:0xc") DPPB_(1, "row_bcast:31 row_mask:0xc") DPPB_(2, "row_bcast:31 row_mask:0xc") DPPB_(3, "row_bcast:31 row_mask:0xc")
      DPPB_(4, "row_bcast:31 row_mask:0xc") DPPB_(5, "row_bcast:31 row_mask:0xc") DPPB_(6, "row_bcast:31 row_mask:0xc") DPPB_(7, "row_bcast:31 row_mask:0xc")
      : "+v"(g[0]), "+v"(g[1]), "+v"(g[2]), "+v"(g[3]), "+v"(g[4]), "+v"(g[5]), "+v"(g[6]), "+v"(g[7])); }
__device__ __forceinline__ void dpp_bcast_add(float (&g)[16]) {
  asm("s_nop 1\n\t" DPPB_(0, "row_bcast:15 row_mask:0xa") DPPB_(1, "row_bcast:15 row_mask:0xa") DPPB_(2, "row_bcast:15 row_mask:0xa") DPPB_(3, "row_bcast:15 row_mask:0xa")
      DPPB_(4, "row_bcast:15 row_mask:0xa") DPPB_(5, "row_bcast:15 row_mask:0xa") DPPB_(6, "row_bcast:15 row_mask:0xa") DPPB_(7, "row_bcast:15 row_mask:0xa")
      DPPB_(8, "row_bcast:15 row_mask:0xa") DPPB_(9, "row_bcast:15 row_mask:0xa") DPPB_(10, "row_bcast:15 row_mask:0xa") DPPB_(11, "row_bcast:15 row_mask:0xa")
      DPPB_(12, "row_bcast:15 row_mask:0xa") DPPB_(13, "row_bcast:15 row_mask:0xa") DPPB_(14, "row_bcast:15 row_mask:0xa") DPPB_(15, "row_bcast:15 row_mask:0xa")
      DPPB_(0, "row_bcast:31 row_mask:0xc") DPPB_(1, "row_bcast:31 row_mask:0xc") DPPB_(2, "row_bcast:31 row_mask:0xc") DPPB_(3, "row_bcast:31 row_mask:0xc")
      DPPB_(4, "row_bcast:31 row_mask:0xc") DPPB_(5, "row_bcast:31 row_mask:0xc") DPPB_(6, "row_bcast:31 row_mask:0xc") DPPB_(7, "row_bcast:31 row_mask:0xc")
      DPPB_(8, "row_bcast:31 row_mask:0xc") DPPB_(9, "row_bcast:31 row_mask:0xc") DPPB_(10, "row_bcast:31 row_mask:0xc") DPPB_(11, "row_bcast:31 row_mask:0xc")
      DPPB_(12, "row_bcast:31 row_mask:0xc") DPPB_(13, "row_bcast:31 row_mask:0xc") DPPB_(14, "row_bcast:31 row_mask:0xc") DPPB_(15, "row_bcast:31 row_mask:0xc")
      : "+v"(g[0]), "+v"(g[1]), "+v"(g[2]), "+v"(g[3]), "+v"(g[4]), "+v"(g[5]), "+v"(g[6]), "+v"(g[7]), "+v"(g[8]), "+v"(g[9]), "+v"(g[10]), "+v"(g[11]), "+v"(g[12]), "+v"(g[13]), "+v"(g[14]), "+v"(g[15])); }
#undef DPPB_
__device__ __forceinline__ float wave_sum(float x) {
  x += __builtin_bit_cast(float, __builtin_amdgcn_update_dpp(0, __builtin_bit_cast(int, x), 0x111, 0xf, 0xf, false));
  x += __builtin_bit_cast(float, __builtin_amdgcn_update_dpp(0, __builtin_bit_cast(int, x), 0x112, 0xf, 0xf, false));
  x += __builtin_bit_cast(float, __builtin_amdgcn_update_dpp(0, __builtin_bit_cast(int, x), 0x114, 0xf, 0xf, false));
  x += __builtin_bit_cast(float, __builtin_amdgcn_update_dpp(0, __builtin_bit_cast(int, x), 0x118, 0xf, 0xf, false));
  dpp_bcast_add(x);
  return __builtin_bit_cast(float, __builtin_amdgcn_readlane(__builtin_bit_cast(int, x), 63));
}
__device__ __forceinline__ float fsigmoid(float x) { return __builtin_amdgcn_rcpf(1.0f + __builtin_amdgcn_exp2f(-1.4426950408889634f * x)); }
__device__ __forceinline__ float fsilu(float x) { return x * fsigmoid(x); }
__device__ __forceinline__ float flog2sigmoid(float x) { const float y = x * 1.4426950408889634f; return fminf(y, 0.f) - __builtin_amdgcn_logf(1.0f + __builtin_amdgcn_exp2f(-fabsf(y))); }
typedef float f32x2_t __attribute__((ext_vector_type(2)));
typedef __bf16 bf16x2_t __attribute__((ext_vector_type(2)));
__device__ __forceinline__ unsigned pk_hw(float a, float b) { const f32x2_t v = {a, b}; return __builtin_bit_cast(unsigned, __builtin_convertvector(v, bf16x2_t)); }
__device__ __forceinline__ unsigned pk2(float a, float b) { return pk_hw(a, b); }
__device__ __forceinline__ void unpack8(u32x4 w, float* f) {
  f[0] = __uint_as_float(w.x << 16); f[1] = __uint_as_float(w.x & 0xffff0000u); f[2] = __uint_as_float(w.y << 16); f[3] = __uint_as_float(w.y & 0xffff0000u);
  f[4] = __uint_as_float(w.z << 16); f[5] = __uint_as_float(w.z & 0xffff0000u); f[6] = __uint_as_float(w.w << 16); f[7] = __uint_as_float(w.w & 0xffff0000u);
}

__device__ __forceinline__ void transpose_job(const Ctx& c, const float* src, int N, bf16_t* dst, int rs, int ro, int tile0, int tile_stride) {
  float* t = (float*)c.lds;
  const int ntn = (N + 63) / 64, ntiles = ntn * 16;
  for (int tl = tile0; tl < ntiles; tl += tile_stride) {
    const int kt = tl / ntn, nt_ = tl % ntn, k0 = kt * 64, n0 = nt_ * 64;
    __syncthreads();
#pragma unroll
    for (int i = 0; i < 8; ++i) { const int idx = c.tid + i * 512, kk = idx >> 6, nn = idx & 63; t[kk * 65 + nn] = (n0 + nn < N) ? src[(size_t)(k0 + kk) * N + n0 + nn] : 0.f; }
    __syncthreads();
#pragma unroll
    for (int i = 0; i < 4; ++i) { const int idx = c.tid + i * 512, nn = idx >> 5, kp = (idx & 31) * 2;
      if (n0 + nn < N) *(unsigned*)(dst + (size_t)((n0 + nn) * rs + ro) * 1024 + k0 + kp) = pk2(t[kp * 65 + nn], t[(kp + 1) * 65 + nn]); }
  }
  __syncthreads();
}
__device__ __forceinline__ void p0_prologue(unsigned char* lds_, int wv, const Params& p) {
  const Ctx c = make_ctx(lds_, wv);
  unsigned char* ws = p.ws;
  if (c.bid == 0) { ((unsigned*)(ws + WS_CTL))[64 + c.tid] = 0u; }
  if (c.bid == 0 && c.tid < 64) { ((unsigned*)(ws + WS_CTL))[1024 + c.tid] = 0u; }
  if (c.bid == 0) { for (int i = c.tid; i < 3456; i += NTHREADS) ((unsigned*)(ws + WS_CTL))[2048 + i] = 0u; }
  { const float* x = p.in[I_X]; bf16_t* hb = (bf16_t*)p.out;
    for (size_t i = (size_t)c.bid * NTHREADS + c.tid; i < (size_t)NTOK * 1024 / 8; i += (size_t)c.G * NTHREADS) {
      const f32x4 a = __builtin_nontemporal_load((const f32x4*)(x + i * 8)), b = __builtin_nontemporal_load((const f32x4*)(x + i * 8 + 4));
      u32x4 w; w.x = pk2(a[0], a[1]); w.y = pk2(a[2], a[3]); w.z = pk2(b[0], b[1]); w.w = pk2(b[2], b[3]);
      *(u32x4*)(hb + i * 8) = w; } }
  transpose_job(c, p.in[I_AB_W_IN], P_AB, (bf16_t*)(ws + WS_WIN_AB), 1, 0, c.bid, c.G);
  transpose_job(c, p.in[I_CD_W_IN], P_CD, (bf16_t*)(ws + WS_WIN_CD), 1, 0, c.bid, c.G);
  transpose_job(c, p.in[I_AB_W_OUT], 1024, (bf16_t*)(ws + WS_WOUT_AB), 1, 0, c.bid, c.G);
  transpose_job(c, p.in[I_CD_W_OUT], 1024, (bf16_t*)(ws + WS_WOUT_CD), 1, 0, c.bid, c.G);
  { float* rope = (float*)(ws + WS_ROPE);
    for (int i = c.bid * NTHREADS + c.tid; i < SEQ * 32; i += c.G * NTHREADS) { const int t = i >> 5, f = i & 31;
      const float freq = powf(10000.0f, -(float)f / 32.0f); const float ang = (float)t * freq; float* d = rope + ((size_t)(f >> 2) * SEQ + t) * 8 + (f & 3) * 2; d[0] = cosf(ang); d[1] = sinf(ang); }
    if (c.bid == 1) { const float* hl = p.in[I_HGRN_LB]; float* lb = (float*)(ws + WS_LB);
      const int cc = c.tid; const float a0 = hl[cc], a1 = hl[512 + cc], a2 = hl[1024 + cc]; const float mx = fmaxf(a0, fmaxf(a1, a2));
      const float e0 = expf(a0 - mx), e1 = expf(a1 - mx), e2 = expf(a2 - mx); lb[cc] = e0 / (e0 + e1 + e2); } }
}
__device__ __forceinline__ void moe_weight_convert(unsigned char* lds_, int wv, const Params& p, int layer, int part, int bidx, int nblk) {
  const Ctx c = make_ctx(lds_, wv);
  bf16_t* w13 = (bf16_t*)(p.ws + WS_W13); bf16_t* w2 = (bf16_t*)(p.ws + WS_W2);
  const size_t lo = (size_t)layer * NEXP * 1024 * 1024;
  const float* W1 = p.in[I_MOE_W1] + lo; const float* W3 = p.in[I_MOE_W3] + lo; const float* W2 = p.in[I_MOE_W2] + lo;
  float* t = (float*)c.lds;
  const int NT = (part == 0 ? 32 : 16) * 128;
  const int lk = c.tid >> 5, ln4 = (c.tid & 31) * 4;
  const int sn = c.tid & 127, sk = (c.tid >> 7) * 8;
  f32x4 ra[4], rb[4];
#define MW_SRC(g_) ((part == 0 ? ((((g_) >> 7) & 1) ? W3 : W1) + (size_t)((g_) >> 8) * 1048576 : W2 + (size_t)((g_) >> 7) * 1048576) + (size_t)((((g_) & 127) >> 3) * 64) * 1024 + ((g_) & 7) * 128)
#define MW_LOAD(r_, g_) do { const float* s_ = MW_SRC(g_); _Pragma("unroll") for (int i = 0; i < 4; ++i) r_[i] = *(const f32x4*)(s_ + (size_t)(lk + 16 * i) * 1024 + ln4); } while (0)
#define MW_TILE(r_, g_) do { \
    __syncthreads();                                \
    _Pragma("unroll") for (int i = 0; i < 4; ++i) *(f32x4*)(t + (lk + 16 * i) * 132 + ln4) = r_[i]; \
    __syncthreads(); \
    if ((g_) + 2 * nblk < NT) MW_LOAD(r_, (g_) + 2 * nblk); \
    const int m = (g_) >> 7, k0 = (((g_) & 127) >> 3) * 64, n0 = ((g_) & 7) * 128; \
    bf16_t* drow = (part == 1) ? w2 + ((size_t)m * 1024 + n0 + sn) * 1024 : w13 + ((size_t)(m >> 1) * 2048 + 2 * (n0 + sn) + (m & 1)) * 1024; \
    _Pragma("unroll") for (int j = 0; j < 2; ++j) { const int kk = sk + 32 * j; const float* s = t + kk * 132 + sn; \
      u32x4 w; w.x = pk2(s[0], s[132]); w.y = pk2(s[2 * 132], s[3 * 132]); w.z = pk2(s[4 * 132], s[5 * 132]); w.w = pk2(s[6 * 132], s[7 * 132]); \
      *(u32x4*)(drow + k0 + kk) = w; } } while (0)
  int g0 = bidx;
  if (g0 < NT) MW_LOAD(ra, g0);
  if (g0 + nblk < NT) MW_LOAD(rb, g0 + nblk);
#pragma unroll 1
  for (; g0 < NT; g0 += 2 * nblk) {
    MW_TILE(ra, g0);
    const int g1 = g0 + nblk;
    if (g1 < NT) MW_TILE(rb, g1);
  }
#undef MW_TILE
#undef MW_SRC
#undef MW_LOAD
  __syncthreads();
}
__device__ __forceinline__ void moe_weight_convert_tix(unsigned char* lds_, int wv, const Params& p, int layer, int part, unsigned* tix) {
  const Ctx c = make_ctx(lds_, wv);
  bf16_t* w13 = (bf16_t*)(p.ws + WS_W13); bf16_t* w2 = (bf16_t*)(p.ws + WS_W2);
  const size_t lo = (size_t)layer * NEXP * 1024 * 1024;
  const float* W1 = p.in[I_MOE_W1] + lo; const float* W3 = p.in[I_MOE_W3] + lo; const float* W2 = p.in[I_MOE_W2] + lo;
  float* t = (float*)c.lds;
  int* tk = (int*)(c.lds + 64 * 129 * 4);
  const int NT = (part == 0 ? 32 : 16) * 128;
  const int lk = c.tid >> 5, ln4 = (c.tid & 31) * 4;
  const int sn = c.tid & 127, sk = (c.tid >> 7) * 8;
  f32x4 r[4];
#define MW_SRC(g_) ((part == 0 ? ((((g_) >> 7) & 1) ? W3 : W1) + (size_t)((g_) >> 8) * 1048576 : W2 + (size_t)((g_) >> 7) * 1048576) + (size_t)((((g_) & 127) >> 3) * 64) * 1024 + ((g_) & 7) * 128)
#define MW_LOAD(g_) do { const float* s_ = MW_SRC(g_); _Pragma("unroll") for (int i = 0; i < 4; ++i) r[i] = __builtin_nontemporal_load((const f32x4*)(s_ + (size_t)(lk + 16 * i) * 1024 + ln4)); } while (0)
  __syncthreads();
  if (c.tid == 0) tk[0] = (int)atomicAdd(tix, 1u);
  __syncthreads();
  int g0 = __builtin_amdgcn_readfirstlane(tk[0]);
  if (g0 < NT) MW_LOAD(g0);
  while (g0 < NT) {
    __syncthreads();
    if (c.tid == 0) tk[0] = (int)atomicAdd(tix, 1u);
#pragma unroll
    for (int i = 0; i < 4; ++i) { float* d = t + (lk + 16 * i) * 129 + ln4; d[0] = r[i][0]; d[1] = r[i][1]; d[2] = r[i][2]; d[3] = r[i][3]; }
    __syncthreads();
    const int gn = __builtin_amdgcn_readfirstlane(tk[0]);
    if (gn < NT) MW_LOAD(gn);
    const int m = g0 >> 7, k0 = ((g0 & 127) >> 3) * 64, n0 = (g0 & 7) * 128;
    bf16_t* drow = (part == 1) ? w2 + ((size_t)m * 1024 + n0 + sn) * 1024 : w13 + ((size_t)(m >> 1) * 2048 + 2 * (n0 + sn) + (m & 1)) * 1024;
#pragma unroll
    for (int j = 0; j < 2; ++j) { const int kk = sk + 32 * j; const float* s = t + kk * 129 + sn;
      u32x4 w; w.x = pk2(s[0], s[129]); w.y = pk2(s[2 * 129], s[3 * 129]); w.z = pk2(s[4 * 129], s[5 * 129]); w.w = pk2(s[6 * 129], s[7 * 129]);
      *(u32x4*)(drow + k0 + kk) = w; }
    g0 = gn;
  }
#undef MW_SRC
#undef MW_LOAD
  __syncthreads();
}

struct ProbInProj {
  static constexpr bool PERM = true;
  pg8::StaticOrder so; const char* A; const char* Bt; bf16_t* P; const float* bias; const float* lb; int layer;
  __device__ __forceinline__ bool next(int i, pg8::Unit& u) const { return so.next(i, u); }
  __device__ __forceinline__ const char* a_base() const { return A; }
  __device__ __forceinline__ unsigned a_off(const pg8::Unit& u, int r) const { return (unsigned)(u.pm * 256 + r) * 2048u; }
  __device__ __forceinline__ const char* b_base(const pg8::Unit& u) const { return Bt + (size_t)u.pn * 256 * 2048; }
  __device__ __forceinline__ void epi(const f32x4 (&acc)[2][2][4][2], const pg8::Unit& u, int wr, int wc, int fr, int fq) const {
    const int row0 = u.row0 + wr * 64 + fr, colb = u.pn * 256 + wc * 32 + 8 * fq;
    int mode = 0;
    const bool tmaj = layer == 0 ? (u.pn < 8 || (u.pn >= 10 && u.pn < 14)) : (u.pn < 4 || u.pn == 10 || u.pn == 11);
    if (layer == 0) { mode = u.pn < 2 ? 1 : (u.pn < 6 ? 2 : (u.pn == 10 ? 3 : 0)); }
#pragma unroll
    for (int bj = 0; bj < 2; ++bj) {
      const int col0 = colb + bj * 128;
      const f32x4 b0 = *(const f32x4*)(bias + col0), b1 = *(const f32x4*)(bias + col0 + 4);
      f32x4 l0 = (f32x4){0.f, 0.f, 0.f, 0.f}, l1 = l0;
      if (mode == 2) { l0 = *(const f32x4*)(lb + ((col0 - 512) & 511)); l1 = *(const f32x4*)(lb + ((col0 - 512) & 511) + 4); }
#pragma unroll
      for (int ai = 0; ai < 2; ++ai)
#pragma unroll
        for (int m = 0; m < 4; ++m) {
          f32x4 v0 = acc[ai][bj][m][0] + b0, v1 = acc[ai][bj][m][1] + b1;
          if (mode == 1) {
#pragma unroll
            for (int j = 0; j < 4; ++j) { v0[j] = fsilu(v0[j]); v1[j] = fsilu(v1[j]); }
          } else if (mode == 2) {
#pragma unroll
            for (int j = 0; j < 4; ++j) { v0[j] = __builtin_amdgcn_logf(l0[j] + (1.0f - l0[j]) * fsigmoid(v0[j])); v1[j] = __builtin_amdgcn_logf(l1[j] + (1.0f - l1[j]) * fsigmoid(v1[j])); }
          } else if (mode == 3) { v0 *= 0.125f; v1 *= 0.125f; }
          u32x4 w; w.x = pk2(v0[0], v0[1]); w.y = pk2(v0[2], v0[3]); w.z = pk2(v1[0], v1[1]); w.w = pk2(v1[2], v1[3]);
          *(u32x4*)(P + (tmaj ? PIDX8(row0 + ai * 128 + m * 16, col0) : PIDX(row0 + ai * 128 + m * 16, col0))) = w;
        }
    }
  }
};
struct ProbOutProj {
  static constexpr bool PERM = true;
  pg8::StaticOrder so; const char* A; const char* Bt; bf16_t* Y; const bf16_t* Hres;
  __device__ __forceinline__ bool next(int i, pg8::Unit& u) const { return so.next(i, u); }
  __device__ __forceinline__ const char* a_base() const { return A; }
  __device__ __forceinline__ unsigned a_off(const pg8::Unit& u, int r) const { return (unsigned)(u.pm * 256 + r) * 2048u; }
  __device__ __forceinline__ const char* b_base(const pg8::Unit& u) const { return Bt + (size_t)u.pn * 256 * 2048; }
  __device__ __forceinline__ void epi(const f32x4 (&acc)[2][2][4][2], const pg8::Unit& u, int wr, int wc, int fr, int fq) const {
    const int row0 = u.row0 + wr * 64 + fr, colb = u.pn * 256 + wc * 32 + 8 * fq;
#pragma unroll
    for (int ai = 0; ai < 2; ++ai)
#pragma unroll
      for (int m = 0; m < 4; ++m) {
        const size_t ro = (size_t)(row0 + ai * 128 + m * 16) * 1024 + colb;
        const u32x4 h0 = *(const u32x4*)(Hres + ro), h1 = *(const u32x4*)(Hres + ro + 128);
#pragma unroll
        for (int bj = 0; bj < 2; ++bj) {
          float hf[8]; unpack8(bj ? h1 : h0, hf);
          const f32x4 v0 = acc[ai][bj][m][0], v1 = acc[ai][bj][m][1];
          u32x4 w; w.x = pk2(v0[0] + ALPHA_F * hf[0], v0[1] + ALPHA_F * hf[1]); w.y = pk2(v0[2] + ALPHA_F * hf[2], v0[3] + ALPHA_F * hf[3]);
          w.z = pk2(v1[0] + ALPHA_F * hf[4], v1[1] + ALPHA_F * hf[5]); w.w = pk2(v1[2] + ALPHA_F * hf[6], v1[3] + ALPHA_F * hf[7]);
          *(u32x4*)(Y + ro + bj * 128) = w;
        }
      }
  }
};
#define MOE_TAB_OFF (128 * 1024)
struct MoeOrder {
  const int* tab;
  __device__ __forceinline__ void init(const int* cnt, int ntn, int G, int c, unsigned char* lds, int wv) {
    int* t = (int*)(lds + MOE_TAB_OFF);
    const int tid = opaque_tid(wv);
    if (tid < 64) {
      int pad = 0, found = 0, ue = 0, upn = 0, upm = 0, urow = 0, une = 0;
      if ((G & 7) == 0) {
        const int x = c & 7; int q = tid * (G >> 3) + (c >> 3);
        for (int e = 0; e < NEXP; ++e) { const int n = cnt[e * 16], mt = (n + 255) >> 8; const int r = ((x - e) % 8 + 8) % 8; const int m = mt > r ? (mt - r - 1) / 8 + 1 : 0; const int units = m * ntn;
          if (!found && q < units) { ue = e; upm = r + 8 * (q % m); upn = q / m; urow = pad + upm * 256; une = n; found = 1; }
          if (!found) { q -= units; pad += mt * 256; } }
      } else {
        int L = tid * G + c;
        for (int e = 0; e < NEXP; ++e) { const int n = cnt[e * 16], mt = (n + 255) >> 8, tiles = mt * ntn;
          if (!found && L < tiles) { ue = e; upn = L / mt; upm = L % mt; urow = pad + upm * 256; une = n; found = 1; }
          if (!found) { L -= tiles; pad += mt * 256; } }
      }
      t[tid * 8 + 0] = found; t[tid * 8 + 1] = ue; t[tid * 8 + 2] = upn; t[tid * 8 + 3] = upm; t[tid * 8 + 4] = urow; t[tid * 8 + 5] = une;
    }
    __syncthreads();
    tab = t;
  }
  __device__ __forceinline__ bool next(int i, pg8::Unit& u) const {
    if (i >= 64) return false;
    const int* t = tab + i * 8;
    if (!__builtin_amdgcn_readfirstlane(t[0])) return false;
    u.e = __builtin_amdgcn_readfirstlane(t[1]); u.pn = __builtin_amdgcn_readfirstlane(t[2]); u.pm = __builtin_amdgcn_readfirstlane(t[3]);
    u.row0 = __builtin_amdgcn_readfirstlane(t[4]); u.ne = __builtin_amdgcn_readfirstlane(t[5]); u.ui = i; return true;
  }
};
struct ProbMoe1 {
  static constexpr bool PERM = true;
  MoeOrder mo; const char* A; const char* W13; const int* list; bf16_t* H; const int* ltok;
  __device__ __forceinline__ void stage_tokens(unsigned char* lds, int wv) {
    int* lt = (int*)(lds + MOE_TAB_OFF + 2048);
    const int tid = opaque_tid(wv);
    pg8::Unit u;
    for (int i = 0; i < 16 && mo.next(i, u); ++i) { if (tid < 256) { const int rr = u.pm * 256 + tid; lt[i * 256 + tid] = rr < u.ne ? list[u.e * NTOK + rr] : 0; } }
    __syncthreads();
    ltok = lt;
  }
  __device__ __forceinline__ bool next(int i, pg8::Unit& u) const { return mo.next(i, u); }
  __device__ __forceinline__ const char* a_base() const { return A; }
  __device__ __forceinline__ unsigned a_off(const pg8::Unit& u, int r) const { const int rr = u.pm * 256 + r; const int tok = rr < u.ne ? list[u.e * NTOK + rr] : 0; return (unsigned)tok * 2048u; }
  __device__ __forceinline__ const char* b_base(const pg8::Unit& u) const { return W13 + ((size_t)u.e * 2048 + (size_t)u.pn * 256) * 2048; }
  __device__ __forceinline__ void epi(const f32x4 (&acc)[2][2][4][2], const pg8::Unit& u, int wr, int wc, int fr, int fq) const {
    const int row0 = u.row0 + wr * 64 + fr, colb = u.pn * 128 + wc * 16 + 4 * fq;
#pragma unroll
    for (int ai = 0; ai < 2; ++ai)
#pragma unroll
      for (int m = 0; m < 4; ++m)
#pragma unroll
        for (int bj = 0; bj < 2; ++bj) {
          const f32x4 v0 = acc[ai][bj][m][0], v1 = acc[ai][bj][m][1];
          u32x2 w; w.x = pk2(fsilu(v0[0]) * v0[1], fsilu(v0[2]) * v0[3]); w.y = pk2(fsilu(v1[0]) * v1[1], fsilu(v1[2]) * v1[3]);
          *(u32x2*)(H + (size_t)(row0 + ai * 128 + m * 16) * 1024 + colb + bj * 64) = w;
        }
  }
};
struct ProbMoe2 {
  static constexpr bool PERM = true;
  MoeOrder mo; const char* A; const char* W2; bf16_t* Y;
  __device__ __forceinline__ bool next(int i, pg8::Unit& u) const { return mo.next(i, u); }
  __device__ __forceinline__ const char* a_base() const { return A; }
  __device__ __forceinline__ unsigned a_off(const pg8::Unit& u, int r) const { return (unsigned)(u.row0 + r) * 2048u; }
  __device__ __forceinline__ const char* b_base(const pg8::Unit& u) const { return W2 + ((size_t)u.e * 1024 + (size_t)u.pn * 256) * 2048; }
  __device__ __forceinline__ void epi(const f32x4 (&acc)[2][2][4][2], const pg8::Unit& u, int wr, int wc, int fr, int fq) const {
    const int row0 = u.row0 + wr * 64 + fr, colb = u.pn * 256 + wc * 32 + 8 * fq;
#pragma unroll
    for (int ai = 0; ai < 2; ++ai)
#pragma unroll
      for (int m = 0; m < 4; ++m)
#pragma unroll
        for (int bj = 0; bj < 2; ++bj) {
          const f32x4 v0 = acc[ai][bj][m][0], v1 = acc[ai][bj][m][1];
          u32x4 w; w.x = pk2(v0[0], v0[1]); w.y = pk2(v0[2], v0[3]); w.z = pk2(v1[0], v1[1]); w.w = pk2(v1[2], v1[3]);
          *(u32x4*)(Y + (size_t)(row0 + ai * 128 + m * 16) * 1024 + colb + bj * 128) = w;
        }
  }
};

template <int NS>
__device__ __forceinline__ void side_phase(unsigned char* lds_, int wv, const Params& p, int layer) {
  const Ctx c = make_ctx(lds_, wv);
  const bf16_t* hb = (const bf16_t*)p.out;
  const bf16_t* wt = (const bf16_t*)(p.ws + (layer == 0 ? WS_WIN_AB : WS_WIN_CD)) + (size_t)(layer == 0 ? PM_AB : PM_CD) * 1024;
  const float* bias = p.in[layer == 0 ? I_AB_B_IN : I_CD_B_IN] + (layer == 0 ? PM_AB : PM_CD);
  float* side = (float*)(p.ws + WS_SIDE);
  float* tl = (float*)c.lds + c.wid * (16 * 33);
  const int fr = c.lane & 15, fq = c.lane >> 4;
  for (int g = c.bid * 8 + c.wid; g < NTOK / 16; g += c.G * 8) {
    const int r0 = g * 16;
    f32x4 acc0 = (f32x4){0.f, 0.f, 0.f, 0.f}, acc1 = acc0;
    const bf16_t* ap = hb + (size_t)(r0 + fr) * 1024 + fq * 8;
    const bf16_t* bp0 = wt + (size_t)fr * 1024 + fq * 8; const bf16_t* bp1 = bp0 + 16 * 1024;
#pragma unroll 16
    for (int k = 0; k < 1024; k += 32) {
      const bf16x8 a = *(const bf16x8*)(ap + k), b0 = *(const bf16x8*)(bp0 + k);
      acc0 = __builtin_amdgcn_mfma_f32_16x16x32_bf16(a, b0, acc0, 0, 0, 0);
      if (NS == 32) { const bf16x8 b1 = *(const bf16x8*)(bp1 + k); acc1 = __builtin_amdgcn_mfma_f32_16x16x32_bf16(a, b1, acc1, 0, 0, 0); }
    }
    float gsc = 1.f, gfb = 0.f; bool gls = false;
    if (NS == 16) { gsc = 1.4426950408889634f; gls = (fr & 4) != 0; gfb = gls ? p.in[I_FGATE_B][(fr >> 3) * 4 + (fr & 3)] : 0.f; }
#pragma unroll
    for (int j = 0; j < 4; ++j) { float v0 = acc0[j] + bias[fr]; if (NS == 16) { v0 = gls ? flog2sigmoid(v0 + gfb) : v0 * gsc; side[(size_t)fr * NTOK + r0 + fq * 4 + j] = v0; }
      tl[(fq * 4 + j) * 33 + fr] = v0;
      if (NS == 32) { const float v1 = acc1[j] + bias[16 + fr]; tl[(fq * 4 + j) * 33 + 16 + fr] = v1; } }
    if (NS == 32) {
      __builtin_amdgcn_s_waitcnt(0xC07F);
      const float* gu = p.in[I_GK_UP]; const float* gb = p.in[I_GK_B]; bf16_t* lfb = (bf16_t*)(p.ws + WS_LFB);
      const int cb = c.lane * 8, dir = cb >> 8, cc = cb & 255;
      float w[16][8];
#pragma unroll
      for (int r = 0; r < 16; ++r)
#pragma unroll
        for (int j = 0; j < 8; ++j) w[r][j] = gu[(dir * 16 + r) * 256 + cc + j];
      float bb[8];
#pragma unroll
      for (int j = 0; j < 8; ++j) bb[j] = gb[dir * 256 + cc + j];
      for (int row = 0; row < 16; ++row) {
        float z[8];
#pragma unroll
        for (int j = 0; j < 8; ++j) z[j] = bb[j];
#pragma unroll
        for (int r = 0; r < 16; ++r) { const float s = tl[row * 33 + dir * 16 + r];
#pragma unroll
          for (int j = 0; j < 8; ++j) z[j] += s * w[r][j]; }
        u32x4 o; o.x = pk2(flog2sigmoid(z[0]) * 0.0625f, flog2sigmoid(z[1]) * 0.0625f); o.y = pk2(flog2sigmoid(z[2]) * 0.0625f, flog2sigmoid(z[3]) * 0.0625f);
        o.z = pk2(flog2sigmoid(z[4]) * 0.0625f, flog2sigmoid(z[5]) * 0.0625f); o.w = pk2(flog2sigmoid(z[6]) * 0.0625f, flog2sigmoid(z[7]) * 0.0625f);
        *(u32x4*)(lfb + PIDX8(r0 + row, cb)) = o;
      }
    }
  }
}

__device__ __forceinline__ void headnorm_phase(unsigned char* lds_, int wv, const Params& p, int layer) {
  const Ctx c = make_ctx(lds_, wv);
  const bf16_t* P = (const bf16_t*)(p.ws + WS_R1); const bf16_t* O = (const bf16_t*)(p.ws + WS_R2);
  bf16_t* mixed = (bf16_t*)(p.ws + WS_MIX);
  const int c0 = c.lane * 16, h8 = c.lane >> 3;
  const float* gain = layer == 0 ? (h8 < 4 ? p.in[I_HGRN_NORM] + c0 : p.in[I_GLA_NORM] + c0 - 512) : (h8 < 4 ? p.in[I_RET_NORM] + c0 : p.in[I_MLSTM_NORM] + c0 - 512);
  const int gcol = layer == 0 ? (h8 < 4 ? 2048 + c0 : 3584 + c0 - 512) : (h8 < 4 ? 1024 + c0 : 3072 + c0 - 512);
  float gn[16];
#pragma unroll
  for (int j = 0; j < 16; ++j) gn[j] = gain[j];
  const int tstride = c.G * 8;
  for (int tok0 = c.bid * 8 + c.wid; tok0 < NTOK; tok0 += 2 * tstride) {
    u32x4 ra[2][2], rb[2][2], rg[2][2];
#pragma unroll
    for (int u = 0; u < 2; ++u) { const int tok = tok0 + u * tstride < NTOK ? tok0 + u * tstride : tok0;
      const u32x4* a = (const u32x4*)(O + PIDX(tok, c0)); const u32x4* b = (const u32x4*)(O + (size_t)NTOK * 1024 + PIDX(tok, c0)); const u32x4* g = (const u32x4*)(P + PIDX(tok, gcol));
      ra[u][0] = __builtin_nontemporal_load(a); ra[u][1] = __builtin_nontemporal_load(a + 1); rb[u][0] = __builtin_nontemporal_load(b); rb[u][1] = __builtin_nontemporal_load(b + 1);
      rg[u][0] = __builtin_nontemporal_load(g); rg[u][1] = __builtin_nontemporal_load(g + 1); }
#pragma unroll
    for (int u = 0; u < 2; ++u) {
      const int tok = tok0 + u * tstride;
      float of[16], ob[16], gt[16];
      unpack8(ra[u][0], of); unpack8(ra[u][1], of + 8); unpack8(rb[u][0], ob); unpack8(rb[u][1], ob + 8); unpack8(rg[u][0], gt); unpack8(rg[u][1], gt + 8);
      float o[16]; float ss = 0.f;
#pragma unroll
      for (int j = 0; j < 16; ++j) { o[j] = of[j] + ob[j]; ss += o[j] * o[j]; }
      ss += __shfl_xor(ss, 1); ss += __shfl_xor(ss, 2); ss += __shfl_xor(ss, 4);
      const float r = 1.0f / sqrtf(ss * (1.0f / 128.0f) + NORM_EPS_F);
      unsigned w[8];
#pragma unroll
      for (int j = 0; j < 8; ++j) {
        float g0 = gt[2 * j], g1 = gt[2 * j + 1];
        if (layer == 1 && h8 >= 4) { g0 = fsigmoid(g0); g1 = fsigmoid(g1); } else { g0 = fsilu(g0); g1 = fsilu(g1); }
        w[j] = pk2(o[2 * j] * r * gn[2 * j] * g0, o[2 * j + 1] * r * gn[2 * j + 1] * g1);
      }
      if (tok < NTOK) { u32x4* d = (u32x4*)(mixed + (size_t)tok * 1024 + c0);
        d[0] = (u32x4){w[0], w[1], w[2], w[3]}; d[1] = (u32x4){w[4], w[5], w[6], w[7]}; }
    }
  }
}

__device__ __forceinline__ void ln_phase(unsigned char* lds_, int wv, const Params& p, int layer, int mode, int dry = 0) {
  const Ctx c = make_ctx(lds_, wv);
  unsigned char* ws = p.ws;
  const bf16_t* zin = (const bf16_t*)(ws + (mode == 0 ? WS_R2 : WS_MIX));
  const bool f32out = (mode == 1 && layer == 1);
  float* hout = dry ? (float*)(ws + WS_H) : p.out;
  bf16_t* hb = dry ? (bf16_t*)(ws + WS_H) : (mode == 0 ? (bf16_t*)(ws + WS_MIX) : (bf16_t*)p.out);
  const float* g = p.in[mode == 0 ? I_LN_MIX_G : I_LN_FFN_G] + layer * 1024; const float* b = p.in[mode == 0 ? I_LN_MIX_B : I_LN_FFN_B] + layer * 1024;
  unsigned* cnt = (unsigned*)(ws + WS_CTL) + CW_CNT(layer);
  int* list = (int*)(ws + WS_LIST) + (size_t)layer * NEXP * NTOK;
  int* assign = (int*)(ws + WS_ASSIGN); float* gate = (float*)(ws + WS_GATE);
  float* rwT = (float*)c.lds;
  int* lcnt = (int*)(c.lds + 65536); int* lbase = lcnt + 16; int* rec = lcnt + 32; float* recg = (float*)(rec + 4 * 2048);
  int pad[NEXP];
  if (mode == 0) { const float* r = p.in[I_ROUTER_W];
    for (int i = c.tid; i < 1024 * 16; i += NTHREADS) rwT[(i & 15) * 1024 + (i >> 4)] = r[i];
    if (c.tid < 16) lcnt[c.tid] = 0;
    __syncthreads(); }
  else { int acc = 0;
#pragma unroll
    for (int e = 0; e < NEXP; ++e) { pad[e] = acc; acc += (((int)cnt[e * 16] + 255) >> 8) << 8; } }
  const int c0 = c.lane * 4;
  float gv[16], bv[16];
#pragma unroll
  for (int q = 0; q < 4; ++q) { const f32x4 t0 = *(const f32x4*)(g + q * 256 + c0), t1 = *(const f32x4*)(b + q * 256 + c0);
#pragma unroll
    for (int j = 0; j < 4; ++j) { gv[4 * q + j] = t0[j]; bv[4 * q + j] = t1[j]; } }
  const int tstride = c.G * 8;
  int it = 0;
  for (int tok0 = c.bid * 8 + c.wid; tok0 < NTOK; tok0 += 2 * tstride, it += 2) {
    float v[2][16];
    float gy0[2], gy1[2];
#pragma unroll
    for (int u = 0; u < 2; ++u) {
      const int tok = tok0 + u * tstride;
      if (tok < NTOK) {
        const float sc = mode == 0 ? 1.0f : ALPHA_F;
#pragma unroll
        for (int q = 0; q < 4; ++q) { const u32x2 t = __builtin_nontemporal_load((const u32x2*)(zin + (size_t)tok * 1024 + q * 256 + c0));
          v[u][4 * q] = sc * __uint_as_float(t.x << 16); v[u][4 * q + 1] = sc * __uint_as_float(t.x & 0xffff0000u); v[u][4 * q + 2] = sc * __uint_as_float(t.y << 16); v[u][4 * q + 3] = sc * __uint_as_float(t.y & 0xffff0000u); }
        if (mode == 1) {
          const int a0 = assign[tok * 4], a1 = assign[tok * 4 + 1], a2 = assign[tok * 4 + 2], a3 = assign[tok * 4 + 3];
          gy0[u] = gate[tok * 2]; gy1[u] = gate[tok * 2 + 1];
          int p0 = 0, p1 = 0;
#pragma unroll
          for (int e = 0; e < NEXP; ++e) { if (e == a0) p0 = pad[e]; if (e == a2) p1 = pad[e]; }
          p0 += a1; p1 += a3;
          const bf16_t* Y = (const bf16_t*)(ws + WS_R2);
#pragma unroll
          for (int q = 0; q < 4; ++q) { const u32x2 y0 = __builtin_nontemporal_load((const u32x2*)(Y + (size_t)p0 * 1024 + q * 256 + c0)), y1 = __builtin_nontemporal_load((const u32x2*)(Y + (size_t)p1 * 1024 + q * 256 + c0));
            v[u][4 * q] += gy0[u] * __uint_as_float(y0.x << 16) + gy1[u] * __uint_as_float(y1.x << 16); v[u][4 * q + 1] += gy0[u] * __uint_as_float(y0.x & 0xffff0000u) + gy1[u] * __uint_as_float(y1.x & 0xffff0000u);
            v[u][4 * q + 2] += gy0[u] * __uint_as_float(y0.y << 16) + gy1[u] * __uint_as_float(y1.y << 16); v[u][4 * q + 3] += gy0[u] * __uint_as_float(y0.y & 0xffff0000u) + gy1[u] * __uint_as_float(y1.y & 0xffff0000u); }
        }
      } else {
#pragma unroll
        for (int j = 0; j < 16; ++j) v[u][j] = 0.f;
      }
    }
#pragma unroll
    for (int u = 0; u < 2; ++u) {
      const int tok = tok0 + u * tstride;
      float s = 0.f;
#pragma unroll
      for (int j = 0; j < 16; ++j) s += v[u][j];
      const float mean = wave_sum(s) * (1.0f / 1024.0f);
      float qq = 0.f;
#pragma unroll
      for (int j = 0; j < 16; ++j) { v[u][j] -= mean; qq += v[u][j] * v[u][j]; }
      const float r = 1.0f / sqrtf(wave_sum(qq) * (1.0f / 1024.0f) + LN_EPS_F);
#pragma unroll
      for (int j = 0; j < 16; ++j) v[u][j] = v[u][j] * r * gv[j] + bv[j];
      if (tok < NTOK) {
        if (f32out) {
#pragma unroll
          for (int q = 0; q < 4; ++q) __builtin_nontemporal_store((f32x4){v[u][4 * q], v[u][4 * q + 1], v[u][4 * q + 2], v[u][4 * q + 3]}, (f32x4*)(hout + (size_t)tok * 1024 + q * 256 + c0));
        } else {
#pragma unroll
          for (int q = 0; q < 4; ++q) *(u32x2*)(hb + (size_t)tok * 1024 + q * 256 + c0) = (u32x2){pk2(v[u][4 * q], v[u][4 * q + 1]), pk2(v[u][4 * q + 2], v[u][4 * q + 3])}; }
      }
      if (mode == 0) {
        float lg[16];
#pragma unroll
        for (int e = 0; e < 16; ++e) { float a = 0.f;
#pragma unroll
          for (int q = 0; q < 4; ++q) { const f32x4 w = *(const f32x4*)(rwT + e * 1024 + q * 256 + c0); a += v[u][4 * q] * w[0] + v[u][4 * q + 1] * w[1] + v[u][4 * q + 2] * w[2] + v[u][4 * q + 3] * w[3]; }
          lg[e] = a; }
#pragma unroll
        for (int e = 0; e < 16; ++e) lg[e] = wave_sum(lg[e]);
        int eo[2]; float go[2];
        route_from_logits(lg, p.in[I_ROUTER_B], eo, go);
        if (c.lane == 0 && tok < NTOK && !dry) {
          const int r1 = atomicAdd(lcnt + eo[0], 1), r2 = atomicAdd(lcnt + eo[1], 1);
          const int ri = (it + u) * 8 + c.wid;
          rec[ri * 4] = eo[0]; rec[ri * 4 + 1] = r1; rec[ri * 4 + 2] = eo[1]; rec[ri * 4 + 3] = r2; recg[ri * 2] = go[0]; recg[ri * 2 + 1] = go[1];
        }
      }
    }
  }
  if (mode == 0 && !dry) {
    __syncthreads();
    if (c.tid < 16) lbase[c.tid] = (int)atomicAdd(cnt + c.tid * 16, (unsigned)lcnt[c.tid]);
    __syncthreads();
    const int nrec = ((NTOK + c.G * 8 - 1) / (c.G * 8)) * 8;
    for (int ri = c.tid; ri < nrec; ri += NTHREADS) {
      const int tok = c.bid * 8 + (ri & 7) + (ri >> 3) * c.G * 8;
      if (tok < NTOK) {
        const int e1 = rec[ri * 4], e2 = rec[ri * 4 + 2]; const int r1 = rec[ri * 4 + 1] + lbase[e1], r2 = rec[ri * 4 + 3] + lbase[e2];
        list[e1 * NTOK + r1] = tok; list[e2 * NTOK + r2] = tok;
        assign[tok * 4] = e1; assign[tok * 4 + 1] = r1; assign[tok * 4 + 2] = e2; assign[tok * 4 + 3] = r2;
        gate[tok * 2] = recg[ri * 2]; gate[tok * 2 + 1] = recg[ri * 2 + 1];
      }
    }
  }
  __syncthreads();
}
#endif
#ifndef CPU_EMU
namespace scan {
typedef short bf16x8 __attribute__((ext_vector_type(8)));
typedef float f32x4 __attribute__((ext_vector_type(4)));
typedef unsigned u32x4 __attribute__((ext_vector_type(4)));
typedef unsigned u32x2 __attribute__((ext_vector_type(2)));
enum { MIX_A = 0, MIX_B = 1, MIX_C = 2, MIX_D = 3 };
constexpr int LD_T = 144;
constexpr int OFF_QS = 0, OFF_KS = 17408, OFF_QI = 34816, OFF_KT = 52224, OFF_VT = 70656, OFF_SC = 77568, OFF_ST = 86784, OFF_DEC = 99840, OFF_EM = 100352, OFF_DEN = 100608, OFF_CW = 100864, SCAN_LDS = 104960;

__device__ __forceinline__ float incl_scan_add(float x) {
  x += __builtin_bit_cast(float, __builtin_amdgcn_update_dpp(0, __builtin_bit_cast(int, x), 0x111, 0xf, 0xf, false));
  x += __builtin_bit_cast(float, __builtin_amdgcn_update_dpp(0, __builtin_bit_cast(int, x), 0x112, 0xf, 0xf, false));
  x += __builtin_bit_cast(float, __builtin_amdgcn_update_dpp(0, __builtin_bit_cast(int, x), 0x114, 0xf, 0xf, false));
  x += __builtin_bit_cast(float, __builtin_amdgcn_update_dpp(0, __builtin_bit_cast(int, x), 0x118, 0xf, 0xf, false));
  dpp_bcast_add(x);
  return x;
}
__device__ __forceinline__ float incl_scan_max(float x) {
  const int ninf = (int)0xff800000u;
  x = fmaxf(x, __builtin_bit_cast(float, __builtin_amdgcn_update_dpp(ninf, __builtin_bit_cast(int, x), 0x111, 0xf, 0xf, false)));
  x = fmaxf(x, __builtin_bit_cast(float, __builtin_amdgcn_update_dpp(ninf, __builtin_bit_cast(int, x), 0x112, 0xf, 0xf, false)));
  x = fmaxf(x, __builtin_bit_cast(float, __builtin_amdgcn_update_dpp(ninf, __builtin_bit_cast(int, x), 0x114, 0xf, 0xf, false)));
  x = fmaxf(x, __builtin_bit_cast(float, __builtin_amdgcn_update_dpp(ninf, __builtin_bit_cast(int, x), 0x118, 0xf, 0xf, false)));
  dpp_bcast_max(x);
  return x;
}
__device__ __forceinline__ float rdlane(float x, int l) { return __builtin_bit_cast(float, __builtin_amdgcn_readlane(__builtin_bit_cast(int, x), l)); }
__device__ __forceinline__ bf16x8 ldfrag(const unsigned char* base, int ld, int row, int kbyte) { return *(const bf16x8*)(base + row * ld + kbyte); }
__device__ __forceinline__ bf16x8 ldfrag2(const unsigned char* base, int ld, int row, int b0, int b1) {
  const u32x2 lo = *(const u32x2*)(base + row * ld + b0), hi = *(const u32x2*)(base + row * ld + b1);
  return __builtin_bit_cast(bf16x8, (u32x4){lo.x, lo.y, hi.x, hi.y}); }
__device__ __forceinline__ unsigned pk(float a, float b) { return pk_hw(a, b); }
__device__ __forceinline__ float lo16(unsigned w) { return __uint_as_float(w << 16); }
__device__ __forceinline__ float hi16(unsigned w) { return __uint_as_float(w & 0xffff0000u); }

__device__ __forceinline__ void lds_barrier() { asm volatile("s_waitcnt lgkmcnt(0)" ::: "memory"); __builtin_amdgcn_s_barrier(); asm volatile("" ::: "memory"); }
struct Raw { u32x4 a0, a1, b0, b1; f32x4 r0, r1; u32x2 v; float s0, s1; };

}

__device__ __forceinline__ void convd_phase(unsigned char* lds_, int wv, const Params& p) {
  const Ctx c = make_ctx(lds_, wv);
  bf16_t* P = (bf16_t*)(p.ws + WS_R1); bf16_t* QD = (bf16_t*)(p.ws + WS_LFB);
  const float* cw = p.in[I_CONV_W]; const float* cb = p.in[I_CONV_B];
  const int ch = c.lane * 16;
  float w0[16], w1[16], w2[16], bb[16];
#pragma unroll
  for (int j = 0; j < 16; ++j) { w0[j] = cw[ch + j]; w1[j] = cw[1024 + ch + j]; w2[j] = cw[2048 + ch + j]; bb[j] = cb[ch + j]; }
  for (int tok = c.bid * 8 + c.wid; tok < NTOK; tok += c.G * 8) {
    const int t = tok % SEQ;
    const bf16_t* row = P + PIDX(tok, 1536 + ch);
    float x0[16], x1[16], x2[16];
    { const u32x4* r1 = (const u32x4*)row; unpack8(r1[0], x1); unpack8(r1[1], x1 + 8); }
    if (t > 0) { const u32x4* r0 = (const u32x4*)(row - 128); unpack8(r0[0], x0); unpack8(r0[1], x0 + 8); }
    else {
#pragma unroll
      for (int j = 0; j < 16; ++j) x0[j] = 0.f; }
    if (t < SEQ - 1) { const u32x4* r2 = (const u32x4*)(row + 128); unpack8(r2[0], x2); unpack8(r2[1], x2 + 8); }
    else {
#pragma unroll
      for (int j = 0; j < 16; ++j) x2[j] = 0.f; }
    const float sc = ch < 512 ? 0.08838834764831845f : 1.0f;
    unsigned w[8];
#pragma unroll
    for (int j = 0; j < 8; ++j) {
      const float a0 = bb[2 * j] + w0[2 * j] * x0[2 * j] + w1[2 * j] * x1[2 * j] + w2[2 * j] * x2[2 * j];
      const float a1 = bb[2 * j + 1] + w0[2 * j + 1] * x0[2 * j + 1] + w1[2 * j + 1] * x1[2 * j + 1] + w2[2 * j + 1] * x2[2 * j + 1];
      w[j] = pk2(fsilu(a0) * sc, fsilu(a1) * sc);
    }
    bf16_t* d = (ch < 512) ? QD + PIDX8(tok, ch) : P + PIDX8(tok, 3584 + (ch - 512));
    *(u32x4*)d = (u32x4){w[0], w[1], w[2], w[3]}; *(u32x4*)(d + (size_t)NTOK * 8) = (u32x4){w[4], w[5], w[6], w[7]};
  }
}

#endif
#ifndef CPU_EMU
namespace scan2 {
using namespace scan;
#ifndef PROBE_ALLTILES
#define PROBE_ALLTILES 0
#endif
__device__ __forceinline__ float FMUL(float a, float b) { float r = a * b; asm("" : "+v"(r)); return r; }
constexpr int U_QI = 0, U_KS = 36864, U_VT = 73728, U_ST = 87552, U_DEC = 115200, U_EM = 116224, U_XCH = 116736, U_END = 134144;
typedef short s16x4 __attribute__((ext_vector_type(4)));
__device__ __forceinline__ bf16x8 ldfrag_tr(const unsigned char* p, int ld) {
  const s16x4 a = __builtin_amdgcn_ds_read_tr16_b64_v4i16((LAS s16x4*)p), b = __builtin_amdgcn_ds_read_tr16_b64_v4i16((LAS s16x4*)(p + 4 * ld));
  return (bf16x8){a.x, a.y, a.z, a.w, b.x, b.y, b.z, b.w}; }
template <int MIXER>
__device__ __forceinline__ void scan_item2(unsigned char* lds, int wv, const Params& p, int b, int h, int dir, int vs) {
  constexpr int DK = (MIXER == MIX_A || MIXER == MIX_D) ? 128 : 64;
  constexpr int NC = DK / 8;
  constexpr int LD_D = DK * 2 + 32;
  constexpr int NVT = MIXER == MIX_D ? 3 : 2;
  constexpr int NKD = DK / 32;
  constexpr int NST = (DK == 128) ? NVT : 1;
  constexpr int NCH = SEQ / 64;
  const int tid = opaque_tid(wv), lane0 = tid & 63, wid = __builtin_amdgcn_readfirstlane(tid >> 6);
  unsigned char* ws = p.ws;
  const bf16_t* P = (const bf16_t*)(ws + WS_R1);
  const bf16_t* LFBp = (const bf16_t*)(ws + WS_LFB);
  const float* side = (const float*)(ws + WS_SIDE);
  const float* rope = (const float*)(ws + WS_ROPE);
  bf16_t* O = (bf16_t*)(ws + WS_R2) + (size_t)dir * NTOK * 1024;
  int qcol, kcol, lfcol, vcol, ocol;
  if (MIXER == MIX_A) { qcol = h * 128; kcol = 0; lfcol = 512 + dir * 512 + h * 128; vcol = 1536 + h * 128 + vs * 32; ocol = h * 128 + vs * 32; }
  else if (MIXER == MIX_B) { qcol = 2560 + h * 64; kcol = 2816 + h * 64; lfcol = dir * 256 + h * 64; vcol = 3072 + h * 128 + vs * 32; ocol = 512 + h * 128 + vs * 32; }
  else if (MIXER == MIX_C) { qcol = h * 64; kcol = 256 + h * 64; lfcol = 0; vcol = 512 + h * 128 + vs * 32; ocol = h * 128 + vs * 32; }
  else { qcol = h * 128; kcol = 3584 + h * 128; lfcol = 0; vcol = 2560 + h * 128 + vs * 32; ocol = 512 + h * 128 + vs * 32; }
  const size_t tokbase = (size_t)b * SEQ;
  const int c0 = (MIXER == MIX_C) ? wid * 4 : wid * NC;
  for (int i = tid; i < 2 * 13824 / 4; i += NTHREADS) ((unsigned*)(lds + U_ST))[i] = 0u;

  if (MIXER == MIX_D) { for (int i = tid; i < 2 * 16 * 64; i += NTHREADS) { const int bf = i >> 10, r = 32 + ((i >> 6) & 15), j = i & 63; *(bf16_t*)(lds + U_VT + bf * 6912 + r * LD_T + j * 2) = (r == 32) ? (bf16_t)0x3F80 : (bf16_t)0; } }
  const float lgam2 = (MIXER == MIX_C) ? log1pf(-exp2f(-(5.0f + 2.0f * (float)h + (float)dir))) * 1.4426950408889634f : 0.f;
  const float fgb = (MIXER == MIX_D) ? p.in[I_FGATE_B][dir * 4 + h] : 0.f;
  float m_st = 0.f;
  __syncthreads();

  Raw R, Rn; u32x2 Rv, Rvn;
#if (PROBE_DUP & 8388608)
  Raw RD; u32x2 RvD; RD.a0 = RD.a1 = RD.b0 = RD.b1 = (u32x4){0u, 0u, 0u, 0u}; RvD = (u32x2){0u, 0u};
#endif
#define A_LOAD(R, Rv, n_) do { \
    const int ln_ = lane0; \
    const int t_ = dir ? (SEQ - 1 - ((n_) * 64 + ln_)) : ((n_) * 64 + ln_); \
    const size_t tk_ = tokbase + t_; \
    if (MIXER == MIX_A) { const bf16_t* qp_ = P + PIDX8(tk_, qcol + c0); const bf16_t* lp_ = P + PIDX8(tk_, lfcol + c0); \
      R.a0 = *(const u32x4*)qp_; R.a1 = *(const u32x4*)(qp_ + (size_t)NTOK * 8); R.b0 = *(const u32x4*)lp_; R.b1 = *(const u32x4*)(lp_ + (size_t)NTOK * 8); } \
    else if (MIXER == MIX_B) { R.a0 = *(const u32x4*)(P + PIDX8(tk_, qcol + c0)); R.a1 = *(const u32x4*)(P + PIDX8(tk_, kcol + c0)); R.b0 = *(const u32x4*)(LFBp + PIDX8(tk_, lfcol + c0)); } \
    else if (MIXER == MIX_C) { const u32x2 qa_ = *(const u32x2*)(P + PIDX8(tk_, qcol + c0)), qb_ = *(const u32x2*)(P + PIDX8(tk_, qcol + 32 + c0)), ka_ = *(const u32x2*)(P + PIDX8(tk_, kcol + c0)), kb_ = *(const u32x2*)(P + PIDX8(tk_, kcol + 32 + c0)); \
      R.a0 = (u32x4){qa_.x, qa_.y, qb_.x, qb_.y}; R.a1 = (u32x4){ka_.x, ka_.y, kb_.x, kb_.y}; \
      const float* rp_ = rope + ((size_t)(c0 >> 2) * SEQ + t_) * 8; R.r0 = *(const f32x4*)rp_; R.r1 = *(const f32x4*)(rp_ + 4); } \
    else { const bf16_t* qp_ = LFBp + PIDX8(tk_, qcol + c0); const bf16_t* kp_ = P + PIDX8(tk_, kcol + c0); \
      R.a0 = *(const u32x4*)qp_; R.a1 = *(const u32x4*)(qp_ + (size_t)NTOK * 8); R.b0 = *(const u32x4*)kp_; R.b1 = *(const u32x4*)(kp_ + (size_t)NTOK * 8); \
      R.s0 = side[(size_t)(dir * 8 + h) * NTOK + tk_]; R.s1 = side[(size_t)(dir * 8 + 4 + h) * NTOK + tk_]; } \
    Rv = *(const u32x2*)(P + PIDX8(tk_, vcol + wid * 4)); } while (0)

  float rr_next = 1.f, rr_cur = 1.f, dsold_next = 1.f, dsold_cur = 1.f, ws_next = 1.f, ws_cur = 1.f;
#define A_PREP(buf_, R, Rv) do { \
    const int lane = lane0; \
    float* DECb = (float*)(lds + U_DEC + (buf_) * 512); float* EMb = (float*)(lds + U_EM + (buf_) * 256); \
    unsigned char* QIb = lds + U_QI + (buf_) * 18432; unsigned char* KSb = lds + U_KS + (buf_) * 18432; \
    float q[NC], k[NC], g[NC]; \
    if (MIXER == MIX_A) { \
      const unsigned qw[8] = {R.a0.x, R.a0.y, R.a0.z, R.a0.w, R.a1.x, R.a1.y, R.a1.z, R.a1.w}, lw[8] = {R.b0.x, R.b0.y, R.b0.z, R.b0.w, R.b1.x, R.b1.y, R.b1.z, R.b1.w}; \
      _Pragma("unroll") for (int c = 0; c < 8; ++c) { q[2 * c] = lo16(qw[c]); q[2 * c + 1] = hi16(qw[c]); g[2 * c] = lo16(lw[c]); g[2 * c + 1] = hi16(lw[c]); } \
      _Pragma("unroll") for (int c = 0; c < NC; ++c) k[c] = 1.0f - __builtin_amdgcn_exp2f(g[c]); \
    } else if (MIXER == MIX_B) { \
      const unsigned qw[4] = {R.a0.x, R.a0.y, R.a0.z, R.a0.w}, kw[4] = {R.a1.x, R.a1.y, R.a1.z, R.a1.w}, lw[4] = {R.b0.x, R.b0.y, R.b0.z, R.b0.w}; \
      _Pragma("unroll") for (int c = 0; c < 4; ++c) { q[2 * c] = lo16(qw[c]); q[2 * c + 1] = hi16(qw[c]); k[2 * c] = lo16(kw[c]); k[2 * c + 1] = hi16(kw[c]); g[2 * c] = lo16(lw[c]); g[2 * c + 1] = hi16(lw[c]); } \
    } else if (MIXER == MIX_C) { \
      const float cs[4] = {R.r0[0], R.r0[2], R.r1[0], R.r1[2]}, sn[4] = {R.r0[1], R.r0[3], R.r1[1], R.r1[3]}; \
      const float q1[4] = {lo16(R.a0.x), hi16(R.a0.x), lo16(R.a0.y), hi16(R.a0.y)}, q2[4] = {lo16(R.a0.z), hi16(R.a0.z), lo16(R.a0.w), hi16(R.a0.w)}; \
      const float k1[4] = {lo16(R.a1.x), hi16(R.a1.x), lo16(R.a1.y), hi16(R.a1.y)}, k2[4] = {lo16(R.a1.z), hi16(R.a1.z), lo16(R.a1.w), hi16(R.a1.w)}; \
      _Pragma("unroll") for (int c = 0; c < 4; ++c) { q[c] = (q1[c] * cs[c] - q2[c] * sn[c]) * 0.125f; q[4 + c] = (q1[c] * sn[c] + q2[c] * cs[c]) * 0.125f; k[c] = k1[c] * cs[c] - k2[c] * sn[c]; k[4 + c] = k1[c] * sn[c] + k2[c] * cs[c]; } \
    } else { \
      const unsigned qw[8] = {R.a0.x, R.a0.y, R.a0.z, R.a0.w, R.a1.x, R.a1.y, R.a1.z, R.a1.w}, kw[8] = {R.b0.x, R.b0.y, R.b0.z, R.b0.w, R.b1.x, R.b1.y, R.b1.z, R.b1.w}; \
      _Pragma("unroll") for (int c = 0; c < 8; ++c) { q[2 * c] = lo16(qw[c]); q[2 * c + 1] = hi16(qw[c]); k[2 * c] = lo16(kw[c]); k[2 * c + 1] = hi16(kw[c]); } \
    } \
    if (MIXER == MIX_A || MIXER == MIX_B) { \
        \
      _Pragma("unroll") for (int c = 0; c < NC; ++c) g[c] += __builtin_bit_cast(float, __builtin_amdgcn_update_dpp(0, __builtin_bit_cast(int, g[c]), 0x111, 0xf, 0xf, false)); \
      _Pragma("unroll") for (int c = 0; c < NC; ++c) g[c] += __builtin_bit_cast(float, __builtin_amdgcn_update_dpp(0, __builtin_bit_cast(int, g[c]), 0x112, 0xf, 0xf, false)); \
      _Pragma("unroll") for (int c = 0; c < NC; ++c) g[c] += __builtin_bit_cast(float, __builtin_amdgcn_update_dpp(0, __builtin_bit_cast(int, g[c]), 0x114, 0xf, 0xf, false)); \
      _Pragma("unroll") for (int c = 0; c < NC; ++c) g[c] += __builtin_bit_cast(float, __builtin_amdgcn_update_dpp(0, __builtin_bit_cast(int, g[c]), 0x118, 0xf, 0xf, false)); \
      dpp_bcast_add(g); \
      float ev[NC]; \
      _Pragma("unroll") for (int c = 0; c < NC; ++c) { \
          \
        const float e = __builtin_amdgcn_exp2f(g[c]), r = __builtin_amdgcn_rcpf(e); \
        q[c] = FMUL(q[c], e); k[c] = FMUL(k[c], r);     \
        ev[c] = e; } \
      if (lane == 63) { _Pragma("unroll") for (int c = 0; c < NC / 4; ++c) *(f32x4*)(DECb + c0 + 4 * c) = (f32x4){ev[4 * c], ev[4 * c + 1], ev[4 * c + 2], ev[4 * c + 3]}; } \
    } else if (MIXER == MIX_C) { \
        \
      const float gl = (float)(lane + 1) * lgam2; \
      const float e = __builtin_amdgcn_exp2f(gl), r = __builtin_amdgcn_rcpf(e); \
      const float e63 = rdlane(e, 63); \
      _Pragma("unroll") for (int c = 0; c < NC; ++c) { q[c] = FMUL(q[c], e); k[c] = FMUL(k[c], r); } \
      if (lane < 4) { DECb[c0 + lane] = e63; DECb[32 + c0 + lane] = e63; } \
    } else { \
      const float li = R.s0, lf = R.s1;     \
      const float bc = incl_scan_add(lf); const float u = li - bc; const float pm = incl_scan_max(u); \
      const float cmax = rdlane(pm, 63), blast = rdlane(bc, 63); \
      const float a_i = bc + m_st, m_i = fmaxf(a_i, bc + pm); \
      const float d_alpha = __builtin_amdgcn_exp2f(bc - m_i + cmax), d_beta = __builtin_amdgcn_exp2f(u - cmax); \
      rr_next = __builtin_amdgcn_exp2f(m_st - cmax);     \
      const float m_new = fmaxf(blast + m_st, blast + cmax); \
        \
      dsold_next = __builtin_amdgcn_exp2f(blast + m_st - m_new); ws_next = __builtin_amdgcn_exp2f(blast + cmax - m_new); m_st = m_new; \
      _Pragma("unroll") for (int c = 0; c < NC; ++c) { q[c] = FMUL(q[c], d_alpha); k[c] = FMUL(k[c], d_beta); } \
      if (wid == 0) EMb[lane] = __builtin_amdgcn_exp2f(-m_i); \
    } \
    { unsigned pq[NC / 2], pks[NC / 2]; \
      _Pragma("unroll") for (int c = 0; c < NC / 2; ++c) { pq[c] = pk_hw(q[2 * c], q[2 * c + 1]); pks[c] = pk_hw(k[2 * c], k[2 * c + 1]); } \
      if (MIXER == MIX_C) { \
        *(u32x2*)(QIb + lane * LD_D + c0 * 2) = (u32x2){pq[0], pq[1]}; *(u32x2*)(QIb + lane * LD_D + (32 + c0) * 2) = (u32x2){pq[2], pq[3]}; \
        *(u32x2*)(KSb + lane * LD_D + c0 * 2) = (u32x2){pks[0], pks[1]}; *(u32x2*)(KSb + lane * LD_D + (32 + c0) * 2) = (u32x2){pks[2], pks[3]}; \
      } else { \
        _Pragma("unroll") for (int c = 0; c < NC / 8; ++c) { \
          *(u32x4*)(QIb + lane * LD_D + (c0 + 8 * c) * 2) = (u32x4){pq[4 * c], pq[4 * c + 1], pq[4 * c + 2], pq[4 * c + 3]}; \
          *(u32x4*)(KSb + lane * LD_D + (c0 + 8 * c) * 2) = (u32x4){pks[4 * c], pks[4 * c + 1], pks[4 * c + 2], pks[4 * c + 3]}; } } } \
    { unsigned char* VTb = lds + U_VT + (buf_) * 6912 + (wid * 4) * LD_T + lane * 2; \
      *(bf16_t*)(VTb + 0 * LD_T) = (bf16_t)(Rv.x & 0xffff); *(bf16_t*)(VTb + 1 * LD_T) = (bf16_t)(Rv.x >> 16); *(bf16_t*)(VTb + 2 * LD_T) = (bf16_t)(Rv.y & 0xffff); *(bf16_t*)(VTb + 3 * LD_T) = (bf16_t)(Rv.y >> 16); } \
  } while (0)
  f32x4 sacc[NST];
  f32x4 own_prev = (f32x4){0.f, 0.f, 0.f, 0.f}; float den_prev = 1.f, em_prev = 1.f;
#pragma unroll
  for (int i = 0; i < NST; ++i) sacc[i] = (f32x4){0.f, 0.f, 0.f, 0.f};
  A_LOAD(R, Rv, 0);
  A_PREP(0, R, Rv);
  A_LOAD(R, Rv, 1);
  A_LOAD(Rn, Rvn, 2);
  rr_cur = rr_next; dsold_cur = dsold_next; ws_cur = ws_next;
  lds_barrier();
#if (PROBE_DUP & 8388608)
#define SCAN_PROBE_LOAD(n_) { asm volatile("" :: "v"(RD.a0), "v"(RD.a1), "v"(RD.b0), "v"(RD.b1), "v"(RvD)); A_LOAD(RD, RvD, n_); }
#else
#define SCAN_PROBE_LOAD(n_)
#endif
#if (PROBE_DUP & (32768 | 131072))
#define SCAN_PROBE_PREP(RX, RvX) if ((PROBE_DUP & 32768) ? (DK == 128) : (DK == 64)) { const float m_sv_ = m_st; A_PREP(nb, RX, RvX); m_st = m_sv_; asm volatile("" : "+v"(RX.a0), "+v"(RX.a1), "+v"(RX.b0), "+v"(RX.b1), "+v"(RvX) :: "memory"); }
#else
#define SCAN_PROBE_PREP(RX, RvX)
#endif
#define SCAN_ITER(n_, RX, RvX) do { const int n = (n_); \
    const int cb = n & 1, nb = (n + 1) & 1; \
    if (n + 1 < NCH) { SCAN_PROBE_PREP(RX, RvX) A_PREP(nb, RX, RvX); if (n + 3 < NCH) { A_LOAD(RX, RvX, n + 3); SCAN_PROBE_LOAD(n + 3) } } \
    { \
      const int lane = lane0; \
      const int fr = lane & 15, fq = lane >> 4; \
      const int it = wid & 3, vt = wid >> 2; \
      const unsigned char* STc = lds + U_ST + cb * 13824; unsigned char* STn = lds + U_ST + nb * 13824; \
      const unsigned char* VTc = lds + U_VT + cb * 6912; \
      const unsigned char* QI = lds + U_QI + cb * 18432; const unsigned char* KS = lds + U_KS + cb * 18432; \
      const float* DECc = (const float*)(lds + U_DEC + cb * 512); const float* EMc = (const float*)(lds + U_EM + cb * 256); \
        \
        \
      bf16x8 qf[NKD], stf[NKD], dsf[NKD], ksf[2][NKD]; \
_Pragma("unroll") \
      for (int ks = 0; ks < NKD; ++ks) qf[ks] = ldfrag(QI, LD_D, it * 16 + fr, ks * 64 + fq * 16); \
_Pragma("unroll") \
      for (int ks = 0; ks < NKD; ++ks) stf[ks] = ldfrag(STc, LD_D, vt * 16 + fr, ks * 64 + fq * 16); \
_Pragma("unroll") \
      for (int ks = 0; ks < NKD; ++ks) dsf[ks] = (NVT == 3) ? ldfrag(STc, LD_D, 32 + fr, ks * 64 + fq * 16) : qf[ks]; \
_Pragma("unroll") \
      for (int j = 0; j < 2; ++j) { \
_Pragma("unroll") \
        for (int ks = 0; ks < NKD; ++ks) ksf[j][ks] = ldfrag(KS, LD_D, (2 * vt + j) * 16 + fr, ks * 64 + fq * 16); } \
      __builtin_amdgcn_sched_barrier(0); \
      f32x4 oacc = (f32x4){0.f, 0.f, 0.f, 0.f}, dacc = (f32x4){0.f, 0.f, 0.f, 0.f}; \
_Pragma("unroll") \
      for (int ks = 0; ks < NKD; ++ks) oacc = __builtin_amdgcn_mfma_f32_16x16x32_bf16(stf[ks], qf[ks], oacc, 0, 0, 0); \
      if (NVT == 3) { \
_Pragma("unroll") \
        for (int ks = 0; ks < NKD; ++ks) dacc = __builtin_amdgcn_mfma_f32_16x16x32_bf16(dsf[ks], qf[ks], dacc, 0, 0, 0); \
      } \
        \
      f32x4 sc[2]; \
_Pragma("unroll") \
      for (int j = 0; j < 2; ++j) { \
        f32x4 acc = (f32x4){0.f, 0.f, 0.f, 0.f}; \
_Pragma("unroll") \
        for (int ks = 0; ks < NKD; ++ks) acc = __builtin_amdgcn_mfma_f32_16x16x32_bf16(ksf[j][ks], qf[ks], acc, 0, 0, 0); \
        sc[j] = acc; } \
        \
        \
      const bf16x8 va_own = ldfrag2(VTc, LD_T, vt * 16 + fr, 64 * vt + fq * 8, 64 * vt + 32 + fq * 8), va_oth = ldfrag2(VTc, LD_T, (1 - vt) * 16 + fr, 64 * vt + fq * 8, 64 * vt + 32 + fq * 8); \
      const bf16x8 vd = (NVT == 3) ? ldfrag2(VTc, LD_T, 32 + fr, 64 * vt + fq * 8, 64 * vt + 32 + fq * 8) : va_own; \
      const int dts = (DK == 128) ? wid : (wid & 3); \
        \
      const unsigned char* ktp = KS + (fq * 8 + (fr >> 2)) * LD_D + (dts * 16 + (fr & 3) * 4) * 2; \
      const bf16x8 kf0 = ldfrag_tr(ktp, LD_D), kf1 = ldfrag_tr(ktp + 32 * LD_D, LD_D); \
      const f32x4 dc = *(const f32x4*)(DECc + dts * 16 + fq * 4); \
      bf16x8 vtf[NST][2]; \
_Pragma("unroll") \
      for (int s = 0; s < NST; ++s) { const int vt2 = (DK == 128) ? s : (wid >> 2); vtf[s][0] = ldfrag(VTc, LD_T, vt2 * 16 + fr, fq * 16); vtf[s][1] = ldfrag(VTc, LD_T, vt2 * 16 + fr, 64 + fq * 16); } \
      const float em = (NVT == 3) ? EMc[it * 16 + fr] : 0.f; \
        \
      const unsigned char* xprev = lds + U_XCH + (nb * 8 + (wid ^ 4)) * 1088; unsigned char* xown = lds + U_XCH + (cb * 8 + wid) * 1088; \
      const f32x4 pp = *(const f32x4*)(xprev + lane * 16); \
      const float pd = (NVT == 3) ? (*(const float*)(xprev + 1024 + fr * 4) + *(const float*)(lds + U_XCH + (nb * 8 + wid) * 1088 + 1024 + fr * 4)) : 1.f; \
      __builtin_amdgcn_sched_barrier(0); \
        \
      if (n > 0) { \
        float dn = 1.0f; \
        if (NVT == 3) dn = 1.0f / fmaxf(fabsf(den_prev + pd), em_prev); \
        const int i = it * 16 + fr; \
        const int ti = dir ? (SEQ - 1 - ((n - 1) * 64 + i)) : ((n - 1) * 64 + i); \
        const f32x4 o = (f32x4){FMUL(own_prev[0] + pp[0], dn), FMUL(own_prev[1] + pp[1], dn), FMUL(own_prev[2] + pp[2], dn), FMUL(own_prev[3] + pp[3], dn)}; \
        *(u32x2*)(O + PIDX(tokbase + ti, ocol + vt * 16 + fq * 4)) = (u32x2){pk_hw(o[0], o[1]), pk_hw(o[2], o[3])}; \
      } \
        \
_Pragma("unroll") \
      for (int s = 0; s < NST; ++s) { \
        const int dt = dts, vt2 = (DK == 128) ? s : (wid >> 2); \
        f32x4 acc = (MIXER == MIX_D) ? (f32x4){0.f, 0.f, 0.f, 0.f} : sacc[s]; \
        acc = __builtin_amdgcn_mfma_f32_16x16x32_bf16(kf0, vtf[s][0], acc, 0, 0, 0); \
        acc = __builtin_amdgcn_mfma_f32_16x16x32_bf16(kf1, vtf[s][1], acc, 0, 0, 0); \
        if (MIXER == MIX_D) { _Pragma("unroll") for (int e_ = 0; e_ < 4; ++e_) acc[e_] = FMUL(sacc[s][e_], dsold_cur) + FMUL(acc[e_], ws_cur); } \
        else { _Pragma("unroll") for (int e_ = 0; e_ < 4; ++e_) acc[e_] = FMUL(acc[e_], dc[e_]); } \
        sacc[s] = acc; \
        *(u32x2*)(STn + (vt2 * 16 + fr) * LD_D + (dt * 16 + fq * 4) * 2) = (u32x2){pk_hw(acc[0], acc[1]), pk_hw(acc[2], acc[3])}; \
      } \
        \
        \
        \
      const int thr = it * 16 + fr - fq * 4 - 32 * vt; \
      const u32x4 sb = (u32x4){pk_hw((0 <= thr) ? sc[0][0] : 0.f, (1 <= thr) ? sc[0][1] : 0.f), pk_hw((2 <= thr) ? sc[0][2] : 0.f, (3 <= thr) ? sc[0][3] : 0.f), \
                               pk_hw((16 <= thr) ? sc[1][0] : 0.f, (17 <= thr) ? sc[1][1] : 0.f), pk_hw((18 <= thr) ? sc[1][2] : 0.f, (19 <= thr) ? sc[1][3] : 0.f)}; \
      if (MIXER == MIX_D) { _Pragma("unroll") for (int e_ = 0; e_ < 4; ++e_) { oacc[e_] = FMUL(oacc[e_], rr_cur); dacc[e_] = FMUL(dacc[e_], rr_cur); } } \
      own_prev = __builtin_amdgcn_mfma_f32_16x16x32_bf16(va_own, __builtin_bit_cast(bf16x8, sb), oacc, 0, 0, 0); \
      const f32x4 oth = __builtin_amdgcn_mfma_f32_16x16x32_bf16(va_oth, __builtin_bit_cast(bf16x8, sb), (f32x4){0.f, 0.f, 0.f, 0.f}, 0, 0, 0); \
      *(f32x4*)(xown + lane * 16) = oth; \
      if (NVT == 3) { \
          \
        const f32x4 dp = __builtin_amdgcn_mfma_f32_16x16x32_bf16(vd, __builtin_bit_cast(bf16x8, sb), (f32x4){0.f, 0.f, 0.f, 0.f}, 0, 0, 0); \
        if (lane < 16) *(float*)(xown + 1024 + lane * 4) = dp[0]; \
        den_prev = __shfl(dacc[0], fr); em_prev = em; \
      } \
    } \
    rr_cur = rr_next; dsold_cur = dsold_next; ws_cur = ws_next; \
    lds_barrier(); \
  } while (0)
  static_assert(NCH % 2 == 0, "chunk count must be even");
#pragma unroll 1
  for (int n2 = 0; n2 < NCH; n2 += 2) { SCAN_ITER(n2, R, Rv); SCAN_ITER(n2 + 1, Rn, Rvn); }
  {
    const int lane = lane0, fr = lane & 15, fq = lane >> 4, it = wid & 3, vt = wid >> 2, pb = (NCH - 1) & 1;
    const unsigned char* xprev = lds + U_XCH + (pb * 8 + (wid ^ 4)) * 1088;
    const f32x4 pp = *(const f32x4*)(xprev + lane * 16);
    float dn = 1.0f;
    if (NVT == 3) { const float pd = *(const float*)(xprev + 1024 + fr * 4) + *(const float*)(lds + U_XCH + (pb * 8 + wid) * 1088 + 1024 + fr * 4); dn = 1.0f / fmaxf(fabsf(den_prev + pd), em_prev); }
    const int i = it * 16 + fr;
    const int ti = dir ? (SEQ - 1 - ((NCH - 1) * 64 + i)) : ((NCH - 1) * 64 + i);
    const f32x4 o = (f32x4){FMUL(own_prev[0] + pp[0], dn), FMUL(own_prev[1] + pp[1], dn), FMUL(own_prev[2] + pp[2], dn), FMUL(own_prev[3] + pp[3], dn)};
    *(u32x2*)(O + PIDX(tokbase + ti, ocol + vt * 16 + fq * 4)) = (u32x2){pk_hw(o[0], o[1]), pk_hw(o[2], o[3])};
  }
#undef SCAN_ITER
#undef A_LOAD
#undef A_PREP
}

template <int MIXER>
__device__ __forceinline__ void scan_dispatch2(unsigned char* lds, int wv, const Params& p, int id) {
  const int vs = id & 3, dir = (id >> 2) & 1, h = (id >> 3) & 3, b = id >> 5;
  scan_item2<MIXER>(lds, wv, p, b, h, dir, vs);
}
}

__device__ __forceinline__ void scan_phase2(unsigned char* lds, int wv, const Params& p, int layer, int convert) {
  bool light = false;
  for (int it0 = blockIdx.x; it0 < 256; it0 += gridDim.x) {
    const int xq = it0 & 7, yq = it0 >> 3, stream = (yq >> 2) * 8 + xq;
    const int item = (stream >> 5) * 128 + (stream & 31) * 4 + (yq & 3);
    if (layer == 0) { if (item < 128) scan2::scan_dispatch2<scan::MIX_A>(lds, wv, p, item); else scan2::scan_dispatch2<scan::MIX_B>(lds, wv, p, item - 128); }
    else { if (item < 128) scan2::scan_dispatch2<scan::MIX_D>(lds, wv, p, item); else scan2::scan_dispatch2<scan::MIX_C>(lds, wv, p, item - 128); }
    light = item >= 128;
    __syncthreads();
  }
  if (convert) {
    const int G = gridDim.x, b = blockIdx.x;
    if (G == 256) { if (light) { moe_weight_convert(lds, wv, p, layer, 0, b - 128, 128); } }
#if (PROBE_DUP & (524288 | 1048576))
    if (G == 256 && layer == ((PROBE_DUP & 524288) ? 0 : 1)) { if (light) { moe_weight_convert(lds, wv, p, layer, 0, b - 128, 128); } }
#endif
    else { moe_weight_convert(lds, wv, p, layer, 0, b, G); }
  }
}
#endif
#ifndef CPU_EMU
#define XB_BASE     2048
#define XB_TMO      (XB_BASE + 128)
#define XB_XCNT(j)  (XB_BASE + 256  + 64 * (j))
#define XB_XSUB(j)  (XB_BASE + 1280 + 64 * (j))
#define XB_XGEN(j)  (XB_BASE + 2304 + 64 * (j))
#define XB_TOP      (XB_BASE + 3328)
#define XB_TOPGEN   (XB_BASE + 3392)
#define XB_WORDS    3456
#define XB_SPIN_CAP (1u << 22)
#define XB_LDS_OFF  (LDS_BYTES - 16)
__device__ __forceinline__ unsigned xb_ld(unsigned* p)              { return __hip_atomic_load(p, __ATOMIC_RELAXED, __HIP_MEMORY_SCOPE_AGENT); }
__device__ __forceinline__ unsigned xb_add(unsigned* p, unsigned v) { return __hip_atomic_fetch_add(p, v, __ATOMIC_RELAXED, __HIP_MEMORY_SCOPE_AGENT); }
__device__ __forceinline__ unsigned xb_xcc_id() { return (unsigned)__builtin_amdgcn_s_getreg((3 << 11) | 20) & 0xFu; }
#define XB_SPIN(cond, bar) do { unsigned _sp = 0; while (cond) { __builtin_amdgcn_s_sleep(1); \
    if ((++_sp & 255u) == 0u) { if (xb_ld(&(bar)[XB_TMO])) break; if (_sp > XB_SPIN_CAP) { atomicAdd(&(bar)[XB_TMO], 1u); break; } } } } while (0)
__device__ __forceinline__ void grid_bar(unsigned* bar, unsigned char* lds_raw, int wv) {
  asm volatile("s_waitcnt vmcnt(0)" ::: "memory");
  __syncthreads();
  if (wv == 0 && lane_id() == 0) {
    volatile unsigned* st = (volatile unsigned*)(lds_raw + XB_LDS_OFF);
    __builtin_amdgcn_s_waitcnt(0);
    const unsigned x = xb_xcc_id();
    unsigned nloc = st[0], nx = st[1];
    const unsigned k = st[2];
    if (nloc == 0u) {
      const unsigned G = gridDim.x; unsigned sum, cnt, mine, sp = 0u;
      for (;;) { sum = 0u; cnt = 0u; mine = 0u;
#pragma unroll
        for (unsigned j = 0; j < 16; ++j) { const unsigned c = xb_ld(&bar[XB_XCNT(j)]); sum += c; cnt += (c > 0u) ? 1u : 0u; mine = (j == x) ? c : mine; }
        if (sum == G) break;
        __builtin_amdgcn_s_sleep(1);
        if ((++sp & 255u) == 0u) { if (xb_ld(&bar[XB_TMO])) break; if (sp > XB_SPIN_CAP) { atomicAdd(&bar[XB_TMO], 1u); break; } } }
      nloc = mine > 0u ? mine : 1u; nx = cnt > 0u ? cnt : 1u; st[0] = nloc; st[1] = nx;
    }
    st[2] = k + 1u;
    const unsigned old = xb_add(&bar[XB_XSUB(x)], 1u);
    if (old + 1u == (k + 1u) * nloc) {
      __builtin_amdgcn_fence(__ATOMIC_RELEASE, "agent");
      asm volatile("s_waitcnt vmcnt(0)" ::: "memory");
      (void)xb_add(&bar[XB_TOP], 1u);
    }
    XB_SPIN(xb_ld(&bar[XB_TOP]) < (k + 1u) * nx, bar);
    __builtin_amdgcn_fence(__ATOMIC_ACQUIRE, "agent");
    asm volatile("s_waitcnt vmcnt(0)" ::: "memory");
  }
  __syncthreads();
}
#if (PROBE_DUP & 16)
#define grid_bar(a, b, c) do { grid_bar(a, b, c); grid_bar(a, b, c); } while (0)
#endif

__global__ void __launch_bounds__(NTHREADS) mk_fwd(Params p) {
  extern __shared__ __attribute__((aligned(16))) unsigned char lds_raw[];
  cg::grid_group grid = cg::this_grid();
  const int G = gridDim.x, bid = blockIdx.x;
  const int wv = __builtin_amdgcn_readfirstlane(threadIdx.x >> 6);
  PG8_LAS unsigned char* lds = (PG8_LAS unsigned char*)lds_raw;
  unsigned char* ws = p.ws;

  if (threadIdx.x < 4) ((unsigned*)(lds_raw + XB_LDS_OFF))[threadIdx.x] = 0u;
  p0_prologue(lds_raw, wv, p);
#if (PROBE_DUP & 128)
  p0_prologue(lds_raw, wv, p);
#endif
  grid.sync();
  unsigned* bar = (unsigned*)(ws + WS_CTL);
  if (wv == 0 && lane_id() == 0) (void)xb_add(&bar[XB_XCNT(xb_xcc_id())], 1u);
  for (int layer = 0; layer < 2; ++layer) {
    { ProbInProj pr; pr.so.init(NTOK, layer == 0 ? PM_AB : PM_CD, G, bid); pr.A = (const char*)p.out; pr.Bt = (const char*)(ws + (layer == 0 ? WS_WIN_AB : WS_WIN_CD));
      pr.P = (bf16_t*)(ws + WS_R1); pr.bias = p.in[layer == 0 ? I_AB_B_IN : I_CD_B_IN]; pr.lb = (const float*)(ws + WS_LB); pr.layer = layer;
      pg8::gemm_phase(lds, pr, wv);
#if (PROBE_DUP & (1 | 2048))
      pg8::gemm_phase(lds, pr, wv);
#endif
      if (layer == 0) side_phase<32>(lds_raw, wv, p, 0); else side_phase<16>(lds_raw, wv, p, 1);
#if (PROBE_DUP & 256)
      if (layer == 0) side_phase<32>(lds_raw, wv, p, 0); else side_phase<16>(lds_raw, wv, p, 1);
#endif
 }
    grid_bar(bar, lds_raw, wv);
    if (layer == 1) { convd_phase(lds_raw, wv, p); grid_bar(bar, lds_raw, wv); }
    scan_phase2(lds_raw, wv, p, layer, 1);
#if (PROBE_DUP & 2)
    scan_phase2(lds_raw, wv, p, layer, 0);
#endif
#if (PROBE_DUP & 512)
    if (layer == 0) scan_phase2(lds_raw, wv, p, layer, 0);
#endif
#if (PROBE_DUP & 1024)
    if (layer == 1) scan_phase2(lds_raw, wv, p, layer, 0);
#endif
    grid_bar(bar, lds_raw, wv);
    headnorm_phase(lds_raw, wv, p, layer);
#if (PROBE_DUP & 8)
    headnorm_phase(lds_raw, wv, p, layer);
#endif
    grid_bar(bar, lds_raw, wv);
    { ProbOutProj pr; pr.so.init(NTOK, 1024, G, bid); pr.A = (const char*)(ws + WS_MIX); pr.Bt = (const char*)(ws + (layer == 0 ? WS_WOUT_AB : WS_WOUT_CD)); pr.Y = (bf16_t*)(ws + WS_R2); pr.Hres = (const bf16_t*)p.out;
      pg8::gemm_phase(lds, pr, wv);
#if (PROBE_DUP & (1 | 16384))
      pg8::gemm_phase(lds, pr, wv);
#endif
 }
    grid_bar(bar, lds_raw, wv);
#if (PROBE_DUP & 32)
    ln_phase(lds_raw, wv, p, layer, 0, 1);
#endif
    ln_phase(lds_raw, wv, p, layer, 0);
    grid_bar(bar, lds_raw, wv);
    { ProbMoe1 pr; pr.mo.init((const int*)((const unsigned*)(ws + WS_CTL) + CW_CNT(layer)), 8, G, bid, lds_raw, wv);
      pr.A = (const char*)(ws + WS_MIX); pr.W13 = (const char*)(ws + WS_W13); pr.list = (const int*)(ws + WS_LIST) + (size_t)layer * NEXP * NTOK; pr.H = (bf16_t*)(ws + WS_H);
      pg8::gemm_phase(lds, pr, wv);
#if (PROBE_DUP & (1 | 4096))
      pg8::gemm_phase(lds, pr, wv);
#endif
      moe_weight_convert_tix(lds_raw, wv, p, layer, 1, (unsigned*)(ws + WS_CTL) + CW_TIX(layer, 1));
 }
    grid_bar(bar, lds_raw, wv);
    { ProbMoe2 pr; pr.mo.init((const int*)((const unsigned*)(ws + WS_CTL) + CW_CNT(layer)), 4, G, bid, lds_raw, wv);
      pr.A = (const char*)(ws + WS_H); pr.W2 = (const char*)(ws + WS_W2); pr.Y = (bf16_t*)(ws + WS_R2);
      pg8::gemm_phase(lds, pr, wv);
#if (PROBE_DUP & (1 | 8192))
      pg8::gemm_phase(lds, pr, wv);
#endif
 }
    grid_bar(bar, lds_raw, wv);
#if (PROBE_DUP & 64)
    ln_phase(lds_raw, wv, p, layer, 1, 1);
#endif
    ln_phase(lds_raw, wv, p, layer, 1);
    if (layer == 0) grid_bar(bar, lds_raw, wv);
  }
}

extern "C" void kernel_launch(void* const* d_in, const int* in_sizes, int n_in, void* d_out, int out_size, void* d_ws, size_t ws_size, hipStream_t stream) {
  static int grid_blocks = 0;
  if (grid_blocks == 0) {
    if (n_in != N_IN || ws_size < WS_END || out_size != NTOK * 1024) { fprintf(stderr, "kernel_launch: bad shapes: n_in %d ws %zu (need %zu) out %d\n", n_in, ws_size, (size_t)WS_END, out_size); grid_blocks = -1; return; }
    int dev = 0, cus = 0, per_cu = 0;
    hipGetDevice(&dev); hipDeviceGetAttribute(&cus, hipDeviceAttributeMultiprocessorCount, dev);
    if (hipFuncSetAttribute((const void*)mk_fwd, hipFuncAttributeMaxDynamicSharedMemorySize, LDS_BYTES) != hipSuccess) { fprintf(stderr, "kernel_launch: hipFuncSetAttribute failed\n"); grid_blocks = -1; return; }
    if (hipOccupancyMaxActiveBlocksPerMultiprocessor(&per_cu, (const void*)mk_fwd, NTHREADS, LDS_BYTES) != hipSuccess || per_cu < 1) { fprintf(stderr, "kernel_launch: occupancy query failed (%d)\n", per_cu); grid_blocks = -1; return; }
    grid_blocks = cus;
    (void)in_sizes;
  }
  if (grid_blocks < 0) return;
  Params p{};
  for (int i = 0; i < N_IN; ++i) p.in[i] = (const float*)d_in[i];
  p.out = (float*)d_out; p.ws = (unsigned char*)d_ws;
  void* args[] = {&p};
  hipError_t e = hipLaunchCooperativeKernel((const void*)mk_fwd, dim3(grid_blocks), dim3(NTHREADS), args, LDS_BYTES, stream);
  if (e != hipSuccess) fprintf(stderr, "cooperative launch failed: %s (grid %d)\n", hipGetErrorString(e), grid_blocks);
}
#endif
```

```cpp
#ifdef CPU_EMU
#include <cmath>
#include <cstdio>
#include <cstring>
#include <cstdlib>
#include <cstddef>
#define DEV
#define DEV_INLINE static inline
typedef void* hipStream_t;
#else
#include <hip/hip_runtime.h>
#include <hip/hip_bf16.h>
#include <cstdio>
#define DEV __device__ __forceinline__
#define DEV_INLINE __device__ __forceinline__
#endif
#ifndef PROBE_DUP
#define PROBE_DUP 0
#endif
#ifndef BATCH
#define BATCH 4
#endif
#ifndef SEQ
#define SEQ 8192
#endif
#define DM 1024
#define NTOK (BATCH * SEQ)
#define P_AB 4128
#define P_CD 3600
#define PM_AB 4096
#define PM_CD 3584
#define NEXP 16
#define ALPHA_F 1.4142135623730951f
#define LN_EPS_F 1e-5f
#define NORM_EPS_F 1e-6f
#define HROWS (2 * NTOK + NEXP * 256)

typedef unsigned short bf16_t;

DEV_INLINE float bf2f(bf16_t b) { unsigned u = ((unsigned)b) << 16; float f; memcpy(&f, &u, 4); return f; }
DEV_INLINE bf16_t f2bf(float f) { unsigned u; memcpy(&u, &f, 4); u += 0x7FFFu + ((u >> 16) & 1u); return (bf16_t)(u >> 16); }
DEV_INLINE float sigmoidf_(float x) { return 1.0f / (1.0f + expf(-x)); }
DEV_INLINE float siluf_(float x) { return x / (1.0f + expf(-x)); }
DEV_INLINE float logsigmoidf_(float x) { return fminf(x, 0.0f) - log1pf(expf(-fabsf(x))); }

#define AL256(x) (((size_t)(x) + 255) & ~(size_t)255)
#define WS_CTL    ((size_t)0)
#define WS_HB     ((size_t)65536)
#define WS_R1     (WS_HB + (size_t)NTOK * 1024 * 2)
#define R1_P_BYTES ((size_t)NTOK * 4096 * 2)
#define R1_MIN    ((size_t)NTOK * 1024 * 2 + AL256((size_t)HROWS * 1024 * 2))
#define R1_PL     (R1_P_BYTES + (size_t)NTOK * 512 * 2)
#define R1_BYTES  (R1_PL > R1_MIN ? R1_PL : R1_MIN)
#define WS_LFB    (WS_R1 + R1_P_BYTES)
#define WS_MIX    (WS_R1)
#define WS_H      (WS_R1 + (size_t)NTOK * 1024 * 2)
#define WS_W13    (WS_HB)
#define WS_W2     (WS_LFB)
#define WMOE_BYTES ((size_t)NEXP * 3072 * 1024 * 2)
#define WS_R2     (WS_R1 + R1_BYTES)
#define R2_BYTES  ((size_t)HROWS * 1024 * 2 > (size_t)NTOK * 1024 * 4 ? (size_t)HROWS * 1024 * 2 : (size_t)NTOK * 1024 * 4)
#define WS_SIDE   (WS_R2 + AL256(R2_BYTES))
#define WS_WIN_AB (WS_SIDE + (size_t)NTOK * 32 * 4)
#define WS_WIN_CD (WS_WIN_AB + (size_t)4128 * 1024 * 2)
#define WS_WOUT_AB (WS_WIN_CD + (size_t)3600 * 1024 * 2)
#define WS_WOUT_CD (WS_WOUT_AB + (size_t)1024 * 1024 * 2)
#define WS_ROPE   (WS_WOUT_CD + (size_t)1024 * 1024 * 2)
#define WS_LB     (WS_ROPE + (size_t)SEQ * 64 * 4)
#define WS_LIST   (WS_LB + 4096)
#define WS_ASSIGN (WS_LIST + (size_t)2 * NEXP * NTOK * 4)
#define WS_GATE   (WS_ASSIGN + (size_t)NTOK * 16)
#define WS_END    (WS_GATE + (size_t)NTOK * 8)
#define CW_CNT(layer) (64 + 256 * (layer))
#define CW_TIX(layer, part) (1024 + 16 * (2 * (layer) + (part)))

#define PSTRIDE 4096
#define PIDX(tok, col) ((((size_t)((col) >> 7)) * NTOK + (size_t)(tok)) * 128 + (size_t)((col) & 127))
#define PIDX8(tok, col) ((((size_t)((col) >> 3)) * NTOK + (size_t)(tok)) * 8 + (size_t)((col) & 7))

enum { I_X, I_AB_W_IN, I_AB_B_IN, I_HGRN_LB, I_GK_UP, I_GK_B, I_HGRN_NORM, I_GLA_NORM, I_AB_W_OUT,
       I_CD_W_IN, I_CD_B_IN, I_CONV_W, I_CONV_B, I_FGATE_B, I_RET_NORM, I_MLSTM_NORM, I_CD_W_OUT,
       I_LN_MIX_G, I_LN_MIX_B, I_LN_FFN_G, I_LN_FFN_B, I_ROUTER_W, I_ROUTER_B, I_MOE_W1, I_MOE_W3, I_MOE_W2, N_IN };

struct Params {
  const float* in[N_IN];
  float* out;
  unsigned char* ws;
};

DEV_INLINE float epi_ab(int col, float v, const float* lb) {
  if (col < 512) return siluf_(v);
  if (col < 1536) { float l = lb[(col - 512) & 511]; return logf(l + (1.0f - l) * sigmoidf_(v)); }
  if (col >= 2560 && col < 2816) return v * 0.125f;
  return v;
}

DEV_INLINE void route_from_logits(const float* lg, const float* rb, int* e_out, float* g_out) {
  float mx = lg[0];
#pragma unroll
  for (int e = 1; e < 16; ++e) mx = fmaxf(mx, lg[e]);
  float sc[16]; float sum = 0.f;
#pragma unroll
  for (int e = 0; e < 16; ++e) { sc[e] = expf(lg[e] - mx); sum += sc[e]; }
  float inv = 1.0f / sum;
  float best_gs = -1e30f; int be1 = 0, be2 = 1; float bs1 = 0.f, bs2 = 0.f;
#pragma unroll
  for (int gq = 0; gq < 4; ++gq) {
    float m1 = -1e30f, m2 = -1e30f, s1 = 0.f, s2 = 0.f; int i1 = 0, i2 = 0;
#pragma unroll
    for (int i = 0; i < 4; ++i) {
      float s = sc[gq * 4 + i] * inv; float v = s + rb[gq * 4 + i];
      if (v > m1) { m2 = m1; i2 = i1; s2 = s1; m1 = v; i1 = gq * 4 + i; s1 = s; }
      else if (v > m2) { m2 = v; i2 = gq * 4 + i; s2 = s; }
    }
    float gs = m1 + m2;
    if (gs > best_gs) { best_gs = gs; be1 = i1; be2 = i2; bs1 = s1; bs2 = s2; }
  }
  e_out[0] = be1; e_out[1] = be2; g_out[0] = bs1 / (bs1 + bs2); g_out[1] = bs2 / (bs1 + bs2);
}
#ifndef CPU_EMU
namespace pg8 {
#define PG8_LAS __attribute__((address_space(3)))
typedef short bf16x8 __attribute__((ext_vector_type(8)));
typedef float f32x4 __attribute__((ext_vector_type(4)));
typedef unsigned u32x4 __attribute__((ext_vector_type(4)));
typedef unsigned u32x2 __attribute__((ext_vector_type(2)));
constexpr int BM = 256, BK = 64, HALF = 128, HTB = HALF * BK * 2, STAGE_BYTES = 8 * HTB, NXCD = 8, WGM = 8, GK = 1024;

__device__ __forceinline__ int lds_byte(int r, int c) { const int st = (r >> 4) * 2 + (c >> 5), rr = r & 15, cc = c & 31, ob = rr * 64 + cc * 2; return st * 1024 + (ob ^ (((ob >> 9) & 1) << 5)); }
__device__ __forceinline__ void stage_rc(int b, int& R, int& C) { const int st = b / 1024, sb = b % 1024, swz = sb ^ (((sb >> 9) & 1) << 5); R = (st >> 1) * 16 + swz / 64; C = (st & 1) * 32 + (swz % 64) / 2; }
__device__ __forceinline__ int perm32(int rho) { const int n = rho >> 4, i = rho & 15; return 8 * (i >> 2) + 4 * n + (i & 3); }
__device__ __forceinline__ unsigned cvt_pk_bf16(float lo, float hi) { unsigned r; asm volatile("v_cvt_pk_bf16_f32 %0, %1, %2" : "=v"(r) : "v"(lo), "v"(hi)); return r; }

struct Unit { int pm, pn, e, row0, ne, ui; };

struct StaticOrder {
  int nM, nN, nwg, G, c;
  __device__ void init(int M, int N, int G_, int c_) { nM = M / BM; nN = N / BM; nwg = nM * nN; G = G_; c = c_; }
  __device__ bool next(int i, Unit& u) const {
    const long L = (long)i * G + c; if (L >= nwg) return false;
    int wgid = (int)L; { const int q = nwg / NXCD, r = nwg % NXCD, xcd = wgid % NXCD, off = wgid / NXCD; wgid = (xcd < r ? xcd * (q + 1) : r * (q + 1) + (xcd - r) * q) + off; }
    const int nig = WGM * nN, gid = wgid / nig, fm = gid * WGM, gsz = (nM - fm) < WGM ? (nM - fm) : WGM;
    u.pm = fm + ((wgid % nig) % gsz); u.pn = (wgid % nig) / gsz; u.e = 0; u.row0 = u.pm * BM; u.ne = 0; u.ui = i; return true;
  }
};

template <class Prob>
__device__ __forceinline__ void gemm_phase(PG8_LAS unsigned char* lds, const Prob& S, int wv) {
  int wv_ = wv; asm volatile("" : "+s"(wv_));
  int l_; asm volatile("v_mbcnt_lo_u32_b32 %0, -1, 0\n\tv_mbcnt_hi_u32_b32 %0, -1, %0" : "=v"(l_));
  int tid_ = wv_ * 64 + l_;
  const int tid = tid_, wid = __builtin_amdgcn_readfirstlane(tid >> 6), lane = tid & 63, wr = wid >> 2, wc = wid & 3, fr = lane & 15, fq = lane >> 4;
  constexpr int K = GK, nt = K / BK;
  int sR[2], sC[2]; unsigned voffB[2];
#pragma unroll
  for (int i = 0; i < 2; ++i) { int R, C; stage_rc(tid * 16 + i * 8192, R, C); sR[i] = R; sC[i] = C; const int Rb = Prob::PERM ? ((R & ~31) + perm32(R & 31)) : R; voffB[i] = (unsigned)(Rb * K + C) * 2u; }
  const size_t kstep = (size_t)(BK * 2);
  const size_t hstep = (size_t)HALF * K * 2;
  const unsigned ldsw = (unsigned)wid * 1024u;
  const int aoff = lds_byte(wr * 64 + fr, fq * 8), boff = lds_byte(wc * 32 + fr, fq * 8);
#define PG8_SA(b, h) (((b) * 2 + (h)) * HTB)
#define PG8_SB(b, h) ((4 + (b) * 2 + (h)) * HTB)
#define PG8_STAGE(bufoff, gbase, voff) do { _Pragma("unroll") for (int _i = 0; _i < 2; ++_i) \
    __builtin_amdgcn_global_load_lds((const unsigned*)((const char*)(gbase) + (voff)[_i]), (PG8_LAS unsigned*)(lds + (bufoff) + ldsw + _i * 8192), 16, 0, 0); } while (0)
#define PG8_LDA(dst, b, h) do { _Pragma("unroll") for (int m = 0; m < 4; ++m) _Pragma("unroll") for (int k = 0; k < 2; ++k) dst[m][k] = *(const PG8_LAS bf16x8*)(lds + PG8_SA(b, h) + aoff + m * 2048 + k * 1024); } while (0)
#define PG8_LDB(dst, b, h) do { _Pragma("unroll") for (int n = 0; n < 2; ++n) _Pragma("unroll") for (int k = 0; k < 2; ++k) dst[n][k] = *(const PG8_LAS bf16x8*)(lds + PG8_SB(b, h) + boff + n * 2048 + k * 1024); } while (0)
#define PG8_MMA(ai, bj, At, Bt) do { __builtin_amdgcn_s_setprio(1); _Pragma("unroll") for (int m = 0; m < 4; ++m) _Pragma("unroll") for (int n = 0; n < 2; ++n) _Pragma("unroll") for (int k = 0; k < 2; ++k) \
    acc[ai][bj][m][n] = __builtin_amdgcn_mfma_f32_16x16x32_bf16(Bt[n][k], At[m][k], acc[ai][bj][m][n], 0, 0, 0); __builtin_amdgcn_s_setprio(0); } while (0)
#define PG8_WAIT_V(n) asm volatile("s_waitcnt vmcnt(" #n ")" ::: "memory")
#define PG8_WAIT_L(n) asm volatile("s_waitcnt lgkmcnt(" #n ")" ::: "memory")
#define PG8_BAR __builtin_amdgcn_s_barrier()
#define PG8_SCHED __builtin_amdgcn_sched_barrier(0)
  Unit cur, nxt; int ui = 0;
  if (!S.next(0, cur)) return;
  f32x4 acc[2][2][4][2];
#pragma unroll
  for (int a = 0; a < 2; ++a)
#pragma unroll
    for (int b = 0; b < 2; ++b)
#pragma unroll
      for (int m = 0; m < 4; ++m)
#pragma unroll
        for (int n = 0; n < 2; ++n) acc[a][b][m][n] = (f32x4){0.f, 0.f, 0.f, 0.f};
  bf16x8 At[4][2], B0[2][2], B1[2][2];
  unsigned oc0[2], oc1[2], on0[2], on1[2];
#pragma unroll
  for (int i = 0; i < 2; ++i) { oc0[i] = S.a_off(cur, sR[i]) + (unsigned)sC[i] * 2u; oc1[i] = S.a_off(cur, HALF + sR[i]) + (unsigned)sC[i] * 2u; }
  const char* const Ab = S.a_base();
  const char* cB = S.b_base(cur);
  PG8_STAGE(PG8_SB(0, 0), cB, voffB); PG8_STAGE(PG8_SB(0, 1), cB + hstep, voffB); PG8_STAGE(PG8_SA(0, 0), Ab, oc0); PG8_STAGE(PG8_SA(0, 1), Ab, oc1);
  if (wr == 1) PG8_BAR;
  PG8_WAIT_V(2); PG8_BAR;
  PG8_STAGE(PG8_SB(1, 0), cB + kstep, voffB); PG8_STAGE(PG8_SA(1, 0), Ab + kstep, oc0); PG8_STAGE(PG8_SB(1, 1), cB + hstep + kstep, voffB);
  PG8_WAIT_V(6); PG8_BAR;
  for (;;) {
    const bool has_next = S.next(ui + 1, nxt);
    const char* nB = cB;
    if (has_next) {
      nB = S.b_base(nxt);
      int l2_; asm volatile("v_mbcnt_lo_u32_b32 %0, -1, 0\n\tv_mbcnt_hi_u32_b32 %0, -1, %0" : "=v"(l2_));
      const int tid2 = wid * 64 + l2_;
#pragma unroll
      for (int i = 0; i < 2; ++i) { int R, C; stage_rc(tid2 * 16 + i * 8192, R, C); on0[i] = S.a_off(nxt, R) + (unsigned)C * 2u; on1[i] = S.a_off(nxt, HALF + R) + (unsigned)C * 2u; }
    } else {
#pragma unroll
      for (int i = 0; i < 2; ++i) { on0[i] = oc0[i]; on1[i] = oc1[i]; }
    }
    for (int t = 0; t < nt; t += 2) {
      const bool last = (t == nt - 2);
      const char* a1 = Ab + (size_t)(t + 1) * kstep;
      const char* a2 = last ? Ab : Ab + (size_t)(t + 2) * kstep; const char* b2 = last ? nB : cB + (size_t)(t + 2) * kstep;
      const char* a3 = a2 + kstep; const char* b3 = b2 + kstep;
      unsigned o20[2], o21[2];
#pragma unroll
      for (int i = 0; i < 2; ++i) { o20[i] = last ? on0[i] : oc0[i]; o21[i] = last ? on1[i] : oc1[i]; }
      PG8_LDB(B0, 0, 0); PG8_LDB(B1, 0, 1); PG8_SCHED; PG8_LDA(At, 0, 0); PG8_STAGE(PG8_SA(1, 1), a1, oc1);
      PG8_WAIT_V(8); PG8_WAIT_L(0); PG8_BAR; PG8_MMA(0, 0, At, B0); PG8_MMA(0, 1, At, B1); PG8_BAR; PG8_SCHED;
      PG8_LDA(At, 0, 1); PG8_STAGE(PG8_SB(0, 0), b2, voffB); PG8_STAGE(PG8_SB(0, 1), b2 + hstep, voffB); PG8_STAGE(PG8_SA(0, 0), a2, o20);
      PG8_WAIT_V(8); PG8_WAIT_L(0); PG8_BAR; PG8_MMA(1, 0, At, B0); PG8_MMA(1, 1, At, B1); PG8_BAR; PG8_SCHED;
      PG8_LDB(B0, 1, 0); PG8_LDB(B1, 1, 1); PG8_SCHED; PG8_LDA(At, 1, 0); PG8_STAGE(PG8_SA(0, 1), a2, o21);
      PG8_WAIT_V(8); PG8_WAIT_L(0); PG8_BAR; PG8_MMA(0, 0, At, B0); PG8_MMA(0, 1, At, B1); PG8_BAR; PG8_SCHED;
      PG8_LDA(At, 1, 1); PG8_STAGE(PG8_SB(1, 0), b3, voffB); PG8_STAGE(PG8_SB(1, 1), b3 + hstep, voffB); PG8_STAGE(PG8_SA(1, 0), a3, o20);
      PG8_WAIT_V(8); PG8_WAIT_L(0); PG8_BAR; PG8_MMA(1, 0, At, B0); PG8_MMA(1, 1, At, B1); PG8_BAR; PG8_SCHED;
    }
    if (wr == 0) PG8_BAR;
    { int l3_; asm volatile("v_mbcnt_lo_u32_b32 %0, -1, 0\n\tv_mbcnt_hi_u32_b32 %0, -1, %0" : "=v"(l3_));
      S.epi(acc, cur, wr, wc, l3_ & 15, l3_ >> 4); }
    if (!has_next) break;
#pragma unroll
    for (int a = 0; a < 2; ++a)
#pragma unroll
      for (int b = 0; b < 2; ++b)
#pragma unroll
        for (int m = 0; m < 4; ++m)
#pragma unroll
          for (int n = 0; n < 2; ++n) acc[a][b][m][n] = (f32x4){0.f, 0.f, 0.f, 0.f};
    cur = nxt; cB = nB; ++ui;
#pragma unroll
    for (int i = 0; i < 2; ++i) { oc0[i] = on0[i]; oc1[i] = on1[i]; }
    if (wr == 1) PG8_BAR;
  }
  PG8_WAIT_V(0);
  PG8_BAR;
#undef PG8_SA
#undef PG8_SB
#undef PG8_STAGE
#undef PG8_LDA
#undef PG8_LDB
#undef PG8_MMA
#undef PG8_WAIT_V
#undef PG8_WAIT_L
#undef PG8_BAR
#undef PG8_SCHED
}
}
#endif
#ifndef CPU_EMU
#include <hip/hip_cooperative_groups.h>
namespace cg = cooperative_groups;
#define LAS __attribute__((address_space(3)))
#define NTHREADS 512
#define LDS_BYTES (154 * 1024)
typedef float f32x4 __attribute__((ext_vector_type(4)));
typedef short bf16x8 __attribute__((ext_vector_type(8)));
typedef unsigned u32x4 __attribute__((ext_vector_type(4)));
typedef unsigned u32x2 __attribute__((ext_vector_type(2)));

struct Ctx { int tid, lane, wid, G, bid; unsigned char* lds; };
__device__ __forceinline__ int lane_id() { int l; asm volatile("v_mbcnt_lo_u32_b32 %0, -1, 0\n\tv_mbcnt_hi_u32_b32 %0, -1, %0" : "=v"(l)); return l; }
__device__ __forceinline__ int opaque_tid(int wv) { int w = wv; asm volatile("" : "+s"(w)); int t = w * 64 + lane_id(); asm volatile("" : "+v"(t)); return t; }
__device__ __forceinline__ Ctx make_ctx(unsigned char* lds, int wv) { Ctx c; c.tid = opaque_tid(wv); c.lane = c.tid & 63; c.wid = __builtin_amdgcn_readfirstlane(c.tid >> 6); c.G = gridDim.x; c.bid = blockIdx.x; c.lds = lds; return c; }

__device__ __forceinline__ void dpp_bcast_add(float& x) {
  asm("s_nop 1\n\tv_add_f32_dpp %0, %0, %0 row_bcast:15 row_mask:0xa\n\ts_nop 1\n\tv_add_f32_dpp %0, %0, %0 row_bcast:31 row_mask:0xc" : "+v"(x)); }
__device__ __forceinline__ void dpp_bcast_max(float& x) {
  asm("s_nop 1\n\tv_max_f32_dpp %0, %0, %0 row_bcast:15 row_mask:0xa\n\ts_nop 1\n\tv_max_f32_dpp %0, %0, %0 row_bcast:31 row_mask:0xc" : "+v"(x)); }
#define DPPB_(i, mod) "v_add_f32_dpp %" #i ", %" #i ", %" #i " " mod "\n\t"
__device__ __forceinline__ void dpp_bcast_add(float (&g)[8]) {
  asm("s_nop 1\n\t" DPPB_(0, "row_bcast:15 row_mask:0xa") DPPB_(1, "row_bcast:15 row_mask:0xa") DPPB_(2, "row_bcast:15 row_mask:0xa") DPPB_(3, "row_bcast:15 row_mask:0xa")
      DPPB_(4, "row_bcast:15 row_mask:0xa") DPPB_(5, "row_bcast:15 row_mask:0xa") DPPB_(6, "row_bcast:15 row_mask:0xa") DPPB_(7, "row_bcast:15 row_mask:0xa")
      DPPB_(0, "row_bcast:31 row_mask:0xc") DPPB_(1, "row_bcast:31 row_mask:0xc") DPPB_(2, "row_bcast:31 row_mask:0xc") DPPB_(3, "row_bcast:31 row_mask:0xc")
      DPPB_(4, "row_bcast:31 row_mask:0xc") DPPB_(5, "row_bcast:31 row_mask:0xc") DPPB_(6, "row_bcast:31 row_mask:0xc") DPPB_(7, "row_bcast:31 row_mask:0xc")
      : "+v"(g[0]), "+v"(g[1]), "+v"(g[2]), "+v"(g[3]), "+v"(g[4]), "+v"(g[5]), "+v"(g[6]), "+v"(g[7])); }
__device__ __forceinline__ void dpp_bcast_add(float (&g)[16]) {
  asm("s_nop 1\n\t" DPPB_(0, "row_bcast:15 row_mask:0xa") DPPB_(1, "row_bcast:15 row_mask:0xa") DPPB_(2, "row_bcast:15 row_mask:0xa") DPPB_(3, "row_bcast:15 row_mask:0xa")
      DPPB_(4, "row_bcast:15 row_mask:0xa") DPPB_(5, "row_bcast:15 row_mask:0xa") DPPB_(6, "row_bcast:15 row_mask:0xa") DPPB_(7, "row_bcast:15 row_mask:0xa")
      DPPB_(8, "row_bcast:15 row_mask:0xa") DPPB_(9, "row_bcast:15 row_mask:0xa") DPPB_(10, "row_bcast:15 row_mask:0xa") DPPB_(11, "row_bcast:15 row_mask:0xa")
      DPPB_(12, "row_bcast:15 row_mask:0xa") DPPB_(13, "row_bcast:15 row_mask:0xa") DPPB_(14, "row_bcast:15 row_mask:0xa") DPPB_(15, "row_bcast:15 row_mask:0xa")
      DPPB_(0, "row_bcast:31 row_mask:0xc") DPPB_(1, "row_bcast:31 row_mask:0xc") DPPB_(2, "row_bcast:31 row_mask:0xc") DPPB_(3, "row_bcast:31 row_mask:0xc")
      DPPB_(4, "row_bcast:31 row_mask:0xc") DPPB_(5, "row_bcast:31 row_mask:0xc") DPPB_(6, "row_bcast:31 row_mask:0xc") DPPB_(7, "row_bcast:31 row_mask:0xc")
      DPPB_(8, "row_bcast:31 row_mask:0xc") DPPB_(9, "row_bcast:31 row_mask:0xc") DPPB_(10, "row_bcast:31 row_mask:0xc") DPPB_(11, "row_bcast:31 row_mask:0xc")
      DPPB_(12, "row_bcast:31 row_mask:0xc") DPPB_(13, "row_bcast:31 row_mask:0xc") DPPB_(14, "row_bcast:31 row_mask:0xc") DPPB_(15, "row_bcast:31 row_mask:0xc")
      : "+v"(g[0]), "+v"(g[1]), "+v"(g[2]), "+v"(g[3]), "+v"(g[4]), "+v"(g[5]), "+v"(g[6]), "+v"(g[7]), "+v"(g[8]), "+v"(g[9]), "+v"(g[10]), "+v"(g[11]), "+v"(g[12]), "+v"(g[13]), "+v"(g[14]), "+v"(g[15])); }
#undef DPPB_
__device__ __forceinline__ float wave_sum(float x) {
  x += __builtin_bit_cast(float, __builtin_amdgcn_update_dpp(0, __builtin_bit_cast(int, x), 0x111, 0xf, 0xf, false));
  x += __builtin_bit_cast(float, __builtin_amdgcn_update_dpp(0, __builtin_bit_cast(int, x), 0x112, 0xf, 0xf, false));
  x += __builtin_bit_cast(float, __builtin_amdgcn_update_dpp(0, __builtin_bit_cast(int, x), 0x114, 0xf, 0xf, false));
  x += __builtin_bit_cast(float, __builtin_amdgcn_update_dpp(0, __builtin_bit_cast(int, x), 0x118, 0xf, 0xf, false));
  dpp_bcast_add(x);
  return __builtin_bit_cast(float, __builtin_amdgcn_readlane(__builtin_bit_cast(int, x), 63));
}
__device__ __forceinline__ float fsigmoid(float x) { return __builtin_amdgcn_rcpf(1.0f + __builtin_amdgcn_exp2f(-1.4426950408889634f * x)); }
__device__ __forceinline__ float fsilu(float x) { return x * fsigmoid(x); }
__device__ __forceinline__ float flog2sigmoid(float x) { const float y = x * 1.4426950408889634f; return fminf(y, 0.f) - __builtin_amdgcn_logf(1.0f + __builtin_amdgcn_exp2f(-fabsf(y))); }
typedef float f32x2_t __attribute__((ext_vector_type(2)));
typedef __bf16 bf16x2_t __attribute__((ext_vector_type(2)));
__device__ __forceinline__ unsigned pk_hw(float a, float b) { const f32x2_t v = {a, b}; return __builtin_bit_cast(unsigned, __builtin_convertvector(v, bf16x2_t)); }
__device__ __forceinline__ unsigned pk2(float a, float b) { return pk_hw(a, b); }
__device__ __forceinline__ void unpack8(u32x4 w, float* f) {
  f[0] = __uint_as_float(w.x << 16); f[1] = __uint_as_float(w.x & 0xffff0000u); f[2] = __uint_as_float(w.y << 16); f[3] = __uint_as_float(w.y & 0xffff0000u);
  f[4] = __uint_as_float(w.z << 16); f[5] = __uint_as_float(w.z & 0xffff0000u); f[6] = __uint_as_float(w.w << 16); f[7] = __uint_as_float(w.w & 0xffff0000u);
}

__device__ __forceinline__ void transpose_job(const Ctx& c, const float* src, int N, bf16_t* dst, int rs, int ro, int tile0, int tile_stride) {
  float* t = (float*)c.lds;
  const int ntn = (N + 63) / 64, ntiles = ntn * 16;
  for (int tl = tile0; tl < ntiles; tl += tile_stride) {
    const int kt = tl / ntn, nt_ = tl % ntn, k0 = kt * 64, n0 = nt_ * 64;
    __syncthreads();
#pragma unroll
    for (int i = 0; i < 8; ++i) { const int idx = c.tid + i * 512, kk = idx >> 6, nn = idx & 63; t[kk * 65 + nn] = (n0 + nn < N) ? src[(size_t)(k0 + kk) * N + n0 + nn] : 0.f; }
    __syncthreads();
#pragma unroll
    for (int i = 0; i < 4; ++i) { const int idx = c.tid + i * 512, nn = idx >> 5, kp = (idx & 31) * 2;
      if (n0 + nn < N) *(unsigned*)(dst + (size_t)((n0 + nn) * rs + ro) * 1024 + k0 + kp) = pk2(t[kp * 65 + nn], t[(kp + 1) * 65 + nn]); }
  }
  __syncthreads();
}
__device__ __forceinline__ void p0_prologue(unsigned char* lds_, int wv, const Params& p) {
  const Ctx c = make_ctx(lds_, wv);
  unsigned char* ws = p.ws;
  if (c.bid == 0) { ((unsigned*)(ws + WS_CTL))[64 + c.tid] = 0u; }
  if (c.bid == 0 && c.tid < 64) { ((unsigned*)(ws + WS_CTL))[1024 + c.tid] = 0u; }
  if (c.bid == 0) { for (int i = c.tid; i < 3456; i += NTHREADS) ((unsigned*)(ws + WS_CTL))[2048 + i] = 0u; }
  { const float* x = p.in[I_X]; bf16_t* hb = (bf16_t*)p.out;
    for (size_t i = (size_t)c.bid * NTHREADS + c.tid; i < (size_t)NTOK * 1024 / 8; i += (size_t)c.G * NTHREADS) {
      const f32x4 a = __builtin_nontemporal_load((const f32x4*)(x + i * 8)), b = __builtin_nontemporal_load((const f32x4*)(x + i * 8 + 4));
      u32x4 w; w.x = pk2(a[0], a[1]); w.y = pk2(a[2], a[3]); w.z = pk2(b[0], b[1]); w.w = pk2(b[2], b[3]);
      *(u32x4*)(hb + i * 8) = w; } }
  transpose_job(c, p.in[I_AB_W_IN], P_AB, (bf16_t*)(ws + WS_WIN_AB), 1, 0, c.bid, c.G);
  transpose_job(c, p.in[I_CD_W_IN], P_CD, (bf16_t*)(ws + WS_WIN_CD), 1, 0, c.bid, c.G);
  transpose_job(c, p.in[I_AB_W_OUT], 1024, (bf16_t*)(ws + WS_WOUT_AB), 1, 0, c.bid, c.G);
  transpose_job(c, p.in[I_CD_W_OUT], 1024, (bf16_t*)(ws + WS_WOUT_CD), 1, 0, c.bid, c.G);
  { float* rope = (float*)(ws + WS_ROPE);
    for (int i = c.bid * NTHREADS + c.tid; i < SEQ * 32; i += c.G * NTHREADS) { const int t = i >> 5, f = i & 31;
      const float freq = powf(10000.0f, -(float)f / 32.0f); const float ang = (float)t * freq; float* d = rope + ((size_t)(f >> 2) * SEQ + t) * 8 + (f & 3) * 2; d[0] = cosf(ang); d[1] = sinf(ang); }
    if (c.bid == 1) { const float* hl = p.in[I_HGRN_LB]; float* lb = (float*)(ws + WS_LB);
      const int cc = c.tid; const float a0 = hl[cc], a1 = hl[512 + cc], a2 = hl[1024 + cc]; const float mx = fmaxf(a0, fmaxf(a1, a2));
      const float e0 = expf(a0 - mx), e1 = expf(a1 - mx), e2 = expf(a2 - mx); lb[cc] = e0 / (e0 + e1 + e2); } }
}
__device__ __forceinline__ void moe_weight_convert(unsigned char* lds_, int wv, const Params& p, int layer, int part, int bidx, int nblk) {
  const Ctx c = make_ctx(lds_, wv);
  bf16_t* w13 = (bf16_t*)(p.ws + WS_W13); bf16_t* w2 = (bf16_t*)(p.ws + WS_W2);
  const size_t lo = (size_t)layer * NEXP * 1024 * 1024;
  const float* W1 = p.in[I_MOE_W1] + lo; const float* W3 = p.in[I_MOE_W3] + lo; const float* W2 = p.in[I_MOE_W2] + lo;
  float* t = (float*)c.lds;
  const int NT = (part == 0 ? 32 : 16) * 128;
  const int lk = c.tid >> 5, ln4 = (c.tid & 31) * 4;
  const int sn = c.tid & 127, sk = (c.tid >> 7) * 8;
  f32x4 r[4];
#define MW_SRC(g_) ((part == 0 ? ((((g_) >> 7) & 1) ? W3 : W1) + (size_t)((g_) >> 8) * 1048576 : W2 + (size_t)((g_) >> 7) * 1048576) + (size_t)((((g_) & 127) >> 3) * 64) * 1024 + ((g_) & 7) * 128)
#define MW_LOAD(g_) do { const float* s_ = MW_SRC(g_); _Pragma("unroll") for (int i = 0; i < 4; ++i) r[i] = __builtin_nontemporal_load((const f32x4*)(s_ + (size_t)(lk + 16 * i) * 1024 + ln4)); } while (0)
  int g0 = bidx;
  if (g0 < NT) MW_LOAD(g0);
  for (; g0 < NT; g0 += nblk) {
    __syncthreads();
#pragma unroll
    for (int i = 0; i < 4; ++i) { float* d = t + (lk + 16 * i) * 129 + ln4; d[0] = r[i][0]; d[1] = r[i][1]; d[2] = r[i][2]; d[3] = r[i][3]; }
    __syncthreads();
    const int gn = g0 + nblk;
    if (gn < NT) MW_LOAD(gn);
    const int m = g0 >> 7, k0 = ((g0 & 127) >> 3) * 64, n0 = (g0 & 7) * 128;
    bf16_t* drow = (part == 1) ? w2 + ((size_t)m * 1024 + n0 + sn) * 1024 : w13 + ((size_t)(m >> 1) * 2048 + 2 * (n0 + sn) + (m & 1)) * 1024;
#pragma unroll
    for (int j = 0; j < 2; ++j) { const int kk = sk + 32 * j; const float* s = t + kk * 129 + sn;
      u32x4 w; w.x = pk2(s[0], s[129]); w.y = pk2(s[2 * 129], s[3 * 129]); w.z = pk2(s[4 * 129], s[5 * 129]); w.w = pk2(s[6 * 129], s[7 * 129]);
      *(u32x4*)(drow + k0 + kk) = w; }
  }
#undef MW_SRC
#undef MW_LOAD
  __syncthreads();
}

__device__ __forceinline__ void moe_weight_convert_tix(unsigned char* lds_, int wv, const Params& p, int layer, int part, unsigned* tix) {
  const Ctx c = make_ctx(lds_, wv);
  bf16_t* w13 = (bf16_t*)(p.ws + WS_W13); bf16_t* w2 = (bf16_t*)(p.ws + WS_W2);
  const size_t lo = (size_t)layer * NEXP * 1024 * 1024;
  const float* W1 = p.in[I_MOE_W1] + lo; const float* W3 = p.in[I_MOE_W3] + lo; const float* W2 = p.in[I_MOE_W2] + lo;
  float* t = (float*)c.lds;
  int* tk = (int*)(c.lds + 64 * 129 * 4);
  const int NT = (part == 0 ? 32 : 16) * 128;
  const int lk = c.tid >> 5, ln4 = (c.tid & 31) * 4;
  const int sn = c.tid & 127, sk = (c.tid >> 7) * 8;
  f32x4 r[4];
#define MW_SRC(g_) ((part == 0 ? ((((g_) >> 7) & 1) ? W3 : W1) + (size_t)((g_) >> 8) * 1048576 : W2 + (size_t)((g_) >> 7) * 1048576) + (size_t)((((g_) & 127) >> 3) * 64) * 1024 + ((g_) & 7) * 128)
#define MW_LOAD(g_) do { const float* s_ = MW_SRC(g_); _Pragma("unroll") for (int i = 0; i < 4; ++i) r[i] = __builtin_nontemporal_load((const f32x4*)(s_ + (size_t)(lk + 16 * i) * 1024 + ln4)); } while (0)
  __syncthreads();
  if (c.tid == 0) tk[0] = (int)atomicAdd(tix, 1u);
  __syncthreads();
  int g0 = __builtin_amdgcn_readfirstlane(tk[0]);
  if (g0 < NT) MW_LOAD(g0);
  while (g0 < NT) {
    __syncthreads();
    if (c.tid == 0) tk[0] = (int)atomicAdd(tix, 1u);
#pragma unroll
    for (int i = 0; i < 4; ++i) { float* d = t + (lk + 16 * i) * 129 + ln4; d[0] = r[i][0]; d[1] = r[i][1]; d[2] = r[i][2]; d[3] = r[i][3]; }
    __syncthreads();
    const int gn = __builtin_amdgcn_readfirstlane(tk[0]);
    if (gn < NT) MW_LOAD(gn);
    const int m = g0 >> 7, k0 = ((g0 & 127) >> 3) * 64, n0 = (g0 & 7) * 128;
    bf16_t* drow = (part == 1) ? w2 + ((size_t)m * 1024 + n0 + sn) * 1024 : w13 + ((size_t)(m >> 1) * 2048 + 2 * (n0 + sn) + (m & 1)) * 1024;
#pragma unroll
    for (int j = 0; j < 2; ++j) { const int kk = sk + 32 * j; const float* s = t + kk * 129 + sn;
      u32x4 w; w.x = pk2(s[0], s[129]); w.y = pk2(s[2 * 129], s[3 * 129]); w.z = pk2(s[4 * 129], s[5 * 129]); w.w = pk2(s[6 * 129], s[7 * 129]);
      *(u32x4*)(drow + k0 + kk) = w; }
    g0 = gn;
  }
#undef MW_SRC
#undef MW_LOAD
  __syncthreads();
}

struct ProbInProj {
  static constexpr bool PERM = true;
  pg8::StaticOrder so; const char* A; const char* Bt; bf16_t* P; const float* bias; const float* lb; int layer;
  __device__ __forceinline__ bool next(int i, pg8::Unit& u) const { return so.next(i, u); }
  __device__ __forceinline__ const char* a_base() const { return A; }
  __device__ __forceinline__ unsigned a_off(const pg8::Unit& u, int r) const { return (unsigned)(u.pm * 256 + r) * 2048u; }
  __device__ __forceinline__ const char* b_base(const pg8::Unit& u) const { return Bt + (size_t)u.pn * 256 * 2048; }
  __device__ __forceinline__ void epi(const f32x4 (&acc)[2][2][4][2], const pg8::Unit& u, int wr, int wc, int fr, int fq) const {
    const int row0 = u.row0 + wr * 64 + fr, colb = u.pn * 256 + wc * 32 + 8 * fq;
    int mode = 0;
    const bool tmaj = layer == 0 ? (u.pn < 8 || (u.pn >= 10 && u.pn < 14)) : (u.pn < 4 || u.pn == 10 || u.pn == 11);
    if (layer == 0) { mode = u.pn < 2 ? 1 : (u.pn < 6 ? 2 : (u.pn == 10 ? 3 : 0)); }
#pragma unroll
    for (int bj = 0; bj < 2; ++bj) {
      const int col0 = colb + bj * 128;
      const f32x4 b0 = *(const f32x4*)(bias + col0), b1 = *(const f32x4*)(bias + col0 + 4);
      f32x4 l0 = (f32x4){0.f, 0.f, 0.f, 0.f}, l1 = l0;
      if (mode == 2) { l0 = *(const f32x4*)(lb + ((col0 - 512) & 511)); l1 = *(const f32x4*)(lb + ((col0 - 512) & 511) + 4); }
#pragma unroll
      for (int ai = 0; ai < 2; ++ai)
#pragma unroll
        for (int m = 0; m < 4; ++m) {
          f32x4 v0 = acc[ai][bj][m][0] + b0, v1 = acc[ai][bj][m][1] + b1;
          if (mode == 1) {
#pragma unroll
            for (int j = 0; j < 4; ++j) { v0[j] = fsilu(v0[j]); v1[j] = fsilu(v1[j]); }
          } else if (mode == 2) {
#pragma unroll
            for (int j = 0; j < 4; ++j) { v0[j] = __builtin_amdgcn_logf(l0[j] + (1.0f - l0[j]) * fsigmoid(v0[j])); v1[j] = __builtin_amdgcn_logf(l1[j] + (1.0f - l1[j]) * fsigmoid(v1[j])); }
          } else if (mode == 3) { v0 *= 0.125f; v1 *= 0.125f; }
          u32x4 w; w.x = pk2(v0[0], v0[1]); w.y = pk2(v0[2], v0[3]); w.z = pk2(v1[0], v1[1]); w.w = pk2(v1[2], v1[3]);
          *(u32x4*)(P + (tmaj ? PIDX8(row0 + ai * 128 + m * 16, col0) : PIDX(row0 + ai * 128 + m * 16, col0))) = w;
        }
    }
  }
};
struct ProbOutProj {
  static constexpr bool PERM = true;
  pg8::StaticOrder so; const char* A; const char* Bt; bf16_t* Y; const bf16_t* Hres;
  __device__ __forceinline__ bool next(int i, pg8::Unit& u) const { return so.next(i, u); }
  __device__ __forceinline__ const char* a_base() const { return A; }
  __device__ __forceinline__ unsigned a_off(const pg8::Unit& u, int r) const { return (unsigned)(u.pm * 256 + r) * 2048u; }
  __device__ __forceinline__ const char* b_base(const pg8::Unit& u) const { return Bt + (size_t)u.pn * 256 * 2048; }
  __device__ __forceinline__ void epi(const f32x4 (&acc)[2][2][4][2], const pg8::Unit& u, int wr, int wc, int fr, int fq) const {
    const int row0 = u.row0 + wr * 64 + fr, colb = u.pn * 256 + wc * 32 + 8 * fq;
#pragma unroll
    for (int ai = 0; ai < 2; ++ai)
#pragma unroll
      for (int m = 0; m < 4; ++m) {
        const size_t ro = (size_t)(row0 + ai * 128 + m * 16) * 1024 + colb;
        const u32x4 h0 = *(const u32x4*)(Hres + ro), h1 = *(const u32x4*)(Hres + ro + 128);
#pragma unroll
        for (int bj = 0; bj < 2; ++bj) {
          float hf[8]; unpack8(bj ? h1 : h0, hf);
          const f32x4 v0 = acc[ai][bj][m][0], v1 = acc[ai][bj][m][1];
          u32x4 w; w.x = pk2(v0[0] + ALPHA_F * hf[0], v0[1] + ALPHA_F * hf[1]); w.y = pk2(v0[2] + ALPHA_F * hf[2], v0[3] + ALPHA_F * hf[3]);
          w.z = pk2(v1[0] + ALPHA_F * hf[4], v1[1] + ALPHA_F * hf[5]); w.w = pk2(v1[2] + ALPHA_F * hf[6], v1[3] + ALPHA_F * hf[7]);
          *(u32x4*)(Y + ro + bj * 128) = w;
        }
      }
  }
};
#define MOE_TAB_OFF (128 * 1024)
struct MoeOrder {
  const int* tab;
  __device__ __forceinline__ void init(const int* cnt, int ntn, int G, int c, unsigned char* lds, int wv) {
    int* t = (int*)(lds + MOE_TAB_OFF);
    const int tid = opaque_tid(wv);
    if (tid < 64) {
      int pad = 0, found = 0, ue = 0, upn = 0, upm = 0, urow = 0, une = 0;
      if ((G & 7) == 0) {
        const int x = c & 7; int q = tid * (G >> 3) + (c >> 3);
        for (int e = 0; e < NEXP; ++e) { const int n = cnt[e * 16], mt = (n + 255) >> 8; const int r = ((x - e) % 8 + 8) % 8; const int m = mt > r ? (mt - r - 1) / 8 + 1 : 0; const int units = m * ntn;
          if (!found && q < units) { ue = e; upm = r + 8 * (q % m); upn = q / m; urow = pad + upm * 256; une = n; found = 1; }
          if (!found) { q -= units; pad += mt * 256; } }
      } else {
        int L = tid * G + c;
        for (int e = 0; e < NEXP; ++e) { const int n = cnt[e * 16], mt = (n + 255) >> 8, tiles = mt * ntn;
          if (!found && L < tiles) { ue = e; upn = L / mt; upm = L % mt; urow = pad + upm * 256; une = n; found = 1; }
          if (!found) { L -= tiles; pad += mt * 256; } }
      }
      t[tid * 8 + 0] = found; t[tid * 8 + 1] = ue; t[tid * 8 + 2] = upn; t[tid * 8 + 3] = upm; t[tid * 8 + 4] = urow; t[tid * 8 + 5] = une;
    }
    __syncthreads();
    tab = t;
  }
  __device__ __forceinline__ bool next(int i, pg8::Unit& u) const {
    if (i >= 64) return false;
    const int* t = tab + i * 8;
    if (!__builtin_amdgcn_readfirstlane(t[0])) return false;
    u.e = __builtin_amdgcn_readfirstlane(t[1]); u.pn = __builtin_amdgcn_readfirstlane(t[2]); u.pm = __builtin_amdgcn_readfirstlane(t[3]);
    u.row0 = __builtin_amdgcn_readfirstlane(t[4]); u.ne = __builtin_amdgcn_readfirstlane(t[5]); u.ui = i; return true;
  }
};
struct ProbMoe1 {
  static constexpr bool PERM = true;
  MoeOrder mo; const char* A; const char* W13; const int* list; bf16_t* H; const int* ltok;
  __device__ __forceinline__ void stage_tokens(unsigned char* lds, int wv) {
    int* lt = (int*)(lds + MOE_TAB_OFF + 2048);
    const int tid = opaque_tid(wv);
    pg8::Unit u;
    for (int i = 0; i < 16 && mo.next(i, u); ++i) { if (tid < 256) { const int rr = u.pm * 256 + tid; lt[i * 256 + tid] = rr < u.ne ? list[u.e * NTOK + rr] : 0; } }
    __syncthreads();
    ltok = lt;
  }
  __device__ __forceinline__ bool next(int i, pg8::Unit& u) const { return mo.next(i, u); }
  __device__ __forceinline__ const char* a_base() const { return A; }
  __device__ __forceinline__ unsigned a_off(const pg8::Unit& u, int r) const { const int rr = u.pm * 256 + r; const int tok = rr < u.ne ? list[u.e * NTOK + rr] : 0; return (unsigned)tok * 2048u; }
  __device__ __forceinline__ const char* b_base(const pg8::Unit& u) const { return W13 + ((size_t)u.e * 2048 + (size_t)u.pn * 256) * 2048; }
  __device__ __forceinline__ void epi(const f32x4 (&acc)[2][2][4][2], const pg8::Unit& u, int wr, int wc, int fr, int fq) const {
    const int row0 = u.row0 + wr * 64 + fr, colb = u.pn * 128 + wc * 16 + 4 * fq;
#pragma unroll
    for (int ai = 0; ai < 2; ++ai)
#pragma unroll
      for (int m = 0; m < 4; ++m)
#pragma unroll
        for (int bj = 0; bj < 2; ++bj) {
          const f32x4 v0 = acc[ai][bj][m][0], v1 = acc[ai][bj][m][1];
          u32x2 w; w.x = pk2(fsilu(v0[0]) * v0[1], fsilu(v0[2]) * v0[3]); w.y = pk2(fsilu(v1[0]) * v1[1], fsilu(v1[2]) * v1[3]);
          *(u32x2*)(H + (size_t)(row0 + ai * 128 + m * 16) * 1024 + colb + bj * 64) = w;
        }
  }
};
struct ProbMoe2 {
  static constexpr bool PERM = true;
  MoeOrder mo; const char* A; const char* W2; bf16_t* Y;
  __device__ __forceinline__ bool next(int i, pg8::Unit& u) const { return mo.next(i, u); }
  __device__ __forceinline__ const char* a_base() const { return A; }
  __device__ __forceinline__ unsigned a_off(const pg8::Unit& u, int r) const { return (unsigned)(u.row0 + r) * 2048u; }
  __device__ __forceinline__ const char* b_base(const pg8::Unit& u) const { return W2 + ((size_t)u.e * 1024 + (size_t)u.pn * 256) * 2048; }
  __device__ __forceinline__ void epi(const f32x4 (&acc)[2][2][4][2], const pg8::Unit& u, int wr, int wc, int fr, int fq) const {
    const int row0 = u.row0 + wr * 64 + fr, colb = u.pn * 256 + wc * 32 + 8 * fq;
#pragma unroll
    for (int ai = 0; ai < 2; ++ai)
#pragma unroll
      for (int m = 0; m < 4; ++m)
#pragma unroll
        for (int bj = 0; bj < 2; ++bj) {
          const f32x4 v0 = acc[ai][bj][m][0], v1 = acc[ai][bj][m][1];
          u32x4 w; w.x = pk2(v0[0], v0[1]); w.y = pk2(v0[2], v0[3]); w.z = pk2(v1[0], v1[1]); w.w = pk2(v1[2], v1[3]);
          *(u32x4*)(Y + (size_t)(row0 + ai * 128 + m * 16) * 1024 + colb + bj * 128) = w;
        }
  }
};

template <int NS>
__device__ __forceinline__ void side_phase(unsigned char* lds_, int wv, const Params& p, int layer) {
  const Ctx c = make_ctx(lds_, wv);
  const bf16_t* hb = (const bf16_t*)p.out;
  const bf16_t* wt = (const bf16_t*)(p.ws + (layer == 0 ? WS_WIN_AB : WS_WIN_CD)) + (size_t)(layer == 0 ? PM_AB : PM_CD) * 1024;
  const float* bias = p.in[layer == 0 ? I_AB_B_IN : I_CD_B_IN] + (layer == 0 ? PM_AB : PM_CD);
  float* side = (float*)(p.ws + WS_SIDE);
  float* tl = (float*)c.lds + c.wid * (16 * 33);
  const int fr = c.lane & 15, fq = c.lane >> 4;
  for (int g = c.bid * 8 + c.wid; g < NTOK / 16; g += c.G * 8) {
    const int r0 = g * 16;
    f32x4 acc0 = (f32x4){0.f, 0.f, 0.f, 0.f}, acc1 = acc0;
    const bf16_t* ap = hb + (size_t)(r0 + fr) * 1024 + fq * 8;
    const bf16_t* bp0 = wt + (size_t)fr * 1024 + fq * 8; const bf16_t* bp1 = bp0 + 16 * 1024;
#pragma unroll 16
    for (int k = 0; k < 1024; k += 32) {
      const bf16x8 a = *(const bf16x8*)(ap + k), b0 = *(const bf16x8*)(bp0 + k);
      acc0 = __builtin_amdgcn_mfma_f32_16x16x32_bf16(a, b0, acc0, 0, 0, 0);
      if (NS == 32) { const bf16x8 b1 = *(const bf16x8*)(bp1 + k); acc1 = __builtin_amdgcn_mfma_f32_16x16x32_bf16(a, b1, acc1, 0, 0, 0); }
    }
    float gsc = 1.f, gfb = 0.f; bool gls = false;
    if (NS == 16) { gsc = 1.4426950408889634f; gls = (fr & 4) != 0; gfb = gls ? p.in[I_FGATE_B][(fr >> 3) * 4 + (fr & 3)] : 0.f; }
#pragma unroll
    for (int j = 0; j < 4; ++j) { float v0 = acc0[j] + bias[fr]; if (NS == 16) { v0 = gls ? flog2sigmoid(v0 + gfb) : v0 * gsc; side[(size_t)fr * NTOK + r0 + fq * 4 + j] = v0; }
      tl[(fq * 4 + j) * 33 + fr] = v0;
      if (NS == 32) { const float v1 = acc1[j] + bias[16 + fr]; tl[(fq * 4 + j) * 33 + 16 + fr] = v1; } }
    if (NS == 32) {
      __builtin_amdgcn_s_waitcnt(0xC07F);
      const float* gu = p.in[I_GK_UP]; const float* gb = p.in[I_GK_B]; bf16_t* lfb = (bf16_t*)(p.ws + WS_LFB);
      const int cb = c.lane * 8, dir = cb >> 8, cc = cb & 255;
      float w[16][8];
#pragma unroll
      for (int r = 0; r < 16; ++r)
#pragma unroll
        for (int j = 0; j < 8; ++j) w[r][j] = gu[(dir * 16 + r) * 256 + cc + j];
      float bb[8];
#pragma unroll
      for (int j = 0; j < 8; ++j) bb[j] = gb[dir * 256 + cc + j];
      for (int row = 0; row < 16; ++row) {
        float z[8];
#pragma unroll
        for (int j = 0; j < 8; ++j) z[j] = bb[j];
#pragma unroll
        for (int r = 0; r < 16; ++r) { const float s = tl[row * 33 + dir * 16 + r];
#pragma unroll
          for (int j = 0; j < 8; ++j) z[j] += s * w[r][j]; }
        u32x4 o; o.x = pk2(flog2sigmoid(z[0]) * 0.0625f, flog2sigmoid(z[1]) * 0.0625f); o.y = pk2(flog2sigmoid(z[2]) * 0.0625f, flog2sigmoid(z[3]) * 0.0625f);
        o.z = pk2(flog2sigmoid(z[4]) * 0.0625f, flog2sigmoid(z[5]) * 0.0625f); o.w = pk2(flog2sigmoid(z[6]) * 0.0625f, flog2sigmoid(z[7]) * 0.0625f);
        *(u32x4*)(lfb + PIDX8(r0 + row, cb)) = o;
      }
    }
  }
}

__device__ __forceinline__ void headnorm_phase(unsigned char* lds_, int wv, const Params& p, int layer) {
  const Ctx c = make_ctx(lds_, wv);
  const bf16_t* P = (const bf16_t*)(p.ws + WS_R1); const bf16_t* O = (const bf16_t*)(p.ws + WS_R2);
  bf16_t* mixed = (bf16_t*)(p.ws + WS_MIX);
  const int hd = c.wid, sub = c.lane >> 3, pc = c.lane & 7;
  const int c0 = hd * 128 + pc * 16, cm = (hd & 3) * 128 + pc * 16;
  const float* gain = layer == 0 ? (hd < 4 ? p.in[I_HGRN_NORM] + cm : p.in[I_GLA_NORM] + cm) : (hd < 4 ? p.in[I_RET_NORM] + cm : p.in[I_MLSTM_NORM] + cm);
  const int gcol = layer == 0 ? (hd < 4 ? 2048 + cm : 3584 + cm) : (hd < 4 ? 1024 + cm : 3072 + cm);
  float gn[16];
#pragma unroll
  for (int j = 0; j < 16; ++j) gn[j] = gain[j];
  const int NG = NTOK / 8;
  for (int tg0 = c.bid; tg0 < NG; tg0 += 2 * c.G) {
    u32x4 ra[2][2], rb[2][2], rg[2][2];
#pragma unroll
    for (int u = 0; u < 2; ++u) { const int tg = tg0 + u * c.G < NG ? tg0 + u * c.G : tg0; const int tok = tg * 8 + sub;
      const u32x4* a = (const u32x4*)(O + PIDX(tok, c0)); const u32x4* b = (const u32x4*)(O + (size_t)NTOK * 1024 + PIDX(tok, c0)); const u32x4* g = (const u32x4*)(P + PIDX(tok, gcol));
      ra[u][0] = __builtin_nontemporal_load(a); ra[u][1] = __builtin_nontemporal_load(a + 1); rb[u][0] = __builtin_nontemporal_load(b); rb[u][1] = __builtin_nontemporal_load(b + 1);
      rg[u][0] = __builtin_nontemporal_load(g); rg[u][1] = __builtin_nontemporal_load(g + 1); }
#pragma unroll
    for (int u = 0; u < 2; ++u) {
      const int tg = tg0 + u * c.G; const int tok = tg * 8 + sub;
      float of[16], ob[16], gt[16];
      unpack8(ra[u][0], of); unpack8(ra[u][1], of + 8); unpack8(rb[u][0], ob); unpack8(rb[u][1], ob + 8); unpack8(rg[u][0], gt); unpack8(rg[u][1], gt + 8);
      float o[16]; float ss = 0.f;
#pragma unroll
      for (int j = 0; j < 16; ++j) { o[j] = of[j] + ob[j]; ss += o[j] * o[j]; }
      ss += __shfl_xor(ss, 1); ss += __shfl_xor(ss, 2); ss += __shfl_xor(ss, 4);
      const float r = 1.0f / sqrtf(ss * (1.0f / 128.0f) + NORM_EPS_F);
      unsigned w[8];
#pragma unroll
      for (int j = 0; j < 8; ++j) {
        float g0 = gt[2 * j], g1 = gt[2 * j + 1];
        if (layer == 1 && hd >= 4) { g0 = fsigmoid(g0); g1 = fsigmoid(g1); } else { g0 = fsilu(g0); g1 = fsilu(g1); }
        w[j] = pk2(o[2 * j] * r * gn[2 * j] * g0, o[2 * j + 1] * r * gn[2 * j + 1] * g1);
      }
      if (tg < NG) { u32x4* d = (u32x4*)(mixed + (size_t)tok * 1024 + c0);
        d[0] = (u32x4){w[0], w[1], w[2], w[3]}; d[1] = (u32x4){w[4], w[5], w[6], w[7]}; }
    }
  }
}

__device__ __forceinline__ void ln_phase(unsigned char* lds_, int wv, const Params& p, int layer, int mode, int dry = 0) {
  const Ctx c = make_ctx(lds_, wv);
  unsigned char* ws = p.ws;
  const bf16_t* zin = (const bf16_t*)(ws + (mode == 0 ? WS_R2 : WS_MIX));
  const bool f32out = (mode == 1 && layer == 1);
  float* hout = dry ? (float*)(ws + WS_H) : p.out;
  bf16_t* hb = dry ? (bf16_t*)(ws + WS_H) : (mode == 0 ? (bf16_t*)(ws + WS_MIX) : (bf16_t*)p.out);
  const float* g = p.in[mode == 0 ? I_LN_MIX_G : I_LN_FFN_G] + layer * 1024; const float* b = p.in[mode == 0 ? I_LN_MIX_B : I_LN_FFN_B] + layer * 1024;
  unsigned* cnt = (unsigned*)(ws + WS_CTL) + CW_CNT(layer);
  int* list = (int*)(ws + WS_LIST) + (size_t)layer * NEXP * NTOK;
  int* assign = (int*)(ws + WS_ASSIGN); float* gate = (float*)(ws + WS_GATE);
  float* rwT = (float*)c.lds;
  int* lcnt = (int*)(c.lds + 65536); int* lbase = lcnt + 16; int* rec = lcnt + 32; float* recg = (float*)(rec + 4 * 2048);
  int pad[NEXP];
  if (mode == 0) { const float* r = p.in[I_ROUTER_W];
    for (int i = c.tid; i < 1024 * 16; i += NTHREADS) rwT[(i & 15) * 1024 + (i >> 4)] = r[i];
    if (c.tid < 16) lcnt[c.tid] = 0;
    __syncthreads(); }
  else { int acc = 0;
#pragma unroll
    for (int e = 0; e < NEXP; ++e) { pad[e] = acc; acc += (((int)cnt[e * 16] + 255) >> 8) << 8; } }
  const int c0 = c.lane * 4;
  float gv[16], bv[16];
#pragma unroll
  for (int q = 0; q < 4; ++q) { const f32x4 t0 = *(const f32x4*)(g + q * 256 + c0), t1 = *(const f32x4*)(b + q * 256 + c0);
#pragma unroll
    for (int j = 0; j < 4; ++j) { gv[4 * q + j] = t0[j]; bv[4 * q + j] = t1[j]; } }
  const int tstride = c.G * 8;
  int it = 0;
  for (int tok0 = c.bid * 8 + c.wid; tok0 < NTOK; tok0 += 2 * tstride, it += 2) {
    float v[2][16];
    float gy0[2], gy1[2];
#pragma unroll
    for (int u = 0; u < 2; ++u) {
      const int tok = tok0 + u * tstride;
      if (tok < NTOK) {
        const float sc = mode == 0 ? 1.0f : ALPHA_F;
#pragma unroll
        for (int q = 0; q < 4; ++q) { const u32x2 t = __builtin_nontemporal_load((const u32x2*)(zin + (size_t)tok * 1024 + q * 256 + c0));
          v[u][4 * q] = sc * __uint_as_float(t.x << 16); v[u][4 * q + 1] = sc * __uint_as_float(t.x & 0xffff0000u); v[u][4 * q + 2] = sc * __uint_as_float(t.y << 16); v[u][4 * q + 3] = sc * __uint_as_float(t.y & 0xffff0000u); }
        if (mode == 1) {
          const int a0 = assign[tok * 4], a1 = assign[tok * 4 + 1], a2 = assign[tok * 4 + 2], a3 = assign[tok * 4 + 3];
          gy0[u] = gate[tok * 2]; gy1[u] = gate[tok * 2 + 1];
          int p0 = 0, p1 = 0;
#pragma unroll
          for (int e = 0; e < NEXP; ++e) { if (e == a0) p0 = pad[e]; if (e == a2) p1 = pad[e]; }
          p0 += a1; p1 += a3;
          const bf16_t* Y = (const bf16_t*)(ws + WS_R2);
#pragma unroll
          for (int q = 0; q < 4; ++q) { const u32x2 y0 = __builtin_nontemporal_load((const u32x2*)(Y + (size_t)p0 * 1024 + q * 256 + c0)), y1 = __builtin_nontemporal_load((const u32x2*)(Y + (size_t)p1 * 1024 + q * 256 + c0));
            v[u][4 * q] += gy0[u] * __uint_as_float(y0.x << 16) + gy1[u] * __uint_as_float(y1.x << 16); v[u][4 * q + 1] += gy0[u] * __uint_as_float(y0.x & 0xffff0000u) + gy1[u] * __uint_as_float(y1.x & 0xffff0000u);
            v[u][4 * q + 2] += gy0[u] * __uint_as_float(y0.y << 16) + gy1[u] * __uint_as_float(y1.y << 16); v[u][4 * q + 3] += gy0[u] * __uint_as_float(y0.y & 0xffff0000u) + gy1[u] * __uint_as_float(y1.y & 0xffff0000u); }
        }
      } else {
#pragma unroll
        for (int j = 0; j < 16; ++j) v[u][j] = 0.f;
      }
    }
#pragma unroll
    for (int u = 0; u < 2; ++u) {
      const int tok = tok0 + u * tstride;
      float s = 0.f;
#pragma unroll
      for (int j = 0; j < 16; ++j) s += v[u][j];
      const float mean = wave_sum(s) * (1.0f / 1024.0f);
      float qq = 0.f;
#pragma unroll
      for (int j = 0; j < 16; ++j) { v[u][j] -= mean; qq += v[u][j] * v[u][j]; }
      const float r = 1.0f / sqrtf(wave_sum(qq) * (1.0f / 1024.0f) + LN_EPS_F);
#pragma unroll
      for (int j = 0; j < 16; ++j) v[u][j] = v[u][j] * r * gv[j] + bv[j];
      if (tok < NTOK) {
        if (f32out) {
#pragma unroll
          for (int q = 0; q < 4; ++q) __builtin_nontemporal_store((f32x4){v[u][4 * q], v[u][4 * q + 1], v[u][4 * q + 2], v[u][4 * q + 3]}, (f32x4*)(hout + (size_t)tok * 1024 + q * 256 + c0));
        } else {
#pragma unroll
          for (int q = 0; q < 4; ++q) *(u32x2*)(hb + (size_t)tok * 1024 + q * 256 + c0) = (u32x2){pk2(v[u][4 * q], v[u][4 * q + 1]), pk2(v[u][4 * q + 2], v[u][4 * q + 3])}; }
      }
      if (mode == 0) {
        float lg[16];
#pragma unroll
        for (int e = 0; e < 16; ++e) { float a = 0.f;
#pragma unroll
          for (int q = 0; q < 4; ++q) { const f32x4 w = *(const f32x4*)(rwT + e * 1024 + q * 256 + c0); a += v[u][4 * q] * w[0] + v[u][4 * q + 1] * w[1] + v[u][4 * q + 2] * w[2] + v[u][4 * q + 3] * w[3]; }
          lg[e] = a; }
#pragma unroll
        for (int e = 0; e < 16; ++e) lg[e] = wave_sum(lg[e]);
        int eo[2]; float go[2];
        route_from_logits(lg, p.in[I_ROUTER_B], eo, go);
        if (c.lane == 0 && tok < NTOK && !dry) {
          const int r1 = atomicAdd(lcnt + eo[0], 1), r2 = atomicAdd(lcnt + eo[1], 1);
          const int ri = (it + u) * 8 + c.wid;
          rec[ri * 4] = eo[0]; rec[ri * 4 + 1] = r1; rec[ri * 4 + 2] = eo[1]; rec[ri * 4 + 3] = r2; recg[ri * 2] = go[0]; recg[ri * 2 + 1] = go[1];
        }
      }
    }
  }
  if (mode == 0 && !dry) {
    __syncthreads();
    if (c.tid < 16) lbase[c.tid] = (int)atomicAdd(cnt + c.tid * 16, (unsigned)lcnt[c.tid]);
    __syncthreads();
    const int nrec = ((NTOK + c.G * 8 - 1) / (c.G * 8)) * 8;
    for (int ri = c.tid; ri < nrec; ri += NTHREADS) {
      const int tok = c.bid * 8 + (ri & 7) + (ri >> 3) * c.G * 8;
      if (tok < NTOK) {
        const int e1 = rec[ri * 4], e2 = rec[ri * 4 + 2]; const int r1 = rec[ri * 4 + 1] + lbase[e1], r2 = rec[ri * 4 + 3] + lbase[e2];
        list[e1 * NTOK + r1] = tok; list[e2 * NTOK + r2] = tok;
        assign[tok * 4] = e1; assign[tok * 4 + 1] = r1; assign[tok * 4 + 2] = e2; assign[tok * 4 + 3] = r2;
        gate[tok * 2] = recg[ri * 2]; gate[tok * 2 + 1] = recg[ri * 2 + 1];
      }
    }
  }
  __syncthreads();
}
#endif
#ifndef CPU_EMU
namespace scan {
typedef short bf16x8 __attribute__((ext_vector_type(8)));
typedef float f32x4 __attribute__((ext_vector_type(4)));
typedef unsigned u32x4 __attribute__((ext_vector_type(4)));
typedef unsigned u32x2 __attribute__((ext_vector_type(2)));
enum { MIX_A = 0, MIX_B = 1, MIX_C = 2, MIX_D = 3 };
constexpr int LD_T = 144;
constexpr int OFF_QS = 0, OFF_KS = 17408, OFF_QI = 34816, OFF_KT = 52224, OFF_VT = 70656, OFF_SC = 77568, OFF_ST = 86784, OFF_DEC = 99840, OFF_EM = 100352, OFF_DEN = 100608, OFF_CW = 100864, SCAN_LDS = 104960;

__device__ __forceinline__ float incl_scan_add(float x) {
  x += __builtin_bit_cast(float, __builtin_amdgcn_update_dpp(0, __builtin_bit_cast(int, x), 0x111, 0xf, 0xf, false));
  x += __builtin_bit_cast(float, __builtin_amdgcn_update_dpp(0, __builtin_bit_cast(int, x), 0x112, 0xf, 0xf, false));
  x += __builtin_bit_cast(float, __builtin_amdgcn_update_dpp(0, __builtin_bit_cast(int, x), 0x114, 0xf, 0xf, false));
  x += __builtin_bit_cast(float, __builtin_amdgcn_update_dpp(0, __builtin_bit_cast(int, x), 0x118, 0xf, 0xf, false));
  dpp_bcast_add(x);
  return x;
}
__device__ __forceinline__ float incl_scan_max(float x) {
  const int ninf = (int)0xff800000u;
  x = fmaxf(x, __builtin_bit_cast(float, __builtin_amdgcn_update_dpp(ninf, __builtin_bit_cast(int, x), 0x111, 0xf, 0xf, false)));
  x = fmaxf(x, __builtin_bit_cast(float, __builtin_amdgcn_update_dpp(ninf, __builtin_bit_cast(int, x), 0x112, 0xf, 0xf, false)));
  x = fmaxf(x, __builtin_bit_cast(float, __builtin_amdgcn_update_dpp(ninf, __builtin_bit_cast(int, x), 0x114, 0xf, 0xf, false)));
  x = fmaxf(x, __builtin_bit_cast(float, __builtin_amdgcn_update_dpp(ninf, __builtin_bit_cast(int, x), 0x118, 0xf, 0xf, false)));
  dpp_bcast_max(x);
  return x;
}
__device__ __forceinline__ float rdlane(float x, int l) { return __builtin_bit_cast(float, __builtin_amdgcn_readlane(__builtin_bit_cast(int, x), l)); }
__device__ __forceinline__ bf16x8 ldfrag(const unsigned char* base, int ld, int row, int kbyte) { return *(const bf16x8*)(base + row * ld + kbyte); }
__device__ __forceinline__ bf16x8 ldfrag2(const unsigned char* base, int ld, int row, int b0, int b1) {
  const u32x2 lo = *(const u32x2*)(base + row * ld + b0), hi = *(const u32x2*)(base + row * ld + b1);
  return __builtin_bit_cast(bf16x8, (u32x4){lo.x, lo.y, hi.x, hi.y}); }
__device__ __forceinline__ unsigned pk(float a, float b) { return pk_hw(a, b); }
__device__ __forceinline__ float lo16(unsigned w) { return __uint_as_float(w << 16); }
__device__ __forceinline__ float hi16(unsigned w) { return __uint_as_float(w & 0xffff0000u); }

__device__ __forceinline__ void lds_barrier() { asm volatile("s_waitcnt lgkmcnt(0)" ::: "memory"); __builtin_amdgcn_s_barrier(); asm volatile("" ::: "memory"); }
struct Raw { u32x4 a0, a1, b0, b1; f32x4 r0, r1; u32x2 v; float s0, s1; };

}

__device__ __forceinline__ void convd_phase(unsigned char* lds_, int wv, const Params& p) {
  const Ctx c = make_ctx(lds_, wv);
  bf16_t* P = (bf16_t*)(p.ws + WS_R1); bf16_t* QD = (bf16_t*)(p.ws + WS_LFB);
  const float* cw = p.in[I_CONV_W]; const float* cb = p.in[I_CONV_B];
  const int ch = c.lane * 16;
  float w0[16], w1[16], w2[16], bb[16];
#pragma unroll
  for (int j = 0; j < 16; ++j) { w0[j] = cw[ch + j]; w1[j] = cw[1024 + ch + j]; w2[j] = cw[2048 + ch + j]; bb[j] = cb[ch + j]; }
  for (int tok = c.bid * 8 + c.wid; tok < NTOK; tok += c.G * 8) {
    const int t = tok % SEQ;
    const bf16_t* row = P + PIDX(tok, 1536 + ch);
    float x0[16], x1[16], x2[16];
    { const u32x4* r1 = (const u32x4*)row; unpack8(r1[0], x1); unpack8(r1[1], x1 + 8); }
    if (t > 0) { const u32x4* r0 = (const u32x4*)(row - 128); unpack8(r0[0], x0); unpack8(r0[1], x0 + 8); }
    else {
#pragma unroll
      for (int j = 0; j < 16; ++j) x0[j] = 0.f; }
    if (t < SEQ - 1) { const u32x4* r2 = (const u32x4*)(row + 128); unpack8(r2[0], x2); unpack8(r2[1], x2 + 8); }
    else {
#pragma unroll
      for (int j = 0; j < 16; ++j) x2[j] = 0.f; }
    const float sc = ch < 512 ? 0.08838834764831845f : 1.0f;
    unsigned w[8];
#pragma unroll
    for (int j = 0; j < 8; ++j) {
      const float a0 = bb[2 * j] + w0[2 * j] * x0[2 * j] + w1[2 * j] * x1[2 * j] + w2[2 * j] * x2[2 * j];
      const float a1 = bb[2 * j + 1] + w0[2 * j + 1] * x0[2 * j + 1] + w1[2 * j + 1] * x1[2 * j + 1] + w2[2 * j + 1] * x2[2 * j + 1];
      w[j] = pk2(fsilu(a0) * sc, fsilu(a1) * sc);
    }
    bf16_t* d = (ch < 512) ? QD + PIDX8(tok, ch) : P + PIDX8(tok, 3584 + (ch - 512));
    *(u32x4*)d = (u32x4){w[0], w[1], w[2], w[3]}; *(u32x4*)(d + (size_t)NTOK * 8) = (u32x4){w[4], w[5], w[6], w[7]};
  }
}

#endif
#ifndef CPU_EMU
namespace scan2 {
using namespace scan;
#ifndef PROBE_ALLTILES
#define PROBE_ALLTILES 0
#endif
__device__ __forceinline__ float FMUL(float a, float b) { float r = a * b; asm("" : "+v"(r)); return r; }
constexpr int U_QI = 0, U_KS = 36864, U_VT = 73728, U_ST = 87552, U_DEC = 115200, U_EM = 116224, U_XCH = 116736, U_END = 134144;
typedef short s16x4 __attribute__((ext_vector_type(4)));
__device__ __forceinline__ bf16x8 ldfrag_tr(const unsigned char* p, int ld) {
  const s16x4 a = __builtin_amdgcn_ds_read_tr16_b64_v4i16((LAS s16x4*)p), b = __builtin_amdgcn_ds_read_tr16_b64_v4i16((LAS s16x4*)(p + 4 * ld));
  return (bf16x8){a.x, a.y, a.z, a.w, b.x, b.y, b.z, b.w}; }
template <int MIXER>
__device__ __forceinline__ void scan_item2(unsigned char* lds, int wv, const Params& p, int b, int h, int dir, int vs) {
  constexpr int DK = (MIXER == MIX_A || MIXER == MIX_D) ? 128 : 64;
  constexpr int NC = DK / 8;
  constexpr int LD_D = DK * 2 + 32;
  constexpr int NVT = MIXER == MIX_D ? 3 : 2;
  constexpr int NKD = DK / 32;
  constexpr int NST = (DK == 128) ? NVT : 1;
  constexpr int NCH = SEQ / 64;
  const int tid = opaque_tid(wv), lane0 = tid & 63, wid = __builtin_amdgcn_readfirstlane(tid >> 6);
  unsigned char* ws = p.ws;
  const bf16_t* P = (const bf16_t*)(ws + WS_R1);
  const bf16_t* LFBp = (const bf16_t*)(ws + WS_LFB);
  const float* side = (const float*)(ws + WS_SIDE);
  const float* rope = (const float*)(ws + WS_ROPE);
  bf16_t* O = (bf16_t*)(ws + WS_R2) + (size_t)dir * NTOK * 1024;
  int qcol, kcol, lfcol, vcol, ocol;
  if (MIXER == MIX_A) { qcol = h * 128; kcol = 0; lfcol = 512 + dir * 512 + h * 128; vcol = 1536 + h * 128 + vs * 32; ocol = h * 128 + vs * 32; }
  else if (MIXER == MIX_B) { qcol = 2560 + h * 64; kcol = 2816 + h * 64; lfcol = dir * 256 + h * 64; vcol = 3072 + h * 128 + vs * 32; ocol = 512 + h * 128 + vs * 32; }
  else if (MIXER == MIX_C) { qcol = h * 64; kcol = 256 + h * 64; lfcol = 0; vcol = 512 + h * 128 + vs * 32; ocol = h * 128 + vs * 32; }
  else { qcol = h * 128; kcol = 3584 + h * 128; lfcol = 0; vcol = 2560 + h * 128 + vs * 32; ocol = 512 + h * 128 + vs * 32; }
  const size_t tokbase = (size_t)b * SEQ;
  const int c0 = (MIXER == MIX_C) ? wid * 4 : wid * NC;
  for (int i = tid; i < 2 * 13824 / 4; i += NTHREADS) ((unsigned*)(lds + U_ST))[i] = 0u;

  if (MIXER == MIX_D) { for (int i = tid; i < 2 * 16 * 64; i += NTHREADS) { const int bf = i >> 10, r = 32 + ((i >> 6) & 15), j = i & 63; *(bf16_t*)(lds + U_VT + bf * 6912 + r * LD_T + j * 2) = (r == 32) ? (bf16_t)0x3F80 : (bf16_t)0; } }
  const float lgam2 = (MIXER == MIX_C) ? log1pf(-exp2f(-(5.0f + 2.0f * (float)h + (float)dir))) * 1.4426950408889634f : 0.f;
  const float fgb = (MIXER == MIX_D) ? p.in[I_FGATE_B][dir * 4 + h] : 0.f;
  float m_st = 0.f;
  __syncthreads();

  Raw R, Rn; u32x2 Rv, Rvn;
#if (PROBE_DUP & 8388608)
  Raw RD; u32x2 RvD; RD.a0 = RD.a1 = RD.b0 = RD.b1 = (u32x4){0u, 0u, 0u, 0u}; RvD = (u32x2){0u, 0u};
#endif
#define A_LOAD(R, Rv, n_) do { \
    const int ln_ = lane0; \
    const int t_ = dir ? (SEQ - 1 - ((n_) * 64 + ln_)) : ((n_) * 64 + ln_); \
    const size_t tk_ = tokbase + t_; \
    if (MIXER == MIX_A) { const bf16_t* qp_ = P + PIDX8(tk_, qcol + c0); const bf16_t* lp_ = P + PIDX8(tk_, lfcol + c0); \
      R.a0 = *(const u32x4*)qp_; R.a1 = *(const u32x4*)(qp_ + (size_t)NTOK * 8); R.b0 = *(const u32x4*)lp_; R.b1 = *(const u32x4*)(lp_ + (size_t)NTOK * 8); } \
    else if (MIXER == MIX_B) { R.a0 = *(const u32x4*)(P + PIDX8(tk_, qcol + c0)); R.a1 = *(const u32x4*)(P + PIDX8(tk_, kcol + c0)); R.b0 = *(const u32x4*)(LFBp + PIDX8(tk_, lfcol + c0)); } \
    else if (MIXER == MIX_C) { const u32x2 qa_ = *(const u32x2*)(P + PIDX8(tk_, qcol + c0)), qb_ = *(const u32x2*)(P + PIDX8(tk_, qcol + 32 + c0)), ka_ = *(const u32x2*)(P + PIDX8(tk_, kcol + c0)), kb_ = *(const u32x2*)(P + PIDX8(tk_, kcol + 32 + c0)); \
      R.a0 = (u32x4){qa_.x, qa_.y, qb_.x, qb_.y}; R.a1 = (u32x4){ka_.x, ka_.y, kb_.x, kb_.y}; \
      const float* rp_ = rope + ((size_t)(c0 >> 2) * SEQ + t_) * 8; R.r0 = *(const f32x4*)rp_; R.r1 = *(const f32x4*)(rp_ + 4); } \
    else { const bf16_t* qp_ = LFBp + PIDX8(tk_, qcol + c0); const bf16_t* kp_ = P + PIDX8(tk_, kcol + c0); \
      R.a0 = *(const u32x4*)qp_; R.a1 = *(const u32x4*)(qp_ + (size_t)NTOK * 8); R.b0 = *(const u32x4*)kp_; R.b1 = *(const u32x4*)(kp_ + (size_t)NTOK * 8); \
      R.s0 = side[(size_t)(dir * 8 + h) * NTOK + tk_]; R.s1 = side[(size_t)(dir * 8 + 4 + h) * NTOK + tk_]; } \
    Rv = *(const u32x2*)(P + PIDX8(tk_, vcol + wid * 4)); } while (0)

  float rr_next = 1.f, rr_cur = 1.f, dsold_next = 1.f, dsold_cur = 1.f, ws_next = 1.f, ws_cur = 1.f;
#define A_PREP(buf_, R, Rv) do { \
    const int lane = lane0; \
    float* DECb = (float*)(lds + U_DEC + (buf_) * 512); float* EMb = (float*)(lds + U_EM + (buf_) * 256); \
    unsigned char* QIb = lds + U_QI + (buf_) * 18432; unsigned char* KSb = lds + U_KS + (buf_) * 18432; \
    float q[NC], k[NC], g[NC]; \
    if (MIXER == MIX_A) { \
      const unsigned qw[8] = {R.a0.x, R.a0.y, R.a0.z, R.a0.w, R.a1.x, R.a1.y, R.a1.z, R.a1.w}, lw[8] = {R.b0.x, R.b0.y, R.b0.z, R.b0.w, R.b1.x, R.b1.y, R.b1.z, R.b1.w}; \
      _Pragma("unroll") for (int c = 0; c < 8; ++c) { q[2 * c] = lo16(qw[c]); q[2 * c + 1] = hi16(qw[c]); g[2 * c] = lo16(lw[c]); g[2 * c + 1] = hi16(lw[c]); } \
      _Pragma("unroll") for (int c = 0; c < NC; ++c) k[c] = 1.0f - __builtin_amdgcn_exp2f(g[c]); \
    } else if (MIXER == MIX_B) { \
      const unsigned qw[4] = {R.a0.x, R.a0.y, R.a0.z, R.a0.w}, kw[4] = {R.a1.x, R.a1.y, R.a1.z, R.a1.w}, lw[4] = {R.b0.x, R.b0.y, R.b0.z, R.b0.w}; \
      _Pragma("unroll") for (int c = 0; c < 4; ++c) { q[2 * c] = lo16(qw[c]); q[2 * c + 1] = hi16(qw[c]); k[2 * c] = lo16(kw[c]); k[2 * c + 1] = hi16(kw[c]); g[2 * c] = lo16(lw[c]); g[2 * c + 1] = hi16(lw[c]); } \
    } else if (MIXER == MIX_C) { \
      const float cs[4] = {R.r0[0], R.r0[2], R.r1[0], R.r1[2]}, sn[4] = {R.r0[1], R.r0[3], R.r1[1], R.r1[3]}; \
      const float q1[4] = {lo16(R.a0.x), hi16(R.a0.x), lo16(R.a0.y), hi16(R.a0.y)}, q2[4] = {lo16(R.a0.z), hi16(R.a0.z), lo16(R.a0.w), hi16(R.a0.w)}; \
      const float k1[4] = {lo16(R.a1.x), hi16(R.a1.x), lo16(R.a1.y), hi16(R.a1.y)}, k2[4] = {lo16(R.a1.z), hi16(R.a1.z), lo16(R.a1.w), hi16(R.a1.w)}; \
      _Pragma("unroll") for (int c = 0; c < 4; ++c) { q[c] = (q1[c] * cs[c] - q2[c] * sn[c]) * 0.125f; q[4 + c] = (q1[c] * sn[c] + q2[c] * cs[c]) * 0.125f; k[c] = k1[c] * cs[c] - k2[c] * sn[c]; k[4 + c] = k1[c] * sn[c] + k2[c] * cs[c]; } \
    } else { \
      const unsigned qw[8] = {R.a0.x, R.a0.y, R.a0.z, R.a0.w, R.a1.x, R.a1.y, R.a1.z, R.a1.w}, kw[8] = {R.b0.x, R.b0.y, R.b0.z, R.b0.w, R.b1.x, R.b1.y, R.b1.z, R.b1.w}; \
      _Pragma("unroll") for (int c = 0; c < 8; ++c) { q[2 * c] = lo16(qw[c]); q[2 * c + 1] = hi16(qw[c]); k[2 * c] = lo16(kw[c]); k[2 * c + 1] = hi16(kw[c]); } \
    } \
    if (MIXER == MIX_A || MIXER == MIX_B) { \
        \
      _Pragma("unroll") for (int c = 0; c < NC; ++c) g[c] += __builtin_bit_cast(float, __builtin_amdgcn_update_dpp(0, __builtin_bit_cast(int, g[c]), 0x111, 0xf, 0xf, false)); \
      _Pragma("unroll") for (int c = 0; c < NC; ++c) g[c] += __builtin_bit_cast(float, __builtin_amdgcn_update_dpp(0, __builtin_bit_cast(int, g[c]), 0x112, 0xf, 0xf, false)); \
      _Pragma("unroll") for (int c = 0; c < NC; ++c) g[c] += __builtin_bit_cast(float, __builtin_amdgcn_update_dpp(0, __builtin_bit_cast(int, g[c]), 0x114, 0xf, 0xf, false)); \
      _Pragma("unroll") for (int c = 0; c < NC; ++c) g[c] += __builtin_bit_cast(float, __builtin_amdgcn_update_dpp(0, __builtin_bit_cast(int, g[c]), 0x118, 0xf, 0xf, false)); \
      dpp_bcast_add(g); \
      float ev[NC]; \
      _Pragma("unroll") for (int c = 0; c < NC; ++c) { \
          \
        const float e = __builtin_amdgcn_exp2f(g[c]), r = __builtin_amdgcn_rcpf(e); \
        q[c] = FMUL(q[c], e); k[c] = FMUL(k[c], r);     \
        ev[c] = e; } \
      if (lane == 63) { _Pragma("unroll") for (int c = 0; c < NC / 4; ++c) *(f32x4*)(DECb + c0 + 4 * c) = (f32x4){ev[4 * c], ev[4 * c + 1], ev[4 * c + 2], ev[4 * c + 3]}; } \
    } else if (MIXER == MIX_C) { \
        \
      const float gl = (float)(lane + 1) * lgam2; \
      const float e = __builtin_amdgcn_exp2f(gl), r = __builtin_amdgcn_rcpf(e); \
      const float e63 = rdlane(e, 63); \
      _Pragma("unroll") for (int c = 0; c < NC; ++c) { q[c] = FMUL(q[c], e); k[c] = FMUL(k[c], r); } \
      if (lane < 4) { DECb[c0 + lane] = e63; DECb[32 + c0 + lane] = e63; } \
    } else { \
      const float li = R.s0, lf = R.s1;     \
      const float bc = incl_scan_add(lf); const float u = li - bc; const float pm = incl_scan_max(u); \
      const float cmax = rdlane(pm, 63), blast = rdlane(bc, 63); \
      const float a_i = bc + m_st, m_i = fmaxf(a_i, bc + pm); \
      const float d_alpha = __builtin_amdgcn_exp2f(bc - m_i + cmax), d_beta = __builtin_amdgcn_exp2f(u - cmax); \
      rr_next = __builtin_amdgcn_exp2f(m_st - cmax);     \
      const float m_new = fmaxf(blast + m_st, blast + cmax); \
        \
      dsold_next = __builtin_amdgcn_exp2f(blast + m_st - m_new); ws_next = __builtin_amdgcn_exp2f(blast + cmax - m_new); m_st = m_new; \
      _Pragma("unroll") for (int c = 0; c < NC; ++c) { q[c] = FMUL(q[c], d_alpha); k[c] = FMUL(k[c], d_beta); } \
      if (wid == 0) EMb[lane] = __builtin_amdgcn_exp2f(-m_i); \
    } \
    { unsigned pq[NC / 2], pks[NC / 2]; \
      _Pragma("unroll") for (int c = 0; c < NC / 2; ++c) { pq[c] = pk_hw(q[2 * c], q[2 * c + 1]); pks[c] = pk_hw(k[2 * c], k[2 * c + 1]); } \
      if (MIXER == MIX_C) { \
        *(u32x2*)(QIb + lane * LD_D + c0 * 2) = (u32x2){pq[0], pq[1]}; *(u32x2*)(QIb + lane * LD_D + (32 + c0) * 2) = (u32x2){pq[2], pq[3]}; \
        *(u32x2*)(KSb + lane * LD_D + c0 * 2) = (u32x2){pks[0], pks[1]}; *(u32x2*)(KSb + lane * LD_D + (32 + c0) * 2) = (u32x2){pks[2], pks[3]}; \
      } else { \
        _Pragma("unroll") for (int c = 0; c < NC / 8; ++c) { \
          *(u32x4*)(QIb + lane * LD_D + (c0 + 8 * c) * 2) = (u32x4){pq[4 * c], pq[4 * c + 1], pq[4 * c + 2], pq[4 * c + 3]}; \
          *(u32x4*)(KSb + lane * LD_D + (c0 + 8 * c) * 2) = (u32x4){pks[4 * c], pks[4 * c + 1], pks[4 * c + 2], pks[4 * c + 3]}; } } } \
    { unsigned char* VTb = lds + U_VT + (buf_) * 6912 + (wid * 4) * LD_T + lane * 2; \
      *(bf16_t*)(VTb + 0 * LD_T) = (bf16_t)(Rv.x & 0xffff); *(bf16_t*)(VTb + 1 * LD_T) = (bf16_t)(Rv.x >> 16); *(bf16_t*)(VTb + 2 * LD_T) = (bf16_t)(Rv.y & 0xffff); *(bf16_t*)(VTb + 3 * LD_T) = (bf16_t)(Rv.y >> 16); } \
  } while (0)
  f32x4 sacc[NST];
  f32x4 own_prev = (f32x4){0.f, 0.f, 0.f, 0.f}; float den_prev = 1.f, em_prev = 1.f;
#pragma unroll
  for (int i = 0; i < NST; ++i) sacc[i] = (f32x4){0.f, 0.f, 0.f, 0.f};
  A_LOAD(R, Rv, 0);
  A_PREP(0, R, Rv);
  A_LOAD(R, Rv, 1);
  A_LOAD(Rn, Rvn, 2);
  rr_cur = rr_next; dsold_cur = dsold_next; ws_cur = ws_next;
  lds_barrier();
#if (PROBE_DUP & 8388608)
#define SCAN_PROBE_LOAD(n_) { asm volatile("" :: "v"(RD.a0), "v"(RD.a1), "v"(RD.b0), "v"(RD.b1), "v"(RvD)); A_LOAD(RD, RvD, n_); }
#else
#define SCAN_PROBE_LOAD(n_)
#endif
#if (PROBE_DUP & (32768 | 131072))
#define SCAN_PROBE_PREP(RX, RvX) if ((PROBE_DUP & 32768) ? (DK == 128) : (DK == 64)) { const float m_sv_ = m_st; A_PREP(nb, RX, RvX); m_st = m_sv_; asm volatile("" : "+v"(RX.a0), "+v"(RX.a1), "+v"(RX.b0), "+v"(RX.b1), "+v"(RvX) :: "memory"); }
#else
#define SCAN_PROBE_PREP(RX, RvX)
#endif
#define SCAN_ITER(n_, RX, RvX) do { const int n = (n_); \
    const int cb = n & 1, nb = (n + 1) & 1; \
    if (n + 1 < NCH) { SCAN_PROBE_PREP(RX, RvX) A_PREP(nb, RX, RvX); if (n + 3 < NCH) { A_LOAD(RX, RvX, n + 3); SCAN_PROBE_LOAD(n + 3) } } \
    { \
      const int lane = lane0; \
      const int fr = lane & 15, fq = lane >> 4; \
      const int it = wid & 3, vt = wid >> 2; \
      const unsigned char* STc = lds + U_ST + cb * 13824; unsigned char* STn = lds + U_ST + nb * 13824; \
      const unsigned char* VTc = lds + U_VT + cb * 6912; \
      const unsigned char* QI = lds + U_QI + cb * 18432; const unsigned char* KS = lds + U_KS + cb * 18432; \
      const float* DECc = (const float*)(lds + U_DEC + cb * 512); const float* EMc = (const float*)(lds + U_EM + cb * 256); \
        \
        \
      bf16x8 qf[NKD], stf[NKD], dsf[NKD], ksf[2][NKD]; \
_Pragma("unroll") \
      for (int ks = 0; ks < NKD; ++ks) qf[ks] = ldfrag(QI, LD_D, it * 16 + fr, ks * 64 + fq * 16); \
_Pragma("unroll") \
      for (int ks = 0; ks < NKD; ++ks) stf[ks] = ldfrag(STc, LD_D, vt * 16 + fr, ks * 64 + fq * 16); \
_Pragma("unroll") \
      for (int ks = 0; ks < NKD; ++ks) dsf[ks] = (NVT == 3) ? ldfrag(STc, LD_D, 32 + fr, ks * 64 + fq * 16) : qf[ks]; \
_Pragma("unroll") \
      for (int j = 0; j < 2; ++j) { \
_Pragma("unroll") \
        for (int ks = 0; ks < NKD; ++ks) ksf[j][ks] = ldfrag(KS, LD_D, (2 * vt + j) * 16 + fr, ks * 64 + fq * 16); } \
      __builtin_amdgcn_sched_barrier(0); \
      f32x4 oacc = (f32x4){0.f, 0.f, 0.f, 0.f}, dacc = (f32x4){0.f, 0.f, 0.f, 0.f}; \
_Pragma("unroll") \
      for (int ks = 0; ks < NKD; ++ks) oacc = __builtin_amdgcn_mfma_f32_16x16x32_bf16(stf[ks], qf[ks], oacc, 0, 0, 0); \
      if (NVT == 3) { \
_Pragma("unroll") \
        for (int ks = 0; ks < NKD; ++ks) dacc = __builtin_amdgcn_mfma_f32_16x16x32_bf16(dsf[ks], qf[ks], dacc, 0, 0, 0); \
      } \
        \
      f32x4 sc[2]; \
_Pragma("unroll") \
      for (int j = 0; j < 2; ++j) { \
        f32x4 acc = (f32x4){0.f, 0.f, 0.f, 0.f}; \
_Pragma("unroll") \
        for (int ks = 0; ks < NKD; ++ks) acc = __builtin_amdgcn_mfma_f32_16x16x32_bf16(ksf[j][ks], qf[ks], acc, 0, 0, 0); \
        sc[j] = acc; } \
        \
        \
      const bf16x8 va_own = ldfrag2(VTc, LD_T, vt * 16 + fr, 64 * vt + fq * 8, 64 * vt + 32 + fq * 8), va_oth = ldfrag2(VTc, LD_T, (1 - vt) * 16 + fr, 64 * vt + fq * 8, 64 * vt + 32 + fq * 8); \
      const bf16x8 vd = (NVT == 3) ? ldfrag2(VTc, LD_T, 32 + fr, 64 * vt + fq * 8, 64 * vt + 32 + fq * 8) : va_own; \
      const int dts = (DK == 128) ? wid : (wid & 3); \
        \
      const unsigned char* ktp = KS + (fq * 8 + (fr >> 2)) * LD_D + (dts * 16 + (fr & 3) * 4) * 2; \
      const bf16x8 kf0 = ldfrag_tr(ktp, LD_D), kf1 = ldfrag_tr(ktp + 32 * LD_D, LD_D); \
      const f32x4 dc = *(const f32x4*)(DECc + dts * 16 + fq * 4); \
      bf16x8 vtf[NST][2]; \
_Pragma("unroll") \
      for (int s = 0; s < NST; ++s) { const int vt2 = (DK == 128) ? s : (wid >> 2); vtf[s][0] = ldfrag(VTc, LD_T, vt2 * 16 + fr, fq * 16); vtf[s][1] = ldfrag(VTc, LD_T, vt2 * 16 + fr, 64 + fq * 16); } \
      const float em = (NVT == 3) ? EMc[it * 16 + fr] : 0.f; \
        \
      const unsigned char* xprev = lds + U_XCH + (nb * 8 + (wid ^ 4)) * 1088; unsigned char* xown = lds + U_XCH + (cb * 8 + wid) * 1088; \
      const f32x4 pp = *(const f32x4*)(xprev + lane * 16); \
      const float pd = (NVT == 3) ? (*(const float*)(xprev + 1024 + fr * 4) + *(const float*)(lds + U_XCH + (nb * 8 + wid) * 1088 + 1024 + fr * 4)) : 1.f; \
      __builtin_amdgcn_sched_barrier(0); \
        \
      if (n > 0) { \
        float dn = 1.0f; \
        if (NVT == 3) dn = 1.0f / fmaxf(fabsf(den_prev + pd), em_prev); \
        const int i = it * 16 + fr; \
        const int ti = dir ? (SEQ - 1 - ((n - 1) * 64 + i)) : ((n - 1) * 64 + i); \
        const f32x4 o = (f32x4){FMUL(own_prev[0] + pp[0], dn), FMUL(own_prev[1] + pp[1], dn), FMUL(own_prev[2] + pp[2], dn), FMUL(own_prev[3] + pp[3], dn)}; \
        *(u32x2*)(O + PIDX(tokbase + ti, ocol + vt * 16 + fq * 4)) = (u32x2){pk_hw(o[0], o[1]), pk_hw(o[2], o[3])}; \
      } \
        \
_Pragma("unroll") \
      for (int s = 0; s < NST; ++s) { \
        const int dt = dts, vt2 = (DK == 128) ? s : (wid >> 2); \
        f32x4 acc = (MIXER == MIX_D) ? (f32x4){0.f, 0.f, 0.f, 0.f} : sacc[s]; \
        acc = __builtin_amdgcn_mfma_f32_16x16x32_bf16(kf0, vtf[s][0], acc, 0, 0, 0); \
        acc = __builtin_amdgcn_mfma_f32_16x16x32_bf16(kf1, vtf[s][1], acc, 0, 0, 0); \
        if (MIXER == MIX_D) { _Pragma("unroll") for (int e_ = 0; e_ < 4; ++e_) acc[e_] = FMUL(sacc[s][e_], dsold_cur) + FMUL(acc[e_], ws_cur); } \
        else { _Pragma("unroll") for (int e_ = 0; e_ < 4; ++e_) acc[e_] = FMUL(acc[e_], dc[e_]); } \
        sacc[s] = acc; \
        *(u32x2*)(STn + (vt2 * 16 + fr) * LD_D + (dt * 16 + fq * 4) * 2) = (u32x2){pk_hw(acc[0], acc[1]), pk_hw(acc[2], acc[3])}; \
      } \
        \
        \
        \
      const int thr = it * 16 + fr - fq * 4 - 32 * vt; \
      const u32x4 sb = (u32x4){pk_hw((0 <= thr) ? sc[0][0] : 0.f, (1 <= thr) ? sc[0][1] : 0.f), pk_hw((2 <= thr) ? sc[0][2] : 0.f, (3 <= thr) ? sc[0][3] : 0.f), \
                               pk_hw((16 <= thr) ? sc[1][0] : 0.f, (17 <= thr) ? sc[1][1] : 0.f), pk_hw((18 <= thr) ? sc[1][2] : 0.f, (19 <= thr) ? sc[1][3] : 0.f)}; \
      if (MIXER == MIX_D) { _Pragma("unroll") for (int e_ = 0; e_ < 4; ++e_) { oacc[e_] = FMUL(oacc[e_], rr_cur); dacc[e_] = FMUL(dacc[e_], rr_cur); } } \
      own_prev = __builtin_amdgcn_mfma_f32_16x16x32_bf16(va_own, __builtin_bit_cast(bf16x8, sb), oacc, 0, 0, 0); \
      const f32x4 oth = __builtin_amdgcn_mfma_f32_16x16x32_bf16(va_oth, __builtin_bit_cast(bf16x8, sb), (f32x4){0.f, 0.f, 0.f, 0.f}, 0, 0, 0); \
      *(f32x4*)(xown + lane * 16) = oth; \
      if (NVT == 3) { \
          \
        const f32x4 dp = __builtin_amdgcn_mfma_f32_16x16x32_bf16(vd, __builtin_bit_cast(bf16x8, sb), (f32x4){0.f, 0.f, 0.f, 0.f}, 0, 0, 0); \
        if (lane < 16) *(float*)(xown + 1024 + lane * 4) = dp[0]; \
        den_prev = __shfl(dacc[0], fr); em_prev = em; \
      } \
    } \
    rr_cur = rr_next; dsold_cur = dsold_next; ws_cur = ws_next; \
    lds_barrier(); \
  } while (0)
  static_assert(NCH % 2 == 0, "chunk count must be even");
#pragma unroll 1
  for (int n2 = 0; n2 < NCH; n2 += 2) { SCAN_ITER(n2, R, Rv); SCAN_ITER(n2 + 1, Rn, Rvn); }
  {
    const int lane = lane0, fr = lane & 15, fq = lane >> 4, it = wid & 3, vt = wid >> 2, pb = (NCH - 1) & 1;
    const unsigned char* xprev = lds + U_XCH + (pb * 8 + (wid ^ 4)) * 1088;
    const f32x4 pp = *(const f32x4*)(xprev + lane * 16);
    float dn = 1.0f;
    if (NVT == 3) { const float pd = *(const float*)(xprev + 1024 + fr * 4) + *(const float*)(lds + U_XCH + (pb * 8 + wid) * 1088 + 1024 + fr * 4); dn = 1.0f / fmaxf(fabsf(den_prev + pd), em_prev); }
    const int i = it * 16 + fr;
    const int ti = dir ? (SEQ - 1 - ((NCH - 1) * 64 + i)) : ((NCH - 1) * 64 + i);
    const f32x4 o = (f32x4){FMUL(own_prev[0] + pp[0], dn), FMUL(own_prev[1] + pp[1], dn), FMUL(own_prev[2] + pp[2], dn), FMUL(own_prev[3] + pp[3], dn)};
    *(u32x2*)(O + PIDX(tokbase + ti, ocol + vt * 16 + fq * 4)) = (u32x2){pk_hw(o[0], o[1]), pk_hw(o[2], o[3])};
  }
#undef SCAN_ITER
#undef A_LOAD
#undef A_PREP
}

template <int MIXER>
__device__ __forceinline__ void scan_dispatch2(unsigned char* lds, int wv, const Params& p, int id) {
  const int vs = id & 3, dir = (id >> 2) & 1, h = (id >> 3) & 3, b = id >> 5;
  scan_item2<MIXER>(lds, wv, p, b, h, dir, vs);
}
}

__device__ __forceinline__ void scan_phase2(unsigned char* lds, int wv, const Params& p, int layer, int convert) {
  bool light = false;
  for (int it0 = blockIdx.x; it0 < 256; it0 += gridDim.x) {
    const int xq = it0 & 7, yq = it0 >> 3, stream = (yq >> 2) * 8 + xq;
    const int item = (stream >> 5) * 128 + (stream & 31) * 4 + (yq & 3);
    if (layer == 0) { if (item < 128) scan2::scan_dispatch2<scan::MIX_A>(lds, wv, p, item); else scan2::scan_dispatch2<scan::MIX_B>(lds, wv, p, item - 128); }
    else { if (item < 128) scan2::scan_dispatch2<scan::MIX_D>(lds, wv, p, item); else scan2::scan_dispatch2<scan::MIX_C>(lds, wv, p, item - 128); }
    light = item >= 128;
    __syncthreads();
  }
  if (convert) {
    const int G = gridDim.x, b = blockIdx.x;
    if (G == 256) { if (light) { moe_weight_convert(lds, wv, p, layer, 0, b - 128, 128); } }
#if (PROBE_DUP & (524288 | 1048576))
    if (G == 256 && layer == ((PROBE_DUP & 524288) ? 0 : 1)) { if (light) { moe_weight_convert(lds, wv, p, layer, 0, b - 128, 128); } }
#endif
    else { moe_weight_convert(lds, wv, p, layer, 0, b, G); }
  }
}
#endif
#ifndef CPU_EMU
#define XB_BASE     2048
#define XB_TMO      (XB_BASE + 128)
#define XB_XCNT(j)  (XB_BASE + 256  + 64 * (j))
#define XB_XSUB(j)  (XB_BASE + 1280 + 64 * (j))
#define XB_XGEN(j)  (XB_BASE + 2304 + 64 * (j))
#define XB_TOP      (XB_BASE + 3328)
#define XB_TOPGEN   (XB_BASE + 3392)
#define XB_WORDS    3456
#define XB_SPIN_CAP (1u << 22)
#define XB_LDS_OFF  (LDS_BYTES - 16)
__device__ __forceinline__ unsigned xb_ld(unsigned* p)              { return __hip_atomic_load(p, __ATOMIC_RELAXED, __HIP_MEMORY_SCOPE_AGENT); }
__device__ __forceinline__ unsigned xb_add(unsigned* p, unsigned v) { return __hip_atomic_fetch_add(p, v, __ATOMIC_RELAXED, __HIP_MEMORY_SCOPE_AGENT); }
__device__ __forceinline__ unsigned xb_xcc_id() { return (unsigned)__builtin_amdgcn_s_getreg((3 << 11) | 20) & 0xFu; }
#define XB_SPIN(cond, bar) do { unsigned _sp = 0; while (cond) { __builtin_amdgcn_s_sleep(1); \
    if ((++_sp & 255u) == 0u) { if (xb_ld(&(bar)[XB_TMO])) break; if (_sp > XB_SPIN_CAP) { atomicAdd(&(bar)[XB_TMO], 1u); break; } } } } while (0)
__device__ __forceinline__ void grid_bar(unsigned* bar, unsigned char* lds_raw, int wv) {
  asm volatile("s_waitcnt vmcnt(0)" ::: "memory");
  __syncthreads();
  if (wv == 0 && lane_id() == 0) {
    volatile unsigned* st = (volatile unsigned*)(lds_raw + XB_LDS_OFF);
    __builtin_amdgcn_s_waitcnt(0);
    const unsigned x = xb_xcc_id();
    unsigned nloc = st[0], nx = st[1];
    const unsigned k = st[2];
    if (nloc == 0u) {
      const unsigned G = gridDim.x; unsigned sum, cnt, mine, sp = 0u;
      for (;;) { sum = 0u; cnt = 0u; mine = 0u;
#pragma unroll
        for (unsigned j = 0; j < 16; ++j) { const unsigned c = xb_ld(&bar[XB_XCNT(j)]); sum += c; cnt += (c > 0u) ? 1u : 0u; mine = (j == x) ? c : mine; }
        if (sum == G) break;
        __builtin_amdgcn_s_sleep(1);
        if ((++sp & 255u) == 0u) { if (xb_ld(&bar[XB_TMO])) break; if (sp > XB_SPIN_CAP) { atomicAdd(&bar[XB_TMO], 1u); break; } } }
      nloc = mine > 0u ? mine : 1u; nx = cnt > 0u ? cnt : 1u; st[0] = nloc; st[1] = nx;
    }
    st[2] = k + 1u;
    const unsigned old = xb_add(&bar[XB_XSUB(x)], 1u);
    if (old + 1u == (k + 1u) * nloc) {
      __builtin_amdgcn_fence(__ATOMIC_RELEASE, "agent");
      asm volatile("s_waitcnt vmcnt(0)" ::: "memory");
      (void)xb_add(&bar[XB_TOP], 1u);
    }
    XB_SPIN(xb_ld(&bar[XB_TOP]) < (k + 1u) * nx, bar);
    __builtin_amdgcn_fence(__ATOMIC_ACQUIRE, "agent");
    asm volatile("s_waitcnt vmcnt(0)" ::: "memory");
  }
  __syncthreads();
}
#if (PROBE_DUP & 16)
#define grid_bar(a, b, c) do { grid_bar(a, b, c); grid_bar(a, b, c); } while (0)
#endif

__global__ void __launch_bounds__(NTHREADS) mk_fwd(Params p) {
  extern __shared__ __attribute__((aligned(16))) unsigned char lds_raw[];
  cg::grid_group grid = cg::this_grid();
  const int G = gridDim.x, bid = blockIdx.x;
  const int wv = __builtin_amdgcn_readfirstlane(threadIdx.x >> 6);
  PG8_LAS unsigned char* lds = (PG8_LAS unsigned char*)lds_raw;
  unsigned char* ws = p.ws;

  if (threadIdx.x < 4) ((unsigned*)(lds_raw + XB_LDS_OFF))[threadIdx.x] = 0u;
  p0_prologue(lds_raw, wv, p);
#if (PROBE_DUP & 128)
  p0_prologue(lds_raw, wv, p);
#endif
  grid.sync();
  unsigned* bar = (unsigned*)(ws + WS_CTL);
  if (wv == 0 && lane_id() == 0) (void)xb_add(&bar[XB_XCNT(xb_xcc_id())], 1u);
  for (int layer = 0; layer < 2; ++layer) {
    { ProbInProj pr; pr.so.init(NTOK, layer == 0 ? PM_AB : PM_CD, G, bid); pr.A = (const char*)p.out; pr.Bt = (const char*)(ws + (layer == 0 ? WS_WIN_AB : WS_WIN_CD));
      pr.P = (bf16_t*)(ws + WS_R1); pr.bias = p.in[layer == 0 ? I_AB_B_IN : I_CD_B_IN]; pr.lb = (const float*)(ws + WS_LB); pr.layer = layer;
      pg8::gemm_phase(lds, pr, wv);
#if (PROBE_DUP & (1 | 2048))
      pg8::gemm_phase(lds, pr, wv);
#endif
      if (layer == 0) side_phase<32>(lds_raw, wv, p, 0); else side_phase<16>(lds_raw, wv, p, 1);
#if (PROBE_DUP & 256)
      if (layer == 0) side_phase<32>(lds_raw, wv, p, 0); else side_phase<16>(lds_raw, wv, p, 1);
#endif
 }
    grid_bar(bar, lds_raw, wv);
    if (layer == 1) { convd_phase(lds_raw, wv, p); grid_bar(bar, lds_raw, wv); }
    scan_phase2(lds_raw, wv, p, layer, 1);
#if (PROBE_DUP & 2)
    scan_phase2(lds_raw, wv, p, layer, 0);
#endif
#if (PROBE_DUP & 512)
    if (layer == 0) scan_phase2(lds_raw, wv, p, layer, 0);
#endif
#if (PROBE_DUP & 1024)
    if (layer == 1) scan_phase2(lds_raw, wv, p, layer, 0);
#endif
    grid_bar(bar, lds_raw, wv);
    headnorm_phase(lds_raw, wv, p, layer);
#if (PROBE_DUP & 8)
    headnorm_phase(lds_raw, wv, p, layer);
#endif
    grid_bar(bar, lds_raw, wv);
    { ProbOutProj pr; pr.so.init(NTOK, 1024, G, bid); pr.A = (const char*)(ws + WS_MIX); pr.Bt = (const char*)(ws + (layer == 0 ? WS_WOUT_AB : WS_WOUT_CD)); pr.Y = (bf16_t*)(ws + WS_R2); pr.Hres = (const bf16_t*)p.out;
      pg8::gemm_phase(lds, pr, wv);
#if (PROBE_DUP & (1 | 16384))
      pg8::gemm_phase(lds, pr, wv);
#endif
 }
    grid_bar(bar, lds_raw, wv);
#if (PROBE_DUP & 32)
    ln_phase(lds_raw, wv, p, layer, 0, 1);
#endif
    ln_phase(lds_raw, wv, p, layer, 0);
    grid_bar(bar, lds_raw, wv);
    { ProbMoe1 pr; pr.mo.init((const int*)((const unsigned*)(ws + WS_CTL) + CW_CNT(layer)), 8, G, bid, lds_raw, wv);
      pr.A = (const char*)(ws + WS_MIX); pr.W13 = (const char*)(ws + WS_W13); pr.list = (const int*)(ws + WS_LIST) + (size_t)layer * NEXP * NTOK; pr.H = (bf16_t*)(ws + WS_H);
      pg8::gemm_phase(lds, pr, wv);
#if (PROBE_DUP & (1 | 4096))
      pg8::gemm_phase(lds, pr, wv);
#endif
      moe_weight_convert_tix(lds_raw, wv, p, layer, 1, (unsigned*)(ws + WS_CTL) + CW_TIX(layer, 1));
 }
    grid_bar(bar, lds_raw, wv);
    { ProbMoe2 pr; pr.mo.init((const int*)((const unsigned*)(ws + WS_CTL) + CW_CNT(layer)), 4, G, bid, lds_raw, wv);
      pr.A = (const char*)(ws + WS_H); pr.W2 = (const char*)(ws + WS_W2); pr.Y = (bf16_t*)(ws + WS_R2);
      pg8::gemm_phase(lds, pr, wv);
#if (PROBE_DUP & (1 | 8192))
      pg8::gemm_phase(lds, pr, wv);
#endif
 }
    grid_bar(bar, lds_raw, wv);
#if (PROBE_DUP & 64)
    ln_phase(lds_raw, wv, p, layer, 1, 1);
#endif
    ln_phase(lds_raw, wv, p, layer, 1);
    if (layer == 0) grid_bar(bar, lds_raw, wv);
  }
}

extern "C" void kernel_launch(void* const* d_in, const int* in_sizes, int n_in, void* d_out, int out_size, void* d_ws, size_t ws_size, hipStream_t stream) {
  static int grid_blocks = 0;
  if (grid_blocks == 0) {
    if (n_in != N_IN || ws_size < WS_END || out_size != NTOK * 1024) { fprintf(stderr, "kernel_launch: bad shapes: n_in %d ws %zu (need %zu) out %d\n", n_in, ws_size, (size_t)WS_END, out_size); grid_blocks = -1; return; }
    int dev = 0, cus = 0, per_cu = 0;
    hipGetDevice(&dev); hipDeviceGetAttribute(&cus, hipDeviceAttributeMultiprocessorCount, dev);
    if (hipFuncSetAttribute((const void*)mk_fwd, hipFuncAttributeMaxDynamicSharedMemorySize, LDS_BYTES) != hipSuccess) { fprintf(stderr, "kernel_launch: hipFuncSetAttribute failed\n"); grid_blocks = -1; return; }
    if (hipOccupancyMaxActiveBlocksPerMultiprocessor(&per_cu, (const void*)mk_fwd, NTHREADS, LDS_BYTES) != hipSuccess || per_cu < 1) { fprintf(stderr, "kernel_launch: occupancy query failed (%d)\n", per_cu); grid_blocks = -1; return; }
    grid_blocks = cus;
    (void)in_sizes;
  }
  if (grid_blocks < 0) return;
  Params p{};
  for (int i = 0; i < N_IN; ++i) p.in[i] = (const float*)d_in[i];
  p.out = (float*)d_out; p.ws = (unsigned char*)d_ws;
  void* args[] = {&p};
  hipError_t e = hipLaunchCooperativeKernel((const void*)mk_fwd, dim3(grid_blocks), dim3(NTHREADS), args, LDS_BYTES, stream);
  if (e != hipSuccess) fprintf(stderr, "cooperative launch failed: %s (grid %d)\n", hipGetErrorString(e), grid_blocks);
}
#endif
```
